# Optimizing an MI355X kernel written in HIP

```python
import math
import jax, jax.numpy as jnp
from jax import lax
import numpy as np

D_MODEL = 1024
BATCH = 16
SEQ = 2048
DEPTH = 2

GRID_W = 64
CTX_LEN = 256
EPS = 1e-6
ROPE_BASE = 10000.0
F32 = jnp.float32

ML_HEADS = 4
ML_QK = 128
ML_V = 256
ML_CHUNK = 64
ML_QKW = ML_HEADS * ML_QK
ML_W = ML_HEADS * ML_V

SSD_HEADS = 16
SSD_P = 64
SSD_N = 64
SSD_GROUPS = 2
SSD_HPG = SSD_HEADS // SSD_GROUPS
SSD_CONV = 5
SSD_CHUNK = 64
SSD_W = SSD_HEADS * SSD_P
SSD_GN = SSD_GROUPS * SSD_N
SSD_XBC = SSD_W + 2 * SSD_GN

MLA_HEADS = 8
MLA_NOPE = 64
MLA_ROPE = 32
MLA_V = 64
MLA_Q_RANK = 384
MLA_KV_RANK = 256
MLA_SCALE = (MLA_NOPE + MLA_ROPE) ** -0.5
Q_BLOCK = 128

RW_HEADS = 16
RW_N = 64
RW_DECAY_RANK = 64
RW_A_RANK = 64
RW_GATE_RANK = 128
RW_W = RW_HEADS * RW_N

N_EXPERTS = 16
N_GROUPS = 4
EXPERTS_PER_GROUP = N_EXPERTS // N_GROUPS
TOP_K = 2
EXPERT_FF = 512

AB_SPLITS = (ML_QKW, ML_QKW, ML_W, ML_W, 2 * ML_HEADS, 2 * ML_HEADS, SSD_W, SSD_XBC, 2 * SSD_HEADS)
AB_IN = sum(AB_SPLITS)
AB_OUT = ML_W + SSD_W
MLA_SPLITS = (MLA_Q_RANK, MLA_KV_RANK, MLA_ROPE)
MLA_IN = sum(MLA_SPLITS)
RW_SPLITS = (RW_W, RW_W, RW_W, 2 * RW_DECAY_RANK, 2 * RW_A_RANK, RW_GATE_RANK)
RW_IN = sum(RW_SPLITS)
CD_IN = MLA_IN + RW_IN
CD_OUT = MLA_HEADS * MLA_V + RW_W

kernel_name = "hybrid_mlstm_ssd_mla_rwkv7_grouped_moe_dit"


def rmsnorm(x, w):
    xf = x.astype(F32)
    y = xf * lax.rsqrt(jnp.mean(xf * xf, axis=-1, keepdims=True) + EPS)
    return y.astype(x.dtype) * w


def head_rmsnorm(h, w):
    hf = h.astype(F32)
    y = hf * lax.rsqrt(jnp.mean(hf * hf, axis=-1, keepdims=True) + EPS)
    return y.reshape(*h.shape[:2], -1) * w


def split_cols(p, sizes):
    return jnp.split(p, [int(i) for i in np.cumsum(sizes)[:-1]], axis=-1)


def to_heads(t, n):
    return t.reshape(*t.shape[:-1], n, t.shape[-1] // n)


def to_chunks(t, L):
    B, T = t.shape[:2]
    return jnp.moveaxis(t.reshape(B, T // L, L, *t.shape[2:]), 1, 0)


def from_chunks(t):
    nc, B, L = t.shape[:3]
    return jnp.moveaxis(t, 0, 1).reshape(B, nc * L, *t.shape[3:])


def dwconv_centred(x, w, b):
    y = lax.conv_general_dilated(x, w[:, None, :].astype(x.dtype), (1,), 'SAME',
                                 dimension_numbers=('NWC', 'WIO', 'NWC'),
                                 feature_group_count=x.shape[-1])
    return y + b


def centred_shift(x):
    prev = jnp.pad(x, ((0, 0), (1, 0), (0, 0)))[:, :-1]
    nxt = jnp.pad(x, ((0, 0), (0, 1), (0, 0)))[:, 1:]
    return 0.5 * (prev + nxt)


def axial_angles(n_rows):
    row = jnp.repeat(jnp.arange(n_rows, dtype=F32), GRID_W)
    col = jnp.tile(jnp.arange(GRID_W, dtype=F32), n_rows)
    n_freq = MLA_ROPE // 4
    inv = ROPE_BASE ** (-jnp.arange(n_freq, dtype=F32) / n_freq)
    return jnp.concatenate([row[:, None] * inv, col[:, None] * inv], axis=-1)


def apply_rope(x, ang):
    x1, x2 = jnp.split(x, 2, axis=-1)
    cos, sin = jnp.cos(ang).astype(x.dtype), jnp.sin(ang).astype(x.dtype)
    return jnp.concatenate([x1 * cos - x2 * sin, x1 * sin + x2 * cos], axis=-1)


def attend_blocked(q, k, v):
    B, S, H, d = q.shape
    qb = jnp.moveaxis(q.reshape(B, S // Q_BLOCK, Q_BLOCK, H, d), 1, 0)

    def block(qi):
        s = jnp.einsum('bqhd,bkhd->bhqk', qi, k).astype(F32)
        p = jax.nn.softmax(s, axis=-1).astype(v.dtype)
        return jnp.einsum('bhqk,bkhv->bqhv', p, v)

    return from_chunks(lax.map(block, qb))


def prefixed_bidir(scan_fn, ctx_fwd, lat_fwd, ctx_bwd, lat_bwd, init):
    flip = lambda ts: tuple(jnp.flip(t, axis=1) for t in ts)
    yc_f, st_f = scan_fn(*ctx_fwd, init)
    yl_f, _ = scan_fn(*lat_fwd, st_f)
    yc_b, st_b = scan_fn(*flip(ctx_bwd), init)
    yl_b, _ = scan_fn(*flip(lat_bwd), st_b)
    return yc_f + jnp.flip(yc_b, axis=1), yl_f + jnp.flip(yl_b, axis=1)


def mlstm_chunked(q, k, v, ig, lf, state):
    L = ML_CHUNK
    mask = jnp.tril(jnp.ones((L, L), bool))[None, :, :, None]

    def step(carry, inp):
        C, n, m = carry
        qc, kc, vc, ic, fc = inp
        b = jnp.cumsum(fc, axis=1)
        logD = jnp.where(mask, b[:, :, None, :] - b[:, None, :, :] + ic[:, None, :, :], -jnp.inf)
        inter = b + m[:, None, :]
        m_j = jnp.maximum(inter, jnp.max(logD, axis=2))
        s = jnp.einsum('bjhd,bshd->bjsh', qc, kc) * jnp.exp(logD - m_j[:, :, None, :])
        w_int = jnp.exp(inter - m_j)
        num = jnp.einsum('bjsh,bshv->bjhv', s, vc) + w_int[..., None] * jnp.einsum('bhvd,bjhd->bjhv', C, qc)
        den = jnp.sum(s, axis=2) + w_int * jnp.einsum('bhd,bjhd->bjh', n, qc)
        h = num / jnp.maximum(jnp.abs(den), jnp.exp(-m_j))[..., None]
        logE = b[:, -1:, :] - b + ic
        m_new = jnp.maximum(b[:, -1] + m, jnp.max(logE, axis=1))
        E = jnp.exp(logE - m_new[:, None, :])
        dec = jnp.exp(b[:, -1] + m - m_new)
        C = dec[..., None, None] * C + jnp.einsum('bsh,bshv,bshd->bhvd', E, vc, kc)
        n = dec[..., None] * n + jnp.einsum('bsh,bshd->bhd', E, kc)
        return (C, n, m_new), h

    state, hs = lax.scan(step, state, tuple(to_chunks(t, L) for t in (q, k, v, ig, lf)))
    return from_chunks(hs), state


def ssd_chunked(x, dt, la, bm, cm, state):
    B, T = x.shape[:2]
    L = SSD_CHUNK
    x = x.reshape(B, T, SSD_GROUPS, SSD_HPG, SSD_P)
    dt = dt.reshape(B, T, SSD_GROUPS, SSD_HPG)
    la = la.reshape(B, T, SSD_GROUPS, SSD_HPG)
    mask = jnp.tril(jnp.ones((L, L), bool))[None, :, :, None, None]

    def step(S, inp):
        xc, dtc, lac, bc, cc = inp
        b = jnp.cumsum(lac, axis=1)
        seg = jnp.exp(jnp.where(mask, b[:, :, None] - b[:, None, :], -jnp.inf))
        cb = jnp.einsum('bjgn,bsgn->bjsg', cc, bc)
        w = cb[..., None] * seg * dtc[:, None]
        y = jnp.einsum('bjsgh,bsghp->bjghp', w, xc) + jnp.exp(b)[..., None] * jnp.einsum('bghpn,bjgn->bjghp', S, cc)
        e = jnp.exp(b[:, -1:] - b) * dtc
        S = jnp.exp(b[:, -1])[..., None, None] * S + jnp.einsum('bsgh,bsghp,bsgn->bghpn', e, xc, bc)
        return S, y

    state, ys = lax.scan(step, state, tuple(to_chunks(t, L) for t in (x, dt, la, bm, cm)))
    return from_chunks(ys).reshape(B, T, SSD_HEADS, SSD_P), state


def rwkv7_scan(r, w, k, v, a, b, state):
    def step(S, inp):
        r_t, w_t, k_t, v_t, a_t, b_t = inp
        sa = jnp.einsum('bhvk,bhk->bhv', S, a_t)
        S = S * w_t[:, :, None, :] + sa[..., None] * b_t[:, :, None, :] + v_t[..., None] * k_t[:, :, None, :]
        return S, jnp.einsum('bhvk,bhk->bhv', S, r_t)

    state, ys = lax.scan(step, state, tuple(jnp.moveaxis(t, 1, 0) for t in (r, w, k, v, a, b)))
    return jnp.moveaxis(ys, 0, 1), state


def mixer_ab(u_c, u_l, w_in, w_out, ml_i_bias, ml_f_bias, ml_norm, ssd_conv_w, ssd_conv_b,
             ssd_dt_bias, ssd_a_log, ssd_d, ssd_norm, with_ctx_out):
    Bsz = u_l.shape[0]
    p_c = split_cols(u_c @ w_in, AB_SPLITS)
    p_l = split_cols(u_l @ w_in, AB_SPLITS)

    def ml_dirs(p):
        q = to_heads(p[0].astype(F32), ML_HEADS) * ML_QK ** -0.5
        k = to_heads(p[1].astype(F32), ML_HEADS)
        v = to_heads(p[2].astype(F32), ML_HEADS)
        ig = to_heads(p[4].astype(F32), 2)
        fg = to_heads(p[5].astype(F32), 2)
        return [(q, k, v, ig[..., d, :] + ml_i_bias[d], jax.nn.log_sigmoid(fg[..., d, :] + ml_f_bias[d])) for d in range(2)]

    mc_f, mc_b = ml_dirs(p_c)
    mlf, mlb = ml_dirs(p_l)
    ml_init = (jnp.zeros((Bsz, ML_HEADS, ML_V, ML_QK), F32), jnp.zeros((Bsz, ML_HEADS, ML_QK), F32),
               jnp.zeros((Bsz, ML_HEADS), F32))
    h_c, h_l = prefixed_bidir(mlstm_chunked, mc_f, mlf, mc_b, mlb, ml_init)

    def ml_out(h, p):
        return head_rmsnorm(h, ml_norm) * jax.nn.sigmoid(p[3].astype(F32))

    def ssd_dirs(p):
        xbc = jax.nn.silu(dwconv_centred(p[7], ssd_conv_w, ssd_conv_b)).astype(F32)
        xs, bm, cm = split_cols(xbc, (SSD_W, SSD_GN, SSD_GN))
        xs, bm, cm = to_heads(xs, SSD_HEADS), to_heads(bm, SSD_GROUPS), to_heads(cm, SSD_GROUPS)
        dt_raw = to_heads(p[8].astype(F32), 2)
        out = []
        for d in range(2):
            dt = jax.nn.softplus(dt_raw[..., d, :] + ssd_dt_bias[d])
            out.append((xs, dt, -dt * jnp.exp(ssd_a_log[d]), bm, cm))
        return out

    sc_f, sc_b = ssd_dirs(p_c)
    sl_f, sl_b = ssd_dirs(p_l)
    ssd_init = jnp.zeros((Bsz, SSD_GROUPS, SSD_HPG, SSD_P, SSD_N), F32)
    y_c, y_l = prefixed_bidir(ssd_chunked, sc_f, sl_f, sc_b, sl_b, ssd_init)

    def ssd_out(y, xs, p):
        y = (y + ssd_d[:, None] * xs).reshape(*y.shape[:2], SSD_W)
        return rmsnorm(y * jax.nn.silu(p[6].astype(F32)), ssd_norm)

    mix_l = jnp.concatenate([ml_out(h_l, p_l), ssd_out(y_l, sl_f[0], p_l)], axis=-1).astype(u_l.dtype) @ w_out
    mix_c = None
    if with_ctx_out:
        mix_c = jnp.concatenate([ml_out(h_c, p_c), ssd_out(y_c, sc_f[0], p_c)], axis=-1).astype(u_c.dtype) @ w_out
    return mix_c, mix_l


def mixer_cd(u_c, u_l, ang, w_in, w_out, mla_qn, mla_w_uq, mla_kvn, mla_w_ukv, rw_mu, rw_w0, rw_w2,
             rw_a0, rw_a2, rw_g2, rw_kk, rw_ka, rw_rk, rw_ln, with_ctx_out):
    Bsz, S = u_l.shape[:2]

    def project(u):
        p = u @ w_in
        p_mla, p_rw = p[..., :MLA_IN], p[..., MLA_IN:].astype(F32)
        p_rw = p_rw + rw_mu * (centred_shift(p_rw) - p_rw)
        return split_cols(p_mla, MLA_SPLITS), split_cols(p_rw, RW_SPLITS)

    (m_c, r_c), (m_l, r_l) = project(u_c), project(u_l)

    def mla_q(m, rotate):
        q = to_heads(rmsnorm(m[0], mla_qn) @ mla_w_uq, MLA_HEADS)
        q_nope, q_rope = q[..., :MLA_NOPE], q[..., MLA_NOPE:]
        if rotate:
            q_rope = apply_rope(q_rope, ang[:, None, :])
        return jnp.concatenate([q_nope, q_rope], axis=-1) * MLA_SCALE

    def mla_kv(m, rotate):
        kv = to_heads(rmsnorm(m[1], mla_kvn) @ mla_w_ukv, MLA_HEADS)
        k_nope, v = kv[..., :MLA_NOPE], kv[..., MLA_NOPE:]
        kr = apply_rope(m[2], ang) if rotate else m[2]
        k_rope = jnp.broadcast_to(kr[:, :, None, :], (*kr.shape[:2], MLA_HEADS, MLA_ROPE))
        return jnp.concatenate([k_nope, k_rope], axis=-1), v

    k_c, v_c = mla_kv(m_c, False)
    k_l, v_l = mla_kv(m_l, True)
    att_l = attend_blocked(mla_q(m_l, True), jnp.concatenate([k_c, k_l], axis=1),
                           jnp.concatenate([v_c, v_l], axis=1))

    def rw_dirs(p):
        r, k, v, w_low, a_low, _ = p
        kk = to_heads(k * rw_kk, RW_HEADS)
        kk = kk / jnp.maximum(jnp.sqrt(jnp.sum(kk * kk, axis=-1, keepdims=True)), 1e-12)
        w_low, a_low = to_heads(w_low, 2), to_heads(a_low, 2)
        out = []
        for d in range(2):
            w_log = -jax.nn.softplus(-(rw_w0[d] + jnp.tanh(w_low[..., d, :]) @ rw_w2[d])) - 0.5
            a = jax.nn.sigmoid(rw_a0[d] + a_low[..., d, :] @ rw_a2[d])
            k_d = k * (1 + (a - 1) * rw_ka)
            out.append((to_heads(r, RW_HEADS), to_heads(jnp.exp(-jnp.exp(w_log)), RW_HEADS),
                        to_heads(k_d, RW_HEADS), to_heads(v, RW_HEADS), -kk, kk * to_heads(a, RW_HEADS)))
        return out

    rc_f, rc_b = rw_dirs(r_c)
    rl_f, rl_b = rw_dirs(r_l)
    rw_init = jnp.zeros((Bsz, RW_HEADS, RW_N, RW_N), F32)
    o_c, o_l = prefixed_bidir(rwkv7_scan, rc_f, rl_f, rc_b, rl_b, rw_init)

    def rw_out(o, p, dirs):
        bonus = sum(jnp.sum(dd[0] * dd[2] * rw_rk, axis=-1, keepdims=True) * dd[3] for dd in dirs)
        y = head_rmsnorm(o, rw_ln) + bonus.reshape(*o.shape[:2], RW_W)
        return y * (jax.nn.sigmoid(p[5]) @ rw_g2)

    mix_l = jnp.concatenate([att_l.reshape(Bsz, S, -1), rw_out(o_l, r_l, (rl_f, rl_b))],
                            axis=-1).astype(u_l.dtype) @ w_out
    mix_c = None
    if with_ctx_out:
        att_c = attend_blocked(mla_q(m_c, False), k_c, v_c)
        mix_c = jnp.concatenate([att_c.reshape(Bsz, u_c.shape[1], -1), rw_out(o_c, r_c, (rc_f, rc_b))],
                                axis=-1).astype(u_c.dtype) @ w_out
    return mix_c, mix_l


def swiglu(x, wg, wu, wd):
    return (jax.nn.silu(x @ wg) * (x @ wu)) @ wd


def moe(v, router_w, router_bias, w_gate, w_up, w_down, s_gate, s_up, s_down):
    B, T, D = v.shape
    xt = v.reshape(B * T, D)
    aff = jax.nn.sigmoid((xt @ router_w).astype(F32))
    sel = (aff + router_bias).reshape(-1, N_GROUPS, EXPERTS_PER_GROUP)
    g_idx = jnp.argmax(jnp.sum(lax.top_k(sel, TOP_K)[0], axis=-1), axis=-1)
    in_group = jnp.take_along_axis(sel, g_idx[:, None, None], axis=1)[:, 0]
    _, local = lax.top_k(in_group, TOP_K)
    e_idx = g_idx[:, None] * EXPERTS_PER_GROUP + local
    w = jnp.take_along_axis(aff, e_idx, axis=-1)
    w = w / jnp.sum(w, axis=-1, keepdims=True)
    gates = jnp.einsum('nk,nke->ne', w, jax.nn.one_hot(e_idx, N_EXPERTS, dtype=F32)).astype(xt.dtype)
    out = swiglu(xt, s_gate, s_up, s_down)
    for e in range(N_EXPERTS):
        out = out + gates[:, e:e + 1] * swiglu(xt, w_gate[e], w_up[e], w_down[e])
    return out.reshape(B, T, D)


def setup_inputs(seed: int = 0) -> dict:
    key = jax.random.key(seed)
    keys = jax.random.split(key, 64)
    counter = [0]

    def nxt():
        k = keys[counter[0]]
        counter[0] += 1
        return k

    def nrm(shape, scale=1.0):
        return jax.random.normal(nxt(), shape, F32) * scale

    def unif(shape, lo, hi):
        return jax.random.uniform(nxt(), shape, F32, lo, hi)

    D = D_MODEL
    NE, NO = (DEPTH + 1) // 2, DEPTH // 2
    dt0 = jnp.exp(unif((NE, 2, SSD_HEADS), math.log(1e-3), math.log(1e-1)))
    return {
        "x": nrm((BATCH, SEQ, D)),
        "c": nrm((BATCH, D)),
        "ctx": nrm((BATCH, CTX_LEN, D)),
        "c_ctx": nrm((D,)),
        "w_mod": nrm((DEPTH, D, 6 * D), 0.5 * D ** -0.5),
        "b_mod": nrm((DEPTH, 6 * D), 0.02),
        "norm_g": 1.0 + nrm((DEPTH, 4, D), 0.05),
        "ab_w_in": nrm((NE, D, AB_IN), D ** -0.5),
        "ab_w_out": nrm((NE, AB_OUT, D), AB_OUT ** -0.5),
        "ml_i_bias": nrm((NE, 2, ML_HEADS), 0.1) - 1.0,
        "ml_f_bias": unif((NE, 2, ML_HEADS), 3.0, 6.0),
        "ml_norm": 1.0 + nrm((NE, ML_W), 0.05),
        "ssd_conv_w": nrm((NE, SSD_CONV, SSD_XBC), SSD_CONV ** -0.5),
        "ssd_conv_b": nrm((NE, SSD_XBC), 0.02),
        "ssd_dt_bias": dt0 + jnp.log(-jnp.expm1(-dt0)),
        "ssd_a_log": jnp.log(unif((NE, 2, SSD_HEADS), 1.0, 16.0)),
        "ssd_d": 1.0 + nrm((NE, SSD_HEADS), 0.1),
        "ssd_norm": 1.0 + nrm((NE, SSD_W), 0.05),
        "cd_w_in": nrm((NO, D, CD_IN), D ** -0.5),
        "cd_w_out": nrm((NO, CD_OUT, D), CD_OUT ** -0.5),
        "mla_qn": 1.0 + nrm((NO, MLA_Q_RANK), 0.05),
        "mla_w_uq": nrm((NO, MLA_Q_RANK, MLA_HEADS * (MLA_NOPE + MLA_ROPE)), MLA_Q_RANK ** -0.5),
        "mla_kvn": 1.0 + nrm((NO, MLA_KV_RANK), 0.05),
        "mla_w_ukv": nrm((NO, MLA_KV_RANK, MLA_HEADS * (MLA_NOPE + MLA_V)), MLA_KV_RANK ** -0.5),
        "rw_mu": unif((NO, RW_IN), 0.0, 1.0),
        "rw_w0": unif((NO, 2, RW_W), -6.0, -1.0),
        "rw_w2": nrm((NO, 2, RW_DECAY_RANK, RW_W), 0.1),
        "rw_a0": nrm((NO, 2, RW_W), 0.1),
        "rw_a2": nrm((NO, 2, RW_A_RANK, RW_W), 0.1),
        "rw_g2": nrm((NO, RW_GATE_RANK, RW_W), RW_GATE_RANK ** -0.5),
        "rw_kk": 0.85 + nrm((NO, RW_W), 0.05),
        "rw_ka": 1.0 + nrm((NO, RW_W), 0.05),
        "rw_rk": nrm((NO, RW_HEADS, RW_N), 0.1),
        "rw_ln": 1.0 + nrm((NO, RW_W), 0.05),
        "router_w": nrm((D, N_EXPERTS), D ** -0.5),
        "router_bias": nrm((N_EXPERTS,), 0.01),
        "exp_w_gate": nrm((DEPTH, N_EXPERTS, D, EXPERT_FF), D ** -0.5),
        "exp_w_up": nrm((DEPTH, N_EXPERTS, D, EXPERT_FF), D ** -0.5),
        "exp_w_down": nrm((DEPTH, N_EXPERTS, EXPERT_FF, D), EXPERT_FF ** -0.5),
        "sh_w_gate": nrm((DEPTH, D, EXPERT_FF), D ** -0.5),
        "sh_w_up": nrm((DEPTH, D, EXPERT_FF), D ** -0.5),
        "sh_w_down": nrm((DEPTH, EXPERT_FF, D), EXPERT_FF ** -0.5),
    }


def reference(x, c, ctx, c_ctx, w_mod, b_mod, norm_g, ab_w_in, ab_w_out, ml_i_bias, ml_f_bias, ml_norm,
              ssd_conv_w, ssd_conv_b, ssd_dt_bias, ssd_a_log, ssd_d, ssd_norm, cd_w_in, cd_w_out, mla_qn,
              mla_w_uq, mla_kvn, mla_w_ukv, rw_mu, rw_w0, rw_w2, rw_a0, rw_a2, rw_g2, rw_kk, rw_ka, rw_rk,
              rw_ln, router_w, router_bias, exp_w_gate, exp_w_up, exp_w_down, sh_w_gate, sh_w_up, sh_w_down):
    n_rows = x.shape[1] // GRID_W
    ang = axial_angles(n_rows)
    s_lat = jax.nn.silu(c)[:, None, :]
    s_ctx = jax.nn.silu(c_ctx)
    h_l, h_c = x, ctx
    for l in range(DEPTH):
        last = l == DEPTH - 1
        sh_a, sc_a, g_a, sh_f, sc_f, g_f = jnp.split(s_lat @ w_mod[l] + b_mod[l], 6, axis=-1)
        csh_a, csc_a, cg_a, csh_f, csc_f, cg_f = jnp.split(s_ctx @ w_mod[l] + b_mod[l], 6, axis=-1)
        u_l = rmsnorm(h_l, norm_g[l, 0]) * (1 + sc_a) + sh_a
        u_c = rmsnorm(h_c, norm_g[l, 0]) * (1 + csc_a) + csh_a
        i = l // 2
        if l % 2 == 0:
            y_c, y_l = mixer_ab(u_c, u_l, ab_w_in[i], ab_w_out[i], ml_i_bias[i], ml_f_bias[i], ml_norm[i],
                                ssd_conv_w[i], ssd_conv_b[i], ssd_dt_bias[i], ssd_a_log[i], ssd_d[i],
                                ssd_norm[i], not last)
        else:
            y_c, y_l = mixer_cd(u_c, u_l, ang, cd_w_in[i], cd_w_out[i], mla_qn[i], mla_w_uq[i], mla_kvn[i],
                                mla_w_ukv[i], rw_mu[i], rw_w0[i], rw_w2[i], rw_a0[i], rw_a2[i], rw_g2[i],
                                rw_kk[i], rw_ka[i], rw_rk[i], rw_ln[i], not last)
        h_l = h_l + g_a * rmsnorm(y_l, norm_g[l, 1])
        v_l = rmsnorm(h_l, norm_g[l, 2]) * (1 + sc_f) + sh_f
        moe_w = (router_w, router_bias, exp_w_gate[l], exp_w_up[l], exp_w_down[l], sh_w_gate[l], sh_w_up[l], sh_w_down[l])
        if last:
            f_l = moe(v_l, *moe_w)
        else:
            h_c = h_c + cg_a * rmsnorm(y_c, norm_g[l, 1])
            v_c = rmsnorm(h_c, norm_g[l, 2]) * (1 + csc_f) + csh_f
            f = moe(jnp.concatenate([v_c, v_l], axis=1), *moe_w)
            f_c, f_l = f[:, :v_c.shape[1]], f[:, v_c.shape[1]:]
            h_c = h_c + cg_f * rmsnorm(f_c, norm_g[l, 3])
        h_l = h_l + g_f * rmsnorm(f_l, norm_g[l, 3])
    return h_l
```

```cpp
#include <hip/hip_runtime.h>
#include <stdint.h>
#include <stdio.h>

typedef unsigned short bf16_t;
typedef short bf16x8 __attribute__((ext_vector_type(8)));
typedef float f32x4 __attribute__((ext_vector_type(4)));
typedef float f32x2 __attribute__((ext_vector_type(2)));
typedef unsigned u32x4 __attribute__((ext_vector_type(4)));
typedef unsigned u32x2 __attribute__((ext_vector_type(2)));

#ifndef N_LAUNCH_MODE
#define N_LAUNCH_MODE 1
#endif

constexpr int NB = 16, SEQ = 2048, CTXL = 256, TT = 2304, D = 1024;
constexpr int NTOK = NB * TT, NLAT = NB * SEQ;
constexpr int NG = 2, BG = NB / NG, RG = BG * TT, RGL = BG * SEQ;
constexpr float EPS = 1e-6f;
constexpr int AB_N = 5424, AB_NPAD = 5504, AB_Q = 0, AB_K = 512, AB_V = 1024, AB_OG = 2048, AB_IG = 3072, AB_FG = 3080, AB_Z = 3088, AB_XBC = 4112, AB_DT = 5392;
constexpr int CD_N = 4128, CD_NPAD = 4224, CD_M0 = 0, CD_M1 = 384, CD_KR = 640, CD_R = 672, CD_K = 1696, CD_V = 2720, CD_WL = 3744, CD_AL = 3872, CD_GL = 4000;
constexpr int CD_RW0 = 672;

constexpr size_t CTL_BYTES = 32768;
constexpr size_t CTL_CNT = 16384;
constexpr size_t WS_MODV = CTL_BYTES;
constexpr size_t WS_HC   = WS_MODV + (size_t)2 * 17 * 6144 * 4;
constexpr size_t WS_TOKE = WS_HC + (size_t)NB * CTXL * D * 4;
constexpr size_t WS_TOKP = WS_TOKE + (size_t)NTOK * 2 * 4;
constexpr size_t WS_TOKW = WS_TOKP + (size_t)NTOK * 2 * 4;
constexpr size_t WS_LIST = WS_TOKW + (size_t)NTOK * 2 * 4;
constexpr size_t WS_BSC  = WS_LIST + (size_t)16 * NTOK * 4;
constexpr size_t WS_SG   = WS_BSC + (size_t)2 * RGL * 16 * 4;
constexpr size_t WS_WMIX = WS_SG + (size_t)RGL * 128 * 2;
constexpr size_t WMIX_BYTES = (size_t)16 << 20;
constexpr size_t WS_V    = WS_WMIX + WMIX_BYTES;
constexpr size_t WS_BIG  = WS_V + (size_t)NTOK * D * 2;
constexpr size_t WM_AB_IN = 0, WM_AB_OUT = (size_t)AB_NPAD * 1024 * 2;
constexpr size_t WM_CD_IN = 0, WM_CD_OUT = (size_t)CD_NPAD * 1024 * 2, WM_UQ = WM_CD_OUT + (size_t)1024 * 1536 * 2, WM_UKV = WM_UQ + (size_t)768 * 384 * 2, WM_G2 = WM_UKV + (size_t)1024 * 256 * 2;
static_assert(WM_AB_OUT + (size_t)1024 * 2048 * 2 <= WMIX_BYTES, "wmix ab");
static_assert(WM_G2 + (size_t)1024 * 128 * 2 <= WMIX_BYTES, "wmix cd");
constexpr size_t SZ_RG1K = (size_t)RG * 1024 * 2, SZ_RGL1K = (size_t)RGL * 1024 * 2;
constexpr size_t L0_P = 0, L0_HF = (size_t)RG * AB_N * 2, L0_HB = L0_HF + SZ_RG1K, L0_YF = L0_HB + SZ_RG1K, L0_YB = L0_YF + SZ_RG1K, L0_U = L0_YB + SZ_RG1K, L0_END = L0_U + SZ_RG1K;
constexpr size_t L1_P = 0, L1_Q = (size_t)RG * CD_N * 2, L1_KV = L1_Q + (size_t)RGL * 768 * 2, L1_OF = L1_KV + SZ_RG1K, L1_OB = L1_OF + SZ_RGL1K, L1_AOUT = L1_OB + SZ_RGL1K, L1_U = L1_AOUT + (size_t)RGL * 1536 * 2, L1_END = L1_U + SZ_RG1K;
constexpr size_t MOE_EXP_BYTES = (size_t)3 * 1024 * 512 * 2;
constexpr size_t MO_W = 0, MO_HID = (size_t)17 * MOE_EXP_BYTES, MO_CON = MO_HID + (size_t)3 * NTOK * 512 * 2, MO_END = MO_CON + (size_t)3 * NTOK * 1024 * 2;
constexpr size_t BIG_BYTES = MO_END > L0_END ? (MO_END > L1_END ? MO_END : L1_END) : (L0_END > L1_END ? L0_END : L1_END);
constexpr size_t WS_NEED = WS_BIG + BIG_BYTES;

constexpr int LDS_BYTES = 147456;

__device__ __forceinline__ float bf2f(unsigned short h) { return __uint_as_float(((unsigned)h) << 16); }
__device__ __forceinline__ unsigned short f2bf(float f) { unsigned u = __float_as_uint(f); u += 0x7fffu + ((u >> 16) & 1u); return (unsigned short)(u >> 16); }
__device__ __forceinline__ unsigned pack2(float a, float b) { return (unsigned)f2bf(a) | ((unsigned)f2bf(b) << 16); }
__device__ __forceinline__ float lo2f(unsigned w) { return __uint_as_float(w << 16); }
__device__ __forceinline__ float hi2f(unsigned w) { return __uint_as_float(w & 0xffff0000u); }
__device__ __forceinline__ float wsum(float v) {
#pragma unroll
    for (int o = 32; o; o >>= 1) v += __shfl_xor(v, o);
    return v; }
__device__ __forceinline__ float sigmoidf_(float x) { return 1.0f / (1.0f + __expf(-x)); }
__device__ __forceinline__ float siluf_(float x) { return x / (1.0f + __expf(-x)); }
__device__ __forceinline__ float softplusf_(float x) { return fmaxf(x, 0.0f) + log1pf(__expf(-fabsf(x))); }
__device__ __forceinline__ float logsigmoidf_(float x) { return fminf(x, 0.0f) - log1pf(__expf(-fabsf(x))); }
__device__ __forceinline__ f32x4 mma16(bf16x8 a, bf16x8 b, f32x4 c) { return __builtin_amdgcn_mfma_f32_16x16x32_bf16(a, b, c, 0, 0, 0); }
__device__ __forceinline__ bf16x8 ldfrag(const bf16_t* base, int ld, int row0, int k0, int fr, int fq) { return *(const bf16x8*)(base + (row0 + fr) * ld + k0 + fq * 8); }
__device__ __forceinline__ void st4bf(bf16_t* p, f32x4 v) { u32x2 w; w.x = pack2(v[0], v[1]); w.y = pack2(v[2], v[3]); *(u32x2*)p = w; }
__device__ __forceinline__ f32x4 ld4bf(const bf16_t* p) { u32x2 w = *(const u32x2*)p; return (f32x4){lo2f(w.x), hi2f(w.x), lo2f(w.y), hi2f(w.y)}; }

#define PHASE_FN __device__ __forceinline__
__device__ __forceinline__ int otid() { int t = threadIdx.x; asm volatile("" : "+v"(t)); return t; }
__device__ __forceinline__ int obid() { int t = blockIdx.x; asm volatile("" : "+s"(t)); return t; }
struct KP { const float* in[42]; float* out; unsigned char* ws; int ph_lo, ph_hi; };

#define XB_TMO      128
#define XB_XCNT(j)  (256  + 64 * (j))
#define XB_XSUB(j)  (1280 + 64 * (j))
#define XB_XGEN(j)  (2304 + 64 * (j))
#define XB_TOP      3328
#define XB_TOPGEN   3392
#define XCD_BAR_WORDS 3456
#define XB_SPIN_CAP (1u << 18)
#define LAS __attribute__((address_space(3)))

__device__ __forceinline__ unsigned xb_ld(unsigned* p)              { return __hip_atomic_load(p, __ATOMIC_RELAXED, __HIP_MEMORY_SCOPE_AGENT); }
__device__ __forceinline__ unsigned xb_add(unsigned* p, unsigned v) { return __hip_atomic_fetch_add(p, v, __ATOMIC_RELAXED, __HIP_MEMORY_SCOPE_AGENT); }
__device__ __forceinline__ unsigned xb_xcc_id() { return (unsigned)__builtin_amdgcn_s_getreg((3 << 11) | 20) & 0xFu; }
#define XB_SPIN(cond, bar) do { unsigned _sp = 0; while (cond) { __builtin_amdgcn_s_sleep(1); \
    if ((++_sp & 255u) == 0u) { if (xb_ld(&(bar)[XB_TMO])) break; if (_sp > XB_SPIN_CAP) { atomicAdd(&(bar)[XB_TMO], 1u); break; } } } } while (0)

struct XcdBarrier {
    unsigned* bar; unsigned x;
    volatile LAS unsigned* st;
};

__device__ __forceinline__ XcdBarrier xcd_barrier_post(unsigned* bar, volatile LAS unsigned* st) {
    XcdBarrier b; b.bar = bar; b.x = xb_xcc_id(); b.st = st;
    if (threadIdx.x == 0) (void)xb_add(&bar[XB_XCNT(b.x)], 1u);
    return b;
}
__device__ __forceinline__ void xcd_barrier_complete(unsigned* bar, unsigned x, unsigned& nloc, unsigned& nx) {
    const unsigned G = gridDim.x * gridDim.y * gridDim.z;
    unsigned sum, cnt, mine, sp = 0u;
    for (;;) {
        sum = 0u; cnt = 0u; mine = 0u;
#pragma unroll
        for (unsigned j = 0; j < 16; ++j) { const unsigned c = xb_ld(&bar[XB_XCNT(j)]); sum += c; cnt += (c > 0u) ? 1u : 0u; mine = (j == x) ? c : mine; }
        if (sum == G) break;
        __builtin_amdgcn_s_sleep(1);
        if ((++sp & 255u) == 0u) { if (xb_ld(&bar[XB_TMO])) break; if (sp > XB_SPIN_CAP) { atomicAdd(&bar[XB_TMO], 1u); break; } }
    }
    nloc = mine > 0u ? mine : 1u; nx = cnt > 0u ? cnt : 1u;
}

__device__ __forceinline__ void xcd_barrier(const XcdBarrier& b) {
    asm volatile("s_waitcnt vmcnt(0)" ::: "memory");
    __syncthreads();
    if (threadIdx.x == 0) {
        unsigned* bar = b.bar;
        __builtin_amdgcn_s_waitcnt(0);
        unsigned nloc = b.st[0], nx = b.st[1];
        if (nloc == 0u) { xcd_barrier_complete(bar, b.x, nloc, nx); b.st[0] = nloc; b.st[1] = nx; }
        const unsigned old = xb_add(&bar[XB_XSUB(b.x)], 1u);
        const unsigned gen = old / nloc;
        if (old + 1u == (gen + 1u) * nloc) {
            __builtin_amdgcn_fence(__ATOMIC_RELEASE, "agent");
            asm volatile("s_waitcnt vmcnt(0)" ::: "memory");
            const unsigned og = xb_add(&bar[XB_TOP], 1u);
            const unsigned tg = og / nx;
            if (og + 1u == (tg + 1u) * nx) xb_add(&bar[XB_TOPGEN], 1u);
            else XB_SPIN(xb_ld(&bar[XB_TOPGEN]) == tg, bar);
            __builtin_amdgcn_fence(__ATOMIC_ACQUIRE, "agent");
            xb_add(&bar[XB_XGEN(b.x)], 1u);
            asm volatile("s_waitcnt vmcnt(0)" ::: "memory");
        } else {
            XB_SPIN(xb_ld(&bar[XB_XGEN(b.x)]) == gen, bar);
            __builtin_amdgcn_fence(__ATOMIC_ACQUIRE, "agent");
            asm volatile("s_waitcnt vmcnt(0)" ::: "memory");
        }
    }
    __syncthreads();
}
struct GA {
    const bf16_t* a0; const bf16_t* a1;
    int ld0, ld1, ksplit;
    const int* list;
    int nrows;
    int mode;
    int row0;
};
constexpr int G_LDT = 40;
constexpr int GEMM_LDS = (2 * 256 * G_LDT + 2 * 128 * G_LDT) * 2;

template <class Epi>
__device__ __forceinline__ void gemm_tile(unsigned char* lds, const GA& ga, const bf16_t* __restrict__ Bt, int K, int mt, int nt, const Epi& epi) {
    const int tid = otid(), lane = tid & 63, wid = tid >> 6, wm = wid >> 1, wn = wid & 1, fr = lane & 15, fq = lane >> 4;
    bf16_t* sA = (bf16_t*)lds;
    bf16_t* sB = sA + 2 * 256 * G_LDT;
    const int kp = tid & 3;
    const int r0 = tid >> 2, r1 = r0 + 128;
    int s0, s1;
    {
        int lr = mt * 256 + r0; if (lr >= ga.nrows) lr = 0;
        s0 = ga.list ? ga.list[lr] : (ga.mode == 1 ? (lr >> 11) * TT + CTXL + (lr & 2047) : ga.row0 + lr);
        lr = mt * 256 + r1; if (lr >= ga.nrows) lr = 0;
        s1 = ga.list ? ga.list[lr] : (ga.mode == 1 ? (lr >> 11) * TT + CTXL + (lr & 2047) : ga.row0 + lr);
    }
    const bf16_t* pa00 = ga.a0 + (size_t)s0 * ga.ld0 + kp * 8;
    const bf16_t* pa01 = ga.a0 + (size_t)s1 * ga.ld0 + kp * 8;
    const bf16_t* pa10 = ga.a1 ? ga.a1 + (size_t)s0 * ga.ld1 + kp * 8 : pa00;
    const bf16_t* pa11 = ga.a1 ? ga.a1 + (size_t)s1 * ga.ld1 + kp * 8 : pa01;
    const bf16_t* pb = Bt + (size_t)(nt * 128 + r0) * K + kp * 8;
    const int ksplit = ga.ksplit;
    f32x4 acc[4][4];
#pragma unroll
    for (int i = 0; i < 4; ++i)
#pragma unroll
        for (int j = 0; j < 4; ++j) acc[i][j] = (f32x4){0.f, 0.f, 0.f, 0.f};
    const int nk = K >> 5;
    u32x4 ra0, ra1, rb;
    {
        ra0 = *(const u32x4*)(pa00); ra1 = *(const u32x4*)(pa01); rb = *(const u32x4*)(pb);
        if (0 >= ksplit) { ra0 = *(const u32x4*)(pa10); ra1 = *(const u32x4*)(pa11); }
    }
    *(u32x4*)(sA + (r0) * G_LDT + kp * 8) = ra0;
    *(u32x4*)(sA + (r1) * G_LDT + kp * 8) = ra1;
    *(u32x4*)(sB + (r0) * G_LDT + kp * 8) = rb;
    __syncthreads();
    for (int kt = 0; kt < nk; ++kt) {
        const int cur = kt & 1;
        if (kt + 1 < nk) {
            const int k0 = (kt + 1) << 5;
            if (k0 < ksplit) { ra0 = *(const u32x4*)(pa00 + k0); ra1 = *(const u32x4*)(pa01 + k0); }
            else { ra0 = *(const u32x4*)(pa10 + (k0 - ksplit)); ra1 = *(const u32x4*)(pa11 + (k0 - ksplit)); }
            rb = *(const u32x4*)(pb + k0);
        }
        const bf16_t* cA = sA + cur * 256 * G_LDT;
        const bf16_t* cB = sB + cur * 128 * G_LDT;
        bf16x8 af[4], bfr[4];
#pragma unroll
        for (int i = 0; i < 4; ++i) af[i] = ldfrag(cA, G_LDT, wm * 64 + i * 16, 0, fr, fq);
#pragma unroll
        for (int j = 0; j < 4; ++j) bfr[j] = ldfrag(cB, G_LDT, wn * 64 + j * 16, 0, fr, fq);
#pragma unroll
        for (int i = 0; i < 4; ++i)
#pragma unroll
            for (int j = 0; j < 4; ++j) acc[i][j] = mma16(bfr[j], af[i], acc[i][j]);
        if (kt + 1 < nk) {
            const int nb = cur ^ 1;
            *(u32x4*)(sA + (nb * 256 + r0) * G_LDT + kp * 8) = ra0;
            *(u32x4*)(sA + (nb * 256 + r1) * G_LDT + kp * 8) = ra1;
            *(u32x4*)(sB + (nb * 128 + r0) * G_LDT + kp * 8) = rb;
        }
        __syncthreads();
    }
    epi(acc, mt * 256 + wm * 64, nt * 128 + wn * 64, fr, fq);
}

struct EpiBf {
    bf16_t* out; int ld, nrows, ncols;
    __device__ __forceinline__ void operator()(const f32x4 (&acc)[4][4], int rb, int cb, int fr, int fq) const {
#pragma unroll
        for (int i = 0; i < 4; ++i) { const int lr = rb + i * 16 + fr; if (lr < nrows) {
#pragma unroll
            for (int j = 0; j < 4; ++j) { const int col = cb + j * 16 + fq * 4; if (col < ncols) st4bf(out + (size_t)lr * ld + col, acc[i][j]); } } }
    }
};
struct EpiSwiglu {
    bf16_t* out; int nrows;
    __device__ __forceinline__ void operator()(const f32x4 (&acc)[4][4], int rb, int cb, int fr, int fq) const {
#pragma unroll
        for (int i = 0; i < 4; ++i) { const int lr = rb + i * 16 + fr; if (lr < nrows) {
#pragma unroll
            for (int j = 0; j < 2; ++j) { const int col = (cb >> 1) + j * 16 + fq * 4; f32x4 g = acc[i][j], u = acc[i][j + 2], o;
#pragma unroll
                for (int r = 0; r < 4; ++r) o[r] = siluf_(g[r]) * u[r];
                st4bf(out + (size_t)lr * 512 + col, o); } } }
    }
};

#define WSP(T, off) ((T*)(kp.ws + (off)))

PHASE_FN void phase_mod(const KP& kp, unsigned char* lds) {
    float* sc = (float*)lds;
    float* red = sc + 17 * 1024;
    float* modv = WSP(float, WS_MODV);
    const int tid = otid();
    for (int i = tid; i < 17 * 1024; i += 512) { const int bb = i >> 10, k = i & 1023; const float c = bb < 16 ? kp.in[1][bb * 1024 + k] : kp.in[3][k]; sc[i] = siluf_(c); }
    __syncthreads();
    const int jc = tid & 63, ks = tid >> 6;
    for (int u = obid(); u < 192; u += gridDim.x) {
        const int l = u / 96, j0 = (u % 96) * 64;
        const float* w = kp.in[4] + (size_t)l * 1024 * 6144 + j0 + jc;
        float acc[17];
#pragma unroll
        for (int bb = 0; bb < 17; ++bb) acc[bb] = 0.f;
        for (int k = ks * 128; k < ks * 128 + 128; ++k) {
            const float wv = w[(size_t)k * 6144];
#pragma unroll
            for (int bb = 0; bb < 17; ++bb) acc[bb] += sc[bb * 1024 + k] * wv;
        }
#pragma unroll
        for (int bb = 0; bb < 17; ++bb) red[(ks * 17 + bb) * 64 + jc] = acc[bb];
        __syncthreads();
        for (int i = tid; i < 17 * 64; i += 512) {
            const int bb = i >> 6, j = i & 63; float s = kp.in[5][l * 6144 + j0 + j];
#pragma unroll
            for (int k2 = 0; k2 < 8; ++k2) s += red[(k2 * 17 + bb) * 64 + j];
            modv[((size_t)l * 17 + bb) * 6144 + j0 + j] = s;
        }
        __syncthreads();
    }
}

__device__ __forceinline__ void conv_tile(float* tile, const float* src, int N, int ldsrc, bf16_t* dst, int ldd, int mode, int kt, int ntile) {
    const int tid = otid(), c = tid & 63, r8 = tid >> 6;
#pragma unroll
    for (int i = 0; i < 8; ++i) { const int k = i * 8 + r8, n = ntile * 64 + c; tile[k * 65 + c] = (n < N) ? src[(size_t)(kt * 64 + k) * ldsrc + n] : 0.f; }
    __syncthreads();
#pragma unroll
    for (int i = 0; i < 8; ++i) { const int nl = i * 8 + r8, n = ntile * 64 + nl;
        if (n < N) { int row = n; if (mode) row = (n >> 6) * 128 + ((n >> 5) & 1) * 64 + (n & 31) + (mode == 2 ? 32 : 0);
            dst[(size_t)row * ldd + kt * 64 + c] = f2bf(tile[c * 65 + nl]); } }
    __syncthreads();
}
__device__ __forceinline__ bool conv_job(float* tile, int& u, const float* src, int K, int N, bf16_t* dst, int mode = 0, int ldd = -1) {
    const int ntl = (N + 63) >> 6, ktl = K >> 6, cnt = ntl * ktl;
    if (u < cnt) { conv_tile(tile, src, N, N, dst, ldd < 0 ? K : ldd, mode, u / ntl, u % ntl); return true; }
    u -= cnt; return false;
}
PHASE_FN void phase_conv_ab(const KP& kp, unsigned char* lds) {
    float* tile = (float*)lds;
    const int total = 16 * 85 + 32 * 16;
    for (int u0 = obid(); u0 < total; u0 += gridDim.x) { int u = u0;
        if (conv_job(tile, u, kp.in[7], 1024, AB_N, WSP(bf16_t, WS_WMIX + WM_AB_IN))) continue;
        conv_job(tile, u, kp.in[8], 2048, 1024, WSP(bf16_t, WS_WMIX + WM_AB_OUT)); }
}
PHASE_FN void phase_conv_cd(const KP& kp, unsigned char* lds) {
    float* tile = (float*)lds;
    const int total = 16 * 65 + 24 * 16 + 6 * 12 + 4 * 16 + 2 * 16;
    for (int u0 = obid(); u0 < total; u0 += gridDim.x) { int u = u0;
        if (conv_job(tile, u, kp.in[18], 1024, CD_N, WSP(bf16_t, WS_WMIX + WM_CD_IN))) continue;
        if (conv_job(tile, u, kp.in[19], 1536, 1024, WSP(bf16_t, WS_WMIX + WM_CD_OUT))) continue;
        if (conv_job(tile, u, kp.in[21], 384, 768, WSP(bf16_t, WS_WMIX + WM_UQ))) continue;
        if (conv_job(tile, u, kp.in[23], 256, 1024, WSP(bf16_t, WS_WMIX + WM_UKV))) continue;
        conv_job(tile, u, kp.in[29], 128, 1024, WSP(bf16_t, WS_WMIX + WM_G2)); }
}
PHASE_FN void phase_conv_moe(const KP& kp, unsigned char* lds, int l) {
    float* tile = (float*)lds;
    const int total = 17 * 384;
    for (int u0 = obid(); u0 < total; u0 += gridDim.x) {
        const int es = u0 / 384; int u = u0 % 384;
        const float* wg = es < 16 ? kp.in[36] + ((size_t)l * 16 + es) * 1024 * 512 : kp.in[39] + (size_t)l * 1024 * 512;
        const float* wu = es < 16 ? kp.in[37] + ((size_t)l * 16 + es) * 1024 * 512 : kp.in[40] + (size_t)l * 1024 * 512;
        const float* wd = es < 16 ? kp.in[38] + ((size_t)l * 16 + es) * 512 * 1024 : kp.in[41] + (size_t)l * 512 * 1024;
        bf16_t* dup = WSP(bf16_t, WS_BIG + MO_W + (size_t)es * MOE_EXP_BYTES);
        bf16_t* ddn = dup + (size_t)1024 * 1024;
        if (conv_job(tile, u, wg, 1024, 512, dup, 1, 1024)) continue;
        if (conv_job(tile, u, wu, 1024, 512, dup, 2, 1024)) continue;
        conv_job(tile, u, wd, 512, 1024, ddn, 0, 512); }
}

__device__ __forceinline__ const float* hrow_rd(const KP& kp, bool from_inputs, int b, int t) {
    if (t < CTXL) return (from_inputs ? kp.in[2] : WSP(const float, WS_HC)) + ((size_t)b * CTXL + t) * D;
    return (from_inputs ? kp.in[0] : kp.out) + ((size_t)b * SEQ + (t - CTXL)) * D;
}
__device__ __forceinline__ float* hrow_wr(const KP& kp, int b, int t) {
    if (t < CTXL) return WSP(float, WS_HC) + ((size_t)b * CTXL + t) * D;
    return kp.out + ((size_t)b * SEQ + (t - CTXL)) * D;
}

PHASE_FN void phase_u(const KP& kp, int layer, int g) {
    const int lane = otid() & 63, wid = otid() >> 6;
    const float* modv = WSP(const float, WS_MODV) + (size_t)layer * 17 * 6144;
    const float* ng = kp.in[6] + (size_t)layer * 4 * 1024;
    bf16_t* U = WSP(bf16_t, WS_BIG + (layer == 0 ? L0_U : L1_U));
    for (int lr = obid() * 8 + wid; lr < RG; lr += gridDim.x * 8) {
        const int bl = lr / TT, t = lr - bl * TT, b = g * BG + bl;
        const float* src = hrow_rd(kp, layer == 0, b, t);
        const float* mv = modv + (size_t)(t < CTXL ? 16 : b) * 6144;
        f32x4 x[4]; float ss = 0.f;
#pragma unroll
        for (int i = 0; i < 4; ++i) { x[i] = *(const f32x4*)(src + i * 256 + lane * 4); ss += x[i][0] * x[i][0] + x[i][1] * x[i][1] + x[i][2] * x[i][2] + x[i][3] * x[i][3]; }
        ss = wsum(ss); const float rstd = rsqrtf(ss * (1.0f / 1024.0f) + EPS);
#pragma unroll
        for (int i = 0; i < 4; ++i) { const int col = i * 256 + lane * 4;
            const f32x4 gv = *(const f32x4*)(ng + col), sc = *(const f32x4*)(mv + 1024 + col), sh = *(const f32x4*)(mv + col);
            st4bf(U + (size_t)lr * 1024 + col, x[i] * rstd * gv * (sc + 1.0f) + sh); }
    }
}

PHASE_FN void phase_r(const KP& kp, unsigned char* lds, int layer, int g) {
    const int tid = otid(), lane = tid & 63, wid = tid >> 6;
    float* rw = (float*)lds;
    int* se = (int*)(rw + 1024 * 16);
    int* sbase = se + 128;
    for (int i = tid; i < 1024 * 16; i += 512) rw[i] = kp.in[34][i];
    __syncthreads();
    const float* modv = WSP(const float, WS_MODV) + (size_t)layer * 17 * 6144;
    const float* ng = kp.in[6] + (size_t)layer * 4 * 1024;
    const bf16_t* MIX = WSP(const bf16_t, WS_BIG + (layer == 0 ? L0_U : L1_U));
    bf16_t* V = WSP(bf16_t, WS_V);
    unsigned* cnt = WSP(unsigned, CTL_CNT) + layer * 16;
    int* TOKE = WSP(int, WS_TOKE); int* TOKP = WSP(int, WS_TOKP); float* TOKW = WSP(float, WS_TOKW); int* LIST = WSP(int, WS_LIST);
    const int nrows = layer == 0 ? RG : RGL, nchunks = nrows >> 6;
    float rbias[16];
#pragma unroll
    for (int e = 0; e < 16; ++e) rbias[e] = kp.in[35][e];
    for (int ch = obid(); ch < nchunks; ch += gridDim.x) {
        for (int rr = 0; rr < 8; ++rr) {
            const int rl = wid * 8 + rr, lr = ch * 64 + rl;
            int b, t, tok;
            if (layer == 0) { const int bl = lr / TT; t = lr - bl * TT; b = g * BG + bl; tok = g * RG + lr; }
            else { const int bl = lr >> 11; t = CTXL + (lr & 2047); b = g * BG + bl; tok = g * RGL + lr; }
            const float* hsrc = hrow_rd(kp, layer == 0, b, t);
            float* hdst = hrow_wr(kp, b, t);
            const float* mv = modv + (size_t)(t < CTXL ? 16 : b) * 6144;
            f32x4 y[4], h[4]; float ss = 0.f;
#pragma unroll
            for (int i = 0; i < 4; ++i) { y[i] = ld4bf(MIX + (size_t)lr * 1024 + i * 256 + lane * 4); ss += y[i][0] * y[i][0] + y[i][1] * y[i][1] + y[i][2] * y[i][2] + y[i][3] * y[i][3]; }
            ss = wsum(ss); float rstd = rsqrtf(ss * (1.0f / 1024.0f) + EPS);
            float s2 = 0.f;
#pragma unroll
            for (int i = 0; i < 4; ++i) { const int col = i * 256 + lane * 4;
                const f32x4 g1 = *(const f32x4*)(ng + 1024 + col), ga = *(const f32x4*)(mv + 2048 + col), hx = *(const f32x4*)(hsrc + col);
                h[i] = hx + ga * (y[i] * rstd * g1);
                *(f32x4*)(hdst + col) = h[i];
                s2 += h[i][0] * h[i][0] + h[i][1] * h[i][1] + h[i][2] * h[i][2] + h[i][3] * h[i][3]; }
            s2 = wsum(s2); rstd = rsqrtf(s2 * (1.0f / 1024.0f) + EPS);
            float lg[16];
#pragma unroll
            for (int e = 0; e < 16; ++e) lg[e] = 0.f;
#pragma unroll
            for (int i = 0; i < 4; ++i) { const int col = i * 256 + lane * 4;
                const f32x4 g2 = *(const f32x4*)(ng + 2048 + col), scf = *(const f32x4*)(mv + 4096 + col), shf = *(const f32x4*)(mv + 3072 + col);
                const f32x4 v = h[i] * rstd * g2 * (scf + 1.0f) + shf;
                st4bf(V + (size_t)tok * 1024 + col, v);
#pragma unroll
                for (int j = 0; j < 4; ++j) {
#pragma unroll
                    for (int q = 0; q < 4; ++q) { const f32x4 w4 = *(const f32x4*)(rw + (col + j) * 16 + q * 4);
                        lg[q * 4 + 0] += v[j] * w4[0]; lg[q * 4 + 1] += v[j] * w4[1]; lg[q * 4 + 2] += v[j] * w4[2]; lg[q * 4 + 3] += v[j] * w4[3]; } } }
#pragma unroll
            for (int e = 0; e < 16; ++e) lg[e] = wsum(lg[e]);
            float aff[16], sel[16];
#pragma unroll
            for (int e = 0; e < 16; ++e) { aff[e] = sigmoidf_(lg[e]); sel[e] = aff[e] + rbias[e]; }
            float gs[4];
#pragma unroll
            for (int gi = 0; gi < 4; ++gi) { const float a0 = sel[gi * 4], a1 = sel[gi * 4 + 1], a2 = sel[gi * 4 + 2], a3 = sel[gi * 4 + 3];
                gs[gi] = fmaxf(fmaxf(fmaxf(a0 + a1, a0 + a2), fmaxf(a0 + a3, a1 + a2)), fmaxf(a1 + a3, a2 + a3)); }
            int gidx = 0; float gb = gs[0];
#pragma unroll
            for (int gi = 1; gi < 4; ++gi) if (gs[gi] > gb) { gb = gs[gi]; gidx = gi; }
            float c[4], f[4];
#pragma unroll
            for (int i = 0; i < 4; ++i) { c[i] = gidx == 0 ? sel[i] : gidx == 1 ? sel[4 + i] : gidx == 2 ? sel[8 + i] : sel[12 + i];
                                           f[i] = gidx == 0 ? aff[i] : gidx == 1 ? aff[4 + i] : gidx == 2 ? aff[8 + i] : aff[12 + i]; }
            int i1 = 0; float cb = c[0];
#pragma unroll
            for (int i = 1; i < 4; ++i) if (c[i] > cb) { cb = c[i]; i1 = i; }
            int i2 = -1; float cb2 = 0.f;
#pragma unroll
            for (int i = 0; i < 4; ++i) if (i != i1 && (i2 < 0 || c[i] > cb2)) { cb2 = c[i]; i2 = i; }
            float w1 = i1 == 0 ? f[0] : i1 == 1 ? f[1] : i1 == 2 ? f[2] : f[3];
            float w2 = i2 == 0 ? f[0] : i2 == 1 ? f[1] : i2 == 2 ? f[2] : f[3];
            const float wsn = 1.0f / (w1 + w2); w1 *= wsn; w2 *= wsn;
            if (lane == 0) { se[rl * 2] = gidx * 4 + i1; se[rl * 2 + 1] = gidx * 4 + i2;
                TOKE[tok * 2] = gidx * 4 + i1; TOKE[tok * 2 + 1] = gidx * 4 + i2; TOKW[tok * 2] = w1; TOKW[tok * 2 + 1] = w2; }
        }
        __syncthreads();
        if (tid < 16) { int c2 = 0; for (int i = 0; i < 128; ++i) c2 += (se[i] == tid) ? 1 : 0; sbase[tid] = (int)atomicAdd(&cnt[tid], (unsigned)c2); }
        __syncthreads();
        if (tid < 128) { const int e = se[tid]; int rank = 0; for (int j = 0; j < tid; ++j) rank += (se[j] == e) ? 1 : 0;
            const int pos = sbase[e] + rank; const int lr = ch * 64 + (tid >> 1); const int tok = (layer == 0 ? g * RG : g * RGL) + lr;
            LIST[(size_t)e * NTOK + pos] = tok; TOKP[tok * 2 + (tid & 1)] = pos; }
        __syncthreads();
    }
}

PHASE_FN void phase_moe_gemm(const KP& kp, unsigned char* lds, int layer, bool down) {
    const int tid = otid();
    int* pre = (int*)(lds + GEMM_LDS);
    const int ntok = layer == 0 ? NTOK : NLAT;
    const unsigned* cnt = WSP(const unsigned, CTL_CNT) + layer * 16;
    if (tid == 0) { int p = 0, rb = ntok; pre[0] = 0; p = ntok / 256; pre[1] = p; pre[32] = 0;
        for (int e = 0; e < 16; ++e) { const int c = (int)cnt[e]; p += (c + 255) >> 8; pre[2 + e] = p; pre[33 + e] = rb; rb += c; } }
    __syncthreads();
    const int units = pre[17] * 8;
    const bf16_t* V = WSP(const bf16_t, WS_V);
    bf16_t* HID = WSP(bf16_t, WS_BIG + MO_HID); bf16_t* CON = WSP(bf16_t, WS_BIG + MO_CON);
    for (int u = obid(); u < units; u += gridDim.x) {
        const int mtg = u >> 3, nt = u & 7;
        int idx = 0;
        for (int e = 1; e < 17; ++e) if (pre[e] <= mtg) idx = e;
        const int mt = mtg - pre[idx], rbase = pre[32 + idx];
        const int nrows = idx == 0 ? ntok : (int)cnt[idx - 1];
        const int slot = idx == 0 ? 16 : idx - 1;
        const bf16_t* wslot = WSP(const bf16_t, WS_BIG + MO_W + (size_t)slot * MOE_EXP_BYTES);
        if (!down) {
            GA ga{V, nullptr, 1024, 0, 1024, idx == 0 ? nullptr : WSP(const int, WS_LIST) + (size_t)(idx - 1) * NTOK, nrows, 0, 0};
            EpiSwiglu ep{HID + (size_t)rbase * 512, nrows};
            gemm_tile(lds, ga, wslot, 1024, mt, nt, ep);
        } else {
            GA ga{HID + (size_t)rbase * 512, nullptr, 512, 0, 512, nullptr, nrows, 0, 0};
            EpiBf ep{CON + (size_t)rbase * 1024, 1024, nrows, 1024};
            gemm_tile(lds, ga, wslot + (size_t)1024 * 1024, 512, mt, nt, ep);
        }
    }
}

PHASE_FN void phase_combine(const KP& kp, int layer) {
    const int lane = otid() & 63, wid = otid() >> 6;
    const int ntok = layer == 0 ? NTOK : NLAT;
    const unsigned* cnt = WSP(const unsigned, CTL_CNT) + layer * 16;
    const float* modv = WSP(const float, WS_MODV) + (size_t)layer * 17 * 6144;
    const float* ng = kp.in[6] + (size_t)layer * 4 * 1024 + 3 * 1024;
    const bf16_t* CON = WSP(const bf16_t, WS_BIG + MO_CON);
    const int* TOKE = WSP(const int, WS_TOKE); const int* TOKP = WSP(const int, WS_TOKP); const float* TOKW = WSP(const float, WS_TOKW);
    int myc = lane < 16 ? (int)cnt[lane] : 0, pref = myc;
#pragma unroll
    for (int o = 1; o < 16; o <<= 1) { const int t = __shfl_up(pref, o); if (lane >= o) pref += t; }
    pref -= myc;
    for (int tok = obid() * 8 + wid; tok < ntok; tok += gridDim.x * 8) {
        const int e1 = TOKE[tok * 2], e2 = TOKE[tok * 2 + 1], p1 = TOKP[tok * 2], p2 = TOKP[tok * 2 + 1];
        const float w1 = TOKW[tok * 2], w2 = TOKW[tok * 2 + 1];
        const size_t r1 = (size_t)ntok + __shfl(pref, e1) + p1, r2 = (size_t)ntok + __shfl(pref, e2) + p2;
        int b, t;
        if (layer == 0) { b = tok / TT; t = tok - b * TT; } else { b = tok >> 11; t = CTXL + (tok & 2047); }
        float* hp = hrow_wr(kp, b, t);
        const float* mv = modv + (size_t)(t < CTXL ? 16 : b) * 6144 + 5 * 1024;
        f32x4 f[4]; float ss = 0.f;
#pragma unroll
        for (int i = 0; i < 4; ++i) { const int col = i * 256 + lane * 4;
            f[i] = ld4bf(CON + (size_t)tok * 1024 + col) + ld4bf(CON + r1 * 1024 + col) * w1 + ld4bf(CON + r2 * 1024 + col) * w2;
            ss += f[i][0] * f[i][0] + f[i][1] * f[i][1] + f[i][2] * f[i][2] + f[i][3] * f[i][3]; }
        ss = wsum(ss); const float rstd = rsqrtf(ss * (1.0f / 1024.0f) + EPS);
#pragma unroll
        for (int i = 0; i < 4; ++i) { const int col = i * 256 + lane * 4;
            const f32x4 g3 = *(const f32x4*)(ng + col), gf = *(const f32x4*)(mv + col), hx = *(const f32x4*)(hp + col);
            *(f32x4*)(hp + col) = hx + gf * (f[i] * rstd * g3); }
    }
}

template <int CH>
__device__ __forceinline__ int scan_t(int dir, int ci, int j) {
    constexpr int NC_CTX = CTXL / CH;
    if (!dir) return ci * CH + j;
    return ci < NC_CTX ? (CTXL - 1 - ci * CH - j) : (TT - 1 - (ci - NC_CTX) * CH - j);
}

constexpr int ML_LQ = 136, ML_LT = 72;
PHASE_FN void mlstm_unit(const KP& kp, unsigned char* lds, int bl, int h, int dir, int vh) {
    const int tid = otid(), lane = tid & 63, wid = tid >> 6, fr = lane & 15, fq = lane >> 4;
    bf16_t* Qs = (bf16_t*)lds;
    bf16_t* Ks = Qs + 64 * ML_LQ;
    bf16_t* KTE = Ks + 64 * ML_LQ;
    bf16_t* VT = KTE + 128 * ML_LT;
    bf16_t* Ps = VT + 128 * ML_LT;
    bf16_t* Cb = Ps + 64 * ML_LT;
    float* fs = (float*)(Cb + 128 * ML_LQ);
    float* s_rowv = fs;
    float* s_colv = fs + 64;
    float* s_wint = fs + 128;
    float* s_emj = fs + 192;
    float* s_E = fs + 256;
    float* s_den = fs + 320;
    float* s_n = fs + 384;
    float* s_misc = fs + 512;
    const bf16_t* P = WSP(const bf16_t, WS_BIG + L0_P);
    bf16_t* HOUT = WSP(bf16_t, WS_BIG + (dir ? L0_HB : L0_HF));
    const float ibias = kp.in[9][dir * 4 + h], fbias = kp.in[10][dir * 4 + h];
    for (int i = tid; i < 128 * ML_LQ; i += 512) Cb[i] = 0;
    if (tid < 128) s_n[tid] = 0.f;
    f32x4 Cacc[8];
#pragma unroll
    for (int i = 0; i < 8; ++i) Cacc[i] = (f32x4){0.f, 0.f, 0.f, 0.f};
    float m_state = 0.f;
    __syncthreads();
    for (int ci = 0; ci < TT / 64; ++ci) {
#pragma unroll
        for (int i = 0; i < 2; ++i) {
            const int p = tid + i * 512, j = p >> 4, c8 = p & 15;
            const size_t row = (size_t)bl * TT + scan_t<64>(dir, ci, j);
            const bf16_t* pr = P + row * AB_N;
            u32x4 q = *(const u32x4*)(pr + AB_Q + h * 128 + c8 * 8);
            const float qs = 0.08838834764831845f;
            q.x = pack2(lo2f(q.x) * qs, hi2f(q.x) * qs); q.y = pack2(lo2f(q.y) * qs, hi2f(q.y) * qs);
            q.z = pack2(lo2f(q.z) * qs, hi2f(q.z) * qs); q.w = pack2(lo2f(q.w) * qs, hi2f(q.w) * qs);
            *(u32x4*)(Qs + j * ML_LQ + c8 * 8) = q;
            *(u32x4*)(Ks + j * ML_LQ + c8 * 8) = *(const u32x4*)(pr + AB_K + h * 128 + c8 * 8);
            const u32x4 v = *(const u32x4*)(pr + AB_V + h * 256 + vh * 128 + c8 * 8);
            bf16_t* vt = VT + (c8 * 8) * ML_LT + j;
            vt[0 * ML_LT] = (bf16_t)(v.x & 0xffff); vt[1 * ML_LT] = (bf16_t)(v.x >> 16); vt[2 * ML_LT] = (bf16_t)(v.y & 0xffff); vt[3 * ML_LT] = (bf16_t)(v.y >> 16);
            vt[4 * ML_LT] = (bf16_t)(v.z & 0xffff); vt[5 * ML_LT] = (bf16_t)(v.z >> 16); vt[6 * ML_LT] = (bf16_t)(v.w & 0xffff); vt[7 * ML_LT] = (bf16_t)(v.w >> 16);
        }
        if (wid == 0) {
            const size_t row = (size_t)bl * TT + scan_t<64>(dir, ci, lane);
            const float ig = bf2f(P[row * AB_N + AB_IG + dir * 4 + h]) + ibias;
            const float lf = logsigmoidf_(bf2f(P[row * AB_N + AB_FG + dir * 4 + h]) + fbias);
            float b = lf;
#pragma unroll
            for (int o = 1; o < 64; o <<= 1) { const float t = __shfl_up(b, o); if (lane >= o) b += t; }
            const float u = ig - b; float pm = u;
#pragma unroll
            for (int o = 1; o < 64; o <<= 1) { const float t = __shfl_up(pm, o); if (lane >= o) pm = fmaxf(pm, t); }
            const float mj = fmaxf(b + m_state, b + pm);
            const float b63 = __shfl(b, 63), pm63 = __shfl(pm, 63);
            const float mnew = fmaxf(b63 + m_state, b63 + pm63);
            s_rowv[lane] = b - mj; s_colv[lane] = u; s_wint[lane] = __expf(b + m_state - mj); s_emj[lane] = __expf(-mj);
            s_E[lane] = __expf(b63 + u - mnew);
            if (lane == 0) { s_misc[0] = mnew; s_misc[1] = __expf(b63 + m_state - mnew); }
        }
        __syncthreads();
        {
            const int jt = wid >> 1;
#pragma unroll
            for (int q2 = 0; q2 < 2; ++q2) {
                const int st = (wid & 1) * 2 + q2;
                f32x4 acc = (f32x4){0.f, 0.f, 0.f, 0.f};
                if (st <= jt) {
#pragma unroll
                    for (int k = 0; k < 4; ++k) acc = mma16(ldfrag(Qs, ML_LQ, jt * 16, k * 32, fr, fq), ldfrag(Ks, ML_LQ, st * 16, k * 32, fr, fq), acc);
                }
                const int s = st * 16 + fr; const float cv = s_colv[s];
#pragma unroll
                for (int r = 0; r < 4; ++r) { const int j = jt * 16 + fq * 4 + r;
                    const float pv = (s <= j) ? acc[r] * __expf(s_rowv[j] + cv) : 0.f;
                    Ps[j * ML_LT + s] = f2bf(pv); }
            }
#pragma unroll
            for (int i = 0; i < 2; ++i) {
                const int p = tid + i * 512, s = p >> 4, c8 = p & 15; const float e = s_E[s];
                const u32x4 kv = *(const u32x4*)(Ks + s * ML_LQ + c8 * 8);
                bf16_t* kt = KTE + (c8 * 8) * ML_LT + s;
                kt[0 * ML_LT] = f2bf(lo2f(kv.x) * e); kt[1 * ML_LT] = f2bf(hi2f(kv.x) * e); kt[2 * ML_LT] = f2bf(lo2f(kv.y) * e); kt[3 * ML_LT] = f2bf(hi2f(kv.y) * e);
                kt[4 * ML_LT] = f2bf(lo2f(kv.z) * e); kt[5 * ML_LT] = f2bf(hi2f(kv.z) * e); kt[6 * ML_LT] = f2bf(lo2f(kv.w) * e); kt[7 * ML_LT] = f2bf(hi2f(kv.w) * e);
            }
        }
        __syncthreads();
        f32x4 a1[4], a2[4];
        {
            const int jt = wid >> 1;
#pragma unroll
            for (int q4 = 0; q4 < 4; ++q4) {
                const int vt = (wid & 1) * 4 + q4;
                a1[q4] = (f32x4){0.f, 0.f, 0.f, 0.f}; a2[q4] = (f32x4){0.f, 0.f, 0.f, 0.f};
#pragma unroll
                for (int k = 0; k < 2; ++k) a1[q4] = mma16(ldfrag(VT, ML_LT, vt * 16, k * 32, fr, fq), ldfrag(Ps, ML_LT, jt * 16, k * 32, fr, fq), a1[q4]);
#pragma unroll
                for (int k = 0; k < 4; ++k) a2[q4] = mma16(ldfrag(Cb, ML_LQ, vt * 16, k * 32, fr, fq), ldfrag(Qs, ML_LQ, jt * 16, k * 32, fr, fq), a2[q4]);
            }
            if (wid == 7) {
                float rs = 0.f, nq = 0.f;
                for (int s = 0; s < 64; ++s) rs += bf2f(Ps[lane * ML_LT + s]);
                for (int d = 0; d < 128; ++d) nq += s_n[d] * bf2f(Qs[lane * ML_LQ + d]);
                const float den = rs + s_wint[lane] * nq;
                s_den[lane] = fmaxf(fabsf(den), s_emj[lane]);
            }
        }
        __syncthreads();
        {
            const int jt = wid >> 1, j = jt * 16 + fr;
            const float wi = s_wint[j], rden = 1.0f / s_den[j];
            const size_t row = (size_t)bl * TT + scan_t<64>(dir, ci, j);
#pragma unroll
            for (int q4 = 0; q4 < 4; ++q4) { const int v0 = ((wid & 1) * 4 + q4) * 16 + fq * 4;
                st4bf(HOUT + row * 1024 + h * 256 + vh * 128 + v0, (a1[q4] + a2[q4] * wi) * rden); }
        }
        {
            const float dec = s_misc[1];
            bf16x8 bv0 = ldfrag(VT, ML_LT, wid * 16, 0, fr, fq), bv1 = ldfrag(VT, ML_LT, wid * 16, 32, fr, fq);
#pragma unroll
            for (int dt = 0; dt < 8; ++dt) {
                Cacc[dt] = Cacc[dt] * dec;
                Cacc[dt] = mma16(ldfrag(KTE, ML_LT, dt * 16, 0, fr, fq), bv0, Cacc[dt]);
                Cacc[dt] = mma16(ldfrag(KTE, ML_LT, dt * 16, 32, fr, fq), bv1, Cacc[dt]);
                st4bf(Cb + (wid * 16 + fr) * ML_LQ + dt * 16 + fq * 4, Cacc[dt]);
            }
            if (tid < 128) { float a = 0.f; for (int s = 0; s < 64; ++s) a += bf2f(KTE[tid * ML_LT + s]); s_n[tid] = dec * s_n[tid] + a; }
            m_state = s_misc[0];
        }
        __syncthreads();
    }
}

constexpr int SS_LR = 264, SS_LT = 72;
PHASE_FN void ssd_unit(const KP& kp, unsigned char* lds, int bl, int dir, int hp) {
    const int tid = otid(), lane = tid & 63, wid = tid >> 6, fr = lane & 15, fq = lane >> 4;
    const int gi = hp >> 2, hh0 = hp * 2;
    bf16_t* RAW = (bf16_t*)lds;
    bf16_t* CM = RAW + 68 * SS_LR;
    bf16_t* BM = CM + 64 * SS_LT;
    bf16_t* Wm = BM + 64 * SS_LT;
    bf16_t* XT = Wm + 2 * 64 * SS_LT;
    bf16_t* BTE = XT + 2 * 64 * SS_LT;
    bf16_t* Sb = BTE + 2 * 64 * SS_LT;
    float* fs = (float*)(Sb + 2 * 64 * SS_LT);
    float* s_b = fs;
    float* s_dt = fs + 128;
    float* s_e = fs + 256;
    float* s_misc = fs + 384;
    const bf16_t* P = WSP(const bf16_t, WS_BIG + L0_P);
    bf16_t* YOUT = WSP(bf16_t, WS_BIG + (dir ? L0_YB : L0_YF));
    for (int i = tid; i < 2 * 64 * SS_LT; i += 512) Sb[i] = 0;
    f32x4 Sacc[4];
#pragma unroll
    for (int i = 0; i < 4; ++i) Sacc[i] = (f32x4){0.f, 0.f, 0.f, 0.f};
    const int ch = tid & 255;
    const int xcol = ch < 128 ? hh0 * 64 + ch : (ch < 192 ? 1024 + gi * 64 + (ch - 128) : 1152 + gi * 64 + (ch - 192));
    float cw[5];
#pragma unroll
    for (int q = 0; q < 5; ++q) cw[q] = kp.in[12][q * 1280 + xcol];
    const float cbias = kp.in[13][xcol];
    const int hl_w = wid >> 2;
    const float dtb = kp.in[14][dir * 16 + hh0 + (wid & 1)], aexp = __expf(kp.in[15][dir * 16 + hh0 + (wid & 1)]);
    const float dskip = kp.in[16][hh0 + hl_w];
    __syncthreads();
    for (int ci = 0; ci < TT / 64; ++ci) {
        const int t0 = dir ? scan_t<64>(1, ci, 63) : ci * 64;
        const int lo = t0 < CTXL ? 0 : CTXL, hi = t0 < CTXL ? CTXL : TT;
        for (int p = tid; p < 68 * 32; p += 512) {
            const int rr = p >> 5, c8 = p & 31, t = t0 - 2 + rr;
            u32x4 v = (u32x4){0u, 0u, 0u, 0u};
            if (t >= lo && t < hi) { const int col = c8 < 16 ? hh0 * 64 + c8 * 8 : (c8 < 24 ? 1024 + gi * 64 + (c8 - 16) * 8 : 1152 + gi * 64 + (c8 - 24) * 8);
                v = *(const u32x4*)(P + ((size_t)bl * TT + t) * AB_N + AB_XBC + col); }
            *(u32x4*)(RAW + rr * SS_LR + c8 * 8) = v;
        }
        if (wid < 2) {
            const size_t row = (size_t)bl * TT + scan_t<64>(dir, ci, lane);
            const float dt = softplusf_(bf2f(P[row * AB_N + AB_DT + dir * 16 + hh0 + wid]) + dtb);
            float b = -dt * aexp;
#pragma unroll
            for (int o = 1; o < 64; o <<= 1) { const float t = __shfl_up(b, o); if (lane >= o) b += t; }
            const float b63 = __shfl(b, 63);
            s_b[wid * 64 + lane] = b; s_dt[wid * 64 + lane] = dt; s_e[wid * 64 + lane] = __expf(b63 - b) * dt;
            if (lane == 0) s_misc[wid] = __expf(b63);
        }
        __syncthreads();
        for (int ii = 0; ii < 32; ++ii) {
            const int i = (tid >> 8) + 2 * ii, j = dir ? 63 - i : i;
            float a = cbias;
#pragma unroll
            for (int q = 0; q < 5; ++q) a += cw[q] * bf2f(RAW[(i + q) * SS_LR + ch]);
            const bf16_t o = f2bf(siluf_(a));
            if (ch < 128) XT[((ch >> 6) * 64 + (ch & 63)) * SS_LT + j] = o;
            else if (ch < 192) BM[j * SS_LT + (ch - 128)] = o;
            else CM[j * SS_LT + (ch - 192)] = o;
        }
        __syncthreads();
        {
            const int jt = wid >> 1;
#pragma unroll
            for (int q2 = 0; q2 < 2; ++q2) {
                const int st = (wid & 1) * 2 + q2;
                f32x4 acc = (f32x4){0.f, 0.f, 0.f, 0.f};
                if (st <= jt) {
#pragma unroll
                    for (int k = 0; k < 2; ++k) acc = mma16(ldfrag(CM, SS_LT, jt * 16, k * 32, fr, fq), ldfrag(BM, SS_LT, st * 16, k * 32, fr, fq), acc);
                }
                const int s = st * 16 + fr;
#pragma unroll
                for (int hl = 0; hl < 2; ++hl) { const float bs = s_b[hl * 64 + s], ds = s_dt[hl * 64 + s];
#pragma unroll
                    for (int r = 0; r < 4; ++r) { const int j = jt * 16 + fq * 4 + r;
                        const float wv = (s <= j) ? acc[r] * __expf(s_b[hl * 64 + j] - bs) * ds : 0.f;
                        Wm[(hl * 64 + j) * SS_LT + s] = f2bf(wv); } }
            }
            {
                const int s = tid >> 3, n8 = tid & 7;
                const u32x4 bv = *(const u32x4*)(BM + s * SS_LT + n8 * 8);
#pragma unroll
                for (int hl = 0; hl < 2; ++hl) { const float e = s_e[hl * 64 + s];
                    bf16_t* bt = BTE + (hl * 64 + n8 * 8) * SS_LT + s;
                    bt[0 * SS_LT] = f2bf(lo2f(bv.x) * e); bt[1 * SS_LT] = f2bf(hi2f(bv.x) * e); bt[2 * SS_LT] = f2bf(lo2f(bv.y) * e); bt[3 * SS_LT] = f2bf(hi2f(bv.y) * e);
                    bt[4 * SS_LT] = f2bf(lo2f(bv.z) * e); bt[5 * SS_LT] = f2bf(hi2f(bv.z) * e); bt[6 * SS_LT] = f2bf(lo2f(bv.w) * e); bt[7 * SS_LT] = f2bf(hi2f(bv.w) * e); }
            }
        }
        __syncthreads();
        {
            const int hl = hl_w, jt = wid & 3, j = jt * 16 + fr;
            const bf16_t* Wh = Wm + hl * 64 * SS_LT; const bf16_t* Xh = XT + hl * 64 * SS_LT; const bf16_t* Sh = Sb + hl * 64 * SS_LT;
            const float eb = __expf(s_b[hl * 64 + j]);
            const size_t row = (size_t)bl * TT + scan_t<64>(dir, ci, j);
#pragma unroll
            for (int pt = 0; pt < 4; ++pt) {
                f32x4 y1 = (f32x4){0.f, 0.f, 0.f, 0.f}, y2 = (f32x4){0.f, 0.f, 0.f, 0.f};
#pragma unroll
                for (int k = 0; k < 2; ++k) { y1 = mma16(ldfrag(Xh, SS_LT, pt * 16, k * 32, fr, fq), ldfrag(Wh, SS_LT, jt * 16, k * 32, fr, fq), y1);
                                              y2 = mma16(ldfrag(Sh, SS_LT, pt * 16, k * 32, fr, fq), ldfrag(CM, SS_LT, jt * 16, k * 32, fr, fq), y2); }
                f32x4 y = y1 + y2 * eb;
                if (!dir) {
#pragma unroll
                    for (int r = 0; r < 4; ++r) y[r] += dskip * bf2f(Xh[(pt * 16 + fq * 4 + r) * SS_LT + j]);
                }
                st4bf(YOUT + row * 1024 + (hh0 + hl) * 64 + pt * 16 + fq * 4, y);
            }
        }
        __syncthreads();
        {
            const int hl = hl_w, pt = wid & 3; const float eb63 = s_misc[hl];
            const bf16_t* Xh = XT + hl * 64 * SS_LT; const bf16_t* Bh = BTE + hl * 64 * SS_LT; bf16_t* Sh = Sb + hl * 64 * SS_LT;
            bf16x8 x0 = ldfrag(Xh, SS_LT, pt * 16, 0, fr, fq), x1 = ldfrag(Xh, SS_LT, pt * 16, 32, fr, fq);
#pragma unroll
            for (int nt = 0; nt < 4; ++nt) {
                Sacc[nt] = Sacc[nt] * eb63;
                Sacc[nt] = mma16(ldfrag(Bh, SS_LT, nt * 16, 0, fr, fq), x0, Sacc[nt]);
                Sacc[nt] = mma16(ldfrag(Bh, SS_LT, nt * 16, 32, fr, fq), x1, Sacc[nt]);
                st4bf(Sh + (pt * 16 + fr) * SS_LT + nt * 16 + fq * 4, Sacc[nt]);
            }
        }
        __syncthreads();
    }
}

__device__ __forceinline__ void phase_scan_ab(const KP& kp, unsigned char* lds) {
    for (int u = obid(); u < 256; u += gridDim.x) if (u < 128) { mlstm_unit(kp, lds, u >> 4, (u >> 2) & 3, (u >> 1) & 1, u & 1); __syncthreads(); }
    for (int u = obid(); u < 256; u += gridDim.x) if (u >= 128) { const int v = u - 128; ssd_unit(kp, lds, v >> 4, (v >> 3) & 1, v & 7); __syncthreads(); }
}

PHASE_FN void phase_fin_ab(const KP& kp) {
    const int lane = otid() & 63, wid = otid() >> 6;
    const bf16_t* P = WSP(const bf16_t, WS_BIG + L0_P);
    bf16_t* HF = WSP(bf16_t, WS_BIG + L0_HF); const bf16_t* HB = WSP(const bf16_t, WS_BIG + L0_HB);
    bf16_t* YF = WSP(bf16_t, WS_BIG + L0_YF); const bf16_t* YB = WSP(const bf16_t, WS_BIG + L0_YB);
    const float* mln = kp.in[11]; const float* sn = kp.in[17];
    for (int lr = obid() * 8 + wid; lr < RG; lr += gridDim.x * 8) {
        const bf16_t* pr = P + (size_t)lr * AB_N;
        f32x4 yz[4]; float ss2 = 0.f;
#pragma unroll
        for (int i = 0; i < 4; ++i) { const int col = i * 256 + lane * 4;
            const f32x4 hs = ld4bf(HF + (size_t)lr * 1024 + col) + ld4bf(HB + (size_t)lr * 1024 + col);
            float ss = hs[0] * hs[0] + hs[1] * hs[1] + hs[2] * hs[2] + hs[3] * hs[3];
            ss = wsum(ss); const float rstd = rsqrtf(ss * (1.0f / 256.0f) + EPS);
            const f32x4 og = ld4bf(pr + AB_OG + col), w = *(const f32x4*)(mln + col);
            f32x4 o;
#pragma unroll
            for (int r = 0; r < 4; ++r) o[r] = hs[r] * rstd * w[r] * sigmoidf_(og[r]);
            st4bf(HF + (size_t)lr * 1024 + col, o);
            const f32x4 ys = ld4bf(YF + (size_t)lr * 1024 + col) + ld4bf(YB + (size_t)lr * 1024 + col), z = ld4bf(pr + AB_Z + col);
#pragma unroll
            for (int r = 0; r < 4; ++r) { yz[i][r] = ys[r] * siluf_(z[r]); ss2 += yz[i][r] * yz[i][r]; }
        }
        ss2 = wsum(ss2); const float rstd2 = rsqrtf(ss2 * (1.0f / 1024.0f) + EPS);
#pragma unroll
        for (int i = 0; i < 4; ++i) { const int col = i * 256 + lane * 4; st4bf(YF + (size_t)lr * 1024 + col, yz[i] * rstd2 * *(const f32x4*)(sn + col)); }
    }
}

PHASE_FN void phase_gemm_in(const KP& kp, unsigned char* lds, int layer) {
    const int ntn = layer == 0 ? AB_NPAD / 128 : CD_NPAD / 128, units = (RG / 256) * ntn;
    GA ga{WSP(const bf16_t, WS_BIG + (layer == 0 ? L0_U : L1_U)), nullptr, 1024, 0, 1024, nullptr, RG, 0, 0};
    EpiBf ep{WSP(bf16_t, WS_BIG), layer == 0 ? AB_N : CD_N, RG, layer == 0 ? AB_N : CD_N};
    const bf16_t* Bt = WSP(const bf16_t, WS_WMIX);
    for (int u = obid(); u < units; u += gridDim.x) gemm_tile(lds, ga, Bt, 1024, u / ntn, u % ntn, ep);
}
PHASE_FN void phase_gemm_out_ab(const KP& kp, unsigned char* lds) {
    GA ga{WSP(const bf16_t, WS_BIG + L0_HF), WSP(const bf16_t, WS_BIG + L0_YF), 1024, 1024, 1024, nullptr, RG, 0, 0};
    EpiBf ep{WSP(bf16_t, WS_BIG + L0_U), 1024, RG, 1024};
    const bf16_t* Bt = WSP(const bf16_t, WS_WMIX + WM_AB_OUT);
    for (int u = obid(); u < (RG / 256) * 8; u += gridDim.x) gemm_tile(lds, ga, Bt, 2048, u >> 3, u & 7, ep);
}

PHASE_FN void phase_prep_cd(const KP& kp) {
    const int lane = otid() & 63, wid = otid() >> 6;
    bf16_t* P = WSP(bf16_t, WS_BIG + L1_P);
    bf16_t* SG = WSP(bf16_t, WS_SG);
    const float* qn = kp.in[20]; const float* kvn = kp.in[22]; const float* mu = kp.in[24];
    for (int lr = obid() * 8 + wid; lr < RG; lr += gridDim.x * 8) {
        const int bl = lr / TT, t = lr - bl * TT;
        bf16_t* pr = P + (size_t)lr * CD_N;
        {
            const f32x4 x = ld4bf(pr + CD_M1 + lane * 4);
            float ss = x[0] * x[0] + x[1] * x[1] + x[2] * x[2] + x[3] * x[3]; ss = wsum(ss);
            const float rstd = rsqrtf(ss * (1.0f / 256.0f) + EPS);
            st4bf(pr + CD_M1 + lane * 4, x * rstd * *(const f32x4*)(kvn + lane * 4));
        }
        if (t >= CTXL) {
            const int s = t - CTXL;
            float x0[3], x1[3]; float ss = 0.f;
#pragma unroll
            for (int i = 0; i < 3; ++i) { const unsigned w = *(const unsigned*)(pr + CD_M0 + i * 128 + lane * 2); x0[i] = lo2f(w); x1[i] = hi2f(w); ss += x0[i] * x0[i] + x1[i] * x1[i]; }
            ss = wsum(ss); const float rstd = rsqrtf(ss * (1.0f / 384.0f) + EPS);
#pragma unroll
            for (int i = 0; i < 3; ++i) { const int c = i * 128 + lane * 2; *(unsigned*)(pr + CD_M0 + c) = pack2(x0[i] * rstd * qn[c], x1[i] * rstd * qn[c + 1]); }
            if (lane < 16) {
                const float pos = (lane < 8) ? (float)(s >> 6) : (float)(s & 63);
                const float inv = __expf(-(float)(lane & 7) * (9.210340371976184f / 8.0f));
                float sn, cs; sincosf(pos * inv, &sn, &cs);
                const float a = bf2f(pr[CD_KR + lane]), b2 = bf2f(pr[CD_KR + 16 + lane]);
                pr[CD_KR + lane] = f2bf(a * cs - b2 * sn); pr[CD_KR + 16 + lane] = f2bf(a * sn + b2 * cs);
            }
            {
                const int c = lane * 2;
                const unsigned w = *(const unsigned*)(pr + CD_GL + c);
                const unsigned wp = s > 0 ? *(const unsigned*)(pr - CD_N + CD_GL + c) : 0u;
                const unsigned wn = s < SEQ - 1 ? *(const unsigned*)(pr + CD_N + CD_GL + c) : 0u;
                const float m0 = mu[CD_GL - CD_RW0 + c], m1 = mu[CD_GL - CD_RW0 + c + 1];
                const float g0 = lo2f(w) + m0 * (0.5f * (lo2f(wp) + lo2f(wn)) - lo2f(w));
                const float g1 = hi2f(w) + m1 * (0.5f * (hi2f(wp) + hi2f(wn)) - hi2f(w));
                *(unsigned*)(SG + ((size_t)bl * SEQ + s) * 128 + c) = pack2(sigmoidf_(g0), sigmoidf_(g1));
            }
        }
    }
}

PHASE_FN void phase_upproj(const KP& kp, unsigned char* lds) {
    const bf16_t* P = WSP(const bf16_t, WS_BIG + L1_P);
    const int nq = (RGL / 256) * 6, nkv = (RG / 256) * 8;
    for (int u = obid(); u < nq + nkv; u += gridDim.x) {
        if (u < nq) {
            GA ga{P + CD_M0, nullptr, CD_N, 0, 384, nullptr, RGL, 1, 0};
            EpiBf ep{WSP(bf16_t, WS_BIG + L1_Q), 768, RGL, 768};
            gemm_tile(lds, ga, WSP(const bf16_t, WS_WMIX + WM_UQ), 384, u / 6, u % 6, ep);
        } else { const int v = u - nq;
            GA ga{P + CD_M1, nullptr, CD_N, 0, 256, nullptr, RG, 0, 0};
            EpiBf ep{WSP(bf16_t, WS_BIG + L1_KV), 1024, RG, 1024};
            gemm_tile(lds, ga, WSP(const bf16_t, WS_WMIX + WM_UKV), 256, v >> 3, v & 7, ep);
        }
    }
}

constexpr int AT_LQ = 104, AT_LV = 72;
PHASE_FN void attn_unit(const KP& kp, unsigned char* lds, int bl, int head, int qb) {
    const int tid = otid(), lane = tid & 63, wid = tid >> 6, fr = lane & 15, fq = lane >> 4;
    bf16_t* Qs = (bf16_t*)lds;
    bf16_t* Kt = Qs + 128 * AT_LQ;
    bf16_t* Vt = Kt + 64 * AT_LQ;
    const bf16_t* P = WSP(const bf16_t, WS_BIG + L1_P);
    const bf16_t* Q = WSP(const bf16_t, WS_BIG + L1_Q);
    const bf16_t* KV = WSP(const bf16_t, WS_BIG + L1_KV);
    bf16_t* AOUT = WSP(bf16_t, WS_BIG + L1_AOUT);
    const float SC = 0.10206207261596577f;
#pragma unroll
    for (int i = 0; i < 3; ++i) { const int p = tid + i * 512, r = p / 12, c = p % 12;
        *(u32x4*)(Qs + r * AT_LQ + c * 8) = *(const u32x4*)(Q + ((size_t)bl * SEQ + qb * 128 + r) * 768 + head * 96 + c * 8); }
    __syncthreads();
#pragma unroll
    for (int i = 0; i < 4; ++i) { const int p = tid + i * 512, r = p >> 4, f = p & 15, s = qb * 128 + r;
        const float pos = (f < 8) ? (float)(s >> 6) : (float)(s & 63);
        const float inv = __expf(-(float)(f & 7) * (9.210340371976184f / 8.0f));
        float sn, cs; sincosf(pos * inv, &sn, &cs);
        const float a = bf2f(Qs[r * AT_LQ + 64 + f]), b2 = bf2f(Qs[r * AT_LQ + 80 + f]);
        Qs[r * AT_LQ + 64 + f] = f2bf(a * cs - b2 * sn); Qs[r * AT_LQ + 80 + f] = f2bf(a * sn + b2 * cs); }
    __syncthreads();
    bf16x8 qf[3];
#pragma unroll
    for (int k = 0; k < 3; ++k) qf[k] = ldfrag(Qs, AT_LQ, wid * 16, k * 32, fr, fq);
    f32x4 ot[4];
#pragma unroll
    for (int i = 0; i < 4; ++i) ot[i] = (f32x4){0.f, 0.f, 0.f, 0.f};
    float mrow = -1e30f, lsum = 0.f;
    for (int kt = 0; kt < TT / 64; ++kt) {
        __syncthreads();
#pragma unroll
        for (int i = 0; i < 2; ++i) { const int p = tid + i * 512;
            if (p < 768) { const int key = p / 12, c = p % 12; const size_t row = (size_t)bl * TT + kt * 64 + key;
                const u32x4 v = c < 8 ? *(const u32x4*)(KV + row * 1024 + head * 128 + c * 8) : *(const u32x4*)(P + row * CD_N + CD_KR + (c - 8) * 8);
                *(u32x4*)(Kt + key * AT_LQ + c * 8) = v; } }
        { const int key = tid >> 3, c8 = tid & 7; const size_t row = (size_t)bl * TT + kt * 64 + key;
            const u32x4 v = *(const u32x4*)(KV + row * 1024 + head * 128 + 64 + c8 * 8);
            bf16_t* vt = Vt + (c8 * 8) * AT_LV + key;
            vt[0 * AT_LV] = (bf16_t)(v.x & 0xffff); vt[1 * AT_LV] = (bf16_t)(v.x >> 16); vt[2 * AT_LV] = (bf16_t)(v.y & 0xffff); vt[3 * AT_LV] = (bf16_t)(v.y >> 16);
            vt[4 * AT_LV] = (bf16_t)(v.z & 0xffff); vt[5 * AT_LV] = (bf16_t)(v.z >> 16); vt[6 * AT_LV] = (bf16_t)(v.w & 0xffff); vt[7 * AT_LV] = (bf16_t)(v.w >> 16); }
        __syncthreads();
        f32x4 st[4];
        float mx = -1e30f;
#pragma unroll
        for (int kk = 0; kk < 4; ++kk) { st[kk] = (f32x4){0.f, 0.f, 0.f, 0.f};
#pragma unroll
            for (int k = 0; k < 3; ++k) st[kk] = mma16(ldfrag(Kt, AT_LQ, kk * 16, k * 32, fr, fq), qf[k], st[kk]);
            mx = fmaxf(mx, fmaxf(fmaxf(st[kk][0], st[kk][1]), fmaxf(st[kk][2], st[kk][3]))); }
        mx = fmaxf(mx, __shfl_xor(mx, 16)); mx = fmaxf(mx, __shfl_xor(mx, 32));
        const float mnew = fmaxf(mrow, mx), alpha = __expf(SC * (mrow - mnew));
        mrow = mnew; lsum *= alpha;
#pragma unroll
        for (int i = 0; i < 4; ++i) ot[i] = ot[i] * alpha;
#pragma unroll
        for (int kk = 0; kk < 4; ++kk)
#pragma unroll
            for (int r = 0; r < 4; ++r) { const float pv = __expf(SC * (st[kk][r] - mnew)); st[kk][r] = pv; lsum += pv; }
#pragma unroll
        for (int k2 = 0; k2 < 2; ++k2) {
            union { bf16x8 v; unsigned u[4]; } pb;
            pb.u[0] = pack2(st[2 * k2][0], st[2 * k2][1]); pb.u[1] = pack2(st[2 * k2][2], st[2 * k2][3]);
            pb.u[2] = pack2(st[2 * k2 + 1][0], st[2 * k2 + 1][1]); pb.u[3] = pack2(st[2 * k2 + 1][2], st[2 * k2 + 1][3]);
#pragma unroll
            for (int dvt = 0; dvt < 4; ++dvt) {
                union { bf16x8 v; u32x2 h[2]; } va;
                const bf16_t* vp = Vt + (dvt * 16 + fr) * AT_LV + k2 * 32 + fq * 4;
                va.h[0] = *(const u32x2*)vp; va.h[1] = *(const u32x2*)(vp + 16);
                ot[dvt] = mma16(va.v, pb.v, ot[dvt]);
            }
        }
    }
    lsum += __shfl_xor(lsum, 16); lsum += __shfl_xor(lsum, 32);
    const float rl = 1.0f / lsum;
    const size_t orow = (size_t)bl * SEQ + qb * 128 + wid * 16 + fr;
#pragma unroll
    for (int dvt = 0; dvt < 4; ++dvt) st4bf(AOUT + orow * 1536 + head * 64 + dvt * 16 + fq * 4, ot[dvt] * rl);
}

constexpr int RW_LR = 328;
PHASE_FN void rwkv_unit(const KP& kp, unsigned char* lds, int bl, int h, int dir) {
    const int tid = otid();
    bf16_t* RAW = (bf16_t*)lds;
    float* TW = (float*)(RAW + 34 * RW_LR);
    float* AL = TW + 32 * 64;
    float* W2s = AL + 32 * 64;
    float* A2s = W2s + 64 * 64;
    float* Rv = A2s + 64 * 64;
    float* Wv = Rv + 32 * 64; float* Kv = Wv + 32 * 64; float* Vv = Kv + 32 * 64; float* Av = Vv + 32 * 64; float* Bv = Av + 32 * 64;
    float* Yv = Bv + 32 * 64;
    const bf16_t* P = WSP(const bf16_t, WS_BIG + L1_P);
    bf16_t* OUT = WSP(bf16_t, WS_BIG + (dir ? L1_OB : L1_OF));
    float* BSC = WSP(float, WS_BSC) + (size_t)dir * RGL * 16;
    const float* mu = kp.in[24];
    for (int i = tid; i < 64 * 64; i += 512) { const int c = i >> 6, n = i & 63;
        W2s[i] = kp.in[26][((size_t)dir * 64 + c) * 1024 + h * 64 + n]; A2s[i] = kp.in[28][((size_t)dir * 64 + c) * 1024 + h * 64 + n]; }
    const int pi = tid >> 4, n4 = (tid & 15) * 4;
    f32x4 w0v = *(const f32x4*)(kp.in[25] + dir * 1024 + h * 64 + n4), a0v = *(const f32x4*)(kp.in[27] + dir * 1024 + h * 64 + n4);
    f32x4 kkw = *(const f32x4*)(kp.in[30] + h * 64 + n4), kaw = *(const f32x4*)(kp.in[31] + h * 64 + n4), rkw = *(const f32x4*)(kp.in[32] + h * 64 + n4);
    f32x4 mur = *(const f32x4*)(mu + h * 64 + n4), muk = *(const f32x4*)(mu + 1024 + h * 64 + n4), muv = *(const f32x4*)(mu + 2048 + h * 64 + n4);
    const int sv = tid >> 3, kq = tid & 7;
    float S[8];
#pragma unroll
    for (int i = 0; i < 8; ++i) S[i] = 0.f;
    __syncthreads();
    for (int ci = 0; ci < TT / 32; ++ci) {
        const int t0 = dir ? scan_t<32>(1, ci, 31) : ci * 32;
        const int lo = t0 < CTXL ? 0 : CTXL, hi = t0 < CTXL ? CTXL : TT;
        for (int p = tid; p < 34 * 40; p += 512) {
            const int rr = p / 40, c = p % 40, t = t0 - 1 + rr;
            u32x4 v = (u32x4){0u, 0u, 0u, 0u};
            if (t >= lo && t < hi) { const int seg = c >> 3, c8 = c & 7;
                const int col = seg == 0 ? CD_R + h * 64 : seg == 1 ? CD_K + h * 64 : seg == 2 ? CD_V + h * 64 : seg == 3 ? CD_WL + dir * 64 : CD_AL + dir * 64;
                v = *(const u32x4*)(P + ((size_t)bl * TT + t) * CD_N + col + c8 * 8); }
            *(u32x4*)(RAW + rr * RW_LR + c * 8) = v;
        }
        __syncthreads();
#pragma unroll
        for (int q = 0; q < 8; ++q) { const int idx = tid + q * 512, which = idx >> 11, i = (idx >> 6) & 31, c = idx & 63;
            const int rc = 192 + which * 64 + c;
            const float x = bf2f(RAW[(i + 1) * RW_LR + rc]), xp = bf2f(RAW[i * RW_LR + rc]), xn = bf2f(RAW[(i + 2) * RW_LR + rc]);
            const float m = mu[(which ? 3200 : 3072) + dir * 64 + c];
            const float l = x + m * (0.5f * (xp + xn) - x);
            if (which) AL[i * 64 + c] = l; else TW[i * 64 + c] = tanhf(l); }
        __syncthreads();
        {
            f32x4 wl = w0v, al = a0v;
            for (int c = 0; c < 64; ++c) { const float tw = TW[pi * 64 + c], av = AL[pi * 64 + c];
                wl += *(const f32x4*)(W2s + c * 64 + n4) * tw; al += *(const f32x4*)(A2s + c * 64 + n4) * av; }
            const bf16_t* r1 = RAW + (pi + 1) * RW_LR; const bf16_t* rp = RAW + pi * RW_LR; const bf16_t* rn = RAW + (pi + 2) * RW_LR;
            f32x4 r = ld4bf(r1 + n4), k = ld4bf(r1 + 64 + n4), v = ld4bf(r1 + 128 + n4);
            r = r + mur * ((ld4bf(rp + n4) + ld4bf(rn + n4)) * 0.5f - r);
            k = k + muk * ((ld4bf(rp + 64 + n4) + ld4bf(rn + 64 + n4)) * 0.5f - k);
            v = v + muv * ((ld4bf(rp + 128 + n4) + ld4bf(rn + 128 + n4)) * 0.5f - v);
            f32x4 w, a, kk = k * kkw;
            float ssq = kk[0] * kk[0] + kk[1] * kk[1] + kk[2] * kk[2] + kk[3] * kk[3];
            ssq += __shfl_xor(ssq, 1); ssq += __shfl_xor(ssq, 2); ssq += __shfl_xor(ssq, 4); ssq += __shfl_xor(ssq, 8);
            const float rn2 = 1.0f / fmaxf(sqrtf(ssq), 1e-12f);
            kk = kk * rn2;
#pragma unroll
            for (int q = 0; q < 4; ++q) { const float wlog = -softplusf_(-wl[q]) - 0.5f; w[q] = __expf(-__expf(wlog)); a[q] = sigmoidf_(al[q]); }
            const f32x4 kd = k * ((a - 1.0f) * kaw + 1.0f);
            float bs = r[0] * kd[0] * rkw[0] + r[1] * kd[1] * rkw[1] + r[2] * kd[2] * rkw[2] + r[3] * kd[3] * rkw[3];
            bs += __shfl_xor(bs, 1); bs += __shfl_xor(bs, 2); bs += __shfl_xor(bs, 4); bs += __shfl_xor(bs, 8);
            const int j = dir ? 31 - pi : pi;
            *(f32x4*)(Rv + j * 64 + n4) = r; *(f32x4*)(Wv + j * 64 + n4) = w; *(f32x4*)(Kv + j * 64 + n4) = kd; *(f32x4*)(Vv + j * 64 + n4) = v;
            *(f32x4*)(Av + j * 64 + n4) = kk * -1.0f; *(f32x4*)(Bv + j * 64 + n4) = kk * a;
            const int t = t0 + pi;
            if (t >= CTXL && (tid & 15) == 0) BSC[((size_t)bl * SEQ + (t - CTXL)) * 16 + h] = bs;
        }
        __syncthreads();
        for (int j = 0; j < 32; ++j) {
            const f32x4 a0 = *(const f32x4*)(Av + j * 64 + kq * 8), a1 = *(const f32x4*)(Av + j * 64 + kq * 8 + 4);
            const f32x4 w0 = *(const f32x4*)(Wv + j * 64 + kq * 8), w1 = *(const f32x4*)(Wv + j * 64 + kq * 8 + 4);
            const f32x4 b0 = *(const f32x4*)(Bv + j * 64 + kq * 8), b1 = *(const f32x4*)(Bv + j * 64 + kq * 8 + 4);
            const f32x4 k0 = *(const f32x4*)(Kv + j * 64 + kq * 8), k1 = *(const f32x4*)(Kv + j * 64 + kq * 8 + 4);
            const f32x4 r0 = *(const f32x4*)(Rv + j * 64 + kq * 8), r1 = *(const f32x4*)(Rv + j * 64 + kq * 8 + 4);
            const float vv = Vv[j * 64 + sv];
            float sa = S[0] * a0[0] + S[1] * a0[1] + S[2] * a0[2] + S[3] * a0[3] + S[4] * a1[0] + S[5] * a1[1] + S[6] * a1[2] + S[7] * a1[3];
            sa += __shfl_xor(sa, 1); sa += __shfl_xor(sa, 2); sa += __shfl_xor(sa, 4);
#pragma unroll
            for (int i = 0; i < 4; ++i) { S[i] = S[i] * w0[i] + sa * b0[i] + vv * k0[i]; S[4 + i] = S[4 + i] * w1[i] + sa * b1[i] + vv * k1[i]; }
            float y = S[0] * r0[0] + S[1] * r0[1] + S[2] * r0[2] + S[3] * r0[3] + S[4] * r1[0] + S[5] * r1[1] + S[6] * r1[2] + S[7] * r1[3];
            y += __shfl_xor(y, 1); y += __shfl_xor(y, 2); y += __shfl_xor(y, 4);
            if (kq == 0) Yv[j * 64 + sv] = y;
        }
        __syncthreads();
        if (t0 >= CTXL) { const int t = scan_t<32>(dir, ci, pi);
            st4bf(OUT + ((size_t)bl * SEQ + (t - CTXL)) * 1024 + h * 64 + n4, *(const f32x4*)(Yv + pi * 64 + n4)); }
    }
}

__device__ __forceinline__ void phase_mix_cd(const KP& kp, unsigned char* lds) {
    for (int u = obid(); u < 256; u += gridDim.x) { rwkv_unit(kp, lds, u >> 5, (u >> 1) & 15, u & 1); __syncthreads(); }
    for (int u = obid(); u < 1024; u += gridDim.x) { attn_unit(kp, lds, u >> 7, (u >> 4) & 7, u & 15); __syncthreads(); }
}

struct EpiFinCD {
    const bf16_t* OF; const bf16_t* OB; const bf16_t* P; const float* BSC; const float* ln; const float* mu; bf16_t* AOUT;
    __device__ __forceinline__ void operator()(const f32x4 (&acc)[4][4], int rb, int cb, int fr, int fq) const {
        const int head = cb >> 6;
#pragma unroll
        for (int i = 0; i < 4; ++i) { const int lr = rb + i * 16 + fr, s = lr & 2047;
            const size_t prow = (size_t)(lr >> 11) * TT + CTXL + s;
            f32x4 o[4]; float ss = 0.f;
#pragma unroll
            for (int j = 0; j < 4; ++j) { const int col = cb + j * 16 + fq * 4;
                o[j] = ld4bf(OF + (size_t)lr * 1024 + col) + ld4bf(OB + (size_t)lr * 1024 + col);
                ss += o[j][0] * o[j][0] + o[j][1] * o[j][1] + o[j][2] * o[j][2] + o[j][3] * o[j][3]; }
            ss += __shfl_xor(ss, 16); ss += __shfl_xor(ss, 32);
            const float rstd = rsqrtf(ss * (1.0f / 64.0f) + EPS);
            const float bon = BSC[(size_t)lr * 16 + head] + BSC[(size_t)RGL * 16 + (size_t)lr * 16 + head];
#pragma unroll
            for (int j = 0; j < 4; ++j) { const int col = cb + j * 16 + fq * 4;
                const bf16_t* pv = P + prow * CD_N + CD_V + col;
                const f32x4 v = ld4bf(pv);
                const f32x4 vp = s > 0 ? ld4bf(pv - CD_N) : (f32x4){0.f, 0.f, 0.f, 0.f};
                const f32x4 vn = s < SEQ - 1 ? ld4bf(pv + CD_N) : (f32x4){0.f, 0.f, 0.f, 0.f};
                const f32x4 vl = v + *(const f32x4*)(mu + 2048 + col) * ((vp + vn) * 0.5f - v);
                const f32x4 y = o[j] * rstd * *(const f32x4*)(ln + col) + vl * bon;
                st4bf(AOUT + (size_t)lr * 1536 + 512 + col, y * acc[i][j]); }
        }
    }
};
PHASE_FN void phase_fin_cd(const KP& kp, unsigned char* lds) {
    GA ga{WSP(const bf16_t, WS_SG), nullptr, 128, 0, 128, nullptr, RGL, 0, 0};
    EpiFinCD ep{WSP(const bf16_t, WS_BIG + L1_OF), WSP(const bf16_t, WS_BIG + L1_OB), WSP(const bf16_t, WS_BIG + L1_P), WSP(const float, WS_BSC), kp.in[33], kp.in[24], WSP(bf16_t, WS_BIG + L1_AOUT)};
    for (int u = obid(); u < (RGL / 256) * 8; u += gridDim.x) gemm_tile(lds, ga, WSP(const bf16_t, WS_WMIX + WM_G2), 128, u >> 3, u & 7, ep);
}
PHASE_FN void phase_gemm_out_cd(const KP& kp, unsigned char* lds) {
    GA ga{WSP(const bf16_t, WS_BIG + L1_AOUT), nullptr, 1536, 0, 1536, nullptr, RGL, 0, 0};
    EpiBf ep{WSP(bf16_t, WS_BIG + L1_U), 1024, RGL, 1024};
    for (int u = obid(); u < (RGL / 256) * 8; u += gridDim.x) gemm_tile(lds, ga, WSP(const bf16_t, WS_WMIX + WM_CD_OUT), 1536, u >> 3, u & 7, ep);
}

__device__ __attribute__((noinline)) void grid_sync(unsigned* barw, unsigned x, volatile LAS unsigned* st) { XcdBarrier b; b.bar = barw; b.x = x; b.st = st; xcd_barrier(b); }
constexpr int N_PHASES = 37;
__global__ void __launch_bounds__(512, 2) fwd_kernel(KP kparg) {
    extern __shared__ __attribute__((aligned(16))) unsigned char lds[];
    const int lo = kparg.ph_lo, hi = kparg.ph_hi;
    KP* skp = (KP*)(lds + LDS_BYTES - 1024);
    if (threadIdx.x == 0) {
#pragma unroll
        for (int i = 0; i < 42; ++i) skp->in[i] = kparg.in[i];
        skp->out = kparg.out; skp->ws = kparg.ws; skp->ph_lo = lo; skp->ph_hi = hi; }
    const KP& kp = *skp;
    volatile LAS unsigned* xbst = (volatile LAS unsigned*)(LAS unsigned char*)(lds + LDS_BYTES - 16);
    if (threadIdx.x == 0) { xbst[0] = 0u; xbst[1] = 0u; }
    __syncthreads();
    XcdBarrier bar; bar.bar = (unsigned*)kparg.ws; bar.x = 0; bar.st = xbst;
    if (hi - lo > 1) bar = xcd_barrier_post((unsigned*)kparg.ws, xbst);
#define IN(k) (lo <= (k) && (k) < hi)
#define SEAM(k) do { if (IN(k) && IN((k) + 1)) grid_sync(bar.bar, bar.x, bar.st); } while (0)
    if (IN(0)) { phase_mod(kp, lds); __syncthreads(); phase_conv_ab(kp, lds); }
    SEAM(0);
    for (int g = 0; g < NG; ++g) {
        const int pb = 1 + g * 6;
        if (IN(pb + 0)) phase_u(kp, 0, g);
        SEAM(pb + 0);
        if (IN(pb + 1)) phase_gemm_in(kp, lds, 0);
        SEAM(pb + 1);
        if (IN(pb + 2)) phase_scan_ab(kp, lds);
        SEAM(pb + 2);
        if (IN(pb + 3)) phase_fin_ab(kp);
        SEAM(pb + 3);
        if (IN(pb + 4)) phase_gemm_out_ab(kp, lds);
        SEAM(pb + 4);
        if (IN(pb + 5)) phase_r(kp, lds, 0, g);
        SEAM(pb + 5);
    }
    if (IN(13)) { phase_conv_moe(kp, lds, 0); phase_conv_cd(kp, lds); }
    SEAM(13);
    if (IN(14)) phase_moe_gemm(kp, lds, 0, false);
    SEAM(14);
    if (IN(15)) phase_moe_gemm(kp, lds, 0, true);
    SEAM(15);
    if (IN(16)) phase_combine(kp, 0);
    SEAM(16);
    for (int g = 0; g < NG; ++g) {
        const int pb = 17 + g * 8;
        if (IN(pb + 0)) phase_u(kp, 1, g);
        SEAM(pb + 0);
        if (IN(pb + 1)) phase_gemm_in(kp, lds, 1);
        SEAM(pb + 1);
        if (IN(pb + 2)) phase_prep_cd(kp);
        SEAM(pb + 2);
        if (IN(pb + 3)) phase_upproj(kp, lds);
        SEAM(pb + 3);
        if (IN(pb + 4)) phase_mix_cd(kp, lds);
        SEAM(pb + 4);
        if (IN(pb + 5)) phase_fin_cd(kp, lds);
        SEAM(pb + 5);
        if (IN(pb + 6)) phase_gemm_out_cd(kp, lds);
        SEAM(pb + 6);
        if (IN(pb + 7)) phase_r(kp, lds, 1, g);
        SEAM(pb + 7);
    }
    if (IN(33)) phase_conv_moe(kp, lds, 1);
    SEAM(33);
    if (IN(34)) phase_moe_gemm(kp, lds, 1, false);
    SEAM(34);
    if (IN(35)) phase_moe_gemm(kp, lds, 1, true);
    SEAM(35);
    if (IN(36)) phase_combine(kp, 1);
#undef IN
#undef SEAM
}

extern "C" void kernel_launch(void* const* d_in, const int* in_sizes, int n_in, void* d_out, int out_size, void* d_ws, size_t ws_size, hipStream_t stream) {
    static int grid = 0;
    if (grid == 0) {
        if (n_in != 42 || out_size != NLAT * D || ws_size < WS_NEED) { fprintf(stderr, "kernel_launch: unexpected shapes: n_in %d out %d ws %zu (need %zu)\n", n_in, out_size, ws_size, (size_t)WS_NEED); grid = -1; return; }
        int dev = 0, cus = 0, per_cu = 0;
        if (hipGetDevice(&dev) != hipSuccess || hipDeviceGetAttribute(&cus, hipDeviceAttributeMultiprocessorCount, dev) != hipSuccess) { grid = -1; return; }
        if (hipFuncSetAttribute((const void*)fwd_kernel, hipFuncAttributeMaxDynamicSharedMemorySize, LDS_BYTES) != hipSuccess) { fprintf(stderr, "kernel_launch: hipFuncSetAttribute failed\n"); grid = -1; return; }
        if (hipOccupancyMaxActiveBlocksPerMultiprocessor(&per_cu, (const void*)fwd_kernel, 512, LDS_BYTES) != hipSuccess || per_cu < 1) { fprintf(stderr, "kernel_launch: occupancy query says %d blocks per CU\n", per_cu); grid = -1; (void)hipGetLastError(); return; }
        grid = cus;
    }
    if (grid < 0) return;
    (void)hipMemsetAsync(d_ws, 0, CTL_BYTES, stream);
    KP kp{};
    for (int i = 0; i < 42; ++i) kp.in[i] = (const float*)d_in[i];
    kp.out = (float*)d_out; kp.ws = (unsigned char*)d_ws;
#if N_LAUNCH_MODE == 1
    kp.ph_lo = 0; kp.ph_hi = N_PHASES;
    hipLaunchKernelGGL(fwd_kernel, dim3(grid), dim3(512), LDS_BYTES, stream, kp);
#else
    for (int p = 0; p < N_PHASES; ++p) { kp.ph_lo = p; kp.ph_hi = p + 1; hipLaunchKernelGGL(fwd_kernel, dim3(grid), dim3(512), LDS_BYTES, stream, kp); }
#endif
}
```

```cpp
#include <hip/hip_runtime.h>
#include <stdint.h>
#include <stdio.h>

typedef unsigned short bf16_t;
typedef short bf16x8 __attribute__((ext_vector_type(8)));
typedef float f32x4 __attribute__((ext_vector_type(4)));
typedef float f32x2 __attribute__((ext_vector_type(2)));
typedef unsigned u32x4 __attribute__((ext_vector_type(4)));
typedef unsigned u32x2 __attribute__((ext_vector_type(2)));

#ifndef PROBE_DUP
#define PROBE_DUP 0
#endif
#ifndef N_LAUNCH_MODE
#define N_LAUNCH_MODE 1
#endif

constexpr int NB = 16, SEQ = 2048, CTXL = 256, TT = 2304, D = 1024;
constexpr int NTOK = NB * TT, NLAT = NB * SEQ;
constexpr int NG = 2, BG = NB / NG, RG = BG * TT, RGL = BG * SEQ;
constexpr float EPS = 1e-6f;
constexpr int AB_N = 5424, AB_NPAD = 5504, AB_Q = 0, AB_K = 512, AB_V = 1024, AB_OG = 2048, AB_IG = 3072, AB_FG = 3080, AB_Z = 3088, AB_XBC = 4112, AB_DT = 5392;
constexpr int CD_N = 4128, CD_NPAD = 4224, CD_M0 = 0, CD_M1 = 384, CD_KR = 640, CD_R = 672, CD_K = 1696, CD_V = 2720, CD_WL = 3744, CD_AL = 3872, CD_GL = 4000;
constexpr int CD_RW0 = 672;

constexpr size_t CTL_BYTES = 32768;
constexpr size_t CTL_CNT = 16384;
constexpr size_t WS_MODV = CTL_BYTES;
constexpr size_t WS_HC   = WS_MODV + (size_t)2 * 17 * 6144 * 4;
constexpr size_t WS_TOKE = WS_HC + (size_t)NB * CTXL * D * 4;
constexpr size_t WS_TOKP = WS_TOKE + (size_t)NTOK * 2 * 4;
constexpr size_t WS_TOKW = WS_TOKP + (size_t)NTOK * 2 * 4;
constexpr size_t WS_LIST = WS_TOKW + (size_t)NTOK * 2 * 4;
constexpr size_t WS_BSC  = WS_LIST + (size_t)16 * NTOK * 4;
constexpr size_t WS_SG   = WS_BSC + (size_t)2 * RGL * 16 * 4;
constexpr size_t WS_WMIX = WS_SG + (size_t)RGL * 128 * 2;
constexpr size_t WMIX_BYTES = (size_t)16 << 20;
constexpr size_t WS_V    = WS_WMIX + WMIX_BYTES;
constexpr size_t WS_BIG  = WS_V + (size_t)NTOK * D * 2;
constexpr size_t WM_AB_IN = 0, WM_AB_OUT = (size_t)AB_NPAD * 1024 * 2;
constexpr size_t WM_CD_IN = 0, WM_CD_OUT = (size_t)CD_NPAD * 1024 * 2, WM_UQ = WM_CD_OUT + (size_t)1024 * 1536 * 2, WM_UKV = WM_UQ + (size_t)768 * 384 * 2, WM_G2 = WM_UKV + (size_t)1024 * 256 * 2;
static_assert(WM_AB_OUT + (size_t)1024 * 2048 * 2 <= WMIX_BYTES, "wmix ab");
static_assert(WM_G2 + (size_t)1024 * 128 * 2 <= WMIX_BYTES, "wmix cd");
constexpr size_t SZ_RG1K = (size_t)RG * 1024 * 2, SZ_RGL1K = (size_t)RGL * 1024 * 2;
constexpr size_t L0_P = 0, L0_HF = (size_t)RG * AB_N * 2, L0_HB = L0_HF + SZ_RG1K, L0_YF = L0_HB + SZ_RG1K, L0_YB = L0_YF + SZ_RG1K, L0_U = L0_YB + SZ_RG1K, L0_END = L0_U + SZ_RG1K;
constexpr size_t L1_P = 0, L1_Q = (size_t)RG * CD_N * 2, L1_KV = L1_Q + (size_t)RGL * 768 * 2, L1_OF = L1_KV + SZ_RG1K, L1_OB = L1_OF + SZ_RGL1K, L1_AOUT = L1_OB + SZ_RGL1K, L1_U = L1_AOUT + (size_t)RGL * 1536 * 2, L1_END = L1_U + SZ_RG1K;
constexpr size_t MOE_EXP_BYTES = (size_t)3 * 1024 * 512 * 2;
constexpr size_t MO_W = 0, MO_HID = (size_t)17 * MOE_EXP_BYTES, MO_CON = MO_HID + (size_t)3 * NTOK * 512 * 2, MO_END = MO_CON + (size_t)3 * NTOK * 1024 * 2;
constexpr size_t BIG_BYTES = MO_END > L0_END ? (MO_END > L1_END ? MO_END : L1_END) : (L0_END > L1_END ? L0_END : L1_END);
constexpr size_t WS_NEED = WS_BIG + BIG_BYTES;

constexpr int LDS_BYTES = 147456;

__device__ __forceinline__ float bf2f(unsigned short h) { return __uint_as_float(((unsigned)h) << 16); }
__device__ __forceinline__ unsigned short f2bf(float f) { unsigned u = __float_as_uint(f); u += 0x7fffu + ((u >> 16) & 1u); return (unsigned short)(u >> 16); }
__device__ __forceinline__ unsigned pack2(float a, float b) { return (unsigned)f2bf(a) | ((unsigned)f2bf(b) << 16); }
__device__ __forceinline__ float lo2f(unsigned w) { return __uint_as_float(w << 16); }
__device__ __forceinline__ float hi2f(unsigned w) { return __uint_as_float(w & 0xffff0000u); }
__device__ __forceinline__ float wsum(float v) {
#pragma unroll
    for (int o = 32; o; o >>= 1) v += __shfl_xor(v, o);
    return v; }
__device__ __forceinline__ float sigmoidf_(float x) { return 1.0f / (1.0f + __expf(-x)); }
__device__ __forceinline__ float siluf_(float x) { return x / (1.0f + __expf(-x)); }
__device__ __forceinline__ float softplusf_(float x) { return fmaxf(x, 0.0f) + log1pf(__expf(-fabsf(x))); }
__device__ __forceinline__ float logsigmoidf_(float x) { return fminf(x, 0.0f) - log1pf(__expf(-fabsf(x))); }
__device__ __forceinline__ f32x4 mma16(bf16x8 a, bf16x8 b, f32x4 c) { return __builtin_amdgcn_mfma_f32_16x16x32_bf16(a, b, c, 0, 0, 0); }
__device__ __forceinline__ bf16x8 ldfrag(const bf16_t* base, int ld, int row0, int k0, int fr, int fq) { return *(const bf16x8*)(base + (row0 + fr) * ld + k0 + fq * 8); }
__device__ __forceinline__ void st4bf(bf16_t* p, f32x4 v) { u32x2 w; w.x = pack2(v[0], v[1]); w.y = pack2(v[2], v[3]); *(u32x2*)p = w; }
__device__ __forceinline__ f32x4 ld4bf(const bf16_t* p) { u32x2 w = *(const u32x2*)p; return (f32x4){lo2f(w.x), hi2f(w.x), lo2f(w.y), hi2f(w.y)}; }

#define PHASE_FN __device__ __forceinline__
__device__ __forceinline__ int otid() { int t = threadIdx.x; asm volatile("" : "+v"(t)); return t; }
__device__ __forceinline__ int obid() { int t = blockIdx.x; asm volatile("" : "+s"(t)); return t; }
struct KP { const float* in[42]; float* out; unsigned char* ws; int ph_lo, ph_hi; };

#define XB_TMO      128
#define XB_XCNT(j)  (256  + 64 * (j))
#define XB_XSUB(j)  (1280 + 64 * (j))
#define XB_XGEN(j)  (2304 + 64 * (j))
#define XB_TOP      3328
#define XB_TOPGEN   3392
#define XCD_BAR_WORDS 3456
#define XB_SPIN_CAP (1u << 18)
#define LAS __attribute__((address_space(3)))

__device__ __forceinline__ unsigned xb_ld(unsigned* p)              { return __hip_atomic_load(p, __ATOMIC_RELAXED, __HIP_MEMORY_SCOPE_AGENT); }
__device__ __forceinline__ unsigned xb_add(unsigned* p, unsigned v) { return __hip_atomic_fetch_add(p, v, __ATOMIC_RELAXED, __HIP_MEMORY_SCOPE_AGENT); }
__device__ __forceinline__ unsigned xb_xcc_id() { return (unsigned)__builtin_amdgcn_s_getreg((3 << 11) | 20) & 0xFu; }
#define XB_SPIN(cond, bar) do { unsigned _sp = 0; while (cond) { __builtin_amdgcn_s_sleep(1); \
    if ((++_sp & 255u) == 0u) { if (xb_ld(&(bar)[XB_TMO])) break; if (_sp > XB_SPIN_CAP) { atomicAdd(&(bar)[XB_TMO], 1u); break; } } } } while (0)

struct XcdBarrier {
    unsigned* bar; unsigned x;
    volatile LAS unsigned* st;
};

__device__ __forceinline__ XcdBarrier xcd_barrier_post(unsigned* bar, volatile LAS unsigned* st) {
    XcdBarrier b; b.bar = bar; b.x = xb_xcc_id(); b.st = st;
    if (threadIdx.x == 0) (void)xb_add(&bar[XB_XCNT(b.x)], 1u);
    return b;
}
__device__ __forceinline__ void xcd_barrier_complete(unsigned* bar, unsigned x, unsigned& nloc, unsigned& nx) {
    const unsigned G = gridDim.x * gridDim.y * gridDim.z;
    unsigned sum, cnt, mine, sp = 0u;
    for (;;) {
        sum = 0u; cnt = 0u; mine = 0u;
#pragma unroll
        for (unsigned j = 0; j < 16; ++j) { const unsigned c = xb_ld(&bar[XB_XCNT(j)]); sum += c; cnt += (c > 0u) ? 1u : 0u; mine = (j == x) ? c : mine; }
        if (sum == G) break;
        __builtin_amdgcn_s_sleep(1);
        if ((++sp & 255u) == 0u) { if (xb_ld(&bar[XB_TMO])) break; if (sp > XB_SPIN_CAP) { atomicAdd(&bar[XB_TMO], 1u); break; } }
    }
    nloc = mine > 0u ? mine : 1u; nx = cnt > 0u ? cnt : 1u;
}

__device__ __forceinline__ void xcd_barrier(const XcdBarrier& b) {
    asm volatile("s_waitcnt vmcnt(0)" ::: "memory");
    __syncthreads();
    if (threadIdx.x == 0) {
        unsigned* bar = b.bar;
        __builtin_amdgcn_s_waitcnt(0);
        unsigned nloc = b.st[0], nx = b.st[1];
        if (nloc == 0u) { xcd_barrier_complete(bar, b.x, nloc, nx); b.st[0] = nloc; b.st[1] = nx; }
        const unsigned old = xb_add(&bar[XB_XSUB(b.x)], 1u);
        const unsigned gen = old / nloc;
        if (old + 1u == (gen + 1u) * nloc) {
            __builtin_amdgcn_fence(__ATOMIC_RELEASE, "agent");
            asm volatile("s_waitcnt vmcnt(0)" ::: "memory");
            const unsigned og = xb_add(&bar[XB_TOP], 1u);
            const unsigned tg = og / nx;
            if (og + 1u == (tg + 1u) * nx) xb_add(&bar[XB_TOPGEN], 1u);
            else XB_SPIN(xb_ld(&bar[XB_TOPGEN]) == tg, bar);
            __builtin_amdgcn_fence(__ATOMIC_ACQUIRE, "agent");
            xb_add(&bar[XB_XGEN(b.x)], 1u);
            asm volatile("s_waitcnt vmcnt(0)" ::: "memory");
        } else {
            XB_SPIN(xb_ld(&bar[XB_XGEN(b.x)]) == gen, bar);
            __builtin_amdgcn_fence(__ATOMIC_ACQUIRE, "agent");
            asm volatile("s_waitcnt vmcnt(0)" ::: "memory");
        }
    }
    __syncthreads();
}
struct GA {
    const bf16_t* a0; const bf16_t* a1;
    int ld0, ld1, ksplit;
    const int* list;
    int nrows;
    int mode;
    int row0;
};
constexpr int G_LDT = 40;
constexpr int GEMM_LDS = (2 * 256 * G_LDT + 2 * 128 * G_LDT) * 2;

template <class Epi>
__device__ __forceinline__ void gemm_tile(unsigned char* lds, const GA& ga, const bf16_t* __restrict__ Bt, int K, int mt, int nt, const Epi& epi) {
    const int tid = otid(), lane = tid & 63, wid = tid >> 6, wm = wid >> 1, wn = wid & 1, fr = lane & 15, fq = lane >> 4;
    bf16_t* sA = (bf16_t*)lds;
    bf16_t* sB = sA + 2 * 256 * G_LDT;
    const int kp = tid & 3;
    const int r0 = tid >> 2, r1 = r0 + 128;
    int s0, s1;
    {
        int lr = mt * 256 + r0; if (lr >= ga.nrows) lr = 0;
        s0 = ga.list ? ga.list[lr] : (ga.mode == 1 ? (lr >> 11) * TT + CTXL + (lr & 2047) : ga.row0 + lr);
        lr = mt * 256 + r1; if (lr >= ga.nrows) lr = 0;
        s1 = ga.list ? ga.list[lr] : (ga.mode == 1 ? (lr >> 11) * TT + CTXL + (lr & 2047) : ga.row0 + lr);
    }
    const bf16_t* pa00 = ga.a0 + (size_t)s0 * ga.ld0 + kp * 8;
    const bf16_t* pa01 = ga.a0 + (size_t)s1 * ga.ld0 + kp * 8;
    const bf16_t* pa10 = ga.a1 ? ga.a1 + (size_t)s0 * ga.ld1 + kp * 8 : pa00;
    const bf16_t* pa11 = ga.a1 ? ga.a1 + (size_t)s1 * ga.ld1 + kp * 8 : pa01;
    const bf16_t* pb = Bt + (size_t)(nt * 128 + r0) * K + kp * 8;
    const int ksplit = ga.ksplit;
    f32x4 acc[4][4];
#pragma unroll
    for (int i = 0; i < 4; ++i)
#pragma unroll
        for (int j = 0; j < 4; ++j) acc[i][j] = (f32x4){0.f, 0.f, 0.f, 0.f};
    const int nk = K >> 5;
    u32x4 ra0, ra1, rb;
    {
        ra0 = *(const u32x4*)(pa00); ra1 = *(const u32x4*)(pa01); rb = *(const u32x4*)(pb);
        if (0 >= ksplit) { ra0 = *(const u32x4*)(pa10); ra1 = *(const u32x4*)(pa11); }
    }
    *(u32x4*)(sA + (r0) * G_LDT + kp * 8) = ra0;
    *(u32x4*)(sA + (r1) * G_LDT + kp * 8) = ra1;
    *(u32x4*)(sB + (r0) * G_LDT + kp * 8) = rb;
    __syncthreads();
    for (int kt = 0; kt < nk; ++kt) {
        const int cur = kt & 1;
        if (kt + 1 < nk) {
            const int k0 = (kt + 1) << 5;
            if (k0 < ksplit) { ra0 = *(const u32x4*)(pa00 + k0); ra1 = *(const u32x4*)(pa01 + k0); }
            else { ra0 = *(const u32x4*)(pa10 + (k0 - ksplit)); ra1 = *(const u32x4*)(pa11 + (k0 - ksplit)); }
            rb = *(const u32x4*)(pb + k0);
        }
        const bf16_t* cA = sA + cur * 256 * G_LDT;
        const bf16_t* cB = sB + cur * 128 * G_LDT;
        bf16x8 af[4], bfr[4];
#pragma unroll
        for (int i = 0; i < 4; ++i) af[i] = ldfrag(cA, G_LDT, wm * 64 + i * 16, 0, fr, fq);
#pragma unroll
        for (int j = 0; j < 4; ++j) bfr[j] = ldfrag(cB, G_LDT, wn * 64 + j * 16, 0, fr, fq);
#pragma unroll
        for (int i = 0; i < 4; ++i)
#pragma unroll
            for (int j = 0; j < 4; ++j) acc[i][j] = mma16(bfr[j], af[i], acc[i][j]);
        if (kt + 1 < nk) {
            const int nb = cur ^ 1;
            *(u32x4*)(sA + (nb * 256 + r0) * G_LDT + kp * 8) = ra0;
            *(u32x4*)(sA + (nb * 256 + r1) * G_LDT + kp * 8) = ra1;
            *(u32x4*)(sB + (nb * 128 + r0) * G_LDT + kp * 8) = rb;
        }
        __syncthreads();
    }
    epi(acc, mt * 256 + wm * 64, nt * 128 + wn * 64, fr, fq);
}

struct EpiBf {
    bf16_t* out; int ld, nrows, ncols;
    __device__ __forceinline__ void operator()(const f32x4 (&acc)[4][4], int rb, int cb, int fr, int fq) const {
#pragma unroll
        for (int i = 0; i < 4; ++i) { const int lr = rb + i * 16 + fr; if (lr < nrows) {
#pragma unroll
            for (int j = 0; j < 4; ++j) { const int col = cb + j * 16 + fq * 4; if (col < ncols) st4bf(out + (size_t)lr * ld + col, acc[i][j]); } } }
    }
};
struct EpiSwiglu {
    bf16_t* out; int nrows;
    __device__ __forceinline__ void operator()(const f32x4 (&acc)[4][4], int rb, int cb, int fr, int fq) const {
#pragma unroll
        for (int i = 0; i < 4; ++i) { const int lr = rb + i * 16 + fr; if (lr < nrows) {
#pragma unroll
            for (int j = 0; j < 2; ++j) { const int col = (cb >> 1) + j * 16 + fq * 4; f32x4 g = acc[i][j], u = acc[i][j + 2], o;
#pragma unroll
                for (int r = 0; r < 4; ++r) o[r] = siluf_(g[r]) * u[r];
                st4bf(out + (size_t)lr * 512 + col, o); } } }
    }
};

#define WSP(T, off) ((T*)(kp.ws + (off)))

PHASE_FN void phase_mod(const KP& kp, unsigned char* lds) {
    float* sc = (float*)lds;
    float* red = sc + 17 * 1024;
    float* modv = WSP(float, WS_MODV);
    const int tid = otid();
    for (int i = tid; i < 17 * 1024; i += 512) { const int bb = i >> 10, k = i & 1023; const float c = bb < 16 ? kp.in[1][bb * 1024 + k] : kp.in[3][k]; sc[i] = siluf_(c); }
    __syncthreads();
    const int jc = tid & 63, ks = tid >> 6;
    for (int u = obid(); u < 192; u += gridDim.x) {
        const int l = u / 96, j0 = (u % 96) * 64;
        const float* w = kp.in[4] + (size_t)l * 1024 * 6144 + j0 + jc;
        float acc[17];
#pragma unroll
        for (int bb = 0; bb < 17; ++bb) acc[bb] = 0.f;
        for (int k = ks * 128; k < ks * 128 + 128; ++k) {
            const float wv = w[(size_t)k * 6144];
#pragma unroll
            for (int bb = 0; bb < 17; ++bb) acc[bb] += sc[bb * 1024 + k] * wv;
        }
#pragma unroll
        for (int bb = 0; bb < 17; ++bb) red[(ks * 17 + bb) * 64 + jc] = acc[bb];
        __syncthreads();
        for (int i = tid; i < 17 * 64; i += 512) {
            const int bb = i >> 6, j = i & 63; float s = kp.in[5][l * 6144 + j0 + j];
#pragma unroll
            for (int k2 = 0; k2 < 8; ++k2) s += red[(k2 * 17 + bb) * 64 + j];
            modv[((size_t)l * 17 + bb) * 6144 + j0 + j] = s;
        }
        __syncthreads();
    }
}

__device__ __forceinline__ void conv_tile(float* tile, const float* src, int N, int ldsrc, bf16_t* dst, int ldd, int mode, int kt, int ntile) {
    const int tid = otid(), c = tid & 63, r8 = tid >> 6;
#pragma unroll
    for (int i = 0; i < 8; ++i) { const int k = i * 8 + r8, n = ntile * 64 + c; tile[k * 65 + c] = (n < N) ? src[(size_t)(kt * 64 + k) * ldsrc + n] : 0.f; }
    __syncthreads();
#pragma unroll
    for (int i = 0; i < 8; ++i) { const int nl = i * 8 + r8, n = ntile * 64 + nl;
        if (n < N) { int row = n; if (mode) row = (n >> 6) * 128 + ((n >> 5) & 1) * 64 + (n & 31) + (mode == 2 ? 32 : 0);
            dst[(size_t)row * ldd + kt * 64 + c] = f2bf(tile[c * 65 + nl]); } }
    __syncthreads();
}
__device__ __forceinline__ bool conv_job(float* tile, int& u, const float* src, int K, int N, bf16_t* dst, int mode = 0, int ldd = -1) {
    const int ntl = (N + 63) >> 6, ktl = K >> 6, cnt = ntl * ktl;
    if (u < cnt) { conv_tile(tile, src, N, N, dst, ldd < 0 ? K : ldd, mode, u / ntl, u % ntl); return true; }
    u -= cnt; return false;
}
PHASE_FN void phase_conv_ab(const KP& kp, unsigned char* lds) {
    float* tile = (float*)lds;
    const int total = 16 * 85 + 32 * 16;
    for (int u0 = obid(); u0 < total; u0 += gridDim.x) { int u = u0;
        if (conv_job(tile, u, kp.in[7], 1024, AB_N, WSP(bf16_t, WS_WMIX + WM_AB_IN))) continue;
        conv_job(tile, u, kp.in[8], 2048, 1024, WSP(bf16_t, WS_WMIX + WM_AB_OUT)); }
}
PHASE_FN void phase_conv_cd(const KP& kp, unsigned char* lds) {
    float* tile = (float*)lds;
    const int total = 16 * 65 + 24 * 16 + 6 * 12 + 4 * 16 + 2 * 16;
    for (int u0 = obid(); u0 < total; u0 += gridDim.x) { int u = u0;
        if (conv_job(tile, u, kp.in[18], 1024, CD_N, WSP(bf16_t, WS_WMIX + WM_CD_IN))) continue;
        if (conv_job(tile, u, kp.in[19], 1536, 1024, WSP(bf16_t, WS_WMIX + WM_CD_OUT))) continue;
        if (conv_job(tile, u, kp.in[21], 384, 768, WSP(bf16_t, WS_WMIX + WM_UQ))) continue;
        if (conv_job(tile, u, kp.in[23], 256, 1024, WSP(bf16_t, WS_WMIX + WM_UKV))) continue;
        conv_job(tile, u, kp.in[29], 128, 1024, WSP(bf16_t, WS_WMIX + WM_G2)); }
}
PHASE_FN void phase_conv_moe(const KP& kp, unsigned char* lds, int l) {
    float* tile = (float*)lds;
    const int total = 17 * 384;
    for (int u0 = obid(); u0 < total; u0 += gridDim.x) {
        const int es = u0 / 384; int u = u0 % 384;
        const float* wg = es < 16 ? kp.in[36] + ((size_t)l * 16 + es) * 1024 * 512 : kp.in[39] + (size_t)l * 1024 * 512;
        const float* wu = es < 16 ? kp.in[37] + ((size_t)l * 16 + es) * 1024 * 512 : kp.in[40] + (size_t)l * 1024 * 512;
        const float* wd = es < 16 ? kp.in[38] + ((size_t)l * 16 + es) * 512 * 1024 : kp.in[41] + (size_t)l * 512 * 1024;
        bf16_t* dup = WSP(bf16_t, WS_BIG + MO_W + (size_t)es * MOE_EXP_BYTES);
        bf16_t* ddn = dup + (size_t)1024 * 1024;
        if (conv_job(tile, u, wg, 1024, 512, dup, 1, 1024)) continue;
        if (conv_job(tile, u, wu, 1024, 512, dup, 2, 1024)) continue;
        conv_job(tile, u, wd, 512, 1024, ddn, 0, 512); }
}

__device__ __forceinline__ const float* hrow_rd(const KP& kp, bool from_inputs, int b, int t) {
    if (t < CTXL) return (from_inputs ? kp.in[2] : WSP(const float, WS_HC)) + ((size_t)b * CTXL + t) * D;
    return (from_inputs ? kp.in[0] : kp.out) + ((size_t)b * SEQ + (t - CTXL)) * D;
}
__device__ __forceinline__ float* hrow_wr(const KP& kp, int b, int t) {
    if (t < CTXL) return WSP(float, WS_HC) + ((size_t)b * CTXL + t) * D;
    return kp.out + ((size_t)b * SEQ + (t - CTXL)) * D;
}

PHASE_FN void phase_u(const KP& kp, int layer, int g) {
    const int lane = otid() & 63, wid = otid() >> 6;
    const float* modv = WSP(const float, WS_MODV) + (size_t)layer * 17 * 6144;
    const float* ng = kp.in[6] + (size_t)layer * 4 * 1024;
    bf16_t* U = WSP(bf16_t, WS_BIG + (layer == 0 ? L0_U : L1_U));
    for (int lr = obid() * 8 + wid; lr < RG; lr += gridDim.x * 8) {
        const int bl = lr / TT, t = lr - bl * TT, b = g * BG + bl;
        const float* src = hrow_rd(kp, layer == 0, b, t);
        const float* mv = modv + (size_t)(t < CTXL ? 16 : b) * 6144;
        f32x4 x[4]; float ss = 0.f;
#pragma unroll
        for (int i = 0; i < 4; ++i) { x[i] = *(const f32x4*)(src + i * 256 + lane * 4); ss += x[i][0] * x[i][0] + x[i][1] * x[i][1] + x[i][2] * x[i][2] + x[i][3] * x[i][3]; }
        ss = wsum(ss); const float rstd = rsqrtf(ss * (1.0f / 1024.0f) + EPS);
#pragma unroll
        for (int i = 0; i < 4; ++i) { const int col = i * 256 + lane * 4;
            const f32x4 gv = *(const f32x4*)(ng + col), sc = *(const f32x4*)(mv + 1024 + col), sh = *(const f32x4*)(mv + col);
            st4bf(U + (size_t)lr * 1024 + col, x[i] * rstd * gv * (sc + 1.0f) + sh); }
    }
}

PHASE_FN void phase_r(const KP& kp, unsigned char* lds, int layer, int g) {
    const int tid = otid(), lane = tid & 63, wid = tid >> 6;
    float* rw = (float*)lds;
    int* se = (int*)(rw + 1024 * 16);
    int* sbase = se + 128;
    for (int i = tid; i < 1024 * 16; i += 512) rw[i] = kp.in[34][i];
    __syncthreads();
    const float* modv = WSP(const float, WS_MODV) + (size_t)layer * 17 * 6144;
    const float* ng = kp.in[6] + (size_t)layer * 4 * 1024;
    const bf16_t* MIX = WSP(const bf16_t, WS_BIG + (layer == 0 ? L0_U : L1_U));
    bf16_t* V = WSP(bf16_t, WS_V);
    unsigned* cnt = WSP(unsigned, CTL_CNT) + layer * 16;
    int* TOKE = WSP(int, WS_TOKE); int* TOKP = WSP(int, WS_TOKP); float* TOKW = WSP(float, WS_TOKW); int* LIST = WSP(int, WS_LIST);
    const int nrows = layer == 0 ? RG : RGL, nchunks = nrows >> 6;
    float rbias[16];
#pragma unroll
    for (int e = 0; e < 16; ++e) rbias[e] = kp.in[35][e];
    for (int ch = obid(); ch < nchunks; ch += gridDim.x) {
        for (int rr = 0; rr < 8; ++rr) {
            const int rl = wid * 8 + rr, lr = ch * 64 + rl;
            int b, t, tok;
            if (layer == 0) { const int bl = lr / TT; t = lr - bl * TT; b = g * BG + bl; tok = g * RG + lr; }
            else { const int bl = lr >> 11; t = CTXL + (lr & 2047); b = g * BG + bl; tok = g * RGL + lr; }
            const float* hsrc = hrow_rd(kp, layer == 0, b, t);
            float* hdst = hrow_wr(kp, b, t);
            const float* mv = modv + (size_t)(t < CTXL ? 16 : b) * 6144;
            f32x4 y[4], h[4]; float ss = 0.f;
#pragma unroll
            for (int i = 0; i < 4; ++i) { y[i] = ld4bf(MIX + (size_t)lr * 1024 + i * 256 + lane * 4); ss += y[i][0] * y[i][0] + y[i][1] * y[i][1] + y[i][2] * y[i][2] + y[i][3] * y[i][3]; }
            ss = wsum(ss); float rstd = rsqrtf(ss * (1.0f / 1024.0f) + EPS);
            float s2 = 0.f;
#pragma unroll
            for (int i = 0; i < 4; ++i) { const int col = i * 256 + lane * 4;
                const f32x4 g1 = *(const f32x4*)(ng + 1024 + col), ga = *(const f32x4*)(mv + 2048 + col), hx = *(const f32x4*)(hsrc + col);
                h[i] = hx + ga * (y[i] * rstd * g1);
                *(f32x4*)(hdst + col) = h[i];
                s2 += h[i][0] * h[i][0] + h[i][1] * h[i][1] + h[i][2] * h[i][2] + h[i][3] * h[i][3]; }
            s2 = wsum(s2); rstd = rsqrtf(s2 * (1.0f / 1024.0f) + EPS);
            float lg[16];
#pragma unroll
            for (int e = 0; e < 16; ++e) lg[e] = 0.f;
#pragma unroll
            for (int i = 0; i < 4; ++i) { const int col = i * 256 + lane * 4;
                const f32x4 g2 = *(const f32x4*)(ng + 2048 + col), scf = *(const f32x4*)(mv + 4096 + col), shf = *(const f32x4*)(mv + 3072 + col);
                const f32x4 v = h[i] * rstd * g2 * (scf + 1.0f) + shf;
                st4bf(V + (size_t)tok * 1024 + col, v);
#pragma unroll
                for (int j = 0; j < 4; ++j) {
#pragma unroll
                    for (int q = 0; q < 4; ++q) { const f32x4 w4 = *(const f32x4*)(rw + (col + j) * 16 + q * 4);
                        lg[q * 4 + 0] += v[j] * w4[0]; lg[q * 4 + 1] += v[j] * w4[1]; lg[q * 4 + 2] += v[j] * w4[2]; lg[q * 4 + 3] += v[j] * w4[3]; } } }
#pragma unroll
            for (int e = 0; e < 16; ++e) lg[e] = wsum(lg[e]);
            float aff[16], sel[16];
#pragma unroll
            for (int e = 0; e < 16; ++e) { aff[e] = sigmoidf_(lg[e]); sel[e] = aff[e] + rbias[e]; }
            float gs[4];
#pragma unroll
            for (int gi = 0; gi < 4; ++gi) { const float a0 = sel[gi * 4], a1 = sel[gi * 4 + 1], a2 = sel[gi * 4 + 2], a3 = sel[gi * 4 + 3];
                gs[gi] = fmaxf(fmaxf(fmaxf(a0 + a1, a0 + a2), fmaxf(a0 + a3, a1 + a2)), fmaxf(a1 + a3, a2 + a3)); }
            int gidx = 0; float gb = gs[0];
#pragma unroll
            for (int gi = 1; gi < 4; ++gi) if (gs[gi] > gb) { gb = gs[gi]; gidx = gi; }
            float c[4], f[4];
#pragma unroll
            for (int i = 0; i < 4; ++i) { c[i] = gidx == 0 ? sel[i] : gidx == 1 ? sel[4 + i] : gidx == 2 ? sel[8 + i] : sel[12 + i];
                                           f[i] = gidx == 0 ? aff[i] : gidx == 1 ? aff[4 + i] : gidx == 2 ? aff[8 + i] : aff[12 + i]; }
            int i1 = 0; float cb = c[0];
#pragma unroll
            for (int i = 1; i < 4; ++i) if (c[i] > cb) { cb = c[i]; i1 = i; }
            int i2 = -1; float cb2 = 0.f;
#pragma unroll
            for (int i = 0; i < 4; ++i) if (i != i1 && (i2 < 0 || c[i] > cb2)) { cb2 = c[i]; i2 = i; }
            float w1 = i1 == 0 ? f[0] : i1 == 1 ? f[1] : i1 == 2 ? f[2] : f[3];
            float w2 = i2 == 0 ? f[0] : i2 == 1 ? f[1] : i2 == 2 ? f[2] : f[3];
            const float wsn = 1.0f / (w1 + w2); w1 *= wsn; w2 *= wsn;
            if (lane == 0) { se[rl * 2] = gidx * 4 + i1; se[rl * 2 + 1] = gidx * 4 + i2;
                TOKE[tok * 2] = gidx * 4 + i1; TOKE[tok * 2 + 1] = gidx * 4 + i2; TOKW[tok * 2] = w1; TOKW[tok * 2 + 1] = w2; }
        }
        __syncthreads();
        if (tid < 16) { int c2 = 0; for (int i = 0; i < 128; ++i) c2 += (se[i] == tid) ? 1 : 0; sbase[tid] = (int)atomicAdd(&cnt[tid], (unsigned)c2); }
        __syncthreads();
        if (tid < 128) { const int e = se[tid]; int rank = 0; for (int j = 0; j < tid; ++j) rank += (se[j] == e) ? 1 : 0;
            const int pos = sbase[e] + rank; const int lr = ch * 64 + (tid >> 1); const int tok = (layer == 0 ? g * RG : g * RGL) + lr;
            LIST[(size_t)e * NTOK + pos] = tok; TOKP[tok * 2 + (tid & 1)] = pos; }
        __syncthreads();
    }
}

PHASE_FN void phase_moe_gemm(const KP& kp, unsigned char* lds, int layer, bool down) {
    const int tid = otid();
    int* pre = (int*)(lds + GEMM_LDS);
    const int ntok = layer == 0 ? NTOK : NLAT;
    const unsigned* cnt = WSP(const unsigned, CTL_CNT) + layer * 16;
    if (tid == 0) { int p = 0, rb = ntok; pre[0] = 0; p = ntok / 256; pre[1] = p; pre[32] = 0;
        for (int e = 0; e < 16; ++e) { const int c = (int)cnt[e]; p += (c + 255) >> 8; pre[2 + e] = p; pre[33 + e] = rb; rb += c; } }
    __syncthreads();
    const int units = pre[17] * 8;
    const bf16_t* V = WSP(const bf16_t, WS_V);
    bf16_t* HID = WSP(bf16_t, WS_BIG + MO_HID); bf16_t* CON = WSP(bf16_t, WS_BIG + MO_CON);
    for (int u = obid(); u < units; u += gridDim.x) {
        const int mtg = u >> 3, nt = u & 7;
        int idx = 0;
        for (int e = 1; e < 17; ++e) if (pre[e] <= mtg) idx = e;
        const int mt = mtg - pre[idx], rbase = pre[32 + idx];
        const int nrows = idx == 0 ? ntok : (int)cnt[idx - 1];
        const int slot = idx == 0 ? 16 : idx - 1;
        const bf16_t* wslot = WSP(const bf16_t, WS_BIG + MO_W + (size_t)slot * MOE_EXP_BYTES);
        if (!down) {
            GA ga{V, nullptr, 1024, 0, 1024, idx == 0 ? nullptr : WSP(const int, WS_LIST) + (size_t)(idx - 1) * NTOK, nrows, 0, 0};
            EpiSwiglu ep{HID + (size_t)rbase * 512, nrows};
            gemm_tile(lds, ga, wslot, 1024, mt, nt, ep);
        } else {
            GA ga{HID + (size_t)rbase * 512, nullptr, 512, 0, 512, nullptr, nrows, 0, 0};
            EpiBf ep{CON + (size_t)rbase * 1024, 1024, nrows, 1024};
            gemm_tile(lds, ga, wslot + (size_t)1024 * 1024, 512, mt, nt, ep);
        }
    }
}

PHASE_FN void phase_combine(const KP& kp, int layer) {
    const int lane = otid() & 63, wid = otid() >> 6;
    const int ntok = layer == 0 ? NTOK : NLAT;
    const unsigned* cnt = WSP(const unsigned, CTL_CNT) + layer * 16;
    const float* modv = WSP(const float, WS_MODV) + (size_t)layer * 17 * 6144;
    const float* ng = kp.in[6] + (size_t)layer * 4 * 1024 + 3 * 1024;
    const bf16_t* CON = WSP(const bf16_t, WS_BIG + MO_CON);
    const int* TOKE = WSP(const int, WS_TOKE); const int* TOKP = WSP(const int, WS_TOKP); const float* TOKW = WSP(const float, WS_TOKW);
    int myc = lane < 16 ? (int)cnt[lane] : 0, pref = myc;
#pragma unroll
    for (int o = 1; o < 16; o <<= 1) { const int t = __shfl_up(pref, o); if (lane >= o) pref += t; }
    pref -= myc;
    for (int tok = obid() * 8 + wid; tok < ntok; tok += gridDim.x * 8) {
        const int e1 = TOKE[tok * 2], e2 = TOKE[tok * 2 + 1], p1 = TOKP[tok * 2], p2 = TOKP[tok * 2 + 1];
        const float w1 = TOKW[tok * 2], w2 = TOKW[tok * 2 + 1];
        const size_t r1 = (size_t)ntok + __shfl(pref, e1) + p1, r2 = (size_t)ntok + __shfl(pref, e2) + p2;
        int b, t;
        if (layer == 0) { b = tok / TT; t = tok - b * TT; } else { b = tok >> 11; t = CTXL + (tok & 2047); }
        float* hp = hrow_wr(kp, b, t);
        const float* mv = modv + (size_t)(t < CTXL ? 16 : b) * 6144 + 5 * 1024;
        f32x4 f[4]; float ss = 0.f;
#pragma unroll
        for (int i = 0; i < 4; ++i) { const int col = i * 256 + lane * 4;
            f[i] = ld4bf(CON + (size_t)tok * 1024 + col) + ld4bf(CON + r1 * 1024 + col) * w1 + ld4bf(CON + r2 * 1024 + col) * w2;
            ss += f[i][0] * f[i][0] + f[i][1] * f[i][1] + f[i][2] * f[i][2] + f[i][3] * f[i][3]; }
        ss = wsum(ss); const float rstd = rsqrtf(ss * (1.0f / 1024.0f) + EPS);
#pragma unroll
        for (int i = 0; i < 4; ++i) { const int col = i * 256 + lane * 4;
            const f32x4 g3 = *(const f32x4*)(ng + col), gf = *(const f32x4*)(mv + col), hx = *(const f32x4*)(hp + col);
            *(f32x4*)(hp + col) = hx + gf * (f[i] * rstd * g3); }
    }
}

template <int CH>
__device__ __forceinline__ int scan_t(int dir, int ci, int j) {
    constexpr int NC_CTX = CTXL / CH;
    if (!dir) return ci * CH + j;
    return ci < NC_CTX ? (CTXL - 1 - ci * CH - j) : (TT - 1 - (ci - NC_CTX) * CH - j);
}

constexpr int ML_LQ = 136, ML_LT = 72;
PHASE_FN void mlstm_unit(const KP& kp, unsigned char* lds, int bl, int h, int dir, int vh) {
    const int tid = otid(), lane = tid & 63, wid = tid >> 6, fr = lane & 15, fq = lane >> 4;
    bf16_t* Qs = (bf16_t*)lds;
    bf16_t* Ks = Qs + 64 * ML_LQ;
    bf16_t* KTE = Ks + 64 * ML_LQ;
    bf16_t* VT = KTE + 128 * ML_LT;
    bf16_t* Ps = VT + 128 * ML_LT;
    bf16_t* Cb = Ps + 64 * ML_LT;
    float* fs = (float*)(Cb + 128 * ML_LQ);
    float* s_rowv = fs;
    float* s_colv = fs + 64;
    float* s_wint = fs + 128;
    float* s_emj = fs + 192;
    float* s_E = fs + 256;
    float* s_den = fs + 320;
    float* s_n = fs + 384;
    float* s_misc = fs + 512;
    const bf16_t* P = WSP(const bf16_t, WS_BIG + L0_P);
    bf16_t* HOUT = WSP(bf16_t, WS_BIG + (dir ? L0_HB : L0_HF));
    const float ibias = kp.in[9][dir * 4 + h], fbias = kp.in[10][dir * 4 + h];
    for (int i = tid; i < 128 * ML_LQ; i += 512) Cb[i] = 0;
    if (tid < 128) s_n[tid] = 0.f;
    f32x4 Cacc[8];
#pragma unroll
    for (int i = 0; i < 8; ++i) Cacc[i] = (f32x4){0.f, 0.f, 0.f, 0.f};
    float m_state = 0.f;
    __syncthreads();
    for (int ci = 0; ci < TT / 64; ++ci) {
#pragma unroll
        for (int i = 0; i < 2; ++i) {
            const int p = tid + i * 512, j = p >> 4, c8 = p & 15;
            const size_t row = (size_t)bl * TT + scan_t<64>(dir, ci, j);
            const bf16_t* pr = P + row * AB_N;
            u32x4 q = *(const u32x4*)(pr + AB_Q + h * 128 + c8 * 8);
            const float qs = 0.08838834764831845f;
            q.x = pack2(lo2f(q.x) * qs, hi2f(q.x) * qs); q.y = pack2(lo2f(q.y) * qs, hi2f(q.y) * qs);
            q.z = pack2(lo2f(q.z) * qs, hi2f(q.z) * qs); q.w = pack2(lo2f(q.w) * qs, hi2f(q.w) * qs);
            *(u32x4*)(Qs + j * ML_LQ + c8 * 8) = q;
            *(u32x4*)(Ks + j * ML_LQ + c8 * 8) = *(const u32x4*)(pr + AB_K + h * 128 + c8 * 8);
            const u32x4 v = *(const u32x4*)(pr + AB_V + h * 256 + vh * 128 + c8 * 8);
            bf16_t* vt = VT + (c8 * 8) * ML_LT + j;
            vt[0 * ML_LT] = (bf16_t)(v.x & 0xffff); vt[1 * ML_LT] = (bf16_t)(v.x >> 16); vt[2 * ML_LT] = (bf16_t)(v.y & 0xffff); vt[3 * ML_LT] = (bf16_t)(v.y >> 16);
            vt[4 * ML_LT] = (bf16_t)(v.z & 0xffff); vt[5 * ML_LT] = (bf16_t)(v.z >> 16); vt[6 * ML_LT] = (bf16_t)(v.w & 0xffff); vt[7 * ML_LT] = (bf16_t)(v.w >> 16);
        }
        if (wid == 0) {
            const size_t row = (size_t)bl * TT + scan_t<64>(dir, ci, lane);
            const float ig = bf2f(P[row * AB_N + AB_IG + dir * 4 + h]) + ibias;
            const float lf = logsigmoidf_(bf2f(P[row * AB_N + AB_FG + dir * 4 + h]) + fbias);
            float b = lf;
#pragma unroll
            for (int o = 1; o < 64; o <<= 1) { const float t = __shfl_up(b, o); if (lane >= o) b += t; }
            const float u = ig - b; float pm = u;
#pragma unroll
            for (int o = 1; o < 64; o <<= 1) { const float t = __shfl_up(pm, o); if (lane >= o) pm = fmaxf(pm, t); }
            const float mj = fmaxf(b + m_state, b + pm);
            const float b63 = __shfl(b, 63), pm63 = __shfl(pm, 63);
            const float mnew = fmaxf(b63 + m_state, b63 + pm63);
            s_rowv[lane] = b - mj; s_colv[lane] = u; s_wint[lane] = __expf(b + m_state - mj); s_emj[lane] = __expf(-mj);
            s_E[lane] = __expf(b63 + u - mnew);
            if (lane == 0) { s_misc[0] = mnew; s_misc[1] = __expf(b63 + m_state - mnew); }
        }
        __syncthreads();
        {
            const int jt = wid >> 1;
#pragma unroll
            for (int q2 = 0; q2 < 2; ++q2) {
                const int st = (wid & 1) * 2 + q2;
                f32x4 acc = (f32x4){0.f, 0.f, 0.f, 0.f};
                if (st <= jt) {
#pragma unroll
                    for (int k = 0; k < 4; ++k) acc = mma16(ldfrag(Qs, ML_LQ, jt * 16, k * 32, fr, fq), ldfrag(Ks, ML_LQ, st * 16, k * 32, fr, fq), acc);
                }
                const int s = st * 16 + fr; const float cv = s_colv[s];
#pragma unroll
                for (int r = 0; r < 4; ++r) { const int j = jt * 16 + fq * 4 + r;
                    const float pv = (s <= j) ? acc[r] * __expf(s_rowv[j] + cv) : 0.f;
                    Ps[j * ML_LT + s] = f2bf(pv); }
            }
#pragma unroll
            for (int i = 0; i < 2; ++i) {
                const int p = tid + i * 512, s = p >> 4, c8 = p & 15; const float e = s_E[s];
                const u32x4 kv = *(const u32x4*)(Ks + s * ML_LQ + c8 * 8);
                bf16_t* kt = KTE + (c8 * 8) * ML_LT + s;
                kt[0 * ML_LT] = f2bf(lo2f(kv.x) * e); kt[1 * ML_LT] = f2bf(hi2f(kv.x) * e); kt[2 * ML_LT] = f2bf(lo2f(kv.y) * e); kt[3 * ML_LT] = f2bf(hi2f(kv.y) * e);
                kt[4 * ML_LT] = f2bf(lo2f(kv.z) * e); kt[5 * ML_LT] = f2bf(hi2f(kv.z) * e); kt[6 * ML_LT] = f2bf(lo2f(kv.w) * e); kt[7 * ML_LT] = f2bf(hi2f(kv.w) * e);
            }
        }
        __syncthreads();
        f32x4 a1[4], a2[4];
        {
            const int jt = wid >> 1;
#pragma unroll
            for (int q4 = 0; q4 < 4; ++q4) {
                const int vt = (wid & 1) * 4 + q4;
                a1[q4] = (f32x4){0.f, 0.f, 0.f, 0.f}; a2[q4] = (f32x4){0.f, 0.f, 0.f, 0.f};
#pragma unroll
                for (int k = 0; k < 2; ++k) a1[q4] = mma16(ldfrag(VT, ML_LT, vt * 16, k * 32, fr, fq), ldfrag(Ps, ML_LT, jt * 16, k * 32, fr, fq), a1[q4]);
#pragma unroll
                for (int k = 0; k < 4; ++k) a2[q4] = mma16(ldfrag(Cb, ML_LQ, vt * 16, k * 32, fr, fq), ldfrag(Qs, ML_LQ, jt * 16, k * 32, fr, fq), a2[q4]);
            }
            if (wid == 7) {
                float rs = 0.f, nq = 0.f;
                for (int s = 0; s < 64; ++s) rs += bf2f(Ps[lane * ML_LT + s]);
                for (int d = 0; d < 128; ++d) nq += s_n[d] * bf2f(Qs[lane * ML_LQ + d]);
                const float den = rs + s_wint[lane] * nq;
                s_den[lane] = fmaxf(fabsf(den), s_emj[lane]);
            }
        }
        __syncthreads();
        {
            const int jt = wid >> 1, j = jt * 16 + fr;
            const float wi = s_wint[j], rden = 1.0f / s_den[j];
            const size_t row = (size_t)bl * TT + scan_t<64>(dir, ci, j);
#pragma unroll
            for (int q4 = 0; q4 < 4; ++q4) { const int v0 = ((wid & 1) * 4 + q4) * 16 + fq * 4;
                st4bf(HOUT + row * 1024 + h * 256 + vh * 128 + v0, (a1[q4] + a2[q4] * wi) * rden); }
        }
        {
            const float dec = s_misc[1];
            bf16x8 bv0 = ldfrag(VT, ML_LT, wid * 16, 0, fr, fq), bv1 = ldfrag(VT, ML_LT, wid * 16, 32, fr, fq);
#pragma unroll
            for (int dt = 0; dt < 8; ++dt) {
                Cacc[dt] = Cacc[dt] * dec;
                Cacc[dt] = mma16(ldfrag(KTE, ML_LT, dt * 16, 0, fr, fq), bv0, Cacc[dt]);
                Cacc[dt] = mma16(ldfrag(KTE, ML_LT, dt * 16, 32, fr, fq), bv1, Cacc[dt]);
                st4bf(Cb + (wid * 16 + fr) * ML_LQ + dt * 16 + fq * 4, Cacc[dt]);
            }
            if (tid < 128) { float a = 0.f; for (int s = 0; s < 64; ++s) a += bf2f(KTE[tid * ML_LT + s]); s_n[tid] = dec * s_n[tid] + a; }
            m_state = s_misc[0];
        }
        __syncthreads();
    }
}

constexpr int SS_LR = 264, SS_LT = 72;
PHASE_FN void ssd_unit(const KP& kp, unsigned char* lds, int bl, int dir, int hp) {
    const int tid = otid(), lane = tid & 63, wid = tid >> 6, fr = lane & 15, fq = lane >> 4;
    const int gi = hp >> 2, hh0 = hp * 2;
    bf16_t* RAW = (bf16_t*)lds;
    bf16_t* CM = RAW + 68 * SS_LR;
    bf16_t* BM = CM + 64 * SS_LT;
    bf16_t* Wm = BM + 64 * SS_LT;
    bf16_t* XT = Wm + 2 * 64 * SS_LT;
    bf16_t* BTE = XT + 2 * 64 * SS_LT;
    bf16_t* Sb = BTE + 2 * 64 * SS_LT;
    float* fs = (float*)(Sb + 2 * 64 * SS_LT);
    float* s_b = fs;
    float* s_dt = fs + 128;
    float* s_e = fs + 256;
    float* s_misc = fs + 384;
    const bf16_t* P = WSP(const bf16_t, WS_BIG + L0_P);
    bf16_t* YOUT = WSP(bf16_t, WS_BIG + (dir ? L0_YB : L0_YF));
    for (int i = tid; i < 2 * 64 * SS_LT; i += 512) Sb[i] = 0;
    f32x4 Sacc[4];
#pragma unroll
    for (int i = 0; i < 4; ++i) Sacc[i] = (f32x4){0.f, 0.f, 0.f, 0.f};
    const int ch = tid & 255;
    const int xcol = ch < 128 ? hh0 * 64 + ch : (ch < 192 ? 1024 + gi * 64 + (ch - 128) : 1152 + gi * 64 + (ch - 192));
    float cw[5];
#pragma unroll
    for (int q = 0; q < 5; ++q) cw[q] = kp.in[12][q * 1280 + xcol];
    const float cbias = kp.in[13][xcol];
    const int hl_w = wid >> 2;
    const float dtb = kp.in[14][dir * 16 + hh0 + (wid & 1)], aexp = __expf(kp.in[15][dir * 16 + hh0 + (wid & 1)]);
    const float dskip = kp.in[16][hh0 + hl_w];
    __syncthreads();
    for (int ci = 0; ci < TT / 64; ++ci) {
        const int t0 = dir ? scan_t<64>(1, ci, 63) : ci * 64;
        const int lo = t0 < CTXL ? 0 : CTXL, hi = t0 < CTXL ? CTXL : TT;
        for (int p = tid; p < 68 * 32; p += 512) {
            const int rr = p >> 5, c8 = p & 31, t = t0 - 2 + rr;
            u32x4 v = (u32x4){0u, 0u, 0u, 0u};
            if (t >= lo && t < hi) { const int col = c8 < 16 ? hh0 * 64 + c8 * 8 : (c8 < 24 ? 1024 + gi * 64 + (c8 - 16) * 8 : 1152 + gi * 64 + (c8 - 24) * 8);
                v = *(const u32x4*)(P + ((size_t)bl * TT + t) * AB_N + AB_XBC + col); }
            *(u32x4*)(RAW + rr * SS_LR + c8 * 8) = v;
        }
        if (wid < 2) {
            const size_t row = (size_t)bl * TT + scan_t<64>(dir, ci, lane);
            const float dt = softplusf_(bf2f(P[row * AB_N + AB_DT + dir * 16 + hh0 + wid]) + dtb);
            float b = -dt * aexp;
#pragma unroll
            for (int o = 1; o < 64; o <<= 1) { const float t = __shfl_up(b, o); if (lane >= o) b += t; }
            const float b63 = __shfl(b, 63);
            s_b[wid * 64 + lane] = b; s_dt[wid * 64 + lane] = dt; s_e[wid * 64 + lane] = __expf(b63 - b) * dt;
            if (lane == 0) s_misc[wid] = __expf(b63);
        }
        __syncthreads();
        for (int ii = 0; ii < 32; ++ii) {
            const int i = (tid >> 8) + 2 * ii, j = dir ? 63 - i : i;
            float a = cbias;
#pragma unroll
            for (int q = 0; q < 5; ++q) a += cw[q] * bf2f(RAW[(i + q) * SS_LR + ch]);
            const bf16_t o = f2bf(siluf_(a));
            if (ch < 128) XT[((ch >> 6) * 64 + (ch & 63)) * SS_LT + j] = o;
            else if (ch < 192) BM[j * SS_LT + (ch - 128)] = o;
            else CM[j * SS_LT + (ch - 192)] = o;
        }
        __syncthreads();
        {
            const int jt = wid >> 1;
#pragma unroll
            for (int q2 = 0; q2 < 2; ++q2) {
                const int st = (wid & 1) * 2 + q2;
                f32x4 acc = (f32x4){0.f, 0.f, 0.f, 0.f};
                if (st <= jt) {
#pragma unroll
                    for (int k = 0; k < 2; ++k) acc = mma16(ldfrag(CM, SS_LT, jt * 16, k * 32, fr, fq), ldfrag(BM, SS_LT, st * 16, k * 32, fr, fq), acc);
                }
                const int s = st * 16 + fr;
#pragma unroll
                for (int hl = 0; hl < 2; ++hl) { const float bs = s_b[hl * 64 + s], ds = s_dt[hl * 64 + s];
#pragma unroll
                    for (int r = 0; r < 4; ++r) { const int j = jt * 16 + fq * 4 + r;
                        const float wv = (s <= j) ? acc[r] * __expf(s_b[hl * 64 + j] - bs) * ds : 0.f;
                        Wm[(hl * 64 + j) * SS_LT + s] = f2bf(wv); } }
            }
            {
                const int s = tid >> 3, n8 = tid & 7;
                const u32x4 bv = *(const u32x4*)(BM + s * SS_LT + n8 * 8);
#pragma unroll
                for (int hl = 0; hl < 2; ++hl) { const float e = s_e[hl * 64 + s];
                    bf16_t* bt = BTE + (hl * 64 + n8 * 8) * SS_LT + s;
                    bt[0 * SS_LT] = f2bf(lo2f(bv.x) * e); bt[1 * SS_LT] = f2bf(hi2f(bv.x) * e); bt[2 * SS_LT] = f2bf(lo2f(bv.y) * e); bt[3 * SS_LT] = f2bf(hi2f(bv.y) * e);
                    bt[4 * SS_LT] = f2bf(lo2f(bv.z) * e); bt[5 * SS_LT] = f2bf(hi2f(bv.z) * e); bt[6 * SS_LT] = f2bf(lo2f(bv.w) * e); bt[7 * SS_LT] = f2bf(hi2f(bv.w) * e); }
            }
        }
        __syncthreads();
        {
            const int hl = hl_w, jt = wid & 3, j = jt * 16 + fr;
            const bf16_t* Wh = Wm + hl * 64 * SS_LT; const bf16_t* Xh = XT + hl * 64 * SS_LT; const bf16_t* Sh = Sb + hl * 64 * SS_LT;
            const float eb = __expf(s_b[hl * 64 + j]);
            const size_t row = (size_t)bl * TT + scan_t<64>(dir, ci, j);
#pragma unroll
            for (int pt = 0; pt < 4; ++pt) {
                f32x4 y1 = (f32x4){0.f, 0.f, 0.f, 0.f}, y2 = (f32x4){0.f, 0.f, 0.f, 0.f};
#pragma unroll
                for (int k = 0; k < 2; ++k) { y1 = mma16(ldfrag(Xh, SS_LT, pt * 16, k * 32, fr, fq), ldfrag(Wh, SS_LT, jt * 16, k * 32, fr, fq), y1);
                                              y2 = mma16(ldfrag(Sh, SS_LT, pt * 16, k * 32, fr, fq), ldfrag(CM, SS_LT, jt * 16, k * 32, fr, fq), y2); }
                f32x4 y = y1 + y2 * eb;
                if (!dir) {
#pragma unroll
                    for (int r = 0; r < 4; ++r) y[r] += dskip * bf2f(Xh[(pt * 16 + fq * 4 + r) * SS_LT + j]);
                }
                st4bf(YOUT + row * 1024 + (hh0 + hl) * 64 + pt * 16 + fq * 4, y);
            }
        }
        __syncthreads();
        {
            const int hl = hl_w, pt = wid & 3; const float eb63 = s_misc[hl];
            const bf16_t* Xh = XT + hl * 64 * SS_LT; const bf16_t* Bh = BTE + hl * 64 * SS_LT; bf16_t* Sh = Sb + hl * 64 * SS_LT;
            bf16x8 x0 = ldfrag(Xh, SS_LT, pt * 16, 0, fr, fq), x1 = ldfrag(Xh, SS_LT, pt * 16, 32, fr, fq);
#pragma unroll
            for (int nt = 0; nt < 4; ++nt) {
                Sacc[nt] = Sacc[nt] * eb63;
                Sacc[nt] = mma16(ldfrag(Bh, SS_LT, nt * 16, 0, fr, fq), x0, Sacc[nt]);
                Sacc[nt] = mma16(ldfrag(Bh, SS_LT, nt * 16, 32, fr, fq), x1, Sacc[nt]);
                st4bf(Sh + (pt * 16 + fr) * SS_LT + nt * 16 + fq * 4, Sacc[nt]);
            }
        }
        __syncthreads();
    }
}

__device__ __forceinline__ void phase_scan_ab(const KP& kp, unsigned char* lds) {
    for (int u = obid(); u < 256; u += gridDim.x) if (u < 128) { mlstm_unit(kp, lds, u >> 4, (u >> 2) & 3, (u >> 1) & 1, u & 1); __syncthreads(); }
    for (int u = obid(); u < 256; u += gridDim.x) if (u >= 128) { const int v = u - 128; ssd_unit(kp, lds, v >> 4, (v >> 3) & 1, v & 7); __syncthreads(); }
}

PHASE_FN void phase_fin_ab(const KP& kp) {
    const int lane = otid() & 63, wid = otid() >> 6;
    const bf16_t* P = WSP(const bf16_t, WS_BIG + L0_P);
    bf16_t* HF = WSP(bf16_t, WS_BIG + L0_HF); const bf16_t* HB = WSP(const bf16_t, WS_BIG + L0_HB);
    bf16_t* YF = WSP(bf16_t, WS_BIG + L0_YF); const bf16_t* YB = WSP(const bf16_t, WS_BIG + L0_YB);
    const float* mln = kp.in[11]; const float* sn = kp.in[17];
    for (int lr = obid() * 8 + wid; lr < RG; lr += gridDim.x * 8) {
        const bf16_t* pr = P + (size_t)lr * AB_N;
        f32x4 yz[4]; float ss2 = 0.f;
#pragma unroll
        for (int i = 0; i < 4; ++i) { const int col = i * 256 + lane * 4;
            const f32x4 hs = ld4bf(HF + (size_t)lr * 1024 + col) + ld4bf(HB + (size_t)lr * 1024 + col);
            float ss = hs[0] * hs[0] + hs[1] * hs[1] + hs[2] * hs[2] + hs[3] * hs[3];
            ss = wsum(ss); const float rstd = rsqrtf(ss * (1.0f / 256.0f) + EPS);
            const f32x4 og = ld4bf(pr + AB_OG + col), w = *(const f32x4*)(mln + col);
            f32x4 o;
#pragma unroll
            for (int r = 0; r < 4; ++r) o[r] = hs[r] * rstd * w[r] * sigmoidf_(og[r]);
            st4bf(HF + (size_t)lr * 1024 + col, o);
            const f32x4 ys = ld4bf(YF + (size_t)lr * 1024 + col) + ld4bf(YB + (size_t)lr * 1024 + col), z = ld4bf(pr + AB_Z + col);
#pragma unroll
            for (int r = 0; r < 4; ++r) { yz[i][r] = ys[r] * siluf_(z[r]); ss2 += yz[i][r] * yz[i][r]; }
        }
        ss2 = wsum(ss2); const float rstd2 = rsqrtf(ss2 * (1.0f / 1024.0f) + EPS);
#pragma unroll
        for (int i = 0; i < 4; ++i) { const int col = i * 256 + lane * 4; st4bf(YF + (size_t)lr * 1024 + col, yz[i] * rstd2 * *(const f32x4*)(sn + col)); }
    }
}

PHASE_FN void phase_gemm_in(const KP& kp, unsigned char* lds, int layer) {
    const int ntn = layer == 0 ? AB_NPAD / 128 : CD_NPAD / 128, units = (RG / 256) * ntn;
    GA ga{WSP(const bf16_t, WS_BIG + (layer == 0 ? L0_U : L1_U)), nullptr, 1024, 0, 1024, nullptr, RG, 0, 0};
    EpiBf ep{WSP(bf16_t, WS_BIG), layer == 0 ? AB_N : CD_N, RG, layer == 0 ? AB_N : CD_N};
    const bf16_t* Bt = WSP(const bf16_t, WS_WMIX);
    for (int u = obid(); u < units; u += gridDim.x) gemm_tile(lds, ga, Bt, 1024, u / ntn, u % ntn, ep);
}
PHASE_FN void phase_gemm_out_ab(const KP& kp, unsigned char* lds) {
    GA ga{WSP(const bf16_t, WS_BIG + L0_HF), WSP(const bf16_t, WS_BIG + L0_YF), 1024, 1024, 1024, nullptr, RG, 0, 0};
    EpiBf ep{WSP(bf16_t, WS_BIG + L0_U), 1024, RG, 1024};
    const bf16_t* Bt = WSP(const bf16_t, WS_WMIX + WM_AB_OUT);
    for (int u = obid(); u < (RG / 256) * 8; u += gridDim.x) gemm_tile(lds, ga, Bt, 2048, u >> 3, u & 7, ep);
}

PHASE_FN void phase_prep_cd(const KP& kp) {
    const int lane = otid() & 63, wid = otid() >> 6;
    bf16_t* P = WSP(bf16_t, WS_BIG + L1_P);
    bf16_t* SG = WSP(bf16_t, WS_SG);
    const float* qn = kp.in[20]; const float* kvn = kp.in[22]; const float* mu = kp.in[24];
    for (int lr = obid() * 8 + wid; lr < RG; lr += gridDim.x * 8) {
        const int bl = lr / TT, t = lr - bl * TT;
        bf16_t* pr = P + (size_t)lr * CD_N;
        {
            const f32x4 x = ld4bf(pr + CD_M1 + lane * 4);
            float ss = x[0] * x[0] + x[1] * x[1] + x[2] * x[2] + x[3] * x[3]; ss = wsum(ss);
            const float rstd = rsqrtf(ss * (1.0f / 256.0f) + EPS);
            st4bf(pr + CD_M1 + lane * 4, x * rstd * *(const f32x4*)(kvn + lane * 4));
        }
        if (t >= CTXL) {
            const int s = t - CTXL;
            float x0[3], x1[3]; float ss = 0.f;
#pragma unroll
            for (int i = 0; i < 3; ++i) { const unsigned w = *(const unsigned*)(pr + CD_M0 + i * 128 + lane * 2); x0[i] = lo2f(w); x1[i] = hi2f(w); ss += x0[i] * x0[i] + x1[i] * x1[i]; }
            ss = wsum(ss); const float rstd = rsqrtf(ss * (1.0f / 384.0f) + EPS);
#pragma unroll
            for (int i = 0; i < 3; ++i) { const int c = i * 128 + lane * 2; *(unsigned*)(pr + CD_M0 + c) = pack2(x0[i] * rstd * qn[c], x1[i] * rstd * qn[c + 1]); }
            if (lane < 16) {
                const float pos = (lane < 8) ? (float)(s >> 6) : (float)(s & 63);
                const float inv = __expf(-(float)(lane & 7) * (9.210340371976184f / 8.0f));
                float sn, cs; sincosf(pos * inv, &sn, &cs);
                const float a = bf2f(pr[CD_KR + lane]), b2 = bf2f(pr[CD_KR + 16 + lane]);
                pr[CD_KR + lane] = f2bf(a * cs - b2 * sn); pr[CD_KR + 16 + lane] = f2bf(a * sn + b2 * cs);
            }
            {
                const int c = lane * 2;
                const unsigned w = *(const unsigned*)(pr + CD_GL + c);
                const unsigned wp = s > 0 ? *(const unsigned*)(pr - CD_N + CD_GL + c) : 0u;
                const unsigned wn = s < SEQ - 1 ? *(const unsigned*)(pr + CD_N + CD_GL + c) : 0u;
                const float m0 = mu[CD_GL - CD_RW0 + c], m1 = mu[CD_GL - CD_RW0 + c + 1];
                const float g0 = lo2f(w) + m0 * (0.5f * (lo2f(wp) + lo2f(wn)) - lo2f(w));
                const float g1 = hi2f(w) + m1 * (0.5f * (hi2f(wp) + hi2f(wn)) - hi2f(w));
                *(unsigned*)(SG + ((size_t)bl * SEQ + s) * 128 + c) = pack2(sigmoidf_(g0), sigmoidf_(g1));
            }
        }
    }
}

PHASE_FN void phase_upproj(const KP& kp, unsigned char* lds) {
    const bf16_t* P = WSP(const bf16_t, WS_BIG + L1_P);
    const int nq = (RGL / 256) * 6, nkv = (RG / 256) * 8;
    for (int u = obid(); u < nq + nkv; u += gridDim.x) {
        if (u < nq) {
            GA ga{P + CD_M0, nullptr, CD_N, 0, 384, nullptr, RGL, 1, 0};
            EpiBf ep{WSP(bf16_t, WS_BIG + L1_Q), 768, RGL, 768};
            gemm_tile(lds, ga, WSP(const bf16_t, WS_WMIX + WM_UQ), 384, u / 6, u % 6, ep);
        } else { const int v = u - nq;
            GA ga{P + CD_M1, nullptr, CD_N, 0, 256, nullptr, RG, 0, 0};
            EpiBf ep{WSP(bf16_t, WS_BIG + L1_KV), 1024, RG, 1024};
            gemm_tile(lds, ga, WSP(const bf16_t, WS_WMIX + WM_UKV), 256, v >> 3, v & 7, ep);
        }
    }
}

constexpr int AT_LQ = 104, AT_LV = 72;
PHASE_FN void attn_unit(const KP& kp, unsigned char* lds, int bl, int head, int qb) {
    const int tid = otid(), lane = tid & 63, wid = tid >> 6, fr = lane & 15, fq = lane >> 4;
    bf16_t* Qs = (bf16_t*)lds;
    bf16_t* Kt = Qs + 128 * AT_LQ;
    bf16_t* Vt = Kt + 64 * AT_LQ;
    const bf16_t* P = WSP(const bf16_t, WS_BIG + L1_P);
    const bf16_t* Q = WSP(const bf16_t, WS_BIG + L1_Q);
    const bf16_t* KV = WSP(const bf16_t, WS_BIG + L1_KV);
    bf16_t* AOUT = WSP(bf16_t, WS_BIG + L1_AOUT);
    const float SC = 0.10206207261596577f;
#pragma unroll
    for (int i = 0; i < 3; ++i) { const int p = tid + i * 512, r = p / 12, c = p % 12;
        *(u32x4*)(Qs + r * AT_LQ + c * 8) = *(const u32x4*)(Q + ((size_t)bl * SEQ + qb * 128 + r) * 768 + head * 96 + c * 8); }
    __syncthreads();
#pragma unroll
    for (int i = 0; i < 4; ++i) { const int p = tid + i * 512, r = p >> 4, f = p & 15, s = qb * 128 + r;
        const float pos = (f < 8) ? (float)(s >> 6) : (float)(s & 63);
        const float inv = __expf(-(float)(f & 7) * (9.210340371976184f / 8.0f));
        float sn, cs; sincosf(pos * inv, &sn, &cs);
        const float a = bf2f(Qs[r * AT_LQ + 64 + f]), b2 = bf2f(Qs[r * AT_LQ + 80 + f]);
        Qs[r * AT_LQ + 64 + f] = f2bf(a * cs - b2 * sn); Qs[r * AT_LQ + 80 + f] = f2bf(a * sn + b2 * cs); }
    __syncthreads();
    bf16x8 qf[3];
#pragma unroll
    for (int k = 0; k < 3; ++k) qf[k] = ldfrag(Qs, AT_LQ, wid * 16, k * 32, fr, fq);
    f32x4 ot[4];
#pragma unroll
    for (int i = 0; i < 4; ++i) ot[i] = (f32x4){0.f, 0.f, 0.f, 0.f};
    float mrow = -1e30f, lsum = 0.f;
    for (int kt = 0; kt < TT / 64; ++kt) {
        __syncthreads();
#pragma unroll
        for (int i = 0; i < 2; ++i) { const int p = tid + i * 512;
            if (p < 768) { const int key = p / 12, c = p % 12; const size_t row = (size_t)bl * TT + kt * 64 + key;
                const u32x4 v = c < 8 ? *(const u32x4*)(KV + row * 1024 + head * 128 + c * 8) : *(const u32x4*)(P + row * CD_N + CD_KR + (c - 8) * 8);
                *(u32x4*)(Kt + key * AT_LQ + c * 8) = v; } }
        { const int key = tid >> 3, c8 = tid & 7; const size_t row = (size_t)bl * TT + kt * 64 + key;
            const u32x4 v = *(const u32x4*)(KV + row * 1024 + head * 128 + 64 + c8 * 8);
            bf16_t* vt = Vt + (c8 * 8) * AT_LV + key;
            vt[0 * AT_LV] = (bf16_t)(v.x & 0xffff); vt[1 * AT_LV] = (bf16_t)(v.x >> 16); vt[2 * AT_LV] = (bf16_t)(v.y & 0xffff); vt[3 * AT_LV] = (bf16_t)(v.y >> 16);
            vt[4 * AT_LV] = (bf16_t)(v.z & 0xffff); vt[5 * AT_LV] = (bf16_t)(v.z >> 16); vt[6 * AT_LV] = (bf16_t)(v.w & 0xffff); vt[7 * AT_LV] = (bf16_t)(v.w >> 16); }
        __syncthreads();
        f32x4 st[4];
        float mx = -1e30f;
#pragma unroll
        for (int kk = 0; kk < 4; ++kk) { st[kk] = (f32x4){0.f, 0.f, 0.f, 0.f};
#pragma unroll
            for (int k = 0; k < 3; ++k) st[kk] = mma16(ldfrag(Kt, AT_LQ, kk * 16, k * 32, fr, fq), qf[k], st[kk]);
            mx = fmaxf(mx, fmaxf(fmaxf(st[kk][0], st[kk][1]), fmaxf(st[kk][2], st[kk][3]))); }
        mx = fmaxf(mx, __shfl_xor(mx, 16)); mx = fmaxf(mx, __shfl_xor(mx, 32));
        const float mnew = fmaxf(mrow, mx), alpha = __expf(SC * (mrow - mnew));
        mrow = mnew; lsum *= alpha;
#pragma unroll
        for (int i = 0; i < 4; ++i) ot[i] = ot[i] * alpha;
#pragma unroll
        for (int kk = 0; kk < 4; ++kk)
#pragma unroll
            for (int r = 0; r < 4; ++r) { const float pv = __expf(SC * (st[kk][r] - mnew)); st[kk][r] = pv; lsum += pv; }
#pragma unroll
        for (int k2 = 0; k2 < 2; ++k2) {
            union { bf16x8 v; unsigned u[4]; } pb;
            pb.u[0] = pack2(st[2 * k2][0], st[2 * k2][1]); pb.u[1] = pack2(st[2 * k2][2], st[2 * k2][3]);
            pb.u[2] = pack2(st[2 * k2 + 1][0], st[2 * k2 + 1][1]); pb.u[3] = pack2(st[2 * k2 + 1][2], st[2 * k2 + 1][3]);
#pragma unroll
            for (int dvt = 0; dvt < 4; ++dvt) {
                union { bf16x8 v; u32x2 h[2]; } va;
                const bf16_t* vp = Vt + (dvt * 16 + fr) * AT_LV + k2 * 32 + fq * 4;
                va.h[0] = *(const u32x2*)vp; va.h[1] = *(const u32x2*)(vp + 16);
                ot[dvt] = mma16(va.v, pb.v, ot[dvt]);
            }
        }
    }
    lsum += __shfl_xor(lsum, 16); lsum += __shfl_xor(lsum, 32);
    const float rl = 1.0f / lsum;
    const size_t orow = (size_t)bl * SEQ + qb * 128 + wid * 16 + fr;
#pragma unroll
    for (int dvt = 0; dvt < 4; ++dvt) st4bf(AOUT + orow * 1536 + head * 64 + dvt * 16 + fq * 4, ot[dvt] * rl);
}

constexpr int RW_LR = 328, RW_LP = 72;
PHASE_FN void rwkv_unit(const KP& kp, unsigned char* lds, int bl, int h, int dir) {
    const int tid = otid();
    bf16_t* RAW = (bf16_t*)lds;
    bf16_t* TWb = RAW + 34 * RW_LR;
    bf16_t* ALb = TWb + 32 * RW_LP;
    bf16_t* W2T = ALb + 32 * RW_LP;
    bf16_t* A2T = W2T + 64 * RW_LP;
    float* CL = (float*)(A2T + 64 * RW_LP);
    bf16_t* AR = (bf16_t*)(CL + 32 * 64);
    bf16_t* BK = AR + 64 * RW_LP;
    float* AAB = (float*)(BK + 64 * RW_LP);
    bf16_t* ARB = (bf16_t*)(AAB + 32 * 36);
    bf16_t* AAK = ARB + 32 * 40;
    bf16_t* ARK = AAK + 32 * 40;
    float* RHS = (float*)(ARK + 32 * 40);
    float* YB = RHS + 32 * 64;
    bf16_t* ZVT = (bf16_t*)(YB + 32 * 64);
    bf16_t* BKh = ZVT + 64 * RW_LP;
    bf16_t* Sb = BKh + 64 * RW_LP;
    float* PL = (float*)(Sb + 64 * RW_LP);
    const bf16_t* P = WSP(const bf16_t, WS_BIG + L1_P);
    bf16_t* OUT = WSP(bf16_t, WS_BIG + (dir ? L1_OB : L1_OF));
    float* BSC = WSP(float, WS_BSC) + (size_t)dir * RGL * 16;
    const float* mu = kp.in[24];
    for (int i = tid; i < 64 * 64; i += 512) { const int c = i >> 6, n = i & 63;
        W2T[n * RW_LP + c] = f2bf(kp.in[26][((size_t)dir * 64 + c) * 1024 + h * 64 + n]); A2T[n * RW_LP + c] = f2bf(kp.in[28][((size_t)dir * 64 + c) * 1024 + h * 64 + n]); }
    for (int i = tid; i < 64 * RW_LP; i += 512) Sb[i] = 0;
    const int n4o = (tid & 15) * 4;
    const f32x4 w0v = *(const f32x4*)(kp.in[25] + dir * 1024 + h * 64 + n4o), a0v = *(const f32x4*)(kp.in[27] + dir * 1024 + h * 64 + n4o);
    const f32x4 kkw = *(const f32x4*)(kp.in[30] + h * 64 + n4o), kaw = *(const f32x4*)(kp.in[31] + h * 64 + n4o), rkw = *(const f32x4*)(kp.in[32] + h * 64 + n4o);
    const f32x4 mur = *(const f32x4*)(mu + h * 64 + n4o), muk = *(const f32x4*)(mu + 1024 + h * 64 + n4o), muv = *(const f32x4*)(mu + 2048 + h * 64 + n4o);
    f32x4 Sacc[2];
    Sacc[0] = (f32x4){0.f, 0.f, 0.f, 0.f}; Sacc[1] = (f32x4){0.f, 0.f, 0.f, 0.f};
    u32x4 pf[3];
#define RW_PREFETCH(cn) do { const int t0n_ = dir ? scan_t<32>(1, (cn), 31) : (cn) * 32; const int lo_ = t0n_ < CTXL ? 0 : CTXL, hi_ = t0n_ < CTXL ? CTXL : TT; \
        _Pragma("unroll") for (int q = 0; q < 3; ++q) { const int p = tid + q * 512; pf[q] = (u32x4){0u, 0u, 0u, 0u}; \
            if (p < 34 * 40) { const int rr = p / 40, c = p % 40, t = t0n_ - 1 + rr; \
                if (t >= lo_ && t < hi_) { const int seg = c >> 3, c8 = c & 7; \
                    const int col = seg == 0 ? CD_R + h * 64 : seg == 1 ? CD_K + h * 64 : seg == 2 ? CD_V + h * 64 : seg == 3 ? CD_WL + dir * 64 : CD_AL + dir * 64; \
                    pf[q] = *(const u32x4*)(P + ((size_t)bl * TT + t) * CD_N + col + c8 * 8); } } } } while (0)
    RW_PREFETCH(0);
    __syncthreads();
    for (int ci = 0; ci < TT / 32; ++ci) {
        int tq = tid; asm volatile("" : "+v"(tq));
        const int lane = tq & 63, wid = tq >> 6, fr = lane & 15, fq = lane >> 4, pi = tq >> 4, n4 = (tq & 15) * 4;
        const int t0 = dir ? scan_t<32>(1, ci, 31) : ci * 32;
#pragma unroll
        for (int q = 0; q < 3; ++q) { const int p = tq + q * 512; if (p < 34 * 40) *(u32x4*)(RAW + (p / 40) * RW_LR + (p % 40) * 8) = pf[q]; }
        if (ci + 1 < TT / 32) RW_PREFETCH(ci + 1);
        __syncthreads();
#pragma unroll
        for (int q = 0; q < 8; ++q) { const int idx = tq + q * 512, which = idx >> 11, i = (idx >> 6) & 31, c = idx & 63;
            const int rc = 192 + which * 64 + c;
            const float x = bf2f(RAW[(i + 1) * RW_LR + rc]), xp = bf2f(RAW[i * RW_LR + rc]), xn = bf2f(RAW[(i + 2) * RW_LR + rc]);
            const float m = mu[(which ? 3200 : 3072) + dir * 64 + c];
            const float l = x + m * (0.5f * (xp + xn) - x);
            if (which) ALb[i * RW_LP + c] = f2bf(l); else TWb[i * RW_LP + c] = f2bf(tanhf(l)); }
        __syncthreads();
        {
            const int which = wid >> 2, tt = (wid >> 1) & 1;
            const bf16_t* Xa = which ? ALb : TWb; const bf16_t* Wt = which ? A2T : W2T; float* Od = which ? YB : RHS;
#pragma unroll
            for (int q2 = 0; q2 < 2; ++q2) { const int nt = (wid & 1) * 2 + q2;
                f32x4 acc = (f32x4){0.f, 0.f, 0.f, 0.f};
#pragma unroll
                for (int k = 0; k < 2; ++k) acc = mma16(ldfrag(Xa, RW_LP, tt * 16, k * 32, fr, fq), ldfrag(Wt, RW_LP, nt * 16, k * 32, fr, fq), acc);
#pragma unroll
                for (int rr = 0; rr < 4; ++rr) Od[(tt * 16 + fq * 4 + rr) * 64 + nt * 16 + fr] = acc[rr]; }
        }
        __syncthreads();
        const int j = dir ? 31 - pi : pi;
        f32x4 r, kd, v, av, bv;
        {
            const f32x4 wl = w0v + *(const f32x4*)(RHS + pi * 64 + n4), al = a0v + *(const f32x4*)(YB + pi * 64 + n4);
            const bf16_t* r1 = RAW + (pi + 1) * RW_LR; const bf16_t* rp = RAW + pi * RW_LR; const bf16_t* rn = RAW + (pi + 2) * RW_LR;
            f32x4 k;
            r = ld4bf(r1 + n4); k = ld4bf(r1 + 64 + n4); v = ld4bf(r1 + 128 + n4);
            r = r + mur * ((ld4bf(rp + n4) + ld4bf(rn + n4)) * 0.5f - r);
            k = k + muk * ((ld4bf(rp + 64 + n4) + ld4bf(rn + 64 + n4)) * 0.5f - k);
            v = v + muv * ((ld4bf(rp + 128 + n4) + ld4bf(rn + 128 + n4)) * 0.5f - v);
            f32x4 a, lw, kk = k * kkw;
            float ssq = kk[0] * kk[0] + kk[1] * kk[1] + kk[2] * kk[2] + kk[3] * kk[3];
            ssq += __shfl_xor(ssq, 1); ssq += __shfl_xor(ssq, 2); ssq += __shfl_xor(ssq, 4); ssq += __shfl_xor(ssq, 8);
            kk = kk * (1.0f / fmaxf(sqrtf(ssq), 1e-12f));
#pragma unroll
            for (int q = 0; q < 4; ++q) { const float wlog = -softplusf_(-wl[q]) - 0.5f; lw[q] = -__expf(wlog); a[q] = sigmoidf_(al[q]); }
            kd = k * ((a - 1.0f) * kaw + 1.0f);
            float bs = r[0] * kd[0] * rkw[0] + r[1] * kd[1] * rkw[1] + r[2] * kd[2] * rkw[2] + r[3] * kd[3] * rkw[3];
            bs += __shfl_xor(bs, 1); bs += __shfl_xor(bs, 2); bs += __shfl_xor(bs, 4); bs += __shfl_xor(bs, 8);
            av = kk * -1.0f; bv = kk * a;
            *(f32x4*)(CL + j * 64 + n4) = lw;
            const int t = t0 + pi;
            if (t >= CTXL && (tq & 15) == 0) BSC[((size_t)bl * SEQ + (t - CTXL)) * 16 + h] = bs;
        }
        __syncthreads();
        if (wid == 0) {
            float c[32];
#pragma unroll
            for (int q = 0; q < 32; ++q) c[q] = CL[q * 64 + lane];
#pragma unroll
            for (int q = 1; q < 32; ++q) c[q] += c[q - 1];
#pragma unroll
            for (int q = 0; q < 32; ++q) CL[q * 64 + lane] = c[q];
            PL[lane] = __expf(c[31]);
        }
        __syncthreads();
        {
            const f32x4 clj = *(const f32x4*)(CL + j * 64 + n4), cle = *(const f32x4*)(CL + 31 * 64 + n4);
            f32x4 clp = (f32x4){0.f, 0.f, 0.f, 0.f};
            if (j > 0) clp = *(const f32x4*)(CL + (j - 1) * 64 + n4);
            f32x4 at, rt, bt, kt, bh, kh;
#pragma unroll
            for (int q = 0; q < 4; ++q) { const float ep = __expf(clp[q]), ej = __expf(clj[q]), ei = __expf(-clj[q]), ee = __expf(cle[q] - clj[q]);
                at[q] = av[q] * ep; rt[q] = r[q] * ej; bt[q] = bv[q] * ei; kt[q] = kd[q] * ei; bh[q] = bv[q] * ee; kh[q] = kd[q] * ee; }
            st4bf(AR + j * RW_LP + n4, at); st4bf(AR + (32 + j) * RW_LP + n4, rt);
            st4bf(BK + j * RW_LP + n4, bt); st4bf(BK + (32 + j) * RW_LP + n4, kt);
#pragma unroll
            for (int q = 0; q < 4; ++q) { BKh[(n4 + q) * RW_LP + j] = f2bf(bh[q]); BKh[(n4 + q) * RW_LP + 32 + j] = f2bf(kh[q]); ZVT[(n4 + q) * RW_LP + 32 + j] = f2bf(v[q]); }
        }
        __syncthreads();
        {
            const int ti = wid >> 1;
#pragma unroll
            for (int q2 = 0; q2 < 2; ++q2) {
                const int si = (wid & 1) * 2 + q2;
                f32x4 acc = (f32x4){0.f, 0.f, 0.f, 0.f};
#pragma unroll
                for (int k = 0; k < 2; ++k) acc = mma16(ldfrag(AR, RW_LP, ti * 16, k * 32, fr, fq), ldfrag(BK, RW_LP, si * 16, k * 32, fr, fq), acc);
                const int sp = si * 16 + fr, s = sp & 31;
#pragma unroll
                for (int rr = 0; rr < 4; ++rr) { const int tp = ti * 16 + fq * 4 + rr, t = tp & 31;
                    const bool incl = tp >= 32;
                    const float val = (incl ? (s <= t) : (s < t)) ? acc[rr] : 0.f;
                    if (sp < 32) { if (incl) ARB[t * 40 + s] = f2bf(val); else AAB[t * 36 + s] = val; }
                    else { (incl ? ARK : AAK)[t * 40 + s] = f2bf(val); } }
            }
        }
        __syncthreads();
        {
            const int which = wid >> 2, tt = (wid >> 1) & 1;
            const bf16_t* Ak = which ? ARK : AAK; float* Od = which ? YB : RHS;
#pragma unroll
            for (int q2 = 0; q2 < 2; ++q2) {
                const int vt = (wid & 1) * 2 + q2;
                f32x4 acc = (f32x4){0.f, 0.f, 0.f, 0.f};
#pragma unroll
                for (int k = 0; k < 2; ++k) acc = mma16(ldfrag(AR, RW_LP, which * 32 + tt * 16, k * 32, fr, fq), ldfrag(Sb, RW_LP, vt * 16, k * 32, fr, fq), acc);
                acc = mma16(ldfrag(Ak, 40, tt * 16, 0, fr, fq), ldfrag(ZVT, RW_LP, vt * 16, 32, fr, fq), acc);
#pragma unroll
                for (int rr = 0; rr < 4; ++rr) Od[(tt * 16 + fq * 4 + rr) * 64 + vt * 16 + fr] = acc[rr];
            }
        }
        __syncthreads();
        if (wid == 0) {
            float z[32];
            f32x4 cur[8], nxt[4];
            z[0] = RHS[lane];
            cur[0] = *(const f32x4*)(AAB + 1 * 36);
#pragma unroll
            for (int t = 1; t < 32; ++t) {
                float p0 = RHS[t * 64 + lane], p1 = 0.f, p2 = 0.f, p3 = 0.f;
#pragma unroll
                for (int q4 = 4; q4 < 8; ++q4) if (q4 * 4 < t) cur[q4] = *(const f32x4*)(AAB + t * 36 + q4 * 4);
                if (t + 1 < 32) {
#pragma unroll
                    for (int q4 = 0; q4 < 4; ++q4) if (q4 * 4 < t + 1) nxt[q4] = *(const f32x4*)(AAB + (t + 1) * 36 + q4 * 4);
                }
#pragma unroll
                for (int q4 = 0; q4 < 8; ++q4) {
                    if (q4 * 4 + 0 < t) p0 += cur[q4][0] * z[q4 * 4 + 0];
                    if (q4 * 4 + 1 < t) p1 += cur[q4][1] * z[q4 * 4 + 1];
                    if (q4 * 4 + 2 < t) p2 += cur[q4][2] * z[q4 * 4 + 2];
                    if (q4 * 4 + 3 < t) p3 += cur[q4][3] * z[q4 * 4 + 3];
                }
                float zt = (p0 + p1) + (p2 + p3);
                asm volatile("" : "+v"(zt) :: "memory");
                z[t] = zt;
#pragma unroll
                for (int q4 = 0; q4 < 4; ++q4) if (q4 * 4 < t + 1) cur[q4] = nxt[q4];
            }
#pragma unroll
            for (int q = 0; q < 4; ++q) { u32x4 w;
                w.x = pack2(z[q * 8 + 0], z[q * 8 + 1]); w.y = pack2(z[q * 8 + 2], z[q * 8 + 3]); w.z = pack2(z[q * 8 + 4], z[q * 8 + 5]); w.w = pack2(z[q * 8 + 6], z[q * 8 + 7]);
                *(u32x4*)(ZVT + lane * RW_LP + q * 8) = w; }
        }
        __syncthreads();
        {
            const int nt = wid >> 1;
            const f32x4 pl = *(const f32x4*)(PL + nt * 16 + fq * 4);
#pragma unroll
            for (int q2 = 0; q2 < 2; ++q2) {
                const int vt = (wid & 1) * 2 + q2;
                Sacc[q2] = Sacc[q2] * pl;
#pragma unroll
                for (int k = 0; k < 2; ++k) Sacc[q2] = mma16(ldfrag(BKh, RW_LP, nt * 16, k * 32, fr, fq), ldfrag(ZVT, RW_LP, vt * 16, k * 32, fr, fq), Sacc[q2]);
                st4bf(Sb + (vt * 16 + fr) * RW_LP + nt * 16 + fq * 4, Sacc[q2]);
            }
        }
        if (t0 >= CTXL) {
            const int vt = wid >> 1, tt = wid & 1;
            f32x4 acc = (f32x4){0.f, 0.f, 0.f, 0.f};
            acc = mma16(ldfrag(ZVT, RW_LP, vt * 16, 0, fr, fq), ldfrag(ARB, 40, tt * 16, 0, fr, fq), acc);
            const int t = tt * 16 + fr, v0 = vt * 16 + fq * 4;
#pragma unroll
            for (int rr = 0; rr < 4; ++rr) acc[rr] += YB[t * 64 + v0 + rr];
            const int tn = scan_t<32>(dir, ci, t);
            st4bf(OUT + ((size_t)bl * SEQ + (tn - CTXL)) * 1024 + h * 64 + v0, acc);
        }
        __syncthreads();
    }
#undef RW_PREFETCH
}

__device__ __forceinline__ void phase_mix_cd(const KP& kp, unsigned char* lds, int which) {
    if (which & 1) for (int u = obid(); u < 256; u += gridDim.x) { rwkv_unit(kp, lds, u >> 5, (u >> 1) & 15, u & 1); __syncthreads(); }
    if (which & 2) for (int u = obid(); u < 1024; u += gridDim.x) { attn_unit(kp, lds, u >> 7, (u >> 4) & 7, u & 15); __syncthreads(); }
}

struct EpiFinCD {
    const bf16_t* OF; const bf16_t* OB; const bf16_t* P; const float* BSC; const float* ln; const float* mu; bf16_t* AOUT;
    __device__ __forceinline__ void operator()(const f32x4 (&acc)[4][4], int rb, int cb, int fr, int fq) const {
        const int head = cb >> 6;
#pragma unroll
        for (int i = 0; i < 4; ++i) { const int lr = rb + i * 16 + fr, s = lr & 2047;
            const size_t prow = (size_t)(lr >> 11) * TT + CTXL + s;
            f32x4 o[4]; float ss = 0.f;
#pragma unroll
            for (int j = 0; j < 4; ++j) { const int col = cb + j * 16 + fq * 4;
                o[j] = ld4bf(OF + (size_t)lr * 1024 + col) + ld4bf(OB + (size_t)lr * 1024 + col);
                ss += o[j][0] * o[j][0] + o[j][1] * o[j][1] + o[j][2] * o[j][2] + o[j][3] * o[j][3]; }
            ss += __shfl_xor(ss, 16); ss += __shfl_xor(ss, 32);
            const float rstd = rsqrtf(ss * (1.0f / 64.0f) + EPS);
            const float bon = BSC[(size_t)lr * 16 + head] + BSC[(size_t)RGL * 16 + (size_t)lr * 16 + head];
#pragma unroll
            for (int j = 0; j < 4; ++j) { const int col = cb + j * 16 + fq * 4;
                const bf16_t* pv = P + prow * CD_N + CD_V + col;
                const f32x4 v = ld4bf(pv);
                const f32x4 vp = s > 0 ? ld4bf(pv - CD_N) : (f32x4){0.f, 0.f, 0.f, 0.f};
                const f32x4 vn = s < SEQ - 1 ? ld4bf(pv + CD_N) : (f32x4){0.f, 0.f, 0.f, 0.f};
                const f32x4 vl = v + *(const f32x4*)(mu + 2048 + col) * ((vp + vn) * 0.5f - v);
                const f32x4 y = o[j] * rstd * *(const f32x4*)(ln + col) + vl * bon;
                st4bf(AOUT + (size_t)lr * 1536 + 512 + col, y * acc[i][j]); }
        }
    }
};
PHASE_FN void phase_fin_cd(const KP& kp, unsigned char* lds) {
    GA ga{WSP(const bf16_t, WS_SG), nullptr, 128, 0, 128, nullptr, RGL, 0, 0};
    EpiFinCD ep{WSP(const bf16_t, WS_BIG + L1_OF), WSP(const bf16_t, WS_BIG + L1_OB), WSP(const bf16_t, WS_BIG + L1_P), WSP(const float, WS_BSC), kp.in[33], kp.in[24], WSP(bf16_t, WS_BIG + L1_AOUT)};
    for (int u = obid(); u < (RGL / 256) * 8; u += gridDim.x) gemm_tile(lds, ga, WSP(const bf16_t, WS_WMIX + WM_G2), 128, u >> 3, u & 7, ep);
}
PHASE_FN void phase_gemm_out_cd(const KP& kp, unsigned char* lds) {
    GA ga{WSP(const bf16_t, WS_BIG + L1_AOUT), nullptr, 1536, 0, 1536, nullptr, RGL, 0, 0};
    EpiBf ep{WSP(bf16_t, WS_BIG + L1_U), 1024, RGL, 1024};
    for (int u = obid(); u < (RGL / 256) * 8; u += gridDim.x) gemm_tile(lds, ga, WSP(const bf16_t, WS_WMIX + WM_CD_OUT), 1536, u >> 3, u & 7, ep);
}

__device__ __attribute__((noinline)) void grid_sync(unsigned* barw, unsigned x, volatile LAS unsigned* st) { XcdBarrier b; b.bar = barw; b.x = x; b.st = st; xcd_barrier(b); }
constexpr int N_PHASES = 37;
__global__ void __launch_bounds__(512, 2) fwd_kernel(KP kparg) {
    extern __shared__ __attribute__((aligned(16))) unsigned char lds[];
    const int lo = kparg.ph_lo, hi = kparg.ph_hi;
    KP* skp = (KP*)(lds + LDS_BYTES - 1024);
    if (threadIdx.x == 0) {
#pragma unroll
        for (int i = 0; i < 42; ++i) skp->in[i] = kparg.in[i];
        skp->out = kparg.out; skp->ws = kparg.ws; skp->ph_lo = lo; skp->ph_hi = hi; }
    const KP& kp = *skp;
    volatile LAS unsigned* xbst = (volatile LAS unsigned*)(LAS unsigned char*)(lds + LDS_BYTES - 16);
    if (threadIdx.x == 0) { xbst[0] = 0u; xbst[1] = 0u; }
    __syncthreads();
    XcdBarrier bar; bar.bar = (unsigned*)kparg.ws; bar.x = 0; bar.st = xbst;
    if (hi - lo > 1) bar = xcd_barrier_post((unsigned*)kparg.ws, xbst);
#define IN(k) (lo <= (k) && (k) < hi)
#define SEAM(k) do { if (IN(k) && IN((k) + 1)) grid_sync(bar.bar, bar.x, bar.st); } while (0)
    if (IN(0)) { phase_mod(kp, lds); __syncthreads(); phase_conv_ab(kp, lds); if (PROBE_DUP & 32) { __syncthreads(); phase_mod(kp, lds); __syncthreads(); phase_conv_ab(kp, lds); } }
    SEAM(0);
    for (int g = 0; g < NG; ++g) {
        const int pb = 1 + g * 6;
        if (IN(pb + 0)) { phase_u(kp, 0, g); if (PROBE_DUP & 128) phase_u(kp, 0, g); }
        SEAM(pb + 0);
        if (IN(pb + 1)) { phase_gemm_in(kp, lds, 0); if (PROBE_DUP & 8) phase_gemm_in(kp, lds, 0); }
        SEAM(pb + 1);
        if (IN(pb + 2)) { phase_scan_ab(kp, lds); if (PROBE_DUP & 1) { __syncthreads(); phase_scan_ab(kp, lds); } }
        SEAM(pb + 2);
        if (IN(pb + 3)) phase_fin_ab(kp);
        SEAM(pb + 3);
        if (IN(pb + 4)) { phase_gemm_out_ab(kp, lds); if (PROBE_DUP & 256) phase_gemm_out_ab(kp, lds); }
        SEAM(pb + 4);
        if (IN(pb + 5)) phase_r(kp, lds, 0, g);
        SEAM(pb + 5);
    }
    if (IN(13)) { phase_conv_moe(kp, lds, 0); phase_conv_cd(kp, lds); if (PROBE_DUP & 64) { phase_conv_moe(kp, lds, 0); phase_conv_cd(kp, lds); } }
    SEAM(13);
    if (IN(14)) { phase_moe_gemm(kp, lds, 0, false); if (PROBE_DUP & 16) { __syncthreads(); phase_moe_gemm(kp, lds, 0, false); } }
    SEAM(14);
    if (IN(15)) { phase_moe_gemm(kp, lds, 0, true); if (PROBE_DUP & 16) { __syncthreads(); phase_moe_gemm(kp, lds, 0, true); } }
    SEAM(15);
    if (IN(16)) phase_combine(kp, 0);
    SEAM(16);
    for (int g = 0; g < NG; ++g) {
        const int pb = 17 + g * 8;
        if (IN(pb + 0)) { phase_u(kp, 1, g); if (PROBE_DUP & 128) phase_u(kp, 1, g); }
        SEAM(pb + 0);
        if (IN(pb + 1)) { phase_gemm_in(kp, lds, 1); if (PROBE_DUP & 8) phase_gemm_in(kp, lds, 1); }
        SEAM(pb + 1);
        if (IN(pb + 2)) phase_prep_cd(kp);
        SEAM(pb + 2);
        if (IN(pb + 3)) { phase_upproj(kp, lds); if (PROBE_DUP & 256) phase_upproj(kp, lds); }
        SEAM(pb + 3);
        if (IN(pb + 4)) { phase_mix_cd(kp, lds, 3); if (PROBE_DUP & 2) { __syncthreads(); phase_mix_cd(kp, lds, 1); } if (PROBE_DUP & 4) { __syncthreads(); phase_mix_cd(kp, lds, 2); } }
        SEAM(pb + 4);
        if (IN(pb + 5)) { phase_fin_cd(kp, lds); if (PROBE_DUP & 256) phase_fin_cd(kp, lds); }
        SEAM(pb + 5);
        if (IN(pb + 6)) { phase_gemm_out_cd(kp, lds); if (PROBE_DUP & 256) phase_gemm_out_cd(kp, lds); }
        SEAM(pb + 6);
        if (IN(pb + 7)) phase_r(kp, lds, 1, g);
        SEAM(pb + 7);
    }
    if (IN(33)) phase_conv_moe(kp, lds, 1);
    SEAM(33);
    if (IN(34)) phase_moe_gemm(kp, lds, 1, false);
    SEAM(34);
    if (IN(35)) phase_moe_gemm(kp, lds, 1, true);
    SEAM(35);
    if (IN(36)) phase_combine(kp, 1);
#undef IN
#undef SEAM
}

extern "C" void kernel_launch(void* const* d_in, const int* in_sizes, int n_in, void* d_out, int out_size, void* d_ws, size_t ws_size, hipStream_t stream) {
    static int grid = 0;
    if (grid == 0) {
        if (n_in != 42 || out_size != NLAT * D || ws_size < WS_NEED) { fprintf(stderr, "kernel_launch: unexpected shapes: n_in %d out %d ws %zu (need %zu)\n", n_in, out_size, ws_size, (size_t)WS_NEED); grid = -1; return; }
        int dev = 0, cus = 0, per_cu = 0;
        if (hipGetDevice(&dev) != hipSuccess || hipDeviceGetAttribute(&cus, hipDeviceAttributeMultiprocessorCount, dev) != hipSuccess) { grid = -1; return; }
        if (hipFuncSetAttribute((const void*)fwd_kernel, hipFuncAttributeMaxDynamicSharedMemorySize, LDS_BYTES) != hipSuccess) { fprintf(stderr, "kernel_launch: hipFuncSetAttribute failed\n"); grid = -1; return; }
        if (hipOccupancyMaxActiveBlocksPerMultiprocessor(&per_cu, (const void*)fwd_kernel, 512, LDS_BYTES) != hipSuccess || per_cu < 1) { fprintf(stderr, "kernel_launch: occupancy query says %d blocks per CU\n", per_cu); grid = -1; (void)hipGetLastError(); return; }
        grid = cus;
    }
    if (grid < 0) return;
    (void)hipMemsetAsync(d_ws, 0, CTL_BYTES, stream);
    KP kp{};
    for (int i = 0; i < 42; ++i) kp.in[i] = (const float*)d_in[i];
    kp.out = (float*)d_out; kp.ws = (unsigned char*)d_ws;
#if N_LAUNCH_MODE == 1
    kp.ph_lo = 0; kp.ph_hi = N_PHASES;
    hipLaunchKernelGGL(fwd_kernel, dim3(grid), dim3(512), LDS_BYTES, stream, kp);
#else
    for (int p = 0; p < N_PHASES; ++p) { kp.ph_lo = p; kp.ph_hi = p + 1; hipLaunchKernelGGL(fwd_kernel, dim3(grid), dim3(512), LDS_BYTES, stream, kp); }
#endif
}
```

```cpp
#include <hip/hip_runtime.h>
#include <stdint.h>
#include <stdio.h>

typedef unsigned short bf16_t;
typedef short bf16x8 __attribute__((ext_vector_type(8)));
typedef float f32x4 __attribute__((ext_vector_type(4)));
typedef float f32x2 __attribute__((ext_vector_type(2)));
typedef unsigned u32x4 __attribute__((ext_vector_type(4)));
typedef unsigned u32x2 __attribute__((ext_vector_type(2)));

#ifndef PROBE_DUP
#define PROBE_DUP 0
#endif
#ifndef N_LAUNCH_MODE
#define N_LAUNCH_MODE 1
#endif

constexpr int NB = 16, SEQ = 2048, CTXL = 256, TT = 2304, D = 1024;
constexpr int NTOK = NB * TT, NLAT = NB * SEQ;
constexpr int NG = 2, BG = NB / NG, RG = BG * TT, RGL = BG * SEQ;
constexpr float EPS = 1e-6f;
constexpr int AB_N = 5424, AB_NPAD = 5632, AB_Q = 0, AB_K = 512, AB_V = 1024, AB_OG = 2048, AB_IG = 3072, AB_FG = 3080, AB_Z = 3088, AB_XBC = 4112, AB_DT = 5392;
constexpr int CD_N = 4128, CD_NPAD = 4352, CD_M0 = 0, CD_M1 = 384, CD_KR = 640, CD_R = 672, CD_K = 1696, CD_V = 2720, CD_WL = 3744, CD_AL = 3872, CD_GL = 4000;
constexpr int CD_RW0 = 672;

constexpr size_t CTL_BYTES = 32768;
constexpr size_t CTL_CNT = 16384;
constexpr size_t WS_MODV = CTL_BYTES;
constexpr size_t WS_HC   = WS_MODV + (size_t)2 * 17 * 6144 * 4;
constexpr size_t WS_TOKE = WS_HC + (size_t)NB * CTXL * D * 4;
constexpr size_t WS_TOKP = WS_TOKE + (size_t)NTOK * 2 * 4;
constexpr size_t WS_TOKW = WS_TOKP + (size_t)NTOK * 2 * 4;
constexpr size_t WS_LIST = WS_TOKW + (size_t)NTOK * 2 * 4;
constexpr size_t WS_BSC  = WS_LIST + (size_t)16 * NTOK * 4;
constexpr size_t WS_SG   = WS_BSC + (size_t)2 * RGL * 16 * 4;
constexpr size_t WS_WMIX = WS_SG + (size_t)RGL * 128 * 2;
constexpr size_t WMIX_BYTES = (size_t)16 << 20;
constexpr size_t WS_V    = WS_WMIX + WMIX_BYTES;
constexpr size_t WS_BIG  = WS_V + (size_t)NTOK * D * 2;
constexpr size_t WM_AB_IN = 0, WM_AB_OUT = (size_t)AB_NPAD * 1024 * 2;
constexpr size_t WM_CD_IN = 0, WM_CD_OUT = (size_t)CD_NPAD * 1024 * 2, WM_UQ = WM_CD_OUT + (size_t)1024 * 1536 * 2, WM_UKV = WM_UQ + (size_t)768 * 384 * 2, WM_G2 = WM_UKV + (size_t)1024 * 256 * 2;
static_assert(WM_AB_OUT + (size_t)1024 * 2048 * 2 <= WMIX_BYTES, "wmix ab");
static_assert(WM_G2 + (size_t)1024 * 128 * 2 <= WMIX_BYTES, "wmix cd");
constexpr size_t SZ_RG1K = (size_t)RG * 1024 * 2, SZ_RGL1K = (size_t)RGL * 1024 * 2;
constexpr size_t L0_P = 0, L0_AO = (size_t)RG * AB_N * 2  , L0_HB = L0_AO + 2 * SZ_RG1K, L0_YB = L0_HB + SZ_RG1K, L0_U = L0_YB + SZ_RG1K, L0_END = L0_U + SZ_RG1K;
constexpr size_t L1_P = 0, L1_Q = (size_t)RG * CD_N * 2, L1_KV = L1_Q + (size_t)RGL * 768 * 2, L1_OF = L1_KV + SZ_RG1K, L1_OB = L1_OF + SZ_RGL1K, L1_AOUT = L1_OB + SZ_RGL1K, L1_U = L1_AOUT + (size_t)RGL * 1536 * 2, L1_END = L1_U + SZ_RG1K;
constexpr int MOE_PADROWS = 16 * 256;
constexpr size_t MO_WUP = 0, MO_WDN = (size_t)17 * 1024 * 1024 * 2, MO_HID = MO_WDN + (size_t)17 * 1024 * 512 * 2;
constexpr size_t MO_XG = MO_HID + (size_t)(3 * NTOK + MOE_PADROWS) * 512 * 2;
constexpr size_t MO_CON = MO_XG, MO_END = MO_CON + (size_t)(3 * NTOK + MOE_PADROWS) * 1024 * 2;
constexpr size_t BIG_BYTES = MO_END > L0_END ? (MO_END > L1_END ? MO_END : L1_END) : (L0_END > L1_END ? L0_END : L1_END);
constexpr size_t WS_NEED = WS_BIG + BIG_BYTES;

constexpr int LDS_BYTES = 147456;

__device__ __forceinline__ float bf2f(unsigned short h) { return __uint_as_float(((unsigned)h) << 16); }
__device__ __forceinline__ unsigned short f2bf(float f) { unsigned u = __float_as_uint(f); u += 0x7fffu + ((u >> 16) & 1u); return (unsigned short)(u >> 16); }
__device__ __forceinline__ unsigned pack2(float a, float b) { return (unsigned)f2bf(a) | ((unsigned)f2bf(b) << 16); }
__device__ __forceinline__ float lo2f(unsigned w) { return __uint_as_float(w << 16); }
__device__ __forceinline__ float hi2f(unsigned w) { return __uint_as_float(w & 0xffff0000u); }
__device__ __forceinline__ float wsum(float v) {
#pragma unroll
    for (int o = 32; o; o >>= 1) v += __shfl_xor(v, o);
    return v; }
__device__ __forceinline__ float sigmoidf_(float x) { return 1.0f / (1.0f + __expf(-x)); }
__device__ __forceinline__ float siluf_(float x) { return x / (1.0f + __expf(-x)); }
__device__ __forceinline__ float softplusf_(float x) { return fmaxf(x, 0.0f) + log1pf(__expf(-fabsf(x))); }
__device__ __forceinline__ float logsigmoidf_(float x) { return fminf(x, 0.0f) - log1pf(__expf(-fabsf(x))); }
__device__ __forceinline__ f32x4 mma16(bf16x8 a, bf16x8 b, f32x4 c) { return __builtin_amdgcn_mfma_f32_16x16x32_bf16(a, b, c, 0, 0, 0); }
__device__ __forceinline__ bf16x8 ldfrag(const bf16_t* base, int ld, int row0, int k0, int fr, int fq) { return *(const bf16x8*)(base + (row0 + fr) * ld + k0 + fq * 8); }
__device__ __forceinline__ void st4bf(bf16_t* p, f32x4 v) { u32x2 w; w.x = pack2(v[0], v[1]); w.y = pack2(v[2], v[3]); *(u32x2*)p = w; }
__device__ __forceinline__ f32x4 ld4bf(const bf16_t* p) { u32x2 w = *(const u32x2*)p; return (f32x4){lo2f(w.x), hi2f(w.x), lo2f(w.y), hi2f(w.y)}; }

#define PHASE_FN __device__ __forceinline__
__device__ __forceinline__ int otid() { int t = threadIdx.x; asm volatile("" : "+v"(t)); return t; }
__device__ __forceinline__ int obid() { int t = blockIdx.x; asm volatile("" : "+s"(t)); return t; }
struct KP { const float* in[42]; float* out; unsigned char* ws; int ph_lo, ph_hi; };

#define XB_TMO      128
#define XB_XCNT(j)  (256  + 64 * (j))
#define XB_XSUB(j)  (1280 + 64 * (j))
#define XB_XGEN(j)  (2304 + 64 * (j))
#define XB_TOP      3328
#define XB_TOPGEN   3392
#define XCD_BAR_WORDS 3456
#define XB_SPIN_CAP (1u << 18)
#define LAS __attribute__((address_space(3)))

__device__ __forceinline__ unsigned xb_ld(unsigned* p)              { return __hip_atomic_load(p, __ATOMIC_RELAXED, __HIP_MEMORY_SCOPE_AGENT); }
__device__ __forceinline__ unsigned xb_add(unsigned* p, unsigned v) { return __hip_atomic_fetch_add(p, v, __ATOMIC_RELAXED, __HIP_MEMORY_SCOPE_AGENT); }
__device__ __forceinline__ unsigned xb_xcc_id() { return (unsigned)__builtin_amdgcn_s_getreg((3 << 11) | 20) & 0xFu; }
#define XB_SPIN(cond, bar) do { unsigned _sp = 0; while (cond) { __builtin_amdgcn_s_sleep(1); \
    if ((++_sp & 255u) == 0u) { if (xb_ld(&(bar)[XB_TMO])) break; if (_sp > XB_SPIN_CAP) { atomicAdd(&(bar)[XB_TMO], 1u); break; } } } } while (0)

struct XcdBarrier {
    unsigned* bar; unsigned x;
    volatile LAS unsigned* st;
};

__device__ __forceinline__ XcdBarrier xcd_barrier_post(unsigned* bar, volatile LAS unsigned* st) {
    XcdBarrier b; b.bar = bar; b.x = xb_xcc_id(); b.st = st;
    if (threadIdx.x == 0) (void)xb_add(&bar[XB_XCNT(b.x)], 1u);
    return b;
}
__device__ __forceinline__ void xcd_barrier_complete(unsigned* bar, unsigned x, unsigned& nloc, unsigned& nx) {
    const unsigned G = gridDim.x * gridDim.y * gridDim.z;
    unsigned sum, cnt, mine, sp = 0u;
    for (;;) {
        sum = 0u; cnt = 0u; mine = 0u;
#pragma unroll
        for (unsigned j = 0; j < 16; ++j) { const unsigned c = xb_ld(&bar[XB_XCNT(j)]); sum += c; cnt += (c > 0u) ? 1u : 0u; mine = (j == x) ? c : mine; }
        if (sum == G) break;
        __builtin_amdgcn_s_sleep(1);
        if ((++sp & 255u) == 0u) { if (xb_ld(&bar[XB_TMO])) break; if (sp > XB_SPIN_CAP) { atomicAdd(&bar[XB_TMO], 1u); break; } }
    }
    nloc = mine > 0u ? mine : 1u; nx = cnt > 0u ? cnt : 1u;
}

__device__ __forceinline__ void xcd_barrier(const XcdBarrier& b) {
    asm volatile("s_waitcnt vmcnt(0)" ::: "memory");
    __syncthreads();
    if (threadIdx.x == 0) {
        unsigned* bar = b.bar;
        __builtin_amdgcn_s_waitcnt(0);
        unsigned nloc = b.st[0], nx = b.st[1];
        if (nloc == 0u) { xcd_barrier_complete(bar, b.x, nloc, nx); b.st[0] = nloc; b.st[1] = nx; }
        const unsigned old = xb_add(&bar[XB_XSUB(b.x)], 1u);
        const unsigned gen = old / nloc;
        if (old + 1u == (gen + 1u) * nloc) {
            __builtin_amdgcn_fence(__ATOMIC_RELEASE, "agent");
            asm volatile("s_waitcnt vmcnt(0)" ::: "memory");
            const unsigned og = xb_add(&bar[XB_TOP], 1u);
            const unsigned tg = og / nx;
            if (og + 1u == (tg + 1u) * nx) xb_add(&bar[XB_TOPGEN], 1u);
            else XB_SPIN(xb_ld(&bar[XB_TOPGEN]) == tg, bar);
            __builtin_amdgcn_fence(__ATOMIC_ACQUIRE, "agent");
            xb_add(&bar[XB_XGEN(b.x)], 1u);
            asm volatile("s_waitcnt vmcnt(0)" ::: "memory");
        } else {
            XB_SPIN(xb_ld(&bar[XB_XGEN(b.x)]) == gen, bar);
            __builtin_amdgcn_fence(__ATOMIC_ACQUIRE, "agent");
            asm volatile("s_waitcnt vmcnt(0)" ::: "memory");
        }
    }
    __syncthreads();
}
struct GA {
    const bf16_t* a0; const bf16_t* a1;
    int ld0, ld1, ksplit;
    const int* list;
    int nrows;
    int mode;
    int row0;
};
constexpr int G_LDT = 40;
constexpr int GEMM_LDS = (2 * 256 * G_LDT + 2 * 128 * G_LDT) * 2;

template <class Epi>
__device__ __forceinline__ void gemm_tile(unsigned char* lds, const GA& ga, const bf16_t* __restrict__ Bt, int K, int mt, int nt, const Epi& epi) {
    const int tid = otid(), lane = tid & 63, wid = tid >> 6, wm = wid >> 1, wn = wid & 1, fr = lane & 15, fq = lane >> 4;
    bf16_t* sA = (bf16_t*)lds;
    bf16_t* sB = sA + 2 * 256 * G_LDT;
    const int kp = tid & 3;
    const int r0 = tid >> 2, r1 = r0 + 128;
    int s0, s1;
    {
        int lr = mt * 256 + r0; if (lr >= ga.nrows) lr = 0;
        s0 = ga.list ? ga.list[lr] : (ga.mode == 1 ? (lr >> 11) * TT + CTXL + (lr & 2047) : ga.row0 + lr);
        lr = mt * 256 + r1; if (lr >= ga.nrows) lr = 0;
        s1 = ga.list ? ga.list[lr] : (ga.mode == 1 ? (lr >> 11) * TT + CTXL + (lr & 2047) : ga.row0 + lr);
    }
    const bf16_t* pa00 = ga.a0 + (size_t)s0 * ga.ld0 + kp * 8;
    const bf16_t* pa01 = ga.a0 + (size_t)s1 * ga.ld0 + kp * 8;
    const bf16_t* pa10 = ga.a1 ? ga.a1 + (size_t)s0 * ga.ld1 + kp * 8 : pa00;
    const bf16_t* pa11 = ga.a1 ? ga.a1 + (size_t)s1 * ga.ld1 + kp * 8 : pa01;
    const bf16_t* pb = Bt + (size_t)(nt * 128 + r0) * K + kp * 8;
    const int ksplit = ga.ksplit;
    f32x4 acc[4][4];
#pragma unroll
    for (int i = 0; i < 4; ++i)
#pragma unroll
        for (int j = 0; j < 4; ++j) acc[i][j] = (f32x4){0.f, 0.f, 0.f, 0.f};
    const int nk = K >> 5;
    u32x4 ra0, ra1, rb;
    {
        ra0 = *(const u32x4*)(pa00); ra1 = *(const u32x4*)(pa01); rb = *(const u32x4*)(pb);
        if (0 >= ksplit) { ra0 = *(const u32x4*)(pa10); ra1 = *(const u32x4*)(pa11); }
    }
    *(u32x4*)(sA + (r0) * G_LDT + kp * 8) = ra0;
    *(u32x4*)(sA + (r1) * G_LDT + kp * 8) = ra1;
    *(u32x4*)(sB + (r0) * G_LDT + kp * 8) = rb;
    __syncthreads();
    for (int kt = 0; kt < nk; ++kt) {
        const int cur = kt & 1;
        if (kt + 1 < nk) {
            const int k0 = (kt + 1) << 5;
            if (k0 < ksplit) { ra0 = *(const u32x4*)(pa00 + k0); ra1 = *(const u32x4*)(pa01 + k0); }
            else { ra0 = *(const u32x4*)(pa10 + (k0 - ksplit)); ra1 = *(const u32x4*)(pa11 + (k0 - ksplit)); }
            rb = *(const u32x4*)(pb + k0);
        }
        const bf16_t* cA = sA + cur * 256 * G_LDT;
        const bf16_t* cB = sB + cur * 128 * G_LDT;
        bf16x8 af[4], bfr[4];
#pragma unroll
        for (int i = 0; i < 4; ++i) af[i] = ldfrag(cA, G_LDT, wm * 64 + i * 16, 0, fr, fq);
#pragma unroll
        for (int j = 0; j < 4; ++j) bfr[j] = ldfrag(cB, G_LDT, wn * 64 + j * 16, 0, fr, fq);
#pragma unroll
        for (int i = 0; i < 4; ++i)
#pragma unroll
            for (int j = 0; j < 4; ++j) acc[i][j] = mma16(bfr[j], af[i], acc[i][j]);
        if (kt + 1 < nk) {
            const int nb = cur ^ 1;
            *(u32x4*)(sA + (nb * 256 + r0) * G_LDT + kp * 8) = ra0;
            *(u32x4*)(sA + (nb * 256 + r1) * G_LDT + kp * 8) = ra1;
            *(u32x4*)(sB + (nb * 128 + r0) * G_LDT + kp * 8) = rb;
        }
        __syncthreads();
    }
    epi(acc, mt * 256 + wm * 64, nt * 128 + wn * 64, fr, fq);
}

struct EpiBf {
    bf16_t* out; int ld, nrows, ncols;
    __device__ __forceinline__ void operator()(const f32x4 (&acc)[4][4], int rb, int cb, int fr, int fq) const {
#pragma unroll
        for (int i = 0; i < 4; ++i) { const int lr = rb + i * 16 + fr; if (lr < nrows) {
#pragma unroll
            for (int j = 0; j < 4; ++j) { const int col = cb + j * 16 + fq * 4; if (col < ncols) st4bf(out + (size_t)lr * ld + col, acc[i][j]); } } }
    }
};
struct EpiSwiglu {
    bf16_t* out; int nrows;
    __device__ __forceinline__ void operator()(const f32x4 (&acc)[4][4], int rb, int cb, int fr, int fq) const {
#pragma unroll
        for (int i = 0; i < 4; ++i) { const int lr = rb + i * 16 + fr; if (lr < nrows) {
#pragma unroll
            for (int j = 0; j < 2; ++j) { const int col = (cb >> 1) + j * 16 + fq * 4; f32x4 g = acc[i][j], u = acc[i][j + 2], o;
#pragma unroll
                for (int r = 0; r < 4; ++r) o[r] = siluf_(g[r]) * u[r];
                st4bf(out + (size_t)lr * 512 + col, o); } } }
    }
};

namespace pg8 {
#define PG8_LAS __attribute__((address_space(3)))
typedef unsigned short bf16_t;
typedef short bf16x8 __attribute__((ext_vector_type(8)));
typedef float f32x4 __attribute__((ext_vector_type(4)));
typedef unsigned u32x4 __attribute__((ext_vector_type(4)));
constexpr int BM = 256, BK = 64, HALF = 128, HTB = HALF * BK * 2  , STAGE_BYTES = 8 * HTB, NXCD = 8, WGM = 8;

__host__ __device__ __forceinline__ int lds_byte(int r, int c) { const int st = (r >> 4) * 2 + (c >> 5), rr = r & 15, cc = c & 31, ob = rr * 64 + cc * 2; return st * 1024 + (ob ^ (((ob >> 9) & 1) << 5)); }
__host__ __device__ __forceinline__ void stage_rc(int b, int& R, int& C) { const int st = b / 1024, sb = b % 1024, swz = sb ^ (((sb >> 9) & 1) << 5); R = (st >> 1) * 16 + swz / 64; C = (st & 1) * 32 + (swz % 64) / 2; }
__host__ __device__ __forceinline__ int perm32(int rho) { const int n = rho >> 4, i = rho & 15; return 8 * (i >> 2) + 4 * n + (i & 3); }

struct Unit { int pm, pn; };
struct Gemm { const bf16_t* A; const bf16_t* Bt; int M, N, K; const bf16_t* A2; int pm_split; };
#define PG8_ABASE(g, pm) ((pm) < (g).pm_split ? (const char*)(g).A + (size_t)(pm) * tstep : (const char*)(g).A2 + (size_t)((pm) - (g).pm_split) * tstep)
struct StaticOrder {
    int nM, nN, nwg, G, c;
    __host__ __device__ void init(int M, int N, int G_, int c_) { nM = M / BM; nN = N / BM; nwg = nM * nN; G = G_; c = c_; }
    __host__ __device__ bool next(int i, Unit& u) const {
        const long L = (long)i * G + c; if (L >= nwg) return false;
        int wgid = (int)L; { const int q = nwg / NXCD, r = nwg % NXCD, xcd = wgid % NXCD, off = wgid / NXCD; wgid = (xcd < r ? xcd * (q + 1) : r * (q + 1) + (xcd - r) * q) + off; }
        const int nig = WGM * nN, gid = wgid / nig, fm = gid * WGM, gsz = (nM - fm) < WGM ? (nM - fm) : WGM;
        u.pm = fm + ((wgid % nig) % gsz); u.pn = (wgid % nig) / gsz; return true;
    }
    __device__ __forceinline__ void a_ready(const Unit&) const {}
    __device__ __forceinline__ void done(const Unit&) const {}
};
__device__ __forceinline__ unsigned cvt_pk_bf16(float lo, float hi) { unsigned r; asm volatile("v_cvt_pk_bf16_f32 %0, %1, %2" : "=v"(r) : "v"(lo), "v"(hi)); return r; }
typedef float f32x2 __attribute__((ext_vector_type(2)));
template <class Epi, class Sched, bool STAMP = false>
__device__ __forceinline__ void gemm_phase(PG8_LAS unsigned char* lds, const Gemm g, const Sched& S, const Epi& E, unsigned long long* stamps) {
    const int tid = otid(), wid = __builtin_amdgcn_readfirstlane(tid >> 6), lane = tid & 63, wr = wid >> 2, wc = wid & 3, fr = lane & 15, fq = lane >> 4;
    const int K = g.K, nt = K / BK;
    int ts_lo = 0, ts_hi = 0, nts = 0; const unsigned long long rt_entry = STAMP ? (unsigned long long)wall_clock64() : 0ull;
#define PG8_STAMP() do { if (STAMP && wid == 0 && nts < 64) { const unsigned long long _c = (unsigned long long)clock64(); \
        ts_lo = (lane == nts) ? (int)(unsigned)_c : ts_lo; ts_hi = (lane == nts) ? (int)(unsigned)(_c >> 32) : ts_hi; ++nts; } } while (0)
    PG8_STAMP();
    unsigned voffA[2], voffB[2];
#pragma unroll
    for (int i = 0; i < 2; ++i) { int R, C; stage_rc(tid * 16 + i * 8192, R, C); const int Rb = Epi::PERM ? ((R & ~31) + perm32(R & 31)) : R;
        voffA[i] = (unsigned)(R * K + C) * 2u; voffB[i] = (unsigned)(Rb * K + C) * 2u; }
    const size_t kstep = (size_t)(BK * 2);
    const size_t hstep = (size_t)HALF * K * 2;
    const size_t tstep = 2 * hstep;
    const unsigned ldsw = (unsigned)wid * 1024u;
    const int aoff = lds_byte(wr * 64 + fr, fq * 8), boff = lds_byte(wc * 32 + fr, fq * 8);
#define PG8_SA(b, h) (((b) * 2 + (h)) * HTB)
#define PG8_SB(b, h) ((4 + (b) * 2 + (h)) * HTB)
#define PG8_STAGE(bufoff, gbase, voff) do { _Pragma("unroll") for (int _i = 0; _i < 2; ++_i) \
        __builtin_amdgcn_global_load_lds((const unsigned*)((const char*)(gbase) + (voff)[_i]), (PG8_LAS unsigned*)(lds + (bufoff) + ldsw + _i * 8192), 16, 0, 0); } while (0)
#define PG8_LDA(dst, b, h) do { _Pragma("unroll") for (int m = 0; m < 4; ++m) _Pragma("unroll") for (int k = 0; k < 2; ++k) dst[m][k] = *(const PG8_LAS bf16x8*)(lds + PG8_SA(b, h) + aoff + m * 2048 + k * 1024); } while (0)
#define PG8_LDB(dst, b, h) do { _Pragma("unroll") for (int n = 0; n < 2; ++n) _Pragma("unroll") for (int k = 0; k < 2; ++k) dst[n][k] = *(const PG8_LAS bf16x8*)(lds + PG8_SB(b, h) + boff + n * 2048 + k * 1024); } while (0)
#define PG8_MMA(ai, bj, At, Bt) do { __builtin_amdgcn_s_setprio(1); _Pragma("unroll") for (int m = 0; m < 4; ++m) _Pragma("unroll") for (int n = 0; n < 2; ++n) _Pragma("unroll") for (int k = 0; k < 2; ++k) \
        acc[ai][bj][m][n] = __builtin_amdgcn_mfma_f32_16x16x32_bf16(Bt[n][k], At[m][k], acc[ai][bj][m][n], 0, 0, 0); __builtin_amdgcn_s_setprio(0); } while (0)
#define PG8_WAIT_V(n) asm volatile("s_waitcnt vmcnt(" #n ")" ::: "memory")
#define PG8_WAIT_L(n) asm volatile("s_waitcnt lgkmcnt(" #n ")" ::: "memory")
#define PG8_BAR __builtin_amdgcn_s_barrier()
#define PG8_SCHED __builtin_amdgcn_sched_barrier(0)
    Unit cur, nxt; int ui = 0;
    if (!S.next(0, cur)) return;
    f32x4 acc[2][2][4][2];
#pragma unroll
    for (int a = 0; a < 2; ++a)
#pragma unroll
        for (int b = 0; b < 2; ++b)
#pragma unroll
            for (int m = 0; m < 4; ++m)
#pragma unroll
                for (int n = 0; n < 2; ++n) acc[a][b][m][n] = (f32x4){0.f, 0.f, 0.f, 0.f};
    bf16x8 At[4][2], B0[2][2], B1[2][2];
    const char* cA = PG8_ABASE(g, cur.pm); const char* cB = (const char*)g.Bt + (size_t)cur.pn * tstep;
    S.a_ready(cur);
    PG8_STAGE(PG8_SB(0, 0), cB, voffB); PG8_STAGE(PG8_SA(0, 0), cA, voffA); PG8_STAGE(PG8_SB(0, 1), cB + hstep, voffB); PG8_STAGE(PG8_SA(0, 1), cA + hstep, voffA);
    if (wr == 1) PG8_BAR;
    PG8_WAIT_V(4); PG8_BAR;
    PG8_STAGE(PG8_SB(1, 0), cB + kstep, voffB); PG8_STAGE(PG8_SA(1, 0), cA + kstep, voffA); PG8_STAGE(PG8_SB(1, 1), cB + hstep + kstep, voffB);
    PG8_WAIT_V(6); PG8_BAR;
    PG8_STAMP();
    for (;;) {
        const bool has_next = S.next(ui + 1, nxt);
        const char* nA = has_next ? PG8_ABASE(g, nxt.pm) : cA; const char* nB = has_next ? (const char*)g.Bt + (size_t)nxt.pn * tstep : cB;
        for (int t = 0; t < nt; t += 2) {
            const bool last = (t == nt - 2);
            const char* a1 = cA + (size_t)(t + 1) * kstep;
            const char* a2 = last ? nA : cA + (size_t)(t + 2) * kstep; const char* b2 = last ? nB : cB + (size_t)(t + 2) * kstep;
            const char* a3 = a2 + kstep; const char* b3 = b2 + kstep;
            if (last && has_next) S.a_ready(nxt);
            PG8_LDB(B0, 0, 0); PG8_SCHED; PG8_LDA(At, 0, 0); PG8_STAGE(PG8_SA(1, 1), a1 + hstep, voffA);
            PG8_WAIT_L(8); PG8_BAR; PG8_WAIT_L(0); PG8_MMA(0, 0, At, B0); PG8_BAR; PG8_SCHED;
            PG8_LDB(B1, 0, 1); PG8_STAGE(PG8_SB(0, 0), b2, voffB);
            PG8_BAR; PG8_WAIT_L(0); PG8_MMA(0, 1, At, B1); PG8_BAR;
            PG8_LDA(At, 0, 1); PG8_STAGE(PG8_SA(0, 0), a2, voffA);
            PG8_BAR; PG8_WAIT_L(0); PG8_MMA(1, 0, At, B0); PG8_BAR; PG8_SCHED;
            PG8_STAGE(PG8_SB(0, 1), b2 + hstep, voffB);
            PG8_WAIT_V(6); PG8_BAR; PG8_MMA(1, 1, At, B1); PG8_BAR;
            PG8_LDB(B0, 1, 0); PG8_SCHED; PG8_LDA(At, 1, 0); PG8_STAGE(PG8_SA(0, 1), a2 + hstep, voffA);
            PG8_WAIT_L(8); PG8_BAR; PG8_WAIT_L(0); PG8_MMA(0, 0, At, B0); PG8_BAR; PG8_SCHED;
            PG8_LDB(B1, 1, 1); PG8_STAGE(PG8_SB(1, 0), b3, voffB);
            PG8_BAR; PG8_WAIT_L(0); PG8_MMA(0, 1, At, B1); PG8_BAR;
            PG8_LDA(At, 1, 1); PG8_STAGE(PG8_SA(1, 0), a3, voffA);
            PG8_BAR; PG8_WAIT_L(0); PG8_MMA(1, 0, At, B0); PG8_BAR; PG8_SCHED;
            PG8_STAGE(PG8_SB(1, 1), b3 + hstep, voffB);
            PG8_WAIT_V(6); PG8_BAR; PG8_MMA(1, 1, At, B1); PG8_BAR;
        }
        PG8_STAMP();
        if constexpr (!Epi::AFTER_DRAIN) { E(acc, cur, wr, wc, fr, fq); S.done(cur); }
        PG8_STAMP();
        if (!has_next) break;
#pragma unroll
        for (int a = 0; a < 2; ++a)
#pragma unroll
            for (int b = 0; b < 2; ++b)
#pragma unroll
                for (int m = 0; m < 4; ++m)
#pragma unroll
                    for (int n = 0; n < 2; ++n) acc[a][b][m][n] = (f32x4){0.f, 0.f, 0.f, 0.f};
        cur = nxt; cA = nA; cB = nB; ++ui;
    }
    PG8_WAIT_V(0);
    if (wr == 0) PG8_BAR;
    PG8_BAR;
    if constexpr (Epi::AFTER_DRAIN) { E.fused(acc, cur, wr, wc, fr, fq, lds, wid, lane); S.done(cur); }
    PG8_STAMP();
    if (STAMP && wid == 0) { stamps[lane] = lane < nts ? (((unsigned long long)(unsigned)ts_hi << 32) | (unsigned)ts_lo) : 0ull;
        if (lane == 62) stamps[62] = rt_entry; if (lane == 63) stamps[63] = (unsigned long long)wall_clock64(); }
#undef PG8_STAMP
#undef PG8_SA
#undef PG8_SB
#undef PG8_STAGE
#undef PG8_LDA
#undef PG8_LDB
#undef PG8_MMA
#undef PG8_WAIT_V
#undef PG8_WAIT_L
#undef PG8_BAR
#undef PG8_SCHED
}
}
namespace pg8 {
struct EpiBfG {
    static constexpr bool PERM = true, AFTER_DRAIN = false;
    bf16_t* O; int ldc, ncols, pn_mask;
    __device__ __forceinline__ void operator()(const f32x4 (&acc)[2][2][4][2], const Unit& u, int wr, int wc, int fr, int fq) const {
        const int row0 = u.pm * BM + wr * 64 + fr, col0 = (u.pn & pn_mask) * BM + wc * 32 + 8 * fq;
#pragma unroll
        for (int ai = 0; ai < 2; ++ai)
#pragma unroll
            for (int m = 0; m < 4; ++m) { bf16_t* rowp = O + (size_t)(row0 + ai * HALF + m * 16) * ldc;
#pragma unroll
                for (int bj = 0; bj < 2; ++bj) { const int c = col0 + bj * HALF;
                    if (c < ncols) { const f32x4 v0 = acc[ai][bj][m][0], v1 = acc[ai][bj][m][1];
                        u32x4 w; w.x = cvt_pk_bf16(v0[0], v0[1]); w.y = cvt_pk_bf16(v0[2], v0[3]); w.z = cvt_pk_bf16(v1[0], v1[1]); w.w = cvt_pk_bf16(v1[2], v1[3]);
                        *(u32x4*)(rowp + c) = w; } } }
    }
};
struct EpiSwi {
    static constexpr bool PERM = true, AFTER_DRAIN = false;
    bf16_t* H;
    __device__ __forceinline__ void operator()(const f32x4 (&acc)[2][2][4][2], const Unit& u, int wr, int wc, int fr, int fq) const {
        const int row0 = u.pm * BM + wr * 64 + fr, hc0 = (u.pn & 3) * HALF + wc * 32 + 8 * fq;
#pragma unroll
        for (int ai = 0; ai < 2; ++ai)
#pragma unroll
            for (int m = 0; m < 4; ++m) { bf16_t* rowp = H + (size_t)(row0 + ai * HALF + m * 16) * 512 + hc0;
                float o[8];
#pragma unroll
                for (int n = 0; n < 2; ++n)
#pragma unroll
                    for (int r = 0; r < 4; ++r) { const float g = acc[ai][0][m][n][r]; o[n * 4 + r] = g / (1.0f + __expf(-g)) * acc[ai][1][m][n][r]; }
                u32x4 w; w.x = cvt_pk_bf16(o[0], o[1]); w.y = cvt_pk_bf16(o[2], o[3]); w.z = cvt_pk_bf16(o[4], o[5]); w.w = cvt_pk_bf16(o[6], o[7]);
                *(u32x4*)rowp = w; }
    }
};
struct MoeOrder {
    const int* slotmap; int ntiles, G, c;
    __device__ __forceinline__ bool next(int i, Unit& u) const {
        const int L = i * G + c; if (L >= ntiles * 4) return false;
        u.pm = L >> 2; u.pn = slotmap[L >> 2] * 4 + (L & 3); return true;
    }
    __device__ __forceinline__ void a_ready(const Unit&) const {}
    __device__ __forceinline__ void done(const Unit&) const {}
};
}
#define WSP(T, off) ((T*)(kp.ws + (off)))

PHASE_FN void phase_mod(const KP& kp, unsigned char* lds) {
    float* sc = (float*)lds;
    float* red = sc + 17 * 1024;
    float* modv = WSP(float, WS_MODV);
    const int tid = otid();
    for (int i = tid; i < 17 * 1024; i += 512) { const int bb = i >> 10, k = i & 1023; const float c = bb < 16 ? kp.in[1][bb * 1024 + k] : kp.in[3][k]; sc[i] = siluf_(c); }
    __syncthreads();
    const int jc = tid & 63, ks = tid >> 6;
    for (int u = obid(); u < 192; u += gridDim.x) {
        const int l = u / 96, j0 = (u % 96) * 64;
        const float* w = kp.in[4] + (size_t)l * 1024 * 6144 + j0 + jc;
        float acc[17];
#pragma unroll
        for (int bb = 0; bb < 17; ++bb) acc[bb] = 0.f;
        for (int k = ks * 128; k < ks * 128 + 128; ++k) {
            const float wv = w[(size_t)k * 6144];
#pragma unroll
            for (int bb = 0; bb < 17; ++bb) acc[bb] += sc[bb * 1024 + k] * wv;
        }
#pragma unroll
        for (int bb = 0; bb < 17; ++bb) red[(ks * 17 + bb) * 64 + jc] = acc[bb];
        __syncthreads();
        for (int i = tid; i < 17 * 64; i += 512) {
            const int bb = i >> 6, j = i & 63; float s = kp.in[5][l * 6144 + j0 + j];
#pragma unroll
            for (int k2 = 0; k2 < 8; ++k2) s += red[(k2 * 17 + bb) * 64 + j];
            modv[((size_t)l * 17 + bb) * 6144 + j0 + j] = s;
        }
        __syncthreads();
    }
}

__device__ __forceinline__ void conv_tile(float* tile, const float* src, int N, int ldsrc, bf16_t* dst, int ldd, int mode, int kt, int ntile) {
    const int tid = otid(), c = tid & 63, r8 = tid >> 6;
#pragma unroll
    for (int i = 0; i < 8; ++i) { const int k = i * 8 + r8, n = ntile * 64 + c; tile[k * 65 + c] = (n < N) ? src[(size_t)(kt * 64 + k) * ldsrc + n] : 0.f; }
    __syncthreads();
#pragma unroll
    for (int i = 0; i < 8; ++i) { const int nl = i * 8 + r8, n = ntile * 64 + nl;
        if (n < N) { int row = n; if (mode) row = (n >> 7) * 256 + (n & 127) + (mode == 2 ? 128 : 0);
            dst[(size_t)row * ldd + kt * 64 + c] = f2bf(tile[c * 65 + nl]); } }
    __syncthreads();
}
__device__ __forceinline__ bool conv_job(float* tile, int& u, const float* src, int K, int N, bf16_t* dst, int mode = 0, int ldd = -1) {
    const int ntl = (N + 63) >> 6, ktl = K >> 6, cnt = ntl * ktl;
    if (u < cnt) { conv_tile(tile, src, N, N, dst, ldd < 0 ? K : ldd, mode, u / ntl, u % ntl); return true; }
    u -= cnt; return false;
}
PHASE_FN void phase_conv_ab(const KP& kp, unsigned char* lds) {
    float* tile = (float*)lds;
    const int total = 16 * 85 + 32 * 16;
    for (int u0 = obid(); u0 < total; u0 += gridDim.x) { int u = u0;
        if (conv_job(tile, u, kp.in[7], 1024, AB_N, WSP(bf16_t, WS_WMIX + WM_AB_IN))) continue;
        conv_job(tile, u, kp.in[8], 2048, 1024, WSP(bf16_t, WS_WMIX + WM_AB_OUT)); }
}
PHASE_FN void phase_conv_cd(const KP& kp, unsigned char* lds) {
    float* tile = (float*)lds;
    const int total = 16 * 65 + 24 * 16 + 6 * 12 + 4 * 16 + 2 * 16;
    for (int u0 = obid(); u0 < total; u0 += gridDim.x) { int u = u0;
        if (conv_job(tile, u, kp.in[18], 1024, CD_N, WSP(bf16_t, WS_WMIX + WM_CD_IN))) continue;
        if (conv_job(tile, u, kp.in[19], 1536, 1024, WSP(bf16_t, WS_WMIX + WM_CD_OUT))) continue;
        if (conv_job(tile, u, kp.in[21], 384, 768, WSP(bf16_t, WS_WMIX + WM_UQ))) continue;
        if (conv_job(tile, u, kp.in[23], 256, 1024, WSP(bf16_t, WS_WMIX + WM_UKV))) continue;
        conv_job(tile, u, kp.in[29], 128, 1024, WSP(bf16_t, WS_WMIX + WM_G2)); }
}
PHASE_FN void phase_conv_moe(const KP& kp, unsigned char* lds, int l) {
    float* tile = (float*)lds;
    const int total = 17 * 384;
    for (int u0 = obid(); u0 < total; u0 += gridDim.x) {
        const int es = u0 / 384; int u = u0 % 384;
        const float* wg = es < 16 ? kp.in[36] + ((size_t)l * 16 + es) * 1024 * 512 : kp.in[39] + (size_t)l * 1024 * 512;
        const float* wu = es < 16 ? kp.in[37] + ((size_t)l * 16 + es) * 1024 * 512 : kp.in[40] + (size_t)l * 1024 * 512;
        const float* wd = es < 16 ? kp.in[38] + ((size_t)l * 16 + es) * 512 * 1024 : kp.in[41] + (size_t)l * 512 * 1024;
        bf16_t* dup = WSP(bf16_t, WS_BIG + MO_WUP) + (size_t)es * 1024 * 1024;
        bf16_t* ddn = WSP(bf16_t, WS_BIG + MO_WDN) + (size_t)es * 1024 * 512;
        if (conv_job(tile, u, wg, 1024, 512, dup, 1, 1024)) continue;
        if (conv_job(tile, u, wu, 1024, 512, dup, 2, 1024)) continue;
        conv_job(tile, u, wd, 512, 1024, ddn, 0, 512); }
}

__device__ __forceinline__ const float* hrow_rd(const KP& kp, bool from_inputs, int b, int t) {
    if (t < CTXL) return (from_inputs ? kp.in[2] : WSP(const float, WS_HC)) + ((size_t)b * CTXL + t) * D;
    return (from_inputs ? kp.in[0] : kp.out) + ((size_t)b * SEQ + (t - CTXL)) * D;
}
__device__ __forceinline__ float* hrow_wr(const KP& kp, int b, int t) {
    if (t < CTXL) return WSP(float, WS_HC) + ((size_t)b * CTXL + t) * D;
    return kp.out + ((size_t)b * SEQ + (t - CTXL)) * D;
}

PHASE_FN void phase_u(const KP& kp, int layer, int g) {
    const int lane = otid() & 63, wid = otid() >> 6;
    const float* modv = WSP(const float, WS_MODV) + (size_t)layer * 17 * 6144;
    const float* ng = kp.in[6] + (size_t)layer * 4 * 1024;
    bf16_t* U = WSP(bf16_t, WS_BIG + (layer == 0 ? L0_U : L1_U));
    for (int lr = obid() * 8 + wid; lr < RG; lr += gridDim.x * 8) {
        const int bl = lr / TT, t = lr - bl * TT, b = g * BG + bl;
        const float* src = hrow_rd(kp, layer == 0, b, t);
        const float* mv = modv + (size_t)(t < CTXL ? 16 : b) * 6144;
        f32x4 x[4]; float ss = 0.f;
#pragma unroll
        for (int i = 0; i < 4; ++i) { x[i] = *(const f32x4*)(src + i * 256 + lane * 4); ss += x[i][0] * x[i][0] + x[i][1] * x[i][1] + x[i][2] * x[i][2] + x[i][3] * x[i][3]; }
        ss = wsum(ss); const float rstd = rsqrtf(ss * (1.0f / 1024.0f) + EPS);
#pragma unroll
        for (int i = 0; i < 4; ++i) { const int col = i * 256 + lane * 4;
            const f32x4 gv = *(const f32x4*)(ng + col), sc = *(const f32x4*)(mv + 1024 + col), sh = *(const f32x4*)(mv + col);
            st4bf(U + (size_t)lr * 1024 + col, x[i] * rstd * gv * (sc + 1.0f) + sh); }
    }
}

PHASE_FN void phase_r(const KP& kp, unsigned char* lds, int layer, int g) {
    const int tid = otid(), lane = tid & 63, wid = tid >> 6;
    float* rw = (float*)lds;
    int* se = (int*)(rw + 1024 * 16);
    int* sbase = se + 128;
    for (int i = tid; i < 1024 * 16; i += 512) rw[i] = kp.in[34][i];
    __syncthreads();
    const float* modv = WSP(const float, WS_MODV) + (size_t)layer * 17 * 6144;
    const float* ng = kp.in[6] + (size_t)layer * 4 * 1024;
    const bf16_t* MIX = WSP(const bf16_t, WS_BIG + (layer == 0 ? L0_U : L1_U));
    bf16_t* V = WSP(bf16_t, WS_V);
    unsigned* cnt = WSP(unsigned, CTL_CNT) + layer * 16;
    int* TOKE = WSP(int, WS_TOKE); int* TOKP = WSP(int, WS_TOKP); float* TOKW = WSP(float, WS_TOKW); int* LIST = WSP(int, WS_LIST);
    const int nrows = layer == 0 ? RG : RGL, nchunks = nrows >> 6;
    float rbias[16];
#pragma unroll
    for (int e = 0; e < 16; ++e) rbias[e] = kp.in[35][e];
    for (int ch = obid(); ch < nchunks; ch += gridDim.x) {
        for (int rr = 0; rr < 8; ++rr) {
            const int rl = wid * 8 + rr, lr = ch * 64 + rl;
            int b, t, tok;
            if (layer == 0) { const int bl = lr / TT; t = lr - bl * TT; b = g * BG + bl; tok = g * RG + lr; }
            else { const int bl = lr >> 11; t = CTXL + (lr & 2047); b = g * BG + bl; tok = g * RGL + lr; }
            const float* hsrc = hrow_rd(kp, layer == 0, b, t);
            float* hdst = hrow_wr(kp, b, t);
            const float* mv = modv + (size_t)(t < CTXL ? 16 : b) * 6144;
            f32x4 y[4], h[4]; float ss = 0.f;
#pragma unroll
            for (int i = 0; i < 4; ++i) { y[i] = ld4bf(MIX + (size_t)lr * 1024 + i * 256 + lane * 4); ss += y[i][0] * y[i][0] + y[i][1] * y[i][1] + y[i][2] * y[i][2] + y[i][3] * y[i][3]; }
            ss = wsum(ss); float rstd = rsqrtf(ss * (1.0f / 1024.0f) + EPS);
            float s2 = 0.f;
#pragma unroll
            for (int i = 0; i < 4; ++i) { const int col = i * 256 + lane * 4;
                const f32x4 g1 = *(const f32x4*)(ng + 1024 + col), ga = *(const f32x4*)(mv + 2048 + col), hx = *(const f32x4*)(hsrc + col);
                h[i] = hx + ga * (y[i] * rstd * g1);
                *(f32x4*)(hdst + col) = h[i];
                s2 += h[i][0] * h[i][0] + h[i][1] * h[i][1] + h[i][2] * h[i][2] + h[i][3] * h[i][3]; }
            s2 = wsum(s2); rstd = rsqrtf(s2 * (1.0f / 1024.0f) + EPS);
            float lg[16];
#pragma unroll
            for (int e = 0; e < 16; ++e) lg[e] = 0.f;
#pragma unroll
            for (int i = 0; i < 4; ++i) { const int col = i * 256 + lane * 4;
                const f32x4 g2 = *(const f32x4*)(ng + 2048 + col), scf = *(const f32x4*)(mv + 4096 + col), shf = *(const f32x4*)(mv + 3072 + col);
                const f32x4 v = h[i] * rstd * g2 * (scf + 1.0f) + shf;
                st4bf(V + (size_t)tok * 1024 + col, v);
#pragma unroll
                for (int j = 0; j < 4; ++j) {
#pragma unroll
                    for (int q = 0; q < 4; ++q) { const f32x4 w4 = *(const f32x4*)(rw + (col + j) * 16 + q * 4);
                        lg[q * 4 + 0] += v[j] * w4[0]; lg[q * 4 + 1] += v[j] * w4[1]; lg[q * 4 + 2] += v[j] * w4[2]; lg[q * 4 + 3] += v[j] * w4[3]; } } }
#pragma unroll
            for (int e = 0; e < 16; ++e) lg[e] = wsum(lg[e]);
            float aff[16], sel[16];
#pragma unroll
            for (int e = 0; e < 16; ++e) { aff[e] = sigmoidf_(lg[e]); sel[e] = aff[e] + rbias[e]; }
            float gs[4];
#pragma unroll
            for (int gi = 0; gi < 4; ++gi) { const float a0 = sel[gi * 4], a1 = sel[gi * 4 + 1], a2 = sel[gi * 4 + 2], a3 = sel[gi * 4 + 3];
                gs[gi] = fmaxf(fmaxf(fmaxf(a0 + a1, a0 + a2), fmaxf(a0 + a3, a1 + a2)), fmaxf(a1 + a3, a2 + a3)); }
            int gidx = 0; float gb = gs[0];
#pragma unroll
            for (int gi = 1; gi < 4; ++gi) if (gs[gi] > gb) { gb = gs[gi]; gidx = gi; }
            float c[4], f[4];
#pragma unroll
            for (int i = 0; i < 4; ++i) { c[i] = gidx == 0 ? sel[i] : gidx == 1 ? sel[4 + i] : gidx == 2 ? sel[8 + i] : sel[12 + i];
                                           f[i] = gidx == 0 ? aff[i] : gidx == 1 ? aff[4 + i] : gidx == 2 ? aff[8 + i] : aff[12 + i]; }
            int i1 = 0; float cb = c[0];
#pragma unroll
            for (int i = 1; i < 4; ++i) if (c[i] > cb) { cb = c[i]; i1 = i; }
            int i2 = -1; float cb2 = 0.f;
#pragma unroll
            for (int i = 0; i < 4; ++i) if (i != i1 && (i2 < 0 || c[i] > cb2)) { cb2 = c[i]; i2 = i; }
            float w1 = i1 == 0 ? f[0] : i1 == 1 ? f[1] : i1 == 2 ? f[2] : f[3];
            float w2 = i2 == 0 ? f[0] : i2 == 1 ? f[1] : i2 == 2 ? f[2] : f[3];
            const float wsn = 1.0f / (w1 + w2); w1 *= wsn; w2 *= wsn;
            if (lane == 0) { se[rl * 2] = gidx * 4 + i1; se[rl * 2 + 1] = gidx * 4 + i2;
                TOKE[tok * 2] = gidx * 4 + i1; TOKE[tok * 2 + 1] = gidx * 4 + i2; TOKW[tok * 2] = w1; TOKW[tok * 2 + 1] = w2; }
        }
        __syncthreads();
        if (tid < 16) { int c2 = 0; for (int i = 0; i < 128; ++i) c2 += (se[i] == tid) ? 1 : 0; sbase[tid] = (int)atomicAdd(&cnt[tid], (unsigned)c2); }
        __syncthreads();
        if (tid < 128) { const int e = se[tid]; int rank = 0; for (int j = 0; j < tid; ++j) rank += (se[j] == e) ? 1 : 0;
            const int pos = sbase[e] + rank; const int lr = ch * 64 + (tid >> 1); const int tok = (layer == 0 ? g * RG : g * RGL) + lr;
            LIST[(size_t)e * NTOK + pos] = tok; TOKP[tok * 2 + (tid & 1)] = pos; }
        __syncthreads();
    }
}

__device__ __forceinline__ int moe_tile_prefix(const unsigned* cnt, int ntok, int lane) {
    const int myt = lane < 16 ? (int)((cnt[lane & 15] + 255u) >> 8) : 0; int pref = myt;
#pragma unroll
    for (int o = 1; o < 16; o <<= 1) { const int t = __shfl_up(pref, o); if (lane >= o) pref += t; }
    return pref - myt + ntok / 256;
}
PHASE_FN void phase_moe_gather(const KP& kp, int layer) {
    const int lane = otid() & 63, wid = otid() >> 6;
    const int ntok = layer == 0 ? NTOK : NLAT;
    const int tpre = moe_tile_prefix(WSP(const unsigned, CTL_CNT) + layer * 16, ntok, lane);
    const bf16_t* V = WSP(const bf16_t, WS_V); bf16_t* XG = WSP(bf16_t, WS_BIG + MO_XG);
    const int* TOKE = WSP(const int, WS_TOKE); const int* TOKP = WSP(const int, WS_TOKP);
    for (int it = obid() * 8 + wid; it < 2 * ntok; it += gridDim.x * 8) {
        const int tok = it >> 1, e = TOKE[it], pos = TOKP[it];
        const size_t row = (size_t)(__shfl(tpre, e) - ntok / 256) * 256 + pos;
        const u32x4* src = (const u32x4*)(V + (size_t)tok * 1024) + lane * 2; u32x4* dst = (u32x4*)(XG + row * 1024) + lane * 2;
        const u32x4 a = src[0], b2 = src[1]; dst[0] = a; dst[1] = b2;
    }
}
PHASE_FN void phase_moe_gemm(const KP& kp, unsigned char* lds, int layer, bool down) {
    const int tid = otid();
    int* pre = (int*)(lds + pg8::STAGE_BYTES);
    int* slotmap = pre + 32;
    const int ntok = layer == 0 ? NTOK : NLAT;
    const unsigned* cnt = WSP(const unsigned, CTL_CNT) + layer * 16;
    if (tid == 0) { int p = ntok / 256; pre[0] = 0; pre[1] = p; for (int e = 0; e < 16; ++e) { p += ((int)cnt[e] + 255) >> 8; pre[2 + e] = p; } }
    __syncthreads();
    const int ntiles = pre[17];
    for (int t = tid; t < ntiles; t += 512) { int idx = 0; for (int e = 1; e < 17; ++e) if (pre[e] <= t) idx = e; slotmap[t] = idx == 0 ? 16 : idx - 1; }
    __syncthreads();
    pg8::MoeOrder S{slotmap, ntiles, (int)gridDim.x, obid()};
    if (!down) {
        pg8::Gemm g{WSP(const bf16_t, WS_V), WSP(const bf16_t, WS_BIG + MO_WUP), 0, 0, 1024, WSP(const bf16_t, WS_BIG + MO_XG), ntok / 256};
        pg8::EpiSwi E{WSP(bf16_t, WS_BIG + MO_HID)};
        pg8::gemm_phase<pg8::EpiSwi, pg8::MoeOrder, false>((PG8_LAS unsigned char*)lds, g, S, E, nullptr);
    } else {
        pg8::Gemm g{WSP(const bf16_t, WS_BIG + MO_HID), WSP(const bf16_t, WS_BIG + MO_WDN), 0, 0, 512, nullptr, 0x7fffffff};
        pg8::EpiBfG E{WSP(bf16_t, WS_BIG + MO_CON), 1024, 1024, 3};
        pg8::gemm_phase<pg8::EpiBfG, pg8::MoeOrder, false>((PG8_LAS unsigned char*)lds, g, S, E, nullptr);
    }
    __syncthreads();
}

PHASE_FN void phase_combine(const KP& kp, int layer) {
    const int lane = otid() & 63, wid = otid() >> 6;
    const int ntok = layer == 0 ? NTOK : NLAT;
    const unsigned* cnt = WSP(const unsigned, CTL_CNT) + layer * 16;
    const float* modv = WSP(const float, WS_MODV) + (size_t)layer * 17 * 6144;
    const float* ng = kp.in[6] + (size_t)layer * 4 * 1024 + 3 * 1024;
    const bf16_t* CON = WSP(const bf16_t, WS_BIG + MO_CON);
    const int* TOKE = WSP(const int, WS_TOKE); const int* TOKP = WSP(const int, WS_TOKP); const float* TOKW = WSP(const float, WS_TOKW);
    const int tpre = moe_tile_prefix(cnt, ntok, lane);
    for (int tok = obid() * 8 + wid; tok < ntok; tok += gridDim.x * 8) {
        const int e1 = TOKE[tok * 2], e2 = TOKE[tok * 2 + 1], p1 = TOKP[tok * 2], p2 = TOKP[tok * 2 + 1];
        const float w1 = TOKW[tok * 2], w2 = TOKW[tok * 2 + 1];
        const size_t r1 = (size_t)__shfl(tpre, e1) * 256 + p1, r2 = (size_t)__shfl(tpre, e2) * 256 + p2;
        int b, t;
        if (layer == 0) { b = tok / TT; t = tok - b * TT; } else { b = tok >> 11; t = CTXL + (tok & 2047); }
        float* hp = hrow_wr(kp, b, t);
        const float* mv = modv + (size_t)(t < CTXL ? 16 : b) * 6144 + 5 * 1024;
        f32x4 f[4]; float ss = 0.f;
#pragma unroll
        for (int i = 0; i < 4; ++i) { const int col = i * 256 + lane * 4;
            f[i] = ld4bf(CON + (size_t)tok * 1024 + col) + ld4bf(CON + r1 * 1024 + col) * w1 + ld4bf(CON + r2 * 1024 + col) * w2;
            ss += f[i][0] * f[i][0] + f[i][1] * f[i][1] + f[i][2] * f[i][2] + f[i][3] * f[i][3]; }
        ss = wsum(ss); const float rstd = rsqrtf(ss * (1.0f / 1024.0f) + EPS);
#pragma unroll
        for (int i = 0; i < 4; ++i) { const int col = i * 256 + lane * 4;
            const f32x4 g3 = *(const f32x4*)(ng + col), gf = *(const f32x4*)(mv + col), hx = *(const f32x4*)(hp + col);
            *(f32x4*)(hp + col) = hx + gf * (f[i] * rstd * g3); }
    }
}

template <int CH>
__device__ __forceinline__ int scan_t(int dir, int ci, int j) {
    constexpr int NC_CTX = CTXL / CH;
    if (!dir) return ci * CH + j;
    return ci < NC_CTX ? (CTXL - 1 - ci * CH - j) : (TT - 1 - (ci - NC_CTX) * CH - j);
}

constexpr int ML_LQ = 136, ML_LT = 72;
PHASE_FN void mlstm_unit(const KP& kp, unsigned char* lds, int bl, int h, int dir, int vh) {
    const int tid = otid(), lane = tid & 63, wid = tid >> 6, fr = lane & 15, fq = lane >> 4;
    bf16_t* Qs = (bf16_t*)lds;
    bf16_t* Ks = Qs + 64 * ML_LQ;
    bf16_t* KTE = Ks + 64 * ML_LQ;
    bf16_t* VT = KTE + 128 * ML_LT;
    bf16_t* Ps = VT + 128 * ML_LT;
    bf16_t* Cb = Ps + 64 * ML_LT;
    float* fs = (float*)(Cb + 128 * ML_LQ);
    float* s_rowv = fs;
    float* s_colv = fs + 64;
    float* s_wint = fs + 128;
    float* s_emj = fs + 192;
    float* s_E = fs + 256;
    float* s_den = fs + 320;
    float* s_n = fs + 384;
    float* s_misc = fs + 512;
    const bf16_t* P = WSP(const bf16_t, WS_BIG + L0_P);
    bf16_t* HOUT = WSP(bf16_t, WS_BIG + (dir ? L0_HB : L0_AO)); const int ldh = dir ? 1024 : 2048;
    const float ibias = kp.in[9][dir * 4 + h], fbias = kp.in[10][dir * 4 + h];
    for (int i = tid; i < 128 * ML_LQ; i += 512) Cb[i] = 0;
    if (tid < 128) s_n[tid] = 0.f;
    f32x4 Cacc[8];
#pragma unroll
    for (int i = 0; i < 8; ++i) Cacc[i] = (f32x4){0.f, 0.f, 0.f, 0.f};
    float m_state = 0.f;
    __syncthreads();
    for (int ci = 0; ci < TT / 64; ++ci) {
#pragma unroll
        for (int i = 0; i < 2; ++i) {
            const int p = tid + i * 512, j = p >> 4, c8 = p & 15;
            const size_t row = (size_t)bl * TT + scan_t<64>(dir, ci, j);
            const bf16_t* pr = P + row * AB_N;
            u32x4 q = *(const u32x4*)(pr + AB_Q + h * 128 + c8 * 8);
            const float qs = 0.08838834764831845f;
            q.x = pack2(lo2f(q.x) * qs, hi2f(q.x) * qs); q.y = pack2(lo2f(q.y) * qs, hi2f(q.y) * qs);
            q.z = pack2(lo2f(q.z) * qs, hi2f(q.z) * qs); q.w = pack2(lo2f(q.w) * qs, hi2f(q.w) * qs);
            *(u32x4*)(Qs + j * ML_LQ + c8 * 8) = q;
            *(u32x4*)(Ks + j * ML_LQ + c8 * 8) = *(const u32x4*)(pr + AB_K + h * 128 + c8 * 8);
            const u32x4 v = *(const u32x4*)(pr + AB_V + h * 256 + vh * 128 + c8 * 8);
            bf16_t* vt = VT + (c8 * 8) * ML_LT + j;
            vt[0 * ML_LT] = (bf16_t)(v.x & 0xffff); vt[1 * ML_LT] = (bf16_t)(v.x >> 16); vt[2 * ML_LT] = (bf16_t)(v.y & 0xffff); vt[3 * ML_LT] = (bf16_t)(v.y >> 16);
            vt[4 * ML_LT] = (bf16_t)(v.z & 0xffff); vt[5 * ML_LT] = (bf16_t)(v.z >> 16); vt[6 * ML_LT] = (bf16_t)(v.w & 0xffff); vt[7 * ML_LT] = (bf16_t)(v.w >> 16);
        }
        if (wid == 0) {
            const size_t row = (size_t)bl * TT + scan_t<64>(dir, ci, lane);
            const float ig = bf2f(P[row * AB_N + AB_IG + dir * 4 + h]) + ibias;
            const float lf = logsigmoidf_(bf2f(P[row * AB_N + AB_FG + dir * 4 + h]) + fbias);
            float b = lf;
#pragma unroll
            for (int o = 1; o < 64; o <<= 1) { const float t = __shfl_up(b, o); if (lane >= o) b += t; }
            const float u = ig - b; float pm = u;
#pragma unroll
            for (int o = 1; o < 64; o <<= 1) { const float t = __shfl_up(pm, o); if (lane >= o) pm = fmaxf(pm, t); }
            const float mj = fmaxf(b + m_state, b + pm);
            const float b63 = __shfl(b, 63), pm63 = __shfl(pm, 63);
            const float mnew = fmaxf(b63 + m_state, b63 + pm63);
            s_rowv[lane] = b - mj; s_colv[lane] = u; s_wint[lane] = __expf(b + m_state - mj); s_emj[lane] = __expf(-mj);
            s_E[lane] = __expf(b63 + u - mnew);
            if (lane == 0) { s_misc[0] = mnew; s_misc[1] = __expf(b63 + m_state - mnew); }
        }
        __syncthreads();
        {
            const int jt = wid >> 1;
#pragma unroll
            for (int q2 = 0; q2 < 2; ++q2) {
                const int st = (wid & 1) * 2 + q2;
                f32x4 acc = (f32x4){0.f, 0.f, 0.f, 0.f};
                if (st <= jt) {
#pragma unroll
                    for (int k = 0; k < 4; ++k) acc = mma16(ldfrag(Qs, ML_LQ, jt * 16, k * 32, fr, fq), ldfrag(Ks, ML_LQ, st * 16, k * 32, fr, fq), acc);
                }
                const int s = st * 16 + fr; const float cv = s_colv[s];
#pragma unroll
                for (int r = 0; r < 4; ++r) { const int j = jt * 16 + fq * 4 + r;
                    const float pv = (s <= j) ? acc[r] * __expf(s_rowv[j] + cv) : 0.f;
                    Ps[j * ML_LT + s] = f2bf(pv); }
            }
#pragma unroll
            for (int i = 0; i < 2; ++i) {
                const int p = tid + i * 512, s = p >> 4, c8 = p & 15; const float e = s_E[s];
                const u32x4 kv = *(const u32x4*)(Ks + s * ML_LQ + c8 * 8);
                bf16_t* kt = KTE + (c8 * 8) * ML_LT + s;
                kt[0 * ML_LT] = f2bf(lo2f(kv.x) * e); kt[1 * ML_LT] = f2bf(hi2f(kv.x) * e); kt[2 * ML_LT] = f2bf(lo2f(kv.y) * e); kt[3 * ML_LT] = f2bf(hi2f(kv.y) * e);
                kt[4 * ML_LT] = f2bf(lo2f(kv.z) * e); kt[5 * ML_LT] = f2bf(hi2f(kv.z) * e); kt[6 * ML_LT] = f2bf(lo2f(kv.w) * e); kt[7 * ML_LT] = f2bf(hi2f(kv.w) * e);
            }
        }
        __syncthreads();
        f32x4 a1[4], a2[4];
        {
            const int jt = wid >> 1;
#pragma unroll
            for (int q4 = 0; q4 < 4; ++q4) {
                const int vt = (wid & 1) * 4 + q4;
                a1[q4] = (f32x4){0.f, 0.f, 0.f, 0.f}; a2[q4] = (f32x4){0.f, 0.f, 0.f, 0.f};
#pragma unroll
                for (int k = 0; k < 2; ++k) a1[q4] = mma16(ldfrag(VT, ML_LT, vt * 16, k * 32, fr, fq), ldfrag(Ps, ML_LT, jt * 16, k * 32, fr, fq), a1[q4]);
#pragma unroll
                for (int k = 0; k < 4; ++k) a2[q4] = mma16(ldfrag(Cb, ML_LQ, vt * 16, k * 32, fr, fq), ldfrag(Qs, ML_LQ, jt * 16, k * 32, fr, fq), a2[q4]);
            }
            if (wid == 7) {
                float rs = 0.f, nq = 0.f;
                for (int s = 0; s < 64; ++s) rs += bf2f(Ps[lane * ML_LT + s]);
                for (int d = 0; d < 128; ++d) nq += s_n[d] * bf2f(Qs[lane * ML_LQ + d]);
                const float den = rs + s_wint[lane] * nq;
                s_den[lane] = fmaxf(fabsf(den), s_emj[lane]);
            }
        }
        __syncthreads();
        {
            const int jt = wid >> 1, j = jt * 16 + fr;
            const float wi = s_wint[j], rden = 1.0f / s_den[j];
            const size_t row = (size_t)bl * TT + scan_t<64>(dir, ci, j);
#pragma unroll
            for (int q4 = 0; q4 < 4; ++q4) { const int v0 = ((wid & 1) * 4 + q4) * 16 + fq * 4;
                st4bf(HOUT + row * ldh + h * 256 + vh * 128 + v0, (a1[q4] + a2[q4] * wi) * rden); }
        }
        {
            const float dec = s_misc[1];
            bf16x8 bv0 = ldfrag(VT, ML_LT, wid * 16, 0, fr, fq), bv1 = ldfrag(VT, ML_LT, wid * 16, 32, fr, fq);
#pragma unroll
            for (int dt = 0; dt < 8; ++dt) {
                Cacc[dt] = Cacc[dt] * dec;
                Cacc[dt] = mma16(ldfrag(KTE, ML_LT, dt * 16, 0, fr, fq), bv0, Cacc[dt]);
                Cacc[dt] = mma16(ldfrag(KTE, ML_LT, dt * 16, 32, fr, fq), bv1, Cacc[dt]);
                st4bf(Cb + (wid * 16 + fr) * ML_LQ + dt * 16 + fq * 4, Cacc[dt]);
            }
            if (tid < 128) { float a = 0.f; for (int s = 0; s < 64; ++s) a += bf2f(KTE[tid * ML_LT + s]); s_n[tid] = dec * s_n[tid] + a; }
            m_state = s_misc[0];
        }
        __syncthreads();
    }
}

constexpr int SS_LR = 264, SS_LT = 72;
PHASE_FN void ssd_unit(const KP& kp, unsigned char* lds, int bl, int dir, int hp) {
    const int tid = otid(), lane = tid & 63, wid = tid >> 6, fr = lane & 15, fq = lane >> 4;
    const int gi = hp >> 2, hh0 = hp * 2;
    bf16_t* RAW = (bf16_t*)lds;
    bf16_t* CM = RAW + 68 * SS_LR;
    bf16_t* BM = CM + 64 * SS_LT;
    bf16_t* Wm = BM + 64 * SS_LT;
    bf16_t* XT = Wm + 2 * 64 * SS_LT;
    bf16_t* BTE = XT + 2 * 64 * SS_LT;
    bf16_t* Sb = BTE + 2 * 64 * SS_LT;
    float* fs = (float*)(Sb + 2 * 64 * SS_LT);
    float* s_b = fs;
    float* s_dt = fs + 128;
    float* s_e = fs + 256;
    float* s_misc = fs + 384;
    const bf16_t* P = WSP(const bf16_t, WS_BIG + L0_P);
    bf16_t* YOUT = WSP(bf16_t, WS_BIG + (dir ? L0_YB : L0_AO + 2048)); const int ldy = dir ? 1024 : 2048;
    for (int i = tid; i < 2 * 64 * SS_LT; i += 512) Sb[i] = 0;
    f32x4 Sacc[4];
#pragma unroll
    for (int i = 0; i < 4; ++i) Sacc[i] = (f32x4){0.f, 0.f, 0.f, 0.f};
    const int ch = tid & 255;
    const int xcol = ch < 128 ? hh0 * 64 + ch : (ch < 192 ? 1024 + gi * 64 + (ch - 128) : 1152 + gi * 64 + (ch - 192));
    float cw[5];
#pragma unroll
    for (int q = 0; q < 5; ++q) cw[q] = kp.in[12][q * 1280 + xcol];
    const float cbias = kp.in[13][xcol];
    const int hl_w = wid >> 2;
    const float dtb = kp.in[14][dir * 16 + hh0 + (wid & 1)], aexp = __expf(kp.in[15][dir * 16 + hh0 + (wid & 1)]);
    const float dskip = kp.in[16][hh0 + hl_w];
    __syncthreads();
    for (int ci = 0; ci < TT / 64; ++ci) {
        const int t0 = dir ? scan_t<64>(1, ci, 63) : ci * 64;
        const int lo = t0 < CTXL ? 0 : CTXL, hi = t0 < CTXL ? CTXL : TT;
        for (int p = tid; p < 68 * 32; p += 512) {
            const int rr = p >> 5, c8 = p & 31, t = t0 - 2 + rr;
            u32x4 v = (u32x4){0u, 0u, 0u, 0u};
            if (t >= lo && t < hi) { const int col = c8 < 16 ? hh0 * 64 + c8 * 8 : (c8 < 24 ? 1024 + gi * 64 + (c8 - 16) * 8 : 1152 + gi * 64 + (c8 - 24) * 8);
                v = *(const u32x4*)(P + ((size_t)bl * TT + t) * AB_N + AB_XBC + col); }
            *(u32x4*)(RAW + rr * SS_LR + c8 * 8) = v;
        }
        if (wid < 2) {
            const size_t row = (size_t)bl * TT + scan_t<64>(dir, ci, lane);
            const float dt = softplusf_(bf2f(P[row * AB_N + AB_DT + dir * 16 + hh0 + wid]) + dtb);
            float b = -dt * aexp;
#pragma unroll
            for (int o = 1; o < 64; o <<= 1) { const float t = __shfl_up(b, o); if (lane >= o) b += t; }
            const float b63 = __shfl(b, 63);
            s_b[wid * 64 + lane] = b; s_dt[wid * 64 + lane] = dt; s_e[wid * 64 + lane] = __expf(b63 - b) * dt;
            if (lane == 0) s_misc[wid] = __expf(b63);
        }
        __syncthreads();
        for (int ii = 0; ii < 32; ++ii) {
            const int i = (tid >> 8) + 2 * ii, j = dir ? 63 - i : i;
            float a = cbias;
#pragma unroll
            for (int q = 0; q < 5; ++q) a += cw[q] * bf2f(RAW[(i + q) * SS_LR + ch]);
            const bf16_t o = f2bf(siluf_(a));
            if (ch < 128) XT[((ch >> 6) * 64 + (ch & 63)) * SS_LT + j] = o;
            else if (ch < 192) BM[j * SS_LT + (ch - 128)] = o;
            else CM[j * SS_LT + (ch - 192)] = o;
        }
        __syncthreads();
        {
            const int jt = wid >> 1;
#pragma unroll
            for (int q2 = 0; q2 < 2; ++q2) {
                const int st = (wid & 1) * 2 + q2;
                f32x4 acc = (f32x4){0.f, 0.f, 0.f, 0.f};
                if (st <= jt) {
#pragma unroll
                    for (int k = 0; k < 2; ++k) acc = mma16(ldfrag(CM, SS_LT, jt * 16, k * 32, fr, fq), ldfrag(BM, SS_LT, st * 16, k * 32, fr, fq), acc);
                }
                const int s = st * 16 + fr;
#pragma unroll
                for (int hl = 0; hl < 2; ++hl) { const float bs = s_b[hl * 64 + s], ds = s_dt[hl * 64 + s];
#pragma unroll
                    for (int r = 0; r < 4; ++r) { const int j = jt * 16 + fq * 4 + r;
                        const float wv = (s <= j) ? acc[r] * __expf(s_b[hl * 64 + j] - bs) * ds : 0.f;
                        Wm[(hl * 64 + j) * SS_LT + s] = f2bf(wv); } }
            }
            {
                const int s = tid >> 3, n8 = tid & 7;
                const u32x4 bv = *(const u32x4*)(BM + s * SS_LT + n8 * 8);
#pragma unroll
                for (int hl = 0; hl < 2; ++hl) { const float e = s_e[hl * 64 + s];
                    bf16_t* bt = BTE + (hl * 64 + n8 * 8) * SS_LT + s;
                    bt[0 * SS_LT] = f2bf(lo2f(bv.x) * e); bt[1 * SS_LT] = f2bf(hi2f(bv.x) * e); bt[2 * SS_LT] = f2bf(lo2f(bv.y) * e); bt[3 * SS_LT] = f2bf(hi2f(bv.y) * e);
                    bt[4 * SS_LT] = f2bf(lo2f(bv.z) * e); bt[5 * SS_LT] = f2bf(hi2f(bv.z) * e); bt[6 * SS_LT] = f2bf(lo2f(bv.w) * e); bt[7 * SS_LT] = f2bf(hi2f(bv.w) * e); }
            }
        }
        __syncthreads();
        {
            const int hl = hl_w, jt = wid & 3, j = jt * 16 + fr;
            const bf16_t* Wh = Wm + hl * 64 * SS_LT; const bf16_t* Xh = XT + hl * 64 * SS_LT; const bf16_t* Sh = Sb + hl * 64 * SS_LT;
            const float eb = __expf(s_b[hl * 64 + j]);
            const size_t row = (size_t)bl * TT + scan_t<64>(dir, ci, j);
#pragma unroll
            for (int pt = 0; pt < 4; ++pt) {
                f32x4 y1 = (f32x4){0.f, 0.f, 0.f, 0.f}, y2 = (f32x4){0.f, 0.f, 0.f, 0.f};
#pragma unroll
                for (int k = 0; k < 2; ++k) { y1 = mma16(ldfrag(Xh, SS_LT, pt * 16, k * 32, fr, fq), ldfrag(Wh, SS_LT, jt * 16, k * 32, fr, fq), y1);
                                              y2 = mma16(ldfrag(Sh, SS_LT, pt * 16, k * 32, fr, fq), ldfrag(CM, SS_LT, jt * 16, k * 32, fr, fq), y2); }
                f32x4 y = y1 + y2 * eb;
                if (!dir) {
#pragma unroll
                    for (int r = 0; r < 4; ++r) y[r] += dskip * bf2f(Xh[(pt * 16 + fq * 4 + r) * SS_LT + j]);
                }
                st4bf(YOUT + row * ldy + (hh0 + hl) * 64 + pt * 16 + fq * 4, y);
            }
        }
        __syncthreads();
        {
            const int hl = hl_w, pt = wid & 3; const float eb63 = s_misc[hl];
            const bf16_t* Xh = XT + hl * 64 * SS_LT; const bf16_t* Bh = BTE + hl * 64 * SS_LT; bf16_t* Sh = Sb + hl * 64 * SS_LT;
            bf16x8 x0 = ldfrag(Xh, SS_LT, pt * 16, 0, fr, fq), x1 = ldfrag(Xh, SS_LT, pt * 16, 32, fr, fq);
#pragma unroll
            for (int nt = 0; nt < 4; ++nt) {
                Sacc[nt] = Sacc[nt] * eb63;
                Sacc[nt] = mma16(ldfrag(Bh, SS_LT, nt * 16, 0, fr, fq), x0, Sacc[nt]);
                Sacc[nt] = mma16(ldfrag(Bh, SS_LT, nt * 16, 32, fr, fq), x1, Sacc[nt]);
                st4bf(Sh + (pt * 16 + fr) * SS_LT + nt * 16 + fq * 4, Sacc[nt]);
            }
        }
        __syncthreads();
    }
}

__device__ __forceinline__ void phase_scan_ab(const KP& kp, unsigned char* lds) {
    for (int u = obid(); u < 256; u += gridDim.x) if (u < 128) { mlstm_unit(kp, lds, u >> 4, (u >> 2) & 3, (u >> 1) & 1, u & 1); __syncthreads(); }
    for (int u = obid(); u < 256; u += gridDim.x) if (u >= 128) { const int v = u - 128; ssd_unit(kp, lds, v >> 4, (v >> 3) & 1, v & 7); __syncthreads(); }
}

PHASE_FN void phase_fin_ab(const KP& kp) {
    const int lane = otid() & 63, wid = otid() >> 6;
    const bf16_t* P = WSP(const bf16_t, WS_BIG + L0_P);
    bf16_t* AO = WSP(bf16_t, WS_BIG + L0_AO); const bf16_t* HB = WSP(const bf16_t, WS_BIG + L0_HB); const bf16_t* YB = WSP(const bf16_t, WS_BIG + L0_YB);
    const float* mln = kp.in[11]; const float* sn = kp.in[17];
    for (int lr = obid() * 8 + wid; lr < RG; lr += gridDim.x * 8) {
        const bf16_t* pr = P + (size_t)lr * AB_N;
        f32x4 yz[4]; float ss2 = 0.f;
#pragma unroll
        for (int i = 0; i < 4; ++i) { const int col = i * 256 + lane * 4;
            const f32x4 hs = ld4bf(AO + (size_t)lr * 2048 + col) + ld4bf(HB + (size_t)lr * 1024 + col);
            float ss = hs[0] * hs[0] + hs[1] * hs[1] + hs[2] * hs[2] + hs[3] * hs[3];
            ss = wsum(ss); const float rstd = rsqrtf(ss * (1.0f / 256.0f) + EPS);
            const f32x4 og = ld4bf(pr + AB_OG + col), w = *(const f32x4*)(mln + col);
            f32x4 o;
#pragma unroll
            for (int r = 0; r < 4; ++r) o[r] = hs[r] * rstd * w[r] * sigmoidf_(og[r]);
            st4bf(AO + (size_t)lr * 2048 + col, o);
            const f32x4 ys = ld4bf(AO + (size_t)lr * 2048 + 1024 + col) + ld4bf(YB + (size_t)lr * 1024 + col), z = ld4bf(pr + AB_Z + col);
#pragma unroll
            for (int r = 0; r < 4; ++r) { yz[i][r] = ys[r] * siluf_(z[r]); ss2 += yz[i][r] * yz[i][r]; }
        }
        ss2 = wsum(ss2); const float rstd2 = rsqrtf(ss2 * (1.0f / 1024.0f) + EPS);
#pragma unroll
        for (int i = 0; i < 4; ++i) { const int col = i * 256 + lane * 4; st4bf(AO + (size_t)lr * 2048 + 1024 + col, yz[i] * rstd2 * *(const f32x4*)(sn + col)); }
    }
}

PHASE_FN void phase_gemm_in(const KP& kp, unsigned char* lds, int layer) {
    const int npad = layer == 0 ? AB_NPAD : CD_NPAD, n = layer == 0 ? AB_N : CD_N;
    pg8::Gemm g{WSP(const bf16_t, WS_BIG + (layer == 0 ? L0_U : L1_U)), WSP(const bf16_t, WS_WMIX), RG, npad, 1024, nullptr, 0x7fffffff};
    pg8::StaticOrder S; S.init(RG, npad, (int)gridDim.x, obid());
    pg8::EpiBfG E{WSP(bf16_t, WS_BIG), n, n, 0x7fffffff};
    pg8::gemm_phase<pg8::EpiBfG, pg8::StaticOrder, false>((PG8_LAS unsigned char*)lds, g, S, E, nullptr);
    __syncthreads();
}
PHASE_FN void phase_gemm_out_ab(const KP& kp, unsigned char* lds) {
    pg8::Gemm g{WSP(const bf16_t, WS_BIG + L0_AO), WSP(const bf16_t, WS_WMIX + WM_AB_OUT), RG, 1024, 2048, nullptr, 0x7fffffff};
    pg8::StaticOrder S; S.init(RG, 1024, (int)gridDim.x, obid());
    pg8::EpiBfG E{WSP(bf16_t, WS_BIG + L0_U), 1024, 1024, 0x7fffffff};
    pg8::gemm_phase<pg8::EpiBfG, pg8::StaticOrder, false>((PG8_LAS unsigned char*)lds, g, S, E, nullptr);
    __syncthreads();
}

PHASE_FN void phase_prep_cd(const KP& kp) {
    const int lane = otid() & 63, wid = otid() >> 6;
    bf16_t* P = WSP(bf16_t, WS_BIG + L1_P);
    bf16_t* SG = WSP(bf16_t, WS_SG);
    const float* qn = kp.in[20]; const float* kvn = kp.in[22]; const float* mu = kp.in[24];
    for (int lr = obid() * 8 + wid; lr < RG; lr += gridDim.x * 8) {
        const int bl = lr / TT, t = lr - bl * TT;
        bf16_t* pr = P + (size_t)lr * CD_N;
        {
            const f32x4 x = ld4bf(pr + CD_M1 + lane * 4);
            float ss = x[0] * x[0] + x[1] * x[1] + x[2] * x[2] + x[3] * x[3]; ss = wsum(ss);
            const float rstd = rsqrtf(ss * (1.0f / 256.0f) + EPS);
            st4bf(pr + CD_M1 + lane * 4, x * rstd * *(const f32x4*)(kvn + lane * 4));
        }
        if (t >= CTXL) {
            const int s = t - CTXL;
            float x0[3], x1[3]; float ss = 0.f;
#pragma unroll
            for (int i = 0; i < 3; ++i) { const unsigned w = *(const unsigned*)(pr + CD_M0 + i * 128 + lane * 2); x0[i] = lo2f(w); x1[i] = hi2f(w); ss += x0[i] * x0[i] + x1[i] * x1[i]; }
            ss = wsum(ss); const float rstd = rsqrtf(ss * (1.0f / 384.0f) + EPS);
#pragma unroll
            for (int i = 0; i < 3; ++i) { const int c = i * 128 + lane * 2; *(unsigned*)(pr + CD_M0 + c) = pack2(x0[i] * rstd * qn[c], x1[i] * rstd * qn[c + 1]); }
            if (lane < 16) {
                const float pos = (lane < 8) ? (float)(s >> 6) : (float)(s & 63);
                const float inv = __expf(-(float)(lane & 7) * (9.210340371976184f / 8.0f));
                float sn, cs; sincosf(pos * inv, &sn, &cs);
                const float a = bf2f(pr[CD_KR + lane]), b2 = bf2f(pr[CD_KR + 16 + lane]);
                pr[CD_KR + lane] = f2bf(a * cs - b2 * sn); pr[CD_KR + 16 + lane] = f2bf(a * sn + b2 * cs);
            }
            {
                const int c = lane * 2;
                const unsigned w = *(const unsigned*)(pr + CD_GL + c);
                const unsigned wp = s > 0 ? *(const unsigned*)(pr - CD_N + CD_GL + c) : 0u;
                const unsigned wn = s < SEQ - 1 ? *(const unsigned*)(pr + CD_N + CD_GL + c) : 0u;
                const float m0 = mu[CD_GL - CD_RW0 + c], m1 = mu[CD_GL - CD_RW0 + c + 1];
                const float g0 = lo2f(w) + m0 * (0.5f * (lo2f(wp) + lo2f(wn)) - lo2f(w));
                const float g1 = hi2f(w) + m1 * (0.5f * (hi2f(wp) + hi2f(wn)) - hi2f(w));
                *(unsigned*)(SG + ((size_t)bl * SEQ + s) * 128 + c) = pack2(sigmoidf_(g0), sigmoidf_(g1));
            }
        }
    }
}

PHASE_FN void phase_upproj(const KP& kp, unsigned char* lds) {
    const bf16_t* P = WSP(const bf16_t, WS_BIG + L1_P);
    const int nq = (RGL / 256) * 6, nkv = (RG / 256) * 8;
    for (int u = obid(); u < nq + nkv; u += gridDim.x) {
        if (u < nq) {
            GA ga{P + CD_M0, nullptr, CD_N, 0, 384, nullptr, RGL, 1, 0};
            EpiBf ep{WSP(bf16_t, WS_BIG + L1_Q), 768, RGL, 768};
            gemm_tile(lds, ga, WSP(const bf16_t, WS_WMIX + WM_UQ), 384, u / 6, u % 6, ep);
        } else { const int v = u - nq;
            GA ga{P + CD_M1, nullptr, CD_N, 0, 256, nullptr, RG, 0, 0};
            EpiBf ep{WSP(bf16_t, WS_BIG + L1_KV), 1024, RG, 1024};
            gemm_tile(lds, ga, WSP(const bf16_t, WS_WMIX + WM_UKV), 256, v >> 3, v & 7, ep);
        }
    }
}

constexpr int AT_LQ = 104, AT_LV = 72;
PHASE_FN void attn_unit(const KP& kp, unsigned char* lds, int bl, int head, int qb) {
    const int tid = otid(), lane = tid & 63, wid = tid >> 6, fr = lane & 15, fq = lane >> 4;
    bf16_t* Qs = (bf16_t*)lds;
    bf16_t* Kt = Qs + 128 * AT_LQ;
    bf16_t* Vt = Kt + 64 * AT_LQ;
    const bf16_t* P = WSP(const bf16_t, WS_BIG + L1_P);
    const bf16_t* Q = WSP(const bf16_t, WS_BIG + L1_Q);
    const bf16_t* KV = WSP(const bf16_t, WS_BIG + L1_KV);
    bf16_t* AOUT = WSP(bf16_t, WS_BIG + L1_AOUT);
    const float SC = 0.10206207261596577f;
#pragma unroll
    for (int i = 0; i < 3; ++i) { const int p = tid + i * 512, r = p / 12, c = p % 12;
        *(u32x4*)(Qs + r * AT_LQ + c * 8) = *(const u32x4*)(Q + ((size_t)bl * SEQ + qb * 128 + r) * 768 + head * 96 + c * 8); }
    __syncthreads();
#pragma unroll
    for (int i = 0; i < 4; ++i) { const int p = tid + i * 512, r = p >> 4, f = p & 15, s = qb * 128 + r;
        const float pos = (f < 8) ? (float)(s >> 6) : (float)(s & 63);
        const float inv = __expf(-(float)(f & 7) * (9.210340371976184f / 8.0f));
        float sn, cs; sincosf(pos * inv, &sn, &cs);
        const float a = bf2f(Qs[r * AT_LQ + 64 + f]), b2 = bf2f(Qs[r * AT_LQ + 80 + f]);
        Qs[r * AT_LQ + 64 + f] = f2bf(a * cs - b2 * sn); Qs[r * AT_LQ + 80 + f] = f2bf(a * sn + b2 * cs); }
    __syncthreads();
    bf16x8 qf[3];
#pragma unroll
    for (int k = 0; k < 3; ++k) qf[k] = ldfrag(Qs, AT_LQ, wid * 16, k * 32, fr, fq);
    f32x4 ot[4];
#pragma unroll
    for (int i = 0; i < 4; ++i) ot[i] = (f32x4){0.f, 0.f, 0.f, 0.f};
    float mrow = -1e30f, lsum = 0.f;
    for (int kt = 0; kt < TT / 64; ++kt) {
        __syncthreads();
#pragma unroll
        for (int i = 0; i < 2; ++i) { const int p = tid + i * 512;
            if (p < 768) { const int key = p / 12, c = p % 12; const size_t row = (size_t)bl * TT + kt * 64 + key;
                const u32x4 v = c < 8 ? *(const u32x4*)(KV + row * 1024 + head * 128 + c * 8) : *(const u32x4*)(P + row * CD_N + CD_KR + (c - 8) * 8);
                *(u32x4*)(Kt + key * AT_LQ + c * 8) = v; } }
        { const int key = tid >> 3, c8 = tid & 7; const size_t row = (size_t)bl * TT + kt * 64 + key;
            const u32x4 v = *(const u32x4*)(KV + row * 1024 + head * 128 + 64 + c8 * 8);
            bf16_t* vt = Vt + (c8 * 8) * AT_LV + key;
            vt[0 * AT_LV] = (bf16_t)(v.x & 0xffff); vt[1 * AT_LV] = (bf16_t)(v.x >> 16); vt[2 * AT_LV] = (bf16_t)(v.y & 0xffff); vt[3 * AT_LV] = (bf16_t)(v.y >> 16);
            vt[4 * AT_LV] = (bf16_t)(v.z & 0xffff); vt[5 * AT_LV] = (bf16_t)(v.z >> 16); vt[6 * AT_LV] = (bf16_t)(v.w & 0xffff); vt[7 * AT_LV] = (bf16_t)(v.w >> 16); }
        __syncthreads();
        f32x4 st[4];
        float mx = -1e30f;
#pragma unroll
        for (int kk = 0; kk < 4; ++kk) { st[kk] = (f32x4){0.f, 0.f, 0.f, 0.f};
#pragma unroll
            for (int k = 0; k < 3; ++k) st[kk] = mma16(ldfrag(Kt, AT_LQ, kk * 16, k * 32, fr, fq), qf[k], st[kk]);
            mx = fmaxf(mx, fmaxf(fmaxf(st[kk][0], st[kk][1]), fmaxf(st[kk][2], st[kk][3]))); }
        mx = fmaxf(mx, __shfl_xor(mx, 16)); mx = fmaxf(mx, __shfl_xor(mx, 32));
        const float mnew = fmaxf(mrow, mx), alpha = __expf(SC * (mrow - mnew));
        mrow = mnew; lsum *= alpha;
#pragma unroll
        for (int i = 0; i < 4; ++i) ot[i] = ot[i] * alpha;
#pragma unroll
        for (int kk = 0; kk < 4; ++kk)
#pragma unroll
            for (int r = 0; r < 4; ++r) { const float pv = __expf(SC * (st[kk][r] - mnew)); st[kk][r] = pv; lsum += pv; }
#pragma unroll
        for (int k2 = 0; k2 < 2; ++k2) {
            union { bf16x8 v; unsigned u[4]; } pb;
            pb.u[0] = pack2(st[2 * k2][0], st[2 * k2][1]); pb.u[1] = pack2(st[2 * k2][2], st[2 * k2][3]);
            pb.u[2] = pack2(st[2 * k2 + 1][0], st[2 * k2 + 1][1]); pb.u[3] = pack2(st[2 * k2 + 1][2], st[2 * k2 + 1][3]);
#pragma unroll
            for (int dvt = 0; dvt < 4; ++dvt) {
                union { bf16x8 v; u32x2 h[2]; } va;
                const bf16_t* vp = Vt + (dvt * 16 + fr) * AT_LV + k2 * 32 + fq * 4;
                va.h[0] = *(const u32x2*)vp; va.h[1] = *(const u32x2*)(vp + 16);
                ot[dvt] = mma16(va.v, pb.v, ot[dvt]);
            }
        }
    }
    lsum += __shfl_xor(lsum, 16); lsum += __shfl_xor(lsum, 32);
    const float rl = 1.0f / lsum;
    const size_t orow = (size_t)bl * SEQ + qb * 128 + wid * 16 + fr;
#pragma unroll
    for (int dvt = 0; dvt < 4; ++dvt) st4bf(AOUT + orow * 1536 + head * 64 + dvt * 16 + fq * 4, ot[dvt] * rl);
}

constexpr int RW_LR = 328, RW_LP = 72;
PHASE_FN void rwkv_unit(const KP& kp, unsigned char* lds, int bl, int h, int dir) {
    const int tid = otid();
    bf16_t* RAW = (bf16_t*)lds;
    bf16_t* TWb = RAW + 34 * RW_LR;
    bf16_t* ALb = TWb + 32 * RW_LP;
    bf16_t* W2T = ALb + 32 * RW_LP;
    bf16_t* A2T = W2T + 64 * RW_LP;
    float* CL = (float*)(A2T + 64 * RW_LP);
    bf16_t* AR = (bf16_t*)(CL + 32 * 64);
    bf16_t* BK = AR + 64 * RW_LP;
    float* AAB = (float*)(BK + 64 * RW_LP);
    bf16_t* ARB = (bf16_t*)(AAB + 32 * 36);
    bf16_t* AAK = ARB + 32 * 40;
    bf16_t* ARK = AAK + 32 * 40;
    float* RHS = (float*)(ARK + 32 * 40);
    float* YB = RHS + 32 * 64;
    bf16_t* ZVT = (bf16_t*)(YB + 32 * 64);
    bf16_t* BKh = ZVT + 64 * RW_LP;
    bf16_t* Sb = BKh + 64 * RW_LP;
    float* PL = (float*)(Sb + 64 * RW_LP);
    const bf16_t* P = WSP(const bf16_t, WS_BIG + L1_P);
    bf16_t* OUT = WSP(bf16_t, WS_BIG + (dir ? L1_OB : L1_OF));
    float* BSC = WSP(float, WS_BSC) + (size_t)dir * RGL * 16;
    const float* mu = kp.in[24];
    for (int i = tid; i < 64 * 64; i += 512) { const int c = i >> 6, n = i & 63;
        W2T[n * RW_LP + c] = f2bf(kp.in[26][((size_t)dir * 64 + c) * 1024 + h * 64 + n]); A2T[n * RW_LP + c] = f2bf(kp.in[28][((size_t)dir * 64 + c) * 1024 + h * 64 + n]); }
    for (int i = tid; i < 64 * RW_LP; i += 512) Sb[i] = 0;
    const int n4o = (tid & 15) * 4;
    const f32x4 w0v = *(const f32x4*)(kp.in[25] + dir * 1024 + h * 64 + n4o), a0v = *(const f32x4*)(kp.in[27] + dir * 1024 + h * 64 + n4o);
    const f32x4 kkw = *(const f32x4*)(kp.in[30] + h * 64 + n4o), kaw = *(const f32x4*)(kp.in[31] + h * 64 + n4o), rkw = *(const f32x4*)(kp.in[32] + h * 64 + n4o);
    const f32x4 mur = *(const f32x4*)(mu + h * 64 + n4o), muk = *(const f32x4*)(mu + 1024 + h * 64 + n4o), muv = *(const f32x4*)(mu + 2048 + h * 64 + n4o);
    f32x4 Sacc[2];
    Sacc[0] = (f32x4){0.f, 0.f, 0.f, 0.f}; Sacc[1] = (f32x4){0.f, 0.f, 0.f, 0.f};
    u32x4 pf[3];
#define RW_PREFETCH(cn) do { const int t0n_ = dir ? scan_t<32>(1, (cn), 31) : (cn) * 32; const int lo_ = t0n_ < CTXL ? 0 : CTXL, hi_ = t0n_ < CTXL ? CTXL : TT; \
        _Pragma("unroll") for (int q = 0; q < 3; ++q) { const int p = tid + q * 512; pf[q] = (u32x4){0u, 0u, 0u, 0u}; \
            if (p < 34 * 40) { const int rr = p / 40, c = p % 40, t = t0n_ - 1 + rr; \
                if (t >= lo_ && t < hi_) { const int seg = c >> 3, c8 = c & 7; \
                    const int col = seg == 0 ? CD_R + h * 64 : seg == 1 ? CD_K + h * 64 : seg == 2 ? CD_V + h * 64 : seg == 3 ? CD_WL + dir * 64 : CD_AL + dir * 64; \
                    pf[q] = *(const u32x4*)(P + ((size_t)bl * TT + t) * CD_N + col + c8 * 8); } } } } while (0)
    RW_PREFETCH(0);
    __syncthreads();
    for (int ci = 0; ci < TT / 32; ++ci) {
        int tq = tid; asm volatile("" : "+v"(tq));
        const int lane = tq & 63, wid = tq >> 6, fr = lane & 15, fq = lane >> 4, pi = tq >> 4, n4 = (tq & 15) * 4;
        const int t0 = dir ? scan_t<32>(1, ci, 31) : ci * 32;
#pragma unroll
        for (int q = 0; q < 3; ++q) { const int p = tq + q * 512; if (p < 34 * 40) *(u32x4*)(RAW + (p / 40) * RW_LR + (p % 40) * 8) = pf[q]; }
        if (ci + 1 < TT / 32) RW_PREFETCH(ci + 1);
        __syncthreads();
#pragma unroll
        for (int q = 0; q < 8; ++q) { const int idx = tq + q * 512, which = idx >> 11, i = (idx >> 6) & 31, c = idx & 63;
            const int rc = 192 + which * 64 + c;
            const float x = bf2f(RAW[(i + 1) * RW_LR + rc]), xp = bf2f(RAW[i * RW_LR + rc]), xn = bf2f(RAW[(i + 2) * RW_LR + rc]);
            const float m = mu[(which ? 3200 : 3072) + dir * 64 + c];
            const float l = x + m * (0.5f * (xp + xn) - x);
            if (which) ALb[i * RW_LP + c] = f2bf(l); else TWb[i * RW_LP + c] = f2bf(tanhf(l)); }
        __syncthreads();
        {
            const int which = wid >> 2, tt = (wid >> 1) & 1;
            const bf16_t* Xa = which ? ALb : TWb; const bf16_t* Wt = which ? A2T : W2T; float* Od = which ? YB : RHS;
#pragma unroll
            for (int q2 = 0; q2 < 2; ++q2) { const int nt = (wid & 1) * 2 + q2;
                f32x4 acc = (f32x4){0.f, 0.f, 0.f, 0.f};
#pragma unroll
                for (int k = 0; k < 2; ++k) acc = mma16(ldfrag(Xa, RW_LP, tt * 16, k * 32, fr, fq), ldfrag(Wt, RW_LP, nt * 16, k * 32, fr, fq), acc);
#pragma unroll
                for (int rr = 0; rr < 4; ++rr) Od[(tt * 16 + fq * 4 + rr) * 64 + nt * 16 + fr] = acc[rr]; }
        }
        __syncthreads();
        const int j = dir ? 31 - pi : pi;
        f32x4 r, kd, v, av, bv;
        {
            const f32x4 wl = w0v + *(const f32x4*)(RHS + pi * 64 + n4), al = a0v + *(const f32x4*)(YB + pi * 64 + n4);
            const bf16_t* r1 = RAW + (pi + 1) * RW_LR; const bf16_t* rp = RAW + pi * RW_LR; const bf16_t* rn = RAW + (pi + 2) * RW_LR;
            f32x4 k;
            r = ld4bf(r1 + n4); k = ld4bf(r1 + 64 + n4); v = ld4bf(r1 + 128 + n4);
            r = r + mur * ((ld4bf(rp + n4) + ld4bf(rn + n4)) * 0.5f - r);
            k = k + muk * ((ld4bf(rp + 64 + n4) + ld4bf(rn + 64 + n4)) * 0.5f - k);
            v = v + muv * ((ld4bf(rp + 128 + n4) + ld4bf(rn + 128 + n4)) * 0.5f - v);
            f32x4 a, lw, kk = k * kkw;
            float ssq = kk[0] * kk[0] + kk[1] * kk[1] + kk[2] * kk[2] + kk[3] * kk[3];
            ssq += __shfl_xor(ssq, 1); ssq += __shfl_xor(ssq, 2); ssq += __shfl_xor(ssq, 4); ssq += __shfl_xor(ssq, 8);
            kk = kk * (1.0f / fmaxf(sqrtf(ssq), 1e-12f));
#pragma unroll
            for (int q = 0; q < 4; ++q) { const float wlog = -softplusf_(-wl[q]) - 0.5f; lw[q] = -__expf(wlog); a[q] = sigmoidf_(al[q]); }
            kd = k * ((a - 1.0f) * kaw + 1.0f);
            float bs = r[0] * kd[0] * rkw[0] + r[1] * kd[1] * rkw[1] + r[2] * kd[2] * rkw[2] + r[3] * kd[3] * rkw[3];
            bs += __shfl_xor(bs, 1); bs += __shfl_xor(bs, 2); bs += __shfl_xor(bs, 4); bs += __shfl_xor(bs, 8);
            av = kk * -1.0f; bv = kk * a;
            *(f32x4*)(CL + j * 64 + n4) = lw;
            const int t = t0 + pi;
            if (t >= CTXL && (tq & 15) == 0) BSC[((size_t)bl * SEQ + (t - CTXL)) * 16 + h] = bs;
        }
        __syncthreads();
        if (wid == 0) {
            float c[32];
#pragma unroll
            for (int q = 0; q < 32; ++q) c[q] = CL[q * 64 + lane];
#pragma unroll
            for (int q = 1; q < 32; ++q) c[q] += c[q - 1];
#pragma unroll
            for (int q = 0; q < 32; ++q) CL[q * 64 + lane] = c[q];
            PL[lane] = __expf(c[31]);
        }
        __syncthreads();
        {
            const f32x4 clj = *(const f32x4*)(CL + j * 64 + n4), cle = *(const f32x4*)(CL + 31 * 64 + n4);
            f32x4 clp = (f32x4){0.f, 0.f, 0.f, 0.f};
            if (j > 0) clp = *(const f32x4*)(CL + (j - 1) * 64 + n4);
            f32x4 at, rt, bt, kt, bh, kh;
#pragma unroll
            for (int q = 0; q < 4; ++q) { const float ep = __expf(clp[q]), ej = __expf(clj[q]), ei = __expf(-clj[q]), ee = __expf(cle[q] - clj[q]);
                at[q] = av[q] * ep; rt[q] = r[q] * ej; bt[q] = bv[q] * ei; kt[q] = kd[q] * ei; bh[q] = bv[q] * ee; kh[q] = kd[q] * ee; }
            st4bf(AR + j * RW_LP + n4, at); st4bf(AR + (32 + j) * RW_LP + n4, rt);
            st4bf(BK + j * RW_LP + n4, bt); st4bf(BK + (32 + j) * RW_LP + n4, kt);
#pragma unroll
            for (int q = 0; q < 4; ++q) { BKh[(n4 + q) * RW_LP + j] = f2bf(bh[q]); BKh[(n4 + q) * RW_LP + 32 + j] = f2bf(kh[q]); ZVT[(n4 + q) * RW_LP + 32 + j] = f2bf(v[q]); }
        }
        __syncthreads();
        {
            const int ti = wid >> 1;
#pragma unroll
            for (int q2 = 0; q2 < 2; ++q2) {
                const int si = (wid & 1) * 2 + q2;
                f32x4 acc = (f32x4){0.f, 0.f, 0.f, 0.f};
#pragma unroll
                for (int k = 0; k < 2; ++k) acc = mma16(ldfrag(AR, RW_LP, ti * 16, k * 32, fr, fq), ldfrag(BK, RW_LP, si * 16, k * 32, fr, fq), acc);
                const int sp = si * 16 + fr, s = sp & 31;
#pragma unroll
                for (int rr = 0; rr < 4; ++rr) { const int tp = ti * 16 + fq * 4 + rr, t = tp & 31;
                    const bool incl = tp >= 32;
                    const float val = (incl ? (s <= t) : (s < t)) ? acc[rr] : 0.f;
                    if (sp < 32) { if (incl) ARB[t * 40 + s] = f2bf(val); else AAB[t * 36 + s] = val; }
                    else { (incl ? ARK : AAK)[t * 40 + s] = f2bf(val); } }
            }
        }
        __syncthreads();
        {
            const int which = wid >> 2, tt = (wid >> 1) & 1;
            const bf16_t* Ak = which ? ARK : AAK; float* Od = which ? YB : RHS;
#pragma unroll
            for (int q2 = 0; q2 < 2; ++q2) {
                const int vt = (wid & 1) * 2 + q2;
                f32x4 acc = (f32x4){0.f, 0.f, 0.f, 0.f};
#pragma unroll
                for (int k = 0; k < 2; ++k) acc = mma16(ldfrag(AR, RW_LP, which * 32 + tt * 16, k * 32, fr, fq), ldfrag(Sb, RW_LP, vt * 16, k * 32, fr, fq), acc);
                acc = mma16(ldfrag(Ak, 40, tt * 16, 0, fr, fq), ldfrag(ZVT, RW_LP, vt * 16, 32, fr, fq), acc);
#pragma unroll
                for (int rr = 0; rr < 4; ++rr) Od[(tt * 16 + fq * 4 + rr) * 64 + vt * 16 + fr] = acc[rr];
            }
        }
        __syncthreads();
        if (wid == 0) {
            float z[32];
            f32x4 cur[8], nxt[4];
            z[0] = RHS[lane];
            cur[0] = *(const f32x4*)(AAB + 1 * 36);
#pragma unroll
            for (int t = 1; t < 32; ++t) {
                float p0 = RHS[t * 64 + lane], p1 = 0.f, p2 = 0.f, p3 = 0.f;
#pragma unroll
                for (int q4 = 4; q4 < 8; ++q4) if (q4 * 4 < t) cur[q4] = *(const f32x4*)(AAB + t * 36 + q4 * 4);
                if (t + 1 < 32) {
#pragma unroll
                    for (int q4 = 0; q4 < 4; ++q4) if (q4 * 4 < t + 1) nxt[q4] = *(const f32x4*)(AAB + (t + 1) * 36 + q4 * 4);
                }
#pragma unroll
                for (int q4 = 0; q4 < 8; ++q4) {
                    if (q4 * 4 + 0 < t) p0 += cur[q4][0] * z[q4 * 4 + 0];
                    if (q4 * 4 + 1 < t) p1 += cur[q4][1] * z[q4 * 4 + 1];
                    if (q4 * 4 + 2 < t) p2 += cur[q4][2] * z[q4 * 4 + 2];
                    if (q4 * 4 + 3 < t) p3 += cur[q4][3] * z[q4 * 4 + 3];
                }
                float zt = (p0 + p1) + (p2 + p3);
                asm volatile("" : "+v"(zt) :: "memory");
                z[t] = zt;
#pragma unroll
                for (int q4 = 0; q4 < 4; ++q4) if (q4 * 4 < t + 1) cur[q4] = nxt[q4];
            }
#pragma unroll
            for (int q = 0; q < 4; ++q) { u32x4 w;
                w.x = pack2(z[q * 8 + 0], z[q * 8 + 1]); w.y = pack2(z[q * 8 + 2], z[q * 8 + 3]); w.z = pack2(z[q * 8 + 4], z[q * 8 + 5]); w.w = pack2(z[q * 8 + 6], z[q * 8 + 7]);
                *(u32x4*)(ZVT + lane * RW_LP + q * 8) = w; }
        }
        __syncthreads();
        {
            const int nt = wid >> 1;
            const f32x4 pl = *(const f32x4*)(PL + nt * 16 + fq * 4);
#pragma unroll
            for (int q2 = 0; q2 < 2; ++q2) {
                const int vt = (wid & 1) * 2 + q2;
                Sacc[q2] = Sacc[q2] * pl;
#pragma unroll
                for (int k = 0; k < 2; ++k) Sacc[q2] = mma16(ldfrag(BKh, RW_LP, nt * 16, k * 32, fr, fq), ldfrag(ZVT, RW_LP, vt * 16, k * 32, fr, fq), Sacc[q2]);
                st4bf(Sb + (vt * 16 + fr) * RW_LP + nt * 16 + fq * 4, Sacc[q2]);
            }
        }
        if (t0 >= CTXL) {
            const int vt = wid >> 1, tt = wid & 1;
            f32x4 acc = (f32x4){0.f, 0.f, 0.f, 0.f};
            acc = mma16(ldfrag(ZVT, RW_LP, vt * 16, 0, fr, fq), ldfrag(ARB, 40, tt * 16, 0, fr, fq), acc);
            const int t = tt * 16 + fr, v0 = vt * 16 + fq * 4;
#pragma unroll
            for (int rr = 0; rr < 4; ++rr) acc[rr] += YB[t * 64 + v0 + rr];
            const int tn = scan_t<32>(dir, ci, t);
            st4bf(OUT + ((size_t)bl * SEQ + (tn - CTXL)) * 1024 + h * 64 + v0, acc);
        }
        __syncthreads();
    }
#undef RW_PREFETCH
}

__device__ __forceinline__ void phase_mix_cd(const KP& kp, unsigned char* lds, int which) {
    if (which & 1) for (int u = obid(); u < 256; u += gridDim.x) { rwkv_unit(kp, lds, u >> 5, (u >> 1) & 15, u & 1); __syncthreads(); }
    if (which & 2) for (int u = obid(); u < 1024; u += gridDim.x) { attn_unit(kp, lds, u >> 7, (u >> 4) & 7, u & 15); __syncthreads(); }
}

struct EpiFinCD {
    const bf16_t* OF; const bf16_t* OB; const bf16_t* P; const float* BSC; const float* ln; const float* mu; bf16_t* AOUT;
    __device__ __forceinline__ void operator()(const f32x4 (&acc)[4][4], int rb, int cb, int fr, int fq) const {
        const int head = cb >> 6;
#pragma unroll
        for (int i = 0; i < 4; ++i) { const int lr = rb + i * 16 + fr, s = lr & 2047;
            const size_t prow = (size_t)(lr >> 11) * TT + CTXL + s;
            f32x4 o[4]; float ss = 0.f;
#pragma unroll
            for (int j = 0; j < 4; ++j) { const int col = cb + j * 16 + fq * 4;
                o[j] = ld4bf(OF + (size_t)lr * 1024 + col) + ld4bf(OB + (size_t)lr * 1024 + col);
                ss += o[j][0] * o[j][0] + o[j][1] * o[j][1] + o[j][2] * o[j][2] + o[j][3] * o[j][3]; }
            ss += __shfl_xor(ss, 16); ss += __shfl_xor(ss, 32);
            const float rstd = rsqrtf(ss * (1.0f / 64.0f) + EPS);
            const float bon = BSC[(size_t)lr * 16 + head] + BSC[(size_t)RGL * 16 + (size_t)lr * 16 + head];
#pragma unroll
            for (int j = 0; j < 4; ++j) { const int col = cb + j * 16 + fq * 4;
                const bf16_t* pv = P + prow * CD_N + CD_V + col;
                const f32x4 v = ld4bf(pv);
                const f32x4 vp = s > 0 ? ld4bf(pv - CD_N) : (f32x4){0.f, 0.f, 0.f, 0.f};
                const f32x4 vn = s < SEQ - 1 ? ld4bf(pv + CD_N) : (f32x4){0.f, 0.f, 0.f, 0.f};
                const f32x4 vl = v + *(const f32x4*)(mu + 2048 + col) * ((vp + vn) * 0.5f - v);
                const f32x4 y = o[j] * rstd * *(const f32x4*)(ln + col) + vl * bon;
                st4bf(AOUT + (size_t)lr * 1536 + 512 + col, y * acc[i][j]); }
        }
    }
};
PHASE_FN void phase_fin_cd(const KP& kp, unsigned char* lds) {
    GA ga{WSP(const bf16_t, WS_SG), nullptr, 128, 0, 128, nullptr, RGL, 0, 0};
    EpiFinCD ep{WSP(const bf16_t, WS_BIG + L1_OF), WSP(const bf16_t, WS_BIG + L1_OB), WSP(const bf16_t, WS_BIG + L1_P), WSP(const float, WS_BSC), kp.in[33], kp.in[24], WSP(bf16_t, WS_BIG + L1_AOUT)};
    for (int u = obid(); u < (RGL / 256) * 8; u += gridDim.x) gemm_tile(lds, ga, WSP(const bf16_t, WS_WMIX + WM_G2), 128, u >> 3, u & 7, ep);
}
PHASE_FN void phase_gemm_out_cd(const KP& kp, unsigned char* lds) {
    pg8::Gemm g{WSP(const bf16_t, WS_BIG + L1_AOUT), WSP(const bf16_t, WS_WMIX + WM_CD_OUT), RGL, 1024, 1536, nullptr, 0x7fffffff};
    pg8::StaticOrder S; S.init(RGL, 1024, (int)gridDim.x, obid());
    pg8::EpiBfG E{WSP(bf16_t, WS_BIG + L1_U), 1024, 1024, 0x7fffffff};
    pg8::gemm_phase<pg8::EpiBfG, pg8::StaticOrder, false>((PG8_LAS unsigned char*)lds, g, S, E, nullptr);
    __syncthreads();
}

__device__ __attribute__((noinline)) void grid_sync(unsigned* barw, unsigned x, volatile LAS unsigned* st) { XcdBarrier b; b.bar = barw; b.x = x; b.st = st; xcd_barrier(b); }
constexpr int N_PHASES = 37;
__global__ void __launch_bounds__(512, 2) fwd_kernel(KP kparg) {
    extern __shared__ __attribute__((aligned(16))) unsigned char lds[];
    const int lo = kparg.ph_lo, hi = kparg.ph_hi;
    KP* skp = (KP*)(lds + LDS_BYTES - 1024);
    if (threadIdx.x == 0) {
#pragma unroll
        for (int i = 0; i < 42; ++i) skp->in[i] = kparg.in[i];
        skp->out = kparg.out; skp->ws = kparg.ws; skp->ph_lo = lo; skp->ph_hi = hi; }
    const KP& kp = *skp;
    volatile LAS unsigned* xbst = (volatile LAS unsigned*)(LAS unsigned char*)(lds + LDS_BYTES - 16);
    if (threadIdx.x == 0) { xbst[0] = 0u; xbst[1] = 0u; }
    __syncthreads();
    XcdBarrier bar; bar.bar = (unsigned*)kparg.ws; bar.x = 0; bar.st = xbst;
    if (hi - lo > 1) bar = xcd_barrier_post((unsigned*)kparg.ws, xbst);
#define IN(k) (lo <= (k) && (k) < hi)
#define SEAM(k) do { if (IN(k) && IN((k) + 1)) grid_sync((unsigned*)kp.ws, bar.x, xbst); } while (0)
    if (IN(0)) { phase_mod(kp, lds); __syncthreads(); phase_conv_ab(kp, lds); if (PROBE_DUP & 32) { __syncthreads(); phase_mod(kp, lds); __syncthreads(); phase_conv_ab(kp, lds); } }
    SEAM(0);
    for (int g = 0; g < NG; ++g) {
        const int pb = 1 + g * 6;
        if (IN(pb + 0)) { phase_u(kp, 0, g); if (PROBE_DUP & 128) phase_u(kp, 0, g); }
        SEAM(pb + 0);
        if (IN(pb + 1)) { phase_gemm_in(kp, lds, 0); if (PROBE_DUP & 8) phase_gemm_in(kp, lds, 0); }
        SEAM(pb + 1);
        if (IN(pb + 2)) { phase_scan_ab(kp, lds); if (PROBE_DUP & 1) { __syncthreads(); phase_scan_ab(kp, lds); } }
        SEAM(pb + 2);
        if (IN(pb + 3)) phase_fin_ab(kp);
        SEAM(pb + 3);
        if (IN(pb + 4)) { phase_gemm_out_ab(kp, lds); if (PROBE_DUP & 256) phase_gemm_out_ab(kp, lds); }
        SEAM(pb + 4);
        if (IN(pb + 5)) phase_r(kp, lds, 0, g);
        SEAM(pb + 5);
    }
    if (IN(13)) { phase_moe_gather(kp, 0); phase_conv_moe(kp, lds, 0); phase_conv_cd(kp, lds); if (PROBE_DUP & 64) { phase_conv_moe(kp, lds, 0); phase_conv_cd(kp, lds); } }
    SEAM(13);
    if (IN(14)) { phase_moe_gemm(kp, lds, 0, false); if (PROBE_DUP & 16) { __syncthreads(); phase_moe_gemm(kp, lds, 0, false); } }
    SEAM(14);
    if (IN(15)) { phase_moe_gemm(kp, lds, 0, true); if (PROBE_DUP & 16) { __syncthreads(); phase_moe_gemm(kp, lds, 0, true); } }
    SEAM(15);
    if (IN(16)) phase_combine(kp, 0);
    SEAM(16);
    for (int g = 0; g < NG; ++g) {
        const int pb = 17 + g * 8;
        if (IN(pb + 0)) { phase_u(kp, 1, g); if (PROBE_DUP & 128) phase_u(kp, 1, g); }
        SEAM(pb + 0);
        if (IN(pb + 1)) { phase_gemm_in(kp, lds, 1); if (PROBE_DUP & 8) phase_gemm_in(kp, lds, 1); }
        SEAM(pb + 1);
        if (IN(pb + 2)) phase_prep_cd(kp);
        SEAM(pb + 2);
        if (IN(pb + 3)) { phase_upproj(kp, lds); if (PROBE_DUP & 256) phase_upproj(kp, lds); }
        SEAM(pb + 3);
        if (IN(pb + 4)) { phase_mix_cd(kp, lds, 3); if (PROBE_DUP & 2) { __syncthreads(); phase_mix_cd(kp, lds, 1); } if (PROBE_DUP & 4) { __syncthreads(); phase_mix_cd(kp, lds, 2); } }
        SEAM(pb + 4);
        if (IN(pb + 5)) { phase_fin_cd(kp, lds); if (PROBE_DUP & 256) phase_fin_cd(kp, lds); }
        SEAM(pb + 5);
        if (IN(pb + 6)) { phase_gemm_out_cd(kp, lds); if (PROBE_DUP & 256) phase_gemm_out_cd(kp, lds); }
        SEAM(pb + 6);
        if (IN(pb + 7)) phase_r(kp, lds, 1, g);
        SEAM(pb + 7);
    }
    if (IN(33)) { phase_moe_gather(kp, 1); phase_conv_moe(kp, lds, 1); }
    SEAM(33);
    if (IN(34)) phase_moe_gemm(kp, lds, 1, false);
    SEAM(34);
    if (IN(35)) phase_moe_gemm(kp, lds, 1, true);
    SEAM(35);
    if (IN(36)) phase_combine(kp, 1);
#undef IN
#undef SEAM
}

extern "C" void kernel_launch(void* const* d_in, const int* in_sizes, int n_in, void* d_out, int out_size, void* d_ws, size_t ws_size, hipStream_t stream) {
    static int grid = 0;
    if (grid == 0) {
        if (n_in != 42 || out_size != NLAT * D || ws_size < WS_NEED) { fprintf(stderr, "kernel_launch: unexpected shapes: n_in %d out %d ws %zu (need %zu)\n", n_in, out_size, ws_size, (size_t)WS_NEED); grid = -1; return; }
        int dev = 0, cus = 0, per_cu = 0;
        if (hipGetDevice(&dev) != hipSuccess || hipDeviceGetAttribute(&cus, hipDeviceAttributeMultiprocessorCount, dev) != hipSuccess) { grid = -1; return; }
        if (hipFuncSetAttribute((const void*)fwd_kernel, hipFuncAttributeMaxDynamicSharedMemorySize, LDS_BYTES) != hipSuccess) { fprintf(stderr, "kernel_launch: hipFuncSetAttribute failed\n"); grid = -1; return; }
        if (hipOccupancyMaxActiveBlocksPerMultiprocessor(&per_cu, (const void*)fwd_kernel, 512, LDS_BYTES) != hipSuccess || per_cu < 1) { fprintf(stderr, "kernel_launch: occupancy query says %d blocks per CU\n", per_cu); grid = -1; (void)hipGetLastError(); return; }
        grid = cus;
    }
    if (grid < 0) return;
    (void)hipMemsetAsync(d_ws, 0, CTL_BYTES, stream);
    KP kp{};
    for (int i = 0; i < 42; ++i) kp.in[i] = (const float*)d_in[i];
    kp.out = (float*)d_out; kp.ws = (unsigned char*)d_ws;
#if N_LAUNCH_MODE == 1
    kp.ph_lo = 0; kp.ph_hi = N_PHASES;
    hipLaunchKernelGGL(fwd_kernel, dim3(grid), dim3(512), LDS_BYTES, stream, kp);
#else
    for (int p = 0; p < N_PHASES; ++p) { kp.ph_lo = p; kp.ph_hi = p + 1; hipLaunchKernelGGL(fwd_kernel, dim3(grid), dim3(512), LDS_BYTES, stream, kp); }
#endif
}
```

```cpp
#include <hip/hip_runtime.h>
#include <stdint.h>
#include <stdio.h>

typedef unsigned short bf16_t;
typedef short bf16x8 __attribute__((ext_vector_type(8)));
typedef float f32x4 __attribute__((ext_vector_type(4)));
typedef float f32x2 __attribute__((ext_vector_type(2)));
typedef unsigned u32x4 __attribute__((ext_vector_type(4)));
typedef unsigned u32x2 __attribute__((ext_vector_type(2)));

#ifndef PROBE_DUP
#define PROBE_DUP 0
#endif
#ifndef N_LAUNCH_MODE
#define N_LAUNCH_MODE 1
#endif

constexpr int NB = 16, SEQ = 2048, CTXL = 256, TT = 2304, D = 1024;
constexpr int NTOK = NB * TT, NLAT = NB * SEQ;
constexpr int NG = 2, BG = NB / NG, RG = BG * TT, RGL = BG * SEQ;
constexpr float EPS = 1e-6f;
constexpr int AB_N = 5424, AB_NPAD = 5632, AB_Q = 0, AB_K = 512, AB_V = 1024, AB_OG = 2048, AB_IG = 3072, AB_FG = 3080, AB_Z = 3088, AB_XBC = 4112, AB_DT = 5392;
constexpr int CD_N = 4128, CD_NPAD = 4352, CD_M0 = 0, CD_M1 = 384, CD_KR = 640, CD_R = 672, CD_K = 1696, CD_V = 2720, CD_WL = 3744, CD_AL = 3872, CD_GL = 4000;
constexpr int CD_RW0 = 672;

constexpr size_t CTL_BYTES = 32768;
constexpr size_t CTL_CNT = 16384;
constexpr size_t WS_MODV = CTL_BYTES;
constexpr size_t WS_HC   = WS_MODV + (size_t)2 * 17 * 6144 * 4;
constexpr size_t WS_TOKE = WS_HC + (size_t)NB * CTXL * D * 4;
constexpr size_t WS_TOKP = WS_TOKE + (size_t)NTOK * 2 * 4;
constexpr size_t WS_TOKW = WS_TOKP + (size_t)NTOK * 2 * 4;
constexpr size_t WS_LIST = WS_TOKW + (size_t)NTOK * 2 * 4;
constexpr size_t WS_BSC  = WS_LIST + (size_t)16 * NTOK * 4;
constexpr size_t WS_SG   = WS_BSC + (size_t)2 * RGL * 16 * 4;
constexpr size_t WS_WMIX = WS_SG + (size_t)RGL * 128 * 2;
constexpr size_t WMIX_BYTES = (size_t)16 << 20;
constexpr size_t WS_V    = WS_WMIX + WMIX_BYTES;
constexpr size_t WS_BIG  = WS_V + (size_t)NTOK * D * 2;
constexpr size_t WM_AB_IN = 0, WM_AB_OUT = (size_t)AB_NPAD * 1024 * 2;
constexpr size_t WM_CD_IN = 0, WM_CD_OUT = (size_t)CD_NPAD * 1024 * 2, WM_UQ = WM_CD_OUT + (size_t)1024 * 1536 * 2, WM_UKV = WM_UQ + (size_t)768 * 384 * 2, WM_G2 = WM_UKV + (size_t)1024 * 256 * 2;
static_assert(WM_AB_OUT + (size_t)1024 * 2048 * 2 <= WMIX_BYTES, "wmix ab");
static_assert(WM_G2 + (size_t)1024 * 128 * 2 <= WMIX_BYTES, "wmix cd");
constexpr size_t SZ_RG1K = (size_t)RG * 1024 * 2, SZ_RGL1K = (size_t)RGL * 1024 * 2;
constexpr size_t L0_P = 0, L0_AO = (size_t)RG * AB_N * 2  , L0_HB = L0_AO + 2 * SZ_RG1K, L0_YB = L0_HB + SZ_RG1K, L0_U = L0_YB + SZ_RG1K, L0_END = L0_U + SZ_RG1K;
constexpr size_t L1_P = 0, L1_Q = (size_t)RG * CD_N * 2, L1_KV = L1_Q + (size_t)RGL * 768 * 2, L1_OF = L1_KV + SZ_RG1K, L1_OB = L1_OF + SZ_RGL1K, L1_AOUT = L1_OB + SZ_RGL1K, L1_U = L1_AOUT + (size_t)RGL * 1536 * 2, L1_END = L1_U + SZ_RG1K;
constexpr int MOE_PADROWS = 16 * 256;
constexpr size_t MO_WUP = 0, MO_WDN = (size_t)17 * 1024 * 1024 * 2, MO_HID = MO_WDN + (size_t)17 * 1024 * 512 * 2;
constexpr size_t MO_XG = MO_HID + (size_t)(3 * NTOK + MOE_PADROWS) * 512 * 2;
constexpr size_t MO_CON = MO_XG, MO_END = MO_CON + (size_t)(3 * NTOK + MOE_PADROWS) * 1024 * 2;
constexpr size_t BIG_BYTES = MO_END > L0_END ? (MO_END > L1_END ? MO_END : L1_END) : (L0_END > L1_END ? L0_END : L1_END);
constexpr size_t WS_NEED = WS_BIG + BIG_BYTES;

constexpr int LDS_BYTES = 147456;

__device__ __forceinline__ float bf2f(unsigned short h) { return __uint_as_float(((unsigned)h) << 16); }
__device__ __forceinline__ unsigned short f2bf(float f) { unsigned u = __float_as_uint(f); u += 0x7fffu + ((u >> 16) & 1u); return (unsigned short)(u >> 16); }
__device__ __forceinline__ unsigned pack2(float a, float b) { return (unsigned)f2bf(a) | ((unsigned)f2bf(b) << 16); }
__device__ __forceinline__ float lo2f(unsigned w) { return __uint_as_float(w << 16); }
__device__ __forceinline__ float hi2f(unsigned w) { return __uint_as_float(w & 0xffff0000u); }
__device__ __forceinline__ float wsum(float v) {
#pragma unroll
    for (int o = 32; o; o >>= 1) v += __shfl_xor(v, o);
    return v; }
__device__ __forceinline__ float frcp_(float x) { return __builtin_amdgcn_rcpf(x); }
__device__ __forceinline__ float sigmoidf_(float x) { return __builtin_amdgcn_rcpf(1.0f + __expf(-x)); }
__device__ __forceinline__ float siluf_(float x) { return x * __builtin_amdgcn_rcpf(1.0f + __expf(-x)); }
__device__ __forceinline__ float softplusf_(float x) { return fmaxf(x, 0.0f) + __logf(1.0f + __expf(-fabsf(x))); }
__device__ __forceinline__ float logsigmoidf_(float x) { return fminf(x, 0.0f) - __logf(1.0f + __expf(-fabsf(x))); }
__device__ __forceinline__ float tanhf_(float x) { return 1.0f - 2.0f * __builtin_amdgcn_rcpf(__expf(2.0f * x) + 1.0f); }
__device__ __forceinline__ f32x4 mma16(bf16x8 a, bf16x8 b, f32x4 c) { return __builtin_amdgcn_mfma_f32_16x16x32_bf16(a, b, c, 0, 0, 0); }
__device__ __forceinline__ bf16x8 ldfrag(const bf16_t* base, int ld, int row0, int k0, int fr, int fq) { return *(const bf16x8*)(base + (row0 + fr) * ld + k0 + fq * 8); }
__device__ __forceinline__ void st4bf(bf16_t* p, f32x4 v) { u32x2 w; w.x = pack2(v[0], v[1]); w.y = pack2(v[2], v[3]); *(u32x2*)p = w; }
__device__ __forceinline__ f32x4 ld4bf(const bf16_t* p) { u32x2 w = *(const u32x2*)p; return (f32x4){lo2f(w.x), hi2f(w.x), lo2f(w.y), hi2f(w.y)}; }

#define PHASE_FN __device__ __forceinline__
__device__ __forceinline__ int otid() { int t = threadIdx.x; asm volatile("" : "+v"(t)); return t; }
__device__ __forceinline__ int obid() { int t = blockIdx.x; asm volatile("" : "+s"(t)); return t; }
struct KP { const float* in[42]; float* out; unsigned char* ws; int ph_lo, ph_hi; };

#define XB_TMO      128
#define XB_XCNT(j)  (256  + 64 * (j))
#define XB_XSUB(j)  (1280 + 64 * (j))
#define XB_XGEN(j)  (2304 + 64 * (j))
#define XB_TOP      3328
#define XB_TOPGEN   3392
#define XCD_BAR_WORDS 3456
#define XB_SPIN_CAP (1u << 18)
#define LAS __attribute__((address_space(3)))

__device__ __forceinline__ unsigned xb_ld(unsigned* p)              { return __hip_atomic_load(p, __ATOMIC_RELAXED, __HIP_MEMORY_SCOPE_AGENT); }
__device__ __forceinline__ unsigned xb_add(unsigned* p, unsigned v) { return __hip_atomic_fetch_add(p, v, __ATOMIC_RELAXED, __HIP_MEMORY_SCOPE_AGENT); }
__device__ __forceinline__ unsigned xb_xcc_id() { return (unsigned)__builtin_amdgcn_s_getreg((3 << 11) | 20) & 0xFu; }
#define XB_SPIN(cond, bar) do { unsigned _sp = 0; while (cond) { __builtin_amdgcn_s_sleep(1); \
    if ((++_sp & 255u) == 0u) { if (xb_ld(&(bar)[XB_TMO])) break; if (_sp > XB_SPIN_CAP) { atomicAdd(&(bar)[XB_TMO], 1u); break; } } } } while (0)

struct XcdBarrier {
    unsigned* bar; unsigned x;
    volatile LAS unsigned* st;
};

__device__ __forceinline__ XcdBarrier xcd_barrier_post(unsigned* bar, volatile LAS unsigned* st) {
    XcdBarrier b; b.bar = bar; b.x = xb_xcc_id(); b.st = st;
    if (threadIdx.x == 0) (void)xb_add(&bar[XB_XCNT(b.x)], 1u);
    return b;
}
__device__ __forceinline__ void xcd_barrier_complete(unsigned* bar, unsigned x, unsigned& nloc, unsigned& nx) {
    const unsigned G = gridDim.x * gridDim.y * gridDim.z;
    unsigned sum, cnt, mine, sp = 0u;
    for (;;) {
        sum = 0u; cnt = 0u; mine = 0u;
#pragma unroll
        for (unsigned j = 0; j < 16; ++j) { const unsigned c = xb_ld(&bar[XB_XCNT(j)]); sum += c; cnt += (c > 0u) ? 1u : 0u; mine = (j == x) ? c : mine; }
        if (sum == G) break;
        __builtin_amdgcn_s_sleep(1);
        if ((++sp & 255u) == 0u) { if (xb_ld(&bar[XB_TMO])) break; if (sp > XB_SPIN_CAP) { atomicAdd(&bar[XB_TMO], 1u); break; } }
    }
    nloc = mine > 0u ? mine : 1u; nx = cnt > 0u ? cnt : 1u;
}

__device__ __forceinline__ void xcd_barrier(const XcdBarrier& b) {
    asm volatile("s_waitcnt vmcnt(0)" ::: "memory");
    __syncthreads();
    if (threadIdx.x == 0) {
        unsigned* bar = b.bar;
        __builtin_amdgcn_s_waitcnt(0);
        unsigned nloc = b.st[0], nx = b.st[1];
        if (nloc == 0u) { xcd_barrier_complete(bar, b.x, nloc, nx); b.st[0] = nloc; b.st[1] = nx; }
        const unsigned old = xb_add(&bar[XB_XSUB(b.x)], 1u);
        const unsigned gen = old / nloc;
        if (old + 1u == (gen + 1u) * nloc) {
            __builtin_amdgcn_fence(__ATOMIC_RELEASE, "agent");
            asm volatile("s_waitcnt vmcnt(0)" ::: "memory");
            const unsigned og = xb_add(&bar[XB_TOP], 1u);
            const unsigned tg = og / nx;
            if (og + 1u == (tg + 1u) * nx) xb_add(&bar[XB_TOPGEN], 1u);
            else XB_SPIN(xb_ld(&bar[XB_TOPGEN]) == tg, bar);
            __builtin_amdgcn_fence(__ATOMIC_ACQUIRE, "agent");
            xb_add(&bar[XB_XGEN(b.x)], 1u);
            asm volatile("s_waitcnt vmcnt(0)" ::: "memory");
        } else {
            XB_SPIN(xb_ld(&bar[XB_XGEN(b.x)]) == gen, bar);
            __builtin_amdgcn_fence(__ATOMIC_ACQUIRE, "agent");
            asm volatile("s_waitcnt vmcnt(0)" ::: "memory");
        }
    }
    __syncthreads();
}
struct GA {
    const bf16_t* a0; const bf16_t* a1;
    int ld0, ld1, ksplit;
    const int* list;
    int nrows;
    int mode;
    int row0;
};
constexpr int G_LDT = 40;
constexpr int GEMM_LDS = (2 * 256 * G_LDT + 2 * 128 * G_LDT) * 2;

template <class Epi>
__device__ __forceinline__ void gemm_tile(unsigned char* lds, const GA& ga, const bf16_t* __restrict__ Bt, int K, int mt, int nt, const Epi& epi) {
    const int tid = otid(), lane = tid & 63, wid = tid >> 6, wm = wid >> 1, wn = wid & 1, fr = lane & 15, fq = lane >> 4;
    bf16_t* sA = (bf16_t*)lds;
    bf16_t* sB = sA + 2 * 256 * G_LDT;
    const int kp = tid & 3;
    const int r0 = tid >> 2, r1 = r0 + 128;
    int s0, s1;
    {
        int lr = mt * 256 + r0; if (lr >= ga.nrows) lr = 0;
        s0 = ga.list ? ga.list[lr] : (ga.mode == 1 ? (lr >> 11) * TT + CTXL + (lr & 2047) : ga.row0 + lr);
        lr = mt * 256 + r1; if (lr >= ga.nrows) lr = 0;
        s1 = ga.list ? ga.list[lr] : (ga.mode == 1 ? (lr >> 11) * TT + CTXL + (lr & 2047) : ga.row0 + lr);
    }
    const bf16_t* pa00 = ga.a0 + (size_t)s0 * ga.ld0 + kp * 8;
    const bf16_t* pa01 = ga.a0 + (size_t)s1 * ga.ld0 + kp * 8;
    const bf16_t* pa10 = ga.a1 ? ga.a1 + (size_t)s0 * ga.ld1 + kp * 8 : pa00;
    const bf16_t* pa11 = ga.a1 ? ga.a1 + (size_t)s1 * ga.ld1 + kp * 8 : pa01;
    const bf16_t* pb = Bt + (size_t)(nt * 128 + r0) * K + kp * 8;
    const int ksplit = ga.ksplit;
    f32x4 acc[4][4];
#pragma unroll
    for (int i = 0; i < 4; ++i)
#pragma unroll
        for (int j = 0; j < 4; ++j) acc[i][j] = (f32x4){0.f, 0.f, 0.f, 0.f};
    const int nk = K >> 5;
    u32x4 ra0, ra1, rb;
    {
        ra0 = *(const u32x4*)(pa00); ra1 = *(const u32x4*)(pa01); rb = *(const u32x4*)(pb);
        if (0 >= ksplit) { ra0 = *(const u32x4*)(pa10); ra1 = *(const u32x4*)(pa11); }
    }
    *(u32x4*)(sA + (r0) * G_LDT + kp * 8) = ra0;
    *(u32x4*)(sA + (r1) * G_LDT + kp * 8) = ra1;
    *(u32x4*)(sB + (r0) * G_LDT + kp * 8) = rb;
    __syncthreads();
    for (int kt = 0; kt < nk; ++kt) {
        const int cur = kt & 1;
        if (kt + 1 < nk) {
            const int k0 = (kt + 1) << 5;
            if (k0 < ksplit) { ra0 = *(const u32x4*)(pa00 + k0); ra1 = *(const u32x4*)(pa01 + k0); }
            else { ra0 = *(const u32x4*)(pa10 + (k0 - ksplit)); ra1 = *(const u32x4*)(pa11 + (k0 - ksplit)); }
            rb = *(const u32x4*)(pb + k0);
        }
        const bf16_t* cA = sA + cur * 256 * G_LDT;
        const bf16_t* cB = sB + cur * 128 * G_LDT;
        bf16x8 af[4], bfr[4];
#pragma unroll
        for (int i = 0; i < 4; ++i) af[i] = ldfrag(cA, G_LDT, wm * 64 + i * 16, 0, fr, fq);
#pragma unroll
        for (int j = 0; j < 4; ++j) bfr[j] = ldfrag(cB, G_LDT, wn * 64 + j * 16, 0, fr, fq);
#pragma unroll
        for (int i = 0; i < 4; ++i)
#pragma unroll
            for (int j = 0; j < 4; ++j) acc[i][j] = mma16(bfr[j], af[i], acc[i][j]);
        if (kt + 1 < nk) {
            const int nb = cur ^ 1;
            *(u32x4*)(sA + (nb * 256 + r0) * G_LDT + kp * 8) = ra0;
            *(u32x4*)(sA + (nb * 256 + r1) * G_LDT + kp * 8) = ra1;
            *(u32x4*)(sB + (nb * 128 + r0) * G_LDT + kp * 8) = rb;
        }
        __syncthreads();
    }
    epi(acc, mt * 256 + wm * 64, nt * 128 + wn * 64, fr, fq);
}

struct EpiBf {
    bf16_t* out; int ld, nrows, ncols;
    __device__ __forceinline__ void operator()(const f32x4 (&acc)[4][4], int rb, int cb, int fr, int fq) const {
#pragma unroll
        for (int i = 0; i < 4; ++i) { const int lr = rb + i * 16 + fr; if (lr < nrows) {
#pragma unroll
            for (int j = 0; j < 4; ++j) { const int col = cb + j * 16 + fq * 4; if (col < ncols) st4bf(out + (size_t)lr * ld + col, acc[i][j]); } } }
    }
};
struct EpiSwiglu {
    bf16_t* out; int nrows;
    __device__ __forceinline__ void operator()(const f32x4 (&acc)[4][4], int rb, int cb, int fr, int fq) const {
#pragma unroll
        for (int i = 0; i < 4; ++i) { const int lr = rb + i * 16 + fr; if (lr < nrows) {
#pragma unroll
            for (int j = 0; j < 2; ++j) { const int col = (cb >> 1) + j * 16 + fq * 4; f32x4 g = acc[i][j], u = acc[i][j + 2], o;
#pragma unroll
                for (int r = 0; r < 4; ++r) o[r] = siluf_(g[r]) * u[r];
                st4bf(out + (size_t)lr * 512 + col, o); } } }
    }
};

namespace pg8 {
#define PG8_LAS __attribute__((address_space(3)))
typedef unsigned short bf16_t;
typedef short bf16x8 __attribute__((ext_vector_type(8)));
typedef float f32x4 __attribute__((ext_vector_type(4)));
typedef unsigned u32x4 __attribute__((ext_vector_type(4)));
constexpr int BM = 256, BK = 64, HALF = 128, HTB = HALF * BK * 2  , STAGE_BYTES = 8 * HTB, NXCD = 8, WGM = 8;

__host__ __device__ __forceinline__ int lds_byte(int r, int c) { const int st = (r >> 4) * 2 + (c >> 5), rr = r & 15, cc = c & 31, ob = rr * 64 + cc * 2; return st * 1024 + (ob ^ (((ob >> 9) & 1) << 5)); }
__host__ __device__ __forceinline__ void stage_rc(int b, int& R, int& C) { const int st = b / 1024, sb = b % 1024, swz = sb ^ (((sb >> 9) & 1) << 5); R = (st >> 1) * 16 + swz / 64; C = (st & 1) * 32 + (swz % 64) / 2; }
__host__ __device__ __forceinline__ int perm32(int rho) { const int n = rho >> 4, i = rho & 15; return 8 * (i >> 2) + 4 * n + (i & 3); }

struct Unit { int pm, pn; };
struct Gemm { const bf16_t* A; const bf16_t* Bt; int M, N, K; const bf16_t* A2; int pm_split; };
#define PG8_ABASE(g, pm) ((pm) < (g).pm_split ? (const char*)(g).A + (size_t)(pm) * tstep : (const char*)(g).A2 + (size_t)((pm) - (g).pm_split) * tstep)
struct StaticOrder {
    int nM, nN, nwg, G, c;
    __host__ __device__ void init(int M, int N, int G_, int c_) { nM = M / BM; nN = N / BM; nwg = nM * nN; G = G_; c = c_; }
    __host__ __device__ bool next(int i, Unit& u) const {
        const long L = (long)i * G + c; if (L >= nwg) return false;
        int wgid = (int)L; { const int q = nwg / NXCD, r = nwg % NXCD, xcd = wgid % NXCD, off = wgid / NXCD; wgid = (xcd < r ? xcd * (q + 1) : r * (q + 1) + (xcd - r) * q) + off; }
        const int nig = WGM * nN, gid = wgid / nig, fm = gid * WGM, gsz = (nM - fm) < WGM ? (nM - fm) : WGM;
        u.pm = fm + ((wgid % nig) % gsz); u.pn = (wgid % nig) / gsz; return true;
    }
    __device__ __forceinline__ void a_ready(const Unit&) const {}
    __device__ __forceinline__ void done(const Unit&) const {}
};
__device__ __forceinline__ unsigned cvt_pk_bf16(float lo, float hi) { unsigned r; asm volatile("v_cvt_pk_bf16_f32 %0, %1, %2" : "=v"(r) : "v"(lo), "v"(hi)); return r; }
typedef float f32x2 __attribute__((ext_vector_type(2)));
template <class Epi, class Sched, bool STAMP = false>
__device__ __forceinline__ void gemm_phase(PG8_LAS unsigned char* lds, const Gemm g, const Sched& S, const Epi& E, unsigned long long* stamps) {
    const int tid = otid(), wid = __builtin_amdgcn_readfirstlane(tid >> 6), lane = tid & 63, wr = wid >> 2, wc = wid & 3, fr = lane & 15, fq = lane >> 4;
    const int K = g.K, nt = K / BK;
    int ts_lo = 0, ts_hi = 0, nts = 0; const unsigned long long rt_entry = STAMP ? (unsigned long long)wall_clock64() : 0ull;
#define PG8_STAMP() do { if (STAMP && wid == 0 && nts < 64) { const unsigned long long _c = (unsigned long long)clock64(); \
        ts_lo = (lane == nts) ? (int)(unsigned)_c : ts_lo; ts_hi = (lane == nts) ? (int)(unsigned)(_c >> 32) : ts_hi; ++nts; } } while (0)
    PG8_STAMP();
    unsigned voffA[2], voffB[2];
#pragma unroll
    for (int i = 0; i < 2; ++i) { int R, C; stage_rc(tid * 16 + i * 8192, R, C); const int Rb = Epi::PERM ? ((R & ~31) + perm32(R & 31)) : R;
        voffA[i] = (unsigned)(R * K + C) * 2u; voffB[i] = (unsigned)(Rb * K + C) * 2u; }
    const size_t kstep = (size_t)(BK * 2);
    const size_t hstep = (size_t)HALF * K * 2;
    const size_t tstep = 2 * hstep;
    const unsigned ldsw = (unsigned)wid * 1024u;
    const int aoff = lds_byte(wr * 64 + fr, fq * 8), boff = lds_byte(wc * 32 + fr, fq * 8);
#define PG8_SA(b, h) (((b) * 2 + (h)) * HTB)
#define PG8_SB(b, h) ((4 + (b) * 2 + (h)) * HTB)
#define PG8_STAGE(bufoff, gbase, voff) do { _Pragma("unroll") for (int _i = 0; _i < 2; ++_i) \
        __builtin_amdgcn_global_load_lds((const unsigned*)((const char*)(gbase) + (voff)[_i]), (PG8_LAS unsigned*)(lds + (bufoff) + ldsw + _i * 8192), 16, 0, 0); } while (0)
#define PG8_LDA(dst, b, h) do { _Pragma("unroll") for (int m = 0; m < 4; ++m) _Pragma("unroll") for (int k = 0; k < 2; ++k) dst[m][k] = *(const PG8_LAS bf16x8*)(lds + PG8_SA(b, h) + aoff + m * 2048 + k * 1024); } while (0)
#define PG8_LDB(dst, b, h) do { _Pragma("unroll") for (int n = 0; n < 2; ++n) _Pragma("unroll") for (int k = 0; k < 2; ++k) dst[n][k] = *(const PG8_LAS bf16x8*)(lds + PG8_SB(b, h) + boff + n * 2048 + k * 1024); } while (0)
#define PG8_MMA(ai, bj, At, Bt) do { __builtin_amdgcn_s_setprio(1); _Pragma("unroll") for (int m = 0; m < 4; ++m) _Pragma("unroll") for (int n = 0; n < 2; ++n) _Pragma("unroll") for (int k = 0; k < 2; ++k) \
        acc[ai][bj][m][n] = __builtin_amdgcn_mfma_f32_16x16x32_bf16(Bt[n][k], At[m][k], acc[ai][bj][m][n], 0, 0, 0); __builtin_amdgcn_s_setprio(0); } while (0)
#define PG8_WAIT_V(n) asm volatile("s_waitcnt vmcnt(" #n ")" ::: "memory")
#define PG8_WAIT_L(n) asm volatile("s_waitcnt lgkmcnt(" #n ")" ::: "memory")
#define PG8_BAR __builtin_amdgcn_s_barrier()
#define PG8_SCHED __builtin_amdgcn_sched_barrier(0)
    Unit cur, nxt; int ui = 0;
    if (!S.next(0, cur)) return;
    f32x4 acc[2][2][4][2];
#pragma unroll
    for (int a = 0; a < 2; ++a)
#pragma unroll
        for (int b = 0; b < 2; ++b)
#pragma unroll
            for (int m = 0; m < 4; ++m)
#pragma unroll
                for (int n = 0; n < 2; ++n) acc[a][b][m][n] = (f32x4){0.f, 0.f, 0.f, 0.f};
    bf16x8 At[4][2], B0[2][2], B1[2][2];
    const char* cA = PG8_ABASE(g, cur.pm); const char* cB = (const char*)g.Bt + (size_t)cur.pn * tstep;
    S.a_ready(cur);
    PG8_STAGE(PG8_SB(0, 0), cB, voffB); PG8_STAGE(PG8_SA(0, 0), cA, voffA); PG8_STAGE(PG8_SB(0, 1), cB + hstep, voffB); PG8_STAGE(PG8_SA(0, 1), cA + hstep, voffA);
    if (wr == 1) PG8_BAR;
    PG8_WAIT_V(4); PG8_BAR;
    PG8_STAGE(PG8_SB(1, 0), cB + kstep, voffB); PG8_STAGE(PG8_SA(1, 0), cA + kstep, voffA); PG8_STAGE(PG8_SB(1, 1), cB + hstep + kstep, voffB);
    PG8_WAIT_V(6); PG8_BAR;
    PG8_STAMP();
    for (;;) {
        const bool has_next = S.next(ui + 1, nxt);
        const char* nA = has_next ? PG8_ABASE(g, nxt.pm) : cA; const char* nB = has_next ? (const char*)g.Bt + (size_t)nxt.pn * tstep : cB;
        for (int t = 0; t < nt; t += 2) {
            const bool last = (t == nt - 2);
            const char* a1 = cA + (size_t)(t + 1) * kstep;
            const char* a2 = last ? nA : cA + (size_t)(t + 2) * kstep; const char* b2 = last ? nB : cB + (size_t)(t + 2) * kstep;
            const char* a3 = a2 + kstep; const char* b3 = b2 + kstep;
            if (last && has_next) S.a_ready(nxt);
            PG8_LDB(B0, 0, 0); PG8_SCHED; PG8_LDA(At, 0, 0); PG8_STAGE(PG8_SA(1, 1), a1 + hstep, voffA);
            PG8_WAIT_L(8); PG8_BAR; PG8_WAIT_L(0); PG8_MMA(0, 0, At, B0); PG8_BAR; PG8_SCHED;
            PG8_LDB(B1, 0, 1); PG8_STAGE(PG8_SB(0, 0), b2, voffB);
            PG8_BAR; PG8_WAIT_L(0); PG8_MMA(0, 1, At, B1); PG8_BAR;
            PG8_LDA(At, 0, 1); PG8_STAGE(PG8_SA(0, 0), a2, voffA);
            PG8_BAR; PG8_WAIT_L(0); PG8_MMA(1, 0, At, B0); PG8_BAR; PG8_SCHED;
            PG8_STAGE(PG8_SB(0, 1), b2 + hstep, voffB);
            PG8_WAIT_V(6); PG8_BAR; PG8_MMA(1, 1, At, B1); PG8_BAR;
            PG8_LDB(B0, 1, 0); PG8_SCHED; PG8_LDA(At, 1, 0); PG8_STAGE(PG8_SA(0, 1), a2 + hstep, voffA);
            PG8_WAIT_L(8); PG8_BAR; PG8_WAIT_L(0); PG8_MMA(0, 0, At, B0); PG8_BAR; PG8_SCHED;
            PG8_LDB(B1, 1, 1); PG8_STAGE(PG8_SB(1, 0), b3, voffB);
            PG8_BAR; PG8_WAIT_L(0); PG8_MMA(0, 1, At, B1); PG8_BAR;
            PG8_LDA(At, 1, 1); PG8_STAGE(PG8_SA(1, 0), a3, voffA);
            PG8_BAR; PG8_WAIT_L(0); PG8_MMA(1, 0, At, B0); PG8_BAR; PG8_SCHED;
            PG8_STAGE(PG8_SB(1, 1), b3 + hstep, voffB);
            PG8_WAIT_V(6); PG8_BAR; PG8_MMA(1, 1, At, B1); PG8_BAR;
        }
        PG8_STAMP();
        if constexpr (!Epi::AFTER_DRAIN) { E(acc, cur, wr, wc, fr, fq); S.done(cur); }
        PG8_STAMP();
        if (!has_next) break;
#pragma unroll
        for (int a = 0; a < 2; ++a)
#pragma unroll
            for (int b = 0; b < 2; ++b)
#pragma unroll
                for (int m = 0; m < 4; ++m)
#pragma unroll
                    for (int n = 0; n < 2; ++n) acc[a][b][m][n] = (f32x4){0.f, 0.f, 0.f, 0.f};
        cur = nxt; cA = nA; cB = nB; ++ui;
    }
    PG8_WAIT_V(0);
    if (wr == 0) PG8_BAR;
    PG8_BAR;
    if constexpr (Epi::AFTER_DRAIN) { E.fused(acc, cur, wr, wc, fr, fq, lds, wid, lane); S.done(cur); }
    PG8_STAMP();
    if (STAMP && wid == 0) { stamps[lane] = lane < nts ? (((unsigned long long)(unsigned)ts_hi << 32) | (unsigned)ts_lo) : 0ull;
        if (lane == 62) stamps[62] = rt_entry; if (lane == 63) stamps[63] = (unsigned long long)wall_clock64(); }
#undef PG8_STAMP
#undef PG8_SA
#undef PG8_SB
#undef PG8_STAGE
#undef PG8_LDA
#undef PG8_LDB
#undef PG8_MMA
#undef PG8_WAIT_V
#undef PG8_WAIT_L
#undef PG8_BAR
#undef PG8_SCHED
}
}
namespace pg8 {
struct EpiBfG {
    static constexpr bool PERM = true, AFTER_DRAIN = false;
    bf16_t* O; int ldc, ncols, pn_mask;
    __device__ __forceinline__ void operator()(const f32x4 (&acc)[2][2][4][2], const Unit& u, int wr, int wc, int fr, int fq) const {
        const int row0 = u.pm * BM + wr * 64 + fr, col0 = (u.pn & pn_mask) * BM + wc * 32 + 8 * fq;
#pragma unroll
        for (int ai = 0; ai < 2; ++ai)
#pragma unroll
            for (int m = 0; m < 4; ++m) { bf16_t* rowp = O + (size_t)(row0 + ai * HALF + m * 16) * ldc;
#pragma unroll
                for (int bj = 0; bj < 2; ++bj) { const int c = col0 + bj * HALF;
                    if (c < ncols) { const f32x4 v0 = acc[ai][bj][m][0], v1 = acc[ai][bj][m][1];
                        u32x4 w; w.x = cvt_pk_bf16(v0[0], v0[1]); w.y = cvt_pk_bf16(v0[2], v0[3]); w.z = cvt_pk_bf16(v1[0], v1[1]); w.w = cvt_pk_bf16(v1[2], v1[3]);
                        *(u32x4*)(rowp + c) = w; } } }
    }
};
struct EpiSwi {
    static constexpr bool PERM = true, AFTER_DRAIN = false;
    bf16_t* H;
    __device__ __forceinline__ void operator()(const f32x4 (&acc)[2][2][4][2], const Unit& u, int wr, int wc, int fr, int fq) const {
        const int row0 = u.pm * BM + wr * 64 + fr, hc0 = (u.pn & 3) * HALF + wc * 32 + 8 * fq;
#pragma unroll
        for (int ai = 0; ai < 2; ++ai)
#pragma unroll
            for (int m = 0; m < 4; ++m) { bf16_t* rowp = H + (size_t)(row0 + ai * HALF + m * 16) * 512 + hc0;
                float o[8];
#pragma unroll
                for (int n = 0; n < 2; ++n)
#pragma unroll
                    for (int r = 0; r < 4; ++r) { const float g = acc[ai][0][m][n][r]; o[n * 4 + r] = g * __builtin_amdgcn_rcpf(1.0f + __expf(-g)) * acc[ai][1][m][n][r]; }
                u32x4 w; w.x = cvt_pk_bf16(o[0], o[1]); w.y = cvt_pk_bf16(o[2], o[3]); w.z = cvt_pk_bf16(o[4], o[5]); w.w = cvt_pk_bf16(o[6], o[7]);
                *(u32x4*)rowp = w; }
    }
};
struct MoeOrder {
    const int* slotmap; int ntiles, G, c;
    __device__ __forceinline__ bool next(int i, Unit& u) const {
        const int L = i * G + c; if (L >= ntiles * 4) return false;
        u.pm = L >> 2; u.pn = slotmap[L >> 2] * 4 + (L & 3); return true;
    }
    __device__ __forceinline__ void a_ready(const Unit&) const {}
    __device__ __forceinline__ void done(const Unit&) const {}
};
}
#define WSP(T, off) ((T*)(kp.ws + (off)))

PHASE_FN void phase_mod(const KP& kp, unsigned char* lds) {
    float* sc = (float*)lds;
    float* red = sc + 17 * 1024;
    float* modv = WSP(float, WS_MODV);
    const int tid = otid();
    for (int i = tid; i < 17 * 1024; i += 512) { const int bb = i >> 10, k = i & 1023; const float c = bb < 16 ? kp.in[1][bb * 1024 + k] : kp.in[3][k]; sc[i] = siluf_(c); }
    __syncthreads();
    const int jc = tid & 63, ks = tid >> 6;
    for (int u = obid(); u < 192; u += gridDim.x) {
        const int l = u / 96, j0 = (u % 96) * 64;
        const float* w = kp.in[4] + (size_t)l * 1024 * 6144 + j0 + jc;
        float acc[17];
#pragma unroll
        for (int bb = 0; bb < 17; ++bb) acc[bb] = 0.f;
        for (int k = ks * 128; k < ks * 128 + 128; ++k) {
            const float wv = w[(size_t)k * 6144];
#pragma unroll
            for (int bb = 0; bb < 17; ++bb) acc[bb] += sc[bb * 1024 + k] * wv;
        }
#pragma unroll
        for (int bb = 0; bb < 17; ++bb) red[(ks * 17 + bb) * 64 + jc] = acc[bb];
        __syncthreads();
        for (int i = tid; i < 17 * 64; i += 512) {
            const int bb = i >> 6, j = i & 63; float s = kp.in[5][l * 6144 + j0 + j];
#pragma unroll
            for (int k2 = 0; k2 < 8; ++k2) s += red[(k2 * 17 + bb) * 64 + j];
            modv[((size_t)l * 17 + bb) * 6144 + j0 + j] = s;
        }
        __syncthreads();
    }
}

__device__ __forceinline__ void conv_tile(float* tile, const float* src, int N, int ldsrc, bf16_t* dst, int ldd, int mode, int kt, int ntile) {
    const int tid = otid(), c = tid & 63, r8 = tid >> 6;
#pragma unroll
    for (int i = 0; i < 8; ++i) { const int k = i * 8 + r8, n = ntile * 64 + c; tile[k * 65 + c] = (n < N) ? src[(size_t)(kt * 64 + k) * ldsrc + n] : 0.f; }
    __syncthreads();
#pragma unroll
    for (int i = 0; i < 8; ++i) { const int nl = i * 8 + r8, n = ntile * 64 + nl;
        if (n < N) { int row = n; if (mode) row = (n >> 7) * 256 + (n & 127) + (mode == 2 ? 128 : 0);
            dst[(size_t)row * ldd + kt * 64 + c] = f2bf(tile[c * 65 + nl]); } }
    __syncthreads();
}
__device__ __forceinline__ bool conv_job(float* tile, int& u, const float* src, int K, int N, bf16_t* dst, int mode = 0, int ldd = -1) {
    const int ntl = (N + 63) >> 6, ktl = K >> 6, cnt = ntl * ktl;
    if (u < cnt) { conv_tile(tile, src, N, N, dst, ldd < 0 ? K : ldd, mode, u / ntl, u % ntl); return true; }
    u -= cnt; return false;
}
PHASE_FN void phase_conv_ab(const KP& kp, unsigned char* lds) {
    float* tile = (float*)lds;
    const int total = 16 * 85 + 32 * 16;
    for (int u0 = obid(); u0 < total; u0 += gridDim.x) { int u = u0;
        if (conv_job(tile, u, kp.in[7], 1024, AB_N, WSP(bf16_t, WS_WMIX + WM_AB_IN))) continue;
        conv_job(tile, u, kp.in[8], 2048, 1024, WSP(bf16_t, WS_WMIX + WM_AB_OUT)); }
}
PHASE_FN void phase_conv_cd(const KP& kp, unsigned char* lds) {
    float* tile = (float*)lds;
    const int total = 16 * 65 + 24 * 16 + 6 * 12 + 4 * 16 + 2 * 16;
    for (int u0 = obid(); u0 < total; u0 += gridDim.x) { int u = u0;
        if (conv_job(tile, u, kp.in[18], 1024, CD_N, WSP(bf16_t, WS_WMIX + WM_CD_IN))) continue;
        if (conv_job(tile, u, kp.in[19], 1536, 1024, WSP(bf16_t, WS_WMIX + WM_CD_OUT))) continue;
        if (conv_job(tile, u, kp.in[21], 384, 768, WSP(bf16_t, WS_WMIX + WM_UQ))) continue;
        if (conv_job(tile, u, kp.in[23], 256, 1024, WSP(bf16_t, WS_WMIX + WM_UKV))) continue;
        conv_job(tile, u, kp.in[29], 128, 1024, WSP(bf16_t, WS_WMIX + WM_G2)); }
}
PHASE_FN void phase_conv_moe(const KP& kp, unsigned char* lds, int l) {
    float* tile = (float*)lds;
    const int total = 17 * 384;
    for (int u0 = obid(); u0 < total; u0 += gridDim.x) {
        const int es = u0 / 384; int u = u0 % 384;
        const float* wg = es < 16 ? kp.in[36] + ((size_t)l * 16 + es) * 1024 * 512 : kp.in[39] + (size_t)l * 1024 * 512;
        const float* wu = es < 16 ? kp.in[37] + ((size_t)l * 16 + es) * 1024 * 512 : kp.in[40] + (size_t)l * 1024 * 512;
        const float* wd = es < 16 ? kp.in[38] + ((size_t)l * 16 + es) * 512 * 1024 : kp.in[41] + (size_t)l * 512 * 1024;
        bf16_t* dup = WSP(bf16_t, WS_BIG + MO_WUP) + (size_t)es * 1024 * 1024;
        bf16_t* ddn = WSP(bf16_t, WS_BIG + MO_WDN) + (size_t)es * 1024 * 512;
        if (conv_job(tile, u, wg, 1024, 512, dup, 1, 1024)) continue;
        if (conv_job(tile, u, wu, 1024, 512, dup, 2, 1024)) continue;
        conv_job(tile, u, wd, 512, 1024, ddn, 0, 512); }
}

__device__ __forceinline__ const float* hrow_rd(const KP& kp, bool from_inputs, int b, int t) {
    if (t < CTXL) return (from_inputs ? kp.in[2] : WSP(const float, WS_HC)) + ((size_t)b * CTXL + t) * D;
    return (from_inputs ? kp.in[0] : kp.out) + ((size_t)b * SEQ + (t - CTXL)) * D;
}
__device__ __forceinline__ float* hrow_wr(const KP& kp, int b, int t) {
    if (t < CTXL) return WSP(float, WS_HC) + ((size_t)b * CTXL + t) * D;
    return kp.out + ((size_t)b * SEQ + (t - CTXL)) * D;
}

PHASE_FN void phase_u(const KP& kp, int layer, int g) {
    const int lane = otid() & 63, wid = otid() >> 6;
    const float* modv = WSP(const float, WS_MODV) + (size_t)layer * 17 * 6144;
    const float* ng = kp.in[6] + (size_t)layer * 4 * 1024;
    bf16_t* U = WSP(bf16_t, WS_BIG + (layer == 0 ? L0_U : L1_U));
    for (int lr = obid() * 8 + wid; lr < RG; lr += gridDim.x * 8) {
        const int bl = lr / TT, t = lr - bl * TT, b = g * BG + bl;
        const float* src = hrow_rd(kp, layer == 0, b, t);
        const float* mv = modv + (size_t)(t < CTXL ? 16 : b) * 6144;
        f32x4 x[4]; float ss = 0.f;
#pragma unroll
        for (int i = 0; i < 4; ++i) { x[i] = *(const f32x4*)(src + i * 256 + lane * 4); ss += x[i][0] * x[i][0] + x[i][1] * x[i][1] + x[i][2] * x[i][2] + x[i][3] * x[i][3]; }
        ss = wsum(ss); const float rstd = rsqrtf(ss * (1.0f / 1024.0f) + EPS);
#pragma unroll
        for (int i = 0; i < 4; ++i) { const int col = i * 256 + lane * 4;
            const f32x4 gv = *(const f32x4*)(ng + col), sc = *(const f32x4*)(mv + 1024 + col), sh = *(const f32x4*)(mv + col);
            st4bf(U + (size_t)lr * 1024 + col, x[i] * rstd * gv * (sc + 1.0f) + sh); }
    }
}

PHASE_FN void phase_r(const KP& kp, unsigned char* lds, int layer, int g) {
    const int tid = otid(), lane = tid & 63, wid = tid >> 6;
    float* rw = (float*)lds;
    int* se = (int*)(rw + 1024 * 16);
    int* sbase = se + 128;
    for (int i = tid; i < 1024 * 16; i += 512) rw[i] = kp.in[34][i];
    __syncthreads();
    const float* modv = WSP(const float, WS_MODV) + (size_t)layer * 17 * 6144;
    const float* ng = kp.in[6] + (size_t)layer * 4 * 1024;
    const bf16_t* MIX = WSP(const bf16_t, WS_BIG + (layer == 0 ? L0_U : L1_U));
    bf16_t* V = WSP(bf16_t, WS_V);
    unsigned* cnt = WSP(unsigned, CTL_CNT) + layer * 16;
    int* TOKE = WSP(int, WS_TOKE); int* TOKP = WSP(int, WS_TOKP); float* TOKW = WSP(float, WS_TOKW); int* LIST = WSP(int, WS_LIST);
    const int nrows = layer == 0 ? RG : RGL, nchunks = nrows >> 6;
    float rbias[16];
#pragma unroll
    for (int e = 0; e < 16; ++e) rbias[e] = kp.in[35][e];
    for (int ch = obid(); ch < nchunks; ch += gridDim.x) {
        for (int rr = 0; rr < 8; ++rr) {
            const int rl = wid * 8 + rr, lr = ch * 64 + rl;
            int b, t, tok;
            if (layer == 0) { const int bl = lr / TT; t = lr - bl * TT; b = g * BG + bl; tok = g * RG + lr; }
            else { const int bl = lr >> 11; t = CTXL + (lr & 2047); b = g * BG + bl; tok = g * RGL + lr; }
            const float* hsrc = hrow_rd(kp, layer == 0, b, t);
            float* hdst = hrow_wr(kp, b, t);
            const float* mv = modv + (size_t)(t < CTXL ? 16 : b) * 6144;
            f32x4 y[4], h[4]; float ss = 0.f;
#pragma unroll
            for (int i = 0; i < 4; ++i) { y[i] = ld4bf(MIX + (size_t)lr * 1024 + i * 256 + lane * 4); ss += y[i][0] * y[i][0] + y[i][1] * y[i][1] + y[i][2] * y[i][2] + y[i][3] * y[i][3]; }
            ss = wsum(ss); float rstd = rsqrtf(ss * (1.0f / 1024.0f) + EPS);
            float s2 = 0.f;
#pragma unroll
            for (int i = 0; i < 4; ++i) { const int col = i * 256 + lane * 4;
                const f32x4 g1 = *(const f32x4*)(ng + 1024 + col), ga = *(const f32x4*)(mv + 2048 + col), hx = *(const f32x4*)(hsrc + col);
                h[i] = hx + ga * (y[i] * rstd * g1);
                *(f32x4*)(hdst + col) = h[i];
                s2 += h[i][0] * h[i][0] + h[i][1] * h[i][1] + h[i][2] * h[i][2] + h[i][3] * h[i][3]; }
            s2 = wsum(s2); rstd = rsqrtf(s2 * (1.0f / 1024.0f) + EPS);
            float lg[16];
#pragma unroll
            for (int e = 0; e < 16; ++e) lg[e] = 0.f;
#pragma unroll
            for (int i = 0; i < 4; ++i) { const int col = i * 256 + lane * 4;
                const f32x4 g2 = *(const f32x4*)(ng + 2048 + col), scf = *(const f32x4*)(mv + 4096 + col), shf = *(const f32x4*)(mv + 3072 + col);
                const f32x4 v = h[i] * rstd * g2 * (scf + 1.0f) + shf;
                st4bf(V + (size_t)tok * 1024 + col, v);
#pragma unroll
                for (int j = 0; j < 4; ++j) {
#pragma unroll
                    for (int q = 0; q < 4; ++q) { const f32x4 w4 = *(const f32x4*)(rw + (col + j) * 16 + q * 4);
                        lg[q * 4 + 0] += v[j] * w4[0]; lg[q * 4 + 1] += v[j] * w4[1]; lg[q * 4 + 2] += v[j] * w4[2]; lg[q * 4 + 3] += v[j] * w4[3]; } } }
#pragma unroll
            for (int e = 0; e < 16; ++e) lg[e] = wsum(lg[e]);
            float aff[16], sel[16];
#pragma unroll
            for (int e = 0; e < 16; ++e) { aff[e] = sigmoidf_(lg[e]); sel[e] = aff[e] + rbias[e]; }
            float gs[4];
#pragma unroll
            for (int gi = 0; gi < 4; ++gi) { const float a0 = sel[gi * 4], a1 = sel[gi * 4 + 1], a2 = sel[gi * 4 + 2], a3 = sel[gi * 4 + 3];
                gs[gi] = fmaxf(fmaxf(fmaxf(a0 + a1, a0 + a2), fmaxf(a0 + a3, a1 + a2)), fmaxf(a1 + a3, a2 + a3)); }
            int gidx = 0; float gb = gs[0];
#pragma unroll
            for (int gi = 1; gi < 4; ++gi) if (gs[gi] > gb) { gb = gs[gi]; gidx = gi; }
            float c[4], f[4];
#pragma unroll
            for (int i = 0; i < 4; ++i) { c[i] = gidx == 0 ? sel[i] : gidx == 1 ? sel[4 + i] : gidx == 2 ? sel[8 + i] : sel[12 + i];
                                           f[i] = gidx == 0 ? aff[i] : gidx == 1 ? aff[4 + i] : gidx == 2 ? aff[8 + i] : aff[12 + i]; }
            int i1 = 0; float cb = c[0];
#pragma unroll
            for (int i = 1; i < 4; ++i) if (c[i] > cb) { cb = c[i]; i1 = i; }
            int i2 = -1; float cb2 = 0.f;
#pragma unroll
            for (int i = 0; i < 4; ++i) if (i != i1 && (i2 < 0 || c[i] > cb2)) { cb2 = c[i]; i2 = i; }
            float w1 = i1 == 0 ? f[0] : i1 == 1 ? f[1] : i1 == 2 ? f[2] : f[3];
            float w2 = i2 == 0 ? f[0] : i2 == 1 ? f[1] : i2 == 2 ? f[2] : f[3];
            const float wsn = 1.0f / (w1 + w2); w1 *= wsn; w2 *= wsn;
            if (lane == 0) { se[rl * 2] = gidx * 4 + i1; se[rl * 2 + 1] = gidx * 4 + i2;
                TOKE[tok * 2] = gidx * 4 + i1; TOKE[tok * 2 + 1] = gidx * 4 + i2; TOKW[tok * 2] = w1; TOKW[tok * 2 + 1] = w2; }
        }
        __syncthreads();
        if (tid < 16) { int c2 = 0; for (int i = 0; i < 128; ++i) c2 += (se[i] == tid) ? 1 : 0; sbase[tid] = (int)atomicAdd(&cnt[tid], (unsigned)c2); }
        __syncthreads();
        if (tid < 128) { const int e = se[tid]; int rank = 0; for (int j = 0; j < tid; ++j) rank += (se[j] == e) ? 1 : 0;
            const int pos = sbase[e] + rank; const int lr = ch * 64 + (tid >> 1); const int tok = (layer == 0 ? g * RG : g * RGL) + lr;
            LIST[(size_t)e * NTOK + pos] = tok; TOKP[tok * 2 + (tid & 1)] = pos; }
        __syncthreads();
    }
}

__device__ __forceinline__ int moe_tile_prefix(const unsigned* cnt, int ntok, int lane) {
    const int myt = lane < 16 ? (int)((cnt[lane & 15] + 255u) >> 8) : 0; int pref = myt;
#pragma unroll
    for (int o = 1; o < 16; o <<= 1) { const int t = __shfl_up(pref, o); if (lane >= o) pref += t; }
    return pref - myt + ntok / 256;
}
PHASE_FN void phase_moe_gather(const KP& kp, int layer) {
    const int lane = otid() & 63, wid = otid() >> 6;
    const int ntok = layer == 0 ? NTOK : NLAT;
    const int tpre = moe_tile_prefix(WSP(const unsigned, CTL_CNT) + layer * 16, ntok, lane);
    const bf16_t* V = WSP(const bf16_t, WS_V); bf16_t* XG = WSP(bf16_t, WS_BIG + MO_XG);
    const int* TOKE = WSP(const int, WS_TOKE); const int* TOKP = WSP(const int, WS_TOKP);
    for (int it = obid() * 8 + wid; it < 2 * ntok; it += gridDim.x * 8) {
        const int tok = it >> 1, e = TOKE[it], pos = TOKP[it];
        const size_t row = (size_t)(__shfl(tpre, e) - ntok / 256) * 256 + pos;
        const u32x4* src = (const u32x4*)(V + (size_t)tok * 1024) + lane * 2; u32x4* dst = (u32x4*)(XG + row * 1024) + lane * 2;
        const u32x4 a = src[0], b2 = src[1]; dst[0] = a; dst[1] = b2;
    }
}
PHASE_FN void phase_moe_gemm(const KP& kp, unsigned char* lds, int layer, bool down) {
    const int tid = otid();
    int* pre = (int*)(lds + pg8::STAGE_BYTES);
    int* slotmap = pre + 32;
    const int ntok = layer == 0 ? NTOK : NLAT;
    const unsigned* cnt = WSP(const unsigned, CTL_CNT) + layer * 16;
    if (tid == 0) { int p = ntok / 256; pre[0] = 0; pre[1] = p; for (int e = 0; e < 16; ++e) { p += ((int)cnt[e] + 255) >> 8; pre[2 + e] = p; } }
    __syncthreads();
    const int ntiles = pre[17];
    for (int t = tid; t < ntiles; t += 512) { int idx = 0; for (int e = 1; e < 17; ++e) if (pre[e] <= t) idx = e; slotmap[t] = idx == 0 ? 16 : idx - 1; }
    __syncthreads();
    pg8::MoeOrder S{slotmap, ntiles, (int)gridDim.x, obid()};
    if (!down) {
        pg8::Gemm g{WSP(const bf16_t, WS_V), WSP(const bf16_t, WS_BIG + MO_WUP), 0, 0, 1024, WSP(const bf16_t, WS_BIG + MO_XG), ntok / 256};
        pg8::EpiSwi E{WSP(bf16_t, WS_BIG + MO_HID)};
        pg8::gemm_phase<pg8::EpiSwi, pg8::MoeOrder, false>((PG8_LAS unsigned char*)lds, g, S, E, nullptr);
    } else {
        pg8::Gemm g{WSP(const bf16_t, WS_BIG + MO_HID), WSP(const bf16_t, WS_BIG + MO_WDN), 0, 0, 512, nullptr, 0x7fffffff};
        pg8::EpiBfG E{WSP(bf16_t, WS_BIG + MO_CON), 1024, 1024, 3};
        pg8::gemm_phase<pg8::EpiBfG, pg8::MoeOrder, false>((PG8_LAS unsigned char*)lds, g, S, E, nullptr);
    }
    __syncthreads();
}

PHASE_FN void phase_combine(const KP& kp, int layer) {
    const int lane = otid() & 63, wid = otid() >> 6;
    const int ntok = layer == 0 ? NTOK : NLAT;
    const unsigned* cnt = WSP(const unsigned, CTL_CNT) + layer * 16;
    const float* modv = WSP(const float, WS_MODV) + (size_t)layer * 17 * 6144;
    const float* ng = kp.in[6] + (size_t)layer * 4 * 1024 + 3 * 1024;
    const bf16_t* CON = WSP(const bf16_t, WS_BIG + MO_CON);
    const int* TOKE = WSP(const int, WS_TOKE); const int* TOKP = WSP(const int, WS_TOKP); const float* TOKW = WSP(const float, WS_TOKW);
    const int tpre = moe_tile_prefix(cnt, ntok, lane);
    for (int tok = obid() * 8 + wid; tok < ntok; tok += gridDim.x * 8) {
        const int e1 = TOKE[tok * 2], e2 = TOKE[tok * 2 + 1], p1 = TOKP[tok * 2], p2 = TOKP[tok * 2 + 1];
        const float w1 = TOKW[tok * 2], w2 = TOKW[tok * 2 + 1];
        const size_t r1 = (size_t)__shfl(tpre, e1) * 256 + p1, r2 = (size_t)__shfl(tpre, e2) * 256 + p2;
        int b, t;
        if (layer == 0) { b = tok / TT; t = tok - b * TT; } else { b = tok >> 11; t = CTXL + (tok & 2047); }
        float* hp = hrow_wr(kp, b, t);
        const float* mv = modv + (size_t)(t < CTXL ? 16 : b) * 6144 + 5 * 1024;
        f32x4 f[4]; float ss = 0.f;
#pragma unroll
        for (int i = 0; i < 4; ++i) { const int col = i * 256 + lane * 4;
            f[i] = ld4bf(CON + (size_t)tok * 1024 + col) + ld4bf(CON + r1 * 1024 + col) * w1 + ld4bf(CON + r2 * 1024 + col) * w2;
            ss += f[i][0] * f[i][0] + f[i][1] * f[i][1] + f[i][2] * f[i][2] + f[i][3] * f[i][3]; }
        ss = wsum(ss); const float rstd = rsqrtf(ss * (1.0f / 1024.0f) + EPS);
#pragma unroll
        for (int i = 0; i < 4; ++i) { const int col = i * 256 + lane * 4;
            const f32x4 g3 = *(const f32x4*)(ng + col), gf = *(const f32x4*)(mv + col), hx = *(const f32x4*)(hp + col);
            *(f32x4*)(hp + col) = hx + gf * (f[i] * rstd * g3); }
    }
}

template <int CH>
__device__ __forceinline__ int scan_t(int dir, int ci, int j) {
    constexpr int NC_CTX = CTXL / CH;
    if (!dir) return ci * CH + j;
    return ci < NC_CTX ? (CTXL - 1 - ci * CH - j) : (TT - 1 - (ci - NC_CTX) * CH - j);
}

constexpr int ML_LQ = 136, ML_LT = 72, ML_VR = 144;
PHASE_FN void mlstm_unit(const KP& kp, unsigned char* lds, int bl, int h, int dir, int vh) {
    const int tid = otid();
    bf16_t* Qs = (bf16_t*)lds;
    bf16_t* Ks = Qs + 64 * ML_LQ;
    bf16_t* KTE = Ks + 64 * ML_LQ;
    bf16_t* VT = KTE + 128 * ML_LT;
    bf16_t* Ps = VT + ML_VR * ML_LT;
    bf16_t* Cb = Ps + 64 * ML_LT;
    float* fs = (float*)(Cb + ML_VR * ML_LQ);
    float* s_rowv = fs;
    float* s_colv = fs + 64;
    float* s_wint = fs + 128;
    float* s_emj = fs + 192;
    float* s_E = fs + 256;
    float* s_den = fs + 320;
    float* s_misc = fs + 384;
    const bf16_t* P = WSP(const bf16_t, WS_BIG + L0_P);
    bf16_t* HOUT = WSP(bf16_t, WS_BIG + (dir ? L0_HB : L0_AO)); const int ldh = dir ? 1024 : 2048;
    const float ibias = kp.in[9][dir * 4 + h], fbias = kp.in[10][dir * 4 + h];
    for (int i = tid; i < ML_VR * ML_LQ; i += 512) Cb[i] = 0;
    for (int i = tid; i < 16 * ML_LT; i += 512) VT[128 * ML_LT + i] = (i < ML_LT) ? (bf16_t)0x3f80 : (bf16_t)0;
    f32x4 Cacc[8], Nacc;
#pragma unroll
    for (int i = 0; i < 8; ++i) Cacc[i] = (f32x4){0.f, 0.f, 0.f, 0.f};
    Nacc = (f32x4){0.f, 0.f, 0.f, 0.f};
    float m_state = 0.f;
    u32x4 pq[2], pk[2], pv[2]; bf16_t pgi = 0, pgf = 0;
#define ML_REQ(ci_) do { _Pragma("unroll") for (int i = 0; i < 2; ++i) { const int p = tid + i * 512, j = p >> 4, c8 = p & 15; \
            const bf16_t* pr = P + ((size_t)bl * TT + scan_t<64>(dir, (ci_), j)) * AB_N; \
            pq[i] = *(const u32x4*)(pr + AB_Q + h * 128 + c8 * 8); pk[i] = *(const u32x4*)(pr + AB_K + h * 128 + c8 * 8); \
            const int jv = tid & 63, cv = (tid >> 6) + i * 8; \
            pv[i] = *(const u32x4*)(P + ((size_t)bl * TT + scan_t<64>(dir, (ci_), jv)) * AB_N + AB_V + h * 256 + vh * 128 + cv * 8); } \
        if (tid < 64) { const bf16_t* pg = P + ((size_t)bl * TT + scan_t<64>(dir, (ci_), tid)) * AB_N; pgi = pg[AB_IG + dir * 4 + h]; pgf = pg[AB_FG + dir * 4 + h]; } } while (0)
    ML_REQ(0);
    __syncthreads();
    for (int ci = 0; ci < TT / 64; ++ci) {
        int tq = tid; asm volatile("" : "+v"(tq));
        const int lane = tq & 63, wid = tq >> 6, fr = lane & 15, fq = lane >> 4;
#pragma unroll
        for (int i = 0; i < 2; ++i) {
            const int p = tq + i * 512, j = p >> 4, c8 = p & 15;
            u32x4 q = pq[i];
            const float qs = 0.08838834764831845f;
            q.x = pack2(lo2f(q.x) * qs, hi2f(q.x) * qs); q.y = pack2(lo2f(q.y) * qs, hi2f(q.y) * qs);
            q.z = pack2(lo2f(q.z) * qs, hi2f(q.z) * qs); q.w = pack2(lo2f(q.w) * qs, hi2f(q.w) * qs);
            *(u32x4*)(Qs + j * ML_LQ + c8 * 8) = q;
            *(u32x4*)(Ks + j * ML_LQ + c8 * 8) = pk[i];
            const u32x4 v = pv[i];
            bf16_t* vt = VT + (((tq >> 6) + i * 8) * 8) * ML_LT + (tq & 63);
            vt[0 * ML_LT] = (bf16_t)(v.x & 0xffff); vt[1 * ML_LT] = (bf16_t)(v.x >> 16); vt[2 * ML_LT] = (bf16_t)(v.y & 0xffff); vt[3 * ML_LT] = (bf16_t)(v.y >> 16);
            vt[4 * ML_LT] = (bf16_t)(v.z & 0xffff); vt[5 * ML_LT] = (bf16_t)(v.z >> 16); vt[6 * ML_LT] = (bf16_t)(v.w & 0xffff); vt[7 * ML_LT] = (bf16_t)(v.w >> 16);
        }
        if (wid == 0) {
            const float ig = bf2f(pgi) + ibias;
            const float lf = logsigmoidf_(bf2f(pgf) + fbias);
            float b = lf;
#pragma unroll
            for (int o = 1; o < 64; o <<= 1) { const float t = __shfl_up(b, o); if (lane >= o) b += t; }
            const float u = ig - b; float pm = u;
#pragma unroll
            for (int o = 1; o < 64; o <<= 1) { const float t = __shfl_up(pm, o); if (lane >= o) pm = fmaxf(pm, t); }
            const float mj = fmaxf(b + m_state, b + pm);
            const float b63 = __shfl(b, 63), pm63 = __shfl(pm, 63);
            const float mnew = fmaxf(b63 + m_state, b63 + pm63);
            s_rowv[lane] = b - mj; s_colv[lane] = u; s_wint[lane] = __expf(b + m_state - mj); s_emj[lane] = __expf(-mj);
            s_E[lane] = __expf(b63 + u - mnew);
            if (lane == 0) { s_misc[0] = mnew; s_misc[1] = __expf(b63 + m_state - mnew); }
        }
        if (ci + 1 < TT / 64) ML_REQ(ci + 1);
        __syncthreads();
        {
            const int jt = wid >> 1;
#pragma unroll
            for (int q2 = 0; q2 < 2; ++q2) {
                const int st = (wid & 1) * 2 + q2;
                f32x4 acc = (f32x4){0.f, 0.f, 0.f, 0.f};
                if (st <= jt) {
#pragma unroll
                    for (int k = 0; k < 4; ++k) acc = mma16(ldfrag(Qs, ML_LQ, jt * 16, k * 32, fr, fq), ldfrag(Ks, ML_LQ, st * 16, k * 32, fr, fq), acc);
                }
                const int s = st * 16 + fr; const float cv = s_colv[s];
#pragma unroll
                for (int r = 0; r < 4; ++r) { const int j = jt * 16 + fq * 4 + r;
                    const float pv2 = (s <= j) ? acc[r] * __expf(s_rowv[j] + cv) : 0.f;
                    Ps[j * ML_LT + s] = f2bf(pv2); }
            }
#pragma unroll
            for (int i = 0; i < 2; ++i) {
                const int s = lane, c8 = wid + i * 8; const float e = s_E[s];
                const u32x4 kv = *(const u32x4*)(Ks + s * ML_LQ + c8 * 8);
                bf16_t* kt = KTE + (c8 * 8) * ML_LT + s;
                kt[0 * ML_LT] = f2bf(lo2f(kv.x) * e); kt[1 * ML_LT] = f2bf(hi2f(kv.x) * e); kt[2 * ML_LT] = f2bf(lo2f(kv.y) * e); kt[3 * ML_LT] = f2bf(hi2f(kv.y) * e);
                kt[4 * ML_LT] = f2bf(lo2f(kv.z) * e); kt[5 * ML_LT] = f2bf(hi2f(kv.z) * e); kt[6 * ML_LT] = f2bf(lo2f(kv.w) * e); kt[7 * ML_LT] = f2bf(hi2f(kv.w) * e);
            }
        }
        __syncthreads();
        f32x4 a1[4], a2[4];
        {
            const int jt = wid >> 1;
#pragma unroll
            for (int q4 = 0; q4 < 4; ++q4) {
                const int vt = (wid & 1) * 4 + q4;
                a1[q4] = (f32x4){0.f, 0.f, 0.f, 0.f}; a2[q4] = (f32x4){0.f, 0.f, 0.f, 0.f};
#pragma unroll
                for (int k = 0; k < 2; ++k) a1[q4] = mma16(ldfrag(VT, ML_LT, vt * 16, k * 32, fr, fq), ldfrag(Ps, ML_LT, jt * 16, k * 32, fr, fq), a1[q4]);
#pragma unroll
                for (int k = 0; k < 4; ++k) a2[q4] = mma16(ldfrag(Cb, ML_LQ, vt * 16, k * 32, fr, fq), ldfrag(Qs, ML_LQ, jt * 16, k * 32, fr, fq), a2[q4]);
            }
            if (wid & 1) {
                f32x4 d1 = (f32x4){0.f, 0.f, 0.f, 0.f}, d2 = (f32x4){0.f, 0.f, 0.f, 0.f};
#pragma unroll
                for (int k = 0; k < 2; ++k) d1 = mma16(ldfrag(VT, ML_LT, 128, k * 32, fr, fq), ldfrag(Ps, ML_LT, jt * 16, k * 32, fr, fq), d1);
#pragma unroll
                for (int k = 0; k < 4; ++k) d2 = mma16(ldfrag(Cb, ML_LQ, 128, k * 32, fr, fq), ldfrag(Qs, ML_LQ, jt * 16, k * 32, fr, fq), d2);
                if (fq == 0) { const int j = jt * 16 + fr; s_den[j] = fmaxf(fabsf(d1[0] + s_wint[j] * d2[0]), s_emj[j]); }
            }
        }
        __syncthreads();
        {
            const int jt = wid >> 1, j = jt * 16 + fr;
            const float wi = s_wint[j], rden = frcp_(s_den[j]);
            const size_t row = (size_t)bl * TT + scan_t<64>(dir, ci, j);
#pragma unroll
            for (int q4 = 0; q4 < 4; ++q4) { const int v0 = ((wid & 1) * 4 + q4) * 16 + fq * 4;
                st4bf(HOUT + row * ldh + h * 256 + vh * 128 + v0, (a1[q4] + a2[q4] * wi) * rden); }
        }
        {
            const float dec = s_misc[1];
            const bf16x8 bv0 = ldfrag(VT, ML_LT, wid * 16, 0, fr, fq), bv1 = ldfrag(VT, ML_LT, wid * 16, 32, fr, fq);
#pragma unroll
            for (int dt = 0; dt < 8; ++dt) {
                Cacc[dt] = Cacc[dt] * dec;
                Cacc[dt] = mma16(ldfrag(KTE, ML_LT, dt * 16, 0, fr, fq), bv0, Cacc[dt]);
                Cacc[dt] = mma16(ldfrag(KTE, ML_LT, dt * 16, 32, fr, fq), bv1, Cacc[dt]);
                st4bf(Cb + (wid * 16 + fr) * ML_LQ + dt * 16 + fq * 4, Cacc[dt]);
            }
            Nacc = Nacc * dec;
            Nacc = mma16(ldfrag(KTE, ML_LT, wid * 16, 0, fr, fq), ldfrag(VT, ML_LT, 128, 0, fr, fq), Nacc);
            Nacc = mma16(ldfrag(KTE, ML_LT, wid * 16, 32, fr, fq), ldfrag(VT, ML_LT, 128, 32, fr, fq), Nacc);
            st4bf(Cb + (128 + fr) * ML_LQ + wid * 16 + fq * 4, Nacc);
            m_state = s_misc[0];
        }
        __syncthreads();
    }
#undef ML_REQ
}

constexpr size_t L0_XC = L0_U;
static_assert(L0_XC + (size_t)RG * 1280 * 2 <= BIG_BYTES, "xconv buffer");
PHASE_FN void phase_xconv(const KP& kp) {
    const int lane = otid() & 63, wid = otid() >> 6;
    const bf16_t* P = WSP(const bf16_t, WS_BIG + L0_P); bf16_t* XC = WSP(bf16_t, WS_BIG + L0_XC);
    const float* cw = kp.in[12]; const float* cb = kp.in[13];
    for (int lr = obid() * 8 + wid; lr < RG; lr += gridDim.x * 8) {
        const int bl = lr / TT, t = lr - bl * TT, lo = t < CTXL ? 0 : CTXL, hi = t < CTXL ? CTXL : TT;
#pragma unroll
        for (int i = 0; i < 5; ++i) { const int col = i * 256 + lane * 4;
            f32x4 a = *(const f32x4*)(cb + col);
#pragma unroll
            for (int q = 0; q < 5; ++q) { const int tt = t - 2 + q;
                if (tt >= lo && tt < hi) a += *(const f32x4*)(cw + q * 1280 + col) * ld4bf(P + ((size_t)bl * TT + tt) * AB_N + AB_XBC + col); }
            f32x4 o;
#pragma unroll
            for (int r = 0; r < 4; ++r) o[r] = siluf_(a[r]);
            st4bf(XC + (size_t)lr * 1280 + col, o); }
    }
}

constexpr int SS_LT = 72, SS_LX = 136;
PHASE_FN void ssd_unit(const KP& kp, unsigned char* lds, int bl, int dir, int hp) {
    const int tid = otid();
    const int gi = hp >> 2, hh0 = hp * 2;
    bf16_t* Wm = (bf16_t*)lds;
    bf16_t* CM = Wm + 2 * 64 * SS_LT;
    bf16_t* BM = CM + 64 * SS_LT;
    bf16_t* Xn = BM + 64 * SS_LT;
    bf16_t* XT = Xn + 64 * SS_LX;
    bf16_t* BTE = XT + 2 * 64 * SS_LT;
    bf16_t* Sb = BTE + 2 * 64 * SS_LT;
    float* fs = (float*)(Sb + 2 * 64 * SS_LT);
    float* s_b = fs;
    float* s_dt = fs + 128;
    float* s_e = fs + 256;
    float* s_misc = fs + 384;
    const bf16_t* P = WSP(const bf16_t, WS_BIG + L0_P); const bf16_t* XC = WSP(const bf16_t, WS_BIG + L0_XC);
    bf16_t* YOUT = WSP(bf16_t, WS_BIG + (dir ? L0_YB : L0_AO + 2048)); const int ldy = dir ? 1024 : 2048;
    for (int i = tid; i < 2 * 64 * SS_LT; i += 512) Sb[i] = 0;
    f32x4 Sacc[4];
#pragma unroll
    for (int i = 0; i < 4; ++i) Sacc[i] = (f32x4){0.f, 0.f, 0.f, 0.f};
    const float dtb = kp.in[14][dir * 16 + hh0 + ((tid >> 6) & 1)], aexp = __expf(kp.in[15][dir * 16 + hh0 + ((tid >> 6) & 1)]);
    const float dskip = kp.in[16][hh0 + (tid >> 8)];
    u32x4 pr[4]; bf16_t pdt = 0;
#define SS_REQ(ci_) do { _Pragma("unroll") for (int q = 0; q < 4; ++q) { const int p = tid + q * 512, j = p >> 5, c8 = p & 31; \
            const int col = c8 < 16 ? hh0 * 64 + c8 * 8 : (c8 < 24 ? 1024 + gi * 64 + (c8 - 16) * 8 : 1152 + gi * 64 + (c8 - 24) * 8); \
            pr[q] = *(const u32x4*)(XC + ((size_t)bl * TT + scan_t<64>(dir, (ci_), j)) * 1280 + col); } \
        if (tid < 128) pdt = P[((size_t)bl * TT + scan_t<64>(dir, (ci_), tid & 63)) * AB_N + AB_DT + dir * 16 + hh0 + (tid >> 6)]; } while (0)
    SS_REQ(0);
    __syncthreads();
    for (int ci = 0; ci < TT / 64; ++ci) {
        int tq = tid; asm volatile("" : "+v"(tq));
        const int lane = tq & 63, wid = tq >> 6, fr = lane & 15, fq = lane >> 4, hl_w = wid >> 2;
#pragma unroll
        for (int q = 0; q < 4; ++q) { const int p = tq + q * 512, j = p >> 5, c8 = p & 31;
            bf16_t* dst = c8 < 16 ? Xn + j * SS_LX + c8 * 8 : (c8 < 24 ? BM + j * SS_LT + (c8 - 16) * 8 : CM + j * SS_LT + (c8 - 24) * 8);
            *(u32x4*)dst = pr[q]; }
        if (wid < 2) {
            const float dt = softplusf_(bf2f(pdt) + dtb);
            float b = -dt * aexp;
#pragma unroll
            for (int o = 1; o < 64; o <<= 1) { const float t = __shfl_up(b, o); if (lane >= o) b += t; }
            const float b63 = __shfl(b, 63);
            s_b[wid * 64 + lane] = b; s_dt[wid * 64 + lane] = dt; s_e[wid * 64 + lane] = __expf(b63 - b) * dt;
            if (lane == 0) s_misc[wid] = __expf(b63);
        }
        if (ci + 1 < TT / 64) SS_REQ(ci + 1);
        __syncthreads();
        {
            const int jt = wid >> 1;
#pragma unroll
            for (int q2 = 0; q2 < 2; ++q2) {
                const int st = (wid & 1) * 2 + q2;
                f32x4 acc = (f32x4){0.f, 0.f, 0.f, 0.f};
                if (st <= jt) {
#pragma unroll
                    for (int k = 0; k < 2; ++k) acc = mma16(ldfrag(CM, SS_LT, jt * 16, k * 32, fr, fq), ldfrag(BM, SS_LT, st * 16, k * 32, fr, fq), acc);
                }
                const int s = st * 16 + fr;
#pragma unroll
                for (int hl = 0; hl < 2; ++hl) { const float bs = s_b[hl * 64 + s], ds = s_dt[hl * 64 + s];
#pragma unroll
                    for (int r = 0; r < 4; ++r) { const int j = jt * 16 + fq * 4 + r;
                        const float wv = (s <= j) ? acc[r] * __expf(s_b[hl * 64 + j] - bs) * ds : 0.f;
                        Wm[(hl * 64 + j) * SS_LT + s] = f2bf(wv); } }
            }
            {
                const int s = lane, n8 = wid;
                const u32x4 bv = *(const u32x4*)(BM + s * SS_LT + n8 * 8);
#pragma unroll
                for (int hl = 0; hl < 2; ++hl) { const float e = s_e[hl * 64 + s];
                    bf16_t* bt = BTE + (hl * 64 + n8 * 8) * SS_LT + s;
                    bt[0 * SS_LT] = f2bf(lo2f(bv.x) * e); bt[1 * SS_LT] = f2bf(hi2f(bv.x) * e); bt[2 * SS_LT] = f2bf(lo2f(bv.y) * e); bt[3 * SS_LT] = f2bf(hi2f(bv.y) * e);
                    bt[4 * SS_LT] = f2bf(lo2f(bv.z) * e); bt[5 * SS_LT] = f2bf(hi2f(bv.z) * e); bt[6 * SS_LT] = f2bf(lo2f(bv.w) * e); bt[7 * SS_LT] = f2bf(hi2f(bv.w) * e); }
#pragma unroll
                for (int i = 0; i < 2; ++i) { const int c8 = wid + i * 8;
                    const u32x4 xv = *(const u32x4*)(Xn + s * SS_LX + c8 * 8);
                    bf16_t* xt = XT + (c8 * 8) * SS_LT + s;
                    xt[0 * SS_LT] = (bf16_t)(xv.x & 0xffff); xt[1 * SS_LT] = (bf16_t)(xv.x >> 16); xt[2 * SS_LT] = (bf16_t)(xv.y & 0xffff); xt[3 * SS_LT] = (bf16_t)(xv.y >> 16);
                    xt[4 * SS_LT] = (bf16_t)(xv.z & 0xffff); xt[5 * SS_LT] = (bf16_t)(xv.z >> 16); xt[6 * SS_LT] = (bf16_t)(xv.w & 0xffff); xt[7 * SS_LT] = (bf16_t)(xv.w >> 16); }
            }
        }
        __syncthreads();
        {
            const int hl = hl_w, jt = wid & 3, j = jt * 16 + fr;
            const bf16_t* Wh = Wm + hl * 64 * SS_LT; const bf16_t* Xh = XT + hl * 64 * SS_LT; const bf16_t* Sh = Sb + hl * 64 * SS_LT;
            const float eb = __expf(s_b[hl * 64 + j]);
            const size_t row = (size_t)bl * TT + scan_t<64>(dir, ci, j);
#pragma unroll
            for (int pt = 0; pt < 4; ++pt) {
                f32x4 y1 = (f32x4){0.f, 0.f, 0.f, 0.f}, y2 = (f32x4){0.f, 0.f, 0.f, 0.f};
#pragma unroll
                for (int k = 0; k < 2; ++k) { y1 = mma16(ldfrag(Xh, SS_LT, pt * 16, k * 32, fr, fq), ldfrag(Wh, SS_LT, jt * 16, k * 32, fr, fq), y1);
                                              y2 = mma16(ldfrag(Sh, SS_LT, pt * 16, k * 32, fr, fq), ldfrag(CM, SS_LT, jt * 16, k * 32, fr, fq), y2); }
                f32x4 y = y1 + y2 * eb;
                if (!dir) y = y + ld4bf(Xn + j * SS_LX + hl * 64 + pt * 16 + fq * 4) * dskip;
                st4bf(YOUT + row * ldy + (hh0 + hl) * 64 + pt * 16 + fq * 4, y);
            }
        }
        __syncthreads();
        {
            const int hl = hl_w, pt = wid & 3; const float eb63 = s_misc[hl];
            const bf16_t* Xh = XT + hl * 64 * SS_LT; const bf16_t* Bh = BTE + hl * 64 * SS_LT; bf16_t* Sh = Sb + hl * 64 * SS_LT;
            const bf16x8 x0 = ldfrag(Xh, SS_LT, pt * 16, 0, fr, fq), x1 = ldfrag(Xh, SS_LT, pt * 16, 32, fr, fq);
#pragma unroll
            for (int nt = 0; nt < 4; ++nt) {
                Sacc[nt] = Sacc[nt] * eb63;
                Sacc[nt] = mma16(ldfrag(Bh, SS_LT, nt * 16, 0, fr, fq), x0, Sacc[nt]);
                Sacc[nt] = mma16(ldfrag(Bh, SS_LT, nt * 16, 32, fr, fq), x1, Sacc[nt]);
                st4bf(Sh + (pt * 16 + fr) * SS_LT + nt * 16 + fq * 4, Sacc[nt]);
            }
        }
        __syncthreads();
    }
#undef SS_REQ
}

__device__ __forceinline__ void phase_scan_ab(const KP& kp, unsigned char* lds) {
    for (int u = obid(); u < 256; u += gridDim.x) if (u < 128) { mlstm_unit(kp, lds, u >> 4, (u >> 2) & 3, (u >> 1) & 1, u & 1); __syncthreads(); }
    for (int u = obid(); u < 256; u += gridDim.x) if (u >= 128) { const int v = u - 128; ssd_unit(kp, lds, v >> 4, (v >> 3) & 1, v & 7); __syncthreads(); }
}

PHASE_FN void phase_fin_ab(const KP& kp) {
    const int lane = otid() & 63, wid = otid() >> 6;
    const bf16_t* P = WSP(const bf16_t, WS_BIG + L0_P);
    bf16_t* AO = WSP(bf16_t, WS_BIG + L0_AO); const bf16_t* HB = WSP(const bf16_t, WS_BIG + L0_HB); const bf16_t* YB = WSP(const bf16_t, WS_BIG + L0_YB);
    const float* mln = kp.in[11]; const float* sn = kp.in[17];
    for (int lr = obid() * 8 + wid; lr < RG; lr += gridDim.x * 8) {
        const bf16_t* pr = P + (size_t)lr * AB_N;
        f32x4 yz[4]; float ss2 = 0.f;
#pragma unroll
        for (int i = 0; i < 4; ++i) { const int col = i * 256 + lane * 4;
            const f32x4 hs = ld4bf(AO + (size_t)lr * 2048 + col) + ld4bf(HB + (size_t)lr * 1024 + col);
            float ss = hs[0] * hs[0] + hs[1] * hs[1] + hs[2] * hs[2] + hs[3] * hs[3];
            ss = wsum(ss); const float rstd = rsqrtf(ss * (1.0f / 256.0f) + EPS);
            const f32x4 og = ld4bf(pr + AB_OG + col), w = *(const f32x4*)(mln + col);
            f32x4 o;
#pragma unroll
            for (int r = 0; r < 4; ++r) o[r] = hs[r] * rstd * w[r] * sigmoidf_(og[r]);
            st4bf(AO + (size_t)lr * 2048 + col, o);
            const f32x4 ys = ld4bf(AO + (size_t)lr * 2048 + 1024 + col) + ld4bf(YB + (size_t)lr * 1024 + col), z = ld4bf(pr + AB_Z + col);
#pragma unroll
            for (int r = 0; r < 4; ++r) { yz[i][r] = ys[r] * siluf_(z[r]); ss2 += yz[i][r] * yz[i][r]; }
        }
        ss2 = wsum(ss2); const float rstd2 = rsqrtf(ss2 * (1.0f / 1024.0f) + EPS);
#pragma unroll
        for (int i = 0; i < 4; ++i) { const int col = i * 256 + lane * 4; st4bf(AO + (size_t)lr * 2048 + 1024 + col, yz[i] * rstd2 * *(const f32x4*)(sn + col)); }
    }
}

PHASE_FN void phase_gemm_in(const KP& kp, unsigned char* lds, int layer) {
    const int npad = layer == 0 ? AB_NPAD : CD_NPAD, n = layer == 0 ? AB_N : CD_N;
    pg8::Gemm g{WSP(const bf16_t, WS_BIG + (layer == 0 ? L0_U : L1_U)), WSP(const bf16_t, WS_WMIX), RG, npad, 1024, nullptr, 0x7fffffff};
    pg8::StaticOrder S; S.init(RG, npad, (int)gridDim.x, obid());
    pg8::EpiBfG E{WSP(bf16_t, WS_BIG), n, n, 0x7fffffff};
    pg8::gemm_phase<pg8::EpiBfG, pg8::StaticOrder, false>((PG8_LAS unsigned char*)lds, g, S, E, nullptr);
    __syncthreads();
}
PHASE_FN void phase_gemm_out_ab(const KP& kp, unsigned char* lds) {
    pg8::Gemm g{WSP(const bf16_t, WS_BIG + L0_AO), WSP(const bf16_t, WS_WMIX + WM_AB_OUT), RG, 1024, 2048, nullptr, 0x7fffffff};
    pg8::StaticOrder S; S.init(RG, 1024, (int)gridDim.x, obid());
    pg8::EpiBfG E{WSP(bf16_t, WS_BIG + L0_U), 1024, 1024, 0x7fffffff};
    pg8::gemm_phase<pg8::EpiBfG, pg8::StaticOrder, false>((PG8_LAS unsigned char*)lds, g, S, E, nullptr);
    __syncthreads();
}

PHASE_FN void phase_prep_cd(const KP& kp) {
    const int lane = otid() & 63, wid = otid() >> 6;
    bf16_t* P = WSP(bf16_t, WS_BIG + L1_P);
    bf16_t* SG = WSP(bf16_t, WS_SG);
    const float* qn = kp.in[20]; const float* kvn = kp.in[22]; const float* mu = kp.in[24];
    for (int lr = obid() * 8 + wid; lr < RG; lr += gridDim.x * 8) {
        const int bl = lr / TT, t = lr - bl * TT;
        bf16_t* pr = P + (size_t)lr * CD_N;
        {
            const f32x4 x = ld4bf(pr + CD_M1 + lane * 4);
            float ss = x[0] * x[0] + x[1] * x[1] + x[2] * x[2] + x[3] * x[3]; ss = wsum(ss);
            const float rstd = rsqrtf(ss * (1.0f / 256.0f) + EPS);
            st4bf(pr + CD_M1 + lane * 4, x * rstd * *(const f32x4*)(kvn + lane * 4));
        }
        if (t >= CTXL) {
            const int s = t - CTXL;
            float x0[3], x1[3]; float ss = 0.f;
#pragma unroll
            for (int i = 0; i < 3; ++i) { const unsigned w = *(const unsigned*)(pr + CD_M0 + i * 128 + lane * 2); x0[i] = lo2f(w); x1[i] = hi2f(w); ss += x0[i] * x0[i] + x1[i] * x1[i]; }
            ss = wsum(ss); const float rstd = rsqrtf(ss * (1.0f / 384.0f) + EPS);
#pragma unroll
            for (int i = 0; i < 3; ++i) { const int c = i * 128 + lane * 2; *(unsigned*)(pr + CD_M0 + c) = pack2(x0[i] * rstd * qn[c], x1[i] * rstd * qn[c + 1]); }
            if (lane < 16) {
                const float pos = (lane < 8) ? (float)(s >> 6) : (float)(s & 63);
                const float inv = __expf(-(float)(lane & 7) * (9.210340371976184f / 8.0f));
                float sn, cs; sincosf(pos * inv, &sn, &cs);
                const float a = bf2f(pr[CD_KR + lane]), b2 = bf2f(pr[CD_KR + 16 + lane]);
                pr[CD_KR + lane] = f2bf(a * cs - b2 * sn); pr[CD_KR + 16 + lane] = f2bf(a * sn + b2 * cs);
            }
            {
                const int c = lane * 2;
                const unsigned w = *(const unsigned*)(pr + CD_GL + c);
                const unsigned wp = s > 0 ? *(const unsigned*)(pr - CD_N + CD_GL + c) : 0u;
                const unsigned wn = s < SEQ - 1 ? *(const unsigned*)(pr + CD_N + CD_GL + c) : 0u;
                const float m0 = mu[CD_GL - CD_RW0 + c], m1 = mu[CD_GL - CD_RW0 + c + 1];
                const float g0 = lo2f(w) + m0 * (0.5f * (lo2f(wp) + lo2f(wn)) - lo2f(w));
                const float g1 = hi2f(w) + m1 * (0.5f * (hi2f(wp) + hi2f(wn)) - hi2f(w));
                *(unsigned*)(SG + ((size_t)bl * SEQ + s) * 128 + c) = pack2(sigmoidf_(g0), sigmoidf_(g1));
            }
        }
    }
}

PHASE_FN void phase_upproj(const KP& kp, unsigned char* lds) {
    const bf16_t* P = WSP(const bf16_t, WS_BIG + L1_P);
    const int nq = (RGL / 256) * 6, nkv = (RG / 256) * 8;
    for (int u = obid(); u < nq + nkv; u += gridDim.x) {
        if (u < nq) {
            GA ga{P + CD_M0, nullptr, CD_N, 0, 384, nullptr, RGL, 1, 0};
            EpiBf ep{WSP(bf16_t, WS_BIG + L1_Q), 768, RGL, 768};
            gemm_tile(lds, ga, WSP(const bf16_t, WS_WMIX + WM_UQ), 384, u / 6, u % 6, ep);
        } else { const int v = u - nq;
            GA ga{P + CD_M1, nullptr, CD_N, 0, 256, nullptr, RG, 0, 0};
            EpiBf ep{WSP(bf16_t, WS_BIG + L1_KV), 1024, RG, 1024};
            gemm_tile(lds, ga, WSP(const bf16_t, WS_WMIX + WM_UKV), 256, v >> 3, v & 7, ep);
        }
    }
}

constexpr int AT_LQ = 104, AT_LV = 72;
PHASE_FN void attn_unit(const KP& kp, unsigned char* lds, int bl, int head, int qb) {
    const int tid = otid(), lane = tid & 63, wid = tid >> 6, fr = lane & 15, fq = lane >> 4;
    bf16_t* Qs = (bf16_t*)lds;
    bf16_t* Kt = Qs + 128 * AT_LQ;
    bf16_t* Vt = Kt + 64 * AT_LQ;
    const bf16_t* P = WSP(const bf16_t, WS_BIG + L1_P);
    const bf16_t* Q = WSP(const bf16_t, WS_BIG + L1_Q);
    const bf16_t* KV = WSP(const bf16_t, WS_BIG + L1_KV);
    bf16_t* AOUT = WSP(bf16_t, WS_BIG + L1_AOUT);
    const float SC = 0.10206207261596577f;
#pragma unroll
    for (int i = 0; i < 3; ++i) { const int p = tid + i * 512, r = p / 12, c = p % 12;
        *(u32x4*)(Qs + r * AT_LQ + c * 8) = *(const u32x4*)(Q + ((size_t)bl * SEQ + qb * 128 + r) * 768 + head * 96 + c * 8); }
    __syncthreads();
#pragma unroll
    for (int i = 0; i < 4; ++i) { const int p = tid + i * 512, r = p >> 4, f = p & 15, s = qb * 128 + r;
        const float pos = (f < 8) ? (float)(s >> 6) : (float)(s & 63);
        const float inv = __expf(-(float)(f & 7) * (9.210340371976184f / 8.0f));
        float sn, cs; sincosf(pos * inv, &sn, &cs);
        const float a = bf2f(Qs[r * AT_LQ + 64 + f]), b2 = bf2f(Qs[r * AT_LQ + 80 + f]);
        Qs[r * AT_LQ + 64 + f] = f2bf(a * cs - b2 * sn); Qs[r * AT_LQ + 80 + f] = f2bf(a * sn + b2 * cs); }
    __syncthreads();
    bf16x8 qf[3];
#pragma unroll
    for (int k = 0; k < 3; ++k) qf[k] = ldfrag(Qs, AT_LQ, wid * 16, k * 32, fr, fq);
    f32x4 ot[4];
#pragma unroll
    for (int i = 0; i < 4; ++i) ot[i] = (f32x4){0.f, 0.f, 0.f, 0.f};
    float mrow = -1e30f, lsum = 0.f;
    u32x4 pk0, pk1, pvv;
    const int kkey0 = tid / 12, kc0 = tid % 12, kkey1 = (tid + 512) / 12, kc1 = (tid + 512) % 12, vkey = tid & 63, vc8 = tid >> 6;
#define AT_REQ(kt_) do { const size_t rb_ = (size_t)bl * TT + (kt_) * 64; \
        pk0 = kc0 < 8 ? *(const u32x4*)(KV + (rb_ + kkey0) * 1024 + head * 128 + kc0 * 8) : *(const u32x4*)(P + (rb_ + kkey0) * CD_N + CD_KR + (kc0 - 8) * 8); \
        if (tid < 256) pk1 = kc1 < 8 ? *(const u32x4*)(KV + (rb_ + kkey1) * 1024 + head * 128 + kc1 * 8) : *(const u32x4*)(P + (rb_ + kkey1) * CD_N + CD_KR + (kc1 - 8) * 8); \
        pvv = *(const u32x4*)(KV + (rb_ + vkey) * 1024 + head * 128 + 64 + vc8 * 8); } while (0)
    AT_REQ(0);
    for (int kt = 0; kt < TT / 64; ++kt) {
        __syncthreads();
        *(u32x4*)(Kt + kkey0 * AT_LQ + kc0 * 8) = pk0;
        if (tid < 256) *(u32x4*)(Kt + kkey1 * AT_LQ + kc1 * 8) = pk1;
        { bf16_t* vt = Vt + (vc8 * 8) * AT_LV + vkey; const u32x4 v = pvv;
            vt[0 * AT_LV] = (bf16_t)(v.x & 0xffff); vt[1 * AT_LV] = (bf16_t)(v.x >> 16); vt[2 * AT_LV] = (bf16_t)(v.y & 0xffff); vt[3 * AT_LV] = (bf16_t)(v.y >> 16);
            vt[4 * AT_LV] = (bf16_t)(v.z & 0xffff); vt[5 * AT_LV] = (bf16_t)(v.z >> 16); vt[6 * AT_LV] = (bf16_t)(v.w & 0xffff); vt[7 * AT_LV] = (bf16_t)(v.w >> 16); }
        if (kt + 1 < TT / 64) AT_REQ(kt + 1);
        __syncthreads();
        f32x4 st[4];
        float mx = -1e30f;
#pragma unroll
        for (int kk = 0; kk < 4; ++kk) { st[kk] = (f32x4){0.f, 0.f, 0.f, 0.f};
#pragma unroll
            for (int k = 0; k < 3; ++k) st[kk] = mma16(ldfrag(Kt, AT_LQ, kk * 16, k * 32, fr, fq), qf[k], st[kk]);
            mx = fmaxf(mx, fmaxf(fmaxf(st[kk][0], st[kk][1]), fmaxf(st[kk][2], st[kk][3]))); }
        mx = fmaxf(mx, __shfl_xor(mx, 16)); mx = fmaxf(mx, __shfl_xor(mx, 32));
        const float mnew = fmaxf(mrow, mx), alpha = __expf(SC * (mrow - mnew));
        mrow = mnew; lsum *= alpha;
#pragma unroll
        for (int i = 0; i < 4; ++i) ot[i] = ot[i] * alpha;
#pragma unroll
        for (int kk = 0; kk < 4; ++kk)
#pragma unroll
            for (int r = 0; r < 4; ++r) { const float pv = __expf(SC * (st[kk][r] - mnew)); st[kk][r] = pv; lsum += pv; }
#pragma unroll
        for (int k2 = 0; k2 < 2; ++k2) {
            union { bf16x8 v; unsigned u[4]; } pb;
            pb.u[0] = pack2(st[2 * k2][0], st[2 * k2][1]); pb.u[1] = pack2(st[2 * k2][2], st[2 * k2][3]);
            pb.u[2] = pack2(st[2 * k2 + 1][0], st[2 * k2 + 1][1]); pb.u[3] = pack2(st[2 * k2 + 1][2], st[2 * k2 + 1][3]);
#pragma unroll
            for (int dvt = 0; dvt < 4; ++dvt) {
                union { bf16x8 v; u32x2 h[2]; } va;
                const bf16_t* vp = Vt + (dvt * 16 + fr) * AT_LV + k2 * 32 + fq * 4;
                va.h[0] = *(const u32x2*)vp; va.h[1] = *(const u32x2*)(vp + 16);
                ot[dvt] = mma16(va.v, pb.v, ot[dvt]);
            }
        }
    }
#undef AT_REQ
    lsum += __shfl_xor(lsum, 16); lsum += __shfl_xor(lsum, 32);
    const float rl = frcp_(lsum);
    const size_t orow = (size_t)bl * SEQ + qb * 128 + wid * 16 + fr;
#pragma unroll
    for (int dvt = 0; dvt < 4; ++dvt) st4bf(AOUT + orow * 1536 + head * 64 + dvt * 16 + fq * 4, ot[dvt] * rl);
}

constexpr int RW_LR = 328, RW_LP = 72;
PHASE_FN void rwkv_unit(const KP& kp, unsigned char* lds, int bl, int h, int dir) {
    const int tid = otid();
    bf16_t* RAW = (bf16_t*)lds;
    bf16_t* TWb = RAW + 34 * RW_LR;
    bf16_t* ALb = TWb + 32 * RW_LP;
    bf16_t* W2T = ALb + 32 * RW_LP;
    bf16_t* A2T = W2T + 64 * RW_LP;
    float* CL = (float*)(A2T + 64 * RW_LP);
    bf16_t* AR = (bf16_t*)(CL + 32 * 64);
    bf16_t* BK = AR + 64 * RW_LP;
    float* AAB = (float*)(BK + 64 * RW_LP);
    bf16_t* ARB = (bf16_t*)(AAB + 32 * 36);
    bf16_t* AAK = ARB + 32 * 40;
    bf16_t* ARK = AAK + 32 * 40;
    float* RHS = (float*)(ARK + 32 * 40);
    float* YB = RHS + 32 * 64;
    bf16_t* ZVT = (bf16_t*)(YB + 32 * 64);
    bf16_t* BKh = ZVT + 64 * RW_LP;
    bf16_t* Sb = BKh + 64 * RW_LP;
    float* PL = (float*)(Sb + 64 * RW_LP);
    const bf16_t* P = WSP(const bf16_t, WS_BIG + L1_P);
    bf16_t* OUT = WSP(bf16_t, WS_BIG + (dir ? L1_OB : L1_OF));
    float* BSC = WSP(float, WS_BSC) + (size_t)dir * RGL * 16;
    const float* mu = kp.in[24];
    for (int i = tid; i < 64 * 64; i += 512) { const int c = i >> 6, n = i & 63;
        W2T[n * RW_LP + c] = f2bf(kp.in[26][((size_t)dir * 64 + c) * 1024 + h * 64 + n]); A2T[n * RW_LP + c] = f2bf(kp.in[28][((size_t)dir * 64 + c) * 1024 + h * 64 + n]); }
    for (int i = tid; i < 64 * RW_LP; i += 512) Sb[i] = 0;
    const int n4o = (tid & 15) * 4;
    const f32x4 w0v = *(const f32x4*)(kp.in[25] + dir * 1024 + h * 64 + n4o), a0v = *(const f32x4*)(kp.in[27] + dir * 1024 + h * 64 + n4o);
    const f32x4 kkw = *(const f32x4*)(kp.in[30] + h * 64 + n4o), kaw = *(const f32x4*)(kp.in[31] + h * 64 + n4o), rkw = *(const f32x4*)(kp.in[32] + h * 64 + n4o);
    const f32x4 mur = *(const f32x4*)(mu + h * 64 + n4o), muk = *(const f32x4*)(mu + 1024 + h * 64 + n4o), muv = *(const f32x4*)(mu + 2048 + h * 64 + n4o);
    f32x4 Sacc[2];
    Sacc[0] = (f32x4){0.f, 0.f, 0.f, 0.f}; Sacc[1] = (f32x4){0.f, 0.f, 0.f, 0.f};
    u32x4 pf[3];
#define RW_PREFETCH(cn) do { const int t0n_ = dir ? scan_t<32>(1, (cn), 31) : (cn) * 32; const int lo_ = t0n_ < CTXL ? 0 : CTXL, hi_ = t0n_ < CTXL ? CTXL : TT; \
        _Pragma("unroll") for (int q = 0; q < 3; ++q) { const int p = tid + q * 512; pf[q] = (u32x4){0u, 0u, 0u, 0u}; \
            if (p < 34 * 40) { const int rr = p / 40, c = p % 40, t = t0n_ - 1 + rr; \
                if (t >= lo_ && t < hi_) { const int seg = c >> 3, c8 = c & 7; \
                    const int col = seg == 0 ? CD_R + h * 64 : seg == 1 ? CD_K + h * 64 : seg == 2 ? CD_V + h * 64 : seg == 3 ? CD_WL + dir * 64 : CD_AL + dir * 64; \
                    pf[q] = *(const u32x4*)(P + ((size_t)bl * TT + t) * CD_N + col + c8 * 8); } } } } while (0)
    RW_PREFETCH(0);
    __syncthreads();
    for (int ci = 0; ci < TT / 32; ++ci) {
        int tq = tid; asm volatile("" : "+v"(tq));
        const int lane = tq & 63, wid = tq >> 6, fr = lane & 15, fq = lane >> 4, pi = tq >> 4, n4 = (tq & 15) * 4;
        const int t0 = dir ? scan_t<32>(1, ci, 31) : ci * 32;
#pragma unroll
        for (int q = 0; q < 3; ++q) { const int p = tq + q * 512; if (p < 34 * 40) *(u32x4*)(RAW + (p / 40) * RW_LR + (p % 40) * 8) = pf[q]; }
        if (ci + 1 < TT / 32) RW_PREFETCH(ci + 1);
        __syncthreads();
#pragma unroll
        for (int q = 0; q < 8; ++q) { const int idx = tq + q * 512, which = idx >> 11, i = (idx >> 6) & 31, c = idx & 63;
            const int rc = 192 + which * 64 + c;
            const float x = bf2f(RAW[(i + 1) * RW_LR + rc]), xp = bf2f(RAW[i * RW_LR + rc]), xn = bf2f(RAW[(i + 2) * RW_LR + rc]);
            const float m = mu[(which ? 3200 : 3072) + dir * 64 + c];
            const float l = x + m * (0.5f * (xp + xn) - x);
            if (which) ALb[i * RW_LP + c] = f2bf(l); else TWb[i * RW_LP + c] = f2bf(tanhf_(l)); }
        __syncthreads();
        {
            const int which = wid >> 2, tt = (wid >> 1) & 1;
            const bf16_t* Xa = which ? ALb : TWb; const bf16_t* Wt = which ? A2T : W2T; float* Od = which ? YB : RHS;
#pragma unroll
            for (int q2 = 0; q2 < 2; ++q2) { const int nt = (wid & 1) * 2 + q2;
                f32x4 acc = (f32x4){0.f, 0.f, 0.f, 0.f};
#pragma unroll
                for (int k = 0; k < 2; ++k) acc = mma16(ldfrag(Xa, RW_LP, tt * 16, k * 32, fr, fq), ldfrag(Wt, RW_LP, nt * 16, k * 32, fr, fq), acc);
#pragma unroll
                for (int rr = 0; rr < 4; ++rr) Od[(tt * 16 + fq * 4 + rr) * 64 + nt * 16 + fr] = acc[rr]; }
        }
        __syncthreads();
        const int j = dir ? 31 - pi : pi;
        f32x4 r, kd, v, av, bv;
        {
            const f32x4 wl = w0v + *(const f32x4*)(RHS + pi * 64 + n4), al = a0v + *(const f32x4*)(YB + pi * 64 + n4);
            const bf16_t* r1 = RAW + (pi + 1) * RW_LR; const bf16_t* rp = RAW + pi * RW_LR; const bf16_t* rn = RAW + (pi + 2) * RW_LR;
            f32x4 k;
            r = ld4bf(r1 + n4); k = ld4bf(r1 + 64 + n4); v = ld4bf(r1 + 128 + n4);
            r = r + mur * ((ld4bf(rp + n4) + ld4bf(rn + n4)) * 0.5f - r);
            k = k + muk * ((ld4bf(rp + 64 + n4) + ld4bf(rn + 64 + n4)) * 0.5f - k);
            v = v + muv * ((ld4bf(rp + 128 + n4) + ld4bf(rn + 128 + n4)) * 0.5f - v);
            f32x4 a, lw, kk = k * kkw;
            float ssq = kk[0] * kk[0] + kk[1] * kk[1] + kk[2] * kk[2] + kk[3] * kk[3];
            ssq += __shfl_xor(ssq, 1); ssq += __shfl_xor(ssq, 2); ssq += __shfl_xor(ssq, 4); ssq += __shfl_xor(ssq, 8);
            kk = kk * __builtin_amdgcn_rsqf(fmaxf(ssq, 1e-24f));
#pragma unroll
            for (int q = 0; q < 4; ++q) { const float wlog = -softplusf_(-wl[q]) - 0.5f; lw[q] = -__expf(wlog); a[q] = sigmoidf_(al[q]); }
            kd = k * ((a - 1.0f) * kaw + 1.0f);
            float bs = r[0] * kd[0] * rkw[0] + r[1] * kd[1] * rkw[1] + r[2] * kd[2] * rkw[2] + r[3] * kd[3] * rkw[3];
            bs += __shfl_xor(bs, 1); bs += __shfl_xor(bs, 2); bs += __shfl_xor(bs, 4); bs += __shfl_xor(bs, 8);
            av = kk * -1.0f; bv = kk * a;
            *(f32x4*)(CL + j * 64 + n4) = lw;
            const int t = t0 + pi;
            if (t >= CTXL && (tq & 15) == 0) BSC[((size_t)bl * SEQ + (t - CTXL)) * 16 + h] = bs;
        }
        __syncthreads();
        if (wid == 0) {
            float c[32];
#pragma unroll
            for (int q = 0; q < 32; ++q) c[q] = CL[q * 64 + lane];
#pragma unroll
            for (int q = 1; q < 32; ++q) c[q] += c[q - 1];
#pragma unroll
            for (int q = 0; q < 32; ++q) CL[q * 64 + lane] = c[q];
            PL[lane] = __expf(c[31]);
        }
        __syncthreads();
        {
            const f32x4 clj = *(const f32x4*)(CL + j * 64 + n4), cle = *(const f32x4*)(CL + 31 * 64 + n4);
            f32x4 clp = (f32x4){0.f, 0.f, 0.f, 0.f};
            if (j > 0) clp = *(const f32x4*)(CL + (j - 1) * 64 + n4);
            f32x4 at, rt, bt, kt, bh, kh;
#pragma unroll
            for (int q = 0; q < 4; ++q) { const float ep = __expf(clp[q]), ej = __expf(clj[q]), ei = __expf(-clj[q]), ee = __expf(cle[q] - clj[q]);
                at[q] = av[q] * ep; rt[q] = r[q] * ej; bt[q] = bv[q] * ei; kt[q] = kd[q] * ei; bh[q] = bv[q] * ee; kh[q] = kd[q] * ee; }
            st4bf(AR + j * RW_LP + n4, at); st4bf(AR + (32 + j) * RW_LP + n4, rt);
            st4bf(BK + j * RW_LP + n4, bt); st4bf(BK + (32 + j) * RW_LP + n4, kt);
#pragma unroll
            for (int q = 0; q < 4; ++q) { BKh[(n4 + q) * RW_LP + j] = f2bf(bh[q]); BKh[(n4 + q) * RW_LP + 32 + j] = f2bf(kh[q]); ZVT[(n4 + q) * RW_LP + 32 + j] = f2bf(v[q]); }
        }
        __syncthreads();
        {
            const int ti = wid >> 1;
#pragma unroll
            for (int q2 = 0; q2 < 2; ++q2) {
                const int si = (wid & 1) * 2 + q2;
                f32x4 acc = (f32x4){0.f, 0.f, 0.f, 0.f};
#pragma unroll
                for (int k = 0; k < 2; ++k) acc = mma16(ldfrag(AR, RW_LP, ti * 16, k * 32, fr, fq), ldfrag(BK, RW_LP, si * 16, k * 32, fr, fq), acc);
                const int sp = si * 16 + fr, s = sp & 31;
#pragma unroll
                for (int rr = 0; rr < 4; ++rr) { const int tp = ti * 16 + fq * 4 + rr, t = tp & 31;
                    const bool incl = tp >= 32;
                    const float val = (incl ? (s <= t) : (s < t)) ? acc[rr] : 0.f;
                    if (sp < 32) { if (incl) ARB[t * 40 + s] = f2bf(val); else AAB[t * 36 + s] = val; }
                    else { (incl ? ARK : AAK)[t * 40 + s] = f2bf(val); } }
            }
        }
        __syncthreads();
        {
            const int which = wid >> 2, tt = (wid >> 1) & 1;
            const bf16_t* Ak = which ? ARK : AAK; float* Od = which ? YB : RHS;
#pragma unroll
            for (int q2 = 0; q2 < 2; ++q2) {
                const int vt = (wid & 1) * 2 + q2;
                f32x4 acc = (f32x4){0.f, 0.f, 0.f, 0.f};
#pragma unroll
                for (int k = 0; k < 2; ++k) acc = mma16(ldfrag(AR, RW_LP, which * 32 + tt * 16, k * 32, fr, fq), ldfrag(Sb, RW_LP, vt * 16, k * 32, fr, fq), acc);
                acc = mma16(ldfrag(Ak, 40, tt * 16, 0, fr, fq), ldfrag(ZVT, RW_LP, vt * 16, 32, fr, fq), acc);
#pragma unroll
                for (int rr = 0; rr < 4; ++rr) Od[(tt * 16 + fq * 4 + rr) * 64 + vt * 16 + fr] = acc[rr];
            }
        }
        __syncthreads();
        if (wid == 0) {
            float z[32];
            f32x4 cur[8], nxt[4];
            z[0] = RHS[lane];
            cur[0] = *(const f32x4*)(AAB + 1 * 36);
#pragma unroll
            for (int t = 1; t < 32; ++t) {
                float p0 = RHS[t * 64 + lane], p1 = 0.f, p2 = 0.f, p3 = 0.f;
#pragma unroll
                for (int q4 = 4; q4 < 8; ++q4) if (q4 * 4 < t) cur[q4] = *(const f32x4*)(AAB + t * 36 + q4 * 4);
                if (t + 1 < 32) {
#pragma unroll
                    for (int q4 = 0; q4 < 4; ++q4) if (q4 * 4 < t + 1) nxt[q4] = *(const f32x4*)(AAB + (t + 1) * 36 + q4 * 4);
                }
#pragma unroll
                for (int q4 = 0; q4 < 8; ++q4) {
                    if (q4 * 4 + 0 < t) p0 += cur[q4][0] * z[q4 * 4 + 0];
                    if (q4 * 4 + 1 < t) p1 += cur[q4][1] * z[q4 * 4 + 1];
                    if (q4 * 4 + 2 < t) p2 += cur[q4][2] * z[q4 * 4 + 2];
                    if (q4 * 4 + 3 < t) p3 += cur[q4][3] * z[q4 * 4 + 3];
                }
                float zt = (p0 + p1) + (p2 + p3);
                asm volatile("" : "+v"(zt) :: "memory");
                z[t] = zt;
#pragma unroll
                for (int q4 = 0; q4 < 4; ++q4) if (q4 * 4 < t + 1) cur[q4] = nxt[q4];
            }
#pragma unroll
            for (int q = 0; q < 4; ++q) { u32x4 w;
                w.x = pack2(z[q * 8 + 0], z[q * 8 + 1]); w.y = pack2(z[q * 8 + 2], z[q * 8 + 3]); w.z = pack2(z[q * 8 + 4], z[q * 8 + 5]); w.w = pack2(z[q * 8 + 6], z[q * 8 + 7]);
                *(u32x4*)(ZVT + lane * RW_LP + q * 8) = w; }
        }
        __syncthreads();
        {
            const int nt = wid >> 1;
            const f32x4 pl = *(const f32x4*)(PL + nt * 16 + fq * 4);
#pragma unroll
            for (int q2 = 0; q2 < 2; ++q2) {
                const int vt = (wid & 1) * 2 + q2;
                Sacc[q2] = Sacc[q2] * pl;
#pragma unroll
                for (int k = 0; k < 2; ++k) Sacc[q2] = mma16(ldfrag(BKh, RW_LP, nt * 16, k * 32, fr, fq), ldfrag(ZVT, RW_LP, vt * 16, k * 32, fr, fq), Sacc[q2]);
                st4bf(Sb + (vt * 16 + fr) * RW_LP + nt * 16 + fq * 4, Sacc[q2]);
            }
        }
        if (t0 >= CTXL) {
            const int vt = wid >> 1, tt = wid & 1;
            f32x4 acc = (f32x4){0.f, 0.f, 0.f, 0.f};
            acc = mma16(ldfrag(ZVT, RW_LP, vt * 16, 0, fr, fq), ldfrag(ARB, 40, tt * 16, 0, fr, fq), acc);
            const int t = tt * 16 + fr, v0 = vt * 16 + fq * 4;
#pragma unroll
            for (int rr = 0; rr < 4; ++rr) acc[rr] += YB[t * 64 + v0 + rr];
            const int tn = scan_t<32>(dir, ci, t);
            st4bf(OUT + ((size_t)bl * SEQ + (tn - CTXL)) * 1024 + h * 64 + v0, acc);
        }
        __syncthreads();
    }
#undef RW_PREFETCH
}

__device__ __forceinline__ void phase_mix_cd(const KP& kp, unsigned char* lds, int which) {
    if (which & 1) for (int u = obid(); u < 256; u += gridDim.x) { rwkv_unit(kp, lds, u >> 5, (u >> 1) & 15, u & 1); __syncthreads(); }
    if (which & 2) for (int u = obid(); u < 1024; u += gridDim.x) { attn_unit(kp, lds, u >> 7, (u >> 4) & 7, u & 15); __syncthreads(); }
}

struct EpiFinCD {
    const bf16_t* OF; const bf16_t* OB; const bf16_t* P; const float* BSC; const float* ln; const float* mu; bf16_t* AOUT;
    __device__ __forceinline__ void operator()(const f32x4 (&acc)[4][4], int rb, int cb, int fr, int fq) const {
        const int head = cb >> 6;
#pragma unroll
        for (int i = 0; i < 4; ++i) { const int lr = rb + i * 16 + fr, s = lr & 2047;
            const size_t prow = (size_t)(lr >> 11) * TT + CTXL + s;
            f32x4 o[4]; float ss = 0.f;
#pragma unroll
            for (int j = 0; j < 4; ++j) { const int col = cb + j * 16 + fq * 4;
                o[j] = ld4bf(OF + (size_t)lr * 1024 + col) + ld4bf(OB + (size_t)lr * 1024 + col);
                ss += o[j][0] * o[j][0] + o[j][1] * o[j][1] + o[j][2] * o[j][2] + o[j][3] * o[j][3]; }
            ss += __shfl_xor(ss, 16); ss += __shfl_xor(ss, 32);
            const float rstd = rsqrtf(ss * (1.0f / 64.0f) + EPS);
            const float bon = BSC[(size_t)lr * 16 + head] + BSC[(size_t)RGL * 16 + (size_t)lr * 16 + head];
#pragma unroll
            for (int j = 0; j < 4; ++j) { const int col = cb + j * 16 + fq * 4;
                const bf16_t* pv = P + prow * CD_N + CD_V + col;
                const f32x4 v = ld4bf(pv);
                const f32x4 vp = s > 0 ? ld4bf(pv - CD_N) : (f32x4){0.f, 0.f, 0.f, 0.f};
                const f32x4 vn = s < SEQ - 1 ? ld4bf(pv + CD_N) : (f32x4){0.f, 0.f, 0.f, 0.f};
                const f32x4 vl = v + *(const f32x4*)(mu + 2048 + col) * ((vp + vn) * 0.5f - v);
                const f32x4 y = o[j] * rstd * *(const f32x4*)(ln + col) + vl * bon;
                st4bf(AOUT + (size_t)lr * 1536 + 512 + col, y * acc[i][j]); }
        }
    }
};
PHASE_FN void phase_fin_cd(const KP& kp, unsigned char* lds) {
    GA ga{WSP(const bf16_t, WS_SG), nullptr, 128, 0, 128, nullptr, RGL, 0, 0};
    EpiFinCD ep{WSP(const bf16_t, WS_BIG + L1_OF), WSP(const bf16_t, WS_BIG + L1_OB), WSP(const bf16_t, WS_BIG + L1_P), WSP(const float, WS_BSC), kp.in[33], kp.in[24], WSP(bf16_t, WS_BIG + L1_AOUT)};
    for (int u = obid(); u < (RGL / 256) * 8; u += gridDim.x) gemm_tile(lds, ga, WSP(const bf16_t, WS_WMIX + WM_G2), 128, u >> 3, u & 7, ep);
}
PHASE_FN void phase_gemm_out_cd(const KP& kp, unsigned char* lds) {
    pg8::Gemm g{WSP(const bf16_t, WS_BIG + L1_AOUT), WSP(const bf16_t, WS_WMIX + WM_CD_OUT), RGL, 1024, 1536, nullptr, 0x7fffffff};
    pg8::StaticOrder S; S.init(RGL, 1024, (int)gridDim.x, obid());
    pg8::EpiBfG E{WSP(bf16_t, WS_BIG + L1_U), 1024, 1024, 0x7fffffff};
    pg8::gemm_phase<pg8::EpiBfG, pg8::StaticOrder, false>((PG8_LAS unsigned char*)lds, g, S, E, nullptr);
    __syncthreads();
}

__device__ __attribute__((noinline)) void grid_sync(unsigned* barw, unsigned x, volatile LAS unsigned* st) { XcdBarrier b; b.bar = barw; b.x = x; b.st = st; xcd_barrier(b); }
constexpr int N_PHASES = 39;
__global__ void __launch_bounds__(512, 2) fwd_kernel(KP kparg) {
    extern __shared__ __attribute__((aligned(16))) unsigned char lds[];
    const int lo = kparg.ph_lo, hi = kparg.ph_hi;
    KP* skp = (KP*)(lds + LDS_BYTES - 1024);
    if (threadIdx.x == 0) {
#pragma unroll
        for (int i = 0; i < 42; ++i) skp->in[i] = kparg.in[i];
        skp->out = kparg.out; skp->ws = kparg.ws; skp->ph_lo = lo; skp->ph_hi = hi; }
    const KP& kp = *skp;
    volatile LAS unsigned* xbst = (volatile LAS unsigned*)(LAS unsigned char*)(lds + LDS_BYTES - 16);
    if (threadIdx.x == 0) { xbst[0] = 0u; xbst[1] = 0u; }
    __syncthreads();
    XcdBarrier bar; bar.bar = (unsigned*)kparg.ws; bar.x = 0; bar.st = xbst;
    if (hi - lo > 1) bar = xcd_barrier_post((unsigned*)kparg.ws, xbst);
#define IN(k) (lo <= (k) && (k) < hi)
#define SEAM(k) do { if (IN(k) && IN((k) + 1)) { grid_sync((unsigned*)kp.ws, bar.x, xbst); if (PROBE_DUP & 512) grid_sync((unsigned*)kp.ws, bar.x, xbst); } } while (0)
#define PHASE(...) do { if (IN(ph)) { __VA_ARGS__ } SEAM(ph); ++ph; } while (0)
    int ph = 0;
    PHASE(phase_mod(kp, lds); __syncthreads(); phase_conv_ab(kp, lds););
#pragma unroll
    for (int g = 0; g < NG; ++g) {
        PHASE(phase_u(kp, 0, g););
        PHASE(phase_gemm_in(kp, lds, 0); if (PROBE_DUP & 8) phase_gemm_in(kp, lds, 0););
        PHASE(phase_xconv(kp););
        PHASE(phase_scan_ab(kp, lds); if (PROBE_DUP & 1) { __syncthreads(); phase_scan_ab(kp, lds); });
        PHASE(phase_fin_ab(kp););
        PHASE(phase_gemm_out_ab(kp, lds););
        PHASE(phase_r(kp, lds, 0, g););
    }
    PHASE(phase_moe_gather(kp, 0); phase_conv_moe(kp, lds, 0); phase_conv_cd(kp, lds););
    PHASE(phase_moe_gemm(kp, lds, 0, false); if (PROBE_DUP & 16) { __syncthreads(); phase_moe_gemm(kp, lds, 0, false); });
    PHASE(phase_moe_gemm(kp, lds, 0, true); if (PROBE_DUP & 16) { __syncthreads(); phase_moe_gemm(kp, lds, 0, true); });
    PHASE(phase_combine(kp, 0););
#pragma unroll
    for (int g = 0; g < NG; ++g) {
        PHASE(phase_u(kp, 1, g););
        PHASE(phase_gemm_in(kp, lds, 1); if (PROBE_DUP & 8) phase_gemm_in(kp, lds, 1););
        PHASE(phase_prep_cd(kp););
        PHASE(phase_upproj(kp, lds););
        PHASE(phase_mix_cd(kp, lds, 3); if (PROBE_DUP & 2) { __syncthreads(); phase_mix_cd(kp, lds, 1); } if (PROBE_DUP & 4) { __syncthreads(); phase_mix_cd(kp, lds, 2); });
        PHASE(phase_fin_cd(kp, lds););
        PHASE(phase_gemm_out_cd(kp, lds););
        PHASE(phase_r(kp, lds, 1, g););
    }
    PHASE(phase_moe_gather(kp, 1); phase_conv_moe(kp, lds, 1););
    PHASE(phase_moe_gemm(kp, lds, 1, false););
    PHASE(phase_moe_gemm(kp, lds, 1, true););
    PHASE(phase_combine(kp, 1););
#undef PHASE
#undef IN
#undef SEAM
}

extern "C" void kernel_launch(void* const* d_in, const int* in_sizes, int n_in, void* d_out, int out_size, void* d_ws, size_t ws_size, hipStream_t stream) {
    static int grid = 0;
    if (grid == 0) {
        if (n_in != 42 || out_size != NLAT * D || ws_size < WS_NEED) { fprintf(stderr, "kernel_launch: unexpected shapes: n_in %d out %d ws %zu (need %zu)\n", n_in, out_size, ws_size, (size_t)WS_NEED); grid = -1; return; }
        int dev = 0, cus = 0, per_cu = 0;
        if (hipGetDevice(&dev) != hipSuccess || hipDeviceGetAttribute(&cus, hipDeviceAttributeMultiprocessorCount, dev) != hipSuccess) { grid = -1; return; }
        if (hipFuncSetAttribute((const void*)fwd_kernel, hipFuncAttributeMaxDynamicSharedMemorySize, LDS_BYTES) != hipSuccess) { fprintf(stderr, "kernel_launch: hipFuncSetAttribute failed\n"); grid = -1; return; }
        if (hipOccupancyMaxActiveBlocksPerMultiprocessor(&per_cu, (const void*)fwd_kernel, 512, LDS_BYTES) != hipSuccess || per_cu < 1) { fprintf(stderr, "kernel_launch: occupancy query says %d blocks per CU\n", per_cu); grid = -1; (void)hipGetLastError(); return; }
        grid = cus;
    }
    if (grid < 0) return;
    (void)hipMemsetAsync(d_ws, 0, CTL_BYTES, stream);
    KP kp{};
    for (int i = 0; i < 42; ++i) kp.in[i] = (const float*)d_in[i];
    kp.out = (float*)d_out; kp.ws = (unsigned char*)d_ws;
#if N_LAUNCH_MODE == 1
    kp.ph_lo = 0; kp.ph_hi = N_PHASES;
    hipLaunchKernelGGL(fwd_kernel, dim3(grid), dim3(512), LDS_BYTES, stream, kp);
#else
    for (int p = 0; p < N_PHASES; ++p) { kp.ph_lo = p; kp.ph_hi = p + 1; hipLaunchKernelGGL(fwd_kernel, dim3(grid), dim3(512), LDS_BYTES, stream, kp); }
#endif
}
```

```cpp
#include <hip/hip_runtime.h>
#include <stdint.h>
#include <stdio.h>

typedef unsigned short bf16_t;
typedef short bf16x8 __attribute__((ext_vector_type(8)));
typedef float f32x4 __attribute__((ext_vector_type(4)));
typedef float f32x2 __attribute__((ext_vector_type(2)));
typedef unsigned u32x4 __attribute__((ext_vector_type(4)));
typedef unsigned u32x2 __attribute__((ext_vector_type(2)));

#ifndef RWP
#define RWP 0
#endif
#ifndef PROBE_DUP
#define PROBE_DUP 0
#endif
#ifndef N_LAUNCH_MODE
#define N_LAUNCH_MODE 1
#endif

constexpr int NB = 16, SEQ = 2048, CTXL = 256, TT = 2304, D = 1024;
constexpr int NTOK = NB * TT, NLAT = NB * SEQ;
constexpr int NG = 2, BG = NB / NG, RG = BG * TT, RGL = BG * SEQ;
constexpr float EPS = 1e-6f;
constexpr int AB_N = 5424, AB_NPAD = 5632, AB_Q = 0, AB_K = 512, AB_V = 1024, AB_OG = 2048, AB_IG = 3072, AB_FG = 3080, AB_Z = 3088, AB_XBC = 4112, AB_DT = 5392;
constexpr int CD_N = 4128, CD_NPAD = 4352, CD_M0 = 0, CD_M1 = 384, CD_KR = 640, CD_R = 672, CD_K = 1696, CD_V = 2720, CD_WL = 3744, CD_AL = 3872, CD_GL = 4000;
constexpr int CD_RW0 = 672;

constexpr size_t CTL_BYTES = 32768;
constexpr size_t CTL_CNT = 16384;
constexpr size_t WS_MODV = CTL_BYTES;
constexpr size_t WS_HC   = WS_MODV + (size_t)2 * 17 * 6144 * 4;
constexpr size_t WS_TOKE = WS_HC + (size_t)NB * CTXL * D * 4;
constexpr size_t WS_TOKP = WS_TOKE + (size_t)NTOK * 2 * 4;
constexpr size_t WS_TOKW = WS_TOKP + (size_t)NTOK * 2 * 4;
constexpr size_t WS_LIST = WS_TOKW + (size_t)NTOK * 2 * 4;
constexpr size_t WS_BSC  = WS_LIST + (size_t)16 * NTOK * 4;
constexpr size_t WS_SG   = WS_BSC + (size_t)2 * RGL * 16 * 4;
constexpr size_t WS_WMIX = WS_SG + (size_t)RGL * 128 * 2;
constexpr size_t WMIX_BYTES = (size_t)16 << 20;
constexpr size_t WS_V    = WS_WMIX + WMIX_BYTES;
constexpr size_t WS_BIG  = WS_V + (size_t)NTOK * D * 2;
constexpr size_t WM_AB_IN = 0, WM_AB_OUT = (size_t)AB_NPAD * 1024 * 2;
constexpr size_t WM_CD_IN = 0, WM_CD_OUT = (size_t)CD_NPAD * 1024 * 2, WM_UQ = WM_CD_OUT + (size_t)1024 * 1536 * 2, WM_UKV = WM_UQ + (size_t)768 * 384 * 2, WM_G2 = WM_UKV + (size_t)1024 * 256 * 2;
static_assert(WM_AB_OUT + (size_t)1024 * 2048 * 2 <= WMIX_BYTES, "wmix ab");
static_assert(WM_G2 + (size_t)1024 * 128 * 2 <= WMIX_BYTES, "wmix cd");
constexpr size_t SZ_RG1K = (size_t)RG * 1024 * 2, SZ_RGL1K = (size_t)RGL * 1024 * 2;
constexpr size_t L0_P = 0, L0_AO = (size_t)RG * AB_N * 2  , L0_HB = L0_AO + 2 * SZ_RG1K, L0_YB = L0_HB + SZ_RG1K, L0_U = L0_YB + SZ_RG1K, L0_END = L0_U + SZ_RG1K;
constexpr size_t L1_P = 0, L1_Q = (size_t)RG * CD_N * 2, L1_KV = L1_Q + (size_t)RGL * 768 * 2, L1_OF = L1_KV + SZ_RG1K, L1_OB = L1_OF + SZ_RGL1K, L1_AOUT = L1_OB + SZ_RGL1K, L1_U = L1_AOUT + (size_t)RGL * 1536 * 2, L1_END = L1_U + SZ_RG1K;
constexpr int MOE_PADROWS = 16 * 256;
constexpr size_t MO_WUP = 0, MO_WDN = (size_t)17 * 1024 * 1024 * 2, MO_HID = MO_WDN + (size_t)17 * 1024 * 512 * 2;
constexpr size_t MO_XG = MO_HID + (size_t)(3 * NTOK + MOE_PADROWS) * 512 * 2;
constexpr size_t MO_CON = MO_XG, MO_END = MO_CON + (size_t)(3 * NTOK + MOE_PADROWS) * 1024 * 2;
constexpr size_t BIG_BYTES = MO_END > L0_END ? (MO_END > L1_END ? MO_END : L1_END) : (L0_END > L1_END ? L0_END : L1_END);
constexpr size_t WS_NEED = WS_BIG + BIG_BYTES;

constexpr int LDS_BYTES = 147456;

__device__ __forceinline__ float bf2f(unsigned short h) { return __uint_as_float(((unsigned)h) << 16); }
typedef __bf16 bf16v2_t __attribute__((ext_vector_type(2)));
__device__ __forceinline__ unsigned pack2(float a, float b) { const bf16v2_t h = __builtin_convertvector((f32x2){a, b}, bf16v2_t); return __builtin_bit_cast(unsigned, h); }
__device__ __forceinline__ unsigned short f2bf(float f) { const __bf16 h = (__bf16)f; return __builtin_bit_cast(unsigned short, h); }
__device__ __forceinline__ float lo2f(unsigned w) { return __uint_as_float(w << 16); }
__device__ __forceinline__ float hi2f(unsigned w) { return __uint_as_float(w & 0xffff0000u); }
__device__ __forceinline__ float wsum(float v) {
#pragma unroll
    for (int o = 32; o; o >>= 1) v += __shfl_xor(v, o);
    return v; }
__device__ __forceinline__ float frcp_(float x) { return __builtin_amdgcn_rcpf(x); }
__device__ __forceinline__ float sigmoidf_(float x) { return __builtin_amdgcn_rcpf(1.0f + __expf(-x)); }
__device__ __forceinline__ float siluf_(float x) { return x * __builtin_amdgcn_rcpf(1.0f + __expf(-x)); }
__device__ __forceinline__ float softplusf_(float x) { return fmaxf(x, 0.0f) + __logf(1.0f + __expf(-fabsf(x))); }
__device__ __forceinline__ float logsigmoidf_(float x) { return fminf(x, 0.0f) - __logf(1.0f + __expf(-fabsf(x))); }
__device__ __forceinline__ float tanhf_(float x) { return 1.0f - 2.0f * __builtin_amdgcn_rcpf(__expf(2.0f * x) + 1.0f); }
__device__ __forceinline__ f32x4 mma16(bf16x8 a, bf16x8 b, f32x4 c) { return __builtin_amdgcn_mfma_f32_16x16x32_bf16(a, b, c, 0, 0, 0); }
__device__ __forceinline__ bf16x8 ldfrag(const bf16_t* base, int ld, int row0, int k0, int fr, int fq) { return *(const bf16x8*)(base + (row0 + fr) * ld + k0 + fq * 8); }
__device__ __forceinline__ void st4bf(bf16_t* p, f32x4 v) { u32x2 w; w.x = pack2(v[0], v[1]); w.y = pack2(v[2], v[3]); *(u32x2*)p = w; }
__device__ __forceinline__ f32x4 ld4bf(const bf16_t* p) { u32x2 w = *(const u32x2*)p; return (f32x4){lo2f(w.x), hi2f(w.x), lo2f(w.y), hi2f(w.y)}; }

#define PHASE_FN __device__ __forceinline__
__device__ __forceinline__ int otid() { int t = threadIdx.x; asm volatile("" : "+v"(t)); return t; }
__device__ __forceinline__ int obid() { int t = blockIdx.x; asm volatile("" : "+s"(t)); return t; }
template <class T> __device__ __forceinline__ T* as_global(T* p) { return p; }
struct KP { const float* in[42]; float* out; unsigned char* ws; int ph_lo, ph_hi; };

#define XB_TMO      128
#define XB_XCNT(j)  (256  + 64 * (j))
#define XB_XSUB(j)  (1280 + 64 * (j))
#define XB_XGEN(j)  (2304 + 64 * (j))
#define XB_TOP      3328
#define XB_TOPGEN   3392
#define XCD_BAR_WORDS 3456
#define XB_SPIN_CAP (1u << 18)
#define LAS __attribute__((address_space(3)))

__device__ __forceinline__ unsigned xb_ld(unsigned* p)              { return __hip_atomic_load(p, __ATOMIC_RELAXED, __HIP_MEMORY_SCOPE_AGENT); }
__device__ __forceinline__ unsigned xb_add(unsigned* p, unsigned v) { return __hip_atomic_fetch_add(p, v, __ATOMIC_RELAXED, __HIP_MEMORY_SCOPE_AGENT); }
__device__ __forceinline__ unsigned xb_xcc_id() { return (unsigned)__builtin_amdgcn_s_getreg((3 << 11) | 20) & 0xFu; }
#define XB_SPIN(cond, bar) do { unsigned _sp = 0; while (cond) { __builtin_amdgcn_s_sleep(1); \
    if ((++_sp & 255u) == 0u) { if (xb_ld(&(bar)[XB_TMO])) break; if (_sp > XB_SPIN_CAP) { atomicAdd(&(bar)[XB_TMO], 1u); break; } } } } while (0)

struct XcdBarrier {
    unsigned* bar; unsigned x;
    volatile LAS unsigned* st;
};

__device__ __forceinline__ XcdBarrier xcd_barrier_post(unsigned* bar, volatile LAS unsigned* st) {
    XcdBarrier b; b.bar = bar; b.x = xb_xcc_id(); b.st = st;
    if (threadIdx.x == 0) (void)xb_add(&bar[XB_XCNT(b.x)], 1u);
    return b;
}
__device__ __forceinline__ void xcd_barrier_complete(unsigned* bar, unsigned x, unsigned& nloc, unsigned& nx) {
    const unsigned G = gridDim.x * gridDim.y * gridDim.z;
    unsigned sum, cnt, mine, sp = 0u;
    for (;;) {
        sum = 0u; cnt = 0u; mine = 0u;
#pragma unroll
        for (unsigned j = 0; j < 16; ++j) { const unsigned c = xb_ld(&bar[XB_XCNT(j)]); sum += c; cnt += (c > 0u) ? 1u : 0u; mine = (j == x) ? c : mine; }
        if (sum == G) break;
        __builtin_amdgcn_s_sleep(1);
        if ((++sp & 255u) == 0u) { if (xb_ld(&bar[XB_TMO])) break; if (sp > XB_SPIN_CAP) { atomicAdd(&bar[XB_TMO], 1u); break; } }
    }
    nloc = mine > 0u ? mine : 1u; nx = cnt > 0u ? cnt : 1u;
}

__device__ __forceinline__ void xcd_barrier(const XcdBarrier& b) {
    asm volatile("s_waitcnt vmcnt(0)" ::: "memory");
    __syncthreads();
    if (threadIdx.x == 0) {
        unsigned* bar = b.bar;
        __builtin_amdgcn_s_waitcnt(0);
        unsigned nloc = b.st[0], nx = b.st[1];
        if (nloc == 0u) { xcd_barrier_complete(bar, b.x, nloc, nx); b.st[0] = nloc; b.st[1] = nx; }
        const unsigned old = xb_add(&bar[XB_XSUB(b.x)], 1u);
        const unsigned gen = old / nloc;
        if (old + 1u == (gen + 1u) * nloc) {
            __builtin_amdgcn_fence(__ATOMIC_RELEASE, "agent");
            asm volatile("s_waitcnt vmcnt(0)" ::: "memory");
            const unsigned og = xb_add(&bar[XB_TOP], 1u);
            const unsigned tg = og / nx;
            if (og + 1u == (tg + 1u) * nx) xb_add(&bar[XB_TOPGEN], 1u);
            else XB_SPIN(xb_ld(&bar[XB_TOPGEN]) == tg, bar);
            __builtin_amdgcn_fence(__ATOMIC_ACQUIRE, "agent");
            xb_add(&bar[XB_XGEN(b.x)], 1u);
            asm volatile("s_waitcnt vmcnt(0)" ::: "memory");
        } else {
            XB_SPIN(xb_ld(&bar[XB_XGEN(b.x)]) == gen, bar);
            __builtin_amdgcn_fence(__ATOMIC_ACQUIRE, "agent");
            asm volatile("s_waitcnt vmcnt(0)" ::: "memory");
        }
    }
    __syncthreads();
}
struct GA {
    const bf16_t* a0; const bf16_t* a1;
    int ld0, ld1, ksplit;
    const int* list;
    int nrows;
    int mode;
    int row0;
};
constexpr int G_LDT = 40;
constexpr int GEMM_LDS = (2 * 256 * G_LDT + 2 * 128 * G_LDT) * 2;

template <class Epi>
__device__ __forceinline__ void gemm_tile(unsigned char* lds, const GA& ga, const bf16_t* __restrict__ Bt, int K, int mt, int nt, const Epi& epi) {
    const int tid = otid(), lane = tid & 63, wid = tid >> 6, wm = wid >> 1, wn = wid & 1, fr = lane & 15, fq = lane >> 4;
    bf16_t* sA = (bf16_t*)lds;
    bf16_t* sB = sA + 2 * 256 * G_LDT;
    const int kp = tid & 3;
    const int r0 = tid >> 2, r1 = r0 + 128;
    int s0, s1;
    {
        int lr = mt * 256 + r0; if (lr >= ga.nrows) lr = 0;
        s0 = ga.list ? ga.list[lr] : (ga.mode == 1 ? (lr >> 11) * TT + CTXL + (lr & 2047) : ga.row0 + lr);
        lr = mt * 256 + r1; if (lr >= ga.nrows) lr = 0;
        s1 = ga.list ? ga.list[lr] : (ga.mode == 1 ? (lr >> 11) * TT + CTXL + (lr & 2047) : ga.row0 + lr);
    }
    const bf16_t* pa00 = ga.a0 + (size_t)s0 * ga.ld0 + kp * 8;
    const bf16_t* pa01 = ga.a0 + (size_t)s1 * ga.ld0 + kp * 8;
    const bf16_t* pa10 = ga.a1 ? ga.a1 + (size_t)s0 * ga.ld1 + kp * 8 : pa00;
    const bf16_t* pa11 = ga.a1 ? ga.a1 + (size_t)s1 * ga.ld1 + kp * 8 : pa01;
    const bf16_t* pb = Bt + (size_t)(nt * 128 + r0) * K + kp * 8;
    const int ksplit = ga.ksplit;
    f32x4 acc[4][4];
#pragma unroll
    for (int i = 0; i < 4; ++i)
#pragma unroll
        for (int j = 0; j < 4; ++j) acc[i][j] = (f32x4){0.f, 0.f, 0.f, 0.f};
    const int nk = K >> 5;
    u32x4 ra0, ra1, rb;
    {
        ra0 = *(const u32x4*)(pa00); ra1 = *(const u32x4*)(pa01); rb = *(const u32x4*)(pb);
        if (0 >= ksplit) { ra0 = *(const u32x4*)(pa10); ra1 = *(const u32x4*)(pa11); }
    }
    *(u32x4*)(sA + (r0) * G_LDT + kp * 8) = ra0;
    *(u32x4*)(sA + (r1) * G_LDT + kp * 8) = ra1;
    *(u32x4*)(sB + (r0) * G_LDT + kp * 8) = rb;
    __syncthreads();
    for (int kt = 0; kt < nk; ++kt) {
        const int cur = kt & 1;
        if (kt + 1 < nk) {
            const int k0 = (kt + 1) << 5;
            if (k0 < ksplit) { ra0 = *(const u32x4*)(pa00 + k0); ra1 = *(const u32x4*)(pa01 + k0); }
            else { ra0 = *(const u32x4*)(pa10 + (k0 - ksplit)); ra1 = *(const u32x4*)(pa11 + (k0 - ksplit)); }
            rb = *(const u32x4*)(pb + k0);
        }
        const bf16_t* cA = sA + cur * 256 * G_LDT;
        const bf16_t* cB = sB + cur * 128 * G_LDT;
        bf16x8 af[4], bfr[4];
#pragma unroll
        for (int i = 0; i < 4; ++i) af[i] = ldfrag(cA, G_LDT, wm * 64 + i * 16, 0, fr, fq);
#pragma unroll
        for (int j = 0; j < 4; ++j) bfr[j] = ldfrag(cB, G_LDT, wn * 64 + j * 16, 0, fr, fq);
#pragma unroll
        for (int i = 0; i < 4; ++i)
#pragma unroll
            for (int j = 0; j < 4; ++j) acc[i][j] = mma16(bfr[j], af[i], acc[i][j]);
        if (kt + 1 < nk) {
            const int nb = cur ^ 1;
            *(u32x4*)(sA + (nb * 256 + r0) * G_LDT + kp * 8) = ra0;
            *(u32x4*)(sA + (nb * 256 + r1) * G_LDT + kp * 8) = ra1;
            *(u32x4*)(sB + (nb * 128 + r0) * G_LDT + kp * 8) = rb;
        }
        __syncthreads();
    }
    epi(acc, mt * 256 + wm * 64, nt * 128 + wn * 64, fr, fq);
}

struct EpiBf {
    bf16_t* out; int ld, nrows, ncols;
    __device__ __forceinline__ void operator()(const f32x4 (&acc)[4][4], int rb, int cb, int fr, int fq) const {
#pragma unroll
        for (int i = 0; i < 4; ++i) { const int lr = rb + i * 16 + fr; if (lr < nrows) {
#pragma unroll
            for (int j = 0; j < 4; ++j) { const int col = cb + j * 16 + fq * 4; if (col < ncols) st4bf(out + (size_t)lr * ld + col, acc[i][j]); } } }
    }
};
struct EpiSwiglu {
    bf16_t* out; int nrows;
    __device__ __forceinline__ void operator()(const f32x4 (&acc)[4][4], int rb, int cb, int fr, int fq) const {
#pragma unroll
        for (int i = 0; i < 4; ++i) { const int lr = rb + i * 16 + fr; if (lr < nrows) {
#pragma unroll
            for (int j = 0; j < 2; ++j) { const int col = (cb >> 1) + j * 16 + fq * 4; f32x4 g = acc[i][j], u = acc[i][j + 2], o;
#pragma unroll
                for (int r = 0; r < 4; ++r) o[r] = siluf_(g[r]) * u[r];
                st4bf(out + (size_t)lr * 512 + col, o); } } }
    }
};

namespace pg8 {
#define PG8_LAS __attribute__((address_space(3)))
typedef unsigned short bf16_t;
typedef short bf16x8 __attribute__((ext_vector_type(8)));
typedef float f32x4 __attribute__((ext_vector_type(4)));
typedef unsigned u32x4 __attribute__((ext_vector_type(4)));
constexpr int BM = 256, BK = 64, HALF = 128, HTB = HALF * BK * 2  , STAGE_BYTES = 8 * HTB, NXCD = 8, WGM = 8;

__host__ __device__ __forceinline__ int lds_byte(int r, int c) { const int st = (r >> 4) * 2 + (c >> 5), rr = r & 15, cc = c & 31, ob = rr * 64 + cc * 2; return st * 1024 + (ob ^ (((ob >> 9) & 1) << 5)); }
__host__ __device__ __forceinline__ void stage_rc(int b, int& R, int& C) { const int st = b / 1024, sb = b % 1024, swz = sb ^ (((sb >> 9) & 1) << 5); R = (st >> 1) * 16 + swz / 64; C = (st & 1) * 32 + (swz % 64) / 2; }
__host__ __device__ __forceinline__ int perm32(int rho) { const int n = rho >> 4, i = rho & 15; return 8 * (i >> 2) + 4 * n + (i & 3); }

struct Unit { int pm, pn; };
struct Gemm { const bf16_t* A; const bf16_t* Bt; int M, N, K; const bf16_t* A2; int pm_split; };
#define PG8_ABASE(g, pm) ((pm) < (g).pm_split ? (const char*)(g).A + (size_t)(pm) * tstep : (const char*)(g).A2 + (size_t)((pm) - (g).pm_split) * tstep)
struct StaticOrder {
    int nM, nN, nwg, G, c;
    __host__ __device__ void init(int M, int N, int G_, int c_) { nM = M / BM; nN = N / BM; nwg = nM * nN; G = G_; c = c_; }
    __host__ __device__ bool next(int i, Unit& u) const {
        const long L = (long)i * G + c; if (L >= nwg) return false;
        int wgid = (int)L; { const int q = nwg / NXCD, r = nwg % NXCD, xcd = wgid % NXCD, off = wgid / NXCD; wgid = (xcd < r ? xcd * (q + 1) : r * (q + 1) + (xcd - r) * q) + off; }
        const int nig = WGM * nN, gid = wgid / nig, fm = gid * WGM, gsz = (nM - fm) < WGM ? (nM - fm) : WGM;
        u.pm = fm + ((wgid % nig) % gsz); u.pn = (wgid % nig) / gsz; return true;
    }
    __device__ __forceinline__ void a_ready(const Unit&) const {}
    __device__ __forceinline__ void done(const Unit&) const {}
};
__device__ __forceinline__ unsigned cvt_pk_bf16(float lo, float hi) { unsigned r; asm volatile("v_cvt_pk_bf16_f32 %0, %1, %2" : "=v"(r) : "v"(lo), "v"(hi)); return r; }
typedef float f32x2 __attribute__((ext_vector_type(2)));
template <class Epi, class Sched, bool STAMP = false>
__device__ __forceinline__ void gemm_phase(PG8_LAS unsigned char* lds, const Gemm g, const Sched& S, const Epi& E, unsigned long long* stamps) {
    const int tid = otid(), wid = __builtin_amdgcn_readfirstlane(tid >> 6), lane = tid & 63, wr = wid >> 2, wc = wid & 3, fr = lane & 15, fq = lane >> 4;
    const int K = g.K, nt = K / BK;
    int ts_lo = 0, ts_hi = 0, nts = 0; const unsigned long long rt_entry = STAMP ? (unsigned long long)wall_clock64() : 0ull;
#define PG8_STAMP() do { if (STAMP && wid == 0 && nts < 64) { const unsigned long long _c = (unsigned long long)clock64(); \
        ts_lo = (lane == nts) ? (int)(unsigned)_c : ts_lo; ts_hi = (lane == nts) ? (int)(unsigned)(_c >> 32) : ts_hi; ++nts; } } while (0)
    PG8_STAMP();
    unsigned voffA[2], voffB[2];
#pragma unroll
    for (int i = 0; i < 2; ++i) { int R, C; stage_rc(tid * 16 + i * 8192, R, C); const int Rb = Epi::PERM ? ((R & ~31) + perm32(R & 31)) : R;
        voffA[i] = (unsigned)(R * K + C) * 2u; voffB[i] = (unsigned)(Rb * K + C) * 2u; }
    const size_t kstep = (size_t)(BK * 2);
    const size_t hstep = (size_t)HALF * K * 2;
    const size_t tstep = 2 * hstep;
    const unsigned ldsw = (unsigned)wid * 1024u;
    const int aoff = lds_byte(wr * 64 + fr, fq * 8), boff = lds_byte(wc * 32 + fr, fq * 8);
#define PG8_SA(b, h) (((b) * 2 + (h)) * HTB)
#define PG8_SB(b, h) ((4 + (b) * 2 + (h)) * HTB)
#define PG8_STAGE(bufoff, gbase, voff) do { _Pragma("unroll") for (int _i = 0; _i < 2; ++_i) \
        __builtin_amdgcn_global_load_lds((const unsigned*)((const char*)(gbase) + (voff)[_i]), (PG8_LAS unsigned*)(lds + (bufoff) + ldsw + _i * 8192), 16, 0, 0); } while (0)
#define PG8_LDA(dst, b, h) do { _Pragma("unroll") for (int m = 0; m < 4; ++m) _Pragma("unroll") for (int k = 0; k < 2; ++k) dst[m][k] = *(const PG8_LAS bf16x8*)(lds + PG8_SA(b, h) + aoff + m * 2048 + k * 1024); } while (0)
#define PG8_LDB(dst, b, h) do { _Pragma("unroll") for (int n = 0; n < 2; ++n) _Pragma("unroll") for (int k = 0; k < 2; ++k) dst[n][k] = *(const PG8_LAS bf16x8*)(lds + PG8_SB(b, h) + boff + n * 2048 + k * 1024); } while (0)
#define PG8_MMA(ai, bj, At, Bt) do { __builtin_amdgcn_s_setprio(1); _Pragma("unroll") for (int m = 0; m < 4; ++m) _Pragma("unroll") for (int n = 0; n < 2; ++n) _Pragma("unroll") for (int k = 0; k < 2; ++k) \
        acc[ai][bj][m][n] = __builtin_amdgcn_mfma_f32_16x16x32_bf16(Bt[n][k], At[m][k], acc[ai][bj][m][n], 0, 0, 0); __builtin_amdgcn_s_setprio(0); } while (0)
#define PG8_WAIT_V(n) asm volatile("s_waitcnt vmcnt(" #n ")" ::: "memory")
#define PG8_WAIT_L(n) asm volatile("s_waitcnt lgkmcnt(" #n ")" ::: "memory")
#define PG8_BAR __builtin_amdgcn_s_barrier()
#define PG8_SCHED __builtin_amdgcn_sched_barrier(0)
    Unit cur, nxt; int ui = 0;
    if (!S.next(0, cur)) return;
    f32x4 acc[2][2][4][2];
#pragma unroll
    for (int a = 0; a < 2; ++a)
#pragma unroll
        for (int b = 0; b < 2; ++b)
#pragma unroll
            for (int m = 0; m < 4; ++m)
#pragma unroll
                for (int n = 0; n < 2; ++n) acc[a][b][m][n] = (f32x4){0.f, 0.f, 0.f, 0.f};
    bf16x8 At[4][2], B0[2][2], B1[2][2];
    const char* cA = PG8_ABASE(g, cur.pm); const char* cB = (const char*)g.Bt + (size_t)cur.pn * tstep;
    S.a_ready(cur);
    PG8_STAGE(PG8_SB(0, 0), cB, voffB); PG8_STAGE(PG8_SA(0, 0), cA, voffA); PG8_STAGE(PG8_SB(0, 1), cB + hstep, voffB); PG8_STAGE(PG8_SA(0, 1), cA + hstep, voffA);
    if (wr == 1) PG8_BAR;
    PG8_WAIT_V(4); PG8_BAR;
    PG8_STAGE(PG8_SB(1, 0), cB + kstep, voffB); PG8_STAGE(PG8_SA(1, 0), cA + kstep, voffA); PG8_STAGE(PG8_SB(1, 1), cB + hstep + kstep, voffB);
    PG8_WAIT_V(6); PG8_BAR;
    PG8_STAMP();
    for (;;) {
        const bool has_next = S.next(ui + 1, nxt);
        const char* nA = has_next ? PG8_ABASE(g, nxt.pm) : cA; const char* nB = has_next ? (const char*)g.Bt + (size_t)nxt.pn * tstep : cB;
        for (int t = 0; t < nt; t += 2) {
            const bool last = (t == nt - 2);
            const char* a1 = cA + (size_t)(t + 1) * kstep;
            const char* a2 = last ? nA : cA + (size_t)(t + 2) * kstep; const char* b2 = last ? nB : cB + (size_t)(t + 2) * kstep;
            const char* a3 = a2 + kstep; const char* b3 = b2 + kstep;
            if (last && has_next) S.a_ready(nxt);
            PG8_LDB(B0, 0, 0); PG8_SCHED; PG8_LDA(At, 0, 0); PG8_STAGE(PG8_SA(1, 1), a1 + hstep, voffA);
            PG8_WAIT_L(8); PG8_BAR; PG8_WAIT_L(0); PG8_MMA(0, 0, At, B0); PG8_BAR; PG8_SCHED;
            PG8_LDB(B1, 0, 1); PG8_STAGE(PG8_SB(0, 0), b2, voffB);
            PG8_BAR; PG8_WAIT_L(0); PG8_MMA(0, 1, At, B1); PG8_BAR;
            PG8_LDA(At, 0, 1); PG8_STAGE(PG8_SA(0, 0), a2, voffA);
            PG8_BAR; PG8_WAIT_L(0); PG8_MMA(1, 0, At, B0); PG8_BAR; PG8_SCHED;
            PG8_STAGE(PG8_SB(0, 1), b2 + hstep, voffB);
            PG8_WAIT_V(6); PG8_BAR; PG8_MMA(1, 1, At, B1); PG8_BAR;
            PG8_LDB(B0, 1, 0); PG8_SCHED; PG8_LDA(At, 1, 0); PG8_STAGE(PG8_SA(0, 1), a2 + hstep, voffA);
            PG8_WAIT_L(8); PG8_BAR; PG8_WAIT_L(0); PG8_MMA(0, 0, At, B0); PG8_BAR; PG8_SCHED;
            PG8_LDB(B1, 1, 1); PG8_STAGE(PG8_SB(1, 0), b3, voffB);
            PG8_BAR; PG8_WAIT_L(0); PG8_MMA(0, 1, At, B1); PG8_BAR;
            PG8_LDA(At, 1, 1); PG8_STAGE(PG8_SA(1, 0), a3, voffA);
            PG8_BAR; PG8_WAIT_L(0); PG8_MMA(1, 0, At, B0); PG8_BAR; PG8_SCHED;
            PG8_STAGE(PG8_SB(1, 1), b3 + hstep, voffB);
            PG8_WAIT_V(6); PG8_BAR; PG8_MMA(1, 1, At, B1); PG8_BAR;
        }
        PG8_STAMP();
        if constexpr (!Epi::AFTER_DRAIN) { E(acc, cur, wr, wc, fr, fq); S.done(cur); }
        PG8_STAMP();
        if (!has_next) break;
#pragma unroll
        for (int a = 0; a < 2; ++a)
#pragma unroll
            for (int b = 0; b < 2; ++b)
#pragma unroll
                for (int m = 0; m < 4; ++m)
#pragma unroll
                    for (int n = 0; n < 2; ++n) acc[a][b][m][n] = (f32x4){0.f, 0.f, 0.f, 0.f};
        cur = nxt; cA = nA; cB = nB; ++ui;
    }
    PG8_WAIT_V(0);
    if (wr == 0) PG8_BAR;
    PG8_BAR;
    if constexpr (Epi::AFTER_DRAIN) { E.fused(acc, cur, wr, wc, fr, fq, lds, wid, lane); S.done(cur); }
    PG8_STAMP();
    if (STAMP && wid == 0) { stamps[lane] = lane < nts ? (((unsigned long long)(unsigned)ts_hi << 32) | (unsigned)ts_lo) : 0ull;
        if (lane == 62) stamps[62] = rt_entry; if (lane == 63) stamps[63] = (unsigned long long)wall_clock64(); }
#undef PG8_STAMP
#undef PG8_SA
#undef PG8_SB
#undef PG8_STAGE
#undef PG8_LDA
#undef PG8_LDB
#undef PG8_MMA
#undef PG8_WAIT_V
#undef PG8_WAIT_L
#undef PG8_BAR
#undef PG8_SCHED
}
}
namespace pg8 {
struct EpiBfG {
    static constexpr bool PERM = true, AFTER_DRAIN = false;
    bf16_t* O; int ldc, ncols, pn_mask;
    __device__ __forceinline__ void operator()(const f32x4 (&acc)[2][2][4][2], const Unit& u, int wr, int wc, int fr, int fq) const {
        const int row0 = u.pm * BM + wr * 64 + fr, col0 = (u.pn & pn_mask) * BM + wc * 32 + 8 * fq;
#pragma unroll
        for (int ai = 0; ai < 2; ++ai)
#pragma unroll
            for (int m = 0; m < 4; ++m) { bf16_t* rowp = O + (size_t)(row0 + ai * HALF + m * 16) * ldc;
#pragma unroll
                for (int bj = 0; bj < 2; ++bj) { const int c = col0 + bj * HALF;
                    if (c < ncols) { const f32x4 v0 = acc[ai][bj][m][0], v1 = acc[ai][bj][m][1];
                        u32x4 w; w.x = cvt_pk_bf16(v0[0], v0[1]); w.y = cvt_pk_bf16(v0[2], v0[3]); w.z = cvt_pk_bf16(v1[0], v1[1]); w.w = cvt_pk_bf16(v1[2], v1[3]);
                        *(u32x4*)(rowp + c) = w; } } }
    }
};
struct EpiSwi {
    static constexpr bool PERM = true, AFTER_DRAIN = false;
    bf16_t* H;
    __device__ __forceinline__ void operator()(const f32x4 (&acc)[2][2][4][2], const Unit& u, int wr, int wc, int fr, int fq) const {
        const int row0 = u.pm * BM + wr * 64 + fr, hc0 = (u.pn & 3) * HALF + wc * 32 + 8 * fq;
#pragma unroll
        for (int ai = 0; ai < 2; ++ai)
#pragma unroll
            for (int m = 0; m < 4; ++m) { bf16_t* rowp = H + (size_t)(row0 + ai * HALF + m * 16) * 512 + hc0;
                float o[8];
#pragma unroll
                for (int n = 0; n < 2; ++n)
#pragma unroll
                    for (int r = 0; r < 4; ++r) { const float g = acc[ai][0][m][n][r]; o[n * 4 + r] = g * __builtin_amdgcn_rcpf(1.0f + __expf(-g)) * acc[ai][1][m][n][r]; }
                u32x4 w; w.x = cvt_pk_bf16(o[0], o[1]); w.y = cvt_pk_bf16(o[2], o[3]); w.z = cvt_pk_bf16(o[4], o[5]); w.w = cvt_pk_bf16(o[6], o[7]);
                *(u32x4*)rowp = w; }
    }
};
struct MoeOrder {
    const int* slotmap; int ntiles, G, c;
    __device__ __forceinline__ bool next(int i, Unit& u) const {
        const int L = i * G + c; if (L >= ntiles * 4) return false;
        u.pm = L >> 2; u.pn = __builtin_amdgcn_readfirstlane(slotmap[L >> 2]) * 4 + (L & 3); return true;
    }
    __device__ __forceinline__ void a_ready(const Unit&) const {}
    __device__ __forceinline__ void done(const Unit&) const {}
};
}
#define WSP(T, off) as_global((T*)(kp.ws + (off)))
#define KIN(i) as_global(kp.in[i])
#define KOUT as_global(kp.out)

PHASE_FN void phase_mod(const KP& kp, unsigned char* lds) {
    float* sc = (float*)lds;
    float* red = sc + 17 * 1024;
    float* modv = WSP(float, WS_MODV);
    const int tid = otid();
    for (int i = tid; i < 17 * 1024; i += 512) { const int bb = i >> 10, k = i & 1023; const float c = bb < 16 ? KIN(1)[bb * 1024 + k] : KIN(3)[k]; sc[i] = siluf_(c); }
    __syncthreads();
    const int jc = tid & 63, ks = tid >> 6;
    for (int u = obid(); u < 192; u += gridDim.x) {
        const int l = u / 96, j0 = (u % 96) * 64;
        const float* w = KIN(4) + (size_t)l * 1024 * 6144 + j0 + jc;
        float acc[17];
#pragma unroll
        for (int bb = 0; bb < 17; ++bb) acc[bb] = 0.f;
        for (int k = ks * 128; k < ks * 128 + 128; ++k) {
            const float wv = w[(size_t)k * 6144];
#pragma unroll
            for (int bb = 0; bb < 17; ++bb) acc[bb] += sc[bb * 1024 + k] * wv;
        }
#pragma unroll
        for (int bb = 0; bb < 17; ++bb) red[(ks * 17 + bb) * 64 + jc] = acc[bb];
        __syncthreads();
        for (int i = tid; i < 17 * 64; i += 512) {
            const int bb = i >> 6, j = i & 63; float s = KIN(5)[l * 6144 + j0 + j];
#pragma unroll
            for (int k2 = 0; k2 < 8; ++k2) s += red[(k2 * 17 + bb) * 64 + j];
            modv[((size_t)l * 17 + bb) * 6144 + j0 + j] = s;
        }
        __syncthreads();
    }
}

struct CvJob { const float* src; bf16_t* dst; int N, ldd, mode, kt, ntile; };
__device__ __forceinline__ bool cv_pick(int& u, CvJob& J, const float* src, int K, int N, bf16_t* dst, int mode = 0, int ldd = -1) {
    const int ntl = (N + 63) >> 6, cnt = ntl * (K >> 6);
    if (u < cnt) { J.src = src; J.dst = dst; J.N = N; J.ldd = ldd < 0 ? K : ldd; J.mode = mode; J.kt = u / ntl; J.ntile = u % ntl; return true; }
    u -= cnt; return false;
}
__device__ __forceinline__ void cv_load(const CvJob& J, int tid, f32x4 (&r)[2]) {
#pragma unroll
    for (int i = 0; i < 2; ++i) { const int idx = tid + i * 512, k = idx >> 4, n0 = J.ntile * 64 + (idx & 15) * 4;
        r[i] = (n0 < J.N) ? *(const f32x4*)(J.src + (size_t)(J.kt * 64 + k) * J.N + n0) : (f32x4){0.f, 0.f, 0.f, 0.f}; }
}
__device__ __forceinline__ void cv_put(float* tile, int tid, const f32x4 (&r)[2]) {
#pragma unroll
    for (int i = 0; i < 2; ++i) { const int idx = tid + i * 512, k = idx >> 4, nq = (idx & 15) * 4;
        tile[k * 65 + nq] = r[i][0]; tile[k * 65 + nq + 1] = r[i][1]; tile[k * 65 + nq + 2] = r[i][2]; tile[k * 65 + nq + 3] = r[i][3]; }
}
__device__ __forceinline__ void cv_store(const float* tile, const CvJob& J, int tid) {
    const int nl = tid >> 3, k8 = tid & 7, n = J.ntile * 64 + nl;
    if (n < J.N) { int row = n; if (J.mode) row = (n >> 7) * 256 + (n & 127) + (J.mode == 2 ? 128 : 0);
        u32x4 w; const float* tp = tile + (k8 * 8) * 65 + nl;
        w.x = pack2(tp[0], tp[65]); w.y = pack2(tp[130], tp[195]); w.z = pack2(tp[260], tp[325]); w.w = pack2(tp[390], tp[455]);
        *(u32x4*)(J.dst + (size_t)row * J.ldd + J.kt * 64 + k8 * 8) = w; }
}
#define CV_RUN(total, PICK) do { float* tile = (float*)lds; const int tid = otid(); const int G_ = gridDim.x; int u_ = obid(); CvJob J, Jn; f32x4 r[2]; \
        if (u_ < (total)) { int u = u_; PICK(u, J); cv_load(J, tid, r); } \
        while (u_ < (total)) { cv_put(tile, tid, r); __syncthreads(); const int un_ = u_ + G_; \
            if (un_ < (total)) { int u = un_; PICK(u, Jn); cv_load(Jn, tid, r); } \
            cv_store(tile, J, tid); __syncthreads(); u_ = un_; J = Jn; } } while (0)
PHASE_FN void phase_conv_ab(const KP& kp, unsigned char* lds) {
#define PICK_AB(u, J) do { if (!cv_pick(u, J, KIN(7), 1024, AB_N, WSP(bf16_t, WS_WMIX + WM_AB_IN))) cv_pick(u, J, KIN(8), 2048, 1024, WSP(bf16_t, WS_WMIX + WM_AB_OUT)); } while (0)
    CV_RUN(16 * 85 + 32 * 16, PICK_AB);
#undef PICK_AB
}
PHASE_FN void phase_conv_cd(const KP& kp, unsigned char* lds) {
#define PICK_CD(u, J) do { if (cv_pick(u, J, KIN(18), 1024, CD_N, WSP(bf16_t, WS_WMIX + WM_CD_IN))) break; \
        if (cv_pick(u, J, KIN(19), 1536, 1024, WSP(bf16_t, WS_WMIX + WM_CD_OUT))) break; \
        if (cv_pick(u, J, KIN(21), 384, 768, WSP(bf16_t, WS_WMIX + WM_UQ))) break; \
        if (cv_pick(u, J, KIN(23), 256, 1024, WSP(bf16_t, WS_WMIX + WM_UKV))) break; \
        cv_pick(u, J, KIN(29), 128, 1024, WSP(bf16_t, WS_WMIX + WM_G2)); } while (0)
    CV_RUN(16 * 65 + 24 * 16 + 6 * 12 + 4 * 16 + 2 * 16, PICK_CD);
#undef PICK_CD
}
PHASE_FN void phase_conv_moe(const KP& kp, unsigned char* lds, int l) {
#define PICK_MOE(u0, J) do { const int es = (u0) / 384; int uu = (u0) % 384; \
        const float* wg = es < 16 ? KIN(36) + ((size_t)l * 16 + es) * 1024 * 512 : KIN(39) + (size_t)l * 1024 * 512; \
        const float* wu = es < 16 ? KIN(37) + ((size_t)l * 16 + es) * 1024 * 512 : KIN(40) + (size_t)l * 1024 * 512; \
        const float* wd = es < 16 ? KIN(38) + ((size_t)l * 16 + es) * 512 * 1024 : KIN(41) + (size_t)l * 512 * 1024; \
        bf16_t* dup = WSP(bf16_t, WS_BIG + MO_WUP) + (size_t)es * 1024 * 1024; bf16_t* ddn = WSP(bf16_t, WS_BIG + MO_WDN) + (size_t)es * 1024 * 512; \
        if (cv_pick(uu, J, wg, 1024, 512, dup, 1, 1024)) break; if (cv_pick(uu, J, wu, 1024, 512, dup, 2, 1024)) break; cv_pick(uu, J, wd, 512, 1024, ddn, 0, 512); } while (0)
    CV_RUN(17 * 384, PICK_MOE);
#undef PICK_MOE
}

__device__ __forceinline__ const float* hrow_rd(const KP& kp, bool from_inputs, int b, int t) {
    if (t < CTXL) return (from_inputs ? KIN(2) : WSP(const float, WS_HC)) + ((size_t)b * CTXL + t) * D;
    return (from_inputs ? KIN(0) : KOUT) + ((size_t)b * SEQ + (t - CTXL)) * D;
}
__device__ __forceinline__ float* hrow_wr(const KP& kp, int b, int t) {
    if (t < CTXL) return WSP(float, WS_HC) + ((size_t)b * CTXL + t) * D;
    return KOUT + ((size_t)b * SEQ + (t - CTXL)) * D;
}

PHASE_FN void phase_u(const KP& kp, int layer, int g) {
    const int lane = otid() & 63, wid = otid() >> 6;
    const float* modv = WSP(const float, WS_MODV) + (size_t)layer * 17 * 6144;
    const float* ng = KIN(6) + (size_t)layer * 4 * 1024;
    bf16_t* U = WSP(bf16_t, WS_BIG + (layer == 0 ? L0_U : L1_U));
    for (int lr = obid() * 8 + wid; lr < RG; lr += gridDim.x * 8) {
        const int bl = lr / TT, t = lr - bl * TT, b = g * BG + bl;
        const float* src = hrow_rd(kp, layer == 0, b, t);
        const float* mv = modv + (size_t)(t < CTXL ? 16 : b) * 6144;
        f32x4 x[4]; float ss = 0.f;
#pragma unroll
        for (int i = 0; i < 4; ++i) { x[i] = *(const f32x4*)(src + i * 256 + lane * 4); ss += x[i][0] * x[i][0] + x[i][1] * x[i][1] + x[i][2] * x[i][2] + x[i][3] * x[i][3]; }
        ss = wsum(ss); const float rstd = rsqrtf(ss * (1.0f / 1024.0f) + EPS);
#pragma unroll
        for (int i = 0; i < 4; ++i) { const int col = i * 256 + lane * 4;
            const f32x4 gv = *(const f32x4*)(ng + col), sc = *(const f32x4*)(mv + 1024 + col), sh = *(const f32x4*)(mv + col);
            st4bf(U + (size_t)lr * 1024 + col, x[i] * rstd * gv * (sc + 1.0f) + sh); }
    }
}

PHASE_FN void phase_r(const KP& kp, unsigned char* lds, int layer, int g) {
    const int tid = otid(), lane = tid & 63, wid = tid >> 6;
    float* rw = (float*)lds;
    int* se = (int*)(rw + 1024 * 16);
    int* sbase = se + 160;
    for (int i = tid; i < 1024 * 16; i += 512) rw[i] = KIN(34)[i];
    __syncthreads();
    const float* modv = WSP(const float, WS_MODV) + (size_t)layer * 17 * 6144;
    const float* ng = KIN(6) + (size_t)layer * 4 * 1024;
    const bf16_t* MIX = WSP(const bf16_t, WS_BIG + (layer == 0 ? L0_U : L1_U));
    bf16_t* V = WSP(bf16_t, WS_V);
    unsigned* cnt = WSP(unsigned, CTL_CNT) + layer * 16;
    int* TOKE = WSP(int, WS_TOKE); int* TOKP = WSP(int, WS_TOKP); float* TOKW = WSP(float, WS_TOKW); int* LIST = WSP(int, WS_LIST);
    const int nrows = layer == 0 ? RG : RGL, CH = layer == 0 ? 72 : 64, RW = CH >> 3, nchunks = nrows / CH;
    float rbias[16];
#pragma unroll
    for (int e = 0; e < 16; ++e) rbias[e] = KIN(35)[e];
    for (int ch = obid(); ch < nchunks; ch += gridDim.x) {
        for (int rr = 0; rr < RW; ++rr) {
            const int rl = wid * RW + rr, lr = ch * CH + rl;
            int b, t, tok;
            if (layer == 0) { const int bl = lr / TT; t = lr - bl * TT; b = g * BG + bl; tok = g * RG + lr; }
            else { const int bl = lr >> 11; t = CTXL + (lr & 2047); b = g * BG + bl; tok = g * RGL + lr; }
            const float* hsrc = hrow_rd(kp, layer == 0, b, t);
            float* hdst = hrow_wr(kp, b, t);
            const float* mv = modv + (size_t)(t < CTXL ? 16 : b) * 6144;
            f32x4 y[4], h[4]; float ss = 0.f;
#pragma unroll
            for (int i = 0; i < 4; ++i) { y[i] = ld4bf(MIX + (size_t)lr * 1024 + i * 256 + lane * 4); ss += y[i][0] * y[i][0] + y[i][1] * y[i][1] + y[i][2] * y[i][2] + y[i][3] * y[i][3]; }
            ss = wsum(ss); float rstd = rsqrtf(ss * (1.0f / 1024.0f) + EPS);
            float s2 = 0.f;
#pragma unroll
            for (int i = 0; i < 4; ++i) { const int col = i * 256 + lane * 4;
                const f32x4 g1 = *(const f32x4*)(ng + 1024 + col), ga = *(const f32x4*)(mv + 2048 + col), hx = *(const f32x4*)(hsrc + col);
                h[i] = hx + ga * (y[i] * rstd * g1);
                *(f32x4*)(hdst + col) = h[i];
                s2 += h[i][0] * h[i][0] + h[i][1] * h[i][1] + h[i][2] * h[i][2] + h[i][3] * h[i][3]; }
            s2 = wsum(s2); rstd = rsqrtf(s2 * (1.0f / 1024.0f) + EPS);
            float lg[16];
#pragma unroll
            for (int e = 0; e < 16; ++e) lg[e] = 0.f;
#pragma unroll
            for (int i = 0; i < 4; ++i) { const int col = i * 256 + lane * 4;
                const f32x4 g2 = *(const f32x4*)(ng + 2048 + col), scf = *(const f32x4*)(mv + 4096 + col), shf = *(const f32x4*)(mv + 3072 + col);
                const f32x4 v = h[i] * rstd * g2 * (scf + 1.0f) + shf;
                st4bf(V + (size_t)tok * 1024 + col, v);
#pragma unroll
                for (int j = 0; j < 4; ++j) {
#pragma unroll
                    for (int q = 0; q < 4; ++q) { const f32x4 w4 = *(const f32x4*)(rw + (col + j) * 16 + q * 4);
                        lg[q * 4 + 0] += v[j] * w4[0]; lg[q * 4 + 1] += v[j] * w4[1]; lg[q * 4 + 2] += v[j] * w4[2]; lg[q * 4 + 3] += v[j] * w4[3]; } } }
#pragma unroll
            for (int e = 0; e < 16; ++e) lg[e] = wsum(lg[e]);
            float aff[16], sel[16];
#pragma unroll
            for (int e = 0; e < 16; ++e) { aff[e] = sigmoidf_(lg[e]); sel[e] = aff[e] + rbias[e]; }
            float gs[4];
#pragma unroll
            for (int gi = 0; gi < 4; ++gi) { const float a0 = sel[gi * 4], a1 = sel[gi * 4 + 1], a2 = sel[gi * 4 + 2], a3 = sel[gi * 4 + 3];
                gs[gi] = fmaxf(fmaxf(fmaxf(a0 + a1, a0 + a2), fmaxf(a0 + a3, a1 + a2)), fmaxf(a1 + a3, a2 + a3)); }
            int gidx = 0; float gb = gs[0];
#pragma unroll
            for (int gi = 1; gi < 4; ++gi) if (gs[gi] > gb) { gb = gs[gi]; gidx = gi; }
            float c[4], f[4];
#pragma unroll
            for (int i = 0; i < 4; ++i) { c[i] = gidx == 0 ? sel[i] : gidx == 1 ? sel[4 + i] : gidx == 2 ? sel[8 + i] : sel[12 + i];
                                           f[i] = gidx == 0 ? aff[i] : gidx == 1 ? aff[4 + i] : gidx == 2 ? aff[8 + i] : aff[12 + i]; }
            int i1 = 0; float cb = c[0];
#pragma unroll
            for (int i = 1; i < 4; ++i) if (c[i] > cb) { cb = c[i]; i1 = i; }
            int i2 = -1; float cb2 = 0.f;
#pragma unroll
            for (int i = 0; i < 4; ++i) if (i != i1 && (i2 < 0 || c[i] > cb2)) { cb2 = c[i]; i2 = i; }
            float w1 = i1 == 0 ? f[0] : i1 == 1 ? f[1] : i1 == 2 ? f[2] : f[3];
            float w2 = i2 == 0 ? f[0] : i2 == 1 ? f[1] : i2 == 2 ? f[2] : f[3];
            const float wsn = 1.0f / (w1 + w2); w1 *= wsn; w2 *= wsn;
            if (lane == 0) { se[rl * 2] = gidx * 4 + i1; se[rl * 2 + 1] = gidx * 4 + i2;
                TOKE[tok * 2] = gidx * 4 + i1; TOKE[tok * 2 + 1] = gidx * 4 + i2; TOKW[tok * 2] = w1; TOKW[tok * 2 + 1] = w2; }
        }
        __syncthreads();
        if (tid < 16) { int c2 = 0; for (int i = 0; i < 2 * CH; ++i) c2 += (se[i] == tid) ? 1 : 0; sbase[tid] = (int)atomicAdd(&cnt[tid], (unsigned)c2); }
        __syncthreads();
        if (tid < 2 * CH) { const int e = se[tid]; int rank = 0; for (int j = 0; j < tid; ++j) rank += (se[j] == e) ? 1 : 0;
            const int pos = sbase[e] + rank; const int lr = ch * CH + (tid >> 1); const int tok = (layer == 0 ? g * RG : g * RGL) + lr;
            LIST[(size_t)e * NTOK + pos] = tok; TOKP[tok * 2 + (tid & 1)] = pos; }
        __syncthreads();
    }
}

__device__ __forceinline__ int moe_tile_prefix(const unsigned* cnt, int ntok, int lane) {
    const int myt = lane < 16 ? (int)((cnt[lane & 15] + 255u) >> 8) : 0; int pref = myt;
#pragma unroll
    for (int o = 1; o < 16; o <<= 1) { const int t = __shfl_up(pref, o); if (lane >= o) pref += t; }
    return pref - myt + ntok / 256;
}
PHASE_FN void phase_moe_gather(const KP& kp, int layer) {
    const int lane = otid() & 63, wid = otid() >> 6;
    const int ntok = layer == 0 ? NTOK : NLAT;
    const int tpre = moe_tile_prefix(WSP(const unsigned, CTL_CNT) + layer * 16, ntok, lane);
    const bf16_t* V = WSP(const bf16_t, WS_V); bf16_t* XG = WSP(bf16_t, WS_BIG + MO_XG);
    const int* TOKE = WSP(const int, WS_TOKE); const int* TOKP = WSP(const int, WS_TOKP);
    for (int it = obid() * 8 + wid; it < 2 * ntok; it += gridDim.x * 8) {
        const int tok = it >> 1, e = TOKE[it], pos = TOKP[it];
        const size_t row = (size_t)(__shfl(tpre, e) - ntok / 256) * 256 + pos;
        const u32x4* src = (const u32x4*)(V + (size_t)tok * 1024) + lane * 2; u32x4* dst = (u32x4*)(XG + row * 1024) + lane * 2;
        const u32x4 a = src[0], b2 = src[1]; dst[0] = a; dst[1] = b2;
    }
}
PHASE_FN void phase_moe_gemm(const KP& kp, unsigned char* lds, int layer, bool down) {
    const int tid = otid();
    int* pre = (int*)(lds + pg8::STAGE_BYTES);
    int* slotmap = pre + 32;
    const int ntok = layer == 0 ? NTOK : NLAT;
    const unsigned* cnt = WSP(const unsigned, CTL_CNT) + layer * 16;
    if (tid == 0) { int p = ntok / 256; pre[0] = 0; pre[1] = p; for (int e = 0; e < 16; ++e) { p += ((int)cnt[e] + 255) >> 8; pre[2 + e] = p; } }
    __syncthreads();
    const int ntiles = pre[17];
    for (int t = tid; t < ntiles; t += 512) { int idx = 0; for (int e = 1; e < 17; ++e) if (pre[e] <= t) idx = e; slotmap[t] = idx == 0 ? 16 : idx - 1; }
    __syncthreads();
    pg8::MoeOrder S{slotmap, ntiles, (int)gridDim.x, obid()};
    if (!down) {
        pg8::Gemm g{WSP(const bf16_t, WS_V), WSP(const bf16_t, WS_BIG + MO_WUP), 0, 0, 1024, WSP(const bf16_t, WS_BIG + MO_XG), ntok / 256};
        pg8::EpiSwi E{WSP(bf16_t, WS_BIG + MO_HID)};
        pg8::gemm_phase<pg8::EpiSwi, pg8::MoeOrder, false>((PG8_LAS unsigned char*)lds, g, S, E, nullptr);
    } else {
        pg8::Gemm g{WSP(const bf16_t, WS_BIG + MO_HID), WSP(const bf16_t, WS_BIG + MO_WDN), 0, 0, 512, nullptr, 0x7fffffff};
        pg8::EpiBfG E{WSP(bf16_t, WS_BIG + MO_CON), 1024, 1024, 3};
        pg8::gemm_phase<pg8::EpiBfG, pg8::MoeOrder, false>((PG8_LAS unsigned char*)lds, g, S, E, nullptr);
    }
    __syncthreads();
}

PHASE_FN void phase_combine(const KP& kp, int layer) {
    const int lane = otid() & 63, wid = otid() >> 6;
    const int ntok = layer == 0 ? NTOK : NLAT;
    const unsigned* cnt = WSP(const unsigned, CTL_CNT) + layer * 16;
    const float* modv = WSP(const float, WS_MODV) + (size_t)layer * 17 * 6144;
    const float* ng = KIN(6) + (size_t)layer * 4 * 1024 + 3 * 1024;
    const bf16_t* CON = WSP(const bf16_t, WS_BIG + MO_CON);
    const int* TOKE = WSP(const int, WS_TOKE); const int* TOKP = WSP(const int, WS_TOKP); const float* TOKW = WSP(const float, WS_TOKW);
    const int tpre = moe_tile_prefix(cnt, ntok, lane);
    for (int tok0 = (obid() * 8 + wid) * 2; tok0 < ntok; tok0 += gridDim.x * 16) {
        int e1[2], e2[2], p1[2], p2[2]; float w1[2], w2[2];
#pragma unroll
        for (int u = 0; u < 2; ++u) { const int tok = tok0 + u; e1[u] = TOKE[tok * 2]; e2[u] = TOKE[tok * 2 + 1]; p1[u] = TOKP[tok * 2]; p2[u] = TOKP[tok * 2 + 1]; w1[u] = TOKW[tok * 2]; w2[u] = TOKW[tok * 2 + 1]; }
        f32x4 f[2][4], hx[2][4]; float* hp[2]; const float* mv[2];
#pragma unroll
        for (int u = 0; u < 2; ++u) { const int tok = tok0 + u;
            const size_t r1 = (size_t)__shfl(tpre, e1[u]) * 256 + p1[u], r2 = (size_t)__shfl(tpre, e2[u]) * 256 + p2[u];
            int b, t;
            if (layer == 0) { b = tok / TT; t = tok - b * TT; } else { b = tok >> 11; t = CTXL + (tok & 2047); }
            hp[u] = hrow_wr(kp, b, t); mv[u] = modv + (size_t)(t < CTXL ? 16 : b) * 6144 + 5 * 1024;
#pragma unroll
            for (int i = 0; i < 4; ++i) { const int col = i * 256 + lane * 4;
                f[u][i] = ld4bf(CON + (size_t)tok * 1024 + col) + ld4bf(CON + r1 * 1024 + col) * w1[u] + ld4bf(CON + r2 * 1024 + col) * w2[u];
                hx[u][i] = *(const f32x4*)(hp[u] + col); } }
#pragma unroll
        for (int u = 0; u < 2; ++u) { float ss = 0.f;
#pragma unroll
            for (int i = 0; i < 4; ++i) ss += f[u][i][0] * f[u][i][0] + f[u][i][1] * f[u][i][1] + f[u][i][2] * f[u][i][2] + f[u][i][3] * f[u][i][3];
            ss = wsum(ss); const float rstd = rsqrtf(ss * (1.0f / 1024.0f) + EPS);
#pragma unroll
            for (int i = 0; i < 4; ++i) { const int col = i * 256 + lane * 4;
                const f32x4 g3 = *(const f32x4*)(ng + col), gf = *(const f32x4*)(mv[u] + col);
                *(f32x4*)(hp[u] + col) = hx[u][i] + gf * (f[u][i] * rstd * g3); } }
    }
}

template <int CH>
__device__ __forceinline__ int scan_t(int dir, int ci, int j) {
    constexpr int NC_CTX = CTXL / CH;
    if (!dir) return ci * CH + j;
    return ci < NC_CTX ? (CTXL - 1 - ci * CH - j) : (TT - 1 - (ci - NC_CTX) * CH - j);
}

constexpr int ML_LQ = 136, ML_LT = 72, ML_VR = 144;
PHASE_FN void mlstm_unit(const KP& kp, unsigned char* lds, int bl, int h, int dir, int vh) {
    const int tid = otid();
    bf16_t* Qs = (bf16_t*)lds;
    bf16_t* Ks = Qs + 64 * ML_LQ;
    bf16_t* KTE = Ks + 64 * ML_LQ;
    bf16_t* VT = KTE + 128 * ML_LT;
    bf16_t* Ps = VT + ML_VR * ML_LT;
    bf16_t* Cb = Ps + 64 * ML_LT;
    float* fs = (float*)(Cb + ML_VR * ML_LQ);
    float* s_rowv = fs;
    float* s_colv = fs + 64;
    float* s_wint = fs + 128;
    float* s_emj = fs + 192;
    float* s_E = fs + 256;
    float* s_den = fs + 320;
    float* s_misc = fs + 384;
    const bf16_t* P = WSP(const bf16_t, WS_BIG + L0_P);
    bf16_t* HOUT = WSP(bf16_t, WS_BIG + (dir ? L0_HB : L0_AO)); const int ldh = dir ? 1024 : 2048;
    const float ibias = KIN(9)[dir * 4 + h], fbias = KIN(10)[dir * 4 + h];
    for (int i = tid; i < ML_VR * ML_LQ; i += 512) Cb[i] = 0;
    for (int i = tid; i < 16 * ML_LT; i += 512) VT[128 * ML_LT + i] = (i < ML_LT) ? (bf16_t)0x3f80 : (bf16_t)0;
    f32x4 Cacc[8], Nacc;
#pragma unroll
    for (int i = 0; i < 8; ++i) Cacc[i] = (f32x4){0.f, 0.f, 0.f, 0.f};
    Nacc = (f32x4){0.f, 0.f, 0.f, 0.f};
    float m_state = 0.f;
    u32x4 pq[2], pk[2], pv[2]; bf16_t pgi = 0, pgf = 0;
#define ML_REQ(ci_) do { _Pragma("unroll") for (int i = 0; i < 2; ++i) { const int p = tid + i * 512, j = p >> 4, c8 = p & 15; \
            const bf16_t* pr = P + ((size_t)bl * TT + scan_t<64>(dir, (ci_), j)) * AB_N; \
            pq[i] = *(const u32x4*)(pr + AB_Q + h * 128 + c8 * 8); pk[i] = *(const u32x4*)(pr + AB_K + h * 128 + c8 * 8); \
            const int jv = tid & 63, cv = (tid >> 6) + i * 8; \
            pv[i] = *(const u32x4*)(P + ((size_t)bl * TT + scan_t<64>(dir, (ci_), jv)) * AB_N + AB_V + h * 256 + vh * 128 + cv * 8); } \
        if (tid < 64) { const bf16_t* pg = P + ((size_t)bl * TT + scan_t<64>(dir, (ci_), tid)) * AB_N; pgi = pg[AB_IG + dir * 4 + h]; pgf = pg[AB_FG + dir * 4 + h]; } } while (0)
    ML_REQ(0);
    __syncthreads();
    for (int ci = 0; ci < TT / 64; ++ci) {
        int tq = tid; asm volatile("" : "+v"(tq));
        const int lane = tq & 63, wid = tq >> 6, fr = lane & 15, fq = lane >> 4;
#pragma unroll
        for (int i = 0; i < 2; ++i) {
            const int p = tq + i * 512, j = p >> 4, c8 = p & 15;
            u32x4 q = pq[i];
            const float qs = 0.08838834764831845f;
            q.x = pack2(lo2f(q.x) * qs, hi2f(q.x) * qs); q.y = pack2(lo2f(q.y) * qs, hi2f(q.y) * qs);
            q.z = pack2(lo2f(q.z) * qs, hi2f(q.z) * qs); q.w = pack2(lo2f(q.w) * qs, hi2f(q.w) * qs);
            *(u32x4*)(Qs + j * ML_LQ + c8 * 8) = q;
            *(u32x4*)(Ks + j * ML_LQ + c8 * 8) = pk[i];
            const u32x4 v = pv[i];
            bf16_t* vt = VT + (((tq >> 6) + i * 8) * 8) * ML_LT + (tq & 63);
            vt[0 * ML_LT] = (bf16_t)(v.x & 0xffff); vt[1 * ML_LT] = (bf16_t)(v.x >> 16); vt[2 * ML_LT] = (bf16_t)(v.y & 0xffff); vt[3 * ML_LT] = (bf16_t)(v.y >> 16);
            vt[4 * ML_LT] = (bf16_t)(v.z & 0xffff); vt[5 * ML_LT] = (bf16_t)(v.z >> 16); vt[6 * ML_LT] = (bf16_t)(v.w & 0xffff); vt[7 * ML_LT] = (bf16_t)(v.w >> 16);
        }
        if (wid == 0) {
            const float ig = bf2f(pgi) + ibias;
            const float lf = logsigmoidf_(bf2f(pgf) + fbias);
            float b = lf;
#pragma unroll
            for (int o = 1; o < 64; o <<= 1) { const float t = __shfl_up(b, o); if (lane >= o) b += t; }
            const float u = ig - b; float pm = u;
#pragma unroll
            for (int o = 1; o < 64; o <<= 1) { const float t = __shfl_up(pm, o); if (lane >= o) pm = fmaxf(pm, t); }
            const float mj = fmaxf(b + m_state, b + pm);
            const float b63 = __shfl(b, 63), pm63 = __shfl(pm, 63);
            const float mnew = fmaxf(b63 + m_state, b63 + pm63);
            s_rowv[lane] = b - mj; s_colv[lane] = u; s_wint[lane] = __expf(b + m_state - mj); s_emj[lane] = __expf(-mj);
            s_E[lane] = __expf(b63 + u - mnew);
            if (lane == 0) { s_misc[0] = mnew; s_misc[1] = __expf(b63 + m_state - mnew); }
        }
        if (ci + 1 < TT / 64) ML_REQ(ci + 1);
        __syncthreads();
        {
            const int jt = wid >> 1;
#pragma unroll
            for (int q2 = 0; q2 < 2; ++q2) {
                const int st = (wid & 1) * 2 + q2;
                f32x4 acc = (f32x4){0.f, 0.f, 0.f, 0.f};
                if (st <= jt) {
#pragma unroll
                    for (int k = 0; k < 4; ++k) acc = mma16(ldfrag(Qs, ML_LQ, jt * 16, k * 32, fr, fq), ldfrag(Ks, ML_LQ, st * 16, k * 32, fr, fq), acc);
                }
                const int s = st * 16 + fr; const float cv = s_colv[s];
#pragma unroll
                for (int r = 0; r < 4; ++r) { const int j = jt * 16 + fq * 4 + r;
                    const float pv2 = (s <= j) ? acc[r] * __expf(s_rowv[j] + cv) : 0.f;
                    Ps[j * ML_LT + s] = f2bf(pv2); }
            }
#pragma unroll
            for (int i = 0; i < 2; ++i) {
                const int s = lane, c8 = wid + i * 8; const float e = s_E[s];
                const u32x4 kv = *(const u32x4*)(Ks + s * ML_LQ + c8 * 8);
                bf16_t* kt = KTE + (c8 * 8) * ML_LT + s;
                kt[0 * ML_LT] = f2bf(lo2f(kv.x) * e); kt[1 * ML_LT] = f2bf(hi2f(kv.x) * e); kt[2 * ML_LT] = f2bf(lo2f(kv.y) * e); kt[3 * ML_LT] = f2bf(hi2f(kv.y) * e);
                kt[4 * ML_LT] = f2bf(lo2f(kv.z) * e); kt[5 * ML_LT] = f2bf(hi2f(kv.z) * e); kt[6 * ML_LT] = f2bf(lo2f(kv.w) * e); kt[7 * ML_LT] = f2bf(hi2f(kv.w) * e);
            }
        }
        __syncthreads();
        f32x4 a1[4], a2[4];
        {
            const int jt = wid >> 1;
#pragma unroll
            for (int q4 = 0; q4 < 4; ++q4) {
                const int vt = (wid & 1) * 4 + q4;
                a1[q4] = (f32x4){0.f, 0.f, 0.f, 0.f}; a2[q4] = (f32x4){0.f, 0.f, 0.f, 0.f};
#pragma unroll
                for (int k = 0; k < 2; ++k) a1[q4] = mma16(ldfrag(VT, ML_LT, vt * 16, k * 32, fr, fq), ldfrag(Ps, ML_LT, jt * 16, k * 32, fr, fq), a1[q4]);
#pragma unroll
                for (int k = 0; k < 4; ++k) a2[q4] = mma16(ldfrag(Cb, ML_LQ, vt * 16, k * 32, fr, fq), ldfrag(Qs, ML_LQ, jt * 16, k * 32, fr, fq), a2[q4]);
            }
            if (wid & 1) {
                f32x4 d1 = (f32x4){0.f, 0.f, 0.f, 0.f}, d2 = (f32x4){0.f, 0.f, 0.f, 0.f};
#pragma unroll
                for (int k = 0; k < 2; ++k) d1 = mma16(ldfrag(VT, ML_LT, 128, k * 32, fr, fq), ldfrag(Ps, ML_LT, jt * 16, k * 32, fr, fq), d1);
#pragma unroll
                for (int k = 0; k < 4; ++k) d2 = mma16(ldfrag(Cb, ML_LQ, 128, k * 32, fr, fq), ldfrag(Qs, ML_LQ, jt * 16, k * 32, fr, fq), d2);
                if (fq == 0) { const int j = jt * 16 + fr; s_den[j] = fmaxf(fabsf(d1[0] + s_wint[j] * d2[0]), s_emj[j]); }
            }
        }
        __syncthreads();
        {
            const int jt = wid >> 1, j = jt * 16 + fr;
            const float wi = s_wint[j], rden = frcp_(s_den[j]);
            const size_t row = (size_t)bl * TT + scan_t<64>(dir, ci, j);
#pragma unroll
            for (int q4 = 0; q4 < 4; ++q4) { const int v0 = ((wid & 1) * 4 + q4) * 16 + fq * 4;
                st4bf(HOUT + row * ldh + h * 256 + vh * 128 + v0, (a1[q4] + a2[q4] * wi) * rden); }
        }
        {
            const float dec = s_misc[1];
            const bf16x8 bv0 = ldfrag(VT, ML_LT, wid * 16, 0, fr, fq), bv1 = ldfrag(VT, ML_LT, wid * 16, 32, fr, fq);
#pragma unroll
            for (int dt = 0; dt < 8; ++dt) {
                Cacc[dt] = Cacc[dt] * dec;
                Cacc[dt] = mma16(ldfrag(KTE, ML_LT, dt * 16, 0, fr, fq), bv0, Cacc[dt]);
                Cacc[dt] = mma16(ldfrag(KTE, ML_LT, dt * 16, 32, fr, fq), bv1, Cacc[dt]);
                st4bf(Cb + (wid * 16 + fr) * ML_LQ + dt * 16 + fq * 4, Cacc[dt]);
            }
            Nacc = Nacc * dec;
            Nacc = mma16(ldfrag(KTE, ML_LT, wid * 16, 0, fr, fq), ldfrag(VT, ML_LT, 128, 0, fr, fq), Nacc);
            Nacc = mma16(ldfrag(KTE, ML_LT, wid * 16, 32, fr, fq), ldfrag(VT, ML_LT, 128, 32, fr, fq), Nacc);
            st4bf(Cb + (128 + fr) * ML_LQ + wid * 16 + fq * 4, Nacc);
            m_state = s_misc[0];
        }
        __syncthreads();
    }
#undef ML_REQ
}

constexpr size_t L0_XC = L0_U;
static_assert(L0_XC + (size_t)RG * 1280 * 2 <= BIG_BYTES, "xconv buffer");
PHASE_FN void phase_xconv(const KP& kp) {
    const int lane = otid() & 63, wid = otid() >> 6;
    const bf16_t* P = WSP(const bf16_t, WS_BIG + L0_P); bf16_t* XC = WSP(bf16_t, WS_BIG + L0_XC);
    const float* cw = KIN(12); const float* cb = KIN(13);
    for (int lr = obid() * 8 + wid; lr < RG; lr += gridDim.x * 8) {
        const int bl = lr / TT, t = lr - bl * TT, lo = t < CTXL ? 0 : CTXL, hi = t < CTXL ? CTXL : TT;
#pragma unroll
        for (int i = 0; i < 5; ++i) { const int col = i * 256 + lane * 4;
            f32x4 a = *(const f32x4*)(cb + col);
#pragma unroll
            for (int q = 0; q < 5; ++q) { const int tt = t - 2 + q;
                if (tt >= lo && tt < hi) a += *(const f32x4*)(cw + q * 1280 + col) * ld4bf(P + ((size_t)bl * TT + tt) * AB_N + AB_XBC + col); }
            f32x4 o;
#pragma unroll
            for (int r = 0; r < 4; ++r) o[r] = siluf_(a[r]);
            st4bf(XC + (size_t)lr * 1280 + col, o); }
    }
}

constexpr int SS_LT = 72, SS_LX = 136;
PHASE_FN void ssd_unit(const KP& kp, unsigned char* lds, int bl, int dir, int hp) {
    const int tid = otid();
    const int gi = hp >> 2, hh0 = hp * 2;
    bf16_t* Wm = (bf16_t*)lds;
    bf16_t* CM = Wm + 2 * 64 * SS_LT;
    bf16_t* BM = CM + 64 * SS_LT;
    bf16_t* Xn = BM + 64 * SS_LT;
    bf16_t* XT = Xn + 64 * SS_LX;
    bf16_t* BTE = XT + 2 * 64 * SS_LT;
    bf16_t* Sb = BTE + 2 * 64 * SS_LT;
    float* fs = (float*)(Sb + 2 * 64 * SS_LT);
    float* s_b = fs;
    float* s_dt = fs + 128;
    float* s_e = fs + 256;
    float* s_misc = fs + 384;
    const bf16_t* P = WSP(const bf16_t, WS_BIG + L0_P); const bf16_t* XC = WSP(const bf16_t, WS_BIG + L0_XC);
    bf16_t* YOUT = WSP(bf16_t, WS_BIG + (dir ? L0_YB : L0_AO + 2048)); const int ldy = dir ? 1024 : 2048;
    for (int i = tid; i < 2 * 64 * SS_LT; i += 512) Sb[i] = 0;
    f32x4 Sacc[4];
#pragma unroll
    for (int i = 0; i < 4; ++i) Sacc[i] = (f32x4){0.f, 0.f, 0.f, 0.f};
    const float dtb = KIN(14)[dir * 16 + hh0 + ((tid >> 6) & 1)], aexp = __expf(KIN(15)[dir * 16 + hh0 + ((tid >> 6) & 1)]);
    const float dskip = KIN(16)[hh0 + (tid >> 8)];
    u32x4 pr[4]; bf16_t pdt = 0;
#define SS_REQ(ci_) do { _Pragma("unroll") for (int q = 0; q < 4; ++q) { const int p = tid + q * 512, j = p >> 5, c8 = p & 31; \
            const int col = c8 < 16 ? hh0 * 64 + c8 * 8 : (c8 < 24 ? 1024 + gi * 64 + (c8 - 16) * 8 : 1152 + gi * 64 + (c8 - 24) * 8); \
            pr[q] = *(const u32x4*)(XC + ((size_t)bl * TT + scan_t<64>(dir, (ci_), j)) * 1280 + col); } \
        if (tid < 128) pdt = P[((size_t)bl * TT + scan_t<64>(dir, (ci_), tid & 63)) * AB_N + AB_DT + dir * 16 + hh0 + (tid >> 6)]; } while (0)
    SS_REQ(0);
    __syncthreads();
    for (int ci = 0; ci < TT / 64; ++ci) {
        int tq = tid; asm volatile("" : "+v"(tq));
        const int lane = tq & 63, wid = tq >> 6, fr = lane & 15, fq = lane >> 4, hl_w = wid >> 2;
#pragma unroll
        for (int q = 0; q < 4; ++q) { const int p = tq + q * 512, j = p >> 5, c8 = p & 31;
            bf16_t* dst = c8 < 16 ? Xn + j * SS_LX + c8 * 8 : (c8 < 24 ? BM + j * SS_LT + (c8 - 16) * 8 : CM + j * SS_LT + (c8 - 24) * 8);
            *(u32x4*)dst = pr[q]; }
        if (wid < 2) {
            const float dt = softplusf_(bf2f(pdt) + dtb);
            float b = -dt * aexp;
#pragma unroll
            for (int o = 1; o < 64; o <<= 1) { const float t = __shfl_up(b, o); if (lane >= o) b += t; }
            const float b63 = __shfl(b, 63);
            s_b[wid * 64 + lane] = b; s_dt[wid * 64 + lane] = dt; s_e[wid * 64 + lane] = __expf(b63 - b) * dt;
            if (lane == 0) s_misc[wid] = __expf(b63);
        }
        if (ci + 1 < TT / 64) SS_REQ(ci + 1);
        __syncthreads();
        {
            const int jt = wid >> 1;
#pragma unroll
            for (int q2 = 0; q2 < 2; ++q2) {
                const int st = (wid & 1) * 2 + q2;
                f32x4 acc = (f32x4){0.f, 0.f, 0.f, 0.f};
                if (st <= jt) {
#pragma unroll
                    for (int k = 0; k < 2; ++k) acc = mma16(ldfrag(CM, SS_LT, jt * 16, k * 32, fr, fq), ldfrag(BM, SS_LT, st * 16, k * 32, fr, fq), acc);
                }
                const int s = st * 16 + fr;
#pragma unroll
                for (int hl = 0; hl < 2; ++hl) { const float bs = s_b[hl * 64 + s], ds = s_dt[hl * 64 + s];
#pragma unroll
                    for (int r = 0; r < 4; ++r) { const int j = jt * 16 + fq * 4 + r;
                        const float wv = (s <= j) ? acc[r] * __expf(s_b[hl * 64 + j] - bs) * ds : 0.f;
                        Wm[(hl * 64 + j) * SS_LT + s] = f2bf(wv); } }
            }
            {
                const int s = lane, n8 = wid;
                const u32x4 bv = *(const u32x4*)(BM + s * SS_LT + n8 * 8);
#pragma unroll
                for (int hl = 0; hl < 2; ++hl) { const float e = s_e[hl * 64 + s];
                    bf16_t* bt = BTE + (hl * 64 + n8 * 8) * SS_LT + s;
                    bt[0 * SS_LT] = f2bf(lo2f(bv.x) * e); bt[1 * SS_LT] = f2bf(hi2f(bv.x) * e); bt[2 * SS_LT] = f2bf(lo2f(bv.y) * e); bt[3 * SS_LT] = f2bf(hi2f(bv.y) * e);
                    bt[4 * SS_LT] = f2bf(lo2f(bv.z) * e); bt[5 * SS_LT] = f2bf(hi2f(bv.z) * e); bt[6 * SS_LT] = f2bf(lo2f(bv.w) * e); bt[7 * SS_LT] = f2bf(hi2f(bv.w) * e); }
#pragma unroll
                for (int i = 0; i < 2; ++i) { const int c8 = wid + i * 8;
                    const u32x4 xv = *(const u32x4*)(Xn + s * SS_LX + c8 * 8);
                    bf16_t* xt = XT + (c8 * 8) * SS_LT + s;
                    xt[0 * SS_LT] = (bf16_t)(xv.x & 0xffff); xt[1 * SS_LT] = (bf16_t)(xv.x >> 16); xt[2 * SS_LT] = (bf16_t)(xv.y & 0xffff); xt[3 * SS_LT] = (bf16_t)(xv.y >> 16);
                    xt[4 * SS_LT] = (bf16_t)(xv.z & 0xffff); xt[5 * SS_LT] = (bf16_t)(xv.z >> 16); xt[6 * SS_LT] = (bf16_t)(xv.w & 0xffff); xt[7 * SS_LT] = (bf16_t)(xv.w >> 16); }
            }
        }
        __syncthreads();
        {
            const int hl = hl_w, jt = wid & 3, j = jt * 16 + fr;
            const bf16_t* Wh = Wm + hl * 64 * SS_LT; const bf16_t* Xh = XT + hl * 64 * SS_LT; const bf16_t* Sh = Sb + hl * 64 * SS_LT;
            const float eb = __expf(s_b[hl * 64 + j]);
            const size_t row = (size_t)bl * TT + scan_t<64>(dir, ci, j);
#pragma unroll
            for (int pt = 0; pt < 4; ++pt) {
                f32x4 y1 = (f32x4){0.f, 0.f, 0.f, 0.f}, y2 = (f32x4){0.f, 0.f, 0.f, 0.f};
#pragma unroll
                for (int k = 0; k < 2; ++k) { y1 = mma16(ldfrag(Xh, SS_LT, pt * 16, k * 32, fr, fq), ldfrag(Wh, SS_LT, jt * 16, k * 32, fr, fq), y1);
                                              y2 = mma16(ldfrag(Sh, SS_LT, pt * 16, k * 32, fr, fq), ldfrag(CM, SS_LT, jt * 16, k * 32, fr, fq), y2); }
                f32x4 y = y1 + y2 * eb;
                if (!dir) y = y + ld4bf(Xn + j * SS_LX + hl * 64 + pt * 16 + fq * 4) * dskip;
                st4bf(YOUT + row * ldy + (hh0 + hl) * 64 + pt * 16 + fq * 4, y);
            }
        }
        __syncthreads();
        {
            const int hl = hl_w, pt = wid & 3; const float eb63 = s_misc[hl];
            const bf16_t* Xh = XT + hl * 64 * SS_LT; const bf16_t* Bh = BTE + hl * 64 * SS_LT; bf16_t* Sh = Sb + hl * 64 * SS_LT;
            const bf16x8 x0 = ldfrag(Xh, SS_LT, pt * 16, 0, fr, fq), x1 = ldfrag(Xh, SS_LT, pt * 16, 32, fr, fq);
#pragma unroll
            for (int nt = 0; nt < 4; ++nt) {
                Sacc[nt] = Sacc[nt] * eb63;
                Sacc[nt] = mma16(ldfrag(Bh, SS_LT, nt * 16, 0, fr, fq), x0, Sacc[nt]);
                Sacc[nt] = mma16(ldfrag(Bh, SS_LT, nt * 16, 32, fr, fq), x1, Sacc[nt]);
                st4bf(Sh + (pt * 16 + fr) * SS_LT + nt * 16 + fq * 4, Sacc[nt]);
            }
        }
        __syncthreads();
    }
#undef SS_REQ
}

__device__ __forceinline__ void phase_scan_ab(const KP& kp, unsigned char* lds) {
    for (int u = obid(); u < 256; u += gridDim.x) if (u < 128) { mlstm_unit(kp, lds, u >> 4, (u >> 2) & 3, (u >> 1) & 1, u & 1); __syncthreads(); }
    for (int u = obid(); u < 256; u += gridDim.x) if (u >= 128) { const int v = u - 128; ssd_unit(kp, lds, v >> 4, (v >> 3) & 1, v & 7); __syncthreads(); }
}

PHASE_FN void phase_fin_ab(const KP& kp) {
    const int lane = otid() & 63, wid = otid() >> 6;
    const bf16_t* P = WSP(const bf16_t, WS_BIG + L0_P);
    bf16_t* AO = WSP(bf16_t, WS_BIG + L0_AO); const bf16_t* HB = WSP(const bf16_t, WS_BIG + L0_HB); const bf16_t* YB = WSP(const bf16_t, WS_BIG + L0_YB);
    const float* mln = KIN(11); const float* sn = KIN(17);
    for (int lr = obid() * 8 + wid; lr < RG; lr += gridDim.x * 8) {
        const bf16_t* pr = P + (size_t)lr * AB_N;
        f32x4 yz[4]; float ss2 = 0.f;
#pragma unroll
        for (int i = 0; i < 4; ++i) { const int col = i * 256 + lane * 4;
            const f32x4 hs = ld4bf(AO + (size_t)lr * 2048 + col) + ld4bf(HB + (size_t)lr * 1024 + col);
            float ss = hs[0] * hs[0] + hs[1] * hs[1] + hs[2] * hs[2] + hs[3] * hs[3];
            ss = wsum(ss); const float rstd = rsqrtf(ss * (1.0f / 256.0f) + EPS);
            const f32x4 og = ld4bf(pr + AB_OG + col), w = *(const f32x4*)(mln + col);
            f32x4 o;
#pragma unroll
            for (int r = 0; r < 4; ++r) o[r] = hs[r] * rstd * w[r] * sigmoidf_(og[r]);
            st4bf(AO + (size_t)lr * 2048 + col, o);
            const f32x4 ys = ld4bf(AO + (size_t)lr * 2048 + 1024 + col) + ld4bf(YB + (size_t)lr * 1024 + col), z = ld4bf(pr + AB_Z + col);
#pragma unroll
            for (int r = 0; r < 4; ++r) { yz[i][r] = ys[r] * siluf_(z[r]); ss2 += yz[i][r] * yz[i][r]; }
        }
        ss2 = wsum(ss2); const float rstd2 = rsqrtf(ss2 * (1.0f / 1024.0f) + EPS);
#pragma unroll
        for (int i = 0; i < 4; ++i) { const int col = i * 256 + lane * 4; st4bf(AO + (size_t)lr * 2048 + 1024 + col, yz[i] * rstd2 * *(const f32x4*)(sn + col)); }
    }
}

PHASE_FN void phase_gemm_in(const KP& kp, unsigned char* lds, int layer) {
    const int npad = layer == 0 ? AB_NPAD : CD_NPAD, n = layer == 0 ? AB_N : CD_N;
    pg8::Gemm g{WSP(const bf16_t, WS_BIG + (layer == 0 ? L0_U : L1_U)), WSP(const bf16_t, WS_WMIX), RG, npad, 1024, nullptr, 0x7fffffff};
    pg8::StaticOrder S; S.init(RG, npad, (int)gridDim.x, obid());
    pg8::EpiBfG E{WSP(bf16_t, WS_BIG), n, n, 0x7fffffff};
    pg8::gemm_phase<pg8::EpiBfG, pg8::StaticOrder, false>((PG8_LAS unsigned char*)lds, g, S, E, nullptr);
    __syncthreads();
}
PHASE_FN void phase_gemm_out_ab(const KP& kp, unsigned char* lds) {
    pg8::Gemm g{WSP(const bf16_t, WS_BIG + L0_AO), WSP(const bf16_t, WS_WMIX + WM_AB_OUT), RG, 1024, 2048, nullptr, 0x7fffffff};
    pg8::StaticOrder S; S.init(RG, 1024, (int)gridDim.x, obid());
    pg8::EpiBfG E{WSP(bf16_t, WS_BIG + L0_U), 1024, 1024, 0x7fffffff};
    pg8::gemm_phase<pg8::EpiBfG, pg8::StaticOrder, false>((PG8_LAS unsigned char*)lds, g, S, E, nullptr);
    __syncthreads();
}

PHASE_FN void phase_prep_cd(const KP& kp) {
    const int lane = otid() & 63, wid = otid() >> 6;
    bf16_t* P = WSP(bf16_t, WS_BIG + L1_P);
    bf16_t* SG = WSP(bf16_t, WS_SG);
    const float* qn = KIN(20); const float* kvn = KIN(22); const float* mu = KIN(24);
    for (int lr = obid() * 8 + wid; lr < RG; lr += gridDim.x * 8) {
        const int bl = lr / TT, t = lr - bl * TT;
        bf16_t* pr = P + (size_t)lr * CD_N;
        {
            const f32x4 x = ld4bf(pr + CD_M1 + lane * 4);
            float ss = x[0] * x[0] + x[1] * x[1] + x[2] * x[2] + x[3] * x[3]; ss = wsum(ss);
            const float rstd = rsqrtf(ss * (1.0f / 256.0f) + EPS);
            st4bf(pr + CD_M1 + lane * 4, x * rstd * *(const f32x4*)(kvn + lane * 4));
        }
        if (t >= CTXL) {
            const int s = t - CTXL;
            float x0[3], x1[3]; float ss = 0.f;
#pragma unroll
            for (int i = 0; i < 3; ++i) { const unsigned w = *(const unsigned*)(pr + CD_M0 + i * 128 + lane * 2); x0[i] = lo2f(w); x1[i] = hi2f(w); ss += x0[i] * x0[i] + x1[i] * x1[i]; }
            ss = wsum(ss); const float rstd = rsqrtf(ss * (1.0f / 384.0f) + EPS);
#pragma unroll
            for (int i = 0; i < 3; ++i) { const int c = i * 128 + lane * 2; *(unsigned*)(pr + CD_M0 + c) = pack2(x0[i] * rstd * qn[c], x1[i] * rstd * qn[c + 1]); }
            if (lane < 16) {
                const float pos = (lane < 8) ? (float)(s >> 6) : (float)(s & 63);
                const float inv = __expf(-(float)(lane & 7) * (9.210340371976184f / 8.0f));
                float sn, cs; sincosf(pos * inv, &sn, &cs);
                const float a = bf2f(pr[CD_KR + lane]), b2 = bf2f(pr[CD_KR + 16 + lane]);
                pr[CD_KR + lane] = f2bf(a * cs - b2 * sn); pr[CD_KR + 16 + lane] = f2bf(a * sn + b2 * cs);
            }
            {
                const int c = lane * 2;
                const unsigned w = *(const unsigned*)(pr + CD_GL + c);
                const unsigned wp = s > 0 ? *(const unsigned*)(pr - CD_N + CD_GL + c) : 0u;
                const unsigned wn = s < SEQ - 1 ? *(const unsigned*)(pr + CD_N + CD_GL + c) : 0u;
                const float m0 = mu[CD_GL - CD_RW0 + c], m1 = mu[CD_GL - CD_RW0 + c + 1];
                const float g0 = lo2f(w) + m0 * (0.5f * (lo2f(wp) + lo2f(wn)) - lo2f(w));
                const float g1 = hi2f(w) + m1 * (0.5f * (hi2f(wp) + hi2f(wn)) - hi2f(w));
                *(unsigned*)(SG + ((size_t)bl * SEQ + s) * 128 + c) = pack2(sigmoidf_(g0), sigmoidf_(g1));
            }
        }
    }
}

PHASE_FN void phase_upproj(const KP& kp, unsigned char* lds) {
    const bf16_t* P = WSP(const bf16_t, WS_BIG + L1_P);
    const int nq = (RGL / 256) * 6, nkv = (RG / 256) * 8;
    for (int u = obid(); u < nq + nkv; u += gridDim.x) {
        if (u < nq) {
            GA ga{P + CD_M0, nullptr, CD_N, 0, 384, nullptr, RGL, 1, 0};
            EpiBf ep{WSP(bf16_t, WS_BIG + L1_Q), 768, RGL, 768};
            gemm_tile(lds, ga, WSP(const bf16_t, WS_WMIX + WM_UQ), 384, u / 6, u % 6, ep);
        } else { const int v = u - nq;
            GA ga{P + CD_M1, nullptr, CD_N, 0, 256, nullptr, RG, 0, 0};
            EpiBf ep{WSP(bf16_t, WS_BIG + L1_KV), 1024, RG, 1024};
            gemm_tile(lds, ga, WSP(const bf16_t, WS_WMIX + WM_UKV), 256, v >> 3, v & 7, ep);
        }
    }
}

constexpr int AT_LQ = 104, AT_LV = 72;
PHASE_FN void attn_unit(const KP& kp, unsigned char* lds, int bl, int head, int qb) {
    const int tid = otid(), lane = tid & 63, wid = tid >> 6, fr = lane & 15, fq = lane >> 4;
    bf16_t* Qs = (bf16_t*)lds;
    bf16_t* Kt = Qs + 128 * AT_LQ;
    bf16_t* Vt = Kt + 64 * AT_LQ;
    const bf16_t* P = WSP(const bf16_t, WS_BIG + L1_P);
    const bf16_t* Q = WSP(const bf16_t, WS_BIG + L1_Q);
    const bf16_t* KV = WSP(const bf16_t, WS_BIG + L1_KV);
    bf16_t* AOUT = WSP(bf16_t, WS_BIG + L1_AOUT);
    const float SC = 0.10206207261596577f;
#pragma unroll
    for (int i = 0; i < 3; ++i) { const int p = tid + i * 512, r = p / 12, c = p % 12;
        *(u32x4*)(Qs + r * AT_LQ + c * 8) = *(const u32x4*)(Q + ((size_t)bl * SEQ + qb * 128 + r) * 768 + head * 96 + c * 8); }
    __syncthreads();
#pragma unroll
    for (int i = 0; i < 4; ++i) { const int p = tid + i * 512, r = p >> 4, f = p & 15, s = qb * 128 + r;
        const float pos = (f < 8) ? (float)(s >> 6) : (float)(s & 63);
        const float inv = __expf(-(float)(f & 7) * (9.210340371976184f / 8.0f));
        float sn, cs; sincosf(pos * inv, &sn, &cs);
        const float a = bf2f(Qs[r * AT_LQ + 64 + f]), b2 = bf2f(Qs[r * AT_LQ + 80 + f]);
        Qs[r * AT_LQ + 64 + f] = f2bf(a * cs - b2 * sn); Qs[r * AT_LQ + 80 + f] = f2bf(a * sn + b2 * cs); }
    __syncthreads();
    bf16x8 qf[3];
#pragma unroll
    for (int k = 0; k < 3; ++k) qf[k] = ldfrag(Qs, AT_LQ, wid * 16, k * 32, fr, fq);
    f32x4 ot[4];
#pragma unroll
    for (int i = 0; i < 4; ++i) ot[i] = (f32x4){0.f, 0.f, 0.f, 0.f};
    float mrow = -1e30f, lsum = 0.f;
    u32x4 pk0, pk1, pvv;
    const int kkey0 = tid / 12, kc0 = tid % 12, kkey1 = (tid + 512) / 12, kc1 = (tid + 512) % 12, vkey = tid & 63, vc8 = tid >> 6;
#define AT_REQ(kt_) do { const size_t rb_ = (size_t)bl * TT + (kt_) * 64; \
        pk0 = kc0 < 8 ? *(const u32x4*)(KV + (rb_ + kkey0) * 1024 + head * 128 + kc0 * 8) : *(const u32x4*)(P + (rb_ + kkey0) * CD_N + CD_KR + (kc0 - 8) * 8); \
        if (tid < 256) pk1 = kc1 < 8 ? *(const u32x4*)(KV + (rb_ + kkey1) * 1024 + head * 128 + kc1 * 8) : *(const u32x4*)(P + (rb_ + kkey1) * CD_N + CD_KR + (kc1 - 8) * 8); \
        pvv = *(const u32x4*)(KV + (rb_ + vkey) * 1024 + head * 128 + 64 + vc8 * 8); } while (0)
    AT_REQ(0);
    for (int kt = 0; kt < TT / 64; ++kt) {
        __syncthreads();
        *(u32x4*)(Kt + kkey0 * AT_LQ + kc0 * 8) = pk0;
        if (tid < 256) *(u32x4*)(Kt + kkey1 * AT_LQ + kc1 * 8) = pk1;
        { bf16_t* vt = Vt + (vc8 * 8) * AT_LV + vkey; const u32x4 v = pvv;
            vt[0 * AT_LV] = (bf16_t)(v.x & 0xffff); vt[1 * AT_LV] = (bf16_t)(v.x >> 16); vt[2 * AT_LV] = (bf16_t)(v.y & 0xffff); vt[3 * AT_LV] = (bf16_t)(v.y >> 16);
            vt[4 * AT_LV] = (bf16_t)(v.z & 0xffff); vt[5 * AT_LV] = (bf16_t)(v.z >> 16); vt[6 * AT_LV] = (bf16_t)(v.w & 0xffff); vt[7 * AT_LV] = (bf16_t)(v.w >> 16); }
        if (kt + 1 < TT / 64) AT_REQ(kt + 1);
        __syncthreads();
        f32x4 st[4];
        float mx = -1e30f;
#pragma unroll
        for (int kk = 0; kk < 4; ++kk) { st[kk] = (f32x4){0.f, 0.f, 0.f, 0.f};
#pragma unroll
            for (int k = 0; k < 3; ++k) st[kk] = mma16(ldfrag(Kt, AT_LQ, kk * 16, k * 32, fr, fq), qf[k], st[kk]);
            mx = fmaxf(mx, fmaxf(fmaxf(st[kk][0], st[kk][1]), fmaxf(st[kk][2], st[kk][3]))); }
        mx = fmaxf(mx, __shfl_xor(mx, 16)); mx = fmaxf(mx, __shfl_xor(mx, 32));
        const float mnew = fmaxf(mrow, mx), alpha = __expf(SC * (mrow - mnew));
        mrow = mnew; lsum *= alpha;
#pragma unroll
        for (int i = 0; i < 4; ++i) ot[i] = ot[i] * alpha;
#pragma unroll
        for (int kk = 0; kk < 4; ++kk)
#pragma unroll
            for (int r = 0; r < 4; ++r) { const float pv = __expf(SC * (st[kk][r] - mnew)); st[kk][r] = pv; lsum += pv; }
#pragma unroll
        for (int k2 = 0; k2 < 2; ++k2) {
            union { bf16x8 v; unsigned u[4]; } pb;
            pb.u[0] = pack2(st[2 * k2][0], st[2 * k2][1]); pb.u[1] = pack2(st[2 * k2][2], st[2 * k2][3]);
            pb.u[2] = pack2(st[2 * k2 + 1][0], st[2 * k2 + 1][1]); pb.u[3] = pack2(st[2 * k2 + 1][2], st[2 * k2 + 1][3]);
#pragma unroll
            for (int dvt = 0; dvt < 4; ++dvt) {
                union { bf16x8 v; u32x2 h[2]; } va;
                const bf16_t* vp = Vt + (dvt * 16 + fr) * AT_LV + k2 * 32 + fq * 4;
                va.h[0] = *(const u32x2*)vp; va.h[1] = *(const u32x2*)(vp + 16);
                ot[dvt] = mma16(va.v, pb.v, ot[dvt]);
            }
        }
    }
#undef AT_REQ
    lsum += __shfl_xor(lsum, 16); lsum += __shfl_xor(lsum, 32);
    const float rl = frcp_(lsum);
    const size_t orow = (size_t)bl * SEQ + qb * 128 + wid * 16 + fr;
#pragma unroll
    for (int dvt = 0; dvt < 4; ++dvt) st4bf(AOUT + orow * 1536 + head * 64 + dvt * 16 + fq * 4, ot[dvt] * rl);
}

constexpr int RW_LR = 328, RW_LP = 72;
PHASE_FN void rwkv_unit(const KP& kp, unsigned char* lds, int bl, int h, int dir) {
    const int tid = otid();
    bf16_t* RAW = (bf16_t*)lds;
    bf16_t* TWb = RAW + 34 * RW_LR;
    bf16_t* ALb = TWb + 32 * RW_LP;
    bf16_t* W2T = ALb + 32 * RW_LP;
    bf16_t* A2T = W2T + 64 * RW_LP;
    float* CL = (float*)(A2T + 64 * RW_LP);
    bf16_t* AR = (bf16_t*)(CL + 32 * 64);
    bf16_t* BK = AR + 64 * RW_LP;
    float* AABT = (float*)(BK + 64 * RW_LP);
    bf16_t* ARB = (bf16_t*)(AABT + 32 * 36);
    bf16_t* AAK = ARB + 32 * 40;
    bf16_t* ARK = AAK + 32 * 40;
    float* RHS = (float*)(ARK + 32 * 40);
    float* YB = RHS + 32 * 64;
    bf16_t* ZVT = (bf16_t*)(YB + 32 * 64);
    bf16_t* BKh = ZVT + 64 * RW_LP;
    bf16_t* Sb = BKh + 64 * RW_LP;
    float* PL = (float*)(Sb + 64 * RW_LP);
    const bf16_t* P = WSP(const bf16_t, WS_BIG + L1_P);
    bf16_t* OUT = WSP(bf16_t, WS_BIG + (dir ? L1_OB : L1_OF));
    float* BSC = WSP(float, WS_BSC) + (size_t)dir * RGL * 16;
    const float* mu = KIN(24);
    for (int i = tid; i < 64 * 64; i += 512) { const int c = i >> 6, n = i & 63;
        W2T[n * RW_LP + c] = f2bf(KIN(26)[((size_t)dir * 64 + c) * 1024 + h * 64 + n]); A2T[n * RW_LP + c] = f2bf(KIN(28)[((size_t)dir * 64 + c) * 1024 + h * 64 + n]); }
    for (int i = tid; i < 64 * RW_LP; i += 512) Sb[i] = 0;
    float* CV = PL + 64;
    if (tid < 64) { const int n = tid;
        CV[0 * 64 + n] = KIN(25)[dir * 1024 + h * 64 + n]; CV[1 * 64 + n] = KIN(27)[dir * 1024 + h * 64 + n];
        CV[2 * 64 + n] = KIN(30)[h * 64 + n]; CV[3 * 64 + n] = KIN(31)[h * 64 + n]; CV[4 * 64 + n] = KIN(32)[h * 64 + n];
        CV[5 * 64 + n] = mu[h * 64 + n]; CV[6 * 64 + n] = mu[1024 + h * 64 + n]; CV[7 * 64 + n] = mu[2048 + h * 64 + n]; }
    f32x4 Sacc[2];
    Sacc[0] = (f32x4){0.f, 0.f, 0.f, 0.f}; Sacc[1] = (f32x4){0.f, 0.f, 0.f, 0.f};
    u32x4 pf[3];
#define RW_PREFETCH(cn) do { const int t0n_ = dir ? scan_t<32>(1, (cn), 31) : (cn) * 32; const int lo_ = t0n_ < CTXL ? 0 : CTXL, hi_ = t0n_ < CTXL ? CTXL : TT; \
        _Pragma("unroll") for (int q = 0; q < 3; ++q) { const int p = tid + q * 512; pf[q] = (u32x4){0u, 0u, 0u, 0u}; \
            if (p < 34 * 40) { const int rr = p / 40, c = p % 40, t = t0n_ - 1 + rr; \
                if (t >= lo_ && t < hi_) { const int seg = c >> 3, c8 = c & 7; \
                    const int col = seg == 0 ? CD_R + h * 64 : seg == 1 ? CD_K + h * 64 : seg == 2 ? CD_V + h * 64 : seg == 3 ? CD_WL + dir * 64 : CD_AL + dir * 64; \
                    pf[q] = *(const u32x4*)(P + ((size_t)bl * TT + t) * CD_N + col + c8 * 8); } } } } while (0)
    RW_PREFETCH(0);
    __syncthreads();
    for (int ci = 0; ci < TT / 32; ++ci) {
        int tq = tid; asm volatile("" : "+v"(tq));
        const int lane = tq & 63, wid = tq >> 6, fr = lane & 15, fq = lane >> 4, pi = tq >> 4, n4 = (tq & 15) * 4;
        const int t0 = dir ? scan_t<32>(1, ci, 31) : ci * 32;
#pragma unroll
        for (int q = 0; q < 3; ++q) { const int p = tq + q * 512; if (p < 34 * 40) *(u32x4*)(RAW + (p / 40) * RW_LR + (p % 40) * 8) = pf[q]; }
        if (ci + 1 < TT / 32) RW_PREFETCH(ci + 1);
        __syncthreads();
#pragma unroll
        for (int q = 0; q < 8; ++q) { const int idx = tq + q * 512, which = idx >> 11, i = (idx >> 6) & 31, c = idx & 63;
            const int rc = 192 + which * 64 + c;
            const float x = bf2f(RAW[(i + 1) * RW_LR + rc]), xp = bf2f(RAW[i * RW_LR + rc]), xn = bf2f(RAW[(i + 2) * RW_LR + rc]);
            const float m = mu[(which ? 3200 : 3072) + dir * 64 + c];
            const float l = x + m * (0.5f * (xp + xn) - x);
            if (which) ALb[i * RW_LP + c] = f2bf(l); else TWb[i * RW_LP + c] = f2bf(tanhf_(l)); }
        __syncthreads();
        {
            const int which = wid >> 2, tt = (wid >> 1) & 1;
            const bf16_t* Xa = which ? ALb : TWb; const bf16_t* Wt = which ? A2T : W2T; float* Od = which ? YB : RHS;
#pragma unroll
            for (int q2 = 0; q2 < 2; ++q2) { const int nt = (wid & 1) * 2 + q2;
                f32x4 acc = (f32x4){0.f, 0.f, 0.f, 0.f};
#pragma unroll
                for (int k = 0; k < 2; ++k) acc = mma16(ldfrag(Xa, RW_LP, tt * 16, k * 32, fr, fq), ldfrag(Wt, RW_LP, nt * 16, k * 32, fr, fq), acc);
#pragma unroll
                for (int rr = 0; rr < 4; ++rr) Od[(tt * 16 + fq * 4 + rr) * 64 + nt * 16 + fr] = acc[rr]; }
        }
        __syncthreads();
        const int j = dir ? 31 - pi : pi;
        f32x4 r, kd, v, av, bv;
        {
            const f32x4 w0v = *(const f32x4*)(CV + n4), a0v = *(const f32x4*)(CV + 64 + n4), kkw = *(const f32x4*)(CV + 128 + n4), kaw = *(const f32x4*)(CV + 192 + n4), rkw = *(const f32x4*)(CV + 256 + n4);
            const f32x4 mur = *(const f32x4*)(CV + 320 + n4), muk = *(const f32x4*)(CV + 384 + n4), muv = *(const f32x4*)(CV + 448 + n4);
            const f32x4 wl = w0v + *(const f32x4*)(RHS + pi * 64 + n4), al = a0v + *(const f32x4*)(YB + pi * 64 + n4);
            const bf16_t* r1 = RAW + (pi + 1) * RW_LR; const bf16_t* rp = RAW + pi * RW_LR; const bf16_t* rn = RAW + (pi + 2) * RW_LR;
            f32x4 k;
            r = ld4bf(r1 + n4); k = ld4bf(r1 + 64 + n4); v = ld4bf(r1 + 128 + n4);
            r = r + mur * ((ld4bf(rp + n4) + ld4bf(rn + n4)) * 0.5f - r);
            k = k + muk * ((ld4bf(rp + 64 + n4) + ld4bf(rn + 64 + n4)) * 0.5f - k);
            v = v + muv * ((ld4bf(rp + 128 + n4) + ld4bf(rn + 128 + n4)) * 0.5f - v);
            f32x4 a, lw, kk = k * kkw;
            float ssq = kk[0] * kk[0] + kk[1] * kk[1] + kk[2] * kk[2] + kk[3] * kk[3];
            ssq += __shfl_xor(ssq, 1); ssq += __shfl_xor(ssq, 2); ssq += __shfl_xor(ssq, 4); ssq += __shfl_xor(ssq, 8);
            kk = kk * __builtin_amdgcn_rsqf(fmaxf(ssq, 1e-24f));
#pragma unroll
            for (int q = 0; q < 4; ++q) { const float wlog = -softplusf_(-wl[q]) - 0.5f; lw[q] = -__expf(wlog); a[q] = sigmoidf_(al[q]); }
            kd = k * ((a - 1.0f) * kaw + 1.0f);
            float bs = r[0] * kd[0] * rkw[0] + r[1] * kd[1] * rkw[1] + r[2] * kd[2] * rkw[2] + r[3] * kd[3] * rkw[3];
            bs += __shfl_xor(bs, 1); bs += __shfl_xor(bs, 2); bs += __shfl_xor(bs, 4); bs += __shfl_xor(bs, 8);
            av = kk * -1.0f; bv = kk * a;
            *(f32x4*)(CL + j * 64 + n4) = lw;
            const int t = t0 + pi;
            if (t >= CTXL && (tq & 15) == 0) BSC[((size_t)bl * SEQ + (t - CTXL)) * 16 + h] = bs;
        }
        __syncthreads();
        if (wid == 0) {
            float c[32];
#pragma unroll
            for (int q = 0; q < 32; ++q) c[q] = CL[q * 64 + lane];
#pragma unroll
            for (int q = 1; q < 32; ++q) c[q] += c[q - 1];
#pragma unroll
            for (int q = 0; q < 32; ++q) CL[q * 64 + lane] = c[q];
            PL[lane] = __expf(c[31]);
        }
        __syncthreads();
        {
            const f32x4 clj = *(const f32x4*)(CL + j * 64 + n4), cle = *(const f32x4*)(CL + 31 * 64 + n4);
            f32x4 clp = (f32x4){0.f, 0.f, 0.f, 0.f};
            if (j > 0) clp = *(const f32x4*)(CL + (j - 1) * 64 + n4);
            f32x4 at, rt, bt, kt, bh, kh;
#pragma unroll
            for (int q = 0; q < 4; ++q) { const float ep = __expf(clp[q]), ej = __expf(clj[q]), ei = __expf(-clj[q]), ee = __expf(cle[q] - clj[q]);
                at[q] = av[q] * ep; rt[q] = r[q] * ej; bt[q] = bv[q] * ei; kt[q] = kd[q] * ei; bh[q] = bv[q] * ee; kh[q] = kd[q] * ee; }
            st4bf(AR + j * RW_LP + n4, at); st4bf(AR + (32 + j) * RW_LP + n4, rt);
            st4bf(BK + j * RW_LP + n4, bt); st4bf(BK + (32 + j) * RW_LP + n4, kt);
#pragma unroll
            for (int q = 0; q < 4; ++q) { BKh[(n4 + q) * RW_LP + j] = f2bf(bh[q]); BKh[(n4 + q) * RW_LP + 32 + j] = f2bf(kh[q]); ZVT[(n4 + q) * RW_LP + 32 + j] = f2bf(v[q]); }
        }
        __syncthreads();
        {
            const int ti = wid >> 1;
#pragma unroll
            for (int q2 = 0; q2 < 2; ++q2) {
                const int si = (wid & 1) * 2 + q2;
                f32x4 acc = (f32x4){0.f, 0.f, 0.f, 0.f};
#pragma unroll
                for (int k = 0; k < 2; ++k) acc = mma16(ldfrag(AR, RW_LP, ti * 16, k * 32, fr, fq), ldfrag(BK, RW_LP, si * 16, k * 32, fr, fq), acc);
                const int sp = si * 16 + fr, s = sp & 31;
#pragma unroll
                for (int rr = 0; rr < 4; ++rr) { const int tp = ti * 16 + fq * 4 + rr, t = tp & 31;
                    const bool incl = tp >= 32;
                    const float val = (incl ? (s <= t) : (s < t)) ? acc[rr] : 0.f;
                    if (sp < 32) { if (incl) ARB[t * 40 + s] = f2bf(val); else AABT[s * 36 + t] = val; }
                    else { (incl ? ARK : AAK)[t * 40 + s] = f2bf(val); } }
            }
        }
        __syncthreads();
        {
            const int which = wid >> 2, tt = (wid >> 1) & 1;
            const bf16_t* Ak = which ? ARK : AAK; float* Od = which ? YB : RHS;
#pragma unroll
            for (int q2 = 0; q2 < 2; ++q2) {
                const int vt = (wid & 1) * 2 + q2;
                f32x4 acc = (f32x4){0.f, 0.f, 0.f, 0.f};
#pragma unroll
                for (int k = 0; k < 2; ++k) acc = mma16(ldfrag(AR, RW_LP, which * 32 + tt * 16, k * 32, fr, fq), ldfrag(Sb, RW_LP, vt * 16, k * 32, fr, fq), acc);
                acc = mma16(ldfrag(Ak, 40, tt * 16, 0, fr, fq), ldfrag(ZVT, RW_LP, vt * 16, 32, fr, fq), acc);
#pragma unroll
                for (int rr = 0; rr < 4; ++rr) Od[(tt * 16 + fq * 4 + rr) * 64 + vt * 16 + fr] = acc[rr];
            }
        }
        __syncthreads();
        if (wid == 0) {
            float z[32];
#pragma unroll
            for (int t = 0; t < 32; ++t) z[t] = RHS[t * 64 + lane];
            f32x4 cur[4], nxt[4];
#pragma unroll
            for (int half = 0; half < 2; ++half) {
                const int r0 = half * 16;
#pragma unroll
                for (int q4 = 0; q4 < 4; ++q4) cur[q4] = *(const f32x4*)(AABT + r0 * 36 + r0 + q4 * 4);
#pragma unroll
                for (int sc = 0; sc < 15; ++sc) {
                    if (sc + 1 < 15) {
#pragma unroll
                        for (int q4 = 0; q4 < 4; ++q4) if (q4 * 4 + 3 > sc + 1) nxt[q4] = *(const f32x4*)(AABT + (r0 + sc + 1) * 36 + r0 + q4 * 4);
                    }
                    const float zs = z[r0 + sc];
#pragma unroll
                    for (int q4 = 0; q4 < 4; ++q4)
#pragma unroll
                        for (int e = 0; e < 4; ++e) if (q4 * 4 + e > sc) z[r0 + q4 * 4 + e] += cur[q4][e] * zs;
                    asm volatile("" : "+v"(z[r0 + sc + 1]) :: "memory");
#pragma unroll
                    for (int q4 = 0; q4 < 4; ++q4) if (q4 * 4 + 3 > sc + 1) cur[q4] = nxt[q4];
                }
                if (half == 0) {
#pragma unroll
                    for (int sc = 0; sc < 16; ++sc) {
                        f32x4 ca[4];
#pragma unroll
                        for (int q4 = 0; q4 < 4; ++q4) ca[q4] = *(const f32x4*)(AABT + sc * 36 + 16 + q4 * 4);
#pragma unroll
                        for (int q4 = 0; q4 < 4; ++q4)
#pragma unroll
                            for (int e = 0; e < 4; ++e) z[16 + q4 * 4 + e] += ca[q4][e] * z[sc];
                        if (sc & 1) asm volatile("" ::: "memory");
                    }
                }
            }
#pragma unroll
            for (int q = 0; q < 4; ++q) { u32x4 w;
                w.x = pack2(z[q * 8 + 0], z[q * 8 + 1]); w.y = pack2(z[q * 8 + 2], z[q * 8 + 3]); w.z = pack2(z[q * 8 + 4], z[q * 8 + 5]); w.w = pack2(z[q * 8 + 6], z[q * 8 + 7]);
                *(u32x4*)(ZVT + lane * RW_LP + q * 8) = w; }
        }
        __syncthreads();
        {
            const int nt = wid >> 1;
            const f32x4 pl = *(const f32x4*)(PL + nt * 16 + fq * 4);
#pragma unroll
            for (int q2 = 0; q2 < 2; ++q2) {
                const int vt = (wid & 1) * 2 + q2;
                Sacc[q2] = Sacc[q2] * pl;
#pragma unroll
                for (int k = 0; k < 2; ++k) Sacc[q2] = mma16(ldfrag(BKh, RW_LP, nt * 16, k * 32, fr, fq), ldfrag(ZVT, RW_LP, vt * 16, k * 32, fr, fq), Sacc[q2]);
                st4bf(Sb + (vt * 16 + fr) * RW_LP + nt * 16 + fq * 4, Sacc[q2]);
            }
        }
        if (t0 >= CTXL) {
            const int vt = wid >> 1, tt = wid & 1;
            f32x4 acc = (f32x4){0.f, 0.f, 0.f, 0.f};
            acc = mma16(ldfrag(ZVT, RW_LP, vt * 16, 0, fr, fq), ldfrag(ARB, 40, tt * 16, 0, fr, fq), acc);
            const int t = tt * 16 + fr, v0 = vt * 16 + fq * 4;
#pragma unroll
            for (int rr = 0; rr < 4; ++rr) acc[rr] += YB[t * 64 + v0 + rr];
            const int tn = scan_t<32>(dir, ci, t);
            st4bf(OUT + ((size_t)bl * SEQ + (tn - CTXL)) * 1024 + h * 64 + v0, acc);
        }
        __syncthreads();
    }
#undef RW_PREFETCH
}

__device__ __forceinline__ void phase_mix_cd(const KP& kp, unsigned char* lds, int which) {
    if (which & 1) for (int u = obid(); u < 256; u += gridDim.x) { rwkv_unit(kp, lds, u >> 5, (u >> 1) & 15, u & 1); __syncthreads(); }
    if (which & 2) for (int u = obid(); u < 1024; u += gridDim.x) { attn_unit(kp, lds, u >> 7, (u >> 4) & 7, u & 15); __syncthreads(); }
}

struct EpiFinCD {
    const bf16_t* OF; const bf16_t* OB; const bf16_t* P; const float* BSC; const float* ln; const float* mu; bf16_t* AOUT;
    __device__ __forceinline__ void operator()(const f32x4 (&acc)[4][4], int rb, int cb, int fr, int fq) const {
        const int head = cb >> 6;
#pragma unroll
        for (int i = 0; i < 4; ++i) { const int lr = rb + i * 16 + fr, s = lr & 2047;
            const size_t prow = (size_t)(lr >> 11) * TT + CTXL + s;
            f32x4 o[4]; float ss = 0.f;
#pragma unroll
            for (int j = 0; j < 4; ++j) { const int col = cb + j * 16 + fq * 4;
                o[j] = ld4bf(OF + (size_t)lr * 1024 + col) + ld4bf(OB + (size_t)lr * 1024 + col);
                ss += o[j][0] * o[j][0] + o[j][1] * o[j][1] + o[j][2] * o[j][2] + o[j][3] * o[j][3]; }
            ss += __shfl_xor(ss, 16); ss += __shfl_xor(ss, 32);
            const float rstd = rsqrtf(ss * (1.0f / 64.0f) + EPS);
            const float bon = BSC[(size_t)lr * 16 + head] + BSC[(size_t)RGL * 16 + (size_t)lr * 16 + head];
#pragma unroll
            for (int j = 0; j < 4; ++j) { const int col = cb + j * 16 + fq * 4;
                const bf16_t* pv = P + prow * CD_N + CD_V + col;
                const f32x4 v = ld4bf(pv);
                const f32x4 vp = s > 0 ? ld4bf(pv - CD_N) : (f32x4){0.f, 0.f, 0.f, 0.f};
                const f32x4 vn = s < SEQ - 1 ? ld4bf(pv + CD_N) : (f32x4){0.f, 0.f, 0.f, 0.f};
                const f32x4 vl = v + *(const f32x4*)(mu + 2048 + col) * ((vp + vn) * 0.5f - v);
                const f32x4 y = o[j] * rstd * *(const f32x4*)(ln + col) + vl * bon;
                st4bf(AOUT + (size_t)lr * 1536 + 512 + col, y * acc[i][j]); }
        }
    }
};
PHASE_FN void phase_fin_cd(const KP& kp, unsigned char* lds) {
    GA ga{WSP(const bf16_t, WS_SG), nullptr, 128, 0, 128, nullptr, RGL, 0, 0};
    EpiFinCD ep{WSP(const bf16_t, WS_BIG + L1_OF), WSP(const bf16_t, WS_BIG + L1_OB), WSP(const bf16_t, WS_BIG + L1_P), WSP(const float, WS_BSC), KIN(33), KIN(24), WSP(bf16_t, WS_BIG + L1_AOUT)};
    for (int u = obid(); u < (RGL / 256) * 8; u += gridDim.x) gemm_tile(lds, ga, WSP(const bf16_t, WS_WMIX + WM_G2), 128, u >> 3, u & 7, ep);
}
PHASE_FN void phase_gemm_out_cd(const KP& kp, unsigned char* lds) {
    pg8::Gemm g{WSP(const bf16_t, WS_BIG + L1_AOUT), WSP(const bf16_t, WS_WMIX + WM_CD_OUT), RGL, 1024, 1536, nullptr, 0x7fffffff};
    pg8::StaticOrder S; S.init(RGL, 1024, (int)gridDim.x, obid());
    pg8::EpiBfG E{WSP(bf16_t, WS_BIG + L1_U), 1024, 1024, 0x7fffffff};
    pg8::gemm_phase<pg8::EpiBfG, pg8::StaticOrder, false>((PG8_LAS unsigned char*)lds, g, S, E, nullptr);
    __syncthreads();
}

__device__ __attribute__((noinline)) void grid_sync(unsigned* barw, unsigned x, volatile LAS unsigned* st) { XcdBarrier b; b.bar = barw; b.x = x; b.st = st; xcd_barrier(b); }
constexpr int N_PHASES = 39;
__global__ void __launch_bounds__(512, 2) fwd_kernel(KP kparg) {
    extern __shared__ __attribute__((aligned(16))) unsigned char lds[];
    const int lo = kparg.ph_lo, hi = kparg.ph_hi;
    const KP& kp = kparg;
    volatile LAS unsigned* xbst = (volatile LAS unsigned*)(LAS unsigned char*)(lds + LDS_BYTES - 16);
    if (threadIdx.x == 0) { xbst[0] = 0u; xbst[1] = 0u; }
    __syncthreads();
    XcdBarrier bar; bar.bar = (unsigned*)kparg.ws; bar.x = 0; bar.st = xbst;
    if (hi - lo > 1) bar = xcd_barrier_post((unsigned*)kparg.ws, xbst);
#define IN(k) (lo <= (k) && (k) < hi)
#define SEAM(k) do { if (IN(k) && IN((k) + 1)) { grid_sync((unsigned*)kp.ws, bar.x, xbst); if (PROBE_DUP & 512) grid_sync((unsigned*)kp.ws, bar.x, xbst); } } while (0)
#define PHASE(...) do { if (IN(ph)) { __VA_ARGS__ } SEAM(ph); ++ph; } while (0)
    int ph = 0;
    PHASE(phase_mod(kp, lds); __syncthreads(); phase_conv_ab(kp, lds); if (PROBE_DUP & 32) { __syncthreads(); phase_mod(kp, lds); __syncthreads(); phase_conv_ab(kp, lds); });
#pragma unroll
    for (int g = 0; g < NG; ++g) {
        PHASE(phase_u(kp, 0, g); if (PROBE_DUP & 128) phase_u(kp, 0, g););
        PHASE(phase_gemm_in(kp, lds, 0); if (PROBE_DUP & 8) phase_gemm_in(kp, lds, 0););
        PHASE(phase_xconv(kp); if (PROBE_DUP & 2048) phase_xconv(kp););
        PHASE(phase_scan_ab(kp, lds); if (PROBE_DUP & 1) { __syncthreads(); phase_scan_ab(kp, lds); });
        PHASE(phase_fin_ab(kp););
        PHASE(phase_gemm_out_ab(kp, lds); if (PROBE_DUP & 256) phase_gemm_out_ab(kp, lds););
        PHASE(phase_r(kp, lds, 0, g););
    }
    PHASE(phase_moe_gather(kp, 0); phase_conv_moe(kp, lds, 0); phase_conv_cd(kp, lds); if (PROBE_DUP & 64) { phase_moe_gather(kp, 0); phase_conv_moe(kp, lds, 0); phase_conv_cd(kp, lds); });
    PHASE(phase_moe_gemm(kp, lds, 0, false); if (PROBE_DUP & 16) { __syncthreads(); phase_moe_gemm(kp, lds, 0, false); });
    PHASE(phase_moe_gemm(kp, lds, 0, true); if (PROBE_DUP & 16) { __syncthreads(); phase_moe_gemm(kp, lds, 0, true); });
    PHASE(phase_combine(kp, 0););
#pragma unroll
    for (int g = 0; g < NG; ++g) {
        PHASE(phase_u(kp, 1, g); if (PROBE_DUP & 128) phase_u(kp, 1, g););
        PHASE(phase_gemm_in(kp, lds, 1); if (PROBE_DUP & 8) phase_gemm_in(kp, lds, 1););
        PHASE(phase_prep_cd(kp););
        PHASE(phase_upproj(kp, lds); if (PROBE_DUP & 4096) phase_upproj(kp, lds););
        PHASE(phase_mix_cd(kp, lds, 3); if (PROBE_DUP & 2) { __syncthreads(); phase_mix_cd(kp, lds, 1); } if (PROBE_DUP & 4) { __syncthreads(); phase_mix_cd(kp, lds, 2); });
        PHASE(phase_fin_cd(kp, lds); if (PROBE_DUP & 4096) phase_fin_cd(kp, lds););
        PHASE(phase_gemm_out_cd(kp, lds); if (PROBE_DUP & 256) phase_gemm_out_cd(kp, lds););
        PHASE(phase_r(kp, lds, 1, g););
    }
    PHASE(phase_moe_gather(kp, 1); phase_conv_moe(kp, lds, 1););
    PHASE(phase_moe_gemm(kp, lds, 1, false););
    PHASE(phase_moe_gemm(kp, lds, 1, true););
    PHASE(phase_combine(kp, 1););
#undef PHASE
#undef IN
#undef SEAM
}

extern "C" void kernel_launch(void* const* d_in, const int* in_sizes, int n_in, void* d_out, int out_size, void* d_ws, size_t ws_size, hipStream_t stream) {
    static int grid = 0;
    if (grid == 0) {
        if (n_in != 42 || out_size != NLAT * D || ws_size < WS_NEED) { fprintf(stderr, "kernel_launch: unexpected shapes: n_in %d out %d ws %zu (need %zu)\n", n_in, out_size, ws_size, (size_t)WS_NEED); grid = -1; return; }
        int dev = 0, cus = 0, per_cu = 0;
        if (hipGetDevice(&dev) != hipSuccess || hipDeviceGetAttribute(&cus, hipDeviceAttributeMultiprocessorCount, dev) != hipSuccess) { grid = -1; return; }
        if (hipFuncSetAttribute((const void*)fwd_kernel, hipFuncAttributeMaxDynamicSharedMemorySize, LDS_BYTES) != hipSuccess) { fprintf(stderr, "kernel_launch: hipFuncSetAttribute failed\n"); grid = -1; return; }
        if (hipOccupancyMaxActiveBlocksPerMultiprocessor(&per_cu, (const void*)fwd_kernel, 512, LDS_BYTES) != hipSuccess || per_cu < 1) { fprintf(stderr, "kernel_launch: occupancy query says %d blocks per CU\n", per_cu); grid = -1; (void)hipGetLastError(); return; }
        grid = cus;
    }
    if (grid < 0) return;
    (void)hipMemsetAsync(d_ws, 0, CTL_BYTES, stream);
    KP kp{};
    for (int i = 0; i < 42; ++i) kp.in[i] = (const float*)d_in[i];
    kp.out = (float*)d_out; kp.ws = (unsigned char*)d_ws;
#if N_LAUNCH_MODE == 1
    kp.ph_lo = 0; kp.ph_hi = N_PHASES;
    hipLaunchKernelGGL(fwd_kernel, dim3(grid), dim3(512), LDS_BYTES, stream, kp);
#else
    for (int p = 0; p < N_PHASES; ++p) { kp.ph_lo = p; kp.ph_hi = p + 1; hipLaunchKernelGGL(fwd_kernel, dim3(grid), dim3(512), LDS_BYTES, stream, kp); }
#endif
}
```

```cpp
#include <hip/hip_runtime.h>
#include <stdint.h>
#include <stdio.h>

typedef unsigned short bf16_t;
typedef short bf16x8 __attribute__((ext_vector_type(8)));
typedef float f32x4 __attribute__((ext_vector_type(4)));
typedef float f32x2 __attribute__((ext_vector_type(2)));
typedef unsigned u32x4 __attribute__((ext_vector_type(4)));
typedef unsigned u32x2 __attribute__((ext_vector_type(2)));

#ifndef RWP
#define RWP 0
#endif
#ifndef PROBE_DUP
#define PROBE_DUP 0
#endif
#ifndef N_LAUNCH_MODE
#define N_LAUNCH_MODE 1
#endif

constexpr int NB = 16, SEQ = 2048, CTXL = 256, TT = 2304, D = 1024;
constexpr int NTOK = NB * TT, NLAT = NB * SEQ;
constexpr int NG = 2, BG = NB / NG, RG = BG * TT, RGL = BG * SEQ;
constexpr float EPS = 1e-6f;
constexpr int AB_N = 5424, AB_NPAD = 5632, AB_Q = 0, AB_K = 512, AB_V = 1024, AB_OG = 2048, AB_IG = 3072, AB_FG = 3080, AB_Z = 3088, AB_XBC = 4112, AB_DT = 5392;
constexpr int CD_N = 4128, CD_NPAD = 4352, CD_M0 = 0, CD_M1 = 384, CD_KR = 640, CD_R = 672, CD_K = 1696, CD_V = 2720, CD_WL = 3744, CD_AL = 3872, CD_GL = 4000;
constexpr int CD_RW0 = 672;

constexpr size_t CTL_BYTES = 32768;
constexpr size_t CTL_CNT = 16384;
constexpr size_t WS_MODV = CTL_BYTES;
constexpr size_t WS_HC   = WS_MODV + (size_t)2 * 17 * 6144 * 4;
constexpr size_t WS_TOKE = WS_HC + (size_t)NB * CTXL * D * 4;
constexpr size_t WS_TOKP = WS_TOKE + (size_t)NTOK * 2 * 4;
constexpr size_t WS_TOKW = WS_TOKP + (size_t)NTOK * 2 * 4;
constexpr size_t WS_LIST = WS_TOKW + (size_t)NTOK * 2 * 4;
constexpr size_t WS_BSC  = WS_LIST + (size_t)16 * NTOK * 4;
constexpr size_t WS_SG   = WS_BSC + (size_t)2 * RGL * 16 * 4;
constexpr size_t WS_WMIX = WS_SG + (size_t)RGL * 128 * 2;
constexpr size_t WMIX_BYTES = (size_t)16 << 20;
constexpr size_t WS_V    = WS_WMIX + WMIX_BYTES;
constexpr size_t WS_BIG  = WS_V + (size_t)NTOK * D * 2;
constexpr size_t WM_AB_IN = 0, WM_AB_OUT = (size_t)AB_NPAD * 1024 * 2;
constexpr size_t WM_CD_IN = 0, WM_CD_OUT = (size_t)CD_NPAD * 1024 * 2, WM_UQ = WM_CD_OUT + (size_t)1024 * 1536 * 2, WM_UKV = WM_UQ + (size_t)768 * 384 * 2, WM_G2 = WM_UKV + (size_t)1024 * 256 * 2;
static_assert(WM_AB_OUT + (size_t)1024 * 2048 * 2 <= WMIX_BYTES, "wmix ab");
static_assert(WM_G2 + (size_t)1024 * 128 * 2 <= WMIX_BYTES, "wmix cd");
constexpr size_t SZ_RG1K = (size_t)RG * 1024 * 2, SZ_RGL1K = (size_t)RGL * 1024 * 2;
constexpr size_t L0_P = 0, L0_AO = (size_t)RG * AB_N * 2  , L0_HB = L0_AO + 2 * SZ_RG1K, L0_YB = L0_HB + SZ_RG1K, L0_U = L0_YB + SZ_RG1K, L0_END = L0_U + SZ_RG1K;
constexpr size_t L1_P = 0, L1_Q = (size_t)RG * CD_N * 2, L1_KV = L1_Q + (size_t)RGL * 768 * 2, L1_OF = L1_KV + SZ_RG1K, L1_OB = L1_OF + SZ_RGL1K, L1_AOUT = L1_OB + SZ_RGL1K, L1_U = L1_AOUT + (size_t)RGL * 1536 * 2, L1_TWAL = L1_U + SZ_RG1K  , L1_END = L1_TWAL + (size_t)RG * 256 * 2;
constexpr int MOE_PADROWS = 16 * 256;
constexpr size_t MO_WUP = 0, MO_WDN = (size_t)17 * 1024 * 1024 * 2, MO_HID = MO_WDN + (size_t)17 * 1024 * 512 * 2;
constexpr size_t MO_XG = MO_HID + (size_t)(3 * NTOK + MOE_PADROWS) * 512 * 2;
constexpr size_t MO_CON = MO_XG, MO_END = MO_CON + (size_t)(3 * NTOK + MOE_PADROWS) * 1024 * 2;
constexpr size_t BIG_BYTES = MO_END > L0_END ? (MO_END > L1_END ? MO_END : L1_END) : (L0_END > L1_END ? L0_END : L1_END);
constexpr size_t WS_NEED = WS_BIG + BIG_BYTES;

constexpr int LDS_BYTES = 147456;

__device__ __forceinline__ float bf2f(unsigned short h) { return __uint_as_float(((unsigned)h) << 16); }
typedef __bf16 bf16v2_t __attribute__((ext_vector_type(2)));
__device__ __forceinline__ unsigned pack2(float a, float b) { const bf16v2_t h = __builtin_convertvector((f32x2){a, b}, bf16v2_t); return __builtin_bit_cast(unsigned, h); }
__device__ __forceinline__ unsigned short f2bf(float f) { const __bf16 h = (__bf16)f; return __builtin_bit_cast(unsigned short, h); }
__device__ __forceinline__ float lo2f(unsigned w) { return __uint_as_float(w << 16); }
__device__ __forceinline__ float hi2f(unsigned w) { return __uint_as_float(w & 0xffff0000u); }
__device__ __forceinline__ float wsum(float v) {
#pragma unroll
    for (int o = 32; o; o >>= 1) v += __shfl_xor(v, o);
    return v; }
__device__ __forceinline__ float frcp_(float x) { return __builtin_amdgcn_rcpf(x); }
__device__ __forceinline__ float sigmoidf_(float x) { return __builtin_amdgcn_rcpf(1.0f + __expf(-x)); }
__device__ __forceinline__ float siluf_(float x) { return x * __builtin_amdgcn_rcpf(1.0f + __expf(-x)); }
__device__ __forceinline__ float softplusf_(float x) { return fmaxf(x, 0.0f) + __logf(1.0f + __expf(-fabsf(x))); }
__device__ __forceinline__ float logsigmoidf_(float x) { return fminf(x, 0.0f) - __logf(1.0f + __expf(-fabsf(x))); }
__device__ __forceinline__ float tanhf_(float x) { return 1.0f - 2.0f * __builtin_amdgcn_rcpf(__expf(2.0f * x) + 1.0f); }
__device__ __forceinline__ f32x4 mma16(bf16x8 a, bf16x8 b, f32x4 c) { return __builtin_amdgcn_mfma_f32_16x16x32_bf16(a, b, c, 0, 0, 0); }
__device__ __forceinline__ bf16x8 ldfrag(const bf16_t* base, int ld, int row0, int k0, int fr, int fq) { return *(const bf16x8*)(base + (row0 + fr) * ld + k0 + fq * 8); }
__device__ __forceinline__ void st4bf(bf16_t* p, f32x4 v) { u32x2 w; w.x = pack2(v[0], v[1]); w.y = pack2(v[2], v[3]); *(u32x2*)p = w; }
__device__ __forceinline__ f32x4 ld4bf(const bf16_t* p) { u32x2 w = *(const u32x2*)p; return (f32x4){lo2f(w.x), hi2f(w.x), lo2f(w.y), hi2f(w.y)}; }

#define PHASE_FN __device__ __forceinline__
__device__ __forceinline__ int otid() { int t = threadIdx.x; asm volatile("" : "+v"(t)); return t; }
__device__ __forceinline__ int obid() { int t = blockIdx.x; asm volatile("" : "+s"(t)); return t; }
template <class T> __device__ __forceinline__ T* as_global(T* p) { return p; }
__device__ __forceinline__ void lds_barrier() { asm volatile("s_waitcnt lgkmcnt(0)" ::: "memory"); __builtin_amdgcn_s_barrier(); asm volatile("" ::: "memory"); }
struct KP { const float* in[42]; float* out; unsigned char* ws; int ph_lo, ph_hi; };

#define XB_TMO      128
#define XB_XCNT(j)  (256  + 64 * (j))
#define XB_XSUB(j)  (1280 + 64 * (j))
#define XB_XGEN(j)  (2304 + 64 * (j))
#define XB_TOP      3328
#define XB_TOPGEN   3392
#define XCD_BAR_WORDS 3456
#define XB_SPIN_CAP (1u << 18)
#define LAS __attribute__((address_space(3)))

__device__ __forceinline__ unsigned xb_ld(unsigned* p)              { return __hip_atomic_load(p, __ATOMIC_RELAXED, __HIP_MEMORY_SCOPE_AGENT); }
__device__ __forceinline__ unsigned xb_add(unsigned* p, unsigned v) { return __hip_atomic_fetch_add(p, v, __ATOMIC_RELAXED, __HIP_MEMORY_SCOPE_AGENT); }
__device__ __forceinline__ unsigned xb_xcc_id() { return (unsigned)__builtin_amdgcn_s_getreg((3 << 11) | 20) & 0xFu; }
#define XB_SPIN(cond, bar) do { unsigned _sp = 0; while (cond) { __builtin_amdgcn_s_sleep(1); \
    if ((++_sp & 255u) == 0u) { if (xb_ld(&(bar)[XB_TMO])) break; if (_sp > XB_SPIN_CAP) { atomicAdd(&(bar)[XB_TMO], 1u); break; } } } } while (0)

struct XcdBarrier {
    unsigned* bar; unsigned x;
    volatile LAS unsigned* st;
};

__device__ __forceinline__ XcdBarrier xcd_barrier_post(unsigned* bar, volatile LAS unsigned* st) {
    XcdBarrier b; b.bar = bar; b.x = xb_xcc_id(); b.st = st;
    if (threadIdx.x == 0) (void)xb_add(&bar[XB_XCNT(b.x)], 1u);
    return b;
}
__device__ __forceinline__ void xcd_barrier_complete(unsigned* bar, unsigned x, unsigned& nloc, unsigned& nx) {
    const unsigned G = gridDim.x * gridDim.y * gridDim.z;
    unsigned sum, cnt, mine, sp = 0u;
    for (;;) {
        sum = 0u; cnt = 0u; mine = 0u;
#pragma unroll
        for (unsigned j = 0; j < 16; ++j) { const unsigned c = xb_ld(&bar[XB_XCNT(j)]); sum += c; cnt += (c > 0u) ? 1u : 0u; mine = (j == x) ? c : mine; }
        if (sum == G) break;
        __builtin_amdgcn_s_sleep(1);
        if ((++sp & 255u) == 0u) { if (xb_ld(&bar[XB_TMO])) break; if (sp > XB_SPIN_CAP) { atomicAdd(&bar[XB_TMO], 1u); break; } }
    }
    nloc = mine > 0u ? mine : 1u; nx = cnt > 0u ? cnt : 1u;
}

__device__ __forceinline__ void xcd_barrier(const XcdBarrier& b) {
    asm volatile("s_waitcnt vmcnt(0)" ::: "memory");
    __syncthreads();
    if (threadIdx.x == 0) {
        unsigned* bar = b.bar;
        __builtin_amdgcn_s_waitcnt(0);
        unsigned nloc = b.st[0], nx = b.st[1];
        if (nloc == 0u) { xcd_barrier_complete(bar, b.x, nloc, nx); b.st[0] = nloc; b.st[1] = nx; }
        const unsigned old = xb_add(&bar[XB_XSUB(b.x)], 1u);
        const unsigned gen = old / nloc;
        if (old + 1u == (gen + 1u) * nloc) {
            __builtin_amdgcn_fence(__ATOMIC_RELEASE, "agent");
            asm volatile("s_waitcnt vmcnt(0)" ::: "memory");
            const unsigned og = xb_add(&bar[XB_TOP], 1u);
            const unsigned tg = og / nx;
            if (og + 1u == (tg + 1u) * nx) xb_add(&bar[XB_TOPGEN], 1u);
            else XB_SPIN(xb_ld(&bar[XB_TOPGEN]) == tg, bar);
            __builtin_amdgcn_fence(__ATOMIC_ACQUIRE, "agent");
            xb_add(&bar[XB_XGEN(b.x)], 1u);
            asm volatile("s_waitcnt vmcnt(0)" ::: "memory");
        } else {
            XB_SPIN(xb_ld(&bar[XB_XGEN(b.x)]) == gen, bar);
            __builtin_amdgcn_fence(__ATOMIC_ACQUIRE, "agent");
            asm volatile("s_waitcnt vmcnt(0)" ::: "memory");
        }
    }
    __syncthreads();
}
struct GA {
    const bf16_t* a0; const bf16_t* a1;
    int ld0, ld1, ksplit;
    const int* list;
    int nrows;
    int mode;
    int row0;
};
constexpr int G_LDT = 40;
constexpr int GEMM_LDS = (2 * 256 * G_LDT + 2 * 128 * G_LDT) * 2;

template <class Epi>
__device__ __forceinline__ void gemm_tile(unsigned char* lds, const GA& ga, const bf16_t* __restrict__ Bt, int K, int mt, int nt, const Epi& epi) {
    const int tid = otid(), lane = tid & 63, wid = __builtin_amdgcn_readfirstlane(tid >> 6), wm = wid >> 1, wn = wid & 1, fr = lane & 15, fq = lane >> 4;
    bf16_t* sA = (bf16_t*)lds;
    bf16_t* sB = sA + 2 * 256 * G_LDT;
    const int kp = tid & 3;
    const int r0 = tid >> 2, r1 = r0 + 128;
    int s0, s1;
    {
        int lr = mt * 256 + r0; if (lr >= ga.nrows) lr = 0;
        s0 = ga.list ? ga.list[lr] : (ga.mode == 1 ? (lr >> 11) * TT + CTXL + (lr & 2047) : ga.row0 + lr);
        lr = mt * 256 + r1; if (lr >= ga.nrows) lr = 0;
        s1 = ga.list ? ga.list[lr] : (ga.mode == 1 ? (lr >> 11) * TT + CTXL + (lr & 2047) : ga.row0 + lr);
    }
    const bf16_t* pa00 = ga.a0 + (size_t)s0 * ga.ld0 + kp * 8;
    const bf16_t* pa01 = ga.a0 + (size_t)s1 * ga.ld0 + kp * 8;
    const bf16_t* pa10 = ga.a1 ? ga.a1 + (size_t)s0 * ga.ld1 + kp * 8 : pa00;
    const bf16_t* pa11 = ga.a1 ? ga.a1 + (size_t)s1 * ga.ld1 + kp * 8 : pa01;
    const bf16_t* pb = Bt + (size_t)(nt * 128 + r0) * K + kp * 8;
    const int ksplit = ga.ksplit;
    f32x4 acc[4][4];
#pragma unroll
    for (int i = 0; i < 4; ++i)
#pragma unroll
        for (int j = 0; j < 4; ++j) acc[i][j] = (f32x4){0.f, 0.f, 0.f, 0.f};
    const int nk = K >> 5;
    u32x4 ra0, ra1, rb;
    {
        ra0 = *(const u32x4*)(pa00); ra1 = *(const u32x4*)(pa01); rb = *(const u32x4*)(pb);
        if (0 >= ksplit) { ra0 = *(const u32x4*)(pa10); ra1 = *(const u32x4*)(pa11); }
    }
    *(u32x4*)(sA + (r0) * G_LDT + kp * 8) = ra0;
    *(u32x4*)(sA + (r1) * G_LDT + kp * 8) = ra1;
    *(u32x4*)(sB + (r0) * G_LDT + kp * 8) = rb;
    __syncthreads();
    for (int kt = 0; kt < nk; ++kt) {
        const int cur = kt & 1;
        if (kt + 1 < nk) {
            const int k0 = (kt + 1) << 5;
            if (k0 < ksplit) { ra0 = *(const u32x4*)(pa00 + k0); ra1 = *(const u32x4*)(pa01 + k0); }
            else { ra0 = *(const u32x4*)(pa10 + (k0 - ksplit)); ra1 = *(const u32x4*)(pa11 + (k0 - ksplit)); }
            rb = *(const u32x4*)(pb + k0);
        }
        const bf16_t* cA = sA + cur * 256 * G_LDT;
        const bf16_t* cB = sB + cur * 128 * G_LDT;
        bf16x8 af[4], bfr[4];
#pragma unroll
        for (int i = 0; i < 4; ++i) af[i] = ldfrag(cA, G_LDT, wm * 64 + i * 16, 0, fr, fq);
#pragma unroll
        for (int j = 0; j < 4; ++j) bfr[j] = ldfrag(cB, G_LDT, wn * 64 + j * 16, 0, fr, fq);
#pragma unroll
        for (int i = 0; i < 4; ++i)
#pragma unroll
            for (int j = 0; j < 4; ++j) acc[i][j] = mma16(bfr[j], af[i], acc[i][j]);
        if (kt + 1 < nk) {
            const int nb = cur ^ 1;
            *(u32x4*)(sA + (nb * 256 + r0) * G_LDT + kp * 8) = ra0;
            *(u32x4*)(sA + (nb * 256 + r1) * G_LDT + kp * 8) = ra1;
            *(u32x4*)(sB + (nb * 128 + r0) * G_LDT + kp * 8) = rb;
        }
        __syncthreads();
    }
    epi(acc, mt * 256 + wm * 64, nt * 128 + wn * 64, fr, fq);
}

struct EpiBf {
    bf16_t* out; int ld, nrows, ncols;
    __device__ __forceinline__ void operator()(const f32x4 (&acc)[4][4], int rb, int cb, int fr, int fq) const {
#pragma unroll
        for (int i = 0; i < 4; ++i) { const int lr = rb + i * 16 + fr; if (lr < nrows) {
#pragma unroll
            for (int j = 0; j < 4; ++j) { const int col = cb + j * 16 + fq * 4; if (col < ncols) st4bf(out + (size_t)lr * ld + col, acc[i][j]); } } }
    }
};
struct EpiSwiglu {
    bf16_t* out; int nrows;
    __device__ __forceinline__ void operator()(const f32x4 (&acc)[4][4], int rb, int cb, int fr, int fq) const {
#pragma unroll
        for (int i = 0; i < 4; ++i) { const int lr = rb + i * 16 + fr; if (lr < nrows) {
#pragma unroll
            for (int j = 0; j < 2; ++j) { const int col = (cb >> 1) + j * 16 + fq * 4; f32x4 g = acc[i][j], u = acc[i][j + 2], o;
#pragma unroll
                for (int r = 0; r < 4; ++r) o[r] = siluf_(g[r]) * u[r];
                st4bf(out + (size_t)lr * 512 + col, o); } } }
    }
};

namespace pg8 {
#define PG8_LAS __attribute__((address_space(3)))
typedef unsigned short bf16_t;
typedef short bf16x8 __attribute__((ext_vector_type(8)));
typedef float f32x4 __attribute__((ext_vector_type(4)));
typedef unsigned u32x4 __attribute__((ext_vector_type(4)));
constexpr int BM = 256, BK = 64, HALF = 128, HTB = HALF * BK * 2  , STAGE_BYTES = 8 * HTB, NXCD = 8, WGM = 8;

__host__ __device__ __forceinline__ int lds_byte(int r, int c) { const int st = (r >> 4) * 2 + (c >> 5), rr = r & 15, cc = c & 31, ob = rr * 64 + cc * 2; return st * 1024 + (ob ^ (((ob >> 9) & 1) << 5)); }
__host__ __device__ __forceinline__ void stage_rc(int b, int& R, int& C) { const int st = b / 1024, sb = b % 1024, swz = sb ^ (((sb >> 9) & 1) << 5); R = (st >> 1) * 16 + swz / 64; C = (st & 1) * 32 + (swz % 64) / 2; }
__host__ __device__ __forceinline__ int perm32(int rho) { const int n = rho >> 4, i = rho & 15; return 8 * (i >> 2) + 4 * n + (i & 3); }

struct Unit { int pm, pn; };
struct Gemm { const bf16_t* A; const bf16_t* Bt; int M, N, K; const bf16_t* A2; int pm_split; };
#define PG8_ABASE(g, pm) ((pm) < (g).pm_split ? (const char*)(g).A + (size_t)(pm) * tstep : (const char*)(g).A2 + (size_t)((pm) - (g).pm_split) * tstep)
struct StaticOrder {
    int nM, nN, nwg, G, c;
    __host__ __device__ void init(int M, int N, int G_, int c_) { nM = M / BM; nN = N / BM; nwg = nM * nN; G = G_; c = c_; }
    __host__ __device__ bool next(int i, Unit& u) const {
        const long L = (long)i * G + c; if (L >= nwg) return false;
        int wgid = (int)L; { const int q = nwg / NXCD, r = nwg % NXCD, xcd = wgid % NXCD, off = wgid / NXCD; wgid = (xcd < r ? xcd * (q + 1) : r * (q + 1) + (xcd - r) * q) + off; }
        const int nig = WGM * nN, gid = wgid / nig, fm = gid * WGM, gsz = (nM - fm) < WGM ? (nM - fm) : WGM;
        u.pm = fm + ((wgid % nig) % gsz); u.pn = (wgid % nig) / gsz; return true;
    }
    __device__ __forceinline__ void a_ready(const Unit&) const {}
    __device__ __forceinline__ void done(const Unit&) const {}
};
__device__ __forceinline__ unsigned cvt_pk_bf16(float lo, float hi) { unsigned r; asm volatile("v_cvt_pk_bf16_f32 %0, %1, %2" : "=v"(r) : "v"(lo), "v"(hi)); return r; }
typedef float f32x2 __attribute__((ext_vector_type(2)));
template <class Epi, class Sched, bool STAMP = false>
__device__ __forceinline__ void gemm_phase(PG8_LAS unsigned char* lds, const Gemm g, const Sched& S, const Epi& E, unsigned long long* stamps) {
    const int tid = otid(), wid = __builtin_amdgcn_readfirstlane(tid >> 6), lane = tid & 63, wr = wid >> 2, wc = wid & 3, fr = lane & 15, fq = lane >> 4;
    const int K = g.K, nt = K / BK;
    int ts_lo = 0, ts_hi = 0, nts = 0; const unsigned long long rt_entry = STAMP ? (unsigned long long)wall_clock64() : 0ull;
#define PG8_STAMP() do { if (STAMP && wid == 0 && nts < 64) { const unsigned long long _c = (unsigned long long)clock64(); \
        ts_lo = (lane == nts) ? (int)(unsigned)_c : ts_lo; ts_hi = (lane == nts) ? (int)(unsigned)(_c >> 32) : ts_hi; ++nts; } } while (0)
    PG8_STAMP();
    unsigned voffA[2], voffB[2];
#pragma unroll
    for (int i = 0; i < 2; ++i) { int R, C; stage_rc(tid * 16 + i * 8192, R, C); const int Rb = Epi::PERM ? ((R & ~31) + perm32(R & 31)) : R;
        voffA[i] = (unsigned)(R * K + C) * 2u; voffB[i] = (unsigned)(Rb * K + C) * 2u; }
    const size_t kstep = (size_t)(BK * 2);
    const size_t hstep = (size_t)HALF * K * 2;
    const size_t tstep = 2 * hstep;
    const unsigned ldsw = (unsigned)wid * 1024u;
    const int aoff = lds_byte(wr * 64 + fr, fq * 8), boff = lds_byte(wc * 32 + fr, fq * 8);
#define PG8_SA(b, h) (((b) * 2 + (h)) * HTB)
#define PG8_SB(b, h) ((4 + (b) * 2 + (h)) * HTB)
#define PG8_STAGE(bufoff, gbase, voff) do { _Pragma("unroll") for (int _i = 0; _i < 2; ++_i) \
        __builtin_amdgcn_global_load_lds((const unsigned*)((const char*)(gbase) + (voff)[_i]), (PG8_LAS unsigned*)(lds + (bufoff) + ldsw + _i * 8192), 16, 0, 0); } while (0)
#define PG8_LDA(dst, b, h) do { _Pragma("unroll") for (int m = 0; m < 4; ++m) _Pragma("unroll") for (int k = 0; k < 2; ++k) dst[m][k] = *(const PG8_LAS bf16x8*)(lds + PG8_SA(b, h) + aoff + m * 2048 + k * 1024); } while (0)
#define PG8_LDB(dst, b, h) do { _Pragma("unroll") for (int n = 0; n < 2; ++n) _Pragma("unroll") for (int k = 0; k < 2; ++k) dst[n][k] = *(const PG8_LAS bf16x8*)(lds + PG8_SB(b, h) + boff + n * 2048 + k * 1024); } while (0)
#define PG8_MMA(ai, bj, At, Bt) do { __builtin_amdgcn_s_setprio(1); _Pragma("unroll") for (int m = 0; m < 4; ++m) _Pragma("unroll") for (int n = 0; n < 2; ++n) _Pragma("unroll") for (int k = 0; k < 2; ++k) \
        acc[ai][bj][m][n] = __builtin_amdgcn_mfma_f32_16x16x32_bf16(Bt[n][k], At[m][k], acc[ai][bj][m][n], 0, 0, 0); __builtin_amdgcn_s_setprio(0); } while (0)
#define PG8_WAIT_V(n) asm volatile("s_waitcnt vmcnt(" #n ")" ::: "memory")
#define PG8_WAIT_L(n) asm volatile("s_waitcnt lgkmcnt(" #n ")" ::: "memory")
#define PG8_BAR __builtin_amdgcn_s_barrier()
#define PG8_SCHED __builtin_amdgcn_sched_barrier(0)
    Unit cur, nxt; int ui = 0;
    if (!S.next(0, cur)) return;
    f32x4 acc[2][2][4][2];
#pragma unroll
    for (int a = 0; a < 2; ++a)
#pragma unroll
        for (int b = 0; b < 2; ++b)
#pragma unroll
            for (int m = 0; m < 4; ++m)
#pragma unroll
                for (int n = 0; n < 2; ++n) acc[a][b][m][n] = (f32x4){0.f, 0.f, 0.f, 0.f};
    bf16x8 At[4][2], B0[2][2], B1[2][2];
    const char* cA = PG8_ABASE(g, cur.pm); const char* cB = (const char*)g.Bt + (size_t)cur.pn * tstep;
    S.a_ready(cur);
    PG8_STAGE(PG8_SB(0, 0), cB, voffB); PG8_STAGE(PG8_SA(0, 0), cA, voffA); PG8_STAGE(PG8_SB(0, 1), cB + hstep, voffB); PG8_STAGE(PG8_SA(0, 1), cA + hstep, voffA);
    if (wr == 1) PG8_BAR;
    PG8_WAIT_V(4); PG8_BAR;
    PG8_STAGE(PG8_SB(1, 0), cB + kstep, voffB); PG8_STAGE(PG8_SA(1, 0), cA + kstep, voffA); PG8_STAGE(PG8_SB(1, 1), cB + hstep + kstep, voffB);
    PG8_WAIT_V(6); PG8_BAR;
    PG8_STAMP();
    for (;;) {
        const bool has_next = S.next(ui + 1, nxt);
        const char* nA = has_next ? PG8_ABASE(g, nxt.pm) : cA; const char* nB = has_next ? (const char*)g.Bt + (size_t)nxt.pn * tstep : cB;
        for (int t = 0; t < nt; t += 2) {
            const bool last = (t == nt - 2);
            const char* a1 = cA + (size_t)(t + 1) * kstep;
            const char* a2 = last ? nA : cA + (size_t)(t + 2) * kstep; const char* b2 = last ? nB : cB + (size_t)(t + 2) * kstep;
            const char* a3 = a2 + kstep; const char* b3 = b2 + kstep;
            if (last && has_next) S.a_ready(nxt);
            PG8_LDB(B0, 0, 0); PG8_SCHED; PG8_LDA(At, 0, 0); PG8_STAGE(PG8_SA(1, 1), a1 + hstep, voffA);
            PG8_WAIT_L(8); PG8_BAR; PG8_WAIT_L(0); PG8_MMA(0, 0, At, B0); PG8_BAR; PG8_SCHED;
            PG8_LDB(B1, 0, 1); PG8_STAGE(PG8_SB(0, 0), b2, voffB);
            PG8_BAR; PG8_WAIT_L(0); PG8_MMA(0, 1, At, B1); PG8_BAR;
            PG8_LDA(At, 0, 1); PG8_STAGE(PG8_SA(0, 0), a2, voffA);
            PG8_BAR; PG8_WAIT_L(0); PG8_MMA(1, 0, At, B0); PG8_BAR; PG8_SCHED;
            PG8_STAGE(PG8_SB(0, 1), b2 + hstep, voffB);
            PG8_WAIT_V(6); PG8_BAR; PG8_MMA(1, 1, At, B1); PG8_BAR;
            PG8_LDB(B0, 1, 0); PG8_SCHED; PG8_LDA(At, 1, 0); PG8_STAGE(PG8_SA(0, 1), a2 + hstep, voffA);
            PG8_WAIT_L(8); PG8_BAR; PG8_WAIT_L(0); PG8_MMA(0, 0, At, B0); PG8_BAR; PG8_SCHED;
            PG8_LDB(B1, 1, 1); PG8_STAGE(PG8_SB(1, 0), b3, voffB);
            PG8_BAR; PG8_WAIT_L(0); PG8_MMA(0, 1, At, B1); PG8_BAR;
            PG8_LDA(At, 1, 1); PG8_STAGE(PG8_SA(1, 0), a3, voffA);
            PG8_BAR; PG8_WAIT_L(0); PG8_MMA(1, 0, At, B0); PG8_BAR; PG8_SCHED;
            PG8_STAGE(PG8_SB(1, 1), b3 + hstep, voffB);
            PG8_WAIT_V(6); PG8_BAR; PG8_MMA(1, 1, At, B1); PG8_BAR;
        }
        PG8_STAMP();
        if constexpr (!Epi::AFTER_DRAIN) { E(acc, cur, wr, wc, fr, fq); S.done(cur); }
        PG8_STAMP();
        if (!has_next) break;
#pragma unroll
        for (int a = 0; a < 2; ++a)
#pragma unroll
            for (int b = 0; b < 2; ++b)
#pragma unroll
                for (int m = 0; m < 4; ++m)
#pragma unroll
                    for (int n = 0; n < 2; ++n) acc[a][b][m][n] = (f32x4){0.f, 0.f, 0.f, 0.f};
        cur = nxt; cA = nA; cB = nB; ++ui;
    }
    PG8_WAIT_V(0);
    if (wr == 0) PG8_BAR;
    PG8_BAR;
    if constexpr (Epi::AFTER_DRAIN) { E.fused(acc, cur, wr, wc, fr, fq, lds, wid, lane); S.done(cur); }
    PG8_STAMP();
    if (STAMP && wid == 0) { stamps[lane] = lane < nts ? (((unsigned long long)(unsigned)ts_hi << 32) | (unsigned)ts_lo) : 0ull;
        if (lane == 62) stamps[62] = rt_entry; if (lane == 63) stamps[63] = (unsigned long long)wall_clock64(); }
#undef PG8_STAMP
#undef PG8_SA
#undef PG8_SB
#undef PG8_STAGE
#undef PG8_LDA
#undef PG8_LDB
#undef PG8_MMA
#undef PG8_WAIT_V
#undef PG8_WAIT_L
#undef PG8_BAR
#undef PG8_SCHED
}
}
namespace pg8 {
struct EpiBfG {
    static constexpr bool PERM = true, AFTER_DRAIN = false;
    bf16_t* O; int ldc, ncols, pn_mask;
    __device__ __forceinline__ void operator()(const f32x4 (&acc)[2][2][4][2], const Unit& u, int wr, int wc, int fr, int fq) const {
        const int row0 = u.pm * BM + wr * 64 + fr, col0 = (u.pn & pn_mask) * BM + wc * 32 + 8 * fq;
#pragma unroll
        for (int ai = 0; ai < 2; ++ai)
#pragma unroll
            for (int m = 0; m < 4; ++m) { bf16_t* rowp = O + (size_t)(row0 + ai * HALF + m * 16) * ldc;
#pragma unroll
                for (int bj = 0; bj < 2; ++bj) { const int c = col0 + bj * HALF;
                    if (c < ncols) { const f32x4 v0 = acc[ai][bj][m][0], v1 = acc[ai][bj][m][1];
                        u32x4 w; w.x = cvt_pk_bf16(v0[0], v0[1]); w.y = cvt_pk_bf16(v0[2], v0[3]); w.z = cvt_pk_bf16(v1[0], v1[1]); w.w = cvt_pk_bf16(v1[2], v1[3]);
                        *(u32x4*)(rowp + c) = w; } } }
    }
};
struct EpiSwi {
    static constexpr bool PERM = true, AFTER_DRAIN = false;
    bf16_t* H;
    __device__ __forceinline__ void operator()(const f32x4 (&acc)[2][2][4][2], const Unit& u, int wr, int wc, int fr, int fq) const {
        const int row0 = u.pm * BM + wr * 64 + fr, hc0 = (u.pn & 3) * HALF + wc * 32 + 8 * fq;
#pragma unroll
        for (int ai = 0; ai < 2; ++ai)
#pragma unroll
            for (int m = 0; m < 4; ++m) { bf16_t* rowp = H + (size_t)(row0 + ai * HALF + m * 16) * 512 + hc0;
                float o[8];
#pragma unroll
                for (int n = 0; n < 2; ++n)
#pragma unroll
                    for (int r = 0; r < 4; ++r) { const float g = acc[ai][0][m][n][r]; o[n * 4 + r] = g * __builtin_amdgcn_rcpf(1.0f + __expf(-g)) * acc[ai][1][m][n][r]; }
                u32x4 w; w.x = cvt_pk_bf16(o[0], o[1]); w.y = cvt_pk_bf16(o[2], o[3]); w.z = cvt_pk_bf16(o[4], o[5]); w.w = cvt_pk_bf16(o[6], o[7]);
                *(u32x4*)rowp = w; }
    }
};
struct MoeOrder {
    const int* slotmap; int ntiles, G, c;
    __device__ __forceinline__ bool next(int i, Unit& u) const {
        const int L = i * G + c; if (L >= ntiles * 4) return false;
        u.pm = L >> 2; u.pn = __builtin_amdgcn_readfirstlane(slotmap[L >> 2]) * 4 + (L & 3); return true;
    }
    __device__ __forceinline__ void a_ready(const Unit&) const {}
    __device__ __forceinline__ void done(const Unit&) const {}
};
}
#define WSP(T, off) as_global((T*)(kp.ws + (off)))
#define KIN(i) as_global(kp.in[i])
#define KOUT as_global(kp.out)

PHASE_FN void phase_mod(const KP& kp, unsigned char* lds) {
    float* sc = (float*)lds;
    float* red = sc + 17 * 1024;
    float* modv = WSP(float, WS_MODV);
    const int tid = otid();
    for (int i = tid; i < 17 * 1024; i += 512) { const int bb = i >> 10, k = i & 1023; const float c = bb < 16 ? KIN(1)[bb * 1024 + k] : KIN(3)[k]; sc[i] = siluf_(c); }
    __syncthreads();
    const int jc = tid & 63, ks = tid >> 6;
    for (int u = obid(); u < 192; u += gridDim.x) {
        const int l = u / 96, j0 = (u % 96) * 64;
        const float* w = KIN(4) + (size_t)l * 1024 * 6144 + j0 + jc;
        float acc[17];
#pragma unroll
        for (int bb = 0; bb < 17; ++bb) acc[bb] = 0.f;
        for (int k = ks * 128; k < ks * 128 + 128; ++k) {
            const float wv = w[(size_t)k * 6144];
#pragma unroll
            for (int bb = 0; bb < 17; ++bb) acc[bb] += sc[bb * 1024 + k] * wv;
        }
#pragma unroll
        for (int bb = 0; bb < 17; ++bb) red[(ks * 17 + bb) * 64 + jc] = acc[bb];
        __syncthreads();
        for (int i = tid; i < 17 * 64; i += 512) {
            const int bb = i >> 6, j = i & 63; float s = KIN(5)[l * 6144 + j0 + j];
#pragma unroll
            for (int k2 = 0; k2 < 8; ++k2) s += red[(k2 * 17 + bb) * 64 + j];
            modv[((size_t)l * 17 + bb) * 6144 + j0 + j] = s;
        }
        __syncthreads();
    }
}

struct CvJob { const float* src; bf16_t* dst; int N, ldd, mode, kt, ntile; };
__device__ __forceinline__ bool cv_pick(int& u, CvJob& J, const float* src, int K, int N, bf16_t* dst, int mode = 0, int ldd = -1) {
    const int ntl = (N + 63) >> 6, cnt = ntl * (K >> 6);
    if (u < cnt) { J.src = src; J.dst = dst; J.N = N; J.ldd = ldd < 0 ? K : ldd; J.mode = mode; J.kt = u / ntl; J.ntile = u % ntl; return true; }
    u -= cnt; return false;
}
__device__ __forceinline__ void cv_load(const CvJob& J, int tid, f32x4 (&r)[2]) {
#pragma unroll
    for (int i = 0; i < 2; ++i) { const int idx = tid + i * 512, k = idx >> 4, n0 = J.ntile * 64 + (idx & 15) * 4;
        r[i] = (n0 < J.N) ? *(const f32x4*)(J.src + (size_t)(J.kt * 64 + k) * J.N + n0) : (f32x4){0.f, 0.f, 0.f, 0.f}; }
}
__device__ __forceinline__ void cv_put(float* tile, int tid, const f32x4 (&r)[2]) {
#pragma unroll
    for (int i = 0; i < 2; ++i) { const int idx = tid + i * 512, k = idx >> 4, nq = (idx & 15) * 4;
        tile[k * 65 + nq] = r[i][0]; tile[k * 65 + nq + 1] = r[i][1]; tile[k * 65 + nq + 2] = r[i][2]; tile[k * 65 + nq + 3] = r[i][3]; }
}
__device__ __forceinline__ void cv_store(const float* tile, const CvJob& J, int tid) {
    const int nl = tid >> 3, k8 = tid & 7, n = J.ntile * 64 + nl;
    if (n < J.N) { int row = n; if (J.mode) row = (n >> 7) * 256 + (n & 127) + (J.mode == 2 ? 128 : 0);
        u32x4 w; const float* tp = tile + (k8 * 8) * 65 + nl;
        w.x = pack2(tp[0], tp[65]); w.y = pack2(tp[130], tp[195]); w.z = pack2(tp[260], tp[325]); w.w = pack2(tp[390], tp[455]);
        *(u32x4*)(J.dst + (size_t)row * J.ldd + J.kt * 64 + k8 * 8) = w; }
}
#define CV_RUN(total, PICK) do { float* tile = (float*)lds; const int tid = otid(); const int G_ = gridDim.x; int u_ = obid(); CvJob J, Jn; f32x4 r[2]; \
        if (u_ < (total)) { int u = u_; PICK(u, J); cv_load(J, tid, r); } \
        while (u_ < (total)) { cv_put(tile, tid, r); __syncthreads(); const int un_ = u_ + G_; \
            if (un_ < (total)) { int u = un_; PICK(u, Jn); cv_load(Jn, tid, r); } \
            cv_store(tile, J, tid); __syncthreads(); u_ = un_; J = Jn; } } while (0)
PHASE_FN void phase_conv_ab(const KP& kp, unsigned char* lds) {
#define PICK_AB(u, J) do { if (!cv_pick(u, J, KIN(7), 1024, AB_N, WSP(bf16_t, WS_WMIX + WM_AB_IN))) cv_pick(u, J, KIN(8), 2048, 1024, WSP(bf16_t, WS_WMIX + WM_AB_OUT)); } while (0)
    CV_RUN(16 * 85 + 32 * 16, PICK_AB);
#undef PICK_AB
}
PHASE_FN void phase_conv_cd(const KP& kp, unsigned char* lds) {
#define PICK_CD(u, J) do { if (cv_pick(u, J, KIN(18), 1024, CD_N, WSP(bf16_t, WS_WMIX + WM_CD_IN))) break; \
        if (cv_pick(u, J, KIN(19), 1536, 1024, WSP(bf16_t, WS_WMIX + WM_CD_OUT))) break; \
        if (cv_pick(u, J, KIN(21), 384, 768, WSP(bf16_t, WS_WMIX + WM_UQ))) break; \
        if (cv_pick(u, J, KIN(23), 256, 1024, WSP(bf16_t, WS_WMIX + WM_UKV))) break; \
        cv_pick(u, J, KIN(29), 128, 1024, WSP(bf16_t, WS_WMIX + WM_G2)); } while (0)
    CV_RUN(16 * 65 + 24 * 16 + 6 * 12 + 4 * 16 + 2 * 16, PICK_CD);
#undef PICK_CD
}
PHASE_FN void phase_conv_moe(const KP& kp, unsigned char* lds, int l) {
#define PICK_MOE(u0, J) do { const int es = (u0) / 384; int uu = (u0) % 384; \
        const float* wg = es < 16 ? KIN(36) + ((size_t)l * 16 + es) * 1024 * 512 : KIN(39) + (size_t)l * 1024 * 512; \
        const float* wu = es < 16 ? KIN(37) + ((size_t)l * 16 + es) * 1024 * 512 : KIN(40) + (size_t)l * 1024 * 512; \
        const float* wd = es < 16 ? KIN(38) + ((size_t)l * 16 + es) * 512 * 1024 : KIN(41) + (size_t)l * 512 * 1024; \
        bf16_t* dup = WSP(bf16_t, WS_BIG + MO_WUP) + (size_t)es * 1024 * 1024; bf16_t* ddn = WSP(bf16_t, WS_BIG + MO_WDN) + (size_t)es * 1024 * 512; \
        if (cv_pick(uu, J, wg, 1024, 512, dup, 1, 1024)) break; if (cv_pick(uu, J, wu, 1024, 512, dup, 2, 1024)) break; cv_pick(uu, J, wd, 512, 1024, ddn, 0, 512); } while (0)
    CV_RUN(17 * 384, PICK_MOE);
#undef PICK_MOE
}

__device__ __forceinline__ const float* hrow_rd(const KP& kp, bool from_inputs, int b, int t) {
    if (t < CTXL) return (from_inputs ? KIN(2) : WSP(const float, WS_HC)) + ((size_t)b * CTXL + t) * D;
    return (from_inputs ? KIN(0) : KOUT) + ((size_t)b * SEQ + (t - CTXL)) * D;
}
__device__ __forceinline__ float* hrow_wr(const KP& kp, int b, int t) {
    if (t < CTXL) return WSP(float, WS_HC) + ((size_t)b * CTXL + t) * D;
    return KOUT + ((size_t)b * SEQ + (t - CTXL)) * D;
}

PHASE_FN void phase_u(const KP& kp, int layer, int g) {
    const int lane = otid() & 63, wid = __builtin_amdgcn_readfirstlane(otid() >> 6);
    const float* modv = WSP(const float, WS_MODV) + (size_t)layer * 17 * 6144;
    const float* ng = KIN(6) + (size_t)layer * 4 * 1024;
    bf16_t* U = WSP(bf16_t, WS_BIG + (layer == 0 ? L0_U : L1_U));
    for (int lr = obid() * 8 + wid; lr < RG; lr += gridDim.x * 8) {
        const int bl = lr / TT, t = lr - bl * TT, b = g * BG + bl;
        const float* src = hrow_rd(kp, layer == 0, b, t);
        const float* mv = modv + (size_t)(t < CTXL ? 16 : b) * 6144;
        f32x4 x[4]; float ss = 0.f;
#pragma unroll
        for (int i = 0; i < 4; ++i) { x[i] = *(const f32x4*)(src + i * 256 + lane * 4); ss += x[i][0] * x[i][0] + x[i][1] * x[i][1] + x[i][2] * x[i][2] + x[i][3] * x[i][3]; }
        ss = wsum(ss); const float rstd = rsqrtf(ss * (1.0f / 1024.0f) + EPS);
#pragma unroll
        for (int i = 0; i < 4; ++i) { const int col = i * 256 + lane * 4;
            const f32x4 gv = *(const f32x4*)(ng + col), sc = *(const f32x4*)(mv + 1024 + col), sh = *(const f32x4*)(mv + col);
            st4bf(U + (size_t)lr * 1024 + col, x[i] * rstd * gv * (sc + 1.0f) + sh); }
    }
}

PHASE_FN void phase_r(const KP& kp, unsigned char* lds, int layer, int g) {
    const int tid = otid(), lane = tid & 63, wid = __builtin_amdgcn_readfirstlane(tid >> 6);
    float* rw = (float*)lds;
    int* se = (int*)(rw + 1024 * 16);
    int* sbase = se + 160;
    for (int i = tid; i < 1024 * 16; i += 512) rw[i] = KIN(34)[i];
    __syncthreads();
    const float* modv = WSP(const float, WS_MODV) + (size_t)layer * 17 * 6144;
    const float* ng = KIN(6) + (size_t)layer * 4 * 1024;
    const bf16_t* MIX = WSP(const bf16_t, WS_BIG + (layer == 0 ? L0_U : L1_U));
    bf16_t* V = WSP(bf16_t, WS_V);
    unsigned* cnt = WSP(unsigned, CTL_CNT) + layer * 16;
    int* TOKE = WSP(int, WS_TOKE); int* TOKP = WSP(int, WS_TOKP); float* TOKW = WSP(float, WS_TOKW); int* LIST = WSP(int, WS_LIST);
    const int nrows = layer == 0 ? RG : RGL, CH = layer == 0 ? 72 : 64, RW = CH >> 3, nchunks = nrows / CH;
    float rbias[16];
#pragma unroll
    for (int e = 0; e < 16; ++e) rbias[e] = KIN(35)[e];
    for (int ch = obid(); ch < nchunks; ch += gridDim.x) {
        for (int rr = 0; rr < RW; ++rr) {
            const int rl = wid * RW + rr, lr = ch * CH + rl;
            int b, t, tok;
            if (layer == 0) { const int bl = lr / TT; t = lr - bl * TT; b = g * BG + bl; tok = g * RG + lr; }
            else { const int bl = lr >> 11; t = CTXL + (lr & 2047); b = g * BG + bl; tok = g * RGL + lr; }
            const float* hsrc = hrow_rd(kp, layer == 0, b, t);
            float* hdst = hrow_wr(kp, b, t);
            const float* mv = modv + (size_t)(t < CTXL ? 16 : b) * 6144;
            f32x4 y[4], h[4]; float ss = 0.f;
#pragma unroll
            for (int i = 0; i < 4; ++i) { y[i] = ld4bf(MIX + (size_t)lr * 1024 + i * 256 + lane * 4); ss += y[i][0] * y[i][0] + y[i][1] * y[i][1] + y[i][2] * y[i][2] + y[i][3] * y[i][3]; }
            ss = wsum(ss); float rstd = rsqrtf(ss * (1.0f / 1024.0f) + EPS);
            float s2 = 0.f;
#pragma unroll
            for (int i = 0; i < 4; ++i) { const int col = i * 256 + lane * 4;
                const f32x4 g1 = *(const f32x4*)(ng + 1024 + col), ga = *(const f32x4*)(mv + 2048 + col), hx = *(const f32x4*)(hsrc + col);
                h[i] = hx + ga * (y[i] * rstd * g1);
                *(f32x4*)(hdst + col) = h[i];
                s2 += h[i][0] * h[i][0] + h[i][1] * h[i][1] + h[i][2] * h[i][2] + h[i][3] * h[i][3]; }
            s2 = wsum(s2); rstd = rsqrtf(s2 * (1.0f / 1024.0f) + EPS);
            float lg[16];
#pragma unroll
            for (int e = 0; e < 16; ++e) lg[e] = 0.f;
#pragma unroll
            for (int i = 0; i < 4; ++i) { const int col = i * 256 + lane * 4;
                const f32x4 g2 = *(const f32x4*)(ng + 2048 + col), scf = *(const f32x4*)(mv + 4096 + col), shf = *(const f32x4*)(mv + 3072 + col);
                const f32x4 v = h[i] * rstd * g2 * (scf + 1.0f) + shf;
                st4bf(V + (size_t)tok * 1024 + col, v);
#pragma unroll
                for (int j = 0; j < 4; ++j) {
#pragma unroll
                    for (int q = 0; q < 4; ++q) { const f32x4 w4 = *(const f32x4*)(rw + (col + j) * 16 + q * 4);
                        lg[q * 4 + 0] += v[j] * w4[0]; lg[q * 4 + 1] += v[j] * w4[1]; lg[q * 4 + 2] += v[j] * w4[2]; lg[q * 4 + 3] += v[j] * w4[3]; } } }
#pragma unroll
            for (int e = 0; e < 16; ++e) lg[e] = wsum(lg[e]);
            float aff[16], sel[16];
#pragma unroll
            for (int e = 0; e < 16; ++e) { aff[e] = sigmoidf_(lg[e]); sel[e] = aff[e] + rbias[e]; }
            float gs[4];
#pragma unroll
            for (int gi = 0; gi < 4; ++gi) { const float a0 = sel[gi * 4], a1 = sel[gi * 4 + 1], a2 = sel[gi * 4 + 2], a3 = sel[gi * 4 + 3];
                gs[gi] = fmaxf(fmaxf(fmaxf(a0 + a1, a0 + a2), fmaxf(a0 + a3, a1 + a2)), fmaxf(a1 + a3, a2 + a3)); }
            int gidx = 0; float gb = gs[0];
#pragma unroll
            for (int gi = 1; gi < 4; ++gi) if (gs[gi] > gb) { gb = gs[gi]; gidx = gi; }
            float c[4], f[4];
#pragma unroll
            for (int i = 0; i < 4; ++i) { c[i] = gidx == 0 ? sel[i] : gidx == 1 ? sel[4 + i] : gidx == 2 ? sel[8 + i] : sel[12 + i];
                                           f[i] = gidx == 0 ? aff[i] : gidx == 1 ? aff[4 + i] : gidx == 2 ? aff[8 + i] : aff[12 + i]; }
            int i1 = 0; float cb = c[0];
#pragma unroll
            for (int i = 1; i < 4; ++i) if (c[i] > cb) { cb = c[i]; i1 = i; }
            int i2 = -1; float cb2 = 0.f;
#pragma unroll
            for (int i = 0; i < 4; ++i) if (i != i1 && (i2 < 0 || c[i] > cb2)) { cb2 = c[i]; i2 = i; }
            float w1 = i1 == 0 ? f[0] : i1 == 1 ? f[1] : i1 == 2 ? f[2] : f[3];
            float w2 = i2 == 0 ? f[0] : i2 == 1 ? f[1] : i2 == 2 ? f[2] : f[3];
            const float wsn = 1.0f / (w1 + w2); w1 *= wsn; w2 *= wsn;
            if (lane == 0) { se[rl * 2] = gidx * 4 + i1; se[rl * 2 + 1] = gidx * 4 + i2;
                TOKE[tok * 2] = gidx * 4 + i1; TOKE[tok * 2 + 1] = gidx * 4 + i2; TOKW[tok * 2] = w1; TOKW[tok * 2 + 1] = w2; }
        }
        __syncthreads();
        if (tid < 16) { int c2 = 0; for (int i = 0; i < 2 * CH; ++i) c2 += (se[i] == tid) ? 1 : 0; sbase[tid] = (int)atomicAdd(&cnt[tid], (unsigned)c2); }
        __syncthreads();
        if (tid < 2 * CH) { const int e = se[tid]; int rank = 0; for (int j = 0; j < tid; ++j) rank += (se[j] == e) ? 1 : 0;
            const int pos = sbase[e] + rank; const int lr = ch * CH + (tid >> 1); const int tok = (layer == 0 ? g * RG : g * RGL) + lr;
            LIST[(size_t)e * NTOK + pos] = tok; TOKP[tok * 2 + (tid & 1)] = pos; }
        __syncthreads();
    }
}

__device__ __forceinline__ int moe_tile_prefix(const unsigned* cnt, int ntok, int lane) {
    const int myt = lane < 16 ? (int)((cnt[lane & 15] + 255u) >> 8) : 0; int pref = myt;
#pragma unroll
    for (int o = 1; o < 16; o <<= 1) { const int t = __shfl_up(pref, o); if (lane >= o) pref += t; }
    return pref - myt + ntok / 256;
}
PHASE_FN void phase_moe_gather(const KP& kp, int layer) {
    const int lane = otid() & 63, wid = __builtin_amdgcn_readfirstlane(otid() >> 6);
    const int ntok = layer == 0 ? NTOK : NLAT;
    const int tpre = moe_tile_prefix(WSP(const unsigned, CTL_CNT) + layer * 16, ntok, lane);
    const bf16_t* V = WSP(const bf16_t, WS_V); bf16_t* XG = WSP(bf16_t, WS_BIG + MO_XG);
    const int* TOKE = WSP(const int, WS_TOKE); const int* TOKP = WSP(const int, WS_TOKP);
    for (int it = obid() * 8 + wid; it < 2 * ntok; it += gridDim.x * 8) {
        const int tok = it >> 1, e = TOKE[it], pos = TOKP[it];
        const size_t row = (size_t)(__shfl(tpre, e) - ntok / 256) * 256 + pos;
        const u32x4* src = (const u32x4*)(V + (size_t)tok * 1024) + lane * 2; u32x4* dst = (u32x4*)(XG + row * 1024) + lane * 2;
        const u32x4 a = src[0], b2 = src[1]; dst[0] = a; dst[1] = b2;
    }
}
PHASE_FN void phase_moe_gemm(const KP& kp, unsigned char* lds, int layer, bool down) {
    const int tid = otid();
    int* pre = (int*)(lds + pg8::STAGE_BYTES);
    int* slotmap = pre + 32;
    const int ntok = layer == 0 ? NTOK : NLAT;
    const unsigned* cnt = WSP(const unsigned, CTL_CNT) + layer * 16;
    if (tid == 0) { int p = ntok / 256; pre[0] = 0; pre[1] = p; for (int e = 0; e < 16; ++e) { p += ((int)cnt[e] + 255) >> 8; pre[2 + e] = p; } }
    __syncthreads();
    const int ntiles = pre[17];
    for (int t = tid; t < ntiles; t += 512) { int idx = 0; for (int e = 1; e < 17; ++e) if (pre[e] <= t) idx = e; slotmap[t] = idx == 0 ? 16 : idx - 1; }
    __syncthreads();
    pg8::MoeOrder S{slotmap, ntiles, (int)gridDim.x, obid()};
    if (!down) {
        pg8::Gemm g{WSP(const bf16_t, WS_V), WSP(const bf16_t, WS_BIG + MO_WUP), 0, 0, 1024, WSP(const bf16_t, WS_BIG + MO_XG), ntok / 256};
        pg8::EpiSwi E{WSP(bf16_t, WS_BIG + MO_HID)};
        pg8::gemm_phase<pg8::EpiSwi, pg8::MoeOrder, false>((PG8_LAS unsigned char*)lds, g, S, E, nullptr);
    } else {
        pg8::Gemm g{WSP(const bf16_t, WS_BIG + MO_HID), WSP(const bf16_t, WS_BIG + MO_WDN), 0, 0, 512, nullptr, 0x7fffffff};
        pg8::EpiBfG E{WSP(bf16_t, WS_BIG + MO_CON), 1024, 1024, 3};
        pg8::gemm_phase<pg8::EpiBfG, pg8::MoeOrder, false>((PG8_LAS unsigned char*)lds, g, S, E, nullptr);
    }
    __syncthreads();
}

PHASE_FN void phase_combine(const KP& kp, int layer) {
    const int lane = otid() & 63, wid = __builtin_amdgcn_readfirstlane(otid() >> 6);
    const int ntok = layer == 0 ? NTOK : NLAT;
    const unsigned* cnt = WSP(const unsigned, CTL_CNT) + layer * 16;
    const float* modv = WSP(const float, WS_MODV) + (size_t)layer * 17 * 6144;
    const float* ng = KIN(6) + (size_t)layer * 4 * 1024 + 3 * 1024;
    const bf16_t* CON = WSP(const bf16_t, WS_BIG + MO_CON);
    const int* TOKE = WSP(const int, WS_TOKE); const int* TOKP = WSP(const int, WS_TOKP); const float* TOKW = WSP(const float, WS_TOKW);
    const int tpre = moe_tile_prefix(cnt, ntok, lane);
    for (int tok0 = (obid() * 8 + wid) * 2; tok0 < ntok; tok0 += gridDim.x * 16) {
        int e1[2], e2[2], p1[2], p2[2]; float w1[2], w2[2];
#pragma unroll
        for (int u = 0; u < 2; ++u) { const int tok = tok0 + u; e1[u] = TOKE[tok * 2]; e2[u] = TOKE[tok * 2 + 1]; p1[u] = TOKP[tok * 2]; p2[u] = TOKP[tok * 2 + 1]; w1[u] = TOKW[tok * 2]; w2[u] = TOKW[tok * 2 + 1]; }
        f32x4 f[2][4], hx[2][4]; float* hp[2]; const float* mv[2];
#pragma unroll
        for (int u = 0; u < 2; ++u) { const int tok = tok0 + u;
            const size_t r1 = (size_t)__shfl(tpre, e1[u]) * 256 + p1[u], r2 = (size_t)__shfl(tpre, e2[u]) * 256 + p2[u];
            int b, t;
            if (layer == 0) { b = tok / TT; t = tok - b * TT; } else { b = tok >> 11; t = CTXL + (tok & 2047); }
            hp[u] = hrow_wr(kp, b, t); mv[u] = modv + (size_t)(t < CTXL ? 16 : b) * 6144 + 5 * 1024;
#pragma unroll
            for (int i = 0; i < 4; ++i) { const int col = i * 256 + lane * 4;
                f[u][i] = ld4bf(CON + (size_t)tok * 1024 + col) + ld4bf(CON + r1 * 1024 + col) * w1[u] + ld4bf(CON + r2 * 1024 + col) * w2[u];
                hx[u][i] = *(const f32x4*)(hp[u] + col); } }
#pragma unroll
        for (int u = 0; u < 2; ++u) { float ss = 0.f;
#pragma unroll
            for (int i = 0; i < 4; ++i) ss += f[u][i][0] * f[u][i][0] + f[u][i][1] * f[u][i][1] + f[u][i][2] * f[u][i][2] + f[u][i][3] * f[u][i][3];
            ss = wsum(ss); const float rstd = rsqrtf(ss * (1.0f / 1024.0f) + EPS);
#pragma unroll
            for (int i = 0; i < 4; ++i) { const int col = i * 256 + lane * 4;
                const f32x4 g3 = *(const f32x4*)(ng + col), gf = *(const f32x4*)(mv[u] + col);
                *(f32x4*)(hp[u] + col) = hx[u][i] + gf * (f[u][i] * rstd * g3); } }
    }
}

template <int CH>
__device__ __forceinline__ int scan_t(int dir, int ci, int j) {
    constexpr int NC_CTX = CTXL / CH;
    if (!dir) return ci * CH + j;
    return ci < NC_CTX ? (CTXL - 1 - ci * CH - j) : (TT - 1 - (ci - NC_CTX) * CH - j);
}

constexpr int ML_LQ = 136, ML_LT = 72, ML_VR = 144;
PHASE_FN void mlstm_unit(const KP& kp, unsigned char* lds, int bl, int h, int dir, int vh) {
    const int tid = otid();
    bf16_t* Qs = (bf16_t*)lds;
    bf16_t* Ks = Qs + 64 * ML_LQ;
    bf16_t* KTE = Ks + 64 * ML_LQ;
    bf16_t* VT = KTE + 128 * ML_LT;
    bf16_t* Ps = VT + ML_VR * ML_LT;
    bf16_t* Cb = Ps + 64 * ML_LT;
    float* fs = (float*)(Cb + ML_VR * ML_LQ);
    float* s_rowv = fs;
    float* s_colv = fs + 64;
    float* s_wint = fs + 128;
    float* s_emj = fs + 192;
    float* s_E = fs + 256;
    float* s_den = fs + 320;
    float* s_misc = fs + 384;
    const bf16_t* P = WSP(const bf16_t, WS_BIG + L0_P);
    bf16_t* HOUT = WSP(bf16_t, WS_BIG + (dir ? L0_HB : L0_AO)); const int ldh = dir ? 1024 : 2048;
    const float ibias = KIN(9)[dir * 4 + h], fbias = KIN(10)[dir * 4 + h];
    for (int i = tid; i < ML_VR * ML_LQ; i += 512) Cb[i] = 0;
    for (int i = tid; i < 16 * ML_LT; i += 512) VT[128 * ML_LT + i] = (i < ML_LT) ? (bf16_t)0x3f80 : (bf16_t)0;
    f32x4 Cacc[8], Nacc;
#pragma unroll
    for (int i = 0; i < 8; ++i) Cacc[i] = (f32x4){0.f, 0.f, 0.f, 0.f};
    Nacc = (f32x4){0.f, 0.f, 0.f, 0.f};
    float m_state = 0.f;
    u32x4 pq[2], pk[2], pv[2]; bf16_t pgi = 0, pgf = 0;
#define ML_REQ(ci_) do { _Pragma("unroll") for (int i = 0; i < 2; ++i) { const int p = tid + i * 512, j = p >> 4, c8 = p & 15; \
            const bf16_t* pr = P + ((size_t)bl * TT + scan_t<64>(dir, (ci_), j)) * AB_N; \
            pq[i] = *(const u32x4*)(pr + AB_Q + h * 128 + c8 * 8); pk[i] = *(const u32x4*)(pr + AB_K + h * 128 + c8 * 8); \
            const int jv = tid & 63, cv = (tid >> 6) + i * 8; \
            pv[i] = *(const u32x4*)(P + ((size_t)bl * TT + scan_t<64>(dir, (ci_), jv)) * AB_N + AB_V + h * 256 + vh * 128 + cv * 8); } \
        if (tid < 64) { const bf16_t* pg = P + ((size_t)bl * TT + scan_t<64>(dir, (ci_), tid)) * AB_N; pgi = pg[AB_IG + dir * 4 + h]; pgf = pg[AB_FG + dir * 4 + h]; } } while (0)
    ML_REQ(0);
    lds_barrier();
    for (int ci = 0; ci < TT / 64; ++ci) {
        int tq = tid; asm volatile("" : "+v"(tq));
        const int lane = tq & 63, wid = __builtin_amdgcn_readfirstlane(tq >> 6), fr = lane & 15, fq = lane >> 4;
#pragma unroll
        for (int i = 0; i < 2; ++i) {
            const int p = tq + i * 512, j = p >> 4, c8 = p & 15;
            u32x4 q = pq[i];
            const float qs = 0.08838834764831845f;
            q.x = pack2(lo2f(q.x) * qs, hi2f(q.x) * qs); q.y = pack2(lo2f(q.y) * qs, hi2f(q.y) * qs);
            q.z = pack2(lo2f(q.z) * qs, hi2f(q.z) * qs); q.w = pack2(lo2f(q.w) * qs, hi2f(q.w) * qs);
            *(u32x4*)(Qs + j * ML_LQ + c8 * 8) = q;
            *(u32x4*)(Ks + j * ML_LQ + c8 * 8) = pk[i];
            const u32x4 v = pv[i];
            bf16_t* vt = VT + (((tq >> 6) + i * 8) * 8) * ML_LT + (tq & 63);
            vt[0 * ML_LT] = (bf16_t)(v.x & 0xffff); vt[1 * ML_LT] = (bf16_t)(v.x >> 16); vt[2 * ML_LT] = (bf16_t)(v.y & 0xffff); vt[3 * ML_LT] = (bf16_t)(v.y >> 16);
            vt[4 * ML_LT] = (bf16_t)(v.z & 0xffff); vt[5 * ML_LT] = (bf16_t)(v.z >> 16); vt[6 * ML_LT] = (bf16_t)(v.w & 0xffff); vt[7 * ML_LT] = (bf16_t)(v.w >> 16);
        }
        if (wid == 0) {
            const float ig = bf2f(pgi) + ibias;
            const float lf = logsigmoidf_(bf2f(pgf) + fbias);
            float b = lf;
#pragma unroll
            for (int o = 1; o < 64; o <<= 1) { const float t = __shfl_up(b, o); if (lane >= o) b += t; }
            const float u = ig - b; float pm = u;
#pragma unroll
            for (int o = 1; o < 64; o <<= 1) { const float t = __shfl_up(pm, o); if (lane >= o) pm = fmaxf(pm, t); }
            const float mj = fmaxf(b + m_state, b + pm);
            const float b63 = __shfl(b, 63), pm63 = __shfl(pm, 63);
            const float mnew = fmaxf(b63 + m_state, b63 + pm63);
            s_rowv[lane] = b - mj; s_colv[lane] = u; s_wint[lane] = __expf(b + m_state - mj); s_emj[lane] = __expf(-mj);
            s_E[lane] = __expf(b63 + u - mnew);
            if (lane == 0) { s_misc[0] = mnew; s_misc[1] = __expf(b63 + m_state - mnew); }
        }
        if (ci + 1 < TT / 64) ML_REQ(ci + 1);
        lds_barrier();
        {
            const int jt = wid >> 1;
#pragma unroll
            for (int q2 = 0; q2 < 2; ++q2) {
                const int st = (wid & 1) * 2 + q2;
                f32x4 acc = (f32x4){0.f, 0.f, 0.f, 0.f};
                if (st <= jt) {
                    bf16x8 fa[4], fb[4];
#pragma unroll
                    for (int k = 0; k < 4; ++k) { fa[k] = ldfrag(Qs, ML_LQ, jt * 16, k * 32, fr, fq); fb[k] = ldfrag(Ks, ML_LQ, st * 16, k * 32, fr, fq); }
                    __builtin_amdgcn_sched_barrier(0);
                    f32x4 acc2 = (f32x4){0.f, 0.f, 0.f, 0.f};
                    acc = mma16(fa[0], fb[0], acc); acc2 = mma16(fa[1], fb[1], acc2); acc = mma16(fa[2], fb[2], acc); acc2 = mma16(fa[3], fb[3], acc2);
                    acc = acc + acc2;
                }
                const int s = st * 16 + fr; const float cv = s_colv[s];
#pragma unroll
                for (int r = 0; r < 4; ++r) { const int j = jt * 16 + fq * 4 + r;
                    const float pv2 = (s <= j) ? acc[r] * __expf(s_rowv[j] + cv) : 0.f;
                    Ps[j * ML_LT + s] = f2bf(pv2); }
            }
#pragma unroll
            for (int i = 0; i < 2; ++i) {
                const int s = lane, c8 = wid + i * 8; const float e = s_E[s];
                const u32x4 kv = *(const u32x4*)(Ks + s * ML_LQ + c8 * 8);
                bf16_t* kt = KTE + (c8 * 8) * ML_LT + s;
                kt[0 * ML_LT] = f2bf(lo2f(kv.x) * e); kt[1 * ML_LT] = f2bf(hi2f(kv.x) * e); kt[2 * ML_LT] = f2bf(lo2f(kv.y) * e); kt[3 * ML_LT] = f2bf(hi2f(kv.y) * e);
                kt[4 * ML_LT] = f2bf(lo2f(kv.z) * e); kt[5 * ML_LT] = f2bf(hi2f(kv.z) * e); kt[6 * ML_LT] = f2bf(lo2f(kv.w) * e); kt[7 * ML_LT] = f2bf(hi2f(kv.w) * e);
            }
        }
        lds_barrier();
        f32x4 a1[4], a2[4];
        {
            const int jt = wid >> 1;
            bf16x8 fp[2], fqq[4];
#pragma unroll
            for (int k = 0; k < 2; ++k) fp[k] = ldfrag(Ps, ML_LT, jt * 16, k * 32, fr, fq);
#pragma unroll
            for (int k = 0; k < 4; ++k) fqq[k] = ldfrag(Qs, ML_LQ, jt * 16, k * 32, fr, fq);
            {
                bf16x8 fv[4][2];
#pragma unroll
                for (int q4 = 0; q4 < 4; ++q4)
#pragma unroll
                    for (int k = 0; k < 2; ++k) fv[q4][k] = ldfrag(VT, ML_LT, ((wid & 1) * 4 + q4) * 16, k * 32, fr, fq);
                __builtin_amdgcn_sched_barrier(0);
#pragma unroll
                for (int q4 = 0; q4 < 4; ++q4) a1[q4] = (f32x4){0.f, 0.f, 0.f, 0.f};
#pragma unroll
                for (int k = 0; k < 2; ++k)
#pragma unroll
                    for (int q4 = 0; q4 < 4; ++q4) a1[q4] = mma16(fv[q4][k], fp[k], a1[q4]);
            }
#pragma unroll
            for (int hh = 0; hh < 2; ++hh) {
                bf16x8 fc[2][4];
#pragma unroll
                for (int q2 = 0; q2 < 2; ++q2)
#pragma unroll
                    for (int k = 0; k < 4; ++k) fc[q2][k] = ldfrag(Cb, ML_LQ, ((wid & 1) * 4 + hh * 2 + q2) * 16, k * 32, fr, fq);
                __builtin_amdgcn_sched_barrier(0);
                a2[hh * 2] = (f32x4){0.f, 0.f, 0.f, 0.f}; a2[hh * 2 + 1] = (f32x4){0.f, 0.f, 0.f, 0.f};
#pragma unroll
                for (int k = 0; k < 4; ++k) { a2[hh * 2] = mma16(fc[0][k], fqq[k], a2[hh * 2]); a2[hh * 2 + 1] = mma16(fc[1][k], fqq[k], a2[hh * 2 + 1]); }
            }
            if (wid & 1) {
                f32x4 d1 = (f32x4){0.f, 0.f, 0.f, 0.f}, d2 = (f32x4){0.f, 0.f, 0.f, 0.f};
                bf16x8 fo[2], fn[4];
#pragma unroll
                for (int k = 0; k < 2; ++k) fo[k] = ldfrag(VT, ML_LT, 128, k * 32, fr, fq);
#pragma unroll
                for (int k = 0; k < 4; ++k) fn[k] = ldfrag(Cb, ML_LQ, 128, k * 32, fr, fq);
                __builtin_amdgcn_sched_barrier(0);
                d1 = mma16(fo[0], fp[0], d1); d2 = mma16(fn[0], fqq[0], d2); d1 = mma16(fo[1], fp[1], d1); d2 = mma16(fn[1], fqq[1], d2);
                d2 = mma16(fn[2], fqq[2], d2); d2 = mma16(fn[3], fqq[3], d2);
                if (fq == 0) { const int j = jt * 16 + fr; s_den[j] = fmaxf(fabsf(d1[0] + s_wint[j] * d2[0]), s_emj[j]); }
            }
        }
        lds_barrier();
        {
            const int jt = wid >> 1, j = jt * 16 + fr;
            const float wi = s_wint[j], rden = frcp_(s_den[j]);
            const size_t row = (size_t)bl * TT + scan_t<64>(dir, ci, j);
#pragma unroll
            for (int q4 = 0; q4 < 4; ++q4) { const int v0 = ((wid & 1) * 4 + q4) * 16 + fq * 4;
                st4bf(HOUT + row * ldh + h * 256 + vh * 128 + v0, (a1[q4] + a2[q4] * wi) * rden); }
        }
        {
            const float dec = s_misc[1];
            const bf16x8 bv0 = ldfrag(VT, ML_LT, wid * 16, 0, fr, fq), bv1 = ldfrag(VT, ML_LT, wid * 16, 32, fr, fq);
#pragma unroll
            for (int hh = 0; hh < 2; ++hh) {
                bf16x8 fk[4][2];
#pragma unroll
                for (int q = 0; q < 4; ++q) { fk[q][0] = ldfrag(KTE, ML_LT, (hh * 4 + q) * 16, 0, fr, fq); fk[q][1] = ldfrag(KTE, ML_LT, (hh * 4 + q) * 16, 32, fr, fq); }
                __builtin_amdgcn_sched_barrier(0);
#pragma unroll
                for (int q = 0; q < 4; ++q) Cacc[hh * 4 + q] = Cacc[hh * 4 + q] * dec;
#pragma unroll
                for (int q = 0; q < 4; ++q) Cacc[hh * 4 + q] = mma16(fk[q][0], bv0, Cacc[hh * 4 + q]);
#pragma unroll
                for (int q = 0; q < 4; ++q) Cacc[hh * 4 + q] = mma16(fk[q][1], bv1, Cacc[hh * 4 + q]);
#pragma unroll
                for (int q = 0; q < 4; ++q) st4bf(Cb + (wid * 16 + fr) * ML_LQ + (hh * 4 + q) * 16 + fq * 4, Cacc[hh * 4 + q]);
            }
            Nacc = Nacc * dec;
            Nacc = mma16(ldfrag(KTE, ML_LT, wid * 16, 0, fr, fq), ldfrag(VT, ML_LT, 128, 0, fr, fq), Nacc);
            Nacc = mma16(ldfrag(KTE, ML_LT, wid * 16, 32, fr, fq), ldfrag(VT, ML_LT, 128, 32, fr, fq), Nacc);
            st4bf(Cb + (128 + fr) * ML_LQ + wid * 16 + fq * 4, Nacc);
            m_state = s_misc[0];
        }
        lds_barrier();
    }
#undef ML_REQ
}

constexpr size_t L0_XC = L0_U;
static_assert(L0_XC + (size_t)RG * 1280 * 2 <= BIG_BYTES, "xconv buffer");
PHASE_FN void phase_xconv(const KP& kp) {
    const int lane = otid() & 63, wid = __builtin_amdgcn_readfirstlane(otid() >> 6);
    const bf16_t* P = WSP(const bf16_t, WS_BIG + L0_P); bf16_t* XC = WSP(bf16_t, WS_BIG + L0_XC);
    const float* cw = KIN(12); const float* cb = KIN(13);
    for (int lr = obid() * 8 + wid; lr < RG; lr += gridDim.x * 8) {
        const int bl = lr / TT, t = lr - bl * TT, lo = t < CTXL ? 0 : CTXL, hi = t < CTXL ? CTXL : TT;
#pragma unroll
        for (int i = 0; i < 5; ++i) { const int col = i * 256 + lane * 4;
            f32x4 a = *(const f32x4*)(cb + col);
#pragma unroll
            for (int q = 0; q < 5; ++q) { const int tt = t - 2 + q;
                if (tt >= lo && tt < hi) a += *(const f32x4*)(cw + q * 1280 + col) * ld4bf(P + ((size_t)bl * TT + tt) * AB_N + AB_XBC + col); }
            f32x4 o;
#pragma unroll
            for (int r = 0; r < 4; ++r) o[r] = siluf_(a[r]);
            st4bf(XC + (size_t)lr * 1280 + col, o); }
    }
}

constexpr int SS_LT = 72, SS_LX = 136;
PHASE_FN void ssd_unit(const KP& kp, unsigned char* lds, int bl, int dir, int hp) {
    const int tid = otid();
    const int gi = hp >> 2, hh0 = hp * 2;
    bf16_t* Wm = (bf16_t*)lds;
    bf16_t* CM = Wm + 2 * 64 * SS_LT;
    bf16_t* BM = CM + 64 * SS_LT;
    bf16_t* Xn = BM + 64 * SS_LT;
    bf16_t* XT = Xn + 64 * SS_LX;
    bf16_t* BTE = XT + 2 * 64 * SS_LT;
    bf16_t* Sb = BTE + 2 * 64 * SS_LT;
    float* fs = (float*)(Sb + 2 * 64 * SS_LT);
    float* s_b = fs;
    float* s_dt = fs + 128;
    float* s_e = fs + 256;
    float* s_misc = fs + 384;
    const bf16_t* P = WSP(const bf16_t, WS_BIG + L0_P); const bf16_t* XC = WSP(const bf16_t, WS_BIG + L0_XC);
    bf16_t* YOUT = WSP(bf16_t, WS_BIG + (dir ? L0_YB : L0_AO + 2048)); const int ldy = dir ? 1024 : 2048;
    for (int i = tid; i < 2 * 64 * SS_LT; i += 512) Sb[i] = 0;
    f32x4 Sacc[4];
#pragma unroll
    for (int i = 0; i < 4; ++i) Sacc[i] = (f32x4){0.f, 0.f, 0.f, 0.f};
    const float dtb = KIN(14)[dir * 16 + hh0 + ((tid >> 6) & 1)], aexp = __expf(KIN(15)[dir * 16 + hh0 + ((tid >> 6) & 1)]);
    const float dskip = KIN(16)[hh0 + (tid >> 8)];
    u32x4 pr[4]; bf16_t pdt = 0;
#define SS_REQ(ci_) do { _Pragma("unroll") for (int q = 0; q < 4; ++q) { const int p = tid + q * 512, j = p >> 5, c8 = p & 31; \
            const int col = c8 < 16 ? hh0 * 64 + c8 * 8 : (c8 < 24 ? 1024 + gi * 64 + (c8 - 16) * 8 : 1152 + gi * 64 + (c8 - 24) * 8); \
            pr[q] = *(const u32x4*)(XC + ((size_t)bl * TT + scan_t<64>(dir, (ci_), j)) * 1280 + col); } \
        if (tid < 128) pdt = P[((size_t)bl * TT + scan_t<64>(dir, (ci_), tid & 63)) * AB_N + AB_DT + dir * 16 + hh0 + (tid >> 6)]; } while (0)
    SS_REQ(0);
    lds_barrier();
    for (int ci = 0; ci < TT / 64; ++ci) {
        int tq = tid; asm volatile("" : "+v"(tq));
        const int lane = tq & 63, wid = __builtin_amdgcn_readfirstlane(tq >> 6), fr = lane & 15, fq = lane >> 4, hl_w = wid >> 2;
#pragma unroll
        for (int q = 0; q < 4; ++q) { const int p = tq + q * 512, j = p >> 5, c8 = p & 31;
            bf16_t* dst = c8 < 16 ? Xn + j * SS_LX + c8 * 8 : (c8 < 24 ? BM + j * SS_LT + (c8 - 16) * 8 : CM + j * SS_LT + (c8 - 24) * 8);
            *(u32x4*)dst = pr[q]; }
        if (wid < 2) {
            const float dt = softplusf_(bf2f(pdt) + dtb);
            float b = -dt * aexp;
#pragma unroll
            for (int o = 1; o < 64; o <<= 1) { const float t = __shfl_up(b, o); if (lane >= o) b += t; }
            const float b63 = __shfl(b, 63);
            s_b[wid * 64 + lane] = b; s_dt[wid * 64 + lane] = dt; s_e[wid * 64 + lane] = __expf(b63 - b) * dt;
            if (lane == 0) s_misc[wid] = __expf(b63);
        }
        if (ci + 1 < TT / 64) SS_REQ(ci + 1);
        lds_barrier();
        {
            const int jt = wid >> 1;
#pragma unroll
            for (int q2 = 0; q2 < 2; ++q2) {
                const int st = (wid & 1) * 2 + q2;
                f32x4 acc = (f32x4){0.f, 0.f, 0.f, 0.f};
                if (st <= jt) {
                    const bf16x8 c0 = ldfrag(CM, SS_LT, jt * 16, 0, fr, fq), c1 = ldfrag(CM, SS_LT, jt * 16, 32, fr, fq), b0 = ldfrag(BM, SS_LT, st * 16, 0, fr, fq), b1 = ldfrag(BM, SS_LT, st * 16, 32, fr, fq);
                    __builtin_amdgcn_sched_barrier(0);
                    acc = mma16(c0, b0, acc); acc = mma16(c1, b1, acc);
                }
                const int s = st * 16 + fr;
#pragma unroll
                for (int hl = 0; hl < 2; ++hl) { const float bs = s_b[hl * 64 + s], ds = s_dt[hl * 64 + s];
#pragma unroll
                    for (int r = 0; r < 4; ++r) { const int j = jt * 16 + fq * 4 + r;
                        const float wv = (s <= j) ? acc[r] * __expf(s_b[hl * 64 + j] - bs) * ds : 0.f;
                        Wm[(hl * 64 + j) * SS_LT + s] = f2bf(wv); } }
            }
            {
                const int s = lane, n8 = wid;
                const u32x4 bv = *(const u32x4*)(BM + s * SS_LT + n8 * 8);
#pragma unroll
                for (int hl = 0; hl < 2; ++hl) { const float e = s_e[hl * 64 + s];
                    bf16_t* bt = BTE + (hl * 64 + n8 * 8) * SS_LT + s;
                    bt[0 * SS_LT] = f2bf(lo2f(bv.x) * e); bt[1 * SS_LT] = f2bf(hi2f(bv.x) * e); bt[2 * SS_LT] = f2bf(lo2f(bv.y) * e); bt[3 * SS_LT] = f2bf(hi2f(bv.y) * e);
                    bt[4 * SS_LT] = f2bf(lo2f(bv.z) * e); bt[5 * SS_LT] = f2bf(hi2f(bv.z) * e); bt[6 * SS_LT] = f2bf(lo2f(bv.w) * e); bt[7 * SS_LT] = f2bf(hi2f(bv.w) * e); }
#pragma unroll
                for (int i = 0; i < 2; ++i) { const int c8 = wid + i * 8;
                    const u32x4 xv = *(const u32x4*)(Xn + s * SS_LX + c8 * 8);
                    bf16_t* xt = XT + (c8 * 8) * SS_LT + s;
                    xt[0 * SS_LT] = (bf16_t)(xv.x & 0xffff); xt[1 * SS_LT] = (bf16_t)(xv.x >> 16); xt[2 * SS_LT] = (bf16_t)(xv.y & 0xffff); xt[3 * SS_LT] = (bf16_t)(xv.y >> 16);
                    xt[4 * SS_LT] = (bf16_t)(xv.z & 0xffff); xt[5 * SS_LT] = (bf16_t)(xv.z >> 16); xt[6 * SS_LT] = (bf16_t)(xv.w & 0xffff); xt[7 * SS_LT] = (bf16_t)(xv.w >> 16); }
            }
        }
        lds_barrier();
        {
            const int hl = hl_w, jt = wid & 3, j = jt * 16 + fr;
            const bf16_t* Wh = Wm + hl * 64 * SS_LT; const bf16_t* Xh = XT + hl * 64 * SS_LT; const bf16_t* Sh = Sb + hl * 64 * SS_LT;
            const float eb = __expf(s_b[hl * 64 + j]);
            const size_t row = (size_t)bl * TT + scan_t<64>(dir, ci, j);
            const bf16x8 w0 = ldfrag(Wh, SS_LT, jt * 16, 0, fr, fq), w1 = ldfrag(Wh, SS_LT, jt * 16, 32, fr, fq), m0 = ldfrag(CM, SS_LT, jt * 16, 0, fr, fq), m1 = ldfrag(CM, SS_LT, jt * 16, 32, fr, fq);
#pragma unroll
            for (int hh = 0; hh < 2; ++hh) {
                bf16x8 fx[2][2], fs2[2][2];
#pragma unroll
                for (int q = 0; q < 2; ++q)
#pragma unroll
                    for (int k = 0; k < 2; ++k) { fx[q][k] = ldfrag(Xh, SS_LT, (hh * 2 + q) * 16, k * 32, fr, fq); fs2[q][k] = ldfrag(Sh, SS_LT, (hh * 2 + q) * 16, k * 32, fr, fq); }
                f32x4 dx[2];
                if (!dir) { dx[0] = ld4bf(Xn + j * SS_LX + hl * 64 + (hh * 2) * 16 + fq * 4); dx[1] = ld4bf(Xn + j * SS_LX + hl * 64 + (hh * 2 + 1) * 16 + fq * 4); }
                __builtin_amdgcn_sched_barrier(0);
                f32x4 y1[2], y2[2];
#pragma unroll
                for (int q = 0; q < 2; ++q) { y1[q] = (f32x4){0.f, 0.f, 0.f, 0.f}; y2[q] = (f32x4){0.f, 0.f, 0.f, 0.f}; }
#pragma unroll
                for (int q = 0; q < 2; ++q) { y1[q] = mma16(fx[q][0], w0, y1[q]); y2[q] = mma16(fs2[q][0], m0, y2[q]); }
#pragma unroll
                for (int q = 0; q < 2; ++q) { y1[q] = mma16(fx[q][1], w1, y1[q]); y2[q] = mma16(fs2[q][1], m1, y2[q]); }
#pragma unroll
                for (int q = 0; q < 2; ++q) { f32x4 y = y1[q] + y2[q] * eb;
                    if (!dir) y = y + dx[q] * dskip;
                    st4bf(YOUT + row * ldy + (hh0 + hl) * 64 + (hh * 2 + q) * 16 + fq * 4, y); }
            }
        }
        lds_barrier();
        {
            const int hl = hl_w, pt = wid & 3; const float eb63 = s_misc[hl];
            const bf16_t* Xh = XT + hl * 64 * SS_LT; const bf16_t* Bh = BTE + hl * 64 * SS_LT; bf16_t* Sh = Sb + hl * 64 * SS_LT;
            const bf16x8 x0 = ldfrag(Xh, SS_LT, pt * 16, 0, fr, fq), x1 = ldfrag(Xh, SS_LT, pt * 16, 32, fr, fq);
            bf16x8 fb[4][2];
#pragma unroll
            for (int nt = 0; nt < 4; ++nt) { fb[nt][0] = ldfrag(Bh, SS_LT, nt * 16, 0, fr, fq); fb[nt][1] = ldfrag(Bh, SS_LT, nt * 16, 32, fr, fq); }
            __builtin_amdgcn_sched_barrier(0);
#pragma unroll
            for (int nt = 0; nt < 4; ++nt) Sacc[nt] = Sacc[nt] * eb63;
#pragma unroll
            for (int nt = 0; nt < 4; ++nt) Sacc[nt] = mma16(fb[nt][0], x0, Sacc[nt]);
#pragma unroll
            for (int nt = 0; nt < 4; ++nt) Sacc[nt] = mma16(fb[nt][1], x1, Sacc[nt]);
#pragma unroll
            for (int nt = 0; nt < 4; ++nt) st4bf(Sh + (pt * 16 + fr) * SS_LT + nt * 16 + fq * 4, Sacc[nt]);
        }
        lds_barrier();
    }
#undef SS_REQ
}

__device__ __forceinline__ void phase_scan_ab(const KP& kp, unsigned char* lds) {
    for (int rep = 0; rep < ((PROBE_DUP & 8192) ? 2 : 1); ++rep)
    for (int u = obid(); u < 256; u += gridDim.x) if (u < 128) { mlstm_unit(kp, lds, u >> 4, (u >> 2) & 3, (u >> 1) & 1, u & 1); __syncthreads(); }
    for (int rep = 0; rep < ((PROBE_DUP & 16384) ? 2 : 1); ++rep)
    for (int u = obid(); u < 256; u += gridDim.x) if (u >= 128) { const int v = u - 128; ssd_unit(kp, lds, v >> 4, (v >> 3) & 1, v & 7); __syncthreads(); }
}

PHASE_FN void phase_fin_ab(const KP& kp) {
    const int lane = otid() & 63, wid = __builtin_amdgcn_readfirstlane(otid() >> 6);
    const bf16_t* P = WSP(const bf16_t, WS_BIG + L0_P);
    bf16_t* AO = WSP(bf16_t, WS_BIG + L0_AO); const bf16_t* HB = WSP(const bf16_t, WS_BIG + L0_HB); const bf16_t* YB = WSP(const bf16_t, WS_BIG + L0_YB);
    const float* mln = KIN(11); const float* sn = KIN(17);
    for (int lr = obid() * 8 + wid; lr < RG; lr += gridDim.x * 8) {
        const bf16_t* pr = P + (size_t)lr * AB_N;
        f32x4 yz[4]; float ss2 = 0.f;
#pragma unroll
        for (int i = 0; i < 4; ++i) { const int col = i * 256 + lane * 4;
            const f32x4 hs = ld4bf(AO + (size_t)lr * 2048 + col) + ld4bf(HB + (size_t)lr * 1024 + col);
            float ss = hs[0] * hs[0] + hs[1] * hs[1] + hs[2] * hs[2] + hs[3] * hs[3];
            ss = wsum(ss); const float rstd = rsqrtf(ss * (1.0f / 256.0f) + EPS);
            const f32x4 og = ld4bf(pr + AB_OG + col), w = *(const f32x4*)(mln + col);
            f32x4 o;
#pragma unroll
            for (int r = 0; r < 4; ++r) o[r] = hs[r] * rstd * w[r] * sigmoidf_(og[r]);
            st4bf(AO + (size_t)lr * 2048 + col, o);
            const f32x4 ys = ld4bf(AO + (size_t)lr * 2048 + 1024 + col) + ld4bf(YB + (size_t)lr * 1024 + col), z = ld4bf(pr + AB_Z + col);
#pragma unroll
            for (int r = 0; r < 4; ++r) { yz[i][r] = ys[r] * siluf_(z[r]); ss2 += yz[i][r] * yz[i][r]; }
        }
        ss2 = wsum(ss2); const float rstd2 = rsqrtf(ss2 * (1.0f / 1024.0f) + EPS);
#pragma unroll
        for (int i = 0; i < 4; ++i) { const int col = i * 256 + lane * 4; st4bf(AO + (size_t)lr * 2048 + 1024 + col, yz[i] * rstd2 * *(const f32x4*)(sn + col)); }
    }
}

PHASE_FN void phase_gemm_in(const KP& kp, unsigned char* lds, int layer) {
    const int npad = layer == 0 ? AB_NPAD : CD_NPAD, n = layer == 0 ? AB_N : CD_N;
    pg8::Gemm g{WSP(const bf16_t, WS_BIG + (layer == 0 ? L0_U : L1_U)), WSP(const bf16_t, WS_WMIX), RG, npad, 1024, nullptr, 0x7fffffff};
    pg8::StaticOrder S; S.init(RG, npad, (int)gridDim.x, obid());
    pg8::EpiBfG E{WSP(bf16_t, WS_BIG), n, n, 0x7fffffff};
    pg8::gemm_phase<pg8::EpiBfG, pg8::StaticOrder, false>((PG8_LAS unsigned char*)lds, g, S, E, nullptr);
    __syncthreads();
}
PHASE_FN void phase_gemm_out_ab(const KP& kp, unsigned char* lds) {
    pg8::Gemm g{WSP(const bf16_t, WS_BIG + L0_AO), WSP(const bf16_t, WS_WMIX + WM_AB_OUT), RG, 1024, 2048, nullptr, 0x7fffffff};
    pg8::StaticOrder S; S.init(RG, 1024, (int)gridDim.x, obid());
    pg8::EpiBfG E{WSP(bf16_t, WS_BIG + L0_U), 1024, 1024, 0x7fffffff};
    pg8::gemm_phase<pg8::EpiBfG, pg8::StaticOrder, false>((PG8_LAS unsigned char*)lds, g, S, E, nullptr);
    __syncthreads();
}

PHASE_FN void phase_prep_cd(const KP& kp) {
    const int lane = otid() & 63, wid = __builtin_amdgcn_readfirstlane(otid() >> 6);
    bf16_t* P = WSP(bf16_t, WS_BIG + L1_P);
    bf16_t* SG = WSP(bf16_t, WS_SG);
    const float* qn = KIN(20); const float* kvn = KIN(22); const float* mu = KIN(24);
    for (int lr = obid() * 8 + wid; lr < RG; lr += gridDim.x * 8) {
        const int bl = lr / TT, t = lr - bl * TT;
        bf16_t* pr = P + (size_t)lr * CD_N;
        {
            const f32x4 x = ld4bf(pr + CD_M1 + lane * 4);
            float ss = x[0] * x[0] + x[1] * x[1] + x[2] * x[2] + x[3] * x[3]; ss = wsum(ss);
            const float rstd = rsqrtf(ss * (1.0f / 256.0f) + EPS);
            st4bf(pr + CD_M1 + lane * 4, x * rstd * *(const f32x4*)(kvn + lane * 4));
        }
        {
            const int lo = t < CTXL ? 0 : CTXL, hi = t < CTXL ? CTXL : TT, c = lane * 4;
            const f32x4 x = ld4bf(pr + CD_WL + c);
            const f32x4 xp = t > lo ? ld4bf(pr - CD_N + CD_WL + c) : (f32x4){0.f, 0.f, 0.f, 0.f};
            const f32x4 xn = t < hi - 1 ? ld4bf(pr + CD_N + CD_WL + c) : (f32x4){0.f, 0.f, 0.f, 0.f};
            f32x4 l = x + *(const f32x4*)(mu + CD_WL - CD_RW0 + c) * ((xp + xn) * 0.5f - x);
            if (c < 128) {
#pragma unroll
                for (int q = 0; q < 4; ++q) l[q] = tanhf_(l[q]); }
            st4bf(WSP(bf16_t, WS_BIG + L1_TWAL) + (size_t)lr * 256 + c, l);
        }
        if (t >= CTXL) {
            const int s = t - CTXL;
            float x0[3], x1[3]; float ss = 0.f;
#pragma unroll
            for (int i = 0; i < 3; ++i) { const unsigned w = *(const unsigned*)(pr + CD_M0 + i * 128 + lane * 2); x0[i] = lo2f(w); x1[i] = hi2f(w); ss += x0[i] * x0[i] + x1[i] * x1[i]; }
            ss = wsum(ss); const float rstd = rsqrtf(ss * (1.0f / 384.0f) + EPS);
#pragma unroll
            for (int i = 0; i < 3; ++i) { const int c = i * 128 + lane * 2; *(unsigned*)(pr + CD_M0 + c) = pack2(x0[i] * rstd * qn[c], x1[i] * rstd * qn[c + 1]); }
            if (lane < 16) {
                const float pos = (lane < 8) ? (float)(s >> 6) : (float)(s & 63);
                const float inv = __expf(-(float)(lane & 7) * (9.210340371976184f / 8.0f));
                float sn, cs; sincosf(pos * inv, &sn, &cs);
                const float a = bf2f(pr[CD_KR + lane]), b2 = bf2f(pr[CD_KR + 16 + lane]);
                pr[CD_KR + lane] = f2bf(a * cs - b2 * sn); pr[CD_KR + 16 + lane] = f2bf(a * sn + b2 * cs);
            }
            {
                const int c = lane * 2;
                const unsigned w = *(const unsigned*)(pr + CD_GL + c);
                const unsigned wp = s > 0 ? *(const unsigned*)(pr - CD_N + CD_GL + c) : 0u;
                const unsigned wn = s < SEQ - 1 ? *(const unsigned*)(pr + CD_N + CD_GL + c) : 0u;
                const float m0 = mu[CD_GL - CD_RW0 + c], m1 = mu[CD_GL - CD_RW0 + c + 1];
                const float g0 = lo2f(w) + m0 * (0.5f * (lo2f(wp) + lo2f(wn)) - lo2f(w));
                const float g1 = hi2f(w) + m1 * (0.5f * (hi2f(wp) + hi2f(wn)) - hi2f(w));
                *(unsigned*)(SG + ((size_t)bl * SEQ + s) * 128 + c) = pack2(sigmoidf_(g0), sigmoidf_(g1));
            }
        }
    }
}

PHASE_FN void phase_upproj(const KP& kp, unsigned char* lds) {
    const bf16_t* P = WSP(const bf16_t, WS_BIG + L1_P);
    const int nq = (RGL / 256) * 6, nkv = (RG / 256) * 8;
    for (int u = obid(); u < nq + nkv; u += gridDim.x) {
        if (u < nq) {
            GA ga{P + CD_M0, nullptr, CD_N, 0, 384, nullptr, RGL, 1, 0};
            EpiBf ep{WSP(bf16_t, WS_BIG + L1_Q), 768, RGL, 768};
            gemm_tile(lds, ga, WSP(const bf16_t, WS_WMIX + WM_UQ), 384, u / 6, u % 6, ep);
        } else { const int v = u - nq;
            GA ga{P + CD_M1, nullptr, CD_N, 0, 256, nullptr, RG, 0, 0};
            EpiBf ep{WSP(bf16_t, WS_BIG + L1_KV), 1024, RG, 1024};
            gemm_tile(lds, ga, WSP(const bf16_t, WS_WMIX + WM_UKV), 256, v >> 3, v & 7, ep);
        }
    }
}

constexpr int AT_LQ = 104, AT_LV = 72;
PHASE_FN void attn_unit(const KP& kp, unsigned char* lds, int bl, int head, int qb) {
    const int tid = otid(), lane = tid & 63, wid = __builtin_amdgcn_readfirstlane(tid >> 6), fr = lane & 15, fq = lane >> 4;
    bf16_t* Qs = (bf16_t*)lds;
    bf16_t* Kt = Qs + 128 * AT_LQ;
    bf16_t* Vt = Kt + 64 * AT_LQ;
    const bf16_t* P = WSP(const bf16_t, WS_BIG + L1_P);
    const bf16_t* Q = WSP(const bf16_t, WS_BIG + L1_Q);
    const bf16_t* KV = WSP(const bf16_t, WS_BIG + L1_KV);
    bf16_t* AOUT = WSP(bf16_t, WS_BIG + L1_AOUT);
    const float SC = 0.10206207261596577f;
#pragma unroll
    for (int i = 0; i < 3; ++i) { const int p = tid + i * 512, r = p / 12, c = p % 12;
        *(u32x4*)(Qs + r * AT_LQ + c * 8) = *(const u32x4*)(Q + ((size_t)bl * SEQ + qb * 128 + r) * 768 + head * 96 + c * 8); }
    lds_barrier();
#pragma unroll
    for (int i = 0; i < 4; ++i) { const int p = tid + i * 512, r = p >> 4, f = p & 15, s = qb * 128 + r;
        const float pos = (f < 8) ? (float)(s >> 6) : (float)(s & 63);
        const float inv = __expf(-(float)(f & 7) * (9.210340371976184f / 8.0f));
        float sn, cs; sincosf(pos * inv, &sn, &cs);
        const float a = bf2f(Qs[r * AT_LQ + 64 + f]), b2 = bf2f(Qs[r * AT_LQ + 80 + f]);
        Qs[r * AT_LQ + 64 + f] = f2bf(a * cs - b2 * sn); Qs[r * AT_LQ + 80 + f] = f2bf(a * sn + b2 * cs); }
    lds_barrier();
    bf16x8 qf[3];
#pragma unroll
    for (int k = 0; k < 3; ++k) qf[k] = ldfrag(Qs, AT_LQ, wid * 16, k * 32, fr, fq);
    f32x4 ot[4];
#pragma unroll
    for (int i = 0; i < 4; ++i) ot[i] = (f32x4){0.f, 0.f, 0.f, 0.f};
    float mrow = -1e30f, lsum = 0.f;
    u32x4 pk0, pk1, pvv;
    const int kkey0 = tid / 12, kc0 = tid % 12, kkey1 = (tid + 512) / 12, kc1 = (tid + 512) % 12, vkey = tid & 63, vc8 = tid >> 6;
#define AT_REQ(kt_) do { const size_t rb_ = (size_t)bl * TT + (kt_) * 64; \
        pk0 = kc0 < 8 ? *(const u32x4*)(KV + (rb_ + kkey0) * 1024 + head * 128 + kc0 * 8) : *(const u32x4*)(P + (rb_ + kkey0) * CD_N + CD_KR + (kc0 - 8) * 8); \
        if (tid < 256) pk1 = kc1 < 8 ? *(const u32x4*)(KV + (rb_ + kkey1) * 1024 + head * 128 + kc1 * 8) : *(const u32x4*)(P + (rb_ + kkey1) * CD_N + CD_KR + (kc1 - 8) * 8); \
        pvv = *(const u32x4*)(KV + (rb_ + vkey) * 1024 + head * 128 + 64 + vc8 * 8); } while (0)
    AT_REQ(0);
    for (int kt = 0; kt < TT / 64; ++kt) {
        lds_barrier();
        *(u32x4*)(Kt + kkey0 * AT_LQ + kc0 * 8) = pk0;
        if (tid < 256) *(u32x4*)(Kt + kkey1 * AT_LQ + kc1 * 8) = pk1;
        { bf16_t* vt = Vt + (vc8 * 8) * AT_LV + vkey; const u32x4 v = pvv;
            vt[0 * AT_LV] = (bf16_t)(v.x & 0xffff); vt[1 * AT_LV] = (bf16_t)(v.x >> 16); vt[2 * AT_LV] = (bf16_t)(v.y & 0xffff); vt[3 * AT_LV] = (bf16_t)(v.y >> 16);
            vt[4 * AT_LV] = (bf16_t)(v.z & 0xffff); vt[5 * AT_LV] = (bf16_t)(v.z >> 16); vt[6 * AT_LV] = (bf16_t)(v.w & 0xffff); vt[7 * AT_LV] = (bf16_t)(v.w >> 16); }
        if (kt + 1 < TT / 64) AT_REQ(kt + 1);
        lds_barrier();
        bf16x8 kf[3][4];
#pragma unroll
        for (int k = 0; k < 3; ++k)
#pragma unroll
            for (int kk = 0; kk < 4; ++kk) kf[k][kk] = ldfrag(Kt, AT_LQ, kk * 16, k * 32, fr, fq);
        u32x2 vlo[2][4], vhi[2][4];
#pragma unroll
        for (int k2 = 0; k2 < 2; ++k2)
#pragma unroll
            for (int dvt = 0; dvt < 4; ++dvt) { const bf16_t* vp = Vt + (dvt * 16 + fr) * AT_LV + k2 * 32 + fq * 4; vlo[k2][dvt] = *(const u32x2*)vp; vhi[k2][dvt] = *(const u32x2*)(vp + 16); }
        __builtin_amdgcn_sched_barrier(0);
        f32x4 st[4];
#pragma unroll
        for (int kk = 0; kk < 4; ++kk) st[kk] = (f32x4){0.f, 0.f, 0.f, 0.f};
#pragma unroll
        for (int k = 0; k < 3; ++k)
#pragma unroll
            for (int kk = 0; kk < 4; ++kk) st[kk] = mma16(kf[k][kk], qf[k], st[kk]);
        float mx = -1e30f;
#pragma unroll
        for (int kk = 0; kk < 4; ++kk) mx = fmaxf(mx, fmaxf(fmaxf(st[kk][0], st[kk][1]), fmaxf(st[kk][2], st[kk][3])));
        mx = fmaxf(mx, __shfl_xor(mx, 16)); mx = fmaxf(mx, __shfl_xor(mx, 32));
        const float mnew = fmaxf(mrow, mx), SC2 = SC * 1.4426950408889634f, mb = mnew * SC2;
        if (__builtin_amdgcn_ballot_w64(mnew > mrow) != 0ull) {
            const float alpha = __builtin_amdgcn_exp2f((mrow - mnew) * SC2);
            lsum *= alpha;
#pragma unroll
            for (int i = 0; i < 4; ++i) ot[i] = ot[i] * alpha;
        }
        mrow = mnew;
#pragma unroll
        for (int kk = 0; kk < 4; ++kk)
#pragma unroll
            for (int r = 0; r < 4; ++r) { const float pv = __builtin_amdgcn_exp2f(st[kk][r] * SC2 - mb); st[kk][r] = pv; lsum += pv; }
        union { bf16x8 v; unsigned u[4]; } pb[2];
#pragma unroll
        for (int k2 = 0; k2 < 2; ++k2) {
            pb[k2].u[0] = pack2(st[2 * k2][0], st[2 * k2][1]); pb[k2].u[1] = pack2(st[2 * k2][2], st[2 * k2][3]);
            pb[k2].u[2] = pack2(st[2 * k2 + 1][0], st[2 * k2 + 1][1]); pb[k2].u[3] = pack2(st[2 * k2 + 1][2], st[2 * k2 + 1][3]); }
#pragma unroll
        for (int k2 = 0; k2 < 2; ++k2)
#pragma unroll
            for (int dvt = 0; dvt < 4; ++dvt) { union { bf16x8 v; u32x2 h[2]; } va; va.h[0] = vlo[k2][dvt]; va.h[1] = vhi[k2][dvt];
                ot[dvt] = mma16(va.v, pb[k2].v, ot[dvt]); }
    }
#undef AT_REQ
    lsum += __shfl_xor(lsum, 16); lsum += __shfl_xor(lsum, 32);
    const float rl = frcp_(lsum);
    const size_t orow = (size_t)bl * SEQ + qb * 128 + wid * 16 + fr;
#pragma unroll
    for (int dvt = 0; dvt < 4; ++dvt) st4bf(AOUT + orow * 1536 + head * 64 + dvt * 16 + fq * 4, ot[dvt] * rl);
}

constexpr int RW_LR = 200, RW_LP = 72;
PHASE_FN void rwkv_unit(const KP& kp, unsigned char* lds, int bl, int h, int dir) {
    const int tid = otid();
    bf16_t* RAW = (bf16_t*)lds;
    bf16_t* TWb = RAW + 34 * RW_LR;
    bf16_t* ALb = TWb + 32 * RW_LP;
    bf16_t* W2T = ALb + 32 * RW_LP;
    bf16_t* A2T = W2T + 64 * RW_LP;
    float* CL = (float*)(A2T + 64 * RW_LP);
    bf16_t* AR = (bf16_t*)(CL + 32 * 64);
    bf16_t* BK = AR + 64 * RW_LP;
    float* AABT = (float*)(BK + 64 * RW_LP);
    bf16_t* ARB = (bf16_t*)(AABT + 32 * 36);
    bf16_t* AAK = ARB + 32 * 40;
    bf16_t* ARK = AAK + 32 * 40;
    float* RHS = (float*)(ARK + 32 * 40);
    float* YB = RHS + 32 * 64;
    bf16_t* ZVT = (bf16_t*)(YB + 32 * 64);
    bf16_t* BKh = ZVT + 64 * RW_LP;
    bf16_t* Sb = BKh + 64 * RW_LP;
    float* PL = (float*)(Sb + 64 * RW_LP);
    const bf16_t* P = WSP(const bf16_t, WS_BIG + L1_P); const bf16_t* TWAL = WSP(const bf16_t, WS_BIG + L1_TWAL);
    bf16_t* OUT = WSP(bf16_t, WS_BIG + (dir ? L1_OB : L1_OF));
    float* BSC = WSP(float, WS_BSC) + (size_t)dir * RGL * 16;
    const float* mu = KIN(24);
    for (int i = tid; i < 64 * 64; i += 512) { const int c = i >> 6, n = i & 63;
        W2T[n * RW_LP + c] = f2bf(KIN(26)[((size_t)dir * 64 + c) * 1024 + h * 64 + n]); A2T[n * RW_LP + c] = f2bf(KIN(28)[((size_t)dir * 64 + c) * 1024 + h * 64 + n]); }
    for (int i = tid; i < 64 * RW_LP; i += 512) Sb[i] = 0;
    float* CV = PL + 64;
    if (tid < 64) { const int n = tid;
        CV[0 * 64 + n] = KIN(25)[dir * 1024 + h * 64 + n]; CV[1 * 64 + n] = KIN(27)[dir * 1024 + h * 64 + n];
        CV[2 * 64 + n] = KIN(30)[h * 64 + n]; CV[3 * 64 + n] = KIN(31)[h * 64 + n]; CV[4 * 64 + n] = KIN(32)[h * 64 + n];
        CV[5 * 64 + n] = mu[h * 64 + n]; CV[6 * 64 + n] = mu[1024 + h * 64 + n]; CV[7 * 64 + n] = mu[2048 + h * 64 + n]; }
    f32x4 Sacc[2];
    Sacc[0] = (f32x4){0.f, 0.f, 0.f, 0.f}; Sacc[1] = (f32x4){0.f, 0.f, 0.f, 0.f};
    u32x4 pf[3];
#define RW_PREFETCH(cn, tix) do { const int t0n_ = dir ? scan_t<32>(1, (cn), 31) : (cn) * 32; const int lo_ = t0n_ < CTXL ? 0 : CTXL, hi_ = t0n_ < CTXL ? CTXL : TT; \
        _Pragma("unroll") for (int q = 0; q < 2; ++q) { const int p = (tix) + q * 512; pf[q] = (u32x4){0u, 0u, 0u, 0u}; \
            if (p < 34 * 24) { const int rr = p / 24, c = p % 24, t = t0n_ - 1 + rr; \
                if (t >= lo_ && t < hi_) { const int seg = c >> 3, c8 = c & 7; \
                    const int col = (seg == 0 ? CD_R : seg == 1 ? CD_K : CD_V) + h * 64; \
                    pf[q] = *(const u32x4*)(P + ((size_t)bl * TT + t) * CD_N + col + c8 * 8); } } } \
        { const int i_ = (tix) >> 4, c16 = (tix) & 15; \
          pf[2] = *(const u32x4*)(TWAL + ((size_t)bl * TT + t0n_ + i_) * 256 + (c16 >> 3) * 128 + dir * 64 + (c16 & 7) * 8); } } while (0)
    RW_PREFETCH(0, tid);
    lds_barrier();
    for (int ci = 0; ci < TT / 32; ++ci) {
        int tq = tid; asm volatile("" : "+v"(tq));
        const int lane = tq & 63, wid = __builtin_amdgcn_readfirstlane(tq >> 6), fr = lane & 15, fq = lane >> 4, pi = tq >> 4, n4 = (tq & 15) * 4;
        const int t0 = dir ? scan_t<32>(1, ci, 31) : ci * 32;
#pragma unroll
        for (int q = 0; q < 2; ++q) { const int p = tq + q * 512; if (p < 34 * 24) *(u32x4*)(RAW + (p / 24) * RW_LR + (p % 24) * 8) = pf[q]; }
        { const int i_ = tq >> 4, c16 = tq & 15; *(u32x4*)(((c16 >> 3) ? ALb : TWb) + i_ * RW_LP + (c16 & 7) * 8) = pf[2]; }
        if (ci + 1 < TT / 32) RW_PREFETCH(ci + 1, tq);
        lds_barrier();
        {
            const int which = wid >> 2, tt = (wid >> 1) & 1;
            const bf16_t* Xa = which ? ALb : TWb; const bf16_t* Wt = which ? A2T : W2T; float* Od = which ? YB : RHS;
#pragma unroll
            for (int q2 = 0; q2 < 2; ++q2) { const int nt = (wid & 1) * 2 + q2;
                f32x4 acc = (f32x4){0.f, 0.f, 0.f, 0.f};
#pragma unroll
                for (int k = 0; k < 2; ++k) acc = mma16(ldfrag(Xa, RW_LP, tt * 16, k * 32, fr, fq), ldfrag(Wt, RW_LP, nt * 16, k * 32, fr, fq), acc);
#pragma unroll
                for (int rr = 0; rr < 4; ++rr) Od[(tt * 16 + fq * 4 + rr) * 64 + nt * 16 + fr] = acc[rr]; }
        }
        lds_barrier();
        const int j = dir ? 31 - pi : pi;
        f32x4 r, kd, v, av, bv;
        {
            const f32x4 w0v = *(const f32x4*)(CV + n4), a0v = *(const f32x4*)(CV + 64 + n4), kkw = *(const f32x4*)(CV + 128 + n4), kaw = *(const f32x4*)(CV + 192 + n4), rkw = *(const f32x4*)(CV + 256 + n4);
            const f32x4 mur = *(const f32x4*)(CV + 320 + n4), muk = *(const f32x4*)(CV + 384 + n4), muv = *(const f32x4*)(CV + 448 + n4);
            const f32x4 wl = w0v + *(const f32x4*)(RHS + pi * 64 + n4), al = a0v + *(const f32x4*)(YB + pi * 64 + n4);
            const bf16_t* r1 = RAW + (pi + 1) * RW_LR; const bf16_t* rp = RAW + pi * RW_LR; const bf16_t* rn = RAW + (pi + 2) * RW_LR;
            f32x4 k;
            r = ld4bf(r1 + n4); k = ld4bf(r1 + 64 + n4); v = ld4bf(r1 + 128 + n4);
            r = r + mur * ((ld4bf(rp + n4) + ld4bf(rn + n4)) * 0.5f - r);
            k = k + muk * ((ld4bf(rp + 64 + n4) + ld4bf(rn + 64 + n4)) * 0.5f - k);
            v = v + muv * ((ld4bf(rp + 128 + n4) + ld4bf(rn + 128 + n4)) * 0.5f - v);
            f32x4 a, lw, kk = k * kkw;
            float ssq = kk[0] * kk[0] + kk[1] * kk[1] + kk[2] * kk[2] + kk[3] * kk[3];
            ssq += __shfl_xor(ssq, 1); ssq += __shfl_xor(ssq, 2); ssq += __shfl_xor(ssq, 4); ssq += __shfl_xor(ssq, 8);
            kk = kk * __builtin_amdgcn_rsqf(fmaxf(ssq, 1e-24f));
#pragma unroll
            for (int q = 0; q < 4; ++q) { const float wlog = -softplusf_(-wl[q]) - 0.5f; lw[q] = -__expf(wlog); a[q] = sigmoidf_(al[q]); }
            kd = k * ((a - 1.0f) * kaw + 1.0f);
            float bs = r[0] * kd[0] * rkw[0] + r[1] * kd[1] * rkw[1] + r[2] * kd[2] * rkw[2] + r[3] * kd[3] * rkw[3];
            bs += __shfl_xor(bs, 1); bs += __shfl_xor(bs, 2); bs += __shfl_xor(bs, 4); bs += __shfl_xor(bs, 8);
            av = kk * -1.0f; bv = kk * a;
            *(f32x4*)(CL + j * 64 + n4) = lw;
            const int t = t0 + pi;
            if (t >= CTXL && (tq & 15) == 0) BSC[((size_t)bl * SEQ + (t - CTXL)) * 16 + h] = bs;
        }
        lds_barrier();
        if (wid == 0) {
            float c[32];
#pragma unroll
            for (int q = 0; q < 32; ++q) c[q] = CL[q * 64 + lane];
#pragma unroll
            for (int q = 1; q < 32; ++q) c[q] += c[q - 1];
#pragma unroll
            for (int q = 0; q < 32; ++q) CL[q * 64 + lane] = c[q];
            PL[lane] = __expf(c[31]);
        }
        lds_barrier();
        {
            const f32x4 clj = *(const f32x4*)(CL + j * 64 + n4), cle = *(const f32x4*)(CL + 31 * 64 + n4);
            f32x4 clp = (f32x4){0.f, 0.f, 0.f, 0.f};
            if (j > 0) clp = *(const f32x4*)(CL + (j - 1) * 64 + n4);
            f32x4 at, rt, bt, kt, bh, kh;
#pragma unroll
            for (int q = 0; q < 4; ++q) { const float ep = __expf(clp[q]), ej = __expf(clj[q]), ei = __expf(-clj[q]), ee = __expf(cle[q] - clj[q]);
                at[q] = av[q] * ep; rt[q] = r[q] * ej; bt[q] = bv[q] * ei; kt[q] = kd[q] * ei; bh[q] = bv[q] * ee; kh[q] = kd[q] * ee; }
            st4bf(AR + j * RW_LP + n4, at); st4bf(AR + (32 + j) * RW_LP + n4, rt);
            st4bf(BK + j * RW_LP + n4, bt); st4bf(BK + (32 + j) * RW_LP + n4, kt);
#pragma unroll
            for (int q = 0; q < 4; ++q) { BKh[(n4 + q) * RW_LP + j] = f2bf(bh[q]); BKh[(n4 + q) * RW_LP + 32 + j] = f2bf(kh[q]); ZVT[(n4 + q) * RW_LP + 32 + j] = f2bf(v[q]); }
        }
        lds_barrier();
        {
            const int ti = wid >> 1;
#pragma unroll
            for (int q2 = 0; q2 < 2; ++q2) {
                const int si = (wid & 1) * 2 + q2;
                f32x4 acc = (f32x4){0.f, 0.f, 0.f, 0.f};
#pragma unroll
                for (int k = 0; k < 2; ++k) acc = mma16(ldfrag(AR, RW_LP, ti * 16, k * 32, fr, fq), ldfrag(BK, RW_LP, si * 16, k * 32, fr, fq), acc);
                const int sp = si * 16 + fr, s = sp & 31;
#pragma unroll
                for (int rr = 0; rr < 4; ++rr) { const int tp = ti * 16 + fq * 4 + rr, t = tp & 31;
                    const bool incl = tp >= 32;
                    const float val = (incl ? (s <= t) : (s < t)) ? acc[rr] : 0.f;
                    if (sp < 32) { if (incl) ARB[t * 40 + s] = f2bf(val); else AABT[s * 36 + t] = val; }
                    else { (incl ? ARK : AAK)[t * 40 + s] = f2bf(val); } }
            }
        }
        lds_barrier();
        {
            const int which = wid >> 2, tt = (wid >> 1) & 1;
            const bf16_t* Ak = which ? ARK : AAK; float* Od = which ? YB : RHS;
#pragma unroll
            for (int q2 = 0; q2 < 2; ++q2) {
                const int vt = (wid & 1) * 2 + q2;
                f32x4 acc = (f32x4){0.f, 0.f, 0.f, 0.f};
#pragma unroll
                for (int k = 0; k < 2; ++k) acc = mma16(ldfrag(AR, RW_LP, which * 32 + tt * 16, k * 32, fr, fq), ldfrag(Sb, RW_LP, vt * 16, k * 32, fr, fq), acc);
                acc = mma16(ldfrag(Ak, 40, tt * 16, 0, fr, fq), ldfrag(ZVT, RW_LP, vt * 16, 32, fr, fq), acc);
#pragma unroll
                for (int rr = 0; rr < 4; ++rr) Od[(tt * 16 + fq * 4 + rr) * 64 + vt * 16 + fr] = acc[rr];
            }
        }
        lds_barrier();
        if (wid == 0) {
            float z[32];
#pragma unroll
            for (int t = 0; t < 32; ++t) z[t] = RHS[t * 64 + lane];
            f32x4 cur[4], nxt[4];
#pragma unroll
            for (int half = 0; half < 2; ++half) {
                const int r0 = half * 16;
#pragma unroll
                for (int q4 = 0; q4 < 4; ++q4) cur[q4] = *(const f32x4*)(AABT + r0 * 36 + r0 + q4 * 4);
#pragma unroll
                for (int sc = 0; sc < 15; ++sc) {
                    if (sc + 1 < 15) {
#pragma unroll
                        for (int q4 = 0; q4 < 4; ++q4) if (q4 * 4 + 3 > sc + 1) nxt[q4] = *(const f32x4*)(AABT + (r0 + sc + 1) * 36 + r0 + q4 * 4);
                    }
                    const float zs = z[r0 + sc];
#pragma unroll
                    for (int q4 = 0; q4 < 4; ++q4)
#pragma unroll
                        for (int e = 0; e < 4; ++e) if (q4 * 4 + e > sc) z[r0 + q4 * 4 + e] += cur[q4][e] * zs;
                    asm volatile("" : "+v"(z[r0 + sc + 1]) :: "memory");
#pragma unroll
                    for (int q4 = 0; q4 < 4; ++q4) if (q4 * 4 + 3 > sc + 1) cur[q4] = nxt[q4];
                }
                if (half == 0) {
#pragma unroll
                    for (int sc = 0; sc < 16; ++sc) {
                        f32x4 ca[4];
#pragma unroll
                        for (int q4 = 0; q4 < 4; ++q4) ca[q4] = *(const f32x4*)(AABT + sc * 36 + 16 + q4 * 4);
#pragma unroll
                        for (int q4 = 0; q4 < 4; ++q4)
#pragma unroll
                            for (int e = 0; e < 4; ++e) z[16 + q4 * 4 + e] += ca[q4][e] * z[sc];
                        if (sc & 1) asm volatile("" ::: "memory");
                    }
                }
            }
#pragma unroll
            for (int q = 0; q < 4; ++q) { u32x4 w;
                w.x = pack2(z[q * 8 + 0], z[q * 8 + 1]); w.y = pack2(z[q * 8 + 2], z[q * 8 + 3]); w.z = pack2(z[q * 8 + 4], z[q * 8 + 5]); w.w = pack2(z[q * 8 + 6], z[q * 8 + 7]);
                *(u32x4*)(ZVT + lane * RW_LP + q * 8) = w; }
        }
        lds_barrier();
        {
            const int nt = wid >> 1;
            const f32x4 pl = *(const f32x4*)(PL + nt * 16 + fq * 4);
#pragma unroll
            for (int q2 = 0; q2 < 2; ++q2) {
                const int vt = (wid & 1) * 2 + q2;
                Sacc[q2] = Sacc[q2] * pl;
#pragma unroll
                for (int k = 0; k < 2; ++k) Sacc[q2] = mma16(ldfrag(BKh, RW_LP, nt * 16, k * 32, fr, fq), ldfrag(ZVT, RW_LP, vt * 16, k * 32, fr, fq), Sacc[q2]);
                st4bf(Sb + (vt * 16 + fr) * RW_LP + nt * 16 + fq * 4, Sacc[q2]);
            }
        }
        if (t0 >= CTXL) {
            const int vt = wid >> 1, tt = wid & 1;
            f32x4 acc = (f32x4){0.f, 0.f, 0.f, 0.f};
            acc = mma16(ldfrag(ZVT, RW_LP, vt * 16, 0, fr, fq), ldfrag(ARB, 40, tt * 16, 0, fr, fq), acc);
            const int t = tt * 16 + fr, v0 = vt * 16 + fq * 4;
#pragma unroll
            for (int rr = 0; rr < 4; ++rr) acc[rr] += YB[t * 64 + v0 + rr];
            const int tn = scan_t<32>(dir, ci, t);
            st4bf(OUT + ((size_t)bl * SEQ + (tn - CTXL)) * 1024 + h * 64 + v0, acc);
        }
    }
    lds_barrier();
#undef RW_PREFETCH
}

__device__ __forceinline__ void phase_mix_cd(const KP& kp, unsigned char* lds, int which) {
    if (which & 1) for (int u = obid(); u < 256; u += gridDim.x) { rwkv_unit(kp, lds, u >> 5, (u >> 1) & 15, u & 1); __syncthreads(); }
    if (which & 2) for (int u = obid(); u < 1024; u += gridDim.x) { attn_unit(kp, lds, u >> 7, (u >> 4) & 7, u & 15); __syncthreads(); }
}

struct EpiFinCD {
    const bf16_t* OF; const bf16_t* OB; const bf16_t* P; const float* BSC; const float* ln; const float* mu; bf16_t* AOUT;
    __device__ __forceinline__ void operator()(const f32x4 (&acc)[4][4], int rb, int cb, int fr, int fq) const {
        const int head = cb >> 6;
#pragma unroll
        for (int i = 0; i < 4; ++i) { const int lr = rb + i * 16 + fr, s = lr & 2047;
            const size_t prow = (size_t)(lr >> 11) * TT + CTXL + s;
            f32x4 o[4]; float ss = 0.f;
#pragma unroll
            for (int j = 0; j < 4; ++j) { const int col = cb + j * 16 + fq * 4;
                o[j] = ld4bf(OF + (size_t)lr * 1024 + col) + ld4bf(OB + (size_t)lr * 1024 + col);
                ss += o[j][0] * o[j][0] + o[j][1] * o[j][1] + o[j][2] * o[j][2] + o[j][3] * o[j][3]; }
            ss += __shfl_xor(ss, 16); ss += __shfl_xor(ss, 32);
            const float rstd = rsqrtf(ss * (1.0f / 64.0f) + EPS);
            const float bon = BSC[(size_t)lr * 16 + head] + BSC[(size_t)RGL * 16 + (size_t)lr * 16 + head];
#pragma unroll
            for (int j = 0; j < 4; ++j) { const int col = cb + j * 16 + fq * 4;
                const bf16_t* pv = P + prow * CD_N + CD_V + col;
                const f32x4 v = ld4bf(pv);
                const f32x4 vp = s > 0 ? ld4bf(pv - CD_N) : (f32x4){0.f, 0.f, 0.f, 0.f};
                const f32x4 vn = s < SEQ - 1 ? ld4bf(pv + CD_N) : (f32x4){0.f, 0.f, 0.f, 0.f};
                const f32x4 vl = v + *(const f32x4*)(mu + 2048 + col) * ((vp + vn) * 0.5f - v);
                const f32x4 y = o[j] * rstd * *(const f32x4*)(ln + col) + vl * bon;
                st4bf(AOUT + (size_t)lr * 1536 + 512 + col, y * acc[i][j]); }
        }
    }
};
PHASE_FN void phase_fin_cd(const KP& kp, unsigned char* lds) {
    GA ga{WSP(const bf16_t, WS_SG), nullptr, 128, 0, 128, nullptr, RGL, 0, 0};
    EpiFinCD ep{WSP(const bf16_t, WS_BIG + L1_OF), WSP(const bf16_t, WS_BIG + L1_OB), WSP(const bf16_t, WS_BIG + L1_P), WSP(const float, WS_BSC), KIN(33), KIN(24), WSP(bf16_t, WS_BIG + L1_AOUT)};
    for (int u = obid(); u < (RGL / 256) * 8; u += gridDim.x) gemm_tile(lds, ga, WSP(const bf16_t, WS_WMIX + WM_G2), 128, u >> 3, u & 7, ep);
}
PHASE_FN void phase_gemm_out_cd(const KP& kp, unsigned char* lds) {
    pg8::Gemm g{WSP(const bf16_t, WS_BIG + L1_AOUT), WSP(const bf16_t, WS_WMIX + WM_CD_OUT), RGL, 1024, 1536, nullptr, 0x7fffffff};
    pg8::StaticOrder S; S.init(RGL, 1024, (int)gridDim.x, obid());
    pg8::EpiBfG E{WSP(bf16_t, WS_BIG + L1_U), 1024, 1024, 0x7fffffff};
    pg8::gemm_phase<pg8::EpiBfG, pg8::StaticOrder, false>((PG8_LAS unsigned char*)lds, g, S, E, nullptr);
    __syncthreads();
}

__device__ __attribute__((noinline)) void grid_sync(unsigned* barw, unsigned x, volatile LAS unsigned* st) { XcdBarrier b; b.bar = barw; b.x = x; b.st = st; xcd_barrier(b); }
constexpr int N_PHASES = 39;
__global__ void __launch_bounds__(512, 2) fwd_kernel(KP kparg) {
    extern __shared__ __attribute__((aligned(16))) unsigned char lds[];
    const int lo = kparg.ph_lo, hi = kparg.ph_hi;
    const KP& kp = kparg;
    volatile LAS unsigned* xbst = (volatile LAS unsigned*)(LAS unsigned char*)(lds + LDS_BYTES - 16);
    if (threadIdx.x == 0) { xbst[0] = 0u; xbst[1] = 0u; }
    __syncthreads();
    XcdBarrier bar; bar.bar = (unsigned*)kparg.ws; bar.x = 0; bar.st = xbst;
    if (hi - lo > 1) bar = xcd_barrier_post((unsigned*)kparg.ws, xbst);
#define IN(k) (lo <= (k) && (k) < hi)
#define SEAM(k) do { if (IN(k) && IN((k) + 1)) { grid_sync((unsigned*)kp.ws, bar.x, xbst); if (PROBE_DUP & 512) grid_sync((unsigned*)kp.ws, bar.x, xbst); } } while (0)
#define PHASE(...) do { if (IN(ph)) { __VA_ARGS__ } SEAM(ph); ++ph; } while (0)
    int ph = 0;
    PHASE(phase_mod(kp, lds); __syncthreads(); phase_conv_ab(kp, lds); if (PROBE_DUP & 32) { __syncthreads(); phase_mod(kp, lds); __syncthreads(); phase_conv_ab(kp, lds); });
#pragma unroll
    for (int g = 0; g < NG; ++g) {
        PHASE(phase_u(kp, 0, g); if (PROBE_DUP & 128) phase_u(kp, 0, g););
        PHASE(phase_gemm_in(kp, lds, 0); if (PROBE_DUP & 8) phase_gemm_in(kp, lds, 0););
        PHASE(phase_xconv(kp); if (PROBE_DUP & 2048) phase_xconv(kp););
        PHASE(phase_scan_ab(kp, lds); if (PROBE_DUP & 1) { __syncthreads(); phase_scan_ab(kp, lds); });
        PHASE(phase_fin_ab(kp););
        PHASE(phase_gemm_out_ab(kp, lds); if (PROBE_DUP & 256) phase_gemm_out_ab(kp, lds););
        PHASE(phase_r(kp, lds, 0, g););
    }
    PHASE(phase_moe_gather(kp, 0); phase_conv_moe(kp, lds, 0); phase_conv_cd(kp, lds); if (PROBE_DUP & 64) { phase_moe_gather(kp, 0); phase_conv_moe(kp, lds, 0); phase_conv_cd(kp, lds); });
    PHASE(phase_moe_gemm(kp, lds, 0, false); if (PROBE_DUP & 16) { __syncthreads(); phase_moe_gemm(kp, lds, 0, false); });
    PHASE(phase_moe_gemm(kp, lds, 0, true); if (PROBE_DUP & 16) { __syncthreads(); phase_moe_gemm(kp, lds, 0, true); });
    PHASE(phase_combine(kp, 0););
#pragma unroll
    for (int g = 0; g < NG; ++g) {
        PHASE(phase_u(kp, 1, g); if (PROBE_DUP & 128) phase_u(kp, 1, g););
        PHASE(phase_gemm_in(kp, lds, 1); if (PROBE_DUP & 8) phase_gemm_in(kp, lds, 1););
        PHASE(phase_prep_cd(kp););
        PHASE(phase_upproj(kp, lds); if (PROBE_DUP & 4096) phase_upproj(kp, lds););
        PHASE(phase_mix_cd(kp, lds, 3); if (PROBE_DUP & 2) { __syncthreads(); phase_mix_cd(kp, lds, 1); } if (PROBE_DUP & 4) { __syncthreads(); phase_mix_cd(kp, lds, 2); });
        PHASE(phase_fin_cd(kp, lds); if (PROBE_DUP & 4096) phase_fin_cd(kp, lds););
        PHASE(phase_gemm_out_cd(kp, lds); if (PROBE_DUP & 256) phase_gemm_out_cd(kp, lds););
        PHASE(phase_r(kp, lds, 1, g););
    }
    PHASE(phase_moe_gather(kp, 1); phase_conv_moe(kp, lds, 1););
    PHASE(phase_moe_gemm(kp, lds, 1, false););
    PHASE(phase_moe_gemm(kp, lds, 1, true););
    PHASE(phase_combine(kp, 1););
#undef PHASE
#undef IN
#undef SEAM
}

extern "C" void kernel_launch(void* const* d_in, const int* in_sizes, int n_in, void* d_out, int out_size, void* d_ws, size_t ws_size, hipStream_t stream) {
    static int grid = 0;
    if (grid == 0) {
        if (n_in != 42 || out_size != NLAT * D || ws_size < WS_NEED) { fprintf(stderr, "kernel_launch: unexpected shapes: n_in %d out %d ws %zu (need %zu)\n", n_in, out_size, ws_size, (size_t)WS_NEED); grid = -1; return; }
        int dev = 0, cus = 0, per_cu = 0;
        if (hipGetDevice(&dev) != hipSuccess || hipDeviceGetAttribute(&cus, hipDeviceAttributeMultiprocessorCount, dev) != hipSuccess) { grid = -1; return; }
        if (hipFuncSetAttribute((const void*)fwd_kernel, hipFuncAttributeMaxDynamicSharedMemorySize, LDS_BYTES) != hipSuccess) { fprintf(stderr, "kernel_launch: hipFuncSetAttribute failed\n"); grid = -1; return; }
        if (hipOccupancyMaxActiveBlocksPerMultiprocessor(&per_cu, (const void*)fwd_kernel, 512, LDS_BYTES) != hipSuccess || per_cu < 1) { fprintf(stderr, "kernel_launch: occupancy query says %d blocks per CU\n", per_cu); grid = -1; (void)hipGetLastError(); return; }
        grid = cus;
    }
    if (grid < 0) return;
    (void)hipMemsetAsync(d_ws, 0, CTL_BYTES, stream);
    KP kp{};
    for (int i = 0; i < 42; ++i) kp.in[i] = (const float*)d_in[i];
    kp.out = (float*)d_out; kp.ws = (unsigned char*)d_ws;
#if N_LAUNCH_MODE == 1
    kp.ph_lo = 0; kp.ph_hi = N_PHASES;
    hipLaunchKernelGGL(fwd_kernel, dim3(grid), dim3(512), LDS_BYTES, stream, kp);
#else
    for (int p = 0; p < N_PHASES; ++p) { kp.ph_lo = p; kp.ph_hi = p + 1; hipLaunchKernelGGL(fwd_kernel, dim3(grid), dim3(512), LDS_BYTES, stream, kp); }
#endif
}
```

```cpp
#include <hip/hip_runtime.h>
#include <stdint.h>
#include <stdio.h>

typedef unsigned short bf16_t;
typedef short bf16x8 __attribute__((ext_vector_type(8)));
typedef float f32x4 __attribute__((ext_vector_type(4)));
typedef float f32x2 __attribute__((ext_vector_type(2)));
typedef unsigned u32x4 __attribute__((ext_vector_type(4)));
typedef unsigned u32x2 __attribute__((ext_vector_type(2)));

#ifndef RWP
#define RWP 0
#endif
#ifndef PROBE_DUP
#define PROBE_DUP 0
#endif
#ifndef N_LAUNCH_MODE
#define N_LAUNCH_MODE 1
#endif

constexpr int NB = 16, SEQ = 2048, CTXL = 256, TT = 2304, D = 1024;
constexpr int NTOK = NB * TT, NLAT = NB * SEQ;
constexpr int NG = 2, BG = NB / NG, RG = BG * TT, RGL = BG * SEQ;
constexpr float EPS = 1e-6f;
constexpr int AB_N = 5424, AB_NPAD = 5632, AB_Q = 0, AB_K = 512, AB_V = 1024, AB_OG = 2048, AB_IG = 3072, AB_FG = 3080, AB_Z = 3088, AB_XBC = 4112, AB_DT = 5392;
constexpr int CD_N = 4128, CD_NPAD = 4352, CD_M0 = 0, CD_M1 = 384, CD_KR = 640, CD_R = 672, CD_K = 1696, CD_V = 2720, CD_WL = 3744, CD_AL = 3872, CD_GL = 4000;
constexpr int CD_RW0 = 672;

constexpr size_t CTL_BYTES = 32768;
constexpr size_t CTL_CNT = 16384;
constexpr size_t WS_MODV = CTL_BYTES;
constexpr size_t WS_HC   = WS_MODV + (size_t)2 * 17 * 6144 * 4;
constexpr size_t WS_TOKE = WS_HC + (size_t)NB * CTXL * D * 4;
constexpr size_t WS_TOKP = WS_TOKE + (size_t)NTOK * 2 * 4;
constexpr size_t WS_TOKW = WS_TOKP + (size_t)NTOK * 2 * 4;
constexpr size_t WS_LIST = WS_TOKW + (size_t)NTOK * 2 * 4;
constexpr size_t WS_BSC  = WS_LIST + (size_t)16 * NTOK * 4;
constexpr size_t WS_SG   = WS_BSC + (size_t)2 * RGL * 16 * 4;
constexpr size_t WS_WMIX = WS_SG + (size_t)RGL * 128 * 2;
constexpr size_t WMIX_BYTES = (size_t)16 << 20;
constexpr size_t WS_V    = WS_WMIX + WMIX_BYTES;
constexpr size_t WS_BIG  = WS_V + (size_t)NTOK * D * 2;
constexpr size_t WM_AB_IN = 0, WM_AB_OUT = (size_t)AB_NPAD * 1024 * 2;
constexpr size_t WM_CD_IN = 0, WM_CD_OUT = (size_t)CD_NPAD * 1024 * 2, WM_UQ = WM_CD_OUT + (size_t)1024 * 1536 * 2, WM_UKV = WM_UQ + (size_t)768 * 384 * 2, WM_G2 = WM_UKV + (size_t)1024 * 256 * 2;
static_assert(WM_AB_OUT + (size_t)1024 * 2048 * 2 <= WMIX_BYTES, "wmix ab");
static_assert(WM_G2 + (size_t)1024 * 128 * 2 <= WMIX_BYTES, "wmix cd");
constexpr size_t SZ_RG1K = (size_t)RG * 1024 * 2, SZ_RGL1K = (size_t)RGL * 1024 * 2;
constexpr size_t L0_P = 0, L0_AO = (size_t)RG * AB_N * 2  , L0_HB = L0_AO + 2 * SZ_RG1K, L0_YB = L0_HB + SZ_RG1K, L0_U = L0_YB + SZ_RG1K, L0_END = L0_U + SZ_RG1K;
constexpr size_t L1_P = 0, L1_Q = (size_t)RG * CD_N * 2, L1_KV = L1_Q + (size_t)RGL * 768 * 2, L1_OF = L1_KV + SZ_RG1K, L1_OB = L1_OF + SZ_RGL1K, L1_AOUT = L1_OB + SZ_RGL1K, L1_U = L1_AOUT + (size_t)RGL * 1536 * 2, L1_TWAL = L1_U + SZ_RG1K  , L1_END = L1_TWAL + (size_t)RG * 256 * 2;
constexpr int MOE_PADROWS = 16 * 256;
constexpr size_t MO_WUP = 0, MO_WDN = (size_t)17 * 1024 * 1024 * 2, MO_HID = MO_WDN + (size_t)17 * 1024 * 512 * 2;
constexpr size_t MO_XG = MO_HID + (size_t)(3 * NTOK + MOE_PADROWS) * 512 * 2;
constexpr size_t MO_CON = MO_XG, MO_END = MO_CON + (size_t)(3 * NTOK + MOE_PADROWS) * 1024 * 2;
constexpr size_t BIG_BYTES = MO_END > L0_END ? (MO_END > L1_END ? MO_END : L1_END) : (L0_END > L1_END ? L0_END : L1_END);
constexpr size_t WS_NEED = WS_BIG + BIG_BYTES;

constexpr int LDS_BYTES = 147456;

__device__ __forceinline__ float bf2f(unsigned short h) { return __uint_as_float(((unsigned)h) << 16); }
typedef __bf16 bf16v2_t __attribute__((ext_vector_type(2)));
__device__ __forceinline__ unsigned pack2(float a, float b) { const bf16v2_t h = __builtin_convertvector((f32x2){a, b}, bf16v2_t); return __builtin_bit_cast(unsigned, h); }
__device__ __forceinline__ unsigned short f2bf(float f) { const __bf16 h = (__bf16)f; return __builtin_bit_cast(unsigned short, h); }
__device__ __forceinline__ float lo2f(unsigned w) { return __uint_as_float(w << 16); }
__device__ __forceinline__ float hi2f(unsigned w) { return __uint_as_float(w & 0xffff0000u); }
__device__ __forceinline__ float wsum(float v) {
#pragma unroll
    for (int o = 32; o; o >>= 1) v += __shfl_xor(v, o);
    return v; }
__device__ __forceinline__ float frcp_(float x) { return __builtin_amdgcn_rcpf(x); }
__device__ __forceinline__ float sigmoidf_(float x) { return __builtin_amdgcn_rcpf(1.0f + __expf(-x)); }
__device__ __forceinline__ float siluf_(float x) { return x * __builtin_amdgcn_rcpf(1.0f + __expf(-x)); }
__device__ __forceinline__ float softplusf_(float x) { return fmaxf(x, 0.0f) + __logf(1.0f + __expf(-fabsf(x))); }
__device__ __forceinline__ float logsigmoidf_(float x) { return fminf(x, 0.0f) - __logf(1.0f + __expf(-fabsf(x))); }
__device__ __forceinline__ float tanhf_(float x) { return 1.0f - 2.0f * __builtin_amdgcn_rcpf(__expf(2.0f * x) + 1.0f); }
__device__ __forceinline__ f32x4 mma16(bf16x8 a, bf16x8 b, f32x4 c) { return __builtin_amdgcn_mfma_f32_16x16x32_bf16(a, b, c, 0, 0, 0); }
__device__ __forceinline__ bf16x8 ldfrag(const bf16_t* base, int ld, int row0, int k0, int fr, int fq) { return *(const bf16x8*)(base + (row0 + fr) * ld + k0 + fq * 8); }
__device__ __forceinline__ void st4bf(bf16_t* p, f32x4 v) { u32x2 w; w.x = pack2(v[0], v[1]); w.y = pack2(v[2], v[3]); *(u32x2*)p = w; }
__device__ __forceinline__ f32x4 ld4bf(const bf16_t* p) { u32x2 w = *(const u32x2*)p; return (f32x4){lo2f(w.x), hi2f(w.x), lo2f(w.y), hi2f(w.y)}; }

#define PHASE_FN __device__ __forceinline__
__device__ __forceinline__ int otid() { int t = threadIdx.x; asm volatile("" : "+v"(t)); return t; }
__device__ __forceinline__ int obid() { int t = blockIdx.x; asm volatile("" : "+s"(t)); return t; }
template <class T> __device__ __forceinline__ T* as_global(T* p) { return p; }
__device__ __forceinline__ void lds_barrier() { asm volatile("s_waitcnt lgkmcnt(0)" ::: "memory"); __builtin_amdgcn_s_barrier(); asm volatile("" ::: "memory"); }
struct KP { const float* in[42]; float* out; unsigned char* ws; int ph_lo, ph_hi; };

#define XB_TMO      128
#define XB_XCNT(j)  (256  + 64 * (j))
#define XB_XSUB(j)  (1280 + 64 * (j))
#define XB_XGEN(j)  (2304 + 64 * (j))
#define XB_TOP      3328
#define XB_TOPGEN   3392
#define XCD_BAR_WORDS 3456
#define XB_SPIN_CAP (1u << 18)
#define LAS __attribute__((address_space(3)))

__device__ __forceinline__ unsigned xb_ld(unsigned* p)              { return __hip_atomic_load(p, __ATOMIC_RELAXED, __HIP_MEMORY_SCOPE_AGENT); }
__device__ __forceinline__ unsigned xb_add(unsigned* p, unsigned v) { return __hip_atomic_fetch_add(p, v, __ATOMIC_RELAXED, __HIP_MEMORY_SCOPE_AGENT); }
__device__ __forceinline__ unsigned xb_xcc_id() { return (unsigned)__builtin_amdgcn_s_getreg((3 << 11) | 20) & 0xFu; }
#define XB_SPIN(cond, bar) do { unsigned _sp = 0; while (cond) { __builtin_amdgcn_s_sleep(1); \
    if ((++_sp & 255u) == 0u) { if (xb_ld(&(bar)[XB_TMO])) break; if (_sp > XB_SPIN_CAP) { atomicAdd(&(bar)[XB_TMO], 1u); break; } } } } while (0)

struct XcdBarrier {
    unsigned* bar; unsigned x;
    volatile LAS unsigned* st;
};

__device__ __forceinline__ XcdBarrier xcd_barrier_post(unsigned* bar, volatile LAS unsigned* st) {
    XcdBarrier b; b.bar = bar; b.x = xb_xcc_id(); b.st = st;
    if (threadIdx.x == 0) (void)xb_add(&bar[XB_XCNT(b.x)], 1u);
    return b;
}
__device__ __forceinline__ void xcd_barrier_complete(unsigned* bar, unsigned x, unsigned& nloc, unsigned& nx) {
    const unsigned G = gridDim.x * gridDim.y * gridDim.z;
    unsigned sum, cnt, mine, sp = 0u;
    for (;;) {
        sum = 0u; cnt = 0u; mine = 0u;
#pragma unroll
        for (unsigned j = 0; j < 16; ++j) { const unsigned c = xb_ld(&bar[XB_XCNT(j)]); sum += c; cnt += (c > 0u) ? 1u : 0u; mine = (j == x) ? c : mine; }
        if (sum == G) break;
        __builtin_amdgcn_s_sleep(1);
        if ((++sp & 255u) == 0u) { if (xb_ld(&bar[XB_TMO])) break; if (sp > XB_SPIN_CAP) { atomicAdd(&bar[XB_TMO], 1u); break; } }
    }
    nloc = mine > 0u ? mine : 1u; nx = cnt > 0u ? cnt : 1u;
}

__device__ __forceinline__ void xcd_barrier(const XcdBarrier& b) {
    asm volatile("s_waitcnt vmcnt(0)" ::: "memory");
    __syncthreads();
    if (threadIdx.x == 0) {
        unsigned* bar = b.bar;
        __builtin_amdgcn_s_waitcnt(0);
        unsigned nloc = b.st[0], nx = b.st[1];
        if (nloc == 0u) { xcd_barrier_complete(bar, b.x, nloc, nx); b.st[0] = nloc; b.st[1] = nx; }
        const unsigned old = xb_add(&bar[XB_XSUB(b.x)], 1u);
        const unsigned gen = old / nloc;
        if (old + 1u == (gen + 1u) * nloc) {
            __builtin_amdgcn_fence(__ATOMIC_RELEASE, "agent");
            asm volatile("s_waitcnt vmcnt(0)" ::: "memory");
            const unsigned og = xb_add(&bar[XB_TOP], 1u);
            const unsigned tg = og / nx;
            if (og + 1u == (tg + 1u) * nx) xb_add(&bar[XB_TOPGEN], 1u);
            else XB_SPIN(xb_ld(&bar[XB_TOPGEN]) == tg, bar);
            __builtin_amdgcn_fence(__ATOMIC_ACQUIRE, "agent");
            xb_add(&bar[XB_XGEN(b.x)], 1u);
            asm volatile("s_waitcnt vmcnt(0)" ::: "memory");
        } else {
            XB_SPIN(xb_ld(&bar[XB_XGEN(b.x)]) == gen, bar);
            __builtin_amdgcn_fence(__ATOMIC_ACQUIRE, "agent");
            asm volatile("s_waitcnt vmcnt(0)" ::: "memory");
        }
    }
    __syncthreads();
}
struct GA {
    const bf16_t* a0; const bf16_t* a1;
    int ld0, ld1, ksplit;
    const int* list;
    int nrows;
    int mode;
    int row0;
};
constexpr int G_LDT = 40;
constexpr int GEMM_LDS = (2 * 256 * G_LDT + 2 * 128 * G_LDT) * 2;

template <class Epi>
__device__ __forceinline__ void gemm_tile(unsigned char* lds, const GA& ga, const bf16_t* __restrict__ Bt, int K, int mt, int nt, const Epi& epi) {
    const int tid = otid(), lane = tid & 63, wid = __builtin_amdgcn_readfirstlane(tid >> 6), wm = wid >> 1, wn = wid & 1, fr = lane & 15, fq = lane >> 4;
    bf16_t* sA = (bf16_t*)lds;
    bf16_t* sB = sA + 2 * 256 * G_LDT;
    const int kp = tid & 3;
    const int r0 = tid >> 2, r1 = r0 + 128;
    int s0, s1;
    {
        int lr = mt * 256 + r0; if (lr >= ga.nrows) lr = 0;
        s0 = ga.list ? ga.list[lr] : (ga.mode == 1 ? (lr >> 11) * TT + CTXL + (lr & 2047) : ga.row0 + lr);
        lr = mt * 256 + r1; if (lr >= ga.nrows) lr = 0;
        s1 = ga.list ? ga.list[lr] : (ga.mode == 1 ? (lr >> 11) * TT + CTXL + (lr & 2047) : ga.row0 + lr);
    }
    const bf16_t* pa00 = ga.a0 + (size_t)s0 * ga.ld0 + kp * 8;
    const bf16_t* pa01 = ga.a0 + (size_t)s1 * ga.ld0 + kp * 8;
    const bf16_t* pa10 = ga.a1 ? ga.a1 + (size_t)s0 * ga.ld1 + kp * 8 : pa00;
    const bf16_t* pa11 = ga.a1 ? ga.a1 + (size_t)s1 * ga.ld1 + kp * 8 : pa01;
    const bf16_t* pb = Bt + (size_t)(nt * 128 + r0) * K + kp * 8;
    const int ksplit = ga.ksplit;
    f32x4 acc[4][4];
#pragma unroll
    for (int i = 0; i < 4; ++i)
#pragma unroll
        for (int j = 0; j < 4; ++j) acc[i][j] = (f32x4){0.f, 0.f, 0.f, 0.f};
    const int nk = K >> 5;
    u32x4 ra0, ra1, rb;
    {
        ra0 = *(const u32x4*)(pa00); ra1 = *(const u32x4*)(pa01); rb = *(const u32x4*)(pb);
        if (0 >= ksplit) { ra0 = *(const u32x4*)(pa10); ra1 = *(const u32x4*)(pa11); }
    }
    *(u32x4*)(sA + (r0) * G_LDT + kp * 8) = ra0;
    *(u32x4*)(sA + (r1) * G_LDT + kp * 8) = ra1;
    *(u32x4*)(sB + (r0) * G_LDT + kp * 8) = rb;
    __syncthreads();
    for (int kt = 0; kt < nk; ++kt) {
        const int cur = kt & 1;
        if (kt + 1 < nk) {
            const int k0 = (kt + 1) << 5;
            if (k0 < ksplit) { ra0 = *(const u32x4*)(pa00 + k0); ra1 = *(const u32x4*)(pa01 + k0); }
            else { ra0 = *(const u32x4*)(pa10 + (k0 - ksplit)); ra1 = *(const u32x4*)(pa11 + (k0 - ksplit)); }
            rb = *(const u32x4*)(pb + k0);
        }
        const bf16_t* cA = sA + cur * 256 * G_LDT;
        const bf16_t* cB = sB + cur * 128 * G_LDT;
        bf16x8 af[4], bfr[4];
#pragma unroll
        for (int i = 0; i < 4; ++i) af[i] = ldfrag(cA, G_LDT, wm * 64 + i * 16, 0, fr, fq);
#pragma unroll
        for (int j = 0; j < 4; ++j) bfr[j] = ldfrag(cB, G_LDT, wn * 64 + j * 16, 0, fr, fq);
#pragma unroll
        for (int i = 0; i < 4; ++i)
#pragma unroll
            for (int j = 0; j < 4; ++j) acc[i][j] = mma16(bfr[j], af[i], acc[i][j]);
        if (kt + 1 < nk) {
            const int nb = cur ^ 1;
            *(u32x4*)(sA + (nb * 256 + r0) * G_LDT + kp * 8) = ra0;
            *(u32x4*)(sA + (nb * 256 + r1) * G_LDT + kp * 8) = ra1;
            *(u32x4*)(sB + (nb * 128 + r0) * G_LDT + kp * 8) = rb;
        }
        __syncthreads();
    }
    epi(acc, mt * 256 + wm * 64, nt * 128 + wn * 64, fr, fq);
}

struct EpiBf {
    bf16_t* out; int ld, nrows, ncols;
    __device__ __forceinline__ void operator()(const f32x4 (&acc)[4][4], int rb, int cb, int fr, int fq) const {
#pragma unroll
        for (int i = 0; i < 4; ++i) { const int lr = rb + i * 16 + fr; if (lr < nrows) {
#pragma unroll
            for (int j = 0; j < 4; ++j) { const int col = cb + j * 16 + fq * 4; if (col < ncols) st4bf(out + (size_t)lr * ld + col, acc[i][j]); } } }
    }
};
struct EpiSwiglu {
    bf16_t* out; int nrows;
    __device__ __forceinline__ void operator()(const f32x4 (&acc)[4][4], int rb, int cb, int fr, int fq) const {
#pragma unroll
        for (int i = 0; i < 4; ++i) { const int lr = rb + i * 16 + fr; if (lr < nrows) {
#pragma unroll
            for (int j = 0; j < 2; ++j) { const int col = (cb >> 1) + j * 16 + fq * 4; f32x4 g = acc[i][j], u = acc[i][j + 2], o;
#pragma unroll
                for (int r = 0; r < 4; ++r) o[r] = siluf_(g[r]) * u[r];
                st4bf(out + (size_t)lr * 512 + col, o); } } }
    }
};

namespace pg8 {
#define PG8_LAS __attribute__((address_space(3)))
typedef unsigned short bf16_t;
typedef short bf16x8 __attribute__((ext_vector_type(8)));
typedef float f32x4 __attribute__((ext_vector_type(4)));
typedef unsigned u32x4 __attribute__((ext_vector_type(4)));
constexpr int BM = 256, BK = 64, HALF = 128, HTB = HALF * BK * 2  , STAGE_BYTES = 8 * HTB, NXCD = 8, WGM = 8;

__host__ __device__ __forceinline__ int lds_byte(int r, int c) { const int st = (r >> 4) * 2 + (c >> 5), rr = r & 15, cc = c & 31, ob = rr * 64 + cc * 2; return st * 1024 + (ob ^ (((ob >> 9) & 1) << 5)); }
__host__ __device__ __forceinline__ void stage_rc(int b, int& R, int& C) { const int st = b / 1024, sb = b % 1024, swz = sb ^ (((sb >> 9) & 1) << 5); R = (st >> 1) * 16 + swz / 64; C = (st & 1) * 32 + (swz % 64) / 2; }
__host__ __device__ __forceinline__ int perm32(int rho) { const int n = rho >> 4, i = rho & 15; return 8 * (i >> 2) + 4 * n + (i & 3); }

struct Unit { int pm, pn; };
struct Gemm { const bf16_t* A; const bf16_t* Bt; int M, N, K; const bf16_t* A2; int pm_split; };
#define PG8_ABASE(g, pm) ((pm) < (g).pm_split ? (const char*)(g).A + (size_t)(pm) * tstep : (const char*)(g).A2 + (size_t)((pm) - (g).pm_split) * tstep)
struct StaticOrder {
    int nM, nN, nwg, G, c;
    __host__ __device__ void init(int M, int N, int G_, int c_) { nM = M / BM; nN = N / BM; nwg = nM * nN; G = G_; c = c_; }
    __host__ __device__ bool next(int i, Unit& u) const {
        const long L = (long)i * G + c; if (L >= nwg) return false;
        int wgid = (int)L; { const int q = nwg / NXCD, r = nwg % NXCD, xcd = wgid % NXCD, off = wgid / NXCD; wgid = (xcd < r ? xcd * (q + 1) : r * (q + 1) + (xcd - r) * q) + off; }
        const int nig = WGM * nN, gid = wgid / nig, fm = gid * WGM, gsz = (nM - fm) < WGM ? (nM - fm) : WGM;
        u.pm = fm + ((wgid % nig) % gsz); u.pn = (wgid % nig) / gsz; return true;
    }
    __device__ __forceinline__ void a_ready(const Unit&) const {}
    __device__ __forceinline__ void done(const Unit&) const {}
};
__device__ __forceinline__ unsigned cvt_pk_bf16(float lo, float hi) { unsigned r; asm volatile("v_cvt_pk_bf16_f32 %0, %1, %2" : "=v"(r) : "v"(lo), "v"(hi)); return r; }
typedef float f32x2 __attribute__((ext_vector_type(2)));
template <class Epi, class Sched, bool STAMP = false>
__device__ __forceinline__ void gemm_phase(PG8_LAS unsigned char* lds, const Gemm g, const Sched& S, const Epi& E, unsigned long long* stamps) {
    const int tid = otid(), wid = __builtin_amdgcn_readfirstlane(tid >> 6), lane = tid & 63, wr = wid >> 2, wc = wid & 3, fr = lane & 15, fq = lane >> 4;
    const int K = g.K, nt = K / BK;
    int ts_lo = 0, ts_hi = 0, nts = 0; const unsigned long long rt_entry = STAMP ? (unsigned long long)wall_clock64() : 0ull;
#define PG8_STAMP() do { if (STAMP && wid == 0 && nts < 64) { const unsigned long long _c = (unsigned long long)clock64(); \
        ts_lo = (lane == nts) ? (int)(unsigned)_c : ts_lo; ts_hi = (lane == nts) ? (int)(unsigned)(_c >> 32) : ts_hi; ++nts; } } while (0)
    PG8_STAMP();
    unsigned voffA[2], voffB[2];
#pragma unroll
    for (int i = 0; i < 2; ++i) { int R, C; stage_rc(tid * 16 + i * 8192, R, C); const int Rb = Epi::PERM ? ((R & ~31) + perm32(R & 31)) : R;
        voffA[i] = (unsigned)(R * K + C) * 2u; voffB[i] = (unsigned)(Rb * K + C) * 2u; }
    const size_t kstep = (size_t)(BK * 2);
    const size_t hstep = (size_t)HALF * K * 2;
    const size_t tstep = 2 * hstep;
    const unsigned ldsw = (unsigned)wid * 1024u;
    const int aoff = lds_byte(wr * 64 + fr, fq * 8), boff = lds_byte(wc * 32 + fr, fq * 8);
#define PG8_SA(b, h) (((b) * 2 + (h)) * HTB)
#define PG8_SB(b, h) ((4 + (b) * 2 + (h)) * HTB)
#define PG8_STAGE(bufoff, gbase, voff) do { _Pragma("unroll") for (int _i = 0; _i < 2; ++_i) \
        __builtin_amdgcn_global_load_lds((const unsigned*)((const char*)(gbase) + (voff)[_i]), (PG8_LAS unsigned*)(lds + (bufoff) + ldsw + _i * 8192), 16, 0, 0); } while (0)
#define PG8_LDA(dst, b, h) do { _Pragma("unroll") for (int m = 0; m < 4; ++m) _Pragma("unroll") for (int k = 0; k < 2; ++k) dst[m][k] = *(const PG8_LAS bf16x8*)(lds + PG8_SA(b, h) + aoff + m * 2048 + k * 1024); } while (0)
#define PG8_LDB(dst, b, h) do { _Pragma("unroll") for (int n = 0; n < 2; ++n) _Pragma("unroll") for (int k = 0; k < 2; ++k) dst[n][k] = *(const PG8_LAS bf16x8*)(lds + PG8_SB(b, h) + boff + n * 2048 + k * 1024); } while (0)
#define PG8_MMA(ai, bj, At, Bt) do { __builtin_amdgcn_s_setprio(1); _Pragma("unroll") for (int m = 0; m < 4; ++m) _Pragma("unroll") for (int n = 0; n < 2; ++n) _Pragma("unroll") for (int k = 0; k < 2; ++k) \
        acc[ai][bj][m][n] = __builtin_amdgcn_mfma_f32_16x16x32_bf16(Bt[n][k], At[m][k], acc[ai][bj][m][n], 0, 0, 0); __builtin_amdgcn_s_setprio(0); } while (0)
#define PG8_WAIT_V(n) asm volatile("s_waitcnt vmcnt(" #n ")" ::: "memory")
#define PG8_WAIT_L(n) asm volatile("s_waitcnt lgkmcnt(" #n ")" ::: "memory")
#define PG8_BAR __builtin_amdgcn_s_barrier()
#define PG8_SCHED __builtin_amdgcn_sched_barrier(0)
    Unit cur, nxt; int ui = 0;
    if (!S.next(0, cur)) return;
    f32x4 acc[2][2][4][2];
#pragma unroll
    for (int a = 0; a < 2; ++a)
#pragma unroll
        for (int b = 0; b < 2; ++b)
#pragma unroll
            for (int m = 0; m < 4; ++m)
#pragma unroll
                for (int n = 0; n < 2; ++n) acc[a][b][m][n] = (f32x4){0.f, 0.f, 0.f, 0.f};
    bf16x8 At[4][2], B0[2][2], B1[2][2];
    const char* cA = PG8_ABASE(g, cur.pm); const char* cB = (const char*)g.Bt + (size_t)cur.pn * tstep;
    S.a_ready(cur);
    PG8_STAGE(PG8_SB(0, 0), cB, voffB); PG8_STAGE(PG8_SA(0, 0), cA, voffA); PG8_STAGE(PG8_SB(0, 1), cB + hstep, voffB); PG8_STAGE(PG8_SA(0, 1), cA + hstep, voffA);
    if (wr == 1) PG8_BAR;
    PG8_WAIT_V(4); PG8_BAR;
    PG8_STAGE(PG8_SB(1, 0), cB + kstep, voffB); PG8_STAGE(PG8_SA(1, 0), cA + kstep, voffA); PG8_STAGE(PG8_SB(1, 1), cB + hstep + kstep, voffB);
    PG8_WAIT_V(6); PG8_BAR;
    PG8_STAMP();
    for (;;) {
        const bool has_next = S.next(ui + 1, nxt);
        const char* nA = has_next ? PG8_ABASE(g, nxt.pm) : cA; const char* nB = has_next ? (const char*)g.Bt + (size_t)nxt.pn * tstep : cB;
        for (int t = 0; t < nt; t += 2) {
            const bool last = (t == nt - 2);
            const char* a1 = cA + (size_t)(t + 1) * kstep;
            const char* a2 = last ? nA : cA + (size_t)(t + 2) * kstep; const char* b2 = last ? nB : cB + (size_t)(t + 2) * kstep;
            const char* a3 = a2 + kstep; const char* b3 = b2 + kstep;
            if (last && has_next) S.a_ready(nxt);
            PG8_LDB(B0, 0, 0); PG8_SCHED; PG8_LDA(At, 0, 0); PG8_STAGE(PG8_SA(1, 1), a1 + hstep, voffA);
            PG8_WAIT_L(8); PG8_BAR; PG8_WAIT_L(0); PG8_MMA(0, 0, At, B0); PG8_BAR; PG8_SCHED;
            PG8_LDB(B1, 0, 1); PG8_STAGE(PG8_SB(0, 0), b2, voffB);
            PG8_BAR; PG8_WAIT_L(0); PG8_MMA(0, 1, At, B1); PG8_BAR;
            PG8_LDA(At, 0, 1); PG8_STAGE(PG8_SA(0, 0), a2, voffA);
            PG8_BAR; PG8_WAIT_L(0); PG8_MMA(1, 0, At, B0); PG8_BAR; PG8_SCHED;
            PG8_STAGE(PG8_SB(0, 1), b2 + hstep, voffB);
            PG8_WAIT_V(6); PG8_BAR; PG8_MMA(1, 1, At, B1); PG8_BAR;
            PG8_LDB(B0, 1, 0); PG8_SCHED; PG8_LDA(At, 1, 0); PG8_STAGE(PG8_SA(0, 1), a2 + hstep, voffA);
            PG8_WAIT_L(8); PG8_BAR; PG8_WAIT_L(0); PG8_MMA(0, 0, At, B0); PG8_BAR; PG8_SCHED;
            PG8_LDB(B1, 1, 1); PG8_STAGE(PG8_SB(1, 0), b3, voffB);
            PG8_BAR; PG8_WAIT_L(0); PG8_MMA(0, 1, At, B1); PG8_BAR;
            PG8_LDA(At, 1, 1); PG8_STAGE(PG8_SA(1, 0), a3, voffA);
            PG8_BAR; PG8_WAIT_L(0); PG8_MMA(1, 0, At, B0); PG8_BAR; PG8_SCHED;
            PG8_STAGE(PG8_SB(1, 1), b3 + hstep, voffB);
            PG8_WAIT_V(6); PG8_BAR; PG8_MMA(1, 1, At, B1); PG8_BAR;
        }
        PG8_STAMP();
        if constexpr (!Epi::AFTER_DRAIN) { E(acc, cur, wr, wc, fr, fq); S.done(cur); }
        PG8_STAMP();
        if (!has_next) break;
#pragma unroll
        for (int a = 0; a < 2; ++a)
#pragma unroll
            for (int b = 0; b < 2; ++b)
#pragma unroll
                for (int m = 0; m < 4; ++m)
#pragma unroll
                    for (int n = 0; n < 2; ++n) acc[a][b][m][n] = (f32x4){0.f, 0.f, 0.f, 0.f};
        cur = nxt; cA = nA; cB = nB; ++ui;
    }
    PG8_WAIT_V(0);
    if (wr == 0) PG8_BAR;
    PG8_BAR;
    if constexpr (Epi::AFTER_DRAIN) { E.fused(acc, cur, wr, wc, fr, fq, lds, wid, lane); S.done(cur); }
    PG8_STAMP();
    if (STAMP && wid == 0) { stamps[lane] = lane < nts ? (((unsigned long long)(unsigned)ts_hi << 32) | (unsigned)ts_lo) : 0ull;
        if (lane == 62) stamps[62] = rt_entry; if (lane == 63) stamps[63] = (unsigned long long)wall_clock64(); }
#undef PG8_STAMP
#undef PG8_SA
#undef PG8_SB
#undef PG8_STAGE
#undef PG8_LDA
#undef PG8_LDB
#undef PG8_MMA
#undef PG8_WAIT_V
#undef PG8_WAIT_L
#undef PG8_BAR
#undef PG8_SCHED
}
}
namespace pg8 {
struct EpiBfG {
    static constexpr bool PERM = true, AFTER_DRAIN = false;
    bf16_t* O; int ldc, ncols, pn_mask;
    __device__ __forceinline__ void operator()(const f32x4 (&acc)[2][2][4][2], const Unit& u, int wr, int wc, int fr, int fq) const {
        const int row0 = u.pm * BM + wr * 64 + fr, col0 = (u.pn & pn_mask) * BM + wc * 32 + 8 * fq;
#pragma unroll
        for (int ai = 0; ai < 2; ++ai)
#pragma unroll
            for (int m = 0; m < 4; ++m) { bf16_t* rowp = O + (size_t)(row0 + ai * HALF + m * 16) * ldc;
#pragma unroll
                for (int bj = 0; bj < 2; ++bj) { const int c = col0 + bj * HALF;
                    if (c < ncols) { const f32x4 v0 = acc[ai][bj][m][0], v1 = acc[ai][bj][m][1];
                        u32x4 w; w.x = cvt_pk_bf16(v0[0], v0[1]); w.y = cvt_pk_bf16(v0[2], v0[3]); w.z = cvt_pk_bf16(v1[0], v1[1]); w.w = cvt_pk_bf16(v1[2], v1[3]);
                        *(u32x4*)(rowp + c) = w; } } }
    }
};
struct EpiSwi {
    static constexpr bool PERM = true, AFTER_DRAIN = false;
    bf16_t* H;
    __device__ __forceinline__ void operator()(const f32x4 (&acc)[2][2][4][2], const Unit& u, int wr, int wc, int fr, int fq) const {
        const int row0 = u.pm * BM + wr * 64 + fr, hc0 = (u.pn & 3) * HALF + wc * 32 + 8 * fq;
#pragma unroll
        for (int ai = 0; ai < 2; ++ai)
#pragma unroll
            for (int m = 0; m < 4; ++m) { bf16_t* rowp = H + (size_t)(row0 + ai * HALF + m * 16) * 512 + hc0;
                float o[8];
#pragma unroll
                for (int n = 0; n < 2; ++n)
#pragma unroll
                    for (int r = 0; r < 4; ++r) { const float g = acc[ai][0][m][n][r]; o[n * 4 + r] = g * __builtin_amdgcn_rcpf(1.0f + __expf(-g)) * acc[ai][1][m][n][r]; }
                u32x4 w; w.x = cvt_pk_bf16(o[0], o[1]); w.y = cvt_pk_bf16(o[2], o[3]); w.z = cvt_pk_bf16(o[4], o[5]); w.w = cvt_pk_bf16(o[6], o[7]);
                *(u32x4*)rowp = w; }
    }
};
struct MoeOrder {
    const int* slotmap; int ntiles, G, c;
    __device__ __forceinline__ bool next(int i, Unit& u) const {
        const int L = i * G + c; if (L >= ntiles * 4) return false;
        u.pm = L >> 2; u.pn = __builtin_amdgcn_readfirstlane(slotmap[L >> 2]) * 4 + (L & 3); return true;
    }
    __device__ __forceinline__ void a_ready(const Unit&) const {}
    __device__ __forceinline__ void done(const Unit&) const {}
};
}
#define WSP(T, off) as_global((T*)(kp.ws + (off)))
#define KIN(i) as_global(kp.in[i])
#define KOUT as_global(kp.out)

PHASE_FN void phase_mod(const KP& kp, unsigned char* lds) {
    float* sc = (float*)lds;
    float* red = sc + 17 * 1024;
    float* modv = WSP(float, WS_MODV);
    const int tid = otid();
    for (int i = tid; i < 17 * 1024; i += 512) { const int bb = i >> 10, k = i & 1023; const float c = bb < 16 ? KIN(1)[bb * 1024 + k] : KIN(3)[k]; sc[i] = siluf_(c); }
    __syncthreads();
    const int jc = tid & 63, ks = tid >> 6;
    for (int u = obid(); u < 192; u += gridDim.x) {
        const int l = u / 96, j0 = (u % 96) * 64;
        const float* w = KIN(4) + (size_t)l * 1024 * 6144 + j0 + jc;
        float acc[17];
#pragma unroll
        for (int bb = 0; bb < 17; ++bb) acc[bb] = 0.f;
        for (int k = ks * 128; k < ks * 128 + 128; ++k) {
            const float wv = w[(size_t)k * 6144];
#pragma unroll
            for (int bb = 0; bb < 17; ++bb) acc[bb] += sc[bb * 1024 + k] * wv;
        }
#pragma unroll
        for (int bb = 0; bb < 17; ++bb) red[(ks * 17 + bb) * 64 + jc] = acc[bb];
        __syncthreads();
        for (int i = tid; i < 17 * 64; i += 512) {
            const int bb = i >> 6, j = i & 63; float s = KIN(5)[l * 6144 + j0 + j];
#pragma unroll
            for (int k2 = 0; k2 < 8; ++k2) s += red[(k2 * 17 + bb) * 64 + j];
            modv[((size_t)l * 17 + bb) * 6144 + j0 + j] = s;
        }
        __syncthreads();
    }
}

struct CvJob { const float* src; bf16_t* dst; int N, ldd, mode, kt, ntile; };
__device__ __forceinline__ bool cv_pick(int& u, CvJob& J, const float* src, int K, int N, bf16_t* dst, int mode = 0, int ldd = -1) {
    const int ntl = (N + 63) >> 6, cnt = ntl * (K >> 6);
    if (u < cnt) { J.src = src; J.dst = dst; J.N = N; J.ldd = ldd < 0 ? K : ldd; J.mode = mode; J.kt = u / ntl; J.ntile = u % ntl; return true; }
    u -= cnt; return false;
}
__device__ __forceinline__ void cv_load(const CvJob& J, int tid, f32x4 (&r)[2]) {
#pragma unroll
    for (int i = 0; i < 2; ++i) { const int idx = tid + i * 512, k = idx >> 4, n0 = J.ntile * 64 + (idx & 15) * 4;
        r[i] = (n0 < J.N) ? *(const f32x4*)(J.src + (size_t)(J.kt * 64 + k) * J.N + n0) : (f32x4){0.f, 0.f, 0.f, 0.f}; }
}
__device__ __forceinline__ void cv_put(float* tile, int tid, const f32x4 (&r)[2]) {
#pragma unroll
    for (int i = 0; i < 2; ++i) { const int idx = tid + i * 512, k = idx >> 4, nq = (idx & 15) * 4;
        tile[k * 65 + nq] = r[i][0]; tile[k * 65 + nq + 1] = r[i][1]; tile[k * 65 + nq + 2] = r[i][2]; tile[k * 65 + nq + 3] = r[i][3]; }
}
__device__ __forceinline__ void cv_store(const float* tile, const CvJob& J, int tid) {
    const int nl = tid >> 3, k8 = tid & 7, n = J.ntile * 64 + nl;
    if (n < J.N) { int row = n; if (J.mode) row = (n >> 7) * 256 + (n & 127) + (J.mode == 2 ? 128 : 0);
        u32x4 w; const float* tp = tile + (k8 * 8) * 65 + nl;
        w.x = pack2(tp[0], tp[65]); w.y = pack2(tp[130], tp[195]); w.z = pack2(tp[260], tp[325]); w.w = pack2(tp[390], tp[455]);
        *(u32x4*)(J.dst + (size_t)row * J.ldd + J.kt * 64 + k8 * 8) = w; }
}
#define CV_RUN(total, PICK) do { float* tile = (float*)lds; const int tid = otid(); const int G_ = gridDim.x; int u_ = obid(); CvJob J, Jn; f32x4 r[2]; \
        if (u_ < (total)) { int u = u_; PICK(u, J); cv_load(J, tid, r); } \
        while (u_ < (total)) { cv_put(tile, tid, r); __syncthreads(); const int un_ = u_ + G_; \
            if (un_ < (total)) { int u = un_; PICK(u, Jn); cv_load(Jn, tid, r); } \
            cv_store(tile, J, tid); __syncthreads(); u_ = un_; J = Jn; } } while (0)
PHASE_FN void phase_conv_ab(const KP& kp, unsigned char* lds) {
#define PICK_AB(u, J) do { if (!cv_pick(u, J, KIN(7), 1024, AB_N, WSP(bf16_t, WS_WMIX + WM_AB_IN))) cv_pick(u, J, KIN(8), 2048, 1024, WSP(bf16_t, WS_WMIX + WM_AB_OUT)); } while (0)
    CV_RUN(16 * 85 + 32 * 16, PICK_AB);
#undef PICK_AB
}
PHASE_FN void phase_conv_cd(const KP& kp, unsigned char* lds) {
#define PICK_CD(u, J) do { if (cv_pick(u, J, KIN(18), 1024, CD_N, WSP(bf16_t, WS_WMIX + WM_CD_IN))) break; \
        if (cv_pick(u, J, KIN(19), 1536, 1024, WSP(bf16_t, WS_WMIX + WM_CD_OUT))) break; \
        if (cv_pick(u, J, KIN(21), 384, 768, WSP(bf16_t, WS_WMIX + WM_UQ))) break; \
        if (cv_pick(u, J, KIN(23), 256, 1024, WSP(bf16_t, WS_WMIX + WM_UKV))) break; \
        cv_pick(u, J, KIN(29), 128, 1024, WSP(bf16_t, WS_WMIX + WM_G2)); } while (0)
    CV_RUN(16 * 65 + 24 * 16 + 6 * 12 + 4 * 16 + 2 * 16, PICK_CD);
#undef PICK_CD
}
PHASE_FN void phase_conv_moe(const KP& kp, unsigned char* lds, int l) {
#define PICK_MOE(u0, J) do { const int es = (u0) / 384; int uu = (u0) % 384; \
        const float* wg = es < 16 ? KIN(36) + ((size_t)l * 16 + es) * 1024 * 512 : KIN(39) + (size_t)l * 1024 * 512; \
        const float* wu = es < 16 ? KIN(37) + ((size_t)l * 16 + es) * 1024 * 512 : KIN(40) + (size_t)l * 1024 * 512; \
        const float* wd = es < 16 ? KIN(38) + ((size_t)l * 16 + es) * 512 * 1024 : KIN(41) + (size_t)l * 512 * 1024; \
        bf16_t* dup = WSP(bf16_t, WS_BIG + MO_WUP) + (size_t)es * 1024 * 1024; bf16_t* ddn = WSP(bf16_t, WS_BIG + MO_WDN) + (size_t)es * 1024 * 512; \
        if (cv_pick(uu, J, wg, 1024, 512, dup, 1, 1024)) break; if (cv_pick(uu, J, wu, 1024, 512, dup, 2, 1024)) break; cv_pick(uu, J, wd, 512, 1024, ddn, 0, 512); } while (0)
    CV_RUN(17 * 384, PICK_MOE);
#undef PICK_MOE
}

__device__ __forceinline__ const float* hrow_rd(const KP& kp, bool from_inputs, int b, int t) {
    if (t < CTXL) return (from_inputs ? KIN(2) : WSP(const float, WS_HC)) + ((size_t)b * CTXL + t) * D;
    return (from_inputs ? KIN(0) : KOUT) + ((size_t)b * SEQ + (t - CTXL)) * D;
}
__device__ __forceinline__ float* hrow_wr(const KP& kp, int b, int t) {
    if (t < CTXL) return WSP(float, WS_HC) + ((size_t)b * CTXL + t) * D;
    return KOUT + ((size_t)b * SEQ + (t - CTXL)) * D;
}

PHASE_FN void phase_u(const KP& kp, int layer, int g) {
    const int lane = otid() & 63, wid = __builtin_amdgcn_readfirstlane(otid() >> 6);
    const float* modv = WSP(const float, WS_MODV) + (size_t)layer * 17 * 6144;
    const float* ng = KIN(6) + (size_t)layer * 4 * 1024;
    bf16_t* U = WSP(bf16_t, WS_BIG + (layer == 0 ? L0_U : L1_U));
    for (int lr = obid() * 8 + wid; lr < RG; lr += gridDim.x * 8) {
        const int bl = lr / TT, t = lr - bl * TT, b = g * BG + bl;
        const float* src = hrow_rd(kp, layer == 0, b, t);
        const float* mv = modv + (size_t)(t < CTXL ? 16 : b) * 6144;
        f32x4 x[4]; float ss = 0.f;
#pragma unroll
        for (int i = 0; i < 4; ++i) { x[i] = *(const f32x4*)(src + i * 256 + lane * 4); ss += x[i][0] * x[i][0] + x[i][1] * x[i][1] + x[i][2] * x[i][2] + x[i][3] * x[i][3]; }
        ss = wsum(ss); const float rstd = rsqrtf(ss * (1.0f / 1024.0f) + EPS);
#pragma unroll
        for (int i = 0; i < 4; ++i) { const int col = i * 256 + lane * 4;
            const f32x4 gv = *(const f32x4*)(ng + col), sc = *(const f32x4*)(mv + 1024 + col), sh = *(const f32x4*)(mv + col);
            st4bf(U + (size_t)lr * 1024 + col, x[i] * rstd * gv * (sc + 1.0f) + sh); }
    }
}

PHASE_FN void phase_r(const KP& kp, unsigned char* lds, int layer, int g) {
    const int tid = otid(), lane = tid & 63, wid = __builtin_amdgcn_readfirstlane(tid >> 6);
    float* rw = (float*)lds;
    int* se = (int*)(rw + 1024 * 16);
    int* sbase = se + 160;
    for (int i = tid; i < 1024 * 16; i += 512) rw[i] = KIN(34)[i];
    __syncthreads();
    const float* modv = WSP(const float, WS_MODV) + (size_t)layer * 17 * 6144;
    const float* ng = KIN(6) + (size_t)layer * 4 * 1024;
    const bf16_t* MIX = WSP(const bf16_t, WS_BIG + (layer == 0 ? L0_U : L1_U));
    bf16_t* V = WSP(bf16_t, WS_V);
    unsigned* cnt = WSP(unsigned, CTL_CNT) + layer * 16;
    int* TOKE = WSP(int, WS_TOKE); int* TOKP = WSP(int, WS_TOKP); float* TOKW = WSP(float, WS_TOKW); int* LIST = WSP(int, WS_LIST);
    const int nrows = layer == 0 ? RG : RGL, CH = layer == 0 ? 72 : 64, RW = CH >> 3, nchunks = nrows / CH;
    float rbias[16];
#pragma unroll
    for (int e = 0; e < 16; ++e) rbias[e] = KIN(35)[e];
    for (int ch = obid(); ch < nchunks; ch += gridDim.x) {
        for (int rr = 0; rr < RW; ++rr) {
            const int rl = wid * RW + rr, lr = ch * CH + rl;
            int b, t, tok;
            if (layer == 0) { const int bl = lr / TT; t = lr - bl * TT; b = g * BG + bl; tok = g * RG + lr; }
            else { const int bl = lr >> 11; t = CTXL + (lr & 2047); b = g * BG + bl; tok = g * RGL + lr; }
            const float* hsrc = hrow_rd(kp, layer == 0, b, t);
            float* hdst = hrow_wr(kp, b, t);
            const float* mv = modv + (size_t)(t < CTXL ? 16 : b) * 6144;
            f32x4 y[4], h[4]; float ss = 0.f;
#pragma unroll
            for (int i = 0; i < 4; ++i) { y[i] = ld4bf(MIX + (size_t)lr * 1024 + i * 256 + lane * 4); ss += y[i][0] * y[i][0] + y[i][1] * y[i][1] + y[i][2] * y[i][2] + y[i][3] * y[i][3]; }
            ss = wsum(ss); float rstd = rsqrtf(ss * (1.0f / 1024.0f) + EPS);
            float s2 = 0.f;
#pragma unroll
            for (int i = 0; i < 4; ++i) { const int col = i * 256 + lane * 4;
                const f32x4 g1 = *(const f32x4*)(ng + 1024 + col), ga = *(const f32x4*)(mv + 2048 + col), hx = *(const f32x4*)(hsrc + col);
                h[i] = hx + ga * (y[i] * rstd * g1);
                *(f32x4*)(hdst + col) = h[i];
                s2 += h[i][0] * h[i][0] + h[i][1] * h[i][1] + h[i][2] * h[i][2] + h[i][3] * h[i][3]; }
            s2 = wsum(s2); rstd = rsqrtf(s2 * (1.0f / 1024.0f) + EPS);
            float lg[16];
#pragma unroll
            for (int e = 0; e < 16; ++e) lg[e] = 0.f;
#pragma unroll
            for (int i = 0; i < 4; ++i) { const int col = i * 256 + lane * 4;
                const f32x4 g2 = *(const f32x4*)(ng + 2048 + col), scf = *(const f32x4*)(mv + 4096 + col), shf = *(const f32x4*)(mv + 3072 + col);
                const f32x4 v = h[i] * rstd * g2 * (scf + 1.0f) + shf;
                st4bf(V + (size_t)tok * 1024 + col, v);
#pragma unroll
                for (int j = 0; j < 4; ++j) {
#pragma unroll
                    for (int q = 0; q < 4; ++q) { const f32x4 w4 = *(const f32x4*)(rw + (col + j) * 16 + q * 4);
                        lg[q * 4 + 0] += v[j] * w4[0]; lg[q * 4 + 1] += v[j] * w4[1]; lg[q * 4 + 2] += v[j] * w4[2]; lg[q * 4 + 3] += v[j] * w4[3]; } } }
#pragma unroll
            for (int e = 0; e < 16; ++e) lg[e] = wsum(lg[e]);
            float aff[16], sel[16];
#pragma unroll
            for (int e = 0; e < 16; ++e) { aff[e] = sigmoidf_(lg[e]); sel[e] = aff[e] + rbias[e]; }
            float gs[4];
#pragma unroll
            for (int gi = 0; gi < 4; ++gi) { const float a0 = sel[gi * 4], a1 = sel[gi * 4 + 1], a2 = sel[gi * 4 + 2], a3 = sel[gi * 4 + 3];
                gs[gi] = fmaxf(fmaxf(fmaxf(a0 + a1, a0 + a2), fmaxf(a0 + a3, a1 + a2)), fmaxf(a1 + a3, a2 + a3)); }
            int gidx = 0; float gb = gs[0];
#pragma unroll
            for (int gi = 1; gi < 4; ++gi) if (gs[gi] > gb) { gb = gs[gi]; gidx = gi; }
            float c[4], f[4];
#pragma unroll
            for (int i = 0; i < 4; ++i) { c[i] = gidx == 0 ? sel[i] : gidx == 1 ? sel[4 + i] : gidx == 2 ? sel[8 + i] : sel[12 + i];
                                           f[i] = gidx == 0 ? aff[i] : gidx == 1 ? aff[4 + i] : gidx == 2 ? aff[8 + i] : aff[12 + i]; }
            int i1 = 0; float cb = c[0];
#pragma unroll
            for (int i = 1; i < 4; ++i) if (c[i] > cb) { cb = c[i]; i1 = i; }
            int i2 = -1; float cb2 = 0.f;
#pragma unroll
            for (int i = 0; i < 4; ++i) if (i != i1 && (i2 < 0 || c[i] > cb2)) { cb2 = c[i]; i2 = i; }
            float w1 = i1 == 0 ? f[0] : i1 == 1 ? f[1] : i1 == 2 ? f[2] : f[3];
            float w2 = i2 == 0 ? f[0] : i2 == 1 ? f[1] : i2 == 2 ? f[2] : f[3];
            const float wsn = 1.0f / (w1 + w2); w1 *= wsn; w2 *= wsn;
            if (lane == 0) { se[rl * 2] = gidx * 4 + i1; se[rl * 2 + 1] = gidx * 4 + i2;
                TOKE[tok * 2] = gidx * 4 + i1; TOKE[tok * 2 + 1] = gidx * 4 + i2; TOKW[tok * 2] = w1; TOKW[tok * 2 + 1] = w2; }
        }
        __syncthreads();
        if (tid < 16) { int c2 = 0; for (int i = 0; i < 2 * CH; ++i) c2 += (se[i] == tid) ? 1 : 0; sbase[tid] = (int)atomicAdd(&cnt[tid], (unsigned)c2); }
        __syncthreads();
        if (tid < 2 * CH) { const int e = se[tid]; int rank = 0; for (int j = 0; j < tid; ++j) rank += (se[j] == e) ? 1 : 0;
            const int pos = sbase[e] + rank; const int lr = ch * CH + (tid >> 1); const int tok = (layer == 0 ? g * RG : g * RGL) + lr;
            LIST[(size_t)e * NTOK + pos] = tok; TOKP[tok * 2 + (tid & 1)] = pos; }
        __syncthreads();
    }
}

__device__ __forceinline__ int moe_tile_prefix(const unsigned* cnt, int ntok, int lane) {
    const int myt = lane < 16 ? (int)((cnt[lane & 15] + 255u) >> 8) : 0; int pref = myt;
#pragma unroll
    for (int o = 1; o < 16; o <<= 1) { const int t = __shfl_up(pref, o); if (lane >= o) pref += t; }
    return pref - myt + ntok / 256;
}
PHASE_FN void phase_moe_gather(const KP& kp, int layer) {
    const int lane = otid() & 63, wid = __builtin_amdgcn_readfirstlane(otid() >> 6);
    const int ntok = layer == 0 ? NTOK : NLAT;
    const int tpre = moe_tile_prefix(WSP(const unsigned, CTL_CNT) + layer * 16, ntok, lane);
    const bf16_t* V = WSP(const bf16_t, WS_V); bf16_t* XG = WSP(bf16_t, WS_BIG + MO_XG);
    const int* TOKE = WSP(const int, WS_TOKE); const int* TOKP = WSP(const int, WS_TOKP);
    for (int it = obid() * 8 + wid; it < 2 * ntok; it += gridDim.x * 8) {
        const int tok = it >> 1, e = TOKE[it], pos = TOKP[it];
        const size_t row = (size_t)(__shfl(tpre, e) - ntok / 256) * 256 + pos;
        const u32x4* src = (const u32x4*)(V + (size_t)tok * 1024) + lane * 2; u32x4* dst = (u32x4*)(XG + row * 1024) + lane * 2;
        const u32x4 a = src[0], b2 = src[1]; dst[0] = a; dst[1] = b2;
    }
}
PHASE_FN void phase_moe_gemm(const KP& kp, unsigned char* lds, int layer, bool down) {
    const int tid = otid();
    int* pre = (int*)(lds + pg8::STAGE_BYTES);
    int* slotmap = pre + 32;
    const int ntok = layer == 0 ? NTOK : NLAT;
    const unsigned* cnt = WSP(const unsigned, CTL_CNT) + layer * 16;
    if (tid == 0) { int p = ntok / 256; pre[0] = 0; pre[1] = p; for (int e = 0; e < 16; ++e) { p += ((int)cnt[e] + 255) >> 8; pre[2 + e] = p; } }
    __syncthreads();
    const int ntiles = pre[17];
    for (int t = tid; t < ntiles; t += 512) { int idx = 0; for (int e = 1; e < 17; ++e) if (pre[e] <= t) idx = e; slotmap[t] = idx == 0 ? 16 : idx - 1; }
    __syncthreads();
    pg8::MoeOrder S{slotmap, ntiles, (int)gridDim.x, obid()};
    if (!down) {
        pg8::Gemm g{WSP(const bf16_t, WS_V), WSP(const bf16_t, WS_BIG + MO_WUP), 0, 0, 1024, WSP(const bf16_t, WS_BIG + MO_XG), ntok / 256};
        pg8::EpiSwi E{WSP(bf16_t, WS_BIG + MO_HID)};
        pg8::gemm_phase<pg8::EpiSwi, pg8::MoeOrder, false>((PG8_LAS unsigned char*)lds, g, S, E, nullptr);
    } else {
        pg8::Gemm g{WSP(const bf16_t, WS_BIG + MO_HID), WSP(const bf16_t, WS_BIG + MO_WDN), 0, 0, 512, nullptr, 0x7fffffff};
        pg8::EpiBfG E{WSP(bf16_t, WS_BIG + MO_CON), 1024, 1024, 3};
        pg8::gemm_phase<pg8::EpiBfG, pg8::MoeOrder, false>((PG8_LAS unsigned char*)lds, g, S, E, nullptr);
    }
    __syncthreads();
}

PHASE_FN void phase_combine(const KP& kp, int layer) {
    const int lane = otid() & 63, wid = __builtin_amdgcn_readfirstlane(otid() >> 6);
    const int ntok = layer == 0 ? NTOK : NLAT;
    const unsigned* cnt = WSP(const unsigned, CTL_CNT) + layer * 16;
    const float* modv = WSP(const float, WS_MODV) + (size_t)layer * 17 * 6144;
    const float* ng = KIN(6) + (size_t)layer * 4 * 1024 + 3 * 1024;
    const bf16_t* CON = WSP(const bf16_t, WS_BIG + MO_CON);
    const int* TOKE = WSP(const int, WS_TOKE); const int* TOKP = WSP(const int, WS_TOKP); const float* TOKW = WSP(const float, WS_TOKW);
    const int tpre = moe_tile_prefix(cnt, ntok, lane);
    for (int tok0 = (obid() * 8 + wid) * 2; tok0 < ntok; tok0 += gridDim.x * 16) {
        int e1[2], e2[2], p1[2], p2[2]; float w1[2], w2[2];
#pragma unroll
        for (int u = 0; u < 2; ++u) { const int tok = tok0 + u; e1[u] = TOKE[tok * 2]; e2[u] = TOKE[tok * 2 + 1]; p1[u] = TOKP[tok * 2]; p2[u] = TOKP[tok * 2 + 1]; w1[u] = TOKW[tok * 2]; w2[u] = TOKW[tok * 2 + 1]; }
        f32x4 f[2][4], hx[2][4]; float* hp[2]; const float* mv[2];
#pragma unroll
        for (int u = 0; u < 2; ++u) { const int tok = tok0 + u;
            const size_t r1 = (size_t)__shfl(tpre, e1[u]) * 256 + p1[u], r2 = (size_t)__shfl(tpre, e2[u]) * 256 + p2[u];
            int b, t;
            if (layer == 0) { b = tok / TT; t = tok - b * TT; } else { b = tok >> 11; t = CTXL + (tok & 2047); }
            hp[u] = hrow_wr(kp, b, t); mv[u] = modv + (size_t)(t < CTXL ? 16 : b) * 6144 + 5 * 1024;
#pragma unroll
            for (int i = 0; i < 4; ++i) { const int col = i * 256 + lane * 4;
                f[u][i] = ld4bf(CON + (size_t)tok * 1024 + col) + ld4bf(CON + r1 * 1024 + col) * w1[u] + ld4bf(CON + r2 * 1024 + col) * w2[u];
                hx[u][i] = *(const f32x4*)(hp[u] + col); } }
#pragma unroll
        for (int u = 0; u < 2; ++u) { float ss = 0.f;
#pragma unroll
            for (int i = 0; i < 4; ++i) ss += f[u][i][0] * f[u][i][0] + f[u][i][1] * f[u][i][1] + f[u][i][2] * f[u][i][2] + f[u][i][3] * f[u][i][3];
            ss = wsum(ss); const float rstd = rsqrtf(ss * (1.0f / 1024.0f) + EPS);
#pragma unroll
            for (int i = 0; i < 4; ++i) { const int col = i * 256 + lane * 4;
                const f32x4 g3 = *(const f32x4*)(ng + col), gf = *(const f32x4*)(mv[u] + col);
                *(f32x4*)(hp[u] + col) = hx[u][i] + gf * (f[u][i] * rstd * g3); } }
    }
}

template <int CH>
__device__ __forceinline__ int scan_t(int dir, int ci, int j) {
    constexpr int NC_CTX = CTXL / CH;
    if (!dir) return ci * CH + j;
    return ci < NC_CTX ? (CTXL - 1 - ci * CH - j) : (TT - 1 - (ci - NC_CTX) * CH - j);
}

constexpr int ML_LQ = 136, ML_LT = 72, ML_VR = 144;
PHASE_FN void mlstm_unit(const KP& kp, unsigned char* lds, int bl, int h, int dir, int vh) {
    const int tid = otid();
    bf16_t* Qs = (bf16_t*)lds;
    bf16_t* Ks = Qs + 64 * ML_LQ;
    bf16_t* KTE = Ks + 64 * ML_LQ;
    bf16_t* VT = KTE + 128 * ML_LT;
    bf16_t* Ps = VT + ML_VR * ML_LT;
    bf16_t* Cb = Ps + 64 * ML_LT;
    float* fs = (float*)(Cb + ML_VR * ML_LQ);
    float* s_rowv = fs;
    float* s_colv = fs + 64;
    float* s_wint = fs + 128;
    float* s_emj = fs + 192;
    float* s_E = fs + 256;
    float* s_den = fs + 320;
    float* s_misc = fs + 384;
    const bf16_t* P = WSP(const bf16_t, WS_BIG + L0_P);
    bf16_t* HOUT = WSP(bf16_t, WS_BIG + (dir ? L0_HB : L0_AO)); const int ldh = dir ? 1024 : 2048;
    const float ibias = KIN(9)[dir * 4 + h], fbias = KIN(10)[dir * 4 + h];
    for (int i = tid; i < ML_VR * ML_LQ; i += 512) Cb[i] = 0;
    for (int i = tid; i < 16 * ML_LT; i += 512) VT[128 * ML_LT + i] = (i < ML_LT) ? (bf16_t)0x3f80 : (bf16_t)0;
    f32x4 Cacc[8], Nacc;
#pragma unroll
    for (int i = 0; i < 8; ++i) Cacc[i] = (f32x4){0.f, 0.f, 0.f, 0.f};
    Nacc = (f32x4){0.f, 0.f, 0.f, 0.f};
    float m_state = 0.f;
    u32x4 pq[2], pk[2], pv[2]; bf16_t pgi = 0, pgf = 0;
#define ML_REQ(ci_) do { _Pragma("unroll") for (int i = 0; i < 2; ++i) { const int p = tid + i * 512, j = p >> 4, c8 = p & 15; \
            const bf16_t* pr = P + ((size_t)bl * TT + scan_t<64>(dir, (ci_), j)) * AB_N; \
            pq[i] = *(const u32x4*)(pr + AB_Q + h * 128 + c8 * 8); pk[i] = *(const u32x4*)(pr + AB_K + h * 128 + c8 * 8); \
            const int jv = tid & 63, cv = (tid >> 6) + i * 8; \
            pv[i] = *(const u32x4*)(P + ((size_t)bl * TT + scan_t<64>(dir, (ci_), jv)) * AB_N + AB_V + h * 256 + vh * 128 + cv * 8); } \
        if (tid < 64) { const bf16_t* pg = P + ((size_t)bl * TT + scan_t<64>(dir, (ci_), tid)) * AB_N; pgi = pg[AB_IG + dir * 4 + h]; pgf = pg[AB_FG + dir * 4 + h]; } } while (0)
    ML_REQ(0);
    lds_barrier();
    for (int ci = 0; ci < TT / 64; ++ci) {
        int tq = tid; asm volatile("" : "+v"(tq));
        const int lane = tq & 63, wid = __builtin_amdgcn_readfirstlane(tq >> 6), fr = lane & 15, fq = lane >> 4;
#pragma unroll
        for (int i = 0; i < 2; ++i) {
            const int p = tq + i * 512, j = p >> 4, c8 = p & 15;
            u32x4 q = pq[i];
            const float qs = 0.08838834764831845f;
            q.x = pack2(lo2f(q.x) * qs, hi2f(q.x) * qs); q.y = pack2(lo2f(q.y) * qs, hi2f(q.y) * qs);
            q.z = pack2(lo2f(q.z) * qs, hi2f(q.z) * qs); q.w = pack2(lo2f(q.w) * qs, hi2f(q.w) * qs);
            *(u32x4*)(Qs + j * ML_LQ + c8 * 8) = q;
            *(u32x4*)(Ks + j * ML_LQ + c8 * 8) = pk[i];
            const u32x4 v = pv[i];
            bf16_t* vt = VT + (((tq >> 6) + i * 8) * 8) * ML_LT + (tq & 63);
            vt[0 * ML_LT] = (bf16_t)(v.x & 0xffff); vt[1 * ML_LT] = (bf16_t)(v.x >> 16); vt[2 * ML_LT] = (bf16_t)(v.y & 0xffff); vt[3 * ML_LT] = (bf16_t)(v.y >> 16);
            vt[4 * ML_LT] = (bf16_t)(v.z & 0xffff); vt[5 * ML_LT] = (bf16_t)(v.z >> 16); vt[6 * ML_LT] = (bf16_t)(v.w & 0xffff); vt[7 * ML_LT] = (bf16_t)(v.w >> 16);
        }
        if (wid == 0) {
            const float ig = bf2f(pgi) + ibias;
            const float lf = logsigmoidf_(bf2f(pgf) + fbias);
            float b = lf;
#pragma unroll
            for (int o = 1; o < 64; o <<= 1) { const float t = __shfl_up(b, o); if (lane >= o) b += t; }
            const float u = ig - b; float pm = u;
#pragma unroll
            for (int o = 1; o < 64; o <<= 1) { const float t = __shfl_up(pm, o); if (lane >= o) pm = fmaxf(pm, t); }
            const float mj = fmaxf(b + m_state, b + pm);
            const float b63 = __shfl(b, 63), pm63 = __shfl(pm, 63);
            const float mnew = fmaxf(b63 + m_state, b63 + pm63);
            s_rowv[lane] = b - mj; s_colv[lane] = u; s_wint[lane] = __expf(b + m_state - mj); s_emj[lane] = __expf(-mj);
            s_E[lane] = __expf(b63 + u - mnew);
            if (lane == 0) { s_misc[0] = mnew; s_misc[1] = __expf(b63 + m_state - mnew); }
        }
        if (ci + 1 < TT / 64) ML_REQ(ci + 1);
        lds_barrier();
        {
            const int jt = wid >> 1;
#pragma unroll
            for (int q2 = 0; q2 < 2; ++q2) {
                const int st = (wid & 1) * 2 + q2;
                f32x4 acc = (f32x4){0.f, 0.f, 0.f, 0.f};
                if (st <= jt) {
                    bf16x8 fa[4], fb[4];
#pragma unroll
                    for (int k = 0; k < 4; ++k) { fa[k] = ldfrag(Qs, ML_LQ, jt * 16, k * 32, fr, fq); fb[k] = ldfrag(Ks, ML_LQ, st * 16, k * 32, fr, fq); }
                    __builtin_amdgcn_sched_barrier(0);
                    f32x4 acc2 = (f32x4){0.f, 0.f, 0.f, 0.f};
                    acc = mma16(fa[0], fb[0], acc); acc2 = mma16(fa[1], fb[1], acc2); acc = mma16(fa[2], fb[2], acc); acc2 = mma16(fa[3], fb[3], acc2);
                    acc = acc + acc2;
                }
                const int s = st * 16 + fr; const float cv = s_colv[s];
#pragma unroll
                for (int r = 0; r < 4; ++r) { const int j = jt * 16 + fq * 4 + r;
                    const float pv2 = (s <= j) ? acc[r] * __expf(s_rowv[j] + cv) : 0.f;
                    Ps[j * ML_LT + s] = f2bf(pv2); }
            }
#pragma unroll
            for (int i = 0; i < 2; ++i) {
                const int s = lane, c8 = wid + i * 8; const float e = s_E[s];
                const u32x4 kv = *(const u32x4*)(Ks + s * ML_LQ + c8 * 8);
                bf16_t* kt = KTE + (c8 * 8) * ML_LT + s;
                kt[0 * ML_LT] = f2bf(lo2f(kv.x) * e); kt[1 * ML_LT] = f2bf(hi2f(kv.x) * e); kt[2 * ML_LT] = f2bf(lo2f(kv.y) * e); kt[3 * ML_LT] = f2bf(hi2f(kv.y) * e);
                kt[4 * ML_LT] = f2bf(lo2f(kv.z) * e); kt[5 * ML_LT] = f2bf(hi2f(kv.z) * e); kt[6 * ML_LT] = f2bf(lo2f(kv.w) * e); kt[7 * ML_LT] = f2bf(hi2f(kv.w) * e);
            }
        }
        lds_barrier();
        f32x4 a1[4], a2[4];
        {
            const int jt = wid >> 1;
            bf16x8 fp[2], fqq[4];
#pragma unroll
            for (int k = 0; k < 2; ++k) fp[k] = ldfrag(Ps, ML_LT, jt * 16, k * 32, fr, fq);
#pragma unroll
            for (int k = 0; k < 4; ++k) fqq[k] = ldfrag(Qs, ML_LQ, jt * 16, k * 32, fr, fq);
            {
                bf16x8 fv[4][2];
#pragma unroll
                for (int q4 = 0; q4 < 4; ++q4)
#pragma unroll
                    for (int k = 0; k < 2; ++k) fv[q4][k] = ldfrag(VT, ML_LT, ((wid & 1) * 4 + q4) * 16, k * 32, fr, fq);
                __builtin_amdgcn_sched_barrier(0);
#pragma unroll
                for (int q4 = 0; q4 < 4; ++q4) a1[q4] = (f32x4){0.f, 0.f, 0.f, 0.f};
#pragma unroll
                for (int k = 0; k < 2; ++k)
#pragma unroll
                    for (int q4 = 0; q4 < 4; ++q4) a1[q4] = mma16(fv[q4][k], fp[k], a1[q4]);
            }
#pragma unroll
            for (int hh = 0; hh < 2; ++hh) {
                bf16x8 fc[2][4];
#pragma unroll
                for (int q2 = 0; q2 < 2; ++q2)
#pragma unroll
                    for (int k = 0; k < 4; ++k) fc[q2][k] = ldfrag(Cb, ML_LQ, ((wid & 1) * 4 + hh * 2 + q2) * 16, k * 32, fr, fq);
                __builtin_amdgcn_sched_barrier(0);
                a2[hh * 2] = (f32x4){0.f, 0.f, 0.f, 0.f}; a2[hh * 2 + 1] = (f32x4){0.f, 0.f, 0.f, 0.f};
#pragma unroll
                for (int k = 0; k < 4; ++k) { a2[hh * 2] = mma16(fc[0][k], fqq[k], a2[hh * 2]); a2[hh * 2 + 1] = mma16(fc[1][k], fqq[k], a2[hh * 2 + 1]); }
            }
            if (wid & 1) {
                f32x4 d1 = (f32x4){0.f, 0.f, 0.f, 0.f}, d2 = (f32x4){0.f, 0.f, 0.f, 0.f};
                bf16x8 fo[2], fn[4];
#pragma unroll
                for (int k = 0; k < 2; ++k) fo[k] = ldfrag(VT, ML_LT, 128, k * 32, fr, fq);
#pragma unroll
                for (int k = 0; k < 4; ++k) fn[k] = ldfrag(Cb, ML_LQ, 128, k * 32, fr, fq);
                __builtin_amdgcn_sched_barrier(0);
                d1 = mma16(fo[0], fp[0], d1); d2 = mma16(fn[0], fqq[0], d2); d1 = mma16(fo[1], fp[1], d1); d2 = mma16(fn[1], fqq[1], d2);
                d2 = mma16(fn[2], fqq[2], d2); d2 = mma16(fn[3], fqq[3], d2);
                if (fq == 0) { const int j = jt * 16 + fr; s_den[j] = fmaxf(fabsf(d1[0] + s_wint[j] * d2[0]), s_emj[j]); }
            }
        }
        lds_barrier();
        {
            const int jt = wid >> 1, j = jt * 16 + fr;
            const float wi = s_wint[j], rden = frcp_(s_den[j]);
            const size_t row = (size_t)bl * TT + scan_t<64>(dir, ci, j);
#pragma unroll
            for (int q4 = 0; q4 < 4; ++q4) { const int v0 = ((wid & 1) * 4 + q4) * 16 + fq * 4;
                st4bf(HOUT + row * ldh + h * 256 + vh * 128 + v0, (a1[q4] + a2[q4] * wi) * rden); }
        }
        {
            const float dec = s_misc[1];
            const bf16x8 bv0 = ldfrag(VT, ML_LT, wid * 16, 0, fr, fq), bv1 = ldfrag(VT, ML_LT, wid * 16, 32, fr, fq);
#pragma unroll
            for (int hh = 0; hh < 2; ++hh) {
                bf16x8 fk[4][2];
#pragma unroll
                for (int q = 0; q < 4; ++q) { fk[q][0] = ldfrag(KTE, ML_LT, (hh * 4 + q) * 16, 0, fr, fq); fk[q][1] = ldfrag(KTE, ML_LT, (hh * 4 + q) * 16, 32, fr, fq); }
                __builtin_amdgcn_sched_barrier(0);
#pragma unroll
                for (int q = 0; q < 4; ++q) Cacc[hh * 4 + q] = Cacc[hh * 4 + q] * dec;
#pragma unroll
                for (int q = 0; q < 4; ++q) Cacc[hh * 4 + q] = mma16(fk[q][0], bv0, Cacc[hh * 4 + q]);
#pragma unroll
                for (int q = 0; q < 4; ++q) Cacc[hh * 4 + q] = mma16(fk[q][1], bv1, Cacc[hh * 4 + q]);
#pragma unroll
                for (int q = 0; q < 4; ++q) st4bf(Cb + (wid * 16 + fr) * ML_LQ + (hh * 4 + q) * 16 + fq * 4, Cacc[hh * 4 + q]);
            }
            Nacc = Nacc * dec;
            Nacc = mma16(ldfrag(KTE, ML_LT, wid * 16, 0, fr, fq), ldfrag(VT, ML_LT, 128, 0, fr, fq), Nacc);
            Nacc = mma16(ldfrag(KTE, ML_LT, wid * 16, 32, fr, fq), ldfrag(VT, ML_LT, 128, 32, fr, fq), Nacc);
            st4bf(Cb + (128 + fr) * ML_LQ + wid * 16 + fq * 4, Nacc);
            m_state = s_misc[0];
        }
        lds_barrier();
    }
#undef ML_REQ
}

constexpr size_t L0_XC = L0_U;
static_assert(L0_XC + (size_t)RG * 1280 * 2 <= BIG_BYTES, "xconv buffer");
PHASE_FN void phase_xconv(const KP& kp) {
    const int lane = otid() & 63, wid = __builtin_amdgcn_readfirstlane(otid() >> 6);
    const bf16_t* P = WSP(const bf16_t, WS_BIG + L0_P); bf16_t* XC = WSP(bf16_t, WS_BIG + L0_XC);
    const float* cw = KIN(12); const float* cb = KIN(13);
    for (int lr = obid() * 8 + wid; lr < RG; lr += gridDim.x * 8) {
        const int bl = lr / TT, t = lr - bl * TT, lo = t < CTXL ? 0 : CTXL, hi = t < CTXL ? CTXL : TT;
#pragma unroll
        for (int i = 0; i < 5; ++i) { const int col = i * 256 + lane * 4;
            f32x4 a = *(const f32x4*)(cb + col);
#pragma unroll
            for (int q = 0; q < 5; ++q) { const int tt = t - 2 + q;
                if (tt >= lo && tt < hi) a += *(const f32x4*)(cw + q * 1280 + col) * ld4bf(P + ((size_t)bl * TT + tt) * AB_N + AB_XBC + col); }
            f32x4 o;
#pragma unroll
            for (int r = 0; r < 4; ++r) o[r] = siluf_(a[r]);
            st4bf(XC + (size_t)lr * 1280 + col, o); }
    }
}

constexpr int SS_LT = 72, SS_LX = 136;
PHASE_FN void ssd_unit(const KP& kp, unsigned char* lds, int bl, int dir, int hp) {
    const int tid = otid();
    const int gi = hp >> 2, hh0 = hp * 2;
    bf16_t* Wm = (bf16_t*)lds;
    bf16_t* CM = Wm + 2 * 64 * SS_LT;
    bf16_t* BM = CM + 64 * SS_LT;
    bf16_t* Xn = BM + 64 * SS_LT;
    bf16_t* XT = Xn + 64 * SS_LX;
    bf16_t* BTE = XT + 2 * 64 * SS_LT;
    bf16_t* Sb = BTE + 2 * 64 * SS_LT;
    float* fs = (float*)(Sb + 2 * 64 * SS_LT);
    float* s_b = fs;
    float* s_dt = fs + 128;
    float* s_e = fs + 256;
    float* s_misc = fs + 384;
    const bf16_t* P = WSP(const bf16_t, WS_BIG + L0_P); const bf16_t* XC = WSP(const bf16_t, WS_BIG + L0_XC);
    bf16_t* YOUT = WSP(bf16_t, WS_BIG + (dir ? L0_YB : L0_AO + 2048)); const int ldy = dir ? 1024 : 2048;
    for (int i = tid; i < 2 * 64 * SS_LT; i += 512) Sb[i] = 0;
    f32x4 Sacc[4];
#pragma unroll
    for (int i = 0; i < 4; ++i) Sacc[i] = (f32x4){0.f, 0.f, 0.f, 0.f};
    const float dtb = KIN(14)[dir * 16 + hh0 + ((tid >> 6) & 1)], aexp = __expf(KIN(15)[dir * 16 + hh0 + ((tid >> 6) & 1)]);
    const float dskip = KIN(16)[hh0 + (tid >> 8)];
    u32x4 pr[4]; bf16_t pdt = 0;
#define SS_REQ(ci_) do { _Pragma("unroll") for (int q = 0; q < 4; ++q) { const int p = tid + q * 512, j = p >> 5, c8 = p & 31; \
            const int col = c8 < 16 ? hh0 * 64 + c8 * 8 : (c8 < 24 ? 1024 + gi * 64 + (c8 - 16) * 8 : 1152 + gi * 64 + (c8 - 24) * 8); \
            pr[q] = *(const u32x4*)(XC + ((size_t)bl * TT + scan_t<64>(dir, (ci_), j)) * 1280 + col); } \
        if (tid < 128) pdt = P[((size_t)bl * TT + scan_t<64>(dir, (ci_), tid & 63)) * AB_N + AB_DT + dir * 16 + hh0 + (tid >> 6)]; } while (0)
    SS_REQ(0);
    lds_barrier();
    for (int ci = 0; ci < TT / 64; ++ci) {
        int tq = tid; asm volatile("" : "+v"(tq));
        const int lane = tq & 63, wid = __builtin_amdgcn_readfirstlane(tq >> 6), fr = lane & 15, fq = lane >> 4, hl_w = wid >> 2;
#pragma unroll
        for (int q = 0; q < 4; ++q) { const int p = tq + q * 512, j = p >> 5, c8 = p & 31;
            bf16_t* dst = c8 < 16 ? Xn + j * SS_LX + c8 * 8 : (c8 < 24 ? BM + j * SS_LT + (c8 - 16) * 8 : CM + j * SS_LT + (c8 - 24) * 8);
            *(u32x4*)dst = pr[q]; }
        if (wid < 2) {
            const float dt = softplusf_(bf2f(pdt) + dtb);
            float b = -dt * aexp;
#pragma unroll
            for (int o = 1; o < 64; o <<= 1) { const float t = __shfl_up(b, o); if (lane >= o) b += t; }
            const float b63 = __shfl(b, 63);
            s_b[wid * 64 + lane] = b; s_dt[wid * 64 + lane] = dt; s_e[wid * 64 + lane] = __expf(b63 - b) * dt;
            if (lane == 0) s_misc[wid] = __expf(b63);
        }
        if (ci + 1 < TT / 64) SS_REQ(ci + 1);
        lds_barrier();
        {
            const int jt = wid >> 1;
#pragma unroll
            for (int q2 = 0; q2 < 2; ++q2) {
                const int st = (wid & 1) * 2 + q2;
                f32x4 acc = (f32x4){0.f, 0.f, 0.f, 0.f};
                if (st <= jt) {
                    const bf16x8 c0 = ldfrag(CM, SS_LT, jt * 16, 0, fr, fq), c1 = ldfrag(CM, SS_LT, jt * 16, 32, fr, fq), b0 = ldfrag(BM, SS_LT, st * 16, 0, fr, fq), b1 = ldfrag(BM, SS_LT, st * 16, 32, fr, fq);
                    __builtin_amdgcn_sched_barrier(0);
                    acc = mma16(c0, b0, acc); acc = mma16(c1, b1, acc);
                }
                const int s = st * 16 + fr;
#pragma unroll
                for (int hl = 0; hl < 2; ++hl) { const float bs = s_b[hl * 64 + s], ds = s_dt[hl * 64 + s];
#pragma unroll
                    for (int r = 0; r < 4; ++r) { const int j = jt * 16 + fq * 4 + r;
                        const float wv = (s <= j) ? acc[r] * __expf(s_b[hl * 64 + j] - bs) * ds : 0.f;
                        Wm[(hl * 64 + j) * SS_LT + s] = f2bf(wv); } }
            }
            {
                const int s = lane, n8 = wid;
                const u32x4 bv = *(const u32x4*)(BM + s * SS_LT + n8 * 8);
#pragma unroll
                for (int hl = 0; hl < 2; ++hl) { const float e = s_e[hl * 64 + s];
                    bf16_t* bt = BTE + (hl * 64 + n8 * 8) * SS_LT + s;
                    bt[0 * SS_LT] = f2bf(lo2f(bv.x) * e); bt[1 * SS_LT] = f2bf(hi2f(bv.x) * e); bt[2 * SS_LT] = f2bf(lo2f(bv.y) * e); bt[3 * SS_LT] = f2bf(hi2f(bv.y) * e);
                    bt[4 * SS_LT] = f2bf(lo2f(bv.z) * e); bt[5 * SS_LT] = f2bf(hi2f(bv.z) * e); bt[6 * SS_LT] = f2bf(lo2f(bv.w) * e); bt[7 * SS_LT] = f2bf(hi2f(bv.w) * e); }
#pragma unroll
                for (int i = 0; i < 2; ++i) { const int c8 = wid + i * 8;
                    const u32x4 xv = *(const u32x4*)(Xn + s * SS_LX + c8 * 8);
                    bf16_t* xt = XT + (c8 * 8) * SS_LT + s;
                    xt[0 * SS_LT] = (bf16_t)(xv.x & 0xffff); xt[1 * SS_LT] = (bf16_t)(xv.x >> 16); xt[2 * SS_LT] = (bf16_t)(xv.y & 0xffff); xt[3 * SS_LT] = (bf16_t)(xv.y >> 16);
                    xt[4 * SS_LT] = (bf16_t)(xv.z & 0xffff); xt[5 * SS_LT] = (bf16_t)(xv.z >> 16); xt[6 * SS_LT] = (bf16_t)(xv.w & 0xffff); xt[7 * SS_LT] = (bf16_t)(xv.w >> 16); }
            }
        }
        lds_barrier();
        {
            const int hl = hl_w, jt = wid & 3, j = jt * 16 + fr;
            const bf16_t* Wh = Wm + hl * 64 * SS_LT; const bf16_t* Xh = XT + hl * 64 * SS_LT; const bf16_t* Sh = Sb + hl * 64 * SS_LT;
            const float eb = __expf(s_b[hl * 64 + j]);
            const size_t row = (size_t)bl * TT + scan_t<64>(dir, ci, j);
            const bf16x8 w0 = ldfrag(Wh, SS_LT, jt * 16, 0, fr, fq), w1 = ldfrag(Wh, SS_LT, jt * 16, 32, fr, fq), m0 = ldfrag(CM, SS_LT, jt * 16, 0, fr, fq), m1 = ldfrag(CM, SS_LT, jt * 16, 32, fr, fq);
#pragma unroll
            for (int hh = 0; hh < 2; ++hh) {
                bf16x8 fx[2][2], fs2[2][2];
#pragma unroll
                for (int q = 0; q < 2; ++q)
#pragma unroll
                    for (int k = 0; k < 2; ++k) { fx[q][k] = ldfrag(Xh, SS_LT, (hh * 2 + q) * 16, k * 32, fr, fq); fs2[q][k] = ldfrag(Sh, SS_LT, (hh * 2 + q) * 16, k * 32, fr, fq); }
                f32x4 dx[2];
                if (!dir) { dx[0] = ld4bf(Xn + j * SS_LX + hl * 64 + (hh * 2) * 16 + fq * 4); dx[1] = ld4bf(Xn + j * SS_LX + hl * 64 + (hh * 2 + 1) * 16 + fq * 4); }
                __builtin_amdgcn_sched_barrier(0);
                f32x4 y1[2], y2[2];
#pragma unroll
                for (int q = 0; q < 2; ++q) { y1[q] = (f32x4){0.f, 0.f, 0.f, 0.f}; y2[q] = (f32x4){0.f, 0.f, 0.f, 0.f}; }
#pragma unroll
                for (int q = 0; q < 2; ++q) { y1[q] = mma16(fx[q][0], w0, y1[q]); y2[q] = mma16(fs2[q][0], m0, y2[q]); }
#pragma unroll
                for (int q = 0; q < 2; ++q) { y1[q] = mma16(fx[q][1], w1, y1[q]); y2[q] = mma16(fs2[q][1], m1, y2[q]); }
#pragma unroll
                for (int q = 0; q < 2; ++q) { f32x4 y = y1[q] + y2[q] * eb;
                    if (!dir) y = y + dx[q] * dskip;
                    st4bf(YOUT + row * ldy + (hh0 + hl) * 64 + (hh * 2 + q) * 16 + fq * 4, y); }
            }
        }
        lds_barrier();
        {
            const int hl = hl_w, pt = wid & 3; const float eb63 = s_misc[hl];
            const bf16_t* Xh = XT + hl * 64 * SS_LT; const bf16_t* Bh = BTE + hl * 64 * SS_LT; bf16_t* Sh = Sb + hl * 64 * SS_LT;
            const bf16x8 x0 = ldfrag(Xh, SS_LT, pt * 16, 0, fr, fq), x1 = ldfrag(Xh, SS_LT, pt * 16, 32, fr, fq);
            bf16x8 fb[4][2];
#pragma unroll
            for (int nt = 0; nt < 4; ++nt) { fb[nt][0] = ldfrag(Bh, SS_LT, nt * 16, 0, fr, fq); fb[nt][1] = ldfrag(Bh, SS_LT, nt * 16, 32, fr, fq); }
            __builtin_amdgcn_sched_barrier(0);
#pragma unroll
            for (int nt = 0; nt < 4; ++nt) Sacc[nt] = Sacc[nt] * eb63;
#pragma unroll
            for (int nt = 0; nt < 4; ++nt) Sacc[nt] = mma16(fb[nt][0], x0, Sacc[nt]);
#pragma unroll
            for (int nt = 0; nt < 4; ++nt) Sacc[nt] = mma16(fb[nt][1], x1, Sacc[nt]);
#pragma unroll
            for (int nt = 0; nt < 4; ++nt) st4bf(Sh + (pt * 16 + fr) * SS_LT + nt * 16 + fq * 4, Sacc[nt]);
        }
        lds_barrier();
    }
#undef SS_REQ
}

__device__ __forceinline__ void phase_scan_ab(const KP& kp, unsigned char* lds) {
    for (int rep = 0; rep < ((PROBE_DUP & 8192) ? 2 : 1); ++rep)
    for (int u = obid(); u < 256; u += gridDim.x) if (u < 128) { mlstm_unit(kp, lds, u >> 4, (u >> 2) & 3, (u >> 1) & 1, u & 1); __syncthreads(); }
    for (int rep = 0; rep < ((PROBE_DUP & 16384) ? 2 : 1); ++rep)
    for (int u = obid(); u < 256; u += gridDim.x) if (u >= 128) { const int v = u - 128; ssd_unit(kp, lds, v >> 4, (v >> 3) & 1, v & 7); __syncthreads(); }
}

PHASE_FN void phase_fin_ab(const KP& kp) {
    const int lane = otid() & 63, wid = __builtin_amdgcn_readfirstlane(otid() >> 6);
    const bf16_t* P = WSP(const bf16_t, WS_BIG + L0_P);
    bf16_t* AO = WSP(bf16_t, WS_BIG + L0_AO); const bf16_t* HB = WSP(const bf16_t, WS_BIG + L0_HB); const bf16_t* YB = WSP(const bf16_t, WS_BIG + L0_YB);
    const float* mln = KIN(11); const float* sn = KIN(17);
    for (int lr = obid() * 8 + wid; lr < RG; lr += gridDim.x * 8) {
        const bf16_t* pr = P + (size_t)lr * AB_N;
        f32x4 yz[4]; float ss2 = 0.f;
#pragma unroll
        for (int i = 0; i < 4; ++i) { const int col = i * 256 + lane * 4;
            const f32x4 hs = ld4bf(AO + (size_t)lr * 2048 + col) + ld4bf(HB + (size_t)lr * 1024 + col);
            float ss = hs[0] * hs[0] + hs[1] * hs[1] + hs[2] * hs[2] + hs[3] * hs[3];
            ss = wsum(ss); const float rstd = rsqrtf(ss * (1.0f / 256.0f) + EPS);
            const f32x4 og = ld4bf(pr + AB_OG + col), w = *(const f32x4*)(mln + col);
            f32x4 o;
#pragma unroll
            for (int r = 0; r < 4; ++r) o[r] = hs[r] * rstd * w[r] * sigmoidf_(og[r]);
            st4bf(AO + (size_t)lr * 2048 + col, o);
            const f32x4 ys = ld4bf(AO + (size_t)lr * 2048 + 1024 + col) + ld4bf(YB + (size_t)lr * 1024 + col), z = ld4bf(pr + AB_Z + col);
#pragma unroll
            for (int r = 0; r < 4; ++r) { yz[i][r] = ys[r] * siluf_(z[r]); ss2 += yz[i][r] * yz[i][r]; }
        }
        ss2 = wsum(ss2); const float rstd2 = rsqrtf(ss2 * (1.0f / 1024.0f) + EPS);
#pragma unroll
        for (int i = 0; i < 4; ++i) { const int col = i * 256 + lane * 4; st4bf(AO + (size_t)lr * 2048 + 1024 + col, yz[i] * rstd2 * *(const f32x4*)(sn + col)); }
    }
}

PHASE_FN void phase_gemm_in(const KP& kp, unsigned char* lds, int layer) {
    const int npad = layer == 0 ? AB_NPAD : CD_NPAD, n = layer == 0 ? AB_N : CD_N;
    pg8::Gemm g{WSP(const bf16_t, WS_BIG + (layer == 0 ? L0_U : L1_U)), WSP(const bf16_t, WS_WMIX), RG, npad, 1024, nullptr, 0x7fffffff};
    pg8::StaticOrder S; S.init(RG, npad, (int)gridDim.x, obid());
    pg8::EpiBfG E{WSP(bf16_t, WS_BIG), n, n, 0x7fffffff};
    pg8::gemm_phase<pg8::EpiBfG, pg8::StaticOrder, false>((PG8_LAS unsigned char*)lds, g, S, E, nullptr);
    __syncthreads();
}
PHASE_FN void phase_gemm_out_ab(const KP& kp, unsigned char* lds) {
    pg8::Gemm g{WSP(const bf16_t, WS_BIG + L0_AO), WSP(const bf16_t, WS_WMIX + WM_AB_OUT), RG, 1024, 2048, nullptr, 0x7fffffff};
    pg8::StaticOrder S; S.init(RG, 1024, (int)gridDim.x, obid());
    pg8::EpiBfG E{WSP(bf16_t, WS_BIG + L0_U), 1024, 1024, 0x7fffffff};
    pg8::gemm_phase<pg8::EpiBfG, pg8::StaticOrder, false>((PG8_LAS unsigned char*)lds, g, S, E, nullptr);
    __syncthreads();
}

PHASE_FN void phase_prep_cd(const KP& kp) {
    const int lane = otid() & 63, wid = __builtin_amdgcn_readfirstlane(otid() >> 6);
    bf16_t* P = WSP(bf16_t, WS_BIG + L1_P);
    bf16_t* SG = WSP(bf16_t, WS_SG);
    const float* qn = KIN(20); const float* kvn = KIN(22); const float* mu = KIN(24);
    for (int lr = obid() * 8 + wid; lr < RG; lr += gridDim.x * 8) {
        const int bl = lr / TT, t = lr - bl * TT;
        bf16_t* pr = P + (size_t)lr * CD_N;
        {
            const f32x4 x = ld4bf(pr + CD_M1 + lane * 4);
            float ss = x[0] * x[0] + x[1] * x[1] + x[2] * x[2] + x[3] * x[3]; ss = wsum(ss);
            const float rstd = rsqrtf(ss * (1.0f / 256.0f) + EPS);
            st4bf(pr + CD_M1 + lane * 4, x * rstd * *(const f32x4*)(kvn + lane * 4));
        }
        {
            const int lo = t < CTXL ? 0 : CTXL, hi = t < CTXL ? CTXL : TT, c = lane * 4;
            const f32x4 x = ld4bf(pr + CD_WL + c);
            const f32x4 xp = t > lo ? ld4bf(pr - CD_N + CD_WL + c) : (f32x4){0.f, 0.f, 0.f, 0.f};
            const f32x4 xn = t < hi - 1 ? ld4bf(pr + CD_N + CD_WL + c) : (f32x4){0.f, 0.f, 0.f, 0.f};
            f32x4 l = x + *(const f32x4*)(mu + CD_WL - CD_RW0 + c) * ((xp + xn) * 0.5f - x);
            if (c < 128) {
#pragma unroll
                for (int q = 0; q < 4; ++q) l[q] = tanhf_(l[q]); }
            st4bf(WSP(bf16_t, WS_BIG + L1_TWAL) + (size_t)lr * 256 + c, l);
        }
        if (t >= CTXL) {
            const int s = t - CTXL;
            float x0[3], x1[3]; float ss = 0.f;
#pragma unroll
            for (int i = 0; i < 3; ++i) { const unsigned w = *(const unsigned*)(pr + CD_M0 + i * 128 + lane * 2); x0[i] = lo2f(w); x1[i] = hi2f(w); ss += x0[i] * x0[i] + x1[i] * x1[i]; }
            ss = wsum(ss); const float rstd = rsqrtf(ss * (1.0f / 384.0f) + EPS);
#pragma unroll
            for (int i = 0; i < 3; ++i) { const int c = i * 128 + lane * 2; *(unsigned*)(pr + CD_M0 + c) = pack2(x0[i] * rstd * qn[c], x1[i] * rstd * qn[c + 1]); }
            if (lane < 16) {
                const float pos = (lane < 8) ? (float)(s >> 6) : (float)(s & 63);
                const float inv = __expf(-(float)(lane & 7) * (9.210340371976184f / 8.0f));
                float sn, cs; sincosf(pos * inv, &sn, &cs);
                const float a = bf2f(pr[CD_KR + lane]), b2 = bf2f(pr[CD_KR + 16 + lane]);
                pr[CD_KR + lane] = f2bf(a * cs - b2 * sn); pr[CD_KR + 16 + lane] = f2bf(a * sn + b2 * cs);
            }
            {
                const int c = lane * 2;
                const unsigned w = *(const unsigned*)(pr + CD_GL + c);
                const unsigned wp = s > 0 ? *(const unsigned*)(pr - CD_N + CD_GL + c) : 0u;
                const unsigned wn = s < SEQ - 1 ? *(const unsigned*)(pr + CD_N + CD_GL + c) : 0u;
                const float m0 = mu[CD_GL - CD_RW0 + c], m1 = mu[CD_GL - CD_RW0 + c + 1];
                const float g0 = lo2f(w) + m0 * (0.5f * (lo2f(wp) + lo2f(wn)) - lo2f(w));
                const float g1 = hi2f(w) + m1 * (0.5f * (hi2f(wp) + hi2f(wn)) - hi2f(w));
                *(unsigned*)(SG + ((size_t)bl * SEQ + s) * 128 + c) = pack2(sigmoidf_(g0), sigmoidf_(g1));
            }
        }
    }
}

PHASE_FN void phase_upproj(const KP& kp, unsigned char* lds) {
    const bf16_t* P = WSP(const bf16_t, WS_BIG + L1_P);
    const int nq = (RGL / 256) * 6, nkv = (RG / 256) * 8;
    for (int u = obid(); u < nq + nkv; u += gridDim.x) {
        if (u < nq) {
            GA ga{P + CD_M0, nullptr, CD_N, 0, 384, nullptr, RGL, 1, 0};
            EpiBf ep{WSP(bf16_t, WS_BIG + L1_Q), 768, RGL, 768};
            gemm_tile(lds, ga, WSP(const bf16_t, WS_WMIX + WM_UQ), 384, u / 6, u % 6, ep);
        } else { const int v = u - nq;
            GA ga{P + CD_M1, nullptr, CD_N, 0, 256, nullptr, RG, 0, 0};
            EpiBf ep{WSP(bf16_t, WS_BIG + L1_KV), 1024, RG, 1024};
            gemm_tile(lds, ga, WSP(const bf16_t, WS_WMIX + WM_UKV), 256, v >> 3, v & 7, ep);
        }
    }
}

constexpr int AT_LQ = 104, AT_LV = 72;
PHASE_FN void attn_unit(const KP& kp, unsigned char* lds, int bl, int head, int qb) {
    const int tid = otid(), lane = tid & 63, wid = __builtin_amdgcn_readfirstlane(tid >> 6), fr = lane & 15, fq = lane >> 4;
    bf16_t* Qs = (bf16_t*)lds;
    bf16_t* Kt = Qs + 128 * AT_LQ;
    bf16_t* Vt = Kt + 64 * AT_LQ;
    const bf16_t* P = WSP(const bf16_t, WS_BIG + L1_P);
    const bf16_t* Q = WSP(const bf16_t, WS_BIG + L1_Q);
    const bf16_t* KV = WSP(const bf16_t, WS_BIG + L1_KV);
    bf16_t* AOUT = WSP(bf16_t, WS_BIG + L1_AOUT);
    const float SC = 0.10206207261596577f;
#pragma unroll
    for (int i = 0; i < 3; ++i) { const int p = tid + i * 512, r = p / 12, c = p % 12;
        *(u32x4*)(Qs + r * AT_LQ + c * 8) = *(const u32x4*)(Q + ((size_t)bl * SEQ + qb * 128 + r) * 768 + head * 96 + c * 8); }
    lds_barrier();
#pragma unroll
    for (int i = 0; i < 4; ++i) { const int p = tid + i * 512, r = p >> 4, f = p & 15, s = qb * 128 + r;
        const float pos = (f < 8) ? (float)(s >> 6) : (float)(s & 63);
        const float inv = __expf(-(float)(f & 7) * (9.210340371976184f / 8.0f));
        float sn, cs; sincosf(pos * inv, &sn, &cs);
        const float a = bf2f(Qs[r * AT_LQ + 64 + f]), b2 = bf2f(Qs[r * AT_LQ + 80 + f]);
        Qs[r * AT_LQ + 64 + f] = f2bf(a * cs - b2 * sn); Qs[r * AT_LQ + 80 + f] = f2bf(a * sn + b2 * cs); }
    lds_barrier();
    bf16x8 qf[3];
#pragma unroll
    for (int k = 0; k < 3; ++k) qf[k] = ldfrag(Qs, AT_LQ, wid * 16, k * 32, fr, fq);
    f32x4 ot[4];
#pragma unroll
    for (int i = 0; i < 4; ++i) ot[i] = (f32x4){0.f, 0.f, 0.f, 0.f};
    float mrow = -1e30f, lsum = 0.f;
    u32x4 pk0, pk1, pvv;
    const int kkey0 = tid / 12, kc0 = tid % 12, kkey1 = (tid + 512) / 12, kc1 = (tid + 512) % 12, vkey = tid & 63, vc8 = tid >> 6;
#define AT_REQ(kt_) do { const size_t rb_ = (size_t)bl * TT + (kt_) * 64; \
        pk0 = kc0 < 8 ? *(const u32x4*)(KV + (rb_ + kkey0) * 1024 + head * 128 + kc0 * 8) : *(const u32x4*)(P + (rb_ + kkey0) * CD_N + CD_KR + (kc0 - 8) * 8); \
        if (tid < 256) pk1 = kc1 < 8 ? *(const u32x4*)(KV + (rb_ + kkey1) * 1024 + head * 128 + kc1 * 8) : *(const u32x4*)(P + (rb_ + kkey1) * CD_N + CD_KR + (kc1 - 8) * 8); \
        pvv = *(const u32x4*)(KV + (rb_ + vkey) * 1024 + head * 128 + 64 + vc8 * 8); } while (0)
    AT_REQ(0);
    for (int kt = 0; kt < TT / 64; ++kt) {
        lds_barrier();
        *(u32x4*)(Kt + kkey0 * AT_LQ + kc0 * 8) = pk0;
        if (tid < 256) *(u32x4*)(Kt + kkey1 * AT_LQ + kc1 * 8) = pk1;
        { bf16_t* vt = Vt + (vc8 * 8) * AT_LV + vkey; const u32x4 v = pvv;
            vt[0 * AT_LV] = (bf16_t)(v.x & 0xffff); vt[1 * AT_LV] = (bf16_t)(v.x >> 16); vt[2 * AT_LV] = (bf16_t)(v.y & 0xffff); vt[3 * AT_LV] = (bf16_t)(v.y >> 16);
            vt[4 * AT_LV] = (bf16_t)(v.z & 0xffff); vt[5 * AT_LV] = (bf16_t)(v.z >> 16); vt[6 * AT_LV] = (bf16_t)(v.w & 0xffff); vt[7 * AT_LV] = (bf16_t)(v.w >> 16); }
        if (kt + 1 < TT / 64) AT_REQ(kt + 1);
        lds_barrier();
        bf16x8 kf[3][4];
#pragma unroll
        for (int k = 0; k < 3; ++k)
#pragma unroll
            for (int kk = 0; kk < 4; ++kk) kf[k][kk] = ldfrag(Kt, AT_LQ, kk * 16, k * 32, fr, fq);
        u32x2 vlo[2][4], vhi[2][4];
#pragma unroll
        for (int k2 = 0; k2 < 2; ++k2)
#pragma unroll
            for (int dvt = 0; dvt < 4; ++dvt) { const bf16_t* vp = Vt + (dvt * 16 + fr) * AT_LV + k2 * 32 + fq * 4; vlo[k2][dvt] = *(const u32x2*)vp; vhi[k2][dvt] = *(const u32x2*)(vp + 16); }
        __builtin_amdgcn_sched_barrier(0);
        f32x4 st[4];
#pragma unroll
        for (int kk = 0; kk < 4; ++kk) st[kk] = (f32x4){0.f, 0.f, 0.f, 0.f};
#pragma unroll
        for (int k = 0; k < 3; ++k)
#pragma unroll
            for (int kk = 0; kk < 4; ++kk) st[kk] = mma16(kf[k][kk], qf[k], st[kk]);
        float mx = -1e30f;
#pragma unroll
        for (int kk = 0; kk < 4; ++kk) mx = fmaxf(mx, fmaxf(fmaxf(st[kk][0], st[kk][1]), fmaxf(st[kk][2], st[kk][3])));
        mx = fmaxf(mx, __shfl_xor(mx, 16)); mx = fmaxf(mx, __shfl_xor(mx, 32));
        const float mnew = fmaxf(mrow, mx), SC2 = SC * 1.4426950408889634f, mb = mnew * SC2;
        if (__builtin_amdgcn_ballot_w64(mnew > mrow) != 0ull) {
            const float alpha = __builtin_amdgcn_exp2f((mrow - mnew) * SC2);
            lsum *= alpha;
#pragma unroll
            for (int i = 0; i < 4; ++i) ot[i] = ot[i] * alpha;
        }
        mrow = mnew;
#pragma unroll
        for (int kk = 0; kk < 4; ++kk)
#pragma unroll
            for (int r = 0; r < 4; ++r) { const float pv = __builtin_amdgcn_exp2f(st[kk][r] * SC2 - mb); st[kk][r] = pv; lsum += pv; }
        union { bf16x8 v; unsigned u[4]; } pb[2];
#pragma unroll
        for (int k2 = 0; k2 < 2; ++k2) {
            pb[k2].u[0] = pack2(st[2 * k2][0], st[2 * k2][1]); pb[k2].u[1] = pack2(st[2 * k2][2], st[2 * k2][3]);
            pb[k2].u[2] = pack2(st[2 * k2 + 1][0], st[2 * k2 + 1][1]); pb[k2].u[3] = pack2(st[2 * k2 + 1][2], st[2 * k2 + 1][3]); }
#pragma unroll
        for (int k2 = 0; k2 < 2; ++k2)
#pragma unroll
            for (int dvt = 0; dvt < 4; ++dvt) { union { bf16x8 v; u32x2 h[2]; } va; va.h[0] = vlo[k2][dvt]; va.h[1] = vhi[k2][dvt];
                ot[dvt] = mma16(va.v, pb[k2].v, ot[dvt]); }
    }
#undef AT_REQ
    lsum += __shfl_xor(lsum, 16); lsum += __shfl_xor(lsum, 32);
    const float rl = frcp_(lsum);
    const size_t orow = (size_t)bl * SEQ + qb * 128 + wid * 16 + fr;
#pragma unroll
    for (int dvt = 0; dvt < 4; ++dvt) st4bf(AOUT + orow * 1536 + head * 64 + dvt * 16 + fq * 4, ot[dvt] * rl);
}

constexpr int RW_LR = 200, RW_LP = 72;
PHASE_FN void rwkv_unit(const KP& kp, unsigned char* lds, int bl, int h, int dir) {
    const int tid = otid();
    bf16_t* RAW = (bf16_t*)lds;
    bf16_t* TWb = RAW + 34 * RW_LR;
    bf16_t* ALb = TWb + 32 * RW_LP;
    bf16_t* W2T = ALb + 32 * RW_LP;
    bf16_t* A2T = W2T + 64 * RW_LP;
    float* CL = (float*)(A2T + 64 * RW_LP);
    bf16_t* AR = (bf16_t*)(CL + 32 * 64);
    bf16_t* BK = AR + 64 * RW_LP;
    float* AABT = (float*)(BK + 64 * RW_LP);
    bf16_t* ARB = (bf16_t*)(AABT + 32 * 36);
    bf16_t* AAK = ARB + 32 * 40;
    bf16_t* ARK = AAK + 32 * 40;
    float* RHS = (float*)(ARK + 32 * 40);
    float* YB = RHS + 32 * 64;
    bf16_t* ZVT = (bf16_t*)(YB + 32 * 64);
    bf16_t* BKh = ZVT + 64 * RW_LP;
    bf16_t* Sb = BKh + 64 * RW_LP;
    float* PL = (float*)(Sb + 64 * RW_LP);
    const bf16_t* P = WSP(const bf16_t, WS_BIG + L1_P); const bf16_t* TWAL = WSP(const bf16_t, WS_BIG + L1_TWAL);
    bf16_t* OUT = WSP(bf16_t, WS_BIG + (dir ? L1_OB : L1_OF));
    float* BSC = WSP(float, WS_BSC) + (size_t)dir * RGL * 16;
    const float* mu = KIN(24);
    for (int i = tid; i < 64 * 64; i += 512) { const int c = i >> 6, n = i & 63;
        W2T[n * RW_LP + c] = f2bf(KIN(26)[((size_t)dir * 64 + c) * 1024 + h * 64 + n]); A2T[n * RW_LP + c] = f2bf(KIN(28)[((size_t)dir * 64 + c) * 1024 + h * 64 + n]); }
    for (int i = tid; i < 64 * RW_LP; i += 512) Sb[i] = 0;
    float* CV = PL + 64;
    bf16_t* A21b = (bf16_t*)(CV + 8 * 64);
    for (int i = tid; i < 16 * 40; i += 512) A21b[i] = 0;
    for (int i = tid; i < 64 * RW_LP; i += 512) ZVT[i] = 0;
    if (tid < 64) { const int n = tid;
        CV[0 * 64 + n] = KIN(25)[dir * 1024 + h * 64 + n]; CV[1 * 64 + n] = KIN(27)[dir * 1024 + h * 64 + n];
        CV[2 * 64 + n] = KIN(30)[h * 64 + n]; CV[3 * 64 + n] = KIN(31)[h * 64 + n]; CV[4 * 64 + n] = KIN(32)[h * 64 + n];
        CV[5 * 64 + n] = mu[h * 64 + n]; CV[6 * 64 + n] = mu[1024 + h * 64 + n]; CV[7 * 64 + n] = mu[2048 + h * 64 + n]; }
    f32x4 Sacc[2];
    Sacc[0] = (f32x4){0.f, 0.f, 0.f, 0.f}; Sacc[1] = (f32x4){0.f, 0.f, 0.f, 0.f};
    u32x4 pf[3];
#define RW_PREFETCH(cn, tix) do { const int t0n_ = dir ? scan_t<32>(1, (cn), 31) : (cn) * 32; const int lo_ = t0n_ < CTXL ? 0 : CTXL, hi_ = t0n_ < CTXL ? CTXL : TT; \
        _Pragma("unroll") for (int q = 0; q < 2; ++q) { const int p = (tix) + q * 512; pf[q] = (u32x4){0u, 0u, 0u, 0u}; \
            if (p < 34 * 24) { const int rr = p / 24, c = p % 24, t = t0n_ - 1 + rr; \
                if (t >= lo_ && t < hi_) { const int seg = c >> 3, c8 = c & 7; \
                    const int col = (seg == 0 ? CD_R : seg == 1 ? CD_K : CD_V) + h * 64; \
                    pf[q] = *(const u32x4*)(P + ((size_t)bl * TT + t) * CD_N + col + c8 * 8); } } } \
        { const int i_ = (tix) >> 4, c16 = (tix) & 15; \
          pf[2] = *(const u32x4*)(TWAL + ((size_t)bl * TT + t0n_ + i_) * 256 + (c16 >> 3) * 128 + dir * 64 + (c16 & 7) * 8); } } while (0)
    RW_PREFETCH(0, tid);
    lds_barrier();
    for (int ci = 0; ci < TT / 32; ++ci) {
        int tq = tid; asm volatile("" : "+v"(tq));
        const int lane = tq & 63, wid = __builtin_amdgcn_readfirstlane(tq >> 6), fr = lane & 15, fq = lane >> 4, pi = tq >> 4, n4 = (tq & 15) * 4;
        const int t0 = dir ? scan_t<32>(1, ci, 31) : ci * 32;
#pragma unroll
        for (int q = 0; q < 2; ++q) { const int p = tq + q * 512; if (p < 34 * 24) *(u32x4*)(RAW + (p / 24) * RW_LR + (p % 24) * 8) = pf[q]; }
        { const int i_ = tq >> 4, c16 = tq & 15; *(u32x4*)(((c16 >> 3) ? ALb : TWb) + i_ * RW_LP + (c16 & 7) * 8) = pf[2]; }
        if (ci + 1 < TT / 32) RW_PREFETCH(ci + 1, tq);
        lds_barrier();
        {
            const int which = wid >> 2, tt = (wid >> 1) & 1;
            const bf16_t* Xa = which ? ALb : TWb; const bf16_t* Wt = which ? A2T : W2T; float* Od = which ? YB : RHS;
#pragma unroll
            for (int q2 = 0; q2 < 2; ++q2) { const int nt = (wid & 1) * 2 + q2;
                f32x4 acc = (f32x4){0.f, 0.f, 0.f, 0.f};
#pragma unroll
                for (int k = 0; k < 2; ++k) acc = mma16(ldfrag(Xa, RW_LP, tt * 16, k * 32, fr, fq), ldfrag(Wt, RW_LP, nt * 16, k * 32, fr, fq), acc);
#pragma unroll
                for (int rr = 0; rr < 4; ++rr) Od[(tt * 16 + fq * 4 + rr) * 64 + nt * 16 + fr] = acc[rr]; }
        }
        lds_barrier();
        const int j = dir ? 31 - pi : pi;
        f32x4 r, kd, v, av, bv;
        {
            const f32x4 w0v = *(const f32x4*)(CV + n4), a0v = *(const f32x4*)(CV + 64 + n4), kkw = *(const f32x4*)(CV + 128 + n4), kaw = *(const f32x4*)(CV + 192 + n4), rkw = *(const f32x4*)(CV + 256 + n4);
            const f32x4 mur = *(const f32x4*)(CV + 320 + n4), muk = *(const f32x4*)(CV + 384 + n4), muv = *(const f32x4*)(CV + 448 + n4);
            const f32x4 wl = w0v + *(const f32x4*)(RHS + pi * 64 + n4), al = a0v + *(const f32x4*)(YB + pi * 64 + n4);
            const bf16_t* r1 = RAW + (pi + 1) * RW_LR; const bf16_t* rp = RAW + pi * RW_LR; const bf16_t* rn = RAW + (pi + 2) * RW_LR;
            f32x4 k;
            r = ld4bf(r1 + n4); k = ld4bf(r1 + 64 + n4); v = ld4bf(r1 + 128 + n4);
            r = r + mur * ((ld4bf(rp + n4) + ld4bf(rn + n4)) * 0.5f - r);
            k = k + muk * ((ld4bf(rp + 64 + n4) + ld4bf(rn + 64 + n4)) * 0.5f - k);
            v = v + muv * ((ld4bf(rp + 128 + n4) + ld4bf(rn + 128 + n4)) * 0.5f - v);
            f32x4 a, lw, kk = k * kkw;
            float ssq = kk[0] * kk[0] + kk[1] * kk[1] + kk[2] * kk[2] + kk[3] * kk[3];
            ssq += __shfl_xor(ssq, 1); ssq += __shfl_xor(ssq, 2); ssq += __shfl_xor(ssq, 4); ssq += __shfl_xor(ssq, 8);
            kk = kk * __builtin_amdgcn_rsqf(fmaxf(ssq, 1e-24f));
#pragma unroll
            for (int q = 0; q < 4; ++q) { const float wlog = -softplusf_(-wl[q]) - 0.5f; lw[q] = -__expf(wlog); a[q] = sigmoidf_(al[q]); }
            kd = k * ((a - 1.0f) * kaw + 1.0f);
            float bs = r[0] * kd[0] * rkw[0] + r[1] * kd[1] * rkw[1] + r[2] * kd[2] * rkw[2] + r[3] * kd[3] * rkw[3];
            bs += __shfl_xor(bs, 1); bs += __shfl_xor(bs, 2); bs += __shfl_xor(bs, 4); bs += __shfl_xor(bs, 8);
            av = kk * -1.0f; bv = kk * a;
            *(f32x4*)(CL + j * 64 + n4) = lw;
            const int t = t0 + pi;
            if (t >= CTXL && (tq & 15) == 0) BSC[((size_t)bl * SEQ + (t - CTXL)) * 16 + h] = bs;
        }
        lds_barrier();
        if (wid == 0) {
            float c[32];
#pragma unroll
            for (int q = 0; q < 32; ++q) c[q] = CL[q * 64 + lane];
#pragma unroll
            for (int q = 1; q < 32; ++q) c[q] += c[q - 1];
#pragma unroll
            for (int q = 0; q < 32; ++q) CL[q * 64 + lane] = c[q];
            PL[lane] = __expf(c[31]);
        }
        lds_barrier();
        {
            const f32x4 clj = *(const f32x4*)(CL + j * 64 + n4), cle = *(const f32x4*)(CL + 31 * 64 + n4);
            f32x4 clp = (f32x4){0.f, 0.f, 0.f, 0.f};
            if (j > 0) clp = *(const f32x4*)(CL + (j - 1) * 64 + n4);
            f32x4 at, rt, bt, kt, bh, kh;
#pragma unroll
            for (int q = 0; q < 4; ++q) { const float ep = __expf(clp[q]), ej = __expf(clj[q]), ei = __expf(-clj[q]), ee = __expf(cle[q] - clj[q]);
                at[q] = av[q] * ep; rt[q] = r[q] * ej; bt[q] = bv[q] * ei; kt[q] = kd[q] * ei; bh[q] = bv[q] * ee; kh[q] = kd[q] * ee; }
            st4bf(AR + j * RW_LP + n4, at); st4bf(AR + (32 + j) * RW_LP + n4, rt);
            st4bf(BK + j * RW_LP + n4, bt); st4bf(BK + (32 + j) * RW_LP + n4, kt);
#pragma unroll
            for (int q = 0; q < 4; ++q) { BKh[(n4 + q) * RW_LP + j] = f2bf(bh[q]); BKh[(n4 + q) * RW_LP + 32 + j] = f2bf(kh[q]); ZVT[(n4 + q) * RW_LP + 32 + j] = f2bf(v[q]); }
        }
        lds_barrier();
        {
            const int ti = wid >> 1;
#pragma unroll
            for (int q2 = 0; q2 < 2; ++q2) {
                const int si = (wid & 1) * 2 + q2;
                f32x4 acc = (f32x4){0.f, 0.f, 0.f, 0.f};
#pragma unroll
                for (int k = 0; k < 2; ++k) acc = mma16(ldfrag(AR, RW_LP, ti * 16, k * 32, fr, fq), ldfrag(BK, RW_LP, si * 16, k * 32, fr, fq), acc);
                const int sp = si * 16 + fr, s = sp & 31;
#pragma unroll
                for (int rr = 0; rr < 4; ++rr) { const int tp = ti * 16 + fq * 4 + rr, t = tp & 31;
                    const bool incl = tp >= 32;
                    const float val = (incl ? (s <= t) : (s < t)) ? acc[rr] : 0.f;
                    if (sp < 32) { if (incl) ARB[t * 40 + s] = f2bf(val); else { AABT[s * 36 + t] = val; if (t >= 16 && s < 16) A21b[(t - 16) * 40 + s] = f2bf(val); } }
                    else { (incl ? ARK : AAK)[t * 40 + s] = f2bf(val); } }
            }
        }
        lds_barrier();
        {
            const int which = wid >> 2, tt = (wid >> 1) & 1;
            const bf16_t* Ak = which ? ARK : AAK; float* Od = which ? YB : RHS;
#pragma unroll
            for (int q2 = 0; q2 < 2; ++q2) {
                const int vt = (wid & 1) * 2 + q2;
                f32x4 acc = (f32x4){0.f, 0.f, 0.f, 0.f};
#pragma unroll
                for (int k = 0; k < 2; ++k) acc = mma16(ldfrag(AR, RW_LP, which * 32 + tt * 16, k * 32, fr, fq), ldfrag(Sb, RW_LP, vt * 16, k * 32, fr, fq), acc);
                acc = mma16(ldfrag(Ak, 40, tt * 16, 0, fr, fq), ldfrag(ZVT, RW_LP, vt * 16, 32, fr, fq), acc);
#pragma unroll
                for (int rr = 0; rr < 4; ++rr) Od[(tt * 16 + fq * 4 + rr) * 64 + vt * 16 + fr] = acc[rr];
            }
        }
        lds_barrier();
        {
            if (wid == 0) {
                float z[16]; f32x4 ca0, ca1, ca2, ca3, cb0, cb1, cb2, cb3;
#pragma unroll
                for (int t = 0; t < 16; ++t) z[t] = RHS[(0 + t) * 64 + lane];
                ca0 = *(const f32x4*)(AABT + 0 * 36 + 0); ca1 = *(const f32x4*)(AABT + 0 * 36 + 4); ca2 = *(const f32x4*)(AABT + 0 * 36 + 8); ca3 = *(const f32x4*)(AABT + 0 * 36 + 12);
                cb0 = *(const f32x4*)(AABT + 1 * 36 + 0); cb1 = *(const f32x4*)(AABT + 1 * 36 + 4); cb2 = *(const f32x4*)(AABT + 1 * 36 + 8); cb3 = *(const f32x4*)(AABT + 1 * 36 + 12);
                { const float zs = z[0]; z[1] = __builtin_fmaf(ca0[1], zs, z[1]); z[2] = __builtin_fmaf(ca0[2], zs, z[2]); z[3] = __builtin_fmaf(ca0[3], zs, z[3]); z[4] = __builtin_fmaf(ca1[0], zs, z[4]); z[5] = __builtin_fmaf(ca1[1], zs, z[5]); z[6] = __builtin_fmaf(ca1[2], zs, z[6]); z[7] = __builtin_fmaf(ca1[3], zs, z[7]); z[8] = __builtin_fmaf(ca2[0], zs, z[8]); z[9] = __builtin_fmaf(ca2[1], zs, z[9]); z[10] = __builtin_fmaf(ca2[2], zs, z[10]); z[11] = __builtin_fmaf(ca2[3], zs, z[11]); z[12] = __builtin_fmaf(ca3[0], zs, z[12]); z[13] = __builtin_fmaf(ca3[1], zs, z[13]); z[14] = __builtin_fmaf(ca3[2], zs, z[14]); z[15] = __builtin_fmaf(ca3[3], zs, z[15]); }
                asm volatile("" : "+v"(z[1]) :: "memory");
                ca0 = *(const f32x4*)(AABT + 2 * 36 + 0); ca1 = *(const f32x4*)(AABT + 2 * 36 + 4); ca2 = *(const f32x4*)(AABT + 2 * 36 + 8); ca3 = *(const f32x4*)(AABT + 2 * 36 + 12);
                { const float zs = z[1]; z[2] = __builtin_fmaf(cb0[2], zs, z[2]); z[3] = __builtin_fmaf(cb0[3], zs, z[3]); z[4] = __builtin_fmaf(cb1[0], zs, z[4]); z[5] = __builtin_fmaf(cb1[1], zs, z[5]); z[6] = __builtin_fmaf(cb1[2], zs, z[6]); z[7] = __builtin_fmaf(cb1[3], zs, z[7]); z[8] = __builtin_fmaf(cb2[0], zs, z[8]); z[9] = __builtin_fmaf(cb2[1], zs, z[9]); z[10] = __builtin_fmaf(cb2[2], zs, z[10]); z[11] = __builtin_fmaf(cb2[3], zs, z[11]); z[12] = __builtin_fmaf(cb3[0], zs, z[12]); z[13] = __builtin_fmaf(cb3[1], zs, z[13]); z[14] = __builtin_fmaf(cb3[2], zs, z[14]); z[15] = __builtin_fmaf(cb3[3], zs, z[15]); }
                asm volatile("" : "+v"(z[2]) :: "memory");
                cb1 = *(const f32x4*)(AABT + 3 * 36 + 4); cb2 = *(const f32x4*)(AABT + 3 * 36 + 8); cb3 = *(const f32x4*)(AABT + 3 * 36 + 12);
                { const float zs = z[2]; z[3] = __builtin_fmaf(ca0[3], zs, z[3]); z[4] = __builtin_fmaf(ca1[0], zs, z[4]); z[5] = __builtin_fmaf(ca1[1], zs, z[5]); z[6] = __builtin_fmaf(ca1[2], zs, z[6]); z[7] = __builtin_fmaf(ca1[3], zs, z[7]); z[8] = __builtin_fmaf(ca2[0], zs, z[8]); z[9] = __builtin_fmaf(ca2[1], zs, z[9]); z[10] = __builtin_fmaf(ca2[2], zs, z[10]); z[11] = __builtin_fmaf(ca2[3], zs, z[11]); z[12] = __builtin_fmaf(ca3[0], zs, z[12]); z[13] = __builtin_fmaf(ca3[1], zs, z[13]); z[14] = __builtin_fmaf(ca3[2], zs, z[14]); z[15] = __builtin_fmaf(ca3[3], zs, z[15]); }
                asm volatile("" : "+v"(z[3]) :: "memory");
                ca1 = *(const f32x4*)(AABT + 4 * 36 + 4); ca2 = *(const f32x4*)(AABT + 4 * 36 + 8); ca3 = *(const f32x4*)(AABT + 4 * 36 + 12);
                { const float zs = z[3]; z[4] = __builtin_fmaf(cb1[0], zs, z[4]); z[5] = __builtin_fmaf(cb1[1], zs, z[5]); z[6] = __builtin_fmaf(cb1[2], zs, z[6]); z[7] = __builtin_fmaf(cb1[3], zs, z[7]); z[8] = __builtin_fmaf(cb2[0], zs, z[8]); z[9] = __builtin_fmaf(cb2[1], zs, z[9]); z[10] = __builtin_fmaf(cb2[2], zs, z[10]); z[11] = __builtin_fmaf(cb2[3], zs, z[11]); z[12] = __builtin_fmaf(cb3[0], zs, z[12]); z[13] = __builtin_fmaf(cb3[1], zs, z[13]); z[14] = __builtin_fmaf(cb3[2], zs, z[14]); z[15] = __builtin_fmaf(cb3[3], zs, z[15]); }
                asm volatile("" : "+v"(z[4]) :: "memory");
                cb1 = *(const f32x4*)(AABT + 5 * 36 + 4); cb2 = *(const f32x4*)(AABT + 5 * 36 + 8); cb3 = *(const f32x4*)(AABT + 5 * 36 + 12);
                { const float zs = z[4]; z[5] = __builtin_fmaf(ca1[1], zs, z[5]); z[6] = __builtin_fmaf(ca1[2], zs, z[6]); z[7] = __builtin_fmaf(ca1[3], zs, z[7]); z[8] = __builtin_fmaf(ca2[0], zs, z[8]); z[9] = __builtin_fmaf(ca2[1], zs, z[9]); z[10] = __builtin_fmaf(ca2[2], zs, z[10]); z[11] = __builtin_fmaf(ca2[3], zs, z[11]); z[12] = __builtin_fmaf(ca3[0], zs, z[12]); z[13] = __builtin_fmaf(ca3[1], zs, z[13]); z[14] = __builtin_fmaf(ca3[2], zs, z[14]); z[15] = __builtin_fmaf(ca3[3], zs, z[15]); }
                asm volatile("" : "+v"(z[5]) :: "memory");
                ca1 = *(const f32x4*)(AABT + 6 * 36 + 4); ca2 = *(const f32x4*)(AABT + 6 * 36 + 8); ca3 = *(const f32x4*)(AABT + 6 * 36 + 12);
                { const float zs = z[5]; z[6] = __builtin_fmaf(cb1[2], zs, z[6]); z[7] = __builtin_fmaf(cb1[3], zs, z[7]); z[8] = __builtin_fmaf(cb2[0], zs, z[8]); z[9] = __builtin_fmaf(cb2[1], zs, z[9]); z[10] = __builtin_fmaf(cb2[2], zs, z[10]); z[11] = __builtin_fmaf(cb2[3], zs, z[11]); z[12] = __builtin_fmaf(cb3[0], zs, z[12]); z[13] = __builtin_fmaf(cb3[1], zs, z[13]); z[14] = __builtin_fmaf(cb3[2], zs, z[14]); z[15] = __builtin_fmaf(cb3[3], zs, z[15]); }
                asm volatile("" : "+v"(z[6]) :: "memory");
                cb2 = *(const f32x4*)(AABT + 7 * 36 + 8); cb3 = *(const f32x4*)(AABT + 7 * 36 + 12);
                { const float zs = z[6]; z[7] = __builtin_fmaf(ca1[3], zs, z[7]); z[8] = __builtin_fmaf(ca2[0], zs, z[8]); z[9] = __builtin_fmaf(ca2[1], zs, z[9]); z[10] = __builtin_fmaf(ca2[2], zs, z[10]); z[11] = __builtin_fmaf(ca2[3], zs, z[11]); z[12] = __builtin_fmaf(ca3[0], zs, z[12]); z[13] = __builtin_fmaf(ca3[1], zs, z[13]); z[14] = __builtin_fmaf(ca3[2], zs, z[14]); z[15] = __builtin_fmaf(ca3[3], zs, z[15]); }
                asm volatile("" : "+v"(z[7]) :: "memory");
                ca2 = *(const f32x4*)(AABT + 8 * 36 + 8); ca3 = *(const f32x4*)(AABT + 8 * 36 + 12);
                { const float zs = z[7]; z[8] = __builtin_fmaf(cb2[0], zs, z[8]); z[9] = __builtin_fmaf(cb2[1], zs, z[9]); z[10] = __builtin_fmaf(cb2[2], zs, z[10]); z[11] = __builtin_fmaf(cb2[3], zs, z[11]); z[12] = __builtin_fmaf(cb3[0], zs, z[12]); z[13] = __builtin_fmaf(cb3[1], zs, z[13]); z[14] = __builtin_fmaf(cb3[2], zs, z[14]); z[15] = __builtin_fmaf(cb3[3], zs, z[15]); }
                asm volatile("" : "+v"(z[8]) :: "memory");
                cb2 = *(const f32x4*)(AABT + 9 * 36 + 8); cb3 = *(const f32x4*)(AABT + 9 * 36 + 12);
                { const float zs = z[8]; z[9] = __builtin_fmaf(ca2[1], zs, z[9]); z[10] = __builtin_fmaf(ca2[2], zs, z[10]); z[11] = __builtin_fmaf(ca2[3], zs, z[11]); z[12] = __builtin_fmaf(ca3[0], zs, z[12]); z[13] = __builtin_fmaf(ca3[1], zs, z[13]); z[14] = __builtin_fmaf(ca3[2], zs, z[14]); z[15] = __builtin_fmaf(ca3[3], zs, z[15]); }
                asm volatile("" : "+v"(z[9]) :: "memory");
                ca2 = *(const f32x4*)(AABT + 10 * 36 + 8); ca3 = *(const f32x4*)(AABT + 10 * 36 + 12);
                { const float zs = z[9]; z[10] = __builtin_fmaf(cb2[2], zs, z[10]); z[11] = __builtin_fmaf(cb2[3], zs, z[11]); z[12] = __builtin_fmaf(cb3[0], zs, z[12]); z[13] = __builtin_fmaf(cb3[1], zs, z[13]); z[14] = __builtin_fmaf(cb3[2], zs, z[14]); z[15] = __builtin_fmaf(cb3[3], zs, z[15]); }
                asm volatile("" : "+v"(z[10]) :: "memory");
                cb3 = *(const f32x4*)(AABT + 11 * 36 + 12);
                { const float zs = z[10]; z[11] = __builtin_fmaf(ca2[3], zs, z[11]); z[12] = __builtin_fmaf(ca3[0], zs, z[12]); z[13] = __builtin_fmaf(ca3[1], zs, z[13]); z[14] = __builtin_fmaf(ca3[2], zs, z[14]); z[15] = __builtin_fmaf(ca3[3], zs, z[15]); }
                asm volatile("" : "+v"(z[11]) :: "memory");
                ca3 = *(const f32x4*)(AABT + 12 * 36 + 12);
                { const float zs = z[11]; z[12] = __builtin_fmaf(cb3[0], zs, z[12]); z[13] = __builtin_fmaf(cb3[1], zs, z[13]); z[14] = __builtin_fmaf(cb3[2], zs, z[14]); z[15] = __builtin_fmaf(cb3[3], zs, z[15]); }
                asm volatile("" : "+v"(z[12]) :: "memory");
                cb3 = *(const f32x4*)(AABT + 13 * 36 + 12);
                { const float zs = z[12]; z[13] = __builtin_fmaf(ca3[1], zs, z[13]); z[14] = __builtin_fmaf(ca3[2], zs, z[14]); z[15] = __builtin_fmaf(ca3[3], zs, z[15]); }
                asm volatile("" : "+v"(z[13]) :: "memory");
                ca3 = *(const f32x4*)(AABT + 14 * 36 + 12);
                { const float zs = z[13]; z[14] = __builtin_fmaf(cb3[2], zs, z[14]); z[15] = __builtin_fmaf(cb3[3], zs, z[15]); }
                asm volatile("" : "+v"(z[14]) :: "memory");
                { const float zs = z[14]; z[15] = __builtin_fmaf(ca3[3], zs, z[15]); }
                asm volatile("" : "+v"(z[15]) :: "memory");
#pragma unroll
                for (int q = 0; q < 2; ++q) { u32x4 w; w.x = pack2(z[q * 8 + 0], z[q * 8 + 1]); w.y = pack2(z[q * 8 + 2], z[q * 8 + 3]); w.z = pack2(z[q * 8 + 4], z[q * 8 + 5]); w.w = pack2(z[q * 8 + 6], z[q * 8 + 7]);
                    *(u32x4*)(ZVT + lane * RW_LP + 0 + q * 8) = w; }
            }
            lds_barrier();
            if (wid < 4) {
                f32x4 acc = (f32x4){0.f, 0.f, 0.f, 0.f};
                acc = mma16(ldfrag(A21b, 40, 0, 0, fr, fq), ldfrag(ZVT, RW_LP, wid * 16, 0, fr, fq), acc);
#pragma unroll
                for (int rr = 0; rr < 4; ++rr) RHS[(16 + fq * 4 + rr) * 64 + wid * 16 + fr] += acc[rr];
            }
            lds_barrier();
            if (wid == 0) {
                float z[16]; f32x4 ca0, ca1, ca2, ca3, cb0, cb1, cb2, cb3;
#pragma unroll
                for (int t = 0; t < 16; ++t) z[t] = RHS[(16 + t) * 64 + lane];
                ca0 = *(const f32x4*)(AABT + 16 * 36 + 16); ca1 = *(const f32x4*)(AABT + 16 * 36 + 20); ca2 = *(const f32x4*)(AABT + 16 * 36 + 24); ca3 = *(const f32x4*)(AABT + 16 * 36 + 28);
                cb0 = *(const f32x4*)(AABT + 17 * 36 + 16); cb1 = *(const f32x4*)(AABT + 17 * 36 + 20); cb2 = *(const f32x4*)(AABT + 17 * 36 + 24); cb3 = *(const f32x4*)(AABT + 17 * 36 + 28);
                { const float zs = z[0]; z[1] = __builtin_fmaf(ca0[1], zs, z[1]); z[2] = __builtin_fmaf(ca0[2], zs, z[2]); z[3] = __builtin_fmaf(ca0[3], zs, z[3]); z[4] = __builtin_fmaf(ca1[0], zs, z[4]); z[5] = __builtin_fmaf(ca1[1], zs, z[5]); z[6] = __builtin_fmaf(ca1[2], zs, z[6]); z[7] = __builtin_fmaf(ca1[3], zs, z[7]); z[8] = __builtin_fmaf(ca2[0], zs, z[8]); z[9] = __builtin_fmaf(ca2[1], zs, z[9]); z[10] = __builtin_fmaf(ca2[2], zs, z[10]); z[11] = __builtin_fmaf(ca2[3], zs, z[11]); z[12] = __builtin_fmaf(ca3[0], zs, z[12]); z[13] = __builtin_fmaf(ca3[1], zs, z[13]); z[14] = __builtin_fmaf(ca3[2], zs, z[14]); z[15] = __builtin_fmaf(ca3[3], zs, z[15]); }
                asm volatile("" : "+v"(z[1]) :: "memory");
                ca0 = *(const f32x4*)(AABT + 18 * 36 + 16); ca1 = *(const f32x4*)(AABT + 18 * 36 + 20); ca2 = *(const f32x4*)(AABT + 18 * 36 + 24); ca3 = *(const f32x4*)(AABT + 18 * 36 + 28);
                { const float zs = z[1]; z[2] = __builtin_fmaf(cb0[2], zs, z[2]); z[3] = __builtin_fmaf(cb0[3], zs, z[3]); z[4] = __builtin_fmaf(cb1[0], zs, z[4]); z[5] = __builtin_fmaf(cb1[1], zs, z[5]); z[6] = __builtin_fmaf(cb1[2], zs, z[6]); z[7] = __builtin_fmaf(cb1[3], zs, z[7]); z[8] = __builtin_fmaf(cb2[0], zs, z[8]); z[9] = __builtin_fmaf(cb2[1], zs, z[9]); z[10] = __builtin_fmaf(cb2[2], zs, z[10]); z[11] = __builtin_fmaf(cb2[3], zs, z[11]); z[12] = __builtin_fmaf(cb3[0], zs, z[12]); z[13] = __builtin_fmaf(cb3[1], zs, z[13]); z[14] = __builtin_fmaf(cb3[2], zs, z[14]); z[15] = __builtin_fmaf(cb3[3], zs, z[15]); }
                asm volatile("" : "+v"(z[2]) :: "memory");
                cb1 = *(const f32x4*)(AABT + 19 * 36 + 20); cb2 = *(const f32x4*)(AABT + 19 * 36 + 24); cb3 = *(const f32x4*)(AABT + 19 * 36 + 28);
                { const float zs = z[2]; z[3] = __builtin_fmaf(ca0[3], zs, z[3]); z[4] = __builtin_fmaf(ca1[0], zs, z[4]); z[5] = __builtin_fmaf(ca1[1], zs, z[5]); z[6] = __builtin_fmaf(ca1[2], zs, z[6]); z[7] = __builtin_fmaf(ca1[3], zs, z[7]); z[8] = __builtin_fmaf(ca2[0], zs, z[8]); z[9] = __builtin_fmaf(ca2[1], zs, z[9]); z[10] = __builtin_fmaf(ca2[2], zs, z[10]); z[11] = __builtin_fmaf(ca2[3], zs, z[11]); z[12] = __builtin_fmaf(ca3[0], zs, z[12]); z[13] = __builtin_fmaf(ca3[1], zs, z[13]); z[14] = __builtin_fmaf(ca3[2], zs, z[14]); z[15] = __builtin_fmaf(ca3[3], zs, z[15]); }
                asm volatile("" : "+v"(z[3]) :: "memory");
                ca1 = *(const f32x4*)(AABT + 20 * 36 + 20); ca2 = *(const f32x4*)(AABT + 20 * 36 + 24); ca3 = *(const f32x4*)(AABT + 20 * 36 + 28);
                { const float zs = z[3]; z[4] = __builtin_fmaf(cb1[0], zs, z[4]); z[5] = __builtin_fmaf(cb1[1], zs, z[5]); z[6] = __builtin_fmaf(cb1[2], zs, z[6]); z[7] = __builtin_fmaf(cb1[3], zs, z[7]); z[8] = __builtin_fmaf(cb2[0], zs, z[8]); z[9] = __builtin_fmaf(cb2[1], zs, z[9]); z[10] = __builtin_fmaf(cb2[2], zs, z[10]); z[11] = __builtin_fmaf(cb2[3], zs, z[11]); z[12] = __builtin_fmaf(cb3[0], zs, z[12]); z[13] = __builtin_fmaf(cb3[1], zs, z[13]); z[14] = __builtin_fmaf(cb3[2], zs, z[14]); z[15] = __builtin_fmaf(cb3[3], zs, z[15]); }
                asm volatile("" : "+v"(z[4]) :: "memory");
                cb1 = *(const f32x4*)(AABT + 21 * 36 + 20); cb2 = *(const f32x4*)(AABT + 21 * 36 + 24); cb3 = *(const f32x4*)(AABT + 21 * 36 + 28);
                { const float zs = z[4]; z[5] = __builtin_fmaf(ca1[1], zs, z[5]); z[6] = __builtin_fmaf(ca1[2], zs, z[6]); z[7] = __builtin_fmaf(ca1[3], zs, z[7]); z[8] = __builtin_fmaf(ca2[0], zs, z[8]); z[9] = __builtin_fmaf(ca2[1], zs, z[9]); z[10] = __builtin_fmaf(ca2[2], zs, z[10]); z[11] = __builtin_fmaf(ca2[3], zs, z[11]); z[12] = __builtin_fmaf(ca3[0], zs, z[12]); z[13] = __builtin_fmaf(ca3[1], zs, z[13]); z[14] = __builtin_fmaf(ca3[2], zs, z[14]); z[15] = __builtin_fmaf(ca3[3], zs, z[15]); }
                asm volatile("" : "+v"(z[5]) :: "memory");
                ca1 = *(const f32x4*)(AABT + 22 * 36 + 20); ca2 = *(const f32x4*)(AABT + 22 * 36 + 24); ca3 = *(const f32x4*)(AABT + 22 * 36 + 28);
                { const float zs = z[5]; z[6] = __builtin_fmaf(cb1[2], zs, z[6]); z[7] = __builtin_fmaf(cb1[3], zs, z[7]); z[8] = __builtin_fmaf(cb2[0], zs, z[8]); z[9] = __builtin_fmaf(cb2[1], zs, z[9]); z[10] = __builtin_fmaf(cb2[2], zs, z[10]); z[11] = __builtin_fmaf(cb2[3], zs, z[11]); z[12] = __builtin_fmaf(cb3[0], zs, z[12]); z[13] = __builtin_fmaf(cb3[1], zs, z[13]); z[14] = __builtin_fmaf(cb3[2], zs, z[14]); z[15] = __builtin_fmaf(cb3[3], zs, z[15]); }
                asm volatile("" : "+v"(z[6]) :: "memory");
                cb2 = *(const f32x4*)(AABT + 23 * 36 + 24); cb3 = *(const f32x4*)(AABT + 23 * 36 + 28);
                { const float zs = z[6]; z[7] = __builtin_fmaf(ca1[3], zs, z[7]); z[8] = __builtin_fmaf(ca2[0], zs, z[8]); z[9] = __builtin_fmaf(ca2[1], zs, z[9]); z[10] = __builtin_fmaf(ca2[2], zs, z[10]); z[11] = __builtin_fmaf(ca2[3], zs, z[11]); z[12] = __builtin_fmaf(ca3[0], zs, z[12]); z[13] = __builtin_fmaf(ca3[1], zs, z[13]); z[14] = __builtin_fmaf(ca3[2], zs, z[14]); z[15] = __builtin_fmaf(ca3[3], zs, z[15]); }
                asm volatile("" : "+v"(z[7]) :: "memory");
                ca2 = *(const f32x4*)(AABT + 24 * 36 + 24); ca3 = *(const f32x4*)(AABT + 24 * 36 + 28);
                { const float zs = z[7]; z[8] = __builtin_fmaf(cb2[0], zs, z[8]); z[9] = __builtin_fmaf(cb2[1], zs, z[9]); z[10] = __builtin_fmaf(cb2[2], zs, z[10]); z[11] = __builtin_fmaf(cb2[3], zs, z[11]); z[12] = __builtin_fmaf(cb3[0], zs, z[12]); z[13] = __builtin_fmaf(cb3[1], zs, z[13]); z[14] = __builtin_fmaf(cb3[2], zs, z[14]); z[15] = __builtin_fmaf(cb3[3], zs, z[15]); }
                asm volatile("" : "+v"(z[8]) :: "memory");
                cb2 = *(const f32x4*)(AABT + 25 * 36 + 24); cb3 = *(const f32x4*)(AABT + 25 * 36 + 28);
                { const float zs = z[8]; z[9] = __builtin_fmaf(ca2[1], zs, z[9]); z[10] = __builtin_fmaf(ca2[2], zs, z[10]); z[11] = __builtin_fmaf(ca2[3], zs, z[11]); z[12] = __builtin_fmaf(ca3[0], zs, z[12]); z[13] = __builtin_fmaf(ca3[1], zs, z[13]); z[14] = __builtin_fmaf(ca3[2], zs, z[14]); z[15] = __builtin_fmaf(ca3[3], zs, z[15]); }
                asm volatile("" : "+v"(z[9]) :: "memory");
                ca2 = *(const f32x4*)(AABT + 26 * 36 + 24); ca3 = *(const f32x4*)(AABT + 26 * 36 + 28);
                { const float zs = z[9]; z[10] = __builtin_fmaf(cb2[2], zs, z[10]); z[11] = __builtin_fmaf(cb2[3], zs, z[11]); z[12] = __builtin_fmaf(cb3[0], zs, z[12]); z[13] = __builtin_fmaf(cb3[1], zs, z[13]); z[14] = __builtin_fmaf(cb3[2], zs, z[14]); z[15] = __builtin_fmaf(cb3[3], zs, z[15]); }
                asm volatile("" : "+v"(z[10]) :: "memory");
                cb3 = *(const f32x4*)(AABT + 27 * 36 + 28);
                { const float zs = z[10]; z[11] = __builtin_fmaf(ca2[3], zs, z[11]); z[12] = __builtin_fmaf(ca3[0], zs, z[12]); z[13] = __builtin_fmaf(ca3[1], zs, z[13]); z[14] = __builtin_fmaf(ca3[2], zs, z[14]); z[15] = __builtin_fmaf(ca3[3], zs, z[15]); }
                asm volatile("" : "+v"(z[11]) :: "memory");
                ca3 = *(const f32x4*)(AABT + 28 * 36 + 28);
                { const float zs = z[11]; z[12] = __builtin_fmaf(cb3[0], zs, z[12]); z[13] = __builtin_fmaf(cb3[1], zs, z[13]); z[14] = __builtin_fmaf(cb3[2], zs, z[14]); z[15] = __builtin_fmaf(cb3[3], zs, z[15]); }
                asm volatile("" : "+v"(z[12]) :: "memory");
                cb3 = *(const f32x4*)(AABT + 29 * 36 + 28);
                { const float zs = z[12]; z[13] = __builtin_fmaf(ca3[1], zs, z[13]); z[14] = __builtin_fmaf(ca3[2], zs, z[14]); z[15] = __builtin_fmaf(ca3[3], zs, z[15]); }
                asm volatile("" : "+v"(z[13]) :: "memory");
                ca3 = *(const f32x4*)(AABT + 30 * 36 + 28);
                { const float zs = z[13]; z[14] = __builtin_fmaf(cb3[2], zs, z[14]); z[15] = __builtin_fmaf(cb3[3], zs, z[15]); }
                asm volatile("" : "+v"(z[14]) :: "memory");
                { const float zs = z[14]; z[15] = __builtin_fmaf(ca3[3], zs, z[15]); }
                asm volatile("" : "+v"(z[15]) :: "memory");
#pragma unroll
                for (int q = 0; q < 2; ++q) { u32x4 w; w.x = pack2(z[q * 8 + 0], z[q * 8 + 1]); w.y = pack2(z[q * 8 + 2], z[q * 8 + 3]); w.z = pack2(z[q * 8 + 4], z[q * 8 + 5]); w.w = pack2(z[q * 8 + 6], z[q * 8 + 7]);
                    *(u32x4*)(ZVT + lane * RW_LP + 16 + q * 8) = w; }
            }
        }
        lds_barrier();
        {
            const int nt = wid >> 1;
            const f32x4 pl = *(const f32x4*)(PL + nt * 16 + fq * 4);
#pragma unroll
            for (int q2 = 0; q2 < 2; ++q2) {
                const int vt = (wid & 1) * 2 + q2;
                Sacc[q2] = Sacc[q2] * pl;
#pragma unroll
                for (int k = 0; k < 2; ++k) Sacc[q2] = mma16(ldfrag(BKh, RW_LP, nt * 16, k * 32, fr, fq), ldfrag(ZVT, RW_LP, vt * 16, k * 32, fr, fq), Sacc[q2]);
                st4bf(Sb + (vt * 16 + fr) * RW_LP + nt * 16 + fq * 4, Sacc[q2]);
            }
        }
        if (t0 >= CTXL) {
            const int vt = wid >> 1, tt = wid & 1;
            f32x4 acc = (f32x4){0.f, 0.f, 0.f, 0.f};
            acc = mma16(ldfrag(ZVT, RW_LP, vt * 16, 0, fr, fq), ldfrag(ARB, 40, tt * 16, 0, fr, fq), acc);
            const int t = tt * 16 + fr, v0 = vt * 16 + fq * 4;
#pragma unroll
            for (int rr = 0; rr < 4; ++rr) acc[rr] += YB[t * 64 + v0 + rr];
            const int tn = scan_t<32>(dir, ci, t);
            st4bf(OUT + ((size_t)bl * SEQ + (tn - CTXL)) * 1024 + h * 64 + v0, acc);
        }
    }
    lds_barrier();
#undef RW_PREFETCH
}

__device__ __forceinline__ void phase_mix_cd(const KP& kp, unsigned char* lds, int which) {
    if (which & 1) for (int u = obid(); u < 256; u += gridDim.x) { rwkv_unit(kp, lds, u >> 5, (u >> 1) & 15, u & 1); __syncthreads(); }
    if (which & 2) for (int u = obid(); u < 1024; u += gridDim.x) { attn_unit(kp, lds, u >> 7, (u >> 4) & 7, u & 15); __syncthreads(); }
}

struct EpiFinCD {
    const bf16_t* OF; const bf16_t* OB; const bf16_t* P; const float* BSC; const float* ln; const float* mu; bf16_t* AOUT;
    __device__ __forceinline__ void operator()(const f32x4 (&acc)[4][4], int rb, int cb, int fr, int fq) const {
        const int head = cb >> 6;
#pragma unroll
        for (int i = 0; i < 4; ++i) { const int lr = rb + i * 16 + fr, s = lr & 2047;
            const size_t prow = (size_t)(lr >> 11) * TT + CTXL + s;
            f32x4 o[4]; float ss = 0.f;
#pragma unroll
            for (int j = 0; j < 4; ++j) { const int col = cb + j * 16 + fq * 4;
                o[j] = ld4bf(OF + (size_t)lr * 1024 + col) + ld4bf(OB + (size_t)lr * 1024 + col);
                ss += o[j][0] * o[j][0] + o[j][1] * o[j][1] + o[j][2] * o[j][2] + o[j][3] * o[j][3]; }
            ss += __shfl_xor(ss, 16); ss += __shfl_xor(ss, 32);
            const float rstd = rsqrtf(ss * (1.0f / 64.0f) + EPS);
            const float bon = BSC[(size_t)lr * 16 + head] + BSC[(size_t)RGL * 16 + (size_t)lr * 16 + head];
#pragma unroll
            for (int j = 0; j < 4; ++j) { const int col = cb + j * 16 + fq * 4;
                const bf16_t* pv = P + prow * CD_N + CD_V + col;
                const f32x4 v = ld4bf(pv);
                const f32x4 vp = s > 0 ? ld4bf(pv - CD_N) : (f32x4){0.f, 0.f, 0.f, 0.f};
                const f32x4 vn = s < SEQ - 1 ? ld4bf(pv + CD_N) : (f32x4){0.f, 0.f, 0.f, 0.f};
                const f32x4 vl = v + *(const f32x4*)(mu + 2048 + col) * ((vp + vn) * 0.5f - v);
                const f32x4 y = o[j] * rstd * *(const f32x4*)(ln + col) + vl * bon;
                st4bf(AOUT + (size_t)lr * 1536 + 512 + col, y * acc[i][j]); }
        }
    }
};
PHASE_FN void phase_fin_cd(const KP& kp, unsigned char* lds) {
    GA ga{WSP(const bf16_t, WS_SG), nullptr, 128, 0, 128, nullptr, RGL, 0, 0};
    EpiFinCD ep{WSP(const bf16_t, WS_BIG + L1_OF), WSP(const bf16_t, WS_BIG + L1_OB), WSP(const bf16_t, WS_BIG + L1_P), WSP(const float, WS_BSC), KIN(33), KIN(24), WSP(bf16_t, WS_BIG + L1_AOUT)};
    for (int u = obid(); u < (RGL / 256) * 8; u += gridDim.x) gemm_tile(lds, ga, WSP(const bf16_t, WS_WMIX + WM_G2), 128, u >> 3, u & 7, ep);
}
PHASE_FN void phase_gemm_out_cd(const KP& kp, unsigned char* lds) {
    pg8::Gemm g{WSP(const bf16_t, WS_BIG + L1_AOUT), WSP(const bf16_t, WS_WMIX + WM_CD_OUT), RGL, 1024, 1536, nullptr, 0x7fffffff};
    pg8::StaticOrder S; S.init(RGL, 1024, (int)gridDim.x, obid());
    pg8::EpiBfG E{WSP(bf16_t, WS_BIG + L1_U), 1024, 1024, 0x7fffffff};
    pg8::gemm_phase<pg8::EpiBfG, pg8::StaticOrder, false>((PG8_LAS unsigned char*)lds, g, S, E, nullptr);
    __syncthreads();
}

__device__ __attribute__((noinline)) void grid_sync(unsigned* barw, unsigned x, volatile LAS unsigned* st) { XcdBarrier b; b.bar = barw; b.x = x; b.st = st; xcd_barrier(b); }
constexpr int N_PHASES = 39;
__global__ void __launch_bounds__(512, 2) fwd_kernel(KP kparg) {
    extern __shared__ __attribute__((aligned(16))) unsigned char lds[];
    const int lo = kparg.ph_lo, hi = kparg.ph_hi;
    const KP& kp = kparg;
    volatile LAS unsigned* xbst = (volatile LAS unsigned*)(LAS unsigned char*)(lds + LDS_BYTES - 16);
    if (threadIdx.x == 0) { xbst[0] = 0u; xbst[1] = 0u; }
    __syncthreads();
    XcdBarrier bar; bar.bar = (unsigned*)kparg.ws; bar.x = 0; bar.st = xbst;
    if (hi - lo > 1) bar = xcd_barrier_post((unsigned*)kparg.ws, xbst);
#define IN(k) (lo <= (k) && (k) < hi)
#define SEAM(k) do { if (IN(k) && IN((k) + 1)) { grid_sync((unsigned*)kp.ws, bar.x, xbst); if (PROBE_DUP & 512) grid_sync((unsigned*)kp.ws, bar.x, xbst); } } while (0)
#define PHASE(...) do { if (IN(ph)) { __VA_ARGS__ } SEAM(ph); ++ph; } while (0)
    int ph = 0;
    PHASE(phase_mod(kp, lds); __syncthreads(); phase_conv_ab(kp, lds); if (PROBE_DUP & 32) { __syncthreads(); phase_mod(kp, lds); __syncthreads(); phase_conv_ab(kp, lds); });
#pragma unroll
    for (int g = 0; g < NG; ++g) {
        PHASE(phase_u(kp, 0, g); if (PROBE_DUP & 128) phase_u(kp, 0, g););
        PHASE(phase_gemm_in(kp, lds, 0); if (PROBE_DUP & 8) phase_gemm_in(kp, lds, 0););
        PHASE(phase_xconv(kp); if (PROBE_DUP & 2048) phase_xconv(kp););
        PHASE(phase_scan_ab(kp, lds); if (PROBE_DUP & 1) { __syncthreads(); phase_scan_ab(kp, lds); });
        PHASE(phase_fin_ab(kp););
        PHASE(phase_gemm_out_ab(kp, lds); if (PROBE_DUP & 256) phase_gemm_out_ab(kp, lds););
        PHASE(phase_r(kp, lds, 0, g););
    }
    PHASE(phase_moe_gather(kp, 0); phase_conv_moe(kp, lds, 0); phase_conv_cd(kp, lds); if (PROBE_DUP & 64) { phase_moe_gather(kp, 0); phase_conv_moe(kp, lds, 0); phase_conv_cd(kp, lds); });
    PHASE(phase_moe_gemm(kp, lds, 0, false); if (PROBE_DUP & 16) { __syncthreads(); phase_moe_gemm(kp, lds, 0, false); });
    PHASE(phase_moe_gemm(kp, lds, 0, true); if (PROBE_DUP & 16) { __syncthreads(); phase_moe_gemm(kp, lds, 0, true); });
    PHASE(phase_combine(kp, 0););
#pragma unroll
    for (int g = 0; g < NG; ++g) {
        PHASE(phase_u(kp, 1, g); if (PROBE_DUP & 128) phase_u(kp, 1, g););
        PHASE(phase_gemm_in(kp, lds, 1); if (PROBE_DUP & 8) phase_gemm_in(kp, lds, 1););
        PHASE(phase_prep_cd(kp););
        PHASE(phase_upproj(kp, lds); if (PROBE_DUP & 4096) phase_upproj(kp, lds););
        PHASE(phase_mix_cd(kp, lds, 3); if (PROBE_DUP & 2) { __syncthreads(); phase_mix_cd(kp, lds, 1); } if (PROBE_DUP & 4) { __syncthreads(); phase_mix_cd(kp, lds, 2); });
        PHASE(phase_fin_cd(kp, lds); if (PROBE_DUP & 4096) phase_fin_cd(kp, lds););
        PHASE(phase_gemm_out_cd(kp, lds); if (PROBE_DUP & 256) phase_gemm_out_cd(kp, lds););
        PHASE(phase_r(kp, lds, 1, g););
    }
    PHASE(phase_moe_gather(kp, 1); phase_conv_moe(kp, lds, 1););
    PHASE(phase_moe_gemm(kp, lds, 1, false););
    PHASE(phase_moe_gemm(kp, lds, 1, true););
    PHASE(phase_combine(kp, 1););
#undef PHASE
#undef IN
#undef SEAM
}

extern "C" void kernel_launch(void* const* d_in, const int* in_sizes, int n_in, void* d_out, int out_size, void* d_ws, size_t ws_size, hipStream_t stream) {
    static int grid = 0;
    if (grid == 0) {
        if (n_in != 42 || out_size != NLAT * D || ws_size < WS_NEED) { fprintf(stderr, "kernel_launch: unexpected shapes: n_in %d out %d ws %zu (need %zu)\n", n_in, out_size, ws_size, (size_t)WS_NEED); grid = -1; return; }
        int dev = 0, cus = 0, per_cu = 0;
        if (hipGetDevice(&dev) != hipSuccess || hipDeviceGetAttribute(&cus, hipDeviceAttributeMultiprocessorCount, dev) != hipSuccess) { grid = -1; return; }
        if (hipFuncSetAttribute((const void*)fwd_kernel, hipFuncAttributeMaxDynamicSharedMemorySize, LDS_BYTES) != hipSuccess) { fprintf(stderr, "kernel_launch: hipFuncSetAttribute failed\n"); grid = -1; return; }
        if (hipOccupancyMaxActiveBlocksPerMultiprocessor(&per_cu, (const void*)fwd_kernel, 512, LDS_BYTES) != hipSuccess || per_cu < 1) { fprintf(stderr, "kernel_launch: occupancy query says %d blocks per CU\n", per_cu); grid = -1; (void)hipGetLastError(); return; }
        grid = cus;
    }
    if (grid < 0) return;
    (void)hipMemsetAsync(d_ws, 0, CTL_BYTES, stream);
    KP kp{};
    for (int i = 0; i < 42; ++i) kp.in[i] = (const float*)d_in[i];
    kp.out = (float*)d_out; kp.ws = (unsigned char*)d_ws;
#if N_LAUNCH_MODE == 1
    kp.ph_lo = 0; kp.ph_hi = N_PHASES;
    hipLaunchKernelGGL(fwd_kernel, dim3(grid), dim3(512), LDS_BYTES, stream, kp);
#else
    for (int p = 0; p < N_PHASES; ++p) { kp.ph_lo = p; kp.ph_hi = p + 1; hipLaunchKernelGGL(fwd_kernel, dim3(grid), dim3(512), LDS_BYTES, stream, kp); }
#endif
}
```

```cpp
#include <hip/hip_runtime.h>
#include <stdint.h>
#include <stdio.h>

typedef unsigned short bf16_t;
typedef short bf16x8 __attribute__((ext_vector_type(8)));
typedef float f32x4 __attribute__((ext_vector_type(4)));
typedef float f32x2 __attribute__((ext_vector_type(2)));
typedef unsigned u32x4 __attribute__((ext_vector_type(4)));
typedef unsigned u32x2 __attribute__((ext_vector_type(2)));

#ifndef RWP
#define RWP 0
#endif
#ifndef PROBE_DUP
#define PROBE_DUP 0
#endif
#ifndef N_LAUNCH_MODE
#define N_LAUNCH_MODE 1
#endif

constexpr int NB = 16, SEQ = 2048, CTXL = 256, TT = 2304, D = 1024;
constexpr int NTOK = NB * TT, NLAT = NB * SEQ;
constexpr int NG = 2, BG = NB / NG, RG = BG * TT, RGL = BG * SEQ;
constexpr float EPS = 1e-6f;
constexpr int AB_N = 5424, AB_NPAD = 5632, AB_Q = 0, AB_K = 512, AB_V = 1024, AB_OG = 2048, AB_IG = 3072, AB_FG = 3080, AB_Z = 3088, AB_XBC = 4112, AB_DT = 5392;
constexpr int CD_N = 4128, CD_NPAD = 4352, CD_M0 = 0, CD_M1 = 384, CD_KR = 640, CD_R = 672, CD_K = 1696, CD_V = 2720, CD_WL = 3744, CD_AL = 3872, CD_GL = 4000;
constexpr int CD_RW0 = 672;

constexpr size_t CTL_BYTES = 32768;
constexpr size_t CTL_CNT = 16384;
constexpr size_t WS_MODV = CTL_BYTES;
constexpr size_t WS_HC   = WS_MODV + (size_t)2 * 17 * 6144 * 4;
constexpr size_t WS_TOKE = WS_HC + (size_t)NB * CTXL * D * 4;
constexpr size_t WS_TOKP = WS_TOKE + (size_t)NTOK * 2 * 4;
constexpr size_t WS_TOKW = WS_TOKP + (size_t)NTOK * 2 * 4;
constexpr size_t WS_LIST = WS_TOKW + (size_t)NTOK * 2 * 4;
constexpr size_t WS_BSC  = WS_LIST + (size_t)16 * NTOK * 4;
constexpr size_t WS_SG   = WS_BSC + (size_t)2 * RGL * 16 * 4;
constexpr size_t WS_WMIX = WS_SG + (size_t)RGL * 128 * 2;
constexpr size_t WMIX_BYTES = (size_t)16 << 20;
constexpr size_t WS_V    = WS_WMIX + WMIX_BYTES;
constexpr size_t WS_BIG  = WS_V + (size_t)NTOK * D * 2;
constexpr size_t WM_AB_IN = 0, WM_AB_OUT = (size_t)AB_NPAD * 1024 * 2;
constexpr size_t WM_CD_IN = 0, WM_CD_OUT = (size_t)CD_NPAD * 1024 * 2, WM_UQ = WM_CD_OUT + (size_t)1024 * 1536 * 2, WM_UKV = WM_UQ + (size_t)768 * 384 * 2, WM_G2 = WM_UKV + (size_t)1024 * 256 * 2;
static_assert(WM_AB_OUT + (size_t)1024 * 2048 * 2 <= WMIX_BYTES, "wmix ab");
static_assert(WM_G2 + (size_t)1024 * 128 * 2 <= WMIX_BYTES, "wmix cd");
constexpr size_t SZ_RG1K = (size_t)RG * 1024 * 2, SZ_RGL1K = (size_t)RGL * 1024 * 2;
constexpr size_t L0_P = 0, L0_AO = (size_t)RG * AB_N * 2  , L0_HB = L0_AO + 2 * SZ_RG1K, L0_YB = L0_HB + SZ_RG1K, L0_U = L0_YB + SZ_RG1K, L0_END = L0_U + SZ_RG1K;
constexpr size_t L1_P = 0, L1_Q = (size_t)RG * CD_N * 2, L1_KV = L1_Q + (size_t)RGL * 768 * 2, L1_OF = L1_KV + SZ_RG1K, L1_OB = L1_OF + SZ_RGL1K, L1_AOUT = L1_OB + SZ_RGL1K, L1_U = L1_AOUT + (size_t)RGL * 1536 * 2, L1_TWAL = L1_U + SZ_RG1K  , L1_END = L1_TWAL + (size_t)RG * 256 * 2;
constexpr int MOE_PADROWS = 16 * 256;
constexpr size_t MO_WUP = 0, MO_WDN = (size_t)17 * 1024 * 1024 * 2, MO_HID = MO_WDN + (size_t)17 * 1024 * 512 * 2;
constexpr size_t MO_XG = MO_HID + (size_t)(3 * NTOK + MOE_PADROWS) * 512 * 2;
constexpr size_t MO_CON = MO_XG, MO_END = MO_CON + (size_t)(3 * NTOK + MOE_PADROWS) * 1024 * 2;
constexpr size_t BIG_BYTES = MO_END > L0_END ? (MO_END > L1_END ? MO_END : L1_END) : (L0_END > L1_END ? L0_END : L1_END);
constexpr size_t WS_NEED = WS_BIG + BIG_BYTES;

constexpr int LDS_BYTES = 147456;

__device__ __forceinline__ float bf2f(unsigned short h) { return __uint_as_float(((unsigned)h) << 16); }
typedef __bf16 bf16v2_t __attribute__((ext_vector_type(2)));
__device__ __forceinline__ unsigned pack2(float a, float b) { const bf16v2_t h = __builtin_convertvector((f32x2){a, b}, bf16v2_t); return __builtin_bit_cast(unsigned, h); }
__device__ __forceinline__ unsigned short f2bf(float f) { const __bf16 h = (__bf16)f; return __builtin_bit_cast(unsigned short, h); }
__device__ __forceinline__ float lo2f(unsigned w) { return __uint_as_float(w << 16); }
__device__ __forceinline__ float hi2f(unsigned w) { return __uint_as_float(w & 0xffff0000u); }
__device__ __forceinline__ float wsum(float v) {
#pragma unroll
    for (int o = 32; o; o >>= 1) v += __shfl_xor(v, o);
    return v; }
__device__ __forceinline__ float frcp_(float x) { return __builtin_amdgcn_rcpf(x); }
__device__ __forceinline__ float sigmoidf_(float x) { return __builtin_amdgcn_rcpf(1.0f + __expf(-x)); }
__device__ __forceinline__ float siluf_(float x) { return x * __builtin_amdgcn_rcpf(1.0f + __expf(-x)); }
__device__ __forceinline__ float softplusf_(float x) { return fmaxf(x, 0.0f) + __logf(1.0f + __expf(-fabsf(x))); }
__device__ __forceinline__ float logsigmoidf_(float x) { return fminf(x, 0.0f) - __logf(1.0f + __expf(-fabsf(x))); }
__device__ __forceinline__ float tanhf_(float x) { return 1.0f - 2.0f * __builtin_amdgcn_rcpf(__expf(2.0f * x) + 1.0f); }
__device__ __forceinline__ f32x4 mma16(bf16x8 a, bf16x8 b, f32x4 c) { return __builtin_amdgcn_mfma_f32_16x16x32_bf16(a, b, c, 0, 0, 0); }
__device__ __forceinline__ bf16x8 ldfrag(const bf16_t* base, int ld, int row0, int k0, int fr, int fq) { return *(const bf16x8*)(base + (row0 + fr) * ld + k0 + fq * 8); }
__device__ __forceinline__ void st4bf(bf16_t* p, f32x4 v) { u32x2 w; w.x = pack2(v[0], v[1]); w.y = pack2(v[2], v[3]); *(u32x2*)p = w; }
__device__ __forceinline__ f32x4 ld4bf(const bf16_t* p) { u32x2 w = *(const u32x2*)p; return (f32x4){lo2f(w.x), hi2f(w.x), lo2f(w.y), hi2f(w.y)}; }

#define PHASE_FN __device__ __forceinline__
__device__ __forceinline__ int otid() { int t = threadIdx.x; asm volatile("" : "+v"(t)); return t; }
__device__ __forceinline__ int obid() { int t = blockIdx.x; asm volatile("" : "+s"(t)); return t; }
template <class T> __device__ __forceinline__ T* as_global(T* p) { return p; }
__device__ __forceinline__ void lds_barrier() { asm volatile("s_waitcnt lgkmcnt(0)" ::: "memory"); __builtin_amdgcn_s_barrier(); asm volatile("" ::: "memory"); }
struct KP { const float* in[42]; float* out; unsigned char* ws; int ph_lo, ph_hi; };

#define XB_TMO      128
#define XB_XCNT(j)  (256  + 64 * (j))
#define XB_XSUB(j)  (1280 + 64 * (j))
#define XB_XGEN(j)  (2304 + 64 * (j))
#define XB_TOP      3328
#define XB_TOPGEN   3392
#define XCD_BAR_WORDS 3456
#define XB_SPIN_CAP (1u << 18)
#define LAS __attribute__((address_space(3)))

__device__ __forceinline__ unsigned xb_ld(unsigned* p)              { return __hip_atomic_load(p, __ATOMIC_RELAXED, __HIP_MEMORY_SCOPE_AGENT); }
__device__ __forceinline__ unsigned xb_add(unsigned* p, unsigned v) { return __hip_atomic_fetch_add(p, v, __ATOMIC_RELAXED, __HIP_MEMORY_SCOPE_AGENT); }
__device__ __forceinline__ unsigned xb_xcc_id() { return (unsigned)__builtin_amdgcn_s_getreg((3 << 11) | 20) & 0xFu; }
#define XB_SPIN(cond, bar) do { unsigned _sp = 0; while (cond) { __builtin_amdgcn_s_sleep(1); \
    if ((++_sp & 255u) == 0u) { if (xb_ld(&(bar)[XB_TMO])) break; if (_sp > XB_SPIN_CAP) { atomicAdd(&(bar)[XB_TMO], 1u); break; } } } } while (0)

struct XcdBarrier {
    unsigned* bar; unsigned x;
    volatile LAS unsigned* st;
};

__device__ __forceinline__ XcdBarrier xcd_barrier_post(unsigned* bar, volatile LAS unsigned* st) {
    XcdBarrier b; b.bar = bar; b.x = xb_xcc_id(); b.st = st;
    if (threadIdx.x == 0) (void)xb_add(&bar[XB_XCNT(b.x)], 1u);
    return b;
}
__device__ __forceinline__ void xcd_barrier_complete(unsigned* bar, unsigned x, unsigned& nloc, unsigned& nx) {
    const unsigned G = gridDim.x * gridDim.y * gridDim.z;
    unsigned sum, cnt, mine, sp = 0u;
    for (;;) {
        sum = 0u; cnt = 0u; mine = 0u;
#pragma unroll
        for (unsigned j = 0; j < 16; ++j) { const unsigned c = xb_ld(&bar[XB_XCNT(j)]); sum += c; cnt += (c > 0u) ? 1u : 0u; mine = (j == x) ? c : mine; }
        if (sum == G) break;
        __builtin_amdgcn_s_sleep(1);
        if ((++sp & 255u) == 0u) { if (xb_ld(&bar[XB_TMO])) break; if (sp > XB_SPIN_CAP) { atomicAdd(&bar[XB_TMO], 1u); break; } }
    }
    nloc = mine > 0u ? mine : 1u; nx = cnt > 0u ? cnt : 1u;
}

__device__ __forceinline__ void xcd_barrier(const XcdBarrier& b) {
    asm volatile("s_waitcnt vmcnt(0)" ::: "memory");
    __syncthreads();
    if (threadIdx.x == 0) {
        unsigned* bar = b.bar;
        __builtin_amdgcn_s_waitcnt(0);
        unsigned nloc = b.st[0], nx = b.st[1];
        if (nloc == 0u) { xcd_barrier_complete(bar, b.x, nloc, nx); b.st[0] = nloc; b.st[1] = nx; }
        const unsigned old = xb_add(&bar[XB_XSUB(b.x)], 1u);
        const unsigned gen = old / nloc;
        if (old + 1u == (gen + 1u) * nloc) {
            __builtin_amdgcn_fence(__ATOMIC_RELEASE, "agent");
            asm volatile("s_waitcnt vmcnt(0)" ::: "memory");
            const unsigned og = xb_add(&bar[XB_TOP], 1u);
            const unsigned tg = og / nx;
            if (og + 1u == (tg + 1u) * nx) xb_add(&bar[XB_TOPGEN], 1u);
            else XB_SPIN(xb_ld(&bar[XB_TOPGEN]) == tg, bar);
            __builtin_amdgcn_fence(__ATOMIC_ACQUIRE, "agent");
            xb_add(&bar[XB_XGEN(b.x)], 1u);
            asm volatile("s_waitcnt vmcnt(0)" ::: "memory");
        } else {
            XB_SPIN(xb_ld(&bar[XB_XGEN(b.x)]) == gen, bar);
            __builtin_amdgcn_fence(__ATOMIC_ACQUIRE, "agent");
            asm volatile("s_waitcnt vmcnt(0)" ::: "memory");
        }
    }
    __syncthreads();
}
struct GA {
    const bf16_t* a0; const bf16_t* a1;
    int ld0, ld1, ksplit;
    const int* list;
    int nrows;
    int mode;
    int row0;
};
constexpr int G_LDT = 40;
constexpr int GEMM_LDS = (2 * 256 * G_LDT + 2 * 128 * G_LDT) * 2;

template <class Epi>
__device__ __forceinline__ void gemm_tile(unsigned char* lds, const GA& ga, const bf16_t* __restrict__ Bt, int K, int mt, int nt, const Epi& epi) {
    const int tid = otid(), lane = tid & 63, wid = __builtin_amdgcn_readfirstlane(tid >> 6), wm = wid >> 1, wn = wid & 1, fr = lane & 15, fq = lane >> 4;
    bf16_t* sA = (bf16_t*)lds;
    bf16_t* sB = sA + 2 * 256 * G_LDT;
    const int kp = tid & 3;
    const int r0 = tid >> 2, r1 = r0 + 128;
    int s0, s1;
    {
        int lr = mt * 256 + r0; if (lr >= ga.nrows) lr = 0;
        s0 = ga.list ? ga.list[lr] : (ga.mode == 1 ? (lr >> 11) * TT + CTXL + (lr & 2047) : ga.row0 + lr);
        lr = mt * 256 + r1; if (lr >= ga.nrows) lr = 0;
        s1 = ga.list ? ga.list[lr] : (ga.mode == 1 ? (lr >> 11) * TT + CTXL + (lr & 2047) : ga.row0 + lr);
    }
    const bf16_t* pa00 = ga.a0 + (size_t)s0 * ga.ld0 + kp * 8;
    const bf16_t* pa01 = ga.a0 + (size_t)s1 * ga.ld0 + kp * 8;
    const bf16_t* pa10 = ga.a1 ? ga.a1 + (size_t)s0 * ga.ld1 + kp * 8 : pa00;
    const bf16_t* pa11 = ga.a1 ? ga.a1 + (size_t)s1 * ga.ld1 + kp * 8 : pa01;
    const bf16_t* pb = Bt + (size_t)(nt * 128 + r0) * K + kp * 8;
    const int ksplit = ga.ksplit;
    f32x4 acc[4][4];
#pragma unroll
    for (int i = 0; i < 4; ++i)
#pragma unroll
        for (int j = 0; j < 4; ++j) acc[i][j] = (f32x4){0.f, 0.f, 0.f, 0.f};
    const int nk = K >> 5;
    u32x4 ra0, ra1, rb;
    {
        ra0 = *(const u32x4*)(pa00); ra1 = *(const u32x4*)(pa01); rb = *(const u32x4*)(pb);
        if (0 >= ksplit) { ra0 = *(const u32x4*)(pa10); ra1 = *(const u32x4*)(pa11); }
    }
    *(u32x4*)(sA + (r0) * G_LDT + kp * 8) = ra0;
    *(u32x4*)(sA + (r1) * G_LDT + kp * 8) = ra1;
    *(u32x4*)(sB + (r0) * G_LDT + kp * 8) = rb;
    __syncthreads();
    for (int kt = 0; kt < nk; ++kt) {
        const int cur = kt & 1;
        if (kt + 1 < nk) {
            const int k0 = (kt + 1) << 5;
            if (k0 < ksplit) { ra0 = *(const u32x4*)(pa00 + k0); ra1 = *(const u32x4*)(pa01 + k0); }
            else { ra0 = *(const u32x4*)(pa10 + (k0 - ksplit)); ra1 = *(const u32x4*)(pa11 + (k0 - ksplit)); }
            rb = *(const u32x4*)(pb + k0);
        }
        const bf16_t* cA = sA + cur * 256 * G_LDT;
        const bf16_t* cB = sB + cur * 128 * G_LDT;
        bf16x8 af[4], bfr[4];
#pragma unroll
        for (int i = 0; i < 4; ++i) af[i] = ldfrag(cA, G_LDT, wm * 64 + i * 16, 0, fr, fq);
#pragma unroll
        for (int j = 0; j < 4; ++j) bfr[j] = ldfrag(cB, G_LDT, wn * 64 + j * 16, 0, fr, fq);
#pragma unroll
        for (int i = 0; i < 4; ++i)
#pragma unroll
            for (int j = 0; j < 4; ++j) acc[i][j] = mma16(bfr[j], af[i], acc[i][j]);
        if (kt + 1 < nk) {
            const int nb = cur ^ 1;
            *(u32x4*)(sA + (nb * 256 + r0) * G_LDT + kp * 8) = ra0;
            *(u32x4*)(sA + (nb * 256 + r1) * G_LDT + kp * 8) = ra1;
            *(u32x4*)(sB + (nb * 128 + r0) * G_LDT + kp * 8) = rb;
        }
        __syncthreads();
    }
    epi(acc, mt * 256 + wm * 64, nt * 128 + wn * 64, fr, fq);
}

struct EpiBf {
    bf16_t* out; int ld, nrows, ncols;
    __device__ __forceinline__ void operator()(const f32x4 (&acc)[4][4], int rb, int cb, int fr, int fq) const {
#pragma unroll
        for (int i = 0; i < 4; ++i) { const int lr = rb + i * 16 + fr; if (lr < nrows) {
#pragma unroll
            for (int j = 0; j < 4; ++j) { const int col = cb + j * 16 + fq * 4; if (col < ncols) st4bf(out + (size_t)lr * ld + col, acc[i][j]); } } }
    }
};
struct EpiSwiglu {
    bf16_t* out; int nrows;
    __device__ __forceinline__ void operator()(const f32x4 (&acc)[4][4], int rb, int cb, int fr, int fq) const {
#pragma unroll
        for (int i = 0; i < 4; ++i) { const int lr = rb + i * 16 + fr; if (lr < nrows) {
#pragma unroll
            for (int j = 0; j < 2; ++j) { const int col = (cb >> 1) + j * 16 + fq * 4; f32x4 g = acc[i][j], u = acc[i][j + 2], o;
#pragma unroll
                for (int r = 0; r < 4; ++r) o[r] = siluf_(g[r]) * u[r];
                st4bf(out + (size_t)lr * 512 + col, o); } } }
    }
};

namespace pg8 {
#define PG8_LAS __attribute__((address_space(3)))
typedef unsigned short bf16_t;
typedef short bf16x8 __attribute__((ext_vector_type(8)));
typedef float f32x4 __attribute__((ext_vector_type(4)));
typedef unsigned u32x4 __attribute__((ext_vector_type(4)));
constexpr int BM = 256, BK = 64, HALF = 128, HTB = HALF * BK * 2  , STAGE_BYTES = 8 * HTB, NXCD = 8, WGM = 8;

__host__ __device__ __forceinline__ int lds_byte(int r, int c) { const int st = (r >> 4) * 2 + (c >> 5), rr = r & 15, cc = c & 31, ob = rr * 64 + cc * 2; return st * 1024 + (ob ^ (((ob >> 9) & 1) << 5)); }
__host__ __device__ __forceinline__ void stage_rc(int b, int& R, int& C) { const int st = b / 1024, sb = b % 1024, swz = sb ^ (((sb >> 9) & 1) << 5); R = (st >> 1) * 16 + swz / 64; C = (st & 1) * 32 + (swz % 64) / 2; }
__host__ __device__ __forceinline__ int perm32(int rho) { const int n = rho >> 4, i = rho & 15; return 8 * (i >> 2) + 4 * n + (i & 3); }

struct Unit { int pm, pn; };
struct Gemm { const bf16_t* A; const bf16_t* Bt; int M, N, K; const bf16_t* A2; int pm_split; };
#define PG8_ABASE(g, pm) ((pm) < (g).pm_split ? (const char*)(g).A + (size_t)(pm) * tstep : (const char*)(g).A2 + (size_t)((pm) - (g).pm_split) * tstep)
struct StaticOrder {
    int nM, nN, nwg, G, c;
    __host__ __device__ void init(int M, int N, int G_, int c_) { nM = M / BM; nN = N / BM; nwg = nM * nN; G = G_; c = c_; }
    __host__ __device__ bool next(int i, Unit& u) const {
        const long L = (long)i * G + c; if (L >= nwg) return false;
        int wgid = (int)L; { const int q = nwg / NXCD, r = nwg % NXCD, xcd = wgid % NXCD, off = wgid / NXCD; wgid = (xcd < r ? xcd * (q + 1) : r * (q + 1) + (xcd - r) * q) + off; }
        const int nig = WGM * nN, gid = wgid / nig, fm = gid * WGM, gsz = (nM - fm) < WGM ? (nM - fm) : WGM;
        u.pm = fm + ((wgid % nig) % gsz); u.pn = (wgid % nig) / gsz; return true;
    }
    __device__ __forceinline__ void a_ready(const Unit&) const {}
    __device__ __forceinline__ void done(const Unit&) const {}
};
__device__ __forceinline__ unsigned cvt_pk_bf16(float lo, float hi) { unsigned r; asm volatile("v_cvt_pk_bf16_f32 %0, %1, %2" : "=v"(r) : "v"(lo), "v"(hi)); return r; }
typedef float f32x2 __attribute__((ext_vector_type(2)));
template <class Epi, class Sched, bool STAMP = false>
__device__ __forceinline__ void gemm_phase(PG8_LAS unsigned char* lds, const Gemm g, const Sched& S, const Epi& E, unsigned long long* stamps) {
    const int tid = otid(), wid = __builtin_amdgcn_readfirstlane(tid >> 6), lane = tid & 63, wr = wid >> 2, wc = wid & 3, fr = lane & 15, fq = lane >> 4;
    const int K = g.K, nt = K / BK;
    int ts_lo = 0, ts_hi = 0, nts = 0; const unsigned long long rt_entry = STAMP ? (unsigned long long)wall_clock64() : 0ull;
#define PG8_STAMP() do { if (STAMP && wid == 0 && nts < 64) { const unsigned long long _c = (unsigned long long)clock64(); \
        ts_lo = (lane == nts) ? (int)(unsigned)_c : ts_lo; ts_hi = (lane == nts) ? (int)(unsigned)(_c >> 32) : ts_hi; ++nts; } } while (0)
    PG8_STAMP();
    unsigned voffA[2], voffB[2];
#pragma unroll
    for (int i = 0; i < 2; ++i) { int R, C; stage_rc(tid * 16 + i * 8192, R, C); const int Rb = Epi::PERM ? ((R & ~31) + perm32(R & 31)) : R;
        voffA[i] = (unsigned)(R * K + C) * 2u; voffB[i] = (unsigned)(Rb * K + C) * 2u; }
    const size_t kstep = (size_t)(BK * 2);
    const size_t hstep = (size_t)HALF * K * 2;
    const size_t tstep = 2 * hstep;
    const unsigned ldsw = (unsigned)wid * 1024u;
    const int aoff = lds_byte(wr * 64 + fr, fq * 8), boff = lds_byte(wc * 32 + fr, fq * 8);
#define PG8_SA(b, h) (((b) * 2 + (h)) * HTB)
#define PG8_SB(b, h) ((4 + (b) * 2 + (h)) * HTB)
#define PG8_STAGE(bufoff, gbase, voff) do { _Pragma("unroll") for (int _i = 0; _i < 2; ++_i) \
        __builtin_amdgcn_global_load_lds((const unsigned*)((const char*)(gbase) + (voff)[_i]), (PG8_LAS unsigned*)(lds + (bufoff) + ldsw + _i * 8192), 16, 0, 0); } while (0)
#define PG8_LDA(dst, b, h) do { _Pragma("unroll") for (int m = 0; m < 4; ++m) _Pragma("unroll") for (int k = 0; k < 2; ++k) dst[m][k] = *(const PG8_LAS bf16x8*)(lds + PG8_SA(b, h) + aoff + m * 2048 + k * 1024); } while (0)
#define PG8_LDB(dst, b, h) do { _Pragma("unroll") for (int n = 0; n < 2; ++n) _Pragma("unroll") for (int k = 0; k < 2; ++k) dst[n][k] = *(const PG8_LAS bf16x8*)(lds + PG8_SB(b, h) + boff + n * 2048 + k * 1024); } while (0)
#define PG8_MMA(ai, bj, At, Bt) do { __builtin_amdgcn_s_setprio(1); _Pragma("unroll") for (int m = 0; m < 4; ++m) _Pragma("unroll") for (int n = 0; n < 2; ++n) _Pragma("unroll") for (int k = 0; k < 2; ++k) \
        acc[ai][bj][m][n] = __builtin_amdgcn_mfma_f32_16x16x32_bf16(Bt[n][k], At[m][k], acc[ai][bj][m][n], 0, 0, 0); __builtin_amdgcn_s_setprio(0); } while (0)
#define PG8_WAIT_V(n) asm volatile("s_waitcnt vmcnt(" #n ")" ::: "memory")
#define PG8_WAIT_L(n) asm volatile("s_waitcnt lgkmcnt(" #n ")" ::: "memory")
#define PG8_BAR __builtin_amdgcn_s_barrier()
#define PG8_SCHED __builtin_amdgcn_sched_barrier(0)
    Unit cur, nxt; int ui = 0;
    if (!S.next(0, cur)) return;
    f32x4 acc[2][2][4][2];
#pragma unroll
    for (int a = 0; a < 2; ++a)
#pragma unroll
        for (int b = 0; b < 2; ++b)
#pragma unroll
            for (int m = 0; m < 4; ++m)
#pragma unroll
                for (int n = 0; n < 2; ++n) acc[a][b][m][n] = (f32x4){0.f, 0.f, 0.f, 0.f};
    bf16x8 At[4][2], B0[2][2], B1[2][2];
    const char* cA = PG8_ABASE(g, cur.pm); const char* cB = (const char*)g.Bt + (size_t)cur.pn * tstep;
    S.a_ready(cur);
    PG8_STAGE(PG8_SB(0, 0), cB, voffB); PG8_STAGE(PG8_SA(0, 0), cA, voffA); PG8_STAGE(PG8_SB(0, 1), cB + hstep, voffB); PG8_STAGE(PG8_SA(0, 1), cA + hstep, voffA);
    if (wr == 1) PG8_BAR;
    PG8_WAIT_V(4); PG8_BAR;
    PG8_STAGE(PG8_SB(1, 0), cB + kstep, voffB); PG8_STAGE(PG8_SA(1, 0), cA + kstep, voffA); PG8_STAGE(PG8_SB(1, 1), cB + hstep + kstep, voffB);
    PG8_WAIT_V(6); PG8_BAR;
    PG8_STAMP();
    for (;;) {
        const bool has_next = S.next(ui + 1, nxt);
        const char* nA = has_next ? PG8_ABASE(g, nxt.pm) : cA; const char* nB = has_next ? (const char*)g.Bt + (size_t)nxt.pn * tstep : cB;
        for (int t = 0; t < nt; t += 2) {
            const bool last = (t == nt - 2);
            const char* a1 = cA + (size_t)(t + 1) * kstep;
            const char* a2 = last ? nA : cA + (size_t)(t + 2) * kstep; const char* b2 = last ? nB : cB + (size_t)(t + 2) * kstep;
            const char* a3 = a2 + kstep; const char* b3 = b2 + kstep;
            if (last && has_next) S.a_ready(nxt);
            PG8_LDB(B0, 0, 0); PG8_SCHED; PG8_LDA(At, 0, 0); PG8_STAGE(PG8_SA(1, 1), a1 + hstep, voffA);
            PG8_WAIT_L(8); PG8_BAR; PG8_WAIT_L(0); PG8_MMA(0, 0, At, B0); PG8_BAR; PG8_SCHED;
            PG8_LDB(B1, 0, 1); PG8_STAGE(PG8_SB(0, 0), b2, voffB);
            PG8_BAR; PG8_WAIT_L(0); PG8_MMA(0, 1, At, B1); PG8_BAR;
            PG8_LDA(At, 0, 1); PG8_STAGE(PG8_SA(0, 0), a2, voffA);
            PG8_BAR; PG8_WAIT_L(0); PG8_MMA(1, 0, At, B0); PG8_BAR; PG8_SCHED;
            PG8_STAGE(PG8_SB(0, 1), b2 + hstep, voffB);
            PG8_WAIT_V(6); PG8_BAR; PG8_MMA(1, 1, At, B1); PG8_BAR;
            PG8_LDB(B0, 1, 0); PG8_SCHED; PG8_LDA(At, 1, 0); PG8_STAGE(PG8_SA(0, 1), a2 + hstep, voffA);
            PG8_WAIT_L(8); PG8_BAR; PG8_WAIT_L(0); PG8_MMA(0, 0, At, B0); PG8_BAR; PG8_SCHED;
            PG8_LDB(B1, 1, 1); PG8_STAGE(PG8_SB(1, 0), b3, voffB);
            PG8_BAR; PG8_WAIT_L(0); PG8_MMA(0, 1, At, B1); PG8_BAR;
            PG8_LDA(At, 1, 1); PG8_STAGE(PG8_SA(1, 0), a3, voffA);
            PG8_BAR; PG8_WAIT_L(0); PG8_MMA(1, 0, At, B0); PG8_BAR; PG8_SCHED;
            PG8_STAGE(PG8_SB(1, 1), b3 + hstep, voffB);
            PG8_WAIT_V(6); PG8_BAR; PG8_MMA(1, 1, At, B1); PG8_BAR;
        }
        PG8_STAMP();
        if constexpr (!Epi::AFTER_DRAIN) { E(acc, cur, wr, wc, fr, fq); S.done(cur); }
        PG8_STAMP();
        if (!has_next) break;
#pragma unroll
        for (int a = 0; a < 2; ++a)
#pragma unroll
            for (int b = 0; b < 2; ++b)
#pragma unroll
                for (int m = 0; m < 4; ++m)
#pragma unroll
                    for (int n = 0; n < 2; ++n) acc[a][b][m][n] = (f32x4){0.f, 0.f, 0.f, 0.f};
        cur = nxt; cA = nA; cB = nB; ++ui;
    }
    PG8_WAIT_V(0);
    if (wr == 0) PG8_BAR;
    PG8_BAR;
    if constexpr (Epi::AFTER_DRAIN) { E.fused(acc, cur, wr, wc, fr, fq, lds, wid, lane); S.done(cur); }
    PG8_STAMP();
    if (STAMP && wid == 0) { stamps[lane] = lane < nts ? (((unsigned long long)(unsigned)ts_hi << 32) | (unsigned)ts_lo) : 0ull;
        if (lane == 62) stamps[62] = rt_entry; if (lane == 63) stamps[63] = (unsigned long long)wall_clock64(); }
#undef PG8_STAMP
#undef PG8_SA
#undef PG8_SB
#undef PG8_STAGE
#undef PG8_LDA
#undef PG8_LDB
#undef PG8_MMA
#undef PG8_WAIT_V
#undef PG8_WAIT_L
#undef PG8_BAR
#undef PG8_SCHED
}
}
namespace pg8 {
struct EpiBfG {
    static constexpr bool PERM = true, AFTER_DRAIN = false;
    bf16_t* O; int ldc, ncols, pn_mask;
    __device__ __forceinline__ void operator()(const f32x4 (&acc)[2][2][4][2], const Unit& u, int wr, int wc, int fr, int fq) const {
        const int row0 = u.pm * BM + wr * 64 + fr, col0 = (u.pn & pn_mask) * BM + wc * 32 + 8 * fq;
#pragma unroll
        for (int ai = 0; ai < 2; ++ai)
#pragma unroll
            for (int m = 0; m < 4; ++m) { bf16_t* rowp = O + (size_t)(row0 + ai * HALF + m * 16) * ldc;
#pragma unroll
                for (int bj = 0; bj < 2; ++bj) { const int c = col0 + bj * HALF;
                    if (c < ncols) { const f32x4 v0 = acc[ai][bj][m][0], v1 = acc[ai][bj][m][1];
                        u32x4 w; w.x = cvt_pk_bf16(v0[0], v0[1]); w.y = cvt_pk_bf16(v0[2], v0[3]); w.z = cvt_pk_bf16(v1[0], v1[1]); w.w = cvt_pk_bf16(v1[2], v1[3]);
                        *(u32x4*)(rowp + c) = w; } } }
    }
};
struct EpiSwi {
    static constexpr bool PERM = true, AFTER_DRAIN = false;
    bf16_t* H;
    __device__ __forceinline__ void operator()(const f32x4 (&acc)[2][2][4][2], const Unit& u, int wr, int wc, int fr, int fq) const {
        const int row0 = u.pm * BM + wr * 64 + fr, hc0 = (u.pn & 3) * HALF + wc * 32 + 8 * fq;
#pragma unroll
        for (int ai = 0; ai < 2; ++ai)
#pragma unroll
            for (int m = 0; m < 4; ++m) { bf16_t* rowp = H + (size_t)(row0 + ai * HALF + m * 16) * 512 + hc0;
                float o[8];
#pragma unroll
                for (int n = 0; n < 2; ++n)
#pragma unroll
                    for (int r = 0; r < 4; ++r) { const float g = acc[ai][0][m][n][r]; o[n * 4 + r] = g * __builtin_amdgcn_rcpf(1.0f + __expf(-g)) * acc[ai][1][m][n][r]; }
                u32x4 w; w.x = cvt_pk_bf16(o[0], o[1]); w.y = cvt_pk_bf16(o[2], o[3]); w.z = cvt_pk_bf16(o[4], o[5]); w.w = cvt_pk_bf16(o[6], o[7]);
                *(u32x4*)rowp = w; }
    }
};
struct MoeOrder {
    const int* slotmap; int ntiles, G, c;
    __device__ __forceinline__ bool next(int i, Unit& u) const {
        const int L = i * G + c; if (L >= ntiles * 4) return false;
        u.pm = L >> 2; u.pn = __builtin_amdgcn_readfirstlane(slotmap[L >> 2]) * 4 + (L & 3); return true;
    }
    __device__ __forceinline__ void a_ready(const Unit&) const {}
    __device__ __forceinline__ void done(const Unit&) const {}
};
}
#define WSP(T, off) as_global((T*)(kp.ws + (off)))
#define KIN(i) as_global(kp.in[i])
#define KOUT as_global(kp.out)

PHASE_FN void phase_mod(const KP& kp, unsigned char* lds) {
    float* sc = (float*)lds;
    float* red = sc + 17 * 1024;
    float* modv = WSP(float, WS_MODV);
    const int tid = otid();
    for (int i = tid; i < 17 * 1024; i += 512) { const int bb = i >> 10, k = i & 1023; const float c = bb < 16 ? KIN(1)[bb * 1024 + k] : KIN(3)[k]; sc[i] = siluf_(c); }
    __syncthreads();
    const int jc = tid & 63, ks = tid >> 6;
    for (int u = obid(); u < 192; u += gridDim.x) {
        const int l = u / 96, j0 = (u % 96) * 64;
        const float* w = KIN(4) + (size_t)l * 1024 * 6144 + j0 + jc;
        float acc[17];
#pragma unroll
        for (int bb = 0; bb < 17; ++bb) acc[bb] = 0.f;
        for (int k = ks * 128; k < ks * 128 + 128; ++k) {
            const float wv = w[(size_t)k * 6144];
#pragma unroll
            for (int bb = 0; bb < 17; ++bb) acc[bb] += sc[bb * 1024 + k] * wv;
        }
#pragma unroll
        for (int bb = 0; bb < 17; ++bb) red[(ks * 17 + bb) * 64 + jc] = acc[bb];
        __syncthreads();
        for (int i = tid; i < 17 * 64; i += 512) {
            const int bb = i >> 6, j = i & 63; float s = KIN(5)[l * 6144 + j0 + j];
#pragma unroll
            for (int k2 = 0; k2 < 8; ++k2) s += red[(k2 * 17 + bb) * 64 + j];
            modv[((size_t)l * 17 + bb) * 6144 + j0 + j] = s;
        }
        __syncthreads();
    }
}

struct CvJob { const float* src; bf16_t* dst; int N, ldd, mode, kt, ntile; };
__device__ __forceinline__ bool cv_pick(int& u, CvJob& J, const float* src, int K, int N, bf16_t* dst, int mode = 0, int ldd = -1) {
    const int ntl = (N + 63) >> 6, cnt = ntl * (K >> 6);
    if (u < cnt) { J.src = src; J.dst = dst; J.N = N; J.ldd = ldd < 0 ? K : ldd; J.mode = mode; J.kt = u / ntl; J.ntile = u % ntl; return true; }
    u -= cnt; return false;
}
__device__ __forceinline__ void cv_load(const CvJob& J, int tid, f32x4 (&r)[2]) {
#pragma unroll
    for (int i = 0; i < 2; ++i) { const int idx = tid + i * 512, k = idx >> 4, n0 = J.ntile * 64 + (idx & 15) * 4;
        r[i] = (n0 < J.N) ? *(const f32x4*)(J.src + (size_t)(J.kt * 64 + k) * J.N + n0) : (f32x4){0.f, 0.f, 0.f, 0.f}; }
}
__device__ __forceinline__ void cv_put(float* tile, int tid, const f32x4 (&r)[2]) {
#pragma unroll
    for (int i = 0; i < 2; ++i) { const int idx = tid + i * 512, k = idx >> 4, nq = (idx & 15) * 4;
        tile[k * 65 + nq] = r[i][0]; tile[k * 65 + nq + 1] = r[i][1]; tile[k * 65 + nq + 2] = r[i][2]; tile[k * 65 + nq + 3] = r[i][3]; }
}
__device__ __forceinline__ void cv_store(const float* tile, const CvJob& J, int tid) {
    const int nl = tid >> 3, k8 = tid & 7, n = J.ntile * 64 + nl;
    if (n < J.N) { int row = n; if (J.mode) row = (n >> 7) * 256 + (n & 127) + (J.mode == 2 ? 128 : 0);
        u32x4 w; const float* tp = tile + (k8 * 8) * 65 + nl;
        w.x = pack2(tp[0], tp[65]); w.y = pack2(tp[130], tp[195]); w.z = pack2(tp[260], tp[325]); w.w = pack2(tp[390], tp[455]);
        *(u32x4*)(J.dst + (size_t)row * J.ldd + J.kt * 64 + k8 * 8) = w; }
}
#define CV_RUN(total, PICK) do { float* tile = (float*)lds; const int tid = otid(); const int G_ = gridDim.x; int u_ = obid(); CvJob J, Jn; f32x4 r[2]; \
        if (u_ < (total)) { int u = u_; PICK(u, J); cv_load(J, tid, r); } \
        while (u_ < (total)) { cv_put(tile, tid, r); __syncthreads(); const int un_ = u_ + G_; \
            if (un_ < (total)) { int u = un_; PICK(u, Jn); cv_load(Jn, tid, r); } \
            cv_store(tile, J, tid); __syncthreads(); u_ = un_; J = Jn; } } while (0)
PHASE_FN void phase_conv_ab(const KP& kp, unsigned char* lds) {
#define PICK_AB(u, J) do { if (!cv_pick(u, J, KIN(7), 1024, AB_N, WSP(bf16_t, WS_WMIX + WM_AB_IN))) cv_pick(u, J, KIN(8), 2048, 1024, WSP(bf16_t, WS_WMIX + WM_AB_OUT)); } while (0)
    CV_RUN(16 * 85 + 32 * 16, PICK_AB);
#undef PICK_AB
}
PHASE_FN void phase_conv_cd(const KP& kp, unsigned char* lds) {
#define PICK_CD(u, J) do { if (cv_pick(u, J, KIN(18), 1024, CD_N, WSP(bf16_t, WS_WMIX + WM_CD_IN))) break; \
        if (cv_pick(u, J, KIN(19), 1536, 1024, WSP(bf16_t, WS_WMIX + WM_CD_OUT))) break; \
        if (cv_pick(u, J, KIN(21), 384, 768, WSP(bf16_t, WS_WMIX + WM_UQ))) break; \
        if (cv_pick(u, J, KIN(23), 256, 1024, WSP(bf16_t, WS_WMIX + WM_UKV))) break; \
        cv_pick(u, J, KIN(29), 128, 1024, WSP(bf16_t, WS_WMIX + WM_G2)); } while (0)
    CV_RUN(16 * 65 + 24 * 16 + 6 * 12 + 4 * 16 + 2 * 16, PICK_CD);
#undef PICK_CD
}
PHASE_FN void phase_conv_moe(const KP& kp, unsigned char* lds, int l) {
#define PICK_MOE(u0, J) do { const int es = (u0) / 384; int uu = (u0) % 384; \
        const float* wg = es < 16 ? KIN(36) + ((size_t)l * 16 + es) * 1024 * 512 : KIN(39) + (size_t)l * 1024 * 512; \
        const float* wu = es < 16 ? KIN(37) + ((size_t)l * 16 + es) * 1024 * 512 : KIN(40) + (size_t)l * 1024 * 512; \
        const float* wd = es < 16 ? KIN(38) + ((size_t)l * 16 + es) * 512 * 1024 : KIN(41) + (size_t)l * 512 * 1024; \
        bf16_t* dup = WSP(bf16_t, WS_BIG + MO_WUP) + (size_t)es * 1024 * 1024; bf16_t* ddn = WSP(bf16_t, WS_BIG + MO_WDN) + (size_t)es * 1024 * 512; \
        if (cv_pick(uu, J, wg, 1024, 512, dup, 1, 1024)) break; if (cv_pick(uu, J, wu, 1024, 512, dup, 2, 1024)) break; cv_pick(uu, J, wd, 512, 1024, ddn, 0, 512); } while (0)
    CV_RUN(17 * 384, PICK_MOE);
#undef PICK_MOE
}

__device__ __forceinline__ const float* hrow_rd(const KP& kp, bool from_inputs, int b, int t) {
    if (t < CTXL) return (from_inputs ? KIN(2) : WSP(const float, WS_HC)) + ((size_t)b * CTXL + t) * D;
    return (from_inputs ? KIN(0) : KOUT) + ((size_t)b * SEQ + (t - CTXL)) * D;
}
__device__ __forceinline__ float* hrow_wr(const KP& kp, int b, int t) {
    if (t < CTXL) return WSP(float, WS_HC) + ((size_t)b * CTXL + t) * D;
    return KOUT + ((size_t)b * SEQ + (t - CTXL)) * D;
}

PHASE_FN void phase_u(const KP& kp, int layer, int g) {
    const int lane = otid() & 63, wid = __builtin_amdgcn_readfirstlane(otid() >> 6);
    const float* modv = WSP(const float, WS_MODV) + (size_t)layer * 17 * 6144;
    const float* ng = KIN(6) + (size_t)layer * 4 * 1024;
    bf16_t* U = WSP(bf16_t, WS_BIG + (layer == 0 ? L0_U : L1_U));
    for (int lr = obid() * 8 + wid; lr < RG; lr += gridDim.x * 8) {
        const int bl = lr / TT, t = lr - bl * TT, b = g * BG + bl;
        const float* src = hrow_rd(kp, layer == 0, b, t);
        const float* mv = modv + (size_t)(t < CTXL ? 16 : b) * 6144;
        f32x4 x[4]; float ss = 0.f;
#pragma unroll
        for (int i = 0; i < 4; ++i) { x[i] = *(const f32x4*)(src + i * 256 + lane * 4); ss += x[i][0] * x[i][0] + x[i][1] * x[i][1] + x[i][2] * x[i][2] + x[i][3] * x[i][3]; }
        ss = wsum(ss); const float rstd = rsqrtf(ss * (1.0f / 1024.0f) + EPS);
#pragma unroll
        for (int i = 0; i < 4; ++i) { const int col = i * 256 + lane * 4;
            const f32x4 gv = *(const f32x4*)(ng + col), sc = *(const f32x4*)(mv + 1024 + col), sh = *(const f32x4*)(mv + col);
            st4bf(U + (size_t)lr * 1024 + col, x[i] * rstd * gv * (sc + 1.0f) + sh); }
    }
}

PHASE_FN void phase_r(const KP& kp, unsigned char* lds, int layer, int g) {
    const int tid = otid(), lane = tid & 63, wid = __builtin_amdgcn_readfirstlane(tid >> 6);
    float* rw = (float*)lds;
    int* se = (int*)(rw + 1024 * 16);
    int* sbase = se + 160;
    for (int i = tid; i < 1024 * 16; i += 512) rw[i] = KIN(34)[i];
    __syncthreads();
    const float* modv = WSP(const float, WS_MODV) + (size_t)layer * 17 * 6144;
    const float* ng = KIN(6) + (size_t)layer * 4 * 1024;
    const bf16_t* MIX = WSP(const bf16_t, WS_BIG + (layer == 0 ? L0_U : L1_U));
    bf16_t* V = WSP(bf16_t, WS_V);
    unsigned* cnt = WSP(unsigned, CTL_CNT) + layer * 16;
    int* TOKE = WSP(int, WS_TOKE); int* TOKP = WSP(int, WS_TOKP); float* TOKW = WSP(float, WS_TOKW); int* LIST = WSP(int, WS_LIST);
    const int nrows = layer == 0 ? RG : RGL, CH = layer == 0 ? 72 : 64, RW = CH >> 3, nchunks = nrows / CH;
    float rbias[16];
#pragma unroll
    for (int e = 0; e < 16; ++e) rbias[e] = KIN(35)[e];
    for (int ch = obid(); ch < nchunks; ch += gridDim.x) {
        for (int rr = 0; rr < RW; ++rr) {
            const int rl = wid * RW + rr, lr = ch * CH + rl;
            int b, t, tok;
            if (layer == 0) { const int bl = lr / TT; t = lr - bl * TT; b = g * BG + bl; tok = g * RG + lr; }
            else { const int bl = lr >> 11; t = CTXL + (lr & 2047); b = g * BG + bl; tok = g * RGL + lr; }
            const float* hsrc = hrow_rd(kp, layer == 0, b, t);
            float* hdst = hrow_wr(kp, b, t);
            const float* mv = modv + (size_t)(t < CTXL ? 16 : b) * 6144;
            f32x4 y[4], h[4]; float ss = 0.f;
#pragma unroll
            for (int i = 0; i < 4; ++i) { y[i] = ld4bf(MIX + (size_t)lr * 1024 + i * 256 + lane * 4); ss += y[i][0] * y[i][0] + y[i][1] * y[i][1] + y[i][2] * y[i][2] + y[i][3] * y[i][3]; }
            ss = wsum(ss); float rstd = rsqrtf(ss * (1.0f / 1024.0f) + EPS);
            float s2 = 0.f;
#pragma unroll
            for (int i = 0; i < 4; ++i) { const int col = i * 256 + lane * 4;
                const f32x4 g1 = *(const f32x4*)(ng + 1024 + col), ga = *(const f32x4*)(mv + 2048 + col), hx = *(const f32x4*)(hsrc + col);
                h[i] = hx + ga * (y[i] * rstd * g1);
                *(f32x4*)(hdst + col) = h[i];
                s2 += h[i][0] * h[i][0] + h[i][1] * h[i][1] + h[i][2] * h[i][2] + h[i][3] * h[i][3]; }
            s2 = wsum(s2); rstd = rsqrtf(s2 * (1.0f / 1024.0f) + EPS);
            float lg[16];
#pragma unroll
            for (int e = 0; e < 16; ++e) lg[e] = 0.f;
#pragma unroll
            for (int i = 0; i < 4; ++i) { const int col = i * 256 + lane * 4;
                const f32x4 g2 = *(const f32x4*)(ng + 2048 + col), scf = *(const f32x4*)(mv + 4096 + col), shf = *(const f32x4*)(mv + 3072 + col);
                const f32x4 v = h[i] * rstd * g2 * (scf + 1.0f) + shf;
                st4bf(V + (size_t)tok * 1024 + col, v);
#pragma unroll
                for (int j = 0; j < 4; ++j) {
#pragma unroll
                    for (int q = 0; q < 4; ++q) { const f32x4 w4 = *(const f32x4*)(rw + (col + j) * 16 + q * 4);
                        lg[q * 4 + 0] += v[j] * w4[0]; lg[q * 4 + 1] += v[j] * w4[1]; lg[q * 4 + 2] += v[j] * w4[2]; lg[q * 4 + 3] += v[j] * w4[3]; } } }
#pragma unroll
            for (int e = 0; e < 16; ++e) lg[e] = wsum(lg[e]);
            float aff[16], sel[16];
#pragma unroll
            for (int e = 0; e < 16; ++e) { aff[e] = sigmoidf_(lg[e]); sel[e] = aff[e] + rbias[e]; }
            float gs[4];
#pragma unroll
            for (int gi = 0; gi < 4; ++gi) { const float a0 = sel[gi * 4], a1 = sel[gi * 4 + 1], a2 = sel[gi * 4 + 2], a3 = sel[gi * 4 + 3];
                gs[gi] = fmaxf(fmaxf(fmaxf(a0 + a1, a0 + a2), fmaxf(a0 + a3, a1 + a2)), fmaxf(a1 + a3, a2 + a3)); }
            int gidx = 0; float gb = gs[0];
#pragma unroll
            for (int gi = 1; gi < 4; ++gi) if (gs[gi] > gb) { gb = gs[gi]; gidx = gi; }
            float c[4], f[4];
#pragma unroll
            for (int i = 0; i < 4; ++i) { c[i] = gidx == 0 ? sel[i] : gidx == 1 ? sel[4 + i] : gidx == 2 ? sel[8 + i] : sel[12 + i];
                                           f[i] = gidx == 0 ? aff[i] : gidx == 1 ? aff[4 + i] : gidx == 2 ? aff[8 + i] : aff[12 + i]; }
            int i1 = 0; float cb = c[0];
#pragma unroll
            for (int i = 1; i < 4; ++i) if (c[i] > cb) { cb = c[i]; i1 = i; }
            int i2 = -1; float cb2 = 0.f;
#pragma unroll
            for (int i = 0; i < 4; ++i) if (i != i1 && (i2 < 0 || c[i] > cb2)) { cb2 = c[i]; i2 = i; }
            float w1 = i1 == 0 ? f[0] : i1 == 1 ? f[1] : i1 == 2 ? f[2] : f[3];
            float w2 = i2 == 0 ? f[0] : i2 == 1 ? f[1] : i2 == 2 ? f[2] : f[3];
            const float wsn = 1.0f / (w1 + w2); w1 *= wsn; w2 *= wsn;
            if (lane == 0) { se[rl * 2] = gidx * 4 + i1; se[rl * 2 + 1] = gidx * 4 + i2;
                TOKE[tok * 2] = gidx * 4 + i1; TOKE[tok * 2 + 1] = gidx * 4 + i2; TOKW[tok * 2] = w1; TOKW[tok * 2 + 1] = w2; }
        }
        __syncthreads();
        if (tid < 16) { int c2 = 0; for (int i = 0; i < 2 * CH; ++i) c2 += (se[i] == tid) ? 1 : 0; sbase[tid] = (int)atomicAdd(&cnt[tid], (unsigned)c2); }
        __syncthreads();
        if (tid < 2 * CH) { const int e = se[tid]; int rank = 0; for (int j = 0; j < tid; ++j) rank += (se[j] == e) ? 1 : 0;
            const int pos = sbase[e] + rank; const int lr = ch * CH + (tid >> 1); const int tok = (layer == 0 ? g * RG : g * RGL) + lr;
            LIST[(size_t)e * NTOK + pos] = tok; TOKP[tok * 2 + (tid & 1)] = pos; }
        __syncthreads();
    }
}

__device__ __forceinline__ int moe_tile_prefix(const unsigned* cnt, int ntok, int lane) {
    const int myt = lane < 16 ? (int)((cnt[lane & 15] + 255u) >> 8) : 0; int pref = myt;
#pragma unroll
    for (int o = 1; o < 16; o <<= 1) { const int t = __shfl_up(pref, o); if (lane >= o) pref += t; }
    return pref - myt + ntok / 256;
}
PHASE_FN void phase_moe_gather(const KP& kp, int layer) {
    const int lane = otid() & 63, wid = __builtin_amdgcn_readfirstlane(otid() >> 6);
    const int ntok = layer == 0 ? NTOK : NLAT;
    const int tpre = moe_tile_prefix(WSP(const unsigned, CTL_CNT) + layer * 16, ntok, lane);
    const bf16_t* V = WSP(const bf16_t, WS_V); bf16_t* XG = WSP(bf16_t, WS_BIG + MO_XG);
    const int* TOKE = WSP(const int, WS_TOKE); const int* TOKP = WSP(const int, WS_TOKP);
    for (int it = obid() * 8 + wid; it < 2 * ntok; it += gridDim.x * 8) {
        const int tok = it >> 1, e = TOKE[it], pos = TOKP[it];
        const size_t row = (size_t)(__shfl(tpre, e) - ntok / 256) * 256 + pos;
        const u32x4* src = (const u32x4*)(V + (size_t)tok * 1024) + lane * 2; u32x4* dst = (u32x4*)(XG + row * 1024) + lane * 2;
        const u32x4 a = src[0], b2 = src[1]; dst[0] = a; dst[1] = b2;
    }
}
PHASE_FN void phase_moe_gemm(const KP& kp, unsigned char* lds, int layer, bool down) {
    const int tid = otid();
    int* pre = (int*)(lds + pg8::STAGE_BYTES);
    int* slotmap = pre + 32;
    const int ntok = layer == 0 ? NTOK : NLAT;
    const unsigned* cnt = WSP(const unsigned, CTL_CNT) + layer * 16;
    if (tid == 0) { int p = ntok / 256; pre[0] = 0; pre[1] = p; for (int e = 0; e < 16; ++e) { p += ((int)cnt[e] + 255) >> 8; pre[2 + e] = p; } }
    __syncthreads();
    const int ntiles = pre[17];
    for (int t = tid; t < ntiles; t += 512) { int idx = 0; for (int e = 1; e < 17; ++e) if (pre[e] <= t) idx = e; slotmap[t] = idx == 0 ? 16 : idx - 1; }
    __syncthreads();
    pg8::MoeOrder S{slotmap, ntiles, (int)gridDim.x, obid()};
    if (!down) {
        pg8::Gemm g{WSP(const bf16_t, WS_V), WSP(const bf16_t, WS_BIG + MO_WUP), 0, 0, 1024, WSP(const bf16_t, WS_BIG + MO_XG), ntok / 256};
        pg8::EpiSwi E{WSP(bf16_t, WS_BIG + MO_HID)};
        pg8::gemm_phase<pg8::EpiSwi, pg8::MoeOrder, false>((PG8_LAS unsigned char*)lds, g, S, E, nullptr);
    } else {
        pg8::Gemm g{WSP(const bf16_t, WS_BIG + MO_HID), WSP(const bf16_t, WS_BIG + MO_WDN), 0, 0, 512, nullptr, 0x7fffffff};
        pg8::EpiBfG E{WSP(bf16_t, WS_BIG + MO_CON), 1024, 1024, 3};
        pg8::gemm_phase<pg8::EpiBfG, pg8::MoeOrder, false>((PG8_LAS unsigned char*)lds, g, S, E, nullptr);
    }
    __syncthreads();
}

PHASE_FN void phase_combine(const KP& kp, int layer) {
    const int lane = otid() & 63, wid = __builtin_amdgcn_readfirstlane(otid() >> 6);
    const int ntok = layer == 0 ? NTOK : NLAT;
    const unsigned* cnt = WSP(const unsigned, CTL_CNT) + layer * 16;
    const float* modv = WSP(const float, WS_MODV) + (size_t)layer * 17 * 6144;
    const float* ng = KIN(6) + (size_t)layer * 4 * 1024 + 3 * 1024;
    const bf16_t* CON = WSP(const bf16_t, WS_BIG + MO_CON);
    const int* TOKE = WSP(const int, WS_TOKE); const int* TOKP = WSP(const int, WS_TOKP); const float* TOKW = WSP(const float, WS_TOKW);
    const int tpre = moe_tile_prefix(cnt, ntok, lane);
    for (int tok0 = (obid() * 8 + wid) * 2; tok0 < ntok; tok0 += gridDim.x * 16) {
        int e1[2], e2[2], p1[2], p2[2]; float w1[2], w2[2];
#pragma unroll
        for (int u = 0; u < 2; ++u) { const int tok = tok0 + u; e1[u] = TOKE[tok * 2]; e2[u] = TOKE[tok * 2 + 1]; p1[u] = TOKP[tok * 2]; p2[u] = TOKP[tok * 2 + 1]; w1[u] = TOKW[tok * 2]; w2[u] = TOKW[tok * 2 + 1]; }
        f32x4 f[2][4], hx[2][4]; float* hp[2]; const float* mv[2];
#pragma unroll
        for (int u = 0; u < 2; ++u) { const int tok = tok0 + u;
            const size_t r1 = (size_t)__shfl(tpre, e1[u]) * 256 + p1[u], r2 = (size_t)__shfl(tpre, e2[u]) * 256 + p2[u];
            int b, t;
            if (layer == 0) { b = tok / TT; t = tok - b * TT; } else { b = tok >> 11; t = CTXL + (tok & 2047); }
            hp[u] = hrow_wr(kp, b, t); mv[u] = modv + (size_t)(t < CTXL ? 16 : b) * 6144 + 5 * 1024;
#pragma unroll
            for (int i = 0; i < 4; ++i) { const int col = i * 256 + lane * 4;
                f[u][i] = ld4bf(CON + (size_t)tok * 1024 + col) + ld4bf(CON + r1 * 1024 + col) * w1[u] + ld4bf(CON + r2 * 1024 + col) * w2[u];
                hx[u][i] = *(const f32x4*)(hp[u] + col); } }
#pragma unroll
        for (int u = 0; u < 2; ++u) { float ss = 0.f;
#pragma unroll
            for (int i = 0; i < 4; ++i) ss += f[u][i][0] * f[u][i][0] + f[u][i][1] * f[u][i][1] + f[u][i][2] * f[u][i][2] + f[u][i][3] * f[u][i][3];
            ss = wsum(ss); const float rstd = rsqrtf(ss * (1.0f / 1024.0f) + EPS);
#pragma unroll
            for (int i = 0; i < 4; ++i) { const int col = i * 256 + lane * 4;
                const f32x4 g3 = *(const f32x4*)(ng + col), gf = *(const f32x4*)(mv[u] + col);
                *(f32x4*)(hp[u] + col) = hx[u][i] + gf * (f[u][i] * rstd * g3); } }
    }
}

template <int CH>
__device__ __forceinline__ int scan_t(int dir, int ci, int j) {
    constexpr int NC_CTX = CTXL / CH;
    if (!dir) return ci * CH + j;
    return ci < NC_CTX ? (CTXL - 1 - ci * CH - j) : (TT - 1 - (ci - NC_CTX) * CH - j);
}

constexpr int ML_LQ = 136, ML_LT = 72, ML_VR = 144;
PHASE_FN void mlstm_unit(const KP& kp, unsigned char* lds, int bl, int h, int dir, int vh) {
    const int tid = otid();
    bf16_t* Qs = (bf16_t*)lds;
    bf16_t* Ks = Qs + 64 * ML_LQ;
    bf16_t* KTE = Ks + 64 * ML_LQ;
    bf16_t* VT = KTE + 128 * ML_LT;
    bf16_t* Ps = VT + ML_VR * ML_LT;
    bf16_t* Cb = Ps + 64 * ML_LT;
    float* fs = (float*)(Cb + ML_VR * ML_LQ);
    float* s_rowv = fs;
    float* s_colv = fs + 64;
    float* s_wint = fs + 128;
    float* s_emj = fs + 192;
    float* s_E = fs + 256;
    float* s_den = fs + 320;
    float* s_misc = fs + 384;
    const bf16_t* P = WSP(const bf16_t, WS_BIG + L0_P);
    bf16_t* HOUT = WSP(bf16_t, WS_BIG + (dir ? L0_HB : L0_AO)); const int ldh = dir ? 1024 : 2048;
    const float ibias = KIN(9)[dir * 4 + h], fbias = KIN(10)[dir * 4 + h];
    for (int i = tid; i < ML_VR * ML_LQ; i += 512) Cb[i] = 0;
    for (int i = tid; i < 16 * ML_LT; i += 512) VT[128 * ML_LT + i] = (i < ML_LT) ? (bf16_t)0x3f80 : (bf16_t)0;
    f32x4 Cacc[8], Nacc;
#pragma unroll
    for (int i = 0; i < 8; ++i) Cacc[i] = (f32x4){0.f, 0.f, 0.f, 0.f};
    Nacc = (f32x4){0.f, 0.f, 0.f, 0.f};
    float m_state = 0.f;
    u32x4 pq[2], pk[2], pv[2]; bf16_t pgi = 0, pgf = 0;
#define ML_REQ(ci_) do { _Pragma("unroll") for (int i = 0; i < 2; ++i) { const int p = tid + i * 512, j = p >> 4, c8 = p & 15; \
            const bf16_t* pr = P + ((size_t)bl * TT + scan_t<64>(dir, (ci_), j)) * AB_N; \
            pq[i] = *(const u32x4*)(pr + AB_Q + h * 128 + c8 * 8); pk[i] = *(const u32x4*)(pr + AB_K + h * 128 + c8 * 8); \
            const int jv = tid & 63, cv = (tid >> 6) + i * 8; \
            pv[i] = *(const u32x4*)(P + ((size_t)bl * TT + scan_t<64>(dir, (ci_), jv)) * AB_N + AB_V + h * 256 + vh * 128 + cv * 8); } \
        if (tid < 64) { const bf16_t* pg = P + ((size_t)bl * TT + scan_t<64>(dir, (ci_), tid)) * AB_N; pgi = pg[AB_IG + dir * 4 + h]; pgf = pg[AB_FG + dir * 4 + h]; } } while (0)
    ML_REQ(0);
    lds_barrier();
    for (int ci = 0; ci < TT / 64; ++ci) {
        int tq = tid; asm volatile("" : "+v"(tq));
        const int lane = tq & 63, wid = __builtin_amdgcn_readfirstlane(tq >> 6), fr = lane & 15, fq = lane >> 4;
#pragma unroll
        for (int i = 0; i < 2; ++i) {
            const int p = tq + i * 512, j = p >> 4, c8 = p & 15;
            u32x4 q = pq[i];
            const float qs = 0.08838834764831845f;
            q.x = pack2(lo2f(q.x) * qs, hi2f(q.x) * qs); q.y = pack2(lo2f(q.y) * qs, hi2f(q.y) * qs);
            q.z = pack2(lo2f(q.z) * qs, hi2f(q.z) * qs); q.w = pack2(lo2f(q.w) * qs, hi2f(q.w) * qs);
            *(u32x4*)(Qs + j * ML_LQ + c8 * 8) = q;
            *(u32x4*)(Ks + j * ML_LQ + c8 * 8) = pk[i];
            const u32x4 v = pv[i];
            bf16_t* vt = VT + (((tq >> 6) + i * 8) * 8) * ML_LT + (tq & 63);
            vt[0 * ML_LT] = (bf16_t)(v.x & 0xffff); vt[1 * ML_LT] = (bf16_t)(v.x >> 16); vt[2 * ML_LT] = (bf16_t)(v.y & 0xffff); vt[3 * ML_LT] = (bf16_t)(v.y >> 16);
            vt[4 * ML_LT] = (bf16_t)(v.z & 0xffff); vt[5 * ML_LT] = (bf16_t)(v.z >> 16); vt[6 * ML_LT] = (bf16_t)(v.w & 0xffff); vt[7 * ML_LT] = (bf16_t)(v.w >> 16);
        }
        if (wid == 0) {
            const float ig = bf2f(pgi) + ibias;
            const float lf = logsigmoidf_(bf2f(pgf) + fbias);
            float b = lf;
#pragma unroll
            for (int o = 1; o < 64; o <<= 1) { const float t = __shfl_up(b, o); if (lane >= o) b += t; }
            const float u = ig - b; float pm = u;
#pragma unroll
            for (int o = 1; o < 64; o <<= 1) { const float t = __shfl_up(pm, o); if (lane >= o) pm = fmaxf(pm, t); }
            const float mj = fmaxf(b + m_state, b + pm);
            const float b63 = __shfl(b, 63), pm63 = __shfl(pm, 63);
            const float mnew = fmaxf(b63 + m_state, b63 + pm63);
            s_rowv[lane] = b - mj; s_colv[lane] = u; s_wint[lane] = __expf(b + m_state - mj); s_emj[lane] = __expf(-mj);
            s_E[lane] = __expf(b63 + u - mnew);
            if (lane == 0) { s_misc[0] = mnew; s_misc[1] = __expf(b63 + m_state - mnew); }
        }
        if (ci + 1 < TT / 64) ML_REQ(ci + 1);
        lds_barrier();
        {
            const int jt = wid >> 1;
#pragma unroll
            for (int q2 = 0; q2 < 2; ++q2) {
                const int st = (wid & 1) * 2 + q2;
                f32x4 acc = (f32x4){0.f, 0.f, 0.f, 0.f};
                if (st <= jt) {
                    bf16x8 fa[4], fb[4];
#pragma unroll
                    for (int k = 0; k < 4; ++k) { fa[k] = ldfrag(Qs, ML_LQ, jt * 16, k * 32, fr, fq); fb[k] = ldfrag(Ks, ML_LQ, st * 16, k * 32, fr, fq); }
                    __builtin_amdgcn_sched_barrier(0);
                    f32x4 acc2 = (f32x4){0.f, 0.f, 0.f, 0.f};
                    acc = mma16(fa[0], fb[0], acc); acc2 = mma16(fa[1], fb[1], acc2); acc = mma16(fa[2], fb[2], acc); acc2 = mma16(fa[3], fb[3], acc2);
                    acc = acc + acc2;
                }
                const int s = st * 16 + fr; const float cv = s_colv[s];
#pragma unroll
                for (int r = 0; r < 4; ++r) { const int j = jt * 16 + fq * 4 + r;
                    const float pv2 = (s <= j) ? acc[r] * __expf(s_rowv[j] + cv) : 0.f;
                    Ps[j * ML_LT + s] = f2bf(pv2); }
            }
#pragma unroll
            for (int i = 0; i < 2; ++i) {
                const int s = lane, c8 = wid + i * 8; const float e = s_E[s];
                const u32x4 kv = *(const u32x4*)(Ks + s * ML_LQ + c8 * 8);
                bf16_t* kt = KTE + (c8 * 8) * ML_LT + s;
                kt[0 * ML_LT] = f2bf(lo2f(kv.x) * e); kt[1 * ML_LT] = f2bf(hi2f(kv.x) * e); kt[2 * ML_LT] = f2bf(lo2f(kv.y) * e); kt[3 * ML_LT] = f2bf(hi2f(kv.y) * e);
                kt[4 * ML_LT] = f2bf(lo2f(kv.z) * e); kt[5 * ML_LT] = f2bf(hi2f(kv.z) * e); kt[6 * ML_LT] = f2bf(lo2f(kv.w) * e); kt[7 * ML_LT] = f2bf(hi2f(kv.w) * e);
            }
        }
        lds_barrier();
        f32x4 a1[4], a2[4];
        {
            const int jt = wid >> 1;
            bf16x8 fp[2], fqq[4];
#pragma unroll
            for (int k = 0; k < 2; ++k) fp[k] = ldfrag(Ps, ML_LT, jt * 16, k * 32, fr, fq);
#pragma unroll
            for (int k = 0; k < 4; ++k) fqq[k] = ldfrag(Qs, ML_LQ, jt * 16, k * 32, fr, fq);
            {
                bf16x8 fv[4][2];
#pragma unroll
                for (int q4 = 0; q4 < 4; ++q4)
#pragma unroll
                    for (int k = 0; k < 2; ++k) fv[q4][k] = ldfrag(VT, ML_LT, ((wid & 1) * 4 + q4) * 16, k * 32, fr, fq);
                __builtin_amdgcn_sched_barrier(0);
#pragma unroll
                for (int q4 = 0; q4 < 4; ++q4) a1[q4] = (f32x4){0.f, 0.f, 0.f, 0.f};
#pragma unroll
                for (int k = 0; k < 2; ++k)
#pragma unroll
                    for (int q4 = 0; q4 < 4; ++q4) a1[q4] = mma16(fv[q4][k], fp[k], a1[q4]);
            }
#pragma unroll
            for (int hh = 0; hh < 2; ++hh) {
                bf16x8 fc[2][4];
#pragma unroll
                for (int q2 = 0; q2 < 2; ++q2)
#pragma unroll
                    for (int k = 0; k < 4; ++k) fc[q2][k] = ldfrag(Cb, ML_LQ, ((wid & 1) * 4 + hh * 2 + q2) * 16, k * 32, fr, fq);
                __builtin_amdgcn_sched_barrier(0);
                a2[hh * 2] = (f32x4){0.f, 0.f, 0.f, 0.f}; a2[hh * 2 + 1] = (f32x4){0.f, 0.f, 0.f, 0.f};
#pragma unroll
                for (int k = 0; k < 4; ++k) { a2[hh * 2] = mma16(fc[0][k], fqq[k], a2[hh * 2]); a2[hh * 2 + 1] = mma16(fc[1][k], fqq[k], a2[hh * 2 + 1]); }
            }
            if (wid & 1) {
                f32x4 d1 = (f32x4){0.f, 0.f, 0.f, 0.f}, d2 = (f32x4){0.f, 0.f, 0.f, 0.f};
                bf16x8 fo[2], fn[4];
#pragma unroll
                for (int k = 0; k < 2; ++k) fo[k] = ldfrag(VT, ML_LT, 128, k * 32, fr, fq);
#pragma unroll
                for (int k = 0; k < 4; ++k) fn[k] = ldfrag(Cb, ML_LQ, 128, k * 32, fr, fq);
                __builtin_amdgcn_sched_barrier(0);
                d1 = mma16(fo[0], fp[0], d1); d2 = mma16(fn[0], fqq[0], d2); d1 = mma16(fo[1], fp[1], d1); d2 = mma16(fn[1], fqq[1], d2);
                d2 = mma16(fn[2], fqq[2], d2); d2 = mma16(fn[3], fqq[3], d2);
                if (fq == 0) { const int j = jt * 16 + fr; s_den[j] = fmaxf(fabsf(d1[0] + s_wint[j] * d2[0]), s_emj[j]); }
            }
        }
        lds_barrier();
        {
            const int jt = wid >> 1, j = jt * 16 + fr;
            const float wi = s_wint[j], rden = frcp_(s_den[j]);
            const size_t row = (size_t)bl * TT + scan_t<64>(dir, ci, j);
#pragma unroll
            for (int q4 = 0; q4 < 4; ++q4) { const int v0 = ((wid & 1) * 4 + q4) * 16 + fq * 4;
                st4bf(HOUT + row * ldh + h * 256 + vh * 128 + v0, (a1[q4] + a2[q4] * wi) * rden); }
        }
        {
            const float dec = s_misc[1];
            const bf16x8 bv0 = ldfrag(VT, ML_LT, wid * 16, 0, fr, fq), bv1 = ldfrag(VT, ML_LT, wid * 16, 32, fr, fq);
#pragma unroll
            for (int hh = 0; hh < 2; ++hh) {
                bf16x8 fk[4][2];
#pragma unroll
                for (int q = 0; q < 4; ++q) { fk[q][0] = ldfrag(KTE, ML_LT, (hh * 4 + q) * 16, 0, fr, fq); fk[q][1] = ldfrag(KTE, ML_LT, (hh * 4 + q) * 16, 32, fr, fq); }
                __builtin_amdgcn_sched_barrier(0);
#pragma unroll
                for (int q = 0; q < 4; ++q) Cacc[hh * 4 + q] = Cacc[hh * 4 + q] * dec;
#pragma unroll
                for (int q = 0; q < 4; ++q) Cacc[hh * 4 + q] = mma16(fk[q][0], bv0, Cacc[hh * 4 + q]);
#pragma unroll
                for (int q = 0; q < 4; ++q) Cacc[hh * 4 + q] = mma16(fk[q][1], bv1, Cacc[hh * 4 + q]);
#pragma unroll
                for (int q = 0; q < 4; ++q) st4bf(Cb + (wid * 16 + fr) * ML_LQ + (hh * 4 + q) * 16 + fq * 4, Cacc[hh * 4 + q]);
            }
            Nacc = Nacc * dec;
            Nacc = mma16(ldfrag(KTE, ML_LT, wid * 16, 0, fr, fq), ldfrag(VT, ML_LT, 128, 0, fr, fq), Nacc);
            Nacc = mma16(ldfrag(KTE, ML_LT, wid * 16, 32, fr, fq), ldfrag(VT, ML_LT, 128, 32, fr, fq), Nacc);
            st4bf(Cb + (128 + fr) * ML_LQ + wid * 16 + fq * 4, Nacc);
            m_state = s_misc[0];
        }
        lds_barrier();
    }
#undef ML_REQ
}

constexpr size_t L0_XC = L0_U;
static_assert(L0_XC + (size_t)RG * 1280 * 2 <= BIG_BYTES, "xconv buffer");
PHASE_FN void phase_xconv(const KP& kp) {
    const int lane = otid() & 63, wid = __builtin_amdgcn_readfirstlane(otid() >> 6);
    const bf16_t* P = WSP(const bf16_t, WS_BIG + L0_P); bf16_t* XC = WSP(bf16_t, WS_BIG + L0_XC);
    const float* cw = KIN(12); const float* cb = KIN(13);
    constexpr int RUN = 9;
    for (int run = obid() * 8 + wid; run < RG / RUN; run += gridDim.x * 8) {
        const int r0 = run * RUN;
#pragma unroll
        for (int i = 0; i < 5; ++i) { const int col = i * 256 + lane * 4;
            const f32x4 bias = *(const f32x4*)(cb + col);
            f32x4 w[5], x[5];
#pragma unroll
            for (int q = 0; q < 5; ++q) w[q] = *(const f32x4*)(cw + q * 1280 + col);
#pragma unroll
            for (int q = 0; q < 4; ++q) { const int rr = r0 - 2 + q; x[q + 1] = (rr >= 0 && rr < RG) ? ld4bf(P + (size_t)rr * AB_N + AB_XBC + col) : (f32x4){0.f, 0.f, 0.f, 0.f}; }
#pragma unroll
            for (int k = 0; k < RUN; ++k) {
                const int lr = r0 + k, bl = lr / TT, t = lr - bl * TT, lo = t < CTXL ? 0 : CTXL, hi = t < CTXL ? CTXL : TT;
#pragma unroll
                for (int q = 0; q < 4; ++q) x[q] = x[q + 1];
                { const int rr = lr + 2; x[4] = (rr < RG) ? ld4bf(P + (size_t)rr * AB_N + AB_XBC + col) : (f32x4){0.f, 0.f, 0.f, 0.f}; }
                f32x4 a = bias;
#pragma unroll
                for (int q = 0; q < 5; ++q) { const int tt = t - 2 + q; if (tt >= lo && tt < hi) a += w[q] * x[q]; }
                f32x4 o;
#pragma unroll
                for (int r = 0; r < 4; ++r) o[r] = siluf_(a[r]);
                st4bf(XC + (size_t)lr * 1280 + col, o);
            }
        }
    }
}

constexpr int SS_LT = 72, SS_LX = 136;
PHASE_FN void ssd_unit(const KP& kp, unsigned char* lds, int bl, int dir, int hp) {
    const int tid = otid();
    const int gi = hp >> 2, hh0 = hp * 2;
    bf16_t* Wm = (bf16_t*)lds;
    bf16_t* CM = Wm + 2 * 64 * SS_LT;
    bf16_t* BM = CM + 64 * SS_LT;
    bf16_t* Xn = BM + 64 * SS_LT;
    bf16_t* XT = Xn + 64 * SS_LX;
    bf16_t* BTE = XT + 2 * 64 * SS_LT;
    bf16_t* Sb = BTE + 2 * 64 * SS_LT;
    float* fs = (float*)(Sb + 2 * 64 * SS_LT);
    float* s_b = fs;
    float* s_dt = fs + 128;
    float* s_e = fs + 256;
    float* s_misc = fs + 384;
    const bf16_t* P = WSP(const bf16_t, WS_BIG + L0_P); const bf16_t* XC = WSP(const bf16_t, WS_BIG + L0_XC);
    bf16_t* YOUT = WSP(bf16_t, WS_BIG + (dir ? L0_YB : L0_AO + 2048)); const int ldy = dir ? 1024 : 2048;
    for (int i = tid; i < 2 * 64 * SS_LT; i += 512) Sb[i] = 0;
    f32x4 Sacc[4];
#pragma unroll
    for (int i = 0; i < 4; ++i) Sacc[i] = (f32x4){0.f, 0.f, 0.f, 0.f};
    const float dtb = KIN(14)[dir * 16 + hh0 + ((tid >> 6) & 1)], aexp = __expf(KIN(15)[dir * 16 + hh0 + ((tid >> 6) & 1)]);
    const float dskip = KIN(16)[hh0 + (tid >> 8)];
    u32x4 pr[4]; bf16_t pdt = 0;
#define SS_REQ(ci_) do { _Pragma("unroll") for (int q = 0; q < 4; ++q) { const int p = tid + q * 512, j = p >> 5, c8 = p & 31; \
            const int col = c8 < 16 ? hh0 * 64 + c8 * 8 : (c8 < 24 ? 1024 + gi * 64 + (c8 - 16) * 8 : 1152 + gi * 64 + (c8 - 24) * 8); \
            pr[q] = *(const u32x4*)(XC + ((size_t)bl * TT + scan_t<64>(dir, (ci_), j)) * 1280 + col); } \
        if (tid < 128) pdt = P[((size_t)bl * TT + scan_t<64>(dir, (ci_), tid & 63)) * AB_N + AB_DT + dir * 16 + hh0 + (tid >> 6)]; } while (0)
    SS_REQ(0);
    lds_barrier();
    for (int ci = 0; ci < TT / 64; ++ci) {
        int tq = tid; asm volatile("" : "+v"(tq));
        const int lane = tq & 63, wid = __builtin_amdgcn_readfirstlane(tq >> 6), fr = lane & 15, fq = lane >> 4, hl_w = wid >> 2;
#pragma unroll
        for (int q = 0; q < 4; ++q) { const int p = tq + q * 512, j = p >> 5, c8 = p & 31;
            bf16_t* dst = c8 < 16 ? Xn + j * SS_LX + c8 * 8 : (c8 < 24 ? BM + j * SS_LT + (c8 - 16) * 8 : CM + j * SS_LT + (c8 - 24) * 8);
            *(u32x4*)dst = pr[q]; }
        if (wid < 2) {
            const float dt = softplusf_(bf2f(pdt) + dtb);
            float b = -dt * aexp;
#pragma unroll
            for (int o = 1; o < 64; o <<= 1) { const float t = __shfl_up(b, o); if (lane >= o) b += t; }
            const float b63 = __shfl(b, 63);
            s_b[wid * 64 + lane] = b; s_dt[wid * 64 + lane] = dt; s_e[wid * 64 + lane] = __expf(b63 - b) * dt;
            if (lane == 0) s_misc[wid] = __expf(b63);
        }
        if (ci + 1 < TT / 64) SS_REQ(ci + 1);
        lds_barrier();
        {
            const int jt = wid >> 1;
#pragma unroll
            for (int q2 = 0; q2 < 2; ++q2) {
                const int st = (wid & 1) * 2 + q2;
                f32x4 acc = (f32x4){0.f, 0.f, 0.f, 0.f};
                if (st <= jt) {
                    const bf16x8 c0 = ldfrag(CM, SS_LT, jt * 16, 0, fr, fq), c1 = ldfrag(CM, SS_LT, jt * 16, 32, fr, fq), b0 = ldfrag(BM, SS_LT, st * 16, 0, fr, fq), b1 = ldfrag(BM, SS_LT, st * 16, 32, fr, fq);
                    __builtin_amdgcn_sched_barrier(0);
                    acc = mma16(c0, b0, acc); acc = mma16(c1, b1, acc);
                }
                const int s = st * 16 + fr;
#pragma unroll
                for (int hl = 0; hl < 2; ++hl) { const float bs = s_b[hl * 64 + s], ds = s_dt[hl * 64 + s];
#pragma unroll
                    for (int r = 0; r < 4; ++r) { const int j = jt * 16 + fq * 4 + r;
                        const float wv = (s <= j) ? acc[r] * __expf(s_b[hl * 64 + j] - bs) * ds : 0.f;
                        Wm[(hl * 64 + j) * SS_LT + s] = f2bf(wv); } }
            }
            {
                const int s = lane, n8 = wid;
                const u32x4 bv = *(const u32x4*)(BM + s * SS_LT + n8 * 8);
#pragma unroll
                for (int hl = 0; hl < 2; ++hl) { const float e = s_e[hl * 64 + s];
                    bf16_t* bt = BTE + (hl * 64 + n8 * 8) * SS_LT + s;
                    bt[0 * SS_LT] = f2bf(lo2f(bv.x) * e); bt[1 * SS_LT] = f2bf(hi2f(bv.x) * e); bt[2 * SS_LT] = f2bf(lo2f(bv.y) * e); bt[3 * SS_LT] = f2bf(hi2f(bv.y) * e);
                    bt[4 * SS_LT] = f2bf(lo2f(bv.z) * e); bt[5 * SS_LT] = f2bf(hi2f(bv.z) * e); bt[6 * SS_LT] = f2bf(lo2f(bv.w) * e); bt[7 * SS_LT] = f2bf(hi2f(bv.w) * e); }
#pragma unroll
                for (int i = 0; i < 2; ++i) { const int c8 = wid + i * 8;
                    const u32x4 xv = *(const u32x4*)(Xn + s * SS_LX + c8 * 8);
                    bf16_t* xt = XT + (c8 * 8) * SS_LT + s;
                    xt[0 * SS_LT] = (bf16_t)(xv.x & 0xffff); xt[1 * SS_LT] = (bf16_t)(xv.x >> 16); xt[2 * SS_LT] = (bf16_t)(xv.y & 0xffff); xt[3 * SS_LT] = (bf16_t)(xv.y >> 16);
                    xt[4 * SS_LT] = (bf16_t)(xv.z & 0xffff); xt[5 * SS_LT] = (bf16_t)(xv.z >> 16); xt[6 * SS_LT] = (bf16_t)(xv.w & 0xffff); xt[7 * SS_LT] = (bf16_t)(xv.w >> 16); }
            }
        }
        lds_barrier();
        {
            const int hl = hl_w, jt = wid & 3, j = jt * 16 + fr;
            const bf16_t* Wh = Wm + hl * 64 * SS_LT; const bf16_t* Xh = XT + hl * 64 * SS_LT; const bf16_t* Sh = Sb + hl * 64 * SS_LT;
            const float eb = __expf(s_b[hl * 64 + j]);
            const size_t row = (size_t)bl * TT + scan_t<64>(dir, ci, j);
            const bf16x8 w0 = ldfrag(Wh, SS_LT, jt * 16, 0, fr, fq), w1 = ldfrag(Wh, SS_LT, jt * 16, 32, fr, fq), m0 = ldfrag(CM, SS_LT, jt * 16, 0, fr, fq), m1 = ldfrag(CM, SS_LT, jt * 16, 32, fr, fq);
#pragma unroll
            for (int hh = 0; hh < 2; ++hh) {
                bf16x8 fx[2][2], fs2[2][2];
#pragma unroll
                for (int q = 0; q < 2; ++q)
#pragma unroll
                    for (int k = 0; k < 2; ++k) { fx[q][k] = ldfrag(Xh, SS_LT, (hh * 2 + q) * 16, k * 32, fr, fq); fs2[q][k] = ldfrag(Sh, SS_LT, (hh * 2 + q) * 16, k * 32, fr, fq); }
                f32x4 dx[2];
                if (!dir) { dx[0] = ld4bf(Xn + j * SS_LX + hl * 64 + (hh * 2) * 16 + fq * 4); dx[1] = ld4bf(Xn + j * SS_LX + hl * 64 + (hh * 2 + 1) * 16 + fq * 4); }
                __builtin_amdgcn_sched_barrier(0);
                f32x4 y1[2], y2[2];
#pragma unroll
                for (int q = 0; q < 2; ++q) { y1[q] = (f32x4){0.f, 0.f, 0.f, 0.f}; y2[q] = (f32x4){0.f, 0.f, 0.f, 0.f}; }
#pragma unroll
                for (int q = 0; q < 2; ++q) { y1[q] = mma16(fx[q][0], w0, y1[q]); y2[q] = mma16(fs2[q][0], m0, y2[q]); }
#pragma unroll
                for (int q = 0; q < 2; ++q) { y1[q] = mma16(fx[q][1], w1, y1[q]); y2[q] = mma16(fs2[q][1], m1, y2[q]); }
#pragma unroll
                for (int q = 0; q < 2; ++q) { f32x4 y = y1[q] + y2[q] * eb;
                    if (!dir) y = y + dx[q] * dskip;
                    st4bf(YOUT + row * ldy + (hh0 + hl) * 64 + (hh * 2 + q) * 16 + fq * 4, y); }
            }
        }
        lds_barrier();
        {
            const int hl = hl_w, pt = wid & 3; const float eb63 = s_misc[hl];
            const bf16_t* Xh = XT + hl * 64 * SS_LT; const bf16_t* Bh = BTE + hl * 64 * SS_LT; bf16_t* Sh = Sb + hl * 64 * SS_LT;
            const bf16x8 x0 = ldfrag(Xh, SS_LT, pt * 16, 0, fr, fq), x1 = ldfrag(Xh, SS_LT, pt * 16, 32, fr, fq);
            bf16x8 fb[4][2];
#pragma unroll
            for (int nt = 0; nt < 4; ++nt) { fb[nt][0] = ldfrag(Bh, SS_LT, nt * 16, 0, fr, fq); fb[nt][1] = ldfrag(Bh, SS_LT, nt * 16, 32, fr, fq); }
            __builtin_amdgcn_sched_barrier(0);
#pragma unroll
            for (int nt = 0; nt < 4; ++nt) Sacc[nt] = Sacc[nt] * eb63;
#pragma unroll
            for (int nt = 0; nt < 4; ++nt) Sacc[nt] = mma16(fb[nt][0], x0, Sacc[nt]);
#pragma unroll
            for (int nt = 0; nt < 4; ++nt) Sacc[nt] = mma16(fb[nt][1], x1, Sacc[nt]);
#pragma unroll
            for (int nt = 0; nt < 4; ++nt) st4bf(Sh + (pt * 16 + fr) * SS_LT + nt * 16 + fq * 4, Sacc[nt]);
        }
        lds_barrier();
    }
#undef SS_REQ
}

__device__ __forceinline__ void phase_scan_ab(const KP& kp, unsigned char* lds) {
    for (int rep = 0; rep < ((PROBE_DUP & 8192) ? 2 : 1); ++rep)
    for (int u = obid(); u < 256; u += gridDim.x) if (u < 128) { mlstm_unit(kp, lds, u >> 4, (u >> 2) & 3, (u >> 1) & 1, u & 1); __syncthreads(); }
    for (int rep = 0; rep < ((PROBE_DUP & 16384) ? 2 : 1); ++rep)
    for (int u = obid(); u < 256; u += gridDim.x) if (u >= 128) { const int v = u - 128; ssd_unit(kp, lds, v >> 4, (v >> 3) & 1, v & 7); __syncthreads(); }
}

PHASE_FN void phase_fin_ab(const KP& kp) {
    const int lane = otid() & 63, wid = __builtin_amdgcn_readfirstlane(otid() >> 6);
    const bf16_t* P = WSP(const bf16_t, WS_BIG + L0_P);
    bf16_t* AO = WSP(bf16_t, WS_BIG + L0_AO); const bf16_t* HB = WSP(const bf16_t, WS_BIG + L0_HB); const bf16_t* YB = WSP(const bf16_t, WS_BIG + L0_YB);
    const float* mln = KIN(11); const float* sn = KIN(17);
    for (int lr = obid() * 8 + wid; lr < RG; lr += gridDim.x * 8) {
        const bf16_t* pr = P + (size_t)lr * AB_N;
        f32x4 yz[4]; float ss2 = 0.f;
#pragma unroll
        for (int i = 0; i < 4; ++i) { const int col = i * 256 + lane * 4;
            const f32x4 hs = ld4bf(AO + (size_t)lr * 2048 + col) + ld4bf(HB + (size_t)lr * 1024 + col);
            float ss = hs[0] * hs[0] + hs[1] * hs[1] + hs[2] * hs[2] + hs[3] * hs[3];
            ss = wsum(ss); const float rstd = rsqrtf(ss * (1.0f / 256.0f) + EPS);
            const f32x4 og = ld4bf(pr + AB_OG + col), w = *(const f32x4*)(mln + col);
            f32x4 o;
#pragma unroll
            for (int r = 0; r < 4; ++r) o[r] = hs[r] * rstd * w[r] * sigmoidf_(og[r]);
            st4bf(AO + (size_t)lr * 2048 + col, o);
            const f32x4 ys = ld4bf(AO + (size_t)lr * 2048 + 1024 + col) + ld4bf(YB + (size_t)lr * 1024 + col), z = ld4bf(pr + AB_Z + col);
#pragma unroll
            for (int r = 0; r < 4; ++r) { yz[i][r] = ys[r] * siluf_(z[r]); ss2 += yz[i][r] * yz[i][r]; }
        }
        ss2 = wsum(ss2); const float rstd2 = rsqrtf(ss2 * (1.0f / 1024.0f) + EPS);
#pragma unroll
        for (int i = 0; i < 4; ++i) { const int col = i * 256 + lane * 4; st4bf(AO + (size_t)lr * 2048 + 1024 + col, yz[i] * rstd2 * *(const f32x4*)(sn + col)); }
    }
}

PHASE_FN void phase_gemm_in(const KP& kp, unsigned char* lds, int layer) {
    const int npad = layer == 0 ? AB_NPAD : CD_NPAD, n = layer == 0 ? AB_N : CD_N;
    pg8::Gemm g{WSP(const bf16_t, WS_BIG + (layer == 0 ? L0_U : L1_U)), WSP(const bf16_t, WS_WMIX), RG, npad, 1024, nullptr, 0x7fffffff};
    pg8::StaticOrder S; S.init(RG, npad, (int)gridDim.x, obid());
    pg8::EpiBfG E{WSP(bf16_t, WS_BIG), n, n, 0x7fffffff};
    pg8::gemm_phase<pg8::EpiBfG, pg8::StaticOrder, false>((PG8_LAS unsigned char*)lds, g, S, E, nullptr);
    __syncthreads();
}
PHASE_FN void phase_gemm_out_ab(const KP& kp, unsigned char* lds) {
    pg8::Gemm g{WSP(const bf16_t, WS_BIG + L0_AO), WSP(const bf16_t, WS_WMIX + WM_AB_OUT), RG, 1024, 2048, nullptr, 0x7fffffff};
    pg8::StaticOrder S; S.init(RG, 1024, (int)gridDim.x, obid());
    pg8::EpiBfG E{WSP(bf16_t, WS_BIG + L0_U), 1024, 1024, 0x7fffffff};
    pg8::gemm_phase<pg8::EpiBfG, pg8::StaticOrder, false>((PG8_LAS unsigned char*)lds, g, S, E, nullptr);
    __syncthreads();
}

PHASE_FN void phase_prep_cd(const KP& kp) {
    const int lane = otid() & 63, wid = __builtin_amdgcn_readfirstlane(otid() >> 6);
    bf16_t* P = WSP(bf16_t, WS_BIG + L1_P);
    bf16_t* SG = WSP(bf16_t, WS_SG);
    const float* qn = KIN(20); const float* kvn = KIN(22); const float* mu = KIN(24);
    for (int lr = obid() * 8 + wid; lr < RG; lr += gridDim.x * 8) {
        const int bl = lr / TT, t = lr - bl * TT;
        bf16_t* pr = P + (size_t)lr * CD_N;
        {
            const f32x4 x = ld4bf(pr + CD_M1 + lane * 4);
            float ss = x[0] * x[0] + x[1] * x[1] + x[2] * x[2] + x[3] * x[3]; ss = wsum(ss);
            const float rstd = rsqrtf(ss * (1.0f / 256.0f) + EPS);
            st4bf(pr + CD_M1 + lane * 4, x * rstd * *(const f32x4*)(kvn + lane * 4));
        }
        {
            const int lo = t < CTXL ? 0 : CTXL, hi = t < CTXL ? CTXL : TT, c = lane * 4;
            const f32x4 x = ld4bf(pr + CD_WL + c);
            const f32x4 xp = t > lo ? ld4bf(pr - CD_N + CD_WL + c) : (f32x4){0.f, 0.f, 0.f, 0.f};
            const f32x4 xn = t < hi - 1 ? ld4bf(pr + CD_N + CD_WL + c) : (f32x4){0.f, 0.f, 0.f, 0.f};
            f32x4 l = x + *(const f32x4*)(mu + CD_WL - CD_RW0 + c) * ((xp + xn) * 0.5f - x);
            if (c < 128) {
#pragma unroll
                for (int q = 0; q < 4; ++q) l[q] = tanhf_(l[q]); }
            st4bf(WSP(bf16_t, WS_BIG + L1_TWAL) + (size_t)lr * 256 + c, l);
        }
        if (t >= CTXL) {
            const int s = t - CTXL;
            float x0[3], x1[3]; float ss = 0.f;
#pragma unroll
            for (int i = 0; i < 3; ++i) { const unsigned w = *(const unsigned*)(pr + CD_M0 + i * 128 + lane * 2); x0[i] = lo2f(w); x1[i] = hi2f(w); ss += x0[i] * x0[i] + x1[i] * x1[i]; }
            ss = wsum(ss); const float rstd = rsqrtf(ss * (1.0f / 384.0f) + EPS);
#pragma unroll
            for (int i = 0; i < 3; ++i) { const int c = i * 128 + lane * 2; *(unsigned*)(pr + CD_M0 + c) = pack2(x0[i] * rstd * qn[c], x1[i] * rstd * qn[c + 1]); }
            if (lane < 16) {
                const float pos = (lane < 8) ? (float)(s >> 6) : (float)(s & 63);
                const float inv = __expf(-(float)(lane & 7) * (9.210340371976184f / 8.0f));
                float sn, cs; sincosf(pos * inv, &sn, &cs);
                const float a = bf2f(pr[CD_KR + lane]), b2 = bf2f(pr[CD_KR + 16 + lane]);
                pr[CD_KR + lane] = f2bf(a * cs - b2 * sn); pr[CD_KR + 16 + lane] = f2bf(a * sn + b2 * cs);
            }
            {
                const int c = lane * 2;
                const unsigned w = *(const unsigned*)(pr + CD_GL + c);
                const unsigned wp = s > 0 ? *(const unsigned*)(pr - CD_N + CD_GL + c) : 0u;
                const unsigned wn = s < SEQ - 1 ? *(const unsigned*)(pr + CD_N + CD_GL + c) : 0u;
                const float m0 = mu[CD_GL - CD_RW0 + c], m1 = mu[CD_GL - CD_RW0 + c + 1];
                const float g0 = lo2f(w) + m0 * (0.5f * (lo2f(wp) + lo2f(wn)) - lo2f(w));
                const float g1 = hi2f(w) + m1 * (0.5f * (hi2f(wp) + hi2f(wn)) - hi2f(w));
                *(unsigned*)(SG + ((size_t)bl * SEQ + s) * 128 + c) = pack2(sigmoidf_(g0), sigmoidf_(g1));
            }
        }
    }
}

PHASE_FN void phase_upproj(const KP& kp, unsigned char* lds) {
    const bf16_t* P = WSP(const bf16_t, WS_BIG + L1_P);
    const int nq = (RGL / 256) * 6, nkv = (RG / 256) * 8;
    for (int u = obid(); u < nq + nkv; u += gridDim.x) {
        if (u < nq) {
            GA ga{P + CD_M0, nullptr, CD_N, 0, 384, nullptr, RGL, 1, 0};
            EpiBf ep{WSP(bf16_t, WS_BIG + L1_Q), 768, RGL, 768};
            gemm_tile(lds, ga, WSP(const bf16_t, WS_WMIX + WM_UQ), 384, u / 6, u % 6, ep);
        } else { const int v = u - nq;
            GA ga{P + CD_M1, nullptr, CD_N, 0, 256, nullptr, RG, 0, 0};
            EpiBf ep{WSP(bf16_t, WS_BIG + L1_KV), 1024, RG, 1024};
            gemm_tile(lds, ga, WSP(const bf16_t, WS_WMIX + WM_UKV), 256, v >> 3, v & 7, ep);
        }
    }
}

constexpr int AT_LQ = 104, AT_LV = 72;
PHASE_FN void attn_unit(const KP& kp, unsigned char* lds, int bl, int head, int qb) {
    const int tid = otid(), lane = tid & 63, wid = __builtin_amdgcn_readfirstlane(tid >> 6), fr = lane & 15, fq = lane >> 4;
    bf16_t* Qs = (bf16_t*)lds;
    bf16_t* Kt = Qs + 256 * AT_LQ;
    bf16_t* Vt = Kt + 64 * AT_LQ;
    const bf16_t* P = WSP(const bf16_t, WS_BIG + L1_P);
    const bf16_t* Q = WSP(const bf16_t, WS_BIG + L1_Q);
    const bf16_t* KV = WSP(const bf16_t, WS_BIG + L1_KV);
    bf16_t* AOUT = WSP(bf16_t, WS_BIG + L1_AOUT);
    const float SC = 0.10206207261596577f;
#pragma unroll
    for (int i = 0; i < 6; ++i) { const int p = tid + i * 512, r = p / 12, c = p % 12;
        *(u32x4*)(Qs + r * AT_LQ + c * 8) = *(const u32x4*)(Q + ((size_t)bl * SEQ + qb * 256 + r) * 768 + head * 96 + c * 8); }
    lds_barrier();
#pragma unroll
    for (int i = 0; i < 8; ++i) { const int p = tid + i * 512, r = p >> 4, f = p & 15, s = qb * 256 + r;
        const float pos = (f < 8) ? (float)(s >> 6) : (float)(s & 63);
        const float inv = __expf(-(float)(f & 7) * (9.210340371976184f / 8.0f));
        float sn, cs; sincosf(pos * inv, &sn, &cs);
        const float a = bf2f(Qs[r * AT_LQ + 64 + f]), b2 = bf2f(Qs[r * AT_LQ + 80 + f]);
        Qs[r * AT_LQ + 64 + f] = f2bf(a * cs - b2 * sn); Qs[r * AT_LQ + 80 + f] = f2bf(a * sn + b2 * cs); }
    lds_barrier();
    bf16x8 qf[2][3];
#pragma unroll
    for (int rt = 0; rt < 2; ++rt)
#pragma unroll
        for (int k = 0; k < 3; ++k) qf[rt][k] = ldfrag(Qs, AT_LQ, wid * 32 + rt * 16, k * 32, fr, fq);
    f32x4 ot[2][4];
#pragma unroll
    for (int rt = 0; rt < 2; ++rt)
#pragma unroll
        for (int i = 0; i < 4; ++i) ot[rt][i] = (f32x4){0.f, 0.f, 0.f, 0.f};
    float mrow[2] = {-1e30f, -1e30f}, lsum[2] = {0.f, 0.f};
    u32x4 pk0, pk1, pvv;
    const int kkey0 = tid / 12, kc0 = tid % 12, kkey1 = (tid + 512) / 12, kc1 = (tid + 512) % 12, vkey = tid & 63, vc8 = tid >> 6;
#define AT_REQ(kt_) do { const size_t rb_ = (size_t)bl * TT + (kt_) * 64; \
        pk0 = kc0 < 8 ? *(const u32x4*)(KV + (rb_ + kkey0) * 1024 + head * 128 + kc0 * 8) : *(const u32x4*)(P + (rb_ + kkey0) * CD_N + CD_KR + (kc0 - 8) * 8); \
        if (tid < 256) pk1 = kc1 < 8 ? *(const u32x4*)(KV + (rb_ + kkey1) * 1024 + head * 128 + kc1 * 8) : *(const u32x4*)(P + (rb_ + kkey1) * CD_N + CD_KR + (kc1 - 8) * 8); \
        pvv = *(const u32x4*)(KV + (rb_ + vkey) * 1024 + head * 128 + 64 + vc8 * 8); } while (0)
    AT_REQ(0);
    const float SC2 = SC * 1.4426950408889634f;
    for (int kt = 0; kt < TT / 64; ++kt) {
        lds_barrier();
        *(u32x4*)(Kt + kkey0 * AT_LQ + kc0 * 8) = pk0;
        if (tid < 256) *(u32x4*)(Kt + kkey1 * AT_LQ + kc1 * 8) = pk1;
        { bf16_t* vt = Vt + (vc8 * 8) * AT_LV + vkey; const u32x4 v = pvv;
            vt[0 * AT_LV] = (bf16_t)(v.x & 0xffff); vt[1 * AT_LV] = (bf16_t)(v.x >> 16); vt[2 * AT_LV] = (bf16_t)(v.y & 0xffff); vt[3 * AT_LV] = (bf16_t)(v.y >> 16);
            vt[4 * AT_LV] = (bf16_t)(v.z & 0xffff); vt[5 * AT_LV] = (bf16_t)(v.z >> 16); vt[6 * AT_LV] = (bf16_t)(v.w & 0xffff); vt[7 * AT_LV] = (bf16_t)(v.w >> 16); }
        if (kt + 1 < TT / 64) AT_REQ(kt + 1);
        lds_barrier();
        bf16x8 kf[3][4];
#pragma unroll
        for (int k = 0; k < 3; ++k)
#pragma unroll
            for (int kk = 0; kk < 4; ++kk) kf[k][kk] = ldfrag(Kt, AT_LQ, kk * 16, k * 32, fr, fq);
        u32x2 vlo[2][4], vhi[2][4];
#pragma unroll
        for (int k2 = 0; k2 < 2; ++k2)
#pragma unroll
            for (int dvt = 0; dvt < 4; ++dvt) { const bf16_t* vp = Vt + (dvt * 16 + fr) * AT_LV + k2 * 32 + fq * 4; vlo[k2][dvt] = *(const u32x2*)vp; vhi[k2][dvt] = *(const u32x2*)(vp + 16); }
        __builtin_amdgcn_sched_barrier(0);
        f32x4 st[2][4];
#pragma unroll
        for (int rt = 0; rt < 2; ++rt)
#pragma unroll
            for (int kk = 0; kk < 4; ++kk) st[rt][kk] = (f32x4){0.f, 0.f, 0.f, 0.f};
#pragma unroll
        for (int k = 0; k < 3; ++k)
#pragma unroll
            for (int kk = 0; kk < 4; ++kk)
#pragma unroll
                for (int rt = 0; rt < 2; ++rt) st[rt][kk] = mma16(kf[k][kk], qf[rt][k], st[rt][kk]);
        union { bf16x8 v; unsigned u[4]; } pb[2][2];
#pragma unroll
        for (int rt = 0; rt < 2; ++rt) {
            float mx = -1e30f;
#pragma unroll
            for (int kk = 0; kk < 4; ++kk) mx = fmaxf(mx, fmaxf(fmaxf(st[rt][kk][0], st[rt][kk][1]), fmaxf(st[rt][kk][2], st[rt][kk][3])));
            mx = fmaxf(mx, __shfl_xor(mx, 16)); mx = fmaxf(mx, __shfl_xor(mx, 32));
            const float mnew = fmaxf(mrow[rt], mx), mb = mnew * SC2;
            if (__builtin_amdgcn_ballot_w64(mnew > mrow[rt]) != 0ull) {
                const float alpha = __builtin_amdgcn_exp2f((mrow[rt] - mnew) * SC2);
                lsum[rt] *= alpha;
#pragma unroll
                for (int i = 0; i < 4; ++i) ot[rt][i] = ot[rt][i] * alpha;
            }
            mrow[rt] = mnew;
#pragma unroll
            for (int kk = 0; kk < 4; ++kk)
#pragma unroll
                for (int r = 0; r < 4; ++r) { const float pv = __builtin_amdgcn_exp2f(st[rt][kk][r] * SC2 - mb); st[rt][kk][r] = pv; lsum[rt] += pv; }
#pragma unroll
            for (int k2 = 0; k2 < 2; ++k2) {
                pb[rt][k2].u[0] = pack2(st[rt][2 * k2][0], st[rt][2 * k2][1]); pb[rt][k2].u[1] = pack2(st[rt][2 * k2][2], st[rt][2 * k2][3]);
                pb[rt][k2].u[2] = pack2(st[rt][2 * k2 + 1][0], st[rt][2 * k2 + 1][1]); pb[rt][k2].u[3] = pack2(st[rt][2 * k2 + 1][2], st[rt][2 * k2 + 1][3]); }
        }
#pragma unroll
        for (int k2 = 0; k2 < 2; ++k2)
#pragma unroll
            for (int dvt = 0; dvt < 4; ++dvt) { union { bf16x8 v; u32x2 h[2]; } va; va.h[0] = vlo[k2][dvt]; va.h[1] = vhi[k2][dvt];
#pragma unroll
                for (int rt = 0; rt < 2; ++rt) ot[rt][dvt] = mma16(va.v, pb[rt][k2].v, ot[rt][dvt]); }
    }
#undef AT_REQ
#pragma unroll
    for (int rt = 0; rt < 2; ++rt) {
        float ls = lsum[rt]; ls += __shfl_xor(ls, 16); ls += __shfl_xor(ls, 32);
        const float rl = frcp_(ls);
        const size_t orow = (size_t)bl * SEQ + qb * 256 + wid * 32 + rt * 16 + fr;
#pragma unroll
        for (int dvt = 0; dvt < 4; ++dvt) st4bf(AOUT + orow * 1536 + head * 64 + dvt * 16 + fq * 4, ot[rt][dvt] * rl);
    }
}

constexpr int RW_LR = 200, RW_LP = 72;
PHASE_FN void rwkv_unit(const KP& kp, unsigned char* lds, int bl, int h, int dir) {
    const int tid = otid();
    bf16_t* RAW = (bf16_t*)lds;
    bf16_t* TWb = RAW + 34 * RW_LR;
    bf16_t* ALb = TWb + 32 * RW_LP;
    bf16_t* W2T = ALb + 32 * RW_LP;
    bf16_t* A2T = W2T + 64 * RW_LP;
    float* CL = (float*)(A2T + 64 * RW_LP);
    bf16_t* AR = (bf16_t*)(CL + 32 * 64);
    bf16_t* BK = AR + 64 * RW_LP;
    float* AABT = (float*)(BK + 64 * RW_LP);
    bf16_t* ARB = (bf16_t*)(AABT + 32 * 36);
    bf16_t* AAK = ARB + 32 * 40;
    bf16_t* ARK = AAK + 32 * 40;
    float* RHS = (float*)(ARK + 32 * 40);
    float* YB = RHS + 32 * 64;
    bf16_t* ZVT = (bf16_t*)(YB + 32 * 64);
    bf16_t* BKh = ZVT + 64 * RW_LP;
    bf16_t* Sb = BKh + 64 * RW_LP;
    float* PL = (float*)(Sb + 64 * RW_LP);
    const bf16_t* P = WSP(const bf16_t, WS_BIG + L1_P); const bf16_t* TWAL = WSP(const bf16_t, WS_BIG + L1_TWAL);
    bf16_t* OUT = WSP(bf16_t, WS_BIG + (dir ? L1_OB : L1_OF));
    float* BSC = WSP(float, WS_BSC) + (size_t)dir * RGL * 16;
    const float* mu = KIN(24);
    for (int i = tid; i < 64 * 64; i += 512) { const int c = i >> 6, n = i & 63;
        W2T[n * RW_LP + c] = f2bf(KIN(26)[((size_t)dir * 64 + c) * 1024 + h * 64 + n]); A2T[n * RW_LP + c] = f2bf(KIN(28)[((size_t)dir * 64 + c) * 1024 + h * 64 + n]); }
    for (int i = tid; i < 64 * RW_LP; i += 512) Sb[i] = 0;
    float* CV = PL + 64;
    bf16_t* A21b = (bf16_t*)(CV + 8 * 64);
    for (int i = tid; i < 16 * 40; i += 512) A21b[i] = 0;
    for (int i = tid; i < 64 * RW_LP; i += 512) ZVT[i] = 0;
    if (tid < 64) { const int n = tid;
        CV[0 * 64 + n] = KIN(25)[dir * 1024 + h * 64 + n]; CV[1 * 64 + n] = KIN(27)[dir * 1024 + h * 64 + n];
        CV[2 * 64 + n] = KIN(30)[h * 64 + n]; CV[3 * 64 + n] = KIN(31)[h * 64 + n]; CV[4 * 64 + n] = KIN(32)[h * 64 + n];
        CV[5 * 64 + n] = mu[h * 64 + n]; CV[6 * 64 + n] = mu[1024 + h * 64 + n]; CV[7 * 64 + n] = mu[2048 + h * 64 + n]; }
    f32x4 Sacc[2];
    Sacc[0] = (f32x4){0.f, 0.f, 0.f, 0.f}; Sacc[1] = (f32x4){0.f, 0.f, 0.f, 0.f};
    u32x4 pf[3];
#define RW_PREFETCH(cn, tix) do { const int t0n_ = dir ? scan_t<32>(1, (cn), 31) : (cn) * 32; const int lo_ = t0n_ < CTXL ? 0 : CTXL, hi_ = t0n_ < CTXL ? CTXL : TT; \
        _Pragma("unroll") for (int q = 0; q < 2; ++q) { const int p = (tix) + q * 512; pf[q] = (u32x4){0u, 0u, 0u, 0u}; \
            if (p < 34 * 24) { const int rr = p / 24, c = p % 24, t = t0n_ - 1 + rr; \
                if (t >= lo_ && t < hi_) { const int seg = c >> 3, c8 = c & 7; \
                    const int col = (seg == 0 ? CD_R : seg == 1 ? CD_K : CD_V) + h * 64; \
                    pf[q] = *(const u32x4*)(P + ((size_t)bl * TT + t) * CD_N + col + c8 * 8); } } } \
        { const int i_ = (tix) >> 4, c16 = (tix) & 15; \
          pf[2] = *(const u32x4*)(TWAL + ((size_t)bl * TT + t0n_ + i_) * 256 + (c16 >> 3) * 128 + dir * 64 + (c16 & 7) * 8); } } while (0)
    RW_PREFETCH(0, tid);
    lds_barrier();
    for (int ci = 0; ci < TT / 32; ++ci) {
        int tq = tid; asm volatile("" : "+v"(tq));
        const int lane = tq & 63, wid = __builtin_amdgcn_readfirstlane(tq >> 6), fr = lane & 15, fq = lane >> 4, pi = tq >> 4, n4 = (tq & 15) * 4;
        const int t0 = dir ? scan_t<32>(1, ci, 31) : ci * 32;
#pragma unroll
        for (int q = 0; q < 2; ++q) { const int p = tq + q * 512; if (p < 34 * 24) *(u32x4*)(RAW + (p / 24) * RW_LR + (p % 24) * 8) = pf[q]; }
        { const int i_ = tq >> 4, c16 = tq & 15; *(u32x4*)(((c16 >> 3) ? ALb : TWb) + i_ * RW_LP + (c16 & 7) * 8) = pf[2]; }
        if (ci + 1 < TT / 32) RW_PREFETCH(ci + 1, tq);
        lds_barrier();
        {
            const int which = wid >> 2, tt = (wid >> 1) & 1;
            const bf16_t* Xa = which ? ALb : TWb; const bf16_t* Wt = which ? A2T : W2T; float* Od = which ? YB : RHS;
#pragma unroll
            for (int q2 = 0; q2 < 2; ++q2) { const int nt = (wid & 1) * 2 + q2;
                f32x4 acc = (f32x4){0.f, 0.f, 0.f, 0.f};
#pragma unroll
                for (int k = 0; k < 2; ++k) acc = mma16(ldfrag(Xa, RW_LP, tt * 16, k * 32, fr, fq), ldfrag(Wt, RW_LP, nt * 16, k * 32, fr, fq), acc);
#pragma unroll
                for (int rr = 0; rr < 4; ++rr) Od[(tt * 16 + fq * 4 + rr) * 64 + nt * 16 + fr] = acc[rr]; }
        }
        lds_barrier();
        const int j = dir ? 31 - pi : pi;
        f32x4 r, kd, v, av, bv;
        {
            const f32x4 w0v = *(const f32x4*)(CV + n4), a0v = *(const f32x4*)(CV + 64 + n4), kkw = *(const f32x4*)(CV + 128 + n4), kaw = *(const f32x4*)(CV + 192 + n4), rkw = *(const f32x4*)(CV + 256 + n4);
            const f32x4 mur = *(const f32x4*)(CV + 320 + n4), muk = *(const f32x4*)(CV + 384 + n4), muv = *(const f32x4*)(CV + 448 + n4);
            const f32x4 wl = w0v + *(const f32x4*)(RHS + pi * 64 + n4), al = a0v + *(const f32x4*)(YB + pi * 64 + n4);
            const bf16_t* r1 = RAW + (pi + 1) * RW_LR; const bf16_t* rp = RAW + pi * RW_LR; const bf16_t* rn = RAW + (pi + 2) * RW_LR;
            f32x4 k;
            r = ld4bf(r1 + n4); k = ld4bf(r1 + 64 + n4); v = ld4bf(r1 + 128 + n4);
            r = r + mur * ((ld4bf(rp + n4) + ld4bf(rn + n4)) * 0.5f - r);
            k = k + muk * ((ld4bf(rp + 64 + n4) + ld4bf(rn + 64 + n4)) * 0.5f - k);
            v = v + muv * ((ld4bf(rp + 128 + n4) + ld4bf(rn + 128 + n4)) * 0.5f - v);
            f32x4 a, lw, kk = k * kkw;
            float ssq = kk[0] * kk[0] + kk[1] * kk[1] + kk[2] * kk[2] + kk[3] * kk[3];
            ssq += __shfl_xor(ssq, 1); ssq += __shfl_xor(ssq, 2); ssq += __shfl_xor(ssq, 4); ssq += __shfl_xor(ssq, 8);
            kk = kk * __builtin_amdgcn_rsqf(fmaxf(ssq, 1e-24f));
#pragma unroll
            for (int q = 0; q < 4; ++q) { const float wlog = -softplusf_(-wl[q]) - 0.5f; lw[q] = -__expf(wlog); a[q] = sigmoidf_(al[q]); }
            kd = k * ((a - 1.0f) * kaw + 1.0f);
            float bs = r[0] * kd[0] * rkw[0] + r[1] * kd[1] * rkw[1] + r[2] * kd[2] * rkw[2] + r[3] * kd[3] * rkw[3];
            bs += __shfl_xor(bs, 1); bs += __shfl_xor(bs, 2); bs += __shfl_xor(bs, 4); bs += __shfl_xor(bs, 8);
            av = kk * -1.0f; bv = kk * a;
            *(f32x4*)(CL + j * 64 + n4) = lw;
            const int t = t0 + pi;
            if (t >= CTXL && (tq & 15) == 0) BSC[((size_t)bl * SEQ + (t - CTXL)) * 16 + h] = bs;
        }
        lds_barrier();
        if (wid == 0) {
            float c[32];
#pragma unroll
            for (int q = 0; q < 32; ++q) c[q] = CL[q * 64 + lane];
#pragma unroll
            for (int q = 1; q < 32; ++q) c[q] += c[q - 1];
#pragma unroll
            for (int q = 0; q < 32; ++q) CL[q * 64 + lane] = c[q];
            PL[lane] = __expf(c[31]);
        }
        lds_barrier();
        {
            const f32x4 clj = *(const f32x4*)(CL + j * 64 + n4), cle = *(const f32x4*)(CL + 31 * 64 + n4);
            f32x4 clp = (f32x4){0.f, 0.f, 0.f, 0.f};
            if (j > 0) clp = *(const f32x4*)(CL + (j - 1) * 64 + n4);
            f32x4 at, rt, bt, kt, bh, kh;
#pragma unroll
            for (int q = 0; q < 4; ++q) { const float ep = __expf(clp[q]), ej = __expf(clj[q]), ei = __expf(-clj[q]), ee = __expf(cle[q] - clj[q]);
                at[q] = av[q] * ep; rt[q] = r[q] * ej; bt[q] = bv[q] * ei; kt[q] = kd[q] * ei; bh[q] = bv[q] * ee; kh[q] = kd[q] * ee; }
            st4bf(AR + j * RW_LP + n4, at); st4bf(AR + (32 + j) * RW_LP + n4, rt);
            st4bf(BK + j * RW_LP + n4, bt); st4bf(BK + (32 + j) * RW_LP + n4, kt);
#pragma unroll
            for (int q = 0; q < 4; ++q) { BKh[(n4 + q) * RW_LP + j] = f2bf(bh[q]); BKh[(n4 + q) * RW_LP + 32 + j] = f2bf(kh[q]); ZVT[(n4 + q) * RW_LP + 32 + j] = f2bf(v[q]); }
        }
        lds_barrier();
        {
            const int ti = wid >> 1;
#pragma unroll
            for (int q2 = 0; q2 < 2; ++q2) {
                const int si = (wid & 1) * 2 + q2;
                f32x4 acc = (f32x4){0.f, 0.f, 0.f, 0.f};
#pragma unroll
                for (int k = 0; k < 2; ++k) acc = mma16(ldfrag(AR, RW_LP, ti * 16, k * 32, fr, fq), ldfrag(BK, RW_LP, si * 16, k * 32, fr, fq), acc);
                const int sp = si * 16 + fr, s = sp & 31;
#pragma unroll
                for (int rr = 0; rr < 4; ++rr) { const int tp = ti * 16 + fq * 4 + rr, t = tp & 31;
                    const bool incl = tp >= 32;
                    const float val = (incl ? (s <= t) : (s < t)) ? acc[rr] : 0.f;
                    if (sp < 32) { if (incl) ARB[t * 40 + s] = f2bf(val); else { AABT[s * 36 + t] = val; if (t >= 16 && s < 16) A21b[(t - 16) * 40 + s] = f2bf(val); } }
                    else { (incl ? ARK : AAK)[t * 40 + s] = f2bf(val); } }
            }
        }
        lds_barrier();
        {
            const int which = wid >> 2, tt = (wid >> 1) & 1;
            const bf16_t* Ak = which ? ARK : AAK; float* Od = which ? YB : RHS;
#pragma unroll
            for (int q2 = 0; q2 < 2; ++q2) {
                const int vt = (wid & 1) * 2 + q2;
                f32x4 acc = (f32x4){0.f, 0.f, 0.f, 0.f};
#pragma unroll
                for (int k = 0; k < 2; ++k) acc = mma16(ldfrag(AR, RW_LP, which * 32 + tt * 16, k * 32, fr, fq), ldfrag(Sb, RW_LP, vt * 16, k * 32, fr, fq), acc);
                acc = mma16(ldfrag(Ak, 40, tt * 16, 0, fr, fq), ldfrag(ZVT, RW_LP, vt * 16, 32, fr, fq), acc);
#pragma unroll
                for (int rr = 0; rr < 4; ++rr) Od[(tt * 16 + fq * 4 + rr) * 64 + vt * 16 + fr] = acc[rr];
            }
        }
        lds_barrier();
        {
            if (wid == 0) {
                float z[16]; f32x4 ca0, ca1, ca2, ca3, cb0, cb1, cb2, cb3;
#pragma unroll
                for (int t = 0; t < 16; ++t) z[t] = RHS[(0 + t) * 64 + lane];
                ca0 = *(const f32x4*)(AABT + 0 * 36 + 0); ca1 = *(const f32x4*)(AABT + 0 * 36 + 4); ca2 = *(const f32x4*)(AABT + 0 * 36 + 8); ca3 = *(const f32x4*)(AABT + 0 * 36 + 12);
                cb0 = *(const f32x4*)(AABT + 1 * 36 + 0); cb1 = *(const f32x4*)(AABT + 1 * 36 + 4); cb2 = *(const f32x4*)(AABT + 1 * 36 + 8); cb3 = *(const f32x4*)(AABT + 1 * 36 + 12);
                { const float zs = z[0]; z[1] = __builtin_fmaf(ca0[1], zs, z[1]); z[2] = __builtin_fmaf(ca0[2], zs, z[2]); z[3] = __builtin_fmaf(ca0[3], zs, z[3]); z[4] = __builtin_fmaf(ca1[0], zs, z[4]); z[5] = __builtin_fmaf(ca1[1], zs, z[5]); z[6] = __builtin_fmaf(ca1[2], zs, z[6]); z[7] = __builtin_fmaf(ca1[3], zs, z[7]); z[8] = __builtin_fmaf(ca2[0], zs, z[8]); z[9] = __builtin_fmaf(ca2[1], zs, z[9]); z[10] = __builtin_fmaf(ca2[2], zs, z[10]); z[11] = __builtin_fmaf(ca2[3], zs, z[11]); z[12] = __builtin_fmaf(ca3[0], zs, z[12]); z[13] = __builtin_fmaf(ca3[1], zs, z[13]); z[14] = __builtin_fmaf(ca3[2], zs, z[14]); z[15] = __builtin_fmaf(ca3[3], zs, z[15]); }
                asm volatile("" : "+v"(z[1]) :: "memory");
                ca0 = *(const f32x4*)(AABT + 2 * 36 + 0); ca1 = *(const f32x4*)(AABT + 2 * 36 + 4); ca2 = *(const f32x4*)(AABT + 2 * 36 + 8); ca3 = *(const f32x4*)(AABT + 2 * 36 + 12);
                { const float zs = z[1]; z[2] = __builtin_fmaf(cb0[2], zs, z[2]); z[3] = __builtin_fmaf(cb0[3], zs, z[3]); z[4] = __builtin_fmaf(cb1[0], zs, z[4]); z[5] = __builtin_fmaf(cb1[1], zs, z[5]); z[6] = __builtin_fmaf(cb1[2], zs, z[6]); z[7] = __builtin_fmaf(cb1[3], zs, z[7]); z[8] = __builtin_fmaf(cb2[0], zs, z[8]); z[9] = __builtin_fmaf(cb2[1], zs, z[9]); z[10] = __builtin_fmaf(cb2[2], zs, z[10]); z[11] = __builtin_fmaf(cb2[3], zs, z[11]); z[12] = __builtin_fmaf(cb3[0], zs, z[12]); z[13] = __builtin_fmaf(cb3[1], zs, z[13]); z[14] = __builtin_fmaf(cb3[2], zs, z[14]); z[15] = __builtin_fmaf(cb3[3], zs, z[15]); }
                asm volatile("" : "+v"(z[2]) :: "memory");
                cb1 = *(const f32x4*)(AABT + 3 * 36 + 4); cb2 = *(const f32x4*)(AABT + 3 * 36 + 8); cb3 = *(const f32x4*)(AABT + 3 * 36 + 12);
                { const float zs = z[2]; z[3] = __builtin_fmaf(ca0[3], zs, z[3]); z[4] = __builtin_fmaf(ca1[0], zs, z[4]); z[5] = __builtin_fmaf(ca1[1], zs, z[5]); z[6] = __builtin_fmaf(ca1[2], zs, z[6]); z[7] = __builtin_fmaf(ca1[3], zs, z[7]); z[8] = __builtin_fmaf(ca2[0], zs, z[8]); z[9] = __builtin_fmaf(ca2[1], zs, z[9]); z[10] = __builtin_fmaf(ca2[2], zs, z[10]); z[11] = __builtin_fmaf(ca2[3], zs, z[11]); z[12] = __builtin_fmaf(ca3[0], zs, z[12]); z[13] = __builtin_fmaf(ca3[1], zs, z[13]); z[14] = __builtin_fmaf(ca3[2], zs, z[14]); z[15] = __builtin_fmaf(ca3[3], zs, z[15]); }
                asm volatile("" : "+v"(z[3]) :: "memory");
                ca1 = *(const f32x4*)(AABT + 4 * 36 + 4); ca2 = *(const f32x4*)(AABT + 4 * 36 + 8); ca3 = *(const f32x4*)(AABT + 4 * 36 + 12);
                { const float zs = z[3]; z[4] = __builtin_fmaf(cb1[0], zs, z[4]); z[5] = __builtin_fmaf(cb1[1], zs, z[5]); z[6] = __builtin_fmaf(cb1[2], zs, z[6]); z[7] = __builtin_fmaf(cb1[3], zs, z[7]); z[8] = __builtin_fmaf(cb2[0], zs, z[8]); z[9] = __builtin_fmaf(cb2[1], zs, z[9]); z[10] = __builtin_fmaf(cb2[2], zs, z[10]); z[11] = __builtin_fmaf(cb2[3], zs, z[11]); z[12] = __builtin_fmaf(cb3[0], zs, z[12]); z[13] = __builtin_fmaf(cb3[1], zs, z[13]); z[14] = __builtin_fmaf(cb3[2], zs, z[14]); z[15] = __builtin_fmaf(cb3[3], zs, z[15]); }
                asm volatile("" : "+v"(z[4]) :: "memory");
                cb1 = *(const f32x4*)(AABT + 5 * 36 + 4); cb2 = *(const f32x4*)(AABT + 5 * 36 + 8); cb3 = *(const f32x4*)(AABT + 5 * 36 + 12);
                { const float zs = z[4]; z[5] = __builtin_fmaf(ca1[1], zs, z[5]); z[6] = __builtin_fmaf(ca1[2], zs, z[6]); z[7] = __builtin_fmaf(ca1[3], zs, z[7]); z[8] = __builtin_fmaf(ca2[0], zs, z[8]); z[9] = __builtin_fmaf(ca2[1], zs, z[9]); z[10] = __builtin_fmaf(ca2[2], zs, z[10]); z[11] = __builtin_fmaf(ca2[3], zs, z[11]); z[12] = __builtin_fmaf(ca3[0], zs, z[12]); z[13] = __builtin_fmaf(ca3[1], zs, z[13]); z[14] = __builtin_fmaf(ca3[2], zs, z[14]); z[15] = __builtin_fmaf(ca3[3], zs, z[15]); }
                asm volatile("" : "+v"(z[5]) :: "memory");
                ca1 = *(const f32x4*)(AABT + 6 * 36 + 4); ca2 = *(const f32x4*)(AABT + 6 * 36 + 8); ca3 = *(const f32x4*)(AABT + 6 * 36 + 12);
                { const float zs = z[5]; z[6] = __builtin_fmaf(cb1[2], zs, z[6]); z[7] = __builtin_fmaf(cb1[3], zs, z[7]); z[8] = __builtin_fmaf(cb2[0], zs, z[8]); z[9] = __builtin_fmaf(cb2[1], zs, z[9]); z[10] = __builtin_fmaf(cb2[2], zs, z[10]); z[11] = __builtin_fmaf(cb2[3], zs, z[11]); z[12] = __builtin_fmaf(cb3[0], zs, z[12]); z[13] = __builtin_fmaf(cb3[1], zs, z[13]); z[14] = __builtin_fmaf(cb3[2], zs, z[14]); z[15] = __builtin_fmaf(cb3[3], zs, z[15]); }
                asm volatile("" : "+v"(z[6]) :: "memory");
                cb2 = *(const f32x4*)(AABT + 7 * 36 + 8); cb3 = *(const f32x4*)(AABT + 7 * 36 + 12);
                { const float zs = z[6]; z[7] = __builtin_fmaf(ca1[3], zs, z[7]); z[8] = __builtin_fmaf(ca2[0], zs, z[8]); z[9] = __builtin_fmaf(ca2[1], zs, z[9]); z[10] = __builtin_fmaf(ca2[2], zs, z[10]); z[11] = __builtin_fmaf(ca2[3], zs, z[11]); z[12] = __builtin_fmaf(ca3[0], zs, z[12]); z[13] = __builtin_fmaf(ca3[1], zs, z[13]); z[14] = __builtin_fmaf(ca3[2], zs, z[14]); z[15] = __builtin_fmaf(ca3[3], zs, z[15]); }
                asm volatile("" : "+v"(z[7]) :: "memory");
                ca2 = *(const f32x4*)(AABT + 8 * 36 + 8); ca3 = *(const f32x4*)(AABT + 8 * 36 + 12);
                { const float zs = z[7]; z[8] = __builtin_fmaf(cb2[0], zs, z[8]); z[9] = __builtin_fmaf(cb2[1], zs, z[9]); z[10] = __builtin_fmaf(cb2[2], zs, z[10]); z[11] = __builtin_fmaf(cb2[3], zs, z[11]); z[12] = __builtin_fmaf(cb3[0], zs, z[12]); z[13] = __builtin_fmaf(cb3[1], zs, z[13]); z[14] = __builtin_fmaf(cb3[2], zs, z[14]); z[15] = __builtin_fmaf(cb3[3], zs, z[15]); }
                asm volatile("" : "+v"(z[8]) :: "memory");
                cb2 = *(const f32x4*)(AABT + 9 * 36 + 8); cb3 = *(const f32x4*)(AABT + 9 * 36 + 12);
                { const float zs = z[8]; z[9] = __builtin_fmaf(ca2[1], zs, z[9]); z[10] = __builtin_fmaf(ca2[2], zs, z[10]); z[11] = __builtin_fmaf(ca2[3], zs, z[11]); z[12] = __builtin_fmaf(ca3[0], zs, z[12]); z[13] = __builtin_fmaf(ca3[1], zs, z[13]); z[14] = __builtin_fmaf(ca3[2], zs, z[14]); z[15] = __builtin_fmaf(ca3[3], zs, z[15]); }
                asm volatile("" : "+v"(z[9]) :: "memory");
                ca2 = *(const f32x4*)(AABT + 10 * 36 + 8); ca3 = *(const f32x4*)(AABT + 10 * 36 + 12);
                { const float zs = z[9]; z[10] = __builtin_fmaf(cb2[2], zs, z[10]); z[11] = __builtin_fmaf(cb2[3], zs, z[11]); z[12] = __builtin_fmaf(cb3[0], zs, z[12]); z[13] = __builtin_fmaf(cb3[1], zs, z[13]); z[14] = __builtin_fmaf(cb3[2], zs, z[14]); z[15] = __builtin_fmaf(cb3[3], zs, z[15]); }
                asm volatile("" : "+v"(z[10]) :: "memory");
                cb3 = *(const f32x4*)(AABT + 11 * 36 + 12);
                { const float zs = z[10]; z[11] = __builtin_fmaf(ca2[3], zs, z[11]); z[12] = __builtin_fmaf(ca3[0], zs, z[12]); z[13] = __builtin_fmaf(ca3[1], zs, z[13]); z[14] = __builtin_fmaf(ca3[2], zs, z[14]); z[15] = __builtin_fmaf(ca3[3], zs, z[15]); }
                asm volatile("" : "+v"(z[11]) :: "memory");
                ca3 = *(const f32x4*)(AABT + 12 * 36 + 12);
                { const float zs = z[11]; z[12] = __builtin_fmaf(cb3[0], zs, z[12]); z[13] = __builtin_fmaf(cb3[1], zs, z[13]); z[14] = __builtin_fmaf(cb3[2], zs, z[14]); z[15] = __builtin_fmaf(cb3[3], zs, z[15]); }
                asm volatile("" : "+v"(z[12]) :: "memory");
                cb3 = *(const f32x4*)(AABT + 13 * 36 + 12);
                { const float zs = z[12]; z[13] = __builtin_fmaf(ca3[1], zs, z[13]); z[14] = __builtin_fmaf(ca3[2], zs, z[14]); z[15] = __builtin_fmaf(ca3[3], zs, z[15]); }
                asm volatile("" : "+v"(z[13]) :: "memory");
                ca3 = *(const f32x4*)(AABT + 14 * 36 + 12);
                { const float zs = z[13]; z[14] = __builtin_fmaf(cb3[2], zs, z[14]); z[15] = __builtin_fmaf(cb3[3], zs, z[15]); }
                asm volatile("" : "+v"(z[14]) :: "memory");
                { const float zs = z[14]; z[15] = __builtin_fmaf(ca3[3], zs, z[15]); }
                asm volatile("" : "+v"(z[15]) :: "memory");
#pragma unroll
                for (int q = 0; q < 2; ++q) { u32x4 w; w.x = pack2(z[q * 8 + 0], z[q * 8 + 1]); w.y = pack2(z[q * 8 + 2], z[q * 8 + 3]); w.z = pack2(z[q * 8 + 4], z[q * 8 + 5]); w.w = pack2(z[q * 8 + 6], z[q * 8 + 7]);
                    *(u32x4*)(ZVT + lane * RW_LP + 0 + q * 8) = w; }
            }
            lds_barrier();
            if (wid < 4) {
                f32x4 acc = (f32x4){0.f, 0.f, 0.f, 0.f};
                acc = mma16(ldfrag(A21b, 40, 0, 0, fr, fq), ldfrag(ZVT, RW_LP, wid * 16, 0, fr, fq), acc);
#pragma unroll
                for (int rr = 0; rr < 4; ++rr) RHS[(16 + fq * 4 + rr) * 64 + wid * 16 + fr] += acc[rr];
            }
            lds_barrier();
            if (wid == 0) {
                float z[16]; f32x4 ca0, ca1, ca2, ca3, cb0, cb1, cb2, cb3;
#pragma unroll
                for (int t = 0; t < 16; ++t) z[t] = RHS[(16 + t) * 64 + lane];
                ca0 = *(const f32x4*)(AABT + 16 * 36 + 16); ca1 = *(const f32x4*)(AABT + 16 * 36 + 20); ca2 = *(const f32x4*)(AABT + 16 * 36 + 24); ca3 = *(const f32x4*)(AABT + 16 * 36 + 28);
                cb0 = *(const f32x4*)(AABT + 17 * 36 + 16); cb1 = *(const f32x4*)(AABT + 17 * 36 + 20); cb2 = *(const f32x4*)(AABT + 17 * 36 + 24); cb3 = *(const f32x4*)(AABT + 17 * 36 + 28);
                { const float zs = z[0]; z[1] = __builtin_fmaf(ca0[1], zs, z[1]); z[2] = __builtin_fmaf(ca0[2], zs, z[2]); z[3] = __builtin_fmaf(ca0[3], zs, z[3]); z[4] = __builtin_fmaf(ca1[0], zs, z[4]); z[5] = __builtin_fmaf(ca1[1], zs, z[5]); z[6] = __builtin_fmaf(ca1[2], zs, z[6]); z[7] = __builtin_fmaf(ca1[3], zs, z[7]); z[8] = __builtin_fmaf(ca2[0], zs, z[8]); z[9] = __builtin_fmaf(ca2[1], zs, z[9]); z[10] = __builtin_fmaf(ca2[2], zs, z[10]); z[11] = __builtin_fmaf(ca2[3], zs, z[11]); z[12] = __builtin_fmaf(ca3[0], zs, z[12]); z[13] = __builtin_fmaf(ca3[1], zs, z[13]); z[14] = __builtin_fmaf(ca3[2], zs, z[14]); z[15] = __builtin_fmaf(ca3[3], zs, z[15]); }
                asm volatile("" : "+v"(z[1]) :: "memory");
                ca0 = *(const f32x4*)(AABT + 18 * 36 + 16); ca1 = *(const f32x4*)(AABT + 18 * 36 + 20); ca2 = *(const f32x4*)(AABT + 18 * 36 + 24); ca3 = *(const f32x4*)(AABT + 18 * 36 + 28);
                { const float zs = z[1]; z[2] = __builtin_fmaf(cb0[2], zs, z[2]); z[3] = __builtin_fmaf(cb0[3], zs, z[3]); z[4] = __builtin_fmaf(cb1[0], zs, z[4]); z[5] = __builtin_fmaf(cb1[1], zs, z[5]); z[6] = __builtin_fmaf(cb1[2], zs, z[6]); z[7] = __builtin_fmaf(cb1[3], zs, z[7]); z[8] = __builtin_fmaf(cb2[0], zs, z[8]); z[9] = __builtin_fmaf(cb2[1], zs, z[9]); z[10] = __builtin_fmaf(cb2[2], zs, z[10]); z[11] = __builtin_fmaf(cb2[3], zs, z[11]); z[12] = __builtin_fmaf(cb3[0], zs, z[12]); z[13] = __builtin_fmaf(cb3[1], zs, z[13]); z[14] = __builtin_fmaf(cb3[2], zs, z[14]); z[15] = __builtin_fmaf(cb3[3], zs, z[15]); }
                asm volatile("" : "+v"(z[2]) :: "memory");
                cb1 = *(const f32x4*)(AABT + 19 * 36 + 20); cb2 = *(const f32x4*)(AABT + 19 * 36 + 24); cb3 = *(const f32x4*)(AABT + 19 * 36 + 28);
                { const float zs = z[2]; z[3] = __builtin_fmaf(ca0[3], zs, z[3]); z[4] = __builtin_fmaf(ca1[0], zs, z[4]); z[5] = __builtin_fmaf(ca1[1], zs, z[5]); z[6] = __builtin_fmaf(ca1[2], zs, z[6]); z[7] = __builtin_fmaf(ca1[3], zs, z[7]); z[8] = __builtin_fmaf(ca2[0], zs, z[8]); z[9] = __builtin_fmaf(ca2[1], zs, z[9]); z[10] = __builtin_fmaf(ca2[2], zs, z[10]); z[11] = __builtin_fmaf(ca2[3], zs, z[11]); z[12] = __builtin_fmaf(ca3[0], zs, z[12]); z[13] = __builtin_fmaf(ca3[1], zs, z[13]); z[14] = __builtin_fmaf(ca3[2], zs, z[14]); z[15] = __builtin_fmaf(ca3[3], zs, z[15]); }
                asm volatile("" : "+v"(z[3]) :: "memory");
                ca1 = *(const f32x4*)(AABT + 20 * 36 + 20); ca2 = *(const f32x4*)(AABT + 20 * 36 + 24); ca3 = *(const f32x4*)(AABT + 20 * 36 + 28);
                { const float zs = z[3]; z[4] = __builtin_fmaf(cb1[0], zs, z[4]); z[5] = __builtin_fmaf(cb1[1], zs, z[5]); z[6] = __builtin_fmaf(cb1[2], zs, z[6]); z[7] = __builtin_fmaf(cb1[3], zs, z[7]); z[8] = __builtin_fmaf(cb2[0], zs, z[8]); z[9] = __builtin_fmaf(cb2[1], zs, z[9]); z[10] = __builtin_fmaf(cb2[2], zs, z[10]); z[11] = __builtin_fmaf(cb2[3], zs, z[11]); z[12] = __builtin_fmaf(cb3[0], zs, z[12]); z[13] = __builtin_fmaf(cb3[1], zs, z[13]); z[14] = __builtin_fmaf(cb3[2], zs, z[14]); z[15] = __builtin_fmaf(cb3[3], zs, z[15]); }
                asm volatile("" : "+v"(z[4]) :: "memory");
                cb1 = *(const f32x4*)(AABT + 21 * 36 + 20); cb2 = *(const f32x4*)(AABT + 21 * 36 + 24); cb3 = *(const f32x4*)(AABT + 21 * 36 + 28);
                { const float zs = z[4]; z[5] = __builtin_fmaf(ca1[1], zs, z[5]); z[6] = __builtin_fmaf(ca1[2], zs, z[6]); z[7] = __builtin_fmaf(ca1[3], zs, z[7]); z[8] = __builtin_fmaf(ca2[0], zs, z[8]); z[9] = __builtin_fmaf(ca2[1], zs, z[9]); z[10] = __builtin_fmaf(ca2[2], zs, z[10]); z[11] = __builtin_fmaf(ca2[3], zs, z[11]); z[12] = __builtin_fmaf(ca3[0], zs, z[12]); z[13] = __builtin_fmaf(ca3[1], zs, z[13]); z[14] = __builtin_fmaf(ca3[2], zs, z[14]); z[15] = __builtin_fmaf(ca3[3], zs, z[15]); }
                asm volatile("" : "+v"(z[5]) :: "memory");
                ca1 = *(const f32x4*)(AABT + 22 * 36 + 20); ca2 = *(const f32x4*)(AABT + 22 * 36 + 24); ca3 = *(const f32x4*)(AABT + 22 * 36 + 28);
                { const float zs = z[5]; z[6] = __builtin_fmaf(cb1[2], zs, z[6]); z[7] = __builtin_fmaf(cb1[3], zs, z[7]); z[8] = __builtin_fmaf(cb2[0], zs, z[8]); z[9] = __builtin_fmaf(cb2[1], zs, z[9]); z[10] = __builtin_fmaf(cb2[2], zs, z[10]); z[11] = __builtin_fmaf(cb2[3], zs, z[11]); z[12] = __builtin_fmaf(cb3[0], zs, z[12]); z[13] = __builtin_fmaf(cb3[1], zs, z[13]); z[14] = __builtin_fmaf(cb3[2], zs, z[14]); z[15] = __builtin_fmaf(cb3[3], zs, z[15]); }
                asm volatile("" : "+v"(z[6]) :: "memory");
                cb2 = *(const f32x4*)(AABT + 23 * 36 + 24); cb3 = *(const f32x4*)(AABT + 23 * 36 + 28);
                { const float zs = z[6]; z[7] = __builtin_fmaf(ca1[3], zs, z[7]); z[8] = __builtin_fmaf(ca2[0], zs, z[8]); z[9] = __builtin_fmaf(ca2[1], zs, z[9]); z[10] = __builtin_fmaf(ca2[2], zs, z[10]); z[11] = __builtin_fmaf(ca2[3], zs, z[11]); z[12] = __builtin_fmaf(ca3[0], zs, z[12]); z[13] = __builtin_fmaf(ca3[1], zs, z[13]); z[14] = __builtin_fmaf(ca3[2], zs, z[14]); z[15] = __builtin_fmaf(ca3[3], zs, z[15]); }
                asm volatile("" : "+v"(z[7]) :: "memory");
                ca2 = *(const f32x4*)(AABT + 24 * 36 + 24); ca3 = *(const f32x4*)(AABT + 24 * 36 + 28);
                { const float zs = z[7]; z[8] = __builtin_fmaf(cb2[0], zs, z[8]); z[9] = __builtin_fmaf(cb2[1], zs, z[9]); z[10] = __builtin_fmaf(cb2[2], zs, z[10]); z[11] = __builtin_fmaf(cb2[3], zs, z[11]); z[12] = __builtin_fmaf(cb3[0], zs, z[12]); z[13] = __builtin_fmaf(cb3[1], zs, z[13]); z[14] = __builtin_fmaf(cb3[2], zs, z[14]); z[15] = __builtin_fmaf(cb3[3], zs, z[15]); }
                asm volatile("" : "+v"(z[8]) :: "memory");
                cb2 = *(const f32x4*)(AABT + 25 * 36 + 24); cb3 = *(const f32x4*)(AABT + 25 * 36 + 28);
                { const float zs = z[8]; z[9] = __builtin_fmaf(ca2[1], zs, z[9]); z[10] = __builtin_fmaf(ca2[2], zs, z[10]); z[11] = __builtin_fmaf(ca2[3], zs, z[11]); z[12] = __builtin_fmaf(ca3[0], zs, z[12]); z[13] = __builtin_fmaf(ca3[1], zs, z[13]); z[14] = __builtin_fmaf(ca3[2], zs, z[14]); z[15] = __builtin_fmaf(ca3[3], zs, z[15]); }
                asm volatile("" : "+v"(z[9]) :: "memory");
                ca2 = *(const f32x4*)(AABT + 26 * 36 + 24); ca3 = *(const f32x4*)(AABT + 26 * 36 + 28);
                { const float zs = z[9]; z[10] = __builtin_fmaf(cb2[2], zs, z[10]); z[11] = __builtin_fmaf(cb2[3], zs, z[11]); z[12] = __builtin_fmaf(cb3[0], zs, z[12]); z[13] = __builtin_fmaf(cb3[1], zs, z[13]); z[14] = __builtin_fmaf(cb3[2], zs, z[14]); z[15] = __builtin_fmaf(cb3[3], zs, z[15]); }
                asm volatile("" : "+v"(z[10]) :: "memory");
                cb3 = *(const f32x4*)(AABT + 27 * 36 + 28);
                { const float zs = z[10]; z[11] = __builtin_fmaf(ca2[3], zs, z[11]); z[12] = __builtin_fmaf(ca3[0], zs, z[12]); z[13] = __builtin_fmaf(ca3[1], zs, z[13]); z[14] = __builtin_fmaf(ca3[2], zs, z[14]); z[15] = __builtin_fmaf(ca3[3], zs, z[15]); }
                asm volatile("" : "+v"(z[11]) :: "memory");
                ca3 = *(const f32x4*)(AABT + 28 * 36 + 28);
                { const float zs = z[11]; z[12] = __builtin_fmaf(cb3[0], zs, z[12]); z[13] = __builtin_fmaf(cb3[1], zs, z[13]); z[14] = __builtin_fmaf(cb3[2], zs, z[14]); z[15] = __builtin_fmaf(cb3[3], zs, z[15]); }
                asm volatile("" : "+v"(z[12]) :: "memory");
                cb3 = *(const f32x4*)(AABT + 29 * 36 + 28);
                { const float zs = z[12]; z[13] = __builtin_fmaf(ca3[1], zs, z[13]); z[14] = __builtin_fmaf(ca3[2], zs, z[14]); z[15] = __builtin_fmaf(ca3[3], zs, z[15]); }
                asm volatile("" : "+v"(z[13]) :: "memory");
                ca3 = *(const f32x4*)(AABT + 30 * 36 + 28);
                { const float zs = z[13]; z[14] = __builtin_fmaf(cb3[2], zs, z[14]); z[15] = __builtin_fmaf(cb3[3], zs, z[15]); }
                asm volatile("" : "+v"(z[14]) :: "memory");
                { const float zs = z[14]; z[15] = __builtin_fmaf(ca3[3], zs, z[15]); }
                asm volatile("" : "+v"(z[15]) :: "memory");
#pragma unroll
                for (int q = 0; q < 2; ++q) { u32x4 w; w.x = pack2(z[q * 8 + 0], z[q * 8 + 1]); w.y = pack2(z[q * 8 + 2], z[q * 8 + 3]); w.z = pack2(z[q * 8 + 4], z[q * 8 + 5]); w.w = pack2(z[q * 8 + 6], z[q * 8 + 7]);
                    *(u32x4*)(ZVT + lane * RW_LP + 16 + q * 8) = w; }
            }
        }
        lds_barrier();
        {
            const int nt = wid >> 1;
            const f32x4 pl = *(const f32x4*)(PL + nt * 16 + fq * 4);
#pragma unroll
            for (int q2 = 0; q2 < 2; ++q2) {
                const int vt = (wid & 1) * 2 + q2;
                Sacc[q2] = Sacc[q2] * pl;
#pragma unroll
                for (int k = 0; k < 2; ++k) Sacc[q2] = mma16(ldfrag(BKh, RW_LP, nt * 16, k * 32, fr, fq), ldfrag(ZVT, RW_LP, vt * 16, k * 32, fr, fq), Sacc[q2]);
                st4bf(Sb + (vt * 16 + fr) * RW_LP + nt * 16 + fq * 4, Sacc[q2]);
            }
        }
        if (t0 >= CTXL) {
            const int vt = wid >> 1, tt = wid & 1;
            f32x4 acc = (f32x4){0.f, 0.f, 0.f, 0.f};
            acc = mma16(ldfrag(ZVT, RW_LP, vt * 16, 0, fr, fq), ldfrag(ARB, 40, tt * 16, 0, fr, fq), acc);
            const int t = tt * 16 + fr, v0 = vt * 16 + fq * 4;
#pragma unroll
            for (int rr = 0; rr < 4; ++rr) acc[rr] += YB[t * 64 + v0 + rr];
            const int tn = scan_t<32>(dir, ci, t);
            st4bf(OUT + ((size_t)bl * SEQ + (tn - CTXL)) * 1024 + h * 64 + v0, acc);
        }
    }
    lds_barrier();
#undef RW_PREFETCH
}

__device__ __forceinline__ void phase_mix_cd(const KP& kp, unsigned char* lds, int which) {
    if (which & 1) for (int u = obid(); u < 256; u += gridDim.x) { rwkv_unit(kp, lds, u >> 5, (u >> 1) & 15, u & 1); __syncthreads(); }
    if (which & 2) for (int u = obid(); u < 512; u += gridDim.x) { attn_unit(kp, lds, u >> 6, (u >> 3) & 7, u & 7); __syncthreads(); }
}

struct EpiFinCD {
    const bf16_t* OF; const bf16_t* OB; const bf16_t* P; const float* BSC; const float* ln; const float* mu; bf16_t* AOUT;
    __device__ __forceinline__ void operator()(const f32x4 (&acc)[4][4], int rb, int cb, int fr, int fq) const {
        const int head = cb >> 6;
#pragma unroll
        for (int i = 0; i < 4; ++i) { const int lr = rb + i * 16 + fr, s = lr & 2047;
            const size_t prow = (size_t)(lr >> 11) * TT + CTXL + s;
            f32x4 o[4]; float ss = 0.f;
#pragma unroll
            for (int j = 0; j < 4; ++j) { const int col = cb + j * 16 + fq * 4;
                o[j] = ld4bf(OF + (size_t)lr * 1024 + col) + ld4bf(OB + (size_t)lr * 1024 + col);
                ss += o[j][0] * o[j][0] + o[j][1] * o[j][1] + o[j][2] * o[j][2] + o[j][3] * o[j][3]; }
            ss += __shfl_xor(ss, 16); ss += __shfl_xor(ss, 32);
            const float rstd = rsqrtf(ss * (1.0f / 64.0f) + EPS);
            const float bon = BSC[(size_t)lr * 16 + head] + BSC[(size_t)RGL * 16 + (size_t)lr * 16 + head];
#pragma unroll
            for (int j = 0; j < 4; ++j) { const int col = cb + j * 16 + fq * 4;
                const bf16_t* pv = P + prow * CD_N + CD_V + col;
                const f32x4 v = ld4bf(pv);
                const f32x4 vp = s > 0 ? ld4bf(pv - CD_N) : (f32x4){0.f, 0.f, 0.f, 0.f};
                const f32x4 vn = s < SEQ - 1 ? ld4bf(pv + CD_N) : (f32x4){0.f, 0.f, 0.f, 0.f};
                const f32x4 vl = v + *(const f32x4*)(mu + 2048 + col) * ((vp + vn) * 0.5f - v);
                const f32x4 y = o[j] * rstd * *(const f32x4*)(ln + col) + vl * bon;
                st4bf(AOUT + (size_t)lr * 1536 + 512 + col, y * acc[i][j]); }
        }
    }
};
PHASE_FN void phase_fin_cd(const KP& kp, unsigned char* lds) {
    GA ga{WSP(const bf16_t, WS_SG), nullptr, 128, 0, 128, nullptr, RGL, 0, 0};
    EpiFinCD ep{WSP(const bf16_t, WS_BIG + L1_OF), WSP(const bf16_t, WS_BIG + L1_OB), WSP(const bf16_t, WS_BIG + L1_P), WSP(const float, WS_BSC), KIN(33), KIN(24), WSP(bf16_t, WS_BIG + L1_AOUT)};
    for (int u = obid(); u < (RGL / 256) * 8; u += gridDim.x) gemm_tile(lds, ga, WSP(const bf16_t, WS_WMIX + WM_G2), 128, u >> 3, u & 7, ep);
}
PHASE_FN void phase_gemm_out_cd(const KP& kp, unsigned char* lds) {
    pg8::Gemm g{WSP(const bf16_t, WS_BIG + L1_AOUT), WSP(const bf16_t, WS_WMIX + WM_CD_OUT), RGL, 1024, 1536, nullptr, 0x7fffffff};
    pg8::StaticOrder S; S.init(RGL, 1024, (int)gridDim.x, obid());
    pg8::EpiBfG E{WSP(bf16_t, WS_BIG + L1_U), 1024, 1024, 0x7fffffff};
    pg8::gemm_phase<pg8::EpiBfG, pg8::StaticOrder, false>((PG8_LAS unsigned char*)lds, g, S, E, nullptr);
    __syncthreads();
}

__device__ __attribute__((noinline)) void grid_sync(unsigned* barw, unsigned x, volatile LAS unsigned* st) { XcdBarrier b; b.bar = barw; b.x = x; b.st = st; xcd_barrier(b); }
constexpr int N_PHASES = 39;
__global__ void __launch_bounds__(512, 2) fwd_kernel(KP kparg) {
    extern __shared__ __attribute__((aligned(16))) unsigned char lds[];
    const int lo = kparg.ph_lo, hi = kparg.ph_hi;
    const KP& kp = kparg;
    volatile LAS unsigned* xbst = (volatile LAS unsigned*)(LAS unsigned char*)(lds + LDS_BYTES - 16);
    if (threadIdx.x == 0) { xbst[0] = 0u; xbst[1] = 0u; }
    __syncthreads();
    XcdBarrier bar; bar.bar = (unsigned*)kparg.ws; bar.x = 0; bar.st = xbst;
    if (hi - lo > 1) bar = xcd_barrier_post((unsigned*)kparg.ws, xbst);
#define IN(k) (lo <= (k) && (k) < hi)
#define SEAM(k) do { if (IN(k) && IN((k) + 1)) { grid_sync((unsigned*)kp.ws, bar.x, xbst); if (PROBE_DUP & 512) grid_sync((unsigned*)kp.ws, bar.x, xbst); } } while (0)
#define PHASE(...) do { if (IN(ph)) { __VA_ARGS__ } SEAM(ph); ++ph; } while (0)
    int ph = 0;
    PHASE(phase_mod(kp, lds); __syncthreads(); phase_conv_ab(kp, lds); if (PROBE_DUP & 32) { __syncthreads(); phase_mod(kp, lds); __syncthreads(); phase_conv_ab(kp, lds); });
#pragma unroll
    for (int g = 0; g < NG; ++g) {
        PHASE(phase_u(kp, 0, g); if (PROBE_DUP & 128) phase_u(kp, 0, g););
        PHASE(phase_gemm_in(kp, lds, 0); if (PROBE_DUP & 8) phase_gemm_in(kp, lds, 0););
        PHASE(phase_xconv(kp); if (PROBE_DUP & 2048) phase_xconv(kp););
        PHASE(phase_scan_ab(kp, lds); if (PROBE_DUP & 1) { __syncthreads(); phase_scan_ab(kp, lds); });
        PHASE(phase_fin_ab(kp););
        PHASE(phase_gemm_out_ab(kp, lds); if (PROBE_DUP & 256) phase_gemm_out_ab(kp, lds););
        PHASE(phase_r(kp, lds, 0, g););
    }
    PHASE(phase_moe_gather(kp, 0); phase_conv_moe(kp, lds, 0); phase_conv_cd(kp, lds); if (PROBE_DUP & 64) { phase_moe_gather(kp, 0); phase_conv_moe(kp, lds, 0); phase_conv_cd(kp, lds); });
    PHASE(phase_moe_gemm(kp, lds, 0, false); if (PROBE_DUP & 16) { __syncthreads(); phase_moe_gemm(kp, lds, 0, false); });
    PHASE(phase_moe_gemm(kp, lds, 0, true); if (PROBE_DUP & 16) { __syncthreads(); phase_moe_gemm(kp, lds, 0, true); });
    PHASE(phase_combine(kp, 0););
#pragma unroll
    for (int g = 0; g < NG; ++g) {
        PHASE(phase_u(kp, 1, g); if (PROBE_DUP & 128) phase_u(kp, 1, g););
        PHASE(phase_gemm_in(kp, lds, 1); if (PROBE_DUP & 8) phase_gemm_in(kp, lds, 1););
        PHASE(phase_prep_cd(kp););
        PHASE(phase_upproj(kp, lds); if (PROBE_DUP & 4096) phase_upproj(kp, lds););
        PHASE(phase_mix_cd(kp, lds, 3); if (PROBE_DUP & 2) { __syncthreads(); phase_mix_cd(kp, lds, 1); } if (PROBE_DUP & 4) { __syncthreads(); phase_mix_cd(kp, lds, 2); });
        PHASE(phase_fin_cd(kp, lds); if (PROBE_DUP & 4096) phase_fin_cd(kp, lds););
        PHASE(phase_gemm_out_cd(kp, lds); if (PROBE_DUP & 256) phase_gemm_out_cd(kp, lds););
        PHASE(phase_r(kp, lds, 1, g););
    }
    PHASE(phase_moe_gather(kp, 1); phase_conv_moe(kp, lds, 1););
    PHASE(phase_moe_gemm(kp, lds, 1, false););
    PHASE(phase_moe_gemm(kp, lds, 1, true););
    PHASE(phase_combine(kp, 1););
#undef PHASE
#undef IN
#undef SEAM
}

extern "C" void kernel_launch(void* const* d_in, const int* in_sizes, int n_in, void* d_out, int out_size, void* d_ws, size_t ws_size, hipStream_t stream) {
    static int grid = 0;
    if (grid == 0) {
        if (n_in != 42 || out_size != NLAT * D || ws_size < WS_NEED) { fprintf(stderr, "kernel_launch: unexpected shapes: n_in %d out %d ws %zu (need %zu)\n", n_in, out_size, ws_size, (size_t)WS_NEED); grid = -1; return; }
        int dev = 0, cus = 0, per_cu = 0;
        if (hipGetDevice(&dev) != hipSuccess || hipDeviceGetAttribute(&cus, hipDeviceAttributeMultiprocessorCount, dev) != hipSuccess) { grid = -1; return; }
        if (hipFuncSetAttribute((const void*)fwd_kernel, hipFuncAttributeMaxDynamicSharedMemorySize, LDS_BYTES) != hipSuccess) { fprintf(stderr, "kernel_launch: hipFuncSetAttribute failed\n"); grid = -1; return; }
        if (hipOccupancyMaxActiveBlocksPerMultiprocessor(&per_cu, (const void*)fwd_kernel, 512, LDS_BYTES) != hipSuccess || per_cu < 1) { fprintf(stderr, "kernel_launch: occupancy query says %d blocks per CU\n", per_cu); grid = -1; (void)hipGetLastError(); return; }
        grid = cus;
    }
    if (grid < 0) return;
    (void)hipMemsetAsync(d_ws, 0, CTL_BYTES, stream);
    KP kp{};
    for (int i = 0; i < 42; ++i) kp.in[i] = (const float*)d_in[i];
    kp.out = (float*)d_out; kp.ws = (unsigned char*)d_ws;
#if N_LAUNCH_MODE == 1
    kp.ph_lo = 0; kp.ph_hi = N_PHASES;
    hipLaunchKernelGGL(fwd_kernel, dim3(grid), dim3(512), LDS_BYTES, stream, kp);
#else
    for (int p = 0; p < N_PHASES; ++p) { kp.ph_lo = p; kp.ph_hi = p + 1; hipLaunchKernelGGL(fwd_kernel, dim3(grid), dim3(512), LDS_BYTES, stream, kp); }
#endif
}
```

```cpp
#include <hip/hip_runtime.h>
#include <stdint.h>
#include <stdio.h>

typedef unsigned short bf16_t;
typedef short bf16x8 __attribute__((ext_vector_type(8)));
typedef float f32x4 __attribute__((ext_vector_type(4)));
typedef float f32x2 __attribute__((ext_vector_type(2)));
typedef unsigned u32x4 __attribute__((ext_vector_type(4)));
typedef unsigned u32x2 __attribute__((ext_vector_type(2)));

#ifndef RWP
#define RWP 0
#endif
#ifndef PROBE_DUP
#define PROBE_DUP 0
#endif
#ifndef N_LAUNCH_MODE
#define N_LAUNCH_MODE 1
#endif

constexpr int NB = 16, SEQ = 2048, CTXL = 256, TT = 2304, D = 1024;
constexpr int NTOK = NB * TT, NLAT = NB * SEQ;
constexpr int NG = 2, BG = NB / NG, RG = BG * TT, RGL = BG * SEQ;
constexpr float EPS = 1e-6f;
constexpr int AB_N = 5424, AB_NPAD = 5632, AB_Q = 0, AB_K = 512, AB_V = 1024, AB_OG = 2048, AB_IG = 3072, AB_FG = 3080, AB_Z = 3088, AB_XBC = 4112, AB_DT = 5392;
constexpr int CD_N = 4128, CD_NPAD = 4352, CD_M0 = 0, CD_M1 = 384, CD_KR = 640, CD_R = 672, CD_K = 1696, CD_V = 2720, CD_WL = 3744, CD_AL = 3872, CD_GL = 4000;
constexpr int CD_RW0 = 672;

constexpr size_t CTL_BYTES = 32768;
constexpr size_t CTL_CNT = 16384;
constexpr size_t WS_MODV = CTL_BYTES;
constexpr size_t WS_HC   = WS_MODV + (size_t)2 * 17 * 6144 * 4;
constexpr size_t WS_TOKE = WS_HC + (size_t)NB * CTXL * D * 4;
constexpr size_t WS_TOKP = WS_TOKE + (size_t)NTOK * 2 * 4;
constexpr size_t WS_TOKW = WS_TOKP + (size_t)NTOK * 2 * 4;
constexpr size_t WS_LIST = WS_TOKW + (size_t)NTOK * 2 * 4;
constexpr size_t WS_BSC  = WS_LIST + (size_t)16 * NTOK * 4;
constexpr size_t WS_SG   = WS_BSC + (size_t)2 * RGL * 16 * 4;
constexpr size_t WS_WMIX = WS_SG + (size_t)RGL * 128 * 2;
constexpr size_t WMIX_BYTES = (size_t)16 << 20;
constexpr size_t WS_V    = WS_WMIX + WMIX_BYTES;
constexpr size_t WS_BIG  = WS_V + (size_t)NTOK * D * 2;
constexpr size_t WM_AB_IN = 0, WM_AB_OUT = (size_t)AB_NPAD * 1024 * 2;
constexpr size_t WM_CD_IN = 0, WM_CD_OUT = (size_t)CD_NPAD * 1024 * 2, WM_UQ = WM_CD_OUT + (size_t)1024 * 1536 * 2, WM_UKV = WM_UQ + (size_t)768 * 384 * 2, WM_G2 = WM_UKV + (size_t)1024 * 256 * 2;
static_assert(WM_AB_OUT + (size_t)1024 * 2048 * 2 <= WMIX_BYTES, "wmix ab");
static_assert(WM_G2 + (size_t)1024 * 128 * 2 <= WMIX_BYTES, "wmix cd");
constexpr size_t SZ_RG1K = (size_t)RG * 1024 * 2, SZ_RGL1K = (size_t)RGL * 1024 * 2;
constexpr size_t L0_P = 0, L0_AO = (size_t)RG * AB_N * 2  , L0_HB = L0_AO + 2 * SZ_RG1K, L0_YB = L0_HB + SZ_RG1K, L0_U = L0_YB + SZ_RG1K, L0_END = L0_U + SZ_RG1K;
constexpr size_t L1_P = 0, L1_Q = (size_t)RG * CD_N * 2, L1_KV = L1_Q + (size_t)RGL * 768 * 2, L1_OF = L1_KV + SZ_RG1K, L1_OB = L1_OF + SZ_RGL1K, L1_AOUT = L1_OB + SZ_RGL1K, L1_U = L1_AOUT + (size_t)RGL * 1536 * 2, L1_TWAL = L1_U + SZ_RG1K  , L1_END = L1_TWAL + (size_t)RG * 256 * 2;
constexpr int MOE_PADROWS = 16 * 256;
constexpr size_t MO_WUP = 0, MO_WDN = (size_t)17 * 1024 * 1024 * 2, MO_HID = MO_WDN + (size_t)17 * 1024 * 512 * 2;
constexpr size_t MO_XG = MO_HID + (size_t)(3 * NTOK + MOE_PADROWS) * 512 * 2;
constexpr size_t MO_CON = MO_XG, MO_END = MO_CON + (size_t)(3 * NTOK + MOE_PADROWS) * 1024 * 2;
constexpr size_t BIG_BYTES = MO_END > L0_END ? (MO_END > L1_END ? MO_END : L1_END) : (L0_END > L1_END ? L0_END : L1_END);
constexpr size_t WS_NEED = WS_BIG + BIG_BYTES;

constexpr int LDS_BYTES = 147456;

__device__ __forceinline__ float bf2f(unsigned short h) { return __uint_as_float(((unsigned)h) << 16); }
typedef __bf16 bf16v2_t __attribute__((ext_vector_type(2)));
__device__ __forceinline__ unsigned pack2(float a, float b) { const bf16v2_t h = __builtin_convertvector((f32x2){a, b}, bf16v2_t); return __builtin_bit_cast(unsigned, h); }
__device__ __forceinline__ unsigned short f2bf(float f) { const __bf16 h = (__bf16)f; return __builtin_bit_cast(unsigned short, h); }
__device__ __forceinline__ float lo2f(unsigned w) { return __uint_as_float(w << 16); }
__device__ __forceinline__ float hi2f(unsigned w) { return __uint_as_float(w & 0xffff0000u); }
__device__ __forceinline__ float wsum(float v) {
#pragma unroll
    for (int o = 32; o; o >>= 1) v += __shfl_xor(v, o);
    return v; }
__device__ __forceinline__ float frcp_(float x) { return __builtin_amdgcn_rcpf(x); }
__device__ __forceinline__ float sigmoidf_(float x) { return __builtin_amdgcn_rcpf(1.0f + __expf(-x)); }
__device__ __forceinline__ float siluf_(float x) { return x * __builtin_amdgcn_rcpf(1.0f + __expf(-x)); }
__device__ __forceinline__ float softplusf_(float x) { return fmaxf(x, 0.0f) + __logf(1.0f + __expf(-fabsf(x))); }
__device__ __forceinline__ float logsigmoidf_(float x) { return fminf(x, 0.0f) - __logf(1.0f + __expf(-fabsf(x))); }
__device__ __forceinline__ float tanhf_(float x) { return 1.0f - 2.0f * __builtin_amdgcn_rcpf(__expf(2.0f * x) + 1.0f); }
__device__ __forceinline__ f32x4 mma16(bf16x8 a, bf16x8 b, f32x4 c) { return __builtin_amdgcn_mfma_f32_16x16x32_bf16(a, b, c, 0, 0, 0); }
__device__ __forceinline__ bf16x8 ldfrag(const bf16_t* base, int ld, int row0, int k0, int fr, int fq) { return *(const bf16x8*)(base + (row0 + fr) * ld + k0 + fq * 8); }
__device__ __forceinline__ void st4bf(bf16_t* p, f32x4 v) { u32x2 w; w.x = pack2(v[0], v[1]); w.y = pack2(v[2], v[3]); *(u32x2*)p = w; }
__device__ __forceinline__ f32x4 ld4bf(const bf16_t* p) { u32x2 w = *(const u32x2*)p; return (f32x4){lo2f(w.x), hi2f(w.x), lo2f(w.y), hi2f(w.y)}; }

#define PHASE_FN __device__ __forceinline__
__device__ __forceinline__ int otid() { int t = threadIdx.x; asm volatile("" : "+v"(t)); return t; }
__device__ __forceinline__ int obid() { int t = blockIdx.x; asm volatile("" : "+s"(t)); return t; }
template <class T> __device__ __forceinline__ T* as_global(T* p) { return p; }
__device__ __forceinline__ void lds_barrier() { asm volatile("s_waitcnt lgkmcnt(0)" ::: "memory"); __builtin_amdgcn_s_barrier(); asm volatile("" ::: "memory"); }
struct KP { const float* in[42]; float* out; unsigned char* ws; int ph_lo, ph_hi; };

#define XB_TMO      128
#define XB_XCNT(j)  (256  + 64 * (j))
#define XB_XSUB(j)  (1280 + 64 * (j))
#define XB_XGEN(j)  (2304 + 64 * (j))
#define XB_TOP      3328
#define XB_TOPGEN   3392
#define XCD_BAR_WORDS 3456
#define XB_SPIN_CAP (1u << 18)
#define LAS __attribute__((address_space(3)))

__device__ __forceinline__ unsigned xb_ld(unsigned* p)              { return __hip_atomic_load(p, __ATOMIC_RELAXED, __HIP_MEMORY_SCOPE_AGENT); }
__device__ __forceinline__ unsigned xb_add(unsigned* p, unsigned v) { return __hip_atomic_fetch_add(p, v, __ATOMIC_RELAXED, __HIP_MEMORY_SCOPE_AGENT); }
__device__ __forceinline__ unsigned xb_xcc_id() { return (unsigned)__builtin_amdgcn_s_getreg((3 << 11) | 20) & 0xFu; }
#define XB_SPIN(cond, bar) do { unsigned _sp = 0; while (cond) { __builtin_amdgcn_s_sleep(1); \
    if ((++_sp & 255u) == 0u) { if (xb_ld(&(bar)[XB_TMO])) break; if (_sp > XB_SPIN_CAP) { atomicAdd(&(bar)[XB_TMO], 1u); break; } } } } while (0)

struct XcdBarrier {
    unsigned* bar; unsigned x;
    volatile LAS unsigned* st;
};

__device__ __forceinline__ XcdBarrier xcd_barrier_post(unsigned* bar, volatile LAS unsigned* st) {
    XcdBarrier b; b.bar = bar; b.x = xb_xcc_id(); b.st = st;
    if (threadIdx.x == 0) (void)xb_add(&bar[XB_XCNT(b.x)], 1u);
    return b;
}
__device__ __forceinline__ void xcd_barrier_complete(unsigned* bar, unsigned x, unsigned& nloc, unsigned& nx) {
    const unsigned G = gridDim.x * gridDim.y * gridDim.z;
    unsigned sum, cnt, mine, sp = 0u;
    for (;;) {
        sum = 0u; cnt = 0u; mine = 0u;
#pragma unroll
        for (unsigned j = 0; j < 16; ++j) { const unsigned c = xb_ld(&bar[XB_XCNT(j)]); sum += c; cnt += (c > 0u) ? 1u : 0u; mine = (j == x) ? c : mine; }
        if (sum == G) break;
        __builtin_amdgcn_s_sleep(1);
        if ((++sp & 255u) == 0u) { if (xb_ld(&bar[XB_TMO])) break; if (sp > XB_SPIN_CAP) { atomicAdd(&bar[XB_TMO], 1u); break; } }
    }
    nloc = mine > 0u ? mine : 1u; nx = cnt > 0u ? cnt : 1u;
}

__device__ __forceinline__ void xcd_barrier(const XcdBarrier& b) {
    asm volatile("s_waitcnt vmcnt(0)" ::: "memory");
    __syncthreads();
    if (threadIdx.x == 0) {
        unsigned* bar = b.bar;
        __builtin_amdgcn_s_waitcnt(0);
        unsigned nloc = b.st[0], nx = b.st[1];
        if (nloc == 0u) { xcd_barrier_complete(bar, b.x, nloc, nx); b.st[0] = nloc; b.st[1] = nx; }
        const unsigned old = xb_add(&bar[XB_XSUB(b.x)], 1u);
        const unsigned gen = old / nloc;
        if (old + 1u == (gen + 1u) * nloc) {
            __builtin_amdgcn_fence(__ATOMIC_RELEASE, "agent");
            asm volatile("s_waitcnt vmcnt(0)" ::: "memory");
            const unsigned og = xb_add(&bar[XB_TOP], 1u);
            const unsigned tg = og / nx;
            if (og + 1u == (tg + 1u) * nx) xb_add(&bar[XB_TOPGEN], 1u);
            else XB_SPIN(xb_ld(&bar[XB_TOPGEN]) == tg, bar);
            __builtin_amdgcn_fence(__ATOMIC_ACQUIRE, "agent");
            xb_add(&bar[XB_XGEN(b.x)], 1u);
            asm volatile("s_waitcnt vmcnt(0)" ::: "memory");
        } else {
            XB_SPIN(xb_ld(&bar[XB_XGEN(b.x)]) == gen, bar);
            __builtin_amdgcn_fence(__ATOMIC_ACQUIRE, "agent");
            asm volatile("s_waitcnt vmcnt(0)" ::: "memory");
        }
    }
    __syncthreads();
}
struct GA {
    const bf16_t* a0; const bf16_t* a1;
    int ld0, ld1, ksplit;
    const int* list;
    int nrows;
    int mode;
    int row0;
};
constexpr int G_LDT = 40;
constexpr int GEMM_LDS = (2 * 256 * G_LDT + 2 * 128 * G_LDT) * 2;

template <class Epi>
__device__ __forceinline__ void gemm_tile(unsigned char* lds, const GA& ga, const bf16_t* __restrict__ Bt, int K, int mt, int nt, const Epi& epi) {
    const int tid = otid(), lane = tid & 63, wid = __builtin_amdgcn_readfirstlane(tid >> 6), wm = wid >> 1, wn = wid & 1, fr = lane & 15, fq = lane >> 4;
    bf16_t* sA = (bf16_t*)lds;
    bf16_t* sB = sA + 2 * 256 * G_LDT;
    const int kp = tid & 3;
    const int r0 = tid >> 2, r1 = r0 + 128;
    int s0, s1;
    {
        int lr = mt * 256 + r0; if (lr >= ga.nrows) lr = 0;
        s0 = ga.list ? ga.list[lr] : (ga.mode == 1 ? (lr >> 11) * TT + CTXL + (lr & 2047) : ga.row0 + lr);
        lr = mt * 256 + r1; if (lr >= ga.nrows) lr = 0;
        s1 = ga.list ? ga.list[lr] : (ga.mode == 1 ? (lr >> 11) * TT + CTXL + (lr & 2047) : ga.row0 + lr);
    }
    const bf16_t* pa00 = ga.a0 + (size_t)s0 * ga.ld0 + kp * 8;
    const bf16_t* pa01 = ga.a0 + (size_t)s1 * ga.ld0 + kp * 8;
    const bf16_t* pa10 = ga.a1 ? ga.a1 + (size_t)s0 * ga.ld1 + kp * 8 : pa00;
    const bf16_t* pa11 = ga.a1 ? ga.a1 + (size_t)s1 * ga.ld1 + kp * 8 : pa01;
    const bf16_t* pb = Bt + (size_t)(nt * 128 + r0) * K + kp * 8;
    const int ksplit = ga.ksplit;
    f32x4 acc[4][4];
#pragma unroll
    for (int i = 0; i < 4; ++i)
#pragma unroll
        for (int j = 0; j < 4; ++j) acc[i][j] = (f32x4){0.f, 0.f, 0.f, 0.f};
    const int nk = K >> 5;
    u32x4 ra0, ra1, rb;
    {
        ra0 = *(const u32x4*)(pa00); ra1 = *(const u32x4*)(pa01); rb = *(const u32x4*)(pb);
        if (0 >= ksplit) { ra0 = *(const u32x4*)(pa10); ra1 = *(const u32x4*)(pa11); }
    }
    *(u32x4*)(sA + (r0) * G_LDT + kp * 8) = ra0;
    *(u32x4*)(sA + (r1) * G_LDT + kp * 8) = ra1;
    *(u32x4*)(sB + (r0) * G_LDT + kp * 8) = rb;
    __syncthreads();
    for (int kt = 0; kt < nk; ++kt) {
        const int cur = kt & 1;
        if (kt + 1 < nk) {
            const int k0 = (kt + 1) << 5;
            if (k0 < ksplit) { ra0 = *(const u32x4*)(pa00 + k0); ra1 = *(const u32x4*)(pa01 + k0); }
            else { ra0 = *(const u32x4*)(pa10 + (k0 - ksplit)); ra1 = *(const u32x4*)(pa11 + (k0 - ksplit)); }
            rb = *(const u32x4*)(pb + k0);
        }
        const bf16_t* cA = sA + cur * 256 * G_LDT;
        const bf16_t* cB = sB + cur * 128 * G_LDT;
        bf16x8 af[4], bfr[4];
#pragma unroll
        for (int i = 0; i < 4; ++i) af[i] = ldfrag(cA, G_LDT, wm * 64 + i * 16, 0, fr, fq);
#pragma unroll
        for (int j = 0; j < 4; ++j) bfr[j] = ldfrag(cB, G_LDT, wn * 64 + j * 16, 0, fr, fq);
#pragma unroll
        for (int i = 0; i < 4; ++i)
#pragma unroll
            for (int j = 0; j < 4; ++j) acc[i][j] = mma16(bfr[j], af[i], acc[i][j]);
        if (kt + 1 < nk) {
            const int nb = cur ^ 1;
            *(u32x4*)(sA + (nb * 256 + r0) * G_LDT + kp * 8) = ra0;
            *(u32x4*)(sA + (nb * 256 + r1) * G_LDT + kp * 8) = ra1;
            *(u32x4*)(sB + (nb * 128 + r0) * G_LDT + kp * 8) = rb;
        }
        __syncthreads();
    }
    epi(acc, mt * 256 + wm * 64, nt * 128 + wn * 64, fr, fq);
}

struct EpiBf {
    bf16_t* out; int ld, nrows, ncols;
    __device__ __forceinline__ void operator()(const f32x4 (&acc)[4][4], int rb, int cb, int fr, int fq) const {
#pragma unroll
        for (int i = 0; i < 4; ++i) { const int lr = rb + i * 16 + fr; if (lr < nrows) {
#pragma unroll
            for (int j = 0; j < 4; ++j) { const int col = cb + j * 16 + fq * 4; if (col < ncols) st4bf(out + (size_t)lr * ld + col, acc[i][j]); } } }
    }
};
struct EpiSwiglu {
    bf16_t* out; int nrows;
    __device__ __forceinline__ void operator()(const f32x4 (&acc)[4][4], int rb, int cb, int fr, int fq) const {
#pragma unroll
        for (int i = 0; i < 4; ++i) { const int lr = rb + i * 16 + fr; if (lr < nrows) {
#pragma unroll
            for (int j = 0; j < 2; ++j) { const int col = (cb >> 1) + j * 16 + fq * 4; f32x4 g = acc[i][j], u = acc[i][j + 2], o;
#pragma unroll
                for (int r = 0; r < 4; ++r) o[r] = siluf_(g[r]) * u[r];
                st4bf(out + (size_t)lr * 512 + col, o); } } }
    }
};

namespace pg8 {
#define PG8_LAS __attribute__((address_space(3)))
typedef unsigned short bf16_t;
typedef short bf16x8 __attribute__((ext_vector_type(8)));
typedef float f32x4 __attribute__((ext_vector_type(4)));
typedef unsigned u32x4 __attribute__((ext_vector_type(4)));
constexpr int BM = 256, BK = 64, HALF = 128, HTB = HALF * BK * 2  , STAGE_BYTES = 8 * HTB, NXCD = 8, WGM = 8;

__host__ __device__ __forceinline__ int lds_byte(int r, int c) { const int st = (r >> 4) * 2 + (c >> 5), rr = r & 15, cc = c & 31, ob = rr * 64 + cc * 2; return st * 1024 + (ob ^ (((ob >> 9) & 1) << 5)); }
__host__ __device__ __forceinline__ void stage_rc(int b, int& R, int& C) { const int st = b / 1024, sb = b % 1024, swz = sb ^ (((sb >> 9) & 1) << 5); R = (st >> 1) * 16 + swz / 64; C = (st & 1) * 32 + (swz % 64) / 2; }
__host__ __device__ __forceinline__ int perm32(int rho) { const int n = rho >> 4, i = rho & 15; return 8 * (i >> 2) + 4 * n + (i & 3); }

struct Unit { int pm, pn; };
struct Gemm { const bf16_t* A; const bf16_t* Bt; int M, N, K; const bf16_t* A2; int pm_split; int lda, amode; };
#define PG8_ABASE(g, pm) ((g).amode == 1 ? (const char*)(g).A + (size_t)(((pm) >> 3) * 2304 + 256 + ((pm) & 7) * 256) * lda_ * 2 : ((pm) < (g).pm_split ? (const char*)(g).A + (size_t)(pm) * tstepA : (const char*)(g).A2 + (size_t)((pm) - (g).pm_split) * tstepA))
struct StaticOrder {
    int nM, nN, nwg, G, c;
    __host__ __device__ void init(int M, int N, int G_, int c_) { nM = M / BM; nN = N / BM; nwg = nM * nN; G = G_; c = c_; }
    __host__ __device__ bool next(int i, Unit& u) const {
        const long L = (long)i * G + c; if (L >= nwg) return false;
        int wgid = (int)L; { const int q = nwg / NXCD, r = nwg % NXCD, xcd = wgid % NXCD, off = wgid / NXCD; wgid = (xcd < r ? xcd * (q + 1) : r * (q + 1) + (xcd - r) * q) + off; }
        const int nig = WGM * nN, gid = wgid / nig, fm = gid * WGM, gsz = (nM - fm) < WGM ? (nM - fm) : WGM;
        u.pm = fm + ((wgid % nig) % gsz); u.pn = (wgid % nig) / gsz; return true;
    }
    __device__ __forceinline__ void a_ready(const Unit&) const {}
    __device__ __forceinline__ void done(const Unit&) const {}
};
__device__ __forceinline__ unsigned cvt_pk_bf16(float lo, float hi) { unsigned r; asm volatile("v_cvt_pk_bf16_f32 %0, %1, %2" : "=v"(r) : "v"(lo), "v"(hi)); return r; }
typedef float f32x2 __attribute__((ext_vector_type(2)));
template <class Epi, class Sched, bool STAMP = false>
__device__ __forceinline__ void gemm_phase(PG8_LAS unsigned char* lds, const Gemm g, const Sched& S, const Epi& E, unsigned long long* stamps) {
    const int tid = otid(), wid = __builtin_amdgcn_readfirstlane(tid >> 6), lane = tid & 63, wr = wid >> 2, wc = wid & 3, fr = lane & 15, fq = lane >> 4;
    const int K = g.K, nt = K / BK, lda_ = g.lda ? g.lda : g.K;
    int ts_lo = 0, ts_hi = 0, nts = 0; const unsigned long long rt_entry = STAMP ? (unsigned long long)wall_clock64() : 0ull;
#define PG8_STAMP() do { if (STAMP && wid == 0 && nts < 64) { const unsigned long long _c = (unsigned long long)clock64(); \
        ts_lo = (lane == nts) ? (int)(unsigned)_c : ts_lo; ts_hi = (lane == nts) ? (int)(unsigned)(_c >> 32) : ts_hi; ++nts; } } while (0)
    PG8_STAMP();
    unsigned voffA[2], voffB[2];
#pragma unroll
    for (int i = 0; i < 2; ++i) { int R, C; stage_rc(tid * 16 + i * 8192, R, C); const int Rb = Epi::PERM ? ((R & ~31) + perm32(R & 31)) : R;
        voffA[i] = (unsigned)(R * lda_ + C) * 2u; voffB[i] = (unsigned)(Rb * K + C) * 2u; }
    const size_t kstep = (size_t)(BK * 2);
    const size_t hstep = (size_t)HALF * K * 2;
    const size_t hstepA = (size_t)HALF * lda_ * 2, tstepA = 2 * hstepA;
    const size_t tstep = 2 * hstep;
    const unsigned ldsw = (unsigned)wid * 1024u;
    const int aoff = lds_byte(wr * 64 + fr, fq * 8), boff = lds_byte(wc * 32 + fr, fq * 8);
#define PG8_SA(b, h) (((b) * 2 + (h)) * HTB)
#define PG8_SB(b, h) ((4 + (b) * 2 + (h)) * HTB)
#define PG8_STAGE(bufoff, gbase, voff) do { _Pragma("unroll") for (int _i = 0; _i < 2; ++_i) \
        __builtin_amdgcn_global_load_lds((const unsigned*)((const char*)(gbase) + (voff)[_i]), (PG8_LAS unsigned*)(lds + (bufoff) + ldsw + _i * 8192), 16, 0, 0); } while (0)
#define PG8_LDA(dst, b, h) do { _Pragma("unroll") for (int m = 0; m < 4; ++m) _Pragma("unroll") for (int k = 0; k < 2; ++k) dst[m][k] = *(const PG8_LAS bf16x8*)(lds + PG8_SA(b, h) + aoff + m * 2048 + k * 1024); } while (0)
#define PG8_LDB(dst, b, h) do { _Pragma("unroll") for (int n = 0; n < 2; ++n) _Pragma("unroll") for (int k = 0; k < 2; ++k) dst[n][k] = *(const PG8_LAS bf16x8*)(lds + PG8_SB(b, h) + boff + n * 2048 + k * 1024); } while (0)
#define PG8_MMA(ai, bj, At, Bt) do { __builtin_amdgcn_s_setprio(1); _Pragma("unroll") for (int m = 0; m < 4; ++m) _Pragma("unroll") for (int n = 0; n < 2; ++n) _Pragma("unroll") for (int k = 0; k < 2; ++k) \
        acc[ai][bj][m][n] = __builtin_amdgcn_mfma_f32_16x16x32_bf16(Bt[n][k], At[m][k], acc[ai][bj][m][n], 0, 0, 0); __builtin_amdgcn_s_setprio(0); } while (0)
#define PG8_WAIT_V(n) asm volatile("s_waitcnt vmcnt(" #n ")" ::: "memory")
#define PG8_WAIT_L(n) asm volatile("s_waitcnt lgkmcnt(" #n ")" ::: "memory")
#define PG8_BAR __builtin_amdgcn_s_barrier()
#define PG8_SCHED __builtin_amdgcn_sched_barrier(0)
    Unit cur, nxt; int ui = 0;
    if (!S.next(0, cur)) return;
    f32x4 acc[2][2][4][2];
#pragma unroll
    for (int a = 0; a < 2; ++a)
#pragma unroll
        for (int b = 0; b < 2; ++b)
#pragma unroll
            for (int m = 0; m < 4; ++m)
#pragma unroll
                for (int n = 0; n < 2; ++n) acc[a][b][m][n] = (f32x4){0.f, 0.f, 0.f, 0.f};
    bf16x8 At[4][2], B0[2][2], B1[2][2];
    const char* cA = PG8_ABASE(g, cur.pm); const char* cB = (const char*)g.Bt + (size_t)cur.pn * tstep;
    S.a_ready(cur);
    PG8_STAGE(PG8_SB(0, 0), cB, voffB); PG8_STAGE(PG8_SA(0, 0), cA, voffA); PG8_STAGE(PG8_SB(0, 1), cB + hstep, voffB); PG8_STAGE(PG8_SA(0, 1), cA + hstepA, voffA);
    if (wr == 1) PG8_BAR;
    PG8_WAIT_V(4); PG8_BAR;
    PG8_STAGE(PG8_SB(1, 0), cB + kstep, voffB); PG8_STAGE(PG8_SA(1, 0), cA + kstep, voffA); PG8_STAGE(PG8_SB(1, 1), cB + hstep + kstep, voffB);
    PG8_WAIT_V(6); PG8_BAR;
    PG8_STAMP();
    for (;;) {
        const bool has_next = S.next(ui + 1, nxt);
        const char* nA = has_next ? PG8_ABASE(g, nxt.pm) : cA; const char* nB = has_next ? (const char*)g.Bt + (size_t)nxt.pn * tstep : cB;
        for (int t = 0; t < nt; t += 2) {
            const bool last = (t == nt - 2);
            const char* a1 = cA + (size_t)(t + 1) * kstep;
            const char* a2 = last ? nA : cA + (size_t)(t + 2) * kstep; const char* b2 = last ? nB : cB + (size_t)(t + 2) * kstep;
            const char* a3 = a2 + kstep; const char* b3 = b2 + kstep;
            if (last && has_next) S.a_ready(nxt);
            PG8_LDB(B0, 0, 0); PG8_SCHED; PG8_LDA(At, 0, 0); PG8_STAGE(PG8_SA(1, 1), a1 + hstepA, voffA);
            PG8_WAIT_L(8); PG8_BAR; PG8_WAIT_L(0); PG8_MMA(0, 0, At, B0); PG8_BAR; PG8_SCHED;
            PG8_LDB(B1, 0, 1); PG8_STAGE(PG8_SB(0, 0), b2, voffB);
            PG8_BAR; PG8_WAIT_L(0); PG8_MMA(0, 1, At, B1); PG8_BAR;
            PG8_LDA(At, 0, 1); PG8_STAGE(PG8_SA(0, 0), a2, voffA);
            PG8_BAR; PG8_WAIT_L(0); PG8_MMA(1, 0, At, B0); PG8_BAR; PG8_SCHED;
            PG8_STAGE(PG8_SB(0, 1), b2 + hstep, voffB);
            PG8_WAIT_V(6); PG8_BAR; PG8_MMA(1, 1, At, B1); PG8_BAR;
            PG8_LDB(B0, 1, 0); PG8_SCHED; PG8_LDA(At, 1, 0); PG8_STAGE(PG8_SA(0, 1), a2 + hstepA, voffA);
            PG8_WAIT_L(8); PG8_BAR; PG8_WAIT_L(0); PG8_MMA(0, 0, At, B0); PG8_BAR; PG8_SCHED;
            PG8_LDB(B1, 1, 1); PG8_STAGE(PG8_SB(1, 0), b3, voffB);
            PG8_BAR; PG8_WAIT_L(0); PG8_MMA(0, 1, At, B1); PG8_BAR;
            PG8_LDA(At, 1, 1); PG8_STAGE(PG8_SA(1, 0), a3, voffA);
            PG8_BAR; PG8_WAIT_L(0); PG8_MMA(1, 0, At, B0); PG8_BAR; PG8_SCHED;
            PG8_STAGE(PG8_SB(1, 1), b3 + hstep, voffB);
            PG8_WAIT_V(6); PG8_BAR; PG8_MMA(1, 1, At, B1); PG8_BAR;
        }
        PG8_STAMP();
        if constexpr (!Epi::AFTER_DRAIN) { E(acc, cur, wr, wc, fr, fq); S.done(cur); }
        PG8_STAMP();
        if (!has_next) break;
#pragma unroll
        for (int a = 0; a < 2; ++a)
#pragma unroll
            for (int b = 0; b < 2; ++b)
#pragma unroll
                for (int m = 0; m < 4; ++m)
#pragma unroll
                    for (int n = 0; n < 2; ++n) acc[a][b][m][n] = (f32x4){0.f, 0.f, 0.f, 0.f};
        cur = nxt; cA = nA; cB = nB; ++ui;
    }
    PG8_WAIT_V(0);
    if (wr == 0) PG8_BAR;
    PG8_BAR;
    if constexpr (Epi::AFTER_DRAIN) { E.fused(acc, cur, wr, wc, fr, fq, lds, wid, lane); S.done(cur); }
    PG8_STAMP();
    if (STAMP && wid == 0) { stamps[lane] = lane < nts ? (((unsigned long long)(unsigned)ts_hi << 32) | (unsigned)ts_lo) : 0ull;
        if (lane == 62) stamps[62] = rt_entry; if (lane == 63) stamps[63] = (unsigned long long)wall_clock64(); }
#undef PG8_STAMP
#undef PG8_SA
#undef PG8_SB
#undef PG8_STAGE
#undef PG8_LDA
#undef PG8_LDB
#undef PG8_MMA
#undef PG8_WAIT_V
#undef PG8_WAIT_L
#undef PG8_BAR
#undef PG8_SCHED
}
}
namespace pg8 {
struct EpiBfG {
    static constexpr bool PERM = true, AFTER_DRAIN = false;
    bf16_t* O; int ldc, ncols, pn_mask;
    __device__ __forceinline__ void operator()(const f32x4 (&acc)[2][2][4][2], const Unit& u, int wr, int wc, int fr, int fq) const {
        const int row0 = u.pm * BM + wr * 64 + fr, col0 = (u.pn & pn_mask) * BM + wc * 32 + 8 * fq;
#pragma unroll
        for (int ai = 0; ai < 2; ++ai)
#pragma unroll
            for (int m = 0; m < 4; ++m) { bf16_t* rowp = O + (size_t)(row0 + ai * HALF + m * 16) * ldc;
#pragma unroll
                for (int bj = 0; bj < 2; ++bj) { const int c = col0 + bj * HALF;
                    if (c < ncols) { const f32x4 v0 = acc[ai][bj][m][0], v1 = acc[ai][bj][m][1];
                        u32x4 w; w.x = cvt_pk_bf16(v0[0], v0[1]); w.y = cvt_pk_bf16(v0[2], v0[3]); w.z = cvt_pk_bf16(v1[0], v1[1]); w.w = cvt_pk_bf16(v1[2], v1[3]);
                        *(u32x4*)(rowp + c) = w; } } }
    }
};
struct EpiSwi {
    static constexpr bool PERM = true, AFTER_DRAIN = false;
    bf16_t* H;
    __device__ __forceinline__ void operator()(const f32x4 (&acc)[2][2][4][2], const Unit& u, int wr, int wc, int fr, int fq) const {
        const int row0 = u.pm * BM + wr * 64 + fr, hc0 = (u.pn & 3) * HALF + wc * 32 + 8 * fq;
#pragma unroll
        for (int ai = 0; ai < 2; ++ai)
#pragma unroll
            for (int m = 0; m < 4; ++m) { bf16_t* rowp = H + (size_t)(row0 + ai * HALF + m * 16) * 512 + hc0;
                float o[8];
#pragma unroll
                for (int n = 0; n < 2; ++n)
#pragma unroll
                    for (int r = 0; r < 4; ++r) { const float g = acc[ai][0][m][n][r]; o[n * 4 + r] = g * __builtin_amdgcn_rcpf(1.0f + __expf(-g)) * acc[ai][1][m][n][r]; }
                u32x4 w; w.x = cvt_pk_bf16(o[0], o[1]); w.y = cvt_pk_bf16(o[2], o[3]); w.z = cvt_pk_bf16(o[4], o[5]); w.w = cvt_pk_bf16(o[6], o[7]);
                *(u32x4*)rowp = w; }
    }
};
struct MoeOrder {
    const int* slotmap; int ntiles, G, c;
    __device__ __forceinline__ bool next(int i, Unit& u) const {
        const int L = i * G + c; if (L >= ntiles * 4) return false;
        u.pm = L >> 2; u.pn = __builtin_amdgcn_readfirstlane(slotmap[L >> 2]) * 4 + (L & 3); return true;
    }
    __device__ __forceinline__ void a_ready(const Unit&) const {}
    __device__ __forceinline__ void done(const Unit&) const {}
};
}
#define WSP(T, off) as_global((T*)(kp.ws + (off)))
#define KIN(i) as_global(kp.in[i])
#define KOUT as_global(kp.out)

PHASE_FN void phase_mod(const KP& kp, unsigned char* lds) {
    float* sc = (float*)lds;
    float* red = sc + 17 * 1024;
    float* modv = WSP(float, WS_MODV);
    const int tid = otid();
    for (int i = tid; i < 17 * 1024; i += 512) { const int bb = i >> 10, k = i & 1023; const float c = bb < 16 ? KIN(1)[bb * 1024 + k] : KIN(3)[k]; sc[i] = siluf_(c); }
    __syncthreads();
    const int jc = tid & 63, ks = tid >> 6;
    for (int u = obid(); u < 192; u += gridDim.x) {
        const int l = u / 96, j0 = (u % 96) * 64;
        const float* w = KIN(4) + (size_t)l * 1024 * 6144 + j0 + jc;
        float acc[17];
#pragma unroll
        for (int bb = 0; bb < 17; ++bb) acc[bb] = 0.f;
        for (int k = ks * 128; k < ks * 128 + 128; ++k) {
            const float wv = w[(size_t)k * 6144];
#pragma unroll
            for (int bb = 0; bb < 17; ++bb) acc[bb] += sc[bb * 1024 + k] * wv;
        }
#pragma unroll
        for (int bb = 0; bb < 17; ++bb) red[(ks * 17 + bb) * 64 + jc] = acc[bb];
        __syncthreads();
        for (int i = tid; i < 17 * 64; i += 512) {
            const int bb = i >> 6, j = i & 63; float s = KIN(5)[l * 6144 + j0 + j];
#pragma unroll
            for (int k2 = 0; k2 < 8; ++k2) s += red[(k2 * 17 + bb) * 64 + j];
            modv[((size_t)l * 17 + bb) * 6144 + j0 + j] = s;
        }
        __syncthreads();
    }
}

struct CvJob { const float* src; bf16_t* dst; int N, ldd, mode, kt, ntile; };
__device__ __forceinline__ bool cv_pick(int& u, CvJob& J, const float* src, int K, int N, bf16_t* dst, int mode = 0, int ldd = -1) {
    const int ntl = (N + 63) >> 6, cnt = ntl * (K >> 6);
    if (u < cnt) { J.src = src; J.dst = dst; J.N = N; J.ldd = ldd < 0 ? K : ldd; J.mode = mode; J.kt = u / ntl; J.ntile = u % ntl; return true; }
    u -= cnt; return false;
}
__device__ __forceinline__ void cv_load(const CvJob& J, int tid, f32x4 (&r)[2]) {
#pragma unroll
    for (int i = 0; i < 2; ++i) { const int idx = tid + i * 512, k = idx >> 4, n0 = J.ntile * 64 + (idx & 15) * 4;
        r[i] = (n0 < J.N) ? *(const f32x4*)(J.src + (size_t)(J.kt * 64 + k) * J.N + n0) : (f32x4){0.f, 0.f, 0.f, 0.f}; }
}
__device__ __forceinline__ void cv_put(float* tile, int tid, const f32x4 (&r)[2]) {
#pragma unroll
    for (int i = 0; i < 2; ++i) { const int idx = tid + i * 512, k = idx >> 4, nq = (idx & 15) * 4;
        tile[k * 65 + nq] = r[i][0]; tile[k * 65 + nq + 1] = r[i][1]; tile[k * 65 + nq + 2] = r[i][2]; tile[k * 65 + nq + 3] = r[i][3]; }
}
__device__ __forceinline__ void cv_store(const float* tile, const CvJob& J, int tid) {
    const int nl = tid >> 3, k8 = tid & 7, n = J.ntile * 64 + nl;
    if (n < J.N) { int row = n; if (J.mode) row = (n >> 7) * 256 + (n & 127) + (J.mode == 2 ? 128 : 0);
        u32x4 w; const float* tp = tile + (k8 * 8) * 65 + nl;
        w.x = pack2(tp[0], tp[65]); w.y = pack2(tp[130], tp[195]); w.z = pack2(tp[260], tp[325]); w.w = pack2(tp[390], tp[455]);
        *(u32x4*)(J.dst + (size_t)row * J.ldd + J.kt * 64 + k8 * 8) = w; }
}
#define CV_RUN(total, PICK) do { float* tile = (float*)lds; const int tid = otid(); const int G_ = gridDim.x; int u_ = obid(); CvJob J, Jn; f32x4 r[2]; \
        if (u_ < (total)) { int u = u_; PICK(u, J); cv_load(J, tid, r); } \
        while (u_ < (total)) { cv_put(tile, tid, r); __syncthreads(); const int un_ = u_ + G_; \
            if (un_ < (total)) { int u = un_; PICK(u, Jn); cv_load(Jn, tid, r); } \
            cv_store(tile, J, tid); __syncthreads(); u_ = un_; J = Jn; } } while (0)
PHASE_FN void phase_conv_ab(const KP& kp, unsigned char* lds) {
#define PICK_AB(u, J) do { if (!cv_pick(u, J, KIN(7), 1024, AB_N, WSP(bf16_t, WS_WMIX + WM_AB_IN))) cv_pick(u, J, KIN(8), 2048, 1024, WSP(bf16_t, WS_WMIX + WM_AB_OUT)); } while (0)
    CV_RUN(16 * 85 + 32 * 16, PICK_AB);
#undef PICK_AB
}
PHASE_FN void phase_conv_cd(const KP& kp, unsigned char* lds) {
#define PICK_CD(u, J) do { if (cv_pick(u, J, KIN(18), 1024, CD_N, WSP(bf16_t, WS_WMIX + WM_CD_IN))) break; \
        if (cv_pick(u, J, KIN(19), 1536, 1024, WSP(bf16_t, WS_WMIX + WM_CD_OUT))) break; \
        if (cv_pick(u, J, KIN(21), 384, 768, WSP(bf16_t, WS_WMIX + WM_UQ))) break; \
        if (cv_pick(u, J, KIN(23), 256, 1024, WSP(bf16_t, WS_WMIX + WM_UKV))) break; \
        cv_pick(u, J, KIN(29), 128, 1024, WSP(bf16_t, WS_WMIX + WM_G2)); } while (0)
    CV_RUN(16 * 65 + 24 * 16 + 6 * 12 + 4 * 16 + 2 * 16, PICK_CD);
#undef PICK_CD
}
PHASE_FN void phase_conv_moe(const KP& kp, unsigned char* lds, int l) {
#define PICK_MOE(u0, J) do { const int es = (u0) / 384; int uu = (u0) % 384; \
        const float* wg = es < 16 ? KIN(36) + ((size_t)l * 16 + es) * 1024 * 512 : KIN(39) + (size_t)l * 1024 * 512; \
        const float* wu = es < 16 ? KIN(37) + ((size_t)l * 16 + es) * 1024 * 512 : KIN(40) + (size_t)l * 1024 * 512; \
        const float* wd = es < 16 ? KIN(38) + ((size_t)l * 16 + es) * 512 * 1024 : KIN(41) + (size_t)l * 512 * 1024; \
        bf16_t* dup = WSP(bf16_t, WS_BIG + MO_WUP) + (size_t)es * 1024 * 1024; bf16_t* ddn = WSP(bf16_t, WS_BIG + MO_WDN) + (size_t)es * 1024 * 512; \
        if (cv_pick(uu, J, wg, 1024, 512, dup, 1, 1024)) break; if (cv_pick(uu, J, wu, 1024, 512, dup, 2, 1024)) break; cv_pick(uu, J, wd, 512, 1024, ddn, 0, 512); } while (0)
    CV_RUN(17 * 384, PICK_MOE);
#undef PICK_MOE
}

__device__ __forceinline__ const float* hrow_rd(const KP& kp, bool from_inputs, int b, int t) {
    if (t < CTXL) return (from_inputs ? KIN(2) : WSP(const float, WS_HC)) + ((size_t)b * CTXL + t) * D;
    return (from_inputs ? KIN(0) : KOUT) + ((size_t)b * SEQ + (t - CTXL)) * D;
}
__device__ __forceinline__ float* hrow_wr(const KP& kp, int b, int t) {
    if (t < CTXL) return WSP(float, WS_HC) + ((size_t)b * CTXL + t) * D;
    return KOUT + ((size_t)b * SEQ + (t - CTXL)) * D;
}

PHASE_FN void phase_u(const KP& kp, int layer, int g) {
    const int lane = otid() & 63, wid = __builtin_amdgcn_readfirstlane(otid() >> 6);
    const float* modv = WSP(const float, WS_MODV) + (size_t)layer * 17 * 6144;
    const float* ng = KIN(6) + (size_t)layer * 4 * 1024;
    bf16_t* U = WSP(bf16_t, WS_BIG + (layer == 0 ? L0_U : L1_U));
    for (int lr = obid() * 8 + wid; lr < RG; lr += gridDim.x * 8) {
        const int bl = lr / TT, t = lr - bl * TT, b = g * BG + bl;
        const float* src = hrow_rd(kp, layer == 0, b, t);
        const float* mv = modv + (size_t)(t < CTXL ? 16 : b) * 6144;
        f32x4 x[4]; float ss = 0.f;
#pragma unroll
        for (int i = 0; i < 4; ++i) { x[i] = *(const f32x4*)(src + i * 256 + lane * 4); ss += x[i][0] * x[i][0] + x[i][1] * x[i][1] + x[i][2] * x[i][2] + x[i][3] * x[i][3]; }
        ss = wsum(ss); const float rstd = rsqrtf(ss * (1.0f / 1024.0f) + EPS);
#pragma unroll
        for (int i = 0; i < 4; ++i) { const int col = i * 256 + lane * 4;
            const f32x4 gv = *(const f32x4*)(ng + col), sc = *(const f32x4*)(mv + 1024 + col), sh = *(const f32x4*)(mv + col);
            st4bf(U + (size_t)lr * 1024 + col, x[i] * rstd * gv * (sc + 1.0f) + sh); }
    }
}

PHASE_FN void phase_r(const KP& kp, unsigned char* lds, int layer, int g) {
    const int tid = otid(), lane = tid & 63, wid = __builtin_amdgcn_readfirstlane(tid >> 6);
    float* rw = (float*)lds;
    int* se = (int*)(rw + 1024 * 16);
    int* sbase = se + 160;
    for (int i = tid; i < 1024 * 16; i += 512) rw[i] = KIN(34)[i];
    __syncthreads();
    const float* modv = WSP(const float, WS_MODV) + (size_t)layer * 17 * 6144;
    const float* ng = KIN(6) + (size_t)layer * 4 * 1024;
    const bf16_t* MIX = WSP(const bf16_t, WS_BIG + (layer == 0 ? L0_U : L1_U));
    bf16_t* V = WSP(bf16_t, WS_V);
    unsigned* cnt = WSP(unsigned, CTL_CNT) + layer * 16;
    int* TOKE = WSP(int, WS_TOKE); int* TOKP = WSP(int, WS_TOKP); float* TOKW = WSP(float, WS_TOKW); int* LIST = WSP(int, WS_LIST);
    const int nrows = layer == 0 ? RG : RGL, CH = layer == 0 ? 72 : 64, RW = CH >> 3, nchunks = nrows / CH;
    float rbias[16];
#pragma unroll
    for (int e = 0; e < 16; ++e) rbias[e] = KIN(35)[e];
    for (int ch = obid(); ch < nchunks; ch += gridDim.x) {
        for (int rr = 0; rr < RW; ++rr) {
            const int rl = wid * RW + rr, lr = ch * CH + rl;
            int b, t, tok;
            if (layer == 0) { const int bl = lr / TT; t = lr - bl * TT; b = g * BG + bl; tok = g * RG + lr; }
            else { const int bl = lr >> 11; t = CTXL + (lr & 2047); b = g * BG + bl; tok = g * RGL + lr; }
            const float* hsrc = hrow_rd(kp, layer == 0, b, t);
            float* hdst = hrow_wr(kp, b, t);
            const float* mv = modv + (size_t)(t < CTXL ? 16 : b) * 6144;
            f32x4 y[4], h[4]; float ss = 0.f;
#pragma unroll
            for (int i = 0; i < 4; ++i) { y[i] = ld4bf(MIX + (size_t)lr * 1024 + i * 256 + lane * 4); ss += y[i][0] * y[i][0] + y[i][1] * y[i][1] + y[i][2] * y[i][2] + y[i][3] * y[i][3]; }
            ss = wsum(ss); float rstd = rsqrtf(ss * (1.0f / 1024.0f) + EPS);
            float s2 = 0.f;
#pragma unroll
            for (int i = 0; i < 4; ++i) { const int col = i * 256 + lane * 4;
                const f32x4 g1 = *(const f32x4*)(ng + 1024 + col), ga = *(const f32x4*)(mv + 2048 + col), hx = *(const f32x4*)(hsrc + col);
                h[i] = hx + ga * (y[i] * rstd * g1);
                *(f32x4*)(hdst + col) = h[i];
                s2 += h[i][0] * h[i][0] + h[i][1] * h[i][1] + h[i][2] * h[i][2] + h[i][3] * h[i][3]; }
            s2 = wsum(s2); rstd = rsqrtf(s2 * (1.0f / 1024.0f) + EPS);
            float lg[16];
#pragma unroll
            for (int e = 0; e < 16; ++e) lg[e] = 0.f;
#pragma unroll
            for (int i = 0; i < 4; ++i) { const int col = i * 256 + lane * 4;
                const f32x4 g2 = *(const f32x4*)(ng + 2048 + col), scf = *(const f32x4*)(mv + 4096 + col), shf = *(const f32x4*)(mv + 3072 + col);
                const f32x4 v = h[i] * rstd * g2 * (scf + 1.0f) + shf;
                st4bf(V + (size_t)tok * 1024 + col, v);
#pragma unroll
                for (int j = 0; j < 4; ++j) {
#pragma unroll
                    for (int q = 0; q < 4; ++q) { const f32x4 w4 = *(const f32x4*)(rw + (col + j) * 16 + q * 4);
                        lg[q * 4 + 0] += v[j] * w4[0]; lg[q * 4 + 1] += v[j] * w4[1]; lg[q * 4 + 2] += v[j] * w4[2]; lg[q * 4 + 3] += v[j] * w4[3]; } } }
#pragma unroll
            for (int e = 0; e < 16; ++e) lg[e] = wsum(lg[e]);
            float aff[16], sel[16];
#pragma unroll
            for (int e = 0; e < 16; ++e) { aff[e] = sigmoidf_(lg[e]); sel[e] = aff[e] + rbias[e]; }
            float gs[4];
#pragma unroll
            for (int gi = 0; gi < 4; ++gi) { const float a0 = sel[gi * 4], a1 = sel[gi * 4 + 1], a2 = sel[gi * 4 + 2], a3 = sel[gi * 4 + 3];
                gs[gi] = fmaxf(fmaxf(fmaxf(a0 + a1, a0 + a2), fmaxf(a0 + a3, a1 + a2)), fmaxf(a1 + a3, a2 + a3)); }
            int gidx = 0; float gb = gs[0];
#pragma unroll
            for (int gi = 1; gi < 4; ++gi) if (gs[gi] > gb) { gb = gs[gi]; gidx = gi; }
            float c[4], f[4];
#pragma unroll
            for (int i = 0; i < 4; ++i) { c[i] = gidx == 0 ? sel[i] : gidx == 1 ? sel[4 + i] : gidx == 2 ? sel[8 + i] : sel[12 + i];
                                           f[i] = gidx == 0 ? aff[i] : gidx == 1 ? aff[4 + i] : gidx == 2 ? aff[8 + i] : aff[12 + i]; }
            int i1 = 0; float cb = c[0];
#pragma unroll
            for (int i = 1; i < 4; ++i) if (c[i] > cb) { cb = c[i]; i1 = i; }
            int i2 = -1; float cb2 = 0.f;
#pragma unroll
            for (int i = 0; i < 4; ++i) if (i != i1 && (i2 < 0 || c[i] > cb2)) { cb2 = c[i]; i2 = i; }
            float w1 = i1 == 0 ? f[0] : i1 == 1 ? f[1] : i1 == 2 ? f[2] : f[3];
            float w2 = i2 == 0 ? f[0] : i2 == 1 ? f[1] : i2 == 2 ? f[2] : f[3];
            const float wsn = 1.0f / (w1 + w2); w1 *= wsn; w2 *= wsn;
            if (lane == 0) { se[rl * 2] = gidx * 4 + i1; se[rl * 2 + 1] = gidx * 4 + i2;
                TOKE[tok * 2] = gidx * 4 + i1; TOKE[tok * 2 + 1] = gidx * 4 + i2; TOKW[tok * 2] = w1; TOKW[tok * 2 + 1] = w2; }
        }
        __syncthreads();
        if (tid < 16) { int c2 = 0; for (int i = 0; i < 2 * CH; ++i) c2 += (se[i] == tid) ? 1 : 0; sbase[tid] = (int)atomicAdd(&cnt[tid], (unsigned)c2); }
        __syncthreads();
        if (tid < 2 * CH) { const int e = se[tid]; int rank = 0; for (int j = 0; j < tid; ++j) rank += (se[j] == e) ? 1 : 0;
            const int pos = sbase[e] + rank; const int lr = ch * CH + (tid >> 1); const int tok = (layer == 0 ? g * RG : g * RGL) + lr;
            LIST[(size_t)e * NTOK + pos] = tok; TOKP[tok * 2 + (tid & 1)] = pos; }
        __syncthreads();
    }
}

__device__ __forceinline__ int moe_tile_prefix(const unsigned* cnt, int ntok, int lane) {
    const int myt = lane < 16 ? (int)((cnt[lane & 15] + 255u) >> 8) : 0; int pref = myt;
#pragma unroll
    for (int o = 1; o < 16; o <<= 1) { const int t = __shfl_up(pref, o); if (lane >= o) pref += t; }
    return pref - myt + ntok / 256;
}
PHASE_FN void phase_moe_gather(const KP& kp, int layer) {
    const int lane = otid() & 63, wid = __builtin_amdgcn_readfirstlane(otid() >> 6);
    const int ntok = layer == 0 ? NTOK : NLAT;
    const int tpre = moe_tile_prefix(WSP(const unsigned, CTL_CNT) + layer * 16, ntok, lane);
    const bf16_t* V = WSP(const bf16_t, WS_V); bf16_t* XG = WSP(bf16_t, WS_BIG + MO_XG);
    const int* TOKE = WSP(const int, WS_TOKE); const int* TOKP = WSP(const int, WS_TOKP);
    for (int it = obid() * 8 + wid; it < 2 * ntok; it += gridDim.x * 8) {
        const int tok = it >> 1, e = TOKE[it], pos = TOKP[it];
        const size_t row = (size_t)(__shfl(tpre, e) - ntok / 256) * 256 + pos;
        const u32x4* src = (const u32x4*)(V + (size_t)tok * 1024) + lane * 2; u32x4* dst = (u32x4*)(XG + row * 1024) + lane * 2;
        const u32x4 a = src[0], b2 = src[1]; dst[0] = a; dst[1] = b2;
    }
}
PHASE_FN void phase_moe_gemm(const KP& kp, unsigned char* lds, int layer, bool down) {
    const int tid = otid();
    int* pre = (int*)(lds + pg8::STAGE_BYTES);
    int* slotmap = pre + 32;
    const int ntok = layer == 0 ? NTOK : NLAT;
    const unsigned* cnt = WSP(const unsigned, CTL_CNT) + layer * 16;
    if (tid == 0) { int p = ntok / 256; pre[0] = 0; pre[1] = p; for (int e = 0; e < 16; ++e) { p += ((int)cnt[e] + 255) >> 8; pre[2 + e] = p; } }
    __syncthreads();
    const int ntiles = pre[17];
    for (int t = tid; t < ntiles; t += 512) { int idx = 0; for (int e = 1; e < 17; ++e) if (pre[e] <= t) idx = e; slotmap[t] = idx == 0 ? 16 : idx - 1; }
    __syncthreads();
    pg8::MoeOrder S{slotmap, ntiles, (int)gridDim.x, obid()};
    if (!down) {
        pg8::Gemm g{WSP(const bf16_t, WS_V), WSP(const bf16_t, WS_BIG + MO_WUP), 0, 0, 1024, WSP(const bf16_t, WS_BIG + MO_XG), ntok / 256};
        pg8::EpiSwi E{WSP(bf16_t, WS_BIG + MO_HID)};
        pg8::gemm_phase<pg8::EpiSwi, pg8::MoeOrder, false>((PG8_LAS unsigned char*)lds, g, S, E, nullptr);
    } else {
        pg8::Gemm g{WSP(const bf16_t, WS_BIG + MO_HID), WSP(const bf16_t, WS_BIG + MO_WDN), 0, 0, 512, nullptr, 0x7fffffff};
        pg8::EpiBfG E{WSP(bf16_t, WS_BIG + MO_CON), 1024, 1024, 3};
        pg8::gemm_phase<pg8::EpiBfG, pg8::MoeOrder, false>((PG8_LAS unsigned char*)lds, g, S, E, nullptr);
    }
    __syncthreads();
}

PHASE_FN void phase_combine(const KP& kp, int layer) {
    const int lane = otid() & 63, wid = __builtin_amdgcn_readfirstlane(otid() >> 6);
    const int ntok = layer == 0 ? NTOK : NLAT;
    const unsigned* cnt = WSP(const unsigned, CTL_CNT) + layer * 16;
    const float* modv = WSP(const float, WS_MODV) + (size_t)layer * 17 * 6144;
    const float* ng = KIN(6) + (size_t)layer * 4 * 1024 + 3 * 1024;
    const bf16_t* CON = WSP(const bf16_t, WS_BIG + MO_CON);
    const int* TOKE = WSP(const int, WS_TOKE); const int* TOKP = WSP(const int, WS_TOKP); const float* TOKW = WSP(const float, WS_TOKW);
    const int tpre = moe_tile_prefix(cnt, ntok, lane);
    for (int tok0 = (obid() * 8 + wid) * 2; tok0 < ntok; tok0 += gridDim.x * 16) {
        int e1[2], e2[2], p1[2], p2[2]; float w1[2], w2[2];
#pragma unroll
        for (int u = 0; u < 2; ++u) { const int tok = tok0 + u; e1[u] = TOKE[tok * 2]; e2[u] = TOKE[tok * 2 + 1]; p1[u] = TOKP[tok * 2]; p2[u] = TOKP[tok * 2 + 1]; w1[u] = TOKW[tok * 2]; w2[u] = TOKW[tok * 2 + 1]; }
        f32x4 f[2][4], hx[2][4]; float* hp[2]; const float* mv[2];
#pragma unroll
        for (int u = 0; u < 2; ++u) { const int tok = tok0 + u;
            const size_t r1 = (size_t)__shfl(tpre, e1[u]) * 256 + p1[u], r2 = (size_t)__shfl(tpre, e2[u]) * 256 + p2[u];
            int b, t;
            if (layer == 0) { b = tok / TT; t = tok - b * TT; } else { b = tok >> 11; t = CTXL + (tok & 2047); }
            hp[u] = hrow_wr(kp, b, t); mv[u] = modv + (size_t)(t < CTXL ? 16 : b) * 6144 + 5 * 1024;
#pragma unroll
            for (int i = 0; i < 4; ++i) { const int col = i * 256 + lane * 4;
                f[u][i] = ld4bf(CON + (size_t)tok * 1024 + col) + ld4bf(CON + r1 * 1024 + col) * w1[u] + ld4bf(CON + r2 * 1024 + col) * w2[u];
                hx[u][i] = *(const f32x4*)(hp[u] + col); } }
#pragma unroll
        for (int u = 0; u < 2; ++u) { float ss = 0.f;
#pragma unroll
            for (int i = 0; i < 4; ++i) ss += f[u][i][0] * f[u][i][0] + f[u][i][1] * f[u][i][1] + f[u][i][2] * f[u][i][2] + f[u][i][3] * f[u][i][3];
            ss = wsum(ss); const float rstd = rsqrtf(ss * (1.0f / 1024.0f) + EPS);
            float s2 = 0.f;
#pragma unroll
            for (int i = 0; i < 4; ++i) { const int col = i * 256 + lane * 4;
                const f32x4 g3 = *(const f32x4*)(ng + col), gf = *(const f32x4*)(mv[u] + col);
                const f32x4 hn = hx[u][i] + gf * (f[u][i] * rstd * g3);
                *(f32x4*)(hp[u] + col) = hn; hx[u][i] = hn;
                s2 += hn[0] * hn[0] + hn[1] * hn[1] + hn[2] * hn[2] + hn[3] * hn[3]; }
            if (layer == 0) {
                s2 = wsum(s2); const float rs2 = rsqrtf(s2 * (1.0f / 1024.0f) + EPS);
                const float* mv1 = mv[u] - 5 * 1024 + 17 * 6144;
                const float* ng1 = KIN(6) + 4 * 1024;
                bf16_t* U1 = WSP(bf16_t, WS_V) + (size_t)(tok0 + u) * 1024;
#pragma unroll
                for (int i = 0; i < 4; ++i) { const int col = i * 256 + lane * 4;
                    const f32x4 gv = *(const f32x4*)(ng1 + col), sc = *(const f32x4*)(mv1 + 1024 + col), sh = *(const f32x4*)(mv1 + col);
                    st4bf(U1 + col, hx[u][i] * rs2 * gv * (sc + 1.0f) + sh); } } }
    }
}

template <int CH>
__device__ __forceinline__ int scan_t(int dir, int ci, int j) {
    constexpr int NC_CTX = CTXL / CH;
    if (!dir) return ci * CH + j;
    return ci < NC_CTX ? (CTXL - 1 - ci * CH - j) : (TT - 1 - (ci - NC_CTX) * CH - j);
}

constexpr int ML_LQ = 136, ML_LT = 72, ML_VR = 144;
PHASE_FN void mlstm_unit(const KP& kp, unsigned char* lds, int bl, int h, int dir, int vh) {
    const int tid = otid();
    bf16_t* Qs = (bf16_t*)lds;
    bf16_t* Ks = Qs + 64 * ML_LQ;
    bf16_t* KTE = Ks + 64 * ML_LQ;
    bf16_t* VT = KTE + 128 * ML_LT;
    bf16_t* Ps = VT + ML_VR * ML_LT;
    bf16_t* Cb = Ps + 64 * ML_LT;
    float* fs = (float*)(Cb + ML_VR * ML_LQ);
    float* s_rowv = fs;
    float* s_colv = fs + 64;
    float* s_wint = fs + 128;
    float* s_emj = fs + 192;
    float* s_E = fs + 256;
    float* s_den = fs + 320;
    float* s_misc = fs + 384;
    const bf16_t* P = WSP(const bf16_t, WS_BIG + L0_P);
    bf16_t* HOUT = WSP(bf16_t, WS_BIG + (dir ? L0_HB : L0_AO)); const int ldh = dir ? 1024 : 2048;
    const float ibias = KIN(9)[dir * 4 + h], fbias = KIN(10)[dir * 4 + h];
    for (int i = tid; i < ML_VR * ML_LQ; i += 512) Cb[i] = 0;
    for (int i = tid; i < 16 * ML_LT; i += 512) VT[128 * ML_LT + i] = (i < ML_LT) ? (bf16_t)0x3f80 : (bf16_t)0;
    f32x4 Cacc[8], Nacc;
#pragma unroll
    for (int i = 0; i < 8; ++i) Cacc[i] = (f32x4){0.f, 0.f, 0.f, 0.f};
    Nacc = (f32x4){0.f, 0.f, 0.f, 0.f};
    float m_state = 0.f;
    u32x4 pq[2], pk[2], pv[2]; bf16_t pgi = 0, pgf = 0;
#define ML_REQ(ci_) do { _Pragma("unroll") for (int i = 0; i < 2; ++i) { const int p = tid + i * 512, j = p >> 4, c8 = p & 15; \
            const bf16_t* pr = P + ((size_t)bl * TT + scan_t<64>(dir, (ci_), j)) * AB_N; \
            pq[i] = *(const u32x4*)(pr + AB_Q + h * 128 + c8 * 8); pk[i] = *(const u32x4*)(pr + AB_K + h * 128 + c8 * 8); \
            const int jv = tid & 63, cv = (tid >> 6) + i * 8; \
            pv[i] = *(const u32x4*)(P + ((size_t)bl * TT + scan_t<64>(dir, (ci_), jv)) * AB_N + AB_V + h * 256 + vh * 128 + cv * 8); } \
        if (tid < 64) { const bf16_t* pg = P + ((size_t)bl * TT + scan_t<64>(dir, (ci_), tid)) * AB_N; pgi = pg[AB_IG + dir * 4 + h]; pgf = pg[AB_FG + dir * 4 + h]; } } while (0)
    ML_REQ(0);
    lds_barrier();
    for (int ci = 0; ci < TT / 64; ++ci) {
        int tq = tid; asm volatile("" : "+v"(tq));
        const int lane = tq & 63, wid = __builtin_amdgcn_readfirstlane(tq >> 6), fr = lane & 15, fq = lane >> 4;
#pragma unroll
        for (int i = 0; i < 2; ++i) {
            const int p = tq + i * 512, j = p >> 4, c8 = p & 15;
            u32x4 q = pq[i];
            const float qs = 0.08838834764831845f;
            q.x = pack2(lo2f(q.x) * qs, hi2f(q.x) * qs); q.y = pack2(lo2f(q.y) * qs, hi2f(q.y) * qs);
            q.z = pack2(lo2f(q.z) * qs, hi2f(q.z) * qs); q.w = pack2(lo2f(q.w) * qs, hi2f(q.w) * qs);
            *(u32x4*)(Qs + j * ML_LQ + c8 * 8) = q;
            *(u32x4*)(Ks + j * ML_LQ + c8 * 8) = pk[i];
            const u32x4 v = pv[i];
            bf16_t* vt = VT + (((tq >> 6) + i * 8) * 8) * ML_LT + (tq & 63);
            vt[0 * ML_LT] = (bf16_t)(v.x & 0xffff); vt[1 * ML_LT] = (bf16_t)(v.x >> 16); vt[2 * ML_LT] = (bf16_t)(v.y & 0xffff); vt[3 * ML_LT] = (bf16_t)(v.y >> 16);
            vt[4 * ML_LT] = (bf16_t)(v.z & 0xffff); vt[5 * ML_LT] = (bf16_t)(v.z >> 16); vt[6 * ML_LT] = (bf16_t)(v.w & 0xffff); vt[7 * ML_LT] = (bf16_t)(v.w >> 16);
        }
        if (wid == 0) {
            const float ig = bf2f(pgi) + ibias;
            const float lf = logsigmoidf_(bf2f(pgf) + fbias);
            float b = lf;
#pragma unroll
            for (int o = 1; o < 64; o <<= 1) { const float t = __shfl_up(b, o); if (lane >= o) b += t; }
            const float u = ig - b; float pm = u;
#pragma unroll
            for (int o = 1; o < 64; o <<= 1) { const float t = __shfl_up(pm, o); if (lane >= o) pm = fmaxf(pm, t); }
            const float mj = fmaxf(b + m_state, b + pm);
            const float b63 = __shfl(b, 63), pm63 = __shfl(pm, 63);
            const float mnew = fmaxf(b63 + m_state, b63 + pm63);
            s_rowv[lane] = b - mj; s_colv[lane] = u; s_wint[lane] = __expf(b + m_state - mj); s_emj[lane] = __expf(-mj);
            s_E[lane] = __expf(b63 + u - mnew);
            if (lane == 0) { s_misc[0] = mnew; s_misc[1] = __expf(b63 + m_state - mnew); }
        }
        if (ci + 1 < TT / 64) ML_REQ(ci + 1);
        lds_barrier();
        {
            const int jt = wid >> 1;
#pragma unroll
            for (int q2 = 0; q2 < 2; ++q2) {
                const int st = (wid & 1) * 2 + q2;
                f32x4 acc = (f32x4){0.f, 0.f, 0.f, 0.f};
                if (st <= jt) {
                    bf16x8 fa[4], fb[4];
#pragma unroll
                    for (int k = 0; k < 4; ++k) { fa[k] = ldfrag(Qs, ML_LQ, jt * 16, k * 32, fr, fq); fb[k] = ldfrag(Ks, ML_LQ, st * 16, k * 32, fr, fq); }
                    __builtin_amdgcn_sched_barrier(0);
                    f32x4 acc2 = (f32x4){0.f, 0.f, 0.f, 0.f};
                    acc = mma16(fa[0], fb[0], acc); acc2 = mma16(fa[1], fb[1], acc2); acc = mma16(fa[2], fb[2], acc); acc2 = mma16(fa[3], fb[3], acc2);
                    acc = acc + acc2;
                }
                const int s = st * 16 + fr; const float cv = s_colv[s];
#pragma unroll
                for (int r = 0; r < 4; ++r) { const int j = jt * 16 + fq * 4 + r;
                    const float pv2 = (s <= j) ? acc[r] * __expf(s_rowv[j] + cv) : 0.f;
                    Ps[j * ML_LT + s] = f2bf(pv2); }
            }
#pragma unroll
            for (int i = 0; i < 2; ++i) {
                const int s = lane, c8 = wid + i * 8; const float e = s_E[s];
                const u32x4 kv = *(const u32x4*)(Ks + s * ML_LQ + c8 * 8);
                bf16_t* kt = KTE + (c8 * 8) * ML_LT + s;
                kt[0 * ML_LT] = f2bf(lo2f(kv.x) * e); kt[1 * ML_LT] = f2bf(hi2f(kv.x) * e); kt[2 * ML_LT] = f2bf(lo2f(kv.y) * e); kt[3 * ML_LT] = f2bf(hi2f(kv.y) * e);
                kt[4 * ML_LT] = f2bf(lo2f(kv.z) * e); kt[5 * ML_LT] = f2bf(hi2f(kv.z) * e); kt[6 * ML_LT] = f2bf(lo2f(kv.w) * e); kt[7 * ML_LT] = f2bf(hi2f(kv.w) * e);
            }
        }
        lds_barrier();
        f32x4 a1[4], a2[4];
        {
            const int jt = wid >> 1;
            bf16x8 fp[2], fqq[4];
#pragma unroll
            for (int k = 0; k < 2; ++k) fp[k] = ldfrag(Ps, ML_LT, jt * 16, k * 32, fr, fq);
#pragma unroll
            for (int k = 0; k < 4; ++k) fqq[k] = ldfrag(Qs, ML_LQ, jt * 16, k * 32, fr, fq);
            {
                bf16x8 fv[4][2];
#pragma unroll
                for (int q4 = 0; q4 < 4; ++q4)
#pragma unroll
                    for (int k = 0; k < 2; ++k) fv[q4][k] = ldfrag(VT, ML_LT, ((wid & 1) * 4 + q4) * 16, k * 32, fr, fq);
                __builtin_amdgcn_sched_barrier(0);
#pragma unroll
                for (int q4 = 0; q4 < 4; ++q4) a1[q4] = (f32x4){0.f, 0.f, 0.f, 0.f};
#pragma unroll
                for (int k = 0; k < 2; ++k)
#pragma unroll
                    for (int q4 = 0; q4 < 4; ++q4) a1[q4] = mma16(fv[q4][k], fp[k], a1[q4]);
            }
#pragma unroll
            for (int hh = 0; hh < 2; ++hh) {
                bf16x8 fc[2][4];
#pragma unroll
                for (int q2 = 0; q2 < 2; ++q2)
#pragma unroll
                    for (int k = 0; k < 4; ++k) fc[q2][k] = ldfrag(Cb, ML_LQ, ((wid & 1) * 4 + hh * 2 + q2) * 16, k * 32, fr, fq);
                __builtin_amdgcn_sched_barrier(0);
                a2[hh * 2] = (f32x4){0.f, 0.f, 0.f, 0.f}; a2[hh * 2 + 1] = (f32x4){0.f, 0.f, 0.f, 0.f};
#pragma unroll
                for (int k = 0; k < 4; ++k) { a2[hh * 2] = mma16(fc[0][k], fqq[k], a2[hh * 2]); a2[hh * 2 + 1] = mma16(fc[1][k], fqq[k], a2[hh * 2 + 1]); }
            }
            if (wid & 1) {
                f32x4 d1 = (f32x4){0.f, 0.f, 0.f, 0.f}, d2 = (f32x4){0.f, 0.f, 0.f, 0.f};
                bf16x8 fo[2], fn[4];
#pragma unroll
                for (int k = 0; k < 2; ++k) fo[k] = ldfrag(VT, ML_LT, 128, k * 32, fr, fq);
#pragma unroll
                for (int k = 0; k < 4; ++k) fn[k] = ldfrag(Cb, ML_LQ, 128, k * 32, fr, fq);
                __builtin_amdgcn_sched_barrier(0);
                d1 = mma16(fo[0], fp[0], d1); d2 = mma16(fn[0], fqq[0], d2); d1 = mma16(fo[1], fp[1], d1); d2 = mma16(fn[1], fqq[1], d2);
                d2 = mma16(fn[2], fqq[2], d2); d2 = mma16(fn[3], fqq[3], d2);
                if (fq == 0) { const int j = jt * 16 + fr; s_den[j] = fmaxf(fabsf(d1[0] + s_wint[j] * d2[0]), s_emj[j]); }
            }
        }
        lds_barrier();
        {
            const int jt = wid >> 1, j = jt * 16 + fr;
            const float wi = s_wint[j], rden = frcp_(s_den[j]);
            const size_t row = (size_t)bl * TT + scan_t<64>(dir, ci, j);
#pragma unroll
            for (int q4 = 0; q4 < 4; ++q4) { const int v0 = ((wid & 1) * 4 + q4) * 16 + fq * 4;
                st4bf(HOUT + row * ldh + h * 256 + vh * 128 + v0, (a1[q4] + a2[q4] * wi) * rden); }
        }
        {
            const float dec = s_misc[1];
            const bf16x8 bv0 = ldfrag(VT, ML_LT, wid * 16, 0, fr, fq), bv1 = ldfrag(VT, ML_LT, wid * 16, 32, fr, fq);
#pragma unroll
            for (int hh = 0; hh < 2; ++hh) {
                bf16x8 fk[4][2];
#pragma unroll
                for (int q = 0; q < 4; ++q) { fk[q][0] = ldfrag(KTE, ML_LT, (hh * 4 + q) * 16, 0, fr, fq); fk[q][1] = ldfrag(KTE, ML_LT, (hh * 4 + q) * 16, 32, fr, fq); }
                __builtin_amdgcn_sched_barrier(0);
#pragma unroll
                for (int q = 0; q < 4; ++q) Cacc[hh * 4 + q] = Cacc[hh * 4 + q] * dec;
#pragma unroll
                for (int q = 0; q < 4; ++q) Cacc[hh * 4 + q] = mma16(fk[q][0], bv0, Cacc[hh * 4 + q]);
#pragma unroll
                for (int q = 0; q < 4; ++q) Cacc[hh * 4 + q] = mma16(fk[q][1], bv1, Cacc[hh * 4 + q]);
#pragma unroll
                for (int q = 0; q < 4; ++q) st4bf(Cb + (wid * 16 + fr) * ML_LQ + (hh * 4 + q) * 16 + fq * 4, Cacc[hh * 4 + q]);
            }
            Nacc = Nacc * dec;
            Nacc = mma16(ldfrag(KTE, ML_LT, wid * 16, 0, fr, fq), ldfrag(VT, ML_LT, 128, 0, fr, fq), Nacc);
            Nacc = mma16(ldfrag(KTE, ML_LT, wid * 16, 32, fr, fq), ldfrag(VT, ML_LT, 128, 32, fr, fq), Nacc);
            st4bf(Cb + (128 + fr) * ML_LQ + wid * 16 + fq * 4, Nacc);
            m_state = s_misc[0];
        }
        lds_barrier();
    }
#undef ML_REQ
}

constexpr size_t L0_XC = L0_U;
static_assert(L0_XC + (size_t)RG * 1280 * 2 <= BIG_BYTES, "xconv buffer");
PHASE_FN void phase_xconv(const KP& kp) {
    const int lane = otid() & 63, wid = __builtin_amdgcn_readfirstlane(otid() >> 6);
    const bf16_t* P = WSP(const bf16_t, WS_BIG + L0_P); bf16_t* XC = WSP(bf16_t, WS_BIG + L0_XC);
    const float* cw = KIN(12); const float* cb = KIN(13);
    constexpr int RUN = 9;
    for (int run = obid() * 8 + wid; run < RG / RUN; run += gridDim.x * 8) {
        const int r0 = run * RUN;
#pragma unroll
        for (int i = 0; i < 5; ++i) { const int col = i * 256 + lane * 4;
            const f32x4 bias = *(const f32x4*)(cb + col);
            f32x4 w[5], x[5];
#pragma unroll
            for (int q = 0; q < 5; ++q) w[q] = *(const f32x4*)(cw + q * 1280 + col);
#pragma unroll
            for (int q = 0; q < 4; ++q) { const int rr = r0 - 2 + q; x[q + 1] = (rr >= 0 && rr < RG) ? ld4bf(P + (size_t)rr * AB_N + AB_XBC + col) : (f32x4){0.f, 0.f, 0.f, 0.f}; }
#pragma unroll
            for (int k = 0; k < RUN; ++k) {
                const int lr = r0 + k, bl = lr / TT, t = lr - bl * TT, lo = t < CTXL ? 0 : CTXL, hi = t < CTXL ? CTXL : TT;
#pragma unroll
                for (int q = 0; q < 4; ++q) x[q] = x[q + 1];
                { const int rr = lr + 2; x[4] = (rr < RG) ? ld4bf(P + (size_t)rr * AB_N + AB_XBC + col) : (f32x4){0.f, 0.f, 0.f, 0.f}; }
                f32x4 a = bias;
#pragma unroll
                for (int q = 0; q < 5; ++q) { const int tt = t - 2 + q; if (tt >= lo && tt < hi) a += w[q] * x[q]; }
                f32x4 o;
#pragma unroll
                for (int r = 0; r < 4; ++r) o[r] = siluf_(a[r]);
                st4bf(XC + (size_t)lr * 1280 + col, o);
            }
        }
    }
}

constexpr int SS_LT = 72, SS_LX = 136;
PHASE_FN void ssd_unit(const KP& kp, unsigned char* lds, int bl, int dir, int hp) {
    const int tid = otid();
    const int gi = hp >> 2, hh0 = hp * 2;
    bf16_t* Wm = (bf16_t*)lds;
    bf16_t* CM = Wm + 2 * 64 * SS_LT;
    bf16_t* BM = CM + 64 * SS_LT;
    bf16_t* Xn = BM + 64 * SS_LT;
    bf16_t* XT = Xn + 64 * SS_LX;
    bf16_t* BTE = XT + 2 * 64 * SS_LT;
    bf16_t* Sb = BTE + 2 * 64 * SS_LT;
    float* fs = (float*)(Sb + 2 * 64 * SS_LT);
    float* s_b = fs;
    float* s_dt = fs + 128;
    float* s_e = fs + 256;
    float* s_misc = fs + 384;
    const bf16_t* P = WSP(const bf16_t, WS_BIG + L0_P); const bf16_t* XC = WSP(const bf16_t, WS_BIG + L0_XC);
    bf16_t* YOUT = WSP(bf16_t, WS_BIG + (dir ? L0_YB : L0_AO + 2048)); const int ldy = dir ? 1024 : 2048;
    for (int i = tid; i < 2 * 64 * SS_LT; i += 512) Sb[i] = 0;
    f32x4 Sacc[4];
#pragma unroll
    for (int i = 0; i < 4; ++i) Sacc[i] = (f32x4){0.f, 0.f, 0.f, 0.f};
    const float dtb = KIN(14)[dir * 16 + hh0 + ((tid >> 6) & 1)], aexp = __expf(KIN(15)[dir * 16 + hh0 + ((tid >> 6) & 1)]);
    const float dskip = KIN(16)[hh0 + (tid >> 8)];
    u32x4 pr[4]; bf16_t pdt = 0;
#define SS_REQ(ci_) do { _Pragma("unroll") for (int q = 0; q < 4; ++q) { const int p = tid + q * 512, j = p >> 5, c8 = p & 31; \
            const int col = c8 < 16 ? hh0 * 64 + c8 * 8 : (c8 < 24 ? 1024 + gi * 64 + (c8 - 16) * 8 : 1152 + gi * 64 + (c8 - 24) * 8); \
            pr[q] = *(const u32x4*)(XC + ((size_t)bl * TT + scan_t<64>(dir, (ci_), j)) * 1280 + col); } \
        if (tid < 128) pdt = P[((size_t)bl * TT + scan_t<64>(dir, (ci_), tid & 63)) * AB_N + AB_DT + dir * 16 + hh0 + (tid >> 6)]; } while (0)
    SS_REQ(0);
    lds_barrier();
    for (int ci = 0; ci < TT / 64; ++ci) {
        int tq = tid; asm volatile("" : "+v"(tq));
        const int lane = tq & 63, wid = __builtin_amdgcn_readfirstlane(tq >> 6), fr = lane & 15, fq = lane >> 4, hl_w = wid >> 2;
#pragma unroll
        for (int q = 0; q < 4; ++q) { const int p = tq + q * 512, j = p >> 5, c8 = p & 31;
            bf16_t* dst = c8 < 16 ? Xn + j * SS_LX + c8 * 8 : (c8 < 24 ? BM + j * SS_LT + (c8 - 16) * 8 : CM + j * SS_LT + (c8 - 24) * 8);
            *(u32x4*)dst = pr[q]; }
        if (wid < 2) {
            const float dt = softplusf_(bf2f(pdt) + dtb);
            float b = -dt * aexp;
#pragma unroll
            for (int o = 1; o < 64; o <<= 1) { const float t = __shfl_up(b, o); if (lane >= o) b += t; }
            const float b63 = __shfl(b, 63);
            s_b[wid * 64 + lane] = b; s_dt[wid * 64 + lane] = dt; s_e[wid * 64 + lane] = __expf(b63 - b) * dt;
            if (lane == 0) s_misc[wid] = __expf(b63);
        }
        if (ci + 1 < TT / 64) SS_REQ(ci + 1);
        lds_barrier();
        {
            const int jt = wid >> 1;
#pragma unroll
            for (int q2 = 0; q2 < 2; ++q2) {
                const int st = (wid & 1) * 2 + q2;
                f32x4 acc = (f32x4){0.f, 0.f, 0.f, 0.f};
                if (st <= jt) {
                    const bf16x8 c0 = ldfrag(CM, SS_LT, jt * 16, 0, fr, fq), c1 = ldfrag(CM, SS_LT, jt * 16, 32, fr, fq), b0 = ldfrag(BM, SS_LT, st * 16, 0, fr, fq), b1 = ldfrag(BM, SS_LT, st * 16, 32, fr, fq);
                    __builtin_amdgcn_sched_barrier(0);
                    acc = mma16(c0, b0, acc); acc = mma16(c1, b1, acc);
                }
                const int s = st * 16 + fr;
#pragma unroll
                for (int hl = 0; hl < 2; ++hl) { const float bs = s_b[hl * 64 + s], ds = s_dt[hl * 64 + s];
#pragma unroll
                    for (int r = 0; r < 4; ++r) { const int j = jt * 16 + fq * 4 + r;
                        const float wv = (s <= j) ? acc[r] * __expf(s_b[hl * 64 + j] - bs) * ds : 0.f;
                        Wm[(hl * 64 + j) * SS_LT + s] = f2bf(wv); } }
            }
            {
                const int s = lane, n8 = wid;
                const u32x4 bv = *(const u32x4*)(BM + s * SS_LT + n8 * 8);
#pragma unroll
                for (int hl = 0; hl < 2; ++hl) { const float e = s_e[hl * 64 + s];
                    bf16_t* bt = BTE + (hl * 64 + n8 * 8) * SS_LT + s;
                    bt[0 * SS_LT] = f2bf(lo2f(bv.x) * e); bt[1 * SS_LT] = f2bf(hi2f(bv.x) * e); bt[2 * SS_LT] = f2bf(lo2f(bv.y) * e); bt[3 * SS_LT] = f2bf(hi2f(bv.y) * e);
                    bt[4 * SS_LT] = f2bf(lo2f(bv.z) * e); bt[5 * SS_LT] = f2bf(hi2f(bv.z) * e); bt[6 * SS_LT] = f2bf(lo2f(bv.w) * e); bt[7 * SS_LT] = f2bf(hi2f(bv.w) * e); }
#pragma unroll
                for (int i = 0; i < 2; ++i) { const int c8 = wid + i * 8;
                    const u32x4 xv = *(const u32x4*)(Xn + s * SS_LX + c8 * 8);
                    bf16_t* xt = XT + (c8 * 8) * SS_LT + s;
                    xt[0 * SS_LT] = (bf16_t)(xv.x & 0xffff); xt[1 * SS_LT] = (bf16_t)(xv.x >> 16); xt[2 * SS_LT] = (bf16_t)(xv.y & 0xffff); xt[3 * SS_LT] = (bf16_t)(xv.y >> 16);
                    xt[4 * SS_LT] = (bf16_t)(xv.z & 0xffff); xt[5 * SS_LT] = (bf16_t)(xv.z >> 16); xt[6 * SS_LT] = (bf16_t)(xv.w & 0xffff); xt[7 * SS_LT] = (bf16_t)(xv.w >> 16); }
            }
        }
        lds_barrier();
        {
            const int hl = hl_w, jt = wid & 3, j = jt * 16 + fr;
            const bf16_t* Wh = Wm + hl * 64 * SS_LT; const bf16_t* Xh = XT + hl * 64 * SS_LT; const bf16_t* Sh = Sb + hl * 64 * SS_LT;
            const float eb = __expf(s_b[hl * 64 + j]);
            const size_t row = (size_t)bl * TT + scan_t<64>(dir, ci, j);
            const bf16x8 w0 = ldfrag(Wh, SS_LT, jt * 16, 0, fr, fq), w1 = ldfrag(Wh, SS_LT, jt * 16, 32, fr, fq), m0 = ldfrag(CM, SS_LT, jt * 16, 0, fr, fq), m1 = ldfrag(CM, SS_LT, jt * 16, 32, fr, fq);
#pragma unroll
            for (int hh = 0; hh < 2; ++hh) {
                bf16x8 fx[2][2], fs2[2][2];
#pragma unroll
                for (int q = 0; q < 2; ++q)
#pragma unroll
                    for (int k = 0; k < 2; ++k) { fx[q][k] = ldfrag(Xh, SS_LT, (hh * 2 + q) * 16, k * 32, fr, fq); fs2[q][k] = ldfrag(Sh, SS_LT, (hh * 2 + q) * 16, k * 32, fr, fq); }
                f32x4 dx[2];
                if (!dir) { dx[0] = ld4bf(Xn + j * SS_LX + hl * 64 + (hh * 2) * 16 + fq * 4); dx[1] = ld4bf(Xn + j * SS_LX + hl * 64 + (hh * 2 + 1) * 16 + fq * 4); }
                __builtin_amdgcn_sched_barrier(0);
                f32x4 y1[2], y2[2];
#pragma unroll
                for (int q = 0; q < 2; ++q) { y1[q] = (f32x4){0.f, 0.f, 0.f, 0.f}; y2[q] = (f32x4){0.f, 0.f, 0.f, 0.f}; }
#pragma unroll
                for (int q = 0; q < 2; ++q) { y1[q] = mma16(fx[q][0], w0, y1[q]); y2[q] = mma16(fs2[q][0], m0, y2[q]); }
#pragma unroll
                for (int q = 0; q < 2; ++q) { y1[q] = mma16(fx[q][1], w1, y1[q]); y2[q] = mma16(fs2[q][1], m1, y2[q]); }
#pragma unroll
                for (int q = 0; q < 2; ++q) { f32x4 y = y1[q] + y2[q] * eb;
                    if (!dir) y = y + dx[q] * dskip;
                    st4bf(YOUT + row * ldy + (hh0 + hl) * 64 + (hh * 2 + q) * 16 + fq * 4, y); }
            }
        }
        lds_barrier();
        {
            const int hl = hl_w, pt = wid & 3; const float eb63 = s_misc[hl];
            const bf16_t* Xh = XT + hl * 64 * SS_LT; const bf16_t* Bh = BTE + hl * 64 * SS_LT; bf16_t* Sh = Sb + hl * 64 * SS_LT;
            const bf16x8 x0 = ldfrag(Xh, SS_LT, pt * 16, 0, fr, fq), x1 = ldfrag(Xh, SS_LT, pt * 16, 32, fr, fq);
            bf16x8 fb[4][2];
#pragma unroll
            for (int nt = 0; nt < 4; ++nt) { fb[nt][0] = ldfrag(Bh, SS_LT, nt * 16, 0, fr, fq); fb[nt][1] = ldfrag(Bh, SS_LT, nt * 16, 32, fr, fq); }
            __builtin_amdgcn_sched_barrier(0);
#pragma unroll
            for (int nt = 0; nt < 4; ++nt) Sacc[nt] = Sacc[nt] * eb63;
#pragma unroll
            for (int nt = 0; nt < 4; ++nt) Sacc[nt] = mma16(fb[nt][0], x0, Sacc[nt]);
#pragma unroll
            for (int nt = 0; nt < 4; ++nt) Sacc[nt] = mma16(fb[nt][1], x1, Sacc[nt]);
#pragma unroll
            for (int nt = 0; nt < 4; ++nt) st4bf(Sh + (pt * 16 + fr) * SS_LT + nt * 16 + fq * 4, Sacc[nt]);
        }
        lds_barrier();
    }
#undef SS_REQ
}

__device__ __forceinline__ void phase_scan_ab(const KP& kp, unsigned char* lds) {
    for (int rep = 0; rep < ((PROBE_DUP & 8192) ? 2 : 1); ++rep)
    for (int u = obid(); u < 256; u += gridDim.x) if (u < 128) { mlstm_unit(kp, lds, u >> 4, (u >> 2) & 3, (u >> 1) & 1, u & 1); __syncthreads(); }
    for (int rep = 0; rep < ((PROBE_DUP & 16384) ? 2 : 1); ++rep)
    for (int u = obid(); u < 256; u += gridDim.x) if (u >= 128) { const int v = u - 128; ssd_unit(kp, lds, v >> 4, (v >> 3) & 1, v & 7); __syncthreads(); }
}

PHASE_FN void phase_fin_ab(const KP& kp) {
    const int lane = otid() & 63, wid = __builtin_amdgcn_readfirstlane(otid() >> 6);
    const bf16_t* P = WSP(const bf16_t, WS_BIG + L0_P);
    bf16_t* AO = WSP(bf16_t, WS_BIG + L0_AO); const bf16_t* HB = WSP(const bf16_t, WS_BIG + L0_HB); const bf16_t* YB = WSP(const bf16_t, WS_BIG + L0_YB);
    const float* mln = KIN(11); const float* sn = KIN(17);
    for (int lr = obid() * 8 + wid; lr < RG; lr += gridDim.x * 8) {
        const bf16_t* pr = P + (size_t)lr * AB_N;
        f32x4 yz[4]; float ss2 = 0.f;
#pragma unroll
        for (int i = 0; i < 4; ++i) { const int col = i * 256 + lane * 4;
            const f32x4 hs = ld4bf(AO + (size_t)lr * 2048 + col) + ld4bf(HB + (size_t)lr * 1024 + col);
            float ss = hs[0] * hs[0] + hs[1] * hs[1] + hs[2] * hs[2] + hs[3] * hs[3];
            ss = wsum(ss); const float rstd = rsqrtf(ss * (1.0f / 256.0f) + EPS);
            const f32x4 og = ld4bf(pr + AB_OG + col), w = *(const f32x4*)(mln + col);
            f32x4 o;
#pragma unroll
            for (int r = 0; r < 4; ++r) o[r] = hs[r] * rstd * w[r] * sigmoidf_(og[r]);
            st4bf(AO + (size_t)lr * 2048 + col, o);
            const f32x4 ys = ld4bf(AO + (size_t)lr * 2048 + 1024 + col) + ld4bf(YB + (size_t)lr * 1024 + col), z = ld4bf(pr + AB_Z + col);
#pragma unroll
            for (int r = 0; r < 4; ++r) { yz[i][r] = ys[r] * siluf_(z[r]); ss2 += yz[i][r] * yz[i][r]; }
        }
        ss2 = wsum(ss2); const float rstd2 = rsqrtf(ss2 * (1.0f / 1024.0f) + EPS);
#pragma unroll
        for (int i = 0; i < 4; ++i) { const int col = i * 256 + lane * 4; st4bf(AO + (size_t)lr * 2048 + 1024 + col, yz[i] * rstd2 * *(const f32x4*)(sn + col)); }
    }
}

PHASE_FN void phase_gemm_in(const KP& kp, unsigned char* lds, int layer, int grp) {
    const int npad = layer == 0 ? AB_NPAD : CD_NPAD, n = layer == 0 ? AB_N : CD_N;
    pg8::Gemm g{layer == 0 ? WSP(const bf16_t, WS_BIG + L0_U) : WSP(const bf16_t, WS_V) + (size_t)grp * RG * 1024, WSP(const bf16_t, WS_WMIX), RG, npad, 1024, nullptr, 0x7fffffff};
    pg8::StaticOrder S; S.init(RG, npad, (int)gridDim.x, obid());
    pg8::EpiBfG E{WSP(bf16_t, WS_BIG), n, n, 0x7fffffff};
    pg8::gemm_phase<pg8::EpiBfG, pg8::StaticOrder, false>((PG8_LAS unsigned char*)lds, g, S, E, nullptr);
    __syncthreads();
}
PHASE_FN void phase_gemm_out_ab(const KP& kp, unsigned char* lds) {
    pg8::Gemm g{WSP(const bf16_t, WS_BIG + L0_AO), WSP(const bf16_t, WS_WMIX + WM_AB_OUT), RG, 1024, 2048, nullptr, 0x7fffffff};
    pg8::StaticOrder S; S.init(RG, 1024, (int)gridDim.x, obid());
    pg8::EpiBfG E{WSP(bf16_t, WS_BIG + L0_U), 1024, 1024, 0x7fffffff};
    pg8::gemm_phase<pg8::EpiBfG, pg8::StaticOrder, false>((PG8_LAS unsigned char*)lds, g, S, E, nullptr);
    __syncthreads();
}

PHASE_FN void phase_prep_cd(const KP& kp) {
    const int lane = otid() & 63, wid = __builtin_amdgcn_readfirstlane(otid() >> 6);
    bf16_t* P = WSP(bf16_t, WS_BIG + L1_P);
    bf16_t* SG = WSP(bf16_t, WS_SG);
    const float* qn = KIN(20); const float* kvn = KIN(22); const float* mu = KIN(24);
    for (int lr = obid() * 8 + wid; lr < RG; lr += gridDim.x * 8) {
        const int bl = lr / TT, t = lr - bl * TT;
        bf16_t* pr = P + (size_t)lr * CD_N;
        {
            const f32x4 x = ld4bf(pr + CD_M1 + lane * 4);
            float ss = x[0] * x[0] + x[1] * x[1] + x[2] * x[2] + x[3] * x[3]; ss = wsum(ss);
            const float rstd = rsqrtf(ss * (1.0f / 256.0f) + EPS);
            st4bf(pr + CD_M1 + lane * 4, x * rstd * *(const f32x4*)(kvn + lane * 4));
        }
        {
            const int lo = t < CTXL ? 0 : CTXL, hi = t < CTXL ? CTXL : TT, c = lane * 4;
            const f32x4 x = ld4bf(pr + CD_WL + c);
            const f32x4 xp = t > lo ? ld4bf(pr - CD_N + CD_WL + c) : (f32x4){0.f, 0.f, 0.f, 0.f};
            const f32x4 xn = t < hi - 1 ? ld4bf(pr + CD_N + CD_WL + c) : (f32x4){0.f, 0.f, 0.f, 0.f};
            f32x4 l = x + *(const f32x4*)(mu + CD_WL - CD_RW0 + c) * ((xp + xn) * 0.5f - x);
            if (c < 128) {
#pragma unroll
                for (int q = 0; q < 4; ++q) l[q] = tanhf_(l[q]); }
            st4bf(WSP(bf16_t, WS_BIG + L1_TWAL) + (size_t)lr * 256 + c, l);
        }
        if (t >= CTXL) {
            const int s = t - CTXL;
            float x0[3], x1[3]; float ss = 0.f;
#pragma unroll
            for (int i = 0; i < 3; ++i) { const unsigned w = *(const unsigned*)(pr + CD_M0 + i * 128 + lane * 2); x0[i] = lo2f(w); x1[i] = hi2f(w); ss += x0[i] * x0[i] + x1[i] * x1[i]; }
            ss = wsum(ss); const float rstd = rsqrtf(ss * (1.0f / 384.0f) + EPS);
#pragma unroll
            for (int i = 0; i < 3; ++i) { const int c = i * 128 + lane * 2; *(unsigned*)(pr + CD_M0 + c) = pack2(x0[i] * rstd * qn[c], x1[i] * rstd * qn[c + 1]); }
            if (lane < 16) {
                const float pos = (lane < 8) ? (float)(s >> 6) : (float)(s & 63);
                const float inv = __expf(-(float)(lane & 7) * (9.210340371976184f / 8.0f));
                float sn, cs; sincosf(pos * inv, &sn, &cs);
                const float a = bf2f(pr[CD_KR + lane]), b2 = bf2f(pr[CD_KR + 16 + lane]);
                pr[CD_KR + lane] = f2bf(a * cs - b2 * sn); pr[CD_KR + 16 + lane] = f2bf(a * sn + b2 * cs);
            }
            {
                const int c = lane * 2;
                const unsigned w = *(const unsigned*)(pr + CD_GL + c);
                const unsigned wp = s > 0 ? *(const unsigned*)(pr - CD_N + CD_GL + c) : 0u;
                const unsigned wn = s < SEQ - 1 ? *(const unsigned*)(pr + CD_N + CD_GL + c) : 0u;
                const float m0 = mu[CD_GL - CD_RW0 + c], m1 = mu[CD_GL - CD_RW0 + c + 1];
                const float g0 = lo2f(w) + m0 * (0.5f * (lo2f(wp) + lo2f(wn)) - lo2f(w));
                const float g1 = hi2f(w) + m1 * (0.5f * (hi2f(wp) + hi2f(wn)) - hi2f(w));
                *(unsigned*)(SG + ((size_t)bl * SEQ + s) * 128 + c) = pack2(sigmoidf_(g0), sigmoidf_(g1));
            }
        }
    }
}

PHASE_FN void phase_upproj(const KP& kp, unsigned char* lds) {
    const bf16_t* P = WSP(const bf16_t, WS_BIG + L1_P);
    {
        pg8::Gemm g{P + CD_M0, WSP(const bf16_t, WS_WMIX + WM_UQ), RGL, 768, 384, nullptr, 0x7fffffff, CD_N, 1};
        pg8::StaticOrder S; S.init(RGL, 768, (int)gridDim.x, obid());
        pg8::EpiBfG E{WSP(bf16_t, WS_BIG + L1_Q), 768, 768, 0x7fffffff};
        pg8::gemm_phase<pg8::EpiBfG, pg8::StaticOrder, false>((PG8_LAS unsigned char*)lds, g, S, E, nullptr);
    }
    __syncthreads();
    {
        pg8::Gemm g{P + CD_M1, WSP(const bf16_t, WS_WMIX + WM_UKV), RG, 1024, 256, nullptr, 0x7fffffff, CD_N, 0};
        pg8::StaticOrder S; S.init(RG, 1024, (int)gridDim.x, obid());
        pg8::EpiBfG E{WSP(bf16_t, WS_BIG + L1_KV), 1024, 1024, 0x7fffffff};
        pg8::gemm_phase<pg8::EpiBfG, pg8::StaticOrder, false>((PG8_LAS unsigned char*)lds, g, S, E, nullptr);
    }
    __syncthreads();
}

constexpr int AT_LQ = 104, AT_LV = 72;
PHASE_FN void attn_unit(const KP& kp, unsigned char* lds, int bl, int head, int qb) {
    const int tid = otid(), lane = tid & 63, wid = __builtin_amdgcn_readfirstlane(tid >> 6), fr = lane & 15, fq = lane >> 4;
    bf16_t* Qs = (bf16_t*)lds;
    bf16_t* Kt = Qs + 256 * AT_LQ;
    bf16_t* Vt = Kt + 64 * AT_LQ;
    const bf16_t* P = WSP(const bf16_t, WS_BIG + L1_P);
    const bf16_t* Q = WSP(const bf16_t, WS_BIG + L1_Q);
    const bf16_t* KV = WSP(const bf16_t, WS_BIG + L1_KV);
    bf16_t* AOUT = WSP(bf16_t, WS_BIG + L1_AOUT);
    const float SC = 0.10206207261596577f;
#pragma unroll
    for (int i = 0; i < 6; ++i) { const int p = tid + i * 512, r = p / 12, c = p % 12;
        *(u32x4*)(Qs + r * AT_LQ + c * 8) = *(const u32x4*)(Q + ((size_t)bl * SEQ + qb * 256 + r) * 768 + head * 96 + c * 8); }
    lds_barrier();
#pragma unroll
    for (int i = 0; i < 8; ++i) { const int p = tid + i * 512, r = p >> 4, f = p & 15, s = qb * 256 + r;
        const float pos = (f < 8) ? (float)(s >> 6) : (float)(s & 63);
        const float inv = __expf(-(float)(f & 7) * (9.210340371976184f / 8.0f));
        float sn, cs; sincosf(pos * inv, &sn, &cs);
        const float a = bf2f(Qs[r * AT_LQ + 64 + f]), b2 = bf2f(Qs[r * AT_LQ + 80 + f]);
        Qs[r * AT_LQ + 64 + f] = f2bf(a * cs - b2 * sn); Qs[r * AT_LQ + 80 + f] = f2bf(a * sn + b2 * cs); }
    lds_barrier();
    bf16x8 qf[2][3];
#pragma unroll
    for (int rt = 0; rt < 2; ++rt)
#pragma unroll
        for (int k = 0; k < 3; ++k) qf[rt][k] = ldfrag(Qs, AT_LQ, wid * 32 + rt * 16, k * 32, fr, fq);
    f32x4 ot[2][4];
#pragma unroll
    for (int rt = 0; rt < 2; ++rt)
#pragma unroll
        for (int i = 0; i < 4; ++i) ot[rt][i] = (f32x4){0.f, 0.f, 0.f, 0.f};
    float mrow[2] = {-1e30f, -1e30f}, lsum[2] = {0.f, 0.f};
    u32x4 pk0, pk1, pvv;
    const int kkey0 = tid / 12, kc0 = tid % 12, kkey1 = (tid + 512) / 12, kc1 = (tid + 512) % 12, vkey = tid & 63, vc8 = tid >> 6;
#define AT_REQ(kt_) do { const size_t rb_ = (size_t)bl * TT + (kt_) * 64; \
        pk0 = kc0 < 8 ? *(const u32x4*)(KV + (rb_ + kkey0) * 1024 + head * 128 + kc0 * 8) : *(const u32x4*)(P + (rb_ + kkey0) * CD_N + CD_KR + (kc0 - 8) * 8); \
        if (tid < 256) pk1 = kc1 < 8 ? *(const u32x4*)(KV + (rb_ + kkey1) * 1024 + head * 128 + kc1 * 8) : *(const u32x4*)(P + (rb_ + kkey1) * CD_N + CD_KR + (kc1 - 8) * 8); \
        pvv = *(const u32x4*)(KV + (rb_ + vkey) * 1024 + head * 128 + 64 + vc8 * 8); } while (0)
    AT_REQ(0);
    const float SC2 = SC * 1.4426950408889634f;
    for (int kt = 0; kt < TT / 64; ++kt) {
        lds_barrier();
        *(u32x4*)(Kt + kkey0 * AT_LQ + kc0 * 8) = pk0;
        if (tid < 256) *(u32x4*)(Kt + kkey1 * AT_LQ + kc1 * 8) = pk1;
        { bf16_t* vt = Vt + (vc8 * 8) * AT_LV + vkey; const u32x4 v = pvv;
            vt[0 * AT_LV] = (bf16_t)(v.x & 0xffff); vt[1 * AT_LV] = (bf16_t)(v.x >> 16); vt[2 * AT_LV] = (bf16_t)(v.y & 0xffff); vt[3 * AT_LV] = (bf16_t)(v.y >> 16);
            vt[4 * AT_LV] = (bf16_t)(v.z & 0xffff); vt[5 * AT_LV] = (bf16_t)(v.z >> 16); vt[6 * AT_LV] = (bf16_t)(v.w & 0xffff); vt[7 * AT_LV] = (bf16_t)(v.w >> 16); }
        if (kt + 1 < TT / 64) AT_REQ(kt + 1);
        lds_barrier();
        bf16x8 kf[3][4];
#pragma unroll
        for (int k = 0; k < 3; ++k)
#pragma unroll
            for (int kk = 0; kk < 4; ++kk) kf[k][kk] = ldfrag(Kt, AT_LQ, kk * 16, k * 32, fr, fq);
        u32x2 vlo[2][4], vhi[2][4];
#pragma unroll
        for (int k2 = 0; k2 < 2; ++k2)
#pragma unroll
            for (int dvt = 0; dvt < 4; ++dvt) { const bf16_t* vp = Vt + (dvt * 16 + fr) * AT_LV + k2 * 32 + fq * 4; vlo[k2][dvt] = *(const u32x2*)vp; vhi[k2][dvt] = *(const u32x2*)(vp + 16); }
        __builtin_amdgcn_sched_barrier(0);
        f32x4 st[2][4];
#pragma unroll
        for (int rt = 0; rt < 2; ++rt)
#pragma unroll
            for (int kk = 0; kk < 4; ++kk) st[rt][kk] = (f32x4){0.f, 0.f, 0.f, 0.f};
#pragma unroll
        for (int k = 0; k < 3; ++k)
#pragma unroll
            for (int kk = 0; kk < 4; ++kk)
#pragma unroll
                for (int rt = 0; rt < 2; ++rt) st[rt][kk] = mma16(kf[k][kk], qf[rt][k], st[rt][kk]);
        union { bf16x8 v; unsigned u[4]; } pb[2][2];
#pragma unroll
        for (int rt = 0; rt < 2; ++rt) {
            float mx = -1e30f;
#pragma unroll
            for (int kk = 0; kk < 4; ++kk) mx = fmaxf(mx, fmaxf(fmaxf(st[rt][kk][0], st[rt][kk][1]), fmaxf(st[rt][kk][2], st[rt][kk][3])));
            mx = fmaxf(mx, __shfl_xor(mx, 16)); mx = fmaxf(mx, __shfl_xor(mx, 32));
            const float mnew = fmaxf(mrow[rt], mx), mb = mnew * SC2;
            if (__builtin_amdgcn_ballot_w64(mnew > mrow[rt]) != 0ull) {
                const float alpha = __builtin_amdgcn_exp2f((mrow[rt] - mnew) * SC2);
                lsum[rt] *= alpha;
#pragma unroll
                for (int i = 0; i < 4; ++i) ot[rt][i] = ot[rt][i] * alpha;
            }
            mrow[rt] = mnew;
#pragma unroll
            for (int kk = 0; kk < 4; ++kk)
#pragma unroll
                for (int r = 0; r < 4; ++r) { const float pv = __builtin_amdgcn_exp2f(st[rt][kk][r] * SC2 - mb); st[rt][kk][r] = pv; lsum[rt] += pv; }
#pragma unroll
            for (int k2 = 0; k2 < 2; ++k2) {
                pb[rt][k2].u[0] = pack2(st[rt][2 * k2][0], st[rt][2 * k2][1]); pb[rt][k2].u[1] = pack2(st[rt][2 * k2][2], st[rt][2 * k2][3]);
                pb[rt][k2].u[2] = pack2(st[rt][2 * k2 + 1][0], st[rt][2 * k2 + 1][1]); pb[rt][k2].u[3] = pack2(st[rt][2 * k2 + 1][2], st[rt][2 * k2 + 1][3]); }
        }
#pragma unroll
        for (int k2 = 0; k2 < 2; ++k2)
#pragma unroll
            for (int dvt = 0; dvt < 4; ++dvt) { union { bf16x8 v; u32x2 h[2]; } va; va.h[0] = vlo[k2][dvt]; va.h[1] = vhi[k2][dvt];
#pragma unroll
                for (int rt = 0; rt < 2; ++rt) ot[rt][dvt] = mma16(va.v, pb[rt][k2].v, ot[rt][dvt]); }
    }
#undef AT_REQ
#pragma unroll
    for (int rt = 0; rt < 2; ++rt) {
        float ls = lsum[rt]; ls += __shfl_xor(ls, 16); ls += __shfl_xor(ls, 32);
        const float rl = frcp_(ls);
        const size_t orow = (size_t)bl * SEQ + qb * 256 + wid * 32 + rt * 16 + fr;
#pragma unroll
        for (int dvt = 0; dvt < 4; ++dvt) st4bf(AOUT + orow * 1536 + head * 64 + dvt * 16 + fq * 4, ot[rt][dvt] * rl);
    }
}

constexpr int RW_LR = 200, RW_LP = 72;
PHASE_FN void rwkv_unit(const KP& kp, unsigned char* lds, int bl, int h, int dir) {
    const int tid = otid();
    bf16_t* RAW = (bf16_t*)lds;
    bf16_t* TWb = RAW + 34 * RW_LR;
    bf16_t* ALb = TWb + 32 * RW_LP;
    bf16_t* W2T = ALb + 32 * RW_LP;
    bf16_t* A2T = W2T + 64 * RW_LP;
    float* CL = (float*)(A2T + 64 * RW_LP);
    bf16_t* AR = (bf16_t*)(CL + 32 * 64);
    bf16_t* BK = AR + 64 * RW_LP;
    float* AABT = (float*)(BK + 64 * RW_LP);
    bf16_t* ARB = (bf16_t*)(AABT + 32 * 36);
    bf16_t* AAK = ARB + 32 * 40;
    bf16_t* ARK = AAK + 32 * 40;
    float* RHS = (float*)(ARK + 32 * 40);
    float* YB = RHS + 32 * 64;
    bf16_t* ZVT = (bf16_t*)(YB + 32 * 64);
    bf16_t* BKh = ZVT + 64 * RW_LP;
    bf16_t* Sb = BKh + 64 * RW_LP;
    float* PL = (float*)(Sb + 64 * RW_LP);
    const bf16_t* P = WSP(const bf16_t, WS_BIG + L1_P); const bf16_t* TWAL = WSP(const bf16_t, WS_BIG + L1_TWAL);
    bf16_t* OUT = WSP(bf16_t, WS_BIG + (dir ? L1_OB : L1_OF));
    float* BSC = WSP(float, WS_BSC) + (size_t)dir * RGL * 16;
    const float* mu = KIN(24);
    for (int i = tid; i < 64 * 64; i += 512) { const int c = i >> 6, n = i & 63;
        W2T[n * RW_LP + c] = f2bf(KIN(26)[((size_t)dir * 64 + c) * 1024 + h * 64 + n]); A2T[n * RW_LP + c] = f2bf(KIN(28)[((size_t)dir * 64 + c) * 1024 + h * 64 + n]); }
    for (int i = tid; i < 64 * RW_LP; i += 512) Sb[i] = 0;
    float* CV = PL + 64;
    bf16_t* A21b = (bf16_t*)(CV + 8 * 64);
    for (int i = tid; i < 16 * 40; i += 512) A21b[i] = 0;
    for (int i = tid; i < 64 * RW_LP; i += 512) ZVT[i] = 0;
    if (tid < 64) { const int n = tid;
        CV[0 * 64 + n] = KIN(25)[dir * 1024 + h * 64 + n]; CV[1 * 64 + n] = KIN(27)[dir * 1024 + h * 64 + n];
        CV[2 * 64 + n] = KIN(30)[h * 64 + n]; CV[3 * 64 + n] = KIN(31)[h * 64 + n]; CV[4 * 64 + n] = KIN(32)[h * 64 + n];
        CV[5 * 64 + n] = mu[h * 64 + n]; CV[6 * 64 + n] = mu[1024 + h * 64 + n]; CV[7 * 64 + n] = mu[2048 + h * 64 + n]; }
    f32x4 Sacc[2];
    Sacc[0] = (f32x4){0.f, 0.f, 0.f, 0.f}; Sacc[1] = (f32x4){0.f, 0.f, 0.f, 0.f};
    u32x4 pf[3];
#define RW_PREFETCH(cn, tix) do { const int t0n_ = dir ? scan_t<32>(1, (cn), 31) : (cn) * 32; const int lo_ = t0n_ < CTXL ? 0 : CTXL, hi_ = t0n_ < CTXL ? CTXL : TT; \
        _Pragma("unroll") for (int q = 0; q < 2; ++q) { const int p = (tix) + q * 512; pf[q] = (u32x4){0u, 0u, 0u, 0u}; \
            if (p < 34 * 24) { const int rr = p / 24, c = p % 24, t = t0n_ - 1 + rr; \
                if (t >= lo_ && t < hi_) { const int seg = c >> 3, c8 = c & 7; \
                    const int col = (seg == 0 ? CD_R : seg == 1 ? CD_K : CD_V) + h * 64; \
                    pf[q] = *(const u32x4*)(P + ((size_t)bl * TT + t) * CD_N + col + c8 * 8); } } } \
        { const int i_ = (tix) >> 4, c16 = (tix) & 15; \
          pf[2] = *(const u32x4*)(TWAL + ((size_t)bl * TT + t0n_ + i_) * 256 + (c16 >> 3) * 128 + dir * 64 + (c16 & 7) * 8); } } while (0)
    RW_PREFETCH(0, tid);
    lds_barrier();
    for (int ci = 0; ci < TT / 32; ++ci) {
        int tq = tid; asm volatile("" : "+v"(tq));
        const int lane = tq & 63, wid = __builtin_amdgcn_readfirstlane(tq >> 6), fr = lane & 15, fq = lane >> 4, pi = tq >> 4, n4 = (tq & 15) * 4;
        const int t0 = dir ? scan_t<32>(1, ci, 31) : ci * 32;
#pragma unroll
        for (int q = 0; q < 2; ++q) { const int p = tq + q * 512; if (p < 34 * 24) *(u32x4*)(RAW + (p / 24) * RW_LR + (p % 24) * 8) = pf[q]; }
        { const int i_ = tq >> 4, c16 = tq & 15; *(u32x4*)(((c16 >> 3) ? ALb : TWb) + i_ * RW_LP + (c16 & 7) * 8) = pf[2]; }
        if (ci + 1 < TT / 32) RW_PREFETCH(ci + 1, tq);
        lds_barrier();
        {
            const int which = wid >> 2, tt = (wid >> 1) & 1;
            const bf16_t* Xa = which ? ALb : TWb; const bf16_t* Wt = which ? A2T : W2T; float* Od = which ? YB : RHS;
#pragma unroll
            for (int q2 = 0; q2 < 2; ++q2) { const int nt = (wid & 1) * 2 + q2;
                f32x4 acc = (f32x4){0.f, 0.f, 0.f, 0.f};
#pragma unroll
                for (int k = 0; k < 2; ++k) acc = mma16(ldfrag(Xa, RW_LP, tt * 16, k * 32, fr, fq), ldfrag(Wt, RW_LP, nt * 16, k * 32, fr, fq), acc);
#pragma unroll
                for (int rr = 0; rr < 4; ++rr) Od[(tt * 16 + fq * 4 + rr) * 64 + nt * 16 + fr] = acc[rr]; }
        }
        lds_barrier();
        const int j = dir ? 31 - pi : pi;
        f32x4 r, kd, v, av, bv;
        {
            const f32x4 w0v = *(const f32x4*)(CV + n4), a0v = *(const f32x4*)(CV + 64 + n4), kkw = *(const f32x4*)(CV + 128 + n4), kaw = *(const f32x4*)(CV + 192 + n4), rkw = *(const f32x4*)(CV + 256 + n4);
            const f32x4 mur = *(const f32x4*)(CV + 320 + n4), muk = *(const f32x4*)(CV + 384 + n4), muv = *(const f32x4*)(CV + 448 + n4);
            const f32x4 wl = w0v + *(const f32x4*)(RHS + pi * 64 + n4), al = a0v + *(const f32x4*)(YB + pi * 64 + n4);
            const bf16_t* r1 = RAW + (pi + 1) * RW_LR; const bf16_t* rp = RAW + pi * RW_LR; const bf16_t* rn = RAW + (pi + 2) * RW_LR;
            f32x4 k;
            r = ld4bf(r1 + n4); k = ld4bf(r1 + 64 + n4); v = ld4bf(r1 + 128 + n4);
            r = r + mur * ((ld4bf(rp + n4) + ld4bf(rn + n4)) * 0.5f - r);
            k = k + muk * ((ld4bf(rp + 64 + n4) + ld4bf(rn + 64 + n4)) * 0.5f - k);
            v = v + muv * ((ld4bf(rp + 128 + n4) + ld4bf(rn + 128 + n4)) * 0.5f - v);
            f32x4 a, lw, kk = k * kkw;
            float ssq = kk[0] * kk[0] + kk[1] * kk[1] + kk[2] * kk[2] + kk[3] * kk[3];
            ssq += __shfl_xor(ssq, 1); ssq += __shfl_xor(ssq, 2); ssq += __shfl_xor(ssq, 4); ssq += __shfl_xor(ssq, 8);
            kk = kk * __builtin_amdgcn_rsqf(fmaxf(ssq, 1e-24f));
#pragma unroll
            for (int q = 0; q < 4; ++q) { const float wlog = -softplusf_(-wl[q]) - 0.5f; lw[q] = -__expf(wlog); a[q] = sigmoidf_(al[q]); }
            kd = k * ((a - 1.0f) * kaw + 1.0f);
            float bs = r[0] * kd[0] * rkw[0] + r[1] * kd[1] * rkw[1] + r[2] * kd[2] * rkw[2] + r[3] * kd[3] * rkw[3];
            bs += __shfl_xor(bs, 1); bs += __shfl_xor(bs, 2); bs += __shfl_xor(bs, 4); bs += __shfl_xor(bs, 8);
            av = kk * -1.0f; bv = kk * a;
            *(f32x4*)(CL + j * 64 + n4) = lw;
            const int t = t0 + pi;
            if (t >= CTXL && (tq & 15) == 0) BSC[((size_t)bl * SEQ + (t - CTXL)) * 16 + h] = bs;
        }
        lds_barrier();
        if (wid == 0) {
            float c[32];
#pragma unroll
            for (int q = 0; q < 32; ++q) c[q] = CL[q * 64 + lane];
#pragma unroll
            for (int q = 1; q < 32; ++q) c[q] += c[q - 1];
#pragma unroll
            for (int q = 0; q < 32; ++q) CL[q * 64 + lane] = c[q];
            PL[lane] = __expf(c[31]);
        }
        lds_barrier();
        {
            const f32x4 clj = *(const f32x4*)(CL + j * 64 + n4), cle = *(const f32x4*)(CL + 31 * 64 + n4);
            f32x4 clp = (f32x4){0.f, 0.f, 0.f, 0.f};
            if (j > 0) clp = *(const f32x4*)(CL + (j - 1) * 64 + n4);
            f32x4 at, rt, bt, kt, bh, kh;
#pragma unroll
            for (int q = 0; q < 4; ++q) { const float ep = __expf(clp[q]), ej = __expf(clj[q]), ei = __expf(-clj[q]), ee = __expf(cle[q] - clj[q]);
                at[q] = av[q] * ep; rt[q] = r[q] * ej; bt[q] = bv[q] * ei; kt[q] = kd[q] * ei; bh[q] = bv[q] * ee; kh[q] = kd[q] * ee; }
            st4bf(AR + j * RW_LP + n4, at); st4bf(AR + (32 + j) * RW_LP + n4, rt);
            st4bf(BK + j * RW_LP + n4, bt); st4bf(BK + (32 + j) * RW_LP + n4, kt);
#pragma unroll
            for (int q = 0; q < 4; ++q) { BKh[(n4 + q) * RW_LP + j] = f2bf(bh[q]); BKh[(n4 + q) * RW_LP + 32 + j] = f2bf(kh[q]); ZVT[(n4 + q) * RW_LP + 32 + j] = f2bf(v[q]); }
        }
        lds_barrier();
        {
            const int ti = wid >> 1;
#pragma unroll
            for (int q2 = 0; q2 < 2; ++q2) {
                const int si = (wid & 1) * 2 + q2;
                f32x4 acc = (f32x4){0.f, 0.f, 0.f, 0.f};
#pragma unroll
                for (int k = 0; k < 2; ++k) acc = mma16(ldfrag(AR, RW_LP, ti * 16, k * 32, fr, fq), ldfrag(BK, RW_LP, si * 16, k * 32, fr, fq), acc);
                const int sp = si * 16 + fr, s = sp & 31;
#pragma unroll
                for (int rr = 0; rr < 4; ++rr) { const int tp = ti * 16 + fq * 4 + rr, t = tp & 31;
                    const bool incl = tp >= 32;
                    const float val = (incl ? (s <= t) : (s < t)) ? acc[rr] : 0.f;
                    if (sp < 32) { if (incl) ARB[t * 40 + s] = f2bf(val); else { AABT[s * 36 + t] = val; if (t >= 16 && s < 16) A21b[(t - 16) * 40 + s] = f2bf(val); } }
                    else { (incl ? ARK : AAK)[t * 40 + s] = f2bf(val); } }
            }
        }
        lds_barrier();
        {
            const int which = wid >> 2, tt = (wid >> 1) & 1;
            const bf16_t* Ak = which ? ARK : AAK; float* Od = which ? YB : RHS;
#pragma unroll
            for (int q2 = 0; q2 < 2; ++q2) {
                const int vt = (wid & 1) * 2 + q2;
                f32x4 acc = (f32x4){0.f, 0.f, 0.f, 0.f};
#pragma unroll
                for (int k = 0; k < 2; ++k) acc = mma16(ldfrag(AR, RW_LP, which * 32 + tt * 16, k * 32, fr, fq), ldfrag(Sb, RW_LP, vt * 16, k * 32, fr, fq), acc);
                acc = mma16(ldfrag(Ak, 40, tt * 16, 0, fr, fq), ldfrag(ZVT, RW_LP, vt * 16, 32, fr, fq), acc);
#pragma unroll
                for (int rr = 0; rr < 4; ++rr) Od[(tt * 16 + fq * 4 + rr) * 64 + vt * 16 + fr] = acc[rr];
            }
        }
        lds_barrier();
        {
            if (wid == 0) {
                float z[16]; f32x4 ca0, ca1, ca2, ca3, cb0, cb1, cb2, cb3;
#pragma unroll
                for (int t = 0; t < 16; ++t) z[t] = RHS[(0 + t) * 64 + lane];
                ca0 = *(const f32x4*)(AABT + 0 * 36 + 0); ca1 = *(const f32x4*)(AABT + 0 * 36 + 4); ca2 = *(const f32x4*)(AABT + 0 * 36 + 8); ca3 = *(const f32x4*)(AABT + 0 * 36 + 12);
                cb0 = *(const f32x4*)(AABT + 1 * 36 + 0); cb1 = *(const f32x4*)(AABT + 1 * 36 + 4); cb2 = *(const f32x4*)(AABT + 1 * 36 + 8); cb3 = *(const f32x4*)(AABT + 1 * 36 + 12);
                { const float zs = z[0]; z[1] = __builtin_fmaf(ca0[1], zs, z[1]); z[2] = __builtin_fmaf(ca0[2], zs, z[2]); z[3] = __builtin_fmaf(ca0[3], zs, z[3]); z[4] = __builtin_fmaf(ca1[0], zs, z[4]); z[5] = __builtin_fmaf(ca1[1], zs, z[5]); z[6] = __builtin_fmaf(ca1[2], zs, z[6]); z[7] = __builtin_fmaf(ca1[3], zs, z[7]); z[8] = __builtin_fmaf(ca2[0], zs, z[8]); z[9] = __builtin_fmaf(ca2[1], zs, z[9]); z[10] = __builtin_fmaf(ca2[2], zs, z[10]); z[11] = __builtin_fmaf(ca2[3], zs, z[11]); z[12] = __builtin_fmaf(ca3[0], zs, z[12]); z[13] = __builtin_fmaf(ca3[1], zs, z[13]); z[14] = __builtin_fmaf(ca3[2], zs, z[14]); z[15] = __builtin_fmaf(ca3[3], zs, z[15]); }
                asm volatile("" : "+v"(z[1]) :: "memory");
                ca0 = *(const f32x4*)(AABT + 2 * 36 + 0); ca1 = *(const f32x4*)(AABT + 2 * 36 + 4); ca2 = *(const f32x4*)(AABT + 2 * 36 + 8); ca3 = *(const f32x4*)(AABT + 2 * 36 + 12);
                { const float zs = z[1]; z[2] = __builtin_fmaf(cb0[2], zs, z[2]); z[3] = __builtin_fmaf(cb0[3], zs, z[3]); z[4] = __builtin_fmaf(cb1[0], zs, z[4]); z[5] = __builtin_fmaf(cb1[1], zs, z[5]); z[6] = __builtin_fmaf(cb1[2], zs, z[6]); z[7] = __builtin_fmaf(cb1[3], zs, z[7]); z[8] = __builtin_fmaf(cb2[0], zs, z[8]); z[9] = __builtin_fmaf(cb2[1], zs, z[9]); z[10] = __builtin_fmaf(cb2[2], zs, z[10]); z[11] = __builtin_fmaf(cb2[3], zs, z[11]); z[12] = __builtin_fmaf(cb3[0], zs, z[12]); z[13] = __builtin_fmaf(cb3[1], zs, z[13]); z[14] = __builtin_fmaf(cb3[2], zs, z[14]); z[15] = __builtin_fmaf(cb3[3], zs, z[15]); }
                asm volatile("" : "+v"(z[2]) :: "memory");
                cb1 = *(const f32x4*)(AABT + 3 * 36 + 4); cb2 = *(const f32x4*)(AABT + 3 * 36 + 8); cb3 = *(const f32x4*)(AABT + 3 * 36 + 12);
                { const float zs = z[2]; z[3] = __builtin_fmaf(ca0[3], zs, z[3]); z[4] = __builtin_fmaf(ca1[0], zs, z[4]); z[5] = __builtin_fmaf(ca1[1], zs, z[5]); z[6] = __builtin_fmaf(ca1[2], zs, z[6]); z[7] = __builtin_fmaf(ca1[3], zs, z[7]); z[8] = __builtin_fmaf(ca2[0], zs, z[8]); z[9] = __builtin_fmaf(ca2[1], zs, z[9]); z[10] = __builtin_fmaf(ca2[2], zs, z[10]); z[11] = __builtin_fmaf(ca2[3], zs, z[11]); z[12] = __builtin_fmaf(ca3[0], zs, z[12]); z[13] = __builtin_fmaf(ca3[1], zs, z[13]); z[14] = __builtin_fmaf(ca3[2], zs, z[14]); z[15] = __builtin_fmaf(ca3[3], zs, z[15]); }
                asm volatile("" : "+v"(z[3]) :: "memory");
                ca1 = *(const f32x4*)(AABT + 4 * 36 + 4); ca2 = *(const f32x4*)(AABT + 4 * 36 + 8); ca3 = *(const f32x4*)(AABT + 4 * 36 + 12);
                { const float zs = z[3]; z[4] = __builtin_fmaf(cb1[0], zs, z[4]); z[5] = __builtin_fmaf(cb1[1], zs, z[5]); z[6] = __builtin_fmaf(cb1[2], zs, z[6]); z[7] = __builtin_fmaf(cb1[3], zs, z[7]); z[8] = __builtin_fmaf(cb2[0], zs, z[8]); z[9] = __builtin_fmaf(cb2[1], zs, z[9]); z[10] = __builtin_fmaf(cb2[2], zs, z[10]); z[11] = __builtin_fmaf(cb2[3], zs, z[11]); z[12] = __builtin_fmaf(cb3[0], zs, z[12]); z[13] = __builtin_fmaf(cb3[1], zs, z[13]); z[14] = __builtin_fmaf(cb3[2], zs, z[14]); z[15] = __builtin_fmaf(cb3[3], zs, z[15]); }
                asm volatile("" : "+v"(z[4]) :: "memory");
                cb1 = *(const f32x4*)(AABT + 5 * 36 + 4); cb2 = *(const f32x4*)(AABT + 5 * 36 + 8); cb3 = *(const f32x4*)(AABT + 5 * 36 + 12);
                { const float zs = z[4]; z[5] = __builtin_fmaf(ca1[1], zs, z[5]); z[6] = __builtin_fmaf(ca1[2], zs, z[6]); z[7] = __builtin_fmaf(ca1[3], zs, z[7]); z[8] = __builtin_fmaf(ca2[0], zs, z[8]); z[9] = __builtin_fmaf(ca2[1], zs, z[9]); z[10] = __builtin_fmaf(ca2[2], zs, z[10]); z[11] = __builtin_fmaf(ca2[3], zs, z[11]); z[12] = __builtin_fmaf(ca3[0], zs, z[12]); z[13] = __builtin_fmaf(ca3[1], zs, z[13]); z[14] = __builtin_fmaf(ca3[2], zs, z[14]); z[15] = __builtin_fmaf(ca3[3], zs, z[15]); }
                asm volatile("" : "+v"(z[5]) :: "memory");
                ca1 = *(const f32x4*)(AABT + 6 * 36 + 4); ca2 = *(const f32x4*)(AABT + 6 * 36 + 8); ca3 = *(const f32x4*)(AABT + 6 * 36 + 12);
                { const float zs = z[5]; z[6] = __builtin_fmaf(cb1[2], zs, z[6]); z[7] = __builtin_fmaf(cb1[3], zs, z[7]); z[8] = __builtin_fmaf(cb2[0], zs, z[8]); z[9] = __builtin_fmaf(cb2[1], zs, z[9]); z[10] = __builtin_fmaf(cb2[2], zs, z[10]); z[11] = __builtin_fmaf(cb2[3], zs, z[11]); z[12] = __builtin_fmaf(cb3[0], zs, z[12]); z[13] = __builtin_fmaf(cb3[1], zs, z[13]); z[14] = __builtin_fmaf(cb3[2], zs, z[14]); z[15] = __builtin_fmaf(cb3[3], zs, z[15]); }
                asm volatile("" : "+v"(z[6]) :: "memory");
                cb2 = *(const f32x4*)(AABT + 7 * 36 + 8); cb3 = *(const f32x4*)(AABT + 7 * 36 + 12);
                { const float zs = z[6]; z[7] = __builtin_fmaf(ca1[3], zs, z[7]); z[8] = __builtin_fmaf(ca2[0], zs, z[8]); z[9] = __builtin_fmaf(ca2[1], zs, z[9]); z[10] = __builtin_fmaf(ca2[2], zs, z[10]); z[11] = __builtin_fmaf(ca2[3], zs, z[11]); z[12] = __builtin_fmaf(ca3[0], zs, z[12]); z[13] = __builtin_fmaf(ca3[1], zs, z[13]); z[14] = __builtin_fmaf(ca3[2], zs, z[14]); z[15] = __builtin_fmaf(ca3[3], zs, z[15]); }
                asm volatile("" : "+v"(z[7]) :: "memory");
                ca2 = *(const f32x4*)(AABT + 8 * 36 + 8); ca3 = *(const f32x4*)(AABT + 8 * 36 + 12);
                { const float zs = z[7]; z[8] = __builtin_fmaf(cb2[0], zs, z[8]); z[9] = __builtin_fmaf(cb2[1], zs, z[9]); z[10] = __builtin_fmaf(cb2[2], zs, z[10]); z[11] = __builtin_fmaf(cb2[3], zs, z[11]); z[12] = __builtin_fmaf(cb3[0], zs, z[12]); z[13] = __builtin_fmaf(cb3[1], zs, z[13]); z[14] = __builtin_fmaf(cb3[2], zs, z[14]); z[15] = __builtin_fmaf(cb3[3], zs, z[15]); }
                asm volatile("" : "+v"(z[8]) :: "memory");
                cb2 = *(const f32x4*)(AABT + 9 * 36 + 8); cb3 = *(const f32x4*)(AABT + 9 * 36 + 12);
                { const float zs = z[8]; z[9] = __builtin_fmaf(ca2[1], zs, z[9]); z[10] = __builtin_fmaf(ca2[2], zs, z[10]); z[11] = __builtin_fmaf(ca2[3], zs, z[11]); z[12] = __builtin_fmaf(ca3[0], zs, z[12]); z[13] = __builtin_fmaf(ca3[1], zs, z[13]); z[14] = __builtin_fmaf(ca3[2], zs, z[14]); z[15] = __builtin_fmaf(ca3[3], zs, z[15]); }
                asm volatile("" : "+v"(z[9]) :: "memory");
                ca2 = *(const f32x4*)(AABT + 10 * 36 + 8); ca3 = *(const f32x4*)(AABT + 10 * 36 + 12);
                { const float zs = z[9]; z[10] = __builtin_fmaf(cb2[2], zs, z[10]); z[11] = __builtin_fmaf(cb2[3], zs, z[11]); z[12] = __builtin_fmaf(cb3[0], zs, z[12]); z[13] = __builtin_fmaf(cb3[1], zs, z[13]); z[14] = __builtin_fmaf(cb3[2], zs, z[14]); z[15] = __builtin_fmaf(cb3[3], zs, z[15]); }
                asm volatile("" : "+v"(z[10]) :: "memory");
                cb3 = *(const f32x4*)(AABT + 11 * 36 + 12);
                { const float zs = z[10]; z[11] = __builtin_fmaf(ca2[3], zs, z[11]); z[12] = __builtin_fmaf(ca3[0], zs, z[12]); z[13] = __builtin_fmaf(ca3[1], zs, z[13]); z[14] = __builtin_fmaf(ca3[2], zs, z[14]); z[15] = __builtin_fmaf(ca3[3], zs, z[15]); }
                asm volatile("" : "+v"(z[11]) :: "memory");
                ca3 = *(const f32x4*)(AABT + 12 * 36 + 12);
                { const float zs = z[11]; z[12] = __builtin_fmaf(cb3[0], zs, z[12]); z[13] = __builtin_fmaf(cb3[1], zs, z[13]); z[14] = __builtin_fmaf(cb3[2], zs, z[14]); z[15] = __builtin_fmaf(cb3[3], zs, z[15]); }
                asm volatile("" : "+v"(z[12]) :: "memory");
                cb3 = *(const f32x4*)(AABT + 13 * 36 + 12);
                { const float zs = z[12]; z[13] = __builtin_fmaf(ca3[1], zs, z[13]); z[14] = __builtin_fmaf(ca3[2], zs, z[14]); z[15] = __builtin_fmaf(ca3[3], zs, z[15]); }
                asm volatile("" : "+v"(z[13]) :: "memory");
                ca3 = *(const f32x4*)(AABT + 14 * 36 + 12);
                { const float zs = z[13]; z[14] = __builtin_fmaf(cb3[2], zs, z[14]); z[15] = __builtin_fmaf(cb3[3], zs, z[15]); }
                asm volatile("" : "+v"(z[14]) :: "memory");
                { const float zs = z[14]; z[15] = __builtin_fmaf(ca3[3], zs, z[15]); }
                asm volatile("" : "+v"(z[15]) :: "memory");
#pragma unroll
                for (int q = 0; q < 2; ++q) { u32x4 w; w.x = pack2(z[q * 8 + 0], z[q * 8 + 1]); w.y = pack2(z[q * 8 + 2], z[q * 8 + 3]); w.z = pack2(z[q * 8 + 4], z[q * 8 + 5]); w.w = pack2(z[q * 8 + 6], z[q * 8 + 7]);
                    *(u32x4*)(ZVT + lane * RW_LP + 0 + q * 8) = w; }
            }
            lds_barrier();
            if (wid < 4) {
                f32x4 acc = (f32x4){0.f, 0.f, 0.f, 0.f};
                acc = mma16(ldfrag(A21b, 40, 0, 0, fr, fq), ldfrag(ZVT, RW_LP, wid * 16, 0, fr, fq), acc);
#pragma unroll
                for (int rr = 0; rr < 4; ++rr) RHS[(16 + fq * 4 + rr) * 64 + wid * 16 + fr] += acc[rr];
            }
            lds_barrier();
            if (wid == 0) {
                float z[16]; f32x4 ca0, ca1, ca2, ca3, cb0, cb1, cb2, cb3;
#pragma unroll
                for (int t = 0; t < 16; ++t) z[t] = RHS[(16 + t) * 64 + lane];
                ca0 = *(const f32x4*)(AABT + 16 * 36 + 16); ca1 = *(const f32x4*)(AABT + 16 * 36 + 20); ca2 = *(const f32x4*)(AABT + 16 * 36 + 24); ca3 = *(const f32x4*)(AABT + 16 * 36 + 28);
                cb0 = *(const f32x4*)(AABT + 17 * 36 + 16); cb1 = *(const f32x4*)(AABT + 17 * 36 + 20); cb2 = *(const f32x4*)(AABT + 17 * 36 + 24); cb3 = *(const f32x4*)(AABT + 17 * 36 + 28);
                { const float zs = z[0]; z[1] = __builtin_fmaf(ca0[1], zs, z[1]); z[2] = __builtin_fmaf(ca0[2], zs, z[2]); z[3] = __builtin_fmaf(ca0[3], zs, z[3]); z[4] = __builtin_fmaf(ca1[0], zs, z[4]); z[5] = __builtin_fmaf(ca1[1], zs, z[5]); z[6] = __builtin_fmaf(ca1[2], zs, z[6]); z[7] = __builtin_fmaf(ca1[3], zs, z[7]); z[8] = __builtin_fmaf(ca2[0], zs, z[8]); z[9] = __builtin_fmaf(ca2[1], zs, z[9]); z[10] = __builtin_fmaf(ca2[2], zs, z[10]); z[11] = __builtin_fmaf(ca2[3], zs, z[11]); z[12] = __builtin_fmaf(ca3[0], zs, z[12]); z[13] = __builtin_fmaf(ca3[1], zs, z[13]); z[14] = __builtin_fmaf(ca3[2], zs, z[14]); z[15] = __builtin_fmaf(ca3[3], zs, z[15]); }
                asm volatile("" : "+v"(z[1]) :: "memory");
                ca0 = *(const f32x4*)(AABT + 18 * 36 + 16); ca1 = *(const f32x4*)(AABT + 18 * 36 + 20); ca2 = *(const f32x4*)(AABT + 18 * 36 + 24); ca3 = *(const f32x4*)(AABT + 18 * 36 + 28);
                { const float zs = z[1]; z[2] = __builtin_fmaf(cb0[2], zs, z[2]); z[3] = __builtin_fmaf(cb0[3], zs, z[3]); z[4] = __builtin_fmaf(cb1[0], zs, z[4]); z[5] = __builtin_fmaf(cb1[1], zs, z[5]); z[6] = __builtin_fmaf(cb1[2], zs, z[6]); z[7] = __builtin_fmaf(cb1[3], zs, z[7]); z[8] = __builtin_fmaf(cb2[0], zs, z[8]); z[9] = __builtin_fmaf(cb2[1], zs, z[9]); z[10] = __builtin_fmaf(cb2[2], zs, z[10]); z[11] = __builtin_fmaf(cb2[3], zs, z[11]); z[12] = __builtin_fmaf(cb3[0], zs, z[12]); z[13] = __builtin_fmaf(cb3[1], zs, z[13]); z[14] = __builtin_fmaf(cb3[2], zs, z[14]); z[15] = __builtin_fmaf(cb3[3], zs, z[15]); }
                asm volatile("" : "+v"(z[2]) :: "memory");
                cb1 = *(const f32x4*)(AABT + 19 * 36 + 20); cb2 = *(const f32x4*)(AABT + 19 * 36 + 24); cb3 = *(const f32x4*)(AABT + 19 * 36 + 28);
                { const float zs = z[2]; z[3] = __builtin_fmaf(ca0[3], zs, z[3]); z[4] = __builtin_fmaf(ca1[0], zs, z[4]); z[5] = __builtin_fmaf(ca1[1], zs, z[5]); z[6] = __builtin_fmaf(ca1[2], zs, z[6]); z[7] = __builtin_fmaf(ca1[3], zs, z[7]); z[8] = __builtin_fmaf(ca2[0], zs, z[8]); z[9] = __builtin_fmaf(ca2[1], zs, z[9]); z[10] = __builtin_fmaf(ca2[2], zs, z[10]); z[11] = __builtin_fmaf(ca2[3], zs, z[11]); z[12] = __builtin_fmaf(ca3[0], zs, z[12]); z[13] = __builtin_fmaf(ca3[1], zs, z[13]); z[14] = __builtin_fmaf(ca3[2], zs, z[14]); z[15] = __builtin_fmaf(ca3[3], zs, z[15]); }
                asm volatile("" : "+v"(z[3]) :: "memory");
                ca1 = *(const f32x4*)(AABT + 20 * 36 + 20); ca2 = *(const f32x4*)(AABT + 20 * 36 + 24); ca3 = *(const f32x4*)(AABT + 20 * 36 + 28);
                { const float zs = z[3]; z[4] = __builtin_fmaf(cb1[0], zs, z[4]); z[5] = __builtin_fmaf(cb1[1], zs, z[5]); z[6] = __builtin_fmaf(cb1[2], zs, z[6]); z[7] = __builtin_fmaf(cb1[3], zs, z[7]); z[8] = __builtin_fmaf(cb2[0], zs, z[8]); z[9] = __builtin_fmaf(cb2[1], zs, z[9]); z[10] = __builtin_fmaf(cb2[2], zs, z[10]); z[11] = __builtin_fmaf(cb2[3], zs, z[11]); z[12] = __builtin_fmaf(cb3[0], zs, z[12]); z[13] = __builtin_fmaf(cb3[1], zs, z[13]); z[14] = __builtin_fmaf(cb3[2], zs, z[14]); z[15] = __builtin_fmaf(cb3[3], zs, z[15]); }
                asm volatile("" : "+v"(z[4]) :: "memory");
                cb1 = *(const f32x4*)(AABT + 21 * 36 + 20); cb2 = *(const f32x4*)(AABT + 21 * 36 + 24); cb3 = *(const f32x4*)(AABT + 21 * 36 + 28);
                { const float zs = z[4]; z[5] = __builtin_fmaf(ca1[1], zs, z[5]); z[6] = __builtin_fmaf(ca1[2], zs, z[6]); z[7] = __builtin_fmaf(ca1[3], zs, z[7]); z[8] = __builtin_fmaf(ca2[0], zs, z[8]); z[9] = __builtin_fmaf(ca2[1], zs, z[9]); z[10] = __builtin_fmaf(ca2[2], zs, z[10]); z[11] = __builtin_fmaf(ca2[3], zs, z[11]); z[12] = __builtin_fmaf(ca3[0], zs, z[12]); z[13] = __builtin_fmaf(ca3[1], zs, z[13]); z[14] = __builtin_fmaf(ca3[2], zs, z[14]); z[15] = __builtin_fmaf(ca3[3], zs, z[15]); }
                asm volatile("" : "+v"(z[5]) :: "memory");
                ca1 = *(const f32x4*)(AABT + 22 * 36 + 20); ca2 = *(const f32x4*)(AABT + 22 * 36 + 24); ca3 = *(const f32x4*)(AABT + 22 * 36 + 28);
                { const float zs = z[5]; z[6] = __builtin_fmaf(cb1[2], zs, z[6]); z[7] = __builtin_fmaf(cb1[3], zs, z[7]); z[8] = __builtin_fmaf(cb2[0], zs, z[8]); z[9] = __builtin_fmaf(cb2[1], zs, z[9]); z[10] = __builtin_fmaf(cb2[2], zs, z[10]); z[11] = __builtin_fmaf(cb2[3], zs, z[11]); z[12] = __builtin_fmaf(cb3[0], zs, z[12]); z[13] = __builtin_fmaf(cb3[1], zs, z[13]); z[14] = __builtin_fmaf(cb3[2], zs, z[14]); z[15] = __builtin_fmaf(cb3[3], zs, z[15]); }
                asm volatile("" : "+v"(z[6]) :: "memory");
                cb2 = *(const f32x4*)(AABT + 23 * 36 + 24); cb3 = *(const f32x4*)(AABT + 23 * 36 + 28);
                { const float zs = z[6]; z[7] = __builtin_fmaf(ca1[3], zs, z[7]); z[8] = __builtin_fmaf(ca2[0], zs, z[8]); z[9] = __builtin_fmaf(ca2[1], zs, z[9]); z[10] = __builtin_fmaf(ca2[2], zs, z[10]); z[11] = __builtin_fmaf(ca2[3], zs, z[11]); z[12] = __builtin_fmaf(ca3[0], zs, z[12]); z[13] = __builtin_fmaf(ca3[1], zs, z[13]); z[14] = __builtin_fmaf(ca3[2], zs, z[14]); z[15] = __builtin_fmaf(ca3[3], zs, z[15]); }
                asm volatile("" : "+v"(z[7]) :: "memory");
                ca2 = *(const f32x4*)(AABT + 24 * 36 + 24); ca3 = *(const f32x4*)(AABT + 24 * 36 + 28);
                { const float zs = z[7]; z[8] = __builtin_fmaf(cb2[0], zs, z[8]); z[9] = __builtin_fmaf(cb2[1], zs, z[9]); z[10] = __builtin_fmaf(cb2[2], zs, z[10]); z[11] = __builtin_fmaf(cb2[3], zs, z[11]); z[12] = __builtin_fmaf(cb3[0], zs, z[12]); z[13] = __builtin_fmaf(cb3[1], zs, z[13]); z[14] = __builtin_fmaf(cb3[2], zs, z[14]); z[15] = __builtin_fmaf(cb3[3], zs, z[15]); }
                asm volatile("" : "+v"(z[8]) :: "memory");
                cb2 = *(const f32x4*)(AABT + 25 * 36 + 24); cb3 = *(const f32x4*)(AABT + 25 * 36 + 28);
                { const float zs = z[8]; z[9] = __builtin_fmaf(ca2[1], zs, z[9]); z[10] = __builtin_fmaf(ca2[2], zs, z[10]); z[11] = __builtin_fmaf(ca2[3], zs, z[11]); z[12] = __builtin_fmaf(ca3[0], zs, z[12]); z[13] = __builtin_fmaf(ca3[1], zs, z[13]); z[14] = __builtin_fmaf(ca3[2], zs, z[14]); z[15] = __builtin_fmaf(ca3[3], zs, z[15]); }
                asm volatile("" : "+v"(z[9]) :: "memory");
                ca2 = *(const f32x4*)(AABT + 26 * 36 + 24); ca3 = *(const f32x4*)(AABT + 26 * 36 + 28);
                { const float zs = z[9]; z[10] = __builtin_fmaf(cb2[2], zs, z[10]); z[11] = __builtin_fmaf(cb2[3], zs, z[11]); z[12] = __builtin_fmaf(cb3[0], zs, z[12]); z[13] = __builtin_fmaf(cb3[1], zs, z[13]); z[14] = __builtin_fmaf(cb3[2], zs, z[14]); z[15] = __builtin_fmaf(cb3[3], zs, z[15]); }
                asm volatile("" : "+v"(z[10]) :: "memory");
                cb3 = *(const f32x4*)(AABT + 27 * 36 + 28);
                { const float zs = z[10]; z[11] = __builtin_fmaf(ca2[3], zs, z[11]); z[12] = __builtin_fmaf(ca3[0], zs, z[12]); z[13] = __builtin_fmaf(ca3[1], zs, z[13]); z[14] = __builtin_fmaf(ca3[2], zs, z[14]); z[15] = __builtin_fmaf(ca3[3], zs, z[15]); }
                asm volatile("" : "+v"(z[11]) :: "memory");
                ca3 = *(const f32x4*)(AABT + 28 * 36 + 28);
                { const float zs = z[11]; z[12] = __builtin_fmaf(cb3[0], zs, z[12]); z[13] = __builtin_fmaf(cb3[1], zs, z[13]); z[14] = __builtin_fmaf(cb3[2], zs, z[14]); z[15] = __builtin_fmaf(cb3[3], zs, z[15]); }
                asm volatile("" : "+v"(z[12]) :: "memory");
                cb3 = *(const f32x4*)(AABT + 29 * 36 + 28);
                { const float zs = z[12]; z[13] = __builtin_fmaf(ca3[1], zs, z[13]); z[14] = __builtin_fmaf(ca3[2], zs, z[14]); z[15] = __builtin_fmaf(ca3[3], zs, z[15]); }
                asm volatile("" : "+v"(z[13]) :: "memory");
                ca3 = *(const f32x4*)(AABT + 30 * 36 + 28);
                { const float zs = z[13]; z[14] = __builtin_fmaf(cb3[2], zs, z[14]); z[15] = __builtin_fmaf(cb3[3], zs, z[15]); }
                asm volatile("" : "+v"(z[14]) :: "memory");
                { const float zs = z[14]; z[15] = __builtin_fmaf(ca3[3], zs, z[15]); }
                asm volatile("" : "+v"(z[15]) :: "memory");
#pragma unroll
                for (int q = 0; q < 2; ++q) { u32x4 w; w.x = pack2(z[q * 8 + 0], z[q * 8 + 1]); w.y = pack2(z[q * 8 + 2], z[q * 8 + 3]); w.z = pack2(z[q * 8 + 4], z[q * 8 + 5]); w.w = pack2(z[q * 8 + 6], z[q * 8 + 7]);
                    *(u32x4*)(ZVT + lane * RW_LP + 16 + q * 8) = w; }
            }
        }
        lds_barrier();
        {
            const int nt = wid >> 1;
            const f32x4 pl = *(const f32x4*)(PL + nt * 16 + fq * 4);
#pragma unroll
            for (int q2 = 0; q2 < 2; ++q2) {
                const int vt = (wid & 1) * 2 + q2;
                Sacc[q2] = Sacc[q2] * pl;
#pragma unroll
                for (int k = 0; k < 2; ++k) Sacc[q2] = mma16(ldfrag(BKh, RW_LP, nt * 16, k * 32, fr, fq), ldfrag(ZVT, RW_LP, vt * 16, k * 32, fr, fq), Sacc[q2]);
                st4bf(Sb + (vt * 16 + fr) * RW_LP + nt * 16 + fq * 4, Sacc[q2]);
            }
        }
        if (t0 >= CTXL) {
            const int vt = wid >> 1, tt = wid & 1;
            f32x4 acc = (f32x4){0.f, 0.f, 0.f, 0.f};
            acc = mma16(ldfrag(ZVT, RW_LP, vt * 16, 0, fr, fq), ldfrag(ARB, 40, tt * 16, 0, fr, fq), acc);
            const int t = tt * 16 + fr, v0 = vt * 16 + fq * 4;
#pragma unroll
            for (int rr = 0; rr < 4; ++rr) acc[rr] += YB[t * 64 + v0 + rr];
            const int tn = scan_t<32>(dir, ci, t);
            st4bf(OUT + ((size_t)bl * SEQ + (tn - CTXL)) * 1024 + h * 64 + v0, acc);
        }
    }
    lds_barrier();
#undef RW_PREFETCH
}

__device__ __forceinline__ void phase_mix_cd(const KP& kp, unsigned char* lds, int which) {
    if (which & 1) for (int u = obid(); u < 256; u += gridDim.x) { rwkv_unit(kp, lds, u >> 5, (u >> 1) & 15, u & 1); __syncthreads(); }
    if (which & 2) for (int u = obid(); u < 512; u += gridDim.x) { attn_unit(kp, lds, u >> 6, (u >> 3) & 7, u & 7); __syncthreads(); }
}

struct EpiFinCD {
    const bf16_t* OF; const bf16_t* OB; const bf16_t* P; const float* BSC; const float* ln; const float* mu; bf16_t* AOUT;
    __device__ __forceinline__ void operator()(const f32x4 (&acc)[4][4], int rb, int cb, int fr, int fq) const {
        const int head = cb >> 6;
#pragma unroll
        for (int i = 0; i < 4; ++i) { const int lr = rb + i * 16 + fr, s = lr & 2047;
            const size_t prow = (size_t)(lr >> 11) * TT + CTXL + s;
            f32x4 o[4]; float ss = 0.f;
#pragma unroll
            for (int j = 0; j < 4; ++j) { const int col = cb + j * 16 + fq * 4;
                o[j] = ld4bf(OF + (size_t)lr * 1024 + col) + ld4bf(OB + (size_t)lr * 1024 + col);
                ss += o[j][0] * o[j][0] + o[j][1] * o[j][1] + o[j][2] * o[j][2] + o[j][3] * o[j][3]; }
            ss += __shfl_xor(ss, 16); ss += __shfl_xor(ss, 32);
            const float rstd = rsqrtf(ss * (1.0f / 64.0f) + EPS);
            const float bon = BSC[(size_t)lr * 16 + head] + BSC[(size_t)RGL * 16 + (size_t)lr * 16 + head];
#pragma unroll
            for (int j = 0; j < 4; ++j) { const int col = cb + j * 16 + fq * 4;
                const bf16_t* pv = P + prow * CD_N + CD_V + col;
                const f32x4 v = ld4bf(pv);
                const f32x4 vp = s > 0 ? ld4bf(pv - CD_N) : (f32x4){0.f, 0.f, 0.f, 0.f};
                const f32x4 vn = s < SEQ - 1 ? ld4bf(pv + CD_N) : (f32x4){0.f, 0.f, 0.f, 0.f};
                const f32x4 vl = v + *(const f32x4*)(mu + 2048 + col) * ((vp + vn) * 0.5f - v);
                const f32x4 y = o[j] * rstd * *(const f32x4*)(ln + col) + vl * bon;
                st4bf(AOUT + (size_t)lr * 1536 + 512 + col, y * acc[i][j]); }
        }
    }
};
PHASE_FN void phase_fin_cd(const KP& kp, unsigned char* lds) {
    GA ga{WSP(const bf16_t, WS_SG), nullptr, 128, 0, 128, nullptr, RGL, 0, 0};
    EpiFinCD ep{WSP(const bf16_t, WS_BIG + L1_OF), WSP(const bf16_t, WS_BIG + L1_OB), WSP(const bf16_t, WS_BIG + L1_P), WSP(const float, WS_BSC), KIN(33), KIN(24), WSP(bf16_t, WS_BIG + L1_AOUT)};
    for (int u = obid(); u < (RGL / 256) * 8; u += gridDim.x) gemm_tile(lds, ga, WSP(const bf16_t, WS_WMIX + WM_G2), 128, u >> 3, u & 7, ep);
}
PHASE_FN void phase_gemm_out_cd(const KP& kp, unsigned char* lds) {
    pg8::Gemm g{WSP(const bf16_t, WS_BIG + L1_AOUT), WSP(const bf16_t, WS_WMIX + WM_CD_OUT), RGL, 1024, 1536, nullptr, 0x7fffffff};
    pg8::StaticOrder S; S.init(RGL, 1024, (int)gridDim.x, obid());
    pg8::EpiBfG E{WSP(bf16_t, WS_BIG + L1_U), 1024, 1024, 0x7fffffff};
    pg8::gemm_phase<pg8::EpiBfG, pg8::StaticOrder, false>((PG8_LAS unsigned char*)lds, g, S, E, nullptr);
    __syncthreads();
}

__device__ __attribute__((noinline)) void grid_sync(unsigned* barw, unsigned x, volatile LAS unsigned* st) { XcdBarrier b; b.bar = barw; b.x = x; b.st = st; xcd_barrier(b); }
constexpr int N_PHASES = 37;
__global__ void __launch_bounds__(512, 2) fwd_kernel(KP kparg) {
    extern __shared__ __attribute__((aligned(16))) unsigned char lds[];
    const int lo = kparg.ph_lo, hi = kparg.ph_hi;
    const KP& kp = kparg;
    volatile LAS unsigned* xbst = (volatile LAS unsigned*)(LAS unsigned char*)(lds + LDS_BYTES - 16);
    if (threadIdx.x == 0) { xbst[0] = 0u; xbst[1] = 0u; }
    __syncthreads();
    XcdBarrier bar; bar.bar = (unsigned*)kparg.ws; bar.x = 0; bar.st = xbst;
    if (hi - lo > 1) bar = xcd_barrier_post((unsigned*)kparg.ws, xbst);
#define IN(k) (lo <= (k) && (k) < hi)
#define SEAM(k) do { if (IN(k) && IN((k) + 1)) { grid_sync((unsigned*)kp.ws, bar.x, xbst); if (PROBE_DUP & 512) grid_sync((unsigned*)kp.ws, bar.x, xbst); } } while (0)
#define PHASE(...) do { if (IN(ph)) { __VA_ARGS__ } SEAM(ph); ++ph; } while (0)
    int ph = 0;
    PHASE(phase_mod(kp, lds); __syncthreads(); phase_conv_ab(kp, lds); if (PROBE_DUP & 32) { __syncthreads(); phase_mod(kp, lds); __syncthreads(); phase_conv_ab(kp, lds); });
#pragma unroll
    for (int g = 0; g < NG; ++g) {
        PHASE(phase_u(kp, 0, g); if (PROBE_DUP & 128) phase_u(kp, 0, g););
        PHASE(phase_gemm_in(kp, lds, 0, g); if (PROBE_DUP & 8) phase_gemm_in(kp, lds, 0, g););
        PHASE(phase_xconv(kp); if (PROBE_DUP & 2048) phase_xconv(kp););
        PHASE(phase_scan_ab(kp, lds); if (PROBE_DUP & 1) { __syncthreads(); phase_scan_ab(kp, lds); });
        PHASE(phase_fin_ab(kp););
        PHASE(phase_gemm_out_ab(kp, lds); if (PROBE_DUP & 256) phase_gemm_out_ab(kp, lds););
        PHASE(phase_r(kp, lds, 0, g););
    }
    PHASE(phase_moe_gather(kp, 0); phase_conv_moe(kp, lds, 0); phase_conv_cd(kp, lds); if (PROBE_DUP & 64) { phase_moe_gather(kp, 0); phase_conv_moe(kp, lds, 0); phase_conv_cd(kp, lds); });
    PHASE(phase_moe_gemm(kp, lds, 0, false); if (PROBE_DUP & 16) { __syncthreads(); phase_moe_gemm(kp, lds, 0, false); });
    PHASE(phase_moe_gemm(kp, lds, 0, true); if (PROBE_DUP & 16) { __syncthreads(); phase_moe_gemm(kp, lds, 0, true); });
    PHASE(phase_combine(kp, 0););
#pragma unroll
    for (int g = 0; g < NG; ++g) {
        PHASE(phase_gemm_in(kp, lds, 1, g); if (PROBE_DUP & 8) phase_gemm_in(kp, lds, 1, g););
        PHASE(phase_prep_cd(kp););
        PHASE(phase_upproj(kp, lds); if (PROBE_DUP & 4096) phase_upproj(kp, lds););
        PHASE(phase_mix_cd(kp, lds, 3); if (PROBE_DUP & 2) { __syncthreads(); phase_mix_cd(kp, lds, 1); } if (PROBE_DUP & 4) { __syncthreads(); phase_mix_cd(kp, lds, 2); });
        PHASE(phase_fin_cd(kp, lds); if (PROBE_DUP & 4096) phase_fin_cd(kp, lds););
        PHASE(phase_gemm_out_cd(kp, lds); if (PROBE_DUP & 256) phase_gemm_out_cd(kp, lds););
        PHASE(phase_r(kp, lds, 1, g););
    }
    PHASE(phase_moe_gather(kp, 1); phase_conv_moe(kp, lds, 1););
    PHASE(phase_moe_gemm(kp, lds, 1, false););
    PHASE(phase_moe_gemm(kp, lds, 1, true););
    PHASE(phase_combine(kp, 1););
#undef PHASE
#undef IN
#undef SEAM
}

extern "C" void kernel_launch(void* const* d_in, const int* in_sizes, int n_in, void* d_out, int out_size, void* d_ws, size_t ws_size, hipStream_t stream) {
    static int grid = 0;
    if (grid == 0) {
        if (n_in != 42 || out_size != NLAT * D || ws_size < WS_NEED) { fprintf(stderr, "kernel_launch: unexpected shapes: n_in %d out %d ws %zu (need %zu)\n", n_in, out_size, ws_size, (size_t)WS_NEED); grid = -1; return; }
        int dev = 0, cus = 0, per_cu = 0;
        if (hipGetDevice(&dev) != hipSuccess || hipDeviceGetAttribute(&cus, hipDeviceAttributeMultiprocessorCount, dev) != hipSuccess) { grid = -1; return; }
        if (hipFuncSetAttribute((const void*)fwd_kernel, hipFuncAttributeMaxDynamicSharedMemorySize, LDS_BYTES) != hipSuccess) { fprintf(stderr, "kernel_launch: hipFuncSetAttribute failed\n"); grid = -1; return; }
        if (hipOccupancyMaxActiveBlocksPerMultiprocessor(&per_cu, (const void*)fwd_kernel, 512, LDS_BYTES) != hipSuccess || per_cu < 1) { fprintf(stderr, "kernel_launch: occupancy query says %d blocks per CU\n", per_cu); grid = -1; (void)hipGetLastError(); return; }
        grid = cus;
    }
    if (grid < 0) return;
    (void)hipMemsetAsync(d_ws, 0, CTL_BYTES, stream);
    KP kp{};
    for (int i = 0; i < 42; ++i) kp.in[i] = (const float*)d_in[i];
    kp.out = (float*)d_out; kp.ws = (unsigned char*)d_ws;
#if N_LAUNCH_MODE == 1
    kp.ph_lo = 0; kp.ph_hi = N_PHASES;
    hipLaunchKernelGGL(fwd_kernel, dim3(grid), dim3(512), LDS_BYTES, stream, kp);
#else
    for (int p = 0; p < N_PHASES; ++p) { kp.ph_lo = p; kp.ph_hi = p + 1; hipLaunchKernelGGL(fwd_kernel, dim3(grid), dim3(512), LDS_BYTES, stream, kp); }
#endif
}
```

```cpp
#include <hip/hip_runtime.h>
#include <stdint.h>
#include <stdio.h>

typedef unsigned short bf16_t;
typedef short bf16x8 __attribute__((ext_vector_type(8)));
typedef float f32x4 __attribute__((ext_vector_type(4)));
typedef float f32x2 __attribute__((ext_vector_type(2)));
typedef unsigned u32x4 __attribute__((ext_vector_type(4)));
typedef unsigned u32x2 __attribute__((ext_vector_type(2)));

#ifndef RWP
#define RWP 0
#endif
#ifndef PROBE_DUP
#define PROBE_DUP 0
#endif
#ifndef N_LAUNCH_MODE
#define N_LAUNCH_MODE 1
#endif

constexpr int NB = 16, SEQ = 2048, CTXL = 256, TT = 2304, D = 1024;
constexpr int NTOK = NB * TT, NLAT = NB * SEQ;
constexpr int NG = 2, BG = NB / NG, RG = BG * TT, RGL = BG * SEQ;
constexpr float EPS = 1e-6f;
constexpr int AB_N = 5424, AB_NPAD = 5632, AB_Q = 0, AB_K = 512, AB_V = 1024, AB_OG = 2048, AB_IG = 3072, AB_FG = 3080, AB_Z = 3088, AB_XBC = 4112, AB_DT = 5392;
constexpr int CD_N = 4128, CD_NPAD = 4352, CD_M0 = 0, CD_M1 = 384, CD_KR = 640, CD_R = 672, CD_K = 1696, CD_V = 2720, CD_WL = 3744, CD_AL = 3872, CD_GL = 4000;
constexpr int CD_RW0 = 672;

constexpr size_t CTL_BYTES = 32768;
constexpr size_t CTL_CNT = 16384;
constexpr size_t WS_MODV = CTL_BYTES;
constexpr size_t WS_HC   = WS_MODV + (size_t)2 * 17 * 6144 * 4;
constexpr size_t WS_TOKE = WS_HC + (size_t)NB * CTXL * D * 4;
constexpr size_t WS_TOKP = WS_TOKE + (size_t)NTOK * 2 * 4;
constexpr size_t WS_TOKW = WS_TOKP + (size_t)NTOK * 2 * 4;
constexpr size_t WS_LIST = WS_TOKW + (size_t)NTOK * 2 * 4;
constexpr size_t WS_BSC  = WS_LIST + (size_t)16 * NTOK * 4;
constexpr size_t WS_SG   = WS_BSC + (size_t)2 * RGL * 16 * 4;
constexpr size_t WS_WMIX = WS_SG + (size_t)RGL * 128 * 2;
constexpr size_t WMIX_BYTES = (size_t)16 << 20;
constexpr size_t WS_V    = WS_WMIX + WMIX_BYTES;
constexpr size_t WS_BIG  = WS_V + (size_t)NTOK * D * 2;
constexpr size_t WM_AB_IN = 0, WM_AB_OUT = (size_t)AB_NPAD * 1024 * 2;
constexpr size_t WM_CD_IN = 0, WM_CD_OUT = (size_t)CD_NPAD * 1024 * 2, WM_UQ = WM_CD_OUT + (size_t)1024 * 1536 * 2, WM_UKV = WM_UQ + (size_t)768 * 384 * 2, WM_G2 = WM_UKV + (size_t)1024 * 256 * 2;
static_assert(WM_AB_OUT + (size_t)1024 * 2048 * 2 <= WMIX_BYTES, "wmix ab");
static_assert(WM_G2 + (size_t)1024 * 128 * 2 <= WMIX_BYTES, "wmix cd");
constexpr size_t SZ_RG1K = (size_t)RG * 1024 * 2, SZ_RGL1K = (size_t)RGL * 1024 * 2;
constexpr size_t L0_P = 0, L0_AO = (size_t)RG * AB_N * 2  , L0_HB = L0_AO + 2 * SZ_RG1K, L0_YB = L0_HB + SZ_RG1K, L0_U = L0_YB + SZ_RG1K, L0_END = L0_U + SZ_RG1K;
constexpr size_t L1_P = 0, L1_Q = (size_t)RG * CD_N * 2, L1_KV = L1_Q + (size_t)RGL * 768 * 2, L1_OF = L1_KV + SZ_RG1K, L1_OB = L1_OF + SZ_RGL1K, L1_AOUT = L1_OB + SZ_RGL1K, L1_U = L1_AOUT + (size_t)RGL * 1536 * 2, L1_TWAL = L1_U + SZ_RG1K  , L1_END = L1_TWAL + (size_t)RG * 256 * 2;
constexpr int MOE_PADROWS = 16 * 256;
constexpr size_t MO_WUP = 0, MO_WDN = (size_t)17 * 1024 * 1024 * 2, MO_HID = MO_WDN + (size_t)17 * 1024 * 512 * 2;
constexpr size_t MO_XG = MO_HID + (size_t)(3 * NTOK + MOE_PADROWS) * 512 * 2;
constexpr size_t MO_CON = MO_XG, MO_END = MO_CON + (size_t)(3 * NTOK + MOE_PADROWS) * 1024 * 2;
constexpr size_t BIG_BYTES = MO_END > L0_END ? (MO_END > L1_END ? MO_END : L1_END) : (L0_END > L1_END ? L0_END : L1_END);
constexpr size_t WS_NEED = WS_BIG + BIG_BYTES;

constexpr int LDS_BYTES = 147456;

__device__ __forceinline__ float bf2f(unsigned short h) { return __uint_as_float(((unsigned)h) << 16); }
typedef __bf16 bf16v2_t __attribute__((ext_vector_type(2)));
__device__ __forceinline__ unsigned pack2(float a, float b) { const bf16v2_t h = __builtin_convertvector((f32x2){a, b}, bf16v2_t); return __builtin_bit_cast(unsigned, h); }
__device__ __forceinline__ unsigned short f2bf(float f) { const __bf16 h = (__bf16)f; return __builtin_bit_cast(unsigned short, h); }
__device__ __forceinline__ float lo2f(unsigned w) { return __uint_as_float(w << 16); }
__device__ __forceinline__ float hi2f(unsigned w) { return __uint_as_float(w & 0xffff0000u); }
__device__ __forceinline__ float wsum(float v) {
#pragma unroll
    for (int o = 32; o; o >>= 1) v += __shfl_xor(v, o);
    return v; }
__device__ __forceinline__ float frcp_(float x) { return __builtin_amdgcn_rcpf(x); }
__device__ __forceinline__ float sigmoidf_(float x) { return __builtin_amdgcn_rcpf(1.0f + __expf(-x)); }
__device__ __forceinline__ float siluf_(float x) { return x * __builtin_amdgcn_rcpf(1.0f + __expf(-x)); }
__device__ __forceinline__ float softplusf_(float x) { return fmaxf(x, 0.0f) + __logf(1.0f + __expf(-fabsf(x))); }
__device__ __forceinline__ float logsigmoidf_(float x) { return fminf(x, 0.0f) - __logf(1.0f + __expf(-fabsf(x))); }
__device__ __forceinline__ float tanhf_(float x) { return 1.0f - 2.0f * __builtin_amdgcn_rcpf(__expf(2.0f * x) + 1.0f); }
__device__ __forceinline__ f32x4 mma16(bf16x8 a, bf16x8 b, f32x4 c) { return __builtin_amdgcn_mfma_f32_16x16x32_bf16(a, b, c, 0, 0, 0); }
__device__ __forceinline__ bf16x8 ldfrag(const bf16_t* base, int ld, int row0, int k0, int fr, int fq) { return *(const bf16x8*)(base + (row0 + fr) * ld + k0 + fq * 8); }
__device__ __forceinline__ void st4bf(bf16_t* p, f32x4 v) { u32x2 w; w.x = pack2(v[0], v[1]); w.y = pack2(v[2], v[3]); *(u32x2*)p = w; }
__device__ __forceinline__ f32x4 ld4bf(const bf16_t* p) { u32x2 w = *(const u32x2*)p; return (f32x4){lo2f(w.x), hi2f(w.x), lo2f(w.y), hi2f(w.y)}; }

#define PHASE_FN __device__ __forceinline__
__device__ __forceinline__ int otid() { int t = threadIdx.x; asm volatile("" : "+v"(t)); return t; }
__device__ __forceinline__ int obid() { int t = blockIdx.x; asm volatile("" : "+s"(t)); return t; }
template <class T> __device__ __forceinline__ T* as_global(T* p) { return p; }
__device__ __forceinline__ void lds_barrier() { asm volatile("s_waitcnt lgkmcnt(0)" ::: "memory"); __builtin_amdgcn_s_barrier(); asm volatile("" ::: "memory"); }
struct KP { const float* in[42]; float* out; unsigned char* ws; int ph_lo, ph_hi; };

#define XB_TMO      128
#define XB_XCNT(j)  (256  + 64 * (j))
#define XB_XSUB(j)  (1280 + 64 * (j))
#define XB_XGEN(j)  (2304 + 64 * (j))
#define XB_TOP      3328
#define XB_TOPGEN   3392
#define XCD_BAR_WORDS 3456
#define XB_SPIN_CAP (1u << 18)
#define LAS __attribute__((address_space(3)))

__device__ __forceinline__ unsigned xb_ld(unsigned* p)              { return __hip_atomic_load(p, __ATOMIC_RELAXED, __HIP_MEMORY_SCOPE_AGENT); }
__device__ __forceinline__ unsigned xb_add(unsigned* p, unsigned v) { return __hip_atomic_fetch_add(p, v, __ATOMIC_RELAXED, __HIP_MEMORY_SCOPE_AGENT); }
__device__ __forceinline__ unsigned xb_xcc_id() { return (unsigned)__builtin_amdgcn_s_getreg((3 << 11) | 20) & 0xFu; }
#define XB_SPIN(cond, bar) do { unsigned _sp = 0; while (cond) { __builtin_amdgcn_s_sleep(1); \
    if ((++_sp & 255u) == 0u) { if (xb_ld(&(bar)[XB_TMO])) break; if (_sp > XB_SPIN_CAP) { atomicAdd(&(bar)[XB_TMO], 1u); break; } } } } while (0)

struct XcdBarrier {
    unsigned* bar; unsigned x;
    volatile LAS unsigned* st;
};

__device__ __forceinline__ XcdBarrier xcd_barrier_post(unsigned* bar, volatile LAS unsigned* st) {
    XcdBarrier b; b.bar = bar; b.x = xb_xcc_id(); b.st = st;
    if (threadIdx.x == 0) (void)xb_add(&bar[XB_XCNT(b.x)], 1u);
    return b;
}
__device__ __forceinline__ void xcd_barrier_complete(unsigned* bar, unsigned x, unsigned& nloc, unsigned& nx) {
    const unsigned G = gridDim.x * gridDim.y * gridDim.z;
    unsigned sum, cnt, mine, sp = 0u;
    for (;;) {
        sum = 0u; cnt = 0u; mine = 0u;
#pragma unroll
        for (unsigned j = 0; j < 16; ++j) { const unsigned c = xb_ld(&bar[XB_XCNT(j)]); sum += c; cnt += (c > 0u) ? 1u : 0u; mine = (j == x) ? c : mine; }
        if (sum == G) break;
        __builtin_amdgcn_s_sleep(1);
        if ((++sp & 255u) == 0u) { if (xb_ld(&bar[XB_TMO])) break; if (sp > XB_SPIN_CAP) { atomicAdd(&bar[XB_TMO], 1u); break; } }
    }
    nloc = mine > 0u ? mine : 1u; nx = cnt > 0u ? cnt : 1u;
}

__device__ __forceinline__ void xcd_barrier(const XcdBarrier& b) {
    asm volatile("s_waitcnt vmcnt(0)" ::: "memory");
    __syncthreads();
    if (threadIdx.x == 0) {
        unsigned* bar = b.bar;
        __builtin_amdgcn_s_waitcnt(0);
        unsigned nloc = b.st[0], nx = b.st[1];
        if (nloc == 0u) { xcd_barrier_complete(bar, b.x, nloc, nx); b.st[0] = nloc; b.st[1] = nx; }
        const unsigned old = xb_add(&bar[XB_XSUB(b.x)], 1u);
        const unsigned gen = old / nloc;
        if (old + 1u == (gen + 1u) * nloc) {
            __builtin_amdgcn_fence(__ATOMIC_RELEASE, "agent");
            asm volatile("s_waitcnt vmcnt(0)" ::: "memory");
            const unsigned og = xb_add(&bar[XB_TOP], 1u);
            const unsigned tg = og / nx;
            if (og + 1u == (tg + 1u) * nx) xb_add(&bar[XB_TOPGEN], 1u);
            else XB_SPIN(xb_ld(&bar[XB_TOPGEN]) == tg, bar);
            __builtin_amdgcn_fence(__ATOMIC_ACQUIRE, "agent");
            xb_add(&bar[XB_XGEN(b.x)], 1u);
            asm volatile("s_waitcnt vmcnt(0)" ::: "memory");
        } else {
            XB_SPIN(xb_ld(&bar[XB_XGEN(b.x)]) == gen, bar);
            __builtin_amdgcn_fence(__ATOMIC_ACQUIRE, "agent");
            asm volatile("s_waitcnt vmcnt(0)" ::: "memory");
        }
    }
    __syncthreads();
}
struct GA {
    const bf16_t* a0; const bf16_t* a1;
    int ld0, ld1, ksplit;
    const int* list;
    int nrows;
    int mode;
    int row0;
};
constexpr int G_LDT = 40;
constexpr int GEMM_LDS = (2 * 256 * G_LDT + 2 * 128 * G_LDT) * 2;

template <class Epi>
__device__ __forceinline__ void gemm_tile(unsigned char* lds, const GA& ga, const bf16_t* __restrict__ Bt, int K, int mt, int nt, const Epi& epi) {
    const int tid = otid(), lane = tid & 63, wid = __builtin_amdgcn_readfirstlane(tid >> 6), wm = wid >> 1, wn = wid & 1, fr = lane & 15, fq = lane >> 4;
    bf16_t* sA = (bf16_t*)lds;
    bf16_t* sB = sA + 2 * 256 * G_LDT;
    const int kp = tid & 3;
    const int r0 = tid >> 2, r1 = r0 + 128;
    int s0, s1;
    {
        int lr = mt * 256 + r0; if (lr >= ga.nrows) lr = 0;
        s0 = ga.list ? ga.list[lr] : (ga.mode == 1 ? (lr >> 11) * TT + CTXL + (lr & 2047) : ga.row0 + lr);
        lr = mt * 256 + r1; if (lr >= ga.nrows) lr = 0;
        s1 = ga.list ? ga.list[lr] : (ga.mode == 1 ? (lr >> 11) * TT + CTXL + (lr & 2047) : ga.row0 + lr);
    }
    const bf16_t* pa00 = ga.a0 + (size_t)s0 * ga.ld0 + kp * 8;
    const bf16_t* pa01 = ga.a0 + (size_t)s1 * ga.ld0 + kp * 8;
    const bf16_t* pa10 = ga.a1 ? ga.a1 + (size_t)s0 * ga.ld1 + kp * 8 : pa00;
    const bf16_t* pa11 = ga.a1 ? ga.a1 + (size_t)s1 * ga.ld1 + kp * 8 : pa01;
    const bf16_t* pb = Bt + (size_t)(nt * 128 + r0) * K + kp * 8;
    const int ksplit = ga.ksplit;
    f32x4 acc[4][4];
#pragma unroll
    for (int i = 0; i < 4; ++i)
#pragma unroll
        for (int j = 0; j < 4; ++j) acc[i][j] = (f32x4){0.f, 0.f, 0.f, 0.f};
    const int nk = K >> 5;
    u32x4 ra0, ra1, rb;
    {
        ra0 = *(const u32x4*)(pa00); ra1 = *(const u32x4*)(pa01); rb = *(const u32x4*)(pb);
        if (0 >= ksplit) { ra0 = *(const u32x4*)(pa10); ra1 = *(const u32x4*)(pa11); }
    }
    *(u32x4*)(sA + (r0) * G_LDT + kp * 8) = ra0;
    *(u32x4*)(sA + (r1) * G_LDT + kp * 8) = ra1;
    *(u32x4*)(sB + (r0) * G_LDT + kp * 8) = rb;
    __syncthreads();
    for (int kt = 0; kt < nk; ++kt) {
        const int cur = kt & 1;
        if (kt + 1 < nk) {
            const int k0 = (kt + 1) << 5;
            if (k0 < ksplit) { ra0 = *(const u32x4*)(pa00 + k0); ra1 = *(const u32x4*)(pa01 + k0); }
            else { ra0 = *(const u32x4*)(pa10 + (k0 - ksplit)); ra1 = *(const u32x4*)(pa11 + (k0 - ksplit)); }
            rb = *(const u32x4*)(pb + k0);
        }
        const bf16_t* cA = sA + cur * 256 * G_LDT;
        const bf16_t* cB = sB + cur * 128 * G_LDT;
        bf16x8 af[4], bfr[4];
#pragma unroll
        for (int i = 0; i < 4; ++i) af[i] = ldfrag(cA, G_LDT, wm * 64 + i * 16, 0, fr, fq);
#pragma unroll
        for (int j = 0; j < 4; ++j) bfr[j] = ldfrag(cB, G_LDT, wn * 64 + j * 16, 0, fr, fq);
#pragma unroll
        for (int i = 0; i < 4; ++i)
#pragma unroll
            for (int j = 0; j < 4; ++j) acc[i][j] = mma16(bfr[j], af[i], acc[i][j]);
        if (kt + 1 < nk) {
            const int nb = cur ^ 1;
            *(u32x4*)(sA + (nb * 256 + r0) * G_LDT + kp * 8) = ra0;
            *(u32x4*)(sA + (nb * 256 + r1) * G_LDT + kp * 8) = ra1;
            *(u32x4*)(sB + (nb * 128 + r0) * G_LDT + kp * 8) = rb;
        }
        __syncthreads();
    }
    epi(acc, mt * 256 + wm * 64, nt * 128 + wn * 64, fr, fq);
}

struct EpiBf {
    bf16_t* out; int ld, nrows, ncols;
    __device__ __forceinline__ void operator()(const f32x4 (&acc)[4][4], int rb, int cb, int fr, int fq) const {
#pragma unroll
        for (int i = 0; i < 4; ++i) { const int lr = rb + i * 16 + fr; if (lr < nrows) {
#pragma unroll
            for (int j = 0; j < 4; ++j) { const int col = cb + j * 16 + fq * 4; if (col < ncols) st4bf(out + (size_t)lr * ld + col, acc[i][j]); } } }
    }
};
struct EpiSwiglu {
    bf16_t* out; int nrows;
    __device__ __forceinline__ void operator()(const f32x4 (&acc)[4][4], int rb, int cb, int fr, int fq) const {
#pragma unroll
        for (int i = 0; i < 4; ++i) { const int lr = rb + i * 16 + fr; if (lr < nrows) {
#pragma unroll
            for (int j = 0; j < 2; ++j) { const int col = (cb >> 1) + j * 16 + fq * 4; f32x4 g = acc[i][j], u = acc[i][j + 2], o;
#pragma unroll
                for (int r = 0; r < 4; ++r) o[r] = siluf_(g[r]) * u[r];
                st4bf(out + (size_t)lr * 512 + col, o); } } }
    }
};

namespace pg8 {
#define PG8_LAS __attribute__((address_space(3)))
typedef unsigned short bf16_t;
typedef short bf16x8 __attribute__((ext_vector_type(8)));
typedef float f32x4 __attribute__((ext_vector_type(4)));
typedef unsigned u32x4 __attribute__((ext_vector_type(4)));
constexpr int BM = 256, BK = 64, HALF = 128, HTB = HALF * BK * 2  , STAGE_BYTES = 8 * HTB, NXCD = 8, WGM = 8;

__host__ __device__ __forceinline__ int lds_byte(int r, int c) { const int st = (r >> 4) * 2 + (c >> 5), rr = r & 15, cc = c & 31, ob = rr * 64 + cc * 2; return st * 1024 + (ob ^ (((ob >> 9) & 1) << 5)); }
__host__ __device__ __forceinline__ void stage_rc(int b, int& R, int& C) { const int st = b / 1024, sb = b % 1024, swz = sb ^ (((sb >> 9) & 1) << 5); R = (st >> 1) * 16 + swz / 64; C = (st & 1) * 32 + (swz % 64) / 2; }
__host__ __device__ __forceinline__ int perm32(int rho) { const int n = rho >> 4, i = rho & 15; return 8 * (i >> 2) + 4 * n + (i & 3); }

struct Unit { int pm, pn; };
struct Gemm { const bf16_t* A; const bf16_t* Bt; int M, N, K; const bf16_t* A2; int pm_split; int lda, amode; };
#define PG8_ABASE(g, pm) ((g).amode == 1 ? (const char*)(g).A + (size_t)(((pm) >> 3) * 2304 + 256 + ((pm) & 7) * 256) * lda_ * 2 : ((pm) < (g).pm_split ? (const char*)(g).A + (size_t)(pm) * tstepA : (const char*)(g).A2 + (size_t)((pm) - (g).pm_split) * tstepA))
struct StaticOrder {
    int nM, nN, nwg, G, c;
    __host__ __device__ void init(int M, int N, int G_, int c_) { nM = M / BM; nN = N / BM; nwg = nM * nN; G = G_; c = c_; }
    __host__ __device__ bool next(int i, Unit& u) const {
        const long L = (long)i * G + c; if (L >= nwg) return false;
        int wgid = (int)L; { const int q = nwg / NXCD, r = nwg % NXCD, xcd = wgid % NXCD, off = wgid / NXCD; wgid = (xcd < r ? xcd * (q + 1) : r * (q + 1) + (xcd - r) * q) + off; }
        const int nig = WGM * nN, gid = wgid / nig, fm = gid * WGM, gsz = (nM - fm) < WGM ? (nM - fm) : WGM;
        u.pm = fm + ((wgid % nig) % gsz); u.pn = (wgid % nig) / gsz; return true;
    }
    __device__ __forceinline__ void a_ready(const Unit&) const {}
    __device__ __forceinline__ void done(const Unit&) const {}
};
__device__ __forceinline__ unsigned cvt_pk_bf16(float lo, float hi) { unsigned r; asm volatile("v_cvt_pk_bf16_f32 %0, %1, %2" : "=v"(r) : "v"(lo), "v"(hi)); return r; }
typedef float f32x2 __attribute__((ext_vector_type(2)));
template <class Epi, class Sched, bool STAMP = false>
__device__ __forceinline__ void gemm_phase(PG8_LAS unsigned char* lds, const Gemm g, const Sched& S, const Epi& E, unsigned long long* stamps) {
    const int tid = otid(), wid = __builtin_amdgcn_readfirstlane(tid >> 6), lane = tid & 63, wr = wid >> 2, wc = wid & 3, fr = lane & 15, fq = lane >> 4;
    const int K = g.K, nt = K / BK, lda_ = g.lda ? g.lda : g.K;
    int ts_lo = 0, ts_hi = 0, nts = 0; const unsigned long long rt_entry = STAMP ? (unsigned long long)wall_clock64() : 0ull;
#define PG8_STAMP() do { if (STAMP && wid == 0 && nts < 64) { const unsigned long long _c = (unsigned long long)clock64(); \
        ts_lo = (lane == nts) ? (int)(unsigned)_c : ts_lo; ts_hi = (lane == nts) ? (int)(unsigned)(_c >> 32) : ts_hi; ++nts; } } while (0)
    PG8_STAMP();
    unsigned voffA[2], voffB[2];
#pragma unroll
    for (int i = 0; i < 2; ++i) { int R, C; stage_rc(tid * 16 + i * 8192, R, C); const int Rb = Epi::PERM ? ((R & ~31) + perm32(R & 31)) : R;
        voffA[i] = (unsigned)(R * lda_ + C) * 2u; voffB[i] = (unsigned)(Rb * K + C) * 2u; }
    const size_t kstep = (size_t)(BK * 2);
    const size_t hstep = (size_t)HALF * K * 2;
    const size_t hstepA = (size_t)HALF * lda_ * 2, tstepA = 2 * hstepA;
    const size_t tstep = 2 * hstep;
    const unsigned ldsw = (unsigned)wid * 1024u;
    const int aoff = lds_byte(wr * 64 + fr, fq * 8), boff = lds_byte(wc * 32 + fr, fq * 8);
#define PG8_SA(b, h) (((b) * 2 + (h)) * HTB)
#define PG8_SB(b, h) ((4 + (b) * 2 + (h)) * HTB)
#define PG8_STAGE(bufoff, gbase, voff) do { _Pragma("unroll") for (int _i = 0; _i < 2; ++_i) \
        __builtin_amdgcn_global_load_lds((const unsigned*)((const char*)(gbase) + (voff)[_i]), (PG8_LAS unsigned*)(lds + (bufoff) + ldsw + _i * 8192), 16, 0, 0); } while (0)
#define PG8_LDA(dst, b, h) do { _Pragma("unroll") for (int m = 0; m < 4; ++m) _Pragma("unroll") for (int k = 0; k < 2; ++k) dst[m][k] = *(const PG8_LAS bf16x8*)(lds + PG8_SA(b, h) + aoff + m * 2048 + k * 1024); } while (0)
#define PG8_LDB(dst, b, h) do { _Pragma("unroll") for (int n = 0; n < 2; ++n) _Pragma("unroll") for (int k = 0; k < 2; ++k) dst[n][k] = *(const PG8_LAS bf16x8*)(lds + PG8_SB(b, h) + boff + n * 2048 + k * 1024); } while (0)
#define PG8_MMA(ai, bj, At, Bt) do { __builtin_amdgcn_s_setprio(1); _Pragma("unroll") for (int m = 0; m < 4; ++m) _Pragma("unroll") for (int n = 0; n < 2; ++n) _Pragma("unroll") for (int k = 0; k < 2; ++k) \
        acc[ai][bj][m][n] = __builtin_amdgcn_mfma_f32_16x16x32_bf16(Bt[n][k], At[m][k], acc[ai][bj][m][n], 0, 0, 0); __builtin_amdgcn_s_setprio(0); } while (0)
#define PG8_WAIT_V(n) asm volatile("s_waitcnt vmcnt(" #n ")" ::: "memory")
#define PG8_WAIT_L(n) asm volatile("s_waitcnt lgkmcnt(" #n ")" ::: "memory")
#define PG8_BAR __builtin_amdgcn_s_barrier()
#define PG8_SCHED __builtin_amdgcn_sched_barrier(0)
    Unit cur, nxt; int ui = 0;
    if (!S.next(0, cur)) return;
    f32x4 acc[2][2][4][2];
#pragma unroll
    for (int a = 0; a < 2; ++a)
#pragma unroll
        for (int b = 0; b < 2; ++b)
#pragma unroll
            for (int m = 0; m < 4; ++m)
#pragma unroll
                for (int n = 0; n < 2; ++n) acc[a][b][m][n] = (f32x4){0.f, 0.f, 0.f, 0.f};
    bf16x8 At[4][2], B0[2][2], B1[2][2];
    const char* cA = PG8_ABASE(g, cur.pm); const char* cB = (const char*)g.Bt + (size_t)cur.pn * tstep;
    S.a_ready(cur);
    PG8_STAGE(PG8_SB(0, 0), cB, voffB); PG8_STAGE(PG8_SA(0, 0), cA, voffA); PG8_STAGE(PG8_SB(0, 1), cB + hstep, voffB); PG8_STAGE(PG8_SA(0, 1), cA + hstepA, voffA);
    if (wr == 1) PG8_BAR;
    PG8_WAIT_V(4); PG8_BAR;
    PG8_STAGE(PG8_SB(1, 0), cB + kstep, voffB); PG8_STAGE(PG8_SA(1, 0), cA + kstep, voffA); PG8_STAGE(PG8_SB(1, 1), cB + hstep + kstep, voffB);
    PG8_WAIT_V(6); PG8_BAR;
    PG8_STAMP();
    for (;;) {
        const bool has_next = S.next(ui + 1, nxt);
        const char* nA = has_next ? PG8_ABASE(g, nxt.pm) : cA; const char* nB = has_next ? (const char*)g.Bt + (size_t)nxt.pn * tstep : cB;
        for (int t = 0; t < nt; t += 2) {
            const bool last = (t == nt - 2);
            const char* a1 = cA + (size_t)(t + 1) * kstep;
            const char* a2 = last ? nA : cA + (size_t)(t + 2) * kstep; const char* b2 = last ? nB : cB + (size_t)(t + 2) * kstep;
            const char* a3 = a2 + kstep; const char* b3 = b2 + kstep;
            if (last && has_next) S.a_ready(nxt);
            PG8_LDB(B0, 0, 0); PG8_SCHED; PG8_LDA(At, 0, 0); PG8_STAGE(PG8_SA(1, 1), a1 + hstepA, voffA);
            PG8_WAIT_L(8); PG8_BAR; PG8_WAIT_L(0); PG8_MMA(0, 0, At, B0); PG8_BAR; PG8_SCHED;
            PG8_LDB(B1, 0, 1); PG8_STAGE(PG8_SB(0, 0), b2, voffB);
            PG8_BAR; PG8_WAIT_L(0); PG8_MMA(0, 1, At, B1); PG8_BAR;
            PG8_LDA(At, 0, 1); PG8_STAGE(PG8_SA(0, 0), a2, voffA);
            PG8_BAR; PG8_WAIT_L(0); PG8_MMA(1, 0, At, B0); PG8_BAR; PG8_SCHED;
            PG8_STAGE(PG8_SB(0, 1), b2 + hstep, voffB);
            PG8_WAIT_V(6); PG8_BAR; PG8_MMA(1, 1, At, B1); PG8_BAR;
            PG8_LDB(B0, 1, 0); PG8_SCHED; PG8_LDA(At, 1, 0); PG8_STAGE(PG8_SA(0, 1), a2 + hstepA, voffA);
            PG8_WAIT_L(8); PG8_BAR; PG8_WAIT_L(0); PG8_MMA(0, 0, At, B0); PG8_BAR; PG8_SCHED;
            PG8_LDB(B1, 1, 1); PG8_STAGE(PG8_SB(1, 0), b3, voffB);
            PG8_BAR; PG8_WAIT_L(0); PG8_MMA(0, 1, At, B1); PG8_BAR;
            PG8_LDA(At, 1, 1); PG8_STAGE(PG8_SA(1, 0), a3, voffA);
            PG8_BAR; PG8_WAIT_L(0); PG8_MMA(1, 0, At, B0); PG8_BAR; PG8_SCHED;
            PG8_STAGE(PG8_SB(1, 1), b3 + hstep, voffB);
            PG8_WAIT_V(6); PG8_BAR; PG8_MMA(1, 1, At, B1); PG8_BAR;
        }
        PG8_STAMP();
        if constexpr (!Epi::AFTER_DRAIN) { E(acc, cur, wr, wc, fr, fq); S.done(cur); }
        PG8_STAMP();
        if (!has_next) break;
#pragma unroll
        for (int a = 0; a < 2; ++a)
#pragma unroll
            for (int b = 0; b < 2; ++b)
#pragma unroll
                for (int m = 0; m < 4; ++m)
#pragma unroll
                    for (int n = 0; n < 2; ++n) acc[a][b][m][n] = (f32x4){0.f, 0.f, 0.f, 0.f};
        cur = nxt; cA = nA; cB = nB; ++ui;
    }
    PG8_WAIT_V(0);
    if (wr == 0) PG8_BAR;
    PG8_BAR;
    if constexpr (Epi::AFTER_DRAIN) { E.fused(acc, cur, wr, wc, fr, fq, lds, wid, lane); S.done(cur); }
    PG8_STAMP();
    if (STAMP && wid == 0) { stamps[lane] = lane < nts ? (((unsigned long long)(unsigned)ts_hi << 32) | (unsigned)ts_lo) : 0ull;
        if (lane == 62) stamps[62] = rt_entry; if (lane == 63) stamps[63] = (unsigned long long)wall_clock64(); }
#undef PG8_STAMP
#undef PG8_SA
#undef PG8_SB
#undef PG8_STAGE
#undef PG8_LDA
#undef PG8_LDB
#undef PG8_MMA
#undef PG8_WAIT_V
#undef PG8_WAIT_L
#undef PG8_BAR
#undef PG8_SCHED
}
}
namespace pg8 {
struct EpiBfG {
    static constexpr bool PERM = true, AFTER_DRAIN = false;
    bf16_t* O; int ldc, ncols, pn_mask;
    __device__ __forceinline__ void operator()(const f32x4 (&acc)[2][2][4][2], const Unit& u, int wr, int wc, int fr, int fq) const {
        const int row0 = u.pm * BM + wr * 64 + fr, col0 = (u.pn & pn_mask) * BM + wc * 32 + 8 * fq;
#pragma unroll
        for (int ai = 0; ai < 2; ++ai)
#pragma unroll
            for (int m = 0; m < 4; ++m) { bf16_t* rowp = O + (size_t)(row0 + ai * HALF + m * 16) * ldc;
#pragma unroll
                for (int bj = 0; bj < 2; ++bj) { const int c = col0 + bj * HALF;
                    if (c < ncols) { const f32x4 v0 = acc[ai][bj][m][0], v1 = acc[ai][bj][m][1];
                        u32x4 w; w.x = cvt_pk_bf16(v0[0], v0[1]); w.y = cvt_pk_bf16(v0[2], v0[3]); w.z = cvt_pk_bf16(v1[0], v1[1]); w.w = cvt_pk_bf16(v1[2], v1[3]);
                        *(u32x4*)(rowp + c) = w; } } }
    }
};
struct EpiSwi {
    static constexpr bool PERM = true, AFTER_DRAIN = false;
    bf16_t* H;
    __device__ __forceinline__ void operator()(const f32x4 (&acc)[2][2][4][2], const Unit& u, int wr, int wc, int fr, int fq) const {
        const int row0 = u.pm * BM + wr * 64 + fr, hc0 = (u.pn & 3) * HALF + wc * 32 + 8 * fq;
#pragma unroll
        for (int ai = 0; ai < 2; ++ai)
#pragma unroll
            for (int m = 0; m < 4; ++m) { bf16_t* rowp = H + (size_t)(row0 + ai * HALF + m * 16) * 512 + hc0;
                float o[8];
#pragma unroll
                for (int n = 0; n < 2; ++n)
#pragma unroll
                    for (int r = 0; r < 4; ++r) { const float g = acc[ai][0][m][n][r]; o[n * 4 + r] = g * __builtin_amdgcn_rcpf(1.0f + __expf(-g)) * acc[ai][1][m][n][r]; }
                u32x4 w; w.x = cvt_pk_bf16(o[0], o[1]); w.y = cvt_pk_bf16(o[2], o[3]); w.z = cvt_pk_bf16(o[4], o[5]); w.w = cvt_pk_bf16(o[6], o[7]);
                *(u32x4*)rowp = w; }
    }
};
struct MoeOrder {
    const int* slotmap; int ntiles, G, c;
    __device__ __forceinline__ bool next(int i, Unit& u) const {
        const int L = i * G + c; if (L >= ntiles * 4) return false;
        u.pm = L >> 2; u.pn = __builtin_amdgcn_readfirstlane(slotmap[L >> 2]) * 4 + (L & 3); return true;
    }
    __device__ __forceinline__ void a_ready(const Unit&) const {}
    __device__ __forceinline__ void done(const Unit&) const {}
};
}
#define WSP(T, off) as_global((T*)(kp.ws + (off)))
#define KIN(i) as_global(kp.in[i])
#define KOUT as_global(kp.out)

PHASE_FN void phase_mod(const KP& kp, unsigned char* lds) {
    float* sc = (float*)lds;
    float* red = sc + 17 * 1024;
    float* modv = WSP(float, WS_MODV);
    const int tid = otid();
    for (int i = tid; i < 17 * 1024; i += 512) { const int bb = i >> 10, k = i & 1023; const float c = bb < 16 ? KIN(1)[bb * 1024 + k] : KIN(3)[k]; sc[i] = siluf_(c); }
    __syncthreads();
    const int jc = tid & 63, ks = tid >> 6;
    for (int u = obid(); u < 192; u += gridDim.x) {
        const int l = u / 96, j0 = (u % 96) * 64;
        const float* w = KIN(4) + (size_t)l * 1024 * 6144 + j0 + jc;
        float acc[17];
#pragma unroll
        for (int bb = 0; bb < 17; ++bb) acc[bb] = 0.f;
        for (int k = ks * 128; k < ks * 128 + 128; ++k) {
            const float wv = w[(size_t)k * 6144];
#pragma unroll
            for (int bb = 0; bb < 17; ++bb) acc[bb] += sc[bb * 1024 + k] * wv;
        }
#pragma unroll
        for (int bb = 0; bb < 17; ++bb) red[(ks * 17 + bb) * 64 + jc] = acc[bb];
        __syncthreads();
        for (int i = tid; i < 17 * 64; i += 512) {
            const int bb = i >> 6, j = i & 63; float s = KIN(5)[l * 6144 + j0 + j];
#pragma unroll
            for (int k2 = 0; k2 < 8; ++k2) s += red[(k2 * 17 + bb) * 64 + j];
            modv[((size_t)l * 17 + bb) * 6144 + j0 + j] = s;
        }
        __syncthreads();
    }
}

struct CvJob { const float* src; bf16_t* dst; int N, ldd, mode, kt, ntile; };
__device__ __forceinline__ bool cv_pick(int& u, CvJob& J, const float* src, int K, int N, bf16_t* dst, int mode = 0, int ldd = -1) {
    const int ntl = (N + 63) >> 6, cnt = ntl * (K >> 6);
    if (u < cnt) { J.src = src; J.dst = dst; J.N = N; J.ldd = ldd < 0 ? K : ldd; J.mode = mode; J.kt = u / ntl; J.ntile = u % ntl; return true; }
    u -= cnt; return false;
}
__device__ __forceinline__ void cv_load(const CvJob& J, int tid, f32x4 (&r)[2]) {
#pragma unroll
    for (int i = 0; i < 2; ++i) { const int idx = tid + i * 512, k = idx >> 4, n0 = J.ntile * 64 + (idx & 15) * 4;
        r[i] = (n0 < J.N) ? *(const f32x4*)(J.src + (size_t)(J.kt * 64 + k) * J.N + n0) : (f32x4){0.f, 0.f, 0.f, 0.f}; }
}
__device__ __forceinline__ void cv_put(float* tile, int tid, const f32x4 (&r)[2]) {
#pragma unroll
    for (int i = 0; i < 2; ++i) { const int idx = tid + i * 512, k = idx >> 4, nq = (idx & 15) * 4;
        tile[k * 65 + nq] = r[i][0]; tile[k * 65 + nq + 1] = r[i][1]; tile[k * 65 + nq + 2] = r[i][2]; tile[k * 65 + nq + 3] = r[i][3]; }
}
__device__ __forceinline__ void cv_store(const float* tile, const CvJob& J, int tid) {
    const int nl = tid >> 3, k8 = tid & 7, n = J.ntile * 64 + nl;
    if (n < J.N) { int row = n; if (J.mode) row = (n >> 7) * 256 + (n & 127) + (J.mode == 2 ? 128 : 0);
        u32x4 w; const float* tp = tile + (k8 * 8) * 65 + nl;
        w.x = pack2(tp[0], tp[65]); w.y = pack2(tp[130], tp[195]); w.z = pack2(tp[260], tp[325]); w.w = pack2(tp[390], tp[455]);
        *(u32x4*)(J.dst + (size_t)row * J.ldd + J.kt * 64 + k8 * 8) = w; }
}
#define CV_RUN(total, PICK) do { float* tile = (float*)lds; const int tid = otid(); const int G_ = gridDim.x; int u_ = obid(); CvJob J, Jn; f32x4 r[2]; \
        if (u_ < (total)) { int u = u_; PICK(u, J); cv_load(J, tid, r); } \
        while (u_ < (total)) { cv_put(tile, tid, r); __syncthreads(); const int un_ = u_ + G_; \
            if (un_ < (total)) { int u = un_; PICK(u, Jn); cv_load(Jn, tid, r); } \
            cv_store(tile, J, tid); __syncthreads(); u_ = un_; J = Jn; } } while (0)
PHASE_FN void phase_conv_ab(const KP& kp, unsigned char* lds) {
#define PICK_AB(u, J) do { if (!cv_pick(u, J, KIN(7), 1024, AB_N, WSP(bf16_t, WS_WMIX + WM_AB_IN))) cv_pick(u, J, KIN(8), 2048, 1024, WSP(bf16_t, WS_WMIX + WM_AB_OUT)); } while (0)
    CV_RUN(16 * 85 + 32 * 16, PICK_AB);
#undef PICK_AB
}
PHASE_FN void phase_conv_cd(const KP& kp, unsigned char* lds) {
#define PICK_CD(u, J) do { if (cv_pick(u, J, KIN(18), 1024, CD_N, WSP(bf16_t, WS_WMIX + WM_CD_IN))) break; \
        if (cv_pick(u, J, KIN(19), 1536, 1024, WSP(bf16_t, WS_WMIX + WM_CD_OUT))) break; \
        if (cv_pick(u, J, KIN(21), 384, 768, WSP(bf16_t, WS_WMIX + WM_UQ))) break; \
        if (cv_pick(u, J, KIN(23), 256, 1024, WSP(bf16_t, WS_WMIX + WM_UKV))) break; \
        cv_pick(u, J, KIN(29), 128, 1024, WSP(bf16_t, WS_WMIX + WM_G2)); } while (0)
    CV_RUN(16 * 65 + 24 * 16 + 6 * 12 + 4 * 16 + 2 * 16, PICK_CD);
#undef PICK_CD
}
PHASE_FN void phase_conv_moe(const KP& kp, unsigned char* lds, int l) {
#define PICK_MOE(u0, J) do { const int es = (u0) / 384; int uu = (u0) % 384; \
        const float* wg = es < 16 ? KIN(36) + ((size_t)l * 16 + es) * 1024 * 512 : KIN(39) + (size_t)l * 1024 * 512; \
        const float* wu = es < 16 ? KIN(37) + ((size_t)l * 16 + es) * 1024 * 512 : KIN(40) + (size_t)l * 1024 * 512; \
        const float* wd = es < 16 ? KIN(38) + ((size_t)l * 16 + es) * 512 * 1024 : KIN(41) + (size_t)l * 512 * 1024; \
        bf16_t* dup = WSP(bf16_t, WS_BIG + MO_WUP) + (size_t)es * 1024 * 1024; bf16_t* ddn = WSP(bf16_t, WS_BIG + MO_WDN) + (size_t)es * 1024 * 512; \
        if (cv_pick(uu, J, wg, 1024, 512, dup, 1, 1024)) break; if (cv_pick(uu, J, wu, 1024, 512, dup, 2, 1024)) break; cv_pick(uu, J, wd, 512, 1024, ddn, 0, 512); } while (0)
    CV_RUN(17 * 384, PICK_MOE);
#undef PICK_MOE
}

__device__ __forceinline__ const float* hrow_rd(const KP& kp, bool from_inputs, int b, int t) {
    if (t < CTXL) return (from_inputs ? KIN(2) : WSP(const float, WS_HC)) + ((size_t)b * CTXL + t) * D;
    return (from_inputs ? KIN(0) : KOUT) + ((size_t)b * SEQ + (t - CTXL)) * D;
}
__device__ __forceinline__ float* hrow_wr(const KP& kp, int b, int t) {
    if (t < CTXL) return WSP(float, WS_HC) + ((size_t)b * CTXL + t) * D;
    return KOUT + ((size_t)b * SEQ + (t - CTXL)) * D;
}

PHASE_FN void phase_u(const KP& kp, int layer, int g) {
    const int lane = otid() & 63, wid = __builtin_amdgcn_readfirstlane(otid() >> 6);
    const float* modv = WSP(const float, WS_MODV) + (size_t)layer * 17 * 6144;
    const float* ng = KIN(6) + (size_t)layer * 4 * 1024;
    bf16_t* U = WSP(bf16_t, WS_BIG + (layer == 0 ? L0_U : L1_U));
    for (int lr = obid() * 8 + wid; lr < RG; lr += gridDim.x * 8) {
        const int bl = lr / TT, t = lr - bl * TT, b = g * BG + bl;
        const float* src = hrow_rd(kp, layer == 0, b, t);
        const float* mv = modv + (size_t)(t < CTXL ? 16 : b) * 6144;
        f32x4 x[4]; float ss = 0.f;
#pragma unroll
        for (int i = 0; i < 4; ++i) { x[i] = *(const f32x4*)(src + i * 256 + lane * 4); ss += x[i][0] * x[i][0] + x[i][1] * x[i][1] + x[i][2] * x[i][2] + x[i][3] * x[i][3]; }
        ss = wsum(ss); const float rstd = rsqrtf(ss * (1.0f / 1024.0f) + EPS);
#pragma unroll
        for (int i = 0; i < 4; ++i) { const int col = i * 256 + lane * 4;
            const f32x4 gv = *(const f32x4*)(ng + col), sc = *(const f32x4*)(mv + 1024 + col), sh = *(const f32x4*)(mv + col);
            st4bf(U + (size_t)lr * 1024 + col, x[i] * rstd * gv * (sc + 1.0f) + sh); }
    }
}

PHASE_FN void phase_r(const KP& kp, unsigned char* lds, int layer, int g) {
    const int tid = otid(), lane = tid & 63, wid = __builtin_amdgcn_readfirstlane(tid >> 6);
    float* rw = (float*)lds;
    int* se = (int*)(rw + 1024 * 16);
    int* sbase = se + 160;
    for (int i = tid; i < 1024 * 16; i += 512) rw[i] = KIN(34)[i];
    __syncthreads();
    const float* modv = WSP(const float, WS_MODV) + (size_t)layer * 17 * 6144;
    const float* ng = KIN(6) + (size_t)layer * 4 * 1024;
    const bf16_t* MIX = WSP(const bf16_t, WS_BIG + (layer == 0 ? L0_U : L1_U));
    bf16_t* V = WSP(bf16_t, WS_V);
    unsigned* cnt = WSP(unsigned, CTL_CNT) + layer * 16;
    int* TOKE = WSP(int, WS_TOKE); int* TOKP = WSP(int, WS_TOKP); float* TOKW = WSP(float, WS_TOKW); int* LIST = WSP(int, WS_LIST);
    const int nrows = layer == 0 ? RG : RGL, CH = layer == 0 ? 72 : 64, RW = CH >> 3, nchunks = nrows / CH;
    float rbias[16];
#pragma unroll
    for (int e = 0; e < 16; ++e) rbias[e] = KIN(35)[e];
    for (int ch = obid(); ch < nchunks; ch += gridDim.x) {
        for (int rr = 0; rr < RW; ++rr) {
            const int rl = wid * RW + rr, lr = ch * CH + rl;
            int b, t, tok;
            if (layer == 0) { const int bl = lr / TT; t = lr - bl * TT; b = g * BG + bl; tok = g * RG + lr; }
            else { const int bl = lr >> 11; t = CTXL + (lr & 2047); b = g * BG + bl; tok = g * RGL + lr; }
            const float* hsrc = hrow_rd(kp, layer == 0, b, t);
            float* hdst = hrow_wr(kp, b, t);
            const float* mv = modv + (size_t)(t < CTXL ? 16 : b) * 6144;
            f32x4 y[4], h[4]; float ss = 0.f;
#pragma unroll
            for (int i = 0; i < 4; ++i) { y[i] = ld4bf(MIX + (size_t)lr * 1024 + i * 256 + lane * 4); ss += y[i][0] * y[i][0] + y[i][1] * y[i][1] + y[i][2] * y[i][2] + y[i][3] * y[i][3]; }
            ss = wsum(ss); float rstd = rsqrtf(ss * (1.0f / 1024.0f) + EPS);
            float s2 = 0.f;
#pragma unroll
            for (int i = 0; i < 4; ++i) { const int col = i * 256 + lane * 4;
                const f32x4 g1 = *(const f32x4*)(ng + 1024 + col), ga = *(const f32x4*)(mv + 2048 + col), hx = *(const f32x4*)(hsrc + col);
                h[i] = hx + ga * (y[i] * rstd * g1);
                *(f32x4*)(hdst + col) = h[i];
                s2 += h[i][0] * h[i][0] + h[i][1] * h[i][1] + h[i][2] * h[i][2] + h[i][3] * h[i][3]; }
            s2 = wsum(s2); rstd = rsqrtf(s2 * (1.0f / 1024.0f) + EPS);
            float lg[16];
#pragma unroll
            for (int e = 0; e < 16; ++e) lg[e] = 0.f;
#pragma unroll
            for (int i = 0; i < 4; ++i) { const int col = i * 256 + lane * 4;
                const f32x4 g2 = *(const f32x4*)(ng + 2048 + col), scf = *(const f32x4*)(mv + 4096 + col), shf = *(const f32x4*)(mv + 3072 + col);
                const f32x4 v = h[i] * rstd * g2 * (scf + 1.0f) + shf;
                st4bf(V + (size_t)tok * 1024 + col, v);
#pragma unroll
                for (int j = 0; j < 4; ++j) {
#pragma unroll
                    for (int q = 0; q < 4; ++q) { const f32x4 w4 = *(const f32x4*)(rw + (col + j) * 16 + q * 4);
                        lg[q * 4 + 0] += v[j] * w4[0]; lg[q * 4 + 1] += v[j] * w4[1]; lg[q * 4 + 2] += v[j] * w4[2]; lg[q * 4 + 3] += v[j] * w4[3]; } } }
#pragma unroll
            for (int e = 0; e < 16; ++e) lg[e] = wsum(lg[e]);
            float aff[16], sel[16];
#pragma unroll
            for (int e = 0; e < 16; ++e) { aff[e] = sigmoidf_(lg[e]); sel[e] = aff[e] + rbias[e]; }
            float gs[4];
#pragma unroll
            for (int gi = 0; gi < 4; ++gi) { const float a0 = sel[gi * 4], a1 = sel[gi * 4 + 1], a2 = sel[gi * 4 + 2], a3 = sel[gi * 4 + 3];
                gs[gi] = fmaxf(fmaxf(fmaxf(a0 + a1, a0 + a2), fmaxf(a0 + a3, a1 + a2)), fmaxf(a1 + a3, a2 + a3)); }
            int gidx = 0; float gb = gs[0];
#pragma unroll
            for (int gi = 1; gi < 4; ++gi) if (gs[gi] > gb) { gb = gs[gi]; gidx = gi; }
            float c[4], f[4];
#pragma unroll
            for (int i = 0; i < 4; ++i) { c[i] = gidx == 0 ? sel[i] : gidx == 1 ? sel[4 + i] : gidx == 2 ? sel[8 + i] : sel[12 + i];
                                           f[i] = gidx == 0 ? aff[i] : gidx == 1 ? aff[4 + i] : gidx == 2 ? aff[8 + i] : aff[12 + i]; }
            int i1 = 0; float cb = c[0];
#pragma unroll
            for (int i = 1; i < 4; ++i) if (c[i] > cb) { cb = c[i]; i1 = i; }
            int i2 = -1; float cb2 = 0.f;
#pragma unroll
            for (int i = 0; i < 4; ++i) if (i != i1 && (i2 < 0 || c[i] > cb2)) { cb2 = c[i]; i2 = i; }
            float w1 = i1 == 0 ? f[0] : i1 == 1 ? f[1] : i1 == 2 ? f[2] : f[3];
            float w2 = i2 == 0 ? f[0] : i2 == 1 ? f[1] : i2 == 2 ? f[2] : f[3];
            const float wsn = 1.0f / (w1 + w2); w1 *= wsn; w2 *= wsn;
            if (lane == 0) { se[rl * 2] = gidx * 4 + i1; se[rl * 2 + 1] = gidx * 4 + i2;
                TOKE[tok * 2] = gidx * 4 + i1; TOKE[tok * 2 + 1] = gidx * 4 + i2; TOKW[tok * 2] = w1; TOKW[tok * 2 + 1] = w2; }
        }
        __syncthreads();
        if (tid < 16) { int c2 = 0; for (int i = 0; i < 2 * CH; ++i) c2 += (se[i] == tid) ? 1 : 0; sbase[tid] = (int)atomicAdd(&cnt[tid], (unsigned)c2); }
        __syncthreads();
        if (tid < 2 * CH) { const int e = se[tid]; int rank = 0; for (int j = 0; j < tid; ++j) rank += (se[j] == e) ? 1 : 0;
            const int pos = sbase[e] + rank; const int lr = ch * CH + (tid >> 1); const int tok = (layer == 0 ? g * RG : g * RGL) + lr;
            LIST[(size_t)e * NTOK + pos] = tok; TOKP[tok * 2 + (tid & 1)] = pos; }
        __syncthreads();
    }
}

__device__ __forceinline__ int moe_tile_prefix(const unsigned* cnt, int ntok, int lane) {
    const int myt = lane < 16 ? (int)((cnt[lane & 15] + 255u) >> 8) : 0; int pref = myt;
#pragma unroll
    for (int o = 1; o < 16; o <<= 1) { const int t = __shfl_up(pref, o); if (lane >= o) pref += t; }
    return pref - myt + ntok / 256;
}
PHASE_FN void phase_moe_gather(const KP& kp, int layer) {
    const int lane = otid() & 63, wid = __builtin_amdgcn_readfirstlane(otid() >> 6);
    const int ntok = layer == 0 ? NTOK : NLAT;
    const int tpre = moe_tile_prefix(WSP(const unsigned, CTL_CNT) + layer * 16, ntok, lane);
    const bf16_t* V = WSP(const bf16_t, WS_V); bf16_t* XG = WSP(bf16_t, WS_BIG + MO_XG);
    const int* TOKE = WSP(const int, WS_TOKE); const int* TOKP = WSP(const int, WS_TOKP);
    for (int it = obid() * 8 + wid; it < 2 * ntok; it += gridDim.x * 8) {
        const int tok = it >> 1, e = TOKE[it], pos = TOKP[it];
        const size_t row = (size_t)(__shfl(tpre, e) - ntok / 256) * 256 + pos;
        const u32x4* src = (const u32x4*)(V + (size_t)tok * 1024) + lane * 2; u32x4* dst = (u32x4*)(XG + row * 1024) + lane * 2;
        const u32x4 a = src[0], b2 = src[1]; dst[0] = a; dst[1] = b2;
    }
}
PHASE_FN void phase_moe_gemm(const KP& kp, unsigned char* lds, int layer, bool down) {
    const int tid = otid();
    int* pre = (int*)(lds + pg8::STAGE_BYTES);
    int* slotmap = pre + 32;
    const int ntok = layer == 0 ? NTOK : NLAT;
    const unsigned* cnt = WSP(const unsigned, CTL_CNT) + layer * 16;
    if (tid == 0) { int p = ntok / 256; pre[0] = 0; pre[1] = p; for (int e = 0; e < 16; ++e) { p += ((int)cnt[e] + 255) >> 8; pre[2 + e] = p; } }
    __syncthreads();
    const int ntiles = pre[17];
    for (int t = tid; t < ntiles; t += 512) { int idx = 0; for (int e = 1; e < 17; ++e) if (pre[e] <= t) idx = e; slotmap[t] = idx == 0 ? 16 : idx - 1; }
    __syncthreads();
    pg8::MoeOrder S{slotmap, ntiles, (int)gridDim.x, obid()};
    if (!down) {
        pg8::Gemm g{WSP(const bf16_t, WS_V), WSP(const bf16_t, WS_BIG + MO_WUP), 0, 0, 1024, WSP(const bf16_t, WS_BIG + MO_XG), ntok / 256};
        pg8::EpiSwi E{WSP(bf16_t, WS_BIG + MO_HID)};
        pg8::gemm_phase<pg8::EpiSwi, pg8::MoeOrder, false>((PG8_LAS unsigned char*)lds, g, S, E, nullptr);
    } else {
        pg8::Gemm g{WSP(const bf16_t, WS_BIG + MO_HID), WSP(const bf16_t, WS_BIG + MO_WDN), 0, 0, 512, nullptr, 0x7fffffff};
        pg8::EpiBfG E{WSP(bf16_t, WS_BIG + MO_CON), 1024, 1024, 3};
        pg8::gemm_phase<pg8::EpiBfG, pg8::MoeOrder, false>((PG8_LAS unsigned char*)lds, g, S, E, nullptr);
    }
    __syncthreads();
}

PHASE_FN void phase_combine(const KP& kp, int layer) {
    const int lane = otid() & 63, wid = __builtin_amdgcn_readfirstlane(otid() >> 6);
    const int ntok = layer == 0 ? NTOK : NLAT;
    const unsigned* cnt = WSP(const unsigned, CTL_CNT) + layer * 16;
    const float* modv = WSP(const float, WS_MODV) + (size_t)layer * 17 * 6144;
    const float* ng = KIN(6) + (size_t)layer * 4 * 1024 + 3 * 1024;
    const bf16_t* CON = WSP(const bf16_t, WS_BIG + MO_CON);
    const int* TOKE = WSP(const int, WS_TOKE); const int* TOKP = WSP(const int, WS_TOKP); const float* TOKW = WSP(const float, WS_TOKW);
    const int tpre = moe_tile_prefix(cnt, ntok, lane);
    for (int tok0 = (obid() * 8 + wid) * 2; tok0 < ntok; tok0 += gridDim.x * 16) {
        int e1[2], e2[2], p1[2], p2[2]; float w1[2], w2[2];
#pragma unroll
        for (int u = 0; u < 2; ++u) { const int tok = tok0 + u; e1[u] = TOKE[tok * 2]; e2[u] = TOKE[tok * 2 + 1]; p1[u] = TOKP[tok * 2]; p2[u] = TOKP[tok * 2 + 1]; w1[u] = TOKW[tok * 2]; w2[u] = TOKW[tok * 2 + 1]; }
        f32x4 f[2][4], hx[2][4]; float* hp[2]; const float* mv[2];
#pragma unroll
        for (int u = 0; u < 2; ++u) { const int tok = tok0 + u;
            const size_t r1 = (size_t)__shfl(tpre, e1[u]) * 256 + p1[u], r2 = (size_t)__shfl(tpre, e2[u]) * 256 + p2[u];
            int b, t;
            if (layer == 0) { b = tok / TT; t = tok - b * TT; } else { b = tok >> 11; t = CTXL + (tok & 2047); }
            hp[u] = hrow_wr(kp, b, t); mv[u] = modv + (size_t)(t < CTXL ? 16 : b) * 6144 + 5 * 1024;
#pragma unroll
            for (int i = 0; i < 4; ++i) { const int col = i * 256 + lane * 4;
                f[u][i] = ld4bf(CON + (size_t)tok * 1024 + col) + ld4bf(CON + r1 * 1024 + col) * w1[u] + ld4bf(CON + r2 * 1024 + col) * w2[u];
                hx[u][i] = *(const f32x4*)(hp[u] + col); } }
#pragma unroll
        for (int u = 0; u < 2; ++u) { float ss = 0.f;
#pragma unroll
            for (int i = 0; i < 4; ++i) ss += f[u][i][0] * f[u][i][0] + f[u][i][1] * f[u][i][1] + f[u][i][2] * f[u][i][2] + f[u][i][3] * f[u][i][3];
            ss = wsum(ss); const float rstd = rsqrtf(ss * (1.0f / 1024.0f) + EPS);
            float s2 = 0.f;
#pragma unroll
            for (int i = 0; i < 4; ++i) { const int col = i * 256 + lane * 4;
                const f32x4 g3 = *(const f32x4*)(ng + col), gf = *(const f32x4*)(mv[u] + col);
                const f32x4 hn = hx[u][i] + gf * (f[u][i] * rstd * g3);
                *(f32x4*)(hp[u] + col) = hn; hx[u][i] = hn;
                s2 += hn[0] * hn[0] + hn[1] * hn[1] + hn[2] * hn[2] + hn[3] * hn[3]; }
            if (layer == 0) {
                s2 = wsum(s2); const float rs2 = rsqrtf(s2 * (1.0f / 1024.0f) + EPS);
                const float* mv1 = mv[u] - 5 * 1024 + 17 * 6144;
                const float* ng1 = KIN(6) + 4 * 1024;
                bf16_t* U1 = WSP(bf16_t, WS_V) + (size_t)(tok0 + u) * 1024;
#pragma unroll
                for (int i = 0; i < 4; ++i) { const int col = i * 256 + lane * 4;
                    const f32x4 gv = *(const f32x4*)(ng1 + col), sc = *(const f32x4*)(mv1 + 1024 + col), sh = *(const f32x4*)(mv1 + col);
                    st4bf(U1 + col, hx[u][i] * rs2 * gv * (sc + 1.0f) + sh); } } }
    }
}

template <int CH>
__device__ __forceinline__ int scan_t(int dir, int ci, int j) {
    constexpr int NC_CTX = CTXL / CH;
    if (!dir) return ci * CH + j;
    return ci < NC_CTX ? (CTXL - 1 - ci * CH - j) : (TT - 1 - (ci - NC_CTX) * CH - j);
}

constexpr int ML_LQ = 136, ML_LT = 72, ML_VR = 144;
PHASE_FN void mlstm_unit(const KP& kp, unsigned char* lds, int bl, int h, int dir, int vh) {
    const int tid = otid();
    bf16_t* Qs = (bf16_t*)lds;
    bf16_t* Ks = Qs + 64 * ML_LQ;
    bf16_t* KTE = Ks + 64 * ML_LQ;
    bf16_t* VT = KTE + 128 * ML_LT;
    bf16_t* Ps = VT + ML_VR * ML_LT;
    bf16_t* Cb = Ps + 64 * ML_LT;
    float* fs = (float*)(Cb + ML_VR * ML_LQ);
    float* s_rowv = fs;
    float* s_colv = fs + 64;
    float* s_wint = fs + 128;
    float* s_emj = fs + 192;
    float* s_E = fs + 256;
    float* s_den = fs + 320;
    float* s_misc = fs + 384;
    const bf16_t* P = WSP(const bf16_t, WS_BIG + L0_P);
    bf16_t* HOUT = WSP(bf16_t, WS_BIG + (dir ? L0_HB : L0_AO)); const int ldh = dir ? 1024 : 2048;
    const float ibias = KIN(9)[dir * 4 + h], fbias = KIN(10)[dir * 4 + h];
    for (int i = tid; i < ML_VR * ML_LQ; i += 512) Cb[i] = 0;
    for (int i = tid; i < 16 * ML_LT; i += 512) VT[128 * ML_LT + i] = (i < ML_LT) ? (bf16_t)0x3f80 : (bf16_t)0;
    f32x4 Cacc[8], Nacc;
#pragma unroll
    for (int i = 0; i < 8; ++i) Cacc[i] = (f32x4){0.f, 0.f, 0.f, 0.f};
    Nacc = (f32x4){0.f, 0.f, 0.f, 0.f};
    float m_state = 0.f;
    u32x4 pq[2], pk[2], pv[2]; bf16_t pgi = 0, pgf = 0;
#define ML_REQ(ci_) do { _Pragma("unroll") for (int i = 0; i < 2; ++i) { const int p = tid + i * 512, j = p >> 4, c8 = p & 15; \
            const bf16_t* pr = P + ((size_t)bl * TT + scan_t<64>(dir, (ci_), j)) * AB_N; \
            pq[i] = *(const u32x4*)(pr + AB_Q + h * 128 + c8 * 8); pk[i] = *(const u32x4*)(pr + AB_K + h * 128 + c8 * 8); \
            const int jv = tid & 63, cv = (tid >> 6) + i * 8; \
            pv[i] = *(const u32x4*)(P + ((size_t)bl * TT + scan_t<64>(dir, (ci_), jv)) * AB_N + AB_V + h * 256 + vh * 128 + cv * 8); } \
        if (tid < 64) { const bf16_t* pg = P + ((size_t)bl * TT + scan_t<64>(dir, (ci_), tid)) * AB_N; pgi = pg[AB_IG + dir * 4 + h]; pgf = pg[AB_FG + dir * 4 + h]; } } while (0)
    ML_REQ(0);
    lds_barrier();
    for (int ci = 0; ci < TT / 64; ++ci) {
        int tq = tid; asm volatile("" : "+v"(tq));
        const int lane = tq & 63, wid = __builtin_amdgcn_readfirstlane(tq >> 6), fr = lane & 15, fq = lane >> 4;
#pragma unroll
        for (int i = 0; i < 2; ++i) {
            const int p = tq + i * 512, j = p >> 4, c8 = p & 15;
            u32x4 q = pq[i];
            const float qs = 0.08838834764831845f;
            q.x = pack2(lo2f(q.x) * qs, hi2f(q.x) * qs); q.y = pack2(lo2f(q.y) * qs, hi2f(q.y) * qs);
            q.z = pack2(lo2f(q.z) * qs, hi2f(q.z) * qs); q.w = pack2(lo2f(q.w) * qs, hi2f(q.w) * qs);
            *(u32x4*)(Qs + j * ML_LQ + c8 * 8) = q;
            *(u32x4*)(Ks + j * ML_LQ + c8 * 8) = pk[i];
            const u32x4 v = pv[i];
            bf16_t* vt = VT + (((tq >> 6) + i * 8) * 8) * ML_LT + (tq & 63);
            vt[0 * ML_LT] = (bf16_t)(v.x & 0xffff); vt[1 * ML_LT] = (bf16_t)(v.x >> 16); vt[2 * ML_LT] = (bf16_t)(v.y & 0xffff); vt[3 * ML_LT] = (bf16_t)(v.y >> 16);
            vt[4 * ML_LT] = (bf16_t)(v.z & 0xffff); vt[5 * ML_LT] = (bf16_t)(v.z >> 16); vt[6 * ML_LT] = (bf16_t)(v.w & 0xffff); vt[7 * ML_LT] = (bf16_t)(v.w >> 16);
        }
        if (wid == 0) {
            const float ig = bf2f(pgi) + ibias;
            const float lf = logsigmoidf_(bf2f(pgf) + fbias);
            float b = lf;
#pragma unroll
            for (int o = 1; o < 64; o <<= 1) { const float t = __shfl_up(b, o); if (lane >= o) b += t; }
            const float u = ig - b; float pm = u;
#pragma unroll
            for (int o = 1; o < 64; o <<= 1) { const float t = __shfl_up(pm, o); if (lane >= o) pm = fmaxf(pm, t); }
            const float mj = fmaxf(b + m_state, b + pm);
            const float b63 = __shfl(b, 63), pm63 = __shfl(pm, 63);
            const float mnew = fmaxf(b63 + m_state, b63 + pm63);
            s_rowv[lane] = b - mj; s_colv[lane] = u; s_wint[lane] = __expf(b + m_state - mj); s_emj[lane] = __expf(-mj);
            s_E[lane] = __expf(b63 + u - mnew);
            if (lane == 0) { s_misc[0] = mnew; s_misc[1] = __expf(b63 + m_state - mnew); }
        }
        if (ci + 1 < TT / 64) ML_REQ(ci + 1);
        lds_barrier();
        {
            const int jt = wid >> 1;
#pragma unroll
            for (int q2 = 0; q2 < 2; ++q2) {
                const int st = (wid & 1) * 2 + q2;
                f32x4 acc = (f32x4){0.f, 0.f, 0.f, 0.f};
                if (st <= jt) {
                    bf16x8 fa[4], fb[4];
#pragma unroll
                    for (int k = 0; k < 4; ++k) { fa[k] = ldfrag(Qs, ML_LQ, jt * 16, k * 32, fr, fq); fb[k] = ldfrag(Ks, ML_LQ, st * 16, k * 32, fr, fq); }
                    __builtin_amdgcn_sched_barrier(0);
                    f32x4 acc2 = (f32x4){0.f, 0.f, 0.f, 0.f};
                    acc = mma16(fa[0], fb[0], acc); acc2 = mma16(fa[1], fb[1], acc2); acc = mma16(fa[2], fb[2], acc); acc2 = mma16(fa[3], fb[3], acc2);
                    acc = acc + acc2;
                }
                const int s = st * 16 + fr; const float cv = s_colv[s];
#pragma unroll
                for (int r = 0; r < 4; ++r) { const int j = jt * 16 + fq * 4 + r;
                    const float pv2 = (s <= j) ? acc[r] * __expf(s_rowv[j] + cv) : 0.f;
                    Ps[j * ML_LT + s] = f2bf(pv2); }
            }
#pragma unroll
            for (int i = 0; i < 2; ++i) {
                const int s = lane, c8 = wid + i * 8; const float e = s_E[s];
                const u32x4 kv = *(const u32x4*)(Ks + s * ML_LQ + c8 * 8);
                bf16_t* kt = KTE + (c8 * 8) * ML_LT + s;
                kt[0 * ML_LT] = f2bf(lo2f(kv.x) * e); kt[1 * ML_LT] = f2bf(hi2f(kv.x) * e); kt[2 * ML_LT] = f2bf(lo2f(kv.y) * e); kt[3 * ML_LT] = f2bf(hi2f(kv.y) * e);
                kt[4 * ML_LT] = f2bf(lo2f(kv.z) * e); kt[5 * ML_LT] = f2bf(hi2f(kv.z) * e); kt[6 * ML_LT] = f2bf(lo2f(kv.w) * e); kt[7 * ML_LT] = f2bf(hi2f(kv.w) * e);
            }
        }
        lds_barrier();
        f32x4 a1[4], a2[4];
        {
            const int jt = wid >> 1;
            bf16x8 fp[2], fqq[4];
#pragma unroll
            for (int k = 0; k < 2; ++k) fp[k] = ldfrag(Ps, ML_LT, jt * 16, k * 32, fr, fq);
#pragma unroll
            for (int k = 0; k < 4; ++k) fqq[k] = ldfrag(Qs, ML_LQ, jt * 16, k * 32, fr, fq);
            {
                bf16x8 fv[4][2];
#pragma unroll
                for (int q4 = 0; q4 < 4; ++q4)
#pragma unroll
                    for (int k = 0; k < 2; ++k) fv[q4][k] = ldfrag(VT, ML_LT, ((wid & 1) * 4 + q4) * 16, k * 32, fr, fq);
                __builtin_amdgcn_sched_barrier(0);
#pragma unroll
                for (int q4 = 0; q4 < 4; ++q4) a1[q4] = (f32x4){0.f, 0.f, 0.f, 0.f};
#pragma unroll
                for (int k = 0; k < 2; ++k)
#pragma unroll
                    for (int q4 = 0; q4 < 4; ++q4) a1[q4] = mma16(fv[q4][k], fp[k], a1[q4]);
            }
#pragma unroll
            for (int hh = 0; hh < 2; ++hh) {
                bf16x8 fc[2][4];
#pragma unroll
                for (int q2 = 0; q2 < 2; ++q2)
#pragma unroll
                    for (int k = 0; k < 4; ++k) fc[q2][k] = ldfrag(Cb, ML_LQ, ((wid & 1) * 4 + hh * 2 + q2) * 16, k * 32, fr, fq);
                __builtin_amdgcn_sched_barrier(0);
                a2[hh * 2] = (f32x4){0.f, 0.f, 0.f, 0.f}; a2[hh * 2 + 1] = (f32x4){0.f, 0.f, 0.f, 0.f};
#pragma unroll
                for (int k = 0; k < 4; ++k) { a2[hh * 2] = mma16(fc[0][k], fqq[k], a2[hh * 2]); a2[hh * 2 + 1] = mma16(fc[1][k], fqq[k], a2[hh * 2 + 1]); }
            }
            if (wid & 1) {
                f32x4 d1 = (f32x4){0.f, 0.f, 0.f, 0.f}, d2 = (f32x4){0.f, 0.f, 0.f, 0.f};
                bf16x8 fo[2], fn[4];
#pragma unroll
                for (int k = 0; k < 2; ++k) fo[k] = ldfrag(VT, ML_LT, 128, k * 32, fr, fq);
#pragma unroll
                for (int k = 0; k < 4; ++k) fn[k] = ldfrag(Cb, ML_LQ, 128, k * 32, fr, fq);
                __builtin_amdgcn_sched_barrier(0);
                d1 = mma16(fo[0], fp[0], d1); d2 = mma16(fn[0], fqq[0], d2); d1 = mma16(fo[1], fp[1], d1); d2 = mma16(fn[1], fqq[1], d2);
                d2 = mma16(fn[2], fqq[2], d2); d2 = mma16(fn[3], fqq[3], d2);
                if (fq == 0) { const int j = jt * 16 + fr; s_den[j] = fmaxf(fabsf(d1[0] + s_wint[j] * d2[0]), s_emj[j]); }
            }
        }
        lds_barrier();
        {
            const int jt = wid >> 1, j = jt * 16 + fr;
            const float wi = s_wint[j], rden = frcp_(s_den[j]);
            const size_t row = (size_t)bl * TT + scan_t<64>(dir, ci, j);
#pragma unroll
            for (int q4 = 0; q4 < 4; ++q4) { const int v0 = ((wid & 1) * 4 + q4) * 16 + fq * 4;
                st4bf(HOUT + row * ldh + h * 256 + vh * 128 + v0, (a1[q4] + a2[q4] * wi) * rden); }
        }
        {
            const float dec = s_misc[1];
            const bf16x8 bv0 = ldfrag(VT, ML_LT, wid * 16, 0, fr, fq), bv1 = ldfrag(VT, ML_LT, wid * 16, 32, fr, fq);
#pragma unroll
            for (int hh = 0; hh < 2; ++hh) {
                bf16x8 fk[4][2];
#pragma unroll
                for (int q = 0; q < 4; ++q) { fk[q][0] = ldfrag(KTE, ML_LT, (hh * 4 + q) * 16, 0, fr, fq); fk[q][1] = ldfrag(KTE, ML_LT, (hh * 4 + q) * 16, 32, fr, fq); }
                __builtin_amdgcn_sched_barrier(0);
#pragma unroll
                for (int q = 0; q < 4; ++q) Cacc[hh * 4 + q] = Cacc[hh * 4 + q] * dec;
#pragma unroll
                for (int q = 0; q < 4; ++q) Cacc[hh * 4 + q] = mma16(fk[q][0], bv0, Cacc[hh * 4 + q]);
#pragma unroll
                for (int q = 0; q < 4; ++q) Cacc[hh * 4 + q] = mma16(fk[q][1], bv1, Cacc[hh * 4 + q]);
#pragma unroll
                for (int q = 0; q < 4; ++q) st4bf(Cb + (wid * 16 + fr) * ML_LQ + (hh * 4 + q) * 16 + fq * 4, Cacc[hh * 4 + q]);
            }
            Nacc = Nacc * dec;
            Nacc = mma16(ldfrag(KTE, ML_LT, wid * 16, 0, fr, fq), ldfrag(VT, ML_LT, 128, 0, fr, fq), Nacc);
            Nacc = mma16(ldfrag(KTE, ML_LT, wid * 16, 32, fr, fq), ldfrag(VT, ML_LT, 128, 32, fr, fq), Nacc);
            st4bf(Cb + (128 + fr) * ML_LQ + wid * 16 + fq * 4, Nacc);
            m_state = s_misc[0];
        }
        lds_barrier();
    }
#undef ML_REQ
}

constexpr size_t L0_XC = L0_U;
static_assert(L0_XC + (size_t)RG * 1280 * 2 <= BIG_BYTES, "xconv buffer");
PHASE_FN void phase_xconv(const KP& kp) {
    const int lane = otid() & 63, wid = __builtin_amdgcn_readfirstlane(otid() >> 6);
    const bf16_t* P = WSP(const bf16_t, WS_BIG + L0_P); bf16_t* XC = WSP(bf16_t, WS_BIG + L0_XC);
    const float* cw = KIN(12); const float* cb = KIN(13);
    constexpr int RUN = 9;
    for (int run = obid() * 8 + wid; run < RG / RUN; run += gridDim.x * 8) {
        const int r0 = run * RUN;
#pragma unroll
        for (int i = 0; i < 5; ++i) { const int col = i * 256 + lane * 4;
            const f32x4 bias = *(const f32x4*)(cb + col);
            f32x4 w[5], x[5];
#pragma unroll
            for (int q = 0; q < 5; ++q) w[q] = *(const f32x4*)(cw + q * 1280 + col);
#pragma unroll
            for (int q = 0; q < 4; ++q) { const int rr = r0 - 2 + q; x[q + 1] = (rr >= 0 && rr < RG) ? ld4bf(P + (size_t)rr * AB_N + AB_XBC + col) : (f32x4){0.f, 0.f, 0.f, 0.f}; }
#pragma unroll
            for (int k = 0; k < RUN; ++k) {
                const int lr = r0 + k, bl = lr / TT, t = lr - bl * TT, lo = t < CTXL ? 0 : CTXL, hi = t < CTXL ? CTXL : TT;
#pragma unroll
                for (int q = 0; q < 4; ++q) x[q] = x[q + 1];
                { const int rr = lr + 2; x[4] = (rr < RG) ? ld4bf(P + (size_t)rr * AB_N + AB_XBC + col) : (f32x4){0.f, 0.f, 0.f, 0.f}; }
                f32x4 a = bias;
#pragma unroll
                for (int q = 0; q < 5; ++q) { const int tt = t - 2 + q; if (tt >= lo && tt < hi) a += w[q] * x[q]; }
                f32x4 o;
#pragma unroll
                for (int r = 0; r < 4; ++r) o[r] = siluf_(a[r]);
                st4bf(XC + (size_t)lr * 1280 + col, o);
            }
        }
    }
}

constexpr int SS_LT = 72, SS_LX = 136;
PHASE_FN void ssd_unit(const KP& kp, unsigned char* lds, int bl, int dir, int hp) {
    const int tid = otid();
    const int gi = hp >> 2, hh0 = hp * 2;
    bf16_t* Wm = (bf16_t*)lds;
    bf16_t* CM = Wm + 2 * 64 * SS_LT;
    bf16_t* BM = CM + 64 * SS_LT;
    bf16_t* Xn = BM + 64 * SS_LT;
    bf16_t* XT = Xn + 64 * SS_LX;
    bf16_t* BTE = XT + 2 * 64 * SS_LT;
    bf16_t* Sb = BTE + 2 * 64 * SS_LT;
    float* fs = (float*)(Sb + 2 * 64 * SS_LT);
    float* s_b = fs;
    float* s_dt = fs + 128;
    float* s_e = fs + 256;
    float* s_misc = fs + 384;
    const bf16_t* P = WSP(const bf16_t, WS_BIG + L0_P); const bf16_t* XC = WSP(const bf16_t, WS_BIG + L0_XC);
    bf16_t* YOUT = WSP(bf16_t, WS_BIG + (dir ? L0_YB : L0_AO + 2048)); const int ldy = dir ? 1024 : 2048;
    for (int i = tid; i < 2 * 64 * SS_LT; i += 512) Sb[i] = 0;
    f32x4 Sacc[4];
#pragma unroll
    for (int i = 0; i < 4; ++i) Sacc[i] = (f32x4){0.f, 0.f, 0.f, 0.f};
    const float dtb = KIN(14)[dir * 16 + hh0 + ((tid >> 6) & 1)], aexp = __expf(KIN(15)[dir * 16 + hh0 + ((tid >> 6) & 1)]);
    const float dskip = KIN(16)[hh0 + (tid >> 8)];
    u32x4 pr[4]; bf16_t pdt = 0;
#define SS_REQ(ci_) do { _Pragma("unroll") for (int q = 0; q < 4; ++q) { const int p = tid + q * 512, j = p >> 5, c8 = p & 31; \
            const int col = c8 < 16 ? hh0 * 64 + c8 * 8 : (c8 < 24 ? 1024 + gi * 64 + (c8 - 16) * 8 : 1152 + gi * 64 + (c8 - 24) * 8); \
            pr[q] = *(const u32x4*)(XC + ((size_t)bl * TT + scan_t<64>(dir, (ci_), j)) * 1280 + col); } \
        if (tid < 128) pdt = P[((size_t)bl * TT + scan_t<64>(dir, (ci_), tid & 63)) * AB_N + AB_DT + dir * 16 + hh0 + (tid >> 6)]; } while (0)
    SS_REQ(0);
    lds_barrier();
    for (int ci = 0; ci < TT / 64; ++ci) {
        int tq = tid; asm volatile("" : "+v"(tq));
        const int lane = tq & 63, wid = __builtin_amdgcn_readfirstlane(tq >> 6), fr = lane & 15, fq = lane >> 4, hl_w = wid >> 2;
#pragma unroll
        for (int q = 0; q < 4; ++q) { const int p = tq + q * 512, j = p >> 5, c8 = p & 31;
            bf16_t* dst = c8 < 16 ? Xn + j * SS_LX + c8 * 8 : (c8 < 24 ? BM + j * SS_LT + (c8 - 16) * 8 : CM + j * SS_LT + (c8 - 24) * 8);
            *(u32x4*)dst = pr[q]; }
        if (wid < 2) {
            const float dt = softplusf_(bf2f(pdt) + dtb);
            float b = -dt * aexp;
#pragma unroll
            for (int o = 1; o < 64; o <<= 1) { const float t = __shfl_up(b, o); if (lane >= o) b += t; }
            const float b63 = __shfl(b, 63);
            s_b[wid * 64 + lane] = b; s_dt[wid * 64 + lane] = dt; s_e[wid * 64 + lane] = __expf(b63 - b) * dt;
            if (lane == 0) s_misc[wid] = __expf(b63);
        }
        if (ci + 1 < TT / 64) SS_REQ(ci + 1);
        lds_barrier();
        {
            const int jt = wid >> 1;
#pragma unroll
            for (int q2 = 0; q2 < 2; ++q2) {
                const int st = (wid & 1) * 2 + q2;
                f32x4 acc = (f32x4){0.f, 0.f, 0.f, 0.f};
                if (st <= jt) {
                    const bf16x8 c0 = ldfrag(CM, SS_LT, jt * 16, 0, fr, fq), c1 = ldfrag(CM, SS_LT, jt * 16, 32, fr, fq), b0 = ldfrag(BM, SS_LT, st * 16, 0, fr, fq), b1 = ldfrag(BM, SS_LT, st * 16, 32, fr, fq);
                    __builtin_amdgcn_sched_barrier(0);
                    acc = mma16(c0, b0, acc); acc = mma16(c1, b1, acc);
                }
                const int s = st * 16 + fr;
#pragma unroll
                for (int hl = 0; hl < 2; ++hl) { const float bs = s_b[hl * 64 + s], ds = s_dt[hl * 64 + s];
#pragma unroll
                    for (int r = 0; r < 4; ++r) { const int j = jt * 16 + fq * 4 + r;
                        const float wv = (s <= j) ? acc[r] * __expf(s_b[hl * 64 + j] - bs) * ds : 0.f;
                        Wm[(hl * 64 + j) * SS_LT + s] = f2bf(wv); } }
            }
            {
                const int s = lane, n8 = wid;
                const u32x4 bv = *(const u32x4*)(BM + s * SS_LT + n8 * 8);
#pragma unroll
                for (int hl = 0; hl < 2; ++hl) { const float e = s_e[hl * 64 + s];
                    bf16_t* bt = BTE + (hl * 64 + n8 * 8) * SS_LT + s;
                    bt[0 * SS_LT] = f2bf(lo2f(bv.x) * e); bt[1 * SS_LT] = f2bf(hi2f(bv.x) * e); bt[2 * SS_LT] = f2bf(lo2f(bv.y) * e); bt[3 * SS_LT] = f2bf(hi2f(bv.y) * e);
                    bt[4 * SS_LT] = f2bf(lo2f(bv.z) * e); bt[5 * SS_LT] = f2bf(hi2f(bv.z) * e); bt[6 * SS_LT] = f2bf(lo2f(bv.w) * e); bt[7 * SS_LT] = f2bf(hi2f(bv.w) * e); }
#pragma unroll
                for (int i = 0; i < 2; ++i) { const int c8 = wid + i * 8;
                    const u32x4 xv = *(const u32x4*)(Xn + s * SS_LX + c8 * 8);
                    bf16_t* xt = XT + (c8 * 8) * SS_LT + s;
                    xt[0 * SS_LT] = (bf16_t)(xv.x & 0xffff); xt[1 * SS_LT] = (bf16_t)(xv.x >> 16); xt[2 * SS_LT] = (bf16_t)(xv.y & 0xffff); xt[3 * SS_LT] = (bf16_t)(xv.y >> 16);
                    xt[4 * SS_LT] = (bf16_t)(xv.z & 0xffff); xt[5 * SS_LT] = (bf16_t)(xv.z >> 16); xt[6 * SS_LT] = (bf16_t)(xv.w & 0xffff); xt[7 * SS_LT] = (bf16_t)(xv.w >> 16); }
            }
        }
        lds_barrier();
        {
            const int hl = hl_w, jt = wid & 3, j = jt * 16 + fr;
            const bf16_t* Wh = Wm + hl * 64 * SS_LT; const bf16_t* Xh = XT + hl * 64 * SS_LT; const bf16_t* Sh = Sb + hl * 64 * SS_LT;
            const float eb = __expf(s_b[hl * 64 + j]);
            const size_t row = (size_t)bl * TT + scan_t<64>(dir, ci, j);
            const bf16x8 w0 = ldfrag(Wh, SS_LT, jt * 16, 0, fr, fq), w1 = ldfrag(Wh, SS_LT, jt * 16, 32, fr, fq), m0 = ldfrag(CM, SS_LT, jt * 16, 0, fr, fq), m1 = ldfrag(CM, SS_LT, jt * 16, 32, fr, fq);
#pragma unroll
            for (int hh = 0; hh < 2; ++hh) {
                bf16x8 fx[2][2], fs2[2][2];
#pragma unroll
                for (int q = 0; q < 2; ++q)
#pragma unroll
                    for (int k = 0; k < 2; ++k) { fx[q][k] = ldfrag(Xh, SS_LT, (hh * 2 + q) * 16, k * 32, fr, fq); fs2[q][k] = ldfrag(Sh, SS_LT, (hh * 2 + q) * 16, k * 32, fr, fq); }
                f32x4 dx[2];
                if (!dir) { dx[0] = ld4bf(Xn + j * SS_LX + hl * 64 + (hh * 2) * 16 + fq * 4); dx[1] = ld4bf(Xn + j * SS_LX + hl * 64 + (hh * 2 + 1) * 16 + fq * 4); }
                __builtin_amdgcn_sched_barrier(0);
                f32x4 y1[2], y2[2];
#pragma unroll
                for (int q = 0; q < 2; ++q) { y1[q] = (f32x4){0.f, 0.f, 0.f, 0.f}; y2[q] = (f32x4){0.f, 0.f, 0.f, 0.f}; }
#pragma unroll
                for (int q = 0; q < 2; ++q) { y1[q] = mma16(fx[q][0], w0, y1[q]); y2[q] = mma16(fs2[q][0], m0, y2[q]); }
#pragma unroll
                for (int q = 0; q < 2; ++q) { y1[q] = mma16(fx[q][1], w1, y1[q]); y2[q] = mma16(fs2[q][1], m1, y2[q]); }
#pragma unroll
                for (int q = 0; q < 2; ++q) { f32x4 y = y1[q] + y2[q] * eb;
                    if (!dir) y = y + dx[q] * dskip;
                    st4bf(YOUT + row * ldy + (hh0 + hl) * 64 + (hh * 2 + q) * 16 + fq * 4, y); }
            }
        }
        lds_barrier();
        {
            const int hl = hl_w, pt = wid & 3; const float eb63 = s_misc[hl];
            const bf16_t* Xh = XT + hl * 64 * SS_LT; const bf16_t* Bh = BTE + hl * 64 * SS_LT; bf16_t* Sh = Sb + hl * 64 * SS_LT;
            const bf16x8 x0 = ldfrag(Xh, SS_LT, pt * 16, 0, fr, fq), x1 = ldfrag(Xh, SS_LT, pt * 16, 32, fr, fq);
            bf16x8 fb[4][2];
#pragma unroll
            for (int nt = 0; nt < 4; ++nt) { fb[nt][0] = ldfrag(Bh, SS_LT, nt * 16, 0, fr, fq); fb[nt][1] = ldfrag(Bh, SS_LT, nt * 16, 32, fr, fq); }
            __builtin_amdgcn_sched_barrier(0);
#pragma unroll
            for (int nt = 0; nt < 4; ++nt) Sacc[nt] = Sacc[nt] * eb63;
#pragma unroll
            for (int nt = 0; nt < 4; ++nt) Sacc[nt] = mma16(fb[nt][0], x0, Sacc[nt]);
#pragma unroll
            for (int nt = 0; nt < 4; ++nt) Sacc[nt] = mma16(fb[nt][1], x1, Sacc[nt]);
#pragma unroll
            for (int nt = 0; nt < 4; ++nt) st4bf(Sh + (pt * 16 + fr) * SS_LT + nt * 16 + fq * 4, Sacc[nt]);
        }
        lds_barrier();
    }
#undef SS_REQ
}

__device__ __forceinline__ void phase_scan_ab(const KP& kp, unsigned char* lds) {
    for (int rep = 0; rep < ((PROBE_DUP & 8192) ? 2 : 1); ++rep)
    for (int u = obid(); u < 256; u += gridDim.x) if (u < 128) { mlstm_unit(kp, lds, u >> 4, (u >> 2) & 3, (u >> 1) & 1, u & 1); __syncthreads(); }
    for (int rep = 0; rep < ((PROBE_DUP & 16384) ? 2 : 1); ++rep)
    for (int u = obid(); u < 256; u += gridDim.x) if (u >= 128) { const int v = u - 128; ssd_unit(kp, lds, v >> 4, (v >> 3) & 1, v & 7); __syncthreads(); }
}

PHASE_FN void phase_fin_ab(const KP& kp) {
    const int lane = otid() & 63, wid = __builtin_amdgcn_readfirstlane(otid() >> 6);
    const bf16_t* P = WSP(const bf16_t, WS_BIG + L0_P);
    bf16_t* AO = WSP(bf16_t, WS_BIG + L0_AO); const bf16_t* HB = WSP(const bf16_t, WS_BIG + L0_HB); const bf16_t* YB = WSP(const bf16_t, WS_BIG + L0_YB);
    const float* mln = KIN(11); const float* sn = KIN(17);
    for (int lr = obid() * 8 + wid; lr < RG; lr += gridDim.x * 8) {
        const bf16_t* pr = P + (size_t)lr * AB_N;
        f32x4 yz[4]; float ss2 = 0.f;
#pragma unroll
        for (int i = 0; i < 4; ++i) { const int col = i * 256 + lane * 4;
            const f32x4 hs = ld4bf(AO + (size_t)lr * 2048 + col) + ld4bf(HB + (size_t)lr * 1024 + col);
            float ss = hs[0] * hs[0] + hs[1] * hs[1] + hs[2] * hs[2] + hs[3] * hs[3];
            ss = wsum(ss); const float rstd = rsqrtf(ss * (1.0f / 256.0f) + EPS);
            const f32x4 og = ld4bf(pr + AB_OG + col), w = *(const f32x4*)(mln + col);
            f32x4 o;
#pragma unroll
            for (int r = 0; r < 4; ++r) o[r] = hs[r] * rstd * w[r] * sigmoidf_(og[r]);
            st4bf(AO + (size_t)lr * 2048 + col, o);
            const f32x4 ys = ld4bf(AO + (size_t)lr * 2048 + 1024 + col) + ld4bf(YB + (size_t)lr * 1024 + col), z = ld4bf(pr + AB_Z + col);
#pragma unroll
            for (int r = 0; r < 4; ++r) { yz[i][r] = ys[r] * siluf_(z[r]); ss2 += yz[i][r] * yz[i][r]; }
        }
        ss2 = wsum(ss2); const float rstd2 = rsqrtf(ss2 * (1.0f / 1024.0f) + EPS);
#pragma unroll
        for (int i = 0; i < 4; ++i) { const int col = i * 256 + lane * 4; st4bf(AO + (size_t)lr * 2048 + 1024 + col, yz[i] * rstd2 * *(const f32x4*)(sn + col)); }
    }
}

PHASE_FN void phase_gemm_in(const KP& kp, unsigned char* lds, int layer, int grp) {
    const int npad = layer == 0 ? AB_NPAD : CD_NPAD, n = layer == 0 ? AB_N : CD_N;
    pg8::Gemm g{layer == 0 ? WSP(const bf16_t, WS_BIG + L0_U) : WSP(const bf16_t, WS_V) + (size_t)grp * RG * 1024, WSP(const bf16_t, WS_WMIX), RG, npad, 1024, nullptr, 0x7fffffff};
    pg8::StaticOrder S; S.init(RG, npad, (int)gridDim.x, obid());
    pg8::EpiBfG E{WSP(bf16_t, WS_BIG), n, n, 0x7fffffff};
    pg8::gemm_phase<pg8::EpiBfG, pg8::StaticOrder, false>((PG8_LAS unsigned char*)lds, g, S, E, nullptr);
    __syncthreads();
}
PHASE_FN void phase_gemm_out_ab(const KP& kp, unsigned char* lds) {
    pg8::Gemm g{WSP(const bf16_t, WS_BIG + L0_AO), WSP(const bf16_t, WS_WMIX + WM_AB_OUT), RG, 1024, 2048, nullptr, 0x7fffffff};
    pg8::StaticOrder S; S.init(RG, 1024, (int)gridDim.x, obid());
    pg8::EpiBfG E{WSP(bf16_t, WS_BIG + L0_U), 1024, 1024, 0x7fffffff};
    pg8::gemm_phase<pg8::EpiBfG, pg8::StaticOrder, false>((PG8_LAS unsigned char*)lds, g, S, E, nullptr);
    __syncthreads();
}

PHASE_FN void phase_prep_cd(const KP& kp) {
    const int lane = otid() & 63, wid = __builtin_amdgcn_readfirstlane(otid() >> 6);
    bf16_t* P = WSP(bf16_t, WS_BIG + L1_P);
    bf16_t* SG = WSP(bf16_t, WS_SG);
    const float* qn = KIN(20); const float* kvn = KIN(22); const float* mu = KIN(24);
    for (int lr = obid() * 8 + wid; lr < RG; lr += gridDim.x * 8) {
        const int bl = lr / TT, t = lr - bl * TT;
        bf16_t* pr = P + (size_t)lr * CD_N;
        {
            const f32x4 x = ld4bf(pr + CD_M1 + lane * 4);
            float ss = x[0] * x[0] + x[1] * x[1] + x[2] * x[2] + x[3] * x[3]; ss = wsum(ss);
            const float rstd = rsqrtf(ss * (1.0f / 256.0f) + EPS);
            st4bf(pr + CD_M1 + lane * 4, x * rstd * *(const f32x4*)(kvn + lane * 4));
        }
        {
            const int lo = t < CTXL ? 0 : CTXL, hi = t < CTXL ? CTXL : TT, c = lane * 4;
            const f32x4 x = ld4bf(pr + CD_WL + c);
            const f32x4 xp = t > lo ? ld4bf(pr - CD_N + CD_WL + c) : (f32x4){0.f, 0.f, 0.f, 0.f};
            const f32x4 xn = t < hi - 1 ? ld4bf(pr + CD_N + CD_WL + c) : (f32x4){0.f, 0.f, 0.f, 0.f};
            f32x4 l = x + *(const f32x4*)(mu + CD_WL - CD_RW0 + c) * ((xp + xn) * 0.5f - x);
            if (c < 128) {
#pragma unroll
                for (int q = 0; q < 4; ++q) l[q] = tanhf_(l[q]); }
            st4bf(WSP(bf16_t, WS_BIG + L1_TWAL) + (size_t)lr * 256 + c, l);
        }
        if (t >= CTXL) {
            const int s = t - CTXL;
            float x0[3], x1[3]; float ss = 0.f;
#pragma unroll
            for (int i = 0; i < 3; ++i) { const unsigned w = *(const unsigned*)(pr + CD_M0 + i * 128 + lane * 2); x0[i] = lo2f(w); x1[i] = hi2f(w); ss += x0[i] * x0[i] + x1[i] * x1[i]; }
            ss = wsum(ss); const float rstd = rsqrtf(ss * (1.0f / 384.0f) + EPS);
#pragma unroll
            for (int i = 0; i < 3; ++i) { const int c = i * 128 + lane * 2; *(unsigned*)(pr + CD_M0 + c) = pack2(x0[i] * rstd * qn[c], x1[i] * rstd * qn[c + 1]); }
            if (lane < 16) {
                const float pos = (lane < 8) ? (float)(s >> 6) : (float)(s & 63);
                const float inv = __expf(-(float)(lane & 7) * (9.210340371976184f / 8.0f));
                float sn, cs; sincosf(pos * inv, &sn, &cs);
                const float a = bf2f(pr[CD_KR + lane]), b2 = bf2f(pr[CD_KR + 16 + lane]);
                pr[CD_KR + lane] = f2bf(a * cs - b2 * sn); pr[CD_KR + 16 + lane] = f2bf(a * sn + b2 * cs);
            }
            {
                const int c = lane * 2;
                const unsigned w = *(const unsigned*)(pr + CD_GL + c);
                const unsigned wp = s > 0 ? *(const unsigned*)(pr - CD_N + CD_GL + c) : 0u;
                const unsigned wn = s < SEQ - 1 ? *(const unsigned*)(pr + CD_N + CD_GL + c) : 0u;
                const float m0 = mu[CD_GL - CD_RW0 + c], m1 = mu[CD_GL - CD_RW0 + c + 1];
                const float g0 = lo2f(w) + m0 * (0.5f * (lo2f(wp) + lo2f(wn)) - lo2f(w));
                const float g1 = hi2f(w) + m1 * (0.5f * (hi2f(wp) + hi2f(wn)) - hi2f(w));
                *(unsigned*)(SG + ((size_t)bl * SEQ + s) * 128 + c) = pack2(sigmoidf_(g0), sigmoidf_(g1));
            }
        }
    }
}

PHASE_FN void phase_upproj(const KP& kp, unsigned char* lds) {
    const bf16_t* P = WSP(const bf16_t, WS_BIG + L1_P);
    {
        pg8::Gemm g{P + CD_M0, WSP(const bf16_t, WS_WMIX + WM_UQ), RGL, 768, 384, nullptr, 0x7fffffff, CD_N, 1};
        pg8::StaticOrder S; S.init(RGL, 768, (int)gridDim.x, obid());
        pg8::EpiBfG E{WSP(bf16_t, WS_BIG + L1_Q), 768, 768, 0x7fffffff};
        pg8::gemm_phase<pg8::EpiBfG, pg8::StaticOrder, false>((PG8_LAS unsigned char*)lds, g, S, E, nullptr);
    }
    __syncthreads();
    {
        pg8::Gemm g{P + CD_M1, WSP(const bf16_t, WS_WMIX + WM_UKV), RG, 1024, 256, nullptr, 0x7fffffff, CD_N, 0};
        pg8::StaticOrder S; S.init(RG, 1024, (int)gridDim.x, obid());
        pg8::EpiBfG E{WSP(bf16_t, WS_BIG + L1_KV), 1024, 1024, 0x7fffffff};
        pg8::gemm_phase<pg8::EpiBfG, pg8::StaticOrder, false>((PG8_LAS unsigned char*)lds, g, S, E, nullptr);
    }
    __syncthreads();
}

constexpr int AT_LQ = 104, AT_LV = 72;
PHASE_FN void attn_unit(const KP& kp, unsigned char* lds, int bl, int head, int qb) {
    const int tid = otid(), lane = tid & 63, wid = __builtin_amdgcn_readfirstlane(tid >> 6), fr = lane & 15, fq = lane >> 4;
    bf16_t* Qs = (bf16_t*)lds;
    bf16_t* Kt = Qs + 256 * AT_LQ;
    bf16_t* Vt = Kt + 2 * 64 * AT_LQ;
    const bf16_t* P = WSP(const bf16_t, WS_BIG + L1_P);
    const bf16_t* Q = WSP(const bf16_t, WS_BIG + L1_Q);
    const bf16_t* KV = WSP(const bf16_t, WS_BIG + L1_KV);
    bf16_t* AOUT = WSP(bf16_t, WS_BIG + L1_AOUT);
    const float SC = 0.10206207261596577f;
#pragma unroll
    for (int i = 0; i < 6; ++i) { const int p = tid + i * 512, r = p / 12, c = p % 12;
        *(u32x4*)(Qs + r * AT_LQ + c * 8) = *(const u32x4*)(Q + ((size_t)bl * SEQ + qb * 256 + r) * 768 + head * 96 + c * 8); }
    lds_barrier();
#pragma unroll
    for (int i = 0; i < 8; ++i) { const int p = tid + i * 512, r = p >> 4, f = p & 15, s = qb * 256 + r;
        const float pos = (f < 8) ? (float)(s >> 6) : (float)(s & 63);
        const float inv = __expf(-(float)(f & 7) * (9.210340371976184f / 8.0f));
        float sn, cs; sincosf(pos * inv, &sn, &cs);
        const float a = bf2f(Qs[r * AT_LQ + 64 + f]), b2 = bf2f(Qs[r * AT_LQ + 80 + f]);
        Qs[r * AT_LQ + 64 + f] = f2bf(a * cs - b2 * sn); Qs[r * AT_LQ + 80 + f] = f2bf(a * sn + b2 * cs); }
    lds_barrier();
    bf16x8 qf[2][3];
#pragma unroll
    for (int rt = 0; rt < 2; ++rt)
#pragma unroll
        for (int k = 0; k < 3; ++k) qf[rt][k] = ldfrag(Qs, AT_LQ, wid * 32 + rt * 16, k * 32, fr, fq);
    f32x4 ot[2][4];
#pragma unroll
    for (int rt = 0; rt < 2; ++rt)
#pragma unroll
        for (int i = 0; i < 4; ++i) ot[rt][i] = (f32x4){0.f, 0.f, 0.f, 0.f};
    float mrow[2] = {-1e30f, -1e30f}, lsum[2] = {0.f, 0.f};
    u32x4 pk0[2], pk1[2], pvv[2];
    const int kkey0 = tid / 12, kc0 = tid % 12, kkey1 = (tid + 512) / 12, kc1 = (tid + 512) % 12, vkey = tid & 63, vc8 = tid >> 6;
#define AT_REQ(kt_) do { _Pragma("unroll") for (int h_ = 0; h_ < 2; ++h_) { const size_t rb_ = (size_t)bl * TT + ((kt_) * 2 + h_) * 64; \
        pk0[h_] = kc0 < 8 ? *(const u32x4*)(KV + (rb_ + kkey0) * 1024 + head * 128 + kc0 * 8) : *(const u32x4*)(P + (rb_ + kkey0) * CD_N + CD_KR + (kc0 - 8) * 8); \
        if (tid < 256) pk1[h_] = kc1 < 8 ? *(const u32x4*)(KV + (rb_ + kkey1) * 1024 + head * 128 + kc1 * 8) : *(const u32x4*)(P + (rb_ + kkey1) * CD_N + CD_KR + (kc1 - 8) * 8); \
        pvv[h_] = *(const u32x4*)(KV + (rb_ + vkey) * 1024 + head * 128 + 64 + vc8 * 8); } } while (0)
    AT_REQ(0);
    const float SC2 = SC * 1.4426950408889634f;
    for (int kt = 0; kt < TT / 128; ++kt) {
        lds_barrier();
#pragma unroll
        for (int h_ = 0; h_ < 2; ++h_) {
            *(u32x4*)(Kt + (h_ * 64 + kkey0) * AT_LQ + kc0 * 8) = pk0[h_];
            if (tid < 256) *(u32x4*)(Kt + (h_ * 64 + kkey1) * AT_LQ + kc1 * 8) = pk1[h_];
            { bf16_t* vt = Vt + (h_ * 64 + vc8 * 8) * AT_LV + vkey; const u32x4 v = pvv[h_];
                vt[0 * AT_LV] = (bf16_t)(v.x & 0xffff); vt[1 * AT_LV] = (bf16_t)(v.x >> 16); vt[2 * AT_LV] = (bf16_t)(v.y & 0xffff); vt[3 * AT_LV] = (bf16_t)(v.y >> 16);
                vt[4 * AT_LV] = (bf16_t)(v.z & 0xffff); vt[5 * AT_LV] = (bf16_t)(v.z >> 16); vt[6 * AT_LV] = (bf16_t)(v.w & 0xffff); vt[7 * AT_LV] = (bf16_t)(v.w >> 16); }
        }
        if (kt + 1 < TT / 128) AT_REQ(kt + 1);
        lds_barrier();
#pragma unroll 1
        for (int hs = 0; hs < 2; ++hs) {
        const bf16_t* Kth = Kt + hs * 64 * AT_LQ; const bf16_t* Vth = Vt + hs * 64 * AT_LV;
        bf16x8 kf[3][4];
#pragma unroll
        for (int k = 0; k < 3; ++k)
#pragma unroll
            for (int kk = 0; kk < 4; ++kk) kf[k][kk] = ldfrag(Kth, AT_LQ, kk * 16, k * 32, fr, fq);
        u32x2 vlo[2][4], vhi[2][4];
#pragma unroll
        for (int k2 = 0; k2 < 2; ++k2)
#pragma unroll
            for (int dvt = 0; dvt < 4; ++dvt) { const bf16_t* vp = Vth + (dvt * 16 + fr) * AT_LV + k2 * 32 + fq * 4; vlo[k2][dvt] = *(const u32x2*)vp; vhi[k2][dvt] = *(const u32x2*)(vp + 16); }
        __builtin_amdgcn_sched_barrier(0);
        f32x4 st[2][4];
#pragma unroll
        for (int rt = 0; rt < 2; ++rt)
#pragma unroll
            for (int kk = 0; kk < 4; ++kk) st[rt][kk] = (f32x4){0.f, 0.f, 0.f, 0.f};
#pragma unroll
        for (int k = 0; k < 3; ++k)
#pragma unroll
            for (int kk = 0; kk < 4; ++kk)
#pragma unroll
                for (int rt = 0; rt < 2; ++rt) st[rt][kk] = mma16(kf[k][kk], qf[rt][k], st[rt][kk]);
        union { bf16x8 v; unsigned u[4]; } pb[2][2];
#pragma unroll
        for (int rt = 0; rt < 2; ++rt) {
            float mx = -1e30f;
#pragma unroll
            for (int kk = 0; kk < 4; ++kk) mx = fmaxf(mx, fmaxf(fmaxf(st[rt][kk][0], st[rt][kk][1]), fmaxf(st[rt][kk][2], st[rt][kk][3])));
            mx = fmaxf(mx, __shfl_xor(mx, 16)); mx = fmaxf(mx, __shfl_xor(mx, 32));
            const float mnew = fmaxf(mrow[rt], mx), mb = mnew * SC2;
            if (__builtin_amdgcn_ballot_w64(mnew > mrow[rt]) != 0ull) {
                const float alpha = __builtin_amdgcn_exp2f((mrow[rt] - mnew) * SC2);
                lsum[rt] *= alpha;
#pragma unroll
                for (int i = 0; i < 4; ++i) ot[rt][i] = ot[rt][i] * alpha;
            }
            mrow[rt] = mnew;
#pragma unroll
            for (int kk = 0; kk < 4; ++kk)
#pragma unroll
                for (int r = 0; r < 4; ++r) { const float pv = __builtin_amdgcn_exp2f(st[rt][kk][r] * SC2 - mb); st[rt][kk][r] = pv; lsum[rt] += pv; }
#pragma unroll
            for (int k2 = 0; k2 < 2; ++k2) {
                pb[rt][k2].u[0] = pack2(st[rt][2 * k2][0], st[rt][2 * k2][1]); pb[rt][k2].u[1] = pack2(st[rt][2 * k2][2], st[rt][2 * k2][3]);
                pb[rt][k2].u[2] = pack2(st[rt][2 * k2 + 1][0], st[rt][2 * k2 + 1][1]); pb[rt][k2].u[3] = pack2(st[rt][2 * k2 + 1][2], st[rt][2 * k2 + 1][3]); }
        }
#pragma unroll
        for (int k2 = 0; k2 < 2; ++k2)
#pragma unroll
            for (int dvt = 0; dvt < 4; ++dvt) { union { bf16x8 v; u32x2 h[2]; } va; va.h[0] = vlo[k2][dvt]; va.h[1] = vhi[k2][dvt];
#pragma unroll
                for (int rt = 0; rt < 2; ++rt) ot[rt][dvt] = mma16(va.v, pb[rt][k2].v, ot[rt][dvt]); }
        }
    }
#undef AT_REQ
#pragma unroll
    for (int rt = 0; rt < 2; ++rt) {
        float ls = lsum[rt]; ls += __shfl_xor(ls, 16); ls += __shfl_xor(ls, 32);
        const float rl = frcp_(ls);
        const size_t orow = (size_t)bl * SEQ + qb * 256 + wid * 32 + rt * 16 + fr;
#pragma unroll
        for (int dvt = 0; dvt < 4; ++dvt) st4bf(AOUT + orow * 1536 + head * 64 + dvt * 16 + fq * 4, ot[rt][dvt] * rl);
    }
}

constexpr int RW_LR = 200, RW_LP = 72;
PHASE_FN void rwkv_unit(const KP& kp, unsigned char* lds, int bl, int h, int dir) {
    const int tid = otid();
    bf16_t* RAW = (bf16_t*)lds;
    bf16_t* TWb = RAW + 34 * RW_LR;
    bf16_t* ALb = TWb + 32 * RW_LP;
    bf16_t* W2T = ALb + 32 * RW_LP;
    bf16_t* A2T = W2T + 64 * RW_LP;
    float* CL = (float*)(A2T + 64 * RW_LP);
    bf16_t* AR = (bf16_t*)(CL + 32 * 64);
    bf16_t* BK = AR + 64 * RW_LP;
    float* AABT = (float*)(BK + 64 * RW_LP);
    bf16_t* ARB = (bf16_t*)(AABT + 32 * 36);
    bf16_t* AAK = ARB + 32 * 40;
    bf16_t* ARK = AAK + 32 * 40;
    float* RHS = (float*)(ARK + 32 * 40);
    float* YB = RHS + 32 * 64;
    bf16_t* ZVT = (bf16_t*)(YB + 32 * 64);
    bf16_t* BKh = ZVT + 64 * RW_LP;
    bf16_t* Sb = BKh + 64 * RW_LP;
    float* PL = (float*)(Sb + 64 * RW_LP);
    const bf16_t* P = WSP(const bf16_t, WS_BIG + L1_P); const bf16_t* TWAL = WSP(const bf16_t, WS_BIG + L1_TWAL);
    bf16_t* OUT = WSP(bf16_t, WS_BIG + (dir ? L1_OB : L1_OF));
    float* BSC = WSP(float, WS_BSC) + (size_t)dir * RGL * 16;
    const float* mu = KIN(24);
    for (int i = tid; i < 64 * 64; i += 512) { const int c = i >> 6, n = i & 63;
        W2T[n * RW_LP + c] = f2bf(KIN(26)[((size_t)dir * 64 + c) * 1024 + h * 64 + n]); A2T[n * RW_LP + c] = f2bf(KIN(28)[((size_t)dir * 64 + c) * 1024 + h * 64 + n]); }
    for (int i = tid; i < 64 * RW_LP; i += 512) Sb[i] = 0;
    float* CV = PL + 64;
    bf16_t* A21b = (bf16_t*)(CV + 8 * 64);
    for (int i = tid; i < 16 * 40; i += 512) A21b[i] = 0;
    for (int i = tid; i < 64 * RW_LP; i += 512) ZVT[i] = 0;
    if (tid < 64) { const int n = tid;
        CV[0 * 64 + n] = KIN(25)[dir * 1024 + h * 64 + n]; CV[1 * 64 + n] = KIN(27)[dir * 1024 + h * 64 + n];
        CV[2 * 64 + n] = KIN(30)[h * 64 + n]; CV[3 * 64 + n] = KIN(31)[h * 64 + n]; CV[4 * 64 + n] = KIN(32)[h * 64 + n];
        CV[5 * 64 + n] = mu[h * 64 + n]; CV[6 * 64 + n] = mu[1024 + h * 64 + n]; CV[7 * 64 + n] = mu[2048 + h * 64 + n]; }
    f32x4 Sacc[2];
    Sacc[0] = (f32x4){0.f, 0.f, 0.f, 0.f}; Sacc[1] = (f32x4){0.f, 0.f, 0.f, 0.f};
    u32x4 pf[3];
#define RW_PREFETCH(cn, tix) do { const int t0n_ = dir ? scan_t<32>(1, (cn), 31) : (cn) * 32; const int lo_ = t0n_ < CTXL ? 0 : CTXL, hi_ = t0n_ < CTXL ? CTXL : TT; \
        _Pragma("unroll") for (int q = 0; q < 2; ++q) { const int p = (tix) + q * 512; pf[q] = (u32x4){0u, 0u, 0u, 0u}; \
            if (p < 34 * 24) { const int rr = p / 24, c = p % 24, t = t0n_ - 1 + rr; \
                if (t >= lo_ && t < hi_) { const int seg = c >> 3, c8 = c & 7; \
                    const int col = (seg == 0 ? CD_R : seg == 1 ? CD_K : CD_V) + h * 64; \
                    pf[q] = *(const u32x4*)(P + ((size_t)bl * TT + t) * CD_N + col + c8 * 8); } } } \
        { const int i_ = (tix) >> 4, c16 = (tix) & 15; \
          pf[2] = *(const u32x4*)(TWAL + ((size_t)bl * TT + t0n_ + i_) * 256 + (c16 >> 3) * 128 + dir * 64 + (c16 & 7) * 8); } } while (0)
    RW_PREFETCH(0, tid);
    lds_barrier();
    for (int ci = 0; ci < TT / 32; ++ci) {
        int tq = tid; asm volatile("" : "+v"(tq));
        const int lane = tq & 63, wid = __builtin_amdgcn_readfirstlane(tq >> 6), fr = lane & 15, fq = lane >> 4, pi = tq >> 4, n4 = (tq & 15) * 4;
        const int t0 = dir ? scan_t<32>(1, ci, 31) : ci * 32;
#pragma unroll
        for (int q = 0; q < 2; ++q) { const int p = tq + q * 512; if (p < 34 * 24) *(u32x4*)(RAW + (p / 24) * RW_LR + (p % 24) * 8) = pf[q]; }
        { const int i_ = tq >> 4, c16 = tq & 15; *(u32x4*)(((c16 >> 3) ? ALb : TWb) + i_ * RW_LP + (c16 & 7) * 8) = pf[2]; }
        if (ci + 1 < TT / 32) RW_PREFETCH(ci + 1, tq);
        lds_barrier();
        {
            const int which = wid >> 2, tt = (wid >> 1) & 1;
            const bf16_t* Xa = which ? ALb : TWb; const bf16_t* Wt = which ? A2T : W2T; float* Od = which ? YB : RHS;
#pragma unroll
            for (int q2 = 0; q2 < 2; ++q2) { const int nt = (wid & 1) * 2 + q2;
                f32x4 acc = (f32x4){0.f, 0.f, 0.f, 0.f};
#pragma unroll
                for (int k = 0; k < 2; ++k) acc = mma16(ldfrag(Xa, RW_LP, tt * 16, k * 32, fr, fq), ldfrag(Wt, RW_LP, nt * 16, k * 32, fr, fq), acc);
#pragma unroll
                for (int rr = 0; rr < 4; ++rr) Od[(tt * 16 + fq * 4 + rr) * 64 + nt * 16 + fr] = acc[rr]; }
        }
        lds_barrier();
        const int j = dir ? 31 - pi : pi;
        f32x4 r, kd, v, av, bv;
        {
            const f32x4 w0v = *(const f32x4*)(CV + n4), a0v = *(const f32x4*)(CV + 64 + n4), kkw = *(const f32x4*)(CV + 128 + n4), kaw = *(const f32x4*)(CV + 192 + n4), rkw = *(const f32x4*)(CV + 256 + n4);
            const f32x4 mur = *(const f32x4*)(CV + 320 + n4), muk = *(const f32x4*)(CV + 384 + n4), muv = *(const f32x4*)(CV + 448 + n4);
            const f32x4 wl = w0v + *(const f32x4*)(RHS + pi * 64 + n4), al = a0v + *(const f32x4*)(YB + pi * 64 + n4);
            const bf16_t* r1 = RAW + (pi + 1) * RW_LR; const bf16_t* rp = RAW + pi * RW_LR; const bf16_t* rn = RAW + (pi + 2) * RW_LR;
            f32x4 k;
            r = ld4bf(r1 + n4); k = ld4bf(r1 + 64 + n4); v = ld4bf(r1 + 128 + n4);
            r = r + mur * ((ld4bf(rp + n4) + ld4bf(rn + n4)) * 0.5f - r);
            k = k + muk * ((ld4bf(rp + 64 + n4) + ld4bf(rn + 64 + n4)) * 0.5f - k);
            v = v + muv * ((ld4bf(rp + 128 + n4) + ld4bf(rn + 128 + n4)) * 0.5f - v);
            f32x4 a, lw, kk = k * kkw;
            float ssq = kk[0] * kk[0] + kk[1] * kk[1] + kk[2] * kk[2] + kk[3] * kk[3];
            ssq += __shfl_xor(ssq, 1); ssq += __shfl_xor(ssq, 2); ssq += __shfl_xor(ssq, 4); ssq += __shfl_xor(ssq, 8);
            kk = kk * __builtin_amdgcn_rsqf(fmaxf(ssq, 1e-24f));
#pragma unroll
            for (int q = 0; q < 4; ++q) { const float wlog = -softplusf_(-wl[q]) - 0.5f; lw[q] = -__expf(wlog); a[q] = sigmoidf_(al[q]); }
            kd = k * ((a - 1.0f) * kaw + 1.0f);
            float bs = r[0] * kd[0] * rkw[0] + r[1] * kd[1] * rkw[1] + r[2] * kd[2] * rkw[2] + r[3] * kd[3] * rkw[3];
            bs += __shfl_xor(bs, 1); bs += __shfl_xor(bs, 2); bs += __shfl_xor(bs, 4); bs += __shfl_xor(bs, 8);
            av = kk * -1.0f; bv = kk * a;
            *(f32x4*)(CL + j * 64 + n4) = lw;
            const int t = t0 + pi;
            if (t >= CTXL && (tq & 15) == 0) BSC[((size_t)bl * SEQ + (t - CTXL)) * 16 + h] = bs;
        }
        lds_barrier();
        if (wid == 0) {
            float c[32];
#pragma unroll
            for (int q = 0; q < 32; ++q) c[q] = CL[q * 64 + lane];
#pragma unroll
            for (int q = 1; q < 32; ++q) c[q] += c[q - 1];
#pragma unroll
            for (int q = 0; q < 32; ++q) CL[q * 64 + lane] = c[q];
            PL[lane] = __expf(c[31]);
        }
        lds_barrier();
        {
            const f32x4 clj = *(const f32x4*)(CL + j * 64 + n4), cle = *(const f32x4*)(CL + 31 * 64 + n4);
            f32x4 clp = (f32x4){0.f, 0.f, 0.f, 0.f};
            if (j > 0) clp = *(const f32x4*)(CL + (j - 1) * 64 + n4);
            f32x4 at, rt, bt, kt, bh, kh;
#pragma unroll
            for (int q = 0; q < 4; ++q) { const float ep = __expf(clp[q]), ej = __expf(clj[q]), ei = __expf(-clj[q]), ee = __expf(cle[q] - clj[q]);
                at[q] = av[q] * ep; rt[q] = r[q] * ej; bt[q] = bv[q] * ei; kt[q] = kd[q] * ei; bh[q] = bv[q] * ee; kh[q] = kd[q] * ee; }
            st4bf(AR + j * RW_LP + n4, at); st4bf(AR + (32 + j) * RW_LP + n4, rt);
            st4bf(BK + j * RW_LP + n4, bt); st4bf(BK + (32 + j) * RW_LP + n4, kt);
#pragma unroll
            for (int q = 0; q < 4; ++q) { BKh[(n4 + q) * RW_LP + j] = f2bf(bh[q]); BKh[(n4 + q) * RW_LP + 32 + j] = f2bf(kh[q]); ZVT[(n4 + q) * RW_LP + 32 + j] = f2bf(v[q]); }
        }
        lds_barrier();
        {
            const int ti = wid >> 1;
#pragma unroll
            for (int q2 = 0; q2 < 2; ++q2) {
                const int si = (wid & 1) * 2 + q2;
                f32x4 acc = (f32x4){0.f, 0.f, 0.f, 0.f};
#pragma unroll
                for (int k = 0; k < 2; ++k) acc = mma16(ldfrag(AR, RW_LP, ti * 16, k * 32, fr, fq), ldfrag(BK, RW_LP, si * 16, k * 32, fr, fq), acc);
                const int sp = si * 16 + fr, s = sp & 31;
#pragma unroll
                for (int rr = 0; rr < 4; ++rr) { const int tp = ti * 16 + fq * 4 + rr, t = tp & 31;
                    const bool incl = tp >= 32;
                    const float val = (incl ? (s <= t) : (s < t)) ? acc[rr] : 0.f;
                    if (sp < 32) { if (incl) ARB[t * 40 + s] = f2bf(val); else { AABT[s * 36 + t] = val; if (t >= 16 && s < 16) A21b[(t - 16) * 40 + s] = f2bf(val); } }
                    else { (incl ? ARK : AAK)[t * 40 + s] = f2bf(val); } }
            }
        }
        lds_barrier();
        {
            const int which = wid >> 2, tt = (wid >> 1) & 1;
            const bf16_t* Ak = which ? ARK : AAK; float* Od = which ? YB : RHS;
#pragma unroll
            for (int q2 = 0; q2 < 2; ++q2) {
                const int vt = (wid & 1) * 2 + q2;
                f32x4 acc = (f32x4){0.f, 0.f, 0.f, 0.f};
#pragma unroll
                for (int k = 0; k < 2; ++k) acc = mma16(ldfrag(AR, RW_LP, which * 32 + tt * 16, k * 32, fr, fq), ldfrag(Sb, RW_LP, vt * 16, k * 32, fr, fq), acc);
                acc = mma16(ldfrag(Ak, 40, tt * 16, 0, fr, fq), ldfrag(ZVT, RW_LP, vt * 16, 32, fr, fq), acc);
#pragma unroll
                for (int rr = 0; rr < 4; ++rr) Od[(tt * 16 + fq * 4 + rr) * 64 + vt * 16 + fr] = acc[rr];
            }
        }
        lds_barrier();
        {
            if (wid == 0) {
                float z[16]; f32x4 ca0, ca1, ca2, ca3, cb0, cb1, cb2, cb3;
#pragma unroll
                for (int t = 0; t < 16; ++t) z[t] = RHS[(0 + t) * 64 + lane];
                ca0 = *(const f32x4*)(AABT + 0 * 36 + 0); ca1 = *(const f32x4*)(AABT + 0 * 36 + 4); ca2 = *(const f32x4*)(AABT + 0 * 36 + 8); ca3 = *(const f32x4*)(AABT + 0 * 36 + 12);
                cb0 = *(const f32x4*)(AABT + 1 * 36 + 0); cb1 = *(const f32x4*)(AABT + 1 * 36 + 4); cb2 = *(const f32x4*)(AABT + 1 * 36 + 8); cb3 = *(const f32x4*)(AABT + 1 * 36 + 12);
                { const float zs = z[0]; z[1] = __builtin_fmaf(ca0[1], zs, z[1]); z[2] = __builtin_fmaf(ca0[2], zs, z[2]); z[3] = __builtin_fmaf(ca0[3], zs, z[3]); z[4] = __builtin_fmaf(ca1[0], zs, z[4]); z[5] = __builtin_fmaf(ca1[1], zs, z[5]); z[6] = __builtin_fmaf(ca1[2], zs, z[6]); z[7] = __builtin_fmaf(ca1[3], zs, z[7]); z[8] = __builtin_fmaf(ca2[0], zs, z[8]); z[9] = __builtin_fmaf(ca2[1], zs, z[9]); z[10] = __builtin_fmaf(ca2[2], zs, z[10]); z[11] = __builtin_fmaf(ca2[3], zs, z[11]); z[12] = __builtin_fmaf(ca3[0], zs, z[12]); z[13] = __builtin_fmaf(ca3[1], zs, z[13]); z[14] = __builtin_fmaf(ca3[2], zs, z[14]); z[15] = __builtin_fmaf(ca3[3], zs, z[15]); }
                asm volatile("" : "+v"(z[1]) :: "memory");
                ca0 = *(const f32x4*)(AABT + 2 * 36 + 0); ca1 = *(const f32x4*)(AABT + 2 * 36 + 4); ca2 = *(const f32x4*)(AABT + 2 * 36 + 8); ca3 = *(const f32x4*)(AABT + 2 * 36 + 12);
                { const float zs = z[1]; z[2] = __builtin_fmaf(cb0[2], zs, z[2]); z[3] = __builtin_fmaf(cb0[3], zs, z[3]); z[4] = __builtin_fmaf(cb1[0], zs, z[4]); z[5] = __builtin_fmaf(cb1[1], zs, z[5]); z[6] = __builtin_fmaf(cb1[2], zs, z[6]); z[7] = __builtin_fmaf(cb1[3], zs, z[7]); z[8] = __builtin_fmaf(cb2[0], zs, z[8]); z[9] = __builtin_fmaf(cb2[1], zs, z[9]); z[10] = __builtin_fmaf(cb2[2], zs, z[10]); z[11] = __builtin_fmaf(cb2[3], zs, z[11]); z[12] = __builtin_fmaf(cb3[0], zs, z[12]); z[13] = __builtin_fmaf(cb3[1], zs, z[13]); z[14] = __builtin_fmaf(cb3[2], zs, z[14]); z[15] = __builtin_fmaf(cb3[3], zs, z[15]); }
                asm volatile("" : "+v"(z[2]) :: "memory");
                cb1 = *(const f32x4*)(AABT + 3 * 36 + 4); cb2 = *(const f32x4*)(AABT + 3 * 36 + 8); cb3 = *(const f32x4*)(AABT + 3 * 36 + 12);
                { const float zs = z[2]; z[3] = __builtin_fmaf(ca0[3], zs, z[3]); z[4] = __builtin_fmaf(ca1[0], zs, z[4]); z[5] = __builtin_fmaf(ca1[1], zs, z[5]); z[6] = __builtin_fmaf(ca1[2], zs, z[6]); z[7] = __builtin_fmaf(ca1[3], zs, z[7]); z[8] = __builtin_fmaf(ca2[0], zs, z[8]); z[9] = __builtin_fmaf(ca2[1], zs, z[9]); z[10] = __builtin_fmaf(ca2[2], zs, z[10]); z[11] = __builtin_fmaf(ca2[3], zs, z[11]); z[12] = __builtin_fmaf(ca3[0], zs, z[12]); z[13] = __builtin_fmaf(ca3[1], zs, z[13]); z[14] = __builtin_fmaf(ca3[2], zs, z[14]); z[15] = __builtin_fmaf(ca3[3], zs, z[15]); }
                asm volatile("" : "+v"(z[3]) :: "memory");
                ca1 = *(const f32x4*)(AABT + 4 * 36 + 4); ca2 = *(const f32x4*)(AABT + 4 * 36 + 8); ca3 = *(const f32x4*)(AABT + 4 * 36 + 12);
                { const float zs = z[3]; z[4] = __builtin_fmaf(cb1[0], zs, z[4]); z[5] = __builtin_fmaf(cb1[1], zs, z[5]); z[6] = __builtin_fmaf(cb1[2], zs, z[6]); z[7] = __builtin_fmaf(cb1[3], zs, z[7]); z[8] = __builtin_fmaf(cb2[0], zs, z[8]); z[9] = __builtin_fmaf(cb2[1], zs, z[9]); z[10] = __builtin_fmaf(cb2[2], zs, z[10]); z[11] = __builtin_fmaf(cb2[3], zs, z[11]); z[12] = __builtin_fmaf(cb3[0], zs, z[12]); z[13] = __builtin_fmaf(cb3[1], zs, z[13]); z[14] = __builtin_fmaf(cb3[2], zs, z[14]); z[15] = __builtin_fmaf(cb3[3], zs, z[15]); }
                asm volatile("" : "+v"(z[4]) :: "memory");
                cb1 = *(const f32x4*)(AABT + 5 * 36 + 4); cb2 = *(const f32x4*)(AABT + 5 * 36 + 8); cb3 = *(const f32x4*)(AABT + 5 * 36 + 12);
                { const float zs = z[4]; z[5] = __builtin_fmaf(ca1[1], zs, z[5]); z[6] = __builtin_fmaf(ca1[2], zs, z[6]); z[7] = __builtin_fmaf(ca1[3], zs, z[7]); z[8] = __builtin_fmaf(ca2[0], zs, z[8]); z[9] = __builtin_fmaf(ca2[1], zs, z[9]); z[10] = __builtin_fmaf(ca2[2], zs, z[10]); z[11] = __builtin_fmaf(ca2[3], zs, z[11]); z[12] = __builtin_fmaf(ca3[0], zs, z[12]); z[13] = __builtin_fmaf(ca3[1], zs, z[13]); z[14] = __builtin_fmaf(ca3[2], zs, z[14]); z[15] = __builtin_fmaf(ca3[3], zs, z[15]); }
                asm volatile("" : "+v"(z[5]) :: "memory");
                ca1 = *(const f32x4*)(AABT + 6 * 36 + 4); ca2 = *(const f32x4*)(AABT + 6 * 36 + 8); ca3 = *(const f32x4*)(AABT + 6 * 36 + 12);
                { const float zs = z[5]; z[6] = __builtin_fmaf(cb1[2], zs, z[6]); z[7] = __builtin_fmaf(cb1[3], zs, z[7]); z[8] = __builtin_fmaf(cb2[0], zs, z[8]); z[9] = __builtin_fmaf(cb2[1], zs, z[9]); z[10] = __builtin_fmaf(cb2[2], zs, z[10]); z[11] = __builtin_fmaf(cb2[3], zs, z[11]); z[12] = __builtin_fmaf(cb3[0], zs, z[12]); z[13] = __builtin_fmaf(cb3[1], zs, z[13]); z[14] = __builtin_fmaf(cb3[2], zs, z[14]); z[15] = __builtin_fmaf(cb3[3], zs, z[15]); }
                asm volatile("" : "+v"(z[6]) :: "memory");
                cb2 = *(const f32x4*)(AABT + 7 * 36 + 8); cb3 = *(const f32x4*)(AABT + 7 * 36 + 12);
                { const float zs = z[6]; z[7] = __builtin_fmaf(ca1[3], zs, z[7]); z[8] = __builtin_fmaf(ca2[0], zs, z[8]); z[9] = __builtin_fmaf(ca2[1], zs, z[9]); z[10] = __builtin_fmaf(ca2[2], zs, z[10]); z[11] = __builtin_fmaf(ca2[3], zs, z[11]); z[12] = __builtin_fmaf(ca3[0], zs, z[12]); z[13] = __builtin_fmaf(ca3[1], zs, z[13]); z[14] = __builtin_fmaf(ca3[2], zs, z[14]); z[15] = __builtin_fmaf(ca3[3], zs, z[15]); }
                asm volatile("" : "+v"(z[7]) :: "memory");
                ca2 = *(const f32x4*)(AABT + 8 * 36 + 8); ca3 = *(const f32x4*)(AABT + 8 * 36 + 12);
                { const float zs = z[7]; z[8] = __builtin_fmaf(cb2[0], zs, z[8]); z[9] = __builtin_fmaf(cb2[1], zs, z[9]); z[10] = __builtin_fmaf(cb2[2], zs, z[10]); z[11] = __builtin_fmaf(cb2[3], zs, z[11]); z[12] = __builtin_fmaf(cb3[0], zs, z[12]); z[13] = __builtin_fmaf(cb3[1], zs, z[13]); z[14] = __builtin_fmaf(cb3[2], zs, z[14]); z[15] = __builtin_fmaf(cb3[3], zs, z[15]); }
                asm volatile("" : "+v"(z[8]) :: "memory");
                cb2 = *(const f32x4*)(AABT + 9 * 36 + 8); cb3 = *(const f32x4*)(AABT + 9 * 36 + 12);
                { const float zs = z[8]; z[9] = __builtin_fmaf(ca2[1], zs, z[9]); z[10] = __builtin_fmaf(ca2[2], zs, z[10]); z[11] = __builtin_fmaf(ca2[3], zs, z[11]); z[12] = __builtin_fmaf(ca3[0], zs, z[12]); z[13] = __builtin_fmaf(ca3[1], zs, z[13]); z[14] = __builtin_fmaf(ca3[2], zs, z[14]); z[15] = __builtin_fmaf(ca3[3], zs, z[15]); }
                asm volatile("" : "+v"(z[9]) :: "memory");
                ca2 = *(const f32x4*)(AABT + 10 * 36 + 8); ca3 = *(const f32x4*)(AABT + 10 * 36 + 12);
                { const float zs = z[9]; z[10] = __builtin_fmaf(cb2[2], zs, z[10]); z[11] = __builtin_fmaf(cb2[3], zs, z[11]); z[12] = __builtin_fmaf(cb3[0], zs, z[12]); z[13] = __builtin_fmaf(cb3[1], zs, z[13]); z[14] = __builtin_fmaf(cb3[2], zs, z[14]); z[15] = __builtin_fmaf(cb3[3], zs, z[15]); }
                asm volatile("" : "+v"(z[10]) :: "memory");
                cb3 = *(const f32x4*)(AABT + 11 * 36 + 12);
                { const float zs = z[10]; z[11] = __builtin_fmaf(ca2[3], zs, z[11]); z[12] = __builtin_fmaf(ca3[0], zs, z[12]); z[13] = __builtin_fmaf(ca3[1], zs, z[13]); z[14] = __builtin_fmaf(ca3[2], zs, z[14]); z[15] = __builtin_fmaf(ca3[3], zs, z[15]); }
                asm volatile("" : "+v"(z[11]) :: "memory");
                ca3 = *(const f32x4*)(AABT + 12 * 36 + 12);
                { const float zs = z[11]; z[12] = __builtin_fmaf(cb3[0], zs, z[12]); z[13] = __builtin_fmaf(cb3[1], zs, z[13]); z[14] = __builtin_fmaf(cb3[2], zs, z[14]); z[15] = __builtin_fmaf(cb3[3], zs, z[15]); }
                asm volatile("" : "+v"(z[12]) :: "memory");
                cb3 = *(const f32x4*)(AABT + 13 * 36 + 12);
                { const float zs = z[12]; z[13] = __builtin_fmaf(ca3[1], zs, z[13]); z[14] = __builtin_fmaf(ca3[2], zs, z[14]); z[15] = __builtin_fmaf(ca3[3], zs, z[15]); }
                asm volatile("" : "+v"(z[13]) :: "memory");
                ca3 = *(const f32x4*)(AABT + 14 * 36 + 12);
                { const float zs = z[13]; z[14] = __builtin_fmaf(cb3[2], zs, z[14]); z[15] = __builtin_fmaf(cb3[3], zs, z[15]); }
                asm volatile("" : "+v"(z[14]) :: "memory");
                { const float zs = z[14]; z[15] = __builtin_fmaf(ca3[3], zs, z[15]); }
                asm volatile("" : "+v"(z[15]) :: "memory");
#pragma unroll
                for (int q = 0; q < 2; ++q) { u32x4 w; w.x = pack2(z[q * 8 + 0], z[q * 8 + 1]); w.y = pack2(z[q * 8 + 2], z[q * 8 + 3]); w.z = pack2(z[q * 8 + 4], z[q * 8 + 5]); w.w = pack2(z[q * 8 + 6], z[q * 8 + 7]);
                    *(u32x4*)(ZVT + lane * RW_LP + 0 + q * 8) = w; }
            }
            lds_barrier();
            if (wid < 4) {
                f32x4 acc = (f32x4){0.f, 0.f, 0.f, 0.f};
                acc = mma16(ldfrag(A21b, 40, 0, 0, fr, fq), ldfrag(ZVT, RW_LP, wid * 16, 0, fr, fq), acc);
#pragma unroll
                for (int rr = 0; rr < 4; ++rr) RHS[(16 + fq * 4 + rr) * 64 + wid * 16 + fr] += acc[rr];
            }
            lds_barrier();
            if (wid == 0) {
                float z[16]; f32x4 ca0, ca1, ca2, ca3, cb0, cb1, cb2, cb3;
#pragma unroll
                for (int t = 0; t < 16; ++t) z[t] = RHS[(16 + t) * 64 + lane];
                ca0 = *(const f32x4*)(AABT + 16 * 36 + 16); ca1 = *(const f32x4*)(AABT + 16 * 36 + 20); ca2 = *(const f32x4*)(AABT + 16 * 36 + 24); ca3 = *(const f32x4*)(AABT + 16 * 36 + 28);
                cb0 = *(const f32x4*)(AABT + 17 * 36 + 16); cb1 = *(const f32x4*)(AABT + 17 * 36 + 20); cb2 = *(const f32x4*)(AABT + 17 * 36 + 24); cb3 = *(const f32x4*)(AABT + 17 * 36 + 28);
                { const float zs = z[0]; z[1] = __builtin_fmaf(ca0[1], zs, z[1]); z[2] = __builtin_fmaf(ca0[2], zs, z[2]); z[3] = __builtin_fmaf(ca0[3], zs, z[3]); z[4] = __builtin_fmaf(ca1[0], zs, z[4]); z[5] = __builtin_fmaf(ca1[1], zs, z[5]); z[6] = __builtin_fmaf(ca1[2], zs, z[6]); z[7] = __builtin_fmaf(ca1[3], zs, z[7]); z[8] = __builtin_fmaf(ca2[0], zs, z[8]); z[9] = __builtin_fmaf(ca2[1], zs, z[9]); z[10] = __builtin_fmaf(ca2[2], zs, z[10]); z[11] = __builtin_fmaf(ca2[3], zs, z[11]); z[12] = __builtin_fmaf(ca3[0], zs, z[12]); z[13] = __builtin_fmaf(ca3[1], zs, z[13]); z[14] = __builtin_fmaf(ca3[2], zs, z[14]); z[15] = __builtin_fmaf(ca3[3], zs, z[15]); }
                asm volatile("" : "+v"(z[1]) :: "memory");
                ca0 = *(const f32x4*)(AABT + 18 * 36 + 16); ca1 = *(const f32x4*)(AABT + 18 * 36 + 20); ca2 = *(const f32x4*)(AABT + 18 * 36 + 24); ca3 = *(const f32x4*)(AABT + 18 * 36 + 28);
                { const float zs = z[1]; z[2] = __builtin_fmaf(cb0[2], zs, z[2]); z[3] = __builtin_fmaf(cb0[3], zs, z[3]); z[4] = __builtin_fmaf(cb1[0], zs, z[4]); z[5] = __builtin_fmaf(cb1[1], zs, z[5]); z[6] = __builtin_fmaf(cb1[2], zs, z[6]); z[7] = __builtin_fmaf(cb1[3], zs, z[7]); z[8] = __builtin_fmaf(cb2[0], zs, z[8]); z[9] = __builtin_fmaf(cb2[1], zs, z[9]); z[10] = __builtin_fmaf(cb2[2], zs, z[10]); z[11] = __builtin_fmaf(cb2[3], zs, z[11]); z[12] = __builtin_fmaf(cb3[0], zs, z[12]); z[13] = __builtin_fmaf(cb3[1], zs, z[13]); z[14] = __builtin_fmaf(cb3[2], zs, z[14]); z[15] = __builtin_fmaf(cb3[3], zs, z[15]); }
                asm volatile("" : "+v"(z[2]) :: "memory");
                cb1 = *(const f32x4*)(AABT + 19 * 36 + 20); cb2 = *(const f32x4*)(AABT + 19 * 36 + 24); cb3 = *(const f32x4*)(AABT + 19 * 36 + 28);
                { const float zs = z[2]; z[3] = __builtin_fmaf(ca0[3], zs, z[3]); z[4] = __builtin_fmaf(ca1[0], zs, z[4]); z[5] = __builtin_fmaf(ca1[1], zs, z[5]); z[6] = __builtin_fmaf(ca1[2], zs, z[6]); z[7] = __builtin_fmaf(ca1[3], zs, z[7]); z[8] = __builtin_fmaf(ca2[0], zs, z[8]); z[9] = __builtin_fmaf(ca2[1], zs, z[9]); z[10] = __builtin_fmaf(ca2[2], zs, z[10]); z[11] = __builtin_fmaf(ca2[3], zs, z[11]); z[12] = __builtin_fmaf(ca3[0], zs, z[12]); z[13] = __builtin_fmaf(ca3[1], zs, z[13]); z[14] = __builtin_fmaf(ca3[2], zs, z[14]); z[15] = __builtin_fmaf(ca3[3], zs, z[15]); }
                asm volatile("" : "+v"(z[3]) :: "memory");
                ca1 = *(const f32x4*)(AABT + 20 * 36 + 20); ca2 = *(const f32x4*)(AABT + 20 * 36 + 24); ca3 = *(const f32x4*)(AABT + 20 * 36 + 28);
                { const float zs = z[3]; z[4] = __builtin_fmaf(cb1[0], zs, z[4]); z[5] = __builtin_fmaf(cb1[1], zs, z[5]); z[6] = __builtin_fmaf(cb1[2], zs, z[6]); z[7] = __builtin_fmaf(cb1[3], zs, z[7]); z[8] = __builtin_fmaf(cb2[0], zs, z[8]); z[9] = __builtin_fmaf(cb2[1], zs, z[9]); z[10] = __builtin_fmaf(cb2[2], zs, z[10]); z[11] = __builtin_fmaf(cb2[3], zs, z[11]); z[12] = __builtin_fmaf(cb3[0], zs, z[12]); z[13] = __builtin_fmaf(cb3[1], zs, z[13]); z[14] = __builtin_fmaf(cb3[2], zs, z[14]); z[15] = __builtin_fmaf(cb3[3], zs, z[15]); }
                asm volatile("" : "+v"(z[4]) :: "memory");
                cb1 = *(const f32x4*)(AABT + 21 * 36 + 20); cb2 = *(const f32x4*)(AABT + 21 * 36 + 24); cb3 = *(const f32x4*)(AABT + 21 * 36 + 28);
                { const float zs = z[4]; z[5] = __builtin_fmaf(ca1[1], zs, z[5]); z[6] = __builtin_fmaf(ca1[2], zs, z[6]); z[7] = __builtin_fmaf(ca1[3], zs, z[7]); z[8] = __builtin_fmaf(ca2[0], zs, z[8]); z[9] = __builtin_fmaf(ca2[1], zs, z[9]); z[10] = __builtin_fmaf(ca2[2], zs, z[10]); z[11] = __builtin_fmaf(ca2[3], zs, z[11]); z[12] = __builtin_fmaf(ca3[0], zs, z[12]); z[13] = __builtin_fmaf(ca3[1], zs, z[13]); z[14] = __builtin_fmaf(ca3[2], zs, z[14]); z[15] = __builtin_fmaf(ca3[3], zs, z[15]); }
                asm volatile("" : "+v"(z[5]) :: "memory");
                ca1 = *(const f32x4*)(AABT + 22 * 36 + 20); ca2 = *(const f32x4*)(AABT + 22 * 36 + 24); ca3 = *(const f32x4*)(AABT + 22 * 36 + 28);
                { const float zs = z[5]; z[6] = __builtin_fmaf(cb1[2], zs, z[6]); z[7] = __builtin_fmaf(cb1[3], zs, z[7]); z[8] = __builtin_fmaf(cb2[0], zs, z[8]); z[9] = __builtin_fmaf(cb2[1], zs, z[9]); z[10] = __builtin_fmaf(cb2[2], zs, z[10]); z[11] = __builtin_fmaf(cb2[3], zs, z[11]); z[12] = __builtin_fmaf(cb3[0], zs, z[12]); z[13] = __builtin_fmaf(cb3[1], zs, z[13]); z[14] = __builtin_fmaf(cb3[2], zs, z[14]); z[15] = __builtin_fmaf(cb3[3], zs, z[15]); }
                asm volatile("" : "+v"(z[6]) :: "memory");
                cb2 = *(const f32x4*)(AABT + 23 * 36 + 24); cb3 = *(const f32x4*)(AABT + 23 * 36 + 28);
                { const float zs = z[6]; z[7] = __builtin_fmaf(ca1[3], zs, z[7]); z[8] = __builtin_fmaf(ca2[0], zs, z[8]); z[9] = __builtin_fmaf(ca2[1], zs, z[9]); z[10] = __builtin_fmaf(ca2[2], zs, z[10]); z[11] = __builtin_fmaf(ca2[3], zs, z[11]); z[12] = __builtin_fmaf(ca3[0], zs, z[12]); z[13] = __builtin_fmaf(ca3[1], zs, z[13]); z[14] = __builtin_fmaf(ca3[2], zs, z[14]); z[15] = __builtin_fmaf(ca3[3], zs, z[15]); }
                asm volatile("" : "+v"(z[7]) :: "memory");
                ca2 = *(const f32x4*)(AABT + 24 * 36 + 24); ca3 = *(const f32x4*)(AABT + 24 * 36 + 28);
                { const float zs = z[7]; z[8] = __builtin_fmaf(cb2[0], zs, z[8]); z[9] = __builtin_fmaf(cb2[1], zs, z[9]); z[10] = __builtin_fmaf(cb2[2], zs, z[10]); z[11] = __builtin_fmaf(cb2[3], zs, z[11]); z[12] = __builtin_fmaf(cb3[0], zs, z[12]); z[13] = __builtin_fmaf(cb3[1], zs, z[13]); z[14] = __builtin_fmaf(cb3[2], zs, z[14]); z[15] = __builtin_fmaf(cb3[3], zs, z[15]); }
                asm volatile("" : "+v"(z[8]) :: "memory");
                cb2 = *(const f32x4*)(AABT + 25 * 36 + 24); cb3 = *(const f32x4*)(AABT + 25 * 36 + 28);
                { const float zs = z[8]; z[9] = __builtin_fmaf(ca2[1], zs, z[9]); z[10] = __builtin_fmaf(ca2[2], zs, z[10]); z[11] = __builtin_fmaf(ca2[3], zs, z[11]); z[12] = __builtin_fmaf(ca3[0], zs, z[12]); z[13] = __builtin_fmaf(ca3[1], zs, z[13]); z[14] = __builtin_fmaf(ca3[2], zs, z[14]); z[15] = __builtin_fmaf(ca3[3], zs, z[15]); }
                asm volatile("" : "+v"(z[9]) :: "memory");
                ca2 = *(const f32x4*)(AABT + 26 * 36 + 24); ca3 = *(const f32x4*)(AABT + 26 * 36 + 28);
                { const float zs = z[9]; z[10] = __builtin_fmaf(cb2[2], zs, z[10]); z[11] = __builtin_fmaf(cb2[3], zs, z[11]); z[12] = __builtin_fmaf(cb3[0], zs, z[12]); z[13] = __builtin_fmaf(cb3[1], zs, z[13]); z[14] = __builtin_fmaf(cb3[2], zs, z[14]); z[15] = __builtin_fmaf(cb3[3], zs, z[15]); }
                asm volatile("" : "+v"(z[10]) :: "memory");
                cb3 = *(const f32x4*)(AABT + 27 * 36 + 28);
                { const float zs = z[10]; z[11] = __builtin_fmaf(ca2[3], zs, z[11]); z[12] = __builtin_fmaf(ca3[0], zs, z[12]); z[13] = __builtin_fmaf(ca3[1], zs, z[13]); z[14] = __builtin_fmaf(ca3[2], zs, z[14]); z[15] = __builtin_fmaf(ca3[3], zs, z[15]); }
                asm volatile("" : "+v"(z[11]) :: "memory");
                ca3 = *(const f32x4*)(AABT + 28 * 36 + 28);
                { const float zs = z[11]; z[12] = __builtin_fmaf(cb3[0], zs, z[12]); z[13] = __builtin_fmaf(cb3[1], zs, z[13]); z[14] = __builtin_fmaf(cb3[2], zs, z[14]); z[15] = __builtin_fmaf(cb3[3], zs, z[15]); }
                asm volatile("" : "+v"(z[12]) :: "memory");
                cb3 = *(const f32x4*)(AABT + 29 * 36 + 28);
                { const float zs = z[12]; z[13] = __builtin_fmaf(ca3[1], zs, z[13]); z[14] = __builtin_fmaf(ca3[2], zs, z[14]); z[15] = __builtin_fmaf(ca3[3], zs, z[15]); }
                asm volatile("" : "+v"(z[13]) :: "memory");
                ca3 = *(const f32x4*)(AABT + 30 * 36 + 28);
                { const float zs = z[13]; z[14] = __builtin_fmaf(cb3[2], zs, z[14]); z[15] = __builtin_fmaf(cb3[3], zs, z[15]); }
                asm volatile("" : "+v"(z[14]) :: "memory");
                { const float zs = z[14]; z[15] = __builtin_fmaf(ca3[3], zs, z[15]); }
                asm volatile("" : "+v"(z[15]) :: "memory");
#pragma unroll
                for (int q = 0; q < 2; ++q) { u32x4 w; w.x = pack2(z[q * 8 + 0], z[q * 8 + 1]); w.y = pack2(z[q * 8 + 2], z[q * 8 + 3]); w.z = pack2(z[q * 8 + 4], z[q * 8 + 5]); w.w = pack2(z[q * 8 + 6], z[q * 8 + 7]);
                    *(u32x4*)(ZVT + lane * RW_LP + 16 + q * 8) = w; }
            }
        }
        lds_barrier();
        {
            const int nt = wid >> 1;
            const f32x4 pl = *(const f32x4*)(PL + nt * 16 + fq * 4);
#pragma unroll
            for (int q2 = 0; q2 < 2; ++q2) {
                const int vt = (wid & 1) * 2 + q2;
                Sacc[q2] = Sacc[q2] * pl;
#pragma unroll
                for (int k = 0; k < 2; ++k) Sacc[q2] = mma16(ldfrag(BKh, RW_LP, nt * 16, k * 32, fr, fq), ldfrag(ZVT, RW_LP, vt * 16, k * 32, fr, fq), Sacc[q2]);
                st4bf(Sb + (vt * 16 + fr) * RW_LP + nt * 16 + fq * 4, Sacc[q2]);
            }
        }
        if (t0 >= CTXL) {
            const int vt = wid >> 1, tt = wid & 1;
            f32x4 acc = (f32x4){0.f, 0.f, 0.f, 0.f};
            acc = mma16(ldfrag(ZVT, RW_LP, vt * 16, 0, fr, fq), ldfrag(ARB, 40, tt * 16, 0, fr, fq), acc);
            const int t = tt * 16 + fr, v0 = vt * 16 + fq * 4;
#pragma unroll
            for (int rr = 0; rr < 4; ++rr) acc[rr] += YB[t * 64 + v0 + rr];
            const int tn = scan_t<32>(dir, ci, t);
            st4bf(OUT + ((size_t)bl * SEQ + (tn - CTXL)) * 1024 + h * 64 + v0, acc);
        }
    }
    lds_barrier();
#undef RW_PREFETCH
}

__device__ __forceinline__ void phase_mix_cd(const KP& kp, unsigned char* lds, int which) {
    if (which & 1) for (int u = obid(); u < 256; u += gridDim.x) { rwkv_unit(kp, lds, u >> 5, (u >> 1) & 15, u & 1); __syncthreads(); }
    if (which & 2) for (int u = obid(); u < 512; u += gridDim.x) { attn_unit(kp, lds, u >> 6, (u >> 3) & 7, u & 7); __syncthreads(); }
}

struct EpiFinCD {
    const bf16_t* OF; const bf16_t* OB; const bf16_t* P; const float* BSC; const float* ln; const float* mu; bf16_t* AOUT;
    __device__ __forceinline__ void operator()(const f32x4 (&acc)[4][4], int rb, int cb, int fr, int fq) const {
        const int head = cb >> 6;
#pragma unroll
        for (int i = 0; i < 4; ++i) { const int lr = rb + i * 16 + fr, s = lr & 2047;
            const size_t prow = (size_t)(lr >> 11) * TT + CTXL + s;
            f32x4 o[4]; float ss = 0.f;
#pragma unroll
            for (int j = 0; j < 4; ++j) { const int col = cb + j * 16 + fq * 4;
                o[j] = ld4bf(OF + (size_t)lr * 1024 + col) + ld4bf(OB + (size_t)lr * 1024 + col);
                ss += o[j][0] * o[j][0] + o[j][1] * o[j][1] + o[j][2] * o[j][2] + o[j][3] * o[j][3]; }
            ss += __shfl_xor(ss, 16); ss += __shfl_xor(ss, 32);
            const float rstd = rsqrtf(ss * (1.0f / 64.0f) + EPS);
            const float bon = BSC[(size_t)lr * 16 + head] + BSC[(size_t)RGL * 16 + (size_t)lr * 16 + head];
#pragma unroll
            for (int j = 0; j < 4; ++j) { const int col = cb + j * 16 + fq * 4;
                const bf16_t* pv = P + prow * CD_N + CD_V + col;
                const f32x4 v = ld4bf(pv);
                const f32x4 vp = s > 0 ? ld4bf(pv - CD_N) : (f32x4){0.f, 0.f, 0.f, 0.f};
                const f32x4 vn = s < SEQ - 1 ? ld4bf(pv + CD_N) : (f32x4){0.f, 0.f, 0.f, 0.f};
                const f32x4 vl = v + *(const f32x4*)(mu + 2048 + col) * ((vp + vn) * 0.5f - v);
                const f32x4 y = o[j] * rstd * *(const f32x4*)(ln + col) + vl * bon;
                st4bf(AOUT + (size_t)lr * 1536 + 512 + col, y * acc[i][j]); }
        }
    }
};
PHASE_FN void phase_fin_cd(const KP& kp, unsigned char* lds) {
    GA ga{WSP(const bf16_t, WS_SG), nullptr, 128, 0, 128, nullptr, RGL, 0, 0};
    EpiFinCD ep{WSP(const bf16_t, WS_BIG + L1_OF), WSP(const bf16_t, WS_BIG + L1_OB), WSP(const bf16_t, WS_BIG + L1_P), WSP(const float, WS_BSC), KIN(33), KIN(24), WSP(bf16_t, WS_BIG + L1_AOUT)};
    for (int u = obid(); u < (RGL / 256) * 8; u += gridDim.x) gemm_tile(lds, ga, WSP(const bf16_t, WS_WMIX + WM_G2), 128, u >> 3, u & 7, ep);
}
PHASE_FN void phase_gemm_out_cd(const KP& kp, unsigned char* lds) {
    pg8::Gemm g{WSP(const bf16_t, WS_BIG + L1_AOUT), WSP(const bf16_t, WS_WMIX + WM_CD_OUT), RGL, 1024, 1536, nullptr, 0x7fffffff};
    pg8::StaticOrder S; S.init(RGL, 1024, (int)gridDim.x, obid());
    pg8::EpiBfG E{WSP(bf16_t, WS_BIG + L1_U), 1024, 1024, 0x7fffffff};
    pg8::gemm_phase<pg8::EpiBfG, pg8::StaticOrder, false>((PG8_LAS unsigned char*)lds, g, S, E, nullptr);
    __syncthreads();
}

__device__ __attribute__((noinline)) void grid_sync(unsigned* barw, unsigned x, volatile LAS unsigned* st) { XcdBarrier b; b.bar = barw; b.x = x; b.st = st; xcd_barrier(b); }
constexpr int N_PHASES = 37;
__global__ void __launch_bounds__(512, 2) fwd_kernel(KP kparg) {
    extern __shared__ __attribute__((aligned(16))) unsigned char lds[];
    const int lo = kparg.ph_lo, hi = kparg.ph_hi;
    const KP& kp = kparg;
    volatile LAS unsigned* xbst = (volatile LAS unsigned*)(LAS unsigned char*)(lds + LDS_BYTES - 16);
    if (threadIdx.x == 0) { xbst[0] = 0u; xbst[1] = 0u; }
    __syncthreads();
    XcdBarrier bar; bar.bar = (unsigned*)kparg.ws; bar.x = 0; bar.st = xbst;
    if (hi - lo > 1) bar = xcd_barrier_post((unsigned*)kparg.ws, xbst);
#define IN(k) (lo <= (k) && (k) < hi)
#define SEAM(k) do { if (IN(k) && IN((k) + 1)) { grid_sync((unsigned*)kp.ws, bar.x, xbst); if (PROBE_DUP & 512) grid_sync((unsigned*)kp.ws, bar.x, xbst); } } while (0)
#define PHASE(...) do { if (IN(ph)) { __VA_ARGS__ } SEAM(ph); ++ph; } while (0)
    int ph = 0;
    PHASE(phase_mod(kp, lds); __syncthreads(); phase_conv_ab(kp, lds); if (PROBE_DUP & 32) { __syncthreads(); phase_mod(kp, lds); __syncthreads(); phase_conv_ab(kp, lds); });
#pragma unroll
    for (int g = 0; g < NG; ++g) {
        PHASE(phase_u(kp, 0, g); if (PROBE_DUP & 128) phase_u(kp, 0, g););
        PHASE(phase_gemm_in(kp, lds, 0, g); if (PROBE_DUP & 8) phase_gemm_in(kp, lds, 0, g););
        PHASE(phase_xconv(kp); if (PROBE_DUP & 2048) phase_xconv(kp););
        PHASE(phase_scan_ab(kp, lds); if (PROBE_DUP & 1) { __syncthreads(); phase_scan_ab(kp, lds); });
        PHASE(phase_fin_ab(kp););
        PHASE(phase_gemm_out_ab(kp, lds); if (PROBE_DUP & 256) phase_gemm_out_ab(kp, lds););
        PHASE(phase_r(kp, lds, 0, g););
    }
    PHASE(phase_moe_gather(kp, 0); phase_conv_moe(kp, lds, 0); phase_conv_cd(kp, lds); if (PROBE_DUP & 64) { phase_moe_gather(kp, 0); phase_conv_moe(kp, lds, 0); phase_conv_cd(kp, lds); });
    PHASE(phase_moe_gemm(kp, lds, 0, false); if (PROBE_DUP & 16) { __syncthreads(); phase_moe_gemm(kp, lds, 0, false); });
    PHASE(phase_moe_gemm(kp, lds, 0, true); if (PROBE_DUP & 16) { __syncthreads(); phase_moe_gemm(kp, lds, 0, true); });
    PHASE(phase_combine(kp, 0););
#pragma unroll
    for (int g = 0; g < NG; ++g) {
        PHASE(phase_gemm_in(kp, lds, 1, g); if (PROBE_DUP & 8) phase_gemm_in(kp, lds, 1, g););
        PHASE(phase_prep_cd(kp););
        PHASE(phase_upproj(kp, lds); if (PROBE_DUP & 4096) phase_upproj(kp, lds););
        PHASE(phase_mix_cd(kp, lds, 3); if (PROBE_DUP & 2) { __syncthreads(); phase_mix_cd(kp, lds, 1); } if (PROBE_DUP & 4) { __syncthreads(); phase_mix_cd(kp, lds, 2); });
        PHASE(phase_fin_cd(kp, lds); if (PROBE_DUP & 4096) phase_fin_cd(kp, lds););
        PHASE(phase_gemm_out_cd(kp, lds); if (PROBE_DUP & 256) phase_gemm_out_cd(kp, lds););
        PHASE(phase_r(kp, lds, 1, g););
    }
    PHASE(phase_moe_gather(kp, 1); phase_conv_moe(kp, lds, 1););
    PHASE(phase_moe_gemm(kp, lds, 1, false););
    PHASE(phase_moe_gemm(kp, lds, 1, true););
    PHASE(phase_combine(kp, 1););
#undef PHASE
#undef IN
#undef SEAM
}

extern "C" void kernel_launch(void* const* d_in, const int* in_sizes, int n_in, void* d_out, int out_size, void* d_ws, size_t ws_size, hipStream_t stream) {
    static int grid = 0;
    if (grid == 0) {
        if (n_in != 42 || out_size != NLAT * D || ws_size < WS_NEED) { fprintf(stderr, "kernel_launch: unexpected shapes: n_in %d out %d ws %zu (need %zu)\n", n_in, out_size, ws_size, (size_t)WS_NEED); grid = -1; return; }
        int dev = 0, cus = 0, per_cu = 0;
        if (hipGetDevice(&dev) != hipSuccess || hipDeviceGetAttribute(&cus, hipDeviceAttributeMultiprocessorCount, dev) != hipSuccess) { grid = -1; return; }
        if (hipFuncSetAttribute((const void*)fwd_kernel, hipFuncAttributeMaxDynamicSharedMemorySize, LDS_BYTES) != hipSuccess) { fprintf(stderr, "kernel_launch: hipFuncSetAttribute failed\n"); grid = -1; return; }
        if (hipOccupancyMaxActiveBlocksPerMultiprocessor(&per_cu, (const void*)fwd_kernel, 512, LDS_BYTES) != hipSuccess || per_cu < 1) { fprintf(stderr, "kernel_launch: occupancy query says %d blocks per CU\n", per_cu); grid = -1; (void)hipGetLastError(); return; }
        grid = cus;
    }
    if (grid < 0) return;
    (void)hipMemsetAsync(d_ws, 0, CTL_BYTES, stream);
    KP kp{};
    for (int i = 0; i < 42; ++i) kp.in[i] = (const float*)d_in[i];
    kp.out = (float*)d_out; kp.ws = (unsigned char*)d_ws;
#if N_LAUNCH_MODE == 1
    kp.ph_lo = 0; kp.ph_hi = N_PHASES;
    hipLaunchKernelGGL(fwd_kernel, dim3(grid), dim3(512), LDS_BYTES, stream, kp);
#else
    for (int p = 0; p < N_PHASES; ++p) { kp.ph_lo = p; kp.ph_hi = p + 1; hipLaunchKernelGGL(fwd_kernel, dim3(grid), dim3(512), LDS_BYTES, stream, kp); }
#endif
}
```

```cpp
#include <hip/hip_runtime.h>
#include <stdint.h>
#include <stdio.h>

typedef unsigned short bf16_t;
typedef short bf16x8 __attribute__((ext_vector_type(8)));
typedef float f32x4 __attribute__((ext_vector_type(4)));
typedef float f32x2 __attribute__((ext_vector_type(2)));
typedef unsigned u32x4 __attribute__((ext_vector_type(4)));
typedef unsigned u32x2 __attribute__((ext_vector_type(2)));

#ifndef RWP
#define RWP 0
#endif
#ifndef PROBE_DUP
#define PROBE_DUP 0
#endif
#ifndef N_LAUNCH_MODE
#define N_LAUNCH_MODE 1
#endif

constexpr int NB = 16, SEQ = 2048, CTXL = 256, TT = 2304, D = 1024;
constexpr int NTOK = NB * TT, NLAT = NB * SEQ;
constexpr int NG = 2, BG = NB / NG, RG = BG * TT, RGL = BG * SEQ;
constexpr float EPS = 1e-6f;
constexpr int AB_N = 5424, AB_NPAD = 5632, AB_Q = 0, AB_K = 512, AB_V = 1024, AB_OG = 2048, AB_IG = 3072, AB_FG = 3080, AB_Z = 3088, AB_XBC = 4112, AB_DT = 5392;
constexpr int CD_N = 4128, CD_NPAD = 4352, CD_M0 = 0, CD_M1 = 384, CD_KR = 640, CD_R = 672, CD_K = 1696, CD_V = 2720, CD_WL = 3744, CD_AL = 3872, CD_GL = 4000;
constexpr int CD_RW0 = 672;

constexpr size_t CTL_BYTES = 32768;
constexpr size_t CTL_CNT = 16384;
constexpr size_t WS_MODV = CTL_BYTES;
constexpr size_t WS_HC   = WS_MODV + (size_t)2 * 17 * 6144 * 4;
constexpr size_t WS_TOKE = WS_HC + (size_t)NB * CTXL * D * 4;
constexpr size_t WS_TOKP = WS_TOKE + (size_t)NTOK * 2 * 4;
constexpr size_t WS_TOKW = WS_TOKP + (size_t)NTOK * 2 * 4;
constexpr size_t WS_LIST = WS_TOKW + (size_t)NTOK * 2 * 4;
constexpr size_t WS_BSC  = WS_LIST + (size_t)16 * NTOK * 4;
constexpr size_t WS_SG   = WS_BSC + (size_t)2 * RGL * 16 * 4;
constexpr size_t WS_WMIX = WS_SG + (size_t)RGL * 128 * 2;
constexpr size_t WMIX_BYTES = (size_t)16 << 20;
constexpr size_t WS_V    = WS_WMIX + WMIX_BYTES;
constexpr size_t WS_BIG  = WS_V + (size_t)NTOK * D * 2;
constexpr size_t WM_AB_IN = 0, WM_AB_OUT = (size_t)AB_NPAD * 1024 * 2;
constexpr size_t WM_CD_IN = 0, WM_CD_OUT = (size_t)CD_NPAD * 1024 * 2, WM_UQ = WM_CD_OUT + (size_t)1024 * 1536 * 2, WM_UKV = WM_UQ + (size_t)768 * 384 * 2, WM_G2 = WM_UKV + (size_t)1024 * 256 * 2;
static_assert(WM_AB_OUT + (size_t)1024 * 2048 * 2 <= WMIX_BYTES, "wmix ab");
static_assert(WM_G2 + (size_t)1024 * 128 * 2 <= WMIX_BYTES, "wmix cd");
constexpr size_t SZ_RG1K = (size_t)RG * 1024 * 2, SZ_RGL1K = (size_t)RGL * 1024 * 2;
constexpr size_t L0_P = 0, L0_AO = (size_t)RG * AB_N * 2  , L0_HB = L0_AO + 2 * SZ_RG1K, L0_YB = L0_HB + SZ_RG1K, L0_U = L0_YB + SZ_RG1K, L0_END = L0_U + SZ_RG1K;
constexpr size_t L1_P = 0, L1_Q = (size_t)RG * CD_N * 2, L1_KV = L1_Q + (size_t)RGL * 768 * 2, L1_OF = L1_KV + SZ_RG1K, L1_OB = L1_OF + SZ_RGL1K, L1_AOUT = L1_OB + SZ_RGL1K, L1_U = L1_AOUT + (size_t)RGL * 1536 * 2, L1_TWAL = L1_U + SZ_RG1K  , L1_END = L1_TWAL + (size_t)RG * 256 * 2;
constexpr int MOE_PADROWS = 16 * 256;
constexpr size_t MO_WUP = 0, MO_WDN = (size_t)17 * 1024 * 1024 * 2, MO_HID = MO_WDN + (size_t)17 * 1024 * 512 * 2;
constexpr size_t MO_XG = MO_HID + (size_t)(3 * NTOK + MOE_PADROWS) * 512 * 2;
constexpr size_t MO_CON = MO_XG, MO_END = MO_CON + (size_t)(3 * NTOK + MOE_PADROWS) * 1024 * 2;
constexpr size_t BIG_BYTES = MO_END > L0_END ? (MO_END > L1_END ? MO_END : L1_END) : (L0_END > L1_END ? L0_END : L1_END);
constexpr size_t WS_NEED = WS_BIG + BIG_BYTES;

constexpr int LDS_BYTES = 147456;

__device__ __forceinline__ float bf2f(unsigned short h) { return __uint_as_float(((unsigned)h) << 16); }
typedef __bf16 bf16v2_t __attribute__((ext_vector_type(2)));
__device__ __forceinline__ unsigned pack2(float a, float b) { const bf16v2_t h = __builtin_convertvector((f32x2){a, b}, bf16v2_t); return __builtin_bit_cast(unsigned, h); }
__device__ __forceinline__ unsigned short f2bf(float f) { const __bf16 h = (__bf16)f; return __builtin_bit_cast(unsigned short, h); }
__device__ __forceinline__ float lo2f(unsigned w) { return __uint_as_float(w << 16); }
__device__ __forceinline__ float hi2f(unsigned w) { return __uint_as_float(w & 0xffff0000u); }
__device__ __forceinline__ float wsum(float v) {
#pragma unroll
    for (int o = 32; o; o >>= 1) v += __shfl_xor(v, o);
    return v; }
__device__ __forceinline__ float frcp_(float x) { return __builtin_amdgcn_rcpf(x); }
__device__ __forceinline__ float sigmoidf_(float x) { return __builtin_amdgcn_rcpf(1.0f + __expf(-x)); }
__device__ __forceinline__ float siluf_(float x) { return x * __builtin_amdgcn_rcpf(1.0f + __expf(-x)); }
__device__ __forceinline__ float softplusf_(float x) { return fmaxf(x, 0.0f) + __logf(1.0f + __expf(-fabsf(x))); }
__device__ __forceinline__ float logsigmoidf_(float x) { return fminf(x, 0.0f) - __logf(1.0f + __expf(-fabsf(x))); }
__device__ __forceinline__ float tanhf_(float x) { return 1.0f - 2.0f * __builtin_amdgcn_rcpf(__expf(2.0f * x) + 1.0f); }
__device__ __forceinline__ f32x4 mma16(bf16x8 a, bf16x8 b, f32x4 c) { return __builtin_amdgcn_mfma_f32_16x16x32_bf16(a, b, c, 0, 0, 0); }
__device__ __forceinline__ bf16x8 ldfrag(const bf16_t* base, int ld, int row0, int k0, int fr, int fq) { return *(const bf16x8*)(base + (row0 + fr) * ld + k0 + fq * 8); }
__device__ __forceinline__ void st4bf(bf16_t* p, f32x4 v) { u32x2 w; w.x = pack2(v[0], v[1]); w.y = pack2(v[2], v[3]); *(u32x2*)p = w; }
__device__ __forceinline__ f32x4 ld4bf(const bf16_t* p) { u32x2 w = *(const u32x2*)p; return (f32x4){lo2f(w.x), hi2f(w.x), lo2f(w.y), hi2f(w.y)}; }

#define PHASE_FN __device__ __forceinline__
__device__ __forceinline__ int otid() { int t = threadIdx.x; asm volatile("" : "+v"(t)); return t; }
__device__ __forceinline__ int obid() { int t = blockIdx.x; asm volatile("" : "+s"(t)); return t; }
template <class T> __device__ __forceinline__ T* as_global(T* p) { return p; }
__device__ __forceinline__ void lds_barrier() { asm volatile("s_waitcnt lgkmcnt(0)" ::: "memory"); __builtin_amdgcn_s_barrier(); asm volatile("" ::: "memory"); }
struct KP { const float* in[42]; float* out; unsigned char* ws; int ph_lo, ph_hi; };

#define XB_TMO      128
#define XB_XCNT(j)  (256  + 64 * (j))
#define XB_XSUB(j)  (1280 + 64 * (j))
#define XB_XGEN(j)  (2304 + 64 * (j))
#define XB_TOP      3328
#define XB_TOPGEN   3392
#define XCD_BAR_WORDS 3456
#define XB_SPIN_CAP (1u << 18)
#define LAS __attribute__((address_space(3)))

__device__ __forceinline__ unsigned xb_ld(unsigned* p)              { return __hip_atomic_load(p, __ATOMIC_RELAXED, __HIP_MEMORY_SCOPE_AGENT); }
__device__ __forceinline__ unsigned xb_add(unsigned* p, unsigned v) { return __hip_atomic_fetch_add(p, v, __ATOMIC_RELAXED, __HIP_MEMORY_SCOPE_AGENT); }
__device__ __forceinline__ unsigned xb_xcc_id() { return (unsigned)__builtin_amdgcn_s_getreg((3 << 11) | 20) & 0xFu; }
#define XB_SPIN(cond, bar) do { unsigned _sp = 0; while (cond) { __builtin_amdgcn_s_sleep(1); \
    if ((++_sp & 255u) == 0u) { if (xb_ld(&(bar)[XB_TMO])) break; if (_sp > XB_SPIN_CAP) { atomicAdd(&(bar)[XB_TMO], 1u); break; } } } } while (0)

struct XcdBarrier {
    unsigned* bar; unsigned x;
    volatile LAS unsigned* st;
};

__device__ __forceinline__ XcdBarrier xcd_barrier_post(unsigned* bar, volatile LAS unsigned* st) {
    XcdBarrier b; b.bar = bar; b.x = xb_xcc_id(); b.st = st;
    if (threadIdx.x == 0) (void)xb_add(&bar[XB_XCNT(b.x)], 1u);
    return b;
}
__device__ __forceinline__ void xcd_barrier_complete(unsigned* bar, unsigned x, unsigned& nloc, unsigned& nx) {
    const unsigned G = gridDim.x * gridDim.y * gridDim.z;
    unsigned sum, cnt, mine, sp = 0u;
    for (;;) {
        sum = 0u; cnt = 0u; mine = 0u;
#pragma unroll
        for (unsigned j = 0; j < 16; ++j) { const unsigned c = xb_ld(&bar[XB_XCNT(j)]); sum += c; cnt += (c > 0u) ? 1u : 0u; mine = (j == x) ? c : mine; }
        if (sum == G) break;
        __builtin_amdgcn_s_sleep(1);
        if ((++sp & 255u) == 0u) { if (xb_ld(&bar[XB_TMO])) break; if (sp > XB_SPIN_CAP) { atomicAdd(&bar[XB_TMO], 1u); break; } }
    }
    nloc = mine > 0u ? mine : 1u; nx = cnt > 0u ? cnt : 1u;
}

__device__ __forceinline__ void xcd_barrier(const XcdBarrier& b) {
    asm volatile("s_waitcnt vmcnt(0)" ::: "memory");
    __syncthreads();
    if (threadIdx.x == 0) {
        unsigned* bar = b.bar;
        __builtin_amdgcn_s_waitcnt(0);
        unsigned nloc = b.st[0], nx = b.st[1];
        if (nloc == 0u) { xcd_barrier_complete(bar, b.x, nloc, nx); b.st[0] = nloc; b.st[1] = nx; }
        const unsigned old = xb_add(&bar[XB_XSUB(b.x)], 1u);
        const unsigned gen = old / nloc;
        if (old + 1u == (gen + 1u) * nloc) {
            __builtin_amdgcn_fence(__ATOMIC_RELEASE, "agent");
            asm volatile("s_waitcnt vmcnt(0)" ::: "memory");
            const unsigned og = xb_add(&bar[XB_TOP], 1u);
            const unsigned tg = og / nx;
            if (og + 1u == (tg + 1u) * nx) xb_add(&bar[XB_TOPGEN], 1u);
            else XB_SPIN(xb_ld(&bar[XB_TOPGEN]) == tg, bar);
            __builtin_amdgcn_fence(__ATOMIC_ACQUIRE, "agent");
            xb_add(&bar[XB_XGEN(b.x)], 1u);
            asm volatile("s_waitcnt vmcnt(0)" ::: "memory");
        } else {
            XB_SPIN(xb_ld(&bar[XB_XGEN(b.x)]) == gen, bar);
            __builtin_amdgcn_fence(__ATOMIC_ACQUIRE, "agent");
            asm volatile("s_waitcnt vmcnt(0)" ::: "memory");
        }
    }
    __syncthreads();
}
struct GA {
    const bf16_t* a0; const bf16_t* a1;
    int ld0, ld1, ksplit;
    const int* list;
    int nrows;
    int mode;
    int row0;
};
constexpr int G_LDT = 40;
constexpr int GEMM_LDS = (2 * 256 * G_LDT + 2 * 128 * G_LDT) * 2;

template <class Epi>
__device__ __forceinline__ void gemm_tile(unsigned char* lds, const GA& ga, const bf16_t* __restrict__ Bt, int K, int mt, int nt, const Epi& epi) {
    const int tid = otid(), lane = tid & 63, wid = __builtin_amdgcn_readfirstlane(tid >> 6), wm = wid >> 1, wn = wid & 1, fr = lane & 15, fq = lane >> 4;
    bf16_t* sA = (bf16_t*)lds;
    bf16_t* sB = sA + 2 * 256 * G_LDT;
    const int kp = tid & 3;
    const int r0 = tid >> 2, r1 = r0 + 128;
    int s0, s1;
    {
        int lr = mt * 256 + r0; if (lr >= ga.nrows) lr = 0;
        s0 = ga.list ? ga.list[lr] : (ga.mode == 1 ? (lr >> 11) * TT + CTXL + (lr & 2047) : ga.row0 + lr);
        lr = mt * 256 + r1; if (lr >= ga.nrows) lr = 0;
        s1 = ga.list ? ga.list[lr] : (ga.mode == 1 ? (lr >> 11) * TT + CTXL + (lr & 2047) : ga.row0 + lr);
    }
    const bf16_t* pa00 = ga.a0 + (size_t)s0 * ga.ld0 + kp * 8;
    const bf16_t* pa01 = ga.a0 + (size_t)s1 * ga.ld0 + kp * 8;
    const bf16_t* pa10 = ga.a1 ? ga.a1 + (size_t)s0 * ga.ld1 + kp * 8 : pa00;
    const bf16_t* pa11 = ga.a1 ? ga.a1 + (size_t)s1 * ga.ld1 + kp * 8 : pa01;
    const bf16_t* pb = Bt + (size_t)(nt * 128 + r0) * K + kp * 8;
    const int ksplit = ga.ksplit;
    f32x4 acc[4][4];
#pragma unroll
    for (int i = 0; i < 4; ++i)
#pragma unroll
        for (int j = 0; j < 4; ++j) acc[i][j] = (f32x4){0.f, 0.f, 0.f, 0.f};
    const int nk = K >> 5;
    u32x4 ra0, ra1, rb;
    {
        ra0 = *(const u32x4*)(pa00); ra1 = *(const u32x4*)(pa01); rb = *(const u32x4*)(pb);
        if (0 >= ksplit) { ra0 = *(const u32x4*)(pa10); ra1 = *(const u32x4*)(pa11); }
    }
    *(u32x4*)(sA + (r0) * G_LDT + kp * 8) = ra0;
    *(u32x4*)(sA + (r1) * G_LDT + kp * 8) = ra1;
    *(u32x4*)(sB + (r0) * G_LDT + kp * 8) = rb;
    __syncthreads();
    for (int kt = 0; kt < nk; ++kt) {
        const int cur = kt & 1;
        if (kt + 1 < nk) {
            const int k0 = (kt + 1) << 5;
            if (k0 < ksplit) { ra0 = *(const u32x4*)(pa00 + k0); ra1 = *(const u32x4*)(pa01 + k0); }
            else { ra0 = *(const u32x4*)(pa10 + (k0 - ksplit)); ra1 = *(const u32x4*)(pa11 + (k0 - ksplit)); }
            rb = *(const u32x4*)(pb + k0);
        }
        const bf16_t* cA = sA + cur * 256 * G_LDT;
        const bf16_t* cB = sB + cur * 128 * G_LDT;
        bf16x8 af[4], bfr[4];
#pragma unroll
        for (int i = 0; i < 4; ++i) af[i] = ldfrag(cA, G_LDT, wm * 64 + i * 16, 0, fr, fq);
#pragma unroll
        for (int j = 0; j < 4; ++j) bfr[j] = ldfrag(cB, G_LDT, wn * 64 + j * 16, 0, fr, fq);
#pragma unroll
        for (int i = 0; i < 4; ++i)
#pragma unroll
            for (int j = 0; j < 4; ++j) acc[i][j] = mma16(bfr[j], af[i], acc[i][j]);
        if (kt + 1 < nk) {
            const int nb = cur ^ 1;
            *(u32x4*)(sA + (nb * 256 + r0) * G_LDT + kp * 8) = ra0;
            *(u32x4*)(sA + (nb * 256 + r1) * G_LDT + kp * 8) = ra1;
            *(u32x4*)(sB + (nb * 128 + r0) * G_LDT + kp * 8) = rb;
        }
        __syncthreads();
    }
    epi(acc, mt * 256 + wm * 64, nt * 128 + wn * 64, fr, fq);
}

struct EpiBf {
    bf16_t* out; int ld, nrows, ncols;
    __device__ __forceinline__ void operator()(const f32x4 (&acc)[4][4], int rb, int cb, int fr, int fq) const {
#pragma unroll
        for (int i = 0; i < 4; ++i) { const int lr = rb + i * 16 + fr; if (lr < nrows) {
#pragma unroll
            for (int j = 0; j < 4; ++j) { const int col = cb + j * 16 + fq * 4; if (col < ncols) st4bf(out + (size_t)lr * ld + col, acc[i][j]); } } }
    }
};
struct EpiSwiglu {
    bf16_t* out; int nrows;
    __device__ __forceinline__ void operator()(const f32x4 (&acc)[4][4], int rb, int cb, int fr, int fq) const {
#pragma unroll
        for (int i = 0; i < 4; ++i) { const int lr = rb + i * 16 + fr; if (lr < nrows) {
#pragma unroll
            for (int j = 0; j < 2; ++j) { const int col = (cb >> 1) + j * 16 + fq * 4; f32x4 g = acc[i][j], u = acc[i][j + 2], o;
#pragma unroll
                for (int r = 0; r < 4; ++r) o[r] = siluf_(g[r]) * u[r];
                st4bf(out + (size_t)lr * 512 + col, o); } } }
    }
};

namespace pg8 {
#define PG8_LAS __attribute__((address_space(3)))
typedef unsigned short bf16_t;
typedef short bf16x8 __attribute__((ext_vector_type(8)));
typedef float f32x4 __attribute__((ext_vector_type(4)));
typedef unsigned u32x4 __attribute__((ext_vector_type(4)));
constexpr int BM = 256, BK = 64, HALF = 128, HTB = HALF * BK * 2  , STAGE_BYTES = 8 * HTB, NXCD = 8, WGM = 8;

__host__ __device__ __forceinline__ int lds_byte(int r, int c) { const int st = (r >> 4) * 2 + (c >> 5), rr = r & 15, cc = c & 31, ob = rr * 64 + cc * 2; return st * 1024 + (ob ^ (((ob >> 9) & 1) << 5)); }
__host__ __device__ __forceinline__ void stage_rc(int b, int& R, int& C) { const int st = b / 1024, sb = b % 1024, swz = sb ^ (((sb >> 9) & 1) << 5); R = (st >> 1) * 16 + swz / 64; C = (st & 1) * 32 + (swz % 64) / 2; }
__host__ __device__ __forceinline__ int perm32(int rho) { const int n = rho >> 4, i = rho & 15; return 8 * (i >> 2) + 4 * n + (i & 3); }

struct Unit { int pm, pn; };
struct Gemm { const bf16_t* A; const bf16_t* Bt; int M, N, K; const bf16_t* A2; int pm_split; int lda, amode; };
#define PG8_ABASE(g, pm) ((g).amode == 1 ? (const char*)(g).A + (size_t)(((pm) >> 3) * 2304 + 256 + ((pm) & 7) * 256) * lda_ * 2 : ((pm) < (g).pm_split ? (const char*)(g).A + (size_t)(pm) * tstepA : (const char*)(g).A2 + (size_t)((pm) - (g).pm_split) * tstepA))
struct StaticOrder {
    int nM, nN, nwg, G, c;
    __host__ __device__ void init(int M, int N, int G_, int c_) { nM = M / BM; nN = N / BM; nwg = nM * nN; G = G_; c = c_; }
    __host__ __device__ bool next(int i, Unit& u) const {
        const long L = (long)i * G + c; if (L >= nwg) return false;
        int wgid = (int)L; { const int q = nwg / NXCD, r = nwg % NXCD, xcd = wgid % NXCD, off = wgid / NXCD; wgid = (xcd < r ? xcd * (q + 1) : r * (q + 1) + (xcd - r) * q) + off; }
        const int nig = WGM * nN, gid = wgid / nig, fm = gid * WGM, gsz = (nM - fm) < WGM ? (nM - fm) : WGM;
        u.pm = fm + ((wgid % nig) % gsz); u.pn = (wgid % nig) / gsz; return true;
    }
    __device__ __forceinline__ void a_ready(const Unit&) const {}
    __device__ __forceinline__ void done(const Unit&) const {}
};
__device__ __forceinline__ unsigned cvt_pk_bf16(float lo, float hi) { unsigned r; asm volatile("v_cvt_pk_bf16_f32 %0, %1, %2" : "=v"(r) : "v"(lo), "v"(hi)); return r; }
typedef float f32x2 __attribute__((ext_vector_type(2)));
template <class Epi, class Sched, bool STAMP = false>
__device__ __forceinline__ void gemm_phase(PG8_LAS unsigned char* lds, const Gemm g, const Sched& S, const Epi& E, unsigned long long* stamps) {
    const int tid = otid(), wid = __builtin_amdgcn_readfirstlane(tid >> 6), lane = tid & 63, wr = wid >> 2, wc = wid & 3, fr = lane & 15, fq = lane >> 4;
    const int K = g.K, nt = K / BK, lda_ = g.lda ? g.lda : g.K;
    int ts_lo = 0, ts_hi = 0, nts = 0; const unsigned long long rt_entry = STAMP ? (unsigned long long)wall_clock64() : 0ull;
#define PG8_STAMP() do { if (STAMP && wid == 0 && nts < 64) { const unsigned long long _c = (unsigned long long)clock64(); \
        ts_lo = (lane == nts) ? (int)(unsigned)_c : ts_lo; ts_hi = (lane == nts) ? (int)(unsigned)(_c >> 32) : ts_hi; ++nts; } } while (0)
    PG8_STAMP();
    unsigned voffA[2], voffB[2];
#pragma unroll
    for (int i = 0; i < 2; ++i) { int R, C; stage_rc(tid * 16 + i * 8192, R, C); const int Rb = Epi::PERM ? ((R & ~31) + perm32(R & 31)) : R;
        voffA[i] = (unsigned)(R * lda_ + C) * 2u; voffB[i] = (unsigned)(Rb * K + C) * 2u; }
    const size_t kstep = (size_t)(BK * 2);
    const size_t hstep = (size_t)HALF * K * 2;
    const size_t hstepA = (size_t)HALF * lda_ * 2, tstepA = 2 * hstepA;
    const size_t tstep = 2 * hstep;
    const unsigned ldsw = (unsigned)wid * 1024u;
    const int aoff = lds_byte(wr * 64 + fr, fq * 8), boff = lds_byte(wc * 32 + fr, fq * 8);
#define PG8_SA(b, h) (((b) * 2 + (h)) * HTB)
#define PG8_SB(b, h) ((4 + (b) * 2 + (h)) * HTB)
#define PG8_STAGE(bufoff, gbase, voff) do { _Pragma("unroll") for (int _i = 0; _i < 2; ++_i) \
        __builtin_amdgcn_global_load_lds((const unsigned*)((const char*)(gbase) + (voff)[_i]), (PG8_LAS unsigned*)(lds + (bufoff) + ldsw + _i * 8192), 16, 0, 0); } while (0)
#define PG8_LDA(dst, b, h) do { _Pragma("unroll") for (int m = 0; m < 4; ++m) _Pragma("unroll") for (int k = 0; k < 2; ++k) dst[m][k] = *(const PG8_LAS bf16x8*)(lds + PG8_SA(b, h) + aoff + m * 2048 + k * 1024); } while (0)
#define PG8_LDB(dst, b, h) do { _Pragma("unroll") for (int n = 0; n < 2; ++n) _Pragma("unroll") for (int k = 0; k < 2; ++k) dst[n][k] = *(const PG8_LAS bf16x8*)(lds + PG8_SB(b, h) + boff + n * 2048 + k * 1024); } while (0)
#define PG8_MMA(ai, bj, At, Bt) do { __builtin_amdgcn_s_setprio(1); _Pragma("unroll") for (int m = 0; m < 4; ++m) _Pragma("unroll") for (int n = 0; n < 2; ++n) _Pragma("unroll") for (int k = 0; k < 2; ++k) \
        acc[ai][bj][m][n] = __builtin_amdgcn_mfma_f32_16x16x32_bf16(Bt[n][k], At[m][k], acc[ai][bj][m][n], 0, 0, 0); __builtin_amdgcn_s_setprio(0); } while (0)
#define PG8_WAIT_V(n) asm volatile("s_waitcnt vmcnt(" #n ")" ::: "memory")
#define PG8_WAIT_L(n) asm volatile("s_waitcnt lgkmcnt(" #n ")" ::: "memory")
#define PG8_BAR __builtin_amdgcn_s_barrier()
#define PG8_SCHED __builtin_amdgcn_sched_barrier(0)
    Unit cur, nxt; int ui = 0;
    if (!S.next(0, cur)) return;
    f32x4 acc[2][2][4][2];
#pragma unroll
    for (int a = 0; a < 2; ++a)
#pragma unroll
        for (int b = 0; b < 2; ++b)
#pragma unroll
            for (int m = 0; m < 4; ++m)
#pragma unroll
                for (int n = 0; n < 2; ++n) acc[a][b][m][n] = (f32x4){0.f, 0.f, 0.f, 0.f};
    bf16x8 At[4][2], B0[2][2], B1[2][2];
    const char* cA = PG8_ABASE(g, cur.pm); const char* cB = (const char*)g.Bt + (size_t)cur.pn * tstep;
    S.a_ready(cur);
    PG8_STAGE(PG8_SB(0, 0), cB, voffB); PG8_STAGE(PG8_SA(0, 0), cA, voffA); PG8_STAGE(PG8_SB(0, 1), cB + hstep, voffB); PG8_STAGE(PG8_SA(0, 1), cA + hstepA, voffA);
    if (wr == 1) PG8_BAR;
    PG8_WAIT_V(4); PG8_BAR;
    PG8_STAGE(PG8_SB(1, 0), cB + kstep, voffB); PG8_STAGE(PG8_SA(1, 0), cA + kstep, voffA); PG8_STAGE(PG8_SB(1, 1), cB + hstep + kstep, voffB);
    PG8_WAIT_V(6); PG8_BAR;
    PG8_STAMP();
    for (;;) {
        const bool has_next = S.next(ui + 1, nxt);
        const char* nA = has_next ? PG8_ABASE(g, nxt.pm) : cA; const char* nB = has_next ? (const char*)g.Bt + (size_t)nxt.pn * tstep : cB;
        for (int t = 0; t < nt; t += 2) {
            const bool last = (t == nt - 2);
            const char* a1 = cA + (size_t)(t + 1) * kstep;
            const char* a2 = last ? nA : cA + (size_t)(t + 2) * kstep; const char* b2 = last ? nB : cB + (size_t)(t + 2) * kstep;
            const char* a3 = a2 + kstep; const char* b3 = b2 + kstep;
            if (last && has_next) S.a_ready(nxt);
            PG8_LDB(B0, 0, 0); PG8_SCHED; PG8_LDA(At, 0, 0); PG8_STAGE(PG8_SA(1, 1), a1 + hstepA, voffA);
            PG8_WAIT_L(8); PG8_BAR; PG8_WAIT_L(0); PG8_MMA(0, 0, At, B0); PG8_BAR; PG8_SCHED;
            PG8_LDB(B1, 0, 1); PG8_STAGE(PG8_SB(0, 0), b2, voffB);
            PG8_BAR; PG8_WAIT_L(0); PG8_MMA(0, 1, At, B1); PG8_BAR;
            PG8_LDA(At, 0, 1); PG8_STAGE(PG8_SA(0, 0), a2, voffA);
            PG8_BAR; PG8_WAIT_L(0); PG8_MMA(1, 0, At, B0); PG8_BAR; PG8_SCHED;
            PG8_STAGE(PG8_SB(0, 1), b2 + hstep, voffB);
            PG8_WAIT_V(6); PG8_BAR; PG8_MMA(1, 1, At, B1); PG8_BAR;
            PG8_LDB(B0, 1, 0); PG8_SCHED; PG8_LDA(At, 1, 0); PG8_STAGE(PG8_SA(0, 1), a2 + hstepA, voffA);
            PG8_WAIT_L(8); PG8_BAR; PG8_WAIT_L(0); PG8_MMA(0, 0, At, B0); PG8_BAR; PG8_SCHED;
            PG8_LDB(B1, 1, 1); PG8_STAGE(PG8_SB(1, 0), b3, voffB);
            PG8_BAR; PG8_WAIT_L(0); PG8_MMA(0, 1, At, B1); PG8_BAR;
            PG8_LDA(At, 1, 1); PG8_STAGE(PG8_SA(1, 0), a3, voffA);
            PG8_BAR; PG8_WAIT_L(0); PG8_MMA(1, 0, At, B0); PG8_BAR; PG8_SCHED;
            PG8_STAGE(PG8_SB(1, 1), b3 + hstep, voffB);
            PG8_WAIT_V(6); PG8_BAR; PG8_MMA(1, 1, At, B1); PG8_BAR;
        }
        PG8_STAMP();
        if constexpr (!Epi::AFTER_DRAIN) { E(acc, cur, wr, wc, fr, fq); S.done(cur); }
        PG8_STAMP();
        if (!has_next) break;
#pragma unroll
        for (int a = 0; a < 2; ++a)
#pragma unroll
            for (int b = 0; b < 2; ++b)
#pragma unroll
                for (int m = 0; m < 4; ++m)
#pragma unroll
                    for (int n = 0; n < 2; ++n) acc[a][b][m][n] = (f32x4){0.f, 0.f, 0.f, 0.f};
        cur = nxt; cA = nA; cB = nB; ++ui;
    }
    PG8_WAIT_V(0);
    if (wr == 0) PG8_BAR;
    PG8_BAR;
    if constexpr (Epi::AFTER_DRAIN) { E.fused(acc, cur, wr, wc, fr, fq, lds, wid, lane); S.done(cur); }
    PG8_STAMP();
    if (STAMP && wid == 0) { stamps[lane] = lane < nts ? (((unsigned long long)(unsigned)ts_hi << 32) | (unsigned)ts_lo) : 0ull;
        if (lane == 62) stamps[62] = rt_entry; if (lane == 63) stamps[63] = (unsigned long long)wall_clock64(); }
#undef PG8_STAMP
#undef PG8_SA
#undef PG8_SB
#undef PG8_STAGE
#undef PG8_LDA
#undef PG8_LDB
#undef PG8_MMA
#undef PG8_WAIT_V
#undef PG8_WAIT_L
#undef PG8_BAR
#undef PG8_SCHED
}
}
namespace pg8 {
struct EpiBfG {
    static constexpr bool PERM = true, AFTER_DRAIN = false;
    bf16_t* O; int ldc, ncols, pn_mask;
    __device__ __forceinline__ void operator()(const f32x4 (&acc)[2][2][4][2], const Unit& u, int wr, int wc, int fr, int fq) const {
        const int row0 = u.pm * BM + wr * 64 + fr, col0 = (u.pn & pn_mask) * BM + wc * 32 + 8 * fq;
#pragma unroll
        for (int ai = 0; ai < 2; ++ai)
#pragma unroll
            for (int m = 0; m < 4; ++m) { bf16_t* rowp = O + (size_t)(row0 + ai * HALF + m * 16) * ldc;
#pragma unroll
                for (int bj = 0; bj < 2; ++bj) { const int c = col0 + bj * HALF;
                    if (c < ncols) { const f32x4 v0 = acc[ai][bj][m][0], v1 = acc[ai][bj][m][1];
                        u32x4 w; w.x = cvt_pk_bf16(v0[0], v0[1]); w.y = cvt_pk_bf16(v0[2], v0[3]); w.z = cvt_pk_bf16(v1[0], v1[1]); w.w = cvt_pk_bf16(v1[2], v1[3]);
                        *(u32x4*)(rowp + c) = w; } } }
    }
};
struct EpiSwi {
    static constexpr bool PERM = true, AFTER_DRAIN = false;
    bf16_t* H;
    __device__ __forceinline__ void operator()(const f32x4 (&acc)[2][2][4][2], const Unit& u, int wr, int wc, int fr, int fq) const {
        const int row0 = u.pm * BM + wr * 64 + fr, hc0 = (u.pn & 3) * HALF + wc * 32 + 8 * fq;
#pragma unroll
        for (int ai = 0; ai < 2; ++ai)
#pragma unroll
            for (int m = 0; m < 4; ++m) { bf16_t* rowp = H + (size_t)(row0 + ai * HALF + m * 16) * 512 + hc0;
                float o[8];
#pragma unroll
                for (int n = 0; n < 2; ++n)
#pragma unroll
                    for (int r = 0; r < 4; ++r) { const float g = acc[ai][0][m][n][r]; o[n * 4 + r] = g * __builtin_amdgcn_rcpf(1.0f + __expf(-g)) * acc[ai][1][m][n][r]; }
                u32x4 w; w.x = cvt_pk_bf16(o[0], o[1]); w.y = cvt_pk_bf16(o[2], o[3]); w.z = cvt_pk_bf16(o[4], o[5]); w.w = cvt_pk_bf16(o[6], o[7]);
                *(u32x4*)rowp = w; }
    }
};
struct MoeOrder {
    const int* slotmap; int ntiles, G, c;
    __device__ __forceinline__ bool next(int i, Unit& u) const {
        const int L = i * G + c; if (L >= ntiles * 4) return false;
        u.pm = L >> 2; u.pn = __builtin_amdgcn_readfirstlane(slotmap[L >> 2]) * 4 + (L & 3); return true;
    }
    __device__ __forceinline__ void a_ready(const Unit&) const {}
    __device__ __forceinline__ void done(const Unit&) const {}
};
}
#define WSP(T, off) as_global((T*)(kp.ws + (off)))
#define KIN(i) as_global(kp.in[i])
#define KOUT as_global(kp.out)

PHASE_FN void phase_mod(const KP& kp, unsigned char* lds) {
    float* sc = (float*)lds;
    float* red = sc + 17 * 1024;
    float* modv = WSP(float, WS_MODV);
    const int tid = otid();
    for (int i = tid; i < 17 * 1024; i += 512) { const int bb = i >> 10, k = i & 1023; const float c = bb < 16 ? KIN(1)[bb * 1024 + k] : KIN(3)[k]; sc[i] = siluf_(c); }
    __syncthreads();
    const int jc = tid & 63, ks = tid >> 6;
    for (int u = obid(); u < 192; u += gridDim.x) {
        const int l = u / 96, j0 = (u % 96) * 64;
        const float* w = KIN(4) + (size_t)l * 1024 * 6144 + j0 + jc;
        float acc[17];
#pragma unroll
        for (int bb = 0; bb < 17; ++bb) acc[bb] = 0.f;
        for (int k = ks * 128; k < ks * 128 + 128; ++k) {
            const float wv = w[(size_t)k * 6144];
#pragma unroll
            for (int bb = 0; bb < 17; ++bb) acc[bb] += sc[bb * 1024 + k] * wv;
        }
#pragma unroll
        for (int bb = 0; bb < 17; ++bb) red[(ks * 17 + bb) * 64 + jc] = acc[bb];
        __syncthreads();
        for (int i = tid; i < 17 * 64; i += 512) {
            const int bb = i >> 6, j = i & 63; float s = KIN(5)[l * 6144 + j0 + j];
#pragma unroll
            for (int k2 = 0; k2 < 8; ++k2) s += red[(k2 * 17 + bb) * 64 + j];
            modv[((size_t)l * 17 + bb) * 6144 + j0 + j] = s;
        }
        __syncthreads();
    }
}

struct CvJob { const float* src; bf16_t* dst; int N, ldd, mode, kt, ntile; };
__device__ __forceinline__ bool cv_pick(int& u, CvJob& J, const float* src, int K, int N, bf16_t* dst, int mode = 0, int ldd = -1) {
    const int ntl = (N + 63) >> 6, cnt = ntl * (K >> 6);
    if (u < cnt) { J.src = src; J.dst = dst; J.N = N; J.ldd = ldd < 0 ? K : ldd; J.mode = mode; J.kt = u / ntl; J.ntile = u % ntl; return true; }
    u -= cnt; return false;
}
__device__ __forceinline__ void cv_load(const CvJob& J, int tid, f32x4 (&r)[2]) {
#pragma unroll
    for (int i = 0; i < 2; ++i) { const int idx = tid + i * 512, k = idx >> 4, n0 = J.ntile * 64 + (idx & 15) * 4;
        r[i] = (n0 < J.N) ? *(const f32x4*)(J.src + (size_t)(J.kt * 64 + k) * J.N + n0) : (f32x4){0.f, 0.f, 0.f, 0.f}; }
}
__device__ __forceinline__ void cv_put(float* tile, int tid, const f32x4 (&r)[2]) {
#pragma unroll
    for (int i = 0; i < 2; ++i) { const int idx = tid + i * 512, k = idx >> 4, nq = (idx & 15) * 4;
        tile[k * 65 + nq] = r[i][0]; tile[k * 65 + nq + 1] = r[i][1]; tile[k * 65 + nq + 2] = r[i][2]; tile[k * 65 + nq + 3] = r[i][3]; }
}
__device__ __forceinline__ void cv_store(const float* tile, const CvJob& J, int tid) {
    const int nl = tid >> 3, k8 = tid & 7, n = J.ntile * 64 + nl;
    if (n < J.N) { int row = n; if (J.mode) row = (n >> 7) * 256 + (n & 127) + (J.mode == 2 ? 128 : 0);
        u32x4 w; const float* tp = tile + (k8 * 8) * 65 + nl;
        w.x = pack2(tp[0], tp[65]); w.y = pack2(tp[130], tp[195]); w.z = pack2(tp[260], tp[325]); w.w = pack2(tp[390], tp[455]);
        *(u32x4*)(J.dst + (size_t)row * J.ldd + J.kt * 64 + k8 * 8) = w; }
}
#define CV_RUN(total, PICK) CV_RUN_ON(total, PICK, obid(), (int)gridDim.x)
#define CV_RUN_ON(total, PICK, bid_, nb_) do { float* tile = (float*)lds; const int tid = otid(); const int G_ = (nb_); int u_ = (bid_); CvJob J, Jn; f32x4 r[2]; \
        if (u_ < (total)) { int u = u_; PICK(u, J); cv_load(J, tid, r); } \
        while (u_ < (total)) { cv_put(tile, tid, r); __syncthreads(); const int un_ = u_ + G_; \
            if (un_ < (total)) { int u = un_; PICK(u, Jn); cv_load(Jn, tid, r); } \
            cv_store(tile, J, tid); __syncthreads(); u_ = un_; J = Jn; } } while (0)
PHASE_FN void phase_conv_ab(const KP& kp, unsigned char* lds) {
#define PICK_AB(u, J) do { if (!cv_pick(u, J, KIN(7), 1024, AB_N, WSP(bf16_t, WS_WMIX + WM_AB_IN))) cv_pick(u, J, KIN(8), 2048, 1024, WSP(bf16_t, WS_WMIX + WM_AB_OUT)); } while (0)
    CV_RUN(16 * 85 + 32 * 16, PICK_AB);
#undef PICK_AB
}
PHASE_FN void phase_conv_cd(const KP& kp, unsigned char* lds) {
#define PICK_CD(u, J) do { if (cv_pick(u, J, KIN(18), 1024, CD_N, WSP(bf16_t, WS_WMIX + WM_CD_IN))) break; \
        if (cv_pick(u, J, KIN(19), 1536, 1024, WSP(bf16_t, WS_WMIX + WM_CD_OUT))) break; \
        if (cv_pick(u, J, KIN(21), 384, 768, WSP(bf16_t, WS_WMIX + WM_UQ))) break; \
        if (cv_pick(u, J, KIN(23), 256, 1024, WSP(bf16_t, WS_WMIX + WM_UKV))) break; \
        cv_pick(u, J, KIN(29), 128, 1024, WSP(bf16_t, WS_WMIX + WM_G2)); } while (0)
    CV_RUN(16 * 65 + 24 * 16 + 6 * 12 + 4 * 16 + 2 * 16, PICK_CD);
#undef PICK_CD
}
PHASE_FN void phase_conv_moe(const KP& kp, unsigned char* lds, int l, int bid, int nb) {
#define PICK_MOE(u0, J) do { const int es = (u0) / 384; int uu = (u0) % 384; \
        const float* wg = es < 16 ? KIN(36) + ((size_t)l * 16 + es) * 1024 * 512 : KIN(39) + (size_t)l * 1024 * 512; \
        const float* wu = es < 16 ? KIN(37) + ((size_t)l * 16 + es) * 1024 * 512 : KIN(40) + (size_t)l * 1024 * 512; \
        const float* wd = es < 16 ? KIN(38) + ((size_t)l * 16 + es) * 512 * 1024 : KIN(41) + (size_t)l * 512 * 1024; \
        bf16_t* dup = WSP(bf16_t, WS_BIG + MO_WUP) + (size_t)es * 1024 * 1024; bf16_t* ddn = WSP(bf16_t, WS_BIG + MO_WDN) + (size_t)es * 1024 * 512; \
        if (cv_pick(uu, J, wg, 1024, 512, dup, 1, 1024)) break; if (cv_pick(uu, J, wu, 1024, 512, dup, 2, 1024)) break; cv_pick(uu, J, wd, 512, 1024, ddn, 0, 512); } while (0)
    CV_RUN_ON(17 * 384, PICK_MOE, bid, nb);
#undef PICK_MOE
}

__device__ __forceinline__ const float* hrow_rd(const KP& kp, bool from_inputs, int b, int t) {
    if (t < CTXL) return (from_inputs ? KIN(2) : WSP(const float, WS_HC)) + ((size_t)b * CTXL + t) * D;
    return (from_inputs ? KIN(0) : KOUT) + ((size_t)b * SEQ + (t - CTXL)) * D;
}
__device__ __forceinline__ float* hrow_wr(const KP& kp, int b, int t) {
    if (t < CTXL) return WSP(float, WS_HC) + ((size_t)b * CTXL + t) * D;
    return KOUT + ((size_t)b * SEQ + (t - CTXL)) * D;
}

PHASE_FN void phase_u(const KP& kp, int layer, int g, int bid, int nb, bool to_v) {
    const int lane = otid() & 63, wid = __builtin_amdgcn_readfirstlane(otid() >> 6);
    const float* modv = WSP(const float, WS_MODV) + (size_t)layer * 17 * 6144;
    const float* ng = KIN(6) + (size_t)layer * 4 * 1024;
    bf16_t* U = to_v ? WSP(bf16_t, WS_V) + (size_t)RG * 1024 : WSP(bf16_t, WS_BIG + (layer == 0 ? L0_U : L1_U));
    for (int lr = bid * 8 + wid; lr < RG; lr += nb * 8) {
        const int bl = lr / TT, t = lr - bl * TT, b = g * BG + bl;
        const float* src = hrow_rd(kp, layer == 0, b, t);
        const float* mv = modv + (size_t)(t < CTXL ? 16 : b) * 6144;
        f32x4 x[4]; float ss = 0.f;
#pragma unroll
        for (int i = 0; i < 4; ++i) { x[i] = *(const f32x4*)(src + i * 256 + lane * 4); ss += x[i][0] * x[i][0] + x[i][1] * x[i][1] + x[i][2] * x[i][2] + x[i][3] * x[i][3]; }
        ss = wsum(ss); const float rstd = rsqrtf(ss * (1.0f / 1024.0f) + EPS);
#pragma unroll
        for (int i = 0; i < 4; ++i) { const int col = i * 256 + lane * 4;
            const f32x4 gv = *(const f32x4*)(ng + col), sc = *(const f32x4*)(mv + 1024 + col), sh = *(const f32x4*)(mv + col);
            st4bf(U + (size_t)lr * 1024 + col, x[i] * rstd * gv * (sc + 1.0f) + sh); }
    }
}

PHASE_FN void phase_r(const KP& kp, unsigned char* lds, int layer, int g) {
    const int tid = otid(), lane = tid & 63, wid = __builtin_amdgcn_readfirstlane(tid >> 6);
    float* rw = (float*)lds;
    int* se = (int*)(rw + 1024 * 16);
    int* sbase = se + 160;
    for (int i = tid; i < 1024 * 16; i += 512) rw[i] = KIN(34)[i];
    __syncthreads();
    const float* modv = WSP(const float, WS_MODV) + (size_t)layer * 17 * 6144;
    const float* ng = KIN(6) + (size_t)layer * 4 * 1024;
    const bf16_t* MIX = WSP(const bf16_t, WS_BIG + (layer == 0 ? L0_U : L1_U));
    bf16_t* V = WSP(bf16_t, WS_V);
    unsigned* cnt = WSP(unsigned, CTL_CNT) + layer * 16;
    int* TOKE = WSP(int, WS_TOKE); int* TOKP = WSP(int, WS_TOKP); float* TOKW = WSP(float, WS_TOKW); int* LIST = WSP(int, WS_LIST);
    const int nrows = layer == 0 ? RG : RGL, CH = layer == 0 ? 72 : 64, RW = CH >> 3, nchunks = nrows / CH;
    float rbias[16];
#pragma unroll
    for (int e = 0; e < 16; ++e) rbias[e] = KIN(35)[e];
    for (int ch = obid(); ch < nchunks; ch += gridDim.x) {
        for (int rr = 0; rr < RW; ++rr) {
            const int rl = wid * RW + rr, lr = ch * CH + rl;
            int b, t, tok;
            if (layer == 0) { const int bl = lr / TT; t = lr - bl * TT; b = g * BG + bl; tok = g * RG + lr; }
            else { const int bl = lr >> 11; t = CTXL + (lr & 2047); b = g * BG + bl; tok = g * RGL + lr; }
            const float* hsrc = hrow_rd(kp, layer == 0, b, t);
            float* hdst = hrow_wr(kp, b, t);
            const float* mv = modv + (size_t)(t < CTXL ? 16 : b) * 6144;
            f32x4 y[4], h[4]; float ss = 0.f;
#pragma unroll
            for (int i = 0; i < 4; ++i) { y[i] = ld4bf(MIX + (size_t)lr * 1024 + i * 256 + lane * 4); ss += y[i][0] * y[i][0] + y[i][1] * y[i][1] + y[i][2] * y[i][2] + y[i][3] * y[i][3]; }
            ss = wsum(ss); float rstd = rsqrtf(ss * (1.0f / 1024.0f) + EPS);
            float s2 = 0.f;
#pragma unroll
            for (int i = 0; i < 4; ++i) { const int col = i * 256 + lane * 4;
                const f32x4 g1 = *(const f32x4*)(ng + 1024 + col), ga = *(const f32x4*)(mv + 2048 + col), hx = *(const f32x4*)(hsrc + col);
                h[i] = hx + ga * (y[i] * rstd * g1);
                *(f32x4*)(hdst + col) = h[i];
                s2 += h[i][0] * h[i][0] + h[i][1] * h[i][1] + h[i][2] * h[i][2] + h[i][3] * h[i][3]; }
            s2 = wsum(s2); rstd = rsqrtf(s2 * (1.0f / 1024.0f) + EPS);
            float lg[16];
#pragma unroll
            for (int e = 0; e < 16; ++e) lg[e] = 0.f;
#pragma unroll
            for (int i = 0; i < 4; ++i) { const int col = i * 256 + lane * 4;
                const f32x4 g2 = *(const f32x4*)(ng + 2048 + col), scf = *(const f32x4*)(mv + 4096 + col), shf = *(const f32x4*)(mv + 3072 + col);
                const f32x4 v = h[i] * rstd * g2 * (scf + 1.0f) + shf;
                st4bf(V + (size_t)tok * 1024 + col, v);
#pragma unroll
                for (int j = 0; j < 4; ++j) {
#pragma unroll
                    for (int q = 0; q < 4; ++q) { const f32x4 w4 = *(const f32x4*)(rw + (col + j) * 16 + q * 4);
                        lg[q * 4 + 0] += v[j] * w4[0]; lg[q * 4 + 1] += v[j] * w4[1]; lg[q * 4 + 2] += v[j] * w4[2]; lg[q * 4 + 3] += v[j] * w4[3]; } } }
#pragma unroll
            for (int e = 0; e < 16; ++e) lg[e] = wsum(lg[e]);
            float aff[16], sel[16];
#pragma unroll
            for (int e = 0; e < 16; ++e) { aff[e] = sigmoidf_(lg[e]); sel[e] = aff[e] + rbias[e]; }
            float gs[4];
#pragma unroll
            for (int gi = 0; gi < 4; ++gi) { const float a0 = sel[gi * 4], a1 = sel[gi * 4 + 1], a2 = sel[gi * 4 + 2], a3 = sel[gi * 4 + 3];
                gs[gi] = fmaxf(fmaxf(fmaxf(a0 + a1, a0 + a2), fmaxf(a0 + a3, a1 + a2)), fmaxf(a1 + a3, a2 + a3)); }
            int gidx = 0; float gb = gs[0];
#pragma unroll
            for (int gi = 1; gi < 4; ++gi) if (gs[gi] > gb) { gb = gs[gi]; gidx = gi; }
            float c[4], f[4];
#pragma unroll
            for (int i = 0; i < 4; ++i) { c[i] = gidx == 0 ? sel[i] : gidx == 1 ? sel[4 + i] : gidx == 2 ? sel[8 + i] : sel[12 + i];
                                           f[i] = gidx == 0 ? aff[i] : gidx == 1 ? aff[4 + i] : gidx == 2 ? aff[8 + i] : aff[12 + i]; }
            int i1 = 0; float cb = c[0];
#pragma unroll
            for (int i = 1; i < 4; ++i) if (c[i] > cb) { cb = c[i]; i1 = i; }
            int i2 = -1; float cb2 = 0.f;
#pragma unroll
            for (int i = 0; i < 4; ++i) if (i != i1 && (i2 < 0 || c[i] > cb2)) { cb2 = c[i]; i2 = i; }
            float w1 = i1 == 0 ? f[0] : i1 == 1 ? f[1] : i1 == 2 ? f[2] : f[3];
            float w2 = i2 == 0 ? f[0] : i2 == 1 ? f[1] : i2 == 2 ? f[2] : f[3];
            const float wsn = 1.0f / (w1 + w2); w1 *= wsn; w2 *= wsn;
            if (lane == 0) { se[rl * 2] = gidx * 4 + i1; se[rl * 2 + 1] = gidx * 4 + i2;
                TOKE[tok * 2] = gidx * 4 + i1; TOKE[tok * 2 + 1] = gidx * 4 + i2; TOKW[tok * 2] = w1; TOKW[tok * 2 + 1] = w2; }
        }
        __syncthreads();
        if (tid < 16) { int c2 = 0; for (int i = 0; i < 2 * CH; ++i) c2 += (se[i] == tid) ? 1 : 0; sbase[tid] = (int)atomicAdd(&cnt[tid], (unsigned)c2); }
        __syncthreads();
        if (tid < 2 * CH) { const int e = se[tid]; int rank = 0; for (int j = 0; j < tid; ++j) rank += (se[j] == e) ? 1 : 0;
            const int pos = sbase[e] + rank; const int lr = ch * CH + (tid >> 1); const int tok = (layer == 0 ? g * RG : g * RGL) + lr;
            LIST[(size_t)e * NTOK + pos] = tok; TOKP[tok * 2 + (tid & 1)] = pos; }
        __syncthreads();
    }
}

__device__ __forceinline__ int moe_tile_prefix(const unsigned* cnt, int ntok, int lane) {
    const int myt = lane < 16 ? (int)((cnt[lane & 15] + 255u) >> 8) : 0; int pref = myt;
#pragma unroll
    for (int o = 1; o < 16; o <<= 1) { const int t = __shfl_up(pref, o); if (lane >= o) pref += t; }
    return pref - myt + ntok / 256;
}
PHASE_FN void phase_moe_gather(const KP& kp, int layer) {
    const int lane = otid() & 63, wid = __builtin_amdgcn_readfirstlane(otid() >> 6);
    const int ntok = layer == 0 ? NTOK : NLAT;
    const int tpre = moe_tile_prefix(WSP(const unsigned, CTL_CNT) + layer * 16, ntok, lane);
    const bf16_t* V = WSP(const bf16_t, WS_V); bf16_t* XG = WSP(bf16_t, WS_BIG + MO_XG);
    const int* TOKE = WSP(const int, WS_TOKE); const int* TOKP = WSP(const int, WS_TOKP);
    for (int it = obid() * 8 + wid; it < 2 * ntok; it += gridDim.x * 8) {
        const int tok = it >> 1, e = TOKE[it], pos = TOKP[it];
        const size_t row = (size_t)(__shfl(tpre, e) - ntok / 256) * 256 + pos;
        const u32x4* src = (const u32x4*)(V + (size_t)tok * 1024) + lane * 2; u32x4* dst = (u32x4*)(XG + row * 1024) + lane * 2;
        const u32x4 a = src[0], b2 = src[1]; dst[0] = a; dst[1] = b2;
    }
}
PHASE_FN void phase_moe_gemm(const KP& kp, unsigned char* lds, int layer, bool down) {
    const int tid = otid();
    int* pre = (int*)(lds + pg8::STAGE_BYTES);
    int* slotmap = pre + 32;
    const int ntok = layer == 0 ? NTOK : NLAT;
    const unsigned* cnt = WSP(const unsigned, CTL_CNT) + layer * 16;
    if (tid == 0) { int p = ntok / 256; pre[0] = 0; pre[1] = p; for (int e = 0; e < 16; ++e) { p += ((int)cnt[e] + 255) >> 8; pre[2 + e] = p; } }
    __syncthreads();
    const int ntiles = pre[17];
    for (int t = tid; t < ntiles; t += 512) { int idx = 0; for (int e = 1; e < 17; ++e) if (pre[e] <= t) idx = e; slotmap[t] = idx == 0 ? 16 : idx - 1; }
    __syncthreads();
    pg8::MoeOrder S{slotmap, ntiles, (int)gridDim.x, obid()};
    if (!down) {
        pg8::Gemm g{WSP(const bf16_t, WS_V), WSP(const bf16_t, WS_BIG + MO_WUP), 0, 0, 1024, WSP(const bf16_t, WS_BIG + MO_XG), ntok / 256};
        pg8::EpiSwi E{WSP(bf16_t, WS_BIG + MO_HID)};
        pg8::gemm_phase<pg8::EpiSwi, pg8::MoeOrder, false>((PG8_LAS unsigned char*)lds, g, S, E, nullptr);
    } else {
        pg8::Gemm g{WSP(const bf16_t, WS_BIG + MO_HID), WSP(const bf16_t, WS_BIG + MO_WDN), 0, 0, 512, nullptr, 0x7fffffff};
        pg8::EpiBfG E{WSP(bf16_t, WS_BIG + MO_CON), 1024, 1024, 3};
        pg8::gemm_phase<pg8::EpiBfG, pg8::MoeOrder, false>((PG8_LAS unsigned char*)lds, g, S, E, nullptr);
    }
    __syncthreads();
}

PHASE_FN void phase_combine(const KP& kp, int layer) {
    const int lane = otid() & 63, wid = __builtin_amdgcn_readfirstlane(otid() >> 6);
    const int ntok = layer == 0 ? NTOK : NLAT;
    const unsigned* cnt = WSP(const unsigned, CTL_CNT) + layer * 16;
    const float* modv = WSP(const float, WS_MODV) + (size_t)layer * 17 * 6144;
    const float* ng = KIN(6) + (size_t)layer * 4 * 1024 + 3 * 1024;
    const bf16_t* CON = WSP(const bf16_t, WS_BIG + MO_CON);
    const int* TOKE = WSP(const int, WS_TOKE); const int* TOKP = WSP(const int, WS_TOKP); const float* TOKW = WSP(const float, WS_TOKW);
    const int tpre = moe_tile_prefix(cnt, ntok, lane);
    for (int tok0 = (obid() * 8 + wid) * 2; tok0 < ntok; tok0 += gridDim.x * 16) {
        int e1[2], e2[2], p1[2], p2[2]; float w1[2], w2[2];
#pragma unroll
        for (int u = 0; u < 2; ++u) { const int tok = tok0 + u; e1[u] = TOKE[tok * 2]; e2[u] = TOKE[tok * 2 + 1]; p1[u] = TOKP[tok * 2]; p2[u] = TOKP[tok * 2 + 1]; w1[u] = TOKW[tok * 2]; w2[u] = TOKW[tok * 2 + 1]; }
        f32x4 f[2][4], hx[2][4]; float* hp[2]; const float* mv[2];
#pragma unroll
        for (int u = 0; u < 2; ++u) { const int tok = tok0 + u;
            const size_t r1 = (size_t)__shfl(tpre, e1[u]) * 256 + p1[u], r2 = (size_t)__shfl(tpre, e2[u]) * 256 + p2[u];
            int b, t;
            if (layer == 0) { b = tok / TT; t = tok - b * TT; } else { b = tok >> 11; t = CTXL + (tok & 2047); }
            hp[u] = hrow_wr(kp, b, t); mv[u] = modv + (size_t)(t < CTXL ? 16 : b) * 6144 + 5 * 1024;
#pragma unroll
            for (int i = 0; i < 4; ++i) { const int col = i * 256 + lane * 4;
                f[u][i] = ld4bf(CON + (size_t)tok * 1024 + col) + ld4bf(CON + r1 * 1024 + col) * w1[u] + ld4bf(CON + r2 * 1024 + col) * w2[u];
                hx[u][i] = *(const f32x4*)(hp[u] + col); } }
#pragma unroll
        for (int u = 0; u < 2; ++u) { float ss = 0.f;
#pragma unroll
            for (int i = 0; i < 4; ++i) ss += f[u][i][0] * f[u][i][0] + f[u][i][1] * f[u][i][1] + f[u][i][2] * f[u][i][2] + f[u][i][3] * f[u][i][3];
            ss = wsum(ss); const float rstd = rsqrtf(ss * (1.0f / 1024.0f) + EPS);
            float s2 = 0.f;
#pragma unroll
            for (int i = 0; i < 4; ++i) { const int col = i * 256 + lane * 4;
                const f32x4 g3 = *(const f32x4*)(ng + col), gf = *(const f32x4*)(mv[u] + col);
                const f32x4 hn = hx[u][i] + gf * (f[u][i] * rstd * g3);
                *(f32x4*)(hp[u] + col) = hn; hx[u][i] = hn;
                s2 += hn[0] * hn[0] + hn[1] * hn[1] + hn[2] * hn[2] + hn[3] * hn[3]; }
            if (layer == 0) {
                s2 = wsum(s2); const float rs2 = rsqrtf(s2 * (1.0f / 1024.0f) + EPS);
                const float* mv1 = mv[u] - 5 * 1024 + 17 * 6144;
                const float* ng1 = KIN(6) + 4 * 1024;
                bf16_t* U1 = WSP(bf16_t, WS_V) + (size_t)(tok0 + u) * 1024;
#pragma unroll
                for (int i = 0; i < 4; ++i) { const int col = i * 256 + lane * 4;
                    const f32x4 gv = *(const f32x4*)(ng1 + col), sc = *(const f32x4*)(mv1 + 1024 + col), sh = *(const f32x4*)(mv1 + col);
                    st4bf(U1 + col, hx[u][i] * rs2 * gv * (sc + 1.0f) + sh); } } }
    }
}

template <int CH>
__device__ __forceinline__ int scan_t(int dir, int ci, int j) {
    constexpr int NC_CTX = CTXL / CH;
    if (!dir) return ci * CH + j;
    return ci < NC_CTX ? (CTXL - 1 - ci * CH - j) : (TT - 1 - (ci - NC_CTX) * CH - j);
}

constexpr int ML_LQ = 136, ML_LT = 72, ML_VR = 144;
PHASE_FN void mlstm_unit(const KP& kp, unsigned char* lds, int bl, int h, int dir, int vh) {
    const int tid = otid();
    bf16_t* Qs = (bf16_t*)lds;
    bf16_t* Ks = Qs + 64 * ML_LQ;
    bf16_t* KTE = Ks + 64 * ML_LQ;
    bf16_t* VT = KTE + 128 * ML_LT;
    bf16_t* Ps = VT + ML_VR * ML_LT;
    bf16_t* Cb = Ps + 64 * ML_LT;
    float* fs = (float*)(Cb + ML_VR * ML_LQ);
    float* s_rowv = fs;
    float* s_colv = fs + 64;
    float* s_wint = fs + 128;
    float* s_emj = fs + 192;
    float* s_E = fs + 256;
    float* s_den = fs + 320;
    float* s_misc = fs + 384;
    const bf16_t* P = WSP(const bf16_t, WS_BIG + L0_P);
    bf16_t* HOUT = WSP(bf16_t, WS_BIG + (dir ? L0_HB : L0_AO)); const int ldh = dir ? 1024 : 2048;
    const float ibias = KIN(9)[dir * 4 + h], fbias = KIN(10)[dir * 4 + h];
    for (int i = tid; i < ML_VR * ML_LQ; i += 512) Cb[i] = 0;
    for (int i = tid; i < 16 * ML_LT; i += 512) VT[128 * ML_LT + i] = (i < ML_LT) ? (bf16_t)0x3f80 : (bf16_t)0;
    f32x4 Cacc[8], Nacc;
#pragma unroll
    for (int i = 0; i < 8; ++i) Cacc[i] = (f32x4){0.f, 0.f, 0.f, 0.f};
    Nacc = (f32x4){0.f, 0.f, 0.f, 0.f};
    float m_state = 0.f;
    u32x4 pq[2], pk[2], pv[2]; bf16_t pgi = 0, pgf = 0;
#define ML_REQ(ci_) do { _Pragma("unroll") for (int i = 0; i < 2; ++i) { const int p = tid + i * 512, j = p >> 4, c8 = p & 15; \
            const bf16_t* pr = P + ((size_t)bl * TT + scan_t<64>(dir, (ci_), j)) * AB_N; \
            pq[i] = *(const u32x4*)(pr + AB_Q + h * 128 + c8 * 8); pk[i] = *(const u32x4*)(pr + AB_K + h * 128 + c8 * 8); \
            const int jv = tid & 63, cv = (tid >> 6) + i * 8; \
            pv[i] = *(const u32x4*)(P + ((size_t)bl * TT + scan_t<64>(dir, (ci_), jv)) * AB_N + AB_V + h * 256 + vh * 128 + cv * 8); } \
        if (tid < 64) { const bf16_t* pg = P + ((size_t)bl * TT + scan_t<64>(dir, (ci_), tid)) * AB_N; pgi = pg[AB_IG + dir * 4 + h]; pgf = pg[AB_FG + dir * 4 + h]; } } while (0)
    ML_REQ(0);
    lds_barrier();
    for (int ci = 0; ci < TT / 64; ++ci) {
        int tq = tid; asm volatile("" : "+v"(tq));
        const int lane = tq & 63, wid = __builtin_amdgcn_readfirstlane(tq >> 6), fr = lane & 15, fq = lane >> 4;
#pragma unroll
        for (int i = 0; i < 2; ++i) {
            const int p = tq + i * 512, j = p >> 4, c8 = p & 15;
            u32x4 q = pq[i];
            const float qs = 0.08838834764831845f;
            q.x = pack2(lo2f(q.x) * qs, hi2f(q.x) * qs); q.y = pack2(lo2f(q.y) * qs, hi2f(q.y) * qs);
            q.z = pack2(lo2f(q.z) * qs, hi2f(q.z) * qs); q.w = pack2(lo2f(q.w) * qs, hi2f(q.w) * qs);
            *(u32x4*)(Qs + j * ML_LQ + c8 * 8) = q;
            *(u32x4*)(Ks + j * ML_LQ + c8 * 8) = pk[i];
            const u32x4 v = pv[i];
            bf16_t* vt = VT + (((tq >> 6) + i * 8) * 8) * ML_LT + (tq & 63);
            vt[0 * ML_LT] = (bf16_t)(v.x & 0xffff); vt[1 * ML_LT] = (bf16_t)(v.x >> 16); vt[2 * ML_LT] = (bf16_t)(v.y & 0xffff); vt[3 * ML_LT] = (bf16_t)(v.y >> 16);
            vt[4 * ML_LT] = (bf16_t)(v.z & 0xffff); vt[5 * ML_LT] = (bf16_t)(v.z >> 16); vt[6 * ML_LT] = (bf16_t)(v.w & 0xffff); vt[7 * ML_LT] = (bf16_t)(v.w >> 16);
        }
        if (wid == 0) {
            const float ig = bf2f(pgi) + ibias;
            const float lf = logsigmoidf_(bf2f(pgf) + fbias);
            float b = lf;
#pragma unroll
            for (int o = 1; o < 64; o <<= 1) { const float t = __shfl_up(b, o); if (lane >= o) b += t; }
            const float u = ig - b; float pm = u;
#pragma unroll
            for (int o = 1; o < 64; o <<= 1) { const float t = __shfl_up(pm, o); if (lane >= o) pm = fmaxf(pm, t); }
            const float mj = fmaxf(b + m_state, b + pm);
            const float b63 = __shfl(b, 63), pm63 = __shfl(pm, 63);
            const float mnew = fmaxf(b63 + m_state, b63 + pm63);
            s_rowv[lane] = b - mj; s_colv[lane] = u; s_wint[lane] = __expf(b + m_state - mj); s_emj[lane] = __expf(-mj);
            s_E[lane] = __expf(b63 + u - mnew);
            if (lane == 0) { s_misc[0] = mnew; s_misc[1] = __expf(b63 + m_state - mnew); }
        }
        if (ci + 1 < TT / 64) ML_REQ(ci + 1);
        lds_barrier();
        {
            const int jt = wid >> 1;
#pragma unroll
            for (int q2 = 0; q2 < 2; ++q2) {
                const int st = (wid & 1) * 2 + q2;
                f32x4 acc = (f32x4){0.f, 0.f, 0.f, 0.f};
                if (st <= jt) {
                    bf16x8 fa[4], fb[4];
#pragma unroll
                    for (int k = 0; k < 4; ++k) { fa[k] = ldfrag(Qs, ML_LQ, jt * 16, k * 32, fr, fq); fb[k] = ldfrag(Ks, ML_LQ, st * 16, k * 32, fr, fq); }
                    __builtin_amdgcn_sched_barrier(0);
                    f32x4 acc2 = (f32x4){0.f, 0.f, 0.f, 0.f};
                    acc = mma16(fa[0], fb[0], acc); acc2 = mma16(fa[1], fb[1], acc2); acc = mma16(fa[2], fb[2], acc); acc2 = mma16(fa[3], fb[3], acc2);
                    acc = acc + acc2;
                }
                const int s = st * 16 + fr; const float cv = s_colv[s];
#pragma unroll
                for (int r = 0; r < 4; ++r) { const int j = jt * 16 + fq * 4 + r;
                    const float pv2 = (s <= j) ? acc[r] * __expf(s_rowv[j] + cv) : 0.f;
                    Ps[j * ML_LT + s] = f2bf(pv2); }
            }
#pragma unroll
            for (int i = 0; i < 2; ++i) {
                const int s = lane, c8 = wid + i * 8; const float e = s_E[s];
                const u32x4 kv = *(const u32x4*)(Ks + s * ML_LQ + c8 * 8);
                bf16_t* kt = KTE + (c8 * 8) * ML_LT + s;
                kt[0 * ML_LT] = f2bf(lo2f(kv.x) * e); kt[1 * ML_LT] = f2bf(hi2f(kv.x) * e); kt[2 * ML_LT] = f2bf(lo2f(kv.y) * e); kt[3 * ML_LT] = f2bf(hi2f(kv.y) * e);
                kt[4 * ML_LT] = f2bf(lo2f(kv.z) * e); kt[5 * ML_LT] = f2bf(hi2f(kv.z) * e); kt[6 * ML_LT] = f2bf(lo2f(kv.w) * e); kt[7 * ML_LT] = f2bf(hi2f(kv.w) * e);
            }
        }
        lds_barrier();
        f32x4 a1[4], a2[4];
        {
            const int jt = wid >> 1;
            bf16x8 fp[2], fqq[4];
#pragma unroll
            for (int k = 0; k < 2; ++k) fp[k] = ldfrag(Ps, ML_LT, jt * 16, k * 32, fr, fq);
#pragma unroll
            for (int k = 0; k < 4; ++k) fqq[k] = ldfrag(Qs, ML_LQ, jt * 16, k * 32, fr, fq);
            {
                bf16x8 fv[4][2];
#pragma unroll
                for (int q4 = 0; q4 < 4; ++q4)
#pragma unroll
                    for (int k = 0; k < 2; ++k) fv[q4][k] = ldfrag(VT, ML_LT, ((wid & 1) * 4 + q4) * 16, k * 32, fr, fq);
                __builtin_amdgcn_sched_barrier(0);
#pragma unroll
                for (int q4 = 0; q4 < 4; ++q4) a1[q4] = (f32x4){0.f, 0.f, 0.f, 0.f};
#pragma unroll
                for (int k = 0; k < 2; ++k)
#pragma unroll
                    for (int q4 = 0; q4 < 4; ++q4) a1[q4] = mma16(fv[q4][k], fp[k], a1[q4]);
            }
#pragma unroll
            for (int hh = 0; hh < 2; ++hh) {
                bf16x8 fc[2][4];
#pragma unroll
                for (int q2 = 0; q2 < 2; ++q2)
#pragma unroll
                    for (int k = 0; k < 4; ++k) fc[q2][k] = ldfrag(Cb, ML_LQ, ((wid & 1) * 4 + hh * 2 + q2) * 16, k * 32, fr, fq);
                __builtin_amdgcn_sched_barrier(0);
                a2[hh * 2] = (f32x4){0.f, 0.f, 0.f, 0.f}; a2[hh * 2 + 1] = (f32x4){0.f, 0.f, 0.f, 0.f};
#pragma unroll
                for (int k = 0; k < 4; ++k) { a2[hh * 2] = mma16(fc[0][k], fqq[k], a2[hh * 2]); a2[hh * 2 + 1] = mma16(fc[1][k], fqq[k], a2[hh * 2 + 1]); }
            }
            if (wid & 1) {
                f32x4 d1 = (f32x4){0.f, 0.f, 0.f, 0.f}, d2 = (f32x4){0.f, 0.f, 0.f, 0.f};
                bf16x8 fo[2], fn[4];
#pragma unroll
                for (int k = 0; k < 2; ++k) fo[k] = ldfrag(VT, ML_LT, 128, k * 32, fr, fq);
#pragma unroll
                for (int k = 0; k < 4; ++k) fn[k] = ldfrag(Cb, ML_LQ, 128, k * 32, fr, fq);
                __builtin_amdgcn_sched_barrier(0);
                d1 = mma16(fo[0], fp[0], d1); d2 = mma16(fn[0], fqq[0], d2); d1 = mma16(fo[1], fp[1], d1); d2 = mma16(fn[1], fqq[1], d2);
                d2 = mma16(fn[2], fqq[2], d2); d2 = mma16(fn[3], fqq[3], d2);
                if (fq == 0) { const int j = jt * 16 + fr; s_den[j] = fmaxf(fabsf(d1[0] + s_wint[j] * d2[0]), s_emj[j]); }
            }
        }
        lds_barrier();
        {
            const int jt = wid >> 1, j = jt * 16 + fr;
            const float wi = s_wint[j], rden = frcp_(s_den[j]);
            const size_t row = (size_t)bl * TT + scan_t<64>(dir, ci, j);
#pragma unroll
            for (int q4 = 0; q4 < 4; ++q4) { const int v0 = ((wid & 1) * 4 + q4) * 16 + fq * 4;
                st4bf(HOUT + row * ldh + h * 256 + vh * 128 + v0, (a1[q4] + a2[q4] * wi) * rden); }
        }
        {
            const float dec = s_misc[1];
            const bf16x8 bv0 = ldfrag(VT, ML_LT, wid * 16, 0, fr, fq), bv1 = ldfrag(VT, ML_LT, wid * 16, 32, fr, fq);
#pragma unroll
            for (int hh = 0; hh < 2; ++hh) {
                bf16x8 fk[4][2];
#pragma unroll
                for (int q = 0; q < 4; ++q) { fk[q][0] = ldfrag(KTE, ML_LT, (hh * 4 + q) * 16, 0, fr, fq); fk[q][1] = ldfrag(KTE, ML_LT, (hh * 4 + q) * 16, 32, fr, fq); }
                __builtin_amdgcn_sched_barrier(0);
#pragma unroll
                for (int q = 0; q < 4; ++q) Cacc[hh * 4 + q] = Cacc[hh * 4 + q] * dec;
#pragma unroll
                for (int q = 0; q < 4; ++q) Cacc[hh * 4 + q] = mma16(fk[q][0], bv0, Cacc[hh * 4 + q]);
#pragma unroll
                for (int q = 0; q < 4; ++q) Cacc[hh * 4 + q] = mma16(fk[q][1], bv1, Cacc[hh * 4 + q]);
#pragma unroll
                for (int q = 0; q < 4; ++q) st4bf(Cb + (wid * 16 + fr) * ML_LQ + (hh * 4 + q) * 16 + fq * 4, Cacc[hh * 4 + q]);
            }
            Nacc = Nacc * dec;
            Nacc = mma16(ldfrag(KTE, ML_LT, wid * 16, 0, fr, fq), ldfrag(VT, ML_LT, 128, 0, fr, fq), Nacc);
            Nacc = mma16(ldfrag(KTE, ML_LT, wid * 16, 32, fr, fq), ldfrag(VT, ML_LT, 128, 32, fr, fq), Nacc);
            st4bf(Cb + (128 + fr) * ML_LQ + wid * 16 + fq * 4, Nacc);
            m_state = s_misc[0];
        }
        lds_barrier();
    }
#undef ML_REQ
}

constexpr size_t L0_XC = L0_U;
static_assert(L0_XC + (size_t)RG * 1280 * 2 <= BIG_BYTES, "xconv buffer");
PHASE_FN void phase_xconv(const KP& kp) {
    const int lane = otid() & 63, wid = __builtin_amdgcn_readfirstlane(otid() >> 6);
    const bf16_t* P = WSP(const bf16_t, WS_BIG + L0_P); bf16_t* XC = WSP(bf16_t, WS_BIG + L0_XC);
    const float* cw = KIN(12); const float* cb = KIN(13);
    constexpr int RUN = 9;
    for (int run = obid() * 8 + wid; run < RG / RUN; run += gridDim.x * 8) {
        const int r0 = run * RUN;
#pragma unroll
        for (int i = 0; i < 5; ++i) { const int col = i * 256 + lane * 4;
            const f32x4 bias = *(const f32x4*)(cb + col);
            f32x4 w[5], x[5];
#pragma unroll
            for (int q = 0; q < 5; ++q) w[q] = *(const f32x4*)(cw + q * 1280 + col);
#pragma unroll
            for (int q = 0; q < 4; ++q) { const int rr = r0 - 2 + q; x[q + 1] = (rr >= 0 && rr < RG) ? ld4bf(P + (size_t)rr * AB_N + AB_XBC + col) : (f32x4){0.f, 0.f, 0.f, 0.f}; }
#pragma unroll
            for (int k = 0; k < RUN; ++k) {
                const int lr = r0 + k, bl = lr / TT, t = lr - bl * TT, lo = t < CTXL ? 0 : CTXL, hi = t < CTXL ? CTXL : TT;
#pragma unroll
                for (int q = 0; q < 4; ++q) x[q] = x[q + 1];
                { const int rr = lr + 2; x[4] = (rr < RG) ? ld4bf(P + (size_t)rr * AB_N + AB_XBC + col) : (f32x4){0.f, 0.f, 0.f, 0.f}; }
                f32x4 a = bias;
#pragma unroll
                for (int q = 0; q < 5; ++q) { const int tt = t - 2 + q; if (tt >= lo && tt < hi) a += w[q] * x[q]; }
                f32x4 o;
#pragma unroll
                for (int r = 0; r < 4; ++r) o[r] = siluf_(a[r]);
                st4bf(XC + (size_t)lr * 1280 + col, o);
            }
        }
    }
}

constexpr int SS_LT = 72, SS_LX = 136;
PHASE_FN void ssd_unit(const KP& kp, unsigned char* lds, int bl, int dir, int hp) {
    const int tid = otid();
    const int gi = hp >> 2, hh0 = hp * 2;
    bf16_t* Wm = (bf16_t*)lds;
    bf16_t* CM = Wm + 2 * 64 * SS_LT;
    bf16_t* BM = CM + 64 * SS_LT;
    bf16_t* Xn = BM + 64 * SS_LT;
    bf16_t* XT = Xn + 64 * SS_LX;
    bf16_t* BTE = XT + 2 * 64 * SS_LT;
    bf16_t* Sb = BTE + 2 * 64 * SS_LT;
    float* fs = (float*)(Sb + 2 * 64 * SS_LT);
    float* s_b = fs;
    float* s_dt = fs + 128;
    float* s_e = fs + 256;
    float* s_misc = fs + 384;
    const bf16_t* P = WSP(const bf16_t, WS_BIG + L0_P); const bf16_t* XC = WSP(const bf16_t, WS_BIG + L0_XC);
    bf16_t* YOUT = WSP(bf16_t, WS_BIG + (dir ? L0_YB : L0_AO + 2048)); const int ldy = dir ? 1024 : 2048;
    for (int i = tid; i < 2 * 64 * SS_LT; i += 512) Sb[i] = 0;
    f32x4 Sacc[4];
#pragma unroll
    for (int i = 0; i < 4; ++i) Sacc[i] = (f32x4){0.f, 0.f, 0.f, 0.f};
    const float dtb = KIN(14)[dir * 16 + hh0 + ((tid >> 6) & 1)], aexp = __expf(KIN(15)[dir * 16 + hh0 + ((tid >> 6) & 1)]);
    const float dskip = KIN(16)[hh0 + (tid >> 8)];
    u32x4 pr[4]; bf16_t pdt = 0;
#define SS_REQ(ci_) do { _Pragma("unroll") for (int q = 0; q < 4; ++q) { const int p = tid + q * 512, j = p >> 5, c8 = p & 31; \
            const int col = c8 < 16 ? hh0 * 64 + c8 * 8 : (c8 < 24 ? 1024 + gi * 64 + (c8 - 16) * 8 : 1152 + gi * 64 + (c8 - 24) * 8); \
            pr[q] = *(const u32x4*)(XC + ((size_t)bl * TT + scan_t<64>(dir, (ci_), j)) * 1280 + col); } \
        if (tid < 128) pdt = P[((size_t)bl * TT + scan_t<64>(dir, (ci_), tid & 63)) * AB_N + AB_DT + dir * 16 + hh0 + (tid >> 6)]; } while (0)
    SS_REQ(0);
    lds_barrier();
    for (int ci = 0; ci < TT / 64; ++ci) {
        int tq = tid; asm volatile("" : "+v"(tq));
        const int lane = tq & 63, wid = __builtin_amdgcn_readfirstlane(tq >> 6), fr = lane & 15, fq = lane >> 4, hl_w = wid >> 2;
#pragma unroll
        for (int q = 0; q < 4; ++q) { const int p = tq + q * 512, j = p >> 5, c8 = p & 31;
            bf16_t* dst = c8 < 16 ? Xn + j * SS_LX + c8 * 8 : (c8 < 24 ? BM + j * SS_LT + (c8 - 16) * 8 : CM + j * SS_LT + (c8 - 24) * 8);
            *(u32x4*)dst = pr[q]; }
        if (wid < 2) {
            const float dt = softplusf_(bf2f(pdt) + dtb);
            float b = -dt * aexp;
#pragma unroll
            for (int o = 1; o < 64; o <<= 1) { const float t = __shfl_up(b, o); if (lane >= o) b += t; }
            const float b63 = __shfl(b, 63);
            s_b[wid * 64 + lane] = b; s_dt[wid * 64 + lane] = dt; s_e[wid * 64 + lane] = __expf(b63 - b) * dt;
            if (lane == 0) s_misc[wid] = __expf(b63);
        }
        if (ci + 1 < TT / 64) SS_REQ(ci + 1);
        lds_barrier();
        {
            const int jt = wid >> 1;
#pragma unroll
            for (int q2 = 0; q2 < 2; ++q2) {
                const int st = (wid & 1) * 2 + q2;
                f32x4 acc = (f32x4){0.f, 0.f, 0.f, 0.f};
                if (st <= jt) {
                    const bf16x8 c0 = ldfrag(CM, SS_LT, jt * 16, 0, fr, fq), c1 = ldfrag(CM, SS_LT, jt * 16, 32, fr, fq), b0 = ldfrag(BM, SS_LT, st * 16, 0, fr, fq), b1 = ldfrag(BM, SS_LT, st * 16, 32, fr, fq);
                    __builtin_amdgcn_sched_barrier(0);
                    acc = mma16(c0, b0, acc); acc = mma16(c1, b1, acc);
                }
                const int s = st * 16 + fr;
#pragma unroll
                for (int hl = 0; hl < 2; ++hl) { const float bs = s_b[hl * 64 + s], ds = s_dt[hl * 64 + s];
#pragma unroll
                    for (int r = 0; r < 4; ++r) { const int j = jt * 16 + fq * 4 + r;
                        const float wv = (s <= j) ? acc[r] * __expf(s_b[hl * 64 + j] - bs) * ds : 0.f;
                        Wm[(hl * 64 + j) * SS_LT + s] = f2bf(wv); } }
            }
            {
                const int s = lane, n8 = wid;
                const u32x4 bv = *(const u32x4*)(BM + s * SS_LT + n8 * 8);
#pragma unroll
                for (int hl = 0; hl < 2; ++hl) { const float e = s_e[hl * 64 + s];
                    bf16_t* bt = BTE + (hl * 64 + n8 * 8) * SS_LT + s;
                    bt[0 * SS_LT] = f2bf(lo2f(bv.x) * e); bt[1 * SS_LT] = f2bf(hi2f(bv.x) * e); bt[2 * SS_LT] = f2bf(lo2f(bv.y) * e); bt[3 * SS_LT] = f2bf(hi2f(bv.y) * e);
                    bt[4 * SS_LT] = f2bf(lo2f(bv.z) * e); bt[5 * SS_LT] = f2bf(hi2f(bv.z) * e); bt[6 * SS_LT] = f2bf(lo2f(bv.w) * e); bt[7 * SS_LT] = f2bf(hi2f(bv.w) * e); }
#pragma unroll
                for (int i = 0; i < 2; ++i) { const int c8 = wid + i * 8;
                    const u32x4 xv = *(const u32x4*)(Xn + s * SS_LX + c8 * 8);
                    bf16_t* xt = XT + (c8 * 8) * SS_LT + s;
                    xt[0 * SS_LT] = (bf16_t)(xv.x & 0xffff); xt[1 * SS_LT] = (bf16_t)(xv.x >> 16); xt[2 * SS_LT] = (bf16_t)(xv.y & 0xffff); xt[3 * SS_LT] = (bf16_t)(xv.y >> 16);
                    xt[4 * SS_LT] = (bf16_t)(xv.z & 0xffff); xt[5 * SS_LT] = (bf16_t)(xv.z >> 16); xt[6 * SS_LT] = (bf16_t)(xv.w & 0xffff); xt[7 * SS_LT] = (bf16_t)(xv.w >> 16); }
            }
        }
        lds_barrier();
        {
            const int hl = hl_w, jt = wid & 3, j = jt * 16 + fr;
            const bf16_t* Wh = Wm + hl * 64 * SS_LT; const bf16_t* Xh = XT + hl * 64 * SS_LT; const bf16_t* Sh = Sb + hl * 64 * SS_LT;
            const float eb = __expf(s_b[hl * 64 + j]);
            const size_t row = (size_t)bl * TT + scan_t<64>(dir, ci, j);
            const bf16x8 w0 = ldfrag(Wh, SS_LT, jt * 16, 0, fr, fq), w1 = ldfrag(Wh, SS_LT, jt * 16, 32, fr, fq), m0 = ldfrag(CM, SS_LT, jt * 16, 0, fr, fq), m1 = ldfrag(CM, SS_LT, jt * 16, 32, fr, fq);
#pragma unroll
            for (int hh = 0; hh < 2; ++hh) {
                bf16x8 fx[2][2], fs2[2][2];
#pragma unroll
                for (int q = 0; q < 2; ++q)
#pragma unroll
                    for (int k = 0; k < 2; ++k) { fx[q][k] = ldfrag(Xh, SS_LT, (hh * 2 + q) * 16, k * 32, fr, fq); fs2[q][k] = ldfrag(Sh, SS_LT, (hh * 2 + q) * 16, k * 32, fr, fq); }
                f32x4 dx[2];
                if (!dir) { dx[0] = ld4bf(Xn + j * SS_LX + hl * 64 + (hh * 2) * 16 + fq * 4); dx[1] = ld4bf(Xn + j * SS_LX + hl * 64 + (hh * 2 + 1) * 16 + fq * 4); }
                __builtin_amdgcn_sched_barrier(0);
                f32x4 y1[2], y2[2];
#pragma unroll
                for (int q = 0; q < 2; ++q) { y1[q] = (f32x4){0.f, 0.f, 0.f, 0.f}; y2[q] = (f32x4){0.f, 0.f, 0.f, 0.f}; }
#pragma unroll
                for (int q = 0; q < 2; ++q) { y1[q] = mma16(fx[q][0], w0, y1[q]); y2[q] = mma16(fs2[q][0], m0, y2[q]); }
#pragma unroll
                for (int q = 0; q < 2; ++q) { y1[q] = mma16(fx[q][1], w1, y1[q]); y2[q] = mma16(fs2[q][1], m1, y2[q]); }
#pragma unroll
                for (int q = 0; q < 2; ++q) { f32x4 y = y1[q] + y2[q] * eb;
                    if (!dir) y = y + dx[q] * dskip;
                    st4bf(YOUT + row * ldy + (hh0 + hl) * 64 + (hh * 2 + q) * 16 + fq * 4, y); }
            }
        }
        lds_barrier();
        {
            const int hl = hl_w, pt = wid & 3; const float eb63 = s_misc[hl];
            const bf16_t* Xh = XT + hl * 64 * SS_LT; const bf16_t* Bh = BTE + hl * 64 * SS_LT; bf16_t* Sh = Sb + hl * 64 * SS_LT;
            const bf16x8 x0 = ldfrag(Xh, SS_LT, pt * 16, 0, fr, fq), x1 = ldfrag(Xh, SS_LT, pt * 16, 32, fr, fq);
            bf16x8 fb[4][2];
#pragma unroll
            for (int nt = 0; nt < 4; ++nt) { fb[nt][0] = ldfrag(Bh, SS_LT, nt * 16, 0, fr, fq); fb[nt][1] = ldfrag(Bh, SS_LT, nt * 16, 32, fr, fq); }
            __builtin_amdgcn_sched_barrier(0);
#pragma unroll
            for (int nt = 0; nt < 4; ++nt) Sacc[nt] = Sacc[nt] * eb63;
#pragma unroll
            for (int nt = 0; nt < 4; ++nt) Sacc[nt] = mma16(fb[nt][0], x0, Sacc[nt]);
#pragma unroll
            for (int nt = 0; nt < 4; ++nt) Sacc[nt] = mma16(fb[nt][1], x1, Sacc[nt]);
#pragma unroll
            for (int nt = 0; nt < 4; ++nt) st4bf(Sh + (pt * 16 + fr) * SS_LT + nt * 16 + fq * 4, Sacc[nt]);
        }
        lds_barrier();
    }
#undef SS_REQ
}

__device__ __forceinline__ void phase_scan_ab(const KP& kp, unsigned char* lds) {
    for (int rep = 0; rep < ((PROBE_DUP & 8192) ? 2 : 1); ++rep)
    for (int u = obid(); u < 256; u += gridDim.x) if (u < 128) { mlstm_unit(kp, lds, u >> 4, (u >> 2) & 3, (u >> 1) & 1, u & 1); __syncthreads(); }
    for (int rep = 0; rep < ((PROBE_DUP & 16384) ? 2 : 1); ++rep)
    for (int u = obid(); u < 256; u += gridDim.x) if (u >= 128) { const int v = u - 128; ssd_unit(kp, lds, v >> 4, (v >> 3) & 1, v & 7); __syncthreads(); }
}

PHASE_FN void phase_fin_ab(const KP& kp) {
    const int lane = otid() & 63, wid = __builtin_amdgcn_readfirstlane(otid() >> 6);
    const bf16_t* P = WSP(const bf16_t, WS_BIG + L0_P);
    bf16_t* AO = WSP(bf16_t, WS_BIG + L0_AO); const bf16_t* HB = WSP(const bf16_t, WS_BIG + L0_HB); const bf16_t* YB = WSP(const bf16_t, WS_BIG + L0_YB);
    const float* mln = KIN(11); const float* sn = KIN(17);
    for (int lr = obid() * 8 + wid; lr < RG; lr += gridDim.x * 8) {
        const bf16_t* pr = P + (size_t)lr * AB_N;
        f32x4 yz[4]; float ss2 = 0.f;
#pragma unroll
        for (int i = 0; i < 4; ++i) { const int col = i * 256 + lane * 4;
            const f32x4 hs = ld4bf(AO + (size_t)lr * 2048 + col) + ld4bf(HB + (size_t)lr * 1024 + col);
            float ss = hs[0] * hs[0] + hs[1] * hs[1] + hs[2] * hs[2] + hs[3] * hs[3];
            ss = wsum(ss); const float rstd = rsqrtf(ss * (1.0f / 256.0f) + EPS);
            const f32x4 og = ld4bf(pr + AB_OG + col), w = *(const f32x4*)(mln + col);
            f32x4 o;
#pragma unroll
            for (int r = 0; r < 4; ++r) o[r] = hs[r] * rstd * w[r] * sigmoidf_(og[r]);
            st4bf(AO + (size_t)lr * 2048 + col, o);
            const f32x4 ys = ld4bf(AO + (size_t)lr * 2048 + 1024 + col) + ld4bf(YB + (size_t)lr * 1024 + col), z = ld4bf(pr + AB_Z + col);
#pragma unroll
            for (int r = 0; r < 4; ++r) { yz[i][r] = ys[r] * siluf_(z[r]); ss2 += yz[i][r] * yz[i][r]; }
        }
        ss2 = wsum(ss2); const float rstd2 = rsqrtf(ss2 * (1.0f / 1024.0f) + EPS);
#pragma unroll
        for (int i = 0; i < 4; ++i) { const int col = i * 256 + lane * 4; st4bf(AO + (size_t)lr * 2048 + 1024 + col, yz[i] * rstd2 * *(const f32x4*)(sn + col)); }
    }
}

PHASE_FN void phase_gemm_in(const KP& kp, unsigned char* lds, int layer, int grp) {
    const int npad = layer == 0 ? AB_NPAD : CD_NPAD, n = layer == 0 ? AB_N : CD_N;
    pg8::Gemm g{(layer == 0 && grp == 0) ? WSP(const bf16_t, WS_BIG + L0_U) : WSP(const bf16_t, WS_V) + (size_t)grp * RG * 1024, WSP(const bf16_t, WS_WMIX), RG, npad, 1024, nullptr, 0x7fffffff};
    pg8::StaticOrder S; S.init(RG, npad, (int)gridDim.x, obid());
    pg8::EpiBfG E{WSP(bf16_t, WS_BIG), n, n, 0x7fffffff};
    pg8::gemm_phase<pg8::EpiBfG, pg8::StaticOrder, false>((PG8_LAS unsigned char*)lds, g, S, E, nullptr);
    __syncthreads();
}
PHASE_FN void phase_gemm_out_ab(const KP& kp, unsigned char* lds, int grp) {
    pg8::Gemm g{WSP(const bf16_t, WS_BIG + L0_AO), WSP(const bf16_t, WS_WMIX + WM_AB_OUT), RG, 1024, 2048, nullptr, 0x7fffffff};
    pg8::StaticOrder S; S.init(RG, 1024, (int)gridDim.x, obid());
    pg8::EpiBfG E{WSP(bf16_t, WS_BIG + L0_U), 1024, 1024, 0x7fffffff};
    pg8::gemm_phase<pg8::EpiBfG, pg8::StaticOrder, false>((PG8_LAS unsigned char*)lds, g, S, E, nullptr);
    __syncthreads();
    const int G = (int)gridDim.x, units = (RG / 256) * 4, two = units > G ? (units - G < G ? units - G : G) : 0;
    const int nb = G - two > 0 ? G - two : G, bid = G - two > 0 ? obid() - two : obid();
    if (bid >= 0) { if (grp == 0) phase_u(kp, 0, 1, bid, nb, true); else phase_conv_moe(kp, lds, 0, bid, nb); }
    __syncthreads();
}

PHASE_FN void phase_prep_cd(const KP& kp) {
    const int lane = otid() & 63, wid = __builtin_amdgcn_readfirstlane(otid() >> 6);
    bf16_t* P = WSP(bf16_t, WS_BIG + L1_P);
    bf16_t* SG = WSP(bf16_t, WS_SG);
    const float* qn = KIN(20); const float* kvn = KIN(22); const float* mu = KIN(24);
    for (int lr = obid() * 8 + wid; lr < RG; lr += gridDim.x * 8) {
        const int bl = lr / TT, t = lr - bl * TT;
        bf16_t* pr = P + (size_t)lr * CD_N;
        {
            const f32x4 x = ld4bf(pr + CD_M1 + lane * 4);
            float ss = x[0] * x[0] + x[1] * x[1] + x[2] * x[2] + x[3] * x[3]; ss = wsum(ss);
            const float rstd = rsqrtf(ss * (1.0f / 256.0f) + EPS);
            st4bf(pr + CD_M1 + lane * 4, x * rstd * *(const f32x4*)(kvn + lane * 4));
        }
        {
            const int lo = t < CTXL ? 0 : CTXL, hi = t < CTXL ? CTXL : TT, c = lane * 4;
            const f32x4 x = ld4bf(pr + CD_WL + c);
            const f32x4 xp = t > lo ? ld4bf(pr - CD_N + CD_WL + c) : (f32x4){0.f, 0.f, 0.f, 0.f};
            const f32x4 xn = t < hi - 1 ? ld4bf(pr + CD_N + CD_WL + c) : (f32x4){0.f, 0.f, 0.f, 0.f};
            f32x4 l = x + *(const f32x4*)(mu + CD_WL - CD_RW0 + c) * ((xp + xn) * 0.5f - x);
            if (c < 128) {
#pragma unroll
                for (int q = 0; q < 4; ++q) l[q] = tanhf_(l[q]); }
            st4bf(WSP(bf16_t, WS_BIG + L1_TWAL) + (size_t)lr * 256 + c, l);
        }
        if (t >= CTXL) {
            const int s = t - CTXL;
            float x0[3], x1[3]; float ss = 0.f;
#pragma unroll
            for (int i = 0; i < 3; ++i) { const unsigned w = *(const unsigned*)(pr + CD_M0 + i * 128 + lane * 2); x0[i] = lo2f(w); x1[i] = hi2f(w); ss += x0[i] * x0[i] + x1[i] * x1[i]; }
            ss = wsum(ss); const float rstd = rsqrtf(ss * (1.0f / 384.0f) + EPS);
#pragma unroll
            for (int i = 0; i < 3; ++i) { const int c = i * 128 + lane * 2; *(unsigned*)(pr + CD_M0 + c) = pack2(x0[i] * rstd * qn[c], x1[i] * rstd * qn[c + 1]); }
            if (lane < 16) {
                const float pos = (lane < 8) ? (float)(s >> 6) : (float)(s & 63);
                const float inv = __expf(-(float)(lane & 7) * (9.210340371976184f / 8.0f));
                float sn, cs; sincosf(pos * inv, &sn, &cs);
                const float a = bf2f(pr[CD_KR + lane]), b2 = bf2f(pr[CD_KR + 16 + lane]);
                pr[CD_KR + lane] = f2bf(a * cs - b2 * sn); pr[CD_KR + 16 + lane] = f2bf(a * sn + b2 * cs);
            }
            {
                const int c = lane * 2;
                const unsigned w = *(const unsigned*)(pr + CD_GL + c);
                const unsigned wp = s > 0 ? *(const unsigned*)(pr - CD_N + CD_GL + c) : 0u;
                const unsigned wn = s < SEQ - 1 ? *(const unsigned*)(pr + CD_N + CD_GL + c) : 0u;
                const float m0 = mu[CD_GL - CD_RW0 + c], m1 = mu[CD_GL - CD_RW0 + c + 1];
                const float g0 = lo2f(w) + m0 * (0.5f * (lo2f(wp) + lo2f(wn)) - lo2f(w));
                const float g1 = hi2f(w) + m1 * (0.5f * (hi2f(wp) + hi2f(wn)) - hi2f(w));
                *(unsigned*)(SG + ((size_t)bl * SEQ + s) * 128 + c) = pack2(sigmoidf_(g0), sigmoidf_(g1));
            }
        }
    }
}

PHASE_FN void phase_upproj(const KP& kp, unsigned char* lds) {
    const bf16_t* P = WSP(const bf16_t, WS_BIG + L1_P);
    {
        pg8::Gemm g{P + CD_M0, WSP(const bf16_t, WS_WMIX + WM_UQ), RGL, 768, 384, nullptr, 0x7fffffff, CD_N, 1};
        pg8::StaticOrder S; S.init(RGL, 768, (int)gridDim.x, obid());
        pg8::EpiBfG E{WSP(bf16_t, WS_BIG + L1_Q), 768, 768, 0x7fffffff};
        pg8::gemm_phase<pg8::EpiBfG, pg8::StaticOrder, false>((PG8_LAS unsigned char*)lds, g, S, E, nullptr);
    }
    __syncthreads();
    {
        pg8::Gemm g{P + CD_M1, WSP(const bf16_t, WS_WMIX + WM_UKV), RG, 1024, 256, nullptr, 0x7fffffff, CD_N, 0};
        pg8::StaticOrder S; S.init(RG, 1024, (int)gridDim.x, obid());
        pg8::EpiBfG E{WSP(bf16_t, WS_BIG + L1_KV), 1024, 1024, 0x7fffffff};
        pg8::gemm_phase<pg8::EpiBfG, pg8::StaticOrder, false>((PG8_LAS unsigned char*)lds, g, S, E, nullptr);
    }
    __syncthreads();
}

constexpr int AT_LQ = 104, AT_LV = 72;
PHASE_FN void attn_unit(const KP& kp, unsigned char* lds, int bl, int head, int qb) {
    const int tid = otid(), lane = tid & 63, wid = __builtin_amdgcn_readfirstlane(tid >> 6), fr = lane & 15, fq = lane >> 4;
    bf16_t* Qs = (bf16_t*)lds;
    bf16_t* Kt = Qs + 256 * AT_LQ;
    bf16_t* Vt = Kt + 2 * 64 * AT_LQ;
    const bf16_t* P = WSP(const bf16_t, WS_BIG + L1_P);
    const bf16_t* Q = WSP(const bf16_t, WS_BIG + L1_Q);
    const bf16_t* KV = WSP(const bf16_t, WS_BIG + L1_KV);
    bf16_t* AOUT = WSP(bf16_t, WS_BIG + L1_AOUT);
    const float SC = 0.10206207261596577f;
#pragma unroll
    for (int i = 0; i < 6; ++i) { const int p = tid + i * 512, r = p / 12, c = p % 12;
        *(u32x4*)(Qs + r * AT_LQ + c * 8) = *(const u32x4*)(Q + ((size_t)bl * SEQ + qb * 256 + r) * 768 + head * 96 + c * 8); }
    lds_barrier();
#pragma unroll
    for (int i = 0; i < 8; ++i) { const int p = tid + i * 512, r = p >> 4, f = p & 15, s = qb * 256 + r;
        const float pos = (f < 8) ? (float)(s >> 6) : (float)(s & 63);
        const float inv = __expf(-(float)(f & 7) * (9.210340371976184f / 8.0f));
        float sn, cs; sincosf(pos * inv, &sn, &cs);
        const float a = bf2f(Qs[r * AT_LQ + 64 + f]), b2 = bf2f(Qs[r * AT_LQ + 80 + f]);
        Qs[r * AT_LQ + 64 + f] = f2bf(a * cs - b2 * sn); Qs[r * AT_LQ + 80 + f] = f2bf(a * sn + b2 * cs); }
    lds_barrier();
    bf16x8 qf[2][3];
#pragma unroll
    for (int rt = 0; rt < 2; ++rt)
#pragma unroll
        for (int k = 0; k < 3; ++k) qf[rt][k] = ldfrag(Qs, AT_LQ, wid * 32 + rt * 16, k * 32, fr, fq);
    f32x4 ot[2][4];
#pragma unroll
    for (int rt = 0; rt < 2; ++rt)
#pragma unroll
        for (int i = 0; i < 4; ++i) ot[rt][i] = (f32x4){0.f, 0.f, 0.f, 0.f};
    float mrow[2] = {-1e30f, -1e30f}, lsum[2] = {0.f, 0.f};
    u32x4 pk0[2], pk1[2], pvv[2];
    const int kkey0 = tid / 12, kc0 = tid % 12, kkey1 = (tid + 512) / 12, kc1 = (tid + 512) % 12, vkey = tid & 63, vc8 = tid >> 6;
#define AT_REQ(kt_) do { _Pragma("unroll") for (int h_ = 0; h_ < 2; ++h_) { const size_t rb_ = (size_t)bl * TT + ((kt_) * 2 + h_) * 64; \
        pk0[h_] = kc0 < 8 ? *(const u32x4*)(KV + (rb_ + kkey0) * 1024 + head * 128 + kc0 * 8) : *(const u32x4*)(P + (rb_ + kkey0) * CD_N + CD_KR + (kc0 - 8) * 8); \
        if (tid < 256) pk1[h_] = kc1 < 8 ? *(const u32x4*)(KV + (rb_ + kkey1) * 1024 + head * 128 + kc1 * 8) : *(const u32x4*)(P + (rb_ + kkey1) * CD_N + CD_KR + (kc1 - 8) * 8); \
        pvv[h_] = *(const u32x4*)(KV + (rb_ + vkey) * 1024 + head * 128 + 64 + vc8 * 8); } } while (0)
    AT_REQ(0);
    const float SC2 = SC * 1.4426950408889634f;
    for (int kt = 0; kt < TT / 128; ++kt) {
        lds_barrier();
#pragma unroll
        for (int h_ = 0; h_ < 2; ++h_) {
            *(u32x4*)(Kt + (h_ * 64 + kkey0) * AT_LQ + kc0 * 8) = pk0[h_];
            if (tid < 256) *(u32x4*)(Kt + (h_ * 64 + kkey1) * AT_LQ + kc1 * 8) = pk1[h_];
            { bf16_t* vt = Vt + (h_ * 64 + vc8 * 8) * AT_LV + vkey; const u32x4 v = pvv[h_];
                vt[0 * AT_LV] = (bf16_t)(v.x & 0xffff); vt[1 * AT_LV] = (bf16_t)(v.x >> 16); vt[2 * AT_LV] = (bf16_t)(v.y & 0xffff); vt[3 * AT_LV] = (bf16_t)(v.y >> 16);
                vt[4 * AT_LV] = (bf16_t)(v.z & 0xffff); vt[5 * AT_LV] = (bf16_t)(v.z >> 16); vt[6 * AT_LV] = (bf16_t)(v.w & 0xffff); vt[7 * AT_LV] = (bf16_t)(v.w >> 16); }
        }
        if (kt + 1 < TT / 128) AT_REQ(kt + 1);
        lds_barrier();
#pragma unroll 1
        for (int hs = 0; hs < 2; ++hs) {
        const bf16_t* Kth = Kt + hs * 64 * AT_LQ; const bf16_t* Vth = Vt + hs * 64 * AT_LV;
        bf16x8 kf[3][4];
#pragma unroll
        for (int k = 0; k < 3; ++k)
#pragma unroll
            for (int kk = 0; kk < 4; ++kk) kf[k][kk] = ldfrag(Kth, AT_LQ, kk * 16, k * 32, fr, fq);
        u32x2 vlo[2][4], vhi[2][4];
#pragma unroll
        for (int k2 = 0; k2 < 2; ++k2)
#pragma unroll
            for (int dvt = 0; dvt < 4; ++dvt) { const bf16_t* vp = Vth + (dvt * 16 + fr) * AT_LV + k2 * 32 + fq * 4; vlo[k2][dvt] = *(const u32x2*)vp; vhi[k2][dvt] = *(const u32x2*)(vp + 16); }
        __builtin_amdgcn_sched_barrier(0);
        f32x4 st[2][4];
#pragma unroll
        for (int rt = 0; rt < 2; ++rt)
#pragma unroll
            for (int kk = 0; kk < 4; ++kk) st[rt][kk] = (f32x4){0.f, 0.f, 0.f, 0.f};
#pragma unroll
        for (int k = 0; k < 3; ++k)
#pragma unroll
            for (int kk = 0; kk < 4; ++kk)
#pragma unroll
                for (int rt = 0; rt < 2; ++rt) st[rt][kk] = mma16(kf[k][kk], qf[rt][k], st[rt][kk]);
        union { bf16x8 v; unsigned u[4]; } pb[2][2];
#pragma unroll
        for (int rt = 0; rt < 2; ++rt) {
            float mx = -1e30f;
#pragma unroll
            for (int kk = 0; kk < 4; ++kk) mx = fmaxf(mx, fmaxf(fmaxf(st[rt][kk][0], st[rt][kk][1]), fmaxf(st[rt][kk][2], st[rt][kk][3])));
            mx = fmaxf(mx, __shfl_xor(mx, 16)); mx = fmaxf(mx, __shfl_xor(mx, 32));
            const float mnew = fmaxf(mrow[rt], mx), mb = mnew * SC2;
            if (__builtin_amdgcn_ballot_w64(mnew > mrow[rt]) != 0ull) {
                const float alpha = __builtin_amdgcn_exp2f((mrow[rt] - mnew) * SC2);
                lsum[rt] *= alpha;
#pragma unroll
                for (int i = 0; i < 4; ++i) ot[rt][i] = ot[rt][i] * alpha;
            }
            mrow[rt] = mnew;
#pragma unroll
            for (int kk = 0; kk < 4; ++kk)
#pragma unroll
                for (int r = 0; r < 4; ++r) { const float pv = __builtin_amdgcn_exp2f(st[rt][kk][r] * SC2 - mb); st[rt][kk][r] = pv; lsum[rt] += pv; }
#pragma unroll
            for (int k2 = 0; k2 < 2; ++k2) {
                pb[rt][k2].u[0] = pack2(st[rt][2 * k2][0], st[rt][2 * k2][1]); pb[rt][k2].u[1] = pack2(st[rt][2 * k2][2], st[rt][2 * k2][3]);
                pb[rt][k2].u[2] = pack2(st[rt][2 * k2 + 1][0], st[rt][2 * k2 + 1][1]); pb[rt][k2].u[3] = pack2(st[rt][2 * k2 + 1][2], st[rt][2 * k2 + 1][3]); }
        }
#pragma unroll
        for (int k2 = 0; k2 < 2; ++k2)
#pragma unroll
            for (int dvt = 0; dvt < 4; ++dvt) { union { bf16x8 v; u32x2 h[2]; } va; va.h[0] = vlo[k2][dvt]; va.h[1] = vhi[k2][dvt];
#pragma unroll
                for (int rt = 0; rt < 2; ++rt) ot[rt][dvt] = mma16(va.v, pb[rt][k2].v, ot[rt][dvt]); }
        }
    }
#undef AT_REQ
#pragma unroll
    for (int rt = 0; rt < 2; ++rt) {
        float ls = lsum[rt]; ls += __shfl_xor(ls, 16); ls += __shfl_xor(ls, 32);
        const float rl = frcp_(ls);
        const size_t orow = (size_t)bl * SEQ + qb * 256 + wid * 32 + rt * 16 + fr;
#pragma unroll
        for (int dvt = 0; dvt < 4; ++dvt) st4bf(AOUT + orow * 1536 + head * 64 + dvt * 16 + fq * 4, ot[rt][dvt] * rl);
    }
}

constexpr int RW_LR = 200, RW_LP = 72;
PHASE_FN void rwkv_unit(const KP& kp, unsigned char* lds, int bl, int h, int dir) {
    const int tid = otid();
    bf16_t* RAW = (bf16_t*)lds;
    bf16_t* TWb = RAW + 34 * RW_LR;
    bf16_t* ALb = TWb + 32 * RW_LP;
    bf16_t* W2T = ALb + 32 * RW_LP;
    bf16_t* A2T = W2T + 64 * RW_LP;
    float* CL = (float*)(A2T + 64 * RW_LP);
    bf16_t* AR = (bf16_t*)(CL + 32 * 64);
    bf16_t* BK = AR + 64 * RW_LP;
    float* AABT = (float*)(BK + 64 * RW_LP);
    bf16_t* ARB = (bf16_t*)(AABT + 32 * 36);
    bf16_t* AAK = ARB + 32 * 40;
    bf16_t* ARK = AAK + 32 * 40;
    float* RHS = (float*)(ARK + 32 * 40);
    float* YB = RHS + 32 * 64;
    bf16_t* ZVT = (bf16_t*)(YB + 32 * 64);
    bf16_t* BKh = ZVT + 64 * RW_LP;
    bf16_t* Sb = BKh + 64 * RW_LP;
    float* PL = (float*)(Sb + 64 * RW_LP);
    const bf16_t* P = WSP(const bf16_t, WS_BIG + L1_P); const bf16_t* TWAL = WSP(const bf16_t, WS_BIG + L1_TWAL);
    bf16_t* OUT = WSP(bf16_t, WS_BIG + (dir ? L1_OB : L1_OF));
    float* BSC = WSP(float, WS_BSC) + (size_t)dir * RGL * 16;
    const float* mu = KIN(24);
    for (int i = tid; i < 64 * 64; i += 512) { const int c = i >> 6, n = i & 63;
        W2T[n * RW_LP + c] = f2bf(KIN(26)[((size_t)dir * 64 + c) * 1024 + h * 64 + n]); A2T[n * RW_LP + c] = f2bf(KIN(28)[((size_t)dir * 64 + c) * 1024 + h * 64 + n]); }
    for (int i = tid; i < 64 * RW_LP; i += 512) Sb[i] = 0;
    float* CV = PL + 64;
    bf16_t* A21b = (bf16_t*)(CV + 8 * 64);
    for (int i = tid; i < 16 * 40; i += 512) A21b[i] = 0;
    for (int i = tid; i < 64 * RW_LP; i += 512) ZVT[i] = 0;
    if (tid < 64) { const int n = tid;
        CV[0 * 64 + n] = KIN(25)[dir * 1024 + h * 64 + n]; CV[1 * 64 + n] = KIN(27)[dir * 1024 + h * 64 + n];
        CV[2 * 64 + n] = KIN(30)[h * 64 + n]; CV[3 * 64 + n] = KIN(31)[h * 64 + n]; CV[4 * 64 + n] = KIN(32)[h * 64 + n];
        CV[5 * 64 + n] = mu[h * 64 + n]; CV[6 * 64 + n] = mu[1024 + h * 64 + n]; CV[7 * 64 + n] = mu[2048 + h * 64 + n]; }
    f32x4 Sacc[2];
    Sacc[0] = (f32x4){0.f, 0.f, 0.f, 0.f}; Sacc[1] = (f32x4){0.f, 0.f, 0.f, 0.f};
    u32x4 pf[3];
#define RW_PREFETCH(cn, tix) do { const int t0n_ = dir ? scan_t<32>(1, (cn), 31) : (cn) * 32; const int lo_ = t0n_ < CTXL ? 0 : CTXL, hi_ = t0n_ < CTXL ? CTXL : TT; \
        _Pragma("unroll") for (int q = 0; q < 2; ++q) { const int p = (tix) + q * 512; pf[q] = (u32x4){0u, 0u, 0u, 0u}; \
            if (p < 34 * 24) { const int rr = p / 24, c = p % 24, t = t0n_ - 1 + rr; \
                if (t >= lo_ && t < hi_) { const int seg = c >> 3, c8 = c & 7; \
                    const int col = (seg == 0 ? CD_R : seg == 1 ? CD_K : CD_V) + h * 64; \
                    pf[q] = *(const u32x4*)(P + ((size_t)bl * TT + t) * CD_N + col + c8 * 8); } } } \
        { const int i_ = (tix) >> 4, c16 = (tix) & 15; \
          pf[2] = *(const u32x4*)(TWAL + ((size_t)bl * TT + t0n_ + i_) * 256 + (c16 >> 3) * 128 + dir * 64 + (c16 & 7) * 8); } } while (0)
    RW_PREFETCH(0, tid);
    lds_barrier();
    for (int ci = 0; ci < TT / 32; ++ci) {
        int tq = tid; asm volatile("" : "+v"(tq));
        const int lane = tq & 63, wid = __builtin_amdgcn_readfirstlane(tq >> 6), fr = lane & 15, fq = lane >> 4, pi = tq >> 4, n4 = (tq & 15) * 4;
        const int t0 = dir ? scan_t<32>(1, ci, 31) : ci * 32;
#pragma unroll
        for (int q = 0; q < 2; ++q) { const int p = tq + q * 512; if (p < 34 * 24) *(u32x4*)(RAW + (p / 24) * RW_LR + (p % 24) * 8) = pf[q]; }
        { const int i_ = tq >> 4, c16 = tq & 15; *(u32x4*)(((c16 >> 3) ? ALb : TWb) + i_ * RW_LP + (c16 & 7) * 8) = pf[2]; }
        if (ci + 1 < TT / 32) RW_PREFETCH(ci + 1, tq);
        lds_barrier();
        {
            const int which = wid >> 2, tt = (wid >> 1) & 1;
            const bf16_t* Xa = which ? ALb : TWb; const bf16_t* Wt = which ? A2T : W2T; float* Od = which ? YB : RHS;
#pragma unroll
            for (int q2 = 0; q2 < 2; ++q2) { const int nt = (wid & 1) * 2 + q2;
                f32x4 acc = (f32x4){0.f, 0.f, 0.f, 0.f};
#pragma unroll
                for (int k = 0; k < 2; ++k) acc = mma16(ldfrag(Xa, RW_LP, tt * 16, k * 32, fr, fq), ldfrag(Wt, RW_LP, nt * 16, k * 32, fr, fq), acc);
#pragma unroll
                for (int rr = 0; rr < 4; ++rr) Od[(tt * 16 + fq * 4 + rr) * 64 + nt * 16 + fr] = acc[rr]; }
        }
        lds_barrier();
        const int j = dir ? 31 - pi : pi;
        f32x4 r, kd, v, av, bv;
        {
            const f32x4 w0v = *(const f32x4*)(CV + n4), a0v = *(const f32x4*)(CV + 64 + n4), kkw = *(const f32x4*)(CV + 128 + n4), kaw = *(const f32x4*)(CV + 192 + n4), rkw = *(const f32x4*)(CV + 256 + n4);
            const f32x4 mur = *(const f32x4*)(CV + 320 + n4), muk = *(const f32x4*)(CV + 384 + n4), muv = *(const f32x4*)(CV + 448 + n4);
            const f32x4 wl = w0v + *(const f32x4*)(RHS + pi * 64 + n4), al = a0v + *(const f32x4*)(YB + pi * 64 + n4);
            const bf16_t* r1 = RAW + (pi + 1) * RW_LR; const bf16_t* rp = RAW + pi * RW_LR; const bf16_t* rn = RAW + (pi + 2) * RW_LR;
            f32x4 k;
            r = ld4bf(r1 + n4); k = ld4bf(r1 + 64 + n4); v = ld4bf(r1 + 128 + n4);
            r = r + mur * ((ld4bf(rp + n4) + ld4bf(rn + n4)) * 0.5f - r);
            k = k + muk * ((ld4bf(rp + 64 + n4) + ld4bf(rn + 64 + n4)) * 0.5f - k);
            v = v + muv * ((ld4bf(rp + 128 + n4) + ld4bf(rn + 128 + n4)) * 0.5f - v);
            f32x4 a, lw, kk = k * kkw;
            float ssq = kk[0] * kk[0] + kk[1] * kk[1] + kk[2] * kk[2] + kk[3] * kk[3];
            ssq += __shfl_xor(ssq, 1); ssq += __shfl_xor(ssq, 2); ssq += __shfl_xor(ssq, 4); ssq += __shfl_xor(ssq, 8);
            kk = kk * __builtin_amdgcn_rsqf(fmaxf(ssq, 1e-24f));
#pragma unroll
            for (int q = 0; q < 4; ++q) { const float wlog = -softplusf_(-wl[q]) - 0.5f; lw[q] = -__expf(wlog); a[q] = sigmoidf_(al[q]); }
            kd = k * ((a - 1.0f) * kaw + 1.0f);
            float bs = r[0] * kd[0] * rkw[0] + r[1] * kd[1] * rkw[1] + r[2] * kd[2] * rkw[2] + r[3] * kd[3] * rkw[3];
            bs += __shfl_xor(bs, 1); bs += __shfl_xor(bs, 2); bs += __shfl_xor(bs, 4); bs += __shfl_xor(bs, 8);
            av = kk * -1.0f; bv = kk * a;
            *(f32x4*)(CL + j * 64 + n4) = lw;
            const int t = t0 + pi;
            if (t >= CTXL && (tq & 15) == 0) BSC[((size_t)bl * SEQ + (t - CTXL)) * 16 + h] = bs;
        }
        lds_barrier();
        if (wid == 0) {
            float c[32];
#pragma unroll
            for (int q = 0; q < 32; ++q) c[q] = CL[q * 64 + lane];
#pragma unroll
            for (int q = 1; q < 32; ++q) c[q] += c[q - 1];
#pragma unroll
            for (int q = 0; q < 32; ++q) CL[q * 64 + lane] = c[q];
            PL[lane] = __expf(c[31]);
        }
        lds_barrier();
        {
            const f32x4 clj = *(const f32x4*)(CL + j * 64 + n4), cle = *(const f32x4*)(CL + 31 * 64 + n4);
            f32x4 clp = (f32x4){0.f, 0.f, 0.f, 0.f};
            if (j > 0) clp = *(const f32x4*)(CL + (j - 1) * 64 + n4);
            f32x4 at, rt, bt, kt, bh, kh;
#pragma unroll
            for (int q = 0; q < 4; ++q) { const float ep = __expf(clp[q]), ej = __expf(clj[q]), ei = __expf(-clj[q]), ee = __expf(cle[q] - clj[q]);
                at[q] = av[q] * ep; rt[q] = r[q] * ej; bt[q] = bv[q] * ei; kt[q] = kd[q] * ei; bh[q] = bv[q] * ee; kh[q] = kd[q] * ee; }
            st4bf(AR + j * RW_LP + n4, at); st4bf(AR + (32 + j) * RW_LP + n4, rt);
            st4bf(BK + j * RW_LP + n4, bt); st4bf(BK + (32 + j) * RW_LP + n4, kt);
#pragma unroll
            for (int q = 0; q < 4; ++q) { BKh[(n4 + q) * RW_LP + j] = f2bf(bh[q]); BKh[(n4 + q) * RW_LP + 32 + j] = f2bf(kh[q]); ZVT[(n4 + q) * RW_LP + 32 + j] = f2bf(v[q]); }
        }
        lds_barrier();
        {
            const int ti = wid >> 1;
#pragma unroll
            for (int q2 = 0; q2 < 2; ++q2) {
                const int si = (wid & 1) * 2 + q2;
                f32x4 acc = (f32x4){0.f, 0.f, 0.f, 0.f};
#pragma unroll
                for (int k = 0; k < 2; ++k) acc = mma16(ldfrag(AR, RW_LP, ti * 16, k * 32, fr, fq), ldfrag(BK, RW_LP, si * 16, k * 32, fr, fq), acc);
                const int sp = si * 16 + fr, s = sp & 31;
#pragma unroll
                for (int rr = 0; rr < 4; ++rr) { const int tp = ti * 16 + fq * 4 + rr, t = tp & 31;
                    const bool incl = tp >= 32;
                    const float val = (incl ? (s <= t) : (s < t)) ? acc[rr] : 0.f;
                    if (sp < 32) { if (incl) ARB[t * 40 + s] = f2bf(val); else { AABT[s * 36 + t] = val; if (t >= 16 && s < 16) A21b[(t - 16) * 40 + s] = f2bf(val); } }
                    else { (incl ? ARK : AAK)[t * 40 + s] = f2bf(val); } }
            }
        }
        lds_barrier();
        {
            const int which = wid >> 2, tt = (wid >> 1) & 1;
            const bf16_t* Ak = which ? ARK : AAK; float* Od = which ? YB : RHS;
#pragma unroll
            for (int q2 = 0; q2 < 2; ++q2) {
                const int vt = (wid & 1) * 2 + q2;
                f32x4 acc = (f32x4){0.f, 0.f, 0.f, 0.f};
#pragma unroll
                for (int k = 0; k < 2; ++k) acc = mma16(ldfrag(AR, RW_LP, which * 32 + tt * 16, k * 32, fr, fq), ldfrag(Sb, RW_LP, vt * 16, k * 32, fr, fq), acc);
                acc = mma16(ldfrag(Ak, 40, tt * 16, 0, fr, fq), ldfrag(ZVT, RW_LP, vt * 16, 32, fr, fq), acc);
#pragma unroll
                for (int rr = 0; rr < 4; ++rr) Od[(tt * 16 + fq * 4 + rr) * 64 + vt * 16 + fr] = acc[rr];
            }
        }
        lds_barrier();
        {
            if (wid == 0) {
                float z[16]; f32x4 ca0, ca1, ca2, ca3, cb0, cb1, cb2, cb3;
#pragma unroll
                for (int t = 0; t < 16; ++t) z[t] = RHS[(0 + t) * 64 + lane];
                ca0 = *(const f32x4*)(AABT + 0 * 36 + 0); ca1 = *(const f32x4*)(AABT + 0 * 36 + 4); ca2 = *(const f32x4*)(AABT + 0 * 36 + 8); ca3 = *(const f32x4*)(AABT + 0 * 36 + 12);
                cb0 = *(const f32x4*)(AABT + 1 * 36 + 0); cb1 = *(const f32x4*)(AABT + 1 * 36 + 4); cb2 = *(const f32x4*)(AABT + 1 * 36 + 8); cb3 = *(const f32x4*)(AABT + 1 * 36 + 12);
                { const float zs = z[0]; z[1] = __builtin_fmaf(ca0[1], zs, z[1]); z[2] = __builtin_fmaf(ca0[2], zs, z[2]); z[3] = __builtin_fmaf(ca0[3], zs, z[3]); z[4] = __builtin_fmaf(ca1[0], zs, z[4]); z[5] = __builtin_fmaf(ca1[1], zs, z[5]); z[6] = __builtin_fmaf(ca1[2], zs, z[6]); z[7] = __builtin_fmaf(ca1[3], zs, z[7]); z[8] = __builtin_fmaf(ca2[0], zs, z[8]); z[9] = __builtin_fmaf(ca2[1], zs, z[9]); z[10] = __builtin_fmaf(ca2[2], zs, z[10]); z[11] = __builtin_fmaf(ca2[3], zs, z[11]); z[12] = __builtin_fmaf(ca3[0], zs, z[12]); z[13] = __builtin_fmaf(ca3[1], zs, z[13]); z[14] = __builtin_fmaf(ca3[2], zs, z[14]); z[15] = __builtin_fmaf(ca3[3], zs, z[15]); }
                asm volatile("" : "+v"(z[1]) :: "memory");
                ca0 = *(const f32x4*)(AABT + 2 * 36 + 0); ca1 = *(const f32x4*)(AABT + 2 * 36 + 4); ca2 = *(const f32x4*)(AABT + 2 * 36 + 8); ca3 = *(const f32x4*)(AABT + 2 * 36 + 12);
                { const float zs = z[1]; z[2] = __builtin_fmaf(cb0[2], zs, z[2]); z[3] = __builtin_fmaf(cb0[3], zs, z[3]); z[4] = __builtin_fmaf(cb1[0], zs, z[4]); z[5] = __builtin_fmaf(cb1[1], zs, z[5]); z[6] = __builtin_fmaf(cb1[2], zs, z[6]); z[7] = __builtin_fmaf(cb1[3], zs, z[7]); z[8] = __builtin_fmaf(cb2[0], zs, z[8]); z[9] = __builtin_fmaf(cb2[1], zs, z[9]); z[10] = __builtin_fmaf(cb2[2], zs, z[10]); z[11] = __builtin_fmaf(cb2[3], zs, z[11]); z[12] = __builtin_fmaf(cb3[0], zs, z[12]); z[13] = __builtin_fmaf(cb3[1], zs, z[13]); z[14] = __builtin_fmaf(cb3[2], zs, z[14]); z[15] = __builtin_fmaf(cb3[3], zs, z[15]); }
                asm volatile("" : "+v"(z[2]) :: "memory");
                cb1 = *(const f32x4*)(AABT + 3 * 36 + 4); cb2 = *(const f32x4*)(AABT + 3 * 36 + 8); cb3 = *(const f32x4*)(AABT + 3 * 36 + 12);
                { const float zs = z[2]; z[3] = __builtin_fmaf(ca0[3], zs, z[3]); z[4] = __builtin_fmaf(ca1[0], zs, z[4]); z[5] = __builtin_fmaf(ca1[1], zs, z[5]); z[6] = __builtin_fmaf(ca1[2], zs, z[6]); z[7] = __builtin_fmaf(ca1[3], zs, z[7]); z[8] = __builtin_fmaf(ca2[0], zs, z[8]); z[9] = __builtin_fmaf(ca2[1], zs, z[9]); z[10] = __builtin_fmaf(ca2[2], zs, z[10]); z[11] = __builtin_fmaf(ca2[3], zs, z[11]); z[12] = __builtin_fmaf(ca3[0], zs, z[12]); z[13] = __builtin_fmaf(ca3[1], zs, z[13]); z[14] = __builtin_fmaf(ca3[2], zs, z[14]); z[15] = __builtin_fmaf(ca3[3], zs, z[15]); }
                asm volatile("" : "+v"(z[3]) :: "memory");
                ca1 = *(const f32x4*)(AABT + 4 * 36 + 4); ca2 = *(const f32x4*)(AABT + 4 * 36 + 8); ca3 = *(const f32x4*)(AABT + 4 * 36 + 12);
                { const float zs = z[3]; z[4] = __builtin_fmaf(cb1[0], zs, z[4]); z[5] = __builtin_fmaf(cb1[1], zs, z[5]); z[6] = __builtin_fmaf(cb1[2], zs, z[6]); z[7] = __builtin_fmaf(cb1[3], zs, z[7]); z[8] = __builtin_fmaf(cb2[0], zs, z[8]); z[9] = __builtin_fmaf(cb2[1], zs, z[9]); z[10] = __builtin_fmaf(cb2[2], zs, z[10]); z[11] = __builtin_fmaf(cb2[3], zs, z[11]); z[12] = __builtin_fmaf(cb3[0], zs, z[12]); z[13] = __builtin_fmaf(cb3[1], zs, z[13]); z[14] = __builtin_fmaf(cb3[2], zs, z[14]); z[15] = __builtin_fmaf(cb3[3], zs, z[15]); }
                asm volatile("" : "+v"(z[4]) :: "memory");
                cb1 = *(const f32x4*)(AABT + 5 * 36 + 4); cb2 = *(const f32x4*)(AABT + 5 * 36 + 8); cb3 = *(const f32x4*)(AABT + 5 * 36 + 12);
                { const float zs = z[4]; z[5] = __builtin_fmaf(ca1[1], zs, z[5]); z[6] = __builtin_fmaf(ca1[2], zs, z[6]); z[7] = __builtin_fmaf(ca1[3], zs, z[7]); z[8] = __builtin_fmaf(ca2[0], zs, z[8]); z[9] = __builtin_fmaf(ca2[1], zs, z[9]); z[10] = __builtin_fmaf(ca2[2], zs, z[10]); z[11] = __builtin_fmaf(ca2[3], zs, z[11]); z[12] = __builtin_fmaf(ca3[0], zs, z[12]); z[13] = __builtin_fmaf(ca3[1], zs, z[13]); z[14] = __builtin_fmaf(ca3[2], zs, z[14]); z[15] = __builtin_fmaf(ca3[3], zs, z[15]); }
                asm volatile("" : "+v"(z[5]) :: "memory");
                ca1 = *(const f32x4*)(AABT + 6 * 36 + 4); ca2 = *(const f32x4*)(AABT + 6 * 36 + 8); ca3 = *(const f32x4*)(AABT + 6 * 36 + 12);
                { const float zs = z[5]; z[6] = __builtin_fmaf(cb1[2], zs, z[6]); z[7] = __builtin_fmaf(cb1[3], zs, z[7]); z[8] = __builtin_fmaf(cb2[0], zs, z[8]); z[9] = __builtin_fmaf(cb2[1], zs, z[9]); z[10] = __builtin_fmaf(cb2[2], zs, z[10]); z[11] = __builtin_fmaf(cb2[3], zs, z[11]); z[12] = __builtin_fmaf(cb3[0], zs, z[12]); z[13] = __builtin_fmaf(cb3[1], zs, z[13]); z[14] = __builtin_fmaf(cb3[2], zs, z[14]); z[15] = __builtin_fmaf(cb3[3], zs, z[15]); }
                asm volatile("" : "+v"(z[6]) :: "memory");
                cb2 = *(const f32x4*)(AABT + 7 * 36 + 8); cb3 = *(const f32x4*)(AABT + 7 * 36 + 12);
                { const float zs = z[6]; z[7] = __builtin_fmaf(ca1[3], zs, z[7]); z[8] = __builtin_fmaf(ca2[0], zs, z[8]); z[9] = __builtin_fmaf(ca2[1], zs, z[9]); z[10] = __builtin_fmaf(ca2[2], zs, z[10]); z[11] = __builtin_fmaf(ca2[3], zs, z[11]); z[12] = __builtin_fmaf(ca3[0], zs, z[12]); z[13] = __builtin_fmaf(ca3[1], zs, z[13]); z[14] = __builtin_fmaf(ca3[2], zs, z[14]); z[15] = __builtin_fmaf(ca3[3], zs, z[15]); }
                asm volatile("" : "+v"(z[7]) :: "memory");
                ca2 = *(const f32x4*)(AABT + 8 * 36 + 8); ca3 = *(const f32x4*)(AABT + 8 * 36 + 12);
                { const float zs = z[7]; z[8] = __builtin_fmaf(cb2[0], zs, z[8]); z[9] = __builtin_fmaf(cb2[1], zs, z[9]); z[10] = __builtin_fmaf(cb2[2], zs, z[10]); z[11] = __builtin_fmaf(cb2[3], zs, z[11]); z[12] = __builtin_fmaf(cb3[0], zs, z[12]); z[13] = __builtin_fmaf(cb3[1], zs, z[13]); z[14] = __builtin_fmaf(cb3[2], zs, z[14]); z[15] = __builtin_fmaf(cb3[3], zs, z[15]); }
                asm volatile("" : "+v"(z[8]) :: "memory");
                cb2 = *(const f32x4*)(AABT + 9 * 36 + 8); cb3 = *(const f32x4*)(AABT + 9 * 36 + 12);
                { const float zs = z[8]; z[9] = __builtin_fmaf(ca2[1], zs, z[9]); z[10] = __builtin_fmaf(ca2[2], zs, z[10]); z[11] = __builtin_fmaf(ca2[3], zs, z[11]); z[12] = __builtin_fmaf(ca3[0], zs, z[12]); z[13] = __builtin_fmaf(ca3[1], zs, z[13]); z[14] = __builtin_fmaf(ca3[2], zs, z[14]); z[15] = __builtin_fmaf(ca3[3], zs, z[15]); }
                asm volatile("" : "+v"(z[9]) :: "memory");
                ca2 = *(const f32x4*)(AABT + 10 * 36 + 8); ca3 = *(const f32x4*)(AABT + 10 * 36 + 12);
                { const float zs = z[9]; z[10] = __builtin_fmaf(cb2[2], zs, z[10]); z[11] = __builtin_fmaf(cb2[3], zs, z[11]); z[12] = __builtin_fmaf(cb3[0], zs, z[12]); z[13] = __builtin_fmaf(cb3[1], zs, z[13]); z[14] = __builtin_fmaf(cb3[2], zs, z[14]); z[15] = __builtin_fmaf(cb3[3], zs, z[15]); }
                asm volatile("" : "+v"(z[10]) :: "memory");
                cb3 = *(const f32x4*)(AABT + 11 * 36 + 12);
                { const float zs = z[10]; z[11] = __builtin_fmaf(ca2[3], zs, z[11]); z[12] = __builtin_fmaf(ca3[0], zs, z[12]); z[13] = __builtin_fmaf(ca3[1], zs, z[13]); z[14] = __builtin_fmaf(ca3[2], zs, z[14]); z[15] = __builtin_fmaf(ca3[3], zs, z[15]); }
                asm volatile("" : "+v"(z[11]) :: "memory");
                ca3 = *(const f32x4*)(AABT + 12 * 36 + 12);
                { const float zs = z[11]; z[12] = __builtin_fmaf(cb3[0], zs, z[12]); z[13] = __builtin_fmaf(cb3[1], zs, z[13]); z[14] = __builtin_fmaf(cb3[2], zs, z[14]); z[15] = __builtin_fmaf(cb3[3], zs, z[15]); }
                asm volatile("" : "+v"(z[12]) :: "memory");
                cb3 = *(const f32x4*)(AABT + 13 * 36 + 12);
                { const float zs = z[12]; z[13] = __builtin_fmaf(ca3[1], zs, z[13]); z[14] = __builtin_fmaf(ca3[2], zs, z[14]); z[15] = __builtin_fmaf(ca3[3], zs, z[15]); }
                asm volatile("" : "+v"(z[13]) :: "memory");
                ca3 = *(const f32x4*)(AABT + 14 * 36 + 12);
                { const float zs = z[13]; z[14] = __builtin_fmaf(cb3[2], zs, z[14]); z[15] = __builtin_fmaf(cb3[3], zs, z[15]); }
                asm volatile("" : "+v"(z[14]) :: "memory");
                { const float zs = z[14]; z[15] = __builtin_fmaf(ca3[3], zs, z[15]); }
                asm volatile("" : "+v"(z[15]) :: "memory");
#pragma unroll
                for (int q = 0; q < 2; ++q) { u32x4 w; w.x = pack2(z[q * 8 + 0], z[q * 8 + 1]); w.y = pack2(z[q * 8 + 2], z[q * 8 + 3]); w.z = pack2(z[q * 8 + 4], z[q * 8 + 5]); w.w = pack2(z[q * 8 + 6], z[q * 8 + 7]);
                    *(u32x4*)(ZVT + lane * RW_LP + 0 + q * 8) = w; }
            }
            lds_barrier();
            if (wid < 4) {
                f32x4 acc = (f32x4){0.f, 0.f, 0.f, 0.f};
                acc = mma16(ldfrag(A21b, 40, 0, 0, fr, fq), ldfrag(ZVT, RW_LP, wid * 16, 0, fr, fq), acc);
#pragma unroll
                for (int rr = 0; rr < 4; ++rr) RHS[(16 + fq * 4 + rr) * 64 + wid * 16 + fr] += acc[rr];
            }
            lds_barrier();
            if (wid == 0) {
                float z[16]; f32x4 ca0, ca1, ca2, ca3, cb0, cb1, cb2, cb3;
#pragma unroll
                for (int t = 0; t < 16; ++t) z[t] = RHS[(16 + t) * 64 + lane];
                ca0 = *(const f32x4*)(AABT + 16 * 36 + 16); ca1 = *(const f32x4*)(AABT + 16 * 36 + 20); ca2 = *(const f32x4*)(AABT + 16 * 36 + 24); ca3 = *(const f32x4*)(AABT + 16 * 36 + 28);
                cb0 = *(const f32x4*)(AABT + 17 * 36 + 16); cb1 = *(const f32x4*)(AABT + 17 * 36 + 20); cb2 = *(const f32x4*)(AABT + 17 * 36 + 24); cb3 = *(const f32x4*)(AABT + 17 * 36 + 28);
                { const float zs = z[0]; z[1] = __builtin_fmaf(ca0[1], zs, z[1]); z[2] = __builtin_fmaf(ca0[2], zs, z[2]); z[3] = __builtin_fmaf(ca0[3], zs, z[3]); z[4] = __builtin_fmaf(ca1[0], zs, z[4]); z[5] = __builtin_fmaf(ca1[1], zs, z[5]); z[6] = __builtin_fmaf(ca1[2], zs, z[6]); z[7] = __builtin_fmaf(ca1[3], zs, z[7]); z[8] = __builtin_fmaf(ca2[0], zs, z[8]); z[9] = __builtin_fmaf(ca2[1], zs, z[9]); z[10] = __builtin_fmaf(ca2[2], zs, z[10]); z[11] = __builtin_fmaf(ca2[3], zs, z[11]); z[12] = __builtin_fmaf(ca3[0], zs, z[12]); z[13] = __builtin_fmaf(ca3[1], zs, z[13]); z[14] = __builtin_fmaf(ca3[2], zs, z[14]); z[15] = __builtin_fmaf(ca3[3], zs, z[15]); }
                asm volatile("" : "+v"(z[1]) :: "memory");
                ca0 = *(const f32x4*)(AABT + 18 * 36 + 16); ca1 = *(const f32x4*)(AABT + 18 * 36 + 20); ca2 = *(const f32x4*)(AABT + 18 * 36 + 24); ca3 = *(const f32x4*)(AABT + 18 * 36 + 28);
                { const float zs = z[1]; z[2] = __builtin_fmaf(cb0[2], zs, z[2]); z[3] = __builtin_fmaf(cb0[3], zs, z[3]); z[4] = __builtin_fmaf(cb1[0], zs, z[4]); z[5] = __builtin_fmaf(cb1[1], zs, z[5]); z[6] = __builtin_fmaf(cb1[2], zs, z[6]); z[7] = __builtin_fmaf(cb1[3], zs, z[7]); z[8] = __builtin_fmaf(cb2[0], zs, z[8]); z[9] = __builtin_fmaf(cb2[1], zs, z[9]); z[10] = __builtin_fmaf(cb2[2], zs, z[10]); z[11] = __builtin_fmaf(cb2[3], zs, z[11]); z[12] = __builtin_fmaf(cb3[0], zs, z[12]); z[13] = __builtin_fmaf(cb3[1], zs, z[13]); z[14] = __builtin_fmaf(cb3[2], zs, z[14]); z[15] = __builtin_fmaf(cb3[3], zs, z[15]); }
                asm volatile("" : "+v"(z[2]) :: "memory");
                cb1 = *(const f32x4*)(AABT + 19 * 36 + 20); cb2 = *(const f32x4*)(AABT + 19 * 36 + 24); cb3 = *(const f32x4*)(AABT + 19 * 36 + 28);
                { const float zs = z[2]; z[3] = __builtin_fmaf(ca0[3], zs, z[3]); z[4] = __builtin_fmaf(ca1[0], zs, z[4]); z[5] = __builtin_fmaf(ca1[1], zs, z[5]); z[6] = __builtin_fmaf(ca1[2], zs, z[6]); z[7] = __builtin_fmaf(ca1[3], zs, z[7]); z[8] = __builtin_fmaf(ca2[0], zs, z[8]); z[9] = __builtin_fmaf(ca2[1], zs, z[9]); z[10] = __builtin_fmaf(ca2[2], zs, z[10]); z[11] = __builtin_fmaf(ca2[3], zs, z[11]); z[12] = __builtin_fmaf(ca3[0], zs, z[12]); z[13] = __builtin_fmaf(ca3[1], zs, z[13]); z[14] = __builtin_fmaf(ca3[2], zs, z[14]); z[15] = __builtin_fmaf(ca3[3], zs, z[15]); }
                asm volatile("" : "+v"(z[3]) :: "memory");
                ca1 = *(const f32x4*)(AABT + 20 * 36 + 20); ca2 = *(const f32x4*)(AABT + 20 * 36 + 24); ca3 = *(const f32x4*)(AABT + 20 * 36 + 28);
                { const float zs = z[3]; z[4] = __builtin_fmaf(cb1[0], zs, z[4]); z[5] = __builtin_fmaf(cb1[1], zs, z[5]); z[6] = __builtin_fmaf(cb1[2], zs, z[6]); z[7] = __builtin_fmaf(cb1[3], zs, z[7]); z[8] = __builtin_fmaf(cb2[0], zs, z[8]); z[9] = __builtin_fmaf(cb2[1], zs, z[9]); z[10] = __builtin_fmaf(cb2[2], zs, z[10]); z[11] = __builtin_fmaf(cb2[3], zs, z[11]); z[12] = __builtin_fmaf(cb3[0], zs, z[12]); z[13] = __builtin_fmaf(cb3[1], zs, z[13]); z[14] = __builtin_fmaf(cb3[2], zs, z[14]); z[15] = __builtin_fmaf(cb3[3], zs, z[15]); }
                asm volatile("" : "+v"(z[4]) :: "memory");
                cb1 = *(const f32x4*)(AABT + 21 * 36 + 20); cb2 = *(const f32x4*)(AABT + 21 * 36 + 24); cb3 = *(const f32x4*)(AABT + 21 * 36 + 28);
                { const float zs = z[4]; z[5] = __builtin_fmaf(ca1[1], zs, z[5]); z[6] = __builtin_fmaf(ca1[2], zs, z[6]); z[7] = __builtin_fmaf(ca1[3], zs, z[7]); z[8] = __builtin_fmaf(ca2[0], zs, z[8]); z[9] = __builtin_fmaf(ca2[1], zs, z[9]); z[10] = __builtin_fmaf(ca2[2], zs, z[10]); z[11] = __builtin_fmaf(ca2[3], zs, z[11]); z[12] = __builtin_fmaf(ca3[0], zs, z[12]); z[13] = __builtin_fmaf(ca3[1], zs, z[13]); z[14] = __builtin_fmaf(ca3[2], zs, z[14]); z[15] = __builtin_fmaf(ca3[3], zs, z[15]); }
                asm volatile("" : "+v"(z[5]) :: "memory");
                ca1 = *(const f32x4*)(AABT + 22 * 36 + 20); ca2 = *(const f32x4*)(AABT + 22 * 36 + 24); ca3 = *(const f32x4*)(AABT + 22 * 36 + 28);
                { const float zs = z[5]; z[6] = __builtin_fmaf(cb1[2], zs, z[6]); z[7] = __builtin_fmaf(cb1[3], zs, z[7]); z[8] = __builtin_fmaf(cb2[0], zs, z[8]); z[9] = __builtin_fmaf(cb2[1], zs, z[9]); z[10] = __builtin_fmaf(cb2[2], zs, z[10]); z[11] = __builtin_fmaf(cb2[3], zs, z[11]); z[12] = __builtin_fmaf(cb3[0], zs, z[12]); z[13] = __builtin_fmaf(cb3[1], zs, z[13]); z[14] = __builtin_fmaf(cb3[2], zs, z[14]); z[15] = __builtin_fmaf(cb3[3], zs, z[15]); }
                asm volatile("" : "+v"(z[6]) :: "memory");
                cb2 = *(const f32x4*)(AABT + 23 * 36 + 24); cb3 = *(const f32x4*)(AABT + 23 * 36 + 28);
                { const float zs = z[6]; z[7] = __builtin_fmaf(ca1[3], zs, z[7]); z[8] = __builtin_fmaf(ca2[0], zs, z[8]); z[9] = __builtin_fmaf(ca2[1], zs, z[9]); z[10] = __builtin_fmaf(ca2[2], zs, z[10]); z[11] = __builtin_fmaf(ca2[3], zs, z[11]); z[12] = __builtin_fmaf(ca3[0], zs, z[12]); z[13] = __builtin_fmaf(ca3[1], zs, z[13]); z[14] = __builtin_fmaf(ca3[2], zs, z[14]); z[15] = __builtin_fmaf(ca3[3], zs, z[15]); }
                asm volatile("" : "+v"(z[7]) :: "memory");
                ca2 = *(const f32x4*)(AABT + 24 * 36 + 24); ca3 = *(const f32x4*)(AABT + 24 * 36 + 28);
                { const float zs = z[7]; z[8] = __builtin_fmaf(cb2[0], zs, z[8]); z[9] = __builtin_fmaf(cb2[1], zs, z[9]); z[10] = __builtin_fmaf(cb2[2], zs, z[10]); z[11] = __builtin_fmaf(cb2[3], zs, z[11]); z[12] = __builtin_fmaf(cb3[0], zs, z[12]); z[13] = __builtin_fmaf(cb3[1], zs, z[13]); z[14] = __builtin_fmaf(cb3[2], zs, z[14]); z[15] = __builtin_fmaf(cb3[3], zs, z[15]); }
                asm volatile("" : "+v"(z[8]) :: "memory");
                cb2 = *(const f32x4*)(AABT + 25 * 36 + 24); cb3 = *(const f32x4*)(AABT + 25 * 36 + 28);
                { const float zs = z[8]; z[9] = __builtin_fmaf(ca2[1], zs, z[9]); z[10] = __builtin_fmaf(ca2[2], zs, z[10]); z[11] = __builtin_fmaf(ca2[3], zs, z[11]); z[12] = __builtin_fmaf(ca3[0], zs, z[12]); z[13] = __builtin_fmaf(ca3[1], zs, z[13]); z[14] = __builtin_fmaf(ca3[2], zs, z[14]); z[15] = __builtin_fmaf(ca3[3], zs, z[15]); }
                asm volatile("" : "+v"(z[9]) :: "memory");
                ca2 = *(const f32x4*)(AABT + 26 * 36 + 24); ca3 = *(const f32x4*)(AABT + 26 * 36 + 28);
                { const float zs = z[9]; z[10] = __builtin_fmaf(cb2[2], zs, z[10]); z[11] = __builtin_fmaf(cb2[3], zs, z[11]); z[12] = __builtin_fmaf(cb3[0], zs, z[12]); z[13] = __builtin_fmaf(cb3[1], zs, z[13]); z[14] = __builtin_fmaf(cb3[2], zs, z[14]); z[15] = __builtin_fmaf(cb3[3], zs, z[15]); }
                asm volatile("" : "+v"(z[10]) :: "memory");
                cb3 = *(const f32x4*)(AABT + 27 * 36 + 28);
                { const float zs = z[10]; z[11] = __builtin_fmaf(ca2[3], zs, z[11]); z[12] = __builtin_fmaf(ca3[0], zs, z[12]); z[13] = __builtin_fmaf(ca3[1], zs, z[13]); z[14] = __builtin_fmaf(ca3[2], zs, z[14]); z[15] = __builtin_fmaf(ca3[3], zs, z[15]); }
                asm volatile("" : "+v"(z[11]) :: "memory");
                ca3 = *(const f32x4*)(AABT + 28 * 36 + 28);
                { const float zs = z[11]; z[12] = __builtin_fmaf(cb3[0], zs, z[12]); z[13] = __builtin_fmaf(cb3[1], zs, z[13]); z[14] = __builtin_fmaf(cb3[2], zs, z[14]); z[15] = __builtin_fmaf(cb3[3], zs, z[15]); }
                asm volatile("" : "+v"(z[12]) :: "memory");
                cb3 = *(const f32x4*)(AABT + 29 * 36 + 28);
                { const float zs = z[12]; z[13] = __builtin_fmaf(ca3[1], zs, z[13]); z[14] = __builtin_fmaf(ca3[2], zs, z[14]); z[15] = __builtin_fmaf(ca3[3], zs, z[15]); }
                asm volatile("" : "+v"(z[13]) :: "memory");
                ca3 = *(const f32x4*)(AABT + 30 * 36 + 28);
                { const float zs = z[13]; z[14] = __builtin_fmaf(cb3[2], zs, z[14]); z[15] = __builtin_fmaf(cb3[3], zs, z[15]); }
                asm volatile("" : "+v"(z[14]) :: "memory");
                { const float zs = z[14]; z[15] = __builtin_fmaf(ca3[3], zs, z[15]); }
                asm volatile("" : "+v"(z[15]) :: "memory");
#pragma unroll
                for (int q = 0; q < 2; ++q) { u32x4 w; w.x = pack2(z[q * 8 + 0], z[q * 8 + 1]); w.y = pack2(z[q * 8 + 2], z[q * 8 + 3]); w.z = pack2(z[q * 8 + 4], z[q * 8 + 5]); w.w = pack2(z[q * 8 + 6], z[q * 8 + 7]);
                    *(u32x4*)(ZVT + lane * RW_LP + 16 + q * 8) = w; }
            }
        }
        lds_barrier();
        {
            const int nt = wid >> 1;
            const f32x4 pl = *(const f32x4*)(PL + nt * 16 + fq * 4);
#pragma unroll
            for (int q2 = 0; q2 < 2; ++q2) {
                const int vt = (wid & 1) * 2 + q2;
                Sacc[q2] = Sacc[q2] * pl;
#pragma unroll
                for (int k = 0; k < 2; ++k) Sacc[q2] = mma16(ldfrag(BKh, RW_LP, nt * 16, k * 32, fr, fq), ldfrag(ZVT, RW_LP, vt * 16, k * 32, fr, fq), Sacc[q2]);
                st4bf(Sb + (vt * 16 + fr) * RW_LP + nt * 16 + fq * 4, Sacc[q2]);
            }
        }
        if (t0 >= CTXL) {
            const int vt = wid >> 1, tt = wid & 1;
            f32x4 acc = (f32x4){0.f, 0.f, 0.f, 0.f};
            acc = mma16(ldfrag(ZVT, RW_LP, vt * 16, 0, fr, fq), ldfrag(ARB, 40, tt * 16, 0, fr, fq), acc);
            const int t = tt * 16 + fr, v0 = vt * 16 + fq * 4;
#pragma unroll
            for (int rr = 0; rr < 4; ++rr) acc[rr] += YB[t * 64 + v0 + rr];
            const int tn = scan_t<32>(dir, ci, t);
            st4bf(OUT + ((size_t)bl * SEQ + (tn - CTXL)) * 1024 + h * 64 + v0, acc);
        }
    }
    lds_barrier();
#undef RW_PREFETCH
}

__device__ __forceinline__ void phase_mix_cd(const KP& kp, unsigned char* lds, int which) {
    if (which & 1) for (int u = obid(); u < 256; u += gridDim.x) { rwkv_unit(kp, lds, u >> 5, (u >> 1) & 15, u & 1); __syncthreads(); }
    if (which & 2) for (int u = obid(); u < 512; u += gridDim.x) { attn_unit(kp, lds, u >> 6, (u >> 3) & 7, u & 7); __syncthreads(); }
}

struct EpiFinCD {
    const bf16_t* OF; const bf16_t* OB; const bf16_t* P; const float* BSC; const float* ln; const float* mu; bf16_t* AOUT;
    __device__ __forceinline__ void operator()(const f32x4 (&acc)[4][4], int rb, int cb, int fr, int fq) const {
        const int head = cb >> 6;
#pragma unroll
        for (int i = 0; i < 4; ++i) { const int lr = rb + i * 16 + fr, s = lr & 2047;
            const size_t prow = (size_t)(lr >> 11) * TT + CTXL + s;
            f32x4 o[4]; float ss = 0.f;
#pragma unroll
            for (int j = 0; j < 4; ++j) { const int col = cb + j * 16 + fq * 4;
                o[j] = ld4bf(OF + (size_t)lr * 1024 + col) + ld4bf(OB + (size_t)lr * 1024 + col);
                ss += o[j][0] * o[j][0] + o[j][1] * o[j][1] + o[j][2] * o[j][2] + o[j][3] * o[j][3]; }
            ss += __shfl_xor(ss, 16); ss += __shfl_xor(ss, 32);
            const float rstd = rsqrtf(ss * (1.0f / 64.0f) + EPS);
            const float bon = BSC[(size_t)lr * 16 + head] + BSC[(size_t)RGL * 16 + (size_t)lr * 16 + head];
#pragma unroll
            for (int j = 0; j < 4; ++j) { const int col = cb + j * 16 + fq * 4;
                const bf16_t* pv = P + prow * CD_N + CD_V + col;
                const f32x4 v = ld4bf(pv);
                const f32x4 vp = s > 0 ? ld4bf(pv - CD_N) : (f32x4){0.f, 0.f, 0.f, 0.f};
                const f32x4 vn = s < SEQ - 1 ? ld4bf(pv + CD_N) : (f32x4){0.f, 0.f, 0.f, 0.f};
                const f32x4 vl = v + *(const f32x4*)(mu + 2048 + col) * ((vp + vn) * 0.5f - v);
                const f32x4 y = o[j] * rstd * *(const f32x4*)(ln + col) + vl * bon;
                st4bf(AOUT + (size_t)lr * 1536 + 512 + col, y * acc[i][j]); }
        }
    }
};
PHASE_FN void phase_fin_cd(const KP& kp, unsigned char* lds) {
    GA ga{WSP(const bf16_t, WS_SG), nullptr, 128, 0, 128, nullptr, RGL, 0, 0};
    EpiFinCD ep{WSP(const bf16_t, WS_BIG + L1_OF), WSP(const bf16_t, WS_BIG + L1_OB), WSP(const bf16_t, WS_BIG + L1_P), WSP(const float, WS_BSC), KIN(33), KIN(24), WSP(bf16_t, WS_BIG + L1_AOUT)};
    for (int u = obid(); u < (RGL / 256) * 8; u += gridDim.x) gemm_tile(lds, ga, WSP(const bf16_t, WS_WMIX + WM_G2), 128, u >> 3, u & 7, ep);
}
PHASE_FN void phase_gemm_out_cd(const KP& kp, unsigned char* lds) {
    pg8::Gemm g{WSP(const bf16_t, WS_BIG + L1_AOUT), WSP(const bf16_t, WS_WMIX + WM_CD_OUT), RGL, 1024, 1536, nullptr, 0x7fffffff};
    pg8::StaticOrder S; S.init(RGL, 1024, (int)gridDim.x, obid());
    pg8::EpiBfG E{WSP(bf16_t, WS_BIG + L1_U), 1024, 1024, 0x7fffffff};
    pg8::gemm_phase<pg8::EpiBfG, pg8::StaticOrder, false>((PG8_LAS unsigned char*)lds, g, S, E, nullptr);
    __syncthreads();
}

__device__ __attribute__((noinline)) void grid_sync(unsigned* barw, unsigned x, volatile LAS unsigned* st) { XcdBarrier b; b.bar = barw; b.x = x; b.st = st; xcd_barrier(b); }
constexpr int N_PHASES = 36;
__global__ void __launch_bounds__(512, 2) fwd_kernel(KP kparg) {
    extern __shared__ __attribute__((aligned(16))) unsigned char lds[];
    const int lo = kparg.ph_lo, hi = kparg.ph_hi;
    const KP& kp = kparg;
    volatile LAS unsigned* xbst = (volatile LAS unsigned*)(LAS unsigned char*)(lds + LDS_BYTES - 16);
    if (threadIdx.x == 0) { xbst[0] = 0u; xbst[1] = 0u; }
    __syncthreads();
    XcdBarrier bar; bar.bar = (unsigned*)kparg.ws; bar.x = 0; bar.st = xbst;
    if (hi - lo > 1) bar = xcd_barrier_post((unsigned*)kparg.ws, xbst);
#define IN(k) (lo <= (k) && (k) < hi)
#define SEAM(k) do { if (IN(k) && IN((k) + 1)) { grid_sync((unsigned*)kp.ws, bar.x, xbst); if (PROBE_DUP & 512) grid_sync((unsigned*)kp.ws, bar.x, xbst); } } while (0)
#define PHASE(...) do { if (IN(ph)) { __VA_ARGS__ } SEAM(ph); ++ph; } while (0)
    int ph = 0;
    PHASE(phase_mod(kp, lds); __syncthreads(); phase_conv_ab(kp, lds); if (PROBE_DUP & 32) { __syncthreads(); phase_mod(kp, lds); __syncthreads(); phase_conv_ab(kp, lds); });
#pragma unroll
    for (int g = 0; g < NG; ++g) {
        if (g == 0) PHASE(phase_u(kp, 0, 0, obid(), (int)gridDim.x, false););
        PHASE(phase_gemm_in(kp, lds, 0, g); if (PROBE_DUP & 8) phase_gemm_in(kp, lds, 0, g););
        PHASE(phase_xconv(kp); if (PROBE_DUP & 2048) phase_xconv(kp););
        PHASE(phase_scan_ab(kp, lds); if (PROBE_DUP & 1) { __syncthreads(); phase_scan_ab(kp, lds); });
        PHASE(phase_fin_ab(kp););
        PHASE(phase_gemm_out_ab(kp, lds, g););
        PHASE(phase_r(kp, lds, 0, g););
    }
    PHASE(phase_moe_gather(kp, 0); phase_conv_cd(kp, lds););
    PHASE(phase_moe_gemm(kp, lds, 0, false); if (PROBE_DUP & 16) { __syncthreads(); phase_moe_gemm(kp, lds, 0, false); });
    PHASE(phase_moe_gemm(kp, lds, 0, true); if (PROBE_DUP & 16) { __syncthreads(); phase_moe_gemm(kp, lds, 0, true); });
    PHASE(phase_combine(kp, 0););
#pragma unroll
    for (int g = 0; g < NG; ++g) {
        PHASE(phase_gemm_in(kp, lds, 1, g); if (PROBE_DUP & 8) phase_gemm_in(kp, lds, 1, g););
        PHASE(phase_prep_cd(kp););
        PHASE(phase_upproj(kp, lds); if (PROBE_DUP & 4096) phase_upproj(kp, lds););
        PHASE(phase_mix_cd(kp, lds, 3); if (PROBE_DUP & 2) { __syncthreads(); phase_mix_cd(kp, lds, 1); } if (PROBE_DUP & 4) { __syncthreads(); phase_mix_cd(kp, lds, 2); });
        PHASE(phase_fin_cd(kp, lds); if (PROBE_DUP & 4096) phase_fin_cd(kp, lds););
        PHASE(phase_gemm_out_cd(kp, lds); if (PROBE_DUP & 256) phase_gemm_out_cd(kp, lds););
        PHASE(phase_r(kp, lds, 1, g););
    }
    PHASE(phase_moe_gather(kp, 1); phase_conv_moe(kp, lds, 1, obid(), (int)gridDim.x););
    PHASE(phase_moe_gemm(kp, lds, 1, false););
    PHASE(phase_moe_gemm(kp, lds, 1, true););
    PHASE(phase_combine(kp, 1););
#undef PHASE
#undef IN
#undef SEAM
}

extern "C" void kernel_launch(void* const* d_in, const int* in_sizes, int n_in, void* d_out, int out_size, void* d_ws, size_t ws_size, hipStream_t stream) {
    static int grid = 0;
    if (grid == 0) {
        if (n_in != 42 || out_size != NLAT * D || ws_size < WS_NEED) { fprintf(stderr, "kernel_launch: unexpected shapes: n_in %d out %d ws %zu (need %zu)\n", n_in, out_size, ws_size, (size_t)WS_NEED); grid = -1; return; }
        int dev = 0, cus = 0, per_cu = 0;
        if (hipGetDevice(&dev) != hipSuccess || hipDeviceGetAttribute(&cus, hipDeviceAttributeMultiprocessorCount, dev) != hipSuccess) { grid = -1; return; }
        if (hipFuncSetAttribute((const void*)fwd_kernel, hipFuncAttributeMaxDynamicSharedMemorySize, LDS_BYTES) != hipSuccess) { fprintf(stderr, "kernel_launch: hipFuncSetAttribute failed\n"); grid = -1; return; }
        if (hipOccupancyMaxActiveBlocksPerMultiprocessor(&per_cu, (const void*)fwd_kernel, 512, LDS_BYTES) != hipSuccess || per_cu < 1) { fprintf(stderr, "kernel_launch: occupancy query says %d blocks per CU\n", per_cu); grid = -1; (void)hipGetLastError(); return; }
        grid = cus;
    }
    if (grid < 0) return;
    (void)hipMemsetAsync(d_ws, 0, CTL_BYTES, stream);
    KP kp{};
    for (int i = 0; i < 42; ++i) kp.in[i] = (const float*)d_in[i];
    kp.out = (float*)d_out; kp.ws = (unsigned char*)d_ws;
#if N_LAUNCH_MODE == 1
    kp.ph_lo = 0; kp.ph_hi = N_PHASES;
    hipLaunchKernelGGL(fwd_kernel, dim3(grid), dim3(512), LDS_BYTES, stream, kp);
#else
    for (int p = 0; p < N_PHASES; ++p) { kp.ph_lo = p; kp.ph_hi = p + 1; hipLaunchKernelGGL(fwd_kernel, dim3(grid), dim3(512), LDS_BYTES, stream, kp); }
#endif
}
```

```cpp
#include <hip/hip_runtime.h>
#include <stdint.h>
#include <stdio.h>

typedef unsigned short bf16_t;
typedef short bf16x8 __attribute__((ext_vector_type(8)));
typedef float f32x4 __attribute__((ext_vector_type(4)));
typedef float f32x2 __attribute__((ext_vector_type(2)));
typedef unsigned u32x4 __attribute__((ext_vector_type(4)));
typedef unsigned u32x2 __attribute__((ext_vector_type(2)));

#ifndef RWP
#define RWP 0
#endif
#ifndef PROBE_DUP
#define PROBE_DUP 0
#endif
#ifndef N_LAUNCH_MODE
#define N_LAUNCH_MODE 1
#endif

constexpr int NB = 16, SEQ = 2048, CTXL = 256, TT = 2304, D = 1024;
constexpr int NTOK = NB * TT, NLAT = NB * SEQ;
constexpr int NG = 2, BG = NB / NG, RG = BG * TT, RGL = BG * SEQ;
constexpr float EPS = 1e-6f;
constexpr int AB_N = 5424, AB_NPAD = 5632, AB_Q = 0, AB_K = 512, AB_V = 1024, AB_OG = 2048, AB_IG = 3072, AB_FG = 3080, AB_Z = 3088, AB_XBC = 4112, AB_DT = 5392;
constexpr int CD_N = 4128, CD_NPAD = 4352, CD_M0 = 0, CD_M1 = 384, CD_KR = 640, CD_R = 672, CD_K = 1696, CD_V = 2720, CD_WL = 3744, CD_AL = 3872, CD_GL = 4000;
constexpr int CD_RW0 = 672;

constexpr size_t CTL_BYTES = 32768;
constexpr size_t CTL_CNT = 16384;
constexpr size_t WS_MODV = CTL_BYTES;
constexpr size_t WS_HC   = WS_MODV + (size_t)2 * 17 * 6144 * 4;
constexpr size_t WS_TOKE = WS_HC + (size_t)NB * CTXL * D * 4;
constexpr size_t WS_TOKP = WS_TOKE + (size_t)NTOK * 2 * 4;
constexpr size_t WS_TOKW = WS_TOKP + (size_t)NTOK * 2 * 4;
constexpr size_t WS_LIST = WS_TOKW + (size_t)NTOK * 2 * 4;
constexpr size_t WS_BSC  = WS_LIST + (size_t)16 * NTOK * 4;
constexpr size_t WS_SG   = WS_BSC + (size_t)2 * RGL * 16 * 4;
constexpr size_t WS_WMIX = WS_SG + (size_t)RGL * 128 * 2;
constexpr size_t WMIX_BYTES = (size_t)16 << 20;
constexpr size_t WS_V    = WS_WMIX + WMIX_BYTES;
constexpr size_t WS_BIG  = WS_V + (size_t)NTOK * D * 2;
constexpr size_t WM_AB_IN = 0, WM_AB_OUT = (size_t)AB_NPAD * 1024 * 2;
constexpr size_t WM_CD_IN = 0, WM_CD_OUT = (size_t)CD_NPAD * 1024 * 2, WM_UQ = WM_CD_OUT + (size_t)1024 * 1536 * 2, WM_UKV = WM_UQ + (size_t)768 * 384 * 2, WM_G2 = WM_UKV + (size_t)1024 * 256 * 2;
static_assert(WM_AB_OUT + (size_t)1024 * 2048 * 2 <= WMIX_BYTES, "wmix ab");
static_assert(WM_G2 + (size_t)1024 * 128 * 2 <= WMIX_BYTES, "wmix cd");
constexpr size_t SZ_RG1K = (size_t)RG * 1024 * 2, SZ_RGL1K = (size_t)RGL * 1024 * 2;
constexpr size_t L0_P = 0, L0_AO = (size_t)RG * AB_N * 2  , L0_HB = L0_AO + 2 * SZ_RG1K, L0_YB = L0_HB + SZ_RG1K, L0_U = L0_YB + SZ_RG1K, L0_END = L0_U + SZ_RG1K;
constexpr size_t L1_P = 0, L1_Q = (size_t)RG * CD_N * 2, L1_KV = L1_Q + (size_t)RGL * 768 * 2, L1_OF = L1_KV + SZ_RG1K, L1_OB = L1_OF + SZ_RGL1K, L1_AOUT = L1_OB + SZ_RGL1K, L1_U = L1_AOUT + (size_t)RGL * 1536 * 2, L1_TWAL = L1_U + SZ_RG1K  , L1_END = L1_TWAL + (size_t)RG * 256 * 2;
constexpr int MOE_PADROWS = 16 * 256;
constexpr size_t MO_WUP = 0, MO_WDN = (size_t)17 * 1024 * 1024 * 2, MO_HID = MO_WDN + (size_t)17 * 1024 * 512 * 2;
constexpr size_t MO_XG = MO_HID + (size_t)(3 * NTOK + MOE_PADROWS) * 512 * 2;
constexpr size_t MO_CON = MO_XG, MO_END = MO_CON + (size_t)(3 * NTOK + MOE_PADROWS) * 1024 * 2;
constexpr size_t BIG_BYTES = MO_END > L0_END ? (MO_END > L1_END ? MO_END : L1_END) : (L0_END > L1_END ? L0_END : L1_END);
constexpr size_t WS_NEED = WS_BIG + BIG_BYTES;

constexpr int LDS_BYTES = 147456;

__device__ __forceinline__ float bf2f(unsigned short h) { return __uint_as_float(((unsigned)h) << 16); }
typedef __bf16 bf16v2_t __attribute__((ext_vector_type(2)));
__device__ __forceinline__ unsigned pack2(float a, float b) { const bf16v2_t h = __builtin_convertvector((f32x2){a, b}, bf16v2_t); return __builtin_bit_cast(unsigned, h); }
__device__ __forceinline__ unsigned short f2bf(float f) { const __bf16 h = (__bf16)f; return __builtin_bit_cast(unsigned short, h); }
__device__ __forceinline__ float lo2f(unsigned w) { return __uint_as_float(w << 16); }
__device__ __forceinline__ float hi2f(unsigned w) { return __uint_as_float(w & 0xffff0000u); }
__device__ __forceinline__ float wsum(float v) {
#pragma unroll
    for (int o = 32; o; o >>= 1) v += __shfl_xor(v, o);
    return v; }
__device__ __forceinline__ float frcp_(float x) { return __builtin_amdgcn_rcpf(x); }
__device__ __forceinline__ float sigmoidf_(float x) { return __builtin_amdgcn_rcpf(1.0f + __expf(-x)); }
__device__ __forceinline__ float siluf_(float x) { return x * __builtin_amdgcn_rcpf(1.0f + __expf(-x)); }
__device__ __forceinline__ float softplusf_(float x) { return fmaxf(x, 0.0f) + __logf(1.0f + __expf(-fabsf(x))); }
__device__ __forceinline__ float logsigmoidf_(float x) { return fminf(x, 0.0f) - __logf(1.0f + __expf(-fabsf(x))); }
__device__ __forceinline__ float tanhf_(float x) { return 1.0f - 2.0f * __builtin_amdgcn_rcpf(__expf(2.0f * x) + 1.0f); }
__device__ __forceinline__ f32x4 mma16(bf16x8 a, bf16x8 b, f32x4 c) { return __builtin_amdgcn_mfma_f32_16x16x32_bf16(a, b, c, 0, 0, 0); }
__device__ __forceinline__ bf16x8 ldfrag(const bf16_t* base, int ld, int row0, int k0, int fr, int fq) { return *(const bf16x8*)(base + (row0 + fr) * ld + k0 + fq * 8); }
__device__ __forceinline__ void st4bf(bf16_t* p, f32x4 v) { u32x2 w; w.x = pack2(v[0], v[1]); w.y = pack2(v[2], v[3]); *(u32x2*)p = w; }
__device__ __forceinline__ f32x4 ld4bf(const bf16_t* p) { u32x2 w = *(const u32x2*)p; return (f32x4){lo2f(w.x), hi2f(w.x), lo2f(w.y), hi2f(w.y)}; }

#define PHASE_FN __device__ __forceinline__
__device__ __forceinline__ int otid() { int t = threadIdx.x; asm volatile("" : "+v"(t)); return t; }
__device__ __forceinline__ int obid() { int t = blockIdx.x; asm volatile("" : "+s"(t)); return t; }
template <class T> __device__ __forceinline__ T* as_global(T* p) { return p; }
__device__ __forceinline__ void lds_barrier() { asm volatile("s_waitcnt lgkmcnt(0)" ::: "memory"); __builtin_amdgcn_s_barrier(); asm volatile("" ::: "memory"); }
constexpr float W8_SCALE = 64.0f, W8_INV = 1.0f / 64.0f;
__device__ __forceinline__ unsigned pack4f8(float a, float b, float c, float d) { unsigned r = 0; r = __builtin_amdgcn_cvt_pk_fp8_f32(a, b, r, false); r = __builtin_amdgcn_cvt_pk_fp8_f32(c, d, r, true); return r; }
__device__ __forceinline__ void st4f8(unsigned char* p, f32x4 v) { *(unsigned*)p = pack4f8(v[0], v[1], v[2], v[3]); }
struct KP { const float* in[42]; float* out; unsigned char* ws; int ph_lo, ph_hi; };

#define XB_TMO      128
#define XB_XCNT(j)  (256  + 64 * (j))
#define XB_XSUB(j)  (1280 + 64 * (j))
#define XB_XGEN(j)  (2304 + 64 * (j))
#define XB_TOP      3328
#define XB_TOPGEN   3392
#define XCD_BAR_WORDS 3456
#define XB_SPIN_CAP (1u << 18)
#define LAS __attribute__((address_space(3)))

__device__ __forceinline__ unsigned xb_ld(unsigned* p)              { return __hip_atomic_load(p, __ATOMIC_RELAXED, __HIP_MEMORY_SCOPE_AGENT); }
__device__ __forceinline__ unsigned xb_add(unsigned* p, unsigned v) { return __hip_atomic_fetch_add(p, v, __ATOMIC_RELAXED, __HIP_MEMORY_SCOPE_AGENT); }
__device__ __forceinline__ unsigned xb_xcc_id() { return (unsigned)__builtin_amdgcn_s_getreg((3 << 11) | 20) & 0xFu; }
#define XB_SPIN(cond, bar) do { unsigned _sp = 0; while (cond) { __builtin_amdgcn_s_sleep(1); \
    if ((++_sp & 255u) == 0u) { if (xb_ld(&(bar)[XB_TMO])) break; if (_sp > XB_SPIN_CAP) { atomicAdd(&(bar)[XB_TMO], 1u); break; } } } } while (0)

struct XcdBarrier {
    unsigned* bar; unsigned x;
    volatile LAS unsigned* st;
};

__device__ __forceinline__ XcdBarrier xcd_barrier_post(unsigned* bar, volatile LAS unsigned* st) {
    XcdBarrier b; b.bar = bar; b.x = xb_xcc_id(); b.st = st;
    if (threadIdx.x == 0) (void)xb_add(&bar[XB_XCNT(b.x)], 1u);
    return b;
}
__device__ __forceinline__ void xcd_barrier_complete(unsigned* bar, unsigned x, unsigned& nloc, unsigned& nx) {
    const unsigned G = gridDim.x * gridDim.y * gridDim.z;
    unsigned sum, cnt, mine, sp = 0u;
    for (;;) {
        sum = 0u; cnt = 0u; mine = 0u;
#pragma unroll
        for (unsigned j = 0; j < 16; ++j) { const unsigned c = xb_ld(&bar[XB_XCNT(j)]); sum += c; cnt += (c > 0u) ? 1u : 0u; mine = (j == x) ? c : mine; }
        if (sum == G) break;
        __builtin_amdgcn_s_sleep(1);
        if ((++sp & 255u) == 0u) { if (xb_ld(&bar[XB_TMO])) break; if (sp > XB_SPIN_CAP) { atomicAdd(&bar[XB_TMO], 1u); break; } }
    }
    nloc = mine > 0u ? mine : 1u; nx = cnt > 0u ? cnt : 1u;
}

__device__ __forceinline__ void xcd_barrier(const XcdBarrier& b) {
    asm volatile("s_waitcnt vmcnt(0)" ::: "memory");
    __syncthreads();
    if (threadIdx.x == 0) {
        unsigned* bar = b.bar;
        __builtin_amdgcn_s_waitcnt(0);
        unsigned nloc = b.st[0], nx = b.st[1];
        if (nloc == 0u) { xcd_barrier_complete(bar, b.x, nloc, nx); b.st[0] = nloc; b.st[1] = nx; }
        const unsigned old = xb_add(&bar[XB_XSUB(b.x)], 1u);
        const unsigned gen = old / nloc;
        if (old + 1u == (gen + 1u) * nloc) {
            __builtin_amdgcn_fence(__ATOMIC_RELEASE, "agent");
            asm volatile("s_waitcnt vmcnt(0)" ::: "memory");
            const unsigned og = xb_add(&bar[XB_TOP], 1u);
            const unsigned tg = og / nx;
            if (og + 1u == (tg + 1u) * nx) xb_add(&bar[XB_TOPGEN], 1u);
            else XB_SPIN(xb_ld(&bar[XB_TOPGEN]) == tg, bar);
            __builtin_amdgcn_fence(__ATOMIC_ACQUIRE, "agent");
            xb_add(&bar[XB_XGEN(b.x)], 1u);
            asm volatile("s_waitcnt vmcnt(0)" ::: "memory");
        } else {
            XB_SPIN(xb_ld(&bar[XB_XGEN(b.x)]) == gen, bar);
            __builtin_amdgcn_fence(__ATOMIC_ACQUIRE, "agent");
            asm volatile("s_waitcnt vmcnt(0)" ::: "memory");
        }
    }
    __syncthreads();
}
struct GA {
    const bf16_t* a0; const bf16_t* a1;
    int ld0, ld1, ksplit;
    const int* list;
    int nrows;
    int mode;
    int row0;
};
constexpr int G_LDT = 40;
constexpr int GEMM_LDS = (2 * 256 * G_LDT + 2 * 128 * G_LDT) * 2;

template <class Epi>
__device__ __forceinline__ void gemm_tile(unsigned char* lds, const GA& ga, const bf16_t* __restrict__ Bt, int K, int mt, int nt, const Epi& epi) {
    const int tid = otid(), lane = tid & 63, wid = __builtin_amdgcn_readfirstlane(tid >> 6), wm = wid >> 1, wn = wid & 1, fr = lane & 15, fq = lane >> 4;
    bf16_t* sA = (bf16_t*)lds;
    bf16_t* sB = sA + 2 * 256 * G_LDT;
    const int kp = tid & 3;
    const int r0 = tid >> 2, r1 = r0 + 128;
    int s0, s1;
    {
        int lr = mt * 256 + r0; if (lr >= ga.nrows) lr = 0;
        s0 = ga.list ? ga.list[lr] : (ga.mode == 1 ? (lr >> 11) * TT + CTXL + (lr & 2047) : ga.row0 + lr);
        lr = mt * 256 + r1; if (lr >= ga.nrows) lr = 0;
        s1 = ga.list ? ga.list[lr] : (ga.mode == 1 ? (lr >> 11) * TT + CTXL + (lr & 2047) : ga.row0 + lr);
    }
    const bf16_t* pa00 = ga.a0 + (size_t)s0 * ga.ld0 + kp * 8;
    const bf16_t* pa01 = ga.a0 + (size_t)s1 * ga.ld0 + kp * 8;
    const bf16_t* pa10 = ga.a1 ? ga.a1 + (size_t)s0 * ga.ld1 + kp * 8 : pa00;
    const bf16_t* pa11 = ga.a1 ? ga.a1 + (size_t)s1 * ga.ld1 + kp * 8 : pa01;
    const bf16_t* pb = Bt + (size_t)(nt * 128 + r0) * K + kp * 8;
    const int ksplit = ga.ksplit;
    f32x4 acc[4][4];
#pragma unroll
    for (int i = 0; i < 4; ++i)
#pragma unroll
        for (int j = 0; j < 4; ++j) acc[i][j] = (f32x4){0.f, 0.f, 0.f, 0.f};
    const int nk = K >> 5;
    u32x4 ra0, ra1, rb;
    {
        ra0 = *(const u32x4*)(pa00); ra1 = *(const u32x4*)(pa01); rb = *(const u32x4*)(pb);
        if (0 >= ksplit) { ra0 = *(const u32x4*)(pa10); ra1 = *(const u32x4*)(pa11); }
    }
    *(u32x4*)(sA + (r0) * G_LDT + kp * 8) = ra0;
    *(u32x4*)(sA + (r1) * G_LDT + kp * 8) = ra1;
    *(u32x4*)(sB + (r0) * G_LDT + kp * 8) = rb;
    __syncthreads();
    for (int kt = 0; kt < nk; ++kt) {
        const int cur = kt & 1;
        if (kt + 1 < nk) {
            const int k0 = (kt + 1) << 5;
            if (k0 < ksplit) { ra0 = *(const u32x4*)(pa00 + k0); ra1 = *(const u32x4*)(pa01 + k0); }
            else { ra0 = *(const u32x4*)(pa10 + (k0 - ksplit)); ra1 = *(const u32x4*)(pa11 + (k0 - ksplit)); }
            rb = *(const u32x4*)(pb + k0);
        }
        const bf16_t* cA = sA + cur * 256 * G_LDT;
        const bf16_t* cB = sB + cur * 128 * G_LDT;
        bf16x8 af[4], bfr[4];
#pragma unroll
        for (int i = 0; i < 4; ++i) af[i] = ldfrag(cA, G_LDT, wm * 64 + i * 16, 0, fr, fq);
#pragma unroll
        for (int j = 0; j < 4; ++j) bfr[j] = ldfrag(cB, G_LDT, wn * 64 + j * 16, 0, fr, fq);
#pragma unroll
        for (int i = 0; i < 4; ++i)
#pragma unroll
            for (int j = 0; j < 4; ++j) acc[i][j] = mma16(bfr[j], af[i], acc[i][j]);
        if (kt + 1 < nk) {
            const int nb = cur ^ 1;
            *(u32x4*)(sA + (nb * 256 + r0) * G_LDT + kp * 8) = ra0;
            *(u32x4*)(sA + (nb * 256 + r1) * G_LDT + kp * 8) = ra1;
            *(u32x4*)(sB + (nb * 128 + r0) * G_LDT + kp * 8) = rb;
        }
        __syncthreads();
    }
    epi(acc, mt * 256 + wm * 64, nt * 128 + wn * 64, fr, fq);
}

struct EpiBf {
    bf16_t* out; int ld, nrows, ncols;
    __device__ __forceinline__ void operator()(const f32x4 (&acc)[4][4], int rb, int cb, int fr, int fq) const {
#pragma unroll
        for (int i = 0; i < 4; ++i) { const int lr = rb + i * 16 + fr; if (lr < nrows) {
#pragma unroll
            for (int j = 0; j < 4; ++j) { const int col = cb + j * 16 + fq * 4; if (col < ncols) st4bf(out + (size_t)lr * ld + col, acc[i][j]); } } }
    }
};
struct EpiSwiglu {
    bf16_t* out; int nrows;
    __device__ __forceinline__ void operator()(const f32x4 (&acc)[4][4], int rb, int cb, int fr, int fq) const {
#pragma unroll
        for (int i = 0; i < 4; ++i) { const int lr = rb + i * 16 + fr; if (lr < nrows) {
#pragma unroll
            for (int j = 0; j < 2; ++j) { const int col = (cb >> 1) + j * 16 + fq * 4; f32x4 g = acc[i][j], u = acc[i][j + 2], o;
#pragma unroll
                for (int r = 0; r < 4; ++r) o[r] = siluf_(g[r]) * u[r];
                st4bf(out + (size_t)lr * 512 + col, o); } } }
    }
};

namespace pg8 {
#define PG8_LAS __attribute__((address_space(3)))
typedef unsigned short bf16_t;
typedef short bf16x8 __attribute__((ext_vector_type(8)));
typedef float f32x4 __attribute__((ext_vector_type(4)));
typedef unsigned u32x4 __attribute__((ext_vector_type(4)));
constexpr int BM = 256, BK = 64, HALF = 128, HTB = HALF * BK * 2  , STAGE_BYTES = 8 * HTB, NXCD = 8, WGM = 8;

__host__ __device__ __forceinline__ int lds_byte(int r, int c) { const int st = (r >> 4) * 2 + (c >> 5), rr = r & 15, cc = c & 31, ob = rr * 64 + cc * 2; return st * 1024 + (ob ^ (((ob >> 9) & 1) << 5)); }
__host__ __device__ __forceinline__ void stage_rc(int b, int& R, int& C) { const int st = b / 1024, sb = b % 1024, swz = sb ^ (((sb >> 9) & 1) << 5); R = (st >> 1) * 16 + swz / 64; C = (st & 1) * 32 + (swz % 64) / 2; }
__host__ __device__ __forceinline__ int perm32(int rho) { const int n = rho >> 4, i = rho & 15; return 8 * (i >> 2) + 4 * n + (i & 3); }

struct Unit { int pm, pn; };
struct Gemm { const bf16_t* A; const bf16_t* Bt; int M, N, K; const bf16_t* A2; int pm_split; int lda, amode; };
#define PG8_ABASE(g, pm) ((g).amode == 1 ? (const char*)(g).A + (size_t)(((pm) >> 3) * 2304 + 256 + ((pm) & 7) * 256) * lda_ * 2 : ((pm) < (g).pm_split ? (const char*)(g).A + (size_t)(pm) * tstepA : (const char*)(g).A2 + (size_t)((pm) - (g).pm_split) * tstepA))
struct StaticOrder {
    int nM, nN, nwg, G, c;
    __host__ __device__ void init(int M, int N, int G_, int c_) { nM = M / BM; nN = N / BM; nwg = nM * nN; G = G_; c = c_; }
    __host__ __device__ bool next(int i, Unit& u) const {
        const long L = (long)i * G + c; if (L >= nwg) return false;
        int wgid = (int)L; { const int q = nwg / NXCD, r = nwg % NXCD, xcd = wgid % NXCD, off = wgid / NXCD; wgid = (xcd < r ? xcd * (q + 1) : r * (q + 1) + (xcd - r) * q) + off; }
        const int nig = WGM * nN, gid = wgid / nig, fm = gid * WGM, gsz = (nM - fm) < WGM ? (nM - fm) : WGM;
        u.pm = fm + ((wgid % nig) % gsz); u.pn = (wgid % nig) / gsz; return true;
    }
    __device__ __forceinline__ void a_ready(const Unit&) const {}
    __device__ __forceinline__ void done(const Unit&) const {}
};
__device__ __forceinline__ unsigned cvt_pk_bf16(float lo, float hi) { unsigned r; asm volatile("v_cvt_pk_bf16_f32 %0, %1, %2" : "=v"(r) : "v"(lo), "v"(hi)); return r; }
typedef float f32x2 __attribute__((ext_vector_type(2)));
template <class Epi, class Sched, bool STAMP = false, bool F8 = false>
__device__ __forceinline__ void gemm_phase(PG8_LAS unsigned char* lds, const Gemm g, const Sched& S, const Epi& E, unsigned long long* stamps) {
    const int tid = otid(), wid = __builtin_amdgcn_readfirstlane(tid >> 6), lane = tid & 63, wr = wid >> 2, wc = wid & 3, fr = lane & 15, fq = lane >> 4;
    const int K = g.K, nt = K / BK, lda_ = g.lda ? g.lda : g.K;
    int ts_lo = 0, ts_hi = 0, nts = 0; const unsigned long long rt_entry = STAMP ? (unsigned long long)wall_clock64() : 0ull;
#define PG8_STAMP() do { if (STAMP && wid == 0 && nts < 64) { const unsigned long long _c = (unsigned long long)clock64(); \
        ts_lo = (lane == nts) ? (int)(unsigned)_c : ts_lo; ts_hi = (lane == nts) ? (int)(unsigned)(_c >> 32) : ts_hi; ++nts; } } while (0)
    PG8_STAMP();
    unsigned voffA[2], voffB[2];
#pragma unroll
    for (int i = 0; i < 2; ++i) { int R, C; stage_rc(tid * 16 + i * 8192, R, C); const int Rb = Epi::PERM ? ((R & ~31) + perm32(R & 31)) : R;
        voffA[i] = (unsigned)(R * lda_ + C) * 2u; voffB[i] = (unsigned)(Rb * K + C) * 2u; }
    const size_t kstep = (size_t)(BK * 2);
    const size_t hstep = (size_t)HALF * K * 2;
    const size_t hstepA = (size_t)HALF * lda_ * 2, tstepA = 2 * hstepA;
    const size_t tstep = 2 * hstep;
    const unsigned ldsw = (unsigned)wid * 1024u;
    const int aoff = lds_byte(wr * 64 + fr, fq * 8), boff = lds_byte(wc * 32 + fr, fq * 8);
#define PG8_SA(b, h) (((b) * 2 + (h)) * HTB)
#define PG8_SB(b, h) ((4 + (b) * 2 + (h)) * HTB)
#define PG8_STAGE(bufoff, gbase, voff) do { _Pragma("unroll") for (int _i = 0; _i < 2; ++_i) \
        __builtin_amdgcn_global_load_lds((const unsigned*)((const char*)(gbase) + (voff)[_i]), (PG8_LAS unsigned*)(lds + (bufoff) + ldsw + _i * 8192), 16, 0, 0); } while (0)
#define PG8_LDA(dst, b, h) do { _Pragma("unroll") for (int m = 0; m < 4; ++m) { \
        if constexpr (F8) { dst##8[m].lo = *(const PG8_LAS v4i_*)(lds + PG8_SA(b, h) + aoff + m * 2048); dst##8[m].hi = *(const PG8_LAS v4i_*)(lds + PG8_SA(b, h) + aoff + m * 2048 + 1024); } \
        else { _Pragma("unroll") for (int k = 0; k < 2; ++k) dst[m][k] = *(const PG8_LAS bf16x8*)(lds + PG8_SA(b, h) + aoff + m * 2048 + k * 1024); } } } while (0)
#define PG8_LDB(dst, b, h) do { _Pragma("unroll") for (int n = 0; n < 2; ++n) { \
        if constexpr (F8) { dst##8[n].lo = *(const PG8_LAS v4i_*)(lds + PG8_SB(b, h) + boff + n * 2048); dst##8[n].hi = *(const PG8_LAS v4i_*)(lds + PG8_SB(b, h) + boff + n * 2048 + 1024); } \
        else { _Pragma("unroll") for (int k = 0; k < 2; ++k) dst[n][k] = *(const PG8_LAS bf16x8*)(lds + PG8_SB(b, h) + boff + n * 2048 + k * 1024); } } } while (0)
#define PG8_MMA(ai, bj, At, Bt) do { __builtin_amdgcn_s_setprio(1); _Pragma("unroll") for (int m = 0; m < 4; ++m) _Pragma("unroll") for (int n = 0; n < 2; ++n) { \
        if constexpr (F8) asm volatile("v_mfma_scale_f32_16x16x128_f8f6f4 %0, %1, %2, %0, %3, %3 op_sel_hi:[0,0,0]" : "+v"(acc[ai][bj][m][n]) : "v"(Bt##8[n]), "v"(At##8[m]), "v"(one_scale)); \
        else { _Pragma("unroll") for (int k = 0; k < 2; ++k) acc[ai][bj][m][n] = __builtin_amdgcn_mfma_f32_16x16x32_bf16(Bt[n][k], At[m][k], acc[ai][bj][m][n], 0, 0, 0); } } \
        __builtin_amdgcn_s_setprio(0); } while (0)
#define PG8_WAIT_V(n) asm volatile("s_waitcnt vmcnt(" #n ")" ::: "memory")
#define PG8_WAIT_L(n) asm volatile("s_waitcnt lgkmcnt(" #n ")" ::: "memory")
#define PG8_BAR __builtin_amdgcn_s_barrier()
#define PG8_SCHED __builtin_amdgcn_sched_barrier(0)
    Unit cur, nxt; int ui = 0;
    if (!S.next(0, cur)) return;
    f32x4 acc[2][2][4][2];
#pragma unroll
    for (int a = 0; a < 2; ++a)
#pragma unroll
        for (int b = 0; b < 2; ++b)
#pragma unroll
            for (int m = 0; m < 4; ++m)
#pragma unroll
                for (int n = 0; n < 2; ++n) acc[a][b][m][n] = (f32x4){0.f, 0.f, 0.f, 0.f};
    bf16x8 At[4][2], B0[2][2], B1[2][2];
    typedef int v4i_ __attribute__((ext_vector_type(4))); typedef int v8i_ __attribute__((ext_vector_type(8)));
    v8i_ At8[4], B08[2], B18[2];
    const int one_scale = 0x7f7f7f7f;
    const char* cA = PG8_ABASE(g, cur.pm); const char* cB = (const char*)g.Bt + (size_t)cur.pn * tstep;
    S.a_ready(cur);
    PG8_STAGE(PG8_SB(0, 0), cB, voffB); PG8_STAGE(PG8_SA(0, 0), cA, voffA); PG8_STAGE(PG8_SB(0, 1), cB + hstep, voffB); PG8_STAGE(PG8_SA(0, 1), cA + hstepA, voffA);
    if (wr == 1) PG8_BAR;
    PG8_WAIT_V(4); PG8_BAR;
    PG8_STAGE(PG8_SB(1, 0), cB + kstep, voffB); PG8_STAGE(PG8_SA(1, 0), cA + kstep, voffA); PG8_STAGE(PG8_SB(1, 1), cB + hstep + kstep, voffB);
    PG8_WAIT_V(6); PG8_BAR;
    PG8_STAMP();
    for (;;) {
        const bool has_next = S.next(ui + 1, nxt);
        const char* nA = has_next ? PG8_ABASE(g, nxt.pm) : cA; const char* nB = has_next ? (const char*)g.Bt + (size_t)nxt.pn * tstep : cB;
#pragma unroll 1
        for (int t = 0; t < nt; t += 2) {
            const bool last = (t == nt - 2);
            const char* a1 = cA + (size_t)(t + 1) * kstep;
            const char* a2 = last ? nA : cA + (size_t)(t + 2) * kstep; const char* b2 = last ? nB : cB + (size_t)(t + 2) * kstep;
            const char* a3 = a2 + kstep; const char* b3 = b2 + kstep;
            if (last && has_next) S.a_ready(nxt);
            PG8_LDB(B0, 0, 0); PG8_SCHED; PG8_LDA(At, 0, 0); PG8_STAGE(PG8_SA(1, 1), a1 + hstepA, voffA);
            PG8_WAIT_L(8); PG8_BAR; PG8_WAIT_L(0); PG8_MMA(0, 0, At, B0); PG8_BAR; PG8_SCHED;
            PG8_LDB(B1, 0, 1); PG8_STAGE(PG8_SB(0, 0), b2, voffB);
            PG8_BAR; PG8_WAIT_L(0); PG8_MMA(0, 1, At, B1); PG8_BAR;
            PG8_LDA(At, 0, 1); PG8_STAGE(PG8_SA(0, 0), a2, voffA);
            PG8_BAR; PG8_WAIT_L(0); PG8_MMA(1, 0, At, B0); PG8_BAR; PG8_SCHED;
            PG8_STAGE(PG8_SB(0, 1), b2 + hstep, voffB);
            PG8_WAIT_V(6); PG8_BAR; PG8_MMA(1, 1, At, B1); PG8_BAR;
            PG8_LDB(B0, 1, 0); PG8_SCHED; PG8_LDA(At, 1, 0); PG8_STAGE(PG8_SA(0, 1), a2 + hstepA, voffA);
            PG8_WAIT_L(8); PG8_BAR; PG8_WAIT_L(0); PG8_MMA(0, 0, At, B0); PG8_BAR; PG8_SCHED;
            PG8_LDB(B1, 1, 1); PG8_STAGE(PG8_SB(1, 0), b3, voffB);
            PG8_BAR; PG8_WAIT_L(0); PG8_MMA(0, 1, At, B1); PG8_BAR;
            PG8_LDA(At, 1, 1); PG8_STAGE(PG8_SA(1, 0), a3, voffA);
            PG8_BAR; PG8_WAIT_L(0); PG8_MMA(1, 0, At, B0); PG8_BAR; PG8_SCHED;
            PG8_STAGE(PG8_SB(1, 1), b3 + hstep, voffB);
            PG8_WAIT_V(6); PG8_BAR; PG8_MMA(1, 1, At, B1); PG8_BAR;
        }
        PG8_STAMP();
        if constexpr (F8) asm volatile("s_nop 15\n\ts_nop 15" ::: "memory");
        if constexpr (!Epi::AFTER_DRAIN) { E(acc, cur, wr, wc, fr, fq); S.done(cur); }
        PG8_STAMP();
        if (!has_next) break;
#pragma unroll
        for (int a = 0; a < 2; ++a)
#pragma unroll
            for (int b = 0; b < 2; ++b)
#pragma unroll
                for (int m = 0; m < 4; ++m)
#pragma unroll
                    for (int n = 0; n < 2; ++n) acc[a][b][m][n] = (f32x4){0.f, 0.f, 0.f, 0.f};
        cur = nxt; cA = nA; cB = nB; ++ui;
    }
    PG8_WAIT_V(0);
    if (wr == 0) PG8_BAR;
    PG8_BAR;
    if constexpr (Epi::AFTER_DRAIN) { E.fused(acc, cur, wr, wc, fr, fq, lds, wid, lane); S.done(cur); }
    PG8_STAMP();
    if (STAMP && wid == 0) { stamps[lane] = lane < nts ? (((unsigned long long)(unsigned)ts_hi << 32) | (unsigned)ts_lo) : 0ull;
        if (lane == 62) stamps[62] = rt_entry; if (lane == 63) stamps[63] = (unsigned long long)wall_clock64(); }
#undef PG8_STAMP
#undef PG8_SA
#undef PG8_SB
#undef PG8_STAGE
#undef PG8_LDA
#undef PG8_LDB
#undef PG8_MMA
#undef PG8_WAIT_V
#undef PG8_WAIT_L
#undef PG8_BAR
#undef PG8_SCHED
}
}
namespace pg8 {
struct EpiBfG {
    static constexpr bool PERM = true, AFTER_DRAIN = false;
    bf16_t* O; int ldc, ncols, pn_mask; float oscale;
    __device__ __forceinline__ void operator()(const f32x4 (&acc)[2][2][4][2], const Unit& u, int wr, int wc, int fr, int fq) const {
        const int row0 = u.pm * BM + wr * 64 + fr, col0 = (u.pn & pn_mask) * BM + wc * 32 + 8 * fq;
#pragma unroll
        for (int ai = 0; ai < 2; ++ai)
#pragma unroll
            for (int m = 0; m < 4; ++m) { bf16_t* rowp = O + (size_t)(row0 + ai * HALF + m * 16) * ldc;
#pragma unroll
                for (int bj = 0; bj < 2; ++bj) { const int c = col0 + bj * HALF;
                    if (c < ncols) { const f32x4 v0 = acc[ai][bj][m][0] * oscale, v1 = acc[ai][bj][m][1] * oscale;
                        u32x4 w; w.x = cvt_pk_bf16(v0[0], v0[1]); w.y = cvt_pk_bf16(v0[2], v0[3]); w.z = cvt_pk_bf16(v1[0], v1[1]); w.w = cvt_pk_bf16(v1[2], v1[3]);
                        *(u32x4*)(rowp + c) = w; } } }
    }
};
struct EpiSwi {
    static constexpr bool PERM = true, AFTER_DRAIN = false;
    bf16_t* H;
    __device__ __forceinline__ void operator()(const f32x4 (&acc)[2][2][4][2], const Unit& u, int wr, int wc, int fr, int fq) const {
        const int row0 = u.pm * BM + wr * 64 + fr, hc0 = (u.pn & 3) * HALF + wc * 32 + 8 * fq;
#pragma unroll
        for (int ai = 0; ai < 2; ++ai)
#pragma unroll
            for (int m = 0; m < 4; ++m) { unsigned char* rowp = (unsigned char*)H + (size_t)(row0 + ai * HALF + m * 16) * 1024 + hc0;
                float o[8];
#pragma unroll
                for (int n = 0; n < 2; ++n)
#pragma unroll
                    for (int r = 0; r < 4; ++r) { const float g = acc[ai][0][m][n][r] * W8_INV; o[n * 4 + r] = g * __builtin_amdgcn_rcpf(1.0f + __expf(-g)) * (acc[ai][1][m][n][r] * W8_INV); }
                u32x2 w; w.x = pack4f8(o[0], o[1], o[2], o[3]); w.y = pack4f8(o[4], o[5], o[6], o[7]);
                *(u32x2*)rowp = w; }
    }
};
struct MoeOrder {
    const int* slotmap; int ntiles, G, c;
    __device__ __forceinline__ bool next(int i, Unit& u) const {
        const int L = i * G + c; if (L >= ntiles * 4) return false;
        u.pm = L >> 2; u.pn = __builtin_amdgcn_readfirstlane(slotmap[L >> 2]) * 4 + (L & 3); return true;
    }
    __device__ __forceinline__ void a_ready(const Unit&) const {}
    __device__ __forceinline__ void done(const Unit&) const {}
};
}
#define WSP(T, off) as_global((T*)(kp.ws + (off)))
#define KIN(i) as_global(kp.in[i])
#define KOUT as_global(kp.out)

PHASE_FN void phase_mod(const KP& kp, unsigned char* lds) {
    float* sc = (float*)lds;
    float* red = sc + 17 * 1024;
    float* modv = WSP(float, WS_MODV);
    const int tid = otid();
    for (int i = tid; i < 17 * 1024; i += 512) { const int bb = i >> 10, k = i & 1023; const float c = bb < 16 ? KIN(1)[bb * 1024 + k] : KIN(3)[k]; sc[i] = siluf_(c); }
    __syncthreads();
    const int jc = tid & 63, ks = tid >> 6;
    for (int u = obid(); u < 192; u += gridDim.x) {
        const int l = u / 96, j0 = (u % 96) * 64;
        const float* w = KIN(4) + (size_t)l * 1024 * 6144 + j0 + jc;
        float acc[17];
#pragma unroll
        for (int bb = 0; bb < 17; ++bb) acc[bb] = 0.f;
        for (int k = ks * 128; k < ks * 128 + 128; ++k) {
            const float wv = w[(size_t)k * 6144];
#pragma unroll
            for (int bb = 0; bb < 17; ++bb) acc[bb] += sc[bb * 1024 + k] * wv;
        }
#pragma unroll
        for (int bb = 0; bb < 17; ++bb) red[(ks * 17 + bb) * 64 + jc] = acc[bb];
        __syncthreads();
        for (int i = tid; i < 17 * 64; i += 512) {
            const int bb = i >> 6, j = i & 63; float s = KIN(5)[l * 6144 + j0 + j];
#pragma unroll
            for (int k2 = 0; k2 < 8; ++k2) s += red[(k2 * 17 + bb) * 64 + j];
            modv[((size_t)l * 17 + bb) * 6144 + j0 + j] = s;
        }
        __syncthreads();
    }
}

struct CvJob { const float* src; bf16_t* dst; int N, ldd, mode, kt, ntile, f8; };
__device__ __forceinline__ bool cv_pick(int& u, CvJob& J, const float* src, int K, int N, bf16_t* dst, int mode = 0, int ldd = -1, int f8 = 0) {
    const int ntl = (N + 63) >> 6, cnt = ntl * (K >> 6);
    if (u < cnt) { J.src = src; J.dst = dst; J.N = N; J.ldd = ldd < 0 ? K : ldd; J.mode = mode; J.kt = u / ntl; J.ntile = u % ntl; J.f8 = f8; return true; }
    u -= cnt; return false;
}
__device__ __forceinline__ void cv_load(const CvJob& J, int tid, f32x4 (&r)[2]) {
#pragma unroll
    for (int i = 0; i < 2; ++i) { const int idx = tid + i * 512, k = idx >> 4, n0 = J.ntile * 64 + (idx & 15) * 4;
        r[i] = (n0 < J.N) ? *(const f32x4*)(J.src + (size_t)(J.kt * 64 + k) * J.N + n0) : (f32x4){0.f, 0.f, 0.f, 0.f}; }
}
__device__ __forceinline__ void cv_put(float* tile, int tid, const f32x4 (&r)[2]) {
#pragma unroll
    for (int i = 0; i < 2; ++i) { const int idx = tid + i * 512, k = idx >> 4, nq = (idx & 15) * 4;
        tile[k * 65 + nq] = r[i][0]; tile[k * 65 + nq + 1] = r[i][1]; tile[k * 65 + nq + 2] = r[i][2]; tile[k * 65 + nq + 3] = r[i][3]; }
}
__device__ __forceinline__ void cv_store(const float* tile, const CvJob& J, int tid) {
    const int nl = tid >> 3, k8 = tid & 7, n = J.ntile * 64 + nl;
    if (n < J.N) { int row = n; if (J.mode) row = (n >> 7) * 256 + (n & 127) + (J.mode == 2 ? 128 : 0);
        const float* tp = tile + (k8 * 8) * 65 + nl;
        if (J.f8) { u32x2 w; w.x = pack4f8(tp[0] * W8_SCALE, tp[65] * W8_SCALE, tp[130] * W8_SCALE, tp[195] * W8_SCALE); w.y = pack4f8(tp[260] * W8_SCALE, tp[325] * W8_SCALE, tp[390] * W8_SCALE, tp[455] * W8_SCALE);
            *(u32x2*)((unsigned char*)J.dst + (size_t)row * J.ldd + J.kt * 64 + k8 * 8) = w; }
        else { u32x4 w; w.x = pack2(tp[0], tp[65]); w.y = pack2(tp[130], tp[195]); w.z = pack2(tp[260], tp[325]); w.w = pack2(tp[390], tp[455]);
            *(u32x4*)(J.dst + (size_t)row * J.ldd + J.kt * 64 + k8 * 8) = w; } }
}
#define CV_RUN(total, PICK) CV_RUN_ON(total, PICK, obid(), (int)gridDim.x)
#define CV_RUN_ON(total, PICK, bid_, nb_) do { float* tile = (float*)lds; const int tid = otid(); const int G_ = (nb_); int u_ = (bid_); CvJob J, Jn; f32x4 r[2]; \
        if (u_ < (total)) { int u = u_; PICK(u, J); cv_load(J, tid, r); } \
        while (u_ < (total)) { cv_put(tile, tid, r); __syncthreads(); const int un_ = u_ + G_; \
            if (un_ < (total)) { int u = un_; PICK(u, Jn); cv_load(Jn, tid, r); } \
            cv_store(tile, J, tid); __syncthreads(); u_ = un_; J = Jn; } } while (0)
PHASE_FN void phase_conv_ab(const KP& kp, unsigned char* lds) {
#define PICK_AB(u, J) do { if (!cv_pick(u, J, KIN(7), 1024, AB_N, WSP(bf16_t, WS_WMIX + WM_AB_IN))) cv_pick(u, J, KIN(8), 2048, 1024, WSP(bf16_t, WS_WMIX + WM_AB_OUT)); } while (0)
    CV_RUN(16 * 85 + 32 * 16, PICK_AB);
#undef PICK_AB
}
PHASE_FN void phase_conv_cd(const KP& kp, unsigned char* lds) {
#define PICK_CD(u, J) do { if (cv_pick(u, J, KIN(18), 1024, CD_N, WSP(bf16_t, WS_WMIX + WM_CD_IN))) break; \
        if (cv_pick(u, J, KIN(19), 1536, 1024, WSP(bf16_t, WS_WMIX + WM_CD_OUT))) break; \
        if (cv_pick(u, J, KIN(21), 384, 768, WSP(bf16_t, WS_WMIX + WM_UQ))) break; \
        if (cv_pick(u, J, KIN(23), 256, 1024, WSP(bf16_t, WS_WMIX + WM_UKV))) break; \
        cv_pick(u, J, KIN(29), 128, 1024, WSP(bf16_t, WS_WMIX + WM_G2)); } while (0)
    CV_RUN(16 * 65 + 24 * 16 + 6 * 12 + 4 * 16 + 2 * 16, PICK_CD);
#undef PICK_CD
}
PHASE_FN void phase_conv_moe(const KP& kp, unsigned char* lds, int l, int bid, int nb) {
#define PICK_MOE(u0, J) do { const int es = (u0) / 384; int uu = (u0) % 384; \
        const float* wg = es < 16 ? KIN(36) + ((size_t)l * 16 + es) * 1024 * 512 : KIN(39) + (size_t)l * 1024 * 512; \
        const float* wu = es < 16 ? KIN(37) + ((size_t)l * 16 + es) * 1024 * 512 : KIN(40) + (size_t)l * 1024 * 512; \
        const float* wd = es < 16 ? KIN(38) + ((size_t)l * 16 + es) * 512 * 1024 : KIN(41) + (size_t)l * 512 * 1024; \
        bf16_t* dup = (bf16_t*)(WSP(unsigned char, WS_BIG + MO_WUP) + (size_t)es * 1024 * 1024); bf16_t* ddn = (bf16_t*)(WSP(unsigned char, WS_BIG + MO_WDN) + (size_t)es * 1024 * 512); \
        if (cv_pick(uu, J, wg, 1024, 512, dup, 1, 1024, 1)) break; if (cv_pick(uu, J, wu, 1024, 512, dup, 2, 1024, 1)) break; cv_pick(uu, J, wd, 512, 1024, ddn, 0, 512, 1); } while (0)
    CV_RUN_ON(17 * 384, PICK_MOE, bid, nb);
#undef PICK_MOE
}

__device__ __forceinline__ const float* hrow_rd(const KP& kp, bool from_inputs, int b, int t) {
    if (t < CTXL) return (from_inputs ? KIN(2) : WSP(const float, WS_HC)) + ((size_t)b * CTXL + t) * D;
    return (from_inputs ? KIN(0) : KOUT) + ((size_t)b * SEQ + (t - CTXL)) * D;
}
__device__ __forceinline__ float* hrow_wr(const KP& kp, int b, int t) {
    if (t < CTXL) return WSP(float, WS_HC) + ((size_t)b * CTXL + t) * D;
    return KOUT + ((size_t)b * SEQ + (t - CTXL)) * D;
}

PHASE_FN void phase_u(const KP& kp, int layer, int g, int bid, int nb, bool to_v) {
    const int lane = otid() & 63, wid = __builtin_amdgcn_readfirstlane(otid() >> 6);
    const float* modv = WSP(const float, WS_MODV) + (size_t)layer * 17 * 6144;
    const float* ng = KIN(6) + (size_t)layer * 4 * 1024;
    bf16_t* U = to_v ? WSP(bf16_t, WS_V) + (size_t)RG * 1024 : WSP(bf16_t, WS_BIG + (layer == 0 ? L0_U : L1_U));
    for (int lr = bid * 8 + wid; lr < RG; lr += nb * 8) {
        const int bl = lr / TT, t = lr - bl * TT, b = g * BG + bl;
        const float* src = hrow_rd(kp, layer == 0, b, t);
        const float* mv = modv + (size_t)(t < CTXL ? 16 : b) * 6144;
        f32x4 x[4]; float ss = 0.f;
#pragma unroll
        for (int i = 0; i < 4; ++i) { x[i] = *(const f32x4*)(src + i * 256 + lane * 4); ss += x[i][0] * x[i][0] + x[i][1] * x[i][1] + x[i][2] * x[i][2] + x[i][3] * x[i][3]; }
        ss = wsum(ss); const float rstd = rsqrtf(ss * (1.0f / 1024.0f) + EPS);
#pragma unroll
        for (int i = 0; i < 4; ++i) { const int col = i * 256 + lane * 4;
            const f32x4 gv = *(const f32x4*)(ng + col), sc = *(const f32x4*)(mv + 1024 + col), sh = *(const f32x4*)(mv + col);
            st4bf(U + (size_t)lr * 1024 + col, x[i] * rstd * gv * (sc + 1.0f) + sh); }
    }
}

PHASE_FN void phase_r(const KP& kp, unsigned char* lds, int layer, int g) {
    const int tid = otid(), lane = tid & 63, wid = __builtin_amdgcn_readfirstlane(tid >> 6);
    float* rw = (float*)lds;
    int* se = (int*)(rw + 1024 * 16);
    int* sbase = se + 160;
    for (int i = tid; i < 1024 * 16; i += 512) rw[i] = KIN(34)[i];
    __syncthreads();
    const float* modv = WSP(const float, WS_MODV) + (size_t)layer * 17 * 6144;
    const float* ng = KIN(6) + (size_t)layer * 4 * 1024;
    const bf16_t* MIX = WSP(const bf16_t, WS_BIG + (layer == 0 ? L0_U : L1_U));
    bf16_t* V = WSP(bf16_t, WS_V);
    unsigned* cnt = WSP(unsigned, CTL_CNT) + layer * 16;
    int* TOKE = WSP(int, WS_TOKE); int* TOKP = WSP(int, WS_TOKP); float* TOKW = WSP(float, WS_TOKW); int* LIST = WSP(int, WS_LIST);
    const int nrows = layer == 0 ? RG : RGL, CH = layer == 0 ? 72 : 64, RW = CH >> 3, nchunks = nrows / CH;
    float rbias[16];
#pragma unroll
    for (int e = 0; e < 16; ++e) rbias[e] = KIN(35)[e];
    for (int ch = obid(); ch < nchunks; ch += gridDim.x) {
        for (int rr = 0; rr < RW; ++rr) {
            const int rl = wid * RW + rr, lr = ch * CH + rl;
            int b, t, tok;
            if (layer == 0) { const int bl = lr / TT; t = lr - bl * TT; b = g * BG + bl; tok = g * RG + lr; }
            else { const int bl = lr >> 11; t = CTXL + (lr & 2047); b = g * BG + bl; tok = g * RGL + lr; }
            const float* hsrc = hrow_rd(kp, layer == 0, b, t);
            float* hdst = hrow_wr(kp, b, t);
            const float* mv = modv + (size_t)(t < CTXL ? 16 : b) * 6144;
            f32x4 y[4], h[4]; float ss = 0.f;
#pragma unroll
            for (int i = 0; i < 4; ++i) { y[i] = ld4bf(MIX + (size_t)lr * 1024 + i * 256 + lane * 4); ss += y[i][0] * y[i][0] + y[i][1] * y[i][1] + y[i][2] * y[i][2] + y[i][3] * y[i][3]; }
            ss = wsum(ss); float rstd = rsqrtf(ss * (1.0f / 1024.0f) + EPS);
            float s2 = 0.f;
#pragma unroll
            for (int i = 0; i < 4; ++i) { const int col = i * 256 + lane * 4;
                const f32x4 g1 = *(const f32x4*)(ng + 1024 + col), ga = *(const f32x4*)(mv + 2048 + col), hx = *(const f32x4*)(hsrc + col);
                h[i] = hx + ga * (y[i] * rstd * g1);
                *(f32x4*)(hdst + col) = h[i];
                s2 += h[i][0] * h[i][0] + h[i][1] * h[i][1] + h[i][2] * h[i][2] + h[i][3] * h[i][3]; }
            s2 = wsum(s2); rstd = rsqrtf(s2 * (1.0f / 1024.0f) + EPS);
            float lg[16];
#pragma unroll
            for (int e = 0; e < 16; ++e) lg[e] = 0.f;
#pragma unroll
            for (int i = 0; i < 4; ++i) { const int col = i * 256 + lane * 4;
                const f32x4 g2 = *(const f32x4*)(ng + 2048 + col), scf = *(const f32x4*)(mv + 4096 + col), shf = *(const f32x4*)(mv + 3072 + col);
                const f32x4 v = h[i] * rstd * g2 * (scf + 1.0f) + shf;
                st4f8((unsigned char*)V + (size_t)tok * 2048 + col, v);
#pragma unroll
                for (int j = 0; j < 4; ++j) {
#pragma unroll
                    for (int q = 0; q < 4; ++q) { const f32x4 w4 = *(const f32x4*)(rw + (col + j) * 16 + q * 4);
                        lg[q * 4 + 0] += v[j] * w4[0]; lg[q * 4 + 1] += v[j] * w4[1]; lg[q * 4 + 2] += v[j] * w4[2]; lg[q * 4 + 3] += v[j] * w4[3]; } } }
#pragma unroll
            for (int e = 0; e < 16; ++e) lg[e] = wsum(lg[e]);
            float aff[16], sel[16];
#pragma unroll
            for (int e = 0; e < 16; ++e) { aff[e] = sigmoidf_(lg[e]); sel[e] = aff[e] + rbias[e]; }
            float gs[4];
#pragma unroll
            for (int gi = 0; gi < 4; ++gi) { const float a0 = sel[gi * 4], a1 = sel[gi * 4 + 1], a2 = sel[gi * 4 + 2], a3 = sel[gi * 4 + 3];
                gs[gi] = fmaxf(fmaxf(fmaxf(a0 + a1, a0 + a2), fmaxf(a0 + a3, a1 + a2)), fmaxf(a1 + a3, a2 + a3)); }
            int gidx = 0; float gb = gs[0];
#pragma unroll
            for (int gi = 1; gi < 4; ++gi) if (gs[gi] > gb) { gb = gs[gi]; gidx = gi; }
            float c[4], f[4];
#pragma unroll
            for (int i = 0; i < 4; ++i) { c[i] = gidx == 0 ? sel[i] : gidx == 1 ? sel[4 + i] : gidx == 2 ? sel[8 + i] : sel[12 + i];
                                           f[i] = gidx == 0 ? aff[i] : gidx == 1 ? aff[4 + i] : gidx == 2 ? aff[8 + i] : aff[12 + i]; }
            int i1 = 0; float cb = c[0];
#pragma unroll
            for (int i = 1; i < 4; ++i) if (c[i] > cb) { cb = c[i]; i1 = i; }
            int i2 = -1; float cb2 = 0.f;
#pragma unroll
            for (int i = 0; i < 4; ++i) if (i != i1 && (i2 < 0 || c[i] > cb2)) { cb2 = c[i]; i2 = i; }
            float w1 = i1 == 0 ? f[0] : i1 == 1 ? f[1] : i1 == 2 ? f[2] : f[3];
            float w2 = i2 == 0 ? f[0] : i2 == 1 ? f[1] : i2 == 2 ? f[2] : f[3];
            const float wsn = 1.0f / (w1 + w2); w1 *= wsn; w2 *= wsn;
            if (lane == 0) { se[rl * 2] = gidx * 4 + i1; se[rl * 2 + 1] = gidx * 4 + i2;
                TOKE[tok * 2] = gidx * 4 + i1; TOKE[tok * 2 + 1] = gidx * 4 + i2; TOKW[tok * 2] = w1; TOKW[tok * 2 + 1] = w2; }
        }
        __syncthreads();
        if (tid < 16) { int c2 = 0; for (int i = 0; i < 2 * CH; ++i) c2 += (se[i] == tid) ? 1 : 0; sbase[tid] = (int)atomicAdd(&cnt[tid], (unsigned)c2); }
        __syncthreads();
        if (tid < 2 * CH) { const int e = se[tid]; int rank = 0; for (int j = 0; j < tid; ++j) rank += (se[j] == e) ? 1 : 0;
            const int pos = sbase[e] + rank; const int lr = ch * CH + (tid >> 1); const int tok = (layer == 0 ? g * RG : g * RGL) + lr;
            LIST[(size_t)e * NTOK + pos] = tok; TOKP[tok * 2 + (tid & 1)] = pos; }
        __syncthreads();
    }
}

__device__ __forceinline__ int moe_tile_prefix(const unsigned* cnt, int ntok, int lane) {
    const int myt = lane < 16 ? (int)((cnt[lane & 15] + 255u) >> 8) : 0; int pref = myt;
#pragma unroll
    for (int o = 1; o < 16; o <<= 1) { const int t = __shfl_up(pref, o); if (lane >= o) pref += t; }
    return pref - myt + ntok / 256;
}
PHASE_FN void phase_moe_gather(const KP& kp, int layer) {
    const int lane = otid() & 63, wid = __builtin_amdgcn_readfirstlane(otid() >> 6);
    const int ntok = layer == 0 ? NTOK : NLAT;
    const int tpre = moe_tile_prefix(WSP(const unsigned, CTL_CNT) + layer * 16, ntok, lane);
    const bf16_t* V = WSP(const bf16_t, WS_V); bf16_t* XG = WSP(bf16_t, WS_BIG + MO_XG);
    const int* TOKE = WSP(const int, WS_TOKE); const int* TOKP = WSP(const int, WS_TOKP);
    for (int it = obid() * 8 + wid; it < 2 * ntok; it += gridDim.x * 8) {
        const int tok = it >> 1, e = TOKE[it], pos = TOKP[it];
        const size_t row = (size_t)(__shfl(tpre, e) - ntok / 256) * 256 + pos;
        const u32x4* src = (const u32x4*)(V + (size_t)tok * 1024) + lane; u32x4* dst = (u32x4*)(XG + row * 1024) + lane;
        dst[0] = src[0];
    }
}
PHASE_FN void phase_moe_gemm(const KP& kp, unsigned char* lds, int layer, bool down) {
    const int tid = otid();
    int* pre = (int*)(lds + pg8::STAGE_BYTES);
    int* slotmap = pre + 32;
    const int ntok = layer == 0 ? NTOK : NLAT;
    const unsigned* cnt = WSP(const unsigned, CTL_CNT) + layer * 16;
    if (tid == 0) { int p = ntok / 256; pre[0] = 0; pre[1] = p; for (int e = 0; e < 16; ++e) { p += ((int)cnt[e] + 255) >> 8; pre[2 + e] = p; } }
    __syncthreads();
    const int ntiles = pre[17];
    for (int t = tid; t < ntiles; t += 512) { int idx = 0; for (int e = 1; e < 17; ++e) if (pre[e] <= t) idx = e; slotmap[t] = idx == 0 ? 16 : idx - 1; }
    __syncthreads();
    pg8::MoeOrder S{slotmap, ntiles, (int)gridDim.x, obid()};
    if (!down) {
        pg8::Gemm g{WSP(const bf16_t, WS_V), WSP(const bf16_t, WS_BIG + MO_WUP), 0, 0, 512, WSP(const bf16_t, WS_BIG + MO_XG), ntok / 256, 1024, 0};
        pg8::EpiSwi E{WSP(bf16_t, WS_BIG + MO_HID)};
        pg8::gemm_phase<pg8::EpiSwi, pg8::MoeOrder, false, true>((PG8_LAS unsigned char*)lds, g, S, E, nullptr);
    } else {
        pg8::Gemm g{WSP(const bf16_t, WS_BIG + MO_HID), WSP(const bf16_t, WS_BIG + MO_WDN), 0, 0, 256, nullptr, 0x7fffffff, 512, 0};
        pg8::EpiBfG E{WSP(bf16_t, WS_BIG + MO_CON), 1024, 1024, 3, W8_INV};
        pg8::gemm_phase<pg8::EpiBfG, pg8::MoeOrder, false, true>((PG8_LAS unsigned char*)lds, g, S, E, nullptr);
    }
    __syncthreads();
}

PHASE_FN void phase_combine(const KP& kp, int layer) {
    const int lane = otid() & 63, wid = __builtin_amdgcn_readfirstlane(otid() >> 6);
    const int ntok = layer == 0 ? NTOK : NLAT;
    const unsigned* cnt = WSP(const unsigned, CTL_CNT) + layer * 16;
    const float* modv = WSP(const float, WS_MODV) + (size_t)layer * 17 * 6144;
    const float* ng = KIN(6) + (size_t)layer * 4 * 1024 + 3 * 1024;
    const bf16_t* CON = WSP(const bf16_t, WS_BIG + MO_CON);
    const int* TOKE = WSP(const int, WS_TOKE); const int* TOKP = WSP(const int, WS_TOKP); const float* TOKW = WSP(const float, WS_TOKW);
    const int tpre = moe_tile_prefix(cnt, ntok, lane);
    for (int tok0 = (obid() * 8 + wid) * 2; tok0 < ntok; tok0 += gridDim.x * 16) {
        int e1[2], e2[2], p1[2], p2[2]; float w1[2], w2[2];
#pragma unroll
        for (int u = 0; u < 2; ++u) { const int tok = tok0 + u; e1[u] = TOKE[tok * 2]; e2[u] = TOKE[tok * 2 + 1]; p1[u] = TOKP[tok * 2]; p2[u] = TOKP[tok * 2 + 1]; w1[u] = TOKW[tok * 2]; w2[u] = TOKW[tok * 2 + 1]; }
        f32x4 f[2][4], hx[2][4]; float* hp[2]; const float* mv[2];
#pragma unroll
        for (int u = 0; u < 2; ++u) { const int tok = tok0 + u;
            const size_t r1 = (size_t)__shfl(tpre, e1[u]) * 256 + p1[u], r2 = (size_t)__shfl(tpre, e2[u]) * 256 + p2[u];
            int b, t;
            if (layer == 0) { b = tok / TT; t = tok - b * TT; } else { b = tok >> 11; t = CTXL + (tok & 2047); }
            hp[u] = hrow_wr(kp, b, t); mv[u] = modv + (size_t)(t < CTXL ? 16 : b) * 6144 + 5 * 1024;
#pragma unroll
            for (int i = 0; i < 4; ++i) { const int col = i * 256 + lane * 4;
                f[u][i] = ld4bf(CON + (size_t)tok * 1024 + col) + ld4bf(CON + r1 * 1024 + col) * w1[u] + ld4bf(CON + r2 * 1024 + col) * w2[u];
                hx[u][i] = *(const f32x4*)(hp[u] + col); } }
#pragma unroll
        for (int u = 0; u < 2; ++u) { float ss = 0.f;
#pragma unroll
            for (int i = 0; i < 4; ++i) ss += f[u][i][0] * f[u][i][0] + f[u][i][1] * f[u][i][1] + f[u][i][2] * f[u][i][2] + f[u][i][3] * f[u][i][3];
            ss = wsum(ss); const float rstd = rsqrtf(ss * (1.0f / 1024.0f) + EPS);
            float s2 = 0.f;
#pragma unroll
            for (int i = 0; i < 4; ++i) { const int col = i * 256 + lane * 4;
                const f32x4 g3 = *(const f32x4*)(ng + col), gf = *(const f32x4*)(mv[u] + col);
                const f32x4 hn = hx[u][i] + gf * (f[u][i] * rstd * g3);
                *(f32x4*)(hp[u] + col) = hn; hx[u][i] = hn;
                s2 += hn[0] * hn[0] + hn[1] * hn[1] + hn[2] * hn[2] + hn[3] * hn[3]; }
            if (layer == 0) {
                s2 = wsum(s2); const float rs2 = rsqrtf(s2 * (1.0f / 1024.0f) + EPS);
                const float* mv1 = mv[u] - 5 * 1024 + 17 * 6144;
                const float* ng1 = KIN(6) + 4 * 1024;
                bf16_t* U1 = WSP(bf16_t, WS_V) + (size_t)(tok0 + u) * 1024;
#pragma unroll
                for (int i = 0; i < 4; ++i) { const int col = i * 256 + lane * 4;
                    const f32x4 gv = *(const f32x4*)(ng1 + col), sc = *(const f32x4*)(mv1 + 1024 + col), sh = *(const f32x4*)(mv1 + col);
                    st4bf(U1 + col, hx[u][i] * rs2 * gv * (sc + 1.0f) + sh); } } }
    }
}

template <int CH>
__device__ __forceinline__ int scan_t(int dir, int ci, int j) {
    constexpr int NC_CTX = CTXL / CH;
    if (!dir) return ci * CH + j;
    return ci < NC_CTX ? (CTXL - 1 - ci * CH - j) : (TT - 1 - (ci - NC_CTX) * CH - j);
}

constexpr int ML_LQ = 136, ML_LT = 72, ML_VR = 144;
PHASE_FN void mlstm_unit(const KP& kp, unsigned char* lds, int bl, int h, int dir, int vh) {
    const int tid = otid();
    bf16_t* Qs = (bf16_t*)lds;
    bf16_t* Ks = Qs + 64 * ML_LQ;
    bf16_t* KTE = Ks + 64 * ML_LQ;
    bf16_t* VT = KTE + 128 * ML_LT;
    bf16_t* Ps = VT + ML_VR * ML_LT;
    bf16_t* Cb = Ps + 64 * ML_LT;
    float* fs = (float*)(Cb + ML_VR * ML_LQ);
    float* s_rowv = fs;
    float* s_colv = fs + 64;
    float* s_wint = fs + 128;
    float* s_emj = fs + 192;
    float* s_E = fs + 256;
    float* s_den = fs + 320;
    float* s_misc = fs + 384;
    const bf16_t* P = WSP(const bf16_t, WS_BIG + L0_P);
    bf16_t* HOUT = WSP(bf16_t, WS_BIG + (dir ? L0_HB : L0_AO)); const int ldh = dir ? 1024 : 2048;
    const float ibias = KIN(9)[dir * 4 + h], fbias = KIN(10)[dir * 4 + h];
    for (int i = tid; i < ML_VR * ML_LQ; i += 512) Cb[i] = 0;
    for (int i = tid; i < 16 * ML_LT; i += 512) VT[128 * ML_LT + i] = (i < ML_LT) ? (bf16_t)0x3f80 : (bf16_t)0;
    f32x4 Cacc[8], Nacc;
#pragma unroll
    for (int i = 0; i < 8; ++i) Cacc[i] = (f32x4){0.f, 0.f, 0.f, 0.f};
    Nacc = (f32x4){0.f, 0.f, 0.f, 0.f};
    float m_state = 0.f;
    u32x4 pq[2], pk[2], pv[2]; bf16_t pgi = 0, pgf = 0;
#define ML_REQ(ci_) do { _Pragma("unroll") for (int i = 0; i < 2; ++i) { const int p = tid + i * 512, j = p >> 4, c8 = p & 15; \
            const bf16_t* pr = P + ((size_t)bl * TT + scan_t<64>(dir, (ci_), j)) * AB_N; \
            pq[i] = *(const u32x4*)(pr + AB_Q + h * 128 + c8 * 8); pk[i] = *(const u32x4*)(pr + AB_K + h * 128 + c8 * 8); \
            const int jv = tid & 63, cv = (tid >> 6) + i * 8; \
            pv[i] = *(const u32x4*)(P + ((size_t)bl * TT + scan_t<64>(dir, (ci_), jv)) * AB_N + AB_V + h * 256 + vh * 128 + cv * 8); } \
        if (tid < 64) { const bf16_t* pg = P + ((size_t)bl * TT + scan_t<64>(dir, (ci_), tid)) * AB_N; pgi = pg[AB_IG + dir * 4 + h]; pgf = pg[AB_FG + dir * 4 + h]; } } while (0)
    ML_REQ(0);
    lds_barrier();
    for (int ci = 0; ci < TT / 64; ++ci) {
        int tq = tid; asm volatile("" : "+v"(tq));
        const int lane = tq & 63, wid = __builtin_amdgcn_readfirstlane(tq >> 6), fr = lane & 15, fq = lane >> 4;
#pragma unroll
        for (int i = 0; i < 2; ++i) {
            const int p = tq + i * 512, j = p >> 4, c8 = p & 15;
            u32x4 q = pq[i];
            const float qs = 0.08838834764831845f;
            q.x = pack2(lo2f(q.x) * qs, hi2f(q.x) * qs); q.y = pack2(lo2f(q.y) * qs, hi2f(q.y) * qs);
            q.z = pack2(lo2f(q.z) * qs, hi2f(q.z) * qs); q.w = pack2(lo2f(q.w) * qs, hi2f(q.w) * qs);
            *(u32x4*)(Qs + j * ML_LQ + c8 * 8) = q;
            *(u32x4*)(Ks + j * ML_LQ + c8 * 8) = pk[i];
            const u32x4 v = pv[i];
            bf16_t* vt = VT + (((tq >> 6) + i * 8) * 8) * ML_LT + (tq & 63);
            vt[0 * ML_LT] = (bf16_t)(v.x & 0xffff); vt[1 * ML_LT] = (bf16_t)(v.x >> 16); vt[2 * ML_LT] = (bf16_t)(v.y & 0xffff); vt[3 * ML_LT] = (bf16_t)(v.y >> 16);
            vt[4 * ML_LT] = (bf16_t)(v.z & 0xffff); vt[5 * ML_LT] = (bf16_t)(v.z >> 16); vt[6 * ML_LT] = (bf16_t)(v.w & 0xffff); vt[7 * ML_LT] = (bf16_t)(v.w >> 16);
        }
        if (wid == 0) {
            const float ig = bf2f(pgi) + ibias;
            const float lf = logsigmoidf_(bf2f(pgf) + fbias);
            float b = lf;
#pragma unroll
            for (int o = 1; o < 64; o <<= 1) { const float t = __shfl_up(b, o); if (lane >= o) b += t; }
            const float u = ig - b; float pm = u;
#pragma unroll
            for (int o = 1; o < 64; o <<= 1) { const float t = __shfl_up(pm, o); if (lane >= o) pm = fmaxf(pm, t); }
            const float mj = fmaxf(b + m_state, b + pm);
            const float b63 = __shfl(b, 63), pm63 = __shfl(pm, 63);
            const float mnew = fmaxf(b63 + m_state, b63 + pm63);
            s_rowv[lane] = b - mj; s_colv[lane] = u; s_wint[lane] = __expf(b + m_state - mj); s_emj[lane] = __expf(-mj);
            s_E[lane] = __expf(b63 + u - mnew);
            if (lane == 0) { s_misc[0] = mnew; s_misc[1] = __expf(b63 + m_state - mnew); }
        }
        if (ci + 1 < TT / 64) ML_REQ(ci + 1);
        lds_barrier();
        {
            const int jt = wid >> 1;
#pragma unroll
            for (int q2 = 0; q2 < 2; ++q2) {
                const int st = (wid & 1) * 2 + q2;
                f32x4 acc = (f32x4){0.f, 0.f, 0.f, 0.f};
                if (st <= jt) {
                    bf16x8 fa[4], fb[4];
#pragma unroll
                    for (int k = 0; k < 4; ++k) { fa[k] = ldfrag(Qs, ML_LQ, jt * 16, k * 32, fr, fq); fb[k] = ldfrag(Ks, ML_LQ, st * 16, k * 32, fr, fq); }
                    __builtin_amdgcn_sched_barrier(0);
                    f32x4 acc2 = (f32x4){0.f, 0.f, 0.f, 0.f};
                    acc = mma16(fa[0], fb[0], acc); acc2 = mma16(fa[1], fb[1], acc2); acc = mma16(fa[2], fb[2], acc); acc2 = mma16(fa[3], fb[3], acc2);
                    acc = acc + acc2;
                }
                const int s = st * 16 + fr; const float cv = s_colv[s];
#pragma unroll
                for (int r = 0; r < 4; ++r) { const int j = jt * 16 + fq * 4 + r;
                    const float pv2 = (s <= j) ? acc[r] * __expf(s_rowv[j] + cv) : 0.f;
                    Ps[j * ML_LT + s] = f2bf(pv2); }
            }
#pragma unroll
            for (int i = 0; i < 2; ++i) {
                const int s = lane, c8 = wid + i * 8; const float e = s_E[s];
                const u32x4 kv = *(const u32x4*)(Ks + s * ML_LQ + c8 * 8);
                bf16_t* kt = KTE + (c8 * 8) * ML_LT + s;
                kt[0 * ML_LT] = f2bf(lo2f(kv.x) * e); kt[1 * ML_LT] = f2bf(hi2f(kv.x) * e); kt[2 * ML_LT] = f2bf(lo2f(kv.y) * e); kt[3 * ML_LT] = f2bf(hi2f(kv.y) * e);
                kt[4 * ML_LT] = f2bf(lo2f(kv.z) * e); kt[5 * ML_LT] = f2bf(hi2f(kv.z) * e); kt[6 * ML_LT] = f2bf(lo2f(kv.w) * e); kt[7 * ML_LT] = f2bf(hi2f(kv.w) * e);
            }
        }
        lds_barrier();
        f32x4 a1[4], a2[4];
        {
            const int jt = wid >> 1;
            bf16x8 fp[2], fqq[4];
#pragma unroll
            for (int k = 0; k < 2; ++k) fp[k] = ldfrag(Ps, ML_LT, jt * 16, k * 32, fr, fq);
#pragma unroll
            for (int k = 0; k < 4; ++k) fqq[k] = ldfrag(Qs, ML_LQ, jt * 16, k * 32, fr, fq);
            {
                bf16x8 fv[4][2];
#pragma unroll
                for (int q4 = 0; q4 < 4; ++q4)
#pragma unroll
                    for (int k = 0; k < 2; ++k) fv[q4][k] = ldfrag(VT, ML_LT, ((wid & 1) * 4 + q4) * 16, k * 32, fr, fq);
                __builtin_amdgcn_sched_barrier(0);
#pragma unroll
                for (int q4 = 0; q4 < 4; ++q4) a1[q4] = (f32x4){0.f, 0.f, 0.f, 0.f};
#pragma unroll
                for (int k = 0; k < 2; ++k)
#pragma unroll
                    for (int q4 = 0; q4 < 4; ++q4) a1[q4] = mma16(fv[q4][k], fp[k], a1[q4]);
            }
#pragma unroll
            for (int hh = 0; hh < 2; ++hh) {
                bf16x8 fc[2][4];
#pragma unroll
                for (int q2 = 0; q2 < 2; ++q2)
#pragma unroll
                    for (int k = 0; k < 4; ++k) fc[q2][k] = ldfrag(Cb, ML_LQ, ((wid & 1) * 4 + hh * 2 + q2) * 16, k * 32, fr, fq);
                __builtin_amdgcn_sched_barrier(0);
                a2[hh * 2] = (f32x4){0.f, 0.f, 0.f, 0.f}; a2[hh * 2 + 1] = (f32x4){0.f, 0.f, 0.f, 0.f};
#pragma unroll
                for (int k = 0; k < 4; ++k) { a2[hh * 2] = mma16(fc[0][k], fqq[k], a2[hh * 2]); a2[hh * 2 + 1] = mma16(fc[1][k], fqq[k], a2[hh * 2 + 1]); }
            }
            if (wid & 1) {
                f32x4 d1 = (f32x4){0.f, 0.f, 0.f, 0.f}, d2 = (f32x4){0.f, 0.f, 0.f, 0.f};
                bf16x8 fo[2], fn[4];
#pragma unroll
                for (int k = 0; k < 2; ++k) fo[k] = ldfrag(VT, ML_LT, 128, k * 32, fr, fq);
#pragma unroll
                for (int k = 0; k < 4; ++k) fn[k] = ldfrag(Cb, ML_LQ, 128, k * 32, fr, fq);
                __builtin_amdgcn_sched_barrier(0);
                d1 = mma16(fo[0], fp[0], d1); d2 = mma16(fn[0], fqq[0], d2); d1 = mma16(fo[1], fp[1], d1); d2 = mma16(fn[1], fqq[1], d2);
                d2 = mma16(fn[2], fqq[2], d2); d2 = mma16(fn[3], fqq[3], d2);
                if (fq == 0) { const int j = jt * 16 + fr; s_den[j] = fmaxf(fabsf(d1[0] + s_wint[j] * d2[0]), s_emj[j]); }
            }
        }
        lds_barrier();
        {
            const int jt = wid >> 1, j = jt * 16 + fr;
            const float wi = s_wint[j], rden = frcp_(s_den[j]);
            const size_t row = (size_t)bl * TT + scan_t<64>(dir, ci, j);
#pragma unroll
            for (int q4 = 0; q4 < 4; ++q4) { const int v0 = ((wid & 1) * 4 + q4) * 16 + fq * 4;
                st4bf(HOUT + row * ldh + h * 256 + vh * 128 + v0, (a1[q4] + a2[q4] * wi) * rden); }
        }
        {
            const float dec = s_misc[1];
            const bf16x8 bv0 = ldfrag(VT, ML_LT, wid * 16, 0, fr, fq), bv1 = ldfrag(VT, ML_LT, wid * 16, 32, fr, fq);
#pragma unroll
            for (int hh = 0; hh < 2; ++hh) {
                bf16x8 fk[4][2];
#pragma unroll
                for (int q = 0; q < 4; ++q) { fk[q][0] = ldfrag(KTE, ML_LT, (hh * 4 + q) * 16, 0, fr, fq); fk[q][1] = ldfrag(KTE, ML_LT, (hh * 4 + q) * 16, 32, fr, fq); }
                __builtin_amdgcn_sched_barrier(0);
#pragma unroll
                for (int q = 0; q < 4; ++q) Cacc[hh * 4 + q] = Cacc[hh * 4 + q] * dec;
#pragma unroll
                for (int q = 0; q < 4; ++q) Cacc[hh * 4 + q] = mma16(fk[q][0], bv0, Cacc[hh * 4 + q]);
#pragma unroll
                for (int q = 0; q < 4; ++q) Cacc[hh * 4 + q] = mma16(fk[q][1], bv1, Cacc[hh * 4 + q]);
#pragma unroll
                for (int q = 0; q < 4; ++q) st4bf(Cb + (wid * 16 + fr) * ML_LQ + (hh * 4 + q) * 16 + fq * 4, Cacc[hh * 4 + q]);
            }
            Nacc = Nacc * dec;
            Nacc = mma16(ldfrag(KTE, ML_LT, wid * 16, 0, fr, fq), ldfrag(VT, ML_LT, 128, 0, fr, fq), Nacc);
            Nacc = mma16(ldfrag(KTE, ML_LT, wid * 16, 32, fr, fq), ldfrag(VT, ML_LT, 128, 32, fr, fq), Nacc);
            st4bf(Cb + (128 + fr) * ML_LQ + wid * 16 + fq * 4, Nacc);
            m_state = s_misc[0];
        }
        lds_barrier();
    }
#undef ML_REQ
}

constexpr size_t L0_XC = L0_U;
static_assert(L0_XC + (size_t)RG * 1280 * 2 <= BIG_BYTES, "xconv buffer");
PHASE_FN void phase_xconv(const KP& kp) {
    const int lane = otid() & 63, wid = __builtin_amdgcn_readfirstlane(otid() >> 6);
    const bf16_t* P = WSP(const bf16_t, WS_BIG + L0_P); bf16_t* XC = WSP(bf16_t, WS_BIG + L0_XC);
    const float* cw = KIN(12); const float* cb = KIN(13);
    constexpr int RUN = 9;
    for (int run = obid() * 8 + wid; run < RG / RUN; run += gridDim.x * 8) {
        const int r0 = run * RUN;
#pragma unroll
        for (int i = 0; i < 5; ++i) { const int col = i * 256 + lane * 4;
            const f32x4 bias = *(const f32x4*)(cb + col);
            f32x4 w[5], x[5];
#pragma unroll
            for (int q = 0; q < 5; ++q) w[q] = *(const f32x4*)(cw + q * 1280 + col);
#pragma unroll
            for (int q = 0; q < 4; ++q) { const int rr = r0 - 2 + q; x[q + 1] = (rr >= 0 && rr < RG) ? ld4bf(P + (size_t)rr * AB_N + AB_XBC + col) : (f32x4){0.f, 0.f, 0.f, 0.f}; }
#pragma unroll
            for (int k = 0; k < RUN; ++k) {
                const int lr = r0 + k, bl = lr / TT, t = lr - bl * TT, lo = t < CTXL ? 0 : CTXL, hi = t < CTXL ? CTXL : TT;
#pragma unroll
                for (int q = 0; q < 4; ++q) x[q] = x[q + 1];
                { const int rr = lr + 2; x[4] = (rr < RG) ? ld4bf(P + (size_t)rr * AB_N + AB_XBC + col) : (f32x4){0.f, 0.f, 0.f, 0.f}; }
                f32x4 a = bias;
#pragma unroll
                for (int q = 0; q < 5; ++q) { const int tt = t - 2 + q; if (tt >= lo && tt < hi) a += w[q] * x[q]; }
                f32x4 o;
#pragma unroll
                for (int r = 0; r < 4; ++r) o[r] = siluf_(a[r]);
                st4bf(XC + (size_t)lr * 1280 + col, o);
            }
        }
    }
}

constexpr int SS_LT = 72, SS_LX = 136;
PHASE_FN void ssd_unit(const KP& kp, unsigned char* lds, int bl, int dir, int hp) {
    const int tid = otid();
    const int gi = hp >> 2, hh0 = hp * 2;
    bf16_t* Wm = (bf16_t*)lds;
    bf16_t* CM = Wm + 2 * 64 * SS_LT;
    bf16_t* BM = CM + 64 * SS_LT;
    bf16_t* Xn = BM + 64 * SS_LT;
    bf16_t* XT = Xn + 64 * SS_LX;
    bf16_t* BTE = XT + 2 * 64 * SS_LT;
    bf16_t* Sb = BTE + 2 * 64 * SS_LT;
    float* fs = (float*)(Sb + 2 * 64 * SS_LT);
    float* s_b = fs;
    float* s_dt = fs + 128;
    float* s_e = fs + 256;
    float* s_misc = fs + 384;
    const bf16_t* P = WSP(const bf16_t, WS_BIG + L0_P); const bf16_t* XC = WSP(const bf16_t, WS_BIG + L0_XC);
    bf16_t* YOUT = WSP(bf16_t, WS_BIG + (dir ? L0_YB : L0_AO + 2048)); const int ldy = dir ? 1024 : 2048;
    for (int i = tid; i < 2 * 64 * SS_LT; i += 512) Sb[i] = 0;
    f32x4 Sacc[4];
#pragma unroll
    for (int i = 0; i < 4; ++i) Sacc[i] = (f32x4){0.f, 0.f, 0.f, 0.f};
    const float dtb = KIN(14)[dir * 16 + hh0 + ((tid >> 6) & 1)], aexp = __expf(KIN(15)[dir * 16 + hh0 + ((tid >> 6) & 1)]);
    const float dskip = KIN(16)[hh0 + (tid >> 8)];
    u32x4 pr[4]; bf16_t pdt = 0;
#define SS_REQ(ci_) do { _Pragma("unroll") for (int q = 0; q < 4; ++q) { const int p = tid + q * 512, j = p >> 5, c8 = p & 31; \
            const int col = c8 < 16 ? hh0 * 64 + c8 * 8 : (c8 < 24 ? 1024 + gi * 64 + (c8 - 16) * 8 : 1152 + gi * 64 + (c8 - 24) * 8); \
            pr[q] = *(const u32x4*)(XC + ((size_t)bl * TT + scan_t<64>(dir, (ci_), j)) * 1280 + col); } \
        if (tid < 128) pdt = P[((size_t)bl * TT + scan_t<64>(dir, (ci_), tid & 63)) * AB_N + AB_DT + dir * 16 + hh0 + (tid >> 6)]; } while (0)
    SS_REQ(0);
    lds_barrier();
    for (int ci = 0; ci < TT / 64; ++ci) {
        int tq = tid; asm volatile("" : "+v"(tq));
        const int lane = tq & 63, wid = __builtin_amdgcn_readfirstlane(tq >> 6), fr = lane & 15, fq = lane >> 4, hl_w = wid >> 2;
#pragma unroll
        for (int q = 0; q < 4; ++q) { const int p = tq + q * 512, j = p >> 5, c8 = p & 31;
            bf16_t* dst = c8 < 16 ? Xn + j * SS_LX + c8 * 8 : (c8 < 24 ? BM + j * SS_LT + (c8 - 16) * 8 : CM + j * SS_LT + (c8 - 24) * 8);
            *(u32x4*)dst = pr[q]; }
        if (wid < 2) {
            const float dt = softplusf_(bf2f(pdt) + dtb);
            float b = -dt * aexp;
#pragma unroll
            for (int o = 1; o < 64; o <<= 1) { const float t = __shfl_up(b, o); if (lane >= o) b += t; }
            const float b63 = __shfl(b, 63);
            s_b[wid * 64 + lane] = b; s_dt[wid * 64 + lane] = dt; s_e[wid * 64 + lane] = __expf(b63 - b) * dt;
            if (lane == 0) s_misc[wid] = __expf(b63);
        }
        if (ci + 1 < TT / 64) SS_REQ(ci + 1);
        lds_barrier();
        {
            const int jt = wid >> 1;
#pragma unroll
            for (int q2 = 0; q2 < 2; ++q2) {
                const int st = (wid & 1) * 2 + q2;
                f32x4 acc = (f32x4){0.f, 0.f, 0.f, 0.f};
                if (st <= jt) {
                    const bf16x8 c0 = ldfrag(CM, SS_LT, jt * 16, 0, fr, fq), c1 = ldfrag(CM, SS_LT, jt * 16, 32, fr, fq), b0 = ldfrag(BM, SS_LT, st * 16, 0, fr, fq), b1 = ldfrag(BM, SS_LT, st * 16, 32, fr, fq);
                    __builtin_amdgcn_sched_barrier(0);
                    acc = mma16(c0, b0, acc); acc = mma16(c1, b1, acc);
                }
                const int s = st * 16 + fr;
#pragma unroll
                for (int hl = 0; hl < 2; ++hl) { const float bs = s_b[hl * 64 + s], ds = s_dt[hl * 64 + s];
#pragma unroll
                    for (int r = 0; r < 4; ++r) { const int j = jt * 16 + fq * 4 + r;
                        const float wv = (s <= j) ? acc[r] * __expf(s_b[hl * 64 + j] - bs) * ds : 0.f;
                        Wm[(hl * 64 + j) * SS_LT + s] = f2bf(wv); } }
            }
            {
                const int s = lane, n8 = wid;
                const u32x4 bv = *(const u32x4*)(BM + s * SS_LT + n8 * 8);
#pragma unroll
                for (int hl = 0; hl < 2; ++hl) { const float e = s_e[hl * 64 + s];
                    bf16_t* bt = BTE + (hl * 64 + n8 * 8) * SS_LT + s;
                    bt[0 * SS_LT] = f2bf(lo2f(bv.x) * e); bt[1 * SS_LT] = f2bf(hi2f(bv.x) * e); bt[2 * SS_LT] = f2bf(lo2f(bv.y) * e); bt[3 * SS_LT] = f2bf(hi2f(bv.y) * e);
                    bt[4 * SS_LT] = f2bf(lo2f(bv.z) * e); bt[5 * SS_LT] = f2bf(hi2f(bv.z) * e); bt[6 * SS_LT] = f2bf(lo2f(bv.w) * e); bt[7 * SS_LT] = f2bf(hi2f(bv.w) * e); }
#pragma unroll
                for (int i = 0; i < 2; ++i) { const int c8 = wid + i * 8;
                    const u32x4 xv = *(const u32x4*)(Xn + s * SS_LX + c8 * 8);
                    bf16_t* xt = XT + (c8 * 8) * SS_LT + s;
                    xt[0 * SS_LT] = (bf16_t)(xv.x & 0xffff); xt[1 * SS_LT] = (bf16_t)(xv.x >> 16); xt[2 * SS_LT] = (bf16_t)(xv.y & 0xffff); xt[3 * SS_LT] = (bf16_t)(xv.y >> 16);
                    xt[4 * SS_LT] = (bf16_t)(xv.z & 0xffff); xt[5 * SS_LT] = (bf16_t)(xv.z >> 16); xt[6 * SS_LT] = (bf16_t)(xv.w & 0xffff); xt[7 * SS_LT] = (bf16_t)(xv.w >> 16); }
            }
        }
        lds_barrier();
        {
            const int hl = hl_w, jt = wid & 3, j = jt * 16 + fr;
            const bf16_t* Wh = Wm + hl * 64 * SS_LT; const bf16_t* Xh = XT + hl * 64 * SS_LT; const bf16_t* Sh = Sb + hl * 64 * SS_LT;
            const float eb = __expf(s_b[hl * 64 + j]);
            const size_t row = (size_t)bl * TT + scan_t<64>(dir, ci, j);
            const bf16x8 w0 = ldfrag(Wh, SS_LT, jt * 16, 0, fr, fq), w1 = ldfrag(Wh, SS_LT, jt * 16, 32, fr, fq), m0 = ldfrag(CM, SS_LT, jt * 16, 0, fr, fq), m1 = ldfrag(CM, SS_LT, jt * 16, 32, fr, fq);
#pragma unroll
            for (int hh = 0; hh < 2; ++hh) {
                bf16x8 fx[2][2], fs2[2][2];
#pragma unroll
                for (int q = 0; q < 2; ++q)
#pragma unroll
                    for (int k = 0; k < 2; ++k) { fx[q][k] = ldfrag(Xh, SS_LT, (hh * 2 + q) * 16, k * 32, fr, fq); fs2[q][k] = ldfrag(Sh, SS_LT, (hh * 2 + q) * 16, k * 32, fr, fq); }
                f32x4 dx[2];
                if (!dir) { dx[0] = ld4bf(Xn + j * SS_LX + hl * 64 + (hh * 2) * 16 + fq * 4); dx[1] = ld4bf(Xn + j * SS_LX + hl * 64 + (hh * 2 + 1) * 16 + fq * 4); }
                __builtin_amdgcn_sched_barrier(0);
                f32x4 y1[2], y2[2];
#pragma unroll
                for (int q = 0; q < 2; ++q) { y1[q] = (f32x4){0.f, 0.f, 0.f, 0.f}; y2[q] = (f32x4){0.f, 0.f, 0.f, 0.f}; }
#pragma unroll
                for (int q = 0; q < 2; ++q) { y1[q] = mma16(fx[q][0], w0, y1[q]); y2[q] = mma16(fs2[q][0], m0, y2[q]); }
#pragma unroll
                for (int q = 0; q < 2; ++q) { y1[q] = mma16(fx[q][1], w1, y1[q]); y2[q] = mma16(fs2[q][1], m1, y2[q]); }
#pragma unroll
                for (int q = 0; q < 2; ++q) { f32x4 y = y1[q] + y2[q] * eb;
                    if (!dir) y = y + dx[q] * dskip;
                    st4bf(YOUT + row * ldy + (hh0 + hl) * 64 + (hh * 2 + q) * 16 + fq * 4, y); }
            }
        }
        lds_barrier();
        {
            const int hl = hl_w, pt = wid & 3; const float eb63 = s_misc[hl];
            const bf16_t* Xh = XT + hl * 64 * SS_LT; const bf16_t* Bh = BTE + hl * 64 * SS_LT; bf16_t* Sh = Sb + hl * 64 * SS_LT;
            const bf16x8 x0 = ldfrag(Xh, SS_LT, pt * 16, 0, fr, fq), x1 = ldfrag(Xh, SS_LT, pt * 16, 32, fr, fq);
            bf16x8 fb[4][2];
#pragma unroll
            for (int nt = 0; nt < 4; ++nt) { fb[nt][0] = ldfrag(Bh, SS_LT, nt * 16, 0, fr, fq); fb[nt][1] = ldfrag(Bh, SS_LT, nt * 16, 32, fr, fq); }
            __builtin_amdgcn_sched_barrier(0);
#pragma unroll
            for (int nt = 0; nt < 4; ++nt) Sacc[nt] = Sacc[nt] * eb63;
#pragma unroll
            for (int nt = 0; nt < 4; ++nt) Sacc[nt] = mma16(fb[nt][0], x0, Sacc[nt]);
#pragma unroll
            for (int nt = 0; nt < 4; ++nt) Sacc[nt] = mma16(fb[nt][1], x1, Sacc[nt]);
#pragma unroll
            for (int nt = 0; nt < 4; ++nt) st4bf(Sh + (pt * 16 + fr) * SS_LT + nt * 16 + fq * 4, Sacc[nt]);
        }
        lds_barrier();
    }
#undef SS_REQ
}

__device__ __forceinline__ void phase_scan_ab(const KP& kp, unsigned char* lds) {
    for (int rep = 0; rep < ((PROBE_DUP & 8192) ? 2 : 1); ++rep)
    for (int u = obid(); u < 256; u += gridDim.x) if (u < 128) { mlstm_unit(kp, lds, u >> 4, (u >> 2) & 3, (u >> 1) & 1, u & 1); __syncthreads(); }
    for (int rep = 0; rep < ((PROBE_DUP & 16384) ? 2 : 1); ++rep)
    for (int u = obid(); u < 256; u += gridDim.x) if (u >= 128) { const int v = u - 128; ssd_unit(kp, lds, v >> 4, (v >> 3) & 1, v & 7); __syncthreads(); }
}

PHASE_FN void phase_fin_ab(const KP& kp) {
    const int lane = otid() & 63, wid = __builtin_amdgcn_readfirstlane(otid() >> 6);
    const bf16_t* P = WSP(const bf16_t, WS_BIG + L0_P);
    bf16_t* AO = WSP(bf16_t, WS_BIG + L0_AO); const bf16_t* HB = WSP(const bf16_t, WS_BIG + L0_HB); const bf16_t* YB = WSP(const bf16_t, WS_BIG + L0_YB);
    const float* mln = KIN(11); const float* sn = KIN(17);
    for (int lr = obid() * 8 + wid; lr < RG; lr += gridDim.x * 8) {
        const bf16_t* pr = P + (size_t)lr * AB_N;
        f32x4 yz[4]; float ss2 = 0.f;
#pragma unroll
        for (int i = 0; i < 4; ++i) { const int col = i * 256 + lane * 4;
            const f32x4 hs = ld4bf(AO + (size_t)lr * 2048 + col) + ld4bf(HB + (size_t)lr * 1024 + col);
            float ss = hs[0] * hs[0] + hs[1] * hs[1] + hs[2] * hs[2] + hs[3] * hs[3];
            ss = wsum(ss); const float rstd = rsqrtf(ss * (1.0f / 256.0f) + EPS);
            const f32x4 og = ld4bf(pr + AB_OG + col), w = *(const f32x4*)(mln + col);
            f32x4 o;
#pragma unroll
            for (int r = 0; r < 4; ++r) o[r] = hs[r] * rstd * w[r] * sigmoidf_(og[r]);
            st4bf(AO + (size_t)lr * 2048 + col, o);
            const f32x4 ys = ld4bf(AO + (size_t)lr * 2048 + 1024 + col) + ld4bf(YB + (size_t)lr * 1024 + col), z = ld4bf(pr + AB_Z + col);
#pragma unroll
            for (int r = 0; r < 4; ++r) { yz[i][r] = ys[r] * siluf_(z[r]); ss2 += yz[i][r] * yz[i][r]; }
        }
        ss2 = wsum(ss2); const float rstd2 = rsqrtf(ss2 * (1.0f / 1024.0f) + EPS);
#pragma unroll
        for (int i = 0; i < 4; ++i) { const int col = i * 256 + lane * 4; st4bf(AO + (size_t)lr * 2048 + 1024 + col, yz[i] * rstd2 * *(const f32x4*)(sn + col)); }
    }
}

PHASE_FN void phase_gemm_in(const KP& kp, unsigned char* lds, int layer, int grp) {
    const int npad = layer == 0 ? AB_NPAD : CD_NPAD, n = layer == 0 ? AB_N : CD_N;
    pg8::Gemm g{(layer == 0 && grp == 0) ? WSP(const bf16_t, WS_BIG + L0_U) : WSP(const bf16_t, WS_V) + (size_t)grp * RG * 1024, WSP(const bf16_t, WS_WMIX), RG, npad, 1024, nullptr, 0x7fffffff};
    pg8::StaticOrder S; S.init(RG, npad, (int)gridDim.x, obid());
    pg8::EpiBfG E{WSP(bf16_t, WS_BIG), n, n, 0x7fffffff, 1.0f};
    pg8::gemm_phase<pg8::EpiBfG, pg8::StaticOrder, false>((PG8_LAS unsigned char*)lds, g, S, E, nullptr);
    __syncthreads();
}
PHASE_FN void phase_gemm_out_ab(const KP& kp, unsigned char* lds, int grp) {
    pg8::Gemm g{WSP(const bf16_t, WS_BIG + L0_AO), WSP(const bf16_t, WS_WMIX + WM_AB_OUT), RG, 1024, 2048, nullptr, 0x7fffffff};
    pg8::StaticOrder S; S.init(RG, 1024, (int)gridDim.x, obid());
    pg8::EpiBfG E{WSP(bf16_t, WS_BIG + L0_U), 1024, 1024, 0x7fffffff, 1.0f};
    pg8::gemm_phase<pg8::EpiBfG, pg8::StaticOrder, false>((PG8_LAS unsigned char*)lds, g, S, E, nullptr);
    __syncthreads();
    const int G = (int)gridDim.x, units = (RG / 256) * 4, two = units > G ? (units - G < G ? units - G : G) : 0;
    const int nb = G - two > 0 ? G - two : G, bid = G - two > 0 ? obid() - two : obid();
    if (bid >= 0) { if (grp == 0) phase_u(kp, 0, 1, bid, nb, true); else phase_conv_moe(kp, lds, 0, bid, nb); }
    __syncthreads();
}

PHASE_FN void phase_prep_cd(const KP& kp) {
    const int lane = otid() & 63, wid = __builtin_amdgcn_readfirstlane(otid() >> 6);
    bf16_t* P = WSP(bf16_t, WS_BIG + L1_P);
    bf16_t* SG = WSP(bf16_t, WS_SG);
    const float* qn = KIN(20); const float* kvn = KIN(22); const float* mu = KIN(24);
    for (int lr = obid() * 8 + wid; lr < RG; lr += gridDim.x * 8) {
        const int bl = lr / TT, t = lr - bl * TT;
        bf16_t* pr = P + (size_t)lr * CD_N;
        {
            const f32x4 x = ld4bf(pr + CD_M1 + lane * 4);
            float ss = x[0] * x[0] + x[1] * x[1] + x[2] * x[2] + x[3] * x[3]; ss = wsum(ss);
            const float rstd = rsqrtf(ss * (1.0f / 256.0f) + EPS);
            st4bf(pr + CD_M1 + lane * 4, x * rstd * *(const f32x4*)(kvn + lane * 4));
        }
        {
            const int lo = t < CTXL ? 0 : CTXL, hi = t < CTXL ? CTXL : TT, c = lane * 4;
            const f32x4 x = ld4bf(pr + CD_WL + c);
            const f32x4 xp = t > lo ? ld4bf(pr - CD_N + CD_WL + c) : (f32x4){0.f, 0.f, 0.f, 0.f};
            const f32x4 xn = t < hi - 1 ? ld4bf(pr + CD_N + CD_WL + c) : (f32x4){0.f, 0.f, 0.f, 0.f};
            f32x4 l = x + *(const f32x4*)(mu + CD_WL - CD_RW0 + c) * ((xp + xn) * 0.5f - x);
            if (c < 128) {
#pragma unroll
                for (int q = 0; q < 4; ++q) l[q] = tanhf_(l[q]); }
            st4bf(WSP(bf16_t, WS_BIG + L1_TWAL) + (size_t)lr * 256 + c, l);
        }
        if (t >= CTXL) {
            const int s = t - CTXL;
            float x0[3], x1[3]; float ss = 0.f;
#pragma unroll
            for (int i = 0; i < 3; ++i) { const unsigned w = *(const unsigned*)(pr + CD_M0 + i * 128 + lane * 2); x0[i] = lo2f(w); x1[i] = hi2f(w); ss += x0[i] * x0[i] + x1[i] * x1[i]; }
            ss = wsum(ss); const float rstd = rsqrtf(ss * (1.0f / 384.0f) + EPS);
#pragma unroll
            for (int i = 0; i < 3; ++i) { const int c = i * 128 + lane * 2; *(unsigned*)(pr + CD_M0 + c) = pack2(x0[i] * rstd * qn[c], x1[i] * rstd * qn[c + 1]); }
            if (lane < 16) {
                const float pos = (lane < 8) ? (float)(s >> 6) : (float)(s & 63);
                const float inv = __expf(-(float)(lane & 7) * (9.210340371976184f / 8.0f));
                float sn, cs; sincosf(pos * inv, &sn, &cs);
                const float a = bf2f(pr[CD_KR + lane]), b2 = bf2f(pr[CD_KR + 16 + lane]);
                pr[CD_KR + lane] = f2bf(a * cs - b2 * sn); pr[CD_KR + 16 + lane] = f2bf(a * sn + b2 * cs);
            }
            {
                const int c = lane * 2;
                const unsigned w = *(const unsigned*)(pr + CD_GL + c);
                const unsigned wp = s > 0 ? *(const unsigned*)(pr - CD_N + CD_GL + c) : 0u;
                const unsigned wn = s < SEQ - 1 ? *(const unsigned*)(pr + CD_N + CD_GL + c) : 0u;
                const float m0 = mu[CD_GL - CD_RW0 + c], m1 = mu[CD_GL - CD_RW0 + c + 1];
                const float g0 = lo2f(w) + m0 * (0.5f * (lo2f(wp) + lo2f(wn)) - lo2f(w));
                const float g1 = hi2f(w) + m1 * (0.5f * (hi2f(wp) + hi2f(wn)) - hi2f(w));
                *(unsigned*)(SG + ((size_t)bl * SEQ + s) * 128 + c) = pack2(sigmoidf_(g0), sigmoidf_(g1));
            }
        }
    }
}

PHASE_FN void phase_upproj(const KP& kp, unsigned char* lds) {
    const bf16_t* P = WSP(const bf16_t, WS_BIG + L1_P);
    {
        pg8::Gemm g{P + CD_M0, WSP(const bf16_t, WS_WMIX + WM_UQ), RGL, 768, 384, nullptr, 0x7fffffff, CD_N, 1};
        pg8::StaticOrder S; S.init(RGL, 768, (int)gridDim.x, obid());
        pg8::EpiBfG E{WSP(bf16_t, WS_BIG + L1_Q), 768, 768, 0x7fffffff, 1.0f};
        pg8::gemm_phase<pg8::EpiBfG, pg8::StaticOrder, false>((PG8_LAS unsigned char*)lds, g, S, E, nullptr);
    }
    __syncthreads();
    {
        pg8::Gemm g{P + CD_M1, WSP(const bf16_t, WS_WMIX + WM_UKV), RG, 1024, 256, nullptr, 0x7fffffff, CD_N, 0};
        pg8::StaticOrder S; S.init(RG, 1024, (int)gridDim.x, obid());
        pg8::EpiBfG E{WSP(bf16_t, WS_BIG + L1_KV), 1024, 1024, 0x7fffffff, 1.0f};
        pg8::gemm_phase<pg8::EpiBfG, pg8::StaticOrder, false>((PG8_LAS unsigned char*)lds, g, S, E, nullptr);
    }
    __syncthreads();
}

constexpr int AT_LQ = 104, AT_LV = 72;
PHASE_FN void attn_unit(const KP& kp, unsigned char* lds, int bl, int head, int qb) {
    const int tid = otid(), lane = tid & 63, wid = __builtin_amdgcn_readfirstlane(tid >> 6), fr = lane & 15, fq = lane >> 4;
    bf16_t* Qs = (bf16_t*)lds;
    bf16_t* Kt = Qs + 256 * AT_LQ;
    bf16_t* Vt = Kt + 2 * 64 * AT_LQ;
    const bf16_t* P = WSP(const bf16_t, WS_BIG + L1_P);
    const bf16_t* Q = WSP(const bf16_t, WS_BIG + L1_Q);
    const bf16_t* KV = WSP(const bf16_t, WS_BIG + L1_KV);
    bf16_t* AOUT = WSP(bf16_t, WS_BIG + L1_AOUT);
    const float SC = 0.10206207261596577f;
#pragma unroll
    for (int i = 0; i < 6; ++i) { const int p = tid + i * 512, r = p / 12, c = p % 12;
        *(u32x4*)(Qs + r * AT_LQ + c * 8) = *(const u32x4*)(Q + ((size_t)bl * SEQ + qb * 256 + r) * 768 + head * 96 + c * 8); }
    lds_barrier();
#pragma unroll
    for (int i = 0; i < 8; ++i) { const int p = tid + i * 512, r = p >> 4, f = p & 15, s = qb * 256 + r;
        const float pos = (f < 8) ? (float)(s >> 6) : (float)(s & 63);
        const float inv = __expf(-(float)(f & 7) * (9.210340371976184f / 8.0f));
        float sn, cs; sincosf(pos * inv, &sn, &cs);
        const float a = bf2f(Qs[r * AT_LQ + 64 + f]), b2 = bf2f(Qs[r * AT_LQ + 80 + f]);
        Qs[r * AT_LQ + 64 + f] = f2bf(a * cs - b2 * sn); Qs[r * AT_LQ + 80 + f] = f2bf(a * sn + b2 * cs); }
    lds_barrier();
    bf16x8 qf[2][3];
#pragma unroll
    for (int rt = 0; rt < 2; ++rt)
#pragma unroll
        for (int k = 0; k < 3; ++k) qf[rt][k] = ldfrag(Qs, AT_LQ, wid * 32 + rt * 16, k * 32, fr, fq);
    f32x4 ot[2][4];
#pragma unroll
    for (int rt = 0; rt < 2; ++rt)
#pragma unroll
        for (int i = 0; i < 4; ++i) ot[rt][i] = (f32x4){0.f, 0.f, 0.f, 0.f};
    float mrow[2] = {-1e30f, -1e30f}, lsum[2] = {0.f, 0.f};
    u32x4 pk0[2], pk1[2], pvv[2];
    const int kkey0 = tid / 12, kc0 = tid % 12, kkey1 = (tid + 512) / 12, kc1 = (tid + 512) % 12, vkey = tid & 63, vc8 = tid >> 6;
#define AT_REQ(kt_) do { _Pragma("unroll") for (int h_ = 0; h_ < 2; ++h_) { const size_t rb_ = (size_t)bl * TT + ((kt_) * 2 + h_) * 64; \
        pk0[h_] = kc0 < 8 ? *(const u32x4*)(KV + (rb_ + kkey0) * 1024 + head * 128 + kc0 * 8) : *(const u32x4*)(P + (rb_ + kkey0) * CD_N + CD_KR + (kc0 - 8) * 8); \
        if (tid < 256) pk1[h_] = kc1 < 8 ? *(const u32x4*)(KV + (rb_ + kkey1) * 1024 + head * 128 + kc1 * 8) : *(const u32x4*)(P + (rb_ + kkey1) * CD_N + CD_KR + (kc1 - 8) * 8); \
        pvv[h_] = *(const u32x4*)(KV + (rb_ + vkey) * 1024 + head * 128 + 64 + vc8 * 8); } } while (0)
    AT_REQ(0);
    const float SC2 = SC * 1.4426950408889634f;
    for (int kt = 0; kt < TT / 128; ++kt) {
        lds_barrier();
#pragma unroll
        for (int h_ = 0; h_ < 2; ++h_) {
            *(u32x4*)(Kt + (h_ * 64 + kkey0) * AT_LQ + kc0 * 8) = pk0[h_];
            if (tid < 256) *(u32x4*)(Kt + (h_ * 64 + kkey1) * AT_LQ + kc1 * 8) = pk1[h_];
            { bf16_t* vt = Vt + (h_ * 64 + vc8 * 8) * AT_LV + vkey; const u32x4 v = pvv[h_];
                vt[0 * AT_LV] = (bf16_t)(v.x & 0xffff); vt[1 * AT_LV] = (bf16_t)(v.x >> 16); vt[2 * AT_LV] = (bf16_t)(v.y & 0xffff); vt[3 * AT_LV] = (bf16_t)(v.y >> 16);
                vt[4 * AT_LV] = (bf16_t)(v.z & 0xffff); vt[5 * AT_LV] = (bf16_t)(v.z >> 16); vt[6 * AT_LV] = (bf16_t)(v.w & 0xffff); vt[7 * AT_LV] = (bf16_t)(v.w >> 16); }
        }
        if (kt + 1 < TT / 128) AT_REQ(kt + 1);
        lds_barrier();
#pragma unroll 1
        for (int hs = 0; hs < 2; ++hs) {
        const bf16_t* Kth = Kt + hs * 64 * AT_LQ; const bf16_t* Vth = Vt + hs * 64 * AT_LV;
        bf16x8 kf[3][4];
#pragma unroll
        for (int k = 0; k < 3; ++k)
#pragma unroll
            for (int kk = 0; kk < 4; ++kk) kf[k][kk] = ldfrag(Kth, AT_LQ, kk * 16, k * 32, fr, fq);
        u32x2 vlo[2][4], vhi[2][4];
#pragma unroll
        for (int k2 = 0; k2 < 2; ++k2)
#pragma unroll
            for (int dvt = 0; dvt < 4; ++dvt) { const bf16_t* vp = Vth + (dvt * 16 + fr) * AT_LV + k2 * 32 + fq * 4; vlo[k2][dvt] = *(const u32x2*)vp; vhi[k2][dvt] = *(const u32x2*)(vp + 16); }
        __builtin_amdgcn_sched_barrier(0);
        f32x4 st[2][4];
#pragma unroll
        for (int rt = 0; rt < 2; ++rt)
#pragma unroll
            for (int kk = 0; kk < 4; ++kk) st[rt][kk] = (f32x4){0.f, 0.f, 0.f, 0.f};
#pragma unroll
        for (int k = 0; k < 3; ++k)
#pragma unroll
            for (int kk = 0; kk < 4; ++kk)
#pragma unroll
                for (int rt = 0; rt < 2; ++rt) st[rt][kk] = mma16(kf[k][kk], qf[rt][k], st[rt][kk]);
        union { bf16x8 v; unsigned u[4]; } pb[2][2];
#pragma unroll
        for (int rt = 0; rt < 2; ++rt) {
            float mx = -1e30f;
#pragma unroll
            for (int kk = 0; kk < 4; ++kk) mx = fmaxf(mx, fmaxf(fmaxf(st[rt][kk][0], st[rt][kk][1]), fmaxf(st[rt][kk][2], st[rt][kk][3])));
            mx = fmaxf(mx, __shfl_xor(mx, 16)); mx = fmaxf(mx, __shfl_xor(mx, 32));
            const float mnew = fmaxf(mrow[rt], mx), mb = mnew * SC2;
            if (__builtin_amdgcn_ballot_w64(mnew > mrow[rt]) != 0ull) {
                const float alpha = __builtin_amdgcn_exp2f((mrow[rt] - mnew) * SC2);
                lsum[rt] *= alpha;
#pragma unroll
                for (int i = 0; i < 4; ++i) ot[rt][i] = ot[rt][i] * alpha;
            }
            mrow[rt] = mnew;
#pragma unroll
            for (int kk = 0; kk < 4; ++kk)
#pragma unroll
                for (int r = 0; r < 4; ++r) { const float pv = __builtin_amdgcn_exp2f(st[rt][kk][r] * SC2 - mb); st[rt][kk][r] = pv; lsum[rt] += pv; }
#pragma unroll
            for (int k2 = 0; k2 < 2; ++k2) {
                pb[rt][k2].u[0] = pack2(st[rt][2 * k2][0], st[rt][2 * k2][1]); pb[rt][k2].u[1] = pack2(st[rt][2 * k2][2], st[rt][2 * k2][3]);
                pb[rt][k2].u[2] = pack2(st[rt][2 * k2 + 1][0], st[rt][2 * k2 + 1][1]); pb[rt][k2].u[3] = pack2(st[rt][2 * k2 + 1][2], st[rt][2 * k2 + 1][3]); }
        }
#pragma unroll
        for (int k2 = 0; k2 < 2; ++k2)
#pragma unroll
            for (int dvt = 0; dvt < 4; ++dvt) { union { bf16x8 v; u32x2 h[2]; } va; va.h[0] = vlo[k2][dvt]; va.h[1] = vhi[k2][dvt];
#pragma unroll
                for (int rt = 0; rt < 2; ++rt) ot[rt][dvt] = mma16(va.v, pb[rt][k2].v, ot[rt][dvt]); }
        }
    }
#undef AT_REQ
#pragma unroll
    for (int rt = 0; rt < 2; ++rt) {
        float ls = lsum[rt]; ls += __shfl_xor(ls, 16); ls += __shfl_xor(ls, 32);
        const float rl = frcp_(ls);
        const size_t orow = (size_t)bl * SEQ + qb * 256 + wid * 32 + rt * 16 + fr;
#pragma unroll
        for (int dvt = 0; dvt < 4; ++dvt) st4bf(AOUT + orow * 1536 + head * 64 + dvt * 16 + fq * 4, ot[rt][dvt] * rl);
    }
}

constexpr int RW_LR = 200, RW_LP = 72;
PHASE_FN void rwkv_unit(const KP& kp, unsigned char* lds, int bl, int h, int dir) {
    const int tid = otid();
    bf16_t* RAW = (bf16_t*)lds;
    bf16_t* TWb = RAW + 34 * RW_LR;
    bf16_t* ALb = TWb + 32 * RW_LP;
    bf16_t* W2T = ALb + 32 * RW_LP;
    bf16_t* A2T = W2T + 64 * RW_LP;
    float* CL = (float*)(A2T + 64 * RW_LP);
    bf16_t* AR = (bf16_t*)(CL + 32 * 64);
    bf16_t* BK = AR + 64 * RW_LP;
    float* AABT = (float*)(BK + 64 * RW_LP);
    bf16_t* ARB = (bf16_t*)(AABT + 32 * 36);
    bf16_t* AAK = ARB + 32 * 40;
    bf16_t* ARK = AAK + 32 * 40;
    float* RHS = (float*)(ARK + 32 * 40);
    float* YB = RHS + 32 * 64;
    bf16_t* ZVT = (bf16_t*)(YB + 32 * 64);
    bf16_t* BKh = ZVT + 64 * RW_LP;
    bf16_t* Sb = BKh + 64 * RW_LP;
    float* PL = (float*)(Sb + 64 * RW_LP);
    const bf16_t* P = WSP(const bf16_t, WS_BIG + L1_P); const bf16_t* TWAL = WSP(const bf16_t, WS_BIG + L1_TWAL);
    bf16_t* OUT = WSP(bf16_t, WS_BIG + (dir ? L1_OB : L1_OF));
    float* BSC = WSP(float, WS_BSC) + (size_t)dir * RGL * 16;
    const float* mu = KIN(24);
    for (int i = tid; i < 64 * 64; i += 512) { const int c = i >> 6, n = i & 63;
        W2T[n * RW_LP + c] = f2bf(KIN(26)[((size_t)dir * 64 + c) * 1024 + h * 64 + n]); A2T[n * RW_LP + c] = f2bf(KIN(28)[((size_t)dir * 64 + c) * 1024 + h * 64 + n]); }
    for (int i = tid; i < 64 * RW_LP; i += 512) Sb[i] = 0;
    float* CV = PL + 64;
    bf16_t* A21b = (bf16_t*)(CV + 8 * 64);
    for (int i = tid; i < 16 * 40; i += 512) A21b[i] = 0;
    for (int i = tid; i < 64 * RW_LP; i += 512) ZVT[i] = 0;
    if (tid < 64) { const int n = tid;
        CV[0 * 64 + n] = KIN(25)[dir * 1024 + h * 64 + n]; CV[1 * 64 + n] = KIN(27)[dir * 1024 + h * 64 + n];
        CV[2 * 64 + n] = KIN(30)[h * 64 + n]; CV[3 * 64 + n] = KIN(31)[h * 64 + n]; CV[4 * 64 + n] = KIN(32)[h * 64 + n];
        CV[5 * 64 + n] = mu[h * 64 + n]; CV[6 * 64 + n] = mu[1024 + h * 64 + n]; CV[7 * 64 + n] = mu[2048 + h * 64 + n]; }
    f32x4 Sacc[2];
    Sacc[0] = (f32x4){0.f, 0.f, 0.f, 0.f}; Sacc[1] = (f32x4){0.f, 0.f, 0.f, 0.f};
    u32x4 pf[3];
#define RW_PREFETCH(cn, tix) do { const int t0n_ = dir ? scan_t<32>(1, (cn), 31) : (cn) * 32; const int lo_ = t0n_ < CTXL ? 0 : CTXL, hi_ = t0n_ < CTXL ? CTXL : TT; \
        _Pragma("unroll") for (int q = 0; q < 2; ++q) { const int p = (tix) + q * 512; pf[q] = (u32x4){0u, 0u, 0u, 0u}; \
            if (p < 34 * 24) { const int rr = p / 24, c = p % 24, t = t0n_ - 1 + rr; \
                if (t >= lo_ && t < hi_) { const int seg = c >> 3, c8 = c & 7; \
                    const int col = (seg == 0 ? CD_R : seg == 1 ? CD_K : CD_V) + h * 64; \
                    pf[q] = *(const u32x4*)(P + ((size_t)bl * TT + t) * CD_N + col + c8 * 8); } } } \
        { const int i_ = (tix) >> 4, c16 = (tix) & 15; \
          pf[2] = *(const u32x4*)(TWAL + ((size_t)bl * TT + t0n_ + i_) * 256 + (c16 >> 3) * 128 + dir * 64 + (c16 & 7) * 8); } } while (0)
    RW_PREFETCH(0, tid);
    lds_barrier();
    for (int ci = 0; ci < TT / 32; ++ci) {
        int tq = tid; asm volatile("" : "+v"(tq));
        const int lane = tq & 63, wid = __builtin_amdgcn_readfirstlane(tq >> 6), fr = lane & 15, fq = lane >> 4, pi = tq >> 4, n4 = (tq & 15) * 4;
        const int t0 = dir ? scan_t<32>(1, ci, 31) : ci * 32;
#pragma unroll
        for (int q = 0; q < 2; ++q) { const int p = tq + q * 512; if (p < 34 * 24) *(u32x4*)(RAW + (p / 24) * RW_LR + (p % 24) * 8) = pf[q]; }
        { const int i_ = tq >> 4, c16 = tq & 15; *(u32x4*)(((c16 >> 3) ? ALb : TWb) + i_ * RW_LP + (c16 & 7) * 8) = pf[2]; }
        if (ci + 1 < TT / 32) RW_PREFETCH(ci + 1, tq);
        lds_barrier();
        {
            const int which = wid >> 2, tt = (wid >> 1) & 1;
            const bf16_t* Xa = which ? ALb : TWb; const bf16_t* Wt = which ? A2T : W2T; float* Od = which ? YB : RHS;
#pragma unroll
            for (int q2 = 0; q2 < 2; ++q2) { const int nt = (wid & 1) * 2 + q2;
                f32x4 acc = (f32x4){0.f, 0.f, 0.f, 0.f};
#pragma unroll
                for (int k = 0; k < 2; ++k) acc = mma16(ldfrag(Xa, RW_LP, tt * 16, k * 32, fr, fq), ldfrag(Wt, RW_LP, nt * 16, k * 32, fr, fq), acc);
#pragma unroll
                for (int rr = 0; rr < 4; ++rr) Od[(tt * 16 + fq * 4 + rr) * 64 + nt * 16 + fr] = acc[rr]; }
        }
        lds_barrier();
        const int j = dir ? 31 - pi : pi;
        f32x4 r, kd, v, av, bv;
        {
            const f32x4 w0v = *(const f32x4*)(CV + n4), a0v = *(const f32x4*)(CV + 64 + n4), kkw = *(const f32x4*)(CV + 128 + n4), kaw = *(const f32x4*)(CV + 192 + n4), rkw = *(const f32x4*)(CV + 256 + n4);
            const f32x4 mur = *(const f32x4*)(CV + 320 + n4), muk = *(const f32x4*)(CV + 384 + n4), muv = *(const f32x4*)(CV + 448 + n4);
            const f32x4 wl = w0v + *(const f32x4*)(RHS + pi * 64 + n4), al = a0v + *(const f32x4*)(YB + pi * 64 + n4);
            const bf16_t* r1 = RAW + (pi + 1) * RW_LR; const bf16_t* rp = RAW + pi * RW_LR; const bf16_t* rn = RAW + (pi + 2) * RW_LR;
            f32x4 k;
            r = ld4bf(r1 + n4); k = ld4bf(r1 + 64 + n4); v = ld4bf(r1 + 128 + n4);
            r = r + mur * ((ld4bf(rp + n4) + ld4bf(rn + n4)) * 0.5f - r);
            k = k + muk * ((ld4bf(rp + 64 + n4) + ld4bf(rn + 64 + n4)) * 0.5f - k);
            v = v + muv * ((ld4bf(rp + 128 + n4) + ld4bf(rn + 128 + n4)) * 0.5f - v);
            f32x4 a, lw, kk = k * kkw;
            float ssq = kk[0] * kk[0] + kk[1] * kk[1] + kk[2] * kk[2] + kk[3] * kk[3];
            ssq += __shfl_xor(ssq, 1); ssq += __shfl_xor(ssq, 2); ssq += __shfl_xor(ssq, 4); ssq += __shfl_xor(ssq, 8);
            kk = kk * __builtin_amdgcn_rsqf(fmaxf(ssq, 1e-24f));
#pragma unroll
            for (int q = 0; q < 4; ++q) { const float wlog = -softplusf_(-wl[q]) - 0.5f; lw[q] = -__expf(wlog); a[q] = sigmoidf_(al[q]); }
            kd = k * ((a - 1.0f) * kaw + 1.0f);
            float bs = r[0] * kd[0] * rkw[0] + r[1] * kd[1] * rkw[1] + r[2] * kd[2] * rkw[2] + r[3] * kd[3] * rkw[3];
            bs += __shfl_xor(bs, 1); bs += __shfl_xor(bs, 2); bs += __shfl_xor(bs, 4); bs += __shfl_xor(bs, 8);
            av = kk * -1.0f; bv = kk * a;
            *(f32x4*)(CL + j * 64 + n4) = lw;
            const int t = t0 + pi;
            if (t >= CTXL && (tq & 15) == 0) BSC[((size_t)bl * SEQ + (t - CTXL)) * 16 + h] = bs;
        }
        lds_barrier();
        if (wid == 0) {
            float c[32];
#pragma unroll
            for (int q = 0; q < 32; ++q) c[q] = CL[q * 64 + lane];
#pragma unroll
            for (int q = 1; q < 32; ++q) c[q] += c[q - 1];
#pragma unroll
            for (int q = 0; q < 32; ++q) CL[q * 64 + lane] = c[q];
            PL[lane] = __expf(c[31]);
        }
        lds_barrier();
        {
            const f32x4 clj = *(const f32x4*)(CL + j * 64 + n4), cle = *(const f32x4*)(CL + 31 * 64 + n4);
            f32x4 clp = (f32x4){0.f, 0.f, 0.f, 0.f};
            if (j > 0) clp = *(const f32x4*)(CL + (j - 1) * 64 + n4);
            f32x4 at, rt, bt, kt, bh, kh;
#pragma unroll
            for (int q = 0; q < 4; ++q) { const float ep = __expf(clp[q]), ej = __expf(clj[q]), ei = __expf(-clj[q]), ee = __expf(cle[q] - clj[q]);
                at[q] = av[q] * ep; rt[q] = r[q] * ej; bt[q] = bv[q] * ei; kt[q] = kd[q] * ei; bh[q] = bv[q] * ee; kh[q] = kd[q] * ee; }
            st4bf(AR + j * RW_LP + n4, at); st4bf(AR + (32 + j) * RW_LP + n4, rt);
            st4bf(BK + j * RW_LP + n4, bt); st4bf(BK + (32 + j) * RW_LP + n4, kt);
#pragma unroll
            for (int q = 0; q < 4; ++q) { BKh[(n4 + q) * RW_LP + j] = f2bf(bh[q]); BKh[(n4 + q) * RW_LP + 32 + j] = f2bf(kh[q]); ZVT[(n4 + q) * RW_LP + 32 + j] = f2bf(v[q]); }
        }
        lds_barrier();
        {
            const int ti = wid >> 1;
#pragma unroll
            for (int q2 = 0; q2 < 2; ++q2) {
                const int si = (wid & 1) * 2 + q2;
                f32x4 acc = (f32x4){0.f, 0.f, 0.f, 0.f};
#pragma unroll
                for (int k = 0; k < 2; ++k) acc = mma16(ldfrag(AR, RW_LP, ti * 16, k * 32, fr, fq), ldfrag(BK, RW_LP, si * 16, k * 32, fr, fq), acc);
                const int sp = si * 16 + fr, s = sp & 31;
#pragma unroll
                for (int rr = 0; rr < 4; ++rr) { const int tp = ti * 16 + fq * 4 + rr, t = tp & 31;
                    const bool incl = tp >= 32;
                    const float val = (incl ? (s <= t) : (s < t)) ? acc[rr] : 0.f;
                    if (sp < 32) { if (incl) ARB[t * 40 + s] = f2bf(val); else { AABT[s * 36 + t] = val; if (t >= 16 && s < 16) A21b[(t - 16) * 40 + s] = f2bf(val); } }
                    else { (incl ? ARK : AAK)[t * 40 + s] = f2bf(val); } }
            }
        }
        lds_barrier();
        {
            const int which = wid >> 2, tt = (wid >> 1) & 1;
            const bf16_t* Ak = which ? ARK : AAK; float* Od = which ? YB : RHS;
#pragma unroll
            for (int q2 = 0; q2 < 2; ++q2) {
                const int vt = (wid & 1) * 2 + q2;
                f32x4 acc = (f32x4){0.f, 0.f, 0.f, 0.f};
#pragma unroll
                for (int k = 0; k < 2; ++k) acc = mma16(ldfrag(AR, RW_LP, which * 32 + tt * 16, k * 32, fr, fq), ldfrag(Sb, RW_LP, vt * 16, k * 32, fr, fq), acc);
                acc = mma16(ldfrag(Ak, 40, tt * 16, 0, fr, fq), ldfrag(ZVT, RW_LP, vt * 16, 32, fr, fq), acc);
#pragma unroll
                for (int rr = 0; rr < 4; ++rr) Od[(tt * 16 + fq * 4 + rr) * 64 + vt * 16 + fr] = acc[rr];
            }
        }
        lds_barrier();
        {
            if (wid == 0) {
                float z[16]; f32x4 ca0, ca1, ca2, ca3, cb0, cb1, cb2, cb3;
#pragma unroll
                for (int t = 0; t < 16; ++t) z[t] = RHS[(0 + t) * 64 + lane];
                ca0 = *(const f32x4*)(AABT + 0 * 36 + 0); ca1 = *(const f32x4*)(AABT + 0 * 36 + 4); ca2 = *(const f32x4*)(AABT + 0 * 36 + 8); ca3 = *(const f32x4*)(AABT + 0 * 36 + 12);
                cb0 = *(const f32x4*)(AABT + 1 * 36 + 0); cb1 = *(const f32x4*)(AABT + 1 * 36 + 4); cb2 = *(const f32x4*)(AABT + 1 * 36 + 8); cb3 = *(const f32x4*)(AABT + 1 * 36 + 12);
                { const float zs = z[0]; z[1] = __builtin_fmaf(ca0[1], zs, z[1]); z[2] = __builtin_fmaf(ca0[2], zs, z[2]); z[3] = __builtin_fmaf(ca0[3], zs, z[3]); z[4] = __builtin_fmaf(ca1[0], zs, z[4]); z[5] = __builtin_fmaf(ca1[1], zs, z[5]); z[6] = __builtin_fmaf(ca1[2], zs, z[6]); z[7] = __builtin_fmaf(ca1[3], zs, z[7]); z[8] = __builtin_fmaf(ca2[0], zs, z[8]); z[9] = __builtin_fmaf(ca2[1], zs, z[9]); z[10] = __builtin_fmaf(ca2[2], zs, z[10]); z[11] = __builtin_fmaf(ca2[3], zs, z[11]); z[12] = __builtin_fmaf(ca3[0], zs, z[12]); z[13] = __builtin_fmaf(ca3[1], zs, z[13]); z[14] = __builtin_fmaf(ca3[2], zs, z[14]); z[15] = __builtin_fmaf(ca3[3], zs, z[15]); }
                asm volatile("" : "+v"(z[1]) :: "memory");
                ca0 = *(const f32x4*)(AABT + 2 * 36 + 0); ca1 = *(const f32x4*)(AABT + 2 * 36 + 4); ca2 = *(const f32x4*)(AABT + 2 * 36 + 8); ca3 = *(const f32x4*)(AABT + 2 * 36 + 12);
                { const float zs = z[1]; z[2] = __builtin_fmaf(cb0[2], zs, z[2]); z[3] = __builtin_fmaf(cb0[3], zs, z[3]); z[4] = __builtin_fmaf(cb1[0], zs, z[4]); z[5] = __builtin_fmaf(cb1[1], zs, z[5]); z[6] = __builtin_fmaf(cb1[2], zs, z[6]); z[7] = __builtin_fmaf(cb1[3], zs, z[7]); z[8] = __builtin_fmaf(cb2[0], zs, z[8]); z[9] = __builtin_fmaf(cb2[1], zs, z[9]); z[10] = __builtin_fmaf(cb2[2], zs, z[10]); z[11] = __builtin_fmaf(cb2[3], zs, z[11]); z[12] = __builtin_fmaf(cb3[0], zs, z[12]); z[13] = __builtin_fmaf(cb3[1], zs, z[13]); z[14] = __builtin_fmaf(cb3[2], zs, z[14]); z[15] = __builtin_fmaf(cb3[3], zs, z[15]); }
                asm volatile("" : "+v"(z[2]) :: "memory");
                cb1 = *(const f32x4*)(AABT + 3 * 36 + 4); cb2 = *(const f32x4*)(AABT + 3 * 36 + 8); cb3 = *(const f32x4*)(AABT + 3 * 36 + 12);
                { const float zs = z[2]; z[3] = __builtin_fmaf(ca0[3], zs, z[3]); z[4] = __builtin_fmaf(ca1[0], zs, z[4]); z[5] = __builtin_fmaf(ca1[1], zs, z[5]); z[6] = __builtin_fmaf(ca1[2], zs, z[6]); z[7] = __builtin_fmaf(ca1[3], zs, z[7]); z[8] = __builtin_fmaf(ca2[0], zs, z[8]); z[9] = __builtin_fmaf(ca2[1], zs, z[9]); z[10] = __builtin_fmaf(ca2[2], zs, z[10]); z[11] = __builtin_fmaf(ca2[3], zs, z[11]); z[12] = __builtin_fmaf(ca3[0], zs, z[12]); z[13] = __builtin_fmaf(ca3[1], zs, z[13]); z[14] = __builtin_fmaf(ca3[2], zs, z[14]); z[15] = __builtin_fmaf(ca3[3], zs, z[15]); }
                asm volatile("" : "+v"(z[3]) :: "memory");
                ca1 = *(const f32x4*)(AABT + 4 * 36 + 4); ca2 = *(const f32x4*)(AABT + 4 * 36 + 8); ca3 = *(const f32x4*)(AABT + 4 * 36 + 12);
                { const float zs = z[3]; z[4] = __builtin_fmaf(cb1[0], zs, z[4]); z[5] = __builtin_fmaf(cb1[1], zs, z[5]); z[6] = __builtin_fmaf(cb1[2], zs, z[6]); z[7] = __builtin_fmaf(cb1[3], zs, z[7]); z[8] = __builtin_fmaf(cb2[0], zs, z[8]); z[9] = __builtin_fmaf(cb2[1], zs, z[9]); z[10] = __builtin_fmaf(cb2[2], zs, z[10]); z[11] = __builtin_fmaf(cb2[3], zs, z[11]); z[12] = __builtin_fmaf(cb3[0], zs, z[12]); z[13] = __builtin_fmaf(cb3[1], zs, z[13]); z[14] = __builtin_fmaf(cb3[2], zs, z[14]); z[15] = __builtin_fmaf(cb3[3], zs, z[15]); }
                asm volatile("" : "+v"(z[4]) :: "memory");
                cb1 = *(const f32x4*)(AABT + 5 * 36 + 4); cb2 = *(const f32x4*)(AABT + 5 * 36 + 8); cb3 = *(const f32x4*)(AABT + 5 * 36 + 12);
                { const float zs = z[4]; z[5] = __builtin_fmaf(ca1[1], zs, z[5]); z[6] = __builtin_fmaf(ca1[2], zs, z[6]); z[7] = __builtin_fmaf(ca1[3], zs, z[7]); z[8] = __builtin_fmaf(ca2[0], zs, z[8]); z[9] = __builtin_fmaf(ca2[1], zs, z[9]); z[10] = __builtin_fmaf(ca2[2], zs, z[10]); z[11] = __builtin_fmaf(ca2[3], zs, z[11]); z[12] = __builtin_fmaf(ca3[0], zs, z[12]); z[13] = __builtin_fmaf(ca3[1], zs, z[13]); z[14] = __builtin_fmaf(ca3[2], zs, z[14]); z[15] = __builtin_fmaf(ca3[3], zs, z[15]); }
                asm volatile("" : "+v"(z[5]) :: "memory");
                ca1 = *(const f32x4*)(AABT + 6 * 36 + 4); ca2 = *(const f32x4*)(AABT + 6 * 36 + 8); ca3 = *(const f32x4*)(AABT + 6 * 36 + 12);
                { const float zs = z[5]; z[6] = __builtin_fmaf(cb1[2], zs, z[6]); z[7] = __builtin_fmaf(cb1[3], zs, z[7]); z[8] = __builtin_fmaf(cb2[0], zs, z[8]); z[9] = __builtin_fmaf(cb2[1], zs, z[9]); z[10] = __builtin_fmaf(cb2[2], zs, z[10]); z[11] = __builtin_fmaf(cb2[3], zs, z[11]); z[12] = __builtin_fmaf(cb3[0], zs, z[12]); z[13] = __builtin_fmaf(cb3[1], zs, z[13]); z[14] = __builtin_fmaf(cb3[2], zs, z[14]); z[15] = __builtin_fmaf(cb3[3], zs, z[15]); }
                asm volatile("" : "+v"(z[6]) :: "memory");
                cb2 = *(const f32x4*)(AABT + 7 * 36 + 8); cb3 = *(const f32x4*)(AABT + 7 * 36 + 12);
                { const float zs = z[6]; z[7] = __builtin_fmaf(ca1[3], zs, z[7]); z[8] = __builtin_fmaf(ca2[0], zs, z[8]); z[9] = __builtin_fmaf(ca2[1], zs, z[9]); z[10] = __builtin_fmaf(ca2[2], zs, z[10]); z[11] = __builtin_fmaf(ca2[3], zs, z[11]); z[12] = __builtin_fmaf(ca3[0], zs, z[12]); z[13] = __builtin_fmaf(ca3[1], zs, z[13]); z[14] = __builtin_fmaf(ca3[2], zs, z[14]); z[15] = __builtin_fmaf(ca3[3], zs, z[15]); }
                asm volatile("" : "+v"(z[7]) :: "memory");
                ca2 = *(const f32x4*)(AABT + 8 * 36 + 8); ca3 = *(const f32x4*)(AABT + 8 * 36 + 12);
                { const float zs = z[7]; z[8] = __builtin_fmaf(cb2[0], zs, z[8]); z[9] = __builtin_fmaf(cb2[1], zs, z[9]); z[10] = __builtin_fmaf(cb2[2], zs, z[10]); z[11] = __builtin_fmaf(cb2[3], zs, z[11]); z[12] = __builtin_fmaf(cb3[0], zs, z[12]); z[13] = __builtin_fmaf(cb3[1], zs, z[13]); z[14] = __builtin_fmaf(cb3[2], zs, z[14]); z[15] = __builtin_fmaf(cb3[3], zs, z[15]); }
                asm volatile("" : "+v"(z[8]) :: "memory");
                cb2 = *(const f32x4*)(AABT + 9 * 36 + 8); cb3 = *(const f32x4*)(AABT + 9 * 36 + 12);
                { const float zs = z[8]; z[9] = __builtin_fmaf(ca2[1], zs, z[9]); z[10] = __builtin_fmaf(ca2[2], zs, z[10]); z[11] = __builtin_fmaf(ca2[3], zs, z[11]); z[12] = __builtin_fmaf(ca3[0], zs, z[12]); z[13] = __builtin_fmaf(ca3[1], zs, z[13]); z[14] = __builtin_fmaf(ca3[2], zs, z[14]); z[15] = __builtin_fmaf(ca3[3], zs, z[15]); }
                asm volatile("" : "+v"(z[9]) :: "memory");
                ca2 = *(const f32x4*)(AABT + 10 * 36 + 8); ca3 = *(const f32x4*)(AABT + 10 * 36 + 12);
                { const float zs = z[9]; z[10] = __builtin_fmaf(cb2[2], zs, z[10]); z[11] = __builtin_fmaf(cb2[3], zs, z[11]); z[12] = __builtin_fmaf(cb3[0], zs, z[12]); z[13] = __builtin_fmaf(cb3[1], zs, z[13]); z[14] = __builtin_fmaf(cb3[2], zs, z[14]); z[15] = __builtin_fmaf(cb3[3], zs, z[15]); }
                asm volatile("" : "+v"(z[10]) :: "memory");
                cb3 = *(const f32x4*)(AABT + 11 * 36 + 12);
                { const float zs = z[10]; z[11] = __builtin_fmaf(ca2[3], zs, z[11]); z[12] = __builtin_fmaf(ca3[0], zs, z[12]); z[13] = __builtin_fmaf(ca3[1], zs, z[13]); z[14] = __builtin_fmaf(ca3[2], zs, z[14]); z[15] = __builtin_fmaf(ca3[3], zs, z[15]); }
                asm volatile("" : "+v"(z[11]) :: "memory");
                ca3 = *(const f32x4*)(AABT + 12 * 36 + 12);
                { const float zs = z[11]; z[12] = __builtin_fmaf(cb3[0], zs, z[12]); z[13] = __builtin_fmaf(cb3[1], zs, z[13]); z[14] = __builtin_fmaf(cb3[2], zs, z[14]); z[15] = __builtin_fmaf(cb3[3], zs, z[15]); }
                asm volatile("" : "+v"(z[12]) :: "memory");
                cb3 = *(const f32x4*)(AABT + 13 * 36 + 12);
                { const float zs = z[12]; z[13] = __builtin_fmaf(ca3[1], zs, z[13]); z[14] = __builtin_fmaf(ca3[2], zs, z[14]); z[15] = __builtin_fmaf(ca3[3], zs, z[15]); }
                asm volatile("" : "+v"(z[13]) :: "memory");
                ca3 = *(const f32x4*)(AABT + 14 * 36 + 12);
                { const float zs = z[13]; z[14] = __builtin_fmaf(cb3[2], zs, z[14]); z[15] = __builtin_fmaf(cb3[3], zs, z[15]); }
                asm volatile("" : "+v"(z[14]) :: "memory");
                { const float zs = z[14]; z[15] = __builtin_fmaf(ca3[3], zs, z[15]); }
                asm volatile("" : "+v"(z[15]) :: "memory");
#pragma unroll
                for (int q = 0; q < 2; ++q) { u32x4 w; w.x = pack2(z[q * 8 + 0], z[q * 8 + 1]); w.y = pack2(z[q * 8 + 2], z[q * 8 + 3]); w.z = pack2(z[q * 8 + 4], z[q * 8 + 5]); w.w = pack2(z[q * 8 + 6], z[q * 8 + 7]);
                    *(u32x4*)(ZVT + lane * RW_LP + 0 + q * 8) = w; }
            }
            lds_barrier();
            if (wid < 4) {
                f32x4 acc = (f32x4){0.f, 0.f, 0.f, 0.f};
                acc = mma16(ldfrag(A21b, 40, 0, 0, fr, fq), ldfrag(ZVT, RW_LP, wid * 16, 0, fr, fq), acc);
#pragma unroll
                for (int rr = 0; rr < 4; ++rr) RHS[(16 + fq * 4 + rr) * 64 + wid * 16 + fr] += acc[rr];
            }
            lds_barrier();
            if (wid == 0) {
                float z[16]; f32x4 ca0, ca1, ca2, ca3, cb0, cb1, cb2, cb3;
#pragma unroll
                for (int t = 0; t < 16; ++t) z[t] = RHS[(16 + t) * 64 + lane];
                ca0 = *(const f32x4*)(AABT + 16 * 36 + 16); ca1 = *(const f32x4*)(AABT + 16 * 36 + 20); ca2 = *(const f32x4*)(AABT + 16 * 36 + 24); ca3 = *(const f32x4*)(AABT + 16 * 36 + 28);
                cb0 = *(const f32x4*)(AABT + 17 * 36 + 16); cb1 = *(const f32x4*)(AABT + 17 * 36 + 20); cb2 = *(const f32x4*)(AABT + 17 * 36 + 24); cb3 = *(const f32x4*)(AABT + 17 * 36 + 28);
                { const float zs = z[0]; z[1] = __builtin_fmaf(ca0[1], zs, z[1]); z[2] = __builtin_fmaf(ca0[2], zs, z[2]); z[3] = __builtin_fmaf(ca0[3], zs, z[3]); z[4] = __builtin_fmaf(ca1[0], zs, z[4]); z[5] = __builtin_fmaf(ca1[1], zs, z[5]); z[6] = __builtin_fmaf(ca1[2], zs, z[6]); z[7] = __builtin_fmaf(ca1[3], zs, z[7]); z[8] = __builtin_fmaf(ca2[0], zs, z[8]); z[9] = __builtin_fmaf(ca2[1], zs, z[9]); z[10] = __builtin_fmaf(ca2[2], zs, z[10]); z[11] = __builtin_fmaf(ca2[3], zs, z[11]); z[12] = __builtin_fmaf(ca3[0], zs, z[12]); z[13] = __builtin_fmaf(ca3[1], zs, z[13]); z[14] = __builtin_fmaf(ca3[2], zs, z[14]); z[15] = __builtin_fmaf(ca3[3], zs, z[15]); }
                asm volatile("" : "+v"(z[1]) :: "memory");
                ca0 = *(const f32x4*)(AABT + 18 * 36 + 16); ca1 = *(const f32x4*)(AABT + 18 * 36 + 20); ca2 = *(const f32x4*)(AABT + 18 * 36 + 24); ca3 = *(const f32x4*)(AABT + 18 * 36 + 28);
                { const float zs = z[1]; z[2] = __builtin_fmaf(cb0[2], zs, z[2]); z[3] = __builtin_fmaf(cb0[3], zs, z[3]); z[4] = __builtin_fmaf(cb1[0], zs, z[4]); z[5] = __builtin_fmaf(cb1[1], zs, z[5]); z[6] = __builtin_fmaf(cb1[2], zs, z[6]); z[7] = __builtin_fmaf(cb1[3], zs, z[7]); z[8] = __builtin_fmaf(cb2[0], zs, z[8]); z[9] = __builtin_fmaf(cb2[1], zs, z[9]); z[10] = __builtin_fmaf(cb2[2], zs, z[10]); z[11] = __builtin_fmaf(cb2[3], zs, z[11]); z[12] = __builtin_fmaf(cb3[0], zs, z[12]); z[13] = __builtin_fmaf(cb3[1], zs, z[13]); z[14] = __builtin_fmaf(cb3[2], zs, z[14]); z[15] = __builtin_fmaf(cb3[3], zs, z[15]); }
                asm volatile("" : "+v"(z[2]) :: "memory");
                cb1 = *(const f32x4*)(AABT + 19 * 36 + 20); cb2 = *(const f32x4*)(AABT + 19 * 36 + 24); cb3 = *(const f32x4*)(AABT + 19 * 36 + 28);
                { const float zs = z[2]; z[3] = __builtin_fmaf(ca0[3], zs, z[3]); z[4] = __builtin_fmaf(ca1[0], zs, z[4]); z[5] = __builtin_fmaf(ca1[1], zs, z[5]); z[6] = __builtin_fmaf(ca1[2], zs, z[6]); z[7] = __builtin_fmaf(ca1[3], zs, z[7]); z[8] = __builtin_fmaf(ca2[0], zs, z[8]); z[9] = __builtin_fmaf(ca2[1], zs, z[9]); z[10] = __builtin_fmaf(ca2[2], zs, z[10]); z[11] = __builtin_fmaf(ca2[3], zs, z[11]); z[12] = __builtin_fmaf(ca3[0], zs, z[12]); z[13] = __builtin_fmaf(ca3[1], zs, z[13]); z[14] = __builtin_fmaf(ca3[2], zs, z[14]); z[15] = __builtin_fmaf(ca3[3], zs, z[15]); }
                asm volatile("" : "+v"(z[3]) :: "memory");
                ca1 = *(const f32x4*)(AABT + 20 * 36 + 20); ca2 = *(const f32x4*)(AABT + 20 * 36 + 24); ca3 = *(const f32x4*)(AABT + 20 * 36 + 28);
                { const float zs = z[3]; z[4] = __builtin_fmaf(cb1[0], zs, z[4]); z[5] = __builtin_fmaf(cb1[1], zs, z[5]); z[6] = __builtin_fmaf(cb1[2], zs, z[6]); z[7] = __builtin_fmaf(cb1[3], zs, z[7]); z[8] = __builtin_fmaf(cb2[0], zs, z[8]); z[9] = __builtin_fmaf(cb2[1], zs, z[9]); z[10] = __builtin_fmaf(cb2[2], zs, z[10]); z[11] = __builtin_fmaf(cb2[3], zs, z[11]); z[12] = __builtin_fmaf(cb3[0], zs, z[12]); z[13] = __builtin_fmaf(cb3[1], zs, z[13]); z[14] = __builtin_fmaf(cb3[2], zs, z[14]); z[15] = __builtin_fmaf(cb3[3], zs, z[15]); }
                asm volatile("" : "+v"(z[4]) :: "memory");
                cb1 = *(const f32x4*)(AABT + 21 * 36 + 20); cb2 = *(const f32x4*)(AABT + 21 * 36 + 24); cb3 = *(const f32x4*)(AABT + 21 * 36 + 28);
                { const float zs = z[4]; z[5] = __builtin_fmaf(ca1[1], zs, z[5]); z[6] = __builtin_fmaf(ca1[2], zs, z[6]); z[7] = __builtin_fmaf(ca1[3], zs, z[7]); z[8] = __builtin_fmaf(ca2[0], zs, z[8]); z[9] = __builtin_fmaf(ca2[1], zs, z[9]); z[10] = __builtin_fmaf(ca2[2], zs, z[10]); z[11] = __builtin_fmaf(ca2[3], zs, z[11]); z[12] = __builtin_fmaf(ca3[0], zs, z[12]); z[13] = __builtin_fmaf(ca3[1], zs, z[13]); z[14] = __builtin_fmaf(ca3[2], zs, z[14]); z[15] = __builtin_fmaf(ca3[3], zs, z[15]); }
                asm volatile("" : "+v"(z[5]) :: "memory");
                ca1 = *(const f32x4*)(AABT + 22 * 36 + 20); ca2 = *(const f32x4*)(AABT + 22 * 36 + 24); ca3 = *(const f32x4*)(AABT + 22 * 36 + 28);
                { const float zs = z[5]; z[6] = __builtin_fmaf(cb1[2], zs, z[6]); z[7] = __builtin_fmaf(cb1[3], zs, z[7]); z[8] = __builtin_fmaf(cb2[0], zs, z[8]); z[9] = __builtin_fmaf(cb2[1], zs, z[9]); z[10] = __builtin_fmaf(cb2[2], zs, z[10]); z[11] = __builtin_fmaf(cb2[3], zs, z[11]); z[12] = __builtin_fmaf(cb3[0], zs, z[12]); z[13] = __builtin_fmaf(cb3[1], zs, z[13]); z[14] = __builtin_fmaf(cb3[2], zs, z[14]); z[15] = __builtin_fmaf(cb3[3], zs, z[15]); }
                asm volatile("" : "+v"(z[6]) :: "memory");
                cb2 = *(const f32x4*)(AABT + 23 * 36 + 24); cb3 = *(const f32x4*)(AABT + 23 * 36 + 28);
                { const float zs = z[6]; z[7] = __builtin_fmaf(ca1[3], zs, z[7]); z[8] = __builtin_fmaf(ca2[0], zs, z[8]); z[9] = __builtin_fmaf(ca2[1], zs, z[9]); z[10] = __builtin_fmaf(ca2[2], zs, z[10]); z[11] = __builtin_fmaf(ca2[3], zs, z[11]); z[12] = __builtin_fmaf(ca3[0], zs, z[12]); z[13] = __builtin_fmaf(ca3[1], zs, z[13]); z[14] = __builtin_fmaf(ca3[2], zs, z[14]); z[15] = __builtin_fmaf(ca3[3], zs, z[15]); }
                asm volatile("" : "+v"(z[7]) :: "memory");
                ca2 = *(const f32x4*)(AABT + 24 * 36 + 24); ca3 = *(const f32x4*)(AABT + 24 * 36 + 28);
                { const float zs = z[7]; z[8] = __builtin_fmaf(cb2[0], zs, z[8]); z[9] = __builtin_fmaf(cb2[1], zs, z[9]); z[10] = __builtin_fmaf(cb2[2], zs, z[10]); z[11] = __builtin_fmaf(cb2[3], zs, z[11]); z[12] = __builtin_fmaf(cb3[0], zs, z[12]); z[13] = __builtin_fmaf(cb3[1], zs, z[13]); z[14] = __builtin_fmaf(cb3[2], zs, z[14]); z[15] = __builtin_fmaf(cb3[3], zs, z[15]); }
                asm volatile("" : "+v"(z[8]) :: "memory");
                cb2 = *(const f32x4*)(AABT + 25 * 36 + 24); cb3 = *(const f32x4*)(AABT + 25 * 36 + 28);
                { const float zs = z[8]; z[9] = __builtin_fmaf(ca2[1], zs, z[9]); z[10] = __builtin_fmaf(ca2[2], zs, z[10]); z[11] = __builtin_fmaf(ca2[3], zs, z[11]); z[12] = __builtin_fmaf(ca3[0], zs, z[12]); z[13] = __builtin_fmaf(ca3[1], zs, z[13]); z[14] = __builtin_fmaf(ca3[2], zs, z[14]); z[15] = __builtin_fmaf(ca3[3], zs, z[15]); }
                asm volatile("" : "+v"(z[9]) :: "memory");
                ca2 = *(const f32x4*)(AABT + 26 * 36 + 24); ca3 = *(const f32x4*)(AABT + 26 * 36 + 28);
                { const float zs = z[9]; z[10] = __builtin_fmaf(cb2[2], zs, z[10]); z[11] = __builtin_fmaf(cb2[3], zs, z[11]); z[12] = __builtin_fmaf(cb3[0], zs, z[12]); z[13] = __builtin_fmaf(cb3[1], zs, z[13]); z[14] = __builtin_fmaf(cb3[2], zs, z[14]); z[15] = __builtin_fmaf(cb3[3], zs, z[15]); }
                asm volatile("" : "+v"(z[10]) :: "memory");
                cb3 = *(const f32x4*)(AABT + 27 * 36 + 28);
                { const float zs = z[10]; z[11] = __builtin_fmaf(ca2[3], zs, z[11]); z[12] = __builtin_fmaf(ca3[0], zs, z[12]); z[13] = __builtin_fmaf(ca3[1], zs, z[13]); z[14] = __builtin_fmaf(ca3[2], zs, z[14]); z[15] = __builtin_fmaf(ca3[3], zs, z[15]); }
                asm volatile("" : "+v"(z[11]) :: "memory");
                ca3 = *(const f32x4*)(AABT + 28 * 36 + 28);
                { const float zs = z[11]; z[12] = __builtin_fmaf(cb3[0], zs, z[12]); z[13] = __builtin_fmaf(cb3[1], zs, z[13]); z[14] = __builtin_fmaf(cb3[2], zs, z[14]); z[15] = __builtin_fmaf(cb3[3], zs, z[15]); }
                asm volatile("" : "+v"(z[12]) :: "memory");
                cb3 = *(const f32x4*)(AABT + 29 * 36 + 28);
                { const float zs = z[12]; z[13] = __builtin_fmaf(ca3[1], zs, z[13]); z[14] = __builtin_fmaf(ca3[2], zs, z[14]); z[15] = __builtin_fmaf(ca3[3], zs, z[15]); }
                asm volatile("" : "+v"(z[13]) :: "memory");
                ca3 = *(const f32x4*)(AABT + 30 * 36 + 28);
                { const float zs = z[13]; z[14] = __builtin_fmaf(cb3[2], zs, z[14]); z[15] = __builtin_fmaf(cb3[3], zs, z[15]); }
                asm volatile("" : "+v"(z[14]) :: "memory");
                { const float zs = z[14]; z[15] = __builtin_fmaf(ca3[3], zs, z[15]); }
                asm volatile("" : "+v"(z[15]) :: "memory");
#pragma unroll
                for (int q = 0; q < 2; ++q) { u32x4 w; w.x = pack2(z[q * 8 + 0], z[q * 8 + 1]); w.y = pack2(z[q * 8 + 2], z[q * 8 + 3]); w.z = pack2(z[q * 8 + 4], z[q * 8 + 5]); w.w = pack2(z[q * 8 + 6], z[q * 8 + 7]);
                    *(u32x4*)(ZVT + lane * RW_LP + 16 + q * 8) = w; }
            }
        }
        lds_barrier();
        {
            const int nt = wid >> 1;
            const f32x4 pl = *(const f32x4*)(PL + nt * 16 + fq * 4);
#pragma unroll
            for (int q2 = 0; q2 < 2; ++q2) {
                const int vt = (wid & 1) * 2 + q2;
                Sacc[q2] = Sacc[q2] * pl;
#pragma unroll
                for (int k = 0; k < 2; ++k) Sacc[q2] = mma16(ldfrag(BKh, RW_LP, nt * 16, k * 32, fr, fq), ldfrag(ZVT, RW_LP, vt * 16, k * 32, fr, fq), Sacc[q2]);
                st4bf(Sb + (vt * 16 + fr) * RW_LP + nt * 16 + fq * 4, Sacc[q2]);
            }
        }
        if (t0 >= CTXL) {
            const int vt = wid >> 1, tt = wid & 1;
            f32x4 acc = (f32x4){0.f, 0.f, 0.f, 0.f};
            acc = mma16(ldfrag(ZVT, RW_LP, vt * 16, 0, fr, fq), ldfrag(ARB, 40, tt * 16, 0, fr, fq), acc);
            const int t = tt * 16 + fr, v0 = vt * 16 + fq * 4;
#pragma unroll
            for (int rr = 0; rr < 4; ++rr) acc[rr] += YB[t * 64 + v0 + rr];
            const int tn = scan_t<32>(dir, ci, t);
            st4bf(OUT + ((size_t)bl * SEQ + (tn - CTXL)) * 1024 + h * 64 + v0, acc);
        }
    }
    lds_barrier();
#undef RW_PREFETCH
}

__device__ __forceinline__ void phase_mix_cd(const KP& kp, unsigned char* lds, int which) {
    if (which & 1) for (int u = obid(); u < 256; u += gridDim.x) { rwkv_unit(kp, lds, u >> 5, (u >> 1) & 15, u & 1); __syncthreads(); }
    if (which & 2) for (int u = obid(); u < 512; u += gridDim.x) { attn_unit(kp, lds, u >> 6, (u >> 3) & 7, u & 7); __syncthreads(); }
}

struct EpiFinCD {
    const bf16_t* OF; const bf16_t* OB; const bf16_t* P; const float* BSC; const float* ln; const float* mu; bf16_t* AOUT;
    __device__ __forceinline__ void operator()(const f32x4 (&acc)[4][4], int rb, int cb, int fr, int fq) const {
        const int head = cb >> 6;
#pragma unroll
        for (int i = 0; i < 4; ++i) { const int lr = rb + i * 16 + fr, s = lr & 2047;
            const size_t prow = (size_t)(lr >> 11) * TT + CTXL + s;
            f32x4 o[4]; float ss = 0.f;
#pragma unroll
            for (int j = 0; j < 4; ++j) { const int col = cb + j * 16 + fq * 4;
                o[j] = ld4bf(OF + (size_t)lr * 1024 + col) + ld4bf(OB + (size_t)lr * 1024 + col);
                ss += o[j][0] * o[j][0] + o[j][1] * o[j][1] + o[j][2] * o[j][2] + o[j][3] * o[j][3]; }
            ss += __shfl_xor(ss, 16); ss += __shfl_xor(ss, 32);
            const float rstd = rsqrtf(ss * (1.0f / 64.0f) + EPS);
            const float bon = BSC[(size_t)lr * 16 + head] + BSC[(size_t)RGL * 16 + (size_t)lr * 16 + head];
#pragma unroll
            for (int j = 0; j < 4; ++j) { const int col = cb + j * 16 + fq * 4;
                const bf16_t* pv = P + prow * CD_N + CD_V + col;
                const f32x4 v = ld4bf(pv);
                const f32x4 vp = s > 0 ? ld4bf(pv - CD_N) : (f32x4){0.f, 0.f, 0.f, 0.f};
                const f32x4 vn = s < SEQ - 1 ? ld4bf(pv + CD_N) : (f32x4){0.f, 0.f, 0.f, 0.f};
                const f32x4 vl = v + *(const f32x4*)(mu + 2048 + col) * ((vp + vn) * 0.5f - v);
                const f32x4 y = o[j] * rstd * *(const f32x4*)(ln + col) + vl * bon;
                st4bf(AOUT + (size_t)lr * 1536 + 512 + col, y * acc[i][j]); }
        }
    }
};
PHASE_FN void phase_fin_cd(const KP& kp, unsigned char* lds) {
    GA ga{WSP(const bf16_t, WS_SG), nullptr, 128, 0, 128, nullptr, RGL, 0, 0};
    EpiFinCD ep{WSP(const bf16_t, WS_BIG + L1_OF), WSP(const bf16_t, WS_BIG + L1_OB), WSP(const bf16_t, WS_BIG + L1_P), WSP(const float, WS_BSC), KIN(33), KIN(24), WSP(bf16_t, WS_BIG + L1_AOUT)};
    for (int u = obid(); u < (RGL / 256) * 8; u += gridDim.x) gemm_tile(lds, ga, WSP(const bf16_t, WS_WMIX + WM_G2), 128, u >> 3, u & 7, ep);
}
PHASE_FN void phase_gemm_out_cd(const KP& kp, unsigned char* lds) {
    pg8::Gemm g{WSP(const bf16_t, WS_BIG + L1_AOUT), WSP(const bf16_t, WS_WMIX + WM_CD_OUT), RGL, 1024, 1536, nullptr, 0x7fffffff};
    pg8::StaticOrder S; S.init(RGL, 1024, (int)gridDim.x, obid());
    pg8::EpiBfG E{WSP(bf16_t, WS_BIG + L1_U), 1024, 1024, 0x7fffffff, 1.0f};
    pg8::gemm_phase<pg8::EpiBfG, pg8::StaticOrder, false>((PG8_LAS unsigned char*)lds, g, S, E, nullptr);
    __syncthreads();
}

__device__ __attribute__((noinline)) void grid_sync(unsigned* barw, unsigned x, volatile LAS unsigned* st) { XcdBarrier b; b.bar = barw; b.x = x; b.st = st; xcd_barrier(b); }
constexpr int N_PHASES = 36;
__global__ void __launch_bounds__(512, 2) fwd_kernel(KP kparg) {
    extern __shared__ __attribute__((aligned(16))) unsigned char lds[];
    const int lo = kparg.ph_lo, hi = kparg.ph_hi;
    const KP& kp = kparg;
    volatile LAS unsigned* xbst = (volatile LAS unsigned*)(LAS unsigned char*)(lds + LDS_BYTES - 16);
    if (threadIdx.x == 0) { xbst[0] = 0u; xbst[1] = 0u; }
    __syncthreads();
    XcdBarrier bar; bar.bar = (unsigned*)kparg.ws; bar.x = 0; bar.st = xbst;
    if (hi - lo > 1) bar = xcd_barrier_post((unsigned*)kparg.ws, xbst);
#define IN(k) (lo <= (k) && (k) < hi)
#define SEAM(k) do { if (IN(k) && IN((k) + 1)) { grid_sync((unsigned*)kp.ws, bar.x, xbst); if (PROBE_DUP & 512) grid_sync((unsigned*)kp.ws, bar.x, xbst); } } while (0)
#define PHASE(...) do { if (IN(ph)) { __VA_ARGS__ } SEAM(ph); ++ph; } while (0)
    int ph = 0;
    PHASE(phase_mod(kp, lds); __syncthreads(); phase_conv_ab(kp, lds); if (PROBE_DUP & 32) { __syncthreads(); phase_mod(kp, lds); __syncthreads(); phase_conv_ab(kp, lds); });
#pragma unroll
    for (int g = 0; g < NG; ++g) {
        if (g == 0) PHASE(phase_u(kp, 0, 0, obid(), (int)gridDim.x, false););
        PHASE(phase_gemm_in(kp, lds, 0, g); if (PROBE_DUP & 8) phase_gemm_in(kp, lds, 0, g););
        PHASE(phase_xconv(kp); if (PROBE_DUP & 2048) phase_xconv(kp););
        PHASE(phase_scan_ab(kp, lds); if (PROBE_DUP & 1) { __syncthreads(); phase_scan_ab(kp, lds); });
        PHASE(phase_fin_ab(kp););
        PHASE(phase_gemm_out_ab(kp, lds, g););
        PHASE(phase_r(kp, lds, 0, g););
    }
    PHASE(phase_moe_gather(kp, 0); phase_conv_cd(kp, lds););
    PHASE(phase_moe_gemm(kp, lds, 0, false); if (PROBE_DUP & 16) { __syncthreads(); phase_moe_gemm(kp, lds, 0, false); });
    PHASE(phase_moe_gemm(kp, lds, 0, true); if (PROBE_DUP & 16) { __syncthreads(); phase_moe_gemm(kp, lds, 0, true); });
    PHASE(phase_combine(kp, 0););
#pragma unroll
    for (int g = 0; g < NG; ++g) {
        PHASE(phase_gemm_in(kp, lds, 1, g); if (PROBE_DUP & 8) phase_gemm_in(kp, lds, 1, g););
        PHASE(phase_prep_cd(kp););
        PHASE(phase_upproj(kp, lds); if (PROBE_DUP & 4096) phase_upproj(kp, lds););
        PHASE(phase_mix_cd(kp, lds, 3); if (PROBE_DUP & 2) { __syncthreads(); phase_mix_cd(kp, lds, 1); } if (PROBE_DUP & 4) { __syncthreads(); phase_mix_cd(kp, lds, 2); });
        PHASE(phase_fin_cd(kp, lds); if (PROBE_DUP & 4096) phase_fin_cd(kp, lds););
        PHASE(phase_gemm_out_cd(kp, lds); if (PROBE_DUP & 256) phase_gemm_out_cd(kp, lds););
        PHASE(phase_r(kp, lds, 1, g););
    }
    PHASE(phase_moe_gather(kp, 1); phase_conv_moe(kp, lds, 1, obid(), (int)gridDim.x););
    PHASE(phase_moe_gemm(kp, lds, 1, false););
    PHASE(phase_moe_gemm(kp, lds, 1, true););
    PHASE(phase_combine(kp, 1););
#undef PHASE
#undef IN
#undef SEAM
}

extern "C" void kernel_launch(void* const* d_in, const int* in_sizes, int n_in, void* d_out, int out_size, void* d_ws, size_t ws_size, hipStream_t stream) {
    static int grid = 0;
    if (grid == 0) {
        if (n_in != 42 || out_size != NLAT * D || ws_size < WS_NEED) { fprintf(stderr, "kernel_launch: unexpected shapes: n_in %d out %d ws %zu (need %zu)\n", n_in, out_size, ws_size, (size_t)WS_NEED); grid = -1; return; }
        int dev = 0, cus = 0, per_cu = 0;
        if (hipGetDevice(&dev) != hipSuccess || hipDeviceGetAttribute(&cus, hipDeviceAttributeMultiprocessorCount, dev) != hipSuccess) { grid = -1; return; }
        if (hipFuncSetAttribute((const void*)fwd_kernel, hipFuncAttributeMaxDynamicSharedMemorySize, LDS_BYTES) != hipSuccess) { fprintf(stderr, "kernel_launch: hipFuncSetAttribute failed\n"); grid = -1; return; }
        if (hipOccupancyMaxActiveBlocksPerMultiprocessor(&per_cu, (const void*)fwd_kernel, 512, LDS_BYTES) != hipSuccess || per_cu < 1) { fprintf(stderr, "kernel_launch: occupancy query says %d blocks per CU\n", per_cu); grid = -1; (void)hipGetLastError(); return; }
        grid = cus;
    }
    if (grid < 0) return;
    (void)hipMemsetAsync(d_ws, 0, CTL_BYTES, stream);
    KP kp{};
    for (int i = 0; i < 42; ++i) kp.in[i] = (const float*)d_in[i];
    kp.out = (float*)d_out; kp.ws = (unsigned char*)d_ws;
#if N_LAUNCH_MODE == 1
    kp.ph_lo = 0; kp.ph_hi = N_PHASES;
    hipLaunchKernelGGL(fwd_kernel, dim3(grid), dim3(512), LDS_BYTES, stream, kp);
#else
    for (int p = 0; p < N_PHASES; ++p) { kp.ph_lo = p; kp.ph_hi = p + 1; hipLaunchKernelGGL(fwd_kernel, dim3(grid), dim3(512), LDS_BYTES, stream, kp); }
#endif
}
```

```cpp
#include <hip/hip_runtime.h>
#include <stdint.h>
#include <stdio.h>

typedef unsigned short bf16_t;
typedef short bf16x8 __attribute__((ext_vector_type(8)));
typedef float f32x4 __attribute__((ext_vector_type(4)));
typedef float f32x2 __attribute__((ext_vector_type(2)));
typedef unsigned u32x4 __attribute__((ext_vector_type(4)));
typedef unsigned u32x2 __attribute__((ext_vector_type(2)));

#ifndef RWP
#define RWP 0
#endif
#ifndef PROBE_DUP
#define PROBE_DUP 0
#endif
#ifndef N_LAUNCH_MODE
#define N_LAUNCH_MODE 1
#endif

constexpr int NB = 16, SEQ = 2048, CTXL = 256, TT = 2304, D = 1024;
constexpr int NTOK = NB * TT, NLAT = NB * SEQ;
constexpr int NG = 2, BG = NB / NG, RG = BG * TT, RGL = BG * SEQ;
constexpr float EPS = 1e-6f;
constexpr int AB_N = 5424, AB_NPAD = 5632, AB_Q = 0, AB_K = 512, AB_V = 1024, AB_OG = 2048, AB_IG = 3072, AB_FG = 3080, AB_Z = 3088, AB_XBC = 4112, AB_DT = 5392;
constexpr int CD_N = 4128, CD_NPAD = 4352, CD_M0 = 0, CD_M1 = 384, CD_KR = 640, CD_R = 672, CD_K = 1696, CD_V = 2720, CD_WL = 3744, CD_AL = 3872, CD_GL = 4000;
constexpr int CD_RW0 = 672;

constexpr size_t CTL_BYTES = 32768;
constexpr size_t CTL_CNT = 16384;
constexpr size_t WS_MODV = CTL_BYTES;
constexpr size_t WS_HC   = WS_MODV + (size_t)2 * 17 * 6144 * 4;
constexpr size_t WS_TOKE = WS_HC + (size_t)NB * CTXL * D * 4;
constexpr size_t WS_TOKP = WS_TOKE + (size_t)NTOK * 2 * 4;
constexpr size_t WS_TOKW = WS_TOKP + (size_t)NTOK * 2 * 4;
constexpr size_t WS_LIST = WS_TOKW + (size_t)NTOK * 2 * 4;
constexpr size_t WS_BSC  = WS_LIST + (size_t)16 * NTOK * 4;
constexpr size_t WS_SG   = WS_BSC + (size_t)2 * RGL * 16 * 4;
constexpr size_t WS_WMIX = WS_SG + (size_t)RGL * 128 * 2;
constexpr size_t WMIX_BYTES = (size_t)16 << 20;
constexpr size_t WS_V    = WS_WMIX + WMIX_BYTES;
constexpr size_t WS_BIG  = WS_V + (size_t)NTOK * D * 2;
constexpr size_t WM_AB_IN = 0, WM_AB_OUT = (size_t)AB_NPAD * 1024 * 2;
constexpr size_t WM_CD_IN = 0, WM_CD_OUT = (size_t)CD_NPAD * 1024 * 2, WM_UQ = WM_CD_OUT + (size_t)1024 * 1536 * 2, WM_UKV = WM_UQ + (size_t)768 * 384 * 2, WM_G2 = WM_UKV + (size_t)1024 * 256 * 2;
static_assert(WM_AB_OUT + (size_t)1024 * 2048 * 2 <= WMIX_BYTES, "wmix ab");
static_assert(WM_G2 + (size_t)1024 * 128 * 2 <= WMIX_BYTES, "wmix cd");
constexpr size_t SZ_RG1K = (size_t)RG * 1024 * 2, SZ_RGL1K = (size_t)RGL * 1024 * 2;
constexpr size_t L0_P = 0, L0_AO = (size_t)RG * AB_N * 2  , L0_HB = L0_AO + 2 * SZ_RG1K, L0_YB = L0_HB + SZ_RG1K, L0_U = L0_YB + SZ_RG1K, L0_END = L0_U + SZ_RG1K;
constexpr size_t L1_P = 0, L1_Q = (size_t)RG * CD_N * 2, L1_KV = L1_Q + (size_t)RGL * 768 * 2, L1_OF = L1_KV + SZ_RG1K, L1_OB = L1_OF + SZ_RGL1K, L1_AOUT = L1_OB + SZ_RGL1K, L1_U = L1_AOUT + (size_t)RGL * 1536 * 2, L1_TWAL = L1_U + SZ_RG1K  , L1_END = L1_TWAL + (size_t)RG * 256 * 2;
constexpr int MOE_PADROWS = 16 * 256;
constexpr size_t MO_WUP = 0, MO_WDN = (size_t)17 * 1024 * 1024 * 2, MO_HID = MO_WDN + (size_t)17 * 1024 * 512 * 2;
constexpr size_t MO_XG = MO_HID + (size_t)(3 * NTOK + MOE_PADROWS) * 512 * 2;
constexpr size_t MO_CON = MO_XG, MO_END = MO_CON + (size_t)(3 * NTOK + MOE_PADROWS) * 1024 * 2;
constexpr size_t BIG_BYTES = MO_END > L0_END ? (MO_END > L1_END ? MO_END : L1_END) : (L0_END > L1_END ? L0_END : L1_END);
constexpr size_t WS_NEED = WS_BIG + BIG_BYTES;

constexpr int LDS_BYTES = 151552;

__device__ __forceinline__ float bf2f(unsigned short h) { return __uint_as_float(((unsigned)h) << 16); }
typedef __bf16 bf16v2_t __attribute__((ext_vector_type(2)));
__device__ __forceinline__ unsigned pack2(float a, float b) { const bf16v2_t h = __builtin_convertvector((f32x2){a, b}, bf16v2_t); return __builtin_bit_cast(unsigned, h); }
__device__ __forceinline__ unsigned short f2bf(float f) { const __bf16 h = (__bf16)f; return __builtin_bit_cast(unsigned short, h); }
__device__ __forceinline__ float lo2f(unsigned w) { return __uint_as_float(w << 16); }
__device__ __forceinline__ float hi2f(unsigned w) { return __uint_as_float(w & 0xffff0000u); }
__device__ __forceinline__ float wsum(float v) {
#pragma unroll
    for (int o = 32; o; o >>= 1) v += __shfl_xor(v, o);
    return v; }
template <int CTRL> __device__ __forceinline__ float dpp_mov(float x) { return __builtin_bit_cast(float, __builtin_amdgcn_update_dpp(0, __builtin_bit_cast(int, x), CTRL, 0xf, 0xf, true)); }
__device__ __forceinline__ float rsum16(float x) { x += dpp_mov<0xB1>(x); x += dpp_mov<0x4E>(x); x += dpp_mov<0x124>(x); x += dpp_mov<0x128>(x); return x; }
__device__ __forceinline__ float frcp_(float x) { return __builtin_amdgcn_rcpf(x); }
__device__ __forceinline__ float sigmoidf_(float x) { return __builtin_amdgcn_rcpf(1.0f + __expf(-x)); }
__device__ __forceinline__ float siluf_(float x) { return x * __builtin_amdgcn_rcpf(1.0f + __expf(-x)); }
__device__ __forceinline__ float softplusf_(float x) { return fmaxf(x, 0.0f) + __logf(1.0f + __expf(-fabsf(x))); }
__device__ __forceinline__ float logsigmoidf_(float x) { return fminf(x, 0.0f) - __logf(1.0f + __expf(-fabsf(x))); }
__device__ __forceinline__ float tanhf_(float x) { return 1.0f - 2.0f * __builtin_amdgcn_rcpf(__expf(2.0f * x) + 1.0f); }
__device__ __forceinline__ f32x4 mma16(bf16x8 a, bf16x8 b, f32x4 c) { return __builtin_amdgcn_mfma_f32_16x16x32_bf16(a, b, c, 0, 0, 0); }
__device__ __forceinline__ bf16x8 ldfrag(const bf16_t* base, int ld, int row0, int k0, int fr, int fq) { return *(const bf16x8*)(base + (row0 + fr) * ld + k0 + fq * 8); }
__device__ __forceinline__ void st4bf(bf16_t* p, f32x4 v) { u32x2 w; w.x = pack2(v[0], v[1]); w.y = pack2(v[2], v[3]); *(u32x2*)p = w; }
__device__ __forceinline__ f32x4 ld4bf(const bf16_t* p) { u32x2 w = *(const u32x2*)p; return (f32x4){lo2f(w.x), hi2f(w.x), lo2f(w.y), hi2f(w.y)}; }

#define PHASE_FN __device__ __forceinline__
__device__ __forceinline__ int otid() { int t = threadIdx.x; asm volatile("" : "+v"(t)); return t; }
__device__ __forceinline__ int obid() { int t = blockIdx.x; asm volatile("" : "+s"(t)); return t; }
template <class T> __device__ __forceinline__ T* as_global(T* p) { return p; }
__device__ __forceinline__ void lds_barrier() { asm volatile("s_waitcnt lgkmcnt(0)" ::: "memory"); __builtin_amdgcn_s_barrier(); asm volatile("" ::: "memory"); }
constexpr float W8_SCALE = 64.0f, W8_INV = 1.0f / 64.0f;
__device__ __forceinline__ unsigned pack4f8(float a, float b, float c, float d) { unsigned r = 0; r = __builtin_amdgcn_cvt_pk_fp8_f32(a, b, r, false); r = __builtin_amdgcn_cvt_pk_fp8_f32(c, d, r, true); return r; }
__device__ __forceinline__ void st4f8(unsigned char* p, f32x4 v) { *(unsigned*)p = pack4f8(v[0], v[1], v[2], v[3]); }
struct KP { const float* in[42]; float* out; unsigned char* ws; int ph_lo, ph_hi; };

#define XB_TMO      128
#define XB_XCNT(j)  (256  + 64 * (j))
#define XB_XSUB(j)  (1280 + 64 * (j))
#define XB_XGEN(j)  (2304 + 64 * (j))
#define XB_TOP      3328
#define XB_TOPGEN   3392
#define XCD_BAR_WORDS 3456
#define XB_SPIN_CAP (1u << 18)
#define LAS __attribute__((address_space(3)))

__device__ __forceinline__ unsigned xb_ld(unsigned* p)              { return __hip_atomic_load(p, __ATOMIC_RELAXED, __HIP_MEMORY_SCOPE_AGENT); }
__device__ __forceinline__ unsigned xb_add(unsigned* p, unsigned v) { return __hip_atomic_fetch_add(p, v, __ATOMIC_RELAXED, __HIP_MEMORY_SCOPE_AGENT); }
__device__ __forceinline__ unsigned xb_xcc_id() { return (unsigned)__builtin_amdgcn_s_getreg((3 << 11) | 20) & 0xFu; }
#define XB_SPIN(cond, bar) do { unsigned _sp = 0; while (cond) { __builtin_amdgcn_s_sleep(1); \
    if ((++_sp & 255u) == 0u) { if (xb_ld(&(bar)[XB_TMO])) break; if (_sp > XB_SPIN_CAP) { atomicAdd(&(bar)[XB_TMO], 1u); break; } } } } while (0)

struct XcdBarrier {
    unsigned* bar; unsigned x;
    volatile LAS unsigned* st;
};

__device__ __forceinline__ XcdBarrier xcd_barrier_post(unsigned* bar, volatile LAS unsigned* st) {
    XcdBarrier b; b.bar = bar; b.x = xb_xcc_id(); b.st = st;
    if (threadIdx.x == 0) (void)xb_add(&bar[XB_XCNT(b.x)], 1u);
    return b;
}
__device__ __forceinline__ void xcd_barrier_complete(unsigned* bar, unsigned x, unsigned& nloc, unsigned& nx) {
    const unsigned G = gridDim.x * gridDim.y * gridDim.z;
    unsigned sum, cnt, mine, sp = 0u;
    for (;;) {
        sum = 0u; cnt = 0u; mine = 0u;
#pragma unroll
        for (unsigned j = 0; j < 16; ++j) { const unsigned c = xb_ld(&bar[XB_XCNT(j)]); sum += c; cnt += (c > 0u) ? 1u : 0u; mine = (j == x) ? c : mine; }
        if (sum == G) break;
        __builtin_amdgcn_s_sleep(1);
        if ((++sp & 255u) == 0u) { if (xb_ld(&bar[XB_TMO])) break; if (sp > XB_SPIN_CAP) { atomicAdd(&bar[XB_TMO], 1u); break; } }
    }
    nloc = mine > 0u ? mine : 1u; nx = cnt > 0u ? cnt : 1u;
}

__device__ __forceinline__ void xcd_barrier(const XcdBarrier& b) {
    asm volatile("s_waitcnt vmcnt(0)" ::: "memory");
    __syncthreads();
    if (threadIdx.x == 0) {
        unsigned* bar = b.bar;
        __builtin_amdgcn_s_waitcnt(0);
        unsigned nloc = b.st[0], nx = b.st[1];
        if (nloc == 0u) { xcd_barrier_complete(bar, b.x, nloc, nx); b.st[0] = nloc; b.st[1] = nx; }
        const unsigned old = xb_add(&bar[XB_XSUB(b.x)], 1u);
        const unsigned gen = old / nloc;
        if (old + 1u == (gen + 1u) * nloc) {
            __builtin_amdgcn_fence(__ATOMIC_RELEASE, "agent");
            asm volatile("s_waitcnt vmcnt(0)" ::: "memory");
            const unsigned og = xb_add(&bar[XB_TOP], 1u);
            const unsigned tg = og / nx;
            if (og + 1u == (tg + 1u) * nx) xb_add(&bar[XB_TOPGEN], 1u);
            else XB_SPIN(xb_ld(&bar[XB_TOPGEN]) == tg, bar);
            __builtin_amdgcn_fence(__ATOMIC_ACQUIRE, "agent");
            xb_add(&bar[XB_XGEN(b.x)], 1u);
            asm volatile("s_waitcnt vmcnt(0)" ::: "memory");
        } else {
            XB_SPIN(xb_ld(&bar[XB_XGEN(b.x)]) == gen, bar);
            __builtin_amdgcn_fence(__ATOMIC_ACQUIRE, "agent");
            asm volatile("s_waitcnt vmcnt(0)" ::: "memory");
        }
    }
    __syncthreads();
}
struct GA {
    const bf16_t* a0; const bf16_t* a1;
    int ld0, ld1, ksplit;
    const int* list;
    int nrows;
    int mode;
    int row0;
};
constexpr int G_LDT = 40;
constexpr int GEMM_LDS = (2 * 256 * G_LDT + 2 * 128 * G_LDT) * 2;

template <class Epi>
__device__ __forceinline__ void gemm_tile(unsigned char* lds, const GA& ga, const bf16_t* __restrict__ Bt, int K, int mt, int nt, const Epi& epi) {
    const int tid = otid(), lane = tid & 63, wid = __builtin_amdgcn_readfirstlane(tid >> 6), wm = wid >> 1, wn = wid & 1, fr = lane & 15, fq = lane >> 4;
    bf16_t* sA = (bf16_t*)lds;
    bf16_t* sB = sA + 2 * 256 * G_LDT;
    const int kp = tid & 3;
    const int r0 = tid >> 2, r1 = r0 + 128;
    int s0, s1;
    {
        int lr = mt * 256 + r0; if (lr >= ga.nrows) lr = 0;
        s0 = ga.list ? ga.list[lr] : (ga.mode == 1 ? (lr >> 11) * TT + CTXL + (lr & 2047) : ga.row0 + lr);
        lr = mt * 256 + r1; if (lr >= ga.nrows) lr = 0;
        s1 = ga.list ? ga.list[lr] : (ga.mode == 1 ? (lr >> 11) * TT + CTXL + (lr & 2047) : ga.row0 + lr);
    }
    const bf16_t* pa00 = ga.a0 + (size_t)s0 * ga.ld0 + kp * 8;
    const bf16_t* pa01 = ga.a0 + (size_t)s1 * ga.ld0 + kp * 8;
    const bf16_t* pa10 = ga.a1 ? ga.a1 + (size_t)s0 * ga.ld1 + kp * 8 : pa00;
    const bf16_t* pa11 = ga.a1 ? ga.a1 + (size_t)s1 * ga.ld1 + kp * 8 : pa01;
    const bf16_t* pb = Bt + (size_t)(nt * 128 + r0) * K + kp * 8;
    const int ksplit = ga.ksplit;
    f32x4 acc[4][4];
#pragma unroll
    for (int i = 0; i < 4; ++i)
#pragma unroll
        for (int j = 0; j < 4; ++j) acc[i][j] = (f32x4){0.f, 0.f, 0.f, 0.f};
    const int nk = K >> 5;
    u32x4 ra0, ra1, rb;
    {
        ra0 = *(const u32x4*)(pa00); ra1 = *(const u32x4*)(pa01); rb = *(const u32x4*)(pb);
        if (0 >= ksplit) { ra0 = *(const u32x4*)(pa10); ra1 = *(const u32x4*)(pa11); }
    }
    *(u32x4*)(sA + (r0) * G_LDT + kp * 8) = ra0;
    *(u32x4*)(sA + (r1) * G_LDT + kp * 8) = ra1;
    *(u32x4*)(sB + (r0) * G_LDT + kp * 8) = rb;
    __syncthreads();
    for (int kt = 0; kt < nk; ++kt) {
        const int cur = kt & 1;
        if (kt + 1 < nk) {
            const int k0 = (kt + 1) << 5;
            if (k0 < ksplit) { ra0 = *(const u32x4*)(pa00 + k0); ra1 = *(const u32x4*)(pa01 + k0); }
            else { ra0 = *(const u32x4*)(pa10 + (k0 - ksplit)); ra1 = *(const u32x4*)(pa11 + (k0 - ksplit)); }
            rb = *(const u32x4*)(pb + k0);
        }
        const bf16_t* cA = sA + cur * 256 * G_LDT;
        const bf16_t* cB = sB + cur * 128 * G_LDT;
        bf16x8 af[4], bfr[4];
#pragma unroll
        for (int i = 0; i < 4; ++i) af[i] = ldfrag(cA, G_LDT, wm * 64 + i * 16, 0, fr, fq);
#pragma unroll
        for (int j = 0; j < 4; ++j) bfr[j] = ldfrag(cB, G_LDT, wn * 64 + j * 16, 0, fr, fq);
#pragma unroll
        for (int i = 0; i < 4; ++i)
#pragma unroll
            for (int j = 0; j < 4; ++j) acc[i][j] = mma16(bfr[j], af[i], acc[i][j]);
        if (kt + 1 < nk) {
            const int nb = cur ^ 1;
            *(u32x4*)(sA + (nb * 256 + r0) * G_LDT + kp * 8) = ra0;
            *(u32x4*)(sA + (nb * 256 + r1) * G_LDT + kp * 8) = ra1;
            *(u32x4*)(sB + (nb * 128 + r0) * G_LDT + kp * 8) = rb;
        }
        __syncthreads();
    }
    epi(acc, mt * 256 + wm * 64, nt * 128 + wn * 64, fr, fq);
}

struct EpiBf {
    bf16_t* out; int ld, nrows, ncols;
    __device__ __forceinline__ void operator()(const f32x4 (&acc)[4][4], int rb, int cb, int fr, int fq) const {
#pragma unroll
        for (int i = 0; i < 4; ++i) { const int lr = rb + i * 16 + fr; if (lr < nrows) {
#pragma unroll
            for (int j = 0; j < 4; ++j) { const int col = cb + j * 16 + fq * 4; if (col < ncols) st4bf(out + (size_t)lr * ld + col, acc[i][j]); } } }
    }
};
struct EpiSwiglu {
    bf16_t* out; int nrows;
    __device__ __forceinline__ void operator()(const f32x4 (&acc)[4][4], int rb, int cb, int fr, int fq) const {
#pragma unroll
        for (int i = 0; i < 4; ++i) { const int lr = rb + i * 16 + fr; if (lr < nrows) {
#pragma unroll
            for (int j = 0; j < 2; ++j) { const int col = (cb >> 1) + j * 16 + fq * 4; f32x4 g = acc[i][j], u = acc[i][j + 2], o;
#pragma unroll
                for (int r = 0; r < 4; ++r) o[r] = siluf_(g[r]) * u[r];
                st4bf(out + (size_t)lr * 512 + col, o); } } }
    }
};

namespace pg8 {
#define PG8_LAS __attribute__((address_space(3)))
typedef unsigned short bf16_t;
typedef short bf16x8 __attribute__((ext_vector_type(8)));
typedef float f32x4 __attribute__((ext_vector_type(4)));
typedef unsigned u32x4 __attribute__((ext_vector_type(4)));
constexpr int BM = 256, BK = 64, HALF = 128, HTB = HALF * BK * 2  , STAGE_BYTES = 8 * HTB, NXCD = 8, WGM = 8;

__host__ __device__ __forceinline__ int lds_byte(int r, int c) { const int st = (r >> 4) * 2 + (c >> 5), rr = r & 15, cc = c & 31, ob = rr * 64 + cc * 2; return st * 1024 + (ob ^ (((ob >> 9) & 1) << 5)); }
__host__ __device__ __forceinline__ void stage_rc(int b, int& R, int& C) { const int st = b / 1024, sb = b % 1024, swz = sb ^ (((sb >> 9) & 1) << 5); R = (st >> 1) * 16 + swz / 64; C = (st & 1) * 32 + (swz % 64) / 2; }
__host__ __device__ __forceinline__ int perm32(int rho) { const int n = rho >> 4, i = rho & 15; return 8 * (i >> 2) + 4 * n + (i & 3); }

struct Unit { int pm, pn; };
struct Gemm { const bf16_t* A; const bf16_t* Bt; int M, N, K; const bf16_t* A2; int pm_split; int lda, amode; };
#define PG8_ABASE(g, pm) ((g).amode == 1 ? (const char*)(g).A + (size_t)(((pm) >> 3) * 2304 + 256 + ((pm) & 7) * 256) * lda_ * 2 : ((pm) < (g).pm_split ? (const char*)(g).A + (size_t)(pm) * tstepA : (const char*)(g).A2 + (size_t)((pm) - (g).pm_split) * tstepA))
struct StaticOrder {
    int nM, nN, nwg, G, c;
    __host__ __device__ void init(int M, int N, int G_, int c_) { nM = M / BM; nN = N / BM; nwg = nM * nN; G = G_; c = c_; }
    __host__ __device__ bool next(int i, Unit& u) const {
        const long L = (long)i * G + c; if (L >= nwg) return false;
        int wgid = (int)L; { const int q = nwg / NXCD, r = nwg % NXCD, xcd = wgid % NXCD, off = wgid / NXCD; wgid = (xcd < r ? xcd * (q + 1) : r * (q + 1) + (xcd - r) * q) + off; }
        const int nig = WGM * nN, gid = wgid / nig, fm = gid * WGM, gsz = (nM - fm) < WGM ? (nM - fm) : WGM;
        u.pm = fm + ((wgid % nig) % gsz); u.pn = (wgid % nig) / gsz; return true;
    }
    __device__ __forceinline__ void a_ready(const Unit&) const {}
    __device__ __forceinline__ void done(const Unit&) const {}
};
__device__ __forceinline__ unsigned cvt_pk_bf16(float lo, float hi) { unsigned r; asm volatile("v_cvt_pk_bf16_f32 %0, %1, %2" : "=v"(r) : "v"(lo), "v"(hi)); return r; }
typedef float f32x2 __attribute__((ext_vector_type(2)));
template <class Epi, class Sched, bool STAMP = false, bool F8 = false>
__device__ __forceinline__ void gemm_phase(PG8_LAS unsigned char* lds, const Gemm g, const Sched& S, const Epi& E, unsigned long long* stamps) {
    const int tid = otid(), wid = __builtin_amdgcn_readfirstlane(tid >> 6), lane = tid & 63, wr = wid >> 2, wc = wid & 3, fr = lane & 15, fq = lane >> 4;
    const int K = g.K, nt = K / BK, lda_ = g.lda ? g.lda : g.K;
    int ts_lo = 0, ts_hi = 0, nts = 0; const unsigned long long rt_entry = STAMP ? (unsigned long long)wall_clock64() : 0ull;
#define PG8_STAMP() do { if (STAMP && wid == 0 && nts < 64) { const unsigned long long _c = (unsigned long long)clock64(); \
        ts_lo = (lane == nts) ? (int)(unsigned)_c : ts_lo; ts_hi = (lane == nts) ? (int)(unsigned)(_c >> 32) : ts_hi; ++nts; } } while (0)
    PG8_STAMP();
    unsigned voffA[2], voffB[2];
#pragma unroll
    for (int i = 0; i < 2; ++i) { int R, C; stage_rc(tid * 16 + i * 8192, R, C); const int Rb = Epi::PERM ? ((R & ~31) + perm32(R & 31)) : R;
        voffA[i] = (unsigned)(R * lda_ + C) * 2u; voffB[i] = (unsigned)(Rb * K + C) * 2u; }
    const size_t kstep = (size_t)(BK * 2);
    const size_t hstep = (size_t)HALF * K * 2;
    const size_t hstepA = (size_t)HALF * lda_ * 2, tstepA = 2 * hstepA;
    const size_t tstep = 2 * hstep;
    const unsigned ldsw = (unsigned)wid * 1024u;
    const int aoff = lds_byte(wr * 64 + fr, fq * 8), boff = lds_byte(wc * 32 + fr, fq * 8);
#define PG8_SA(b, h) (((b) * 2 + (h)) * HTB)
#define PG8_SB(b, h) ((4 + (b) * 2 + (h)) * HTB)
#define PG8_STAGE(bufoff, gbase, voff) do { _Pragma("unroll") for (int _i = 0; _i < 2; ++_i) \
        __builtin_amdgcn_global_load_lds((const unsigned*)((const char*)(gbase) + (voff)[_i]), (PG8_LAS unsigned*)(lds + (bufoff) + ldsw + _i * 8192), 16, 0, 0); } while (0)
#define PG8_LDA(dst, b, h) do { _Pragma("unroll") for (int m = 0; m < 4; ++m) { \
        if constexpr (F8) { dst##8[m].lo = *(const PG8_LAS v4i_*)(lds + PG8_SA(b, h) + aoff + m * 2048); dst##8[m].hi = *(const PG8_LAS v4i_*)(lds + PG8_SA(b, h) + aoff + m * 2048 + 1024); } \
        else { _Pragma("unroll") for (int k = 0; k < 2; ++k) dst[m][k] = *(const PG8_LAS bf16x8*)(lds + PG8_SA(b, h) + aoff + m * 2048 + k * 1024); } } } while (0)
#define PG8_LDB(dst, b, h) do { _Pragma("unroll") for (int n = 0; n < 2; ++n) { \
        if constexpr (F8) { dst##8[n].lo = *(const PG8_LAS v4i_*)(lds + PG8_SB(b, h) + boff + n * 2048); dst##8[n].hi = *(const PG8_LAS v4i_*)(lds + PG8_SB(b, h) + boff + n * 2048 + 1024); } \
        else { _Pragma("unroll") for (int k = 0; k < 2; ++k) dst[n][k] = *(const PG8_LAS bf16x8*)(lds + PG8_SB(b, h) + boff + n * 2048 + k * 1024); } } } while (0)
#define PG8_MMA(ai, bj, At, Bt) do { __builtin_amdgcn_s_setprio(1); _Pragma("unroll") for (int m = 0; m < 4; ++m) _Pragma("unroll") for (int n = 0; n < 2; ++n) { \
        if constexpr (F8) asm volatile("v_mfma_scale_f32_16x16x128_f8f6f4 %0, %1, %2, %0, %3, %3 op_sel_hi:[0,0,0]" : "+v"(acc[ai][bj][m][n]) : "v"(Bt##8[n]), "v"(At##8[m]), "v"(one_scale)); \
        else { _Pragma("unroll") for (int k = 0; k < 2; ++k) acc[ai][bj][m][n] = __builtin_amdgcn_mfma_f32_16x16x32_bf16(Bt[n][k], At[m][k], acc[ai][bj][m][n], 0, 0, 0); } } \
        __builtin_amdgcn_s_setprio(0); } while (0)
#define PG8_WAIT_V(n) asm volatile("s_waitcnt vmcnt(" #n ")" ::: "memory")
#define PG8_WAIT_L(n) asm volatile("s_waitcnt lgkmcnt(" #n ")" ::: "memory")
#define PG8_BAR __builtin_amdgcn_s_barrier()
#define PG8_SCHED __builtin_amdgcn_sched_barrier(0)
    Unit cur, nxt; int ui = 0;
    if (!S.next(0, cur)) return;
    f32x4 acc[2][2][4][2];
#pragma unroll
    for (int a = 0; a < 2; ++a)
#pragma unroll
        for (int b = 0; b < 2; ++b)
#pragma unroll
            for (int m = 0; m < 4; ++m)
#pragma unroll
                for (int n = 0; n < 2; ++n) acc[a][b][m][n] = (f32x4){0.f, 0.f, 0.f, 0.f};
    bf16x8 At[4][2], B0[2][2], B1[2][2];
    typedef int v4i_ __attribute__((ext_vector_type(4))); typedef int v8i_ __attribute__((ext_vector_type(8)));
    v8i_ At8[4], B08[2], B18[2];
    const int one_scale = 0x7f7f7f7f;
    const char* cA = PG8_ABASE(g, cur.pm); const char* cB = (const char*)g.Bt + (size_t)cur.pn * tstep;
    S.a_ready(cur);
    PG8_STAGE(PG8_SB(0, 0), cB, voffB); PG8_STAGE(PG8_SA(0, 0), cA, voffA); PG8_STAGE(PG8_SB(0, 1), cB + hstep, voffB); PG8_STAGE(PG8_SA(0, 1), cA + hstepA, voffA);
    if (wr == 1) PG8_BAR;
    PG8_WAIT_V(4); PG8_BAR;
    PG8_STAGE(PG8_SB(1, 0), cB + kstep, voffB); PG8_STAGE(PG8_SA(1, 0), cA + kstep, voffA); PG8_STAGE(PG8_SB(1, 1), cB + hstep + kstep, voffB);
    PG8_WAIT_V(6); PG8_BAR;
    PG8_STAMP();
    for (;;) {
        const bool has_next = S.next(ui + 1, nxt);
        const char* nA = has_next ? PG8_ABASE(g, nxt.pm) : cA; const char* nB = has_next ? (const char*)g.Bt + (size_t)nxt.pn * tstep : cB;
#pragma unroll 1
        for (int t = 0; t < nt; t += 2) {
            const bool last = (t == nt - 2);
            const char* a1 = cA + (size_t)(t + 1) * kstep;
            const char* a2 = last ? nA : cA + (size_t)(t + 2) * kstep; const char* b2 = last ? nB : cB + (size_t)(t + 2) * kstep;
            const char* a3 = a2 + kstep; const char* b3 = b2 + kstep;
            if (last && has_next) S.a_ready(nxt);
            PG8_LDB(B0, 0, 0); PG8_SCHED; PG8_LDA(At, 0, 0); PG8_STAGE(PG8_SA(1, 1), a1 + hstepA, voffA);
            PG8_WAIT_L(8); PG8_BAR; PG8_WAIT_L(0); PG8_MMA(0, 0, At, B0); PG8_BAR; PG8_SCHED;
            PG8_LDB(B1, 0, 1); PG8_STAGE(PG8_SB(0, 0), b2, voffB);
            PG8_BAR; PG8_WAIT_L(0); PG8_MMA(0, 1, At, B1); PG8_BAR;
            PG8_LDA(At, 0, 1); PG8_STAGE(PG8_SA(0, 0), a2, voffA);
            PG8_BAR; PG8_WAIT_L(0); PG8_MMA(1, 0, At, B0); PG8_BAR; PG8_SCHED;
            PG8_STAGE(PG8_SB(0, 1), b2 + hstep, voffB);
            PG8_WAIT_V(6); PG8_BAR; PG8_MMA(1, 1, At, B1); PG8_BAR;
            PG8_LDB(B0, 1, 0); PG8_SCHED; PG8_LDA(At, 1, 0); PG8_STAGE(PG8_SA(0, 1), a2 + hstepA, voffA);
            PG8_WAIT_L(8); PG8_BAR; PG8_WAIT_L(0); PG8_MMA(0, 0, At, B0); PG8_BAR; PG8_SCHED;
            PG8_LDB(B1, 1, 1); PG8_STAGE(PG8_SB(1, 0), b3, voffB);
            PG8_BAR; PG8_WAIT_L(0); PG8_MMA(0, 1, At, B1); PG8_BAR;
            PG8_LDA(At, 1, 1); PG8_STAGE(PG8_SA(1, 0), a3, voffA);
            PG8_BAR; PG8_WAIT_L(0); PG8_MMA(1, 0, At, B0); PG8_BAR; PG8_SCHED;
            PG8_STAGE(PG8_SB(1, 1), b3 + hstep, voffB);
            PG8_WAIT_V(6); PG8_BAR; PG8_MMA(1, 1, At, B1); PG8_BAR;
        }
        PG8_STAMP();
        if constexpr (F8) asm volatile("s_nop 15\n\ts_nop 15" ::: "memory");
        if constexpr (!Epi::AFTER_DRAIN) { E(acc, cur, wr, wc, fr, fq); S.done(cur); }
        PG8_STAMP();
        if (!has_next) break;
#pragma unroll
        for (int a = 0; a < 2; ++a)
#pragma unroll
            for (int b = 0; b < 2; ++b)
#pragma unroll
                for (int m = 0; m < 4; ++m)
#pragma unroll
                    for (int n = 0; n < 2; ++n) acc[a][b][m][n] = (f32x4){0.f, 0.f, 0.f, 0.f};
        cur = nxt; cA = nA; cB = nB; ++ui;
    }
    PG8_WAIT_V(0);
    if (wr == 0) PG8_BAR;
    PG8_BAR;
    if constexpr (Epi::AFTER_DRAIN) { E.fused(acc, cur, wr, wc, fr, fq, lds, wid, lane); S.done(cur); }
    PG8_STAMP();
    if (STAMP && wid == 0) { stamps[lane] = lane < nts ? (((unsigned long long)(unsigned)ts_hi << 32) | (unsigned)ts_lo) : 0ull;
        if (lane == 62) stamps[62] = rt_entry; if (lane == 63) stamps[63] = (unsigned long long)wall_clock64(); }
#undef PG8_STAMP
#undef PG8_SA
#undef PG8_SB
#undef PG8_STAGE
#undef PG8_LDA
#undef PG8_LDB
#undef PG8_MMA
#undef PG8_WAIT_V
#undef PG8_WAIT_L
#undef PG8_BAR
#undef PG8_SCHED
}
}
namespace pg8 {
struct EpiBfG {
    static constexpr bool PERM = true, AFTER_DRAIN = false;
    bf16_t* O; int ldc, ncols, pn_mask; float oscale;
    __device__ __forceinline__ void operator()(const f32x4 (&acc)[2][2][4][2], const Unit& u, int wr, int wc, int fr, int fq) const {
        const int row0 = u.pm * BM + wr * 64 + fr, col0 = (u.pn & pn_mask) * BM + wc * 32 + 8 * fq;
#pragma unroll
        for (int ai = 0; ai < 2; ++ai)
#pragma unroll
            for (int m = 0; m < 4; ++m) { bf16_t* rowp = O + (size_t)(row0 + ai * HALF + m * 16) * ldc;
#pragma unroll
                for (int bj = 0; bj < 2; ++bj) { const int c = col0 + bj * HALF;
                    if (c < ncols) { const f32x4 v0 = acc[ai][bj][m][0] * oscale, v1 = acc[ai][bj][m][1] * oscale;
                        u32x4 w; w.x = cvt_pk_bf16(v0[0], v0[1]); w.y = cvt_pk_bf16(v0[2], v0[3]); w.z = cvt_pk_bf16(v1[0], v1[1]); w.w = cvt_pk_bf16(v1[2], v1[3]);
                        *(u32x4*)(rowp + c) = w; } } }
    }
};
struct EpiSwi {
    static constexpr bool PERM = true, AFTER_DRAIN = false;
    bf16_t* H;
    __device__ __forceinline__ void operator()(const f32x4 (&acc)[2][2][4][2], const Unit& u, int wr, int wc, int fr, int fq) const {
        const int row0 = u.pm * BM + wr * 64 + fr, hc0 = (u.pn & 3) * HALF + wc * 32 + 8 * fq;
#pragma unroll
        for (int ai = 0; ai < 2; ++ai)
#pragma unroll
            for (int m = 0; m < 4; ++m) { unsigned char* rowp = (unsigned char*)H + (size_t)(row0 + ai * HALF + m * 16) * 1024 + hc0;
                float o[8];
#pragma unroll
                for (int n = 0; n < 2; ++n)
#pragma unroll
                    for (int r = 0; r < 4; ++r) { const float g = acc[ai][0][m][n][r] * W8_INV; o[n * 4 + r] = g * __builtin_amdgcn_rcpf(1.0f + __expf(-g)) * (acc[ai][1][m][n][r] * W8_INV); }
                u32x2 w; w.x = pack4f8(o[0], o[1], o[2], o[3]); w.y = pack4f8(o[4], o[5], o[6], o[7]);
                *(u32x2*)rowp = w; }
    }
};
struct MoeOrder {
    const int* slotmap; int ntiles, G, c;
    __device__ __forceinline__ bool next(int i, Unit& u) const {
        const int L = i * G + c; if (L >= ntiles * 4) return false;
        u.pm = L >> 2; u.pn = __builtin_amdgcn_readfirstlane(slotmap[L >> 2]) * 4 + (L & 3); return true;
    }
    __device__ __forceinline__ void a_ready(const Unit&) const {}
    __device__ __forceinline__ void done(const Unit&) const {}
};
}
#define WSP(T, off) as_global((T*)(kp.ws + (off)))
#define KIN(i) as_global(kp.in[i])
#define KOUT as_global(kp.out)

PHASE_FN void phase_mod(const KP& kp, unsigned char* lds) {
    float* sc = (float*)lds;
    float* red = sc + 17 * 1024;
    float* modv = WSP(float, WS_MODV);
    const int tid = otid();
    for (int i = tid; i < 17 * 1024; i += 512) { const int bb = i >> 10, k = i & 1023; const float c = bb < 16 ? KIN(1)[bb * 1024 + k] : KIN(3)[k]; sc[i] = siluf_(c); }
    __syncthreads();
    const int jc = tid & 63, ks = tid >> 6;
    for (int u = obid(); u < 192; u += gridDim.x) {
        const int l = u / 96, j0 = (u % 96) * 64;
        const float* w = KIN(4) + (size_t)l * 1024 * 6144 + j0 + jc;
        float acc[17];
#pragma unroll
        for (int bb = 0; bb < 17; ++bb) acc[bb] = 0.f;
        for (int k = ks * 128; k < ks * 128 + 128; ++k) {
            const float wv = w[(size_t)k * 6144];
#pragma unroll
            for (int bb = 0; bb < 17; ++bb) acc[bb] += sc[bb * 1024 + k] * wv;
        }
#pragma unroll
        for (int bb = 0; bb < 17; ++bb) red[(ks * 17 + bb) * 64 + jc] = acc[bb];
        __syncthreads();
        for (int i = tid; i < 17 * 64; i += 512) {
            const int bb = i >> 6, j = i & 63; float s = KIN(5)[l * 6144 + j0 + j];
#pragma unroll
            for (int k2 = 0; k2 < 8; ++k2) s += red[(k2 * 17 + bb) * 64 + j];
            modv[((size_t)l * 17 + bb) * 6144 + j0 + j] = s;
        }
        __syncthreads();
    }
}

struct CvJob { const float* src; bf16_t* dst; int N, ldd, mode, kt, ntile, f8; };
__device__ __forceinline__ bool cv_pick(int& u, CvJob& J, const float* src, int K, int N, bf16_t* dst, int mode = 0, int ldd = -1, int f8 = 0) {
    const int ntl = (N + 63) >> 6, cnt = ntl * (K >> 6);
    if (u < cnt) { J.src = src; J.dst = dst; J.N = N; J.ldd = ldd < 0 ? K : ldd; J.mode = mode; J.kt = u / ntl; J.ntile = u % ntl; J.f8 = f8; return true; }
    u -= cnt; return false;
}
__device__ __forceinline__ void cv_load(const CvJob& J, int tid, f32x4 (&r)[2]) {
#pragma unroll
    for (int i = 0; i < 2; ++i) { const int idx = tid + i * 512, k = idx >> 4, n0 = J.ntile * 64 + (idx & 15) * 4;
        r[i] = (n0 < J.N) ? *(const f32x4*)(J.src + (size_t)(J.kt * 64 + k) * J.N + n0) : (f32x4){0.f, 0.f, 0.f, 0.f}; }
}
__device__ __forceinline__ void cv_put(float* tile, int tid, const f32x4 (&r)[2]) {
#pragma unroll
    for (int i = 0; i < 2; ++i) { const int idx = tid + i * 512, k = idx >> 4, nq = (idx & 15) * 4;
        tile[k * 65 + nq] = r[i][0]; tile[k * 65 + nq + 1] = r[i][1]; tile[k * 65 + nq + 2] = r[i][2]; tile[k * 65 + nq + 3] = r[i][3]; }
}
__device__ __forceinline__ void cv_store(const float* tile, const CvJob& J, int tid) {
    const int nl = tid >> 3, k8 = tid & 7, n = J.ntile * 64 + nl;
    if (n < J.N) { int row = n; if (J.mode) row = (n >> 7) * 256 + (n & 127) + (J.mode == 2 ? 128 : 0);
        const float* tp = tile + (k8 * 8) * 65 + nl;
        if (J.f8) { u32x2 w; w.x = pack4f8(tp[0] * W8_SCALE, tp[65] * W8_SCALE, tp[130] * W8_SCALE, tp[195] * W8_SCALE); w.y = pack4f8(tp[260] * W8_SCALE, tp[325] * W8_SCALE, tp[390] * W8_SCALE, tp[455] * W8_SCALE);
            *(u32x2*)((unsigned char*)J.dst + (size_t)row * J.ldd + J.kt * 64 + k8 * 8) = w; }
        else { u32x4 w; w.x = pack2(tp[0], tp[65]); w.y = pack2(tp[130], tp[195]); w.z = pack2(tp[260], tp[325]); w.w = pack2(tp[390], tp[455]);
            *(u32x4*)(J.dst + (size_t)row * J.ldd + J.kt * 64 + k8 * 8) = w; } }
}
#define CV_RUN(total, PICK) CV_RUN_ON(total, PICK, obid(), (int)gridDim.x)
#define CV_RUN_ON(total, PICK, bid_, nb_) do { float* tile = (float*)lds; const int tid = otid(); const int G_ = (nb_); int u_ = (bid_); CvJob J, Jn; f32x4 r[2]; \
        if (u_ < (total)) { int u = u_; PICK(u, J); cv_load(J, tid, r); } \
        while (u_ < (total)) { cv_put(tile, tid, r); __syncthreads(); const int un_ = u_ + G_; \
            if (un_ < (total)) { int u = un_; PICK(u, Jn); cv_load(Jn, tid, r); } \
            cv_store(tile, J, tid); __syncthreads(); u_ = un_; J = Jn; } } while (0)
PHASE_FN void phase_conv_ab(const KP& kp, unsigned char* lds) {
#define PICK_AB(u, J) do { if (!cv_pick(u, J, KIN(7), 1024, AB_N, WSP(bf16_t, WS_WMIX + WM_AB_IN))) cv_pick(u, J, KIN(8), 2048, 1024, WSP(bf16_t, WS_WMIX + WM_AB_OUT)); } while (0)
    CV_RUN(16 * 85 + 32 * 16, PICK_AB);
#undef PICK_AB
}
PHASE_FN void phase_conv_cd(const KP& kp, unsigned char* lds) {
#define PICK_CD(u, J) do { if (cv_pick(u, J, KIN(18), 1024, CD_N, WSP(bf16_t, WS_WMIX + WM_CD_IN))) break; \
        if (cv_pick(u, J, KIN(19), 1536, 1024, WSP(bf16_t, WS_WMIX + WM_CD_OUT))) break; \
        if (cv_pick(u, J, KIN(21), 384, 768, WSP(bf16_t, WS_WMIX + WM_UQ))) break; \
        if (cv_pick(u, J, KIN(23), 256, 1024, WSP(bf16_t, WS_WMIX + WM_UKV))) break; \
        cv_pick(u, J, KIN(29), 128, 1024, WSP(bf16_t, WS_WMIX + WM_G2)); } while (0)
    CV_RUN(16 * 65 + 24 * 16 + 6 * 12 + 4 * 16 + 2 * 16, PICK_CD);
#undef PICK_CD
}
PHASE_FN void phase_conv_moe(const KP& kp, unsigned char* lds, int l, int bid, int nb) {
#define PICK_MOE(u0, J) do { const int es = (u0) / 384; int uu = (u0) % 384; \
        const float* wg = es < 16 ? KIN(36) + ((size_t)l * 16 + es) * 1024 * 512 : KIN(39) + (size_t)l * 1024 * 512; \
        const float* wu = es < 16 ? KIN(37) + ((size_t)l * 16 + es) * 1024 * 512 : KIN(40) + (size_t)l * 1024 * 512; \
        const float* wd = es < 16 ? KIN(38) + ((size_t)l * 16 + es) * 512 * 1024 : KIN(41) + (size_t)l * 512 * 1024; \
        bf16_t* dup = (bf16_t*)(WSP(unsigned char, WS_BIG + MO_WUP) + (size_t)es * 1024 * 1024); bf16_t* ddn = (bf16_t*)(WSP(unsigned char, WS_BIG + MO_WDN) + (size_t)es * 1024 * 512); \
        if (cv_pick(uu, J, wg, 1024, 512, dup, 1, 1024, 1)) break; if (cv_pick(uu, J, wu, 1024, 512, dup, 2, 1024, 1)) break; cv_pick(uu, J, wd, 512, 1024, ddn, 0, 512, 1); } while (0)
    CV_RUN_ON(17 * 384, PICK_MOE, bid, nb);
#undef PICK_MOE
}

__device__ __forceinline__ const float* hrow_rd(const KP& kp, bool from_inputs, int b, int t) {
    if (t < CTXL) return (from_inputs ? KIN(2) : WSP(const float, WS_HC)) + ((size_t)b * CTXL + t) * D;
    return (from_inputs ? KIN(0) : KOUT) + ((size_t)b * SEQ + (t - CTXL)) * D;
}
__device__ __forceinline__ float* hrow_wr(const KP& kp, int b, int t) {
    if (t < CTXL) return WSP(float, WS_HC) + ((size_t)b * CTXL + t) * D;
    return KOUT + ((size_t)b * SEQ + (t - CTXL)) * D;
}

PHASE_FN void phase_u(const KP& kp, int layer, int g, int bid, int nb, bool to_v) {
    const int lane = otid() & 63, wid = __builtin_amdgcn_readfirstlane(otid() >> 6);
    const float* modv = WSP(const float, WS_MODV) + (size_t)layer * 17 * 6144;
    const float* ng = KIN(6) + (size_t)layer * 4 * 1024;
    bf16_t* U = to_v ? WSP(bf16_t, WS_V) + (size_t)RG * 1024 : WSP(bf16_t, WS_BIG + (layer == 0 ? L0_U : L1_U));
    for (int lr = bid * 8 + wid; lr < RG; lr += nb * 8) {
        const int bl = lr / TT, t = lr - bl * TT, b = g * BG + bl;
        const float* src = hrow_rd(kp, layer == 0, b, t);
        const float* mv = modv + (size_t)(t < CTXL ? 16 : b) * 6144;
        f32x4 x[4]; float ss = 0.f;
#pragma unroll
        for (int i = 0; i < 4; ++i) { x[i] = *(const f32x4*)(src + i * 256 + lane * 4); ss += x[i][0] * x[i][0] + x[i][1] * x[i][1] + x[i][2] * x[i][2] + x[i][3] * x[i][3]; }
        ss = wsum(ss); const float rstd = rsqrtf(ss * (1.0f / 1024.0f) + EPS);
#pragma unroll
        for (int i = 0; i < 4; ++i) { const int col = i * 256 + lane * 4;
            const f32x4 gv = *(const f32x4*)(ng + col), sc = *(const f32x4*)(mv + 1024 + col), sh = *(const f32x4*)(mv + col);
            st4bf(U + (size_t)lr * 1024 + col, x[i] * rstd * gv * (sc + 1.0f) + sh); }
    }
}

PHASE_FN void phase_r(const KP& kp, unsigned char* lds, int layer, int g) {
    const int tid = otid(), lane = tid & 63, wid = __builtin_amdgcn_readfirstlane(tid >> 6);
    float* rw = (float*)lds;
    int* se = (int*)(rw + 1024 * 16);
    int* sbase = se + 160;
    for (int i = tid; i < 1024 * 16; i += 512) rw[i] = KIN(34)[i];
    __syncthreads();
    const float* modv = WSP(const float, WS_MODV) + (size_t)layer * 17 * 6144;
    const float* ng = KIN(6) + (size_t)layer * 4 * 1024;
    const bf16_t* MIX = WSP(const bf16_t, WS_BIG + (layer == 0 ? L0_U : L1_U));
    bf16_t* V = WSP(bf16_t, WS_V);
    unsigned* cnt = WSP(unsigned, CTL_CNT) + layer * 16;
    int* TOKE = WSP(int, WS_TOKE); int* TOKP = WSP(int, WS_TOKP); float* TOKW = WSP(float, WS_TOKW); int* LIST = WSP(int, WS_LIST);
    const int nrows = layer == 0 ? RG : RGL, CH = layer == 0 ? 72 : 64, RW = CH >> 3, nchunks = nrows / CH;
    float rbias[16];
#pragma unroll
    for (int e = 0; e < 16; ++e) rbias[e] = KIN(35)[e];
    for (int ch = obid(); ch < nchunks; ch += gridDim.x) {
        for (int rr = 0; rr < RW; ++rr) {
            const int rl = wid * RW + rr, lr = ch * CH + rl;
            int b, t, tok;
            if (layer == 0) { const int bl = lr / TT; t = lr - bl * TT; b = g * BG + bl; tok = g * RG + lr; }
            else { const int bl = lr >> 11; t = CTXL + (lr & 2047); b = g * BG + bl; tok = g * RGL + lr; }
            const float* hsrc = hrow_rd(kp, layer == 0, b, t);
            float* hdst = hrow_wr(kp, b, t);
            const float* mv = modv + (size_t)(t < CTXL ? 16 : b) * 6144;
            f32x4 y[4], h[4]; float ss = 0.f;
#pragma unroll
            for (int i = 0; i < 4; ++i) { y[i] = ld4bf(MIX + (size_t)lr * 1024 + i * 256 + lane * 4); ss += y[i][0] * y[i][0] + y[i][1] * y[i][1] + y[i][2] * y[i][2] + y[i][3] * y[i][3]; }
            ss = wsum(ss); float rstd = rsqrtf(ss * (1.0f / 1024.0f) + EPS);
            float s2 = 0.f;
#pragma unroll
            for (int i = 0; i < 4; ++i) { const int col = i * 256 + lane * 4;
                const f32x4 g1 = *(const f32x4*)(ng + 1024 + col), ga = *(const f32x4*)(mv + 2048 + col), hx = *(const f32x4*)(hsrc + col);
                h[i] = hx + ga * (y[i] * rstd * g1);
                *(f32x4*)(hdst + col) = h[i];
                s2 += h[i][0] * h[i][0] + h[i][1] * h[i][1] + h[i][2] * h[i][2] + h[i][3] * h[i][3]; }
            s2 = wsum(s2); rstd = rsqrtf(s2 * (1.0f / 1024.0f) + EPS);
            float lg[16];
#pragma unroll
            for (int e = 0; e < 16; ++e) lg[e] = 0.f;
#pragma unroll
            for (int i = 0; i < 4; ++i) { const int col = i * 256 + lane * 4;
                const f32x4 g2 = *(const f32x4*)(ng + 2048 + col), scf = *(const f32x4*)(mv + 4096 + col), shf = *(const f32x4*)(mv + 3072 + col);
                const f32x4 v = h[i] * rstd * g2 * (scf + 1.0f) + shf;
                st4f8((unsigned char*)V + (size_t)tok * 2048 + col, v);
#pragma unroll
                for (int j = 0; j < 4; ++j) {
#pragma unroll
                    for (int q = 0; q < 4; ++q) { const f32x4 w4 = *(const f32x4*)(rw + (col + j) * 16 + q * 4);
                        lg[q * 4 + 0] += v[j] * w4[0]; lg[q * 4 + 1] += v[j] * w4[1]; lg[q * 4 + 2] += v[j] * w4[2]; lg[q * 4 + 3] += v[j] * w4[3]; } } }
#pragma unroll
            for (int e = 0; e < 16; ++e) lg[e] = wsum(lg[e]);
            float aff[16], sel[16];
#pragma unroll
            for (int e = 0; e < 16; ++e) { aff[e] = sigmoidf_(lg[e]); sel[e] = aff[e] + rbias[e]; }
            float gs[4];
#pragma unroll
            for (int gi = 0; gi < 4; ++gi) { const float a0 = sel[gi * 4], a1 = sel[gi * 4 + 1], a2 = sel[gi * 4 + 2], a3 = sel[gi * 4 + 3];
                gs[gi] = fmaxf(fmaxf(fmaxf(a0 + a1, a0 + a2), fmaxf(a0 + a3, a1 + a2)), fmaxf(a1 + a3, a2 + a3)); }
            int gidx = 0; float gb = gs[0];
#pragma unroll
            for (int gi = 1; gi < 4; ++gi) if (gs[gi] > gb) { gb = gs[gi]; gidx = gi; }
            float c[4], f[4];
#pragma unroll
            for (int i = 0; i < 4; ++i) { c[i] = gidx == 0 ? sel[i] : gidx == 1 ? sel[4 + i] : gidx == 2 ? sel[8 + i] : sel[12 + i];
                                           f[i] = gidx == 0 ? aff[i] : gidx == 1 ? aff[4 + i] : gidx == 2 ? aff[8 + i] : aff[12 + i]; }
            int i1 = 0; float cb = c[0];
#pragma unroll
            for (int i = 1; i < 4; ++i) if (c[i] > cb) { cb = c[i]; i1 = i; }
            int i2 = -1; float cb2 = 0.f;
#pragma unroll
            for (int i = 0; i < 4; ++i) if (i != i1 && (i2 < 0 || c[i] > cb2)) { cb2 = c[i]; i2 = i; }
            float w1 = i1 == 0 ? f[0] : i1 == 1 ? f[1] : i1 == 2 ? f[2] : f[3];
            float w2 = i2 == 0 ? f[0] : i2 == 1 ? f[1] : i2 == 2 ? f[2] : f[3];
            const float wsn = 1.0f / (w1 + w2); w1 *= wsn; w2 *= wsn;
            if (lane == 0) { se[rl * 2] = gidx * 4 + i1; se[rl * 2 + 1] = gidx * 4 + i2;
                TOKE[tok * 2] = gidx * 4 + i1; TOKE[tok * 2 + 1] = gidx * 4 + i2; TOKW[tok * 2] = w1; TOKW[tok * 2 + 1] = w2; }
        }
        __syncthreads();
        if (tid < 16) { int c2 = 0; for (int i = 0; i < 2 * CH; ++i) c2 += (se[i] == tid) ? 1 : 0; sbase[tid] = (int)atomicAdd(&cnt[tid], (unsigned)c2); }
        __syncthreads();
        if (tid < 2 * CH) { const int e = se[tid]; int rank = 0; for (int j = 0; j < tid; ++j) rank += (se[j] == e) ? 1 : 0;
            const int pos = sbase[e] + rank; const int lr = ch * CH + (tid >> 1); const int tok = (layer == 0 ? g * RG : g * RGL) + lr;
            LIST[(size_t)e * NTOK + pos] = tok; TOKP[tok * 2 + (tid & 1)] = pos; }
        __syncthreads();
    }
}

__device__ __forceinline__ int moe_tile_prefix(const unsigned* cnt, int ntok, int lane) {
    const int myt = lane < 16 ? (int)((cnt[lane & 15] + 255u) >> 8) : 0; int pref = myt;
#pragma unroll
    for (int o = 1; o < 16; o <<= 1) { const int t = __shfl_up(pref, o); if (lane >= o) pref += t; }
    return pref - myt + ntok / 256;
}
PHASE_FN void phase_moe_gather(const KP& kp, int layer) {
    const int lane = otid() & 63, wid = __builtin_amdgcn_readfirstlane(otid() >> 6);
    const int ntok = layer == 0 ? NTOK : NLAT;
    const int tpre = moe_tile_prefix(WSP(const unsigned, CTL_CNT) + layer * 16, ntok, lane);
    const bf16_t* V = WSP(const bf16_t, WS_V); bf16_t* XG = WSP(bf16_t, WS_BIG + MO_XG);
    const int* TOKE = WSP(const int, WS_TOKE); const int* TOKP = WSP(const int, WS_TOKP);
    for (int it = obid() * 8 + wid; it < 2 * ntok; it += gridDim.x * 8) {
        const int tok = it >> 1, e = TOKE[it], pos = TOKP[it];
        const size_t row = (size_t)(__shfl(tpre, e) - ntok / 256) * 256 + pos;
        const u32x4* src = (const u32x4*)(V + (size_t)tok * 1024) + lane; u32x4* dst = (u32x4*)(XG + row * 1024) + lane;
        dst[0] = src[0];
    }
}
PHASE_FN void phase_moe_gemm(const KP& kp, unsigned char* lds, int layer, bool down) {
    const int tid = otid();
    int* pre = (int*)(lds + pg8::STAGE_BYTES);
    int* slotmap = pre + 32;
    const int ntok = layer == 0 ? NTOK : NLAT;
    const unsigned* cnt = WSP(const unsigned, CTL_CNT) + layer * 16;
    if (tid == 0) { int p = ntok / 256; pre[0] = 0; pre[1] = p; for (int e = 0; e < 16; ++e) { p += ((int)cnt[e] + 255) >> 8; pre[2 + e] = p; } }
    __syncthreads();
    const int ntiles = pre[17];
    for (int t = tid; t < ntiles; t += 512) { int idx = 0; for (int e = 1; e < 17; ++e) if (pre[e] <= t) idx = e; slotmap[t] = idx == 0 ? 16 : idx - 1; }
    __syncthreads();
    pg8::MoeOrder S{slotmap, ntiles, (int)gridDim.x, obid()};
    if (!down) {
        pg8::Gemm g{WSP(const bf16_t, WS_V), WSP(const bf16_t, WS_BIG + MO_WUP), 0, 0, 512, WSP(const bf16_t, WS_BIG + MO_XG), ntok / 256, 1024, 0};
        pg8::EpiSwi E{WSP(bf16_t, WS_BIG + MO_HID)};
        pg8::gemm_phase<pg8::EpiSwi, pg8::MoeOrder, false, true>((PG8_LAS unsigned char*)lds, g, S, E, nullptr);
    } else {
        pg8::Gemm g{WSP(const bf16_t, WS_BIG + MO_HID), WSP(const bf16_t, WS_BIG + MO_WDN), 0, 0, 256, nullptr, 0x7fffffff, 512, 0};
        pg8::EpiBfG E{WSP(bf16_t, WS_BIG + MO_CON), 1024, 1024, 3, W8_INV};
        pg8::gemm_phase<pg8::EpiBfG, pg8::MoeOrder, false, true>((PG8_LAS unsigned char*)lds, g, S, E, nullptr);
    }
    __syncthreads();
}

PHASE_FN void phase_combine(const KP& kp, int layer) {
    const int lane = otid() & 63, wid = __builtin_amdgcn_readfirstlane(otid() >> 6);
    const int ntok = layer == 0 ? NTOK : NLAT;
    const unsigned* cnt = WSP(const unsigned, CTL_CNT) + layer * 16;
    const float* modv = WSP(const float, WS_MODV) + (size_t)layer * 17 * 6144;
    const float* ng = KIN(6) + (size_t)layer * 4 * 1024 + 3 * 1024;
    const bf16_t* CON = WSP(const bf16_t, WS_BIG + MO_CON);
    const int* TOKE = WSP(const int, WS_TOKE); const int* TOKP = WSP(const int, WS_TOKP); const float* TOKW = WSP(const float, WS_TOKW);
    const int tpre = moe_tile_prefix(cnt, ntok, lane);
    for (int tok0 = (obid() * 8 + wid) * 2; tok0 < ntok; tok0 += gridDim.x * 16) {
        int e1[2], e2[2], p1[2], p2[2]; float w1[2], w2[2];
#pragma unroll
        for (int u = 0; u < 2; ++u) { const int tok = tok0 + u; e1[u] = TOKE[tok * 2]; e2[u] = TOKE[tok * 2 + 1]; p1[u] = TOKP[tok * 2]; p2[u] = TOKP[tok * 2 + 1]; w1[u] = TOKW[tok * 2]; w2[u] = TOKW[tok * 2 + 1]; }
        f32x4 f[2][4], hx[2][4]; float* hp[2]; const float* mv[2];
#pragma unroll
        for (int u = 0; u < 2; ++u) { const int tok = tok0 + u;
            const size_t r1 = (size_t)__shfl(tpre, e1[u]) * 256 + p1[u], r2 = (size_t)__shfl(tpre, e2[u]) * 256 + p2[u];
            int b, t;
            if (layer == 0) { b = tok / TT; t = tok - b * TT; } else { b = tok >> 11; t = CTXL + (tok & 2047); }
            hp[u] = hrow_wr(kp, b, t); mv[u] = modv + (size_t)(t < CTXL ? 16 : b) * 6144 + 5 * 1024;
#pragma unroll
            for (int i = 0; i < 4; ++i) { const int col = i * 256 + lane * 4;
                f[u][i] = ld4bf(CON + (size_t)tok * 1024 + col) + ld4bf(CON + r1 * 1024 + col) * w1[u] + ld4bf(CON + r2 * 1024 + col) * w2[u];
                hx[u][i] = *(const f32x4*)(hp[u] + col); } }
#pragma unroll
        for (int u = 0; u < 2; ++u) { float ss = 0.f;
#pragma unroll
            for (int i = 0; i < 4; ++i) ss += f[u][i][0] * f[u][i][0] + f[u][i][1] * f[u][i][1] + f[u][i][2] * f[u][i][2] + f[u][i][3] * f[u][i][3];
            ss = wsum(ss); const float rstd = rsqrtf(ss * (1.0f / 1024.0f) + EPS);
            float s2 = 0.f;
#pragma unroll
            for (int i = 0; i < 4; ++i) { const int col = i * 256 + lane * 4;
                const f32x4 g3 = *(const f32x4*)(ng + col), gf = *(const f32x4*)(mv[u] + col);
                const f32x4 hn = hx[u][i] + gf * (f[u][i] * rstd * g3);
                *(f32x4*)(hp[u] + col) = hn; hx[u][i] = hn;
                s2 += hn[0] * hn[0] + hn[1] * hn[1] + hn[2] * hn[2] + hn[3] * hn[3]; }
            if (layer == 0) {
                s2 = wsum(s2); const float rs2 = rsqrtf(s2 * (1.0f / 1024.0f) + EPS);
                const float* mv1 = mv[u] - 5 * 1024 + 17 * 6144;
                const float* ng1 = KIN(6) + 4 * 1024;
                bf16_t* U1 = WSP(bf16_t, WS_V) + (size_t)(tok0 + u) * 1024;
#pragma unroll
                for (int i = 0; i < 4; ++i) { const int col = i * 256 + lane * 4;
                    const f32x4 gv = *(const f32x4*)(ng1 + col), sc = *(const f32x4*)(mv1 + 1024 + col), sh = *(const f32x4*)(mv1 + col);
                    st4bf(U1 + col, hx[u][i] * rs2 * gv * (sc + 1.0f) + sh); } } }
    }
}

template <int CH>
__device__ __forceinline__ int scan_t(int dir, int ci, int j) {
    constexpr int NC_CTX = CTXL / CH;
    if (!dir) return ci * CH + j;
    return ci < NC_CTX ? (CTXL - 1 - ci * CH - j) : (TT - 1 - (ci - NC_CTX) * CH - j);
}

constexpr int ML_LQ = 136, ML_LT = 72, ML_VR = 144;
PHASE_FN void mlstm_unit(const KP& kp, unsigned char* lds, int bl, int h, int dir, int vh) {
    const int tid = otid();
    bf16_t* Qs = (bf16_t*)lds;
    bf16_t* Ks = Qs + 64 * ML_LQ;
    bf16_t* KTE = Ks + 64 * ML_LQ;
    bf16_t* VT = KTE + 128 * ML_LT;
    bf16_t* Ps = VT + ML_VR * ML_LT;
    bf16_t* Cb = Ps + 64 * ML_LT;
    float* fs = (float*)(Cb + ML_VR * ML_LQ);
    float* s_rowv = fs;
    float* s_colv = fs + 64;
    float* s_wint = fs + 128;
    float* s_emj = fs + 192;
    float* s_E = fs + 256;
    float* s_den = fs + 320;
    float* s_misc = fs + 384;
    const bf16_t* P = WSP(const bf16_t, WS_BIG + L0_P);
    bf16_t* HOUT = WSP(bf16_t, WS_BIG + (dir ? L0_HB : L0_AO)); const int ldh = dir ? 1024 : 2048;
    const float ibias = KIN(9)[dir * 4 + h], fbias = KIN(10)[dir * 4 + h];
    for (int i = tid; i < ML_VR * ML_LQ; i += 512) Cb[i] = 0;
    for (int i = tid; i < 16 * ML_LT; i += 512) VT[128 * ML_LT + i] = (i < ML_LT) ? (bf16_t)0x3f80 : (bf16_t)0;
    f32x4 Cacc[8], Nacc;
#pragma unroll
    for (int i = 0; i < 8; ++i) Cacc[i] = (f32x4){0.f, 0.f, 0.f, 0.f};
    Nacc = (f32x4){0.f, 0.f, 0.f, 0.f};
    float m_state = 0.f;
    u32x4 pq[2], pk[2], pv[2]; bf16_t pgi = 0, pgf = 0;
#define ML_REQ(ci_) do { _Pragma("unroll") for (int i = 0; i < 2; ++i) { const int p = tid + i * 512, j = p >> 4, c8 = p & 15; \
            const bf16_t* pr = P + ((size_t)bl * TT + scan_t<64>(dir, (ci_), j)) * AB_N; \
            pq[i] = *(const u32x4*)(pr + AB_Q + h * 128 + c8 * 8); pk[i] = *(const u32x4*)(pr + AB_K + h * 128 + c8 * 8); \
            const int jv = tid & 63, cv = (tid >> 6) + i * 8; \
            pv[i] = *(const u32x4*)(P + ((size_t)bl * TT + scan_t<64>(dir, (ci_), jv)) * AB_N + AB_V + h * 256 + vh * 128 + cv * 8); } \
        if (tid < 64) { const bf16_t* pg = P + ((size_t)bl * TT + scan_t<64>(dir, (ci_), tid)) * AB_N; pgi = pg[AB_IG + dir * 4 + h]; pgf = pg[AB_FG + dir * 4 + h]; } } while (0)
    ML_REQ(0);
    lds_barrier();
    for (int ci = 0; ci < TT / 64; ++ci) {
        int tq = tid; asm volatile("" : "+v"(tq));
        const int lane = tq & 63, wid = __builtin_amdgcn_readfirstlane(tq >> 6), fr = lane & 15, fq = lane >> 4;
#pragma unroll
        for (int i = 0; i < 2; ++i) {
            const int p = tq + i * 512, j = p >> 4, c8 = p & 15;
            u32x4 q = pq[i];
            const float qs = 0.08838834764831845f;
            q.x = pack2(lo2f(q.x) * qs, hi2f(q.x) * qs); q.y = pack2(lo2f(q.y) * qs, hi2f(q.y) * qs);
            q.z = pack2(lo2f(q.z) * qs, hi2f(q.z) * qs); q.w = pack2(lo2f(q.w) * qs, hi2f(q.w) * qs);
            *(u32x4*)(Qs + j * ML_LQ + c8 * 8) = q;
            *(u32x4*)(Ks + j * ML_LQ + c8 * 8) = pk[i];
            const u32x4 v = pv[i];
            bf16_t* vt = VT + (((tq >> 6) + i * 8) * 8) * ML_LT + (tq & 63);
            vt[0 * ML_LT] = (bf16_t)(v.x & 0xffff); vt[1 * ML_LT] = (bf16_t)(v.x >> 16); vt[2 * ML_LT] = (bf16_t)(v.y & 0xffff); vt[3 * ML_LT] = (bf16_t)(v.y >> 16);
            vt[4 * ML_LT] = (bf16_t)(v.z & 0xffff); vt[5 * ML_LT] = (bf16_t)(v.z >> 16); vt[6 * ML_LT] = (bf16_t)(v.w & 0xffff); vt[7 * ML_LT] = (bf16_t)(v.w >> 16);
        }
        if (wid == 0) {
            const float ig = bf2f(pgi) + ibias;
            const float lf = logsigmoidf_(bf2f(pgf) + fbias);
            float b = lf;
#pragma unroll
            for (int o = 1; o < 64; o <<= 1) { const float t = __shfl_up(b, o); if (lane >= o) b += t; }
            const float u = ig - b; float pm = u;
#pragma unroll
            for (int o = 1; o < 64; o <<= 1) { const float t = __shfl_up(pm, o); if (lane >= o) pm = fmaxf(pm, t); }
            const float mj = fmaxf(b + m_state, b + pm);
            const float b63 = __shfl(b, 63), pm63 = __shfl(pm, 63);
            const float mnew = fmaxf(b63 + m_state, b63 + pm63);
            s_rowv[lane] = b - mj; s_colv[lane] = u; s_wint[lane] = __expf(b + m_state - mj); s_emj[lane] = __expf(-mj);
            s_E[lane] = __expf(b63 + u - mnew);
            if (lane == 0) { s_misc[0] = mnew; s_misc[1] = __expf(b63 + m_state - mnew); }
        }
        if (ci + 1 < TT / 64) ML_REQ(ci + 1);
        lds_barrier();
        {
            const int jt = wid >> 1;
#pragma unroll
            for (int q2 = 0; q2 < 2; ++q2) {
                const int st = (wid & 1) * 2 + q2;
                f32x4 acc = (f32x4){0.f, 0.f, 0.f, 0.f};
                if (st <= jt) {
                    bf16x8 fa[4], fb[4];
#pragma unroll
                    for (int k = 0; k < 4; ++k) { fa[k] = ldfrag(Qs, ML_LQ, jt * 16, k * 32, fr, fq); fb[k] = ldfrag(Ks, ML_LQ, st * 16, k * 32, fr, fq); }
                    __builtin_amdgcn_sched_barrier(0);
                    f32x4 acc2 = (f32x4){0.f, 0.f, 0.f, 0.f};
                    acc = mma16(fa[0], fb[0], acc); acc2 = mma16(fa[1], fb[1], acc2); acc = mma16(fa[2], fb[2], acc); acc2 = mma16(fa[3], fb[3], acc2);
                    acc = acc + acc2;
                }
                const int s = st * 16 + fr; const float cv = s_colv[s];
#pragma unroll
                for (int r = 0; r < 4; ++r) { const int j = jt * 16 + fq * 4 + r;
                    const float pv2 = (s <= j) ? acc[r] * __expf(s_rowv[j] + cv) : 0.f;
                    Ps[j * ML_LT + s] = f2bf(pv2); }
            }
#pragma unroll
            for (int i = 0; i < 2; ++i) {
                const int s = lane, c8 = wid + i * 8; const float e = s_E[s];
                const u32x4 kv = *(const u32x4*)(Ks + s * ML_LQ + c8 * 8);
                bf16_t* kt = KTE + (c8 * 8) * ML_LT + s;
                kt[0 * ML_LT] = f2bf(lo2f(kv.x) * e); kt[1 * ML_LT] = f2bf(hi2f(kv.x) * e); kt[2 * ML_LT] = f2bf(lo2f(kv.y) * e); kt[3 * ML_LT] = f2bf(hi2f(kv.y) * e);
                kt[4 * ML_LT] = f2bf(lo2f(kv.z) * e); kt[5 * ML_LT] = f2bf(hi2f(kv.z) * e); kt[6 * ML_LT] = f2bf(lo2f(kv.w) * e); kt[7 * ML_LT] = f2bf(hi2f(kv.w) * e);
            }
        }
        lds_barrier();
        f32x4 a1[4], a2[4];
        {
            const int jt = wid >> 1;
            bf16x8 fp[2], fqq[4];
#pragma unroll
            for (int k = 0; k < 2; ++k) fp[k] = ldfrag(Ps, ML_LT, jt * 16, k * 32, fr, fq);
#pragma unroll
            for (int k = 0; k < 4; ++k) fqq[k] = ldfrag(Qs, ML_LQ, jt * 16, k * 32, fr, fq);
            {
                bf16x8 fv[4][2];
#pragma unroll
                for (int q4 = 0; q4 < 4; ++q4)
#pragma unroll
                    for (int k = 0; k < 2; ++k) fv[q4][k] = ldfrag(VT, ML_LT, ((wid & 1) * 4 + q4) * 16, k * 32, fr, fq);
                __builtin_amdgcn_sched_barrier(0);
#pragma unroll
                for (int q4 = 0; q4 < 4; ++q4) a1[q4] = (f32x4){0.f, 0.f, 0.f, 0.f};
#pragma unroll
                for (int k = 0; k < 2; ++k)
#pragma unroll
                    for (int q4 = 0; q4 < 4; ++q4) a1[q4] = mma16(fv[q4][k], fp[k], a1[q4]);
            }
#pragma unroll
            for (int hh = 0; hh < 2; ++hh) {
                bf16x8 fc[2][4];
#pragma unroll
                for (int q2 = 0; q2 < 2; ++q2)
#pragma unroll
                    for (int k = 0; k < 4; ++k) fc[q2][k] = ldfrag(Cb, ML_LQ, ((wid & 1) * 4 + hh * 2 + q2) * 16, k * 32, fr, fq);
                __builtin_amdgcn_sched_barrier(0);
                a2[hh * 2] = (f32x4){0.f, 0.f, 0.f, 0.f}; a2[hh * 2 + 1] = (f32x4){0.f, 0.f, 0.f, 0.f};
#pragma unroll
                for (int k = 0; k < 4; ++k) { a2[hh * 2] = mma16(fc[0][k], fqq[k], a2[hh * 2]); a2[hh * 2 + 1] = mma16(fc[1][k], fqq[k], a2[hh * 2 + 1]); }
            }
            if (wid & 1) {
                f32x4 d1 = (f32x4){0.f, 0.f, 0.f, 0.f}, d2 = (f32x4){0.f, 0.f, 0.f, 0.f};
                bf16x8 fo[2], fn[4];
#pragma unroll
                for (int k = 0; k < 2; ++k) fo[k] = ldfrag(VT, ML_LT, 128, k * 32, fr, fq);
#pragma unroll
                for (int k = 0; k < 4; ++k) fn[k] = ldfrag(Cb, ML_LQ, 128, k * 32, fr, fq);
                __builtin_amdgcn_sched_barrier(0);
                d1 = mma16(fo[0], fp[0], d1); d2 = mma16(fn[0], fqq[0], d2); d1 = mma16(fo[1], fp[1], d1); d2 = mma16(fn[1], fqq[1], d2);
                d2 = mma16(fn[2], fqq[2], d2); d2 = mma16(fn[3], fqq[3], d2);
                if (fq == 0) { const int j = jt * 16 + fr; s_den[j] = fmaxf(fabsf(d1[0] + s_wint[j] * d2[0]), s_emj[j]); }
            }
        }
        lds_barrier();
        {
            const int jt = wid >> 1, j = jt * 16 + fr;
            const float wi = s_wint[j], rden = frcp_(s_den[j]);
            const size_t row = (size_t)bl * TT + scan_t<64>(dir, ci, j);
#pragma unroll
            for (int q4 = 0; q4 < 4; ++q4) { const int v0 = ((wid & 1) * 4 + q4) * 16 + fq * 4;
                st4bf(HOUT + row * ldh + h * 256 + vh * 128 + v0, (a1[q4] + a2[q4] * wi) * rden); }
        }
        {
            const float dec = s_misc[1];
            const bf16x8 bv0 = ldfrag(VT, ML_LT, wid * 16, 0, fr, fq), bv1 = ldfrag(VT, ML_LT, wid * 16, 32, fr, fq);
#pragma unroll
            for (int hh = 0; hh < 2; ++hh) {
                bf16x8 fk[4][2];
#pragma unroll
                for (int q = 0; q < 4; ++q) { fk[q][0] = ldfrag(KTE, ML_LT, (hh * 4 + q) * 16, 0, fr, fq); fk[q][1] = ldfrag(KTE, ML_LT, (hh * 4 + q) * 16, 32, fr, fq); }
                __builtin_amdgcn_sched_barrier(0);
#pragma unroll
                for (int q = 0; q < 4; ++q) Cacc[hh * 4 + q] = Cacc[hh * 4 + q] * dec;
#pragma unroll
                for (int q = 0; q < 4; ++q) Cacc[hh * 4 + q] = mma16(fk[q][0], bv0, Cacc[hh * 4 + q]);
#pragma unroll
                for (int q = 0; q < 4; ++q) Cacc[hh * 4 + q] = mma16(fk[q][1], bv1, Cacc[hh * 4 + q]);
#pragma unroll
                for (int q = 0; q < 4; ++q) st4bf(Cb + (wid * 16 + fr) * ML_LQ + (hh * 4 + q) * 16 + fq * 4, Cacc[hh * 4 + q]);
            }
            Nacc = Nacc * dec;
            Nacc = mma16(ldfrag(KTE, ML_LT, wid * 16, 0, fr, fq), ldfrag(VT, ML_LT, 128, 0, fr, fq), Nacc);
            Nacc = mma16(ldfrag(KTE, ML_LT, wid * 16, 32, fr, fq), ldfrag(VT, ML_LT, 128, 32, fr, fq), Nacc);
            st4bf(Cb + (128 + fr) * ML_LQ + wid * 16 + fq * 4, Nacc);
            m_state = s_misc[0];
        }
        lds_barrier();
    }
#undef ML_REQ
}

constexpr size_t L0_XC = L0_U;
static_assert(L0_XC + (size_t)RG * 1280 * 2 <= BIG_BYTES, "xconv buffer");
PHASE_FN void phase_xconv(const KP& kp) {
    const int lane = otid() & 63, wid = __builtin_amdgcn_readfirstlane(otid() >> 6);
    const bf16_t* P = WSP(const bf16_t, WS_BIG + L0_P); bf16_t* XC = WSP(bf16_t, WS_BIG + L0_XC);
    const float* cw = KIN(12); const float* cb = KIN(13);
    constexpr int RUN = 9;
    for (int run = obid() * 8 + wid; run < RG / RUN; run += gridDim.x * 8) {
        const int r0 = run * RUN;
#pragma unroll
        for (int i = 0; i < 5; ++i) { const int col = i * 256 + lane * 4;
            const f32x4 bias = *(const f32x4*)(cb + col);
            f32x4 w[5], x[5];
#pragma unroll
            for (int q = 0; q < 5; ++q) w[q] = *(const f32x4*)(cw + q * 1280 + col);
#pragma unroll
            for (int q = 0; q < 4; ++q) { const int rr = r0 - 2 + q; x[q + 1] = (rr >= 0 && rr < RG) ? ld4bf(P + (size_t)rr * AB_N + AB_XBC + col) : (f32x4){0.f, 0.f, 0.f, 0.f}; }
#pragma unroll
            for (int k = 0; k < RUN; ++k) {
                const int lr = r0 + k, bl = lr / TT, t = lr - bl * TT, lo = t < CTXL ? 0 : CTXL, hi = t < CTXL ? CTXL : TT;
#pragma unroll
                for (int q = 0; q < 4; ++q) x[q] = x[q + 1];
                { const int rr = lr + 2; x[4] = (rr < RG) ? ld4bf(P + (size_t)rr * AB_N + AB_XBC + col) : (f32x4){0.f, 0.f, 0.f, 0.f}; }
                f32x4 a = bias;
#pragma unroll
                for (int q = 0; q < 5; ++q) { const int tt = t - 2 + q; if (tt >= lo && tt < hi) a += w[q] * x[q]; }
                f32x4 o;
#pragma unroll
                for (int r = 0; r < 4; ++r) o[r] = siluf_(a[r]);
                st4bf(XC + (size_t)lr * 1280 + col, o);
            }
        }
    }
}

constexpr int SS_LT = 72, SS_LX = 136;
PHASE_FN void ssd_unit(const KP& kp, unsigned char* lds, int bl, int dir, int hp) {
    const int tid = otid();
    const int gi = hp >> 2, hh0 = hp * 2;
    bf16_t* Wm = (bf16_t*)lds;
    bf16_t* CM = Wm + 2 * 64 * SS_LT;
    bf16_t* BM = CM + 64 * SS_LT;
    bf16_t* Xn = BM + 64 * SS_LT;
    bf16_t* XT = Xn + 64 * SS_LX;
    bf16_t* BTE = XT + 2 * 64 * SS_LT;
    bf16_t* Sb = BTE + 2 * 64 * SS_LT;
    float* fs = (float*)(Sb + 2 * 64 * SS_LT);
    float* s_b = fs;
    float* s_dt = fs + 128;
    float* s_e = fs + 256;
    float* s_misc = fs + 384;
    const bf16_t* P = WSP(const bf16_t, WS_BIG + L0_P); const bf16_t* XC = WSP(const bf16_t, WS_BIG + L0_XC);
    bf16_t* YOUT = WSP(bf16_t, WS_BIG + (dir ? L0_YB : L0_AO + 2048)); const int ldy = dir ? 1024 : 2048;
    for (int i = tid; i < 2 * 64 * SS_LT; i += 512) Sb[i] = 0;
    f32x4 Sacc[4];
#pragma unroll
    for (int i = 0; i < 4; ++i) Sacc[i] = (f32x4){0.f, 0.f, 0.f, 0.f};
    const float dtb = KIN(14)[dir * 16 + hh0 + ((tid >> 6) & 1)], aexp = __expf(KIN(15)[dir * 16 + hh0 + ((tid >> 6) & 1)]);
    const float dskip = KIN(16)[hh0 + (tid >> 8)];
    u32x4 pr[4]; bf16_t pdt = 0;
#define SS_REQ(ci_) do { _Pragma("unroll") for (int q = 0; q < 4; ++q) { const int p = tid + q * 512, j = p >> 5, c8 = p & 31; \
            const int col = c8 < 16 ? hh0 * 64 + c8 * 8 : (c8 < 24 ? 1024 + gi * 64 + (c8 - 16) * 8 : 1152 + gi * 64 + (c8 - 24) * 8); \
            pr[q] = *(const u32x4*)(XC + ((size_t)bl * TT + scan_t<64>(dir, (ci_), j)) * 1280 + col); } \
        if (tid < 128) pdt = P[((size_t)bl * TT + scan_t<64>(dir, (ci_), tid & 63)) * AB_N + AB_DT + dir * 16 + hh0 + (tid >> 6)]; } while (0)
    SS_REQ(0);
    lds_barrier();
    for (int ci = 0; ci < TT / 64; ++ci) {
        int tq = tid; asm volatile("" : "+v"(tq));
        const int lane = tq & 63, wid = __builtin_amdgcn_readfirstlane(tq >> 6), fr = lane & 15, fq = lane >> 4, hl_w = wid >> 2;
#pragma unroll
        for (int q = 0; q < 4; ++q) { const int p = tq + q * 512, j = p >> 5, c8 = p & 31;
            bf16_t* dst = c8 < 16 ? Xn + j * SS_LX + c8 * 8 : (c8 < 24 ? BM + j * SS_LT + (c8 - 16) * 8 : CM + j * SS_LT + (c8 - 24) * 8);
            *(u32x4*)dst = pr[q]; }
        if (wid < 2) {
            const float dt = softplusf_(bf2f(pdt) + dtb);
            float b = -dt * aexp;
#pragma unroll
            for (int o = 1; o < 64; o <<= 1) { const float t = __shfl_up(b, o); if (lane >= o) b += t; }
            const float b63 = __shfl(b, 63);
            s_b[wid * 64 + lane] = b; s_dt[wid * 64 + lane] = dt; s_e[wid * 64 + lane] = __expf(b63 - b) * dt;
            if (lane == 0) s_misc[wid] = __expf(b63);
        }
        if (ci + 1 < TT / 64) SS_REQ(ci + 1);
        lds_barrier();
        {
            const int jt = wid >> 1;
#pragma unroll
            for (int q2 = 0; q2 < 2; ++q2) {
                const int st = (wid & 1) * 2 + q2;
                f32x4 acc = (f32x4){0.f, 0.f, 0.f, 0.f};
                if (st <= jt) {
                    const bf16x8 c0 = ldfrag(CM, SS_LT, jt * 16, 0, fr, fq), c1 = ldfrag(CM, SS_LT, jt * 16, 32, fr, fq), b0 = ldfrag(BM, SS_LT, st * 16, 0, fr, fq), b1 = ldfrag(BM, SS_LT, st * 16, 32, fr, fq);
                    __builtin_amdgcn_sched_barrier(0);
                    acc = mma16(c0, b0, acc); acc = mma16(c1, b1, acc);
                }
                const int s = st * 16 + fr;
#pragma unroll
                for (int hl = 0; hl < 2; ++hl) { const float bs = s_b[hl * 64 + s], ds = s_dt[hl * 64 + s];
#pragma unroll
                    for (int r = 0; r < 4; ++r) { const int j = jt * 16 + fq * 4 + r;
                        const float wv = (s <= j) ? acc[r] * __expf(s_b[hl * 64 + j] - bs) * ds : 0.f;
                        Wm[(hl * 64 + j) * SS_LT + s] = f2bf(wv); } }
            }
            {
                const int s = lane, n8 = wid;
                const u32x4 bv = *(const u32x4*)(BM + s * SS_LT + n8 * 8);
#pragma unroll
                for (int hl = 0; hl < 2; ++hl) { const float e = s_e[hl * 64 + s];
                    bf16_t* bt = BTE + (hl * 64 + n8 * 8) * SS_LT + s;
                    bt[0 * SS_LT] = f2bf(lo2f(bv.x) * e); bt[1 * SS_LT] = f2bf(hi2f(bv.x) * e); bt[2 * SS_LT] = f2bf(lo2f(bv.y) * e); bt[3 * SS_LT] = f2bf(hi2f(bv.y) * e);
                    bt[4 * SS_LT] = f2bf(lo2f(bv.z) * e); bt[5 * SS_LT] = f2bf(hi2f(bv.z) * e); bt[6 * SS_LT] = f2bf(lo2f(bv.w) * e); bt[7 * SS_LT] = f2bf(hi2f(bv.w) * e); }
#pragma unroll
                for (int i = 0; i < 2; ++i) { const int c8 = wid + i * 8;
                    const u32x4 xv = *(const u32x4*)(Xn + s * SS_LX + c8 * 8);
                    bf16_t* xt = XT + (c8 * 8) * SS_LT + s;
                    xt[0 * SS_LT] = (bf16_t)(xv.x & 0xffff); xt[1 * SS_LT] = (bf16_t)(xv.x >> 16); xt[2 * SS_LT] = (bf16_t)(xv.y & 0xffff); xt[3 * SS_LT] = (bf16_t)(xv.y >> 16);
                    xt[4 * SS_LT] = (bf16_t)(xv.z & 0xffff); xt[5 * SS_LT] = (bf16_t)(xv.z >> 16); xt[6 * SS_LT] = (bf16_t)(xv.w & 0xffff); xt[7 * SS_LT] = (bf16_t)(xv.w >> 16); }
            }
        }
        lds_barrier();
        {
            const int hl = hl_w, jt = wid & 3, j = jt * 16 + fr;
            const bf16_t* Wh = Wm + hl * 64 * SS_LT; const bf16_t* Xh = XT + hl * 64 * SS_LT; const bf16_t* Sh = Sb + hl * 64 * SS_LT;
            const float eb = __expf(s_b[hl * 64 + j]);
            const size_t row = (size_t)bl * TT + scan_t<64>(dir, ci, j);
            const bf16x8 w0 = ldfrag(Wh, SS_LT, jt * 16, 0, fr, fq), w1 = ldfrag(Wh, SS_LT, jt * 16, 32, fr, fq), m0 = ldfrag(CM, SS_LT, jt * 16, 0, fr, fq), m1 = ldfrag(CM, SS_LT, jt * 16, 32, fr, fq);
#pragma unroll
            for (int hh = 0; hh < 2; ++hh) {
                bf16x8 fx[2][2], fs2[2][2];
#pragma unroll
                for (int q = 0; q < 2; ++q)
#pragma unroll
                    for (int k = 0; k < 2; ++k) { fx[q][k] = ldfrag(Xh, SS_LT, (hh * 2 + q) * 16, k * 32, fr, fq); fs2[q][k] = ldfrag(Sh, SS_LT, (hh * 2 + q) * 16, k * 32, fr, fq); }
                f32x4 dx[2];
                if (!dir) { dx[0] = ld4bf(Xn + j * SS_LX + hl * 64 + (hh * 2) * 16 + fq * 4); dx[1] = ld4bf(Xn + j * SS_LX + hl * 64 + (hh * 2 + 1) * 16 + fq * 4); }
                __builtin_amdgcn_sched_barrier(0);
                f32x4 y1[2], y2[2];
#pragma unroll
                for (int q = 0; q < 2; ++q) { y1[q] = (f32x4){0.f, 0.f, 0.f, 0.f}; y2[q] = (f32x4){0.f, 0.f, 0.f, 0.f}; }
#pragma unroll
                for (int q = 0; q < 2; ++q) { y1[q] = mma16(fx[q][0], w0, y1[q]); y2[q] = mma16(fs2[q][0], m0, y2[q]); }
#pragma unroll
                for (int q = 0; q < 2; ++q) { y1[q] = mma16(fx[q][1], w1, y1[q]); y2[q] = mma16(fs2[q][1], m1, y2[q]); }
#pragma unroll
                for (int q = 0; q < 2; ++q) { f32x4 y = y1[q] + y2[q] * eb;
                    if (!dir) y = y + dx[q] * dskip;
                    st4bf(YOUT + row * ldy + (hh0 + hl) * 64 + (hh * 2 + q) * 16 + fq * 4, y); }
            }
        }
        lds_barrier();
        {
            const int hl = hl_w, pt = wid & 3; const float eb63 = s_misc[hl];
            const bf16_t* Xh = XT + hl * 64 * SS_LT; const bf16_t* Bh = BTE + hl * 64 * SS_LT; bf16_t* Sh = Sb + hl * 64 * SS_LT;
            const bf16x8 x0 = ldfrag(Xh, SS_LT, pt * 16, 0, fr, fq), x1 = ldfrag(Xh, SS_LT, pt * 16, 32, fr, fq);
            bf16x8 fb[4][2];
#pragma unroll
            for (int nt = 0; nt < 4; ++nt) { fb[nt][0] = ldfrag(Bh, SS_LT, nt * 16, 0, fr, fq); fb[nt][1] = ldfrag(Bh, SS_LT, nt * 16, 32, fr, fq); }
            __builtin_amdgcn_sched_barrier(0);
#pragma unroll
            for (int nt = 0; nt < 4; ++nt) Sacc[nt] = Sacc[nt] * eb63;
#pragma unroll
            for (int nt = 0; nt < 4; ++nt) Sacc[nt] = mma16(fb[nt][0], x0, Sacc[nt]);
#pragma unroll
            for (int nt = 0; nt < 4; ++nt) Sacc[nt] = mma16(fb[nt][1], x1, Sacc[nt]);
#pragma unroll
            for (int nt = 0; nt < 4; ++nt) st4bf(Sh + (pt * 16 + fr) * SS_LT + nt * 16 + fq * 4, Sacc[nt]);
        }
        lds_barrier();
    }
#undef SS_REQ
}

__device__ __forceinline__ void phase_scan_ab(const KP& kp, unsigned char* lds) {
    for (int rep = 0; rep < ((PROBE_DUP & 8192) ? 2 : 1); ++rep)
    for (int u = obid(); u < 256; u += gridDim.x) if (u < 128) { mlstm_unit(kp, lds, u >> 4, (u >> 2) & 3, (u >> 1) & 1, u & 1); __syncthreads(); }
    for (int rep = 0; rep < ((PROBE_DUP & 16384) ? 2 : 1); ++rep)
    for (int u = obid(); u < 256; u += gridDim.x) if (u >= 128) { const int v = u - 128; ssd_unit(kp, lds, v >> 4, (v >> 3) & 1, v & 7); __syncthreads(); }
}

PHASE_FN void phase_fin_ab(const KP& kp) {
    const int lane = otid() & 63, wid = __builtin_amdgcn_readfirstlane(otid() >> 6);
    const bf16_t* P = WSP(const bf16_t, WS_BIG + L0_P);
    bf16_t* AO = WSP(bf16_t, WS_BIG + L0_AO); const bf16_t* HB = WSP(const bf16_t, WS_BIG + L0_HB); const bf16_t* YB = WSP(const bf16_t, WS_BIG + L0_YB);
    const float* mln = KIN(11); const float* sn = KIN(17);
    for (int lr = obid() * 8 + wid; lr < RG; lr += gridDim.x * 8) {
        const bf16_t* pr = P + (size_t)lr * AB_N;
        f32x4 yz[4]; float ss2 = 0.f;
#pragma unroll
        for (int i = 0; i < 4; ++i) { const int col = i * 256 + lane * 4;
            const f32x4 hs = ld4bf(AO + (size_t)lr * 2048 + col) + ld4bf(HB + (size_t)lr * 1024 + col);
            float ss = hs[0] * hs[0] + hs[1] * hs[1] + hs[2] * hs[2] + hs[3] * hs[3];
            ss = wsum(ss); const float rstd = rsqrtf(ss * (1.0f / 256.0f) + EPS);
            const f32x4 og = ld4bf(pr + AB_OG + col), w = *(const f32x4*)(mln + col);
            f32x4 o;
#pragma unroll
            for (int r = 0; r < 4; ++r) o[r] = hs[r] * rstd * w[r] * sigmoidf_(og[r]);
            st4bf(AO + (size_t)lr * 2048 + col, o);
            const f32x4 ys = ld4bf(AO + (size_t)lr * 2048 + 1024 + col) + ld4bf(YB + (size_t)lr * 1024 + col), z = ld4bf(pr + AB_Z + col);
#pragma unroll
            for (int r = 0; r < 4; ++r) { yz[i][r] = ys[r] * siluf_(z[r]); ss2 += yz[i][r] * yz[i][r]; }
        }
        ss2 = wsum(ss2); const float rstd2 = rsqrtf(ss2 * (1.0f / 1024.0f) + EPS);
#pragma unroll
        for (int i = 0; i < 4; ++i) { const int col = i * 256 + lane * 4; st4bf(AO + (size_t)lr * 2048 + 1024 + col, yz[i] * rstd2 * *(const f32x4*)(sn + col)); }
    }
}

PHASE_FN void phase_gemm_in(const KP& kp, unsigned char* lds, int layer, int grp) {
    const int npad = layer == 0 ? AB_NPAD : CD_NPAD, n = layer == 0 ? AB_N : CD_N;
    pg8::Gemm g{(layer == 0 && grp == 0) ? WSP(const bf16_t, WS_BIG + L0_U) : WSP(const bf16_t, WS_V) + (size_t)grp * RG * 1024, WSP(const bf16_t, WS_WMIX), RG, npad, 1024, nullptr, 0x7fffffff};
    pg8::StaticOrder S; S.init(RG, npad, (int)gridDim.x, obid());
    pg8::EpiBfG E{WSP(bf16_t, WS_BIG), n, n, 0x7fffffff, 1.0f};
    pg8::gemm_phase<pg8::EpiBfG, pg8::StaticOrder, false>((PG8_LAS unsigned char*)lds, g, S, E, nullptr);
    __syncthreads();
}
PHASE_FN void phase_gemm_out_ab(const KP& kp, unsigned char* lds, int grp) {
    pg8::Gemm g{WSP(const bf16_t, WS_BIG + L0_AO), WSP(const bf16_t, WS_WMIX + WM_AB_OUT), RG, 1024, 2048, nullptr, 0x7fffffff};
    pg8::StaticOrder S; S.init(RG, 1024, (int)gridDim.x, obid());
    pg8::EpiBfG E{WSP(bf16_t, WS_BIG + L0_U), 1024, 1024, 0x7fffffff, 1.0f};
    pg8::gemm_phase<pg8::EpiBfG, pg8::StaticOrder, false>((PG8_LAS unsigned char*)lds, g, S, E, nullptr);
    __syncthreads();
    const int G = (int)gridDim.x, units = (RG / 256) * 4, two = units > G ? (units - G < G ? units - G : G) : 0;
    const int nb = G - two > 0 ? G - two : G, bid = G - two > 0 ? obid() - two : obid();
    if (bid >= 0) { if (grp == 0) phase_u(kp, 0, 1, bid, nb, true); else phase_conv_moe(kp, lds, 0, bid, nb); }
    __syncthreads();
}

PHASE_FN void phase_prep_cd(const KP& kp) {
    const int lane = otid() & 63, wid = __builtin_amdgcn_readfirstlane(otid() >> 6);
    bf16_t* P = WSP(bf16_t, WS_BIG + L1_P);
    bf16_t* SG = WSP(bf16_t, WS_SG);
    const float* qn = KIN(20); const float* kvn = KIN(22); const float* mu = KIN(24);
    for (int lr = obid() * 8 + wid; lr < RG; lr += gridDim.x * 8) {
        const int bl = lr / TT, t = lr - bl * TT;
        bf16_t* pr = P + (size_t)lr * CD_N;
        {
            const f32x4 x = ld4bf(pr + CD_M1 + lane * 4);
            float ss = x[0] * x[0] + x[1] * x[1] + x[2] * x[2] + x[3] * x[3]; ss = wsum(ss);
            const float rstd = rsqrtf(ss * (1.0f / 256.0f) + EPS);
            st4bf(pr + CD_M1 + lane * 4, x * rstd * *(const f32x4*)(kvn + lane * 4));
        }
        {
            const int lo = t < CTXL ? 0 : CTXL, hi = t < CTXL ? CTXL : TT, c = lane * 4;
            const f32x4 x = ld4bf(pr + CD_WL + c);
            const f32x4 xp = t > lo ? ld4bf(pr - CD_N + CD_WL + c) : (f32x4){0.f, 0.f, 0.f, 0.f};
            const f32x4 xn = t < hi - 1 ? ld4bf(pr + CD_N + CD_WL + c) : (f32x4){0.f, 0.f, 0.f, 0.f};
            f32x4 l = x + *(const f32x4*)(mu + CD_WL - CD_RW0 + c) * ((xp + xn) * 0.5f - x);
            if (c < 128) {
#pragma unroll
                for (int q = 0; q < 4; ++q) l[q] = tanhf_(l[q]); }
            st4bf(WSP(bf16_t, WS_BIG + L1_TWAL) + (size_t)lr * 256 + c, l);
        }
        if (t >= CTXL) {
            const int s = t - CTXL;
            float x0[3], x1[3]; float ss = 0.f;
#pragma unroll
            for (int i = 0; i < 3; ++i) { const unsigned w = *(const unsigned*)(pr + CD_M0 + i * 128 + lane * 2); x0[i] = lo2f(w); x1[i] = hi2f(w); ss += x0[i] * x0[i] + x1[i] * x1[i]; }
            ss = wsum(ss); const float rstd = rsqrtf(ss * (1.0f / 384.0f) + EPS);
#pragma unroll
            for (int i = 0; i < 3; ++i) { const int c = i * 128 + lane * 2; *(unsigned*)(pr + CD_M0 + c) = pack2(x0[i] * rstd * qn[c], x1[i] * rstd * qn[c + 1]); }
            if (lane < 16) {
                const float pos = (lane < 8) ? (float)(s >> 6) : (float)(s & 63);
                const float inv = __expf(-(float)(lane & 7) * (9.210340371976184f / 8.0f));
                float sn, cs; sincosf(pos * inv, &sn, &cs);
                const float a = bf2f(pr[CD_KR + lane]), b2 = bf2f(pr[CD_KR + 16 + lane]);
                pr[CD_KR + lane] = f2bf(a * cs - b2 * sn); pr[CD_KR + 16 + lane] = f2bf(a * sn + b2 * cs);
            }
            {
                const int c = lane * 2;
                const unsigned w = *(const unsigned*)(pr + CD_GL + c);
                const unsigned wp = s > 0 ? *(const unsigned*)(pr - CD_N + CD_GL + c) : 0u;
                const unsigned wn = s < SEQ - 1 ? *(const unsigned*)(pr + CD_N + CD_GL + c) : 0u;
                const float m0 = mu[CD_GL - CD_RW0 + c], m1 = mu[CD_GL - CD_RW0 + c + 1];
                const float g0 = lo2f(w) + m0 * (0.5f * (lo2f(wp) + lo2f(wn)) - lo2f(w));
                const float g1 = hi2f(w) + m1 * (0.5f * (hi2f(wp) + hi2f(wn)) - hi2f(w));
                *(unsigned*)(SG + ((size_t)bl * SEQ + s) * 128 + c) = pack2(sigmoidf_(g0), sigmoidf_(g1));
            }
        }
    }
}

PHASE_FN void phase_upproj(const KP& kp, unsigned char* lds) {
    const bf16_t* P = WSP(const bf16_t, WS_BIG + L1_P);
    {
        pg8::Gemm g{P + CD_M0, WSP(const bf16_t, WS_WMIX + WM_UQ), RGL, 768, 384, nullptr, 0x7fffffff, CD_N, 1};
        pg8::StaticOrder S; S.init(RGL, 768, (int)gridDim.x, obid());
        pg8::EpiBfG E{WSP(bf16_t, WS_BIG + L1_Q), 768, 768, 0x7fffffff, 1.0f};
        pg8::gemm_phase<pg8::EpiBfG, pg8::StaticOrder, false>((PG8_LAS unsigned char*)lds, g, S, E, nullptr);
    }
    __syncthreads();
    {
        pg8::Gemm g{P + CD_M1, WSP(const bf16_t, WS_WMIX + WM_UKV), RG, 1024, 256, nullptr, 0x7fffffff, CD_N, 0};
        pg8::StaticOrder S; S.init(RG, 1024, (int)gridDim.x, obid());
        pg8::EpiBfG E{WSP(bf16_t, WS_BIG + L1_KV), 1024, 1024, 0x7fffffff, 1.0f};
        pg8::gemm_phase<pg8::EpiBfG, pg8::StaticOrder, false>((PG8_LAS unsigned char*)lds, g, S, E, nullptr);
    }
    __syncthreads();
}

constexpr int AT_LQ = 104, AT_LV = 72;
PHASE_FN void attn_unit(const KP& kp, unsigned char* lds, int bl, int head, int qb) {
    const int tid = otid(), lane = tid & 63, wid = __builtin_amdgcn_readfirstlane(tid >> 6), fr = lane & 15, fq = lane >> 4;
    bf16_t* Qs = (bf16_t*)lds;
    bf16_t* Kt = Qs + 256 * AT_LQ;
    bf16_t* Vt = Kt + 2 * 64 * AT_LQ;
    const bf16_t* P = WSP(const bf16_t, WS_BIG + L1_P);
    const bf16_t* Q = WSP(const bf16_t, WS_BIG + L1_Q);
    const bf16_t* KV = WSP(const bf16_t, WS_BIG + L1_KV);
    bf16_t* AOUT = WSP(bf16_t, WS_BIG + L1_AOUT);
    const float SC = 0.10206207261596577f;
#pragma unroll
    for (int i = 0; i < 6; ++i) { const int p = tid + i * 512, r = p / 12, c = p % 12;
        *(u32x4*)(Qs + r * AT_LQ + c * 8) = *(const u32x4*)(Q + ((size_t)bl * SEQ + qb * 256 + r) * 768 + head * 96 + c * 8); }
    lds_barrier();
#pragma unroll
    for (int i = 0; i < 8; ++i) { const int p = tid + i * 512, r = p >> 4, f = p & 15, s = qb * 256 + r;
        const float pos = (f < 8) ? (float)(s >> 6) : (float)(s & 63);
        const float inv = __expf(-(float)(f & 7) * (9.210340371976184f / 8.0f));
        float sn, cs; sincosf(pos * inv, &sn, &cs);
        const float a = bf2f(Qs[r * AT_LQ + 64 + f]), b2 = bf2f(Qs[r * AT_LQ + 80 + f]);
        Qs[r * AT_LQ + 64 + f] = f2bf(a * cs - b2 * sn); Qs[r * AT_LQ + 80 + f] = f2bf(a * sn + b2 * cs); }
    lds_barrier();
    bf16x8 qf[2][3];
#pragma unroll
    for (int rt = 0; rt < 2; ++rt)
#pragma unroll
        for (int k = 0; k < 3; ++k) qf[rt][k] = ldfrag(Qs, AT_LQ, wid * 32 + rt * 16, k * 32, fr, fq);
    f32x4 ot[2][4];
#pragma unroll
    for (int rt = 0; rt < 2; ++rt)
#pragma unroll
        for (int i = 0; i < 4; ++i) ot[rt][i] = (f32x4){0.f, 0.f, 0.f, 0.f};
    float mrow[2] = {-1e30f, -1e30f}, lsum[2] = {0.f, 0.f};
    u32x4 pk0[2], pk1[2], pvv[2];
    const int kkey0 = tid / 12, kc0 = tid % 12, kkey1 = (tid + 512) / 12, kc1 = (tid + 512) % 12, vkey = tid & 63, vc8 = tid >> 6;
#define AT_REQ(kt_) do { _Pragma("unroll") for (int h_ = 0; h_ < 2; ++h_) { const size_t rb_ = (size_t)bl * TT + ((kt_) * 2 + h_) * 64; \
        pk0[h_] = kc0 < 8 ? *(const u32x4*)(KV + (rb_ + kkey0) * 1024 + head * 128 + kc0 * 8) : *(const u32x4*)(P + (rb_ + kkey0) * CD_N + CD_KR + (kc0 - 8) * 8); \
        if (tid < 256) pk1[h_] = kc1 < 8 ? *(const u32x4*)(KV + (rb_ + kkey1) * 1024 + head * 128 + kc1 * 8) : *(const u32x4*)(P + (rb_ + kkey1) * CD_N + CD_KR + (kc1 - 8) * 8); \
        pvv[h_] = *(const u32x4*)(KV + (rb_ + vkey) * 1024 + head * 128 + 64 + vc8 * 8); } } while (0)
    AT_REQ(0);
    const float SC2 = SC * 1.4426950408889634f;
    for (int kt = 0; kt < TT / 128; ++kt) {
        lds_barrier();
#pragma unroll
        for (int h_ = 0; h_ < 2; ++h_) {
            *(u32x4*)(Kt + (h_ * 64 + kkey0) * AT_LQ + kc0 * 8) = pk0[h_];
            if (tid < 256) *(u32x4*)(Kt + (h_ * 64 + kkey1) * AT_LQ + kc1 * 8) = pk1[h_];
            { bf16_t* vt = Vt + (h_ * 64 + vc8 * 8) * AT_LV + vkey; const u32x4 v = pvv[h_];
                vt[0 * AT_LV] = (bf16_t)(v.x & 0xffff); vt[1 * AT_LV] = (bf16_t)(v.x >> 16); vt[2 * AT_LV] = (bf16_t)(v.y & 0xffff); vt[3 * AT_LV] = (bf16_t)(v.y >> 16);
                vt[4 * AT_LV] = (bf16_t)(v.z & 0xffff); vt[5 * AT_LV] = (bf16_t)(v.z >> 16); vt[6 * AT_LV] = (bf16_t)(v.w & 0xffff); vt[7 * AT_LV] = (bf16_t)(v.w >> 16); }
        }
        if (kt + 1 < TT / 128) AT_REQ(kt + 1);
        lds_barrier();
#pragma unroll 1
        for (int hs = 0; hs < 2; ++hs) {
        const bf16_t* Kth = Kt + hs * 64 * AT_LQ; const bf16_t* Vth = Vt + hs * 64 * AT_LV;
        bf16x8 kf[3][4];
#pragma unroll
        for (int k = 0; k < 3; ++k)
#pragma unroll
            for (int kk = 0; kk < 4; ++kk) kf[k][kk] = ldfrag(Kth, AT_LQ, kk * 16, k * 32, fr, fq);
        u32x2 vlo[2][4], vhi[2][4];
#pragma unroll
        for (int k2 = 0; k2 < 2; ++k2)
#pragma unroll
            for (int dvt = 0; dvt < 4; ++dvt) { const bf16_t* vp = Vth + (dvt * 16 + fr) * AT_LV + k2 * 32 + fq * 4; vlo[k2][dvt] = *(const u32x2*)vp; vhi[k2][dvt] = *(const u32x2*)(vp + 16); }
        __builtin_amdgcn_sched_barrier(0);
        f32x4 st[2][4];
#pragma unroll
        for (int rt = 0; rt < 2; ++rt)
#pragma unroll
            for (int kk = 0; kk < 4; ++kk) st[rt][kk] = (f32x4){0.f, 0.f, 0.f, 0.f};
#pragma unroll
        for (int k = 0; k < 3; ++k)
#pragma unroll
            for (int kk = 0; kk < 4; ++kk)
#pragma unroll
                for (int rt = 0; rt < 2; ++rt) st[rt][kk] = mma16(kf[k][kk], qf[rt][k], st[rt][kk]);
        union { bf16x8 v; unsigned u[4]; } pb[2][2];
#pragma unroll
        for (int rt = 0; rt < 2; ++rt) {
            float mx = -1e30f;
#pragma unroll
            for (int kk = 0; kk < 4; ++kk) mx = fmaxf(mx, fmaxf(fmaxf(st[rt][kk][0], st[rt][kk][1]), fmaxf(st[rt][kk][2], st[rt][kk][3])));
            mx = fmaxf(mx, __shfl_xor(mx, 16)); mx = fmaxf(mx, __shfl_xor(mx, 32));
            const float mnew = fmaxf(mrow[rt], mx), mb = mnew * SC2;
            if (__builtin_amdgcn_ballot_w64(mnew > mrow[rt]) != 0ull) {
                const float alpha = __builtin_amdgcn_exp2f((mrow[rt] - mnew) * SC2);
                lsum[rt] *= alpha;
#pragma unroll
                for (int i = 0; i < 4; ++i) ot[rt][i] = ot[rt][i] * alpha;
            }
            mrow[rt] = mnew;
#pragma unroll
            for (int kk = 0; kk < 4; ++kk)
#pragma unroll
                for (int r = 0; r < 4; ++r) { const float pv = __builtin_amdgcn_exp2f(st[rt][kk][r] * SC2 - mb); st[rt][kk][r] = pv; lsum[rt] += pv; }
#pragma unroll
            for (int k2 = 0; k2 < 2; ++k2) {
                pb[rt][k2].u[0] = pack2(st[rt][2 * k2][0], st[rt][2 * k2][1]); pb[rt][k2].u[1] = pack2(st[rt][2 * k2][2], st[rt][2 * k2][3]);
                pb[rt][k2].u[2] = pack2(st[rt][2 * k2 + 1][0], st[rt][2 * k2 + 1][1]); pb[rt][k2].u[3] = pack2(st[rt][2 * k2 + 1][2], st[rt][2 * k2 + 1][3]); }
        }
#pragma unroll
        for (int k2 = 0; k2 < 2; ++k2)
#pragma unroll
            for (int dvt = 0; dvt < 4; ++dvt) { union { bf16x8 v; u32x2 h[2]; } va; va.h[0] = vlo[k2][dvt]; va.h[1] = vhi[k2][dvt];
#pragma unroll
                for (int rt = 0; rt < 2; ++rt) ot[rt][dvt] = mma16(va.v, pb[rt][k2].v, ot[rt][dvt]); }
        }
    }
#undef AT_REQ
#pragma unroll
    for (int rt = 0; rt < 2; ++rt) {
        float ls = lsum[rt]; ls += __shfl_xor(ls, 16); ls += __shfl_xor(ls, 32);
        const float rl = frcp_(ls);
        const size_t orow = (size_t)bl * SEQ + qb * 256 + wid * 32 + rt * 16 + fr;
#pragma unroll
        for (int dvt = 0; dvt < 4; ++dvt) st4bf(AOUT + orow * 1536 + head * 64 + dvt * 16 + fq * 4, ot[rt][dvt] * rl);
    }
}

constexpr int RW_LR = 200, RW_LP = 72;
struct TrueT { static constexpr bool value = true; }; struct FalseT { static constexpr bool value = false; };
PHASE_FN void rwkv_unit(const KP& kp, unsigned char* lds, int bl, int h, int dir) {
    const int tid = otid();
    constexpr int NC = TT / 32;
    bf16_t* RAW = (bf16_t*)lds;
    bf16_t* TWb = RAW + 34 * RW_LR;
    bf16_t* ALb = TWb + 32 * RW_LP;
    bf16_t* W2T = ALb + 32 * RW_LP;
    bf16_t* A2T = W2T + 64 * RW_LP;
    float* WLf = (float*)(A2T + 64 * RW_LP);
    float* ALf = WLf + 32 * 64;
    bf16_t* BK = (bf16_t*)WLf;
    float* WT = ALf + 32 * 64;
    bf16_t* AR = (bf16_t*)(WT + 8 * 64);
    float* AABT = (float*)(AR + 64 * RW_LP);
    bf16_t* ARB0 = (bf16_t*)(AABT + 32 * 36);
    bf16_t* AAK = ARB0 + 2 * 32 * 40;
    bf16_t* ARK = AAK + 32 * 40;
    float* RHS = (float*)(ARK + 32 * 40);
    float* YB = RHS + 32 * 64;
    bf16_t* ZVT0 = (bf16_t*)(YB + 32 * 64);
    bf16_t* BKh0 = ZVT0 + 2 * 64 * RW_LP;
    bf16_t* Sb = BKh0 + 2 * 64 * RW_LP;
    float* PL0 = (float*)(Sb + 64 * RW_LP);
    float* CV = PL0 + 2 * 64;
    bf16_t* A21b = (bf16_t*)(CV + 8 * 64);
    static_assert((34 * RW_LR + 2 * 32 * RW_LP + 2 * 64 * RW_LP) * 2 + (2 * 32 * 64 + 8 * 64) * 4 + 64 * RW_LP * 2 + 32 * 36 * 4 + 4 * 32 * 40 * 2 + 2 * 32 * 64 * 4
                  + 5 * 64 * RW_LP * 2 + (2 * 64 + 8 * 64) * 4 + 16 * 40 * 2 <= LDS_BYTES - 16, "rwkv LDS");
    const bf16_t* P = WSP(const bf16_t, WS_BIG + L1_P); const bf16_t* TWAL = WSP(const bf16_t, WS_BIG + L1_TWAL);
    bf16_t* OUT = WSP(bf16_t, WS_BIG + (dir ? L1_OB : L1_OF));
    float* BSC = WSP(float, WS_BSC) + (size_t)dir * RGL * 16;
    const float* mu = KIN(24);
    for (int i = tid; i < 64 * 64; i += 512) { const int c = i >> 6, n = i & 63;
        W2T[n * RW_LP + c] = f2bf(KIN(26)[((size_t)dir * 64 + c) * 1024 + h * 64 + n]); A2T[n * RW_LP + c] = f2bf(KIN(28)[((size_t)dir * 64 + c) * 1024 + h * 64 + n]); }
    for (int i = tid; i < 64 * RW_LP; i += 512) Sb[i] = 0;
    for (int i = tid; i < 16 * 40; i += 512) A21b[i] = 0;
    for (int i = tid; i < 2 * 64 * RW_LP; i += 512) ZVT0[i] = 0;
    if (tid < 64) { const int n = tid;
        CV[0 * 64 + n] = KIN(25)[dir * 1024 + h * 64 + n]; CV[1 * 64 + n] = KIN(27)[dir * 1024 + h * 64 + n];
        CV[2 * 64 + n] = KIN(30)[h * 64 + n]; CV[3 * 64 + n] = KIN(31)[h * 64 + n]; CV[4 * 64 + n] = KIN(32)[h * 64 + n];
        CV[5 * 64 + n] = mu[h * 64 + n]; CV[6 * 64 + n] = mu[1024 + h * 64 + n]; CV[7 * 64 + n] = mu[2048 + h * 64 + n]; }
    f32x4 Sacc[2];
    Sacc[0] = (f32x4){0.f, 0.f, 0.f, 0.f}; Sacc[1] = (f32x4){0.f, 0.f, 0.f, 0.f};
    u32x4 pf[3];
#define RW_PREFETCH(cn, tix) do { const int t0n_ = dir ? scan_t<32>(1, (cn), 31) : (cn) * 32; const int lo_ = t0n_ < CTXL ? 0 : CTXL, hi_ = t0n_ < CTXL ? CTXL : TT; \
        _Pragma("unroll") for (int q = 0; q < 2; ++q) { const int p = (tix) + q * 512; pf[q] = (u32x4){0u, 0u, 0u, 0u}; \
            if (p < 34 * 24) { const int rr = p / 24, c = p % 24, t = t0n_ - 1 + rr; \
                if (t >= lo_ && t < hi_) { const int seg = c >> 3, c8 = c & 7; \
                    const int col = (seg == 0 ? CD_R : seg == 1 ? CD_K : CD_V) + h * 64; \
                    pf[q] = *(const u32x4*)(P + ((size_t)bl * TT + t) * CD_N + col + c8 * 8); } } } \
        { const int i_ = (tix) >> 4, c16 = (tix) & 15; \
          pf[2] = *(const u32x4*)(TWAL + ((size_t)bl * TT + t0n_ + i_) * 256 + (c16 >> 3) * 128 + dir * 64 + (c16 & 7) * 8); } } while (0)
    RW_PREFETCH(0, tid);
    lds_barrier();
    auto step = [&](auto doP_t, auto doD_t, const int ci) __attribute__((always_inline)) {
        constexpr bool doP = decltype(doP_t)::value, doD = decltype(doD_t)::value;
        int tq = tid; asm volatile("" : "+v"(tq));
        const int lane = tq & 63, wid = __builtin_amdgcn_readfirstlane(tq >> 6), fr = lane & 15, fq = lane >> 4, pi = tq >> 4, n4 = (tq & 15) * 4;
        const int cp = ci + 1, pc = ci & 1, pn = cp & 1;
        const int t0 = dir ? scan_t<32>(1, ci, 31) : ci * 32, t0p = dir ? scan_t<32>(1, cp, 31) : cp * 32;
        bf16_t* ZVc = ZVT0 + pc * 64 * RW_LP; bf16_t* ZVn = ZVT0 + pn * 64 * RW_LP;
        const bf16_t* BKhc = BKh0 + pc * 64 * RW_LP; bf16_t* BKhn = BKh0 + pn * 64 * RW_LP;
        const bf16_t* ARBc = ARB0 + pc * 32 * 40; bf16_t* ARBn = ARB0 + pn * 32 * 40;
        const float* PLc = PL0 + pc * 64; float* PLn = PL0 + pn * 64;
        if constexpr (doP) {
#pragma unroll
            for (int q = 0; q < 2; ++q) { const int p = tq + q * 512; if (p < 34 * 24) *(u32x4*)(RAW + (p / 24) * RW_LR + (p % 24) * 8) = pf[q]; }
            { const int i_ = tq >> 4, c16 = tq & 15; *(u32x4*)(((c16 >> 3) ? ALb : TWb) + i_ * RW_LP + (c16 & 7) * 8) = pf[2]; }
        }
        if constexpr (doD) for (int rep_ = 0; rep_ < ((RWP & 32) ? 2 : 1); ++rep_) {
            const int which = wid >> 2, tt = (wid >> 1) & 1;
            const bf16_t* Ak = which ? ARK : AAK; float* Od = which ? YB : RHS;
#pragma unroll
            for (int q2 = 0; q2 < 2; ++q2) {
                const int vt = (wid & 1) * 2 + q2;
                f32x4 acc = (f32x4){0.f, 0.f, 0.f, 0.f};
#pragma unroll
                for (int k = 0; k < 2; ++k) acc = mma16(ldfrag(AR, RW_LP, which * 32 + tt * 16, k * 32, fr, fq), ldfrag(Sb, RW_LP, vt * 16, k * 32, fr, fq), acc);
                acc = mma16(ldfrag(Ak, 40, tt * 16, 0, fr, fq), ldfrag(ZVc, RW_LP, vt * 16, 32, fr, fq), acc);
#pragma unroll
                for (int rr = 0; rr < 4; ++rr) Od[(tt * 16 + fq * 4 + rr) * 64 + vt * 16 + fr] = acc[rr];
            }
        }
        if constexpr (doP) { if (cp + 1 < NC) RW_PREFETCH(cp + 1, tq); }
        lds_barrier();
        if constexpr (doD) if (wid == 0) for (int rep_ = 0; rep_ < ((RWP & 1) ? 2 : 1); ++rep_) {
                float z[16]; f32x4 ca0, ca1, ca2, ca3, cb0, cb1, cb2, cb3;
#pragma unroll
                for (int t = 0; t < 16; ++t) z[t] = RHS[(0 + t) * 64 + lane];
                ca0 = *(const f32x4*)(AABT + 0 * 36 + 0); ca1 = *(const f32x4*)(AABT + 0 * 36 + 4); ca2 = *(const f32x4*)(AABT + 0 * 36 + 8); ca3 = *(const f32x4*)(AABT + 0 * 36 + 12);
                cb0 = *(const f32x4*)(AABT + 1 * 36 + 0); cb1 = *(const f32x4*)(AABT + 1 * 36 + 4); cb2 = *(const f32x4*)(AABT + 1 * 36 + 8); cb3 = *(const f32x4*)(AABT + 1 * 36 + 12);
                { const float zs = z[0]; z[1] = __builtin_fmaf(ca0[1], zs, z[1]); z[2] = __builtin_fmaf(ca0[2], zs, z[2]); z[3] = __builtin_fmaf(ca0[3], zs, z[3]); z[4] = __builtin_fmaf(ca1[0], zs, z[4]); z[5] = __builtin_fmaf(ca1[1], zs, z[5]); z[6] = __builtin_fmaf(ca1[2], zs, z[6]); z[7] = __builtin_fmaf(ca1[3], zs, z[7]); z[8] = __builtin_fmaf(ca2[0], zs, z[8]); z[9] = __builtin_fmaf(ca2[1], zs, z[9]); z[10] = __builtin_fmaf(ca2[2], zs, z[10]); z[11] = __builtin_fmaf(ca2[3], zs, z[11]); z[12] = __builtin_fmaf(ca3[0], zs, z[12]); z[13] = __builtin_fmaf(ca3[1], zs, z[13]); z[14] = __builtin_fmaf(ca3[2], zs, z[14]); z[15] = __builtin_fmaf(ca3[3], zs, z[15]); }
                asm volatile("" : "+v"(z[1]) :: "memory");
                ca0 = *(const f32x4*)(AABT + 2 * 36 + 0); ca1 = *(const f32x4*)(AABT + 2 * 36 + 4); ca2 = *(const f32x4*)(AABT + 2 * 36 + 8); ca3 = *(const f32x4*)(AABT + 2 * 36 + 12);
                { const float zs = z[1]; z[2] = __builtin_fmaf(cb0[2], zs, z[2]); z[3] = __builtin_fmaf(cb0[3], zs, z[3]); z[4] = __builtin_fmaf(cb1[0], zs, z[4]); z[5] = __builtin_fmaf(cb1[1], zs, z[5]); z[6] = __builtin_fmaf(cb1[2], zs, z[6]); z[7] = __builtin_fmaf(cb1[3], zs, z[7]); z[8] = __builtin_fmaf(cb2[0], zs, z[8]); z[9] = __builtin_fmaf(cb2[1], zs, z[9]); z[10] = __builtin_fmaf(cb2[2], zs, z[10]); z[11] = __builtin_fmaf(cb2[3], zs, z[11]); z[12] = __builtin_fmaf(cb3[0], zs, z[12]); z[13] = __builtin_fmaf(cb3[1], zs, z[13]); z[14] = __builtin_fmaf(cb3[2], zs, z[14]); z[15] = __builtin_fmaf(cb3[3], zs, z[15]); }
                asm volatile("" : "+v"(z[2]) :: "memory");
                cb1 = *(const f32x4*)(AABT + 3 * 36 + 4); cb2 = *(const f32x4*)(AABT + 3 * 36 + 8); cb3 = *(const f32x4*)(AABT + 3 * 36 + 12);
                { const float zs = z[2]; z[3] = __builtin_fmaf(ca0[3], zs, z[3]); z[4] = __builtin_fmaf(ca1[0], zs, z[4]); z[5] = __builtin_fmaf(ca1[1], zs, z[5]); z[6] = __builtin_fmaf(ca1[2], zs, z[6]); z[7] = __builtin_fmaf(ca1[3], zs, z[7]); z[8] = __builtin_fmaf(ca2[0], zs, z[8]); z[9] = __builtin_fmaf(ca2[1], zs, z[9]); z[10] = __builtin_fmaf(ca2[2], zs, z[10]); z[11] = __builtin_fmaf(ca2[3], zs, z[11]); z[12] = __builtin_fmaf(ca3[0], zs, z[12]); z[13] = __builtin_fmaf(ca3[1], zs, z[13]); z[14] = __builtin_fmaf(ca3[2], zs, z[14]); z[15] = __builtin_fmaf(ca3[3], zs, z[15]); }
                asm volatile("" : "+v"(z[3]) :: "memory");
                ca1 = *(const f32x4*)(AABT + 4 * 36 + 4); ca2 = *(const f32x4*)(AABT + 4 * 36 + 8); ca3 = *(const f32x4*)(AABT + 4 * 36 + 12);
                { const float zs = z[3]; z[4] = __builtin_fmaf(cb1[0], zs, z[4]); z[5] = __builtin_fmaf(cb1[1], zs, z[5]); z[6] = __builtin_fmaf(cb1[2], zs, z[6]); z[7] = __builtin_fmaf(cb1[3], zs, z[7]); z[8] = __builtin_fmaf(cb2[0], zs, z[8]); z[9] = __builtin_fmaf(cb2[1], zs, z[9]); z[10] = __builtin_fmaf(cb2[2], zs, z[10]); z[11] = __builtin_fmaf(cb2[3], zs, z[11]); z[12] = __builtin_fmaf(cb3[0], zs, z[12]); z[13] = __builtin_fmaf(cb3[1], zs, z[13]); z[14] = __builtin_fmaf(cb3[2], zs, z[14]); z[15] = __builtin_fmaf(cb3[3], zs, z[15]); }
                asm volatile("" : "+v"(z[4]) :: "memory");
                cb1 = *(const f32x4*)(AABT + 5 * 36 + 4); cb2 = *(const f32x4*)(AABT + 5 * 36 + 8); cb3 = *(const f32x4*)(AABT + 5 * 36 + 12);
                { const float zs = z[4]; z[5] = __builtin_fmaf(ca1[1], zs, z[5]); z[6] = __builtin_fmaf(ca1[2], zs, z[6]); z[7] = __builtin_fmaf(ca1[3], zs, z[7]); z[8] = __builtin_fmaf(ca2[0], zs, z[8]); z[9] = __builtin_fmaf(ca2[1], zs, z[9]); z[10] = __builtin_fmaf(ca2[2], zs, z[10]); z[11] = __builtin_fmaf(ca2[3], zs, z[11]); z[12] = __builtin_fmaf(ca3[0], zs, z[12]); z[13] = __builtin_fmaf(ca3[1], zs, z[13]); z[14] = __builtin_fmaf(ca3[2], zs, z[14]); z[15] = __builtin_fmaf(ca3[3], zs, z[15]); }
                asm volatile("" : "+v"(z[5]) :: "memory");
                ca1 = *(const f32x4*)(AABT + 6 * 36 + 4); ca2 = *(const f32x4*)(AABT + 6 * 36 + 8); ca3 = *(const f32x4*)(AABT + 6 * 36 + 12);
                { const float zs = z[5]; z[6] = __builtin_fmaf(cb1[2], zs, z[6]); z[7] = __builtin_fmaf(cb1[3], zs, z[7]); z[8] = __builtin_fmaf(cb2[0], zs, z[8]); z[9] = __builtin_fmaf(cb2[1], zs, z[9]); z[10] = __builtin_fmaf(cb2[2], zs, z[10]); z[11] = __builtin_fmaf(cb2[3], zs, z[11]); z[12] = __builtin_fmaf(cb3[0], zs, z[12]); z[13] = __builtin_fmaf(cb3[1], zs, z[13]); z[14] = __builtin_fmaf(cb3[2], zs, z[14]); z[15] = __builtin_fmaf(cb3[3], zs, z[15]); }
                asm volatile("" : "+v"(z[6]) :: "memory");
                cb2 = *(const f32x4*)(AABT + 7 * 36 + 8); cb3 = *(const f32x4*)(AABT + 7 * 36 + 12);
                { const float zs = z[6]; z[7] = __builtin_fmaf(ca1[3], zs, z[7]); z[8] = __builtin_fmaf(ca2[0], zs, z[8]); z[9] = __builtin_fmaf(ca2[1], zs, z[9]); z[10] = __builtin_fmaf(ca2[2], zs, z[10]); z[11] = __builtin_fmaf(ca2[3], zs, z[11]); z[12] = __builtin_fmaf(ca3[0], zs, z[12]); z[13] = __builtin_fmaf(ca3[1], zs, z[13]); z[14] = __builtin_fmaf(ca3[2], zs, z[14]); z[15] = __builtin_fmaf(ca3[3], zs, z[15]); }
                asm volatile("" : "+v"(z[7]) :: "memory");
                ca2 = *(const f32x4*)(AABT + 8 * 36 + 8); ca3 = *(const f32x4*)(AABT + 8 * 36 + 12);
                { const float zs = z[7]; z[8] = __builtin_fmaf(cb2[0], zs, z[8]); z[9] = __builtin_fmaf(cb2[1], zs, z[9]); z[10] = __builtin_fmaf(cb2[2], zs, z[10]); z[11] = __builtin_fmaf(cb2[3], zs, z[11]); z[12] = __builtin_fmaf(cb3[0], zs, z[12]); z[13] = __builtin_fmaf(cb3[1], zs, z[13]); z[14] = __builtin_fmaf(cb3[2], zs, z[14]); z[15] = __builtin_fmaf(cb3[3], zs, z[15]); }
                asm volatile("" : "+v"(z[8]) :: "memory");
                cb2 = *(const f32x4*)(AABT + 9 * 36 + 8); cb3 = *(const f32x4*)(AABT + 9 * 36 + 12);
                { const float zs = z[8]; z[9] = __builtin_fmaf(ca2[1], zs, z[9]); z[10] = __builtin_fmaf(ca2[2], zs, z[10]); z[11] = __builtin_fmaf(ca2[3], zs, z[11]); z[12] = __builtin_fmaf(ca3[0], zs, z[12]); z[13] = __builtin_fmaf(ca3[1], zs, z[13]); z[14] = __builtin_fmaf(ca3[2], zs, z[14]); z[15] = __builtin_fmaf(ca3[3], zs, z[15]); }
                asm volatile("" : "+v"(z[9]) :: "memory");
                ca2 = *(const f32x4*)(AABT + 10 * 36 + 8); ca3 = *(const f32x4*)(AABT + 10 * 36 + 12);
                { const float zs = z[9]; z[10] = __builtin_fmaf(cb2[2], zs, z[10]); z[11] = __builtin_fmaf(cb2[3], zs, z[11]); z[12] = __builtin_fmaf(cb3[0], zs, z[12]); z[13] = __builtin_fmaf(cb3[1], zs, z[13]); z[14] = __builtin_fmaf(cb3[2], zs, z[14]); z[15] = __builtin_fmaf(cb3[3], zs, z[15]); }
                asm volatile("" : "+v"(z[10]) :: "memory");
                cb3 = *(const f32x4*)(AABT + 11 * 36 + 12);
                { const float zs = z[10]; z[11] = __builtin_fmaf(ca2[3], zs, z[11]); z[12] = __builtin_fmaf(ca3[0], zs, z[12]); z[13] = __builtin_fmaf(ca3[1], zs, z[13]); z[14] = __builtin_fmaf(ca3[2], zs, z[14]); z[15] = __builtin_fmaf(ca3[3], zs, z[15]); }
                asm volatile("" : "+v"(z[11]) :: "memory");
                ca3 = *(const f32x4*)(AABT + 12 * 36 + 12);
                { const float zs = z[11]; z[12] = __builtin_fmaf(cb3[0], zs, z[12]); z[13] = __builtin_fmaf(cb3[1], zs, z[13]); z[14] = __builtin_fmaf(cb3[2], zs, z[14]); z[15] = __builtin_fmaf(cb3[3], zs, z[15]); }
                asm volatile("" : "+v"(z[12]) :: "memory");
                cb3 = *(const f32x4*)(AABT + 13 * 36 + 12);
                { const float zs = z[12]; z[13] = __builtin_fmaf(ca3[1], zs, z[13]); z[14] = __builtin_fmaf(ca3[2], zs, z[14]); z[15] = __builtin_fmaf(ca3[3], zs, z[15]); }
                asm volatile("" : "+v"(z[13]) :: "memory");
                ca3 = *(const f32x4*)(AABT + 14 * 36 + 12);
                { const float zs = z[13]; z[14] = __builtin_fmaf(cb3[2], zs, z[14]); z[15] = __builtin_fmaf(cb3[3], zs, z[15]); }
                asm volatile("" : "+v"(z[14]) :: "memory");
                { const float zs = z[14]; z[15] = __builtin_fmaf(ca3[3], zs, z[15]); }
                asm volatile("" : "+v"(z[15]) :: "memory");
#pragma unroll
                for (int q = 0; q < 2; ++q) { u32x4 w; w.x = pack2(z[q * 8 + 0], z[q * 8 + 1]); w.y = pack2(z[q * 8 + 2], z[q * 8 + 3]); w.z = pack2(z[q * 8 + 4], z[q * 8 + 5]); w.w = pack2(z[q * 8 + 6], z[q * 8 + 7]);
                    *(u32x4*)(ZVc + lane * RW_LP + 0 + q * 8) = w; }
        }
        if constexpr (doP) for (int rep_ = 0; rep_ < ((RWP & 64) ? 2 : 1); ++rep_) {
            const int which = wid >> 2, tt = (wid >> 1) & 1;
            const bf16_t* Xa = which ? ALb : TWb; const bf16_t* Wt = which ? A2T : W2T; float* Od = which ? ALf : WLf;
#pragma unroll
            for (int q2 = 0; q2 < 2; ++q2) { const int nt = (wid & 1) * 2 + q2;
                f32x4 acc = (f32x4){0.f, 0.f, 0.f, 0.f};
#pragma unroll
                for (int k = 0; k < 2; ++k) acc = mma16(ldfrag(Xa, RW_LP, tt * 16, k * 32, fr, fq), ldfrag(Wt, RW_LP, nt * 16, k * 32, fr, fq), acc);
#pragma unroll
                for (int rr = 0; rr < 4; ++rr) Od[(tt * 16 + fq * 4 + rr) * 64 + nt * 16 + fr] = acc[rr]; }
            const int pp = tq & 31, cg = tq >> 5, jj = dir ? 31 - pp : pp;
            const bf16_t* r1v = RAW + (pp + 1) * RW_LR + 128 + cg * 4;
            const f32x4 muv = *(const f32x4*)(CV + 448 + cg * 4);
            f32x4 v = ld4bf(r1v);
            v = v + muv * ((ld4bf(r1v - RW_LR) + ld4bf(r1v + RW_LR)) * 0.5f - v);
#pragma unroll
            for (int q = 0; q < 4; ++q) ZVn[(cg * 4 + q) * RW_LP + 32 + jj] = f2bf(v[q]);
        }
        lds_barrier();
        if (RWP & 16) { lds_barrier(); lds_barrier(); lds_barrier(); lds_barrier(); lds_barrier(); }
        const int j = dir ? 31 - pi : pi;
        f32x4 r, kd, av, bv, lw, cin;
        f32x4 xacc = (f32x4){0.f, 0.f, 0.f, 0.f};
        if constexpr (doD) {
            xacc = mma16(ldfrag(A21b, 40, 0, 0, fr, fq), ldfrag(ZVc, RW_LP, (wid & 3) * 16, 0, fr, fq), xacc);
#pragma unroll
            for (int rr = 0; rr < 4; ++rr) xacc[rr] += RHS[(16 + fq * 4 + rr) * 64 + (wid & 3) * 16 + fr];
        }
        if constexpr (doP) for (int rep_ = 0; rep_ < ((RWP & 2) ? 2 : 1); ++rep_) {
            const f32x4 w0v = *(const f32x4*)(CV + n4), a0v = *(const f32x4*)(CV + 64 + n4), kkw = *(const f32x4*)(CV + 128 + n4), kaw = *(const f32x4*)(CV + 192 + n4), rkw = *(const f32x4*)(CV + 256 + n4);
            const f32x4 mur = *(const f32x4*)(CV + 320 + n4), muk = *(const f32x4*)(CV + 384 + n4);
            const f32x4 wl = w0v + *(const f32x4*)(WLf + pi * 64 + n4), al = a0v + *(const f32x4*)(ALf + pi * 64 + n4);
            const bf16_t* r1 = RAW + (pi + 1) * RW_LR; const bf16_t* rp = RAW + pi * RW_LR; const bf16_t* rn = RAW + (pi + 2) * RW_LR;
            f32x4 k;
            r = ld4bf(r1 + n4); k = ld4bf(r1 + 64 + n4);
            r = r + mur * ((ld4bf(rp + n4) + ld4bf(rn + n4)) * 0.5f - r);
            k = k + muk * ((ld4bf(rp + 64 + n4) + ld4bf(rn + 64 + n4)) * 0.5f - k);
            f32x4 a, kk = k * kkw;
            float ssq = kk[0] * kk[0] + kk[1] * kk[1] + kk[2] * kk[2] + kk[3] * kk[3];
            ssq = rsum16(ssq);
            kk = kk * __builtin_amdgcn_rsqf(fmaxf(ssq, 1e-24f));
#pragma unroll
            for (int q = 0; q < 4; ++q) { lw[q] = -0.6065306597126334f * sigmoidf_(wl[q]); a[q] = sigmoidf_(al[q]); }
            kd = k * ((a - 1.0f) * kaw + 1.0f);
            float bs = r[0] * kd[0] * rkw[0] + r[1] * kd[1] * rkw[1] + r[2] * kd[2] * rkw[2] + r[3] * kd[3] * rkw[3];
            bs = rsum16(bs);
            av = kk * -1.0f; bv = kk * a;
            f32x4 wt;
#pragma unroll
            for (int q = 0; q < 4; ++q) {
                const float lwq = lw[q];
                const auto e16 = __builtin_amdgcn_permlane16_swap(__builtin_bit_cast(unsigned, lwq), __builtin_bit_cast(unsigned, lwq), false, false);
                const unsigned e16a = e16[0], e16b = e16[1];
                const float y = __builtin_bit_cast(float, e16a) + __builtin_bit_cast(float, e16b);
                const auto e32 = __builtin_amdgcn_permlane32_swap(__builtin_bit_cast(unsigned, y), __builtin_bit_cast(unsigned, y), false, false);
                const unsigned e32a = e32[0], e32b = e32[1];
                wt[q] = __builtin_bit_cast(float, e32a) + __builtin_bit_cast(float, e32b);
                cin[q] = ((fq & 1) ? y : lwq) + ((fq & 2) ? (wt[q] - y) : 0.f);
            }
            if (fq == 0) *(f32x4*)(WT + wid * 64 + n4) = wt;
            const int t = t0p + pi;
            if (t >= CTXL && (tq & 15) == 0) BSC[((size_t)bl * SEQ + (t - CTXL)) * 16 + h] = bs;
        }
        if constexpr (doD) if (wid < 4) {
#pragma unroll
            for (int rr = 0; rr < 4; ++rr) RHS[(16 + fq * 4 + rr) * 64 + wid * 16 + fr] = xacc[rr];
        }
        lds_barrier();
        if constexpr (doD) if (wid == 0) for (int rep_ = 0; rep_ < ((RWP & 1) ? 2 : 1); ++rep_) {
                float z[16]; f32x4 ca0, ca1, ca2, ca3, cb0, cb1, cb2, cb3;
#pragma unroll
                for (int t = 0; t < 16; ++t) z[t] = RHS[(16 + t) * 64 + lane];
                ca0 = *(const f32x4*)(AABT + 16 * 36 + 16); ca1 = *(const f32x4*)(AABT + 16 * 36 + 20); ca2 = *(const f32x4*)(AABT + 16 * 36 + 24); ca3 = *(const f32x4*)(AABT + 16 * 36 + 28);
                cb0 = *(const f32x4*)(AABT + 17 * 36 + 16); cb1 = *(const f32x4*)(AABT + 17 * 36 + 20); cb2 = *(const f32x4*)(AABT + 17 * 36 + 24); cb3 = *(const f32x4*)(AABT + 17 * 36 + 28);
                { const float zs = z[0]; z[1] = __builtin_fmaf(ca0[1], zs, z[1]); z[2] = __builtin_fmaf(ca0[2], zs, z[2]); z[3] = __builtin_fmaf(ca0[3], zs, z[3]); z[4] = __builtin_fmaf(ca1[0], zs, z[4]); z[5] = __builtin_fmaf(ca1[1], zs, z[5]); z[6] = __builtin_fmaf(ca1[2], zs, z[6]); z[7] = __builtin_fmaf(ca1[3], zs, z[7]); z[8] = __builtin_fmaf(ca2[0], zs, z[8]); z[9] = __builtin_fmaf(ca2[1], zs, z[9]); z[10] = __builtin_fmaf(ca2[2], zs, z[10]); z[11] = __builtin_fmaf(ca2[3], zs, z[11]); z[12] = __builtin_fmaf(ca3[0], zs, z[12]); z[13] = __builtin_fmaf(ca3[1], zs, z[13]); z[14] = __builtin_fmaf(ca3[2], zs, z[14]); z[15] = __builtin_fmaf(ca3[3], zs, z[15]); }
                asm volatile("" : "+v"(z[1]) :: "memory");
                ca0 = *(const f32x4*)(AABT + 18 * 36 + 16); ca1 = *(const f32x4*)(AABT + 18 * 36 + 20); ca2 = *(const f32x4*)(AABT + 18 * 36 + 24); ca3 = *(const f32x4*)(AABT + 18 * 36 + 28);
                { const float zs = z[1]; z[2] = __builtin_fmaf(cb0[2], zs, z[2]); z[3] = __builtin_fmaf(cb0[3], zs, z[3]); z[4] = __builtin_fmaf(cb1[0], zs, z[4]); z[5] = __builtin_fmaf(cb1[1], zs, z[5]); z[6] = __builtin_fmaf(cb1[2], zs, z[6]); z[7] = __builtin_fmaf(cb1[3], zs, z[7]); z[8] = __builtin_fmaf(cb2[0], zs, z[8]); z[9] = __builtin_fmaf(cb2[1], zs, z[9]); z[10] = __builtin_fmaf(cb2[2], zs, z[10]); z[11] = __builtin_fmaf(cb2[3], zs, z[11]); z[12] = __builtin_fmaf(cb3[0], zs, z[12]); z[13] = __builtin_fmaf(cb3[1], zs, z[13]); z[14] = __builtin_fmaf(cb3[2], zs, z[14]); z[15] = __builtin_fmaf(cb3[3], zs, z[15]); }
                asm volatile("" : "+v"(z[2]) :: "memory");
                cb1 = *(const f32x4*)(AABT + 19 * 36 + 20); cb2 = *(const f32x4*)(AABT + 19 * 36 + 24); cb3 = *(const f32x4*)(AABT + 19 * 36 + 28);
                { const float zs = z[2]; z[3] = __builtin_fmaf(ca0[3], zs, z[3]); z[4] = __builtin_fmaf(ca1[0], zs, z[4]); z[5] = __builtin_fmaf(ca1[1], zs, z[5]); z[6] = __builtin_fmaf(ca1[2], zs, z[6]); z[7] = __builtin_fmaf(ca1[3], zs, z[7]); z[8] = __builtin_fmaf(ca2[0], zs, z[8]); z[9] = __builtin_fmaf(ca2[1], zs, z[9]); z[10] = __builtin_fmaf(ca2[2], zs, z[10]); z[11] = __builtin_fmaf(ca2[3], zs, z[11]); z[12] = __builtin_fmaf(ca3[0], zs, z[12]); z[13] = __builtin_fmaf(ca3[1], zs, z[13]); z[14] = __builtin_fmaf(ca3[2], zs, z[14]); z[15] = __builtin_fmaf(ca3[3], zs, z[15]); }
                asm volatile("" : "+v"(z[3]) :: "memory");
                ca1 = *(const f32x4*)(AABT + 20 * 36 + 20); ca2 = *(const f32x4*)(AABT + 20 * 36 + 24); ca3 = *(const f32x4*)(AABT + 20 * 36 + 28);
                { const float zs = z[3]; z[4] = __builtin_fmaf(cb1[0], zs, z[4]); z[5] = __builtin_fmaf(cb1[1], zs, z[5]); z[6] = __builtin_fmaf(cb1[2], zs, z[6]); z[7] = __builtin_fmaf(cb1[3], zs, z[7]); z[8] = __builtin_fmaf(cb2[0], zs, z[8]); z[9] = __builtin_fmaf(cb2[1], zs, z[9]); z[10] = __builtin_fmaf(cb2[2], zs, z[10]); z[11] = __builtin_fmaf(cb2[3], zs, z[11]); z[12] = __builtin_fmaf(cb3[0], zs, z[12]); z[13] = __builtin_fmaf(cb3[1], zs, z[13]); z[14] = __builtin_fmaf(cb3[2], zs, z[14]); z[15] = __builtin_fmaf(cb3[3], zs, z[15]); }
                asm volatile("" : "+v"(z[4]) :: "memory");
                cb1 = *(const f32x4*)(AABT + 21 * 36 + 20); cb2 = *(const f32x4*)(AABT + 21 * 36 + 24); cb3 = *(const f32x4*)(AABT + 21 * 36 + 28);
                { const float zs = z[4]; z[5] = __builtin_fmaf(ca1[1], zs, z[5]); z[6] = __builtin_fmaf(ca1[2], zs, z[6]); z[7] = __builtin_fmaf(ca1[3], zs, z[7]); z[8] = __builtin_fmaf(ca2[0], zs, z[8]); z[9] = __builtin_fmaf(ca2[1], zs, z[9]); z[10] = __builtin_fmaf(ca2[2], zs, z[10]); z[11] = __builtin_fmaf(ca2[3], zs, z[11]); z[12] = __builtin_fmaf(ca3[0], zs, z[12]); z[13] = __builtin_fmaf(ca3[1], zs, z[13]); z[14] = __builtin_fmaf(ca3[2], zs, z[14]); z[15] = __builtin_fmaf(ca3[3], zs, z[15]); }
                asm volatile("" : "+v"(z[5]) :: "memory");
                ca1 = *(const f32x4*)(AABT + 22 * 36 + 20); ca2 = *(const f32x4*)(AABT + 22 * 36 + 24); ca3 = *(const f32x4*)(AABT + 22 * 36 + 28);
                { const float zs = z[5]; z[6] = __builtin_fmaf(cb1[2], zs, z[6]); z[7] = __builtin_fmaf(cb1[3], zs, z[7]); z[8] = __builtin_fmaf(cb2[0], zs, z[8]); z[9] = __builtin_fmaf(cb2[1], zs, z[9]); z[10] = __builtin_fmaf(cb2[2], zs, z[10]); z[11] = __builtin_fmaf(cb2[3], zs, z[11]); z[12] = __builtin_fmaf(cb3[0], zs, z[12]); z[13] = __builtin_fmaf(cb3[1], zs, z[13]); z[14] = __builtin_fmaf(cb3[2], zs, z[14]); z[15] = __builtin_fmaf(cb3[3], zs, z[15]); }
                asm volatile("" : "+v"(z[6]) :: "memory");
                cb2 = *(const f32x4*)(AABT + 23 * 36 + 24); cb3 = *(const f32x4*)(AABT + 23 * 36 + 28);
                { const float zs = z[6]; z[7] = __builtin_fmaf(ca1[3], zs, z[7]); z[8] = __builtin_fmaf(ca2[0], zs, z[8]); z[9] = __builtin_fmaf(ca2[1], zs, z[9]); z[10] = __builtin_fmaf(ca2[2], zs, z[10]); z[11] = __builtin_fmaf(ca2[3], zs, z[11]); z[12] = __builtin_fmaf(ca3[0], zs, z[12]); z[13] = __builtin_fmaf(ca3[1], zs, z[13]); z[14] = __builtin_fmaf(ca3[2], zs, z[14]); z[15] = __builtin_fmaf(ca3[3], zs, z[15]); }
                asm volatile("" : "+v"(z[7]) :: "memory");
                ca2 = *(const f32x4*)(AABT + 24 * 36 + 24); ca3 = *(const f32x4*)(AABT + 24 * 36 + 28);
                { const float zs = z[7]; z[8] = __builtin_fmaf(cb2[0], zs, z[8]); z[9] = __builtin_fmaf(cb2[1], zs, z[9]); z[10] = __builtin_fmaf(cb2[2], zs, z[10]); z[11] = __builtin_fmaf(cb2[3], zs, z[11]); z[12] = __builtin_fmaf(cb3[0], zs, z[12]); z[13] = __builtin_fmaf(cb3[1], zs, z[13]); z[14] = __builtin_fmaf(cb3[2], zs, z[14]); z[15] = __builtin_fmaf(cb3[3], zs, z[15]); }
                asm volatile("" : "+v"(z[8]) :: "memory");
                cb2 = *(const f32x4*)(AABT + 25 * 36 + 24); cb3 = *(const f32x4*)(AABT + 25 * 36 + 28);
                { const float zs = z[8]; z[9] = __builtin_fmaf(ca2[1], zs, z[9]); z[10] = __builtin_fmaf(ca2[2], zs, z[10]); z[11] = __builtin_fmaf(ca2[3], zs, z[11]); z[12] = __builtin_fmaf(ca3[0], zs, z[12]); z[13] = __builtin_fmaf(ca3[1], zs, z[13]); z[14] = __builtin_fmaf(ca3[2], zs, z[14]); z[15] = __builtin_fmaf(ca3[3], zs, z[15]); }
                asm volatile("" : "+v"(z[9]) :: "memory");
                ca2 = *(const f32x4*)(AABT + 26 * 36 + 24); ca3 = *(const f32x4*)(AABT + 26 * 36 + 28);
                { const float zs = z[9]; z[10] = __builtin_fmaf(cb2[2], zs, z[10]); z[11] = __builtin_fmaf(cb2[3], zs, z[11]); z[12] = __builtin_fmaf(cb3[0], zs, z[12]); z[13] = __builtin_fmaf(cb3[1], zs, z[13]); z[14] = __builtin_fmaf(cb3[2], zs, z[14]); z[15] = __builtin_fmaf(cb3[3], zs, z[15]); }
                asm volatile("" : "+v"(z[10]) :: "memory");
                cb3 = *(const f32x4*)(AABT + 27 * 36 + 28);
                { const float zs = z[10]; z[11] = __builtin_fmaf(ca2[3], zs, z[11]); z[12] = __builtin_fmaf(ca3[0], zs, z[12]); z[13] = __builtin_fmaf(ca3[1], zs, z[13]); z[14] = __builtin_fmaf(ca3[2], zs, z[14]); z[15] = __builtin_fmaf(ca3[3], zs, z[15]); }
                asm volatile("" : "+v"(z[11]) :: "memory");
                ca3 = *(const f32x4*)(AABT + 28 * 36 + 28);
                { const float zs = z[11]; z[12] = __builtin_fmaf(cb3[0], zs, z[12]); z[13] = __builtin_fmaf(cb3[1], zs, z[13]); z[14] = __builtin_fmaf(cb3[2], zs, z[14]); z[15] = __builtin_fmaf(cb3[3], zs, z[15]); }
                asm volatile("" : "+v"(z[12]) :: "memory");
                cb3 = *(const f32x4*)(AABT + 29 * 36 + 28);
                { const float zs = z[12]; z[13] = __builtin_fmaf(ca3[1], zs, z[13]); z[14] = __builtin_fmaf(ca3[2], zs, z[14]); z[15] = __builtin_fmaf(ca3[3], zs, z[15]); }
                asm volatile("" : "+v"(z[13]) :: "memory");
                ca3 = *(const f32x4*)(AABT + 30 * 36 + 28);
                { const float zs = z[13]; z[14] = __builtin_fmaf(cb3[2], zs, z[14]); z[15] = __builtin_fmaf(cb3[3], zs, z[15]); }
                asm volatile("" : "+v"(z[14]) :: "memory");
                { const float zs = z[14]; z[15] = __builtin_fmaf(ca3[3], zs, z[15]); }
                asm volatile("" : "+v"(z[15]) :: "memory");
#pragma unroll
                for (int q = 0; q < 2; ++q) { u32x4 w; w.x = pack2(z[q * 8 + 0], z[q * 8 + 1]); w.y = pack2(z[q * 8 + 2], z[q * 8 + 3]); w.z = pack2(z[q * 8 + 4], z[q * 8 + 5]); w.w = pack2(z[q * 8 + 6], z[q * 8 + 7]);
                    *(u32x4*)(ZVc + lane * RW_LP + 16 + q * 8) = w; }
        }
        if constexpr (doP) for (int rep_ = 0; rep_ < ((RWP & 4) ? 2 : 1); ++rep_) {
            f32x4 pre = (f32x4){0.f, 0.f, 0.f, 0.f}, cle = (f32x4){0.f, 0.f, 0.f, 0.f};
#pragma unroll
            for (int w = 0; w < 8; ++w) { const f32x4 t4 = *(const f32x4*)(WT + w * 64 + n4); cle = cle + t4; if (w < wid) pre = pre + t4; }
            const f32x4 cim = cin + pre;
            const f32x4 clj = dir ? cle - cim + lw : cim;
            const f32x4 clp = dir ? cle - cim : cim - lw;
            f32x4 at, rt, bt, kt, bh, kh;
#pragma unroll
            for (int q = 0; q < 4; ++q) { const float ep = __expf(clp[q]), ej = __expf(clj[q]), ei = __expf(-clj[q]), ee = __expf(cle[q] - clj[q]);
                at[q] = av[q] * ep; rt[q] = r[q] * ej; bt[q] = bv[q] * ei; kt[q] = kd[q] * ei; bh[q] = bv[q] * ee; kh[q] = kd[q] * ee; }
            if (tq < 16) { f32x4 e;
#pragma unroll
                for (int q = 0; q < 4; ++q) e[q] = __expf(cle[q]);
                *(f32x4*)(PLn + n4) = e; }
            st4bf(AR + j * RW_LP + n4, at); st4bf(AR + (32 + j) * RW_LP + n4, rt);
            st4bf(BK + j * RW_LP + n4, bt); st4bf(BK + (32 + j) * RW_LP + n4, kt);
            const int cbh = (((j >> 3) ^ (tq & 7)) << 3) | (j & 7), ckh = ((((j >> 3) + 4) ^ (tq & 7)) << 3) | (j & 7);
#pragma unroll
            for (int q = 0; q < 4; ++q) { BKhn[(n4 + q) * RW_LP + cbh] = f2bf(bh[q]); BKhn[(n4 + q) * RW_LP + ckh] = f2bf(kh[q]); }
        }
        lds_barrier();
        if constexpr (doD) {
            const int nt = wid >> 1;
            const f32x4 pl = *(const f32x4*)(PLc + nt * 16 + fq * 4);
#pragma unroll
            for (int q2 = 0; q2 < 2; ++q2) {
                const int vt = (wid & 1) * 2 + q2;
                Sacc[q2] = Sacc[q2] * pl;
#pragma unroll
                for (int k = 0; k < 2; ++k) Sacc[q2] = mma16(*(const bf16x8*)(BKhc + (nt * 16 + fr) * RW_LP + (((k * 4 + fq) ^ (((nt & 1) << 2) + (fr >> 2))) << 3)), ldfrag(ZVc, RW_LP, vt * 16, k * 32, fr, fq), Sacc[q2]);
                st4bf(Sb + (vt * 16 + fr) * RW_LP + nt * 16 + fq * 4, Sacc[q2]);
            }
            if (t0 >= CTXL) {
                const int vt = wid >> 1, tt = wid & 1;
                f32x4 acc = (f32x4){0.f, 0.f, 0.f, 0.f};
                acc = mma16(ldfrag(ZVc, RW_LP, vt * 16, 0, fr, fq), ldfrag(ARBc, 40, tt * 16, 0, fr, fq), acc);
                const int t = tt * 16 + fr, v0 = vt * 16 + fq * 4;
#pragma unroll
                for (int rr = 0; rr < 4; ++rr) acc[rr] += YB[t * 64 + v0 + rr];
                const int tn = scan_t<32>(dir, ci, t);
                st4bf(OUT + ((size_t)bl * SEQ + (tn - CTXL)) * 1024 + h * 64 + v0, acc);
            }
        }
        if constexpr (doP) for (int rep_ = 0; rep_ < ((RWP & 8) ? 2 : 1); ++rep_) {
            const int ti = wid >> 1;
#pragma unroll
            for (int q2 = 0; q2 < 2; ++q2) {
                const int si = (wid & 1) * 2 + q2;
                f32x4 acc = (f32x4){0.f, 0.f, 0.f, 0.f};
#pragma unroll
                for (int k = 0; k < 2; ++k) acc = mma16(ldfrag(AR, RW_LP, ti * 16, k * 32, fr, fq), ldfrag(BK, RW_LP, si * 16, k * 32, fr, fq), acc);
                const int s = (si & 1) * 16 + fr;
                const bool incl = ti >= 2, kcols = si >= 2;
                bf16_t* dstb = kcols ? (incl ? ARK : AAK) : ARBn;
#pragma unroll
                for (int rr = 0; rr < 4; ++rr) { const int t = (ti & 1) * 16 + fq * 4 + rr;
                    const float val = (incl ? (s <= t) : (s < t)) ? acc[rr] : 0.f;
                    if (kcols || incl) dstb[t * 40 + s] = f2bf(val);
                    else { AABT[s * 36 + t] = val; if (ti == 1 && si == 0) A21b[(t - 16) * 40 + s] = f2bf(val); } }
            }
        }
        lds_barrier();
    };
    step(TrueT{}, FalseT{}, -1);
#pragma unroll 1
    for (int ci = 0; ci < NC - 1; ++ci) step(TrueT{}, TrueT{}, ci);
    step(FalseT{}, TrueT{}, NC - 1);
#undef RW_PREFETCH
}

__device__ __forceinline__ void phase_mix_cd(const KP& kp, unsigned char* lds, int which) {
    if (which & 1) for (int u = obid(); u < 256; u += gridDim.x) { rwkv_unit(kp, lds, u >> 5, (u >> 1) & 15, u & 1); __syncthreads(); }
    if (which & 2) for (int u = obid(); u < 512; u += gridDim.x) { attn_unit(kp, lds, u >> 6, (u >> 3) & 7, u & 7); __syncthreads(); }
}

struct EpiFinCD {
    const bf16_t* OF; const bf16_t* OB; const bf16_t* P; const float* BSC; const float* ln; const float* mu; bf16_t* AOUT;
    __device__ __forceinline__ void operator()(const f32x4 (&acc)[4][4], int rb, int cb, int fr, int fq) const {
        const int head = cb >> 6;
#pragma unroll
        for (int i = 0; i < 4; ++i) { const int lr = rb + i * 16 + fr, s = lr & 2047;
            const size_t prow = (size_t)(lr >> 11) * TT + CTXL + s;
            f32x4 o[4]; float ss = 0.f;
#pragma unroll
            for (int j = 0; j < 4; ++j) { const int col = cb + j * 16 + fq * 4;
                o[j] = ld4bf(OF + (size_t)lr * 1024 + col) + ld4bf(OB + (size_t)lr * 1024 + col);
                ss += o[j][0] * o[j][0] + o[j][1] * o[j][1] + o[j][2] * o[j][2] + o[j][3] * o[j][3]; }
            ss += __shfl_xor(ss, 16); ss += __shfl_xor(ss, 32);
            const float rstd = rsqrtf(ss * (1.0f / 64.0f) + EPS);
            const float bon = BSC[(size_t)lr * 16 + head] + BSC[(size_t)RGL * 16 + (size_t)lr * 16 + head];
#pragma unroll
            for (int j = 0; j < 4; ++j) { const int col = cb + j * 16 + fq * 4;
                const bf16_t* pv = P + prow * CD_N + CD_V + col;
                const f32x4 v = ld4bf(pv);
                const f32x4 vp = s > 0 ? ld4bf(pv - CD_N) : (f32x4){0.f, 0.f, 0.f, 0.f};
                const f32x4 vn = s < SEQ - 1 ? ld4bf(pv + CD_N) : (f32x4){0.f, 0.f, 0.f, 0.f};
                const f32x4 vl = v + *(const f32x4*)(mu + 2048 + col) * ((vp + vn) * 0.5f - v);
                const f32x4 y = o[j] * rstd * *(const f32x4*)(ln + col) + vl * bon;
                st4bf(AOUT + (size_t)lr * 1536 + 512 + col, y * acc[i][j]); }
        }
    }
};
PHASE_FN void phase_fin_cd(const KP& kp, unsigned char* lds) {
    GA ga{WSP(const bf16_t, WS_SG), nullptr, 128, 0, 128, nullptr, RGL, 0, 0};
    EpiFinCD ep{WSP(const bf16_t, WS_BIG + L1_OF), WSP(const bf16_t, WS_BIG + L1_OB), WSP(const bf16_t, WS_BIG + L1_P), WSP(const float, WS_BSC), KIN(33), KIN(24), WSP(bf16_t, WS_BIG + L1_AOUT)};
    for (int u = obid(); u < (RGL / 256) * 8; u += gridDim.x) gemm_tile(lds, ga, WSP(const bf16_t, WS_WMIX + WM_G2), 128, u >> 3, u & 7, ep);
}
PHASE_FN void phase_gemm_out_cd(const KP& kp, unsigned char* lds) {
    pg8::Gemm g{WSP(const bf16_t, WS_BIG + L1_AOUT), WSP(const bf16_t, WS_WMIX + WM_CD_OUT), RGL, 1024, 1536, nullptr, 0x7fffffff};
    pg8::StaticOrder S; S.init(RGL, 1024, (int)gridDim.x, obid());
    pg8::EpiBfG E{WSP(bf16_t, WS_BIG + L1_U), 1024, 1024, 0x7fffffff, 1.0f};
    pg8::gemm_phase<pg8::EpiBfG, pg8::StaticOrder, false>((PG8_LAS unsigned char*)lds, g, S, E, nullptr);
    __syncthreads();
}

__device__ __attribute__((noinline)) void grid_sync(unsigned* barw, unsigned x, volatile LAS unsigned* st) { XcdBarrier b; b.bar = barw; b.x = x; b.st = st; xcd_barrier(b); }
constexpr int N_PHASES = 36;
__global__ void __launch_bounds__(512, 2) fwd_kernel(KP kparg) {
    extern __shared__ __attribute__((aligned(16))) unsigned char lds[];
    const int lo = kparg.ph_lo, hi = kparg.ph_hi;
    const KP& kp = kparg;
    volatile LAS unsigned* xbst = (volatile LAS unsigned*)(LAS unsigned char*)(lds + LDS_BYTES - 16);
    if (threadIdx.x == 0) { xbst[0] = 0u; xbst[1] = 0u; }
    __syncthreads();
    XcdBarrier bar; bar.bar = (unsigned*)kparg.ws; bar.x = 0; bar.st = xbst;
    if (hi - lo > 1) bar = xcd_barrier_post((unsigned*)kparg.ws, xbst);
#define IN(k) (lo <= (k) && (k) < hi)
#define SEAM(k) do { if (IN(k) && IN((k) + 1)) { grid_sync((unsigned*)kp.ws, bar.x, xbst); if (PROBE_DUP & 512) grid_sync((unsigned*)kp.ws, bar.x, xbst); } } while (0)
#define PHASE(...) do { if (IN(ph)) { __VA_ARGS__ } SEAM(ph); ++ph; } while (0)
    int ph = 0;
    PHASE(phase_mod(kp, lds); __syncthreads(); phase_conv_ab(kp, lds); if (PROBE_DUP & 32) { __syncthreads(); phase_mod(kp, lds); __syncthreads(); phase_conv_ab(kp, lds); });
#pragma unroll
    for (int g = 0; g < NG; ++g) {
        if (g == 0) PHASE(phase_u(kp, 0, 0, obid(), (int)gridDim.x, false););
        PHASE(phase_gemm_in(kp, lds, 0, g); if (PROBE_DUP & 8) phase_gemm_in(kp, lds, 0, g););
        PHASE(phase_xconv(kp); if (PROBE_DUP & 2048) phase_xconv(kp););
        PHASE(phase_scan_ab(kp, lds); if (PROBE_DUP & 1) { __syncthreads(); phase_scan_ab(kp, lds); });
        PHASE(phase_fin_ab(kp););
        PHASE(phase_gemm_out_ab(kp, lds, g););
        PHASE(phase_r(kp, lds, 0, g););
    }
    PHASE(phase_moe_gather(kp, 0); phase_conv_cd(kp, lds););
    PHASE(phase_moe_gemm(kp, lds, 0, false); if (PROBE_DUP & 16) { __syncthreads(); phase_moe_gemm(kp, lds, 0, false); });
    PHASE(phase_moe_gemm(kp, lds, 0, true); if (PROBE_DUP & 16) { __syncthreads(); phase_moe_gemm(kp, lds, 0, true); });
    PHASE(phase_combine(kp, 0););
#pragma unroll
    for (int g = 0; g < NG; ++g) {
        PHASE(phase_gemm_in(kp, lds, 1, g); if (PROBE_DUP & 8) phase_gemm_in(kp, lds, 1, g););
        PHASE(phase_prep_cd(kp););
        PHASE(phase_upproj(kp, lds); if (PROBE_DUP & 4096) phase_upproj(kp, lds););
        PHASE(phase_mix_cd(kp, lds, 3); if (PROBE_DUP & 2) { __syncthreads(); phase_mix_cd(kp, lds, 1); } if (PROBE_DUP & 4) { __syncthreads(); phase_mix_cd(kp, lds, 2); });
        PHASE(phase_fin_cd(kp, lds); if (PROBE_DUP & 4096) phase_fin_cd(kp, lds););
        PHASE(phase_gemm_out_cd(kp, lds); if (PROBE_DUP & 256) phase_gemm_out_cd(kp, lds););
        PHASE(phase_r(kp, lds, 1, g););
    }
    PHASE(phase_moe_gather(kp, 1); phase_conv_moe(kp, lds, 1, obid(), (int)gridDim.x););
    PHASE(phase_moe_gemm(kp, lds, 1, false););
    PHASE(phase_moe_gemm(kp, lds, 1, true););
    PHASE(phase_combine(kp, 1););
#undef PHASE
#undef IN
#undef SEAM
}

extern "C" void kernel_launch(void* const* d_in, const int* in_sizes, int n_in, void* d_out, int out_size, void* d_ws, size_t ws_size, hipStream_t stream) {
    static int grid = 0;
    if (grid == 0) {
        if (n_in != 42 || out_size != NLAT * D || ws_size < WS_NEED) { fprintf(stderr, "kernel_launch: unexpected shapes: n_in %d out %d ws %zu (need %zu)\n", n_in, out_size, ws_size, (size_t)WS_NEED); grid = -1; return; }
        int dev = 0, cus = 0, per_cu = 0;
        if (hipGetDevice(&dev) != hipSuccess || hipDeviceGetAttribute(&cus, hipDeviceAttributeMultiprocessorCount, dev) != hipSuccess) { grid = -1; return; }
        if (hipFuncSetAttribute((const void*)fwd_kernel, hipFuncAttributeMaxDynamicSharedMemorySize, LDS_BYTES) != hipSuccess) { fprintf(stderr, "kernel_launch: hipFuncSetAttribute failed\n"); grid = -1; return; }
        if (hipOccupancyMaxActiveBlocksPerMultiprocessor(&per_cu, (const void*)fwd_kernel, 512, LDS_BYTES) != hipSuccess || per_cu < 1) { fprintf(stderr, "kernel_launch: occupancy query says %d blocks per CU\n", per_cu); grid = -1; (void)hipGetLastError(); return; }
        grid = cus;
    }
    if (grid < 0) return;
    (void)hipMemsetAsync(d_ws, 0, CTL_BYTES, stream);
    KP kp{};
    for (int i = 0; i < 42; ++i) kp.in[i] = (const float*)d_in[i];
    kp.out = (float*)d_out; kp.ws = (unsigned char*)d_ws;
#if N_LAUNCH_MODE == 1
    kp.ph_lo = 0; kp.ph_hi = N_PHASES;
    hipLaunchKernelGGL(fwd_kernel, dim3(grid), dim3(512), LDS_BYTES, stream, kp);
#else
    for (int p = 0; p < N_PHASES; ++p) { kp.ph_lo = p; kp.ph_hi = p + 1; hipLaunchKernelGGL(fwd_kernel, dim3(grid), dim3(512), LDS_BYTES, stream, kp); }
#endif
}
```

```cpp
#include <hip/hip_runtime.h>
#include <stdint.h>
#include <stdio.h>

typedef unsigned short bf16_t;
typedef short bf16x8 __attribute__((ext_vector_type(8)));
typedef float f32x4 __attribute__((ext_vector_type(4)));
typedef float f32x2 __attribute__((ext_vector_type(2)));
typedef unsigned u32x4 __attribute__((ext_vector_type(4)));
typedef unsigned u32x2 __attribute__((ext_vector_type(2)));

#ifndef RWP
#define RWP 0
#endif
#ifndef PROBE_DUP
#define PROBE_DUP 0
#endif
#ifndef N_LAUNCH_MODE
#define N_LAUNCH_MODE 1
#endif

constexpr int NB = 16, SEQ = 2048, CTXL = 256, TT = 2304, D = 1024;
constexpr int NTOK = NB * TT, NLAT = NB * SEQ;
constexpr int NG = 2, BG = NB / NG, RG = BG * TT, RGL = BG * SEQ;
constexpr float EPS = 1e-6f;
constexpr int AB_N = 5424, AB_NPAD = 5632, AB_Q = 0, AB_K = 512, AB_V = 1024, AB_OG = 2048, AB_IG = 3072, AB_FG = 3080, AB_Z = 3088, AB_XBC = 4112, AB_DT = 5392;
constexpr int CD_N = 4128, CD_NPAD = 4352, CD_M0 = 0, CD_M1 = 384, CD_KR = 640, CD_R = 672, CD_K = 1696, CD_V = 2720, CD_WL = 3744, CD_AL = 3872, CD_GL = 4000;
constexpr int CD_RW0 = 672;

constexpr size_t CTL_BYTES = 32768;
constexpr size_t CTL_CNT = 16384;
constexpr size_t WS_MODV = CTL_BYTES;
constexpr size_t WS_HC   = WS_MODV + (size_t)2 * 17 * 6144 * 4;
constexpr size_t WS_TOKE = WS_HC + (size_t)NB * CTXL * D * 4;
constexpr size_t WS_TOKP = WS_TOKE + (size_t)NTOK * 2 * 4;
constexpr size_t WS_TOKW = WS_TOKP + (size_t)NTOK * 2 * 4;
constexpr size_t WS_LIST = WS_TOKW + (size_t)NTOK * 2 * 4;
constexpr size_t WS_BSC  = WS_LIST + (size_t)16 * NTOK * 4;
constexpr size_t WS_SG   = WS_BSC + (size_t)2 * RGL * 16 * 4;
constexpr size_t WS_WMIX = WS_SG + (size_t)RGL * 128 * 2;
constexpr size_t WMIX_BYTES = (size_t)16 << 20;
constexpr size_t WS_V    = WS_WMIX + WMIX_BYTES;
constexpr size_t WS_BIG  = WS_V + (size_t)NTOK * D * 2;
constexpr size_t WM_AB_IN = 0, WM_AB_OUT = (size_t)AB_NPAD * 1024 * 2;
constexpr size_t WM_CD_IN = 0, WM_CD_OUT = (size_t)CD_NPAD * 1024 * 2, WM_UQ = WM_CD_OUT + (size_t)1024 * 1536 * 2, WM_UKV = WM_UQ + (size_t)768 * 384 * 2, WM_G2 = WM_UKV + (size_t)1024 * 256 * 2;
static_assert(WM_AB_OUT + (size_t)1024 * 2048 * 2 <= WMIX_BYTES, "wmix ab");
static_assert(WM_G2 + (size_t)1024 * 128 * 2 <= WMIX_BYTES, "wmix cd");
constexpr size_t SZ_RG1K = (size_t)RG * 1024 * 2, SZ_RGL1K = (size_t)RGL * 1024 * 2;
constexpr size_t L0_P = 0, L0_AO = (size_t)RG * AB_N * 2  , L0_HB = L0_AO + 2 * SZ_RG1K, L0_YB = L0_HB + SZ_RG1K, L0_U = L0_YB + SZ_RG1K, L0_END = L0_U + SZ_RG1K;
constexpr size_t L1_P = 0, L1_Q = (size_t)RG * CD_N * 2, L1_KV = L1_Q + (size_t)RGL * 768 * 2, L1_OF = L1_KV + SZ_RG1K, L1_OB = L1_OF + SZ_RGL1K, L1_AOUT = L1_OB + SZ_RGL1K, L1_U = L1_AOUT + (size_t)RGL * 1536 * 2, L1_TWAL = L1_U + SZ_RG1K  , L1_END = L1_TWAL + (size_t)RG * 256 * 2;
constexpr int MOE_PADROWS = 16 * 256;
constexpr size_t MO_WUP = 0, MO_WDN = (size_t)17 * 1024 * 1024 * 2, MO_HID = MO_WDN + (size_t)17 * 1024 * 512 * 2;
constexpr size_t MO_XG = MO_HID + (size_t)(3 * NTOK + MOE_PADROWS) * 512 * 2;
constexpr size_t MO_CON = MO_XG, MO_END = MO_CON + (size_t)(3 * NTOK + MOE_PADROWS) * 1024 * 2;
constexpr size_t BIG_BYTES = MO_END > L0_END ? (MO_END > L1_END ? MO_END : L1_END) : (L0_END > L1_END ? L0_END : L1_END);
constexpr size_t WS_NEED = WS_BIG + BIG_BYTES;

constexpr int LDS_BYTES = 151552;

__device__ __forceinline__ float bf2f(unsigned short h) { return __uint_as_float(((unsigned)h) << 16); }
typedef __bf16 bf16v2_t __attribute__((ext_vector_type(2)));
__device__ __forceinline__ unsigned pack2(float a, float b) { const bf16v2_t h = __builtin_convertvector((f32x2){a, b}, bf16v2_t); return __builtin_bit_cast(unsigned, h); }
__device__ __forceinline__ unsigned short f2bf(float f) { const __bf16 h = (__bf16)f; return __builtin_bit_cast(unsigned short, h); }
__device__ __forceinline__ float lo2f(unsigned w) { return __uint_as_float(w << 16); }
__device__ __forceinline__ float hi2f(unsigned w) { return __uint_as_float(w & 0xffff0000u); }
__device__ __forceinline__ float wsum(float v) {
#pragma unroll
    for (int o = 32; o; o >>= 1) v += __shfl_xor(v, o);
    return v; }
template <int CTRL> __device__ __forceinline__ float dpp_mov(float x) { return __builtin_bit_cast(float, __builtin_amdgcn_update_dpp(0, __builtin_bit_cast(int, x), CTRL, 0xf, 0xf, true)); }
__device__ __forceinline__ float rsum16(float x) { x += dpp_mov<0xB1>(x); x += dpp_mov<0x4E>(x); x += dpp_mov<0x124>(x); x += dpp_mov<0x128>(x); return x; }
__device__ __forceinline__ float frcp_(float x) { return __builtin_amdgcn_rcpf(x); }
__device__ __forceinline__ float sigmoidf_(float x) { return __builtin_amdgcn_rcpf(1.0f + __expf(-x)); }
__device__ __forceinline__ float siluf_(float x) { return x * __builtin_amdgcn_rcpf(1.0f + __expf(-x)); }
__device__ __forceinline__ float softplusf_(float x) { return fmaxf(x, 0.0f) + __logf(1.0f + __expf(-fabsf(x))); }
__device__ __forceinline__ float logsigmoidf_(float x) { return fminf(x, 0.0f) - __logf(1.0f + __expf(-fabsf(x))); }
__device__ __forceinline__ float tanhf_(float x) { return 1.0f - 2.0f * __builtin_amdgcn_rcpf(__expf(2.0f * x) + 1.0f); }
__device__ __forceinline__ f32x4 mma16(bf16x8 a, bf16x8 b, f32x4 c) { return __builtin_amdgcn_mfma_f32_16x16x32_bf16(a, b, c, 0, 0, 0); }
__device__ __forceinline__ bf16x8 ldfrag(const bf16_t* base, int ld, int row0, int k0, int fr, int fq) { return *(const bf16x8*)(base + (row0 + fr) * ld + k0 + fq * 8); }
__device__ __forceinline__ void st4bf(bf16_t* p, f32x4 v) { u32x2 w; w.x = pack2(v[0], v[1]); w.y = pack2(v[2], v[3]); *(u32x2*)p = w; }
__device__ __forceinline__ f32x4 ld4bf(const bf16_t* p) { u32x2 w = *(const u32x2*)p; return (f32x4){lo2f(w.x), hi2f(w.x), lo2f(w.y), hi2f(w.y)}; }

#define PHASE_FN __device__ __forceinline__
__device__ __forceinline__ int otid() { int t = threadIdx.x; asm volatile("" : "+v"(t)); return t; }
__device__ __forceinline__ int obid() { int t = blockIdx.x; asm volatile("" : "+s"(t)); return t; }
template <class T> __device__ __forceinline__ T* as_global(T* p) { return p; }
__device__ __forceinline__ void lds_barrier() { asm volatile("s_waitcnt lgkmcnt(0)" ::: "memory"); __builtin_amdgcn_s_barrier(); asm volatile("" ::: "memory"); }
constexpr float W8_SCALE = 64.0f, W8_INV = 1.0f / 64.0f;
__device__ __forceinline__ unsigned pack4f8(float a, float b, float c, float d) { unsigned r = 0; r = __builtin_amdgcn_cvt_pk_fp8_f32(a, b, r, false); r = __builtin_amdgcn_cvt_pk_fp8_f32(c, d, r, true); return r; }
__device__ __forceinline__ void st4f8(unsigned char* p, f32x4 v) { *(unsigned*)p = pack4f8(v[0], v[1], v[2], v[3]); }
struct KP { const float* in[42]; float* out; unsigned char* ws; int ph_lo, ph_hi; };

#define XB_TMO      128
#define XB_XCNT(j)  (256  + 64 * (j))
#define XB_XSUB(j)  (1280 + 64 * (j))
#define XB_XGEN(j)  (2304 + 64 * (j))
#define XB_TOP      3328
#define XB_TOPGEN   3392
#define XCD_BAR_WORDS 3456
#define XB_SPIN_CAP (1u << 18)
#define LAS __attribute__((address_space(3)))

__device__ __forceinline__ unsigned xb_ld(unsigned* p)              { return __hip_atomic_load(p, __ATOMIC_RELAXED, __HIP_MEMORY_SCOPE_AGENT); }
__device__ __forceinline__ unsigned xb_add(unsigned* p, unsigned v) { return __hip_atomic_fetch_add(p, v, __ATOMIC_RELAXED, __HIP_MEMORY_SCOPE_AGENT); }
__device__ __forceinline__ unsigned xb_xcc_id() { return (unsigned)__builtin_amdgcn_s_getreg((3 << 11) | 20) & 0xFu; }
#define XB_SPIN(cond, bar) do { unsigned _sp = 0; while (cond) { __builtin_amdgcn_s_sleep(1); \
    if ((++_sp & 255u) == 0u) { if (xb_ld(&(bar)[XB_TMO])) break; if (_sp > XB_SPIN_CAP) { atomicAdd(&(bar)[XB_TMO], 1u); break; } } } } while (0)

struct XcdBarrier {
    unsigned* bar; unsigned x;
    volatile LAS unsigned* st;
};

__device__ __forceinline__ XcdBarrier xcd_barrier_post(unsigned* bar, volatile LAS unsigned* st) {
    XcdBarrier b; b.bar = bar; b.x = xb_xcc_id(); b.st = st;
    if (threadIdx.x == 0) (void)xb_add(&bar[XB_XCNT(b.x)], 1u);
    return b;
}
__device__ __forceinline__ void xcd_barrier_complete(unsigned* bar, unsigned x, unsigned& nloc, unsigned& nx) {
    const unsigned G = gridDim.x * gridDim.y * gridDim.z;
    unsigned sum, cnt, mine, sp = 0u;
    for (;;) {
        sum = 0u; cnt = 0u; mine = 0u;
#pragma unroll
        for (unsigned j = 0; j < 16; ++j) { const unsigned c = xb_ld(&bar[XB_XCNT(j)]); sum += c; cnt += (c > 0u) ? 1u : 0u; mine = (j == x) ? c : mine; }
        if (sum == G) break;
        __builtin_amdgcn_s_sleep(1);
        if ((++sp & 255u) == 0u) { if (xb_ld(&bar[XB_TMO])) break; if (sp > XB_SPIN_CAP) { atomicAdd(&bar[XB_TMO], 1u); break; } }
    }
    nloc = mine > 0u ? mine : 1u; nx = cnt > 0u ? cnt : 1u;
}

__device__ __forceinline__ void xcd_barrier(const XcdBarrier& b) {
    asm volatile("s_waitcnt vmcnt(0)" ::: "memory");
    __syncthreads();
    if (threadIdx.x == 0) {
        unsigned* bar = b.bar;
        __builtin_amdgcn_s_waitcnt(0);
        unsigned nloc = b.st[0], nx = b.st[1];
        if (nloc == 0u) { xcd_barrier_complete(bar, b.x, nloc, nx); b.st[0] = nloc; b.st[1] = nx; }
        const unsigned old = xb_add(&bar[XB_XSUB(b.x)], 1u);
        const unsigned gen = old / nloc;
        if (old + 1u == (gen + 1u) * nloc) {
            __builtin_amdgcn_fence(__ATOMIC_RELEASE, "agent");
            asm volatile("s_waitcnt vmcnt(0)" ::: "memory");
            const unsigned og = xb_add(&bar[XB_TOP], 1u);
            const unsigned tg = og / nx;
            if (og + 1u == (tg + 1u) * nx) xb_add(&bar[XB_TOPGEN], 1u);
            else XB_SPIN(xb_ld(&bar[XB_TOPGEN]) == tg, bar);
            __builtin_amdgcn_fence(__ATOMIC_ACQUIRE, "agent");
            xb_add(&bar[XB_XGEN(b.x)], 1u);
            asm volatile("s_waitcnt vmcnt(0)" ::: "memory");
        } else {
            XB_SPIN(xb_ld(&bar[XB_XGEN(b.x)]) == gen, bar);
            __builtin_amdgcn_fence(__ATOMIC_ACQUIRE, "agent");
            asm volatile("s_waitcnt vmcnt(0)" ::: "memory");
        }
    }
    __syncthreads();
}
struct GA {
    const bf16_t* a0; const bf16_t* a1;
    int ld0, ld1, ksplit;
    const int* list;
    int nrows;
    int mode;
    int row0;
};
constexpr int G_LDT = 40;
constexpr int GEMM_LDS = (2 * 256 * G_LDT + 2 * 128 * G_LDT) * 2;

template <class Epi>
__device__ __forceinline__ void gemm_tile(unsigned char* lds, const GA& ga, const bf16_t* __restrict__ Bt, int K, int mt, int nt, const Epi& epi) {
    const int tid = otid(), lane = tid & 63, wid = __builtin_amdgcn_readfirstlane(tid >> 6), wm = wid >> 1, wn = wid & 1, fr = lane & 15, fq = lane >> 4;
    bf16_t* sA = (bf16_t*)lds;
    bf16_t* sB = sA + 2 * 256 * G_LDT;
    const int kp = tid & 3;
    const int r0 = tid >> 2, r1 = r0 + 128;
    int s0, s1;
    {
        int lr = mt * 256 + r0; if (lr >= ga.nrows) lr = 0;
        s0 = ga.list ? ga.list[lr] : (ga.mode == 1 ? (lr >> 11) * TT + CTXL + (lr & 2047) : ga.row0 + lr);
        lr = mt * 256 + r1; if (lr >= ga.nrows) lr = 0;
        s1 = ga.list ? ga.list[lr] : (ga.mode == 1 ? (lr >> 11) * TT + CTXL + (lr & 2047) : ga.row0 + lr);
    }
    const bf16_t* pa00 = ga.a0 + (size_t)s0 * ga.ld0 + kp * 8;
    const bf16_t* pa01 = ga.a0 + (size_t)s1 * ga.ld0 + kp * 8;
    const bf16_t* pa10 = ga.a1 ? ga.a1 + (size_t)s0 * ga.ld1 + kp * 8 : pa00;
    const bf16_t* pa11 = ga.a1 ? ga.a1 + (size_t)s1 * ga.ld1 + kp * 8 : pa01;
    const bf16_t* pb = Bt + (size_t)(nt * 128 + r0) * K + kp * 8;
    const int ksplit = ga.ksplit;
    f32x4 acc[4][4];
#pragma unroll
    for (int i = 0; i < 4; ++i)
#pragma unroll
        for (int j = 0; j < 4; ++j) acc[i][j] = (f32x4){0.f, 0.f, 0.f, 0.f};
    const int nk = K >> 5;
    u32x4 ra0, ra1, rb;
    {
        ra0 = *(const u32x4*)(pa00); ra1 = *(const u32x4*)(pa01); rb = *(const u32x4*)(pb);
        if (0 >= ksplit) { ra0 = *(const u32x4*)(pa10); ra1 = *(const u32x4*)(pa11); }
    }
    *(u32x4*)(sA + (r0) * G_LDT + kp * 8) = ra0;
    *(u32x4*)(sA + (r1) * G_LDT + kp * 8) = ra1;
    *(u32x4*)(sB + (r0) * G_LDT + kp * 8) = rb;
    __syncthreads();
    for (int kt = 0; kt < nk; ++kt) {
        const int cur = kt & 1;
        if (kt + 1 < nk) {
            const int k0 = (kt + 1) << 5;
            if (k0 < ksplit) { ra0 = *(const u32x4*)(pa00 + k0); ra1 = *(const u32x4*)(pa01 + k0); }
            else { ra0 = *(const u32x4*)(pa10 + (k0 - ksplit)); ra1 = *(const u32x4*)(pa11 + (k0 - ksplit)); }
            rb = *(const u32x4*)(pb + k0);
        }
        const bf16_t* cA = sA + cur * 256 * G_LDT;
        const bf16_t* cB = sB + cur * 128 * G_LDT;
        bf16x8 af[4], bfr[4];
#pragma unroll
        for (int i = 0; i < 4; ++i) af[i] = ldfrag(cA, G_LDT, wm * 64 + i * 16, 0, fr, fq);
#pragma unroll
        for (int j = 0; j < 4; ++j) bfr[j] = ldfrag(cB, G_LDT, wn * 64 + j * 16, 0, fr, fq);
#pragma unroll
        for (int i = 0; i < 4; ++i)
#pragma unroll
            for (int j = 0; j < 4; ++j) acc[i][j] = mma16(bfr[j], af[i], acc[i][j]);
        if (kt + 1 < nk) {
            const int nb = cur ^ 1;
            *(u32x4*)(sA + (nb * 256 + r0) * G_LDT + kp * 8) = ra0;
            *(u32x4*)(sA + (nb * 256 + r1) * G_LDT + kp * 8) = ra1;
            *(u32x4*)(sB + (nb * 128 + r0) * G_LDT + kp * 8) = rb;
        }
        __syncthreads();
    }
    epi(acc, mt * 256 + wm * 64, nt * 128 + wn * 64, fr, fq);
}

struct EpiBf {
    bf16_t* out; int ld, nrows, ncols;
    __device__ __forceinline__ void operator()(const f32x4 (&acc)[4][4], int rb, int cb, int fr, int fq) const {
#pragma unroll
        for (int i = 0; i < 4; ++i) { const int lr = rb + i * 16 + fr; if (lr < nrows) {
#pragma unroll
            for (int j = 0; j < 4; ++j) { const int col = cb + j * 16 + fq * 4; if (col < ncols) st4bf(out + (size_t)lr * ld + col, acc[i][j]); } } }
    }
};
struct EpiSwiglu {
    bf16_t* out; int nrows;
    __device__ __forceinline__ void operator()(const f32x4 (&acc)[4][4], int rb, int cb, int fr, int fq) const {
#pragma unroll
        for (int i = 0; i < 4; ++i) { const int lr = rb + i * 16 + fr; if (lr < nrows) {
#pragma unroll
            for (int j = 0; j < 2; ++j) { const int col = (cb >> 1) + j * 16 + fq * 4; f32x4 g = acc[i][j], u = acc[i][j + 2], o;
#pragma unroll
                for (int r = 0; r < 4; ++r) o[r] = siluf_(g[r]) * u[r];
                st4bf(out + (size_t)lr * 512 + col, o); } } }
    }
};

namespace pg8 {
#define PG8_LAS __attribute__((address_space(3)))
typedef unsigned short bf16_t;
typedef short bf16x8 __attribute__((ext_vector_type(8)));
typedef float f32x4 __attribute__((ext_vector_type(4)));
typedef unsigned u32x4 __attribute__((ext_vector_type(4)));
constexpr int BM = 256, BK = 64, HALF = 128, HTB = HALF * BK * 2  , STAGE_BYTES = 8 * HTB, NXCD = 8, WGM = 8;

__host__ __device__ __forceinline__ int lds_byte(int r, int c) { const int st = (r >> 4) * 2 + (c >> 5), rr = r & 15, cc = c & 31, ob = rr * 64 + cc * 2; return st * 1024 + (ob ^ (((ob >> 9) & 1) << 5)); }
__host__ __device__ __forceinline__ void stage_rc(int b, int& R, int& C) { const int st = b / 1024, sb = b % 1024, swz = sb ^ (((sb >> 9) & 1) << 5); R = (st >> 1) * 16 + swz / 64; C = (st & 1) * 32 + (swz % 64) / 2; }
__host__ __device__ __forceinline__ int perm32(int rho) { const int n = rho >> 4, i = rho & 15; return 8 * (i >> 2) + 4 * n + (i & 3); }

struct Unit { int pm, pn; };
struct Gemm { const bf16_t* A; const bf16_t* Bt; int M, N, K; const bf16_t* A2; int pm_split; int lda, amode; };
#define PG8_ABASE(g, pm) ((g).amode == 1 ? (const char*)(g).A + (size_t)(((pm) >> 3) * 2304 + 256 + ((pm) & 7) * 256) * lda_ * 2 : ((pm) < (g).pm_split ? (const char*)(g).A + (size_t)(pm) * tstepA : (const char*)(g).A2 + (size_t)((pm) - (g).pm_split) * tstepA))
struct StaticOrder {
    int nM, nN, nwg, G, c;
    __host__ __device__ void init(int M, int N, int G_, int c_) { nM = M / BM; nN = N / BM; nwg = nM * nN; G = G_; c = c_; }
    __host__ __device__ bool next(int i, Unit& u) const {
        const long L = (long)i * G + c; if (L >= nwg) return false;
        int wgid = (int)L; { const int q = nwg / NXCD, r = nwg % NXCD, xcd = wgid % NXCD, off = wgid / NXCD; wgid = (xcd < r ? xcd * (q + 1) : r * (q + 1) + (xcd - r) * q) + off; }
        const int nig = WGM * nN, gid = wgid / nig, fm = gid * WGM, gsz = (nM - fm) < WGM ? (nM - fm) : WGM;
        u.pm = fm + ((wgid % nig) % gsz); u.pn = (wgid % nig) / gsz; return true;
    }
    __device__ __forceinline__ void a_ready(const Unit&) const {}
    __device__ __forceinline__ void done(const Unit&) const {}
};
__device__ __forceinline__ unsigned cvt_pk_bf16(float lo, float hi) { unsigned r; asm volatile("v_cvt_pk_bf16_f32 %0, %1, %2" : "=v"(r) : "v"(lo), "v"(hi)); return r; }
typedef float f32x2 __attribute__((ext_vector_type(2)));
template <class Epi, class Sched, bool STAMP = false, bool F8 = false>
__device__ __forceinline__ void gemm_phase(PG8_LAS unsigned char* lds, const Gemm g, const Sched& S, const Epi& E, unsigned long long* stamps) {
    const int tid = otid(), wid = __builtin_amdgcn_readfirstlane(tid >> 6), lane = tid & 63, wr = wid >> 2, wc = wid & 3, fr = lane & 15, fq = lane >> 4;
    const int K = g.K, nt = K / BK, lda_ = g.lda ? g.lda : g.K;
    int ts_lo = 0, ts_hi = 0, nts = 0; const unsigned long long rt_entry = STAMP ? (unsigned long long)wall_clock64() : 0ull;
#define PG8_STAMP() do { if (STAMP && wid == 0 && nts < 64) { const unsigned long long _c = (unsigned long long)clock64(); \
        ts_lo = (lane == nts) ? (int)(unsigned)_c : ts_lo; ts_hi = (lane == nts) ? (int)(unsigned)(_c >> 32) : ts_hi; ++nts; } } while (0)
    PG8_STAMP();
    unsigned voffA[2], voffB[2];
#pragma unroll
    for (int i = 0; i < 2; ++i) { int R, C; stage_rc(tid * 16 + i * 8192, R, C); const int Rb = Epi::PERM ? ((R & ~31) + perm32(R & 31)) : R;
        voffA[i] = (unsigned)(R * lda_ + C) * 2u; voffB[i] = (unsigned)(Rb * K + C) * 2u; }
    const size_t kstep = (size_t)(BK * 2);
    const size_t hstep = (size_t)HALF * K * 2;
    const size_t hstepA = (size_t)HALF * lda_ * 2, tstepA = 2 * hstepA;
    const size_t tstep = 2 * hstep;
    const unsigned ldsw = (unsigned)wid * 1024u;
    const int aoff = lds_byte(wr * 64 + fr, fq * 8), boff = lds_byte(wc * 32 + fr, fq * 8);
#define PG8_SA(b, h) (((b) * 2 + (h)) * HTB)
#define PG8_SB(b, h) ((4 + (b) * 2 + (h)) * HTB)
#define PG8_STAGE(bufoff, gbase, voff) do { _Pragma("unroll") for (int _i = 0; _i < 2; ++_i) \
        __builtin_amdgcn_global_load_lds((const unsigned*)((const char*)(gbase) + (voff)[_i]), (PG8_LAS unsigned*)(lds + (bufoff) + ldsw + _i * 8192), 16, 0, 0); } while (0)
#define PG8_LDA(dst, b, h) do { _Pragma("unroll") for (int m = 0; m < 4; ++m) { \
        if constexpr (F8) { dst##8[m].lo = *(const PG8_LAS v4i_*)(lds + PG8_SA(b, h) + aoff + m * 2048); dst##8[m].hi = *(const PG8_LAS v4i_*)(lds + PG8_SA(b, h) + aoff + m * 2048 + 1024); } \
        else { _Pragma("unroll") for (int k = 0; k < 2; ++k) dst[m][k] = *(const PG8_LAS bf16x8*)(lds + PG8_SA(b, h) + aoff + m * 2048 + k * 1024); } } } while (0)
#define PG8_LDB(dst, b, h) do { _Pragma("unroll") for (int n = 0; n < 2; ++n) { \
        if constexpr (F8) { dst##8[n].lo = *(const PG8_LAS v4i_*)(lds + PG8_SB(b, h) + boff + n * 2048); dst##8[n].hi = *(const PG8_LAS v4i_*)(lds + PG8_SB(b, h) + boff + n * 2048 + 1024); } \
        else { _Pragma("unroll") for (int k = 0; k < 2; ++k) dst[n][k] = *(const PG8_LAS bf16x8*)(lds + PG8_SB(b, h) + boff + n * 2048 + k * 1024); } } } while (0)
#define PG8_MMA(ai, bj, At, Bt) do { __builtin_amdgcn_s_setprio(1); _Pragma("unroll") for (int m = 0; m < 4; ++m) _Pragma("unroll") for (int n = 0; n < 2; ++n) { \
        if constexpr (F8) asm volatile("v_mfma_scale_f32_16x16x128_f8f6f4 %0, %1, %2, %0, %3, %3 op_sel_hi:[0,0,0]" : "+v"(acc[ai][bj][m][n]) : "v"(Bt##8[n]), "v"(At##8[m]), "v"(one_scale)); \
        else { _Pragma("unroll") for (int k = 0; k < 2; ++k) acc[ai][bj][m][n] = __builtin_amdgcn_mfma_f32_16x16x32_bf16(Bt[n][k], At[m][k], acc[ai][bj][m][n], 0, 0, 0); } } \
        __builtin_amdgcn_s_setprio(0); } while (0)
#define PG8_WAIT_V(n) asm volatile("s_waitcnt vmcnt(" #n ")" ::: "memory")
#define PG8_WAIT_L(n) asm volatile("s_waitcnt lgkmcnt(" #n ")" ::: "memory")
#define PG8_BAR __builtin_amdgcn_s_barrier()
#define PG8_SCHED __builtin_amdgcn_sched_barrier(0)
    Unit cur, nxt; int ui = 0;
    if (!S.next(0, cur)) return;
    f32x4 acc[2][2][4][2];
#pragma unroll
    for (int a = 0; a < 2; ++a)
#pragma unroll
        for (int b = 0; b < 2; ++b)
#pragma unroll
            for (int m = 0; m < 4; ++m)
#pragma unroll
                for (int n = 0; n < 2; ++n) acc[a][b][m][n] = (f32x4){0.f, 0.f, 0.f, 0.f};
    bf16x8 At[4][2], B0[2][2], B1[2][2];
    typedef int v4i_ __attribute__((ext_vector_type(4))); typedef int v8i_ __attribute__((ext_vector_type(8)));
    v8i_ At8[4], B08[2], B18[2];
    const int one_scale = 0x7f7f7f7f;
    const char* cA = PG8_ABASE(g, cur.pm); const char* cB = (const char*)g.Bt + (size_t)cur.pn * tstep;
    S.a_ready(cur);
    PG8_STAGE(PG8_SB(0, 0), cB, voffB); PG8_STAGE(PG8_SA(0, 0), cA, voffA); PG8_STAGE(PG8_SB(0, 1), cB + hstep, voffB); PG8_STAGE(PG8_SA(0, 1), cA + hstepA, voffA);
    if (wr == 1) PG8_BAR;
    PG8_WAIT_V(4); PG8_BAR;
    PG8_STAGE(PG8_SB(1, 0), cB + kstep, voffB); PG8_STAGE(PG8_SA(1, 0), cA + kstep, voffA); PG8_STAGE(PG8_SB(1, 1), cB + hstep + kstep, voffB);
    PG8_WAIT_V(6); PG8_BAR;
    PG8_STAMP();
    for (;;) {
        const bool has_next = S.next(ui + 1, nxt);
        const char* nA = has_next ? PG8_ABASE(g, nxt.pm) : cA; const char* nB = has_next ? (const char*)g.Bt + (size_t)nxt.pn * tstep : cB;
#pragma unroll 1
        for (int t = 0; t < nt; t += 2) {
            const bool last = (t == nt - 2);
            const char* a1 = cA + (size_t)(t + 1) * kstep;
            const char* a2 = last ? nA : cA + (size_t)(t + 2) * kstep; const char* b2 = last ? nB : cB + (size_t)(t + 2) * kstep;
            const char* a3 = a2 + kstep; const char* b3 = b2 + kstep;
            if (last && has_next) S.a_ready(nxt);
            PG8_LDB(B0, 0, 0); PG8_SCHED; PG8_LDA(At, 0, 0); PG8_STAGE(PG8_SA(1, 1), a1 + hstepA, voffA);
            PG8_WAIT_L(8); PG8_BAR; PG8_WAIT_L(0); PG8_MMA(0, 0, At, B0); PG8_BAR; PG8_SCHED;
            PG8_LDB(B1, 0, 1); PG8_STAGE(PG8_SB(0, 0), b2, voffB);
            PG8_BAR; PG8_WAIT_L(0); PG8_MMA(0, 1, At, B1); PG8_BAR;
            PG8_LDA(At, 0, 1); PG8_STAGE(PG8_SA(0, 0), a2, voffA);
            PG8_BAR; PG8_WAIT_L(0); PG8_MMA(1, 0, At, B0); PG8_BAR; PG8_SCHED;
            PG8_STAGE(PG8_SB(0, 1), b2 + hstep, voffB);
            PG8_WAIT_V(6); PG8_BAR; PG8_MMA(1, 1, At, B1); PG8_BAR;
            PG8_LDB(B0, 1, 0); PG8_SCHED; PG8_LDA(At, 1, 0); PG8_STAGE(PG8_SA(0, 1), a2 + hstepA, voffA);
            PG8_WAIT_L(8); PG8_BAR; PG8_WAIT_L(0); PG8_MMA(0, 0, At, B0); PG8_BAR; PG8_SCHED;
            PG8_LDB(B1, 1, 1); PG8_STAGE(PG8_SB(1, 0), b3, voffB);
            PG8_BAR; PG8_WAIT_L(0); PG8_MMA(0, 1, At, B1); PG8_BAR;
            PG8_LDA(At, 1, 1); PG8_STAGE(PG8_SA(1, 0), a3, voffA);
            PG8_BAR; PG8_WAIT_L(0); PG8_MMA(1, 0, At, B0); PG8_BAR; PG8_SCHED;
            PG8_STAGE(PG8_SB(1, 1), b3 + hstep, voffB);
            PG8_WAIT_V(6); PG8_BAR; PG8_MMA(1, 1, At, B1); PG8_BAR;
        }
        PG8_STAMP();
        if constexpr (F8) asm volatile("s_nop 15\n\ts_nop 15" ::: "memory");
        if constexpr (!Epi::AFTER_DRAIN) { E(acc, cur, wr, wc, fr, fq); S.done(cur); }
        PG8_STAMP();
        if (!has_next) break;
#pragma unroll
        for (int a = 0; a < 2; ++a)
#pragma unroll
            for (int b = 0; b < 2; ++b)
#pragma unroll
                for (int m = 0; m < 4; ++m)
#pragma unroll
                    for (int n = 0; n < 2; ++n) acc[a][b][m][n] = (f32x4){0.f, 0.f, 0.f, 0.f};
        cur = nxt; cA = nA; cB = nB; ++ui;
    }
    PG8_WAIT_V(0);
    if (wr == 0) PG8_BAR;
    PG8_BAR;
    if constexpr (Epi::AFTER_DRAIN) { E.fused(acc, cur, wr, wc, fr, fq, lds, wid, lane); S.done(cur); }
    PG8_STAMP();
    if (STAMP && wid == 0) { stamps[lane] = lane < nts ? (((unsigned long long)(unsigned)ts_hi << 32) | (unsigned)ts_lo) : 0ull;
        if (lane == 62) stamps[62] = rt_entry; if (lane == 63) stamps[63] = (unsigned long long)wall_clock64(); }
#undef PG8_STAMP
#undef PG8_SA
#undef PG8_SB
#undef PG8_STAGE
#undef PG8_LDA
#undef PG8_LDB
#undef PG8_MMA
#undef PG8_WAIT_V
#undef PG8_WAIT_L
#undef PG8_BAR
#undef PG8_SCHED
}
}
namespace pg8 {
struct EpiBfG {
    static constexpr bool PERM = true, AFTER_DRAIN = false;
    bf16_t* O; int ldc, ncols, pn_mask; float oscale;
    __device__ __forceinline__ void operator()(const f32x4 (&acc)[2][2][4][2], const Unit& u, int wr, int wc, int fr, int fq) const {
        const int row0 = u.pm * BM + wr * 64 + fr, col0 = (u.pn & pn_mask) * BM + wc * 32 + 8 * fq;
#pragma unroll
        for (int ai = 0; ai < 2; ++ai)
#pragma unroll
            for (int m = 0; m < 4; ++m) { bf16_t* rowp = O + (size_t)(row0 + ai * HALF + m * 16) * ldc;
#pragma unroll
                for (int bj = 0; bj < 2; ++bj) { const int c = col0 + bj * HALF;
                    if (c < ncols) { const f32x4 v0 = acc[ai][bj][m][0] * oscale, v1 = acc[ai][bj][m][1] * oscale;
                        u32x4 w; w.x = cvt_pk_bf16(v0[0], v0[1]); w.y = cvt_pk_bf16(v0[2], v0[3]); w.z = cvt_pk_bf16(v1[0], v1[1]); w.w = cvt_pk_bf16(v1[2], v1[3]);
                        *(u32x4*)(rowp + c) = w; } } }
    }
};
struct EpiSwi {
    static constexpr bool PERM = true, AFTER_DRAIN = false;
    bf16_t* H;
    __device__ __forceinline__ void operator()(const f32x4 (&acc)[2][2][4][2], const Unit& u, int wr, int wc, int fr, int fq) const {
        const int row0 = u.pm * BM + wr * 64 + fr, hc0 = (u.pn & 3) * HALF + wc * 32 + 8 * fq;
#pragma unroll
        for (int ai = 0; ai < 2; ++ai)
#pragma unroll
            for (int m = 0; m < 4; ++m) { unsigned char* rowp = (unsigned char*)H + (size_t)(row0 + ai * HALF + m * 16) * 1024 + hc0;
                float o[8];
#pragma unroll
                for (int n = 0; n < 2; ++n)
#pragma unroll
                    for (int r = 0; r < 4; ++r) { const float g = acc[ai][0][m][n][r] * W8_INV; o[n * 4 + r] = g * __builtin_amdgcn_rcpf(1.0f + __expf(-g)) * (acc[ai][1][m][n][r] * W8_INV); }
                u32x2 w; w.x = pack4f8(o[0], o[1], o[2], o[3]); w.y = pack4f8(o[4], o[5], o[6], o[7]);
                *(u32x2*)rowp = w; }
    }
};
struct MoeOrder {
    const int* slotmap; int ntiles, G, c;
    __device__ __forceinline__ bool next(int i, Unit& u) const {
        const int L = i * G + c; if (L >= ntiles * 4) return false;
        u.pm = L >> 2; u.pn = __builtin_amdgcn_readfirstlane(slotmap[L >> 2]) * 4 + (L & 3); return true;
    }
    __device__ __forceinline__ void a_ready(const Unit&) const {}
    __device__ __forceinline__ void done(const Unit&) const {}
};
}
#define WSP(T, off) as_global((T*)(kp.ws + (off)))
#define KIN(i) as_global(kp.in[i])
#define KOUT as_global(kp.out)

PHASE_FN void phase_mod(const KP& kp, unsigned char* lds) {
    float* sc = (float*)lds;
    float* red = sc + 17 * 1024;
    float* modv = WSP(float, WS_MODV);
    const int tid = otid();
    for (int i = tid; i < 17 * 1024; i += 512) { const int bb = i >> 10, k = i & 1023; const float c = bb < 16 ? KIN(1)[bb * 1024 + k] : KIN(3)[k]; sc[i] = siluf_(c); }
    __syncthreads();
    const int jc = tid & 63, ks = tid >> 6;
    for (int u = obid(); u < 192; u += gridDim.x) {
        const int l = u / 96, j0 = (u % 96) * 64;
        const float* w = KIN(4) + (size_t)l * 1024 * 6144 + j0 + jc;
        float acc[17];
#pragma unroll
        for (int bb = 0; bb < 17; ++bb) acc[bb] = 0.f;
        for (int k = ks * 128; k < ks * 128 + 128; ++k) {
            const float wv = w[(size_t)k * 6144];
#pragma unroll
            for (int bb = 0; bb < 17; ++bb) acc[bb] += sc[bb * 1024 + k] * wv;
        }
#pragma unroll
        for (int bb = 0; bb < 17; ++bb) red[(ks * 17 + bb) * 64 + jc] = acc[bb];
        __syncthreads();
        for (int i = tid; i < 17 * 64; i += 512) {
            const int bb = i >> 6, j = i & 63; float s = KIN(5)[l * 6144 + j0 + j];
#pragma unroll
            for (int k2 = 0; k2 < 8; ++k2) s += red[(k2 * 17 + bb) * 64 + j];
            modv[((size_t)l * 17 + bb) * 6144 + j0 + j] = s;
        }
        __syncthreads();
    }
}

struct CvJob { const float* src; bf16_t* dst; int N, ldd, mode, kt, ntile, f8; };
__device__ __forceinline__ bool cv_pick(int& u, CvJob& J, const float* src, int K, int N, bf16_t* dst, int mode = 0, int ldd = -1, int f8 = 0) {
    const int ntl = (N + 63) >> 6, cnt = ntl * (K >> 6);
    if (u < cnt) { J.src = src; J.dst = dst; J.N = N; J.ldd = ldd < 0 ? K : ldd; J.mode = mode; J.kt = u / ntl; J.ntile = u % ntl; J.f8 = f8; return true; }
    u -= cnt; return false;
}
__device__ __forceinline__ void cv_load(const CvJob& J, int tid, f32x4 (&r)[2]) {
#pragma unroll
    for (int i = 0; i < 2; ++i) { const int idx = tid + i * 512, k = idx >> 4, n0 = J.ntile * 64 + (idx & 15) * 4;
        r[i] = (n0 < J.N) ? *(const f32x4*)(J.src + (size_t)(J.kt * 64 + k) * J.N + n0) : (f32x4){0.f, 0.f, 0.f, 0.f}; }
}
__device__ __forceinline__ void cv_put(float* tile, int tid, const f32x4 (&r)[2]) {
#pragma unroll
    for (int i = 0; i < 2; ++i) { const int idx = tid + i * 512, k = idx >> 4, nq = (idx & 15) * 4;
        tile[k * 65 + nq] = r[i][0]; tile[k * 65 + nq + 1] = r[i][1]; tile[k * 65 + nq + 2] = r[i][2]; tile[k * 65 + nq + 3] = r[i][3]; }
}
__device__ __forceinline__ void cv_store(const float* tile, const CvJob& J, int tid) {
    const int nl = tid >> 3, k8 = tid & 7, n = J.ntile * 64 + nl;
    if (n < J.N) { int row = n; if (J.mode) row = (n >> 7) * 256 + (n & 127) + (J.mode == 2 ? 128 : 0);
        const float* tp = tile + (k8 * 8) * 65 + nl;
        if (J.f8) { u32x2 w; w.x = pack4f8(tp[0] * W8_SCALE, tp[65] * W8_SCALE, tp[130] * W8_SCALE, tp[195] * W8_SCALE); w.y = pack4f8(tp[260] * W8_SCALE, tp[325] * W8_SCALE, tp[390] * W8_SCALE, tp[455] * W8_SCALE);
            *(u32x2*)((unsigned char*)J.dst + (size_t)row * J.ldd + J.kt * 64 + k8 * 8) = w; }
        else { u32x4 w; w.x = pack2(tp[0], tp[65]); w.y = pack2(tp[130], tp[195]); w.z = pack2(tp[260], tp[325]); w.w = pack2(tp[390], tp[455]);
            *(u32x4*)(J.dst + (size_t)row * J.ldd + J.kt * 64 + k8 * 8) = w; } }
}
#define CV_RUN(total, PICK) CV_RUN_ON(total, PICK, obid(), (int)gridDim.x)
#define CV_RUN_ON(total, PICK, bid_, nb_) do { float* tile = (float*)lds; const int tid = otid(); const int G_ = (nb_); int u_ = (bid_); CvJob J, Jn; f32x4 r[2]; \
        if (u_ < (total)) { int u = u_; PICK(u, J); cv_load(J, tid, r); } \
        while (u_ < (total)) { cv_put(tile, tid, r); __syncthreads(); const int un_ = u_ + G_; \
            if (un_ < (total)) { int u = un_; PICK(u, Jn); cv_load(Jn, tid, r); } \
            cv_store(tile, J, tid); __syncthreads(); u_ = un_; J = Jn; } } while (0)
PHASE_FN void phase_conv_ab(const KP& kp, unsigned char* lds) {
#define PICK_AB(u, J) do { if (!cv_pick(u, J, KIN(7), 1024, AB_N, WSP(bf16_t, WS_WMIX + WM_AB_IN))) cv_pick(u, J, KIN(8), 2048, 1024, WSP(bf16_t, WS_WMIX + WM_AB_OUT)); } while (0)
    CV_RUN(16 * 85 + 32 * 16, PICK_AB);
#undef PICK_AB
}
PHASE_FN void phase_conv_cd(const KP& kp, unsigned char* lds) {
#define PICK_CD(u, J) do { if (cv_pick(u, J, KIN(18), 1024, CD_N, WSP(bf16_t, WS_WMIX + WM_CD_IN))) break; \
        if (cv_pick(u, J, KIN(19), 1536, 1024, WSP(bf16_t, WS_WMIX + WM_CD_OUT))) break; \
        if (cv_pick(u, J, KIN(21), 384, 768, WSP(bf16_t, WS_WMIX + WM_UQ))) break; \
        if (cv_pick(u, J, KIN(23), 256, 1024, WSP(bf16_t, WS_WMIX + WM_UKV))) break; \
        cv_pick(u, J, KIN(29), 128, 1024, WSP(bf16_t, WS_WMIX + WM_G2)); } while (0)
    CV_RUN(16 * 65 + 24 * 16 + 6 * 12 + 4 * 16 + 2 * 16, PICK_CD);
#undef PICK_CD
}
PHASE_FN void phase_conv_moe(const KP& kp, unsigned char* lds, int l, int bid, int nb) {
#define PICK_MOE(u0, J) do { const int es = (u0) / 384; int uu = (u0) % 384; \
        const float* wg = es < 16 ? KIN(36) + ((size_t)l * 16 + es) * 1024 * 512 : KIN(39) + (size_t)l * 1024 * 512; \
        const float* wu = es < 16 ? KIN(37) + ((size_t)l * 16 + es) * 1024 * 512 : KIN(40) + (size_t)l * 1024 * 512; \
        const float* wd = es < 16 ? KIN(38) + ((size_t)l * 16 + es) * 512 * 1024 : KIN(41) + (size_t)l * 512 * 1024; \
        bf16_t* dup = (bf16_t*)(WSP(unsigned char, WS_BIG + MO_WUP) + (size_t)es * 1024 * 1024); bf16_t* ddn = (bf16_t*)(WSP(unsigned char, WS_BIG + MO_WDN) + (size_t)es * 1024 * 512); \
        if (cv_pick(uu, J, wg, 1024, 512, dup, 1, 1024, 1)) break; if (cv_pick(uu, J, wu, 1024, 512, dup, 2, 1024, 1)) break; cv_pick(uu, J, wd, 512, 1024, ddn, 0, 512, 1); } while (0)
    CV_RUN_ON(17 * 384, PICK_MOE, bid, nb);
#undef PICK_MOE
}

__device__ __forceinline__ const float* hrow_rd(const KP& kp, bool from_inputs, int b, int t) {
    if (t < CTXL) return (from_inputs ? KIN(2) : WSP(const float, WS_HC)) + ((size_t)b * CTXL + t) * D;
    return (from_inputs ? KIN(0) : KOUT) + ((size_t)b * SEQ + (t - CTXL)) * D;
}
__device__ __forceinline__ float* hrow_wr(const KP& kp, int b, int t) {
    if (t < CTXL) return WSP(float, WS_HC) + ((size_t)b * CTXL + t) * D;
    return KOUT + ((size_t)b * SEQ + (t - CTXL)) * D;
}

PHASE_FN void phase_u(const KP& kp, int layer, int g, int bid, int nb, bool to_v) {
    const int lane = otid() & 63, wid = __builtin_amdgcn_readfirstlane(otid() >> 6);
    const float* modv = WSP(const float, WS_MODV) + (size_t)layer * 17 * 6144;
    const float* ng = KIN(6) + (size_t)layer * 4 * 1024;
    bf16_t* U = to_v ? WSP(bf16_t, WS_V) + (size_t)RG * 1024 : WSP(bf16_t, WS_BIG + (layer == 0 ? L0_U : L1_U));
    for (int lr = bid * 8 + wid; lr < RG; lr += nb * 8) {
        const int bl = lr / TT, t = lr - bl * TT, b = g * BG + bl;
        const float* src = hrow_rd(kp, layer == 0, b, t);
        const float* mv = modv + (size_t)(t < CTXL ? 16 : b) * 6144;
        f32x4 x[4]; float ss = 0.f;
#pragma unroll
        for (int i = 0; i < 4; ++i) { x[i] = *(const f32x4*)(src + i * 256 + lane * 4); ss += x[i][0] * x[i][0] + x[i][1] * x[i][1] + x[i][2] * x[i][2] + x[i][3] * x[i][3]; }
        ss = wsum(ss); const float rstd = rsqrtf(ss * (1.0f / 1024.0f) + EPS);
#pragma unroll
        for (int i = 0; i < 4; ++i) { const int col = i * 256 + lane * 4;
            const f32x4 gv = *(const f32x4*)(ng + col), sc = *(const f32x4*)(mv + 1024 + col), sh = *(const f32x4*)(mv + col);
            st4bf(U + (size_t)lr * 1024 + col, x[i] * rstd * gv * (sc + 1.0f) + sh); }
    }
}

PHASE_FN void phase_r(const KP& kp, unsigned char* lds, int layer, int g) {
    const int tid = otid(), lane = tid & 63, wid = __builtin_amdgcn_readfirstlane(tid >> 6);
    float* rw = (float*)lds;
    int* se = (int*)(rw + 1024 * 16);
    int* sbase = se + 160;
    for (int i = tid; i < 1024 * 16; i += 512) rw[i] = KIN(34)[i];
    __syncthreads();
    const float* modv = WSP(const float, WS_MODV) + (size_t)layer * 17 * 6144;
    const float* ng = KIN(6) + (size_t)layer * 4 * 1024;
    const bf16_t* MIX = WSP(const bf16_t, WS_BIG + (layer == 0 ? L0_U : L1_U));
    bf16_t* V = WSP(bf16_t, WS_V);
    unsigned* cnt = WSP(unsigned, CTL_CNT) + layer * 16;
    int* TOKE = WSP(int, WS_TOKE); int* TOKP = WSP(int, WS_TOKP); float* TOKW = WSP(float, WS_TOKW); int* LIST = WSP(int, WS_LIST);
    const int nrows = layer == 0 ? RG : RGL, CH = layer == 0 ? 72 : 64, RW = CH >> 3, nchunks = nrows / CH;
    float rbias[16];
#pragma unroll
    for (int e = 0; e < 16; ++e) rbias[e] = KIN(35)[e];
    for (int ch = obid(); ch < nchunks; ch += gridDim.x) {
        for (int rr = 0; rr < RW; ++rr) {
            const int rl = wid * RW + rr, lr = ch * CH + rl;
            int b, t, tok;
            if (layer == 0) { const int bl = lr / TT; t = lr - bl * TT; b = g * BG + bl; tok = g * RG + lr; }
            else { const int bl = lr >> 11; t = CTXL + (lr & 2047); b = g * BG + bl; tok = g * RGL + lr; }
            const float* hsrc = hrow_rd(kp, layer == 0, b, t);
            float* hdst = hrow_wr(kp, b, t);
            const float* mv = modv + (size_t)(t < CTXL ? 16 : b) * 6144;
            f32x4 y[4], h[4]; float ss = 0.f;
#pragma unroll
            for (int i = 0; i < 4; ++i) { y[i] = ld4bf(MIX + (size_t)lr * 1024 + i * 256 + lane * 4); ss += y[i][0] * y[i][0] + y[i][1] * y[i][1] + y[i][2] * y[i][2] + y[i][3] * y[i][3]; }
            ss = wsum(ss); float rstd = rsqrtf(ss * (1.0f / 1024.0f) + EPS);
            float s2 = 0.f;
#pragma unroll
            for (int i = 0; i < 4; ++i) { const int col = i * 256 + lane * 4;
                const f32x4 g1 = *(const f32x4*)(ng + 1024 + col), ga = *(const f32x4*)(mv + 2048 + col), hx = *(const f32x4*)(hsrc + col);
                h[i] = hx + ga * (y[i] * rstd * g1);
                *(f32x4*)(hdst + col) = h[i];
                s2 += h[i][0] * h[i][0] + h[i][1] * h[i][1] + h[i][2] * h[i][2] + h[i][3] * h[i][3]; }
            s2 = wsum(s2); rstd = rsqrtf(s2 * (1.0f / 1024.0f) + EPS);
            float lg[16];
#pragma unroll
            for (int e = 0; e < 16; ++e) lg[e] = 0.f;
#pragma unroll
            for (int i = 0; i < 4; ++i) { const int col = i * 256 + lane * 4;
                const f32x4 g2 = *(const f32x4*)(ng + 2048 + col), scf = *(const f32x4*)(mv + 4096 + col), shf = *(const f32x4*)(mv + 3072 + col);
                const f32x4 v = h[i] * rstd * g2 * (scf + 1.0f) + shf;
                st4f8((unsigned char*)V + (size_t)tok * 2048 + col, v);
#pragma unroll
                for (int j = 0; j < 4; ++j) {
#pragma unroll
                    for (int q = 0; q < 4; ++q) { const f32x4 w4 = *(const f32x4*)(rw + (col + j) * 16 + q * 4);
                        lg[q * 4 + 0] += v[j] * w4[0]; lg[q * 4 + 1] += v[j] * w4[1]; lg[q * 4 + 2] += v[j] * w4[2]; lg[q * 4 + 3] += v[j] * w4[3]; } } }
#pragma unroll
            for (int e = 0; e < 16; ++e) lg[e] = wsum(lg[e]);
            float aff[16], sel[16];
#pragma unroll
            for (int e = 0; e < 16; ++e) { aff[e] = sigmoidf_(lg[e]); sel[e] = aff[e] + rbias[e]; }
            float gs[4];
#pragma unroll
            for (int gi = 0; gi < 4; ++gi) { const float a0 = sel[gi * 4], a1 = sel[gi * 4 + 1], a2 = sel[gi * 4 + 2], a3 = sel[gi * 4 + 3];
                gs[gi] = fmaxf(fmaxf(fmaxf(a0 + a1, a0 + a2), fmaxf(a0 + a3, a1 + a2)), fmaxf(a1 + a3, a2 + a3)); }
            int gidx = 0; float gb = gs[0];
#pragma unroll
            for (int gi = 1; gi < 4; ++gi) if (gs[gi] > gb) { gb = gs[gi]; gidx = gi; }
            float c[4], f[4];
#pragma unroll
            for (int i = 0; i < 4; ++i) { c[i] = gidx == 0 ? sel[i] : gidx == 1 ? sel[4 + i] : gidx == 2 ? sel[8 + i] : sel[12 + i];
                                           f[i] = gidx == 0 ? aff[i] : gidx == 1 ? aff[4 + i] : gidx == 2 ? aff[8 + i] : aff[12 + i]; }
            int i1 = 0; float cb = c[0];
#pragma unroll
            for (int i = 1; i < 4; ++i) if (c[i] > cb) { cb = c[i]; i1 = i; }
            int i2 = -1; float cb2 = 0.f;
#pragma unroll
            for (int i = 0; i < 4; ++i) if (i != i1 && (i2 < 0 || c[i] > cb2)) { cb2 = c[i]; i2 = i; }
            float w1 = i1 == 0 ? f[0] : i1 == 1 ? f[1] : i1 == 2 ? f[2] : f[3];
            float w2 = i2 == 0 ? f[0] : i2 == 1 ? f[1] : i2 == 2 ? f[2] : f[3];
            const float wsn = 1.0f / (w1 + w2); w1 *= wsn; w2 *= wsn;
            if (lane == 0) { se[rl * 2] = gidx * 4 + i1; se[rl * 2 + 1] = gidx * 4 + i2;
                TOKE[tok * 2] = gidx * 4 + i1; TOKE[tok * 2 + 1] = gidx * 4 + i2; TOKW[tok * 2] = w1; TOKW[tok * 2 + 1] = w2; }
        }
        __syncthreads();
        if (tid < 16) { int c2 = 0; for (int i = 0; i < 2 * CH; ++i) c2 += (se[i] == tid) ? 1 : 0; sbase[tid] = (int)atomicAdd(&cnt[tid], (unsigned)c2); }
        __syncthreads();
        if (tid < 2 * CH) { const int e = se[tid]; int rank = 0; for (int j = 0; j < tid; ++j) rank += (se[j] == e) ? 1 : 0;
            const int pos = sbase[e] + rank; const int lr = ch * CH + (tid >> 1); const int tok = (layer == 0 ? g * RG : g * RGL) + lr;
            LIST[(size_t)e * NTOK + pos] = tok; TOKP[tok * 2 + (tid & 1)] = pos; }
        __syncthreads();
    }
}

__device__ __forceinline__ int moe_tile_prefix(const unsigned* cnt, int ntok, int lane) {
    const int myt = lane < 16 ? (int)((cnt[lane & 15] + 255u) >> 8) : 0; int pref = myt;
#pragma unroll
    for (int o = 1; o < 16; o <<= 1) { const int t = __shfl_up(pref, o); if (lane >= o) pref += t; }
    return pref - myt + ntok / 256;
}
PHASE_FN void phase_moe_gather(const KP& kp, int layer) {
    const int lane = otid() & 63, wid = __builtin_amdgcn_readfirstlane(otid() >> 6);
    const int ntok = layer == 0 ? NTOK : NLAT;
    const int tpre = moe_tile_prefix(WSP(const unsigned, CTL_CNT) + layer * 16, ntok, lane);
    const bf16_t* V = WSP(const bf16_t, WS_V); bf16_t* XG = WSP(bf16_t, WS_BIG + MO_XG);
    const int* TOKE = WSP(const int, WS_TOKE); const int* TOKP = WSP(const int, WS_TOKP);
    for (int it = obid() * 8 + wid; it < 2 * ntok; it += gridDim.x * 8) {
        const int tok = it >> 1, e = TOKE[it], pos = TOKP[it];
        const size_t row = (size_t)(__shfl(tpre, e) - ntok / 256) * 256 + pos;
        const u32x4* src = (const u32x4*)(V + (size_t)tok * 1024) + lane; u32x4* dst = (u32x4*)(XG + row * 1024) + lane;
        dst[0] = src[0];
    }
}
PHASE_FN void phase_moe_gemm(const KP& kp, unsigned char* lds, int layer, bool down) {
    const int tid = otid();
    int* pre = (int*)(lds + pg8::STAGE_BYTES);
    int* slotmap = pre + 32;
    const int ntok = layer == 0 ? NTOK : NLAT;
    const unsigned* cnt = WSP(const unsigned, CTL_CNT) + layer * 16;
    if (tid == 0) { int p = ntok / 256; pre[0] = 0; pre[1] = p; for (int e = 0; e < 16; ++e) { p += ((int)cnt[e] + 255) >> 8; pre[2 + e] = p; } }
    __syncthreads();
    const int ntiles = pre[17];
    for (int t = tid; t < ntiles; t += 512) { int idx = 0; for (int e = 1; e < 17; ++e) if (pre[e] <= t) idx = e; slotmap[t] = idx == 0 ? 16 : idx - 1; }
    __syncthreads();
    pg8::MoeOrder S{slotmap, ntiles, (int)gridDim.x, obid()};
    if (!down) {
        pg8::Gemm g{WSP(const bf16_t, WS_V), WSP(const bf16_t, WS_BIG + MO_WUP), 0, 0, 512, WSP(const bf16_t, WS_BIG + MO_XG), ntok / 256, 1024, 0};
        pg8::EpiSwi E{WSP(bf16_t, WS_BIG + MO_HID)};
        pg8::gemm_phase<pg8::EpiSwi, pg8::MoeOrder, false, true>((PG8_LAS unsigned char*)lds, g, S, E, nullptr);
    } else {
        pg8::Gemm g{WSP(const bf16_t, WS_BIG + MO_HID), WSP(const bf16_t, WS_BIG + MO_WDN), 0, 0, 256, nullptr, 0x7fffffff, 512, 0};
        pg8::EpiBfG E{WSP(bf16_t, WS_BIG + MO_CON), 1024, 1024, 3, W8_INV};
        pg8::gemm_phase<pg8::EpiBfG, pg8::MoeOrder, false, true>((PG8_LAS unsigned char*)lds, g, S, E, nullptr);
    }
    __syncthreads();
}

PHASE_FN void phase_combine(const KP& kp, int layer) {
    const int lane = otid() & 63, wid = __builtin_amdgcn_readfirstlane(otid() >> 6);
    const int ntok = layer == 0 ? NTOK : NLAT;
    const unsigned* cnt = WSP(const unsigned, CTL_CNT) + layer * 16;
    const float* modv = WSP(const float, WS_MODV) + (size_t)layer * 17 * 6144;
    const float* ng = KIN(6) + (size_t)layer * 4 * 1024 + 3 * 1024;
    const bf16_t* CON = WSP(const bf16_t, WS_BIG + MO_CON);
    const int* TOKE = WSP(const int, WS_TOKE); const int* TOKP = WSP(const int, WS_TOKP); const float* TOKW = WSP(const float, WS_TOKW);
    const int tpre = moe_tile_prefix(cnt, ntok, lane);
    for (int tok0 = (obid() * 8 + wid) * 2; tok0 < ntok; tok0 += gridDim.x * 16) {
        int e1[2], e2[2], p1[2], p2[2]; float w1[2], w2[2];
#pragma unroll
        for (int u = 0; u < 2; ++u) { const int tok = tok0 + u; e1[u] = TOKE[tok * 2]; e2[u] = TOKE[tok * 2 + 1]; p1[u] = TOKP[tok * 2]; p2[u] = TOKP[tok * 2 + 1]; w1[u] = TOKW[tok * 2]; w2[u] = TOKW[tok * 2 + 1]; }
        f32x4 f[2][4], hx[2][4]; float* hp[2]; const float* mv[2];
#pragma unroll
        for (int u = 0; u < 2; ++u) { const int tok = tok0 + u;
            const size_t r1 = (size_t)__shfl(tpre, e1[u]) * 256 + p1[u], r2 = (size_t)__shfl(tpre, e2[u]) * 256 + p2[u];
            int b, t;
            if (layer == 0) { b = tok / TT; t = tok - b * TT; } else { b = tok >> 11; t = CTXL + (tok & 2047); }
            hp[u] = hrow_wr(kp, b, t); mv[u] = modv + (size_t)(t < CTXL ? 16 : b) * 6144 + 5 * 1024;
#pragma unroll
            for (int i = 0; i < 4; ++i) { const int col = i * 256 + lane * 4;
                f[u][i] = ld4bf(CON + (size_t)tok * 1024 + col) + ld4bf(CON + r1 * 1024 + col) * w1[u] + ld4bf(CON + r2 * 1024 + col) * w2[u];
                hx[u][i] = *(const f32x4*)(hp[u] + col); } }
#pragma unroll
        for (int u = 0; u < 2; ++u) { float ss = 0.f;
#pragma unroll
            for (int i = 0; i < 4; ++i) ss += f[u][i][0] * f[u][i][0] + f[u][i][1] * f[u][i][1] + f[u][i][2] * f[u][i][2] + f[u][i][3] * f[u][i][3];
            ss = wsum(ss); const float rstd = rsqrtf(ss * (1.0f / 1024.0f) + EPS);
            float s2 = 0.f;
#pragma unroll
            for (int i = 0; i < 4; ++i) { const int col = i * 256 + lane * 4;
                const f32x4 g3 = *(const f32x4*)(ng + col), gf = *(const f32x4*)(mv[u] + col);
                const f32x4 hn = hx[u][i] + gf * (f[u][i] * rstd * g3);
                *(f32x4*)(hp[u] + col) = hn; hx[u][i] = hn;
                s2 += hn[0] * hn[0] + hn[1] * hn[1] + hn[2] * hn[2] + hn[3] * hn[3]; }
            if (layer == 0) {
                s2 = wsum(s2); const float rs2 = rsqrtf(s2 * (1.0f / 1024.0f) + EPS);
                const float* mv1 = mv[u] - 5 * 1024 + 17 * 6144;
                const float* ng1 = KIN(6) + 4 * 1024;
                bf16_t* U1 = WSP(bf16_t, WS_V) + (size_t)(tok0 + u) * 1024;
#pragma unroll
                for (int i = 0; i < 4; ++i) { const int col = i * 256 + lane * 4;
                    const f32x4 gv = *(const f32x4*)(ng1 + col), sc = *(const f32x4*)(mv1 + 1024 + col), sh = *(const f32x4*)(mv1 + col);
                    st4bf(U1 + col, hx[u][i] * rs2 * gv * (sc + 1.0f) + sh); } } }
    }
}

template <int CH>
__device__ __forceinline__ int scan_t(int dir, int ci, int j) {
    constexpr int NC_CTX = CTXL / CH;
    if (!dir) return ci * CH + j;
    return ci < NC_CTX ? (CTXL - 1 - ci * CH - j) : (TT - 1 - (ci - NC_CTX) * CH - j);
}

constexpr int ML_LQ = 136, ML_LT = 72, ML_VR = 144;
PHASE_FN void mlstm_unit(const KP& kp, unsigned char* lds, int bl, int h, int dir, int vh) {
    const int tid = otid();
    bf16_t* Qs = (bf16_t*)lds;
    bf16_t* Ks = Qs + 64 * ML_LQ;
    bf16_t* KTE = Ks + 64 * ML_LQ;
    bf16_t* VT = KTE + 128 * ML_LT;
    bf16_t* Ps = VT + ML_VR * ML_LT;
    bf16_t* Cb = Ps + 64 * ML_LT;
    float* fs = (float*)(Cb + ML_VR * ML_LQ);
    float* s_rowv = fs;
    float* s_colv = fs + 64;
    float* s_wint = fs + 128;
    float* s_emj = fs + 192;
    float* s_E = fs + 256;
    float* s_den = fs + 320;
    float* s_misc = fs + 384;
    const bf16_t* P = WSP(const bf16_t, WS_BIG + L0_P);
    bf16_t* HOUT = WSP(bf16_t, WS_BIG + (dir ? L0_HB : L0_AO)); const int ldh = dir ? 1024 : 2048;
    const float ibias = KIN(9)[dir * 4 + h], fbias = KIN(10)[dir * 4 + h];
    for (int i = tid; i < ML_VR * ML_LQ; i += 512) Cb[i] = 0;
    for (int i = tid; i < 16 * ML_LT; i += 512) VT[128 * ML_LT + i] = (i < ML_LT) ? (bf16_t)0x3f80 : (bf16_t)0;
    f32x4 Cacc[8], Nacc;
#pragma unroll
    for (int i = 0; i < 8; ++i) Cacc[i] = (f32x4){0.f, 0.f, 0.f, 0.f};
    Nacc = (f32x4){0.f, 0.f, 0.f, 0.f};
    float m_state = 0.f;
    u32x4 pq[2], pk[2], pv[2]; bf16_t pgi = 0, pgf = 0;
#define ML_REQ(ci_) do { _Pragma("unroll") for (int i = 0; i < 2; ++i) { const int p = tid + i * 512, j = p >> 4, c8 = p & 15; \
            const bf16_t* pr = P + ((size_t)bl * TT + scan_t<64>(dir, (ci_), j)) * AB_N; \
            pq[i] = *(const u32x4*)(pr + AB_Q + h * 128 + c8 * 8); pk[i] = *(const u32x4*)(pr + AB_K + h * 128 + c8 * 8); \
            const int jv = tid & 63, cv = (tid >> 6) + i * 8; \
            pv[i] = *(const u32x4*)(P + ((size_t)bl * TT + scan_t<64>(dir, (ci_), jv)) * AB_N + AB_V + h * 256 + vh * 128 + cv * 8); } \
        if (tid < 64) { const bf16_t* pg = P + ((size_t)bl * TT + scan_t<64>(dir, (ci_), tid)) * AB_N; pgi = pg[AB_IG + dir * 4 + h]; pgf = pg[AB_FG + dir * 4 + h]; } } while (0)
    ML_REQ(0);
    lds_barrier();
    for (int ci = 0; ci < TT / 64; ++ci) {
        int tq = tid; asm volatile("" : "+v"(tq));
        const int lane = tq & 63, wid = __builtin_amdgcn_readfirstlane(tq >> 6), fr = lane & 15, fq = lane >> 4;
#pragma unroll
        for (int i = 0; i < 2; ++i) {
            const int p = tq + i * 512, j = p >> 4, c8 = p & 15;
            u32x4 q = pq[i];
            const float qs = 0.08838834764831845f;
            q.x = pack2(lo2f(q.x) * qs, hi2f(q.x) * qs); q.y = pack2(lo2f(q.y) * qs, hi2f(q.y) * qs);
            q.z = pack2(lo2f(q.z) * qs, hi2f(q.z) * qs); q.w = pack2(lo2f(q.w) * qs, hi2f(q.w) * qs);
            *(u32x4*)(Qs + j * ML_LQ + c8 * 8) = q;
            *(u32x4*)(Ks + j * ML_LQ + c8 * 8) = pk[i];
            const u32x4 v = pv[i];
            bf16_t* vt = VT + (((tq >> 6) + i * 8) * 8) * ML_LT + (tq & 63);
            vt[0 * ML_LT] = (bf16_t)(v.x & 0xffff); vt[1 * ML_LT] = (bf16_t)(v.x >> 16); vt[2 * ML_LT] = (bf16_t)(v.y & 0xffff); vt[3 * ML_LT] = (bf16_t)(v.y >> 16);
            vt[4 * ML_LT] = (bf16_t)(v.z & 0xffff); vt[5 * ML_LT] = (bf16_t)(v.z >> 16); vt[6 * ML_LT] = (bf16_t)(v.w & 0xffff); vt[7 * ML_LT] = (bf16_t)(v.w >> 16);
        }
        if (wid == 0) {
            const float ig = bf2f(pgi) + ibias;
            const float lf = logsigmoidf_(bf2f(pgf) + fbias);
            float b = lf;
#pragma unroll
            for (int o = 1; o < 64; o <<= 1) { const float t = __shfl_up(b, o); if (lane >= o) b += t; }
            const float u = ig - b; float pm = u;
#pragma unroll
            for (int o = 1; o < 64; o <<= 1) { const float t = __shfl_up(pm, o); if (lane >= o) pm = fmaxf(pm, t); }
            const float mj = fmaxf(b + m_state, b + pm);
            const float b63 = __shfl(b, 63), pm63 = __shfl(pm, 63);
            const float mnew = fmaxf(b63 + m_state, b63 + pm63);
            s_rowv[lane] = b - mj; s_colv[lane] = u; s_wint[lane] = __expf(b + m_state - mj); s_emj[lane] = __expf(-mj);
            s_E[lane] = __expf(b63 + u - mnew);
            if (lane == 0) { s_misc[0] = mnew; s_misc[1] = __expf(b63 + m_state - mnew); }
        }
        if (ci + 1 < TT / 64) ML_REQ(ci + 1);
        lds_barrier();
        {
            const int jt = wid >> 1;
#pragma unroll
            for (int q2 = 0; q2 < 2; ++q2) {
                const int st = (wid & 1) * 2 + q2;
                f32x4 acc = (f32x4){0.f, 0.f, 0.f, 0.f};
                if (st <= jt) {
                    bf16x8 fa[4], fb[4];
#pragma unroll
                    for (int k = 0; k < 4; ++k) { fa[k] = ldfrag(Qs, ML_LQ, jt * 16, k * 32, fr, fq); fb[k] = ldfrag(Ks, ML_LQ, st * 16, k * 32, fr, fq); }
                    __builtin_amdgcn_sched_barrier(0);
                    f32x4 acc2 = (f32x4){0.f, 0.f, 0.f, 0.f};
                    acc = mma16(fa[0], fb[0], acc); acc2 = mma16(fa[1], fb[1], acc2); acc = mma16(fa[2], fb[2], acc); acc2 = mma16(fa[3], fb[3], acc2);
                    acc = acc + acc2;
                }
                const int s = st * 16 + fr; const float cv = s_colv[s];
#pragma unroll
                for (int r = 0; r < 4; ++r) { const int j = jt * 16 + fq * 4 + r;
                    const float pv2 = (s <= j) ? acc[r] * __expf(s_rowv[j] + cv) : 0.f;
                    Ps[j * ML_LT + s] = f2bf(pv2); }
            }
#pragma unroll
            for (int i = 0; i < 2; ++i) {
                const int s = lane, c8 = wid + i * 8; const float e = s_E[s];
                const u32x4 kv = *(const u32x4*)(Ks + s * ML_LQ + c8 * 8);
                bf16_t* kt = KTE + (c8 * 8) * ML_LT + s;
                kt[0 * ML_LT] = f2bf(lo2f(kv.x) * e); kt[1 * ML_LT] = f2bf(hi2f(kv.x) * e); kt[2 * ML_LT] = f2bf(lo2f(kv.y) * e); kt[3 * ML_LT] = f2bf(hi2f(kv.y) * e);
                kt[4 * ML_LT] = f2bf(lo2f(kv.z) * e); kt[5 * ML_LT] = f2bf(hi2f(kv.z) * e); kt[6 * ML_LT] = f2bf(lo2f(kv.w) * e); kt[7 * ML_LT] = f2bf(hi2f(kv.w) * e);
            }
        }
        lds_barrier();
        f32x4 a1[4], a2[4];
        {
            const int jt = wid >> 1;
            bf16x8 fp[2], fqq[4];
#pragma unroll
            for (int k = 0; k < 2; ++k) fp[k] = ldfrag(Ps, ML_LT, jt * 16, k * 32, fr, fq);
#pragma unroll
            for (int k = 0; k < 4; ++k) fqq[k] = ldfrag(Qs, ML_LQ, jt * 16, k * 32, fr, fq);
            {
                bf16x8 fv[4][2];
#pragma unroll
                for (int q4 = 0; q4 < 4; ++q4)
#pragma unroll
                    for (int k = 0; k < 2; ++k) fv[q4][k] = ldfrag(VT, ML_LT, ((wid & 1) * 4 + q4) * 16, k * 32, fr, fq);
                __builtin_amdgcn_sched_barrier(0);
#pragma unroll
                for (int q4 = 0; q4 < 4; ++q4) a1[q4] = (f32x4){0.f, 0.f, 0.f, 0.f};
#pragma unroll
                for (int k = 0; k < 2; ++k)
#pragma unroll
                    for (int q4 = 0; q4 < 4; ++q4) a1[q4] = mma16(fv[q4][k], fp[k], a1[q4]);
            }
#pragma unroll
            for (int hh = 0; hh < 2; ++hh) {
                bf16x8 fc[2][4];
#pragma unroll
                for (int q2 = 0; q2 < 2; ++q2)
#pragma unroll
                    for (int k = 0; k < 4; ++k) fc[q2][k] = ldfrag(Cb, ML_LQ, ((wid & 1) * 4 + hh * 2 + q2) * 16, k * 32, fr, fq);
                __builtin_amdgcn_sched_barrier(0);
                a2[hh * 2] = (f32x4){0.f, 0.f, 0.f, 0.f}; a2[hh * 2 + 1] = (f32x4){0.f, 0.f, 0.f, 0.f};
#pragma unroll
                for (int k = 0; k < 4; ++k) { a2[hh * 2] = mma16(fc[0][k], fqq[k], a2[hh * 2]); a2[hh * 2 + 1] = mma16(fc[1][k], fqq[k], a2[hh * 2 + 1]); }
            }
            if (wid & 1) {
                f32x4 d1 = (f32x4){0.f, 0.f, 0.f, 0.f}, d2 = (f32x4){0.f, 0.f, 0.f, 0.f};
                bf16x8 fo[2], fn[4];
#pragma unroll
                for (int k = 0; k < 2; ++k) fo[k] = ldfrag(VT, ML_LT, 128, k * 32, fr, fq);
#pragma unroll
                for (int k = 0; k < 4; ++k) fn[k] = ldfrag(Cb, ML_LQ, 128, k * 32, fr, fq);
                __builtin_amdgcn_sched_barrier(0);
                d1 = mma16(fo[0], fp[0], d1); d2 = mma16(fn[0], fqq[0], d2); d1 = mma16(fo[1], fp[1], d1); d2 = mma16(fn[1], fqq[1], d2);
                d2 = mma16(fn[2], fqq[2], d2); d2 = mma16(fn[3], fqq[3], d2);
                if (fq == 0) { const int j = jt * 16 + fr; s_den[j] = fmaxf(fabsf(d1[0] + s_wint[j] * d2[0]), s_emj[j]); }
            }
        }
        lds_barrier();
        {
            const int jt = wid >> 1, j = jt * 16 + fr;
            const float wi = s_wint[j], rden = frcp_(s_den[j]);
            const size_t row = (size_t)bl * TT + scan_t<64>(dir, ci, j);
#pragma unroll
            for (int q4 = 0; q4 < 4; ++q4) { const int v0 = ((wid & 1) * 4 + q4) * 16 + fq * 4;
                st4bf(HOUT + row * ldh + h * 256 + vh * 128 + v0, (a1[q4] + a2[q4] * wi) * rden); }
        }
        {
            const float dec = s_misc[1];
            const bf16x8 bv0 = ldfrag(VT, ML_LT, wid * 16, 0, fr, fq), bv1 = ldfrag(VT, ML_LT, wid * 16, 32, fr, fq);
#pragma unroll
            for (int hh = 0; hh < 2; ++hh) {
                bf16x8 fk[4][2];
#pragma unroll
                for (int q = 0; q < 4; ++q) { fk[q][0] = ldfrag(KTE, ML_LT, (hh * 4 + q) * 16, 0, fr, fq); fk[q][1] = ldfrag(KTE, ML_LT, (hh * 4 + q) * 16, 32, fr, fq); }
                __builtin_amdgcn_sched_barrier(0);
#pragma unroll
                for (int q = 0; q < 4; ++q) Cacc[hh * 4 + q] = Cacc[hh * 4 + q] * dec;
#pragma unroll
                for (int q = 0; q < 4; ++q) Cacc[hh * 4 + q] = mma16(fk[q][0], bv0, Cacc[hh * 4 + q]);
#pragma unroll
                for (int q = 0; q < 4; ++q) Cacc[hh * 4 + q] = mma16(fk[q][1], bv1, Cacc[hh * 4 + q]);
#pragma unroll
                for (int q = 0; q < 4; ++q) st4bf(Cb + (wid * 16 + fr) * ML_LQ + (hh * 4 + q) * 16 + fq * 4, Cacc[hh * 4 + q]);
            }
            Nacc = Nacc * dec;
            Nacc = mma16(ldfrag(KTE, ML_LT, wid * 16, 0, fr, fq), ldfrag(VT, ML_LT, 128, 0, fr, fq), Nacc);
            Nacc = mma16(ldfrag(KTE, ML_LT, wid * 16, 32, fr, fq), ldfrag(VT, ML_LT, 128, 32, fr, fq), Nacc);
            st4bf(Cb + (128 + fr) * ML_LQ + wid * 16 + fq * 4, Nacc);
            m_state = s_misc[0];
        }
        lds_barrier();
    }
#undef ML_REQ
}

constexpr size_t L0_XC = L0_U;
static_assert(L0_XC + (size_t)RG * 1280 * 2 <= BIG_BYTES, "xconv buffer");
PHASE_FN void phase_xconv(const KP& kp) {
    const int lane = otid() & 63, wid = __builtin_amdgcn_readfirstlane(otid() >> 6);
    const bf16_t* P = WSP(const bf16_t, WS_BIG + L0_P); bf16_t* XC = WSP(bf16_t, WS_BIG + L0_XC);
    const float* cw = KIN(12); const float* cb = KIN(13);
    constexpr int RUN = 9;
    for (int run = obid() * 8 + wid; run < RG / RUN; run += gridDim.x * 8) {
        const int r0 = run * RUN;
#pragma unroll
        for (int i = 0; i < 5; ++i) { const int col = i * 256 + lane * 4;
            const f32x4 bias = *(const f32x4*)(cb + col);
            f32x4 w[5], x[5];
#pragma unroll
            for (int q = 0; q < 5; ++q) w[q] = *(const f32x4*)(cw + q * 1280 + col);
#pragma unroll
            for (int q = 0; q < 4; ++q) { const int rr = r0 - 2 + q; x[q + 1] = (rr >= 0 && rr < RG) ? ld4bf(P + (size_t)rr * AB_N + AB_XBC + col) : (f32x4){0.f, 0.f, 0.f, 0.f}; }
#pragma unroll
            for (int k = 0; k < RUN; ++k) {
                const int lr = r0 + k, bl = lr / TT, t = lr - bl * TT, lo = t < CTXL ? 0 : CTXL, hi = t < CTXL ? CTXL : TT;
#pragma unroll
                for (int q = 0; q < 4; ++q) x[q] = x[q + 1];
                { const int rr = lr + 2; x[4] = (rr < RG) ? ld4bf(P + (size_t)rr * AB_N + AB_XBC + col) : (f32x4){0.f, 0.f, 0.f, 0.f}; }
                f32x4 a = bias;
#pragma unroll
                for (int q = 0; q < 5; ++q) { const int tt = t - 2 + q; if (tt >= lo && tt < hi) a += w[q] * x[q]; }
                f32x4 o;
#pragma unroll
                for (int r = 0; r < 4; ++r) o[r] = siluf_(a[r]);
                st4bf(XC + (size_t)lr * 1280 + col, o);
            }
        }
    }
}

constexpr int SS_LT = 72, SS_LX = 136;
PHASE_FN void ssd_unit(const KP& kp, unsigned char* lds, int bl, int dir, int hp) {
    const int tid = otid();
    const int gi = hp >> 2, hh0 = hp * 2;
    bf16_t* Wm = (bf16_t*)lds;
    bf16_t* CM = Wm + 2 * 64 * SS_LT;
    bf16_t* BM = CM + 64 * SS_LT;
    bf16_t* Xn = BM + 64 * SS_LT;
    bf16_t* XT = Xn + 64 * SS_LX;
    bf16_t* BTE = XT + 2 * 64 * SS_LT;
    bf16_t* Sb = BTE + 2 * 64 * SS_LT;
    float* fs = (float*)(Sb + 2 * 64 * SS_LT);
    float* s_b = fs;
    float* s_dt = fs + 128;
    float* s_e = fs + 256;
    float* s_misc = fs + 384;
    const bf16_t* P = WSP(const bf16_t, WS_BIG + L0_P); const bf16_t* XC = WSP(const bf16_t, WS_BIG + L0_XC);
    bf16_t* YOUT = WSP(bf16_t, WS_BIG + (dir ? L0_YB : L0_AO + 2048)); const int ldy = dir ? 1024 : 2048;
    for (int i = tid; i < 2 * 64 * SS_LT; i += 512) Sb[i] = 0;
    f32x4 Sacc[4];
#pragma unroll
    for (int i = 0; i < 4; ++i) Sacc[i] = (f32x4){0.f, 0.f, 0.f, 0.f};
    const float dtb = KIN(14)[dir * 16 + hh0 + ((tid >> 6) & 1)], aexp = __expf(KIN(15)[dir * 16 + hh0 + ((tid >> 6) & 1)]);
    const float dskip = KIN(16)[hh0 + (tid >> 8)];
    u32x4 pr[4]; bf16_t pdt = 0;
#define SS_REQ(ci_) do { _Pragma("unroll") for (int q = 0; q < 4; ++q) { const int p = tid + q * 512, j = p >> 5, c8 = p & 31; \
            const int col = c8 < 16 ? hh0 * 64 + c8 * 8 : (c8 < 24 ? 1024 + gi * 64 + (c8 - 16) * 8 : 1152 + gi * 64 + (c8 - 24) * 8); \
            pr[q] = *(const u32x4*)(XC + ((size_t)bl * TT + scan_t<64>(dir, (ci_), j)) * 1280 + col); } \
        if (tid < 128) pdt = P[((size_t)bl * TT + scan_t<64>(dir, (ci_), tid & 63)) * AB_N + AB_DT + dir * 16 + hh0 + (tid >> 6)]; } while (0)
    SS_REQ(0);
    lds_barrier();
    for (int ci = 0; ci < TT / 64; ++ci) {
        int tq = tid; asm volatile("" : "+v"(tq));
        const int lane = tq & 63, wid = __builtin_amdgcn_readfirstlane(tq >> 6), fr = lane & 15, fq = lane >> 4, hl_w = wid >> 2;
#pragma unroll
        for (int q = 0; q < 4; ++q) { const int p = tq + q * 512, j = p >> 5, c8 = p & 31;
            bf16_t* dst = c8 < 16 ? Xn + j * SS_LX + c8 * 8 : (c8 < 24 ? BM + j * SS_LT + (c8 - 16) * 8 : CM + j * SS_LT + (c8 - 24) * 8);
            *(u32x4*)dst = pr[q]; }
        if (wid < 2) {
            const float dt = softplusf_(bf2f(pdt) + dtb);
            float b = -dt * aexp;
#pragma unroll
            for (int o = 1; o < 64; o <<= 1) { const float t = __shfl_up(b, o); if (lane >= o) b += t; }
            const float b63 = __shfl(b, 63);
            s_b[wid * 64 + lane] = b; s_dt[wid * 64 + lane] = dt; s_e[wid * 64 + lane] = __expf(b63 - b) * dt;
            if (lane == 0) s_misc[wid] = __expf(b63);
        }
        if (ci + 1 < TT / 64) SS_REQ(ci + 1);
        lds_barrier();
        {
            const int jt = wid >> 1;
#pragma unroll
            for (int q2 = 0; q2 < 2; ++q2) {
                const int st = (wid & 1) * 2 + q2;
                f32x4 acc = (f32x4){0.f, 0.f, 0.f, 0.f};
                if (st <= jt) {
                    const bf16x8 c0 = ldfrag(CM, SS_LT, jt * 16, 0, fr, fq), c1 = ldfrag(CM, SS_LT, jt * 16, 32, fr, fq), b0 = ldfrag(BM, SS_LT, st * 16, 0, fr, fq), b1 = ldfrag(BM, SS_LT, st * 16, 32, fr, fq);
                    __builtin_amdgcn_sched_barrier(0);
                    acc = mma16(c0, b0, acc); acc = mma16(c1, b1, acc);
                }
                const int s = st * 16 + fr;
#pragma unroll
                for (int hl = 0; hl < 2; ++hl) { const float bs = s_b[hl * 64 + s], ds = s_dt[hl * 64 + s];
#pragma unroll
                    for (int r = 0; r < 4; ++r) { const int j = jt * 16 + fq * 4 + r;
                        const float wv = (s <= j) ? acc[r] * __expf(s_b[hl * 64 + j] - bs) * ds : 0.f;
                        Wm[(hl * 64 + j) * SS_LT + s] = f2bf(wv); } }
            }
            {
                const int s = lane, n8 = wid;
                const u32x4 bv = *(const u32x4*)(BM + s * SS_LT + n8 * 8);
#pragma unroll
                for (int hl = 0; hl < 2; ++hl) { const float e = s_e[hl * 64 + s];
                    bf16_t* bt = BTE + (hl * 64 + n8 * 8) * SS_LT + s;
                    bt[0 * SS_LT] = f2bf(lo2f(bv.x) * e); bt[1 * SS_LT] = f2bf(hi2f(bv.x) * e); bt[2 * SS_LT] = f2bf(lo2f(bv.y) * e); bt[3 * SS_LT] = f2bf(hi2f(bv.y) * e);
                    bt[4 * SS_LT] = f2bf(lo2f(bv.z) * e); bt[5 * SS_LT] = f2bf(hi2f(bv.z) * e); bt[6 * SS_LT] = f2bf(lo2f(bv.w) * e); bt[7 * SS_LT] = f2bf(hi2f(bv.w) * e); }
#pragma unroll
                for (int i = 0; i < 2; ++i) { const int c8 = wid + i * 8;
                    const u32x4 xv = *(const u32x4*)(Xn + s * SS_LX + c8 * 8);
                    bf16_t* xt = XT + (c8 * 8) * SS_LT + s;
                    xt[0 * SS_LT] = (bf16_t)(xv.x & 0xffff); xt[1 * SS_LT] = (bf16_t)(xv.x >> 16); xt[2 * SS_LT] = (bf16_t)(xv.y & 0xffff); xt[3 * SS_LT] = (bf16_t)(xv.y >> 16);
                    xt[4 * SS_LT] = (bf16_t)(xv.z & 0xffff); xt[5 * SS_LT] = (bf16_t)(xv.z >> 16); xt[6 * SS_LT] = (bf16_t)(xv.w & 0xffff); xt[7 * SS_LT] = (bf16_t)(xv.w >> 16); }
            }
        }
        lds_barrier();
        {
            const int hl = hl_w, jt = wid & 3, j = jt * 16 + fr;
            const bf16_t* Wh = Wm + hl * 64 * SS_LT; const bf16_t* Xh = XT + hl * 64 * SS_LT; const bf16_t* Sh = Sb + hl * 64 * SS_LT;
            const float eb = __expf(s_b[hl * 64 + j]);
            const size_t row = (size_t)bl * TT + scan_t<64>(dir, ci, j);
            const bf16x8 w0 = ldfrag(Wh, SS_LT, jt * 16, 0, fr, fq), w1 = ldfrag(Wh, SS_LT, jt * 16, 32, fr, fq), m0 = ldfrag(CM, SS_LT, jt * 16, 0, fr, fq), m1 = ldfrag(CM, SS_LT, jt * 16, 32, fr, fq);
#pragma unroll
            for (int hh = 0; hh < 2; ++hh) {
                bf16x8 fx[2][2], fs2[2][2];
#pragma unroll
                for (int q = 0; q < 2; ++q)
#pragma unroll
                    for (int k = 0; k < 2; ++k) { fx[q][k] = ldfrag(Xh, SS_LT, (hh * 2 + q) * 16, k * 32, fr, fq); fs2[q][k] = ldfrag(Sh, SS_LT, (hh * 2 + q) * 16, k * 32, fr, fq); }
                f32x4 dx[2];
                if (!dir) { dx[0] = ld4bf(Xn + j * SS_LX + hl * 64 + (hh * 2) * 16 + fq * 4); dx[1] = ld4bf(Xn + j * SS_LX + hl * 64 + (hh * 2 + 1) * 16 + fq * 4); }
                __builtin_amdgcn_sched_barrier(0);
                f32x4 y1[2], y2[2];
#pragma unroll
                for (int q = 0; q < 2; ++q) { y1[q] = (f32x4){0.f, 0.f, 0.f, 0.f}; y2[q] = (f32x4){0.f, 0.f, 0.f, 0.f}; }
#pragma unroll
                for (int q = 0; q < 2; ++q) { y1[q] = mma16(fx[q][0], w0, y1[q]); y2[q] = mma16(fs2[q][0], m0, y2[q]); }
#pragma unroll
                for (int q = 0; q < 2; ++q) { y1[q] = mma16(fx[q][1], w1, y1[q]); y2[q] = mma16(fs2[q][1], m1, y2[q]); }
#pragma unroll
                for (int q = 0; q < 2; ++q) { f32x4 y = y1[q] + y2[q] * eb;
                    if (!dir) y = y + dx[q] * dskip;
                    st4bf(YOUT + row * ldy + (hh0 + hl) * 64 + (hh * 2 + q) * 16 + fq * 4, y); }
            }
        }
        lds_barrier();
        {
            const int hl = hl_w, pt = wid & 3; const float eb63 = s_misc[hl];
            const bf16_t* Xh = XT + hl * 64 * SS_LT; const bf16_t* Bh = BTE + hl * 64 * SS_LT; bf16_t* Sh = Sb + hl * 64 * SS_LT;
            const bf16x8 x0 = ldfrag(Xh, SS_LT, pt * 16, 0, fr, fq), x1 = ldfrag(Xh, SS_LT, pt * 16, 32, fr, fq);
            bf16x8 fb[4][2];
#pragma unroll
            for (int nt = 0; nt < 4; ++nt) { fb[nt][0] = ldfrag(Bh, SS_LT, nt * 16, 0, fr, fq); fb[nt][1] = ldfrag(Bh, SS_LT, nt * 16, 32, fr, fq); }
            __builtin_amdgcn_sched_barrier(0);
#pragma unroll
            for (int nt = 0; nt < 4; ++nt) Sacc[nt] = Sacc[nt] * eb63;
#pragma unroll
            for (int nt = 0; nt < 4; ++nt) Sacc[nt] = mma16(fb[nt][0], x0, Sacc[nt]);
#pragma unroll
            for (int nt = 0; nt < 4; ++nt) Sacc[nt] = mma16(fb[nt][1], x1, Sacc[nt]);
#pragma unroll
            for (int nt = 0; nt < 4; ++nt) st4bf(Sh + (pt * 16 + fr) * SS_LT + nt * 16 + fq * 4, Sacc[nt]);
        }
        lds_barrier();
    }
#undef SS_REQ
}

__device__ __forceinline__ void phase_scan_ab(const KP& kp, unsigned char* lds) {
    for (int rep = 0; rep < ((PROBE_DUP & 8192) ? 2 : 1); ++rep)
    for (int u = obid(); u < 256; u += gridDim.x) if (u < 128) { mlstm_unit(kp, lds, u >> 4, (u >> 2) & 3, (u >> 1) & 1, u & 1); __syncthreads(); }
    for (int rep = 0; rep < ((PROBE_DUP & 16384) ? 2 : 1); ++rep)
    for (int u = obid(); u < 256; u += gridDim.x) if (u >= 128) { const int v = u - 128; ssd_unit(kp, lds, v >> 4, (v >> 3) & 1, v & 7); __syncthreads(); }
}

PHASE_FN void phase_fin_ab(const KP& kp) {
    const int lane = otid() & 63, wid = __builtin_amdgcn_readfirstlane(otid() >> 6);
    const bf16_t* P = WSP(const bf16_t, WS_BIG + L0_P);
    bf16_t* AO = WSP(bf16_t, WS_BIG + L0_AO); const bf16_t* HB = WSP(const bf16_t, WS_BIG + L0_HB); const bf16_t* YB = WSP(const bf16_t, WS_BIG + L0_YB);
    const float* mln = KIN(11); const float* sn = KIN(17);
    for (int lr = obid() * 8 + wid; lr < RG; lr += gridDim.x * 8) {
        const bf16_t* pr = P + (size_t)lr * AB_N;
        f32x4 yz[4]; float ss2 = 0.f;
#pragma unroll
        for (int i = 0; i < 4; ++i) { const int col = i * 256 + lane * 4;
            const f32x4 hs = ld4bf(AO + (size_t)lr * 2048 + col) + ld4bf(HB + (size_t)lr * 1024 + col);
            float ss = hs[0] * hs[0] + hs[1] * hs[1] + hs[2] * hs[2] + hs[3] * hs[3];
            ss = wsum(ss); const float rstd = rsqrtf(ss * (1.0f / 256.0f) + EPS);
            const f32x4 og = ld4bf(pr + AB_OG + col), w = *(const f32x4*)(mln + col);
            f32x4 o;
#pragma unroll
            for (int r = 0; r < 4; ++r) o[r] = hs[r] * rstd * w[r] * sigmoidf_(og[r]);
            st4bf(AO + (size_t)lr * 2048 + col, o);
            const f32x4 ys = ld4bf(AO + (size_t)lr * 2048 + 1024 + col) + ld4bf(YB + (size_t)lr * 1024 + col), z = ld4bf(pr + AB_Z + col);
#pragma unroll
            for (int r = 0; r < 4; ++r) { yz[i][r] = ys[r] * siluf_(z[r]); ss2 += yz[i][r] * yz[i][r]; }
        }
        ss2 = wsum(ss2); const float rstd2 = rsqrtf(ss2 * (1.0f / 1024.0f) + EPS);
#pragma unroll
        for (int i = 0; i < 4; ++i) { const int col = i * 256 + lane * 4; st4bf(AO + (size_t)lr * 2048 + 1024 + col, yz[i] * rstd2 * *(const f32x4*)(sn + col)); }
    }
}

PHASE_FN void phase_gemm_in(const KP& kp, unsigned char* lds, int layer, int grp) {
    const int npad = layer == 0 ? AB_NPAD : CD_NPAD, n = layer == 0 ? AB_N : CD_N;
    pg8::Gemm g{(layer == 0 && grp == 0) ? WSP(const bf16_t, WS_BIG + L0_U) : WSP(const bf16_t, WS_V) + (size_t)grp * RG * 1024, WSP(const bf16_t, WS_WMIX), RG, npad, 1024, nullptr, 0x7fffffff};
    pg8::StaticOrder S; S.init(RG, npad, (int)gridDim.x, obid());
    pg8::EpiBfG E{WSP(bf16_t, WS_BIG), n, n, 0x7fffffff, 1.0f};
    pg8::gemm_phase<pg8::EpiBfG, pg8::StaticOrder, false>((PG8_LAS unsigned char*)lds, g, S, E, nullptr);
    __syncthreads();
}
PHASE_FN void phase_gemm_out_ab(const KP& kp, unsigned char* lds, int grp) {
    pg8::Gemm g{WSP(const bf16_t, WS_BIG + L0_AO), WSP(const bf16_t, WS_WMIX + WM_AB_OUT), RG, 1024, 2048, nullptr, 0x7fffffff};
    pg8::StaticOrder S; S.init(RG, 1024, (int)gridDim.x, obid());
    pg8::EpiBfG E{WSP(bf16_t, WS_BIG + L0_U), 1024, 1024, 0x7fffffff, 1.0f};
    pg8::gemm_phase<pg8::EpiBfG, pg8::StaticOrder, false>((PG8_LAS unsigned char*)lds, g, S, E, nullptr);
    __syncthreads();
    const int G = (int)gridDim.x, units = (RG / 256) * 4, two = units > G ? (units - G < G ? units - G : G) : 0;
    const int nb = G - two > 0 ? G - two : G, bid = G - two > 0 ? obid() - two : obid();
    if (bid >= 0) { if (grp == 0) phase_u(kp, 0, 1, bid, nb, true); else phase_conv_moe(kp, lds, 0, bid, nb); }
    __syncthreads();
}

PHASE_FN void phase_prep_cd(const KP& kp) {
    const int lane = otid() & 63, wid = __builtin_amdgcn_readfirstlane(otid() >> 6);
    bf16_t* P = WSP(bf16_t, WS_BIG + L1_P);
    bf16_t* SG = WSP(bf16_t, WS_SG);
    const float* qn = KIN(20); const float* kvn = KIN(22); const float* mu = KIN(24);
    for (int lr = obid() * 8 + wid; lr < RG; lr += gridDim.x * 8) {
        const int bl = lr / TT, t = lr - bl * TT;
        bf16_t* pr = P + (size_t)lr * CD_N;
        {
            const f32x4 x = ld4bf(pr + CD_M1 + lane * 4);
            float ss = x[0] * x[0] + x[1] * x[1] + x[2] * x[2] + x[3] * x[3]; ss = wsum(ss);
            const float rstd = rsqrtf(ss * (1.0f / 256.0f) + EPS);
            st4bf(pr + CD_M1 + lane * 4, x * rstd * *(const f32x4*)(kvn + lane * 4));
        }
        {
            const int lo = t < CTXL ? 0 : CTXL, hi = t < CTXL ? CTXL : TT, c = lane * 4;
            const f32x4 x = ld4bf(pr + CD_WL + c);
            const f32x4 xp = t > lo ? ld4bf(pr - CD_N + CD_WL + c) : (f32x4){0.f, 0.f, 0.f, 0.f};
            const f32x4 xn = t < hi - 1 ? ld4bf(pr + CD_N + CD_WL + c) : (f32x4){0.f, 0.f, 0.f, 0.f};
            f32x4 l = x + *(const f32x4*)(mu + CD_WL - CD_RW0 + c) * ((xp + xn) * 0.5f - x);
            if (c < 128) {
#pragma unroll
                for (int q = 0; q < 4; ++q) l[q] = tanhf_(l[q]); }
            st4bf(WSP(bf16_t, WS_BIG + L1_TWAL) + (size_t)lr * 256 + c, l);
        }
        if (t >= CTXL) {
            const int s = t - CTXL;
            float x0[3], x1[3]; float ss = 0.f;
#pragma unroll
            for (int i = 0; i < 3; ++i) { const unsigned w = *(const unsigned*)(pr + CD_M0 + i * 128 + lane * 2); x0[i] = lo2f(w); x1[i] = hi2f(w); ss += x0[i] * x0[i] + x1[i] * x1[i]; }
            ss = wsum(ss); const float rstd = rsqrtf(ss * (1.0f / 384.0f) + EPS);
#pragma unroll
            for (int i = 0; i < 3; ++i) { const int c = i * 128 + lane * 2; *(unsigned*)(pr + CD_M0 + c) = pack2(x0[i] * rstd * qn[c], x1[i] * rstd * qn[c + 1]); }
            if (lane < 16) {
                const float pos = (lane < 8) ? (float)(s >> 6) : (float)(s & 63);
                const float inv = __expf(-(float)(lane & 7) * (9.210340371976184f / 8.0f));
                float sn, cs; sincosf(pos * inv, &sn, &cs);
                const float a = bf2f(pr[CD_KR + lane]), b2 = bf2f(pr[CD_KR + 16 + lane]);
                pr[CD_KR + lane] = f2bf(a * cs - b2 * sn); pr[CD_KR + 16 + lane] = f2bf(a * sn + b2 * cs);
            }
            {
                const int c = lane * 2;
                const unsigned w = *(const unsigned*)(pr + CD_GL + c);
                const unsigned wp = s > 0 ? *(const unsigned*)(pr - CD_N + CD_GL + c) : 0u;
                const unsigned wn = s < SEQ - 1 ? *(const unsigned*)(pr + CD_N + CD_GL + c) : 0u;
                const float m0 = mu[CD_GL - CD_RW0 + c], m1 = mu[CD_GL - CD_RW0 + c + 1];
                const float g0 = lo2f(w) + m0 * (0.5f * (lo2f(wp) + lo2f(wn)) - lo2f(w));
                const float g1 = hi2f(w) + m1 * (0.5f * (hi2f(wp) + hi2f(wn)) - hi2f(w));
                *(unsigned*)(SG + ((size_t)bl * SEQ + s) * 128 + c) = pack2(sigmoidf_(g0), sigmoidf_(g1));
            }
        }
    }
}

PHASE_FN void phase_upproj(const KP& kp, unsigned char* lds) {
    const bf16_t* P = WSP(const bf16_t, WS_BIG + L1_P);
    {
        pg8::Gemm g{P + CD_M0, WSP(const bf16_t, WS_WMIX + WM_UQ), RGL, 768, 384, nullptr, 0x7fffffff, CD_N, 1};
        pg8::StaticOrder S; S.init(RGL, 768, (int)gridDim.x, obid());
        pg8::EpiBfG E{WSP(bf16_t, WS_BIG + L1_Q), 768, 768, 0x7fffffff, 1.0f};
        pg8::gemm_phase<pg8::EpiBfG, pg8::StaticOrder, false>((PG8_LAS unsigned char*)lds, g, S, E, nullptr);
    }
    __syncthreads();
    {
        pg8::Gemm g{P + CD_M1, WSP(const bf16_t, WS_WMIX + WM_UKV), RG, 1024, 256, nullptr, 0x7fffffff, CD_N, 0};
        pg8::StaticOrder S; S.init(RG, 1024, (int)gridDim.x, obid());
        pg8::EpiBfG E{WSP(bf16_t, WS_BIG + L1_KV), 1024, 1024, 0x7fffffff, 1.0f};
        pg8::gemm_phase<pg8::EpiBfG, pg8::StaticOrder, false>((PG8_LAS unsigned char*)lds, g, S, E, nullptr);
    }
    __syncthreads();
}

constexpr int AT_LQ = 104, AT_LV = 72;
PHASE_FN void attn_unit(const KP& kp, unsigned char* lds, int bl, int head, int qb) {
    const int tid = otid(), lane = tid & 63, wid = __builtin_amdgcn_readfirstlane(tid >> 6), fr = lane & 15, fq = lane >> 4;
    bf16_t* Qs = (bf16_t*)lds;
    bf16_t* Kt = Qs + 256 * AT_LQ;
    bf16_t* Vt = Kt + 2 * 64 * AT_LQ;
    const bf16_t* P = WSP(const bf16_t, WS_BIG + L1_P);
    const bf16_t* Q = WSP(const bf16_t, WS_BIG + L1_Q);
    const bf16_t* KV = WSP(const bf16_t, WS_BIG + L1_KV);
    bf16_t* AOUT = WSP(bf16_t, WS_BIG + L1_AOUT);
    const float SC = 0.10206207261596577f;
#pragma unroll
    for (int i = 0; i < 6; ++i) { const int p = tid + i * 512, r = p / 12, c = p % 12;
        *(u32x4*)(Qs + r * AT_LQ + c * 8) = *(const u32x4*)(Q + ((size_t)bl * SEQ + qb * 256 + r) * 768 + head * 96 + c * 8); }
    lds_barrier();
#pragma unroll
    for (int i = 0; i < 8; ++i) { const int p = tid + i * 512, r = p >> 4, f = p & 15, s = qb * 256 + r;
        const float pos = (f < 8) ? (float)(s >> 6) : (float)(s & 63);
        const float inv = __expf(-(float)(f & 7) * (9.210340371976184f / 8.0f));
        float sn, cs; sincosf(pos * inv, &sn, &cs);
        const float a = bf2f(Qs[r * AT_LQ + 64 + f]), b2 = bf2f(Qs[r * AT_LQ + 80 + f]);
        Qs[r * AT_LQ + 64 + f] = f2bf(a * cs - b2 * sn); Qs[r * AT_LQ + 80 + f] = f2bf(a * sn + b2 * cs); }
    lds_barrier();
    bf16x8 qf[2][3];
#pragma unroll
    for (int rt = 0; rt < 2; ++rt)
#pragma unroll
        for (int k = 0; k < 3; ++k) qf[rt][k] = ldfrag(Qs, AT_LQ, wid * 32 + rt * 16, k * 32, fr, fq);
    f32x4 ot[2][4];
#pragma unroll
    for (int rt = 0; rt < 2; ++rt)
#pragma unroll
        for (int i = 0; i < 4; ++i) ot[rt][i] = (f32x4){0.f, 0.f, 0.f, 0.f};
    float mrow[2] = {-1e30f, -1e30f}, lsum[2] = {0.f, 0.f};
    u32x4 pk0[2], pk1[2], pvv[2];
    const int kkey0 = tid / 12, kc0 = tid % 12, kkey1 = (tid + 512) / 12, kc1 = (tid + 512) % 12, vkey = tid & 63, vc8 = tid >> 6;
#define AT_REQ(kt_) do { _Pragma("unroll") for (int h_ = 0; h_ < 2; ++h_) { const size_t rb_ = (size_t)bl * TT + ((kt_) * 2 + h_) * 64; \
        pk0[h_] = kc0 < 8 ? *(const u32x4*)(KV + (rb_ + kkey0) * 1024 + head * 128 + kc0 * 8) : *(const u32x4*)(P + (rb_ + kkey0) * CD_N + CD_KR + (kc0 - 8) * 8); \
        if (tid < 256) pk1[h_] = kc1 < 8 ? *(const u32x4*)(KV + (rb_ + kkey1) * 1024 + head * 128 + kc1 * 8) : *(const u32x4*)(P + (rb_ + kkey1) * CD_N + CD_KR + (kc1 - 8) * 8); \
        pvv[h_] = *(const u32x4*)(KV + (rb_ + vkey) * 1024 + head * 128 + 64 + vc8 * 8); } } while (0)
    AT_REQ(0);
    const float SC2 = SC * 1.4426950408889634f;
    for (int kt = 0; kt < TT / 128; ++kt) {
        lds_barrier();
#pragma unroll
        for (int h_ = 0; h_ < 2; ++h_) {
            *(u32x4*)(Kt + (h_ * 64 + kkey0) * AT_LQ + kc0 * 8) = pk0[h_];
            if (tid < 256) *(u32x4*)(Kt + (h_ * 64 + kkey1) * AT_LQ + kc1 * 8) = pk1[h_];
            { bf16_t* vt = Vt + (h_ * 64 + vc8 * 8) * AT_LV + vkey; const u32x4 v = pvv[h_];
                vt[0 * AT_LV] = (bf16_t)(v.x & 0xffff); vt[1 * AT_LV] = (bf16_t)(v.x >> 16); vt[2 * AT_LV] = (bf16_t)(v.y & 0xffff); vt[3 * AT_LV] = (bf16_t)(v.y >> 16);
                vt[4 * AT_LV] = (bf16_t)(v.z & 0xffff); vt[5 * AT_LV] = (bf16_t)(v.z >> 16); vt[6 * AT_LV] = (bf16_t)(v.w & 0xffff); vt[7 * AT_LV] = (bf16_t)(v.w >> 16); }
        }
        if (kt + 1 < TT / 128) AT_REQ(kt + 1);
        lds_barrier();
#pragma unroll 1
        for (int hs = 0; hs < 2; ++hs) {
        const bf16_t* Kth = Kt + hs * 64 * AT_LQ; const bf16_t* Vth = Vt + hs * 64 * AT_LV;
        bf16x8 kf[3][4];
#pragma unroll
        for (int k = 0; k < 3; ++k)
#pragma unroll
            for (int kk = 0; kk < 4; ++kk) kf[k][kk] = ldfrag(Kth, AT_LQ, kk * 16, k * 32, fr, fq);
        u32x2 vlo[2][4], vhi[2][4];
#pragma unroll
        for (int k2 = 0; k2 < 2; ++k2)
#pragma unroll
            for (int dvt = 0; dvt < 4; ++dvt) { const bf16_t* vp = Vth + (dvt * 16 + fr) * AT_LV + k2 * 32 + fq * 4; vlo[k2][dvt] = *(const u32x2*)vp; vhi[k2][dvt] = *(const u32x2*)(vp + 16); }
        __builtin_amdgcn_sched_barrier(0);
        f32x4 st[2][4];
#pragma unroll
        for (int rt = 0; rt < 2; ++rt)
#pragma unroll
            for (int kk = 0; kk < 4; ++kk) st[rt][kk] = (f32x4){0.f, 0.f, 0.f, 0.f};
#pragma unroll
        for (int k = 0; k < 3; ++k)
#pragma unroll
            for (int kk = 0; kk < 4; ++kk)
#pragma unroll
                for (int rt = 0; rt < 2; ++rt) st[rt][kk] = mma16(kf[k][kk], qf[rt][k], st[rt][kk]);
        union { bf16x8 v; unsigned u[4]; } pb[2][2];
#pragma unroll
        for (int rt = 0; rt < 2; ++rt) {
            float mx = -1e30f;
#pragma unroll
            for (int kk = 0; kk < 4; ++kk) mx = fmaxf(mx, fmaxf(fmaxf(st[rt][kk][0], st[rt][kk][1]), fmaxf(st[rt][kk][2], st[rt][kk][3])));
            mx = fmaxf(mx, __shfl_xor(mx, 16)); mx = fmaxf(mx, __shfl_xor(mx, 32));
            const float mnew = fmaxf(mrow[rt], mx), mb = mnew * SC2;
            if (__builtin_amdgcn_ballot_w64(mnew > mrow[rt]) != 0ull) {
                const float alpha = __builtin_amdgcn_exp2f((mrow[rt] - mnew) * SC2);
                lsum[rt] *= alpha;
#pragma unroll
                for (int i = 0; i < 4; ++i) ot[rt][i] = ot[rt][i] * alpha;
            }
            mrow[rt] = mnew;
#pragma unroll
            for (int kk = 0; kk < 4; ++kk)
#pragma unroll
                for (int r = 0; r < 4; ++r) { const float pv = __builtin_amdgcn_exp2f(st[rt][kk][r] * SC2 - mb); st[rt][kk][r] = pv; lsum[rt] += pv; }
#pragma unroll
            for (int k2 = 0; k2 < 2; ++k2) {
                pb[rt][k2].u[0] = pack2(st[rt][2 * k2][0], st[rt][2 * k2][1]); pb[rt][k2].u[1] = pack2(st[rt][2 * k2][2], st[rt][2 * k2][3]);
                pb[rt][k2].u[2] = pack2(st[rt][2 * k2 + 1][0], st[rt][2 * k2 + 1][1]); pb[rt][k2].u[3] = pack2(st[rt][2 * k2 + 1][2], st[rt][2 * k2 + 1][3]); }
        }
#pragma unroll
        for (int k2 = 0; k2 < 2; ++k2)
#pragma unroll
            for (int dvt = 0; dvt < 4; ++dvt) { union { bf16x8 v; u32x2 h[2]; } va; va.h[0] = vlo[k2][dvt]; va.h[1] = vhi[k2][dvt];
#pragma unroll
                for (int rt = 0; rt < 2; ++rt) ot[rt][dvt] = mma16(va.v, pb[rt][k2].v, ot[rt][dvt]); }
        }
    }
#undef AT_REQ
#pragma unroll
    for (int rt = 0; rt < 2; ++rt) {
        float ls = lsum[rt]; ls += __shfl_xor(ls, 16); ls += __shfl_xor(ls, 32);
        const float rl = frcp_(ls);
        const size_t orow = (size_t)bl * SEQ + qb * 256 + wid * 32 + rt * 16 + fr;
#pragma unroll
        for (int dvt = 0; dvt < 4; ++dvt) st4bf(AOUT + orow * 1536 + head * 64 + dvt * 16 + fq * 4, ot[rt][dvt] * rl);
    }
}

constexpr int RW_LR = 200, RW_LP = 72;
struct TrueT { static constexpr bool value = true; }; struct FalseT { static constexpr bool value = false; };
PHASE_FN void rwkv_unit(const KP& kp, unsigned char* lds, int bl, int h, int dir) {
    const int tid = otid();
    constexpr int NC = TT / 32;
    bf16_t* RAW = (bf16_t*)lds;
    bf16_t* TWb = RAW + 34 * RW_LR;
    bf16_t* ALb = TWb + 32 * RW_LP;
    float* WLf = (float*)(ALb + 32 * RW_LP);
    float* ALf = WLf + 32 * 64;
    bf16_t* BK = (bf16_t*)WLf;
    float* WT = ALf + 32 * 64;
    bf16_t* AR = (bf16_t*)(WT + 8 * 64);
    float* AABT = (float*)(AR + 64 * RW_LP);
    bf16_t* ARB0 = (bf16_t*)(AABT + 32 * 36);
    bf16_t* AAK = ARB0 + 2 * 32 * 40;
    bf16_t* ARK = AAK + 32 * 40;
    float* RHS = (float*)(ARK + 32 * 40);
    float* YB = RHS + 32 * 64;
    bf16_t* ZVT0 = (bf16_t*)(YB + 32 * 64);
    bf16_t* BKh0 = ZVT0 + 2 * 64 * RW_LP;
    bf16_t* Sb = BKh0 + 2 * 64 * RW_LP;
    float* PL0 = (float*)(Sb + 64 * RW_LP);
    float* CV = PL0 + 2 * 64;
    bf16_t* A21b = (bf16_t*)(CV + 8 * 64);
    bf16_t* TI = A21b + 16 * 40;
    bf16_t* RHSb = TI + 2 * 16 * 40;
    bf16_t* XB = RHSb + 64 * 40;
    static_assert((34 * RW_LR + 2 * 32 * RW_LP) * 2 + (2 * 32 * 64 + 8 * 64) * 4 + 64 * RW_LP * 2 + 32 * 36 * 4 + 4 * 32 * 40 * 2 + 2 * 32 * 64 * 4
                  + 5 * 64 * RW_LP * 2 + (2 * 64 + 8 * 64) * 4 + (16 * 40 + 2 * 16 * 40 + 2 * 64 * 40) * 2 <= LDS_BYTES - 16, "rwkv LDS");
    const bf16_t* P = WSP(const bf16_t, WS_BIG + L1_P); const bf16_t* TWAL = WSP(const bf16_t, WS_BIG + L1_TWAL);
    bf16_t* OUT = WSP(bf16_t, WS_BIG + (dir ? L1_OB : L1_OF));
    float* BSC = WSP(float, WS_BSC) + (size_t)dir * RGL * 16;
    const float* mu = KIN(24);
    bf16x8 wfr[2][2];
    {
        const int wv = tid >> 6, fr0 = tid & 15, fq0 = (tid & 63) >> 4; const float* wsrc = (wv >> 2) ? KIN(28) : KIN(26);
#pragma unroll
        for (int q2 = 0; q2 < 2; ++q2)
#pragma unroll
            for (int k = 0; k < 2; ++k) { const int n = ((wv & 1) * 2 + q2) * 16 + fr0; union { bf16x8 v; unsigned u[4]; } tw;
#pragma unroll
                for (int e = 0; e < 4; ++e) { const int c0 = k * 32 + fq0 * 8 + 2 * e;
                    tw.u[e] = pack2(wsrc[((size_t)dir * 64 + c0) * 1024 + h * 64 + n], wsrc[((size_t)dir * 64 + c0 + 1) * 1024 + h * 64 + n]); }
                wfr[q2][k] = tw.v; }
    }
    for (int i = tid; i < 2 * 16 * 40; i += 512) TI[i] = 0;
    for (int i = tid; i < 64 * 40; i += 512) XB[i] = 0;
    for (int i = tid; i < 64 * RW_LP; i += 512) Sb[i] = 0;
    for (int i = tid; i < 16 * 40; i += 512) A21b[i] = 0;
    for (int i = tid; i < 2 * 64 * RW_LP; i += 512) ZVT0[i] = 0;
    if (tid < 64) { const int n = tid;
        CV[0 * 64 + n] = KIN(25)[dir * 1024 + h * 64 + n]; CV[1 * 64 + n] = KIN(27)[dir * 1024 + h * 64 + n];
        CV[2 * 64 + n] = KIN(30)[h * 64 + n]; CV[3 * 64 + n] = KIN(31)[h * 64 + n]; CV[4 * 64 + n] = KIN(32)[h * 64 + n];
        CV[5 * 64 + n] = mu[h * 64 + n]; CV[6 * 64 + n] = mu[1024 + h * 64 + n]; CV[7 * 64 + n] = mu[2048 + h * 64 + n]; }
    f32x4 Sacc[2];
    Sacc[0] = (f32x4){0.f, 0.f, 0.f, 0.f}; Sacc[1] = (f32x4){0.f, 0.f, 0.f, 0.f};
    u32x4 pf[3];
#define RW_PREFETCH(cn, tix) do { const int t0n_ = dir ? scan_t<32>(1, (cn), 31) : (cn) * 32; const int lo_ = t0n_ < CTXL ? 0 : CTXL, hi_ = t0n_ < CTXL ? CTXL : TT; \
        _Pragma("unroll") for (int q = 0; q < 2; ++q) { const int p = (tix) + q * 512; pf[q] = (u32x4){0u, 0u, 0u, 0u}; \
            if (p < 34 * 24) { const int rr = p / 24, c = p % 24, t = t0n_ - 1 + rr; \
                if (t >= lo_ && t < hi_) { const int seg = c >> 3, c8 = c & 7; \
                    const int col = (seg == 0 ? CD_R : seg == 1 ? CD_K : CD_V) + h * 64; \
                    pf[q] = *(const u32x4*)(P + ((size_t)bl * TT + t) * CD_N + col + c8 * 8); } } } \
        { const int i_ = (tix) >> 4, c16 = (tix) & 15; \
          pf[2] = *(const u32x4*)(TWAL + ((size_t)bl * TT + t0n_ + i_) * 256 + (c16 >> 3) * 128 + dir * 64 + (c16 & 7) * 8); } } while (0)
    RW_PREFETCH(0, tid);
    lds_barrier();
    auto step = [&](auto doP_t, auto doD_t, const int ci) __attribute__((always_inline)) {
        constexpr bool doP = decltype(doP_t)::value, doD = decltype(doD_t)::value;
        int tq = tid; asm volatile("" : "+v"(tq));
        const int lane = tq & 63, wid = __builtin_amdgcn_readfirstlane(tq >> 6), fr = lane & 15, fq = lane >> 4, pi = tq >> 4, n4 = (tq & 15) * 4;
        const int cp = ci + 1, pc = ci & 1, pn = cp & 1;
        const int t0 = dir ? scan_t<32>(1, ci, 31) : ci * 32, t0p = dir ? scan_t<32>(1, cp, 31) : cp * 32;
        bf16_t* ZVc = ZVT0 + pc * 64 * RW_LP; bf16_t* ZVn = ZVT0 + pn * 64 * RW_LP;
        const bf16_t* BKhc = BKh0 + pc * 64 * RW_LP; bf16_t* BKhn = BKh0 + pn * 64 * RW_LP;
        const bf16_t* ARBc = ARB0 + pc * 32 * 40; bf16_t* ARBn = ARB0 + pn * 32 * 40;
        const float* PLc = PL0 + pc * 64; float* PLn = PL0 + pn * 64;
        if constexpr (doP) {
#pragma unroll
            for (int q = 0; q < 2; ++q) { const int p = tq + q * 512; if (p < 34 * 24) *(u32x4*)(RAW + (p / 24) * RW_LR + (p % 24) * 8) = pf[q]; }
            { const int i_ = tq >> 4, c16 = tq & 15; *(u32x4*)(((c16 >> 3) ? ALb : TWb) + i_ * RW_LP + (c16 & 7) * 8) = pf[2]; }
        }
        if constexpr (doD) {
            if (wid > 0) for (int rep_ = 0; rep_ < ((RWP & 32) ? 2 : 1); ++rep_) {
#pragma unroll
                for (int q3 = 0; q3 < 3; ++q3) { const int tl = (wid - 1) + 7 * q3;
                    if (tl < 16) {
                        const int which = tl >> 3, tt = (tl >> 2) & 1, vt = tl & 3;
                        const bf16_t* Ak = which ? ARK : AAK; float* Od = which ? YB : RHS;
                        f32x4 acc = (f32x4){0.f, 0.f, 0.f, 0.f};
#pragma unroll
                        for (int k = 0; k < 2; ++k) acc = mma16(ldfrag(AR, RW_LP, which * 32 + tt * 16, k * 32, fr, fq), ldfrag(Sb, RW_LP, vt * 16, k * 32, fr, fq), acc);
                        acc = mma16(ldfrag(Ak, 40, tt * 16, 0, fr, fq), ldfrag(ZVc, RW_LP, vt * 16, 32, fr, fq), acc);
#pragma unroll
                        for (int rr = 0; rr < 4; ++rr) Od[(tt * 16 + fq * 4 + rr) * 64 + vt * 16 + fr] = acc[rr];
                        if (!which) st4bf(RHSb + (vt * 16 + fr) * 40 + tt * 16 + fq * 4, acc);
                    } }
            } else for (int rep_ = 0; rep_ < ((RWP & 1) ? 2 : 1); ++rep_) {
                const float* AB = AABT + ((lane >> 4) & 1) * (16 * 36 + 16);
                float z[16]; f32x4 ca0, ca1, ca2, ca3, cb0, cb1, cb2, cb3;
#pragma unroll
                for (int t = 0; t < 16; ++t) z[t] = (t == (lane & 15)) ? 1.0f : 0.f;
                ca0 = *(const f32x4*)(AB + 0 * 36 + 0); ca1 = *(const f32x4*)(AB + 0 * 36 + 4); ca2 = *(const f32x4*)(AB + 0 * 36 + 8); ca3 = *(const f32x4*)(AB + 0 * 36 + 12);
                cb0 = *(const f32x4*)(AB + 1 * 36 + 0); cb1 = *(const f32x4*)(AB + 1 * 36 + 4); cb2 = *(const f32x4*)(AB + 1 * 36 + 8); cb3 = *(const f32x4*)(AB + 1 * 36 + 12);
                { const float zs = z[0]; z[1] = __builtin_fmaf(ca0[1], zs, z[1]); z[2] = __builtin_fmaf(ca0[2], zs, z[2]); z[3] = __builtin_fmaf(ca0[3], zs, z[3]); z[4] = __builtin_fmaf(ca1[0], zs, z[4]); z[5] = __builtin_fmaf(ca1[1], zs, z[5]); z[6] = __builtin_fmaf(ca1[2], zs, z[6]); z[7] = __builtin_fmaf(ca1[3], zs, z[7]); z[8] = __builtin_fmaf(ca2[0], zs, z[8]); z[9] = __builtin_fmaf(ca2[1], zs, z[9]); z[10] = __builtin_fmaf(ca2[2], zs, z[10]); z[11] = __builtin_fmaf(ca2[3], zs, z[11]); z[12] = __builtin_fmaf(ca3[0], zs, z[12]); z[13] = __builtin_fmaf(ca3[1], zs, z[13]); z[14] = __builtin_fmaf(ca3[2], zs, z[14]); z[15] = __builtin_fmaf(ca3[3], zs, z[15]); }
                asm volatile("" : "+v"(z[1]) :: "memory");
                ca0 = *(const f32x4*)(AB + 2 * 36 + 0); ca1 = *(const f32x4*)(AB + 2 * 36 + 4); ca2 = *(const f32x4*)(AB + 2 * 36 + 8); ca3 = *(const f32x4*)(AB + 2 * 36 + 12);
                { const float zs = z[1]; z[2] = __builtin_fmaf(cb0[2], zs, z[2]); z[3] = __builtin_fmaf(cb0[3], zs, z[3]); z[4] = __builtin_fmaf(cb1[0], zs, z[4]); z[5] = __builtin_fmaf(cb1[1], zs, z[5]); z[6] = __builtin_fmaf(cb1[2], zs, z[6]); z[7] = __builtin_fmaf(cb1[3], zs, z[7]); z[8] = __builtin_fmaf(cb2[0], zs, z[8]); z[9] = __builtin_fmaf(cb2[1], zs, z[9]); z[10] = __builtin_fmaf(cb2[2], zs, z[10]); z[11] = __builtin_fmaf(cb2[3], zs, z[11]); z[12] = __builtin_fmaf(cb3[0], zs, z[12]); z[13] = __builtin_fmaf(cb3[1], zs, z[13]); z[14] = __builtin_fmaf(cb3[2], zs, z[14]); z[15] = __builtin_fmaf(cb3[3], zs, z[15]); }
                asm volatile("" : "+v"(z[2]) :: "memory");
                cb1 = *(const f32x4*)(AB + 3 * 36 + 4); cb2 = *(const f32x4*)(AB + 3 * 36 + 8); cb3 = *(const f32x4*)(AB + 3 * 36 + 12);
                { const float zs = z[2]; z[3] = __builtin_fmaf(ca0[3], zs, z[3]); z[4] = __builtin_fmaf(ca1[0], zs, z[4]); z[5] = __builtin_fmaf(ca1[1], zs, z[5]); z[6] = __builtin_fmaf(ca1[2], zs, z[6]); z[7] = __builtin_fmaf(ca1[3], zs, z[7]); z[8] = __builtin_fmaf(ca2[0], zs, z[8]); z[9] = __builtin_fmaf(ca2[1], zs, z[9]); z[10] = __builtin_fmaf(ca2[2], zs, z[10]); z[11] = __builtin_fmaf(ca2[3], zs, z[11]); z[12] = __builtin_fmaf(ca3[0], zs, z[12]); z[13] = __builtin_fmaf(ca3[1], zs, z[13]); z[14] = __builtin_fmaf(ca3[2], zs, z[14]); z[15] = __builtin_fmaf(ca3[3], zs, z[15]); }
                asm volatile("" : "+v"(z[3]) :: "memory");
                ca1 = *(const f32x4*)(AB + 4 * 36 + 4); ca2 = *(const f32x4*)(AB + 4 * 36 + 8); ca3 = *(const f32x4*)(AB + 4 * 36 + 12);
                { const float zs = z[3]; z[4] = __builtin_fmaf(cb1[0], zs, z[4]); z[5] = __builtin_fmaf(cb1[1], zs, z[5]); z[6] = __builtin_fmaf(cb1[2], zs, z[6]); z[7] = __builtin_fmaf(cb1[3], zs, z[7]); z[8] = __builtin_fmaf(cb2[0], zs, z[8]); z[9] = __builtin_fmaf(cb2[1], zs, z[9]); z[10] = __builtin_fmaf(cb2[2], zs, z[10]); z[11] = __builtin_fmaf(cb2[3], zs, z[11]); z[12] = __builtin_fmaf(cb3[0], zs, z[12]); z[13] = __builtin_fmaf(cb3[1], zs, z[13]); z[14] = __builtin_fmaf(cb3[2], zs, z[14]); z[15] = __builtin_fmaf(cb3[3], zs, z[15]); }
                asm volatile("" : "+v"(z[4]) :: "memory");
                cb1 = *(const f32x4*)(AB + 5 * 36 + 4); cb2 = *(const f32x4*)(AB + 5 * 36 + 8); cb3 = *(const f32x4*)(AB + 5 * 36 + 12);
                { const float zs = z[4]; z[5] = __builtin_fmaf(ca1[1], zs, z[5]); z[6] = __builtin_fmaf(ca1[2], zs, z[6]); z[7] = __builtin_fmaf(ca1[3], zs, z[7]); z[8] = __builtin_fmaf(ca2[0], zs, z[8]); z[9] = __builtin_fmaf(ca2[1], zs, z[9]); z[10] = __builtin_fmaf(ca2[2], zs, z[10]); z[11] = __builtin_fmaf(ca2[3], zs, z[11]); z[12] = __builtin_fmaf(ca3[0], zs, z[12]); z[13] = __builtin_fmaf(ca3[1], zs, z[13]); z[14] = __builtin_fmaf(ca3[2], zs, z[14]); z[15] = __builtin_fmaf(ca3[3], zs, z[15]); }
                asm volatile("" : "+v"(z[5]) :: "memory");
                ca1 = *(const f32x4*)(AB + 6 * 36 + 4); ca2 = *(const f32x4*)(AB + 6 * 36 + 8); ca3 = *(const f32x4*)(AB + 6 * 36 + 12);
                { const float zs = z[5]; z[6] = __builtin_fmaf(cb1[2], zs, z[6]); z[7] = __builtin_fmaf(cb1[3], zs, z[7]); z[8] = __builtin_fmaf(cb2[0], zs, z[8]); z[9] = __builtin_fmaf(cb2[1], zs, z[9]); z[10] = __builtin_fmaf(cb2[2], zs, z[10]); z[11] = __builtin_fmaf(cb2[3], zs, z[11]); z[12] = __builtin_fmaf(cb3[0], zs, z[12]); z[13] = __builtin_fmaf(cb3[1], zs, z[13]); z[14] = __builtin_fmaf(cb3[2], zs, z[14]); z[15] = __builtin_fmaf(cb3[3], zs, z[15]); }
                asm volatile("" : "+v"(z[6]) :: "memory");
                cb2 = *(const f32x4*)(AB + 7 * 36 + 8); cb3 = *(const f32x4*)(AB + 7 * 36 + 12);
                { const float zs = z[6]; z[7] = __builtin_fmaf(ca1[3], zs, z[7]); z[8] = __builtin_fmaf(ca2[0], zs, z[8]); z[9] = __builtin_fmaf(ca2[1], zs, z[9]); z[10] = __builtin_fmaf(ca2[2], zs, z[10]); z[11] = __builtin_fmaf(ca2[3], zs, z[11]); z[12] = __builtin_fmaf(ca3[0], zs, z[12]); z[13] = __builtin_fmaf(ca3[1], zs, z[13]); z[14] = __builtin_fmaf(ca3[2], zs, z[14]); z[15] = __builtin_fmaf(ca3[3], zs, z[15]); }
                asm volatile("" : "+v"(z[7]) :: "memory");
                ca2 = *(const f32x4*)(AB + 8 * 36 + 8); ca3 = *(const f32x4*)(AB + 8 * 36 + 12);
                { const float zs = z[7]; z[8] = __builtin_fmaf(cb2[0], zs, z[8]); z[9] = __builtin_fmaf(cb2[1], zs, z[9]); z[10] = __builtin_fmaf(cb2[2], zs, z[10]); z[11] = __builtin_fmaf(cb2[3], zs, z[11]); z[12] = __builtin_fmaf(cb3[0], zs, z[12]); z[13] = __builtin_fmaf(cb3[1], zs, z[13]); z[14] = __builtin_fmaf(cb3[2], zs, z[14]); z[15] = __builtin_fmaf(cb3[3], zs, z[15]); }
                asm volatile("" : "+v"(z[8]) :: "memory");
                cb2 = *(const f32x4*)(AB + 9 * 36 + 8); cb3 = *(const f32x4*)(AB + 9 * 36 + 12);
                { const float zs = z[8]; z[9] = __builtin_fmaf(ca2[1], zs, z[9]); z[10] = __builtin_fmaf(ca2[2], zs, z[10]); z[11] = __builtin_fmaf(ca2[3], zs, z[11]); z[12] = __builtin_fmaf(ca3[0], zs, z[12]); z[13] = __builtin_fmaf(ca3[1], zs, z[13]); z[14] = __builtin_fmaf(ca3[2], zs, z[14]); z[15] = __builtin_fmaf(ca3[3], zs, z[15]); }
                asm volatile("" : "+v"(z[9]) :: "memory");
                ca2 = *(const f32x4*)(AB + 10 * 36 + 8); ca3 = *(const f32x4*)(AB + 10 * 36 + 12);
                { const float zs = z[9]; z[10] = __builtin_fmaf(cb2[2], zs, z[10]); z[11] = __builtin_fmaf(cb2[3], zs, z[11]); z[12] = __builtin_fmaf(cb3[0], zs, z[12]); z[13] = __builtin_fmaf(cb3[1], zs, z[13]); z[14] = __builtin_fmaf(cb3[2], zs, z[14]); z[15] = __builtin_fmaf(cb3[3], zs, z[15]); }
                asm volatile("" : "+v"(z[10]) :: "memory");
                cb3 = *(const f32x4*)(AB + 11 * 36 + 12);
                { const float zs = z[10]; z[11] = __builtin_fmaf(ca2[3], zs, z[11]); z[12] = __builtin_fmaf(ca3[0], zs, z[12]); z[13] = __builtin_fmaf(ca3[1], zs, z[13]); z[14] = __builtin_fmaf(ca3[2], zs, z[14]); z[15] = __builtin_fmaf(ca3[3], zs, z[15]); }
                asm volatile("" : "+v"(z[11]) :: "memory");
                ca3 = *(const f32x4*)(AB + 12 * 36 + 12);
                { const float zs = z[11]; z[12] = __builtin_fmaf(cb3[0], zs, z[12]); z[13] = __builtin_fmaf(cb3[1], zs, z[13]); z[14] = __builtin_fmaf(cb3[2], zs, z[14]); z[15] = __builtin_fmaf(cb3[3], zs, z[15]); }
                asm volatile("" : "+v"(z[12]) :: "memory");
                cb3 = *(const f32x4*)(AB + 13 * 36 + 12);
                { const float zs = z[12]; z[13] = __builtin_fmaf(ca3[1], zs, z[13]); z[14] = __builtin_fmaf(ca3[2], zs, z[14]); z[15] = __builtin_fmaf(ca3[3], zs, z[15]); }
                asm volatile("" : "+v"(z[13]) :: "memory");
                ca3 = *(const f32x4*)(AB + 14 * 36 + 12);
                { const float zs = z[13]; z[14] = __builtin_fmaf(cb3[2], zs, z[14]); z[15] = __builtin_fmaf(cb3[3], zs, z[15]); }
                asm volatile("" : "+v"(z[14]) :: "memory");
                { const float zs = z[14]; z[15] = __builtin_fmaf(ca3[3], zs, z[15]); }
                asm volatile("" : "+v"(z[15]) :: "memory");
                if (lane < 32) {
#pragma unroll
                    for (int t = 0; t < 16; ++t) TI[(lane >> 4) * 16 * 40 + t * 40 + (lane & 15)] = f2bf(z[t]);
                }
            }
        }
        if constexpr (doP) { if (cp + 1 < NC) RW_PREFETCH(cp + 1, tq); }
        lds_barrier();
        if constexpr (doD) if (wid < 4) {
            f32x4 acc = (f32x4){0.f, 0.f, 0.f, 0.f};
            acc = mma16(ldfrag(TI, 40, 0, 0, fr, fq), ldfrag(RHSb, 40, wid * 16, 0, fr, fq), acc);
            st4bf(ZVc + (wid * 16 + fr) * RW_LP + fq * 4, acc);
        }
        if constexpr (doP) for (int rep_ = 0; rep_ < ((RWP & 64) ? 2 : 1); ++rep_) {
            const int which = wid >> 2, tt = (wid >> 1) & 1;
            const bf16_t* Xa = which ? ALb : TWb; float* Od = which ? ALf : WLf;
#pragma unroll
            for (int q2 = 0; q2 < 2; ++q2) { const int nt = (wid & 1) * 2 + q2;
                f32x4 acc = (f32x4){0.f, 0.f, 0.f, 0.f};
#pragma unroll
                for (int k = 0; k < 2; ++k) acc = mma16(ldfrag(Xa, RW_LP, tt * 16, k * 32, fr, fq), wfr[q2][k], acc);
#pragma unroll
                for (int rr = 0; rr < 4; ++rr) Od[(tt * 16 + fq * 4 + rr) * 64 + nt * 16 + fr] = acc[rr]; }
            const int pp = tq & 31, cg = tq >> 5, jj = dir ? 31 - pp : pp;
            const bf16_t* r1v = RAW + (pp + 1) * RW_LR + 128 + cg * 4;
            const f32x4 muv = *(const f32x4*)(CV + 448 + cg * 4);
            f32x4 v = ld4bf(r1v);
            v = v + muv * ((ld4bf(r1v - RW_LR) + ld4bf(r1v + RW_LR)) * 0.5f - v);
#pragma unroll
            for (int q = 0; q < 4; ++q) ZVn[(cg * 4 + q) * RW_LP + 32 + jj] = f2bf(v[q]);
        }
        lds_barrier();
        if (RWP & 16) { lds_barrier(); lds_barrier(); lds_barrier(); lds_barrier(); lds_barrier(); }
        const int j = dir ? 31 - pi : pi;
        f32x4 r, kd, av, bv, lw, cin;
        f32x4 xacc = (f32x4){0.f, 0.f, 0.f, 0.f};
        if constexpr (doD) {
            xacc = mma16(ldfrag(A21b, 40, 0, 0, fr, fq), ldfrag(ZVc, RW_LP, (wid & 3) * 16, 0, fr, fq), xacc);
#pragma unroll
            for (int rr = 0; rr < 4; ++rr) xacc[rr] += RHS[(16 + fq * 4 + rr) * 64 + (wid & 3) * 16 + fr];
        }
        if constexpr (doP) for (int rep_ = 0; rep_ < ((RWP & 2) ? 2 : 1); ++rep_) {
            const f32x4 w0v = *(const f32x4*)(CV + n4), a0v = *(const f32x4*)(CV + 64 + n4), kkw = *(const f32x4*)(CV + 128 + n4), kaw = *(const f32x4*)(CV + 192 + n4), rkw = *(const f32x4*)(CV + 256 + n4);
            const f32x4 mur = *(const f32x4*)(CV + 320 + n4), muk = *(const f32x4*)(CV + 384 + n4);
            const f32x4 wl = w0v + *(const f32x4*)(WLf + pi * 64 + n4), al = a0v + *(const f32x4*)(ALf + pi * 64 + n4);
            const bf16_t* r1 = RAW + (pi + 1) * RW_LR; const bf16_t* rp = RAW + pi * RW_LR; const bf16_t* rn = RAW + (pi + 2) * RW_LR;
            f32x4 k;
            r = ld4bf(r1 + n4); k = ld4bf(r1 + 64 + n4);
            r = r + mur * ((ld4bf(rp + n4) + ld4bf(rn + n4)) * 0.5f - r);
            k = k + muk * ((ld4bf(rp + 64 + n4) + ld4bf(rn + 64 + n4)) * 0.5f - k);
            f32x4 a, kk = k * kkw;
            float ssq = kk[0] * kk[0] + kk[1] * kk[1] + kk[2] * kk[2] + kk[3] * kk[3];
            ssq = rsum16(ssq);
            kk = kk * __builtin_amdgcn_rsqf(fmaxf(ssq, 1e-24f));
#pragma unroll
            for (int q = 0; q < 4; ++q) { lw[q] = -0.6065306597126334f * sigmoidf_(wl[q]); a[q] = sigmoidf_(al[q]); }
            kd = k * ((a - 1.0f) * kaw + 1.0f);
            float bs = r[0] * kd[0] * rkw[0] + r[1] * kd[1] * rkw[1] + r[2] * kd[2] * rkw[2] + r[3] * kd[3] * rkw[3];
            bs = rsum16(bs);
            av = kk * -1.0f; bv = kk * a;
            f32x4 wt;
#pragma unroll
            for (int q = 0; q < 4; ++q) {
                const float lwq = lw[q];
                const auto e16 = __builtin_amdgcn_permlane16_swap(__builtin_bit_cast(unsigned, lwq), __builtin_bit_cast(unsigned, lwq), false, false);
                const unsigned e16a = e16[0], e16b = e16[1];
                const float y = __builtin_bit_cast(float, e16a) + __builtin_bit_cast(float, e16b);
                const auto e32 = __builtin_amdgcn_permlane32_swap(__builtin_bit_cast(unsigned, y), __builtin_bit_cast(unsigned, y), false, false);
                const unsigned e32a = e32[0], e32b = e32[1];
                wt[q] = __builtin_bit_cast(float, e32a) + __builtin_bit_cast(float, e32b);
                cin[q] = ((fq & 1) ? y : lwq) + ((fq & 2) ? (wt[q] - y) : 0.f);
            }
            if (fq == 0) *(f32x4*)(WT + wid * 64 + n4) = wt;
            const int t = t0p + pi;
            if (t >= CTXL && (tq & 15) == 0) BSC[((size_t)bl * SEQ + (t - CTXL)) * 16 + h] = bs;
        }
        if constexpr (doD) if (wid < 4) st4bf(XB + (wid * 16 + fr) * 40 + fq * 4, xacc);
        lds_barrier();
        if constexpr (doD) if (wid < 4) {
            f32x4 acc = (f32x4){0.f, 0.f, 0.f, 0.f};
            acc = mma16(ldfrag(TI + 16 * 40, 40, 0, 0, fr, fq), ldfrag(XB, 40, wid * 16, 0, fr, fq), acc);
            st4bf(ZVc + (wid * 16 + fr) * RW_LP + 16 + fq * 4, acc);
        }
        if constexpr (doP) for (int rep_ = 0; rep_ < ((RWP & 4) ? 2 : 1); ++rep_) {
            f32x4 pre = (f32x4){0.f, 0.f, 0.f, 0.f}, cle = (f32x4){0.f, 0.f, 0.f, 0.f};
#pragma unroll
            for (int w = 0; w < 8; ++w) { const f32x4 t4 = *(const f32x4*)(WT + w * 64 + n4); cle = cle + t4; if (w < wid) pre = pre + t4; }
            const f32x4 cim = cin + pre;
            const f32x4 clj = dir ? cle - cim + lw : cim;
            const f32x4 clp = dir ? cle - cim : cim - lw;
            f32x4 at, rt, bt, kt, bh, kh;
#pragma unroll
            for (int q = 0; q < 4; ++q) { const float ep = __expf(clp[q]), ej = __expf(clj[q]), ei = __expf(-clj[q]), ee = __expf(cle[q] - clj[q]);
                at[q] = av[q] * ep; rt[q] = r[q] * ej; bt[q] = bv[q] * ei; kt[q] = kd[q] * ei; bh[q] = bv[q] * ee; kh[q] = kd[q] * ee; }
            if (tq < 16) { f32x4 e;
#pragma unroll
                for (int q = 0; q < 4; ++q) e[q] = __expf(cle[q]);
                *(f32x4*)(PLn + n4) = e; }
            st4bf(AR + j * RW_LP + n4, at); st4bf(AR + (32 + j) * RW_LP + n4, rt);
            st4bf(BK + j * RW_LP + n4, bt); st4bf(BK + (32 + j) * RW_LP + n4, kt);
            const int cbh = (((j >> 3) ^ (tq & 7)) << 3) | (j & 7), ckh = ((((j >> 3) + 4) ^ (tq & 7)) << 3) | (j & 7);
#pragma unroll
            for (int q = 0; q < 4; ++q) { BKhn[(n4 + q) * RW_LP + cbh] = f2bf(bh[q]); BKhn[(n4 + q) * RW_LP + ckh] = f2bf(kh[q]); }
        }
        lds_barrier();
        if constexpr (doD) {
            const int nt = wid >> 1;
            const f32x4 pl = *(const f32x4*)(PLc + nt * 16 + fq * 4);
#pragma unroll
            for (int q2 = 0; q2 < 2; ++q2) {
                const int vt = (wid & 1) * 2 + q2;
                Sacc[q2] = Sacc[q2] * pl;
#pragma unroll
                for (int k = 0; k < 2; ++k) Sacc[q2] = mma16(*(const bf16x8*)(BKhc + (nt * 16 + fr) * RW_LP + (((k * 4 + fq) ^ (((nt & 1) << 2) + (fr >> 2))) << 3)), ldfrag(ZVc, RW_LP, vt * 16, k * 32, fr, fq), Sacc[q2]);
                st4bf(Sb + (vt * 16 + fr) * RW_LP + nt * 16 + fq * 4, Sacc[q2]);
            }
            if (t0 >= CTXL) {
                const int vt = wid >> 1, tt = wid & 1;
                f32x4 acc = (f32x4){0.f, 0.f, 0.f, 0.f};
                acc = mma16(ldfrag(ZVc, RW_LP, vt * 16, 0, fr, fq), ldfrag(ARBc, 40, tt * 16, 0, fr, fq), acc);
                const int t = tt * 16 + fr, v0 = vt * 16 + fq * 4;
#pragma unroll
                for (int rr = 0; rr < 4; ++rr) acc[rr] += YB[t * 64 + v0 + rr];
                const int tn = scan_t<32>(dir, ci, t);
                st4bf(OUT + ((size_t)bl * SEQ + (tn - CTXL)) * 1024 + h * 64 + v0, acc);
            }
        }
        if constexpr (doP) for (int rep_ = 0; rep_ < ((RWP & 8) ? 2 : 1); ++rep_) {
            const int ti = wid >> 1;
#pragma unroll
            for (int q2 = 0; q2 < 2; ++q2) {
                const int si = (wid & 1) * 2 + q2;
                f32x4 acc = (f32x4){0.f, 0.f, 0.f, 0.f};
#pragma unroll
                for (int k = 0; k < 2; ++k) acc = mma16(ldfrag(AR, RW_LP, ti * 16, k * 32, fr, fq), ldfrag(BK, RW_LP, si * 16, k * 32, fr, fq), acc);
                const int s = (si & 1) * 16 + fr;
                const bool incl = ti >= 2, kcols = si >= 2;
                bf16_t* dstb = kcols ? (incl ? ARK : AAK) : ARBn;
#pragma unroll
                for (int rr = 0; rr < 4; ++rr) { const int t = (ti & 1) * 16 + fq * 4 + rr;
                    const float val = (incl ? (s <= t) : (s < t)) ? acc[rr] : 0.f;
                    if (kcols || incl) dstb[t * 40 + s] = f2bf(val);
                    else { AABT[s * 36 + t] = val; if (ti == 1 && si == 0) A21b[(t - 16) * 40 + s] = f2bf(val); } }
            }
        }
        lds_barrier();
    };
    step(TrueT{}, FalseT{}, -1);
#pragma unroll 1
    for (int ci = 0; ci < NC - 1; ++ci) step(TrueT{}, TrueT{}, ci);
    step(FalseT{}, TrueT{}, NC - 1);
#undef RW_PREFETCH
}

__device__ __forceinline__ void phase_mix_cd(const KP& kp, unsigned char* lds, int which) {
    if (which & 1) for (int u = obid(); u < 256; u += gridDim.x) { rwkv_unit(kp, lds, u >> 5, (u >> 1) & 15, u & 1); __syncthreads(); }
    if (which & 2) for (int u = obid(); u < 512; u += gridDim.x) { attn_unit(kp, lds, u >> 6, (u >> 3) & 7, u & 7); __syncthreads(); }
}

struct EpiFinCD {
    const bf16_t* OF; const bf16_t* OB; const bf16_t* P; const float* BSC; const float* ln; const float* mu; bf16_t* AOUT;
    __device__ __forceinline__ void operator()(const f32x4 (&acc)[4][4], int rb, int cb, int fr, int fq) const {
        const int head = cb >> 6;
#pragma unroll
        for (int i = 0; i < 4; ++i) { const int lr = rb + i * 16 + fr, s = lr & 2047;
            const size_t prow = (size_t)(lr >> 11) * TT + CTXL + s;
            f32x4 o[4]; float ss = 0.f;
#pragma unroll
            for (int j = 0; j < 4; ++j) { const int col = cb + j * 16 + fq * 4;
                o[j] = ld4bf(OF + (size_t)lr * 1024 + col) + ld4bf(OB + (size_t)lr * 1024 + col);
                ss += o[j][0] * o[j][0] + o[j][1] * o[j][1] + o[j][2] * o[j][2] + o[j][3] * o[j][3]; }
            ss += __shfl_xor(ss, 16); ss += __shfl_xor(ss, 32);
            const float rstd = rsqrtf(ss * (1.0f / 64.0f) + EPS);
            const float bon = BSC[(size_t)lr * 16 + head] + BSC[(size_t)RGL * 16 + (size_t)lr * 16 + head];
#pragma unroll
            for (int j = 0; j < 4; ++j) { const int col = cb + j * 16 + fq * 4;
                const bf16_t* pv = P + prow * CD_N + CD_V + col;
                const f32x4 v = ld4bf(pv);
                const f32x4 vp = s > 0 ? ld4bf(pv - CD_N) : (f32x4){0.f, 0.f, 0.f, 0.f};
                const f32x4 vn = s < SEQ - 1 ? ld4bf(pv + CD_N) : (f32x4){0.f, 0.f, 0.f, 0.f};
                const f32x4 vl = v + *(const f32x4*)(mu + 2048 + col) * ((vp + vn) * 0.5f - v);
                const f32x4 y = o[j] * rstd * *(const f32x4*)(ln + col) + vl * bon;
                st4bf(AOUT + (size_t)lr * 1536 + 512 + col, y * acc[i][j]); }
        }
    }
};
PHASE_FN void phase_fin_cd(const KP& kp, unsigned char* lds) {
    GA ga{WSP(const bf16_t, WS_SG), nullptr, 128, 0, 128, nullptr, RGL, 0, 0};
    EpiFinCD ep{WSP(const bf16_t, WS_BIG + L1_OF), WSP(const bf16_t, WS_BIG + L1_OB), WSP(const bf16_t, WS_BIG + L1_P), WSP(const float, WS_BSC), KIN(33), KIN(24), WSP(bf16_t, WS_BIG + L1_AOUT)};
    for (int u = obid(); u < (RGL / 256) * 8; u += gridDim.x) gemm_tile(lds, ga, WSP(const bf16_t, WS_WMIX + WM_G2), 128, u >> 3, u & 7, ep);
}
PHASE_FN void phase_gemm_out_cd(const KP& kp, unsigned char* lds) {
    pg8::Gemm g{WSP(const bf16_t, WS_BIG + L1_AOUT), WSP(const bf16_t, WS_WMIX + WM_CD_OUT), RGL, 1024, 1536, nullptr, 0x7fffffff};
    pg8::StaticOrder S; S.init(RGL, 1024, (int)gridDim.x, obid());
    pg8::EpiBfG E{WSP(bf16_t, WS_BIG + L1_U), 1024, 1024, 0x7fffffff, 1.0f};
    pg8::gemm_phase<pg8::EpiBfG, pg8::StaticOrder, false>((PG8_LAS unsigned char*)lds, g, S, E, nullptr);
    __syncthreads();
}

__device__ __attribute__((noinline)) void grid_sync(unsigned* barw, unsigned x, volatile LAS unsigned* st) { XcdBarrier b; b.bar = barw; b.x = x; b.st = st; xcd_barrier(b); }
constexpr int N_PHASES = 36;
__global__ void __launch_bounds__(512, 2) fwd_kernel(KP kparg) {
    extern __shared__ __attribute__((aligned(16))) unsigned char lds[];
    const int lo = kparg.ph_lo, hi = kparg.ph_hi;
    const KP& kp = kparg;
    volatile LAS unsigned* xbst = (volatile LAS unsigned*)(LAS unsigned char*)(lds + LDS_BYTES - 16);
    if (threadIdx.x == 0) { xbst[0] = 0u; xbst[1] = 0u; }
    __syncthreads();
    XcdBarrier bar; bar.bar = (unsigned*)kparg.ws; bar.x = 0; bar.st = xbst;
    if (hi - lo > 1) bar = xcd_barrier_post((unsigned*)kparg.ws, xbst);
#define IN(k) (lo <= (k) && (k) < hi)
#define SEAM(k) do { if (IN(k) && IN((k) + 1)) { grid_sync((unsigned*)kp.ws, bar.x, xbst); if (PROBE_DUP & 512) grid_sync((unsigned*)kp.ws, bar.x, xbst); } } while (0)
#define PHASE(...) do { if (IN(ph)) { __VA_ARGS__ } SEAM(ph); ++ph; } while (0)
    int ph = 0;
    PHASE(phase_mod(kp, lds); __syncthreads(); phase_conv_ab(kp, lds); if (PROBE_DUP & 32) { __syncthreads(); phase_mod(kp, lds); __syncthreads(); phase_conv_ab(kp, lds); });
#pragma unroll
    for (int g = 0; g < NG; ++g) {
        if (g == 0) PHASE(phase_u(kp, 0, 0, obid(), (int)gridDim.x, false););
        PHASE(phase_gemm_in(kp, lds, 0, g); if (PROBE_DUP & 8) phase_gemm_in(kp, lds, 0, g););
        PHASE(phase_xconv(kp); if (PROBE_DUP & 2048) phase_xconv(kp););
        PHASE(phase_scan_ab(kp, lds); if (PROBE_DUP & 1) { __syncthreads(); phase_scan_ab(kp, lds); });
        PHASE(phase_fin_ab(kp););
        PHASE(phase_gemm_out_ab(kp, lds, g););
        PHASE(phase_r(kp, lds, 0, g););
    }
    PHASE(phase_moe_gather(kp, 0); phase_conv_cd(kp, lds););
    PHASE(phase_moe_gemm(kp, lds, 0, false); if (PROBE_DUP & 16) { __syncthreads(); phase_moe_gemm(kp, lds, 0, false); });
    PHASE(phase_moe_gemm(kp, lds, 0, true); if (PROBE_DUP & 16) { __syncthreads(); phase_moe_gemm(kp, lds, 0, true); });
    PHASE(phase_combine(kp, 0););
#pragma unroll
    for (int g = 0; g < NG; ++g) {
        PHASE(phase_gemm_in(kp, lds, 1, g); if (PROBE_DUP & 8) phase_gemm_in(kp, lds, 1, g););
        PHASE(phase_prep_cd(kp););
        PHASE(phase_upproj(kp, lds); if (PROBE_DUP & 4096) phase_upproj(kp, lds););
        PHASE(phase_mix_cd(kp, lds, 3); if (PROBE_DUP & 2) { __syncthreads(); phase_mix_cd(kp, lds, 1); } if (PROBE_DUP & 4) { __syncthreads(); phase_mix_cd(kp, lds, 2); });
        PHASE(phase_fin_cd(kp, lds); if (PROBE_DUP & 4096) phase_fin_cd(kp, lds););
        PHASE(phase_gemm_out_cd(kp, lds); if (PROBE_DUP & 256) phase_gemm_out_cd(kp, lds););
        PHASE(phase_r(kp, lds, 1, g););
    }
    PHASE(phase_moe_gather(kp, 1); phase_conv_moe(kp, lds, 1, obid(), (int)gridDim.x););
    PHASE(phase_moe_gemm(kp, lds, 1, false););
    PHASE(phase_moe_gemm(kp, lds, 1, true););
    PHASE(phase_combine(kp, 1););
#undef PHASE
#undef IN
#undef SEAM
}

extern "C" void kernel_launch(void* const* d_in, const int* in_sizes, int n_in, void* d_out, int out_size, void* d_ws, size_t ws_size, hipStream_t stream) {
    static int grid = 0;
    if (grid == 0) {
        if (n_in != 42 || out_size != NLAT * D || ws_size < WS_NEED) { fprintf(stderr, "kernel_launch: unexpected shapes: n_in %d out %d ws %zu (need %zu)\n", n_in, out_size, ws_size, (size_t)WS_NEED); grid = -1; return; }
        int dev = 0, cus = 0, per_cu = 0;
        if (hipGetDevice(&dev) != hipSuccess || hipDeviceGetAttribute(&cus, hipDeviceAttributeMultiprocessorCount, dev) != hipSuccess) { grid = -1; return; }
        if (hipFuncSetAttribute((const void*)fwd_kernel, hipFuncAttributeMaxDynamicSharedMemorySize, LDS_BYTES) != hipSuccess) { fprintf(stderr, "kernel_launch: hipFuncSetAttribute failed\n"); grid = -1; return; }
        if (hipOccupancyMaxActiveBlocksPerMultiprocessor(&per_cu, (const void*)fwd_kernel, 512, LDS_BYTES) != hipSuccess || per_cu < 1) { fprintf(stderr, "kernel_launch: occupancy query says %d blocks per CU\n", per_cu); grid = -1; (void)hipGetLastError(); return; }
        grid = cus;
    }
    if (grid < 0) return;
    (void)hipMemsetAsync(d_ws, 0, CTL_BYTES, stream);
    KP kp{};
    for (int i = 0; i < 42; ++i) kp.in[i] = (const float*)d_in[i];
    kp.out = (float*)d_out; kp.ws = (unsigned char*)d_ws;
#if N_LAUNCH_MODE == 1
    kp.ph_lo = 0; kp.ph_hi = N_PHASES;
    hipLaunchKernelGGL(fwd_kernel, dim3(grid), dim3(512), LDS_BYTES, stream, kp);
#else
    for (int p = 0; p < N_PHASES; ++p) { kp.ph_lo = p; kp.ph_hi = p + 1; hipLaunchKernelGGL(fwd_kernel, dim3(grid), dim3(512), LDS_BYTES, stream, kp); }
#endif
}
```

```cpp
#include <hip/hip_runtime.h>
#include <stdint.h>
#include <stdio.h>

typedef unsigned short bf16_t;
typedef short bf16x8 __attribute__((ext_vector_type(8)));
typedef float f32x4 __attribute__((ext_vector_type(4)));
typedef float f32x2 __attribute__((ext_vector_type(2)));
typedef unsigned u32x4 __attribute__((ext_vector_type(4)));
typedef unsigned u32x2 __attribute__((ext_vector_type(2)));

#ifndef RWP
#define RWP 0
#endif
#ifndef PROBE_DUP
#define PROBE_DUP 0
#endif
#ifndef N_LAUNCH_MODE
#define N_LAUNCH_MODE 1
#endif

constexpr int NB = 16, SEQ = 2048, CTXL = 256, TT = 2304, D = 1024;
constexpr int NTOK = NB * TT, NLAT = NB * SEQ;
constexpr int NG = 2, BG = NB / NG, RG = BG * TT, RGL = BG * SEQ;
constexpr float EPS = 1e-6f;
constexpr int AB_N = 5424, AB_NPAD = 5632, AB_Q = 0, AB_K = 512, AB_V = 1024, AB_OG = 2048, AB_IG = 3072, AB_FG = 3080, AB_Z = 3088, AB_XBC = 4112, AB_DT = 5392;
constexpr int CD_N = 4128, CD_NPAD = 4352, CD_M0 = 0, CD_M1 = 384, CD_KR = 640, CD_R = 672, CD_K = 1696, CD_V = 2720, CD_WL = 3744, CD_AL = 3872, CD_GL = 4000;
constexpr int CD_RW0 = 672;

constexpr size_t CTL_BYTES = 32768;
constexpr size_t CTL_CNT = 16384;
constexpr size_t WS_MODV = CTL_BYTES;
constexpr size_t WS_HC   = WS_MODV + (size_t)2 * 17 * 6144 * 4;
constexpr size_t WS_TOKE = WS_HC + (size_t)NB * CTXL * D * 4;
constexpr size_t WS_TOKP = WS_TOKE + (size_t)NTOK * 2 * 4;
constexpr size_t WS_TOKW = WS_TOKP + (size_t)NTOK * 2 * 4;
constexpr size_t WS_LIST = WS_TOKW + (size_t)NTOK * 2 * 4;
constexpr size_t WS_BSC  = WS_LIST + (size_t)16 * NTOK * 4;
constexpr size_t WS_SG   = WS_BSC + (size_t)2 * RGL * 16 * 4;
constexpr size_t WS_WMIX = WS_SG + (size_t)RGL * 128 * 2;
constexpr size_t WMIX_BYTES = (size_t)16 << 20;
constexpr size_t WS_V    = WS_WMIX + WMIX_BYTES;
constexpr size_t WS_BIG  = WS_V + (size_t)NTOK * D * 2;
constexpr size_t WM_AB_IN = 0, WM_AB_OUT = (size_t)AB_NPAD * 1024 * 2;
constexpr size_t WM_CD_IN = 0, WM_CD_OUT = (size_t)CD_NPAD * 1024 * 2, WM_UQ = WM_CD_OUT + (size_t)1024 * 1536 * 2, WM_UKV = WM_UQ + (size_t)768 * 384 * 2, WM_G2 = WM_UKV + (size_t)1024 * 256 * 2;
static_assert(WM_AB_OUT + (size_t)1024 * 2048 * 2 <= WMIX_BYTES, "wmix ab");
static_assert(WM_G2 + (size_t)1024 * 128 * 2 <= WMIX_BYTES, "wmix cd");
constexpr size_t SZ_RG1K = (size_t)RG * 1024 * 2, SZ_RGL1K = (size_t)RGL * 1024 * 2;
constexpr size_t L0_P = 0, L0_AO = (size_t)RG * AB_N * 2  , L0_HB = L0_AO + 2 * SZ_RG1K, L0_YB = L0_HB + SZ_RG1K, L0_U = L0_YB + SZ_RG1K, L0_END = L0_U + SZ_RG1K;
constexpr size_t L1_P = 0, L1_Q = (size_t)RG * CD_N * 2, L1_KV = L1_Q + (size_t)RGL * 768 * 2, L1_OF = L1_KV + SZ_RG1K, L1_OB = L1_OF + SZ_RGL1K, L1_AOUT = L1_OB + SZ_RGL1K, L1_U = L1_AOUT + (size_t)RGL * 1536 * 2, L1_TWAL = L1_U + SZ_RG1K  , L1_END = L1_TWAL + (size_t)RG * 256 * 2;
constexpr int MOE_PADROWS = 16 * 256;
constexpr size_t MO_WUP = 0, MO_WDN = (size_t)17 * 1024 * 1024 * 2, MO_HID = MO_WDN + (size_t)17 * 1024 * 512 * 2;
constexpr size_t MO_XG = MO_HID + (size_t)(3 * NTOK + MOE_PADROWS) * 512 * 2;
constexpr size_t MO_CON = MO_XG, MO_END = MO_CON + (size_t)(3 * NTOK + MOE_PADROWS) * 1024 * 2;
constexpr size_t BIG_BYTES = MO_END > L0_END ? (MO_END > L1_END ? MO_END : L1_END) : (L0_END > L1_END ? L0_END : L1_END);
constexpr size_t WS_NEED = WS_BIG + BIG_BYTES;

constexpr int LDS_BYTES = 151552;

__device__ __forceinline__ float bf2f(unsigned short h) { return __uint_as_float(((unsigned)h) << 16); }
typedef __bf16 bf16v2_t __attribute__((ext_vector_type(2)));
__device__ __forceinline__ unsigned pack2(float a, float b) { const bf16v2_t h = __builtin_convertvector((f32x2){a, b}, bf16v2_t); return __builtin_bit_cast(unsigned, h); }
__device__ __forceinline__ unsigned short f2bf(float f) { const __bf16 h = (__bf16)f; return __builtin_bit_cast(unsigned short, h); }
__device__ __forceinline__ float lo2f(unsigned w) { return __uint_as_float(w << 16); }
__device__ __forceinline__ float hi2f(unsigned w) { return __uint_as_float(w & 0xffff0000u); }
__device__ __forceinline__ float wsum(float v) {
#pragma unroll
    for (int o = 32; o; o >>= 1) v += __shfl_xor(v, o);
    return v; }
template <int CTRL> __device__ __forceinline__ float dpp_mov(float x) { return __builtin_bit_cast(float, __builtin_amdgcn_update_dpp(0, __builtin_bit_cast(int, x), CTRL, 0xf, 0xf, true)); }
__device__ __forceinline__ float rsum16(float x) { x += dpp_mov<0xB1>(x); x += dpp_mov<0x4E>(x); x += dpp_mov<0x124>(x); x += dpp_mov<0x128>(x); return x; }
template <int CTRL, int RM> __device__ __forceinline__ float dpp_upd(float old, float x) { return __builtin_bit_cast(float, __builtin_amdgcn_update_dpp(__builtin_bit_cast(int, old), __builtin_bit_cast(int, x), CTRL, RM, 0xf, false)); }
__device__ __forceinline__ float wscan_add(float x) { x += dpp_upd<0x111, 0xf>(0.f, x); x += dpp_upd<0x112, 0xf>(0.f, x); x += dpp_upd<0x114, 0xf>(0.f, x); x += dpp_upd<0x118, 0xf>(0.f, x);
    x += dpp_upd<0x142, 0xa>(0.f, x); x += dpp_upd<0x143, 0xc>(0.f, x); return x; }
__device__ __forceinline__ float wscan_max(float x) { const float ni = -__builtin_inff();
    x = fmaxf(x, dpp_upd<0x111, 0xf>(ni, x)); x = fmaxf(x, dpp_upd<0x112, 0xf>(ni, x)); x = fmaxf(x, dpp_upd<0x114, 0xf>(ni, x)); x = fmaxf(x, dpp_upd<0x118, 0xf>(ni, x));
    x = fmaxf(x, dpp_upd<0x142, 0xa>(ni, x)); x = fmaxf(x, dpp_upd<0x143, 0xc>(ni, x)); return x; }
__device__ __forceinline__ float lane63(float x) { return __builtin_bit_cast(float, __builtin_amdgcn_readlane(__builtin_bit_cast(int, x), 63)); }
__device__ __forceinline__ float frcp_(float x) { return __builtin_amdgcn_rcpf(x); }
__device__ __forceinline__ float sigmoidf_(float x) { return __builtin_amdgcn_rcpf(1.0f + __expf(-x)); }
__device__ __forceinline__ float siluf_(float x) { return x * __builtin_amdgcn_rcpf(1.0f + __expf(-x)); }
__device__ __forceinline__ float softplusf_(float x) { return fmaxf(x, 0.0f) + __logf(1.0f + __expf(-fabsf(x))); }
__device__ __forceinline__ float logsigmoidf_(float x) { return fminf(x, 0.0f) - __logf(1.0f + __expf(-fabsf(x))); }
__device__ __forceinline__ float tanhf_(float x) { return 1.0f - 2.0f * __builtin_amdgcn_rcpf(__expf(2.0f * x) + 1.0f); }
__device__ __forceinline__ f32x4 mma16(bf16x8 a, bf16x8 b, f32x4 c) { return __builtin_amdgcn_mfma_f32_16x16x32_bf16(a, b, c, 0, 0, 0); }
__device__ __forceinline__ bf16x8 ldfrag(const bf16_t* base, int ld, int row0, int k0, int fr, int fq) { return *(const bf16x8*)(base + (row0 + fr) * ld + k0 + fq * 8); }
__device__ __forceinline__ void st4bf(bf16_t* p, f32x4 v) { u32x2 w; w.x = pack2(v[0], v[1]); w.y = pack2(v[2], v[3]); *(u32x2*)p = w; }
__device__ __forceinline__ f32x4 ld4bf(const bf16_t* p) { u32x2 w = *(const u32x2*)p; return (f32x4){lo2f(w.x), hi2f(w.x), lo2f(w.y), hi2f(w.y)}; }

#define PHASE_FN __device__ __forceinline__
__device__ __forceinline__ int otid() { int t = threadIdx.x; asm volatile("" : "+v"(t)); return t; }
__device__ __forceinline__ int obid() { int t = blockIdx.x; asm volatile("" : "+s"(t)); return t; }
template <class T> __device__ __forceinline__ T* as_global(T* p) { return p; }
__device__ __forceinline__ void lds_barrier() { asm volatile("s_waitcnt lgkmcnt(0)" ::: "memory"); __builtin_amdgcn_s_barrier(); asm volatile("" ::: "memory"); }
constexpr float W8_SCALE = 64.0f, W8_INV = 1.0f / 64.0f;
__device__ __forceinline__ unsigned pack4f8(float a, float b, float c, float d) { unsigned r = 0; r = __builtin_amdgcn_cvt_pk_fp8_f32(a, b, r, false); r = __builtin_amdgcn_cvt_pk_fp8_f32(c, d, r, true); return r; }
__device__ __forceinline__ void st4f8(unsigned char* p, f32x4 v) { *(unsigned*)p = pack4f8(v[0], v[1], v[2], v[3]); }
struct KP { const float* in[42]; float* out; unsigned char* ws; int ph_lo, ph_hi; };

#define XB_TMO      128
#define XB_XCNT(j)  (256  + 64 * (j))
#define XB_XSUB(j)  (1280 + 64 * (j))
#define XB_XGEN(j)  (2304 + 64 * (j))
#define XB_TOP      3328
#define XB_TOPGEN   3392
#define XCD_BAR_WORDS 3456
#define XB_SPIN_CAP (1u << 18)
#define LAS __attribute__((address_space(3)))

__device__ __forceinline__ unsigned xb_ld(unsigned* p)              { return __hip_atomic_load(p, __ATOMIC_RELAXED, __HIP_MEMORY_SCOPE_AGENT); }
__device__ __forceinline__ unsigned xb_add(unsigned* p, unsigned v) { return __hip_atomic_fetch_add(p, v, __ATOMIC_RELAXED, __HIP_MEMORY_SCOPE_AGENT); }
__device__ __forceinline__ unsigned xb_xcc_id() { return (unsigned)__builtin_amdgcn_s_getreg((3 << 11) | 20) & 0xFu; }
#define XB_SPIN(cond, bar) do { unsigned _sp = 0; while (cond) { __builtin_amdgcn_s_sleep(1); \
    if ((++_sp & 255u) == 0u) { if (xb_ld(&(bar)[XB_TMO])) break; if (_sp > XB_SPIN_CAP) { atomicAdd(&(bar)[XB_TMO], 1u); break; } } } } while (0)

struct XcdBarrier {
    unsigned* bar; unsigned x;
    volatile LAS unsigned* st;
};

__device__ __forceinline__ XcdBarrier xcd_barrier_post(unsigned* bar, volatile LAS unsigned* st) {
    XcdBarrier b; b.bar = bar; b.x = xb_xcc_id(); b.st = st;
    if (threadIdx.x == 0) (void)xb_add(&bar[XB_XCNT(b.x)], 1u);
    return b;
}
__device__ __forceinline__ void xcd_barrier_complete(unsigned* bar, unsigned x, unsigned& nloc, unsigned& nx) {
    const unsigned G = gridDim.x * gridDim.y * gridDim.z;
    unsigned sum, cnt, mine, sp = 0u;
    for (;;) {
        sum = 0u; cnt = 0u; mine = 0u;
#pragma unroll
        for (unsigned j = 0; j < 16; ++j) { const unsigned c = xb_ld(&bar[XB_XCNT(j)]); sum += c; cnt += (c > 0u) ? 1u : 0u; mine = (j == x) ? c : mine; }
        if (sum == G) break;
        __builtin_amdgcn_s_sleep(1);
        if ((++sp & 255u) == 0u) { if (xb_ld(&bar[XB_TMO])) break; if (sp > XB_SPIN_CAP) { atomicAdd(&bar[XB_TMO], 1u); break; } }
    }
    nloc = mine > 0u ? mine : 1u; nx = cnt > 0u ? cnt : 1u;
}

__device__ __forceinline__ void xcd_barrier(const XcdBarrier& b) {
    asm volatile("s_waitcnt vmcnt(0)" ::: "memory");
    __syncthreads();
    if (threadIdx.x == 0) {
        unsigned* bar = b.bar;
        __builtin_amdgcn_s_waitcnt(0);
        unsigned nloc = b.st[0], nx = b.st[1];
        if (nloc == 0u) { xcd_barrier_complete(bar, b.x, nloc, nx); b.st[0] = nloc; b.st[1] = nx; }
        const unsigned old = xb_add(&bar[XB_XSUB(b.x)], 1u);
        const unsigned gen = old / nloc;
        if (old + 1u == (gen + 1u) * nloc) {
            __builtin_amdgcn_fence(__ATOMIC_RELEASE, "agent");
            asm volatile("s_waitcnt vmcnt(0)" ::: "memory");
            const unsigned og = xb_add(&bar[XB_TOP], 1u);
            const unsigned tg = og / nx;
            if (og + 1u == (tg + 1u) * nx) xb_add(&bar[XB_TOPGEN], 1u);
            else XB_SPIN(xb_ld(&bar[XB_TOPGEN]) == tg, bar);
            __builtin_amdgcn_fence(__ATOMIC_ACQUIRE, "agent");
            xb_add(&bar[XB_XGEN(b.x)], 1u);
            asm volatile("s_waitcnt vmcnt(0)" ::: "memory");
        } else {
            XB_SPIN(xb_ld(&bar[XB_XGEN(b.x)]) == gen, bar);
            __builtin_amdgcn_fence(__ATOMIC_ACQUIRE, "agent");
            asm volatile("s_waitcnt vmcnt(0)" ::: "memory");
        }
    }
    __syncthreads();
}
struct GA {
    const bf16_t* a0; const bf16_t* a1;
    int ld0, ld1, ksplit;
    const int* list;
    int nrows;
    int mode;
    int row0;
};
constexpr int G_LDT = 40;
constexpr int GEMM_LDS = (2 * 256 * G_LDT + 2 * 128 * G_LDT) * 2;

template <class Epi>
__device__ __forceinline__ void gemm_tile(unsigned char* lds, const GA& ga, const bf16_t* __restrict__ Bt, int K, int mt, int nt, const Epi& epi) {
    const int tid = otid(), lane = tid & 63, wid = __builtin_amdgcn_readfirstlane(tid >> 6), wm = wid >> 1, wn = wid & 1, fr = lane & 15, fq = lane >> 4;
    bf16_t* sA = (bf16_t*)lds;
    bf16_t* sB = sA + 2 * 256 * G_LDT;
    const int kp = tid & 3;
    const int r0 = tid >> 2, r1 = r0 + 128;
    int s0, s1;
    {
        int lr = mt * 256 + r0; if (lr >= ga.nrows) lr = 0;
        s0 = ga.list ? ga.list[lr] : (ga.mode == 1 ? (lr >> 11) * TT + CTXL + (lr & 2047) : ga.row0 + lr);
        lr = mt * 256 + r1; if (lr >= ga.nrows) lr = 0;
        s1 = ga.list ? ga.list[lr] : (ga.mode == 1 ? (lr >> 11) * TT + CTXL + (lr & 2047) : ga.row0 + lr);
    }
    const bf16_t* pa00 = ga.a0 + (size_t)s0 * ga.ld0 + kp * 8;
    const bf16_t* pa01 = ga.a0 + (size_t)s1 * ga.ld0 + kp * 8;
    const bf16_t* pa10 = ga.a1 ? ga.a1 + (size_t)s0 * ga.ld1 + kp * 8 : pa00;
    const bf16_t* pa11 = ga.a1 ? ga.a1 + (size_t)s1 * ga.ld1 + kp * 8 : pa01;
    const bf16_t* pb = Bt + (size_t)(nt * 128 + r0) * K + kp * 8;
    const int ksplit = ga.ksplit;
    f32x4 acc[4][4];
#pragma unroll
    for (int i = 0; i < 4; ++i)
#pragma unroll
        for (int j = 0; j < 4; ++j) acc[i][j] = (f32x4){0.f, 0.f, 0.f, 0.f};
    const int nk = K >> 5;
    u32x4 ra0, ra1, rb;
    {
        ra0 = *(const u32x4*)(pa00); ra1 = *(const u32x4*)(pa01); rb = *(const u32x4*)(pb);
        if (0 >= ksplit) { ra0 = *(const u32x4*)(pa10); ra1 = *(const u32x4*)(pa11); }
    }
    *(u32x4*)(sA + (r0) * G_LDT + kp * 8) = ra0;
    *(u32x4*)(sA + (r1) * G_LDT + kp * 8) = ra1;
    *(u32x4*)(sB + (r0) * G_LDT + kp * 8) = rb;
    __syncthreads();
    for (int kt = 0; kt < nk; ++kt) {
        const int cur = kt & 1;
        if (kt + 1 < nk) {
            const int k0 = (kt + 1) << 5;
            if (k0 < ksplit) { ra0 = *(const u32x4*)(pa00 + k0); ra1 = *(const u32x4*)(pa01 + k0); }
            else { ra0 = *(const u32x4*)(pa10 + (k0 - ksplit)); ra1 = *(const u32x4*)(pa11 + (k0 - ksplit)); }
            rb = *(const u32x4*)(pb + k0);
        }
        const bf16_t* cA = sA + cur * 256 * G_LDT;
        const bf16_t* cB = sB + cur * 128 * G_LDT;
        bf16x8 af[4], bfr[4];
#pragma unroll
        for (int i = 0; i < 4; ++i) af[i] = ldfrag(cA, G_LDT, wm * 64 + i * 16, 0, fr, fq);
#pragma unroll
        for (int j = 0; j < 4; ++j) bfr[j] = ldfrag(cB, G_LDT, wn * 64 + j * 16, 0, fr, fq);
#pragma unroll
        for (int i = 0; i < 4; ++i)
#pragma unroll
            for (int j = 0; j < 4; ++j) acc[i][j] = mma16(bfr[j], af[i], acc[i][j]);
        if (kt + 1 < nk) {
            const int nb = cur ^ 1;
            *(u32x4*)(sA + (nb * 256 + r0) * G_LDT + kp * 8) = ra0;
            *(u32x4*)(sA + (nb * 256 + r1) * G_LDT + kp * 8) = ra1;
            *(u32x4*)(sB + (nb * 128 + r0) * G_LDT + kp * 8) = rb;
        }
        __syncthreads();
    }
    epi(acc, mt * 256 + wm * 64, nt * 128 + wn * 64, fr, fq);
}

struct EpiBf {
    bf16_t* out; int ld, nrows, ncols;
    __device__ __forceinline__ void operator()(const f32x4 (&acc)[4][4], int rb, int cb, int fr, int fq) const {
#pragma unroll
        for (int i = 0; i < 4; ++i) { const int lr = rb + i * 16 + fr; if (lr < nrows) {
#pragma unroll
            for (int j = 0; j < 4; ++j) { const int col = cb + j * 16 + fq * 4; if (col < ncols) st4bf(out + (size_t)lr * ld + col, acc[i][j]); } } }
    }
};
struct EpiSwiglu {
    bf16_t* out; int nrows;
    __device__ __forceinline__ void operator()(const f32x4 (&acc)[4][4], int rb, int cb, int fr, int fq) const {
#pragma unroll
        for (int i = 0; i < 4; ++i) { const int lr = rb + i * 16 + fr; if (lr < nrows) {
#pragma unroll
            for (int j = 0; j < 2; ++j) { const int col = (cb >> 1) + j * 16 + fq * 4; f32x4 g = acc[i][j], u = acc[i][j + 2], o;
#pragma unroll
                for (int r = 0; r < 4; ++r) o[r] = siluf_(g[r]) * u[r];
                st4bf(out + (size_t)lr * 512 + col, o); } } }
    }
};

namespace pg8 {
#define PG8_LAS __attribute__((address_space(3)))
typedef unsigned short bf16_t;
typedef short bf16x8 __attribute__((ext_vector_type(8)));
typedef float f32x4 __attribute__((ext_vector_type(4)));
typedef unsigned u32x4 __attribute__((ext_vector_type(4)));
constexpr int BM = 256, BK = 64, HALF = 128, HTB = HALF * BK * 2  , STAGE_BYTES = 8 * HTB, NXCD = 8, WGM = 8;

__host__ __device__ __forceinline__ int lds_byte(int r, int c) { const int st = (r >> 4) * 2 + (c >> 5), rr = r & 15, cc = c & 31, ob = rr * 64 + cc * 2; return st * 1024 + (ob ^ (((ob >> 9) & 1) << 5)); }
__host__ __device__ __forceinline__ void stage_rc(int b, int& R, int& C) { const int st = b / 1024, sb = b % 1024, swz = sb ^ (((sb >> 9) & 1) << 5); R = (st >> 1) * 16 + swz / 64; C = (st & 1) * 32 + (swz % 64) / 2; }
__host__ __device__ __forceinline__ int perm32(int rho) { const int n = rho >> 4, i = rho & 15; return 8 * (i >> 2) + 4 * n + (i & 3); }

struct Unit { int pm, pn; };
struct Gemm { const bf16_t* A; const bf16_t* Bt; int M, N, K; const bf16_t* A2; int pm_split; int lda, amode; };
#define PG8_ABASE(g, pm) ((g).amode == 1 ? (const char*)(g).A + (size_t)(((pm) >> 3) * 2304 + 256 + ((pm) & 7) * 256) * lda_ * 2 : ((pm) < (g).pm_split ? (const char*)(g).A + (size_t)(pm) * tstepA : (const char*)(g).A2 + (size_t)((pm) - (g).pm_split) * tstepA))
struct StaticOrder {
    int nM, nN, nwg, G, c;
    __host__ __device__ void init(int M, int N, int G_, int c_) { nM = M / BM; nN = N / BM; nwg = nM * nN; G = G_; c = c_; }
    __host__ __device__ bool next(int i, Unit& u) const {
        const long L = (long)i * G + c; if (L >= nwg) return false;
        int wgid = (int)L; { const int q = nwg / NXCD, r = nwg % NXCD, xcd = wgid % NXCD, off = wgid / NXCD; wgid = (xcd < r ? xcd * (q + 1) : r * (q + 1) + (xcd - r) * q) + off; }
        const int nig = WGM * nN, gid = wgid / nig, fm = gid * WGM, gsz = (nM - fm) < WGM ? (nM - fm) : WGM;
        u.pm = fm + ((wgid % nig) % gsz); u.pn = (wgid % nig) / gsz; return true;
    }
    __device__ __forceinline__ void a_ready(const Unit&) const {}
    __device__ __forceinline__ void done(const Unit&) const {}
};
__device__ __forceinline__ unsigned cvt_pk_bf16(float lo, float hi) { unsigned r; asm volatile("v_cvt_pk_bf16_f32 %0, %1, %2" : "=v"(r) : "v"(lo), "v"(hi)); return r; }
typedef float f32x2 __attribute__((ext_vector_type(2)));
template <class Epi, class Sched, bool STAMP = false, bool F8 = false>
__device__ __forceinline__ void gemm_phase(PG8_LAS unsigned char* lds, const Gemm g, const Sched& S, const Epi& E, unsigned long long* stamps) {
    const int tid = otid(), wid = __builtin_amdgcn_readfirstlane(tid >> 6), lane = tid & 63, wr = wid >> 2, wc = wid & 3, fr = lane & 15, fq = lane >> 4;
    const int K = g.K, nt = K / BK, lda_ = g.lda ? g.lda : g.K;
    int ts_lo = 0, ts_hi = 0, nts = 0; const unsigned long long rt_entry = STAMP ? (unsigned long long)wall_clock64() : 0ull;
#define PG8_STAMP() do { if (STAMP && wid == 0 && nts < 64) { const unsigned long long _c = (unsigned long long)clock64(); \
        ts_lo = (lane == nts) ? (int)(unsigned)_c : ts_lo; ts_hi = (lane == nts) ? (int)(unsigned)(_c >> 32) : ts_hi; ++nts; } } while (0)
    PG8_STAMP();
    unsigned voffA[2], voffB[2];
#pragma unroll
    for (int i = 0; i < 2; ++i) { int R, C; stage_rc(tid * 16 + i * 8192, R, C); const int Rb = Epi::PERM ? ((R & ~31) + perm32(R & 31)) : R;
        voffA[i] = (unsigned)(R * lda_ + C) * 2u; voffB[i] = (unsigned)(Rb * K + C) * 2u; }
    const size_t kstep = (size_t)(BK * 2);
    const size_t hstep = (size_t)HALF * K * 2;
    const size_t hstepA = (size_t)HALF * lda_ * 2, tstepA = 2 * hstepA;
    const size_t tstep = 2 * hstep;
    const unsigned ldsw = (unsigned)wid * 1024u;
    const int aoff = lds_byte(wr * 64 + fr, fq * 8), boff = lds_byte(wc * 32 + fr, fq * 8);
#define PG8_SA(b, h) (((b) * 2 + (h)) * HTB)
#define PG8_SB(b, h) ((4 + (b) * 2 + (h)) * HTB)
#define PG8_STAGE(bufoff, gbase, voff) do { _Pragma("unroll") for (int _i = 0; _i < 2; ++_i) \
        __builtin_amdgcn_global_load_lds((const unsigned*)((const char*)(gbase) + (voff)[_i]), (PG8_LAS unsigned*)(lds + (bufoff) + ldsw + _i * 8192), 16, 0, 0); } while (0)
#define PG8_LDA(dst, b, h) do { _Pragma("unroll") for (int m = 0; m < 4; ++m) { \
        if constexpr (F8) { dst##8[m].lo = *(const PG8_LAS v4i_*)(lds + PG8_SA(b, h) + aoff + m * 2048); dst##8[m].hi = *(const PG8_LAS v4i_*)(lds + PG8_SA(b, h) + aoff + m * 2048 + 1024); } \
        else { _Pragma("unroll") for (int k = 0; k < 2; ++k) dst[m][k] = *(const PG8_LAS bf16x8*)(lds + PG8_SA(b, h) + aoff + m * 2048 + k * 1024); } } } while (0)
#define PG8_LDB(dst, b, h) do { _Pragma("unroll") for (int n = 0; n < 2; ++n) { \
        if constexpr (F8) { dst##8[n].lo = *(const PG8_LAS v4i_*)(lds + PG8_SB(b, h) + boff + n * 2048); dst##8[n].hi = *(const PG8_LAS v4i_*)(lds + PG8_SB(b, h) + boff + n * 2048 + 1024); } \
        else { _Pragma("unroll") for (int k = 0; k < 2; ++k) dst[n][k] = *(const PG8_LAS bf16x8*)(lds + PG8_SB(b, h) + boff + n * 2048 + k * 1024); } } } while (0)
#define PG8_MMA(ai, bj, At, Bt) do { __builtin_amdgcn_s_setprio(1); _Pragma("unroll") for (int m = 0; m < 4; ++m) _Pragma("unroll") for (int n = 0; n < 2; ++n) { \
        if constexpr (F8) asm volatile("v_mfma_scale_f32_16x16x128_f8f6f4 %0, %1, %2, %0, %3, %3 op_sel_hi:[0,0,0]" : "+v"(acc[ai][bj][m][n]) : "v"(Bt##8[n]), "v"(At##8[m]), "v"(one_scale)); \
        else { _Pragma("unroll") for (int k = 0; k < 2; ++k) acc[ai][bj][m][n] = __builtin_amdgcn_mfma_f32_16x16x32_bf16(Bt[n][k], At[m][k], acc[ai][bj][m][n], 0, 0, 0); } } \
        __builtin_amdgcn_s_setprio(0); } while (0)
#define PG8_WAIT_V(n) asm volatile("s_waitcnt vmcnt(" #n ")" ::: "memory")
#define PG8_WAIT_L(n) asm volatile("s_waitcnt lgkmcnt(" #n ")" ::: "memory")
#define PG8_BAR __builtin_amdgcn_s_barrier()
#define PG8_SCHED __builtin_amdgcn_sched_barrier(0)
    Unit cur, nxt; int ui = 0;
    if (!S.next(0, cur)) return;
    f32x4 acc[2][2][4][2];
#pragma unroll
    for (int a = 0; a < 2; ++a)
#pragma unroll
        for (int b = 0; b < 2; ++b)
#pragma unroll
            for (int m = 0; m < 4; ++m)
#pragma unroll
                for (int n = 0; n < 2; ++n) acc[a][b][m][n] = (f32x4){0.f, 0.f, 0.f, 0.f};
    bf16x8 At[4][2], B0[2][2], B1[2][2];
    typedef int v4i_ __attribute__((ext_vector_type(4))); typedef int v8i_ __attribute__((ext_vector_type(8)));
    v8i_ At8[4], B08[2], B18[2];
    const int one_scale = 0x7f7f7f7f;
    const char* cA = PG8_ABASE(g, cur.pm); const char* cB = (const char*)g.Bt + (size_t)cur.pn * tstep;
    S.a_ready(cur);
    PG8_STAGE(PG8_SB(0, 0), cB, voffB); PG8_STAGE(PG8_SA(0, 0), cA, voffA); PG8_STAGE(PG8_SB(0, 1), cB + hstep, voffB); PG8_STAGE(PG8_SA(0, 1), cA + hstepA, voffA);
    if (wr == 1) PG8_BAR;
    PG8_WAIT_V(4); PG8_BAR;
    PG8_STAGE(PG8_SB(1, 0), cB + kstep, voffB); PG8_STAGE(PG8_SA(1, 0), cA + kstep, voffA); PG8_STAGE(PG8_SB(1, 1), cB + hstep + kstep, voffB);
    PG8_WAIT_V(6); PG8_BAR;
    PG8_STAMP();
    for (;;) {
        const bool has_next = S.next(ui + 1, nxt);
        const char* nA = has_next ? PG8_ABASE(g, nxt.pm) : cA; const char* nB = has_next ? (const char*)g.Bt + (size_t)nxt.pn * tstep : cB;
#pragma unroll 1
        for (int t = 0; t < nt; t += 2) {
            const bool last = (t == nt - 2);
            const char* a1 = cA + (size_t)(t + 1) * kstep;
            const char* a2 = last ? nA : cA + (size_t)(t + 2) * kstep; const char* b2 = last ? nB : cB + (size_t)(t + 2) * kstep;
            const char* a3 = a2 + kstep; const char* b3 = b2 + kstep;
            if (last && has_next) S.a_ready(nxt);
            PG8_LDB(B0, 0, 0); PG8_SCHED; PG8_LDA(At, 0, 0); PG8_STAGE(PG8_SA(1, 1), a1 + hstepA, voffA);
            PG8_WAIT_L(8); PG8_BAR; PG8_WAIT_L(0); PG8_MMA(0, 0, At, B0); PG8_BAR; PG8_SCHED;
            PG8_LDB(B1, 0, 1); PG8_STAGE(PG8_SB(0, 0), b2, voffB);
            PG8_BAR; PG8_WAIT_L(0); PG8_MMA(0, 1, At, B1); PG8_BAR;
            PG8_LDA(At, 0, 1); PG8_STAGE(PG8_SA(0, 0), a2, voffA);
            PG8_BAR; PG8_WAIT_L(0); PG8_MMA(1, 0, At, B0); PG8_BAR; PG8_SCHED;
            PG8_STAGE(PG8_SB(0, 1), b2 + hstep, voffB);
            PG8_WAIT_V(6); PG8_BAR; PG8_MMA(1, 1, At, B1); PG8_BAR;
            PG8_LDB(B0, 1, 0); PG8_SCHED; PG8_LDA(At, 1, 0); PG8_STAGE(PG8_SA(0, 1), a2 + hstepA, voffA);
            PG8_WAIT_L(8); PG8_BAR; PG8_WAIT_L(0); PG8_MMA(0, 0, At, B0); PG8_BAR; PG8_SCHED;
            PG8_LDB(B1, 1, 1); PG8_STAGE(PG8_SB(1, 0), b3, voffB);
            PG8_BAR; PG8_WAIT_L(0); PG8_MMA(0, 1, At, B1); PG8_BAR;
            PG8_LDA(At, 1, 1); PG8_STAGE(PG8_SA(1, 0), a3, voffA);
            PG8_BAR; PG8_WAIT_L(0); PG8_MMA(1, 0, At, B0); PG8_BAR; PG8_SCHED;
            PG8_STAGE(PG8_SB(1, 1), b3 + hstep, voffB);
            PG8_WAIT_V(6); PG8_BAR; PG8_MMA(1, 1, At, B1); PG8_BAR;
        }
        PG8_STAMP();
        if constexpr (F8) asm volatile("s_nop 15\n\ts_nop 15" ::: "memory");
        if constexpr (!Epi::AFTER_DRAIN) { E(acc, cur, wr, wc, fr, fq); S.done(cur); }
        PG8_STAMP();
        if (!has_next) break;
#pragma unroll
        for (int a = 0; a < 2; ++a)
#pragma unroll
            for (int b = 0; b < 2; ++b)
#pragma unroll
                for (int m = 0; m < 4; ++m)
#pragma unroll
                    for (int n = 0; n < 2; ++n) acc[a][b][m][n] = (f32x4){0.f, 0.f, 0.f, 0.f};
        cur = nxt; cA = nA; cB = nB; ++ui;
    }
    PG8_WAIT_V(0);
    if (wr == 0) PG8_BAR;
    PG8_BAR;
    if constexpr (Epi::AFTER_DRAIN) { E.fused(acc, cur, wr, wc, fr, fq, lds, wid, lane); S.done(cur); }
    PG8_STAMP();
    if (STAMP && wid == 0) { stamps[lane] = lane < nts ? (((unsigned long long)(unsigned)ts_hi << 32) | (unsigned)ts_lo) : 0ull;
        if (lane == 62) stamps[62] = rt_entry; if (lane == 63) stamps[63] = (unsigned long long)wall_clock64(); }
#undef PG8_STAMP
#undef PG8_SA
#undef PG8_SB
#undef PG8_STAGE
#undef PG8_LDA
#undef PG8_LDB
#undef PG8_MMA
#undef PG8_WAIT_V
#undef PG8_WAIT_L
#undef PG8_BAR
#undef PG8_SCHED
}
}
namespace pg8 {
struct EpiBfG {
    static constexpr bool PERM = true, AFTER_DRAIN = false;
    bf16_t* O; int ldc, ncols, pn_mask; float oscale;
    __device__ __forceinline__ void operator()(const f32x4 (&acc)[2][2][4][2], const Unit& u, int wr, int wc, int fr, int fq) const {
        const int row0 = u.pm * BM + wr * 64 + fr, col0 = (u.pn & pn_mask) * BM + wc * 32 + 8 * fq;
#pragma unroll
        for (int ai = 0; ai < 2; ++ai)
#pragma unroll
            for (int m = 0; m < 4; ++m) { bf16_t* rowp = O + (size_t)(row0 + ai * HALF + m * 16) * ldc;
#pragma unroll
                for (int bj = 0; bj < 2; ++bj) { const int c = col0 + bj * HALF;
                    if (c < ncols) { const f32x4 v0 = acc[ai][bj][m][0] * oscale, v1 = acc[ai][bj][m][1] * oscale;
                        u32x4 w; w.x = cvt_pk_bf16(v0[0], v0[1]); w.y = cvt_pk_bf16(v0[2], v0[3]); w.z = cvt_pk_bf16(v1[0], v1[1]); w.w = cvt_pk_bf16(v1[2], v1[3]);
                        *(u32x4*)(rowp + c) = w; } } }
    }
};
struct EpiSwi {
    static constexpr bool PERM = true, AFTER_DRAIN = false;
    bf16_t* H;
    __device__ __forceinline__ void operator()(const f32x4 (&acc)[2][2][4][2], const Unit& u, int wr, int wc, int fr, int fq) const {
        const int row0 = u.pm * BM + wr * 64 + fr, hc0 = (u.pn & 3) * HALF + wc * 32 + 8 * fq;
#pragma unroll
        for (int ai = 0; ai < 2; ++ai)
#pragma unroll
            for (int m = 0; m < 4; ++m) { unsigned char* rowp = (unsigned char*)H + (size_t)(row0 + ai * HALF + m * 16) * 1024 + hc0;
                float o[8];
#pragma unroll
                for (int n = 0; n < 2; ++n)
#pragma unroll
                    for (int r = 0; r < 4; ++r) { const float g = acc[ai][0][m][n][r] * W8_INV; o[n * 4 + r] = g * __builtin_amdgcn_rcpf(1.0f + __expf(-g)) * (acc[ai][1][m][n][r] * W8_INV); }
                u32x2 w; w.x = pack4f8(o[0], o[1], o[2], o[3]); w.y = pack4f8(o[4], o[5], o[6], o[7]);
                *(u32x2*)rowp = w; }
    }
};
struct MoeOrder {
    const int* slotmap; int ntiles, G, c;
    __device__ __forceinline__ bool next(int i, Unit& u) const {
        const int L = i * G + c; if (L >= ntiles * 4) return false;
        u.pm = L >> 2; u.pn = __builtin_amdgcn_readfirstlane(slotmap[L >> 2]) * 4 + (L & 3); return true;
    }
    __device__ __forceinline__ void a_ready(const Unit&) const {}
    __device__ __forceinline__ void done(const Unit&) const {}
};
}
#define WSP(T, off) as_global((T*)(kp.ws + (off)))
#define KIN(i) as_global(kp.in[i])
#define KOUT as_global(kp.out)

PHASE_FN void phase_mod(const KP& kp, unsigned char* lds) {
    float* sc = (float*)lds;
    float* red = sc + 17 * 1024;
    float* modv = WSP(float, WS_MODV);
    const int tid = otid();
    for (int i = tid; i < 17 * 1024; i += 512) { const int bb = i >> 10, k = i & 1023; const float c = bb < 16 ? KIN(1)[bb * 1024 + k] : KIN(3)[k]; sc[i] = siluf_(c); }
    __syncthreads();
    const int jc = tid & 63, ks = tid >> 6;
    for (int u = obid(); u < 192; u += gridDim.x) {
        const int l = u / 96, j0 = (u % 96) * 64;
        const float* w = KIN(4) + (size_t)l * 1024 * 6144 + j0 + jc;
        float acc[17];
#pragma unroll
        for (int bb = 0; bb < 17; ++bb) acc[bb] = 0.f;
        for (int k = ks * 128; k < ks * 128 + 128; ++k) {
            const float wv = w[(size_t)k * 6144];
#pragma unroll
            for (int bb = 0; bb < 17; ++bb) acc[bb] += sc[bb * 1024 + k] * wv;
        }
#pragma unroll
        for (int bb = 0; bb < 17; ++bb) red[(ks * 17 + bb) * 64 + jc] = acc[bb];
        __syncthreads();
        for (int i = tid; i < 17 * 64; i += 512) {
            const int bb = i >> 6, j = i & 63; float s = KIN(5)[l * 6144 + j0 + j];
#pragma unroll
            for (int k2 = 0; k2 < 8; ++k2) s += red[(k2 * 17 + bb) * 64 + j];
            modv[((size_t)l * 17 + bb) * 6144 + j0 + j] = s;
        }
        __syncthreads();
    }
}

struct CvJob { const float* src; bf16_t* dst; int N, ldd, mode, kt, ntile, f8; };
__device__ __forceinline__ bool cv_pick(int& u, CvJob& J, const float* src, int K, int N, bf16_t* dst, int mode = 0, int ldd = -1, int f8 = 0) {
    const int ntl = (N + 63) >> 6, cnt = ntl * (K >> 6);
    if (u < cnt) { J.src = src; J.dst = dst; J.N = N; J.ldd = ldd < 0 ? K : ldd; J.mode = mode; J.kt = u / ntl; J.ntile = u % ntl; J.f8 = f8; return true; }
    u -= cnt; return false;
}
__device__ __forceinline__ void cv_load(const CvJob& J, int tid, f32x4 (&r)[2]) {
#pragma unroll
    for (int i = 0; i < 2; ++i) { const int idx = tid + i * 512, k = idx >> 4, n0 = J.ntile * 64 + (idx & 15) * 4;
        r[i] = (n0 < J.N) ? *(const f32x4*)(J.src + (size_t)(J.kt * 64 + k) * J.N + n0) : (f32x4){0.f, 0.f, 0.f, 0.f}; }
}
__device__ __forceinline__ void cv_put(float* tile, int tid, const f32x4 (&r)[2]) {
#pragma unroll
    for (int i = 0; i < 2; ++i) { const int idx = tid + i * 512, k = idx >> 4, nq = (idx & 15) * 4;
        tile[k * 65 + nq] = r[i][0]; tile[k * 65 + nq + 1] = r[i][1]; tile[k * 65 + nq + 2] = r[i][2]; tile[k * 65 + nq + 3] = r[i][3]; }
}
__device__ __forceinline__ void cv_store(const float* tile, const CvJob& J, int tid) {
    const int nl = tid >> 3, k8 = tid & 7, n = J.ntile * 64 + nl;
    if (n < J.N) { int row = n; if (J.mode) row = (n >> 7) * 256 + (n & 127) + (J.mode == 2 ? 128 : 0);
        const float* tp = tile + (k8 * 8) * 65 + nl;
        if (J.f8) { u32x2 w; w.x = pack4f8(tp[0] * W8_SCALE, tp[65] * W8_SCALE, tp[130] * W8_SCALE, tp[195] * W8_SCALE); w.y = pack4f8(tp[260] * W8_SCALE, tp[325] * W8_SCALE, tp[390] * W8_SCALE, tp[455] * W8_SCALE);
            *(u32x2*)((unsigned char*)J.dst + (size_t)row * J.ldd + J.kt * 64 + k8 * 8) = w; }
        else { u32x4 w; w.x = pack2(tp[0], tp[65]); w.y = pack2(tp[130], tp[195]); w.z = pack2(tp[260], tp[325]); w.w = pack2(tp[390], tp[455]);
            *(u32x4*)(J.dst + (size_t)row * J.ldd + J.kt * 64 + k8 * 8) = w; } }
}
#define CV_RUN(total, PICK) CV_RUN_ON(total, PICK, obid(), (int)gridDim.x)
#define CV_RUN_ON(total, PICK, bid_, nb_) do { float* tile = (float*)lds; const int tid = otid(); const int G_ = (nb_); int u_ = (bid_); CvJob J, Jn; f32x4 r[2]; \
        if (u_ < (total)) { int u = u_; PICK(u, J); cv_load(J, tid, r); } \
        while (u_ < (total)) { cv_put(tile, tid, r); __syncthreads(); const int un_ = u_ + G_; \
            if (un_ < (total)) { int u = un_; PICK(u, Jn); cv_load(Jn, tid, r); } \
            cv_store(tile, J, tid); __syncthreads(); u_ = un_; J = Jn; } } while (0)
PHASE_FN void phase_conv_ab(const KP& kp, unsigned char* lds) {
#define PICK_AB(u, J) do { if (!cv_pick(u, J, KIN(7), 1024, AB_N, WSP(bf16_t, WS_WMIX + WM_AB_IN))) cv_pick(u, J, KIN(8), 2048, 1024, WSP(bf16_t, WS_WMIX + WM_AB_OUT)); } while (0)
    CV_RUN(16 * 85 + 32 * 16, PICK_AB);
#undef PICK_AB
}
PHASE_FN void phase_conv_cd(const KP& kp, unsigned char* lds) {
#define PICK_CD(u, J) do { if (cv_pick(u, J, KIN(18), 1024, CD_N, WSP(bf16_t, WS_WMIX + WM_CD_IN), 0, 1024, 1)) break;     \
        if (cv_pick(u, J, KIN(19), 1536, 1024, WSP(bf16_t, WS_WMIX + WM_CD_OUT))) break; \
        if (cv_pick(u, J, KIN(21), 384, 768, WSP(bf16_t, WS_WMIX + WM_UQ))) break; \
        if (cv_pick(u, J, KIN(23), 256, 1024, WSP(bf16_t, WS_WMIX + WM_UKV))) break; \
        cv_pick(u, J, KIN(29), 128, 1024, WSP(bf16_t, WS_WMIX + WM_G2)); } while (0)
    CV_RUN(16 * 65 + 24 * 16 + 6 * 12 + 4 * 16 + 2 * 16, PICK_CD);
#undef PICK_CD
}
PHASE_FN void phase_conv_moe(const KP& kp, unsigned char* lds, int l, int bid, int nb) {
#define PICK_MOE(u0, J) do { const int es = (u0) / 384; int uu = (u0) % 384; \
        const float* wg = es < 16 ? KIN(36) + ((size_t)l * 16 + es) * 1024 * 512 : KIN(39) + (size_t)l * 1024 * 512; \
        const float* wu = es < 16 ? KIN(37) + ((size_t)l * 16 + es) * 1024 * 512 : KIN(40) + (size_t)l * 1024 * 512; \
        const float* wd = es < 16 ? KIN(38) + ((size_t)l * 16 + es) * 512 * 1024 : KIN(41) + (size_t)l * 512 * 1024; \
        bf16_t* dup = (bf16_t*)(WSP(unsigned char, WS_BIG + MO_WUP) + (size_t)es * 1024 * 1024); bf16_t* ddn = (bf16_t*)(WSP(unsigned char, WS_BIG + MO_WDN) + (size_t)es * 1024 * 512); \
        if (cv_pick(uu, J, wg, 1024, 512, dup, 1, 1024, 1)) break; if (cv_pick(uu, J, wu, 1024, 512, dup, 2, 1024, 1)) break; cv_pick(uu, J, wd, 512, 1024, ddn, 0, 512, 1); } while (0)
    CV_RUN_ON(17 * 384, PICK_MOE, bid, nb);
#undef PICK_MOE
}

__device__ __forceinline__ const float* hrow_rd(const KP& kp, bool from_inputs, int b, int t) {
    if (t < CTXL) return (from_inputs ? KIN(2) : WSP(const float, WS_HC)) + ((size_t)b * CTXL + t) * D;
    return (from_inputs ? KIN(0) : KOUT) + ((size_t)b * SEQ + (t - CTXL)) * D;
}
__device__ __forceinline__ float* hrow_wr(const KP& kp, int b, int t) {
    if (t < CTXL) return WSP(float, WS_HC) + ((size_t)b * CTXL + t) * D;
    return KOUT + ((size_t)b * SEQ + (t - CTXL)) * D;
}

PHASE_FN void phase_u(const KP& kp, int layer, int g, int bid, int nb, bool to_v) {
    const int lane = otid() & 63, wid = __builtin_amdgcn_readfirstlane(otid() >> 6);
    const float* modv = WSP(const float, WS_MODV) + (size_t)layer * 17 * 6144;
    const float* ng = KIN(6) + (size_t)layer * 4 * 1024;
    bf16_t* U = to_v ? WSP(bf16_t, WS_V) + (size_t)RG * 1024 : WSP(bf16_t, WS_BIG + (layer == 0 ? L0_U : L1_U));
    for (int lr = bid * 8 + wid; lr < RG; lr += nb * 8) {
        const int bl = lr / TT, t = lr - bl * TT, b = g * BG + bl;
        const float* src = hrow_rd(kp, layer == 0, b, t);
        const float* mv = modv + (size_t)(t < CTXL ? 16 : b) * 6144;
        f32x4 x[4]; float ss = 0.f;
#pragma unroll
        for (int i = 0; i < 4; ++i) { x[i] = *(const f32x4*)(src + i * 256 + lane * 4); ss += x[i][0] * x[i][0] + x[i][1] * x[i][1] + x[i][2] * x[i][2] + x[i][3] * x[i][3]; }
        ss = wsum(ss); const float rstd = rsqrtf(ss * (1.0f / 1024.0f) + EPS);
#pragma unroll
        for (int i = 0; i < 4; ++i) { const int col = i * 256 + lane * 4;
            const f32x4 gv = *(const f32x4*)(ng + col), sc = *(const f32x4*)(mv + 1024 + col), sh = *(const f32x4*)(mv + col);
            st4bf(U + (size_t)lr * 1024 + col, x[i] * rstd * gv * (sc + 1.0f) + sh); }
    }
}

PHASE_FN void phase_r(const KP& kp, unsigned char* lds, int layer, int g) {
    const int tid = otid(), lane = tid & 63, wid = __builtin_amdgcn_readfirstlane(tid >> 6);
    float* rw = (float*)lds;
    int* se = (int*)(rw + 1024 * 16);
    int* sbase = se + 160;
    for (int i = tid; i < 1024 * 16; i += 512) rw[i] = KIN(34)[i];
    __syncthreads();
    const float* modv = WSP(const float, WS_MODV) + (size_t)layer * 17 * 6144;
    const float* ng = KIN(6) + (size_t)layer * 4 * 1024;
    const bf16_t* MIX = WSP(const bf16_t, WS_BIG + (layer == 0 ? L0_U : L1_U));
    bf16_t* V = WSP(bf16_t, WS_V);
    unsigned* cnt = WSP(unsigned, CTL_CNT) + layer * 16;
    int* TOKE = WSP(int, WS_TOKE); int* TOKP = WSP(int, WS_TOKP); float* TOKW = WSP(float, WS_TOKW); int* LIST = WSP(int, WS_LIST);
    const int nrows = layer == 0 ? RG : RGL, CH = layer == 0 ? 72 : 64, RW = CH >> 3, nchunks = nrows / CH;
    float rbias[16];
#pragma unroll
    for (int e = 0; e < 16; ++e) rbias[e] = KIN(35)[e];
    for (int ch = obid(); ch < nchunks; ch += gridDim.x) {
        for (int rr = 0; rr < RW; ++rr) {
            const int rl = wid * RW + rr, lr = ch * CH + rl;
            int b, t, tok;
            if (layer == 0) { const int bl = lr / TT; t = lr - bl * TT; b = g * BG + bl; tok = g * RG + lr; }
            else { const int bl = lr >> 11; t = CTXL + (lr & 2047); b = g * BG + bl; tok = g * RGL + lr; }
            const float* hsrc = hrow_rd(kp, layer == 0, b, t);
            float* hdst = hrow_wr(kp, b, t);
            const float* mv = modv + (size_t)(t < CTXL ? 16 : b) * 6144;
            f32x4 y[4], h[4]; float ss = 0.f;
#pragma unroll
            for (int i = 0; i < 4; ++i) { y[i] = ld4bf(MIX + (size_t)lr * 1024 + i * 256 + lane * 4); ss += y[i][0] * y[i][0] + y[i][1] * y[i][1] + y[i][2] * y[i][2] + y[i][3] * y[i][3]; }
            ss = wsum(ss); float rstd = rsqrtf(ss * (1.0f / 1024.0f) + EPS);
            float s2 = 0.f;
#pragma unroll
            for (int i = 0; i < 4; ++i) { const int col = i * 256 + lane * 4;
                const f32x4 g1 = *(const f32x4*)(ng + 1024 + col), ga = *(const f32x4*)(mv + 2048 + col), hx = *(const f32x4*)(hsrc + col);
                h[i] = hx + ga * (y[i] * rstd * g1);
                *(f32x4*)(hdst + col) = h[i];
                s2 += h[i][0] * h[i][0] + h[i][1] * h[i][1] + h[i][2] * h[i][2] + h[i][3] * h[i][3]; }
            s2 = wsum(s2); rstd = rsqrtf(s2 * (1.0f / 1024.0f) + EPS);
            float lg[16];
#pragma unroll
            for (int e = 0; e < 16; ++e) lg[e] = 0.f;
#pragma unroll
            for (int i = 0; i < 4; ++i) { const int col = i * 256 + lane * 4;
                const f32x4 g2 = *(const f32x4*)(ng + 2048 + col), scf = *(const f32x4*)(mv + 4096 + col), shf = *(const f32x4*)(mv + 3072 + col);
                const f32x4 v = h[i] * rstd * g2 * (scf + 1.0f) + shf;
                st4f8((unsigned char*)V + (size_t)tok * 2048 + col, v);
#pragma unroll
                for (int j = 0; j < 4; ++j) {
#pragma unroll
                    for (int q = 0; q < 4; ++q) { const f32x4 w4 = *(const f32x4*)(rw + (col + j) * 16 + q * 4);
                        lg[q * 4 + 0] += v[j] * w4[0]; lg[q * 4 + 1] += v[j] * w4[1]; lg[q * 4 + 2] += v[j] * w4[2]; lg[q * 4 + 3] += v[j] * w4[3]; } } }
#pragma unroll
            for (int e = 0; e < 16; ++e) lg[e] = wsum(lg[e]);
            float aff[16], sel[16];
#pragma unroll
            for (int e = 0; e < 16; ++e) { aff[e] = sigmoidf_(lg[e]); sel[e] = aff[e] + rbias[e]; }
            float gs[4];
#pragma unroll
            for (int gi = 0; gi < 4; ++gi) { const float a0 = sel[gi * 4], a1 = sel[gi * 4 + 1], a2 = sel[gi * 4 + 2], a3 = sel[gi * 4 + 3];
                gs[gi] = fmaxf(fmaxf(fmaxf(a0 + a1, a0 + a2), fmaxf(a0 + a3, a1 + a2)), fmaxf(a1 + a3, a2 + a3)); }
            int gidx = 0; float gb = gs[0];
#pragma unroll
            for (int gi = 1; gi < 4; ++gi) if (gs[gi] > gb) { gb = gs[gi]; gidx = gi; }
            float c[4], f[4];
#pragma unroll
            for (int i = 0; i < 4; ++i) { c[i] = gidx == 0 ? sel[i] : gidx == 1 ? sel[4 + i] : gidx == 2 ? sel[8 + i] : sel[12 + i];
                                           f[i] = gidx == 0 ? aff[i] : gidx == 1 ? aff[4 + i] : gidx == 2 ? aff[8 + i] : aff[12 + i]; }
            int i1 = 0; float cb = c[0];
#pragma unroll
            for (int i = 1; i < 4; ++i) if (c[i] > cb) { cb = c[i]; i1 = i; }
            int i2 = -1; float cb2 = 0.f;
#pragma unroll
            for (int i = 0; i < 4; ++i) if (i != i1 && (i2 < 0 || c[i] > cb2)) { cb2 = c[i]; i2 = i; }
            float w1 = i1 == 0 ? f[0] : i1 == 1 ? f[1] : i1 == 2 ? f[2] : f[3];
            float w2 = i2 == 0 ? f[0] : i2 == 1 ? f[1] : i2 == 2 ? f[2] : f[3];
            const float wsn = 1.0f / (w1 + w2); w1 *= wsn; w2 *= wsn;
            if (lane == 0) { se[rl * 2] = gidx * 4 + i1; se[rl * 2 + 1] = gidx * 4 + i2;
                TOKE[tok * 2] = gidx * 4 + i1; TOKE[tok * 2 + 1] = gidx * 4 + i2; TOKW[tok * 2] = w1; TOKW[tok * 2 + 1] = w2; }
        }
        __syncthreads();
        if (tid < 16) { int c2 = 0; for (int i = 0; i < 2 * CH; ++i) c2 += (se[i] == tid) ? 1 : 0; sbase[tid] = (int)atomicAdd(&cnt[tid], (unsigned)c2); }
        __syncthreads();
        if (tid < 2 * CH) { const int e = se[tid]; int rank = 0; for (int j = 0; j < tid; ++j) rank += (se[j] == e) ? 1 : 0;
            const int pos = sbase[e] + rank; const int lr = ch * CH + (tid >> 1); const int tok = (layer == 0 ? g * RG : g * RGL) + lr;
            LIST[(size_t)e * NTOK + pos] = tok; TOKP[tok * 2 + (tid & 1)] = pos; }
        __syncthreads();
    }
}

__device__ __forceinline__ int moe_tile_prefix(const unsigned* cnt, int ntok, int lane) {
    const int myt = lane < 16 ? (int)((cnt[lane & 15] + 255u) >> 8) : 0; int pref = myt;
#pragma unroll
    for (int o = 1; o < 16; o <<= 1) { const int t = __shfl_up(pref, o); if (lane >= o) pref += t; }
    return pref - myt + ntok / 256;
}
PHASE_FN void phase_moe_gather(const KP& kp, int layer) {
    const int lane = otid() & 63, wid = __builtin_amdgcn_readfirstlane(otid() >> 6);
    const int ntok = layer == 0 ? NTOK : NLAT;
    const int tpre = moe_tile_prefix(WSP(const unsigned, CTL_CNT) + layer * 16, ntok, lane);
    const bf16_t* V = WSP(const bf16_t, WS_V); bf16_t* XG = WSP(bf16_t, WS_BIG + MO_XG);
    const int* TOKE = WSP(const int, WS_TOKE); const int* TOKP = WSP(const int, WS_TOKP);
    for (int it = obid() * 8 + wid; it < 2 * ntok; it += gridDim.x * 8) {
        const int tok = it >> 1, e = TOKE[it], pos = TOKP[it];
        const size_t row = (size_t)(__shfl(tpre, e) - ntok / 256) * 256 + pos;
        const u32x4* src = (const u32x4*)(V + (size_t)tok * 1024) + lane; u32x4* dst = (u32x4*)(XG + row * 1024) + lane;
        dst[0] = src[0];
    }
}
PHASE_FN void phase_moe_gemm(const KP& kp, unsigned char* lds, int layer, bool down) {
    const int tid = otid();
    int* pre = (int*)(lds + pg8::STAGE_BYTES);
    int* slotmap = pre + 32;
    const int ntok = layer == 0 ? NTOK : NLAT;
    const unsigned* cnt = WSP(const unsigned, CTL_CNT) + layer * 16;
    if (tid == 0) { int p = ntok / 256; pre[0] = 0; pre[1] = p; for (int e = 0; e < 16; ++e) { p += ((int)cnt[e] + 255) >> 8; pre[2 + e] = p; } }
    __syncthreads();
    const int ntiles = pre[17];
    for (int t = tid; t < ntiles; t += 512) { int idx = 0; for (int e = 1; e < 17; ++e) if (pre[e] <= t) idx = e; slotmap[t] = idx == 0 ? 16 : idx - 1; }
    __syncthreads();
    pg8::MoeOrder S{slotmap, ntiles, (int)gridDim.x, obid()};
    if (!down) {
        pg8::Gemm g{WSP(const bf16_t, WS_V), WSP(const bf16_t, WS_BIG + MO_WUP), 0, 0, 512, WSP(const bf16_t, WS_BIG + MO_XG), ntok / 256, 1024, 0};
        pg8::EpiSwi E{WSP(bf16_t, WS_BIG + MO_HID)};
        pg8::gemm_phase<pg8::EpiSwi, pg8::MoeOrder, false, true>((PG8_LAS unsigned char*)lds, g, S, E, nullptr);
    } else {
        pg8::Gemm g{WSP(const bf16_t, WS_BIG + MO_HID), WSP(const bf16_t, WS_BIG + MO_WDN), 0, 0, 256, nullptr, 0x7fffffff, 512, 0};
        pg8::EpiBfG E{WSP(bf16_t, WS_BIG + MO_CON), 1024, 1024, 3, W8_INV};
        pg8::gemm_phase<pg8::EpiBfG, pg8::MoeOrder, false, true>((PG8_LAS unsigned char*)lds, g, S, E, nullptr);
    }
    __syncthreads();
}

PHASE_FN void phase_combine(const KP& kp, int layer) {
    const int lane = otid() & 63, wid = __builtin_amdgcn_readfirstlane(otid() >> 6);
    const int ntok = layer == 0 ? NTOK : NLAT;
    const unsigned* cnt = WSP(const unsigned, CTL_CNT) + layer * 16;
    const float* modv = WSP(const float, WS_MODV) + (size_t)layer * 17 * 6144;
    const float* ng = KIN(6) + (size_t)layer * 4 * 1024 + 3 * 1024;
    const bf16_t* CON = WSP(const bf16_t, WS_BIG + MO_CON);
    const int* TOKE = WSP(const int, WS_TOKE); const int* TOKP = WSP(const int, WS_TOKP); const float* TOKW = WSP(const float, WS_TOKW);
    const int tpre = moe_tile_prefix(cnt, ntok, lane);
    for (int tok0 = (obid() * 8 + wid) * 2; tok0 < ntok; tok0 += gridDim.x * 16) {
        int e1[2], e2[2], p1[2], p2[2]; float w1[2], w2[2];
#pragma unroll
        for (int u = 0; u < 2; ++u) { const int tok = tok0 + u; e1[u] = TOKE[tok * 2]; e2[u] = TOKE[tok * 2 + 1]; p1[u] = TOKP[tok * 2]; p2[u] = TOKP[tok * 2 + 1]; w1[u] = TOKW[tok * 2]; w2[u] = TOKW[tok * 2 + 1]; }
        f32x4 f[2][4], hx[2][4]; float* hp[2]; const float* mv[2];
#pragma unroll
        for (int u = 0; u < 2; ++u) { const int tok = tok0 + u;
            const size_t r1 = (size_t)__shfl(tpre, e1[u]) * 256 + p1[u], r2 = (size_t)__shfl(tpre, e2[u]) * 256 + p2[u];
            int b, t;
            if (layer == 0) { b = tok / TT; t = tok - b * TT; } else { b = tok >> 11; t = CTXL + (tok & 2047); }
            hp[u] = hrow_wr(kp, b, t); mv[u] = modv + (size_t)(t < CTXL ? 16 : b) * 6144 + 5 * 1024;
#pragma unroll
            for (int i = 0; i < 4; ++i) { const int col = i * 256 + lane * 4;
                f[u][i] = ld4bf(CON + (size_t)tok * 1024 + col) + ld4bf(CON + r1 * 1024 + col) * w1[u] + ld4bf(CON + r2 * 1024 + col) * w2[u];
                hx[u][i] = *(const f32x4*)(hp[u] + col); } }
#pragma unroll
        for (int u = 0; u < 2; ++u) { float ss = 0.f;
#pragma unroll
            for (int i = 0; i < 4; ++i) ss += f[u][i][0] * f[u][i][0] + f[u][i][1] * f[u][i][1] + f[u][i][2] * f[u][i][2] + f[u][i][3] * f[u][i][3];
            ss = wsum(ss); const float rstd = rsqrtf(ss * (1.0f / 1024.0f) + EPS);
            float s2 = 0.f;
#pragma unroll
            for (int i = 0; i < 4; ++i) { const int col = i * 256 + lane * 4;
                const f32x4 g3 = *(const f32x4*)(ng + col), gf = *(const f32x4*)(mv[u] + col);
                const f32x4 hn = hx[u][i] + gf * (f[u][i] * rstd * g3);
                *(f32x4*)(hp[u] + col) = hn; hx[u][i] = hn;
                s2 += hn[0] * hn[0] + hn[1] * hn[1] + hn[2] * hn[2] + hn[3] * hn[3]; }
            if (layer == 0) {
                s2 = wsum(s2); const float rs2 = rsqrtf(s2 * (1.0f / 1024.0f) + EPS);
                const float* mv1 = mv[u] - 5 * 1024 + 17 * 6144;
                const float* ng1 = KIN(6) + 4 * 1024;
                unsigned char* U1 = WSP(unsigned char, WS_V) + (size_t)(tok0 + u) * 2048;
#pragma unroll
                for (int i = 0; i < 4; ++i) { const int col = i * 256 + lane * 4;
                    const f32x4 gv = *(const f32x4*)(ng1 + col), sc = *(const f32x4*)(mv1 + 1024 + col), sh = *(const f32x4*)(mv1 + col);
                    st4f8(U1 + col, hx[u][i] * rs2 * gv * (sc + 1.0f) + sh); } } }
    }
}

template <int CH>
__device__ __forceinline__ int scan_t(int dir, int ci, int j) {
    constexpr int NC_CTX = CTXL / CH;
    if (!dir) return ci * CH + j;
    return ci < NC_CTX ? (CTXL - 1 - ci * CH - j) : (TT - 1 - (ci - NC_CTX) * CH - j);
}

constexpr int ML_LQ = 136, ML_LT = 72, ML_VR = 144;
PHASE_FN void mlstm_unit(const KP& kp, unsigned char* lds, int bl, int h, int dir, int vh) {
    const int tid = otid();
    bf16_t* Qs = (bf16_t*)lds;
    bf16_t* Ks = Qs + 64 * ML_LQ;
    bf16_t* KTE = Ks + 64 * ML_LQ;
    bf16_t* VT = KTE + 128 * ML_LT;
    bf16_t* Ps = VT + ML_VR * ML_LT;
    bf16_t* Cb = Ps + 64 * ML_LT;
    float* fs = (float*)(Cb + ML_VR * ML_LQ);
    float* s_rowv = fs;
    float* s_colv = fs + 64;
    float* s_wint = fs + 128;
    float* s_emj = fs + 192;
    float* s_E = fs + 256;
    float* s_den = fs + 320;
    float* s_misc = fs + 384;
    const bf16_t* P = WSP(const bf16_t, WS_BIG + L0_P);
    bf16_t* HOUT = WSP(bf16_t, WS_BIG + (dir ? L0_HB : L0_AO)); const int ldh = dir ? 1024 : 2048;
    const float ibias = KIN(9)[dir * 4 + h], fbias = KIN(10)[dir * 4 + h];
    for (int i = tid; i < ML_VR * ML_LQ; i += 512) Cb[i] = 0;
    for (int i = tid; i < 16 * ML_LT; i += 512) VT[128 * ML_LT + i] = (i < ML_LT) ? (bf16_t)0x3f80 : (bf16_t)0;
    f32x4 Cacc[8], Nacc;
#pragma unroll
    for (int i = 0; i < 8; ++i) Cacc[i] = (f32x4){0.f, 0.f, 0.f, 0.f};
    Nacc = (f32x4){0.f, 0.f, 0.f, 0.f};
    float m_state = 0.f;
    u32x4 pq[2], pk[2], pv[2]; bf16_t pgi = 0, pgf = 0;
#define ML_REQ(ci_) do { _Pragma("unroll") for (int i = 0; i < 2; ++i) { const int p = tid + i * 512, j = p >> 4, c8 = p & 15; \
            const bf16_t* pr = P + ((size_t)bl * TT + scan_t<64>(dir, (ci_), j)) * AB_N; \
            pq[i] = *(const u32x4*)(pr + AB_Q + h * 128 + c8 * 8); pk[i] = *(const u32x4*)(pr + AB_K + h * 128 + c8 * 8); \
            const int jv = tid & 63, cv = (tid >> 6) + i * 8; \
            pv[i] = *(const u32x4*)(P + ((size_t)bl * TT + scan_t<64>(dir, (ci_), jv)) * AB_N + AB_V + h * 256 + vh * 128 + cv * 8); } \
        if (tid < 64) { const bf16_t* pg = P + ((size_t)bl * TT + scan_t<64>(dir, (ci_), tid)) * AB_N; pgi = pg[AB_IG + dir * 4 + h]; pgf = pg[AB_FG + dir * 4 + h]; } } while (0)
    ML_REQ(0);
    lds_barrier();
    for (int ci = 0; ci < TT / 64; ++ci) {
        int tq = tid; asm volatile("" : "+v"(tq));
        const int lane = tq & 63, wid = __builtin_amdgcn_readfirstlane(tq >> 6), fr = lane & 15, fq = lane >> 4;
#pragma unroll
        for (int i = 0; i < 2; ++i) {
            const int p = tq + i * 512, j = p >> 4, c8 = p & 15;
            u32x4 q = pq[i];
            const float qs = 0.08838834764831845f;
            q.x = pack2(lo2f(q.x) * qs, hi2f(q.x) * qs); q.y = pack2(lo2f(q.y) * qs, hi2f(q.y) * qs);
            q.z = pack2(lo2f(q.z) * qs, hi2f(q.z) * qs); q.w = pack2(lo2f(q.w) * qs, hi2f(q.w) * qs);
            *(u32x4*)(Qs + j * ML_LQ + c8 * 8) = q;
            *(u32x4*)(Ks + j * ML_LQ + c8 * 8) = pk[i];
            const u32x4 v = pv[i];
            bf16_t* vt = VT + (((tq >> 6) + i * 8) * 8) * ML_LT + (tq & 63);
            vt[0 * ML_LT] = (bf16_t)(v.x & 0xffff); vt[1 * ML_LT] = (bf16_t)(v.x >> 16); vt[2 * ML_LT] = (bf16_t)(v.y & 0xffff); vt[3 * ML_LT] = (bf16_t)(v.y >> 16);
            vt[4 * ML_LT] = (bf16_t)(v.z & 0xffff); vt[5 * ML_LT] = (bf16_t)(v.z >> 16); vt[6 * ML_LT] = (bf16_t)(v.w & 0xffff); vt[7 * ML_LT] = (bf16_t)(v.w >> 16);
        }
        if (wid == 0) {
            const float ig = bf2f(pgi) + ibias;
            const float lf = logsigmoidf_(bf2f(pgf) + fbias);
            const float b = wscan_add(lf);
            const float u = ig - b; const float pm = wscan_max(u);
            const float mj = fmaxf(b + m_state, b + pm);
            const float b63 = lane63(b), pm63 = lane63(pm);
            const float mnew = fmaxf(b63 + m_state, b63 + pm63);
            s_rowv[lane] = b - mj; s_colv[lane] = u; s_wint[lane] = __expf(b + m_state - mj); s_emj[lane] = __expf(-mj);
            s_E[lane] = __expf(b63 + u - mnew);
            if (lane == 0) { s_misc[0] = mnew; s_misc[1] = __expf(b63 + m_state - mnew); }
        }
        if (ci + 1 < TT / 64) ML_REQ(ci + 1);
        lds_barrier();
        {
            const int jt = wid >> 1;
#pragma unroll
            for (int q2 = 0; q2 < 2; ++q2) {
                const int st = (wid & 1) * 2 + q2;
                f32x4 acc = (f32x4){0.f, 0.f, 0.f, 0.f};
                if (st <= jt) {
                    bf16x8 fa[4], fb[4];
#pragma unroll
                    for (int k = 0; k < 4; ++k) { fa[k] = ldfrag(Qs, ML_LQ, jt * 16, k * 32, fr, fq); fb[k] = ldfrag(Ks, ML_LQ, st * 16, k * 32, fr, fq); }
                    __builtin_amdgcn_sched_barrier(0);
                    f32x4 acc2 = (f32x4){0.f, 0.f, 0.f, 0.f};
                    acc = mma16(fa[0], fb[0], acc); acc2 = mma16(fa[1], fb[1], acc2); acc = mma16(fa[2], fb[2], acc); acc2 = mma16(fa[3], fb[3], acc2);
                    acc = acc + acc2;
                }
                const int s = st * 16 + fr; const float cv = s_colv[s];
#pragma unroll
                for (int r = 0; r < 4; ++r) { const int j = jt * 16 + fq * 4 + r;
                    const float pv2 = (s <= j) ? acc[r] * __expf(s_rowv[j] + cv) : 0.f;
                    Ps[j * ML_LT + s] = f2bf(pv2); }
            }
#pragma unroll
            for (int i = 0; i < 2; ++i) {
                const int s = lane, c8 = wid + i * 8; const float e = s_E[s];
                const u32x4 kv = *(const u32x4*)(Ks + s * ML_LQ + c8 * 8);
                bf16_t* kt = KTE + (c8 * 8) * ML_LT + s;
                kt[0 * ML_LT] = f2bf(lo2f(kv.x) * e); kt[1 * ML_LT] = f2bf(hi2f(kv.x) * e); kt[2 * ML_LT] = f2bf(lo2f(kv.y) * e); kt[3 * ML_LT] = f2bf(hi2f(kv.y) * e);
                kt[4 * ML_LT] = f2bf(lo2f(kv.z) * e); kt[5 * ML_LT] = f2bf(hi2f(kv.z) * e); kt[6 * ML_LT] = f2bf(lo2f(kv.w) * e); kt[7 * ML_LT] = f2bf(hi2f(kv.w) * e);
            }
        }
        lds_barrier();
        f32x4 a1[4], a2[4];
        {
            const int jt = wid >> 1;
            bf16x8 fp[2], fqq[4];
#pragma unroll
            for (int k = 0; k < 2; ++k) fp[k] = ldfrag(Ps, ML_LT, jt * 16, k * 32, fr, fq);
#pragma unroll
            for (int k = 0; k < 4; ++k) fqq[k] = ldfrag(Qs, ML_LQ, jt * 16, k * 32, fr, fq);
            {
                bf16x8 fv[4][2];
#pragma unroll
                for (int q4 = 0; q4 < 4; ++q4)
#pragma unroll
                    for (int k = 0; k < 2; ++k) fv[q4][k] = ldfrag(VT, ML_LT, ((wid & 1) * 4 + q4) * 16, k * 32, fr, fq);
                __builtin_amdgcn_sched_barrier(0);
#pragma unroll
                for (int q4 = 0; q4 < 4; ++q4) a1[q4] = (f32x4){0.f, 0.f, 0.f, 0.f};
#pragma unroll
                for (int k = 0; k < 2; ++k)
#pragma unroll
                    for (int q4 = 0; q4 < 4; ++q4) a1[q4] = mma16(fv[q4][k], fp[k], a1[q4]);
            }
#pragma unroll
            for (int hh = 0; hh < 2; ++hh) {
                bf16x8 fc[2][4];
#pragma unroll
                for (int q2 = 0; q2 < 2; ++q2)
#pragma unroll
                    for (int k = 0; k < 4; ++k) fc[q2][k] = ldfrag(Cb, ML_LQ, ((wid & 1) * 4 + hh * 2 + q2) * 16, k * 32, fr, fq);
                __builtin_amdgcn_sched_barrier(0);
                a2[hh * 2] = (f32x4){0.f, 0.f, 0.f, 0.f}; a2[hh * 2 + 1] = (f32x4){0.f, 0.f, 0.f, 0.f};
#pragma unroll
                for (int k = 0; k < 4; ++k) { a2[hh * 2] = mma16(fc[0][k], fqq[k], a2[hh * 2]); a2[hh * 2 + 1] = mma16(fc[1][k], fqq[k], a2[hh * 2 + 1]); }
            }
            if (wid & 1) {
                f32x4 d1 = (f32x4){0.f, 0.f, 0.f, 0.f}, d2 = (f32x4){0.f, 0.f, 0.f, 0.f};
                bf16x8 fo[2], fn[4];
#pragma unroll
                for (int k = 0; k < 2; ++k) fo[k] = ldfrag(VT, ML_LT, 128, k * 32, fr, fq);
#pragma unroll
                for (int k = 0; k < 4; ++k) fn[k] = ldfrag(Cb, ML_LQ, 128, k * 32, fr, fq);
                __builtin_amdgcn_sched_barrier(0);
                d1 = mma16(fo[0], fp[0], d1); d2 = mma16(fn[0], fqq[0], d2); d1 = mma16(fo[1], fp[1], d1); d2 = mma16(fn[1], fqq[1], d2);
                d2 = mma16(fn[2], fqq[2], d2); d2 = mma16(fn[3], fqq[3], d2);
                if (fq == 0) { const int j = jt * 16 + fr; s_den[j] = fmaxf(fabsf(d1[0] + s_wint[j] * d2[0]), s_emj[j]); }
            }
        }
        lds_barrier();
        {
            const int jt = wid >> 1, j = jt * 16 + fr;
            const float wi = s_wint[j], rden = frcp_(s_den[j]);
            const size_t row = (size_t)bl * TT + scan_t<64>(dir, ci, j);
#pragma unroll
            for (int q4 = 0; q4 < 4; ++q4) { const int v0 = ((wid & 1) * 4 + q4) * 16 + fq * 4;
                st4bf(HOUT + row * ldh + h * 256 + vh * 128 + v0, (a1[q4] + a2[q4] * wi) * rden); }
        }
        {
            const float dec = s_misc[1];
            const bf16x8 bv0 = ldfrag(VT, ML_LT, wid * 16, 0, fr, fq), bv1 = ldfrag(VT, ML_LT, wid * 16, 32, fr, fq);
#pragma unroll
            for (int hh = 0; hh < 2; ++hh) {
                bf16x8 fk[4][2];
#pragma unroll
                for (int q = 0; q < 4; ++q) { fk[q][0] = ldfrag(KTE, ML_LT, (hh * 4 + q) * 16, 0, fr, fq); fk[q][1] = ldfrag(KTE, ML_LT, (hh * 4 + q) * 16, 32, fr, fq); }
                __builtin_amdgcn_sched_barrier(0);
#pragma unroll
                for (int q = 0; q < 4; ++q) Cacc[hh * 4 + q] = Cacc[hh * 4 + q] * dec;
#pragma unroll
                for (int q = 0; q < 4; ++q) Cacc[hh * 4 + q] = mma16(fk[q][0], bv0, Cacc[hh * 4 + q]);
#pragma unroll
                for (int q = 0; q < 4; ++q) Cacc[hh * 4 + q] = mma16(fk[q][1], bv1, Cacc[hh * 4 + q]);
#pragma unroll
                for (int q = 0; q < 4; ++q) st4bf(Cb + (wid * 16 + fr) * ML_LQ + (hh * 4 + q) * 16 + fq * 4, Cacc[hh * 4 + q]);
            }
            Nacc = Nacc * dec;
            Nacc = mma16(ldfrag(KTE, ML_LT, wid * 16, 0, fr, fq), ldfrag(VT, ML_LT, 128, 0, fr, fq), Nacc);
            Nacc = mma16(ldfrag(KTE, ML_LT, wid * 16, 32, fr, fq), ldfrag(VT, ML_LT, 128, 32, fr, fq), Nacc);
            st4bf(Cb + (128 + fr) * ML_LQ + wid * 16 + fq * 4, Nacc);
            m_state = s_misc[0];
        }
        lds_barrier();
    }
#undef ML_REQ
}

constexpr size_t L0_XC = L0_U;
static_assert(L0_XC + (size_t)RG * 1280 * 2 <= BIG_BYTES, "xconv buffer");
PHASE_FN void phase_xconv(const KP& kp) {
    const int lane = otid() & 63, wid = __builtin_amdgcn_readfirstlane(otid() >> 6);
    const bf16_t* P = WSP(const bf16_t, WS_BIG + L0_P); bf16_t* XC = WSP(bf16_t, WS_BIG + L0_XC);
    const float* cw = KIN(12); const float* cb = KIN(13);
    constexpr int RUN = 9;
    for (int run = obid() * 8 + wid; run < RG / RUN; run += gridDim.x * 8) {
        const int r0 = run * RUN;
#pragma unroll
        for (int i = 0; i < 5; ++i) { const int col = i * 256 + lane * 4;
            const f32x4 bias = *(const f32x4*)(cb + col);
            f32x4 w[5], x[5];
#pragma unroll
            for (int q = 0; q < 5; ++q) w[q] = *(const f32x4*)(cw + q * 1280 + col);
#pragma unroll
            for (int q = 0; q < 4; ++q) { const int rr = r0 - 2 + q; x[q + 1] = (rr >= 0 && rr < RG) ? ld4bf(P + (size_t)rr * AB_N + AB_XBC + col) : (f32x4){0.f, 0.f, 0.f, 0.f}; }
#pragma unroll
            for (int k = 0; k < RUN; ++k) {
                const int lr = r0 + k, bl = lr / TT, t = lr - bl * TT, lo = t < CTXL ? 0 : CTXL, hi = t < CTXL ? CTXL : TT;
#pragma unroll
                for (int q = 0; q < 4; ++q) x[q] = x[q + 1];
                { const int rr = lr + 2; x[4] = (rr < RG) ? ld4bf(P + (size_t)rr * AB_N + AB_XBC + col) : (f32x4){0.f, 0.f, 0.f, 0.f}; }
                f32x4 a = bias;
#pragma unroll
                for (int q = 0; q < 5; ++q) { const int tt = t - 2 + q; if (tt >= lo && tt < hi) a += w[q] * x[q]; }
                f32x4 o;
#pragma unroll
                for (int r = 0; r < 4; ++r) o[r] = siluf_(a[r]);
                st4bf(XC + (size_t)lr * 1280 + col, o);
            }
        }
    }
}

constexpr int SS_LT = 72, SS_LX = 136;
PHASE_FN void ssd_unit(const KP& kp, unsigned char* lds, int bl, int dir, int hp) {
    const int tid = otid();
    const int gi = hp >> 2, hh0 = hp * 2;
    bf16_t* Wm = (bf16_t*)lds;
    bf16_t* CM = Wm + 2 * 64 * SS_LT;
    bf16_t* BM = CM + 64 * SS_LT;
    bf16_t* Xn = BM + 64 * SS_LT;
    bf16_t* XT = Xn + 64 * SS_LX;
    bf16_t* BTE = XT + 2 * 64 * SS_LT;
    bf16_t* Sb = BTE + 2 * 64 * SS_LT;
    float* fs = (float*)(Sb + 2 * 64 * SS_LT);
    float* s_b = fs;
    float* s_dt = fs + 128;
    float* s_e = fs + 256;
    float* s_misc = fs + 384;
    const bf16_t* P = WSP(const bf16_t, WS_BIG + L0_P); const bf16_t* XC = WSP(const bf16_t, WS_BIG + L0_XC);
    bf16_t* YOUT = WSP(bf16_t, WS_BIG + (dir ? L0_YB : L0_AO + 2048)); const int ldy = dir ? 1024 : 2048;
    for (int i = tid; i < 2 * 64 * SS_LT; i += 512) Sb[i] = 0;
    f32x4 Sacc[4];
#pragma unroll
    for (int i = 0; i < 4; ++i) Sacc[i] = (f32x4){0.f, 0.f, 0.f, 0.f};
    const float dtb = KIN(14)[dir * 16 + hh0 + ((tid >> 6) & 1)], aexp = __expf(KIN(15)[dir * 16 + hh0 + ((tid >> 6) & 1)]);
    const float dskip = KIN(16)[hh0 + (tid >> 8)];
    u32x4 pr[4]; bf16_t pdt = 0;
#define SS_REQ(ci_) do { _Pragma("unroll") for (int q = 0; q < 4; ++q) { const int p = tid + q * 512, j = p >> 5, c8 = p & 31; \
            const int col = c8 < 16 ? hh0 * 64 + c8 * 8 : (c8 < 24 ? 1024 + gi * 64 + (c8 - 16) * 8 : 1152 + gi * 64 + (c8 - 24) * 8); \
            pr[q] = *(const u32x4*)(XC + ((size_t)bl * TT + scan_t<64>(dir, (ci_), j)) * 1280 + col); } \
        if (tid < 128) pdt = P[((size_t)bl * TT + scan_t<64>(dir, (ci_), tid & 63)) * AB_N + AB_DT + dir * 16 + hh0 + (tid >> 6)]; } while (0)
    SS_REQ(0);
    lds_barrier();
    for (int ci = 0; ci < TT / 64; ++ci) {
        int tq = tid; asm volatile("" : "+v"(tq));
        const int lane = tq & 63, wid = __builtin_amdgcn_readfirstlane(tq >> 6), fr = lane & 15, fq = lane >> 4, hl_w = wid >> 2;
#pragma unroll
        for (int q = 0; q < 4; ++q) { const int p = tq + q * 512, j = p >> 5, c8 = p & 31;
            bf16_t* dst = c8 < 16 ? Xn + j * SS_LX + c8 * 8 : (c8 < 24 ? BM + j * SS_LT + (c8 - 16) * 8 : CM + j * SS_LT + (c8 - 24) * 8);
            *(u32x4*)dst = pr[q]; }
        if (wid < 2) {
            const float dt = softplusf_(bf2f(pdt) + dtb);
            const float b = wscan_add(-dt * aexp);
            const float b63 = lane63(b);
            s_b[wid * 64 + lane] = b; s_dt[wid * 64 + lane] = dt; s_e[wid * 64 + lane] = __expf(b63 - b) * dt;
            if (lane == 0) s_misc[wid] = __expf(b63);
        }
        if (ci + 1 < TT / 64) SS_REQ(ci + 1);
        lds_barrier();
        {
            const int jt = wid >> 1;
#pragma unroll
            for (int q2 = 0; q2 < 2; ++q2) {
                const int st = (wid & 1) * 2 + q2;
                f32x4 acc = (f32x4){0.f, 0.f, 0.f, 0.f};
                if (st <= jt) {
                    const bf16x8 c0 = ldfrag(CM, SS_LT, jt * 16, 0, fr, fq), c1 = ldfrag(CM, SS_LT, jt * 16, 32, fr, fq), b0 = ldfrag(BM, SS_LT, st * 16, 0, fr, fq), b1 = ldfrag(BM, SS_LT, st * 16, 32, fr, fq);
                    __builtin_amdgcn_sched_barrier(0);
                    acc = mma16(c0, b0, acc); acc = mma16(c1, b1, acc);
                }
                const int s = st * 16 + fr;
#pragma unroll
                for (int hl = 0; hl < 2; ++hl) { const float bs = s_b[hl * 64 + s], ds = s_dt[hl * 64 + s];
#pragma unroll
                    for (int r = 0; r < 4; ++r) { const int j = jt * 16 + fq * 4 + r;
                        const float wv = (s <= j) ? acc[r] * __expf(s_b[hl * 64 + j] - bs) * ds : 0.f;
                        Wm[(hl * 64 + j) * SS_LT + s] = f2bf(wv); } }
            }
            {
                const int s = lane, n8 = wid;
                const u32x4 bv = *(const u32x4*)(BM + s * SS_LT + n8 * 8);
#pragma unroll
                for (int hl = 0; hl < 2; ++hl) { const float e = s_e[hl * 64 + s];
                    bf16_t* bt = BTE + (hl * 64 + n8 * 8) * SS_LT + s;
                    bt[0 * SS_LT] = f2bf(lo2f(bv.x) * e); bt[1 * SS_LT] = f2bf(hi2f(bv.x) * e); bt[2 * SS_LT] = f2bf(lo2f(bv.y) * e); bt[3 * SS_LT] = f2bf(hi2f(bv.y) * e);
                    bt[4 * SS_LT] = f2bf(lo2f(bv.z) * e); bt[5 * SS_LT] = f2bf(hi2f(bv.z) * e); bt[6 * SS_LT] = f2bf(lo2f(bv.w) * e); bt[7 * SS_LT] = f2bf(hi2f(bv.w) * e); }
#pragma unroll
                for (int i = 0; i < 2; ++i) { const int c8 = wid + i * 8;
                    const u32x4 xv = *(const u32x4*)(Xn + s * SS_LX + c8 * 8);
                    bf16_t* xt = XT + (c8 * 8) * SS_LT + s;
                    xt[0 * SS_LT] = (bf16_t)(xv.x & 0xffff); xt[1 * SS_LT] = (bf16_t)(xv.x >> 16); xt[2 * SS_LT] = (bf16_t)(xv.y & 0xffff); xt[3 * SS_LT] = (bf16_t)(xv.y >> 16);
                    xt[4 * SS_LT] = (bf16_t)(xv.z & 0xffff); xt[5 * SS_LT] = (bf16_t)(xv.z >> 16); xt[6 * SS_LT] = (bf16_t)(xv.w & 0xffff); xt[7 * SS_LT] = (bf16_t)(xv.w >> 16); }
            }
        }
        lds_barrier();
        {
            const int hl = hl_w, jt = wid & 3, j = jt * 16 + fr;
            const bf16_t* Wh = Wm + hl * 64 * SS_LT; const bf16_t* Xh = XT + hl * 64 * SS_LT; const bf16_t* Sh = Sb + hl * 64 * SS_LT;
            const float eb = __expf(s_b[hl * 64 + j]);
            const size_t row = (size_t)bl * TT + scan_t<64>(dir, ci, j);
            const bf16x8 w0 = ldfrag(Wh, SS_LT, jt * 16, 0, fr, fq), w1 = ldfrag(Wh, SS_LT, jt * 16, 32, fr, fq), m0 = ldfrag(CM, SS_LT, jt * 16, 0, fr, fq), m1 = ldfrag(CM, SS_LT, jt * 16, 32, fr, fq);
#pragma unroll
            for (int hh = 0; hh < 2; ++hh) {
                bf16x8 fx[2][2], fs2[2][2];
#pragma unroll
                for (int q = 0; q < 2; ++q)
#pragma unroll
                    for (int k = 0; k < 2; ++k) { fx[q][k] = ldfrag(Xh, SS_LT, (hh * 2 + q) * 16, k * 32, fr, fq); fs2[q][k] = ldfrag(Sh, SS_LT, (hh * 2 + q) * 16, k * 32, fr, fq); }
                f32x4 dx[2];
                if (!dir) { dx[0] = ld4bf(Xn + j * SS_LX + hl * 64 + (hh * 2) * 16 + fq * 4); dx[1] = ld4bf(Xn + j * SS_LX + hl * 64 + (hh * 2 + 1) * 16 + fq * 4); }
                __builtin_amdgcn_sched_barrier(0);
                f32x4 y1[2], y2[2];
#pragma unroll
                for (int q = 0; q < 2; ++q) { y1[q] = (f32x4){0.f, 0.f, 0.f, 0.f}; y2[q] = (f32x4){0.f, 0.f, 0.f, 0.f}; }
#pragma unroll
                for (int q = 0; q < 2; ++q) { y1[q] = mma16(fx[q][0], w0, y1[q]); y2[q] = mma16(fs2[q][0], m0, y2[q]); }
#pragma unroll
                for (int q = 0; q < 2; ++q) { y1[q] = mma16(fx[q][1], w1, y1[q]); y2[q] = mma16(fs2[q][1], m1, y2[q]); }
#pragma unroll
                for (int q = 0; q < 2; ++q) { f32x4 y = y1[q] + y2[q] * eb;
                    if (!dir) y = y + dx[q] * dskip;
                    st4bf(YOUT + row * ldy + (hh0 + hl) * 64 + (hh * 2 + q) * 16 + fq * 4, y); }
            }
        }
        lds_barrier();
        {
            const int hl = hl_w, pt = wid & 3; const float eb63 = s_misc[hl];
            const bf16_t* Xh = XT + hl * 64 * SS_LT; const bf16_t* Bh = BTE + hl * 64 * SS_LT; bf16_t* Sh = Sb + hl * 64 * SS_LT;
            const bf16x8 x0 = ldfrag(Xh, SS_LT, pt * 16, 0, fr, fq), x1 = ldfrag(Xh, SS_LT, pt * 16, 32, fr, fq);
            bf16x8 fb[4][2];
#pragma unroll
            for (int nt = 0; nt < 4; ++nt) { fb[nt][0] = ldfrag(Bh, SS_LT, nt * 16, 0, fr, fq); fb[nt][1] = ldfrag(Bh, SS_LT, nt * 16, 32, fr, fq); }
            __builtin_amdgcn_sched_barrier(0);
#pragma unroll
            for (int nt = 0; nt < 4; ++nt) Sacc[nt] = Sacc[nt] * eb63;
#pragma unroll
            for (int nt = 0; nt < 4; ++nt) Sacc[nt] = mma16(fb[nt][0], x0, Sacc[nt]);
#pragma unroll
            for (int nt = 0; nt < 4; ++nt) Sacc[nt] = mma16(fb[nt][1], x1, Sacc[nt]);
#pragma unroll
            for (int nt = 0; nt < 4; ++nt) st4bf(Sh + (pt * 16 + fr) * SS_LT + nt * 16 + fq * 4, Sacc[nt]);
        }
        lds_barrier();
    }
#undef SS_REQ
}

__device__ __forceinline__ void phase_scan_ab(const KP& kp, unsigned char* lds) {
    for (int rep = 0; rep < ((PROBE_DUP & 8192) ? 2 : 1); ++rep)
    for (int u = obid(); u < 256; u += gridDim.x) if (u < 128) { mlstm_unit(kp, lds, u >> 4, (u >> 2) & 3, (u >> 1) & 1, u & 1); __syncthreads(); }
    for (int rep = 0; rep < ((PROBE_DUP & 16384) ? 2 : 1); ++rep)
    for (int u = obid(); u < 256; u += gridDim.x) if (u >= 128) { const int v = u - 128; ssd_unit(kp, lds, v >> 4, (v >> 3) & 1, v & 7); __syncthreads(); }
}

PHASE_FN void phase_fin_ab(const KP& kp) {
    const int lane = otid() & 63, wid = __builtin_amdgcn_readfirstlane(otid() >> 6);
    const bf16_t* P = WSP(const bf16_t, WS_BIG + L0_P);
    bf16_t* AO = WSP(bf16_t, WS_BIG + L0_AO); const bf16_t* HB = WSP(const bf16_t, WS_BIG + L0_HB); const bf16_t* YB = WSP(const bf16_t, WS_BIG + L0_YB);
    const float* mln = KIN(11); const float* sn = KIN(17);
    for (int lr = obid() * 8 + wid; lr < RG; lr += gridDim.x * 8) {
        const bf16_t* pr = P + (size_t)lr * AB_N;
        f32x4 yz[4]; float ss2 = 0.f;
#pragma unroll
        for (int i = 0; i < 4; ++i) { const int col = i * 256 + lane * 4;
            const f32x4 hs = ld4bf(AO + (size_t)lr * 2048 + col) + ld4bf(HB + (size_t)lr * 1024 + col);
            float ss = hs[0] * hs[0] + hs[1] * hs[1] + hs[2] * hs[2] + hs[3] * hs[3];
            ss = wsum(ss); const float rstd = rsqrtf(ss * (1.0f / 256.0f) + EPS);
            const f32x4 og = ld4bf(pr + AB_OG + col), w = *(const f32x4*)(mln + col);
            f32x4 o;
#pragma unroll
            for (int r = 0; r < 4; ++r) o[r] = hs[r] * rstd * w[r] * sigmoidf_(og[r]);
            st4bf(AO + (size_t)lr * 2048 + col, o);
            const f32x4 ys = ld4bf(AO + (size_t)lr * 2048 + 1024 + col) + ld4bf(YB + (size_t)lr * 1024 + col), z = ld4bf(pr + AB_Z + col);
#pragma unroll
            for (int r = 0; r < 4; ++r) { yz[i][r] = ys[r] * siluf_(z[r]); ss2 += yz[i][r] * yz[i][r]; }
        }
        ss2 = wsum(ss2); const float rstd2 = rsqrtf(ss2 * (1.0f / 1024.0f) + EPS);
#pragma unroll
        for (int i = 0; i < 4; ++i) { const int col = i * 256 + lane * 4; st4bf(AO + (size_t)lr * 2048 + 1024 + col, yz[i] * rstd2 * *(const f32x4*)(sn + col)); }
    }
}

PHASE_FN void phase_gemm_in(const KP& kp, unsigned char* lds, int layer, int grp) {
    const int npad = layer == 0 ? AB_NPAD : CD_NPAD, n = layer == 0 ? AB_N : CD_N;
    pg8::StaticOrder S; S.init(RG, npad, (int)gridDim.x, obid());
    if (layer == 0) {
        pg8::Gemm g{grp == 0 ? WSP(const bf16_t, WS_BIG + L0_U) : WSP(const bf16_t, WS_V) + (size_t)grp * RG * 1024, WSP(const bf16_t, WS_WMIX), RG, npad, 1024, nullptr, 0x7fffffff};
        pg8::EpiBfG E{WSP(bf16_t, WS_BIG), n, n, 0x7fffffff, 1.0f};
        pg8::gemm_phase<pg8::EpiBfG, pg8::StaticOrder, false>((PG8_LAS unsigned char*)lds, g, S, E, nullptr);
    } else {
        pg8::Gemm g{WSP(const bf16_t, WS_V) + (size_t)grp * RG * 1024, WSP(const bf16_t, WS_WMIX), RG, npad, 512, nullptr, 0x7fffffff, 1024, 0};
        pg8::EpiBfG E{WSP(bf16_t, WS_BIG), n, n, 0x7fffffff, W8_INV};
        pg8::gemm_phase<pg8::EpiBfG, pg8::StaticOrder, false, true>((PG8_LAS unsigned char*)lds, g, S, E, nullptr);
    }
    __syncthreads();
}
PHASE_FN void phase_gemm_out_ab(const KP& kp, unsigned char* lds, int grp) {
    pg8::Gemm g{WSP(const bf16_t, WS_BIG + L0_AO), WSP(const bf16_t, WS_WMIX + WM_AB_OUT), RG, 1024, 2048, nullptr, 0x7fffffff};
    pg8::StaticOrder S; S.init(RG, 1024, (int)gridDim.x, obid());
    pg8::EpiBfG E{WSP(bf16_t, WS_BIG + L0_U), 1024, 1024, 0x7fffffff, 1.0f};
    pg8::gemm_phase<pg8::EpiBfG, pg8::StaticOrder, false>((PG8_LAS unsigned char*)lds, g, S, E, nullptr);
    __syncthreads();
    const int G = (int)gridDim.x, units = (RG / 256) * 4, two = units > G ? (units - G < G ? units - G : G) : 0;
    const int nb = G - two > 0 ? G - two : G, bid = G - two > 0 ? obid() - two : obid();
    if (bid >= 0) { if (grp == 0) phase_u(kp, 0, 1, bid, nb, true); else phase_conv_moe(kp, lds, 0, bid, nb); }
    __syncthreads();
}

PHASE_FN void phase_prep_cd(const KP& kp) {
    const int lane = otid() & 63, wid = __builtin_amdgcn_readfirstlane(otid() >> 6);
    bf16_t* P = WSP(bf16_t, WS_BIG + L1_P);
    bf16_t* SG = WSP(bf16_t, WS_SG);
    const float* qn = KIN(20); const float* kvn = KIN(22); const float* mu = KIN(24);
    for (int lr = obid() * 8 + wid; lr < RG; lr += gridDim.x * 8) {
        const int bl = lr / TT, t = lr - bl * TT;
        bf16_t* pr = P + (size_t)lr * CD_N;
        {
            const f32x4 x = ld4bf(pr + CD_M1 + lane * 4);
            float ss = x[0] * x[0] + x[1] * x[1] + x[2] * x[2] + x[3] * x[3]; ss = wsum(ss);
            const float rstd = rsqrtf(ss * (1.0f / 256.0f) + EPS);
            st4bf(pr + CD_M1 + lane * 4, x * rstd * *(const f32x4*)(kvn + lane * 4));
        }
        {
            const int lo = t < CTXL ? 0 : CTXL, hi = t < CTXL ? CTXL : TT, c = lane * 4;
            const f32x4 x = ld4bf(pr + CD_WL + c);
            const f32x4 xp = t > lo ? ld4bf(pr - CD_N + CD_WL + c) : (f32x4){0.f, 0.f, 0.f, 0.f};
            const f32x4 xn = t < hi - 1 ? ld4bf(pr + CD_N + CD_WL + c) : (f32x4){0.f, 0.f, 0.f, 0.f};
            f32x4 l = x + *(const f32x4*)(mu + CD_WL - CD_RW0 + c) * ((xp + xn) * 0.5f - x);
            if (c < 128) {
#pragma unroll
                for (int q = 0; q < 4; ++q) l[q] = tanhf_(l[q]); }
            st4bf(WSP(bf16_t, WS_BIG + L1_TWAL) + (size_t)lr * 256 + c, l);
        }
        if (t >= CTXL) {
            const int s = t - CTXL;
            float x0[3], x1[3]; float ss = 0.f;
#pragma unroll
            for (int i = 0; i < 3; ++i) { const unsigned w = *(const unsigned*)(pr + CD_M0 + i * 128 + lane * 2); x0[i] = lo2f(w); x1[i] = hi2f(w); ss += x0[i] * x0[i] + x1[i] * x1[i]; }
            ss = wsum(ss); const float rstd = rsqrtf(ss * (1.0f / 384.0f) + EPS);
#pragma unroll
            for (int i = 0; i < 3; ++i) { const int c = i * 128 + lane * 2; *(unsigned*)(pr + CD_M0 + c) = pack2(x0[i] * rstd * qn[c], x1[i] * rstd * qn[c + 1]); }
            if (lane < 16) {
                const float pos = (lane < 8) ? (float)(s >> 6) : (float)(s & 63);
                const float inv = __expf(-(float)(lane & 7) * (9.210340371976184f / 8.0f));
                float sn, cs; sincosf(pos * inv, &sn, &cs);
                const float a = bf2f(pr[CD_KR + lane]), b2 = bf2f(pr[CD_KR + 16 + lane]);
                pr[CD_KR + lane] = f2bf(a * cs - b2 * sn); pr[CD_KR + 16 + lane] = f2bf(a * sn + b2 * cs);
            }
            {
                const int c = lane * 2;
                const unsigned w = *(const unsigned*)(pr + CD_GL + c);
                const unsigned wp = s > 0 ? *(const unsigned*)(pr - CD_N + CD_GL + c) : 0u;
                const unsigned wn = s < SEQ - 1 ? *(const unsigned*)(pr + CD_N + CD_GL + c) : 0u;
                const float m0 = mu[CD_GL - CD_RW0 + c], m1 = mu[CD_GL - CD_RW0 + c + 1];
                const float g0 = lo2f(w) + m0 * (0.5f * (lo2f(wp) + lo2f(wn)) - lo2f(w));
                const float g1 = hi2f(w) + m1 * (0.5f * (hi2f(wp) + hi2f(wn)) - hi2f(w));
                *(unsigned*)(SG + ((size_t)bl * SEQ + s) * 128 + c) = pack2(sigmoidf_(g0), sigmoidf_(g1));
            }
        }
    }
}

PHASE_FN void phase_upproj(const KP& kp, unsigned char* lds) {
    const bf16_t* P = WSP(const bf16_t, WS_BIG + L1_P);
    {
        pg8::Gemm g{P + CD_M0, WSP(const bf16_t, WS_WMIX + WM_UQ), RGL, 768, 384, nullptr, 0x7fffffff, CD_N, 1};
        pg8::StaticOrder S; S.init(RGL, 768, (int)gridDim.x, obid());
        pg8::EpiBfG E{WSP(bf16_t, WS_BIG + L1_Q), 768, 768, 0x7fffffff, 1.0f};
        pg8::gemm_phase<pg8::EpiBfG, pg8::StaticOrder, false>((PG8_LAS unsigned char*)lds, g, S, E, nullptr);
    }
    __syncthreads();
    {
        pg8::Gemm g{P + CD_M1, WSP(const bf16_t, WS_WMIX + WM_UKV), RG, 1024, 256, nullptr, 0x7fffffff, CD_N, 0};
        pg8::StaticOrder S; S.init(RG, 1024, (int)gridDim.x, obid());
        pg8::EpiBfG E{WSP(bf16_t, WS_BIG + L1_KV), 1024, 1024, 0x7fffffff, 1.0f};
        pg8::gemm_phase<pg8::EpiBfG, pg8::StaticOrder, false>((PG8_LAS unsigned char*)lds, g, S, E, nullptr);
    }
    __syncthreads();
}

constexpr int AT_LQ = 104, AT_LV = 72;
PHASE_FN void attn_unit(const KP& kp, unsigned char* lds, int bl, int head, int qb) {
    const int tid = otid(), lane = tid & 63, wid = __builtin_amdgcn_readfirstlane(tid >> 6), fr = lane & 15, fq = lane >> 4;
    bf16_t* Qs = (bf16_t*)lds;
    bf16_t* Kt = Qs + 256 * AT_LQ;
    bf16_t* Vt = Kt + 2 * 64 * AT_LQ;
    const bf16_t* P = WSP(const bf16_t, WS_BIG + L1_P);
    const bf16_t* Q = WSP(const bf16_t, WS_BIG + L1_Q);
    const bf16_t* KV = WSP(const bf16_t, WS_BIG + L1_KV);
    bf16_t* AOUT = WSP(bf16_t, WS_BIG + L1_AOUT);
    const float SC = 0.10206207261596577f;
#pragma unroll
    for (int i = 0; i < 6; ++i) { const int p = tid + i * 512, r = p / 12, c = p % 12;
        *(u32x4*)(Qs + r * AT_LQ + c * 8) = *(const u32x4*)(Q + ((size_t)bl * SEQ + qb * 256 + r) * 768 + head * 96 + c * 8); }
    lds_barrier();
#pragma unroll
    for (int i = 0; i < 8; ++i) { const int p = tid + i * 512, r = p >> 4, f = p & 15, s = qb * 256 + r;
        const float pos = (f < 8) ? (float)(s >> 6) : (float)(s & 63);
        const float inv = __expf(-(float)(f & 7) * (9.210340371976184f / 8.0f));
        float sn, cs; sincosf(pos * inv, &sn, &cs);
        const float a = bf2f(Qs[r * AT_LQ + 64 + f]), b2 = bf2f(Qs[r * AT_LQ + 80 + f]);
        Qs[r * AT_LQ + 64 + f] = f2bf(a * cs - b2 * sn); Qs[r * AT_LQ + 80 + f] = f2bf(a * sn + b2 * cs); }
    lds_barrier();
    bf16x8 qf[2][3];
#pragma unroll
    for (int rt = 0; rt < 2; ++rt)
#pragma unroll
        for (int k = 0; k < 3; ++k) qf[rt][k] = ldfrag(Qs, AT_LQ, wid * 32 + rt * 16, k * 32, fr, fq);
    f32x4 ot[2][4];
#pragma unroll
    for (int rt = 0; rt < 2; ++rt)
#pragma unroll
        for (int i = 0; i < 4; ++i) ot[rt][i] = (f32x4){0.f, 0.f, 0.f, 0.f};
    float mrow[2] = {-1e30f, -1e30f}, lsum[2] = {0.f, 0.f};
    u32x4 pk0[2], pk1[2], pvv[2];
    const int kkey0 = tid / 12, kc0 = tid % 12, kkey1 = (tid + 512) / 12, kc1 = (tid + 512) % 12, vkey = tid & 63, vc8 = tid >> 6;
#define AT_REQ(kt_) do { _Pragma("unroll") for (int h_ = 0; h_ < 2; ++h_) { const size_t rb_ = (size_t)bl * TT + ((kt_) * 2 + h_) * 64; \
        pk0[h_] = kc0 < 8 ? *(const u32x4*)(KV + (rb_ + kkey0) * 1024 + head * 128 + kc0 * 8) : *(const u32x4*)(P + (rb_ + kkey0) * CD_N + CD_KR + (kc0 - 8) * 8); \
        if (tid < 256) pk1[h_] = kc1 < 8 ? *(const u32x4*)(KV + (rb_ + kkey1) * 1024 + head * 128 + kc1 * 8) : *(const u32x4*)(P + (rb_ + kkey1) * CD_N + CD_KR + (kc1 - 8) * 8); \
        pvv[h_] = *(const u32x4*)(KV + (rb_ + vkey) * 1024 + head * 128 + 64 + vc8 * 8); } } while (0)
    AT_REQ(0);
    const float SC2 = SC * 1.4426950408889634f;
    for (int kt = 0; kt < TT / 128; ++kt) {
        lds_barrier();
#pragma unroll
        for (int h_ = 0; h_ < 2; ++h_) {
            *(u32x4*)(Kt + (h_ * 64 + kkey0) * AT_LQ + kc0 * 8) = pk0[h_];
            if (tid < 256) *(u32x4*)(Kt + (h_ * 64 + kkey1) * AT_LQ + kc1 * 8) = pk1[h_];
            { bf16_t* vt = Vt + (h_ * 64 + vc8 * 8) * AT_LV + vkey; const u32x4 v = pvv[h_];
                vt[0 * AT_LV] = (bf16_t)(v.x & 0xffff); vt[1 * AT_LV] = (bf16_t)(v.x >> 16); vt[2 * AT_LV] = (bf16_t)(v.y & 0xffff); vt[3 * AT_LV] = (bf16_t)(v.y >> 16);
                vt[4 * AT_LV] = (bf16_t)(v.z & 0xffff); vt[5 * AT_LV] = (bf16_t)(v.z >> 16); vt[6 * AT_LV] = (bf16_t)(v.w & 0xffff); vt[7 * AT_LV] = (bf16_t)(v.w >> 16); }
        }
        if (kt + 1 < TT / 128) AT_REQ(kt + 1);
        lds_barrier();
#pragma unroll 1
        for (int hs = 0; hs < 2; ++hs) {
        const bf16_t* Kth = Kt + hs * 64 * AT_LQ; const bf16_t* Vth = Vt + hs * 64 * AT_LV;
        bf16x8 kf[3][4];
#pragma unroll
        for (int k = 0; k < 3; ++k)
#pragma unroll
            for (int kk = 0; kk < 4; ++kk) kf[k][kk] = ldfrag(Kth, AT_LQ, kk * 16, k * 32, fr, fq);
        u32x2 vlo[2][4], vhi[2][4];
#pragma unroll
        for (int k2 = 0; k2 < 2; ++k2)
#pragma unroll
            for (int dvt = 0; dvt < 4; ++dvt) { const bf16_t* vp = Vth + (dvt * 16 + fr) * AT_LV + k2 * 32 + fq * 4; vlo[k2][dvt] = *(const u32x2*)vp; vhi[k2][dvt] = *(const u32x2*)(vp + 16); }
        __builtin_amdgcn_sched_barrier(0);
        f32x4 st[2][4];
#pragma unroll
        for (int rt = 0; rt < 2; ++rt)
#pragma unroll
            for (int kk = 0; kk < 4; ++kk) st[rt][kk] = (f32x4){0.f, 0.f, 0.f, 0.f};
#pragma unroll
        for (int k = 0; k < 3; ++k)
#pragma unroll
            for (int kk = 0; kk < 4; ++kk)
#pragma unroll
                for (int rt = 0; rt < 2; ++rt) st[rt][kk] = mma16(kf[k][kk], qf[rt][k], st[rt][kk]);
        union { bf16x8 v; unsigned u[4]; } pb[2][2];
#pragma unroll
        for (int rt = 0; rt < 2; ++rt) {
            float mx = -1e30f;
#pragma unroll
            for (int kk = 0; kk < 4; ++kk) mx = fmaxf(mx, fmaxf(fmaxf(st[rt][kk][0], st[rt][kk][1]), fmaxf(st[rt][kk][2], st[rt][kk][3])));
            mx = fmaxf(mx, __shfl_xor(mx, 16)); mx = fmaxf(mx, __shfl_xor(mx, 32));
            const float mnew = fmaxf(mrow[rt], mx), mb = mnew * SC2;
            if (__builtin_amdgcn_ballot_w64(mnew > mrow[rt]) != 0ull) {
                const float alpha = __builtin_amdgcn_exp2f((mrow[rt] - mnew) * SC2);
                lsum[rt] *= alpha;
#pragma unroll
                for (int i = 0; i < 4; ++i) ot[rt][i] = ot[rt][i] * alpha;
            }
            mrow[rt] = mnew;
#pragma unroll
            for (int kk = 0; kk < 4; ++kk)
#pragma unroll
                for (int r = 0; r < 4; ++r) { const float pv = __builtin_amdgcn_exp2f(st[rt][kk][r] * SC2 - mb); st[rt][kk][r] = pv; lsum[rt] += pv; }
#pragma unroll
            for (int k2 = 0; k2 < 2; ++k2) {
                pb[rt][k2].u[0] = pack2(st[rt][2 * k2][0], st[rt][2 * k2][1]); pb[rt][k2].u[1] = pack2(st[rt][2 * k2][2], st[rt][2 * k2][3]);
                pb[rt][k2].u[2] = pack2(st[rt][2 * k2 + 1][0], st[rt][2 * k2 + 1][1]); pb[rt][k2].u[3] = pack2(st[rt][2 * k2 + 1][2], st[rt][2 * k2 + 1][3]); }
        }
#pragma unroll
        for (int k2 = 0; k2 < 2; ++k2)
#pragma unroll
            for (int dvt = 0; dvt < 4; ++dvt) { union { bf16x8 v; u32x2 h[2]; } va; va.h[0] = vlo[k2][dvt]; va.h[1] = vhi[k2][dvt];
#pragma unroll
                for (int rt = 0; rt < 2; ++rt) ot[rt][dvt] = mma16(va.v, pb[rt][k2].v, ot[rt][dvt]); }
        }
    }
#undef AT_REQ
#pragma unroll
    for (int rt = 0; rt < 2; ++rt) {
        float ls = lsum[rt]; ls += __shfl_xor(ls, 16); ls += __shfl_xor(ls, 32);
        const float rl = frcp_(ls);
        const size_t orow = (size_t)bl * SEQ + qb * 256 + wid * 32 + rt * 16 + fr;
#pragma unroll
        for (int dvt = 0; dvt < 4; ++dvt) st4bf(AOUT + orow * 1536 + head * 64 + dvt * 16 + fq * 4, ot[rt][dvt] * rl);
    }
}

constexpr int RW_LR = 200, RW_LP = 72;
struct TrueT { static constexpr bool value = true; }; struct FalseT { static constexpr bool value = false; };
PHASE_FN void rwkv_unit(const KP& kp, unsigned char* lds, int bl, int h, int dir) {
    const int tid = otid();
    constexpr int NC = TT / 32;
    bf16_t* RAW = (bf16_t*)lds;
    bf16_t* TWb = RAW + 34 * RW_LR;
    bf16_t* ALb = TWb + 32 * RW_LP;
    float* WLf = (float*)(ALb + 32 * RW_LP);
    float* ALf = WLf + 32 * 64;
    bf16_t* BK = (bf16_t*)WLf;
    float* WT = ALf + 32 * 64;
    bf16_t* AR = (bf16_t*)(WT + 8 * 64);
    float* AABT = (float*)(AR + 64 * RW_LP);
    bf16_t* ARB0 = (bf16_t*)(AABT + 32 * 36);
    bf16_t* AAK = ARB0 + 2 * 32 * 40;
    bf16_t* ARK = AAK + 32 * 40;
    float* RHS = (float*)(ARK + 32 * 40);
    float* YB = RHS + 32 * 64;
    bf16_t* ZVT0 = (bf16_t*)(YB + 32 * 64);
    bf16_t* BKh0 = ZVT0 + 2 * 64 * RW_LP;
    bf16_t* Sb = BKh0 + 2 * 64 * RW_LP;
    float* PL0 = (float*)(Sb + 64 * RW_LP);
    float* CV = PL0 + 2 * 64;
    bf16_t* A21b = (bf16_t*)(CV + 8 * 64);
    bf16_t* TI = A21b + 16 * 40;
    bf16_t* RHSb = TI + 2 * 16 * 40;
    bf16_t* XB = RHSb + 64 * 40;
    static_assert((34 * RW_LR + 2 * 32 * RW_LP) * 2 + (2 * 32 * 64 + 8 * 64) * 4 + 64 * RW_LP * 2 + 32 * 36 * 4 + 4 * 32 * 40 * 2 + 2 * 32 * 64 * 4
                  + 5 * 64 * RW_LP * 2 + (2 * 64 + 8 * 64) * 4 + (16 * 40 + 2 * 16 * 40 + 2 * 64 * 40) * 2 <= LDS_BYTES - 16, "rwkv LDS");
    const bf16_t* P = WSP(const bf16_t, WS_BIG + L1_P); const bf16_t* TWAL = WSP(const bf16_t, WS_BIG + L1_TWAL);
    bf16_t* OUT = WSP(bf16_t, WS_BIG + (dir ? L1_OB : L1_OF));
    float* BSC = WSP(float, WS_BSC) + (size_t)dir * RGL * 16;
    const float* mu = KIN(24);
    bf16x8 wfr[2][2];
    {
        const int wv = tid >> 6, fr0 = tid & 15, fq0 = (tid & 63) >> 4; const float* wsrc = (wv >> 2) ? KIN(28) : KIN(26);
#pragma unroll
        for (int q2 = 0; q2 < 2; ++q2)
#pragma unroll
            for (int k = 0; k < 2; ++k) { const int n = ((wv & 1) * 2 + q2) * 16 + fr0; union { bf16x8 v; unsigned u[4]; } tw;
#pragma unroll
                for (int e = 0; e < 4; ++e) { const int c0 = k * 32 + fq0 * 8 + 2 * e;
                    tw.u[e] = pack2(wsrc[((size_t)dir * 64 + c0) * 1024 + h * 64 + n], wsrc[((size_t)dir * 64 + c0 + 1) * 1024 + h * 64 + n]); }
                wfr[q2][k] = tw.v; }
    }
    for (int i = tid; i < 2 * 16 * 40; i += 512) TI[i] = 0;
    for (int i = tid; i < 64 * 40; i += 512) XB[i] = 0;
    for (int i = tid; i < 64 * RW_LP; i += 512) Sb[i] = 0;
    for (int i = tid; i < 16 * 40; i += 512) A21b[i] = 0;
    for (int i = tid; i < 2 * 64 * RW_LP; i += 512) ZVT0[i] = 0;
    if (tid < 64) { const int n = tid;
        CV[0 * 64 + n] = KIN(25)[dir * 1024 + h * 64 + n]; CV[1 * 64 + n] = KIN(27)[dir * 1024 + h * 64 + n];
        CV[2 * 64 + n] = KIN(30)[h * 64 + n]; CV[3 * 64 + n] = KIN(31)[h * 64 + n]; CV[4 * 64 + n] = KIN(32)[h * 64 + n];
        CV[5 * 64 + n] = mu[h * 64 + n]; CV[6 * 64 + n] = mu[1024 + h * 64 + n]; CV[7 * 64 + n] = mu[2048 + h * 64 + n]; }
    f32x4 Sacc[2];
    Sacc[0] = (f32x4){0.f, 0.f, 0.f, 0.f}; Sacc[1] = (f32x4){0.f, 0.f, 0.f, 0.f};
    u32x4 pf[3];
#define RW_PREFETCH(cn, tix) do { const int t0n_ = dir ? scan_t<32>(1, (cn), 31) : (cn) * 32; const int lo_ = t0n_ < CTXL ? 0 : CTXL, hi_ = t0n_ < CTXL ? CTXL : TT; \
        _Pragma("unroll") for (int q = 0; q < 2; ++q) { const int p = (tix) + q * 512; pf[q] = (u32x4){0u, 0u, 0u, 0u}; \
            if (p < 34 * 24) { const int rr = p / 24, c = p % 24, t = t0n_ - 1 + rr; \
                if (t >= lo_ && t < hi_) { const int seg = c >> 3, c8 = c & 7; \
                    const int col = (seg == 0 ? CD_R : seg == 1 ? CD_K : CD_V) + h * 64; \
                    pf[q] = *(const u32x4*)(P + ((size_t)bl * TT + t) * CD_N + col + c8 * 8); } } } \
        { const int i_ = (tix) >> 4, c16 = (tix) & 15; \
          pf[2] = *(const u32x4*)(TWAL + ((size_t)bl * TT + t0n_ + i_) * 256 + (c16 >> 3) * 128 + dir * 64 + (c16 & 7) * 8); } } while (0)
    RW_PREFETCH(0, tid);
    lds_barrier();
    auto step = [&](auto doP_t, auto doD_t, const int ci) __attribute__((always_inline)) {
        constexpr bool doP = decltype(doP_t)::value, doD = decltype(doD_t)::value;
        int tq = tid; asm volatile("" : "+v"(tq));
        const int lane = tq & 63, wid = __builtin_amdgcn_readfirstlane(tq >> 6), fr = lane & 15, fq = lane >> 4, pi = tq >> 4, n4 = (tq & 15) * 4;
        const int cp = ci + 1, pc = ci & 1, pn = cp & 1;
        const int t0 = dir ? scan_t<32>(1, ci, 31) : ci * 32, t0p = dir ? scan_t<32>(1, cp, 31) : cp * 32;
        bf16_t* ZVc = ZVT0 + pc * 64 * RW_LP; bf16_t* ZVn = ZVT0 + pn * 64 * RW_LP;
        const bf16_t* BKhc = BKh0 + pc * 64 * RW_LP; bf16_t* BKhn = BKh0 + pn * 64 * RW_LP;
        const bf16_t* ARBc = ARB0 + pc * 32 * 40; bf16_t* ARBn = ARB0 + pn * 32 * 40;
        const float* PLc = PL0 + pc * 64; float* PLn = PL0 + pn * 64;
        if constexpr (doP) {
#pragma unroll
            for (int q = 0; q < 2; ++q) { const int p = tq + q * 512; if (p < 34 * 24) *(u32x4*)(RAW + (p / 24) * RW_LR + (p % 24) * 8) = pf[q]; }
            { const int i_ = tq >> 4, c16 = tq & 15; *(u32x4*)(((c16 >> 3) ? ALb : TWb) + i_ * RW_LP + (c16 & 7) * 8) = pf[2]; }
        }
        if constexpr (doD) {
            if (wid > 0) for (int rep_ = 0; rep_ < ((RWP & 32) ? 2 : 1); ++rep_) {
#pragma unroll
                for (int q3 = 0; q3 < 3; ++q3) { const int tl = (wid - 1) + 7 * q3;
                    if (tl < 16) {
                        const int which = tl >> 3, tt = (tl >> 2) & 1, vt = tl & 3;
                        const bf16_t* Ak = which ? ARK : AAK; float* Od = which ? YB : RHS;
                        f32x4 acc = (f32x4){0.f, 0.f, 0.f, 0.f};
#pragma unroll
                        for (int k = 0; k < 2; ++k) acc = mma16(ldfrag(AR, RW_LP, which * 32 + tt * 16, k * 32, fr, fq), ldfrag(Sb, RW_LP, vt * 16, k * 32, fr, fq), acc);
                        acc = mma16(ldfrag(Ak, 40, tt * 16, 0, fr, fq), ldfrag(ZVc, RW_LP, vt * 16, 32, fr, fq), acc);
#pragma unroll
                        for (int rr = 0; rr < 4; ++rr) Od[(tt * 16 + fq * 4 + rr) * 64 + vt * 16 + fr] = acc[rr];
                        if (!which) st4bf(RHSb + (vt * 16 + fr) * 40 + tt * 16 + fq * 4, acc);
                    } }
            } else for (int rep_ = 0; rep_ < ((RWP & 1) ? 2 : 1); ++rep_) {
                const float* AB = AABT + ((lane >> 4) & 1) * (16 * 36 + 16);
                float z[16]; f32x4 ca0, ca1, ca2, ca3, cb0, cb1, cb2, cb3;
#pragma unroll
                for (int t = 0; t < 16; ++t) z[t] = (t == (lane & 15)) ? 1.0f : 0.f;
                ca0 = *(const f32x4*)(AB + 0 * 36 + 0); ca1 = *(const f32x4*)(AB + 0 * 36 + 4); ca2 = *(const f32x4*)(AB + 0 * 36 + 8); ca3 = *(const f32x4*)(AB + 0 * 36 + 12);
                cb0 = *(const f32x4*)(AB + 1 * 36 + 0); cb1 = *(const f32x4*)(AB + 1 * 36 + 4); cb2 = *(const f32x4*)(AB + 1 * 36 + 8); cb3 = *(const f32x4*)(AB + 1 * 36 + 12);
                { const float zs = z[0]; z[1] = __builtin_fmaf(ca0[1], zs, z[1]); z[2] = __builtin_fmaf(ca0[2], zs, z[2]); z[3] = __builtin_fmaf(ca0[3], zs, z[3]); z[4] = __builtin_fmaf(ca1[0], zs, z[4]); z[5] = __builtin_fmaf(ca1[1], zs, z[5]); z[6] = __builtin_fmaf(ca1[2], zs, z[6]); z[7] = __builtin_fmaf(ca1[3], zs, z[7]); z[8] = __builtin_fmaf(ca2[0], zs, z[8]); z[9] = __builtin_fmaf(ca2[1], zs, z[9]); z[10] = __builtin_fmaf(ca2[2], zs, z[10]); z[11] = __builtin_fmaf(ca2[3], zs, z[11]); z[12] = __builtin_fmaf(ca3[0], zs, z[12]); z[13] = __builtin_fmaf(ca3[1], zs, z[13]); z[14] = __builtin_fmaf(ca3[2], zs, z[14]); z[15] = __builtin_fmaf(ca3[3], zs, z[15]); }
                asm volatile("" : "+v"(z[1]) :: "memory");
                ca0 = *(const f32x4*)(AB + 2 * 36 + 0); ca1 = *(const f32x4*)(AB + 2 * 36 + 4); ca2 = *(const f32x4*)(AB + 2 * 36 + 8); ca3 = *(const f32x4*)(AB + 2 * 36 + 12);
                { const float zs = z[1]; z[2] = __builtin_fmaf(cb0[2], zs, z[2]); z[3] = __builtin_fmaf(cb0[3], zs, z[3]); z[4] = __builtin_fmaf(cb1[0], zs, z[4]); z[5] = __builtin_fmaf(cb1[1], zs, z[5]); z[6] = __builtin_fmaf(cb1[2], zs, z[6]); z[7] = __builtin_fmaf(cb1[3], zs, z[7]); z[8] = __builtin_fmaf(cb2[0], zs, z[8]); z[9] = __builtin_fmaf(cb2[1], zs, z[9]); z[10] = __builtin_fmaf(cb2[2], zs, z[10]); z[11] = __builtin_fmaf(cb2[3], zs, z[11]); z[12] = __builtin_fmaf(cb3[0], zs, z[12]); z[13] = __builtin_fmaf(cb3[1], zs, z[13]); z[14] = __builtin_fmaf(cb3[2], zs, z[14]); z[15] = __builtin_fmaf(cb3[3], zs, z[15]); }
                asm volatile("" : "+v"(z[2]) :: "memory");
                cb1 = *(const f32x4*)(AB + 3 * 36 + 4); cb2 = *(const f32x4*)(AB + 3 * 36 + 8); cb3 = *(const f32x4*)(AB + 3 * 36 + 12);
                { const float zs = z[2]; z[3] = __builtin_fmaf(ca0[3], zs, z[3]); z[4] = __builtin_fmaf(ca1[0], zs, z[4]); z[5] = __builtin_fmaf(ca1[1], zs, z[5]); z[6] = __builtin_fmaf(ca1[2], zs, z[6]); z[7] = __builtin_fmaf(ca1[3], zs, z[7]); z[8] = __builtin_fmaf(ca2[0], zs, z[8]); z[9] = __builtin_fmaf(ca2[1], zs, z[9]); z[10] = __builtin_fmaf(ca2[2], zs, z[10]); z[11] = __builtin_fmaf(ca2[3], zs, z[11]); z[12] = __builtin_fmaf(ca3[0], zs, z[12]); z[13] = __builtin_fmaf(ca3[1], zs, z[13]); z[14] = __builtin_fmaf(ca3[2], zs, z[14]); z[15] = __builtin_fmaf(ca3[3], zs, z[15]); }
                asm volatile("" : "+v"(z[3]) :: "memory");
                ca1 = *(const f32x4*)(AB + 4 * 36 + 4); ca2 = *(const f32x4*)(AB + 4 * 36 + 8); ca3 = *(const f32x4*)(AB + 4 * 36 + 12);
                { const float zs = z[3]; z[4] = __builtin_fmaf(cb1[0], zs, z[4]); z[5] = __builtin_fmaf(cb1[1], zs, z[5]); z[6] = __builtin_fmaf(cb1[2], zs, z[6]); z[7] = __builtin_fmaf(cb1[3], zs, z[7]); z[8] = __builtin_fmaf(cb2[0], zs, z[8]); z[9] = __builtin_fmaf(cb2[1], zs, z[9]); z[10] = __builtin_fmaf(cb2[2], zs, z[10]); z[11] = __builtin_fmaf(cb2[3], zs, z[11]); z[12] = __builtin_fmaf(cb3[0], zs, z[12]); z[13] = __builtin_fmaf(cb3[1], zs, z[13]); z[14] = __builtin_fmaf(cb3[2], zs, z[14]); z[15] = __builtin_fmaf(cb3[3], zs, z[15]); }
                asm volatile("" : "+v"(z[4]) :: "memory");
                cb1 = *(const f32x4*)(AB + 5 * 36 + 4); cb2 = *(const f32x4*)(AB + 5 * 36 + 8); cb3 = *(const f32x4*)(AB + 5 * 36 + 12);
                { const float zs = z[4]; z[5] = __builtin_fmaf(ca1[1], zs, z[5]); z[6] = __builtin_fmaf(ca1[2], zs, z[6]); z[7] = __builtin_fmaf(ca1[3], zs, z[7]); z[8] = __builtin_fmaf(ca2[0], zs, z[8]); z[9] = __builtin_fmaf(ca2[1], zs, z[9]); z[10] = __builtin_fmaf(ca2[2], zs, z[10]); z[11] = __builtin_fmaf(ca2[3], zs, z[11]); z[12] = __builtin_fmaf(ca3[0], zs, z[12]); z[13] = __builtin_fmaf(ca3[1], zs, z[13]); z[14] = __builtin_fmaf(ca3[2], zs, z[14]); z[15] = __builtin_fmaf(ca3[3], zs, z[15]); }
                asm volatile("" : "+v"(z[5]) :: "memory");
                ca1 = *(const f32x4*)(AB + 6 * 36 + 4); ca2 = *(const f32x4*)(AB + 6 * 36 + 8); ca3 = *(const f32x4*)(AB + 6 * 36 + 12);
                { const float zs = z[5]; z[6] = __builtin_fmaf(cb1[2], zs, z[6]); z[7] = __builtin_fmaf(cb1[3], zs, z[7]); z[8] = __builtin_fmaf(cb2[0], zs, z[8]); z[9] = __builtin_fmaf(cb2[1], zs, z[9]); z[10] = __builtin_fmaf(cb2[2], zs, z[10]); z[11] = __builtin_fmaf(cb2[3], zs, z[11]); z[12] = __builtin_fmaf(cb3[0], zs, z[12]); z[13] = __builtin_fmaf(cb3[1], zs, z[13]); z[14] = __builtin_fmaf(cb3[2], zs, z[14]); z[15] = __builtin_fmaf(cb3[3], zs, z[15]); }
                asm volatile("" : "+v"(z[6]) :: "memory");
                cb2 = *(const f32x4*)(AB + 7 * 36 + 8); cb3 = *(const f32x4*)(AB + 7 * 36 + 12);
                { const float zs = z[6]; z[7] = __builtin_fmaf(ca1[3], zs, z[7]); z[8] = __builtin_fmaf(ca2[0], zs, z[8]); z[9] = __builtin_fmaf(ca2[1], zs, z[9]); z[10] = __builtin_fmaf(ca2[2], zs, z[10]); z[11] = __builtin_fmaf(ca2[3], zs, z[11]); z[12] = __builtin_fmaf(ca3[0], zs, z[12]); z[13] = __builtin_fmaf(ca3[1], zs, z[13]); z[14] = __builtin_fmaf(ca3[2], zs, z[14]); z[15] = __builtin_fmaf(ca3[3], zs, z[15]); }
                asm volatile("" : "+v"(z[7]) :: "memory");
                ca2 = *(const f32x4*)(AB + 8 * 36 + 8); ca3 = *(const f32x4*)(AB + 8 * 36 + 12);
                { const float zs = z[7]; z[8] = __builtin_fmaf(cb2[0], zs, z[8]); z[9] = __builtin_fmaf(cb2[1], zs, z[9]); z[10] = __builtin_fmaf(cb2[2], zs, z[10]); z[11] = __builtin_fmaf(cb2[3], zs, z[11]); z[12] = __builtin_fmaf(cb3[0], zs, z[12]); z[13] = __builtin_fmaf(cb3[1], zs, z[13]); z[14] = __builtin_fmaf(cb3[2], zs, z[14]); z[15] = __builtin_fmaf(cb3[3], zs, z[15]); }
                asm volatile("" : "+v"(z[8]) :: "memory");
                cb2 = *(const f32x4*)(AB + 9 * 36 + 8); cb3 = *(const f32x4*)(AB + 9 * 36 + 12);
                { const float zs = z[8]; z[9] = __builtin_fmaf(ca2[1], zs, z[9]); z[10] = __builtin_fmaf(ca2[2], zs, z[10]); z[11] = __builtin_fmaf(ca2[3], zs, z[11]); z[12] = __builtin_fmaf(ca3[0], zs, z[12]); z[13] = __builtin_fmaf(ca3[1], zs, z[13]); z[14] = __builtin_fmaf(ca3[2], zs, z[14]); z[15] = __builtin_fmaf(ca3[3], zs, z[15]); }
                asm volatile("" : "+v"(z[9]) :: "memory");
                ca2 = *(const f32x4*)(AB + 10 * 36 + 8); ca3 = *(const f32x4*)(AB + 10 * 36 + 12);
                { const float zs = z[9]; z[10] = __builtin_fmaf(cb2[2], zs, z[10]); z[11] = __builtin_fmaf(cb2[3], zs, z[11]); z[12] = __builtin_fmaf(cb3[0], zs, z[12]); z[13] = __builtin_fmaf(cb3[1], zs, z[13]); z[14] = __builtin_fmaf(cb3[2], zs, z[14]); z[15] = __builtin_fmaf(cb3[3], zs, z[15]); }
                asm volatile("" : "+v"(z[10]) :: "memory");
                cb3 = *(const f32x4*)(AB + 11 * 36 + 12);
                { const float zs = z[10]; z[11] = __builtin_fmaf(ca2[3], zs, z[11]); z[12] = __builtin_fmaf(ca3[0], zs, z[12]); z[13] = __builtin_fmaf(ca3[1], zs, z[13]); z[14] = __builtin_fmaf(ca3[2], zs, z[14]); z[15] = __builtin_fmaf(ca3[3], zs, z[15]); }
                asm volatile("" : "+v"(z[11]) :: "memory");
                ca3 = *(const f32x4*)(AB + 12 * 36 + 12);
                { const float zs = z[11]; z[12] = __builtin_fmaf(cb3[0], zs, z[12]); z[13] = __builtin_fmaf(cb3[1], zs, z[13]); z[14] = __builtin_fmaf(cb3[2], zs, z[14]); z[15] = __builtin_fmaf(cb3[3], zs, z[15]); }
                asm volatile("" : "+v"(z[12]) :: "memory");
                cb3 = *(const f32x4*)(AB + 13 * 36 + 12);
                { const float zs = z[12]; z[13] = __builtin_fmaf(ca3[1], zs, z[13]); z[14] = __builtin_fmaf(ca3[2], zs, z[14]); z[15] = __builtin_fmaf(ca3[3], zs, z[15]); }
                asm volatile("" : "+v"(z[13]) :: "memory");
                ca3 = *(const f32x4*)(AB + 14 * 36 + 12);
                { const float zs = z[13]; z[14] = __builtin_fmaf(cb3[2], zs, z[14]); z[15] = __builtin_fmaf(cb3[3], zs, z[15]); }
                asm volatile("" : "+v"(z[14]) :: "memory");
                { const float zs = z[14]; z[15] = __builtin_fmaf(ca3[3], zs, z[15]); }
                asm volatile("" : "+v"(z[15]) :: "memory");
                if (lane < 32) {
#pragma unroll
                    for (int t = 0; t < 16; ++t) TI[(lane >> 4) * 16 * 40 + t * 40 + (lane & 15)] = f2bf(z[t]);
                }
            }
        }
        if constexpr (doP) { if (cp + 1 < NC) RW_PREFETCH(cp + 1, tq); }
        lds_barrier();
        if constexpr (doD) if (wid < 4) {
            f32x4 acc = (f32x4){0.f, 0.f, 0.f, 0.f};
            acc = mma16(ldfrag(TI, 40, 0, 0, fr, fq), ldfrag(RHSb, 40, wid * 16, 0, fr, fq), acc);
            st4bf(ZVc + (wid * 16 + fr) * RW_LP + fq * 4, acc);
        }
        if constexpr (doP) for (int rep_ = 0; rep_ < ((RWP & 64) ? 2 : 1); ++rep_) {
            const int which = wid >> 2, tt = (wid >> 1) & 1;
            const bf16_t* Xa = which ? ALb : TWb; float* Od = which ? ALf : WLf;
#pragma unroll
            for (int q2 = 0; q2 < 2; ++q2) { const int nt = (wid & 1) * 2 + q2;
                f32x4 acc = (f32x4){0.f, 0.f, 0.f, 0.f};
#pragma unroll
                for (int k = 0; k < 2; ++k) acc = mma16(ldfrag(Xa, RW_LP, tt * 16, k * 32, fr, fq), wfr[q2][k], acc);
#pragma unroll
                for (int rr = 0; rr < 4; ++rr) Od[(tt * 16 + fq * 4 + rr) * 64 + nt * 16 + fr] = acc[rr]; }
            const int pp = tq & 31, cg = tq >> 5, jj = dir ? 31 - pp : pp;
            const bf16_t* r1v = RAW + (pp + 1) * RW_LR + 128 + cg * 4;
            const f32x4 muv = *(const f32x4*)(CV + 448 + cg * 4);
            f32x4 v = ld4bf(r1v);
            v = v + muv * ((ld4bf(r1v - RW_LR) + ld4bf(r1v + RW_LR)) * 0.5f - v);
#pragma unroll
            for (int q = 0; q < 4; ++q) ZVn[(cg * 4 + q) * RW_LP + 32 + jj] = f2bf(v[q]);
        }
        lds_barrier();
        if (RWP & 16) { lds_barrier(); lds_barrier(); lds_barrier(); lds_barrier(); lds_barrier(); }
        const int j = dir ? 31 - pi : pi;
        f32x4 r, kd, av, bv, lw, cin;
        f32x4 xacc = (f32x4){0.f, 0.f, 0.f, 0.f};
        if constexpr (doD) {
            xacc = mma16(ldfrag(A21b, 40, 0, 0, fr, fq), ldfrag(ZVc, RW_LP, (wid & 3) * 16, 0, fr, fq), xacc);
#pragma unroll
            for (int rr = 0; rr < 4; ++rr) xacc[rr] += RHS[(16 + fq * 4 + rr) * 64 + (wid & 3) * 16 + fr];
        }
        if constexpr (doP) for (int rep_ = 0; rep_ < ((RWP & 2) ? 2 : 1); ++rep_) {
            const f32x4 w0v = *(const f32x4*)(CV + n4), a0v = *(const f32x4*)(CV + 64 + n4), kkw = *(const f32x4*)(CV + 128 + n4), kaw = *(const f32x4*)(CV + 192 + n4), rkw = *(const f32x4*)(CV + 256 + n4);
            const f32x4 mur = *(const f32x4*)(CV + 320 + n4), muk = *(const f32x4*)(CV + 384 + n4);
            const f32x4 wl = w0v + *(const f32x4*)(WLf + pi * 64 + n4), al = a0v + *(const f32x4*)(ALf + pi * 64 + n4);
            const bf16_t* r1 = RAW + (pi + 1) * RW_LR; const bf16_t* rp = RAW + pi * RW_LR; const bf16_t* rn = RAW + (pi + 2) * RW_LR;
            f32x4 k;
            r = ld4bf(r1 + n4); k = ld4bf(r1 + 64 + n4);
            r = r + mur * ((ld4bf(rp + n4) + ld4bf(rn + n4)) * 0.5f - r);
            k = k + muk * ((ld4bf(rp + 64 + n4) + ld4bf(rn + 64 + n4)) * 0.5f - k);
            f32x4 a, kk = k * kkw;
            float ssq = kk[0] * kk[0] + kk[1] * kk[1] + kk[2] * kk[2] + kk[3] * kk[3];
            ssq = rsum16(ssq);
            kk = kk * __builtin_amdgcn_rsqf(fmaxf(ssq, 1e-24f));
#pragma unroll
            for (int q = 0; q < 4; ++q) { lw[q] = -0.6065306597126334f * sigmoidf_(wl[q]); a[q] = sigmoidf_(al[q]); }
            kd = k * ((a - 1.0f) * kaw + 1.0f);
            float bs = r[0] * kd[0] * rkw[0] + r[1] * kd[1] * rkw[1] + r[2] * kd[2] * rkw[2] + r[3] * kd[3] * rkw[3];
            bs = rsum16(bs);
            av = kk * -1.0f; bv = kk * a;
            f32x4 wt;
#pragma unroll
            for (int q = 0; q < 4; ++q) {
                const float lwq = lw[q];
                const auto e16 = __builtin_amdgcn_permlane16_swap(__builtin_bit_cast(unsigned, lwq), __builtin_bit_cast(unsigned, lwq), false, false);
                const unsigned e16a = e16[0], e16b = e16[1];
                const float y = __builtin_bit_cast(float, e16a) + __builtin_bit_cast(float, e16b);
                const auto e32 = __builtin_amdgcn_permlane32_swap(__builtin_bit_cast(unsigned, y), __builtin_bit_cast(unsigned, y), false, false);
                const unsigned e32a = e32[0], e32b = e32[1];
                wt[q] = __builtin_bit_cast(float, e32a) + __builtin_bit_cast(float, e32b);
                cin[q] = ((fq & 1) ? y : lwq) + ((fq & 2) ? (wt[q] - y) : 0.f);
            }
            if (fq == 0) *(f32x4*)(WT + wid * 64 + n4) = wt;
            const int t = t0p + pi;
            if (t >= CTXL && (tq & 15) == 0) BSC[((size_t)bl * SEQ + (t - CTXL)) * 16 + h] = bs;
        }
        if constexpr (doD) if (wid < 4) st4bf(XB + (wid * 16 + fr) * 40 + fq * 4, xacc);
        lds_barrier();
        if constexpr (doD) if (wid < 4) {
            f32x4 acc = (f32x4){0.f, 0.f, 0.f, 0.f};
            acc = mma16(ldfrag(TI + 16 * 40, 40, 0, 0, fr, fq), ldfrag(XB, 40, wid * 16, 0, fr, fq), acc);
            st4bf(ZVc + (wid * 16 + fr) * RW_LP + 16 + fq * 4, acc);
        }
        if constexpr (doP) for (int rep_ = 0; rep_ < ((RWP & 4) ? 2 : 1); ++rep_) {
            f32x4 pre = (f32x4){0.f, 0.f, 0.f, 0.f}, cle = (f32x4){0.f, 0.f, 0.f, 0.f};
#pragma unroll
            for (int w = 0; w < 8; ++w) { const f32x4 t4 = *(const f32x4*)(WT + w * 64 + n4); cle = cle + t4; if (w < wid) pre = pre + t4; }
            const f32x4 cim = cin + pre;
            const f32x4 clj = dir ? cle - cim + lw : cim;
            const f32x4 clp = dir ? cle - cim : cim - lw;
            f32x4 at, rt, bt, kt, bh, kh;
#pragma unroll
            for (int q = 0; q < 4; ++q) { const float ep = __expf(clp[q]), ej = __expf(clj[q]), ei = __expf(-clj[q]), ee = __expf(cle[q] - clj[q]);
                at[q] = av[q] * ep; rt[q] = r[q] * ej; bt[q] = bv[q] * ei; kt[q] = kd[q] * ei; bh[q] = bv[q] * ee; kh[q] = kd[q] * ee; }
            if (tq < 16) { f32x4 e;
#pragma unroll
                for (int q = 0; q < 4; ++q) e[q] = __expf(cle[q]);
                *(f32x4*)(PLn + n4) = e; }
            st4bf(AR + j * RW_LP + n4, at); st4bf(AR + (32 + j) * RW_LP + n4, rt);
            st4bf(BK + j * RW_LP + n4, bt); st4bf(BK + (32 + j) * RW_LP + n4, kt);
            const int cbh = (((j >> 3) ^ (tq & 7)) << 3) | (j & 7), ckh = ((((j >> 3) + 4) ^ (tq & 7)) << 3) | (j & 7);
#pragma unroll
            for (int q = 0; q < 4; ++q) { BKhn[(n4 + q) * RW_LP + cbh] = f2bf(bh[q]); BKhn[(n4 + q) * RW_LP + ckh] = f2bf(kh[q]); }
        }
        lds_barrier();
        if constexpr (doD) {
            const int nt = wid >> 1;
            const f32x4 pl = *(const f32x4*)(PLc + nt * 16 + fq * 4);
#pragma unroll
            for (int q2 = 0; q2 < 2; ++q2) {
                const int vt = (wid & 1) * 2 + q2;
                Sacc[q2] = Sacc[q2] * pl;
#pragma unroll
                for (int k = 0; k < 2; ++k) Sacc[q2] = mma16(*(const bf16x8*)(BKhc + (nt * 16 + fr) * RW_LP + (((k * 4 + fq) ^ (((nt & 1) << 2) + (fr >> 2))) << 3)), ldfrag(ZVc, RW_LP, vt * 16, k * 32, fr, fq), Sacc[q2]);
                st4bf(Sb + (vt * 16 + fr) * RW_LP + nt * 16 + fq * 4, Sacc[q2]);
            }
            if (t0 >= CTXL) {
                const int vt = wid >> 1, tt = wid & 1;
                f32x4 acc = (f32x4){0.f, 0.f, 0.f, 0.f};
                acc = mma16(ldfrag(ZVc, RW_LP, vt * 16, 0, fr, fq), ldfrag(ARBc, 40, tt * 16, 0, fr, fq), acc);
                const int t = tt * 16 + fr, v0 = vt * 16 + fq * 4;
#pragma unroll
                for (int rr = 0; rr < 4; ++rr) acc[rr] += YB[t * 64 + v0 + rr];
                const int tn = scan_t<32>(dir, ci, t);
                st4bf(OUT + ((size_t)bl * SEQ + (tn - CTXL)) * 1024 + h * 64 + v0, acc);
            }
        }
        if constexpr (doP) for (int rep_ = 0; rep_ < ((RWP & 8) ? 2 : 1); ++rep_) {
            const int ti = wid >> 1;
#pragma unroll
            for (int q2 = 0; q2 < 2; ++q2) {
                const int si = (wid & 1) * 2 + q2;
                f32x4 acc = (f32x4){0.f, 0.f, 0.f, 0.f};
#pragma unroll
                for (int k = 0; k < 2; ++k) acc = mma16(ldfrag(AR, RW_LP, ti * 16, k * 32, fr, fq), ldfrag(BK, RW_LP, si * 16, k * 32, fr, fq), acc);
                const int s = (si & 1) * 16 + fr;
                const bool incl = ti >= 2, kcols = si >= 2;
                bf16_t* dstb = kcols ? (incl ? ARK : AAK) : ARBn;
#pragma unroll
                for (int rr = 0; rr < 4; ++rr) { const int t = (ti & 1) * 16 + fq * 4 + rr;
                    const float val = (incl ? (s <= t) : (s < t)) ? acc[rr] : 0.f;
                    if (kcols || incl) dstb[t * 40 + s] = f2bf(val);
                    else { AABT[s * 36 + t] = val; if (ti == 1 && si == 0) A21b[(t - 16) * 40 + s] = f2bf(val); } }
            }
        }
        lds_barrier();
    };
    step(TrueT{}, FalseT{}, -1);
#pragma unroll 1
    for (int ci = 0; ci < NC - 1; ++ci) step(TrueT{}, TrueT{}, ci);
    step(FalseT{}, TrueT{}, NC - 1);
#undef RW_PREFETCH
}

__device__ __forceinline__ void phase_mix_cd(const KP& kp, unsigned char* lds, int which) {
    if (which & 1) for (int u = obid(); u < 256; u += gridDim.x) { rwkv_unit(kp, lds, u >> 5, (u >> 1) & 15, u & 1); __syncthreads(); }
    if (which & 2) for (int u = obid(); u < 512; u += gridDim.x) { attn_unit(kp, lds, u >> 6, (u >> 3) & 7, u & 7); __syncthreads(); }
}

struct EpiFinCD {
    const bf16_t* OF; const bf16_t* OB; const bf16_t* P; const float* BSC; const float* ln; const float* mu; bf16_t* AOUT;
    __device__ __forceinline__ void operator()(const f32x4 (&acc)[4][4], int rb, int cb, int fr, int fq) const {
        const int head = cb >> 6;
#pragma unroll
        for (int i = 0; i < 4; ++i) { const int lr = rb + i * 16 + fr, s = lr & 2047;
            const size_t prow = (size_t)(lr >> 11) * TT + CTXL + s;
            f32x4 o[4]; float ss = 0.f;
#pragma unroll
            for (int j = 0; j < 4; ++j) { const int col = cb + j * 16 + fq * 4;
                o[j] = ld4bf(OF + (size_t)lr * 1024 + col) + ld4bf(OB + (size_t)lr * 1024 + col);
                ss += o[j][0] * o[j][0] + o[j][1] * o[j][1] + o[j][2] * o[j][2] + o[j][3] * o[j][3]; }
            ss += __shfl_xor(ss, 16); ss += __shfl_xor(ss, 32);
            const float rstd = rsqrtf(ss * (1.0f / 64.0f) + EPS);
            const float bon = BSC[(size_t)lr * 16 + head] + BSC[(size_t)RGL * 16 + (size_t)lr * 16 + head];
#pragma unroll
            for (int j = 0; j < 4; ++j) { const int col = cb + j * 16 + fq * 4;
                const bf16_t* pv = P + prow * CD_N + CD_V + col;
                const f32x4 v = ld4bf(pv);
                const f32x4 vp = s > 0 ? ld4bf(pv - CD_N) : (f32x4){0.f, 0.f, 0.f, 0.f};
                const f32x4 vn = s < SEQ - 1 ? ld4bf(pv + CD_N) : (f32x4){0.f, 0.f, 0.f, 0.f};
                const f32x4 vl = v + *(const f32x4*)(mu + 2048 + col) * ((vp + vn) * 0.5f - v);
                const f32x4 y = o[j] * rstd * *(const f32x4*)(ln + col) + vl * bon;
                st4bf(AOUT + (size_t)lr * 1536 + 512 + col, y * acc[i][j]); }
        }
    }
};
PHASE_FN void phase_fin_cd(const KP& kp, unsigned char* lds) {
    GA ga{WSP(const bf16_t, WS_SG), nullptr, 128, 0, 128, nullptr, RGL, 0, 0};
    EpiFinCD ep{WSP(const bf16_t, WS_BIG + L1_OF), WSP(const bf16_t, WS_BIG + L1_OB), WSP(const bf16_t, WS_BIG + L1_P), WSP(const float, WS_BSC), KIN(33), KIN(24), WSP(bf16_t, WS_BIG + L1_AOUT)};
    for (int u = obid(); u < (RGL / 256) * 8; u += gridDim.x) gemm_tile(lds, ga, WSP(const bf16_t, WS_WMIX + WM_G2), 128, u >> 3, u & 7, ep);
}
PHASE_FN void phase_gemm_out_cd(const KP& kp, unsigned char* lds) {
    pg8::Gemm g{WSP(const bf16_t, WS_BIG + L1_AOUT), WSP(const bf16_t, WS_WMIX + WM_CD_OUT), RGL, 1024, 1536, nullptr, 0x7fffffff};
    pg8::StaticOrder S; S.init(RGL, 1024, (int)gridDim.x, obid());
    pg8::EpiBfG E{WSP(bf16_t, WS_BIG + L1_U), 1024, 1024, 0x7fffffff, 1.0f};
    pg8::gemm_phase<pg8::EpiBfG, pg8::StaticOrder, false>((PG8_LAS unsigned char*)lds, g, S, E, nullptr);
    __syncthreads();
}

__device__ __attribute__((noinline)) void grid_sync(unsigned* barw, unsigned x, volatile LAS unsigned* st) { XcdBarrier b; b.bar = barw; b.x = x; b.st = st; xcd_barrier(b); }
constexpr int N_PHASES = 36;
__global__ void __launch_bounds__(512, 2) fwd_kernel(KP kparg) {
    extern __shared__ __attribute__((aligned(16))) unsigned char lds[];
    const int lo = kparg.ph_lo, hi = kparg.ph_hi;
    const KP& kp = kparg;
    volatile LAS unsigned* xbst = (volatile LAS unsigned*)(LAS unsigned char*)(lds + LDS_BYTES - 16);
    if (threadIdx.x == 0) { xbst[0] = 0u; xbst[1] = 0u; }
    __syncthreads();
    XcdBarrier bar; bar.bar = (unsigned*)kparg.ws; bar.x = 0; bar.st = xbst;
    if (hi - lo > 1) bar = xcd_barrier_post((unsigned*)kparg.ws, xbst);
#define IN(k) (lo <= (k) && (k) < hi)
#define SEAM(k) do { if (IN(k) && IN((k) + 1)) { grid_sync((unsigned*)kp.ws, bar.x, xbst); if (PROBE_DUP & 512) grid_sync((unsigned*)kp.ws, bar.x, xbst); } } while (0)
#define PHASE(...) do { if (IN(ph)) { __VA_ARGS__ } SEAM(ph); ++ph; } while (0)
    int ph = 0;
    PHASE(phase_mod(kp, lds); __syncthreads(); phase_conv_ab(kp, lds); if (PROBE_DUP & 32) { __syncthreads(); phase_mod(kp, lds); __syncthreads(); phase_conv_ab(kp, lds); });
#pragma unroll
    for (int g = 0; g < NG; ++g) {
        if (g == 0) PHASE(phase_u(kp, 0, 0, obid(), (int)gridDim.x, false););
        PHASE(phase_gemm_in(kp, lds, 0, g); if (PROBE_DUP & 8) phase_gemm_in(kp, lds, 0, g););
        PHASE(phase_xconv(kp); if (PROBE_DUP & 2048) phase_xconv(kp););
        PHASE(phase_scan_ab(kp, lds); if (PROBE_DUP & 1) { __syncthreads(); phase_scan_ab(kp, lds); });
        PHASE(phase_fin_ab(kp););
        PHASE(phase_gemm_out_ab(kp, lds, g););
        PHASE(phase_r(kp, lds, 0, g););
    }
    PHASE(phase_moe_gather(kp, 0); phase_conv_cd(kp, lds););
    PHASE(phase_moe_gemm(kp, lds, 0, false); if (PROBE_DUP & 16) { __syncthreads(); phase_moe_gemm(kp, lds, 0, false); });
    PHASE(phase_moe_gemm(kp, lds, 0, true); if (PROBE_DUP & 16) { __syncthreads(); phase_moe_gemm(kp, lds, 0, true); });
    PHASE(phase_combine(kp, 0););
#pragma unroll
    for (int g = 0; g < NG; ++g) {
        PHASE(phase_gemm_in(kp, lds, 1, g); if (PROBE_DUP & 8) phase_gemm_in(kp, lds, 1, g););
        PHASE(phase_prep_cd(kp););
        PHASE(phase_upproj(kp, lds); if (PROBE_DUP & 4096) phase_upproj(kp, lds););
        PHASE(phase_mix_cd(kp, lds, 3); if (PROBE_DUP & 2) { __syncthreads(); phase_mix_cd(kp, lds, 1); } if (PROBE_DUP & 4) { __syncthreads(); phase_mix_cd(kp, lds, 2); });
        PHASE(phase_fin_cd(kp, lds); if (PROBE_DUP & 4096) phase_fin_cd(kp, lds););
        PHASE(phase_gemm_out_cd(kp, lds); if (PROBE_DUP & 256) phase_gemm_out_cd(kp, lds););
        PHASE(phase_r(kp, lds, 1, g););
    }
    PHASE(phase_moe_gather(kp, 1); phase_conv_moe(kp, lds, 1, obid(), (int)gridDim.x););
    PHASE(phase_moe_gemm(kp, lds, 1, false););
    PHASE(phase_moe_gemm(kp, lds, 1, true););
    PHASE(phase_combine(kp, 1););
#undef PHASE
#undef IN
#undef SEAM
}

extern "C" void kernel_launch(void* const* d_in, const int* in_sizes, int n_in, void* d_out, int out_size, void* d_ws, size_t ws_size, hipStream_t stream) {
    static int grid = 0;
    if (grid == 0) {
        if (n_in != 42 || out_size != NLAT * D || ws_size < WS_NEED) { fprintf(stderr, "kernel_launch: unexpected shapes: n_in %d out %d ws %zu (need %zu)\n", n_in, out_size, ws_size, (size_t)WS_NEED); grid = -1; return; }
        int dev = 0, cus = 0, per_cu = 0;
        if (hipGetDevice(&dev) != hipSuccess || hipDeviceGetAttribute(&cus, hipDeviceAttributeMultiprocessorCount, dev) != hipSuccess) { grid = -1; return; }
        if (hipFuncSetAttribute((const void*)fwd_kernel, hipFuncAttributeMaxDynamicSharedMemorySize, LDS_BYTES) != hipSuccess) { fprintf(stderr, "kernel_launch: hipFuncSetAttribute failed\n"); grid = -1; return; }
        if (hipOccupancyMaxActiveBlocksPerMultiprocessor(&per_cu, (const void*)fwd_kernel, 512, LDS_BYTES) != hipSuccess || per_cu < 1) { fprintf(stderr, "kernel_launch: occupancy query says %d blocks per CU\n", per_cu); grid = -1; (void)hipGetLastError(); return; }
        grid = cus;
    }
    if (grid < 0) return;
    (void)hipMemsetAsync(d_ws, 0, CTL_BYTES, stream);
    KP kp{};
    for (int i = 0; i < 42; ++i) kp.in[i] = (const float*)d_in[i];
    kp.out = (float*)d_out; kp.ws = (unsigned char*)d_ws;
#if N_LAUNCH_MODE == 1
    kp.ph_lo = 0; kp.ph_hi = N_PHASES;
    hipLaunchKernelGGL(fwd_kernel, dim3(grid), dim3(512), LDS_BYTES, stream, kp);
#else
    for (int p = 0; p < N_PHASES; ++p) { kp.ph_lo = p; kp.ph_hi = p + 1; hipLaunchKernelGGL(fwd_kernel, dim3(grid), dim3(512), LDS_BYTES, stream, kp); }
#endif
}
```

```cpp
#include <hip/hip_runtime.h>
#include <stdint.h>
#include <stdio.h>

typedef unsigned short bf16_t;
typedef short bf16x8 __attribute__((ext_vector_type(8)));
typedef float f32x4 __attribute__((ext_vector_type(4)));
typedef float f32x2 __attribute__((ext_vector_type(2)));
typedef unsigned u32x4 __attribute__((ext_vector_type(4)));
typedef unsigned u32x2 __attribute__((ext_vector_type(2)));

#ifndef RWP
#define RWP 0
#endif
#ifndef PROBE_DUP
#define PROBE_DUP 0
#endif
#ifndef N_LAUNCH_MODE
#define N_LAUNCH_MODE 1
#endif

constexpr int NB = 16, SEQ = 2048, CTXL = 256, TT = 2304, D = 1024;
constexpr int NTOK = NB * TT, NLAT = NB * SEQ;
constexpr int NG = 2, BG = NB / NG, RG = BG * TT, RGL = BG * SEQ;
constexpr float EPS = 1e-6f;
constexpr int AB_N = 5424, AB_NPAD = 5632, AB_Q = 0, AB_K = 512, AB_V = 1024, AB_OG = 2048, AB_IG = 3072, AB_FG = 3080, AB_Z = 3088, AB_XBC = 4112, AB_DT = 5392;
constexpr int CD_N = 4128, CD_NPAD = 4352, CD_M0 = 0, CD_M1 = 384, CD_KR = 640, CD_R = 672, CD_K = 1696, CD_V = 2720, CD_WL = 3744, CD_AL = 3872, CD_GL = 4000;
constexpr int CD_RW0 = 672;

constexpr size_t CTL_BYTES = 32768;
constexpr size_t CTL_CNT = 16384;
constexpr size_t WS_MODV = CTL_BYTES;
constexpr size_t WS_HC   = WS_MODV + (size_t)2 * 17 * 6144 * 4;
constexpr size_t WS_TOKE = WS_HC + (size_t)NB * CTXL * D * 4;
constexpr size_t WS_TOKP = WS_TOKE + (size_t)NTOK * 2 * 4;
constexpr size_t WS_TOKW = WS_TOKP + (size_t)NTOK * 2 * 4;
constexpr size_t WS_LIST = WS_TOKW + (size_t)NTOK * 2 * 4;
constexpr size_t WS_BSC  = WS_LIST + (size_t)16 * NTOK * 4;
constexpr size_t WS_SG   = WS_BSC + (size_t)2 * RGL * 16 * 4;
constexpr size_t WS_WMIX = WS_SG + (size_t)RGL * 128 * 2;
constexpr size_t WMIX_BYTES = (size_t)16 << 20;
constexpr size_t WS_V    = WS_WMIX + WMIX_BYTES;
constexpr size_t WS_BIG  = WS_V + (size_t)NTOK * D * 2;
constexpr size_t WM_AB_IN = 0, WM_AB_OUT = (size_t)AB_NPAD * 1024 * 2;
constexpr size_t WM_CD_IN = 0, WM_CD_OUT = (size_t)CD_NPAD * 1024 * 2, WM_UQ = WM_CD_OUT + (size_t)1024 * 1536 * 2, WM_UKV = WM_UQ + (size_t)768 * 384 * 2, WM_G2 = WM_UKV + (size_t)1024 * 256 * 2;
static_assert(WM_AB_OUT + (size_t)1024 * 2048 * 2 <= WMIX_BYTES, "wmix ab");
static_assert(WM_G2 + (size_t)1024 * 128 * 2 <= WMIX_BYTES, "wmix cd");
constexpr size_t SZ_RG1K = (size_t)RG * 1024 * 2, SZ_RGL1K = (size_t)RGL * 1024 * 2;
constexpr size_t L0_P = 0, L0_AO = (size_t)RG * AB_N * 2  , L0_HB = L0_AO + 2 * SZ_RG1K, L0_YB = L0_HB + SZ_RG1K, L0_U = L0_YB + SZ_RG1K, L0_END = L0_U + SZ_RG1K;
constexpr size_t L1_P = 0, L1_Q = (size_t)RG * CD_N * 2, L1_KV = L1_Q + (size_t)RGL * 768 * 2, L1_OF = L1_KV + SZ_RG1K, L1_OB = L1_OF + SZ_RGL1K, L1_AOUT = L1_OB + SZ_RGL1K, L1_U = L1_AOUT + (size_t)RGL * 1536 * 2, L1_TWAL = L1_U + SZ_RG1K  , L1_END = L1_TWAL + (size_t)RG * 256 * 2;
constexpr int MOE_PADROWS = 16 * 256;
constexpr size_t MO_WUP = 0, MO_WDN = (size_t)17 * 1024 * 1024 * 2, MO_HID = MO_WDN + (size_t)17 * 1024 * 512 * 2;
constexpr size_t MO_XG = MO_HID + (size_t)(3 * NTOK + MOE_PADROWS) * 512 * 2;
constexpr size_t MO_CON = MO_XG, MO_END = MO_CON + (size_t)(3 * NTOK + MOE_PADROWS) * 1024 * 2;
constexpr size_t BIG_BYTES = MO_END > L0_END ? (MO_END > L1_END ? MO_END : L1_END) : (L0_END > L1_END ? L0_END : L1_END);
constexpr size_t WS_NEED = WS_BIG + BIG_BYTES;

constexpr int LDS_BYTES = 151552;

__device__ __forceinline__ float bf2f(unsigned short h) { return __uint_as_float(((unsigned)h) << 16); }
typedef __bf16 bf16v2_t __attribute__((ext_vector_type(2)));
__device__ __forceinline__ unsigned pack2(float a, float b) { const bf16v2_t h = __builtin_convertvector((f32x2){a, b}, bf16v2_t); return __builtin_bit_cast(unsigned, h); }
__device__ __forceinline__ unsigned short f2bf(float f) { const __bf16 h = (__bf16)f; return __builtin_bit_cast(unsigned short, h); }
__device__ __forceinline__ float lo2f(unsigned w) { return __uint_as_float(w << 16); }
__device__ __forceinline__ float hi2f(unsigned w) { return __uint_as_float(w & 0xffff0000u); }
__device__ __forceinline__ float wsum(float v) {
#pragma unroll
    for (int o = 32; o; o >>= 1) v += __shfl_xor(v, o);
    return v; }
template <int CTRL> __device__ __forceinline__ float dpp_mov(float x) { return __builtin_bit_cast(float, __builtin_amdgcn_update_dpp(0, __builtin_bit_cast(int, x), CTRL, 0xf, 0xf, true)); }
__device__ __forceinline__ float rsum16(float x) { x += dpp_mov<0xB1>(x); x += dpp_mov<0x4E>(x); x += dpp_mov<0x124>(x); x += dpp_mov<0x128>(x); return x; }
template <int CTRL, int RM> __device__ __forceinline__ float dpp_upd(float old, float x) { return __builtin_bit_cast(float, __builtin_amdgcn_update_dpp(__builtin_bit_cast(int, old), __builtin_bit_cast(int, x), CTRL, RM, 0xf, false)); }
__device__ __forceinline__ float wscan_add(float x) { x += dpp_upd<0x111, 0xf>(0.f, x); x += dpp_upd<0x112, 0xf>(0.f, x); x += dpp_upd<0x114, 0xf>(0.f, x); x += dpp_upd<0x118, 0xf>(0.f, x);
    x += dpp_upd<0x142, 0xa>(0.f, x); x += dpp_upd<0x143, 0xc>(0.f, x); return x; }
__device__ __forceinline__ float wscan_max(float x) { const float ni = -__builtin_inff();
    x = fmaxf(x, dpp_upd<0x111, 0xf>(ni, x)); x = fmaxf(x, dpp_upd<0x112, 0xf>(ni, x)); x = fmaxf(x, dpp_upd<0x114, 0xf>(ni, x)); x = fmaxf(x, dpp_upd<0x118, 0xf>(ni, x));
    x = fmaxf(x, dpp_upd<0x142, 0xa>(ni, x)); x = fmaxf(x, dpp_upd<0x143, 0xc>(ni, x)); return x; }
__device__ __forceinline__ float lane63(float x) { return __builtin_bit_cast(float, __builtin_amdgcn_readlane(__builtin_bit_cast(int, x), 63)); }
__device__ __forceinline__ float xmax_rows(float x) {
    const auto a = __builtin_amdgcn_permlane16_swap(__builtin_bit_cast(unsigned, x), __builtin_bit_cast(unsigned, x), false, false);
    const unsigned a0 = a[0], a1 = a[1]; x = fmaxf(__builtin_bit_cast(float, a0), __builtin_bit_cast(float, a1));
    const auto b = __builtin_amdgcn_permlane32_swap(__builtin_bit_cast(unsigned, x), __builtin_bit_cast(unsigned, x), false, false);
    const unsigned b0 = b[0], b1 = b[1]; return fmaxf(__builtin_bit_cast(float, b0), __builtin_bit_cast(float, b1)); }
__device__ __forceinline__ float frcp_(float x) { return __builtin_amdgcn_rcpf(x); }
__device__ __forceinline__ float sigmoidf_(float x) { return __builtin_amdgcn_rcpf(1.0f + __expf(-x)); }
__device__ __forceinline__ float siluf_(float x) { return x * __builtin_amdgcn_rcpf(1.0f + __expf(-x)); }
__device__ __forceinline__ float softplusf_(float x) { return fmaxf(x, 0.0f) + __logf(1.0f + __expf(-fabsf(x))); }
__device__ __forceinline__ float logsigmoidf_(float x) { return fminf(x, 0.0f) - __logf(1.0f + __expf(-fabsf(x))); }
__device__ __forceinline__ float tanhf_(float x) { return 1.0f - 2.0f * __builtin_amdgcn_rcpf(__expf(2.0f * x) + 1.0f); }
__device__ __forceinline__ f32x4 mma16(bf16x8 a, bf16x8 b, f32x4 c) { return __builtin_amdgcn_mfma_f32_16x16x32_bf16(a, b, c, 0, 0, 0); }
__device__ __forceinline__ bf16x8 ldfrag(const bf16_t* base, int ld, int row0, int k0, int fr, int fq) { return *(const bf16x8*)(base + (row0 + fr) * ld + k0 + fq * 8); }
__device__ __forceinline__ void st4bf(bf16_t* p, f32x4 v) { u32x2 w; w.x = pack2(v[0], v[1]); w.y = pack2(v[2], v[3]); *(u32x2*)p = w; }
__device__ __forceinline__ f32x4 ld4bf(const bf16_t* p) { u32x2 w = *(const u32x2*)p; return (f32x4){lo2f(w.x), hi2f(w.x), lo2f(w.y), hi2f(w.y)}; }

#define PHASE_FN __device__ __forceinline__
__device__ __forceinline__ int otid() { int t = threadIdx.x; asm volatile("" : "+v"(t)); return t; }
__device__ __forceinline__ int obid() { int t = blockIdx.x; asm volatile("" : "+s"(t)); return t; }
template <class T> __device__ __forceinline__ T* as_global(T* p) { return p; }
__device__ __forceinline__ void lds_barrier() { asm volatile("s_waitcnt lgkmcnt(0)" ::: "memory"); __builtin_amdgcn_s_barrier(); asm volatile("" ::: "memory"); }
constexpr float W8_SCALE = 64.0f, W8_INV = 1.0f / 64.0f;
__device__ __forceinline__ unsigned pack4f8(float a, float b, float c, float d) { unsigned r = 0; r = __builtin_amdgcn_cvt_pk_fp8_f32(a, b, r, false); r = __builtin_amdgcn_cvt_pk_fp8_f32(c, d, r, true); return r; }
__device__ __forceinline__ void st4f8(unsigned char* p, f32x4 v) { *(unsigned*)p = pack4f8(v[0], v[1], v[2], v[3]); }
struct KP { const float* in[42]; float* out; unsigned char* ws; int ph_lo, ph_hi; };

#define XB_TMO      128
#define XB_XCNT(j)  (256  + 64 * (j))
#define XB_XSUB(j)  (1280 + 64 * (j))
#define XB_XGEN(j)  (2304 + 64 * (j))
#define XB_TOP      3328
#define XB_TOPGEN   3392
#define XCD_BAR_WORDS 3456
#define XB_SPIN_CAP (1u << 18)
#define LAS __attribute__((address_space(3)))

__device__ __forceinline__ unsigned xb_ld(unsigned* p)              { return __hip_atomic_load(p, __ATOMIC_RELAXED, __HIP_MEMORY_SCOPE_AGENT); }
__device__ __forceinline__ unsigned xb_add(unsigned* p, unsigned v) { return __hip_atomic_fetch_add(p, v, __ATOMIC_RELAXED, __HIP_MEMORY_SCOPE_AGENT); }
__device__ __forceinline__ unsigned xb_xcc_id() { return (unsigned)__builtin_amdgcn_s_getreg((3 << 11) | 20) & 0xFu; }
#define XB_SPIN(cond, bar) do { unsigned _sp = 0; while (cond) { __builtin_amdgcn_s_sleep(1); \
    if ((++_sp & 255u) == 0u) { if (xb_ld(&(bar)[XB_TMO])) break; if (_sp > XB_SPIN_CAP) { atomicAdd(&(bar)[XB_TMO], 1u); break; } } } } while (0)

struct XcdBarrier {
    unsigned* bar; unsigned x;
    volatile LAS unsigned* st;
};

__device__ __forceinline__ XcdBarrier xcd_barrier_post(unsigned* bar, volatile LAS unsigned* st) {
    XcdBarrier b; b.bar = bar; b.x = xb_xcc_id(); b.st = st;
    if (threadIdx.x == 0) (void)xb_add(&bar[XB_XCNT(b.x)], 1u);
    return b;
}
__device__ __forceinline__ void xcd_barrier_complete(unsigned* bar, unsigned x, unsigned& nloc, unsigned& nx) {
    const unsigned G = gridDim.x * gridDim.y * gridDim.z;
    unsigned sum, cnt, mine, sp = 0u;
    for (;;) {
        sum = 0u; cnt = 0u; mine = 0u;
#pragma unroll
        for (unsigned j = 0; j < 16; ++j) { const unsigned c = xb_ld(&bar[XB_XCNT(j)]); sum += c; cnt += (c > 0u) ? 1u : 0u; mine = (j == x) ? c : mine; }
        if (sum == G) break;
        __builtin_amdgcn_s_sleep(1);
        if ((++sp & 255u) == 0u) { if (xb_ld(&bar[XB_TMO])) break; if (sp > XB_SPIN_CAP) { atomicAdd(&bar[XB_TMO], 1u); break; } }
    }
    nloc = mine > 0u ? mine : 1u; nx = cnt > 0u ? cnt : 1u;
}

__device__ __forceinline__ void xcd_barrier(const XcdBarrier& b) {
    asm volatile("s_waitcnt vmcnt(0)" ::: "memory");
    __syncthreads();
    if (threadIdx.x == 0) {
        unsigned* bar = b.bar;
        __builtin_amdgcn_s_waitcnt(0);
        unsigned nloc = b.st[0], nx = b.st[1];
        if (nloc == 0u) { xcd_barrier_complete(bar, b.x, nloc, nx); b.st[0] = nloc; b.st[1] = nx; }
        const unsigned old = xb_add(&bar[XB_XSUB(b.x)], 1u);
        const unsigned gen = old / nloc;
        if (old + 1u == (gen + 1u) * nloc) {
            __builtin_amdgcn_fence(__ATOMIC_RELEASE, "agent");
            asm volatile("s_waitcnt vmcnt(0)" ::: "memory");
            const unsigned og = xb_add(&bar[XB_TOP], 1u);
            const unsigned tg = og / nx;
            if (og + 1u == (tg + 1u) * nx) xb_add(&bar[XB_TOPGEN], 1u);
            else XB_SPIN(xb_ld(&bar[XB_TOPGEN]) == tg, bar);
            __builtin_amdgcn_fence(__ATOMIC_ACQUIRE, "agent");
            xb_add(&bar[XB_XGEN(b.x)], 1u);
            asm volatile("s_waitcnt vmcnt(0)" ::: "memory");
        } else {
            XB_SPIN(xb_ld(&bar[XB_XGEN(b.x)]) == gen, bar);
            __builtin_amdgcn_fence(__ATOMIC_ACQUIRE, "agent");
            asm volatile("s_waitcnt vmcnt(0)" ::: "memory");
        }
    }
    __syncthreads();
}
struct GA {
    const bf16_t* a0; const bf16_t* a1;
    int ld0, ld1, ksplit;
    const int* list;
    int nrows;
    int mode;
    int row0;
};
constexpr int G_LDT = 40;
constexpr int GEMM_LDS = (2 * 256 * G_LDT + 2 * 128 * G_LDT) * 2;

template <class Epi>
__device__ __forceinline__ void gemm_tile(unsigned char* lds, const GA& ga, const bf16_t* __restrict__ Bt, int K, int mt, int nt, const Epi& epi) {
    const int tid = otid(), lane = tid & 63, wid = __builtin_amdgcn_readfirstlane(tid >> 6), wm = wid >> 1, wn = wid & 1, fr = lane & 15, fq = lane >> 4;
    bf16_t* sA = (bf16_t*)lds;
    bf16_t* sB = sA + 2 * 256 * G_LDT;
    const int kp = tid & 3;
    const int r0 = tid >> 2, r1 = r0 + 128;
    int s0, s1;
    {
        int lr = mt * 256 + r0; if (lr >= ga.nrows) lr = 0;
        s0 = ga.list ? ga.list[lr] : (ga.mode == 1 ? (lr >> 11) * TT + CTXL + (lr & 2047) : ga.row0 + lr);
        lr = mt * 256 + r1; if (lr >= ga.nrows) lr = 0;
        s1 = ga.list ? ga.list[lr] : (ga.mode == 1 ? (lr >> 11) * TT + CTXL + (lr & 2047) : ga.row0 + lr);
    }
    const bf16_t* pa00 = ga.a0 + (size_t)s0 * ga.ld0 + kp * 8;
    const bf16_t* pa01 = ga.a0 + (size_t)s1 * ga.ld0 + kp * 8;
    const bf16_t* pa10 = ga.a1 ? ga.a1 + (size_t)s0 * ga.ld1 + kp * 8 : pa00;
    const bf16_t* pa11 = ga.a1 ? ga.a1 + (size_t)s1 * ga.ld1 + kp * 8 : pa01;
    const bf16_t* pb = Bt + (size_t)(nt * 128 + r0) * K + kp * 8;
    const int ksplit = ga.ksplit;
    f32x4 acc[4][4];
#pragma unroll
    for (int i = 0; i < 4; ++i)
#pragma unroll
        for (int j = 0; j < 4; ++j) acc[i][j] = (f32x4){0.f, 0.f, 0.f, 0.f};
    const int nk = K >> 5;
    u32x4 ra0, ra1, rb;
    {
        ra0 = *(const u32x4*)(pa00); ra1 = *(const u32x4*)(pa01); rb = *(const u32x4*)(pb);
        if (0 >= ksplit) { ra0 = *(const u32x4*)(pa10); ra1 = *(const u32x4*)(pa11); }
    }
    *(u32x4*)(sA + (r0) * G_LDT + kp * 8) = ra0;
    *(u32x4*)(sA + (r1) * G_LDT + kp * 8) = ra1;
    *(u32x4*)(sB + (r0) * G_LDT + kp * 8) = rb;
    __syncthreads();
    for (int kt = 0; kt < nk; ++kt) {
        const int cur = kt & 1;
        if (kt + 1 < nk) {
            const int k0 = (kt + 1) << 5;
            if (k0 < ksplit) { ra0 = *(const u32x4*)(pa00 + k0); ra1 = *(const u32x4*)(pa01 + k0); }
            else { ra0 = *(const u32x4*)(pa10 + (k0 - ksplit)); ra1 = *(const u32x4*)(pa11 + (k0 - ksplit)); }
            rb = *(const u32x4*)(pb + k0);
        }
        const bf16_t* cA = sA + cur * 256 * G_LDT;
        const bf16_t* cB = sB + cur * 128 * G_LDT;
        bf16x8 af[4], bfr[4];
#pragma unroll
        for (int i = 0; i < 4; ++i) af[i] = ldfrag(cA, G_LDT, wm * 64 + i * 16, 0, fr, fq);
#pragma unroll
        for (int j = 0; j < 4; ++j) bfr[j] = ldfrag(cB, G_LDT, wn * 64 + j * 16, 0, fr, fq);
#pragma unroll
        for (int i = 0; i < 4; ++i)
#pragma unroll
            for (int j = 0; j < 4; ++j) acc[i][j] = mma16(bfr[j], af[i], acc[i][j]);
        if (kt + 1 < nk) {
            const int nb = cur ^ 1;
            *(u32x4*)(sA + (nb * 256 + r0) * G_LDT + kp * 8) = ra0;
            *(u32x4*)(sA + (nb * 256 + r1) * G_LDT + kp * 8) = ra1;
            *(u32x4*)(sB + (nb * 128 + r0) * G_LDT + kp * 8) = rb;
        }
        __syncthreads();
    }
    epi(acc, mt * 256 + wm * 64, nt * 128 + wn * 64, fr, fq);
}

struct EpiBf {
    bf16_t* out; int ld, nrows, ncols;
    __device__ __forceinline__ void operator()(const f32x4 (&acc)[4][4], int rb, int cb, int fr, int fq) const {
#pragma unroll
        for (int i = 0; i < 4; ++i) { const int lr = rb + i * 16 + fr; if (lr < nrows) {
#pragma unroll
            for (int j = 0; j < 4; ++j) { const int col = cb + j * 16 + fq * 4; if (col < ncols) st4bf(out + (size_t)lr * ld + col, acc[i][j]); } } }
    }
};
struct EpiSwiglu {
    bf16_t* out; int nrows;
    __device__ __forceinline__ void operator()(const f32x4 (&acc)[4][4], int rb, int cb, int fr, int fq) const {
#pragma unroll
        for (int i = 0; i < 4; ++i) { const int lr = rb + i * 16 + fr; if (lr < nrows) {
#pragma unroll
            for (int j = 0; j < 2; ++j) { const int col = (cb >> 1) + j * 16 + fq * 4; f32x4 g = acc[i][j], u = acc[i][j + 2], o;
#pragma unroll
                for (int r = 0; r < 4; ++r) o[r] = siluf_(g[r]) * u[r];
                st4bf(out + (size_t)lr * 512 + col, o); } } }
    }
};

namespace pg8 {
#define PG8_LAS __attribute__((address_space(3)))
typedef unsigned short bf16_t;
typedef short bf16x8 __attribute__((ext_vector_type(8)));
typedef float f32x4 __attribute__((ext_vector_type(4)));
typedef unsigned u32x4 __attribute__((ext_vector_type(4)));
constexpr int BM = 256, BK = 64, HALF = 128, HTB = HALF * BK * 2  , STAGE_BYTES = 8 * HTB, NXCD = 8, WGM = 8;

__host__ __device__ __forceinline__ int lds_byte(int r, int c) { const int st = (r >> 4) * 2 + (c >> 5), rr = r & 15, cc = c & 31, ob = rr * 64 + cc * 2; return st * 1024 + (ob ^ (((ob >> 9) & 1) << 5)); }
__host__ __device__ __forceinline__ void stage_rc(int b, int& R, int& C) { const int st = b / 1024, sb = b % 1024, swz = sb ^ (((sb >> 9) & 1) << 5); R = (st >> 1) * 16 + swz / 64; C = (st & 1) * 32 + (swz % 64) / 2; }
__host__ __device__ __forceinline__ int perm32(int rho) { const int n = rho >> 4, i = rho & 15; return 8 * (i >> 2) + 4 * n + (i & 3); }

struct Unit { int pm, pn; };
struct Gemm { const bf16_t* A; const bf16_t* Bt; int M, N, K; const bf16_t* A2; int pm_split; int lda, amode; };
#define PG8_ABASE(g, pm) ((g).amode == 1 ? (const char*)(g).A + (size_t)(((pm) >> 3) * 2304 + 256 + ((pm) & 7) * 256) * lda_ * 2 : ((pm) < (g).pm_split ? (const char*)(g).A + (size_t)(pm) * tstepA : (const char*)(g).A2 + (size_t)((pm) - (g).pm_split) * tstepA))
struct StaticOrder {
    int nM, nN, nwg, G, c;
    __host__ __device__ void init(int M, int N, int G_, int c_) { nM = M / BM; nN = N / BM; nwg = nM * nN; G = G_; c = c_; }
    __host__ __device__ bool next(int i, Unit& u) const {
        const long L = (long)i * G + c; if (L >= nwg) return false;
        int wgid = (int)L; { const int q = nwg / NXCD, r = nwg % NXCD, xcd = wgid % NXCD, off = wgid / NXCD; wgid = (xcd < r ? xcd * (q + 1) : r * (q + 1) + (xcd - r) * q) + off; }
        const int nig = WGM * nN, gid = wgid / nig, fm = gid * WGM, gsz = (nM - fm) < WGM ? (nM - fm) : WGM;
        u.pm = fm + ((wgid % nig) % gsz); u.pn = (wgid % nig) / gsz; return true;
    }
    __device__ __forceinline__ void a_ready(const Unit&) const {}
    __device__ __forceinline__ void done(const Unit&) const {}
};
__device__ __forceinline__ unsigned cvt_pk_bf16(float lo, float hi) { unsigned r; asm volatile("v_cvt_pk_bf16_f32 %0, %1, %2" : "=v"(r) : "v"(lo), "v"(hi)); return r; }
typedef float f32x2 __attribute__((ext_vector_type(2)));
template <class Epi, class Sched, bool STAMP = false, bool F8 = false>
__device__ __forceinline__ void gemm_phase(PG8_LAS unsigned char* lds, const Gemm g, const Sched& S, const Epi& E, unsigned long long* stamps) {
    const int tid = otid(), wid = __builtin_amdgcn_readfirstlane(tid >> 6), lane = tid & 63, wr = wid >> 2, wc = wid & 3, fr = lane & 15, fq = lane >> 4;
    const int K = g.K, nt = K / BK, lda_ = g.lda ? g.lda : g.K;
    int ts_lo = 0, ts_hi = 0, nts = 0; const unsigned long long rt_entry = STAMP ? (unsigned long long)wall_clock64() : 0ull;
#define PG8_STAMP() do { if (STAMP && wid == 0 && nts < 64) { const unsigned long long _c = (unsigned long long)clock64(); \
        ts_lo = (lane == nts) ? (int)(unsigned)_c : ts_lo; ts_hi = (lane == nts) ? (int)(unsigned)(_c >> 32) : ts_hi; ++nts; } } while (0)
    PG8_STAMP();
    unsigned voffA[2], voffB[2];
#pragma unroll
    for (int i = 0; i < 2; ++i) { int R, C; stage_rc(tid * 16 + i * 8192, R, C); const int Rb = Epi::PERM ? ((R & ~31) + perm32(R & 31)) : R;
        voffA[i] = (unsigned)(R * lda_ + C) * 2u; voffB[i] = (unsigned)(Rb * K + C) * 2u; }
    const size_t kstep = (size_t)(BK * 2);
    const size_t hstep = (size_t)HALF * K * 2;
    const size_t hstepA = (size_t)HALF * lda_ * 2, tstepA = 2 * hstepA;
    const size_t tstep = 2 * hstep;
    const unsigned ldsw = (unsigned)wid * 1024u;
    const int aoff = lds_byte(wr * 64 + fr, fq * 8), boff = lds_byte(wc * 32 + fr, fq * 8);
#define PG8_SA(b, h) (((b) * 2 + (h)) * HTB)
#define PG8_SB(b, h) ((4 + (b) * 2 + (h)) * HTB)
#define PG8_STAGE(bufoff, gbase, voff) do { _Pragma("unroll") for (int _i = 0; _i < 2; ++_i) \
        __builtin_amdgcn_global_load_lds((const unsigned*)((const char*)(gbase) + (voff)[_i]), (PG8_LAS unsigned*)(lds + (bufoff) + ldsw + _i * 8192), 16, 0, 0); } while (0)
#define PG8_LDA(dst, b, h) do { _Pragma("unroll") for (int m = 0; m < 4; ++m) { \
        if constexpr (F8) { dst##8[m].lo = *(const PG8_LAS v4i_*)(lds + PG8_SA(b, h) + aoff + m * 2048); dst##8[m].hi = *(const PG8_LAS v4i_*)(lds + PG8_SA(b, h) + aoff + m * 2048 + 1024); } \
        else { _Pragma("unroll") for (int k = 0; k < 2; ++k) dst[m][k] = *(const PG8_LAS bf16x8*)(lds + PG8_SA(b, h) + aoff + m * 2048 + k * 1024); } } } while (0)
#define PG8_LDB(dst, b, h) do { _Pragma("unroll") for (int n = 0; n < 2; ++n) { \
        if constexpr (F8) { dst##8[n].lo = *(const PG8_LAS v4i_*)(lds + PG8_SB(b, h) + boff + n * 2048); dst##8[n].hi = *(const PG8_LAS v4i_*)(lds + PG8_SB(b, h) + boff + n * 2048 + 1024); } \
        else { _Pragma("unroll") for (int k = 0; k < 2; ++k) dst[n][k] = *(const PG8_LAS bf16x8*)(lds + PG8_SB(b, h) + boff + n * 2048 + k * 1024); } } } while (0)
#define PG8_MMA(ai, bj, At, Bt) do { __builtin_amdgcn_s_setprio(1); _Pragma("unroll") for (int m = 0; m < 4; ++m) _Pragma("unroll") for (int n = 0; n < 2; ++n) { \
        if constexpr (F8) asm volatile("v_mfma_scale_f32_16x16x128_f8f6f4 %0, %1, %2, %0, %3, %3 op_sel_hi:[0,0,0]" : "+v"(acc[ai][bj][m][n]) : "v"(Bt##8[n]), "v"(At##8[m]), "v"(one_scale)); \
        else { _Pragma("unroll") for (int k = 0; k < 2; ++k) acc[ai][bj][m][n] = __builtin_amdgcn_mfma_f32_16x16x32_bf16(Bt[n][k], At[m][k], acc[ai][bj][m][n], 0, 0, 0); } } \
        __builtin_amdgcn_s_setprio(0); } while (0)
#define PG8_WAIT_V(n) asm volatile("s_waitcnt vmcnt(" #n ")" ::: "memory")
#define PG8_WAIT_L(n) asm volatile("s_waitcnt lgkmcnt(" #n ")" ::: "memory")
#define PG8_BAR __builtin_amdgcn_s_barrier()
#define PG8_SCHED __builtin_amdgcn_sched_barrier(0)
    Unit cur, nxt; int ui = 0;
    if (!S.next(0, cur)) return;
    f32x4 acc[2][2][4][2];
#pragma unroll
    for (int a = 0; a < 2; ++a)
#pragma unroll
        for (int b = 0; b < 2; ++b)
#pragma unroll
            for (int m = 0; m < 4; ++m)
#pragma unroll
                for (int n = 0; n < 2; ++n) acc[a][b][m][n] = (f32x4){0.f, 0.f, 0.f, 0.f};
    bf16x8 At[4][2], B0[2][2], B1[2][2];
    typedef int v4i_ __attribute__((ext_vector_type(4))); typedef int v8i_ __attribute__((ext_vector_type(8)));
    v8i_ At8[4], B08[2], B18[2];
    const int one_scale = 0x7f7f7f7f;
    const char* cA = PG8_ABASE(g, cur.pm); const char* cB = (const char*)g.Bt + (size_t)cur.pn * tstep;
    S.a_ready(cur);
    PG8_STAGE(PG8_SB(0, 0), cB, voffB); PG8_STAGE(PG8_SA(0, 0), cA, voffA); PG8_STAGE(PG8_SB(0, 1), cB + hstep, voffB); PG8_STAGE(PG8_SA(0, 1), cA + hstepA, voffA);
    if (wr == 1) PG8_BAR;
    PG8_WAIT_V(4); PG8_BAR;
    PG8_STAGE(PG8_SB(1, 0), cB + kstep, voffB); PG8_STAGE(PG8_SA(1, 0), cA + kstep, voffA); PG8_STAGE(PG8_SB(1, 1), cB + hstep + kstep, voffB);
    PG8_WAIT_V(6); PG8_BAR;
    PG8_STAMP();
    for (;;) {
        const bool has_next = S.next(ui + 1, nxt);
        const char* nA = has_next ? PG8_ABASE(g, nxt.pm) : cA; const char* nB = has_next ? (const char*)g.Bt + (size_t)nxt.pn * tstep : cB;
#pragma unroll 1
        for (int t = 0; t < nt; t += 2) {
            const bool last = (t == nt - 2);
            const char* a1 = cA + (size_t)(t + 1) * kstep;
            const char* a2 = last ? nA : cA + (size_t)(t + 2) * kstep; const char* b2 = last ? nB : cB + (size_t)(t + 2) * kstep;
            const char* a3 = a2 + kstep; const char* b3 = b2 + kstep;
            if (last && has_next) S.a_ready(nxt);
            PG8_LDB(B0, 0, 0); PG8_SCHED; PG8_LDA(At, 0, 0); PG8_STAGE(PG8_SA(1, 1), a1 + hstepA, voffA);
            PG8_WAIT_L(8); PG8_BAR; PG8_WAIT_L(0); PG8_MMA(0, 0, At, B0); PG8_BAR; PG8_SCHED;
            PG8_LDB(B1, 0, 1); PG8_STAGE(PG8_SB(0, 0), b2, voffB);
            PG8_BAR; PG8_WAIT_L(0); PG8_MMA(0, 1, At, B1); PG8_BAR;
            PG8_LDA(At, 0, 1); PG8_STAGE(PG8_SA(0, 0), a2, voffA);
            PG8_BAR; PG8_WAIT_L(0); PG8_MMA(1, 0, At, B0); PG8_BAR; PG8_SCHED;
            PG8_STAGE(PG8_SB(0, 1), b2 + hstep, voffB);
            PG8_WAIT_V(6); PG8_BAR; PG8_MMA(1, 1, At, B1); PG8_BAR;
            PG8_LDB(B0, 1, 0); PG8_SCHED; PG8_LDA(At, 1, 0); PG8_STAGE(PG8_SA(0, 1), a2 + hstepA, voffA);
            PG8_WAIT_L(8); PG8_BAR; PG8_WAIT_L(0); PG8_MMA(0, 0, At, B0); PG8_BAR; PG8_SCHED;
            PG8_LDB(B1, 1, 1); PG8_STAGE(PG8_SB(1, 0), b3, voffB);
            PG8_BAR; PG8_WAIT_L(0); PG8_MMA(0, 1, At, B1); PG8_BAR;
            PG8_LDA(At, 1, 1); PG8_STAGE(PG8_SA(1, 0), a3, voffA);
            PG8_BAR; PG8_WAIT_L(0); PG8_MMA(1, 0, At, B0); PG8_BAR; PG8_SCHED;
            PG8_STAGE(PG8_SB(1, 1), b3 + hstep, voffB);
            PG8_WAIT_V(6); PG8_BAR; PG8_MMA(1, 1, At, B1); PG8_BAR;
        }
        PG8_STAMP();
        if constexpr (F8) asm volatile("s_nop 15\n\ts_nop 15" ::: "memory");
        if constexpr (!Epi::AFTER_DRAIN) { E(acc, cur, wr, wc, fr, fq); S.done(cur); }
        PG8_STAMP();
        if (!has_next) break;
#pragma unroll
        for (int a = 0; a < 2; ++a)
#pragma unroll
            for (int b = 0; b < 2; ++b)
#pragma unroll
                for (int m = 0; m < 4; ++m)
#pragma unroll
                    for (int n = 0; n < 2; ++n) acc[a][b][m][n] = (f32x4){0.f, 0.f, 0.f, 0.f};
        cur = nxt; cA = nA; cB = nB; ++ui;
    }
    PG8_WAIT_V(0);
    if (wr == 0) PG8_BAR;
    PG8_BAR;
    if constexpr (Epi::AFTER_DRAIN) { E.fused(acc, cur, wr, wc, fr, fq, lds, wid, lane); S.done(cur); }
    PG8_STAMP();
    if (STAMP && wid == 0) { stamps[lane] = lane < nts ? (((unsigned long long)(unsigned)ts_hi << 32) | (unsigned)ts_lo) : 0ull;
        if (lane == 62) stamps[62] = rt_entry; if (lane == 63) stamps[63] = (unsigned long long)wall_clock64(); }
#undef PG8_STAMP
#undef PG8_SA
#undef PG8_SB
#undef PG8_STAGE
#undef PG8_LDA
#undef PG8_LDB
#undef PG8_MMA
#undef PG8_WAIT_V
#undef PG8_WAIT_L
#undef PG8_BAR
#undef PG8_SCHED
}
}
namespace pg8 {
struct EpiBfG {
    static constexpr bool PERM = true, AFTER_DRAIN = false;
    bf16_t* O; int ldc, ncols, pn_mask; float oscale;
    __device__ __forceinline__ void operator()(const f32x4 (&acc)[2][2][4][2], const Unit& u, int wr, int wc, int fr, int fq) const {
        const int row0 = u.pm * BM + wr * 64 + fr, col0 = (u.pn & pn_mask) * BM + wc * 32 + 8 * fq;
#pragma unroll
        for (int ai = 0; ai < 2; ++ai)
#pragma unroll
            for (int m = 0; m < 4; ++m) { bf16_t* rowp = O + (size_t)(row0 + ai * HALF + m * 16) * ldc;
#pragma unroll
                for (int bj = 0; bj < 2; ++bj) { const int c = col0 + bj * HALF;
                    if (c < ncols) { const f32x4 v0 = acc[ai][bj][m][0] * oscale, v1 = acc[ai][bj][m][1] * oscale;
                        u32x4 w; w.x = cvt_pk_bf16(v0[0], v0[1]); w.y = cvt_pk_bf16(v0[2], v0[3]); w.z = cvt_pk_bf16(v1[0], v1[1]); w.w = cvt_pk_bf16(v1[2], v1[3]);
                        *(u32x4*)(rowp + c) = w; } } }
    }
};
struct EpiSwi {
    static constexpr bool PERM = true, AFTER_DRAIN = false;
    bf16_t* H;
    __device__ __forceinline__ void operator()(const f32x4 (&acc)[2][2][4][2], const Unit& u, int wr, int wc, int fr, int fq) const {
        const int row0 = u.pm * BM + wr * 64 + fr, hc0 = (u.pn & 3) * HALF + wc * 32 + 8 * fq;
#pragma unroll
        for (int ai = 0; ai < 2; ++ai)
#pragma unroll
            for (int m = 0; m < 4; ++m) { unsigned char* rowp = (unsigned char*)H + (size_t)(row0 + ai * HALF + m * 16) * 1024 + hc0;
                float o[8];
#pragma unroll
                for (int n = 0; n < 2; ++n)
#pragma unroll
                    for (int r = 0; r < 4; ++r) { const float g = acc[ai][0][m][n][r] * W8_INV; o[n * 4 + r] = g * __builtin_amdgcn_rcpf(1.0f + __expf(-g)) * (acc[ai][1][m][n][r] * W8_INV); }
                u32x2 w; w.x = pack4f8(o[0], o[1], o[2], o[3]); w.y = pack4f8(o[4], o[5], o[6], o[7]);
                *(u32x2*)rowp = w; }
    }
};
struct MoeOrder {
    const int* slotmap; int ntiles, G, c;
    __device__ __forceinline__ bool next(int i, Unit& u) const {
        const int L = i * G + c; if (L >= ntiles * 4) return false;
        u.pm = L >> 2; u.pn = __builtin_amdgcn_readfirstlane(slotmap[L >> 2]) * 4 + (L & 3); return true;
    }
    __device__ __forceinline__ void a_ready(const Unit&) const {}
    __device__ __forceinline__ void done(const Unit&) const {}
};
}
#define WSP(T, off) as_global((T*)(kp.ws + (off)))
#define KIN(i) as_global(kp.in[i])
#define KOUT as_global(kp.out)

PHASE_FN void phase_mod(const KP& kp, unsigned char* lds) {
    float* sc = (float*)lds;
    float* red = sc + 17 * 1024;
    float* modv = WSP(float, WS_MODV);
    const int tid = otid();
    for (int i = tid; i < 17 * 1024; i += 512) { const int bb = i >> 10, k = i & 1023; const float c = bb < 16 ? KIN(1)[bb * 1024 + k] : KIN(3)[k]; sc[i] = siluf_(c); }
    __syncthreads();
    const int jc = tid & 63, ks = tid >> 6;
    for (int u = obid(); u < 192; u += gridDim.x) {
        const int l = u / 96, j0 = (u % 96) * 64;
        const float* w = KIN(4) + (size_t)l * 1024 * 6144 + j0 + jc;
        float acc[17];
#pragma unroll
        for (int bb = 0; bb < 17; ++bb) acc[bb] = 0.f;
        for (int k = ks * 128; k < ks * 128 + 128; ++k) {
            const float wv = w[(size_t)k * 6144];
#pragma unroll
            for (int bb = 0; bb < 17; ++bb) acc[bb] += sc[bb * 1024 + k] * wv;
        }
#pragma unroll
        for (int bb = 0; bb < 17; ++bb) red[(ks * 17 + bb) * 64 + jc] = acc[bb];
        __syncthreads();
        for (int i = tid; i < 17 * 64; i += 512) {
            const int bb = i >> 6, j = i & 63; float s = KIN(5)[l * 6144 + j0 + j];
#pragma unroll
            for (int k2 = 0; k2 < 8; ++k2) s += red[(k2 * 17 + bb) * 64 + j];
            modv[((size_t)l * 17 + bb) * 6144 + j0 + j] = s;
        }
        __syncthreads();
    }
}

struct CvJob { const float* src; bf16_t* dst; int N, ldd, mode, kt, ntile, f8; };
__device__ __forceinline__ bool cv_pick(int& u, CvJob& J, const float* src, int K, int N, bf16_t* dst, int mode = 0, int ldd = -1, int f8 = 0) {
    const int ntl = (N + 63) >> 6, cnt = ntl * (K >> 6);
    if (u < cnt) { J.src = src; J.dst = dst; J.N = N; J.ldd = ldd < 0 ? K : ldd; J.mode = mode; J.kt = u / ntl; J.ntile = u % ntl; J.f8 = f8; return true; }
    u -= cnt; return false;
}
__device__ __forceinline__ void cv_load(const CvJob& J, int tid, f32x4 (&r)[2]) {
#pragma unroll
    for (int i = 0; i < 2; ++i) { const int idx = tid + i * 512, k = idx >> 4, n0 = J.ntile * 64 + (idx & 15) * 4;
        r[i] = (n0 < J.N) ? *(const f32x4*)(J.src + (size_t)(J.kt * 64 + k) * J.N + n0) : (f32x4){0.f, 0.f, 0.f, 0.f}; }
}
__device__ __forceinline__ void cv_put(float* tile, int tid, const f32x4 (&r)[2]) {
#pragma unroll
    for (int i = 0; i < 2; ++i) { const int idx = tid + i * 512, k = idx >> 4, nq = (idx & 15) * 4;
        tile[k * 65 + nq] = r[i][0]; tile[k * 65 + nq + 1] = r[i][1]; tile[k * 65 + nq + 2] = r[i][2]; tile[k * 65 + nq + 3] = r[i][3]; }
}
__device__ __forceinline__ void cv_store(const float* tile, const CvJob& J, int tid) {
    const int nl = tid >> 3, k8 = tid & 7, n = J.ntile * 64 + nl;
    if (n < J.N) { int row = n; if (J.mode) row = (n >> 7) * 256 + (n & 127) + (J.mode == 2 ? 128 : 0);
        const float* tp = tile + (k8 * 8) * 65 + nl;
        if (J.f8) { u32x2 w; w.x = pack4f8(tp[0] * W8_SCALE, tp[65] * W8_SCALE, tp[130] * W8_SCALE, tp[195] * W8_SCALE); w.y = pack4f8(tp[260] * W8_SCALE, tp[325] * W8_SCALE, tp[390] * W8_SCALE, tp[455] * W8_SCALE);
            *(u32x2*)((unsigned char*)J.dst + (size_t)row * J.ldd + J.kt * 64 + k8 * 8) = w; }
        else { u32x4 w; w.x = pack2(tp[0], tp[65]); w.y = pack2(tp[130], tp[195]); w.z = pack2(tp[260], tp[325]); w.w = pack2(tp[390], tp[455]);
            *(u32x4*)(J.dst + (size_t)row * J.ldd + J.kt * 64 + k8 * 8) = w; } }
}
#define CV_RUN(total, PICK) CV_RUN_ON(total, PICK, obid(), (int)gridDim.x)
#define CV_RUN_ON(total, PICK, bid_, nb_) do { float* tile = (float*)lds; const int tid = otid(); const int G_ = (nb_); int u_ = (bid_); CvJob J, Jn; f32x4 r[2]; \
        if (u_ < (total)) { int u = u_; PICK(u, J); cv_load(J, tid, r); } \
        while (u_ < (total)) { cv_put(tile, tid, r); __syncthreads(); const int un_ = u_ + G_; \
            if (un_ < (total)) { int u = un_; PICK(u, Jn); cv_load(Jn, tid, r); } \
            cv_store(tile, J, tid); __syncthreads(); u_ = un_; J = Jn; } } while (0)
PHASE_FN void phase_conv_ab(const KP& kp, unsigned char* lds) {
#define PICK_AB(u, J) do { if (!cv_pick(u, J, KIN(7), 1024, AB_N, WSP(bf16_t, WS_WMIX + WM_AB_IN))) cv_pick(u, J, KIN(8), 2048, 1024, WSP(bf16_t, WS_WMIX + WM_AB_OUT)); } while (0)
    CV_RUN(16 * 85 + 32 * 16, PICK_AB);
#undef PICK_AB
}
PHASE_FN void phase_conv_cd(const KP& kp, unsigned char* lds) {
#define PICK_CD(u, J) do { if (cv_pick(u, J, KIN(18), 1024, CD_N, WSP(bf16_t, WS_WMIX + WM_CD_IN), 0, 1024, 1)) break;     \
        if (cv_pick(u, J, KIN(19), 1536, 1024, WSP(bf16_t, WS_WMIX + WM_CD_OUT))) break; \
        if (cv_pick(u, J, KIN(21), 384, 768, WSP(bf16_t, WS_WMIX + WM_UQ))) break; \
        if (cv_pick(u, J, KIN(23), 256, 1024, WSP(bf16_t, WS_WMIX + WM_UKV))) break; \
        cv_pick(u, J, KIN(29), 128, 1024, WSP(bf16_t, WS_WMIX + WM_G2)); } while (0)
    CV_RUN(16 * 65 + 24 * 16 + 6 * 12 + 4 * 16 + 2 * 16, PICK_CD);
#undef PICK_CD
}
PHASE_FN void phase_conv_moe(const KP& kp, unsigned char* lds, int l, int bid, int nb) {
#define PICK_MOE(u0, J) do { const int es = (u0) / 384; int uu = (u0) % 384; \
        const float* wg = es < 16 ? KIN(36) + ((size_t)l * 16 + es) * 1024 * 512 : KIN(39) + (size_t)l * 1024 * 512; \
        const float* wu = es < 16 ? KIN(37) + ((size_t)l * 16 + es) * 1024 * 512 : KIN(40) + (size_t)l * 1024 * 512; \
        const float* wd = es < 16 ? KIN(38) + ((size_t)l * 16 + es) * 512 * 1024 : KIN(41) + (size_t)l * 512 * 1024; \
        bf16_t* dup = (bf16_t*)(WSP(unsigned char, WS_BIG + MO_WUP) + (size_t)es * 1024 * 1024); bf16_t* ddn = (bf16_t*)(WSP(unsigned char, WS_BIG + MO_WDN) + (size_t)es * 1024 * 512); \
        if (cv_pick(uu, J, wg, 1024, 512, dup, 1, 1024, 1)) break; if (cv_pick(uu, J, wu, 1024, 512, dup, 2, 1024, 1)) break; cv_pick(uu, J, wd, 512, 1024, ddn, 0, 512, 1); } while (0)
    CV_RUN_ON(17 * 384, PICK_MOE, bid, nb);
#undef PICK_MOE
}

__device__ __forceinline__ const float* hrow_rd(const KP& kp, bool from_inputs, int b, int t) {
    if (t < CTXL) return (from_inputs ? KIN(2) : WSP(const float, WS_HC)) + ((size_t)b * CTXL + t) * D;
    return (from_inputs ? KIN(0) : KOUT) + ((size_t)b * SEQ + (t - CTXL)) * D;
}
__device__ __forceinline__ float* hrow_wr(const KP& kp, int b, int t) {
    if (t < CTXL) return WSP(float, WS_HC) + ((size_t)b * CTXL + t) * D;
    return KOUT + ((size_t)b * SEQ + (t - CTXL)) * D;
}

PHASE_FN void phase_u(const KP& kp, int layer, int g, int bid, int nb, bool to_v) {
    const int lane = otid() & 63, wid = __builtin_amdgcn_readfirstlane(otid() >> 6);
    const float* modv = WSP(const float, WS_MODV) + (size_t)layer * 17 * 6144;
    const float* ng = KIN(6) + (size_t)layer * 4 * 1024;
    bf16_t* U = to_v ? WSP(bf16_t, WS_V) + (size_t)RG * 1024 : WSP(bf16_t, WS_BIG + (layer == 0 ? L0_U : L1_U));
    for (int lr = bid * 8 + wid; lr < RG; lr += nb * 8) {
        const int bl = lr / TT, t = lr - bl * TT, b = g * BG + bl;
        const float* src = hrow_rd(kp, layer == 0, b, t);
        const float* mv = modv + (size_t)(t < CTXL ? 16 : b) * 6144;
        f32x4 x[4]; float ss = 0.f;
#pragma unroll
        for (int i = 0; i < 4; ++i) { x[i] = *(const f32x4*)(src + i * 256 + lane * 4); ss += x[i][0] * x[i][0] + x[i][1] * x[i][1] + x[i][2] * x[i][2] + x[i][3] * x[i][3]; }
        ss = wsum(ss); const float rstd = rsqrtf(ss * (1.0f / 1024.0f) + EPS);
#pragma unroll
        for (int i = 0; i < 4; ++i) { const int col = i * 256 + lane * 4;
            const f32x4 gv = *(const f32x4*)(ng + col), sc = *(const f32x4*)(mv + 1024 + col), sh = *(const f32x4*)(mv + col);
            st4bf(U + (size_t)lr * 1024 + col, x[i] * rstd * gv * (sc + 1.0f) + sh); }
    }
}

PHASE_FN void phase_r(const KP& kp, unsigned char* lds, int layer, int g) {
    const int tid = otid(), lane = tid & 63, wid = __builtin_amdgcn_readfirstlane(tid >> 6);
    float* rw = (float*)lds;
    int* se = (int*)(rw + 1024 * 16);
    int* sbase = se + 160;
    for (int i = tid; i < 1024 * 16; i += 512) rw[i] = KIN(34)[i];
    __syncthreads();
    const float* modv = WSP(const float, WS_MODV) + (size_t)layer * 17 * 6144;
    const float* ng = KIN(6) + (size_t)layer * 4 * 1024;
    const bf16_t* MIX = WSP(const bf16_t, WS_BIG + (layer == 0 ? L0_U : L1_U));
    bf16_t* V = WSP(bf16_t, WS_V);
    unsigned* cnt = WSP(unsigned, CTL_CNT) + layer * 16;
    int* TOKE = WSP(int, WS_TOKE); int* TOKP = WSP(int, WS_TOKP); float* TOKW = WSP(float, WS_TOKW); int* LIST = WSP(int, WS_LIST);
    const int nrows = layer == 0 ? RG : RGL, CH = layer == 0 ? 72 : 64, RW = CH >> 3, nchunks = nrows / CH;
    float rbias[16];
#pragma unroll
    for (int e = 0; e < 16; ++e) rbias[e] = KIN(35)[e];
    for (int ch = obid(); ch < nchunks; ch += gridDim.x) {
        for (int rr = 0; rr < RW; ++rr) {
            const int rl = wid * RW + rr, lr = ch * CH + rl;
            int b, t, tok;
            if (layer == 0) { const int bl = lr / TT; t = lr - bl * TT; b = g * BG + bl; tok = g * RG + lr; }
            else { const int bl = lr >> 11; t = CTXL + (lr & 2047); b = g * BG + bl; tok = g * RGL + lr; }
            const float* hsrc = hrow_rd(kp, layer == 0, b, t);
            float* hdst = hrow_wr(kp, b, t);
            const float* mv = modv + (size_t)(t < CTXL ? 16 : b) * 6144;
            f32x4 y[4], h[4]; float ss = 0.f;
#pragma unroll
            for (int i = 0; i < 4; ++i) { y[i] = ld4bf(MIX + (size_t)lr * 1024 + i * 256 + lane * 4); ss += y[i][0] * y[i][0] + y[i][1] * y[i][1] + y[i][2] * y[i][2] + y[i][3] * y[i][3]; }
            ss = wsum(ss); float rstd = rsqrtf(ss * (1.0f / 1024.0f) + EPS);
            float s2 = 0.f;
#pragma unroll
            for (int i = 0; i < 4; ++i) { const int col = i * 256 + lane * 4;
                const f32x4 g1 = *(const f32x4*)(ng + 1024 + col), ga = *(const f32x4*)(mv + 2048 + col), hx = *(const f32x4*)(hsrc + col);
                h[i] = hx + ga * (y[i] * rstd * g1);
                *(f32x4*)(hdst + col) = h[i];
                s2 += h[i][0] * h[i][0] + h[i][1] * h[i][1] + h[i][2] * h[i][2] + h[i][3] * h[i][3]; }
            s2 = wsum(s2); rstd = rsqrtf(s2 * (1.0f / 1024.0f) + EPS);
            float lg[16];
#pragma unroll
            for (int e = 0; e < 16; ++e) lg[e] = 0.f;
#pragma unroll
            for (int i = 0; i < 4; ++i) { const int col = i * 256 + lane * 4;
                const f32x4 g2 = *(const f32x4*)(ng + 2048 + col), scf = *(const f32x4*)(mv + 4096 + col), shf = *(const f32x4*)(mv + 3072 + col);
                const f32x4 v = h[i] * rstd * g2 * (scf + 1.0f) + shf;
                st4f8((unsigned char*)V + (size_t)tok * 2048 + col, v);
#pragma unroll
                for (int j = 0; j < 4; ++j) {
#pragma unroll
                    for (int q = 0; q < 4; ++q) { const f32x4 w4 = *(const f32x4*)(rw + (col + j) * 16 + q * 4);
                        lg[q * 4 + 0] += v[j] * w4[0]; lg[q * 4 + 1] += v[j] * w4[1]; lg[q * 4 + 2] += v[j] * w4[2]; lg[q * 4 + 3] += v[j] * w4[3]; } } }
#pragma unroll
            for (int e = 0; e < 16; ++e) lg[e] = wsum(lg[e]);
            float aff[16], sel[16];
#pragma unroll
            for (int e = 0; e < 16; ++e) { aff[e] = sigmoidf_(lg[e]); sel[e] = aff[e] + rbias[e]; }
            float gs[4];
#pragma unroll
            for (int gi = 0; gi < 4; ++gi) { const float a0 = sel[gi * 4], a1 = sel[gi * 4 + 1], a2 = sel[gi * 4 + 2], a3 = sel[gi * 4 + 3];
                gs[gi] = fmaxf(fmaxf(fmaxf(a0 + a1, a0 + a2), fmaxf(a0 + a3, a1 + a2)), fmaxf(a1 + a3, a2 + a3)); }
            int gidx = 0; float gb = gs[0];
#pragma unroll
            for (int gi = 1; gi < 4; ++gi) if (gs[gi] > gb) { gb = gs[gi]; gidx = gi; }
            float c[4], f[4];
#pragma unroll
            for (int i = 0; i < 4; ++i) { c[i] = gidx == 0 ? sel[i] : gidx == 1 ? sel[4 + i] : gidx == 2 ? sel[8 + i] : sel[12 + i];
                                           f[i] = gidx == 0 ? aff[i] : gidx == 1 ? aff[4 + i] : gidx == 2 ? aff[8 + i] : aff[12 + i]; }
            int i1 = 0; float cb = c[0];
#pragma unroll
            for (int i = 1; i < 4; ++i) if (c[i] > cb) { cb = c[i]; i1 = i; }
            int i2 = -1; float cb2 = 0.f;
#pragma unroll
            for (int i = 0; i < 4; ++i) if (i != i1 && (i2 < 0 || c[i] > cb2)) { cb2 = c[i]; i2 = i; }
            float w1 = i1 == 0 ? f[0] : i1 == 1 ? f[1] : i1 == 2 ? f[2] : f[3];
            float w2 = i2 == 0 ? f[0] : i2 == 1 ? f[1] : i2 == 2 ? f[2] : f[3];
            const float wsn = 1.0f / (w1 + w2); w1 *= wsn; w2 *= wsn;
            if (lane == 0) { se[rl * 2] = gidx * 4 + i1; se[rl * 2 + 1] = gidx * 4 + i2;
                TOKE[tok * 2] = gidx * 4 + i1; TOKE[tok * 2 + 1] = gidx * 4 + i2; TOKW[tok * 2] = w1; TOKW[tok * 2 + 1] = w2; }
        }
        __syncthreads();
        if (tid < 16) { int c2 = 0; for (int i = 0; i < 2 * CH; ++i) c2 += (se[i] == tid) ? 1 : 0; sbase[tid] = (int)atomicAdd(&cnt[tid], (unsigned)c2); }
        __syncthreads();
        if (tid < 2 * CH) { const int e = se[tid]; int rank = 0; for (int j = 0; j < tid; ++j) rank += (se[j] == e) ? 1 : 0;
            const int pos = sbase[e] + rank; const int lr = ch * CH + (tid >> 1); const int tok = (layer == 0 ? g * RG : g * RGL) + lr;
            LIST[(size_t)e * NTOK + pos] = tok; TOKP[tok * 2 + (tid & 1)] = pos; }
        __syncthreads();
    }
}

__device__ __forceinline__ int moe_tile_prefix(const unsigned* cnt, int ntok, int lane) {
    const int myt = lane < 16 ? (int)((cnt[lane & 15] + 255u) >> 8) : 0; int pref = myt;
#pragma unroll
    for (int o = 1; o < 16; o <<= 1) { const int t = __shfl_up(pref, o); if (lane >= o) pref += t; }
    return pref - myt + ntok / 256;
}
PHASE_FN void phase_moe_gather(const KP& kp, int layer) {
    const int lane = otid() & 63, wid = __builtin_amdgcn_readfirstlane(otid() >> 6);
    const int ntok = layer == 0 ? NTOK : NLAT;
    const int tpre = moe_tile_prefix(WSP(const unsigned, CTL_CNT) + layer * 16, ntok, lane);
    const bf16_t* V = WSP(const bf16_t, WS_V); bf16_t* XG = WSP(bf16_t, WS_BIG + MO_XG);
    const int* TOKE = WSP(const int, WS_TOKE); const int* TOKP = WSP(const int, WS_TOKP);
    for (int it = obid() * 8 + wid; it < 2 * ntok; it += gridDim.x * 8) {
        const int tok = it >> 1, e = TOKE[it], pos = TOKP[it];
        const size_t row = (size_t)(__shfl(tpre, e) - ntok / 256) * 256 + pos;
        const u32x4* src = (const u32x4*)(V + (size_t)tok * 1024) + lane; u32x4* dst = (u32x4*)(XG + row * 1024) + lane;
        dst[0] = src[0];
    }
}
PHASE_FN void phase_moe_gemm(const KP& kp, unsigned char* lds, int layer, bool down) {
    const int tid = otid();
    int* pre = (int*)(lds + pg8::STAGE_BYTES);
    int* slotmap = pre + 32;
    const int ntok = layer == 0 ? NTOK : NLAT;
    const unsigned* cnt = WSP(const unsigned, CTL_CNT) + layer * 16;
    if (tid == 0) { int p = ntok / 256; pre[0] = 0; pre[1] = p; for (int e = 0; e < 16; ++e) { p += ((int)cnt[e] + 255) >> 8; pre[2 + e] = p; } }
    __syncthreads();
    const int ntiles = pre[17];
    for (int t = tid; t < ntiles; t += 512) { int idx = 0; for (int e = 1; e < 17; ++e) if (pre[e] <= t) idx = e; slotmap[t] = idx == 0 ? 16 : idx - 1; }
    __syncthreads();
    pg8::MoeOrder S{slotmap, ntiles, (int)gridDim.x, obid()};
    if (!down) {
        pg8::Gemm g{WSP(const bf16_t, WS_V), WSP(const bf16_t, WS_BIG + MO_WUP), 0, 0, 512, WSP(const bf16_t, WS_BIG + MO_XG), ntok / 256, 1024, 0};
        pg8::EpiSwi E{WSP(bf16_t, WS_BIG + MO_HID)};
        pg8::gemm_phase<pg8::EpiSwi, pg8::MoeOrder, false, true>((PG8_LAS unsigned char*)lds, g, S, E, nullptr);
    } else {
        pg8::Gemm g{WSP(const bf16_t, WS_BIG + MO_HID), WSP(const bf16_t, WS_BIG + MO_WDN), 0, 0, 256, nullptr, 0x7fffffff, 512, 0};
        pg8::EpiBfG E{WSP(bf16_t, WS_BIG + MO_CON), 1024, 1024, 3, W8_INV};
        pg8::gemm_phase<pg8::EpiBfG, pg8::MoeOrder, false, true>((PG8_LAS unsigned char*)lds, g, S, E, nullptr);
    }
    __syncthreads();
}

PHASE_FN void phase_combine(const KP& kp, int layer) {
    const int lane = otid() & 63, wid = __builtin_amdgcn_readfirstlane(otid() >> 6);
    const int ntok = layer == 0 ? NTOK : NLAT;
    const unsigned* cnt = WSP(const unsigned, CTL_CNT) + layer * 16;
    const float* modv = WSP(const float, WS_MODV) + (size_t)layer * 17 * 6144;
    const float* ng = KIN(6) + (size_t)layer * 4 * 1024 + 3 * 1024;
    const bf16_t* CON = WSP(const bf16_t, WS_BIG + MO_CON);
    const int* TOKE = WSP(const int, WS_TOKE); const int* TOKP = WSP(const int, WS_TOKP); const float* TOKW = WSP(const float, WS_TOKW);
    const int tpre = moe_tile_prefix(cnt, ntok, lane);
    for (int tok0 = (obid() * 8 + wid) * 2; tok0 < ntok; tok0 += gridDim.x * 16) {
        int e1[2], e2[2], p1[2], p2[2]; float w1[2], w2[2];
#pragma unroll
        for (int u = 0; u < 2; ++u) { const int tok = tok0 + u; e1[u] = TOKE[tok * 2]; e2[u] = TOKE[tok * 2 + 1]; p1[u] = TOKP[tok * 2]; p2[u] = TOKP[tok * 2 + 1]; w1[u] = TOKW[tok * 2]; w2[u] = TOKW[tok * 2 + 1]; }
        f32x4 f[2][4], hx[2][4]; float* hp[2]; const float* mv[2];
#pragma unroll
        for (int u = 0; u < 2; ++u) { const int tok = tok0 + u;
            const size_t r1 = (size_t)__shfl(tpre, e1[u]) * 256 + p1[u], r2 = (size_t)__shfl(tpre, e2[u]) * 256 + p2[u];
            int b, t;
            if (layer == 0) { b = tok / TT; t = tok - b * TT; } else { b = tok >> 11; t = CTXL + (tok & 2047); }
            hp[u] = hrow_wr(kp, b, t); mv[u] = modv + (size_t)(t < CTXL ? 16 : b) * 6144 + 5 * 1024;
#pragma unroll
            for (int i = 0; i < 4; ++i) { const int col = i * 256 + lane * 4;
                f[u][i] = ld4bf(CON + (size_t)tok * 1024 + col) + ld4bf(CON + r1 * 1024 + col) * w1[u] + ld4bf(CON + r2 * 1024 + col) * w2[u];
                hx[u][i] = *(const f32x4*)(hp[u] + col); } }
#pragma unroll
        for (int u = 0; u < 2; ++u) { float ss = 0.f;
#pragma unroll
            for (int i = 0; i < 4; ++i) ss += f[u][i][0] * f[u][i][0] + f[u][i][1] * f[u][i][1] + f[u][i][2] * f[u][i][2] + f[u][i][3] * f[u][i][3];
            ss = wsum(ss); const float rstd = rsqrtf(ss * (1.0f / 1024.0f) + EPS);
            float s2 = 0.f;
#pragma unroll
            for (int i = 0; i < 4; ++i) { const int col = i * 256 + lane * 4;
                const f32x4 g3 = *(const f32x4*)(ng + col), gf = *(const f32x4*)(mv[u] + col);
                const f32x4 hn = hx[u][i] + gf * (f[u][i] * rstd * g3);
                *(f32x4*)(hp[u] + col) = hn; hx[u][i] = hn;
                s2 += hn[0] * hn[0] + hn[1] * hn[1] + hn[2] * hn[2] + hn[3] * hn[3]; }
            if (layer == 0) {
                s2 = wsum(s2); const float rs2 = rsqrtf(s2 * (1.0f / 1024.0f) + EPS);
                const float* mv1 = mv[u] - 5 * 1024 + 17 * 6144;
                const float* ng1 = KIN(6) + 4 * 1024;
                unsigned char* U1 = WSP(unsigned char, WS_V) + (size_t)(tok0 + u) * 2048;
#pragma unroll
                for (int i = 0; i < 4; ++i) { const int col = i * 256 + lane * 4;
                    const f32x4 gv = *(const f32x4*)(ng1 + col), sc = *(const f32x4*)(mv1 + 1024 + col), sh = *(const f32x4*)(mv1 + col);
                    st4f8(U1 + col, hx[u][i] * rs2 * gv * (sc + 1.0f) + sh); } } }
    }
}

template <int CH>
__device__ __forceinline__ int scan_t(int dir, int ci, int j) {
    constexpr int NC_CTX = CTXL / CH;
    if (!dir) return ci * CH + j;
    return ci < NC_CTX ? (CTXL - 1 - ci * CH - j) : (TT - 1 - (ci - NC_CTX) * CH - j);
}

constexpr int ML_LQ = 136, ML_LT = 72, ML_VR = 144;
PHASE_FN void mlstm_unit(const KP& kp, unsigned char* lds, int bl, int h, int dir, int vh) {
    const int tid = otid();
    bf16_t* Qs = (bf16_t*)lds;
    bf16_t* Ks = Qs + 64 * ML_LQ;
    bf16_t* KTE = Ks + 64 * ML_LQ;
    bf16_t* VT = KTE + 128 * ML_LT;
    bf16_t* Ps = VT + ML_VR * ML_LT;
    bf16_t* Cb = Ps + 64 * ML_LT;
    float* fs = (float*)(Cb + ML_VR * ML_LQ);
    float* s_rowv = fs;
    float* s_colv = fs + 64;
    float* s_wint = fs + 128;
    float* s_emj = fs + 192;
    float* s_E = fs + 256;
    float* s_den = fs + 320;
    float* s_misc = fs + 384;
    const bf16_t* P = WSP(const bf16_t, WS_BIG + L0_P);
    bf16_t* HOUT = WSP(bf16_t, WS_BIG + (dir ? L0_HB : L0_AO)); const int ldh = dir ? 1024 : 2048;
    const float ibias = KIN(9)[dir * 4 + h], fbias = KIN(10)[dir * 4 + h];
    for (int i = tid; i < ML_VR * ML_LQ; i += 512) Cb[i] = 0;
    for (int i = tid; i < 16 * ML_LT; i += 512) VT[128 * ML_LT + i] = (i < ML_LT) ? (bf16_t)0x3f80 : (bf16_t)0;
    f32x4 Cacc[8], Nacc;
#pragma unroll
    for (int i = 0; i < 8; ++i) Cacc[i] = (f32x4){0.f, 0.f, 0.f, 0.f};
    Nacc = (f32x4){0.f, 0.f, 0.f, 0.f};
    float m_state = 0.f;
    u32x4 pq[2], pk[2], pv[2]; bf16_t pgi = 0, pgf = 0;
#define ML_REQ(ci_) do { _Pragma("unroll") for (int i = 0; i < 2; ++i) { const int p = tid + i * 512, j = p >> 4, c8 = p & 15; \
            const bf16_t* pr = P + ((size_t)bl * TT + scan_t<64>(dir, (ci_), j)) * AB_N; \
            pq[i] = *(const u32x4*)(pr + AB_Q + h * 128 + c8 * 8); pk[i] = *(const u32x4*)(pr + AB_K + h * 128 + c8 * 8); \
            const int jv = tid & 63, cv = (tid >> 6) + i * 8; \
            pv[i] = *(const u32x4*)(P + ((size_t)bl * TT + scan_t<64>(dir, (ci_), jv)) * AB_N + AB_V + h * 256 + vh * 128 + cv * 8); } \
        if (tid < 64) { const bf16_t* pg = P + ((size_t)bl * TT + scan_t<64>(dir, (ci_), tid)) * AB_N; pgi = pg[AB_IG + dir * 4 + h]; pgf = pg[AB_FG + dir * 4 + h]; } } while (0)
    ML_REQ(0);
    lds_barrier();
    for (int ci = 0; ci < TT / 64; ++ci) {
        int tq = tid; asm volatile("" : "+v"(tq));
        const int lane = tq & 63, wid = __builtin_amdgcn_readfirstlane(tq >> 6), fr = lane & 15, fq = lane >> 4;
#pragma unroll
        for (int i = 0; i < 2; ++i) {
            const int p = tq + i * 512, j = p >> 4, c8 = p & 15;
            u32x4 q = pq[i];
            const float qs = 0.08838834764831845f;
            q.x = pack2(lo2f(q.x) * qs, hi2f(q.x) * qs); q.y = pack2(lo2f(q.y) * qs, hi2f(q.y) * qs);
            q.z = pack2(lo2f(q.z) * qs, hi2f(q.z) * qs); q.w = pack2(lo2f(q.w) * qs, hi2f(q.w) * qs);
            *(u32x4*)(Qs + j * ML_LQ + c8 * 8) = q;
            *(u32x4*)(Ks + j * ML_LQ + c8 * 8) = pk[i];
            const u32x4 v = pv[i];
            bf16_t* vt = VT + (((tq >> 6) + i * 8) * 8) * ML_LT + (tq & 63);
            vt[0 * ML_LT] = (bf16_t)(v.x & 0xffff); vt[1 * ML_LT] = (bf16_t)(v.x >> 16); vt[2 * ML_LT] = (bf16_t)(v.y & 0xffff); vt[3 * ML_LT] = (bf16_t)(v.y >> 16);
            vt[4 * ML_LT] = (bf16_t)(v.z & 0xffff); vt[5 * ML_LT] = (bf16_t)(v.z >> 16); vt[6 * ML_LT] = (bf16_t)(v.w & 0xffff); vt[7 * ML_LT] = (bf16_t)(v.w >> 16);
        }
        if (wid == 0) {
            const float ig = bf2f(pgi) + ibias;
            const float lf = logsigmoidf_(bf2f(pgf) + fbias);
            const float b = wscan_add(lf);
            const float u = ig - b; const float pm = wscan_max(u);
            const float mj = fmaxf(b + m_state, b + pm);
            const float b63 = lane63(b), pm63 = lane63(pm);
            const float mnew = fmaxf(b63 + m_state, b63 + pm63);
            s_rowv[lane] = b - mj; s_colv[lane] = u; s_wint[lane] = __expf(b + m_state - mj); s_emj[lane] = __expf(-mj);
            s_E[lane] = __expf(b63 + u - mnew);
            if (lane == 0) { s_misc[0] = mnew; s_misc[1] = __expf(b63 + m_state - mnew); }
        }
        if (ci + 1 < TT / 64) ML_REQ(ci + 1);
        lds_barrier();
        {
            const int jt = wid >> 1;
#pragma unroll
            for (int q2 = 0; q2 < 2; ++q2) {
                const int st = (wid & 1) * 2 + q2;
                f32x4 acc = (f32x4){0.f, 0.f, 0.f, 0.f};
                if (st <= jt) {
                    bf16x8 fa[4], fb[4];
#pragma unroll
                    for (int k = 0; k < 4; ++k) { fa[k] = ldfrag(Qs, ML_LQ, jt * 16, k * 32, fr, fq); fb[k] = ldfrag(Ks, ML_LQ, st * 16, k * 32, fr, fq); }
                    __builtin_amdgcn_sched_barrier(0);
                    f32x4 acc2 = (f32x4){0.f, 0.f, 0.f, 0.f};
                    acc = mma16(fa[0], fb[0], acc); acc2 = mma16(fa[1], fb[1], acc2); acc = mma16(fa[2], fb[2], acc); acc2 = mma16(fa[3], fb[3], acc2);
                    acc = acc + acc2;
                }
                const int s = st * 16 + fr; const float cv = s_colv[s];
#pragma unroll
                for (int r = 0; r < 4; ++r) { const int j = jt * 16 + fq * 4 + r;
                    const float pv2 = (s <= j) ? acc[r] * __expf(s_rowv[j] + cv) : 0.f;
                    Ps[j * ML_LT + s] = f2bf(pv2); }
            }
#pragma unroll
            for (int i = 0; i < 2; ++i) {
                const int s = lane, c8 = wid + i * 8; const float e = s_E[s];
                const u32x4 kv = *(const u32x4*)(Ks + s * ML_LQ + c8 * 8);
                bf16_t* kt = KTE + (c8 * 8) * ML_LT + s;
                kt[0 * ML_LT] = f2bf(lo2f(kv.x) * e); kt[1 * ML_LT] = f2bf(hi2f(kv.x) * e); kt[2 * ML_LT] = f2bf(lo2f(kv.y) * e); kt[3 * ML_LT] = f2bf(hi2f(kv.y) * e);
                kt[4 * ML_LT] = f2bf(lo2f(kv.z) * e); kt[5 * ML_LT] = f2bf(hi2f(kv.z) * e); kt[6 * ML_LT] = f2bf(lo2f(kv.w) * e); kt[7 * ML_LT] = f2bf(hi2f(kv.w) * e);
            }
        }
        lds_barrier();
        f32x4 a1[4], a2[4];
        {
            const int jt = wid >> 1;
            bf16x8 fp[2], fqq[4];
#pragma unroll
            for (int k = 0; k < 2; ++k) fp[k] = ldfrag(Ps, ML_LT, jt * 16, k * 32, fr, fq);
#pragma unroll
            for (int k = 0; k < 4; ++k) fqq[k] = ldfrag(Qs, ML_LQ, jt * 16, k * 32, fr, fq);
            {
                bf16x8 fv[4][2];
#pragma unroll
                for (int q4 = 0; q4 < 4; ++q4)
#pragma unroll
                    for (int k = 0; k < 2; ++k) fv[q4][k] = ldfrag(VT, ML_LT, ((wid & 1) * 4 + q4) * 16, k * 32, fr, fq);
                __builtin_amdgcn_sched_barrier(0);
#pragma unroll
                for (int q4 = 0; q4 < 4; ++q4) a1[q4] = (f32x4){0.f, 0.f, 0.f, 0.f};
#pragma unroll
                for (int k = 0; k < 2; ++k)
#pragma unroll
                    for (int q4 = 0; q4 < 4; ++q4) a1[q4] = mma16(fv[q4][k], fp[k], a1[q4]);
            }
#pragma unroll
            for (int hh = 0; hh < 2; ++hh) {
                bf16x8 fc[2][4];
#pragma unroll
                for (int q2 = 0; q2 < 2; ++q2)
#pragma unroll
                    for (int k = 0; k < 4; ++k) fc[q2][k] = ldfrag(Cb, ML_LQ, ((wid & 1) * 4 + hh * 2 + q2) * 16, k * 32, fr, fq);
                __builtin_amdgcn_sched_barrier(0);
                a2[hh * 2] = (f32x4){0.f, 0.f, 0.f, 0.f}; a2[hh * 2 + 1] = (f32x4){0.f, 0.f, 0.f, 0.f};
#pragma unroll
                for (int k = 0; k < 4; ++k) { a2[hh * 2] = mma16(fc[0][k], fqq[k], a2[hh * 2]); a2[hh * 2 + 1] = mma16(fc[1][k], fqq[k], a2[hh * 2 + 1]); }
            }
            if (wid & 1) {
                f32x4 d1 = (f32x4){0.f, 0.f, 0.f, 0.f}, d2 = (f32x4){0.f, 0.f, 0.f, 0.f};
                bf16x8 fo[2], fn[4];
#pragma unroll
                for (int k = 0; k < 2; ++k) fo[k] = ldfrag(VT, ML_LT, 128, k * 32, fr, fq);
#pragma unroll
                for (int k = 0; k < 4; ++k) fn[k] = ldfrag(Cb, ML_LQ, 128, k * 32, fr, fq);
                __builtin_amdgcn_sched_barrier(0);
                d1 = mma16(fo[0], fp[0], d1); d2 = mma16(fn[0], fqq[0], d2); d1 = mma16(fo[1], fp[1], d1); d2 = mma16(fn[1], fqq[1], d2);
                d2 = mma16(fn[2], fqq[2], d2); d2 = mma16(fn[3], fqq[3], d2);
                if (fq == 0) { const int j = jt * 16 + fr; s_den[j] = fmaxf(fabsf(d1[0] + s_wint[j] * d2[0]), s_emj[j]); }
            }
        }
        lds_barrier();
        {
            const int jt = wid >> 1, j = jt * 16 + fr;
            const float wi = s_wint[j], rden = frcp_(s_den[j]);
            const size_t row = (size_t)bl * TT + scan_t<64>(dir, ci, j);
#pragma unroll
            for (int q4 = 0; q4 < 4; ++q4) { const int v0 = ((wid & 1) * 4 + q4) * 16 + fq * 4;
                st4bf(HOUT + row * ldh + h * 256 + vh * 128 + v0, (a1[q4] + a2[q4] * wi) * rden); }
        }
        {
            const float dec = s_misc[1];
            const bf16x8 bv0 = ldfrag(VT, ML_LT, wid * 16, 0, fr, fq), bv1 = ldfrag(VT, ML_LT, wid * 16, 32, fr, fq);
#pragma unroll
            for (int hh = 0; hh < 2; ++hh) {
                bf16x8 fk[4][2];
#pragma unroll
                for (int q = 0; q < 4; ++q) { fk[q][0] = ldfrag(KTE, ML_LT, (hh * 4 + q) * 16, 0, fr, fq); fk[q][1] = ldfrag(KTE, ML_LT, (hh * 4 + q) * 16, 32, fr, fq); }
                __builtin_amdgcn_sched_barrier(0);
#pragma unroll
                for (int q = 0; q < 4; ++q) Cacc[hh * 4 + q] = Cacc[hh * 4 + q] * dec;
#pragma unroll
                for (int q = 0; q < 4; ++q) Cacc[hh * 4 + q] = mma16(fk[q][0], bv0, Cacc[hh * 4 + q]);
#pragma unroll
                for (int q = 0; q < 4; ++q) Cacc[hh * 4 + q] = mma16(fk[q][1], bv1, Cacc[hh * 4 + q]);
#pragma unroll
                for (int q = 0; q < 4; ++q) st4bf(Cb + (wid * 16 + fr) * ML_LQ + (hh * 4 + q) * 16 + fq * 4, Cacc[hh * 4 + q]);
            }
            Nacc = Nacc * dec;
            Nacc = mma16(ldfrag(KTE, ML_LT, wid * 16, 0, fr, fq), ldfrag(VT, ML_LT, 128, 0, fr, fq), Nacc);
            Nacc = mma16(ldfrag(KTE, ML_LT, wid * 16, 32, fr, fq), ldfrag(VT, ML_LT, 128, 32, fr, fq), Nacc);
            st4bf(Cb + (128 + fr) * ML_LQ + wid * 16 + fq * 4, Nacc);
            m_state = s_misc[0];
        }
        lds_barrier();
    }
#undef ML_REQ
}

constexpr size_t L0_XC = L0_U;
static_assert(L0_XC + (size_t)RG * 1280 * 2 <= BIG_BYTES, "xconv buffer");
PHASE_FN void phase_xconv(const KP& kp) {
    const int lane = otid() & 63, wid = __builtin_amdgcn_readfirstlane(otid() >> 6);
    const bf16_t* P = WSP(const bf16_t, WS_BIG + L0_P); bf16_t* XC = WSP(bf16_t, WS_BIG + L0_XC);
    const float* cw = KIN(12); const float* cb = KIN(13);
    constexpr int RUN = 9;
    for (int run = obid() * 8 + wid; run < RG / RUN; run += gridDim.x * 8) {
        const int r0 = run * RUN;
#pragma unroll
        for (int i = 0; i < 5; ++i) { const int col = i * 256 + lane * 4;
            const f32x4 bias = *(const f32x4*)(cb + col);
            f32x4 w[5], x[5];
#pragma unroll
            for (int q = 0; q < 5; ++q) w[q] = *(const f32x4*)(cw + q * 1280 + col);
#pragma unroll
            for (int q = 0; q < 4; ++q) { const int rr = r0 - 2 + q; x[q + 1] = (rr >= 0 && rr < RG) ? ld4bf(P + (size_t)rr * AB_N + AB_XBC + col) : (f32x4){0.f, 0.f, 0.f, 0.f}; }
#pragma unroll
            for (int k = 0; k < RUN; ++k) {
                const int lr = r0 + k, bl = lr / TT, t = lr - bl * TT, lo = t < CTXL ? 0 : CTXL, hi = t < CTXL ? CTXL : TT;
#pragma unroll
                for (int q = 0; q < 4; ++q) x[q] = x[q + 1];
                { const int rr = lr + 2; x[4] = (rr < RG) ? ld4bf(P + (size_t)rr * AB_N + AB_XBC + col) : (f32x4){0.f, 0.f, 0.f, 0.f}; }
                f32x4 a = bias;
#pragma unroll
                for (int q = 0; q < 5; ++q) { const int tt = t - 2 + q; if (tt >= lo && tt < hi) a += w[q] * x[q]; }
                f32x4 o;
#pragma unroll
                for (int r = 0; r < 4; ++r) o[r] = siluf_(a[r]);
                st4bf(XC + (size_t)lr * 1280 + col, o);
            }
        }
    }
}

constexpr int SS_LT = 72, SS_LX = 136;
PHASE_FN void ssd_unit(const KP& kp, unsigned char* lds, int bl, int dir, int hp) {
    const int tid = otid();
    const int gi = hp >> 2, hh0 = hp * 2;
    bf16_t* Wm = (bf16_t*)lds;
    bf16_t* CM = Wm + 2 * 64 * SS_LT;
    bf16_t* BM = CM + 64 * SS_LT;
    bf16_t* Xn = BM + 64 * SS_LT;
    bf16_t* XT = Xn + 64 * SS_LX;
    bf16_t* BTE = XT + 2 * 64 * SS_LT;
    bf16_t* Sb = BTE + 2 * 64 * SS_LT;
    float* fs = (float*)(Sb + 2 * 64 * SS_LT);
    float* s_b = fs;
    float* s_dt = fs + 128;
    float* s_e = fs + 256;
    float* s_misc = fs + 384;
    const bf16_t* P = WSP(const bf16_t, WS_BIG + L0_P); const bf16_t* XC = WSP(const bf16_t, WS_BIG + L0_XC);
    bf16_t* YOUT = WSP(bf16_t, WS_BIG + (dir ? L0_YB : L0_AO + 2048)); const int ldy = dir ? 1024 : 2048;
    for (int i = tid; i < 2 * 64 * SS_LT; i += 512) Sb[i] = 0;
    f32x4 Sacc[4];
#pragma unroll
    for (int i = 0; i < 4; ++i) Sacc[i] = (f32x4){0.f, 0.f, 0.f, 0.f};
    const float dtb = KIN(14)[dir * 16 + hh0 + ((tid >> 6) & 1)], aexp = __expf(KIN(15)[dir * 16 + hh0 + ((tid >> 6) & 1)]);
    const float dskip = KIN(16)[hh0 + (tid >> 8)];
    u32x4 pr[4]; bf16_t pdt = 0;
#define SS_REQ(ci_) do { _Pragma("unroll") for (int q = 0; q < 4; ++q) { const int p = tid + q * 512, j = p >> 5, c8 = p & 31; \
            const int col = c8 < 16 ? hh0 * 64 + c8 * 8 : (c8 < 24 ? 1024 + gi * 64 + (c8 - 16) * 8 : 1152 + gi * 64 + (c8 - 24) * 8); \
            pr[q] = *(const u32x4*)(XC + ((size_t)bl * TT + scan_t<64>(dir, (ci_), j)) * 1280 + col); } \
        if (tid < 128) pdt = P[((size_t)bl * TT + scan_t<64>(dir, (ci_), tid & 63)) * AB_N + AB_DT + dir * 16 + hh0 + (tid >> 6)]; } while (0)
    SS_REQ(0);
    lds_barrier();
    for (int ci = 0; ci < TT / 64; ++ci) {
        int tq = tid; asm volatile("" : "+v"(tq));
        const int lane = tq & 63, wid = __builtin_amdgcn_readfirstlane(tq >> 6), fr = lane & 15, fq = lane >> 4, hl_w = wid >> 2;
#pragma unroll
        for (int q = 0; q < 4; ++q) { const int p = tq + q * 512, j = p >> 5, c8 = p & 31;
            bf16_t* dst = c8 < 16 ? Xn + j * SS_LX + c8 * 8 : (c8 < 24 ? BM + j * SS_LT + (c8 - 16) * 8 : CM + j * SS_LT + (c8 - 24) * 8);
            *(u32x4*)dst = pr[q]; }
        if (wid < 2) {
            const float dt = softplusf_(bf2f(pdt) + dtb);
            const float b = wscan_add(-dt * aexp);
            const float b63 = lane63(b);
            s_b[wid * 64 + lane] = b; s_dt[wid * 64 + lane] = dt; s_e[wid * 64 + lane] = __expf(b63 - b) * dt;
            if (lane == 0) s_misc[wid] = __expf(b63);
        }
        if (ci + 1 < TT / 64) SS_REQ(ci + 1);
        lds_barrier();
        {
            const int jt = wid >> 1;
#pragma unroll
            for (int q2 = 0; q2 < 2; ++q2) {
                const int st = (wid & 1) * 2 + q2;
                f32x4 acc = (f32x4){0.f, 0.f, 0.f, 0.f};
                if (st <= jt) {
                    const bf16x8 c0 = ldfrag(CM, SS_LT, jt * 16, 0, fr, fq), c1 = ldfrag(CM, SS_LT, jt * 16, 32, fr, fq), b0 = ldfrag(BM, SS_LT, st * 16, 0, fr, fq), b1 = ldfrag(BM, SS_LT, st * 16, 32, fr, fq);
                    __builtin_amdgcn_sched_barrier(0);
                    acc = mma16(c0, b0, acc); acc = mma16(c1, b1, acc);
                }
                const int s = st * 16 + fr;
#pragma unroll
                for (int hl = 0; hl < 2; ++hl) { const float bs = s_b[hl * 64 + s], ds = s_dt[hl * 64 + s];
#pragma unroll
                    for (int r = 0; r < 4; ++r) { const int j = jt * 16 + fq * 4 + r;
                        const float wv = (s <= j) ? acc[r] * __expf(s_b[hl * 64 + j] - bs) * ds : 0.f;
                        Wm[(hl * 64 + j) * SS_LT + s] = f2bf(wv); } }
            }
            {
                const int s = lane, n8 = wid;
                const u32x4 bv = *(const u32x4*)(BM + s * SS_LT + n8 * 8);
#pragma unroll
                for (int hl = 0; hl < 2; ++hl) { const float e = s_e[hl * 64 + s];
                    bf16_t* bt = BTE + (hl * 64 + n8 * 8) * SS_LT + s;
                    bt[0 * SS_LT] = f2bf(lo2f(bv.x) * e); bt[1 * SS_LT] = f2bf(hi2f(bv.x) * e); bt[2 * SS_LT] = f2bf(lo2f(bv.y) * e); bt[3 * SS_LT] = f2bf(hi2f(bv.y) * e);
                    bt[4 * SS_LT] = f2bf(lo2f(bv.z) * e); bt[5 * SS_LT] = f2bf(hi2f(bv.z) * e); bt[6 * SS_LT] = f2bf(lo2f(bv.w) * e); bt[7 * SS_LT] = f2bf(hi2f(bv.w) * e); }
#pragma unroll
                for (int i = 0; i < 2; ++i) { const int c8 = wid + i * 8;
                    const u32x4 xv = *(const u32x4*)(Xn + s * SS_LX + c8 * 8);
                    bf16_t* xt = XT + (c8 * 8) * SS_LT + s;
                    xt[0 * SS_LT] = (bf16_t)(xv.x & 0xffff); xt[1 * SS_LT] = (bf16_t)(xv.x >> 16); xt[2 * SS_LT] = (bf16_t)(xv.y & 0xffff); xt[3 * SS_LT] = (bf16_t)(xv.y >> 16);
                    xt[4 * SS_LT] = (bf16_t)(xv.z & 0xffff); xt[5 * SS_LT] = (bf16_t)(xv.z >> 16); xt[6 * SS_LT] = (bf16_t)(xv.w & 0xffff); xt[7 * SS_LT] = (bf16_t)(xv.w >> 16); }
            }
        }
        lds_barrier();
        {
            const int hl = hl_w, jt = wid & 3, j = jt * 16 + fr;
            const bf16_t* Wh = Wm + hl * 64 * SS_LT; const bf16_t* Xh = XT + hl * 64 * SS_LT; const bf16_t* Sh = Sb + hl * 64 * SS_LT;
            const float eb = __expf(s_b[hl * 64 + j]);
            const size_t row = (size_t)bl * TT + scan_t<64>(dir, ci, j);
            const bf16x8 w0 = ldfrag(Wh, SS_LT, jt * 16, 0, fr, fq), w1 = ldfrag(Wh, SS_LT, jt * 16, 32, fr, fq), m0 = ldfrag(CM, SS_LT, jt * 16, 0, fr, fq), m1 = ldfrag(CM, SS_LT, jt * 16, 32, fr, fq);
#pragma unroll
            for (int hh = 0; hh < 2; ++hh) {
                bf16x8 fx[2][2], fs2[2][2];
#pragma unroll
                for (int q = 0; q < 2; ++q)
#pragma unroll
                    for (int k = 0; k < 2; ++k) { fx[q][k] = ldfrag(Xh, SS_LT, (hh * 2 + q) * 16, k * 32, fr, fq); fs2[q][k] = ldfrag(Sh, SS_LT, (hh * 2 + q) * 16, k * 32, fr, fq); }
                f32x4 dx[2];
                if (!dir) { dx[0] = ld4bf(Xn + j * SS_LX + hl * 64 + (hh * 2) * 16 + fq * 4); dx[1] = ld4bf(Xn + j * SS_LX + hl * 64 + (hh * 2 + 1) * 16 + fq * 4); }
                __builtin_amdgcn_sched_barrier(0);
                f32x4 y1[2], y2[2];
#pragma unroll
                for (int q = 0; q < 2; ++q) { y1[q] = (f32x4){0.f, 0.f, 0.f, 0.f}; y2[q] = (f32x4){0.f, 0.f, 0.f, 0.f}; }
#pragma unroll
                for (int q = 0; q < 2; ++q) { y1[q] = mma16(fx[q][0], w0, y1[q]); y2[q] = mma16(fs2[q][0], m0, y2[q]); }
#pragma unroll
                for (int q = 0; q < 2; ++q) { y1[q] = mma16(fx[q][1], w1, y1[q]); y2[q] = mma16(fs2[q][1], m1, y2[q]); }
#pragma unroll
                for (int q = 0; q < 2; ++q) { f32x4 y = y1[q] + y2[q] * eb;
                    if (!dir) y = y + dx[q] * dskip;
                    st4bf(YOUT + row * ldy + (hh0 + hl) * 64 + (hh * 2 + q) * 16 + fq * 4, y); }
            }
        }
        lds_barrier();
        {
            const int hl = hl_w, pt = wid & 3; const float eb63 = s_misc[hl];
            const bf16_t* Xh = XT + hl * 64 * SS_LT; const bf16_t* Bh = BTE + hl * 64 * SS_LT; bf16_t* Sh = Sb + hl * 64 * SS_LT;
            const bf16x8 x0 = ldfrag(Xh, SS_LT, pt * 16, 0, fr, fq), x1 = ldfrag(Xh, SS_LT, pt * 16, 32, fr, fq);
            bf16x8 fb[4][2];
#pragma unroll
            for (int nt = 0; nt < 4; ++nt) { fb[nt][0] = ldfrag(Bh, SS_LT, nt * 16, 0, fr, fq); fb[nt][1] = ldfrag(Bh, SS_LT, nt * 16, 32, fr, fq); }
            __builtin_amdgcn_sched_barrier(0);
#pragma unroll
            for (int nt = 0; nt < 4; ++nt) Sacc[nt] = Sacc[nt] * eb63;
#pragma unroll
            for (int nt = 0; nt < 4; ++nt) Sacc[nt] = mma16(fb[nt][0], x0, Sacc[nt]);
#pragma unroll
            for (int nt = 0; nt < 4; ++nt) Sacc[nt] = mma16(fb[nt][1], x1, Sacc[nt]);
#pragma unroll
            for (int nt = 0; nt < 4; ++nt) st4bf(Sh + (pt * 16 + fr) * SS_LT + nt * 16 + fq * 4, Sacc[nt]);
        }
        lds_barrier();
    }
#undef SS_REQ
}

__device__ __forceinline__ void phase_scan_ab(const KP& kp, unsigned char* lds) {
    for (int rep = 0; rep < ((PROBE_DUP & 8192) ? 2 : 1); ++rep)
    for (int u = obid(); u < 256; u += gridDim.x) if (u < 128) { mlstm_unit(kp, lds, u >> 4, (u >> 2) & 3, (u >> 1) & 1, u & 1); __syncthreads(); }
    for (int rep = 0; rep < ((PROBE_DUP & 16384) ? 2 : 1); ++rep)
    for (int u = obid(); u < 256; u += gridDim.x) if (u >= 128) { const int v = u - 128; ssd_unit(kp, lds, v >> 4, (v >> 3) & 1, v & 7); __syncthreads(); }
}

PHASE_FN void phase_fin_ab(const KP& kp) {
    const int lane = otid() & 63, wid = __builtin_amdgcn_readfirstlane(otid() >> 6);
    const bf16_t* P = WSP(const bf16_t, WS_BIG + L0_P);
    bf16_t* AO = WSP(bf16_t, WS_BIG + L0_AO); const bf16_t* HB = WSP(const bf16_t, WS_BIG + L0_HB); const bf16_t* YB = WSP(const bf16_t, WS_BIG + L0_YB);
    const float* mln = KIN(11); const float* sn = KIN(17);
    for (int lr = obid() * 8 + wid; lr < RG; lr += gridDim.x * 8) {
        const bf16_t* pr = P + (size_t)lr * AB_N;
        f32x4 yz[4]; float ss2 = 0.f;
#pragma unroll
        for (int i = 0; i < 4; ++i) { const int col = i * 256 + lane * 4;
            const f32x4 hs = ld4bf(AO + (size_t)lr * 2048 + col) + ld4bf(HB + (size_t)lr * 1024 + col);
            float ss = hs[0] * hs[0] + hs[1] * hs[1] + hs[2] * hs[2] + hs[3] * hs[3];
            ss = wsum(ss); const float rstd = rsqrtf(ss * (1.0f / 256.0f) + EPS);
            const f32x4 og = ld4bf(pr + AB_OG + col), w = *(const f32x4*)(mln + col);
            f32x4 o;
#pragma unroll
            for (int r = 0; r < 4; ++r) o[r] = hs[r] * rstd * w[r] * sigmoidf_(og[r]);
            st4bf(AO + (size_t)lr * 2048 + col, o);
            const f32x4 ys = ld4bf(AO + (size_t)lr * 2048 + 1024 + col) + ld4bf(YB + (size_t)lr * 1024 + col), z = ld4bf(pr + AB_Z + col);
#pragma unroll
            for (int r = 0; r < 4; ++r) { yz[i][r] = ys[r] * siluf_(z[r]); ss2 += yz[i][r] * yz[i][r]; }
        }
        ss2 = wsum(ss2); const float rstd2 = rsqrtf(ss2 * (1.0f / 1024.0f) + EPS);
#pragma unroll
        for (int i = 0; i < 4; ++i) { const int col = i * 256 + lane * 4; st4bf(AO + (size_t)lr * 2048 + 1024 + col, yz[i] * rstd2 * *(const f32x4*)(sn + col)); }
    }
}

PHASE_FN void phase_gemm_in(const KP& kp, unsigned char* lds, int layer, int grp) {
    const int npad = layer == 0 ? AB_NPAD : CD_NPAD, n = layer == 0 ? AB_N : CD_N;
    pg8::StaticOrder S; S.init(RG, npad, (int)gridDim.x, obid());
    if (layer == 0) {
        pg8::Gemm g{grp == 0 ? WSP(const bf16_t, WS_BIG + L0_U) : WSP(const bf16_t, WS_V) + (size_t)grp * RG * 1024, WSP(const bf16_t, WS_WMIX), RG, npad, 1024, nullptr, 0x7fffffff};
        pg8::EpiBfG E{WSP(bf16_t, WS_BIG), n, n, 0x7fffffff, 1.0f};
        pg8::gemm_phase<pg8::EpiBfG, pg8::StaticOrder, false>((PG8_LAS unsigned char*)lds, g, S, E, nullptr);
    } else {
        pg8::Gemm g{WSP(const bf16_t, WS_V) + (size_t)grp * RG * 1024, WSP(const bf16_t, WS_WMIX), RG, npad, 512, nullptr, 0x7fffffff, 1024, 0};
        pg8::EpiBfG E{WSP(bf16_t, WS_BIG), n, n, 0x7fffffff, W8_INV};
        pg8::gemm_phase<pg8::EpiBfG, pg8::StaticOrder, false, true>((PG8_LAS unsigned char*)lds, g, S, E, nullptr);
    }
    __syncthreads();
}
PHASE_FN void phase_gemm_out_ab(const KP& kp, unsigned char* lds, int grp) {
    pg8::Gemm g{WSP(const bf16_t, WS_BIG + L0_AO), WSP(const bf16_t, WS_WMIX + WM_AB_OUT), RG, 1024, 2048, nullptr, 0x7fffffff};
    pg8::StaticOrder S; S.init(RG, 1024, (int)gridDim.x, obid());
    pg8::EpiBfG E{WSP(bf16_t, WS_BIG + L0_U), 1024, 1024, 0x7fffffff, 1.0f};
    pg8::gemm_phase<pg8::EpiBfG, pg8::StaticOrder, false>((PG8_LAS unsigned char*)lds, g, S, E, nullptr);
    __syncthreads();
    const int G = (int)gridDim.x, units = (RG / 256) * 4, two = units > G ? (units - G < G ? units - G : G) : 0;
    const int nb = G - two > 0 ? G - two : G, bid = G - two > 0 ? obid() - two : obid();
    if (bid >= 0) { if (grp == 0) phase_u(kp, 0, 1, bid, nb, true); else phase_conv_moe(kp, lds, 0, bid, nb); }
    __syncthreads();
}

PHASE_FN void phase_prep_cd(const KP& kp) {
    const int lane = otid() & 63, wid = __builtin_amdgcn_readfirstlane(otid() >> 6);
    bf16_t* P = WSP(bf16_t, WS_BIG + L1_P);
    bf16_t* SG = WSP(bf16_t, WS_SG);
    const float* qn = KIN(20); const float* kvn = KIN(22); const float* mu = KIN(24);
    for (int lr = obid() * 8 + wid; lr < RG; lr += gridDim.x * 8) {
        const int bl = lr / TT, t = lr - bl * TT;
        bf16_t* pr = P + (size_t)lr * CD_N;
        {
            const f32x4 x = ld4bf(pr + CD_M1 + lane * 4);
            float ss = x[0] * x[0] + x[1] * x[1] + x[2] * x[2] + x[3] * x[3]; ss = wsum(ss);
            const float rstd = rsqrtf(ss * (1.0f / 256.0f) + EPS);
            st4bf(pr + CD_M1 + lane * 4, x * rstd * *(const f32x4*)(kvn + lane * 4));
        }
        {
            const int lo = t < CTXL ? 0 : CTXL, hi = t < CTXL ? CTXL : TT, c = lane * 4;
            const f32x4 x = ld4bf(pr + CD_WL + c);
            const f32x4 xp = t > lo ? ld4bf(pr - CD_N + CD_WL + c) : (f32x4){0.f, 0.f, 0.f, 0.f};
            const f32x4 xn = t < hi - 1 ? ld4bf(pr + CD_N + CD_WL + c) : (f32x4){0.f, 0.f, 0.f, 0.f};
            f32x4 l = x + *(const f32x4*)(mu + CD_WL - CD_RW0 + c) * ((xp + xn) * 0.5f - x);
            if (c < 128) {
#pragma unroll
                for (int q = 0; q < 4; ++q) l[q] = tanhf_(l[q]); }
            st4bf(WSP(bf16_t, WS_BIG + L1_TWAL) + (size_t)lr * 256 + c, l);
        }
        if (t >= CTXL) {
            const int s = t - CTXL;
            float x0[3], x1[3]; float ss = 0.f;
#pragma unroll
            for (int i = 0; i < 3; ++i) { const unsigned w = *(const unsigned*)(pr + CD_M0 + i * 128 + lane * 2); x0[i] = lo2f(w); x1[i] = hi2f(w); ss += x0[i] * x0[i] + x1[i] * x1[i]; }
            ss = wsum(ss); const float rstd = rsqrtf(ss * (1.0f / 384.0f) + EPS);
#pragma unroll
            for (int i = 0; i < 3; ++i) { const int c = i * 128 + lane * 2; *(unsigned*)(pr + CD_M0 + c) = pack2(x0[i] * rstd * qn[c], x1[i] * rstd * qn[c + 1]); }
            if (lane < 16) {
                const float pos = (lane < 8) ? (float)(s >> 6) : (float)(s & 63);
                const float inv = __expf(-(float)(lane & 7) * (9.210340371976184f / 8.0f));
                float sn, cs; sincosf(pos * inv, &sn, &cs);
                const float a = bf2f(pr[CD_KR + lane]), b2 = bf2f(pr[CD_KR + 16 + lane]);
                pr[CD_KR + lane] = f2bf(a * cs - b2 * sn); pr[CD_KR + 16 + lane] = f2bf(a * sn + b2 * cs);
            }
            {
                const int c = lane * 2;
                const unsigned w = *(const unsigned*)(pr + CD_GL + c);
                const unsigned wp = s > 0 ? *(const unsigned*)(pr - CD_N + CD_GL + c) : 0u;
                const unsigned wn = s < SEQ - 1 ? *(const unsigned*)(pr + CD_N + CD_GL + c) : 0u;
                const float m0 = mu[CD_GL - CD_RW0 + c], m1 = mu[CD_GL - CD_RW0 + c + 1];
                const float g0 = lo2f(w) + m0 * (0.5f * (lo2f(wp) + lo2f(wn)) - lo2f(w));
                const float g1 = hi2f(w) + m1 * (0.5f * (hi2f(wp) + hi2f(wn)) - hi2f(w));
                *(unsigned*)(SG + ((size_t)bl * SEQ + s) * 128 + c) = pack2(sigmoidf_(g0), sigmoidf_(g1));
            }
        }
    }
}

PHASE_FN void phase_upproj(const KP& kp, unsigned char* lds) {
    const bf16_t* P = WSP(const bf16_t, WS_BIG + L1_P);
    {
        pg8::Gemm g{P + CD_M0, WSP(const bf16_t, WS_WMIX + WM_UQ), RGL, 768, 384, nullptr, 0x7fffffff, CD_N, 1};
        pg8::StaticOrder S; S.init(RGL, 768, (int)gridDim.x, obid());
        pg8::EpiBfG E{WSP(bf16_t, WS_BIG + L1_Q), 768, 768, 0x7fffffff, 1.0f};
        pg8::gemm_phase<pg8::EpiBfG, pg8::StaticOrder, false>((PG8_LAS unsigned char*)lds, g, S, E, nullptr);
    }
    __syncthreads();
    {
        pg8::Gemm g{P + CD_M1, WSP(const bf16_t, WS_WMIX + WM_UKV), RG, 1024, 256, nullptr, 0x7fffffff, CD_N, 0};
        pg8::StaticOrder S; S.init(RG, 1024, (int)gridDim.x, obid());
        pg8::EpiBfG E{WSP(bf16_t, WS_BIG + L1_KV), 1024, 1024, 0x7fffffff, 1.0f};
        pg8::gemm_phase<pg8::EpiBfG, pg8::StaticOrder, false>((PG8_LAS unsigned char*)lds, g, S, E, nullptr);
    }
    __syncthreads();
}

constexpr int AT_LQ = 104, AT_LV = 72;
PHASE_FN void attn_unit(const KP& kp, unsigned char* lds, int bl, int head, int qb) {
    const int tid = otid(), lane = tid & 63, wid = __builtin_amdgcn_readfirstlane(tid >> 6), fr = lane & 15, fq = lane >> 4;
    bf16_t* Qs = (bf16_t*)lds;
    bf16_t* Kt = Qs + 256 * AT_LQ;
    bf16_t* Vt = Kt + 2 * 64 * AT_LQ;
    const bf16_t* P = WSP(const bf16_t, WS_BIG + L1_P);
    const bf16_t* Q = WSP(const bf16_t, WS_BIG + L1_Q);
    const bf16_t* KV = WSP(const bf16_t, WS_BIG + L1_KV);
    bf16_t* AOUT = WSP(bf16_t, WS_BIG + L1_AOUT);
    const float SC = 0.10206207261596577f;
#pragma unroll
    for (int i = 0; i < 6; ++i) { const int p = tid + i * 512, r = p / 12, c = p % 12;
        *(u32x4*)(Qs + r * AT_LQ + c * 8) = *(const u32x4*)(Q + ((size_t)bl * SEQ + qb * 256 + r) * 768 + head * 96 + c * 8); }
    lds_barrier();
#pragma unroll
    for (int i = 0; i < 8; ++i) { const int p = tid + i * 512, r = p >> 4, f = p & 15, s = qb * 256 + r;
        const float pos = (f < 8) ? (float)(s >> 6) : (float)(s & 63);
        const float inv = __expf(-(float)(f & 7) * (9.210340371976184f / 8.0f));
        float sn, cs; sincosf(pos * inv, &sn, &cs);
        const float a = bf2f(Qs[r * AT_LQ + 64 + f]), b2 = bf2f(Qs[r * AT_LQ + 80 + f]);
        Qs[r * AT_LQ + 64 + f] = f2bf(a * cs - b2 * sn); Qs[r * AT_LQ + 80 + f] = f2bf(a * sn + b2 * cs); }
    lds_barrier();
    bf16x8 qf[2][3];
#pragma unroll
    for (int rt = 0; rt < 2; ++rt)
#pragma unroll
        for (int k = 0; k < 3; ++k) qf[rt][k] = ldfrag(Qs, AT_LQ, wid * 32 + rt * 16, k * 32, fr, fq);
    f32x4 ot[2][4];
#pragma unroll
    for (int rt = 0; rt < 2; ++rt)
#pragma unroll
        for (int i = 0; i < 4; ++i) ot[rt][i] = (f32x4){0.f, 0.f, 0.f, 0.f};
    float mrow[2] = {-1e30f, -1e30f}, lsum[2] = {0.f, 0.f};
    u32x4 pk0[2], pk1[2], pvv[2];
    const int kkey0 = tid / 12, kc0 = tid % 12, kkey1 = (tid + 512) / 12, kc1 = (tid + 512) % 12, vkey = tid & 63, vc8 = tid >> 6;
#define AT_REQ(kt_) do { _Pragma("unroll") for (int h_ = 0; h_ < 2; ++h_) { const size_t rb_ = (size_t)bl * TT + ((kt_) * 2 + h_) * 64; \
        pk0[h_] = kc0 < 8 ? *(const u32x4*)(KV + (rb_ + kkey0) * 1024 + head * 128 + kc0 * 8) : *(const u32x4*)(P + (rb_ + kkey0) * CD_N + CD_KR + (kc0 - 8) * 8); \
        if (tid < 256) pk1[h_] = kc1 < 8 ? *(const u32x4*)(KV + (rb_ + kkey1) * 1024 + head * 128 + kc1 * 8) : *(const u32x4*)(P + (rb_ + kkey1) * CD_N + CD_KR + (kc1 - 8) * 8); \
        pvv[h_] = *(const u32x4*)(KV + (rb_ + vkey) * 1024 + head * 128 + 64 + vc8 * 8); } } while (0)
    AT_REQ(0);
    const float SC2 = SC * 1.4426950408889634f;
    for (int kt = 0; kt < TT / 128; ++kt) {
        lds_barrier();
#pragma unroll
        for (int h_ = 0; h_ < 2; ++h_) {
            *(u32x4*)(Kt + (h_ * 64 + kkey0) * AT_LQ + kc0 * 8) = pk0[h_];
            if (tid < 256) *(u32x4*)(Kt + (h_ * 64 + kkey1) * AT_LQ + kc1 * 8) = pk1[h_];
            { bf16_t* vt = Vt + (h_ * 64 + vc8 * 8) * AT_LV + vkey; const u32x4 v = pvv[h_];
                vt[0 * AT_LV] = (bf16_t)(v.x & 0xffff); vt[1 * AT_LV] = (bf16_t)(v.x >> 16); vt[2 * AT_LV] = (bf16_t)(v.y & 0xffff); vt[3 * AT_LV] = (bf16_t)(v.y >> 16);
                vt[4 * AT_LV] = (bf16_t)(v.z & 0xffff); vt[5 * AT_LV] = (bf16_t)(v.z >> 16); vt[6 * AT_LV] = (bf16_t)(v.w & 0xffff); vt[7 * AT_LV] = (bf16_t)(v.w >> 16); }
        }
        if (kt + 1 < TT / 128) AT_REQ(kt + 1);
        lds_barrier();
        {
        bf16x8 kf[3][4]; f32x4 sta[2][4], stb[2][4]; u32x2 vlo[2][4], vhi[2][4];
        union { bf16x8 v; unsigned u[4]; } pb[2][2];
#define AT_LOADK(hs_) do { const bf16_t* Kth = Kt + (hs_) * 64 * AT_LQ; \
            _Pragma("unroll") for (int k = 0; k < 3; ++k) _Pragma("unroll") for (int kk = 0; kk < 4; ++kk) kf[k][kk] = ldfrag(Kth, AT_LQ, kk * 16, k * 32, fr, fq); } while (0)
#define AT_LOADV(hs_) do { const bf16_t* Vth = Vt + (hs_) * 64 * AT_LV; \
            _Pragma("unroll") for (int k2 = 0; k2 < 2; ++k2) _Pragma("unroll") for (int dvt = 0; dvt < 4; ++dvt) { const bf16_t* vp = Vth + (dvt * 16 + fr) * AT_LV + k2 * 32 + fq * 4; vlo[k2][dvt] = *(const u32x2*)vp; vhi[k2][dvt] = *(const u32x2*)(vp + 16); } } while (0)
#define AT_QK(st) do { _Pragma("unroll") for (int rt = 0; rt < 2; ++rt) _Pragma("unroll") for (int kk = 0; kk < 4; ++kk) st[rt][kk] = (f32x4){0.f, 0.f, 0.f, 0.f}; \
            _Pragma("unroll") for (int k = 0; k < 3; ++k) _Pragma("unroll") for (int kk = 0; kk < 4; ++kk) _Pragma("unroll") for (int rt = 0; rt < 2; ++rt) st[rt][kk] = mma16(kf[k][kk], qf[rt][k], st[rt][kk]); } while (0)
#define AT_SM(st) do { _Pragma("unroll") for (int rt = 0; rt < 2; ++rt) { \
            float mx = -1e30f; \
            _Pragma("unroll") for (int kk = 0; kk < 4; ++kk) mx = fmaxf(mx, fmaxf(fmaxf(st[rt][kk][0], st[rt][kk][1]), fmaxf(st[rt][kk][2], st[rt][kk][3]))); \
            mx = xmax_rows(mx); \
            const float mold = mrow[rt], mnew = fmaxf(mold, mx), mb = mnew * SC2; \
            float ls = 0.f; \
            _Pragma("unroll") for (int kk = 0; kk < 4; ++kk) _Pragma("unroll") for (int r = 0; r < 4; ++r) { const float pv = __builtin_amdgcn_exp2f(st[rt][kk][r] * SC2 - mb); st[rt][kk][r] = pv; ls += pv; } \
            _Pragma("unroll") for (int k2 = 0; k2 < 2; ++k2) { \
                pb[rt][k2].u[0] = pack2(st[rt][2 * k2][0], st[rt][2 * k2][1]); pb[rt][k2].u[1] = pack2(st[rt][2 * k2][2], st[rt][2 * k2][3]); \
                pb[rt][k2].u[2] = pack2(st[rt][2 * k2 + 1][0], st[rt][2 * k2 + 1][1]); pb[rt][k2].u[3] = pack2(st[rt][2 * k2 + 1][2], st[rt][2 * k2 + 1][3]); } \
            if (__builtin_amdgcn_ballot_w64(mnew > mold) != 0ull) {         \
                const float alpha = __builtin_amdgcn_exp2f((mold - mnew) * SC2); \
                lsum[rt] *= alpha; \
                _Pragma("unroll") for (int i = 0; i < 4; ++i) ot[rt][i] = ot[rt][i] * alpha; } \
            mrow[rt] = mnew; lsum[rt] += ls; } } while (0)
#define AT_PV() do { _Pragma("unroll") for (int k2 = 0; k2 < 2; ++k2) _Pragma("unroll") for (int dvt = 0; dvt < 4; ++dvt) { union { bf16x8 v; u32x2 h[2]; } va; va.h[0] = vlo[k2][dvt]; va.h[1] = vhi[k2][dvt]; \
            _Pragma("unroll") for (int rt = 0; rt < 2; ++rt) ot[rt][dvt] = mma16(va.v, pb[rt][k2].v, ot[rt][dvt]); } } while (0)
        AT_LOADK(0);
        __builtin_amdgcn_sched_barrier(0);
        AT_QK(sta);
        AT_LOADK(1);
        AT_QK(stb);
        AT_LOADV(0);
        __builtin_amdgcn_sched_barrier(0);
        AT_SM(sta);
        AT_PV();
        AT_LOADV(1);
        __builtin_amdgcn_sched_barrier(0);
        AT_SM(stb);
        AT_PV();
#undef AT_LOADK
#undef AT_LOADV
#undef AT_QK
#undef AT_SM
#undef AT_PV
        }
    }
#undef AT_REQ
#pragma unroll
    for (int rt = 0; rt < 2; ++rt) {
        float ls = lsum[rt]; ls += __shfl_xor(ls, 16); ls += __shfl_xor(ls, 32);
        const float rl = frcp_(ls);
        const size_t orow = (size_t)bl * SEQ + qb * 256 + wid * 32 + rt * 16 + fr;
#pragma unroll
        for (int dvt = 0; dvt < 4; ++dvt) st4bf(AOUT + orow * 1536 + head * 64 + dvt * 16 + fq * 4, ot[rt][dvt] * rl);
    }
}

constexpr int RW_LR = 200, RW_LP = 72;
struct TrueT { static constexpr bool value = true; }; struct FalseT { static constexpr bool value = false; };
PHASE_FN void rwkv_unit(const KP& kp, unsigned char* lds, int bl, int h, int dir) {
    const int tid = otid();
    constexpr int NC = TT / 32;
    bf16_t* RAW = (bf16_t*)lds;
    bf16_t* TWb = RAW + 34 * RW_LR;
    bf16_t* ALb = TWb + 32 * RW_LP;
    float* WLf = (float*)(ALb + 32 * RW_LP);
    float* ALf = WLf + 32 * 64;
    bf16_t* BK = (bf16_t*)WLf;
    float* WT = ALf + 32 * 64;
    bf16_t* AR = (bf16_t*)(WT + 8 * 64);
    float* AABT = (float*)(AR + 64 * RW_LP);
    bf16_t* ARB0 = (bf16_t*)(AABT + 32 * 36);
    bf16_t* AAK = ARB0 + 2 * 32 * 40;
    bf16_t* ARK = AAK + 32 * 40;
    float* RHS = (float*)(ARK + 32 * 40);
    float* YB = RHS + 32 * 64;
    bf16_t* ZVT0 = (bf16_t*)(YB + 32 * 64);
    bf16_t* BKh0 = ZVT0 + 2 * 64 * RW_LP;
    bf16_t* Sb = BKh0 + 2 * 64 * RW_LP;
    float* PL0 = (float*)(Sb + 64 * RW_LP);
    float* CV = PL0 + 2 * 64;
    bf16_t* A21b = (bf16_t*)(CV + 8 * 64);
    bf16_t* TI = A21b + 16 * 40;
    bf16_t* RHSb = TI + 2 * 16 * 40;
    bf16_t* XB = RHSb + 64 * 40;
    static_assert((34 * RW_LR + 2 * 32 * RW_LP) * 2 + (2 * 32 * 64 + 8 * 64) * 4 + 64 * RW_LP * 2 + 32 * 36 * 4 + 4 * 32 * 40 * 2 + 2 * 32 * 64 * 4
                  + 5 * 64 * RW_LP * 2 + (2 * 64 + 8 * 64) * 4 + (16 * 40 + 2 * 16 * 40 + 2 * 64 * 40) * 2 <= LDS_BYTES - 16, "rwkv LDS");
    const bf16_t* P = WSP(const bf16_t, WS_BIG + L1_P); const bf16_t* TWAL = WSP(const bf16_t, WS_BIG + L1_TWAL);
    bf16_t* OUT = WSP(bf16_t, WS_BIG + (dir ? L1_OB : L1_OF));
    float* BSC = WSP(float, WS_BSC) + (size_t)dir * RGL * 16;
    const float* mu = KIN(24);
    bf16x8 wfr[2][2];
    {
        const int wv = tid >> 6, fr0 = tid & 15, fq0 = (tid & 63) >> 4; const float* wsrc = (wv >> 2) ? KIN(28) : KIN(26);
#pragma unroll
        for (int q2 = 0; q2 < 2; ++q2)
#pragma unroll
            for (int k = 0; k < 2; ++k) { const int n = ((wv & 1) * 2 + q2) * 16 + fr0; union { bf16x8 v; unsigned u[4]; } tw;
#pragma unroll
                for (int e = 0; e < 4; ++e) { const int c0 = k * 32 + fq0 * 8 + 2 * e;
                    tw.u[e] = pack2(wsrc[((size_t)dir * 64 + c0) * 1024 + h * 64 + n], wsrc[((size_t)dir * 64 + c0 + 1) * 1024 + h * 64 + n]); }
                wfr[q2][k] = tw.v; }
    }
    for (int i = tid; i < 2 * 16 * 40; i += 512) TI[i] = 0;
    for (int i = tid; i < 64 * 40; i += 512) XB[i] = 0;
    for (int i = tid; i < 64 * RW_LP; i += 512) Sb[i] = 0;
    for (int i = tid; i < 16 * 40; i += 512) A21b[i] = 0;
    for (int i = tid; i < 2 * 64 * RW_LP; i += 512) ZVT0[i] = 0;
    if (tid < 64) { const int n = tid;
        CV[0 * 64 + n] = KIN(25)[dir * 1024 + h * 64 + n]; CV[1 * 64 + n] = KIN(27)[dir * 1024 + h * 64 + n];
        CV[2 * 64 + n] = KIN(30)[h * 64 + n]; CV[3 * 64 + n] = KIN(31)[h * 64 + n]; CV[4 * 64 + n] = KIN(32)[h * 64 + n];
        CV[5 * 64 + n] = mu[h * 64 + n]; CV[6 * 64 + n] = mu[1024 + h * 64 + n]; CV[7 * 64 + n] = mu[2048 + h * 64 + n]; }
    f32x4 Sacc[2];
    Sacc[0] = (f32x4){0.f, 0.f, 0.f, 0.f}; Sacc[1] = (f32x4){0.f, 0.f, 0.f, 0.f};
    u32x4 pf[3];
#define RW_PREFETCH(cn, tix) do { const int t0n_ = dir ? scan_t<32>(1, (cn), 31) : (cn) * 32; const int lo_ = t0n_ < CTXL ? 0 : CTXL, hi_ = t0n_ < CTXL ? CTXL : TT; \
        _Pragma("unroll") for (int q = 0; q < 2; ++q) { const int p = (tix) + q * 512; pf[q] = (u32x4){0u, 0u, 0u, 0u}; \
            if (p < 34 * 24) { const int rr = p / 24, c = p % 24, t = t0n_ - 1 + rr; \
                if (t >= lo_ && t < hi_) { const int seg = c >> 3, c8 = c & 7; \
                    const int col = (seg == 0 ? CD_R : seg == 1 ? CD_K : CD_V) + h * 64; \
                    pf[q] = *(const u32x4*)(P + ((size_t)bl * TT + t) * CD_N + col + c8 * 8); } } } \
        { const int i_ = (tix) >> 4, c16 = (tix) & 15; \
          pf[2] = *(const u32x4*)(TWAL + ((size_t)bl * TT + t0n_ + i_) * 256 + (c16 >> 3) * 128 + dir * 64 + (c16 & 7) * 8); } } while (0)
    RW_PREFETCH(0, tid);
    lds_barrier();
    auto step = [&](auto doP_t, auto doD_t, const int ci) __attribute__((always_inline)) {
        constexpr bool doP = decltype(doP_t)::value, doD = decltype(doD_t)::value;
        int tq = tid; asm volatile("" : "+v"(tq));
        const int lane = tq & 63, wid = __builtin_amdgcn_readfirstlane(tq >> 6), fr = lane & 15, fq = lane >> 4, pi = tq >> 4, n4 = (tq & 15) * 4;
        const int cp = ci + 1, pc = ci & 1, pn = cp & 1;
        const int t0 = dir ? scan_t<32>(1, ci, 31) : ci * 32, t0p = dir ? scan_t<32>(1, cp, 31) : cp * 32;
        bf16_t* ZVc = ZVT0 + pc * 64 * RW_LP; bf16_t* ZVn = ZVT0 + pn * 64 * RW_LP;
        const bf16_t* BKhc = BKh0 + pc * 64 * RW_LP; bf16_t* BKhn = BKh0 + pn * 64 * RW_LP;
        const bf16_t* ARBc = ARB0 + pc * 32 * 40; bf16_t* ARBn = ARB0 + pn * 32 * 40;
        const float* PLc = PL0 + pc * 64; float* PLn = PL0 + pn * 64;
        if constexpr (doP) {
#pragma unroll
            for (int q = 0; q < 2; ++q) { const int p = tq + q * 512; if (p < 34 * 24) *(u32x4*)(RAW + (p / 24) * RW_LR + (p % 24) * 8) = pf[q]; }
            { const int i_ = tq >> 4, c16 = tq & 15; *(u32x4*)(((c16 >> 3) ? ALb : TWb) + i_ * RW_LP + (c16 & 7) * 8) = pf[2]; }
        }
        if constexpr (doD) {
            if (wid > 0) for (int rep_ = 0; rep_ < ((RWP & 32) ? 2 : 1); ++rep_) {
#pragma unroll
                for (int q3 = 0; q3 < 3; ++q3) { const int tl = (wid - 1) + 7 * q3;
                    if (tl < 16) {
                        const int which = tl >> 3, tt = (tl >> 2) & 1, vt = tl & 3;
                        const bf16_t* Ak = which ? ARK : AAK; float* Od = which ? YB : RHS;
                        f32x4 acc = (f32x4){0.f, 0.f, 0.f, 0.f};
#pragma unroll
                        for (int k = 0; k < 2; ++k) acc = mma16(ldfrag(AR, RW_LP, which * 32 + tt * 16, k * 32, fr, fq), ldfrag(Sb, RW_LP, vt * 16, k * 32, fr, fq), acc);
                        acc = mma16(ldfrag(Ak, 40, tt * 16, 0, fr, fq), ldfrag(ZVc, RW_LP, vt * 16, 32, fr, fq), acc);
#pragma unroll
                        for (int rr = 0; rr < 4; ++rr) Od[(tt * 16 + fq * 4 + rr) * 64 + vt * 16 + fr] = acc[rr];
                        if (!which) st4bf(RHSb + (vt * 16 + fr) * 40 + tt * 16 + fq * 4, acc);
                    } }
            } else for (int rep_ = 0; rep_ < ((RWP & 1) ? 2 : 1); ++rep_) {
                const float* AB = AABT + ((lane >> 4) & 1) * (16 * 36 + 16);
                float z[16]; f32x4 ca0, ca1, ca2, ca3, cb0, cb1, cb2, cb3;
#pragma unroll
                for (int t = 0; t < 16; ++t) z[t] = (t == (lane & 15)) ? 1.0f : 0.f;
                ca0 = *(const f32x4*)(AB + 0 * 36 + 0); ca1 = *(const f32x4*)(AB + 0 * 36 + 4); ca2 = *(const f32x4*)(AB + 0 * 36 + 8); ca3 = *(const f32x4*)(AB + 0 * 36 + 12);
                cb0 = *(const f32x4*)(AB + 1 * 36 + 0); cb1 = *(const f32x4*)(AB + 1 * 36 + 4); cb2 = *(const f32x4*)(AB + 1 * 36 + 8); cb3 = *(const f32x4*)(AB + 1 * 36 + 12);
                { const float zs = z[0]; z[1] = __builtin_fmaf(ca0[1], zs, z[1]); z[2] = __builtin_fmaf(ca0[2], zs, z[2]); z[3] = __builtin_fmaf(ca0[3], zs, z[3]); z[4] = __builtin_fmaf(ca1[0], zs, z[4]); z[5] = __builtin_fmaf(ca1[1], zs, z[5]); z[6] = __builtin_fmaf(ca1[2], zs, z[6]); z[7] = __builtin_fmaf(ca1[3], zs, z[7]); z[8] = __builtin_fmaf(ca2[0], zs, z[8]); z[9] = __builtin_fmaf(ca2[1], zs, z[9]); z[10] = __builtin_fmaf(ca2[2], zs, z[10]); z[11] = __builtin_fmaf(ca2[3], zs, z[11]); z[12] = __builtin_fmaf(ca3[0], zs, z[12]); z[13] = __builtin_fmaf(ca3[1], zs, z[13]); z[14] = __builtin_fmaf(ca3[2], zs, z[14]); z[15] = __builtin_fmaf(ca3[3], zs, z[15]); }
                asm volatile("" : "+v"(z[1]) :: "memory");
                ca0 = *(const f32x4*)(AB + 2 * 36 + 0); ca1 = *(const f32x4*)(AB + 2 * 36 + 4); ca2 = *(const f32x4*)(AB + 2 * 36 + 8); ca3 = *(const f32x4*)(AB + 2 * 36 + 12);
                { const float zs = z[1]; z[2] = __builtin_fmaf(cb0[2], zs, z[2]); z[3] = __builtin_fmaf(cb0[3], zs, z[3]); z[4] = __builtin_fmaf(cb1[0], zs, z[4]); z[5] = __builtin_fmaf(cb1[1], zs, z[5]); z[6] = __builtin_fmaf(cb1[2], zs, z[6]); z[7] = __builtin_fmaf(cb1[3], zs, z[7]); z[8] = __builtin_fmaf(cb2[0], zs, z[8]); z[9] = __builtin_fmaf(cb2[1], zs, z[9]); z[10] = __builtin_fmaf(cb2[2], zs, z[10]); z[11] = __builtin_fmaf(cb2[3], zs, z[11]); z[12] = __builtin_fmaf(cb3[0], zs, z[12]); z[13] = __builtin_fmaf(cb3[1], zs, z[13]); z[14] = __builtin_fmaf(cb3[2], zs, z[14]); z[15] = __builtin_fmaf(cb3[3], zs, z[15]); }
                asm volatile("" : "+v"(z[2]) :: "memory");
                cb1 = *(const f32x4*)(AB + 3 * 36 + 4); cb2 = *(const f32x4*)(AB + 3 * 36 + 8); cb3 = *(const f32x4*)(AB + 3 * 36 + 12);
                { const float zs = z[2]; z[3] = __builtin_fmaf(ca0[3], zs, z[3]); z[4] = __builtin_fmaf(ca1[0], zs, z[4]); z[5] = __builtin_fmaf(ca1[1], zs, z[5]); z[6] = __builtin_fmaf(ca1[2], zs, z[6]); z[7] = __builtin_fmaf(ca1[3], zs, z[7]); z[8] = __builtin_fmaf(ca2[0], zs, z[8]); z[9] = __builtin_fmaf(ca2[1], zs, z[9]); z[10] = __builtin_fmaf(ca2[2], zs, z[10]); z[11] = __builtin_fmaf(ca2[3], zs, z[11]); z[12] = __builtin_fmaf(ca3[0], zs, z[12]); z[13] = __builtin_fmaf(ca3[1], zs, z[13]); z[14] = __builtin_fmaf(ca3[2], zs, z[14]); z[15] = __builtin_fmaf(ca3[3], zs, z[15]); }
                asm volatile("" : "+v"(z[3]) :: "memory");
                ca1 = *(const f32x4*)(AB + 4 * 36 + 4); ca2 = *(const f32x4*)(AB + 4 * 36 + 8); ca3 = *(const f32x4*)(AB + 4 * 36 + 12);
                { const float zs = z[3]; z[4] = __builtin_fmaf(cb1[0], zs, z[4]); z[5] = __builtin_fmaf(cb1[1], zs, z[5]); z[6] = __builtin_fmaf(cb1[2], zs, z[6]); z[7] = __builtin_fmaf(cb1[3], zs, z[7]); z[8] = __builtin_fmaf(cb2[0], zs, z[8]); z[9] = __builtin_fmaf(cb2[1], zs, z[9]); z[10] = __builtin_fmaf(cb2[2], zs, z[10]); z[11] = __builtin_fmaf(cb2[3], zs, z[11]); z[12] = __builtin_fmaf(cb3[0], zs, z[12]); z[13] = __builtin_fmaf(cb3[1], zs, z[13]); z[14] = __builtin_fmaf(cb3[2], zs, z[14]); z[15] = __builtin_fmaf(cb3[3], zs, z[15]); }
                asm volatile("" : "+v"(z[4]) :: "memory");
                cb1 = *(const f32x4*)(AB + 5 * 36 + 4); cb2 = *(const f32x4*)(AB + 5 * 36 + 8); cb3 = *(const f32x4*)(AB + 5 * 36 + 12);
                { const float zs = z[4]; z[5] = __builtin_fmaf(ca1[1], zs, z[5]); z[6] = __builtin_fmaf(ca1[2], zs, z[6]); z[7] = __builtin_fmaf(ca1[3], zs, z[7]); z[8] = __builtin_fmaf(ca2[0], zs, z[8]); z[9] = __builtin_fmaf(ca2[1], zs, z[9]); z[10] = __builtin_fmaf(ca2[2], zs, z[10]); z[11] = __builtin_fmaf(ca2[3], zs, z[11]); z[12] = __builtin_fmaf(ca3[0], zs, z[12]); z[13] = __builtin_fmaf(ca3[1], zs, z[13]); z[14] = __builtin_fmaf(ca3[2], zs, z[14]); z[15] = __builtin_fmaf(ca3[3], zs, z[15]); }
                asm volatile("" : "+v"(z[5]) :: "memory");
                ca1 = *(const f32x4*)(AB + 6 * 36 + 4); ca2 = *(const f32x4*)(AB + 6 * 36 + 8); ca3 = *(const f32x4*)(AB + 6 * 36 + 12);
                { const float zs = z[5]; z[6] = __builtin_fmaf(cb1[2], zs, z[6]); z[7] = __builtin_fmaf(cb1[3], zs, z[7]); z[8] = __builtin_fmaf(cb2[0], zs, z[8]); z[9] = __builtin_fmaf(cb2[1], zs, z[9]); z[10] = __builtin_fmaf(cb2[2], zs, z[10]); z[11] = __builtin_fmaf(cb2[3], zs, z[11]); z[12] = __builtin_fmaf(cb3[0], zs, z[12]); z[13] = __builtin_fmaf(cb3[1], zs, z[13]); z[14] = __builtin_fmaf(cb3[2], zs, z[14]); z[15] = __builtin_fmaf(cb3[3], zs, z[15]); }
                asm volatile("" : "+v"(z[6]) :: "memory");
                cb2 = *(const f32x4*)(AB + 7 * 36 + 8); cb3 = *(const f32x4*)(AB + 7 * 36 + 12);
                { const float zs = z[6]; z[7] = __builtin_fmaf(ca1[3], zs, z[7]); z[8] = __builtin_fmaf(ca2[0], zs, z[8]); z[9] = __builtin_fmaf(ca2[1], zs, z[9]); z[10] = __builtin_fmaf(ca2[2], zs, z[10]); z[11] = __builtin_fmaf(ca2[3], zs, z[11]); z[12] = __builtin_fmaf(ca3[0], zs, z[12]); z[13] = __builtin_fmaf(ca3[1], zs, z[13]); z[14] = __builtin_fmaf(ca3[2], zs, z[14]); z[15] = __builtin_fmaf(ca3[3], zs, z[15]); }
                asm volatile("" : "+v"(z[7]) :: "memory");
                ca2 = *(const f32x4*)(AB + 8 * 36 + 8); ca3 = *(const f32x4*)(AB + 8 * 36 + 12);
                { const float zs = z[7]; z[8] = __builtin_fmaf(cb2[0], zs, z[8]); z[9] = __builtin_fmaf(cb2[1], zs, z[9]); z[10] = __builtin_fmaf(cb2[2], zs, z[10]); z[11] = __builtin_fmaf(cb2[3], zs, z[11]); z[12] = __builtin_fmaf(cb3[0], zs, z[12]); z[13] = __builtin_fmaf(cb3[1], zs, z[13]); z[14] = __builtin_fmaf(cb3[2], zs, z[14]); z[15] = __builtin_fmaf(cb3[3], zs, z[15]); }
                asm volatile("" : "+v"(z[8]) :: "memory");
                cb2 = *(const f32x4*)(AB + 9 * 36 + 8); cb3 = *(const f32x4*)(AB + 9 * 36 + 12);
                { const float zs = z[8]; z[9] = __builtin_fmaf(ca2[1], zs, z[9]); z[10] = __builtin_fmaf(ca2[2], zs, z[10]); z[11] = __builtin_fmaf(ca2[3], zs, z[11]); z[12] = __builtin_fmaf(ca3[0], zs, z[12]); z[13] = __builtin_fmaf(ca3[1], zs, z[13]); z[14] = __builtin_fmaf(ca3[2], zs, z[14]); z[15] = __builtin_fmaf(ca3[3], zs, z[15]); }
                asm volatile("" : "+v"(z[9]) :: "memory");
                ca2 = *(const f32x4*)(AB + 10 * 36 + 8); ca3 = *(const f32x4*)(AB + 10 * 36 + 12);
                { const float zs = z[9]; z[10] = __builtin_fmaf(cb2[2], zs, z[10]); z[11] = __builtin_fmaf(cb2[3], zs, z[11]); z[12] = __builtin_fmaf(cb3[0], zs, z[12]); z[13] = __builtin_fmaf(cb3[1], zs, z[13]); z[14] = __builtin_fmaf(cb3[2], zs, z[14]); z[15] = __builtin_fmaf(cb3[3], zs, z[15]); }
                asm volatile("" : "+v"(z[10]) :: "memory");
                cb3 = *(const f32x4*)(AB + 11 * 36 + 12);
                { const float zs = z[10]; z[11] = __builtin_fmaf(ca2[3], zs, z[11]); z[12] = __builtin_fmaf(ca3[0], zs, z[12]); z[13] = __builtin_fmaf(ca3[1], zs, z[13]); z[14] = __builtin_fmaf(ca3[2], zs, z[14]); z[15] = __builtin_fmaf(ca3[3], zs, z[15]); }
                asm volatile("" : "+v"(z[11]) :: "memory");
                ca3 = *(const f32x4*)(AB + 12 * 36 + 12);
                { const float zs = z[11]; z[12] = __builtin_fmaf(cb3[0], zs, z[12]); z[13] = __builtin_fmaf(cb3[1], zs, z[13]); z[14] = __builtin_fmaf(cb3[2], zs, z[14]); z[15] = __builtin_fmaf(cb3[3], zs, z[15]); }
                asm volatile("" : "+v"(z[12]) :: "memory");
                cb3 = *(const f32x4*)(AB + 13 * 36 + 12);
                { const float zs = z[12]; z[13] = __builtin_fmaf(ca3[1], zs, z[13]); z[14] = __builtin_fmaf(ca3[2], zs, z[14]); z[15] = __builtin_fmaf(ca3[3], zs, z[15]); }
                asm volatile("" : "+v"(z[13]) :: "memory");
                ca3 = *(const f32x4*)(AB + 14 * 36 + 12);
                { const float zs = z[13]; z[14] = __builtin_fmaf(cb3[2], zs, z[14]); z[15] = __builtin_fmaf(cb3[3], zs, z[15]); }
                asm volatile("" : "+v"(z[14]) :: "memory");
                { const float zs = z[14]; z[15] = __builtin_fmaf(ca3[3], zs, z[15]); }
                asm volatile("" : "+v"(z[15]) :: "memory");
                if (lane < 32) {
#pragma unroll
                    for (int t = 0; t < 16; ++t) TI[(lane >> 4) * 16 * 40 + t * 40 + (lane & 15)] = f2bf(z[t]);
                }
            }
        }
        if constexpr (doP) { if (cp + 1 < NC) RW_PREFETCH(cp + 1, tq); }
        lds_barrier();
        if constexpr (doD) if (wid < 4) {
            f32x4 acc = (f32x4){0.f, 0.f, 0.f, 0.f};
            acc = mma16(ldfrag(TI, 40, 0, 0, fr, fq), ldfrag(RHSb, 40, wid * 16, 0, fr, fq), acc);
            st4bf(ZVc + (wid * 16 + fr) * RW_LP + fq * 4, acc);
        }
        if constexpr (doP) for (int rep_ = 0; rep_ < ((RWP & 64) ? 2 : 1); ++rep_) {
            const int which = wid >> 2, tt = (wid >> 1) & 1;
            const bf16_t* Xa = which ? ALb : TWb; float* Od = which ? ALf : WLf;
#pragma unroll
            for (int q2 = 0; q2 < 2; ++q2) { const int nt = (wid & 1) * 2 + q2;
                f32x4 acc = (f32x4){0.f, 0.f, 0.f, 0.f};
#pragma unroll
                for (int k = 0; k < 2; ++k) acc = mma16(ldfrag(Xa, RW_LP, tt * 16, k * 32, fr, fq), wfr[q2][k], acc);
#pragma unroll
                for (int rr = 0; rr < 4; ++rr) Od[(tt * 16 + fq * 4 + rr) * 64 + nt * 16 + fr] = acc[rr]; }
            const int pp = tq & 31, cg = tq >> 5, jj = dir ? 31 - pp : pp;
            const bf16_t* r1v = RAW + (pp + 1) * RW_LR + 128 + cg * 4;
            const f32x4 muv = *(const f32x4*)(CV + 448 + cg * 4);
            f32x4 v = ld4bf(r1v);
            v = v + muv * ((ld4bf(r1v - RW_LR) + ld4bf(r1v + RW_LR)) * 0.5f - v);
#pragma unroll
            for (int q = 0; q < 4; ++q) ZVn[(cg * 4 + q) * RW_LP + 32 + jj] = f2bf(v[q]);
        }
        lds_barrier();
        if (RWP & 16) { lds_barrier(); lds_barrier(); lds_barrier(); lds_barrier(); lds_barrier(); }
        const int j = dir ? 31 - pi : pi;
        f32x4 r, kd, av, bv, lw, cin;
        f32x4 xacc = (f32x4){0.f, 0.f, 0.f, 0.f};
        if constexpr (doD) {
            xacc = mma16(ldfrag(A21b, 40, 0, 0, fr, fq), ldfrag(ZVc, RW_LP, (wid & 3) * 16, 0, fr, fq), xacc);
#pragma unroll
            for (int rr = 0; rr < 4; ++rr) xacc[rr] += RHS[(16 + fq * 4 + rr) * 64 + (wid & 3) * 16 + fr];
        }
        if constexpr (doP) for (int rep_ = 0; rep_ < ((RWP & 2) ? 2 : 1); ++rep_) {
            const f32x4 w0v = *(const f32x4*)(CV + n4), a0v = *(const f32x4*)(CV + 64 + n4), kkw = *(const f32x4*)(CV + 128 + n4), kaw = *(const f32x4*)(CV + 192 + n4), rkw = *(const f32x4*)(CV + 256 + n4);
            const f32x4 mur = *(const f32x4*)(CV + 320 + n4), muk = *(const f32x4*)(CV + 384 + n4);
            const f32x4 wl = w0v + *(const f32x4*)(WLf + pi * 64 + n4), al = a0v + *(const f32x4*)(ALf + pi * 64 + n4);
            const bf16_t* r1 = RAW + (pi + 1) * RW_LR; const bf16_t* rp = RAW + pi * RW_LR; const bf16_t* rn = RAW + (pi + 2) * RW_LR;
            f32x4 k;
            r = ld4bf(r1 + n4); k = ld4bf(r1 + 64 + n4);
            r = r + mur * ((ld4bf(rp + n4) + ld4bf(rn + n4)) * 0.5f - r);
            k = k + muk * ((ld4bf(rp + 64 + n4) + ld4bf(rn + 64 + n4)) * 0.5f - k);
            f32x4 a, kk = k * kkw;
            float ssq = kk[0] * kk[0] + kk[1] * kk[1] + kk[2] * kk[2] + kk[3] * kk[3];
            ssq = rsum16(ssq);
            kk = kk * __builtin_amdgcn_rsqf(fmaxf(ssq, 1e-24f));
#pragma unroll
            for (int q = 0; q < 4; ++q) { lw[q] = -0.6065306597126334f * sigmoidf_(wl[q]); a[q] = sigmoidf_(al[q]); }
            kd = k * ((a - 1.0f) * kaw + 1.0f);
            float bs = r[0] * kd[0] * rkw[0] + r[1] * kd[1] * rkw[1] + r[2] * kd[2] * rkw[2] + r[3] * kd[3] * rkw[3];
            bs = rsum16(bs);
            av = kk * -1.0f; bv = kk * a;
            f32x4 wt;
#pragma unroll
            for (int q = 0; q < 4; ++q) {
                const float lwq = lw[q];
                const auto e16 = __builtin_amdgcn_permlane16_swap(__builtin_bit_cast(unsigned, lwq), __builtin_bit_cast(unsigned, lwq), false, false);
                const unsigned e16a = e16[0], e16b = e16[1];
                const float y = __builtin_bit_cast(float, e16a) + __builtin_bit_cast(float, e16b);
                const auto e32 = __builtin_amdgcn_permlane32_swap(__builtin_bit_cast(unsigned, y), __builtin_bit_cast(unsigned, y), false, false);
                const unsigned e32a = e32[0], e32b = e32[1];
                wt[q] = __builtin_bit_cast(float, e32a) + __builtin_bit_cast(float, e32b);
                cin[q] = ((fq & 1) ? y : lwq) + ((fq & 2) ? (wt[q] - y) : 0.f);
            }
            if (fq == 0) *(f32x4*)(WT + wid * 64 + n4) = wt;
            const int t = t0p + pi;
            if (t >= CTXL && (tq & 15) == 0) BSC[((size_t)bl * SEQ + (t - CTXL)) * 16 + h] = bs;
        }
        if constexpr (doD) if (wid < 4) st4bf(XB + (wid * 16 + fr) * 40 + fq * 4, xacc);
        lds_barrier();
        if constexpr (doD) if (wid < 4) {
            f32x4 acc = (f32x4){0.f, 0.f, 0.f, 0.f};
            acc = mma16(ldfrag(TI + 16 * 40, 40, 0, 0, fr, fq), ldfrag(XB, 40, wid * 16, 0, fr, fq), acc);
            st4bf(ZVc + (wid * 16 + fr) * RW_LP + 16 + fq * 4, acc);
        }
        if constexpr (doP) for (int rep_ = 0; rep_ < ((RWP & 4) ? 2 : 1); ++rep_) {
            f32x4 pre = (f32x4){0.f, 0.f, 0.f, 0.f}, cle = (f32x4){0.f, 0.f, 0.f, 0.f};
#pragma unroll
            for (int w = 0; w < 8; ++w) { const f32x4 t4 = *(const f32x4*)(WT + w * 64 + n4); cle = cle + t4; if (w < wid) pre = pre + t4; }
            const f32x4 cim = cin + pre;
            const f32x4 clj = dir ? cle - cim + lw : cim;
            const f32x4 clp = dir ? cle - cim : cim - lw;
            f32x4 at, rt, bt, kt, bh, kh;
#pragma unroll
            for (int q = 0; q < 4; ++q) { const float ep = __expf(clp[q]), ej = __expf(clj[q]), ei = __expf(-clj[q]), ee = __expf(cle[q] - clj[q]);
                at[q] = av[q] * ep; rt[q] = r[q] * ej; bt[q] = bv[q] * ei; kt[q] = kd[q] * ei; bh[q] = bv[q] * ee; kh[q] = kd[q] * ee; }
            if (tq < 16) { f32x4 e;
#pragma unroll
                for (int q = 0; q < 4; ++q) e[q] = __expf(cle[q]);
                *(f32x4*)(PLn + n4) = e; }
            st4bf(AR + j * RW_LP + n4, at); st4bf(AR + (32 + j) * RW_LP + n4, rt);
            st4bf(BK + j * RW_LP + n4, bt); st4bf(BK + (32 + j) * RW_LP + n4, kt);
            const int cbh = (((j >> 3) ^ (tq & 7)) << 3) | (j & 7), ckh = ((((j >> 3) + 4) ^ (tq & 7)) << 3) | (j & 7);
#pragma unroll
            for (int q = 0; q < 4; ++q) { BKhn[(n4 + q) * RW_LP + cbh] = f2bf(bh[q]); BKhn[(n4 + q) * RW_LP + ckh] = f2bf(kh[q]); }
        }
        lds_barrier();
        if constexpr (doD) {
            const int nt = wid >> 1;
            const f32x4 pl = *(const f32x4*)(PLc + nt * 16 + fq * 4);
#pragma unroll
            for (int q2 = 0; q2 < 2; ++q2) {
                const int vt = (wid & 1) * 2 + q2;
                Sacc[q2] = Sacc[q2] * pl;
#pragma unroll
                for (int k = 0; k < 2; ++k) Sacc[q2] = mma16(*(const bf16x8*)(BKhc + (nt * 16 + fr) * RW_LP + (((k * 4 + fq) ^ (((nt & 1) << 2) + (fr >> 2))) << 3)), ldfrag(ZVc, RW_LP, vt * 16, k * 32, fr, fq), Sacc[q2]);
                st4bf(Sb + (vt * 16 + fr) * RW_LP + nt * 16 + fq * 4, Sacc[q2]);
            }
            if (t0 >= CTXL) {
                const int vt = wid >> 1, tt = wid & 1;
                f32x4 acc = (f32x4){0.f, 0.f, 0.f, 0.f};
                acc = mma16(ldfrag(ZVc, RW_LP, vt * 16, 0, fr, fq), ldfrag(ARBc, 40, tt * 16, 0, fr, fq), acc);
                const int t = tt * 16 + fr, v0 = vt * 16 + fq * 4;
#pragma unroll
                for (int rr = 0; rr < 4; ++rr) acc[rr] += YB[t * 64 + v0 + rr];
                const int tn = scan_t<32>(dir, ci, t);
                st4bf(OUT + ((size_t)bl * SEQ + (tn - CTXL)) * 1024 + h * 64 + v0, acc);
            }
        }
        if constexpr (doP) for (int rep_ = 0; rep_ < ((RWP & 8) ? 2 : 1); ++rep_) {
            const int ti = wid >> 1;
#pragma unroll
            for (int q2 = 0; q2 < 2; ++q2) {
                const int si = (wid & 1) * 2 + q2;
                f32x4 acc = (f32x4){0.f, 0.f, 0.f, 0.f};
#pragma unroll
                for (int k = 0; k < 2; ++k) acc = mma16(ldfrag(AR, RW_LP, ti * 16, k * 32, fr, fq), ldfrag(BK, RW_LP, si * 16, k * 32, fr, fq), acc);
                const int s = (si & 1) * 16 + fr;
                const bool incl = ti >= 2, kcols = si >= 2;
                bf16_t* dstb = kcols ? (incl ? ARK : AAK) : ARBn;
#pragma unroll
                for (int rr = 0; rr < 4; ++rr) { const int t = (ti & 1) * 16 + fq * 4 + rr;
                    const float val = (incl ? (s <= t) : (s < t)) ? acc[rr] : 0.f;
                    if (kcols || incl) dstb[t * 40 + s] = f2bf(val);
                    else { AABT[s * 36 + t] = val; if (ti == 1 && si == 0) A21b[(t - 16) * 40 + s] = f2bf(val); } }
            }
        }
        lds_barrier();
    };
    step(TrueT{}, FalseT{}, -1);
#pragma unroll 1
    for (int ci = 0; ci < NC - 1; ++ci) step(TrueT{}, TrueT{}, ci);
    step(FalseT{}, TrueT{}, NC - 1);
#undef RW_PREFETCH
}

__device__ __forceinline__ void phase_mix_cd(const KP& kp, unsigned char* lds, int which) {
    if (which & 1) for (int u = obid(); u < 256; u += gridDim.x) { rwkv_unit(kp, lds, u >> 5, (u >> 1) & 15, u & 1); __syncthreads(); }
    if (which & 2) for (int u = obid(); u < 512; u += gridDim.x) { attn_unit(kp, lds, u >> 6, (u >> 3) & 7, u & 7); __syncthreads(); }
}

struct EpiFinCD {
    const bf16_t* OF; const bf16_t* OB; const bf16_t* P; const float* BSC; const float* ln; const float* mu; bf16_t* AOUT;
    __device__ __forceinline__ void operator()(const f32x4 (&acc)[4][4], int rb, int cb, int fr, int fq) const {
        const int head = cb >> 6;
#pragma unroll
        for (int i = 0; i < 4; ++i) { const int lr = rb + i * 16 + fr, s = lr & 2047;
            const size_t prow = (size_t)(lr >> 11) * TT + CTXL + s;
            f32x4 o[4]; float ss = 0.f;
#pragma unroll
            for (int j = 0; j < 4; ++j) { const int col = cb + j * 16 + fq * 4;
                o[j] = ld4bf(OF + (size_t)lr * 1024 + col) + ld4bf(OB + (size_t)lr * 1024 + col);
                ss += o[j][0] * o[j][0] + o[j][1] * o[j][1] + o[j][2] * o[j][2] + o[j][3] * o[j][3]; }
            ss += __shfl_xor(ss, 16); ss += __shfl_xor(ss, 32);
            const float rstd = rsqrtf(ss * (1.0f / 64.0f) + EPS);
            const float bon = BSC[(size_t)lr * 16 + head] + BSC[(size_t)RGL * 16 + (size_t)lr * 16 + head];
#pragma unroll
            for (int j = 0; j < 4; ++j) { const int col = cb + j * 16 + fq * 4;
                const bf16_t* pv = P + prow * CD_N + CD_V + col;
                const f32x4 v = ld4bf(pv);
                const f32x4 vp = s > 0 ? ld4bf(pv - CD_N) : (f32x4){0.f, 0.f, 0.f, 0.f};
                const f32x4 vn = s < SEQ - 1 ? ld4bf(pv + CD_N) : (f32x4){0.f, 0.f, 0.f, 0.f};
                const f32x4 vl = v + *(const f32x4*)(mu + 2048 + col) * ((vp + vn) * 0.5f - v);
                const f32x4 y = o[j] * rstd * *(const f32x4*)(ln + col) + vl * bon;
                st4bf(AOUT + (size_t)lr * 1536 + 512 + col, y * acc[i][j]); }
        }
    }
};
PHASE_FN void phase_fin_cd(const KP& kp, unsigned char* lds) {
    GA ga{WSP(const bf16_t, WS_SG), nullptr, 128, 0, 128, nullptr, RGL, 0, 0};
    EpiFinCD ep{WSP(const bf16_t, WS_BIG + L1_OF), WSP(const bf16_t, WS_BIG + L1_OB), WSP(const bf16_t, WS_BIG + L1_P), WSP(const float, WS_BSC), KIN(33), KIN(24), WSP(bf16_t, WS_BIG + L1_AOUT)};
    for (int u = obid(); u < (RGL / 256) * 8; u += gridDim.x) gemm_tile(lds, ga, WSP(const bf16_t, WS_WMIX + WM_G2), 128, u >> 3, u & 7, ep);
}
PHASE_FN void phase_gemm_out_cd(const KP& kp, unsigned char* lds) {
    pg8::Gemm g{WSP(const bf16_t, WS_BIG + L1_AOUT), WSP(const bf16_t, WS_WMIX + WM_CD_OUT), RGL, 1024, 1536, nullptr, 0x7fffffff};
    pg8::StaticOrder S; S.init(RGL, 1024, (int)gridDim.x, obid());
    pg8::EpiBfG E{WSP(bf16_t, WS_BIG + L1_U), 1024, 1024, 0x7fffffff, 1.0f};
    pg8::gemm_phase<pg8::EpiBfG, pg8::StaticOrder, false>((PG8_LAS unsigned char*)lds, g, S, E, nullptr);
    __syncthreads();
}

__device__ __attribute__((noinline)) void grid_sync(unsigned* barw, unsigned x, volatile LAS unsigned* st) { XcdBarrier b; b.bar = barw; b.x = x; b.st = st; xcd_barrier(b); }
constexpr int N_PHASES = 36;
__global__ void __launch_bounds__(512, 2) fwd_kernel(KP kparg) {
    extern __shared__ __attribute__((aligned(16))) unsigned char lds[];
    const int lo = kparg.ph_lo, hi = kparg.ph_hi;
    const KP& kp = kparg;
    volatile LAS unsigned* xbst = (volatile LAS unsigned*)(LAS unsigned char*)(lds + LDS_BYTES - 16);
    if (threadIdx.x == 0) { xbst[0] = 0u; xbst[1] = 0u; }
    __syncthreads();
    XcdBarrier bar; bar.bar = (unsigned*)kparg.ws; bar.x = 0; bar.st = xbst;
    if (hi - lo > 1) bar = xcd_barrier_post((unsigned*)kparg.ws, xbst);
#define IN(k) (lo <= (k) && (k) < hi)
#define SEAM(k) do { if (IN(k) && IN((k) + 1)) { grid_sync((unsigned*)kp.ws, bar.x, xbst); if (PROBE_DUP & 512) grid_sync((unsigned*)kp.ws, bar.x, xbst); } } while (0)
#define PHASE(...) do { if (IN(ph)) { __VA_ARGS__ } SEAM(ph); ++ph; } while (0)
    int ph = 0;
    PHASE(phase_mod(kp, lds); __syncthreads(); phase_conv_ab(kp, lds); if (PROBE_DUP & 32) { __syncthreads(); phase_mod(kp, lds); __syncthreads(); phase_conv_ab(kp, lds); });
#pragma unroll
    for (int g = 0; g < NG; ++g) {
        if (g == 0) PHASE(phase_u(kp, 0, 0, obid(), (int)gridDim.x, false););
        PHASE(phase_gemm_in(kp, lds, 0, g); if (PROBE_DUP & 8) phase_gemm_in(kp, lds, 0, g););
        PHASE(phase_xconv(kp); if (PROBE_DUP & 2048) phase_xconv(kp););
        PHASE(phase_scan_ab(kp, lds); if (PROBE_DUP & 1) { __syncthreads(); phase_scan_ab(kp, lds); });
        PHASE(phase_fin_ab(kp););
        PHASE(phase_gemm_out_ab(kp, lds, g););
        PHASE(phase_r(kp, lds, 0, g););
    }
    PHASE(phase_moe_gather(kp, 0); phase_conv_cd(kp, lds););
    PHASE(phase_moe_gemm(kp, lds, 0, false); if (PROBE_DUP & 16) { __syncthreads(); phase_moe_gemm(kp, lds, 0, false); });
    PHASE(phase_moe_gemm(kp, lds, 0, true); if (PROBE_DUP & 16) { __syncthreads(); phase_moe_gemm(kp, lds, 0, true); });
    PHASE(phase_combine(kp, 0););
#pragma unroll
    for (int g = 0; g < NG; ++g) {
        PHASE(phase_gemm_in(kp, lds, 1, g); if (PROBE_DUP & 8) phase_gemm_in(kp, lds, 1, g););
        PHASE(phase_prep_cd(kp););
        PHASE(phase_upproj(kp, lds); if (PROBE_DUP & 4096) phase_upproj(kp, lds););
        PHASE(phase_mix_cd(kp, lds, 3); if (PROBE_DUP & 2) { __syncthreads(); phase_mix_cd(kp, lds, 1); } if (PROBE_DUP & 4) { __syncthreads(); phase_mix_cd(kp, lds, 2); });
        PHASE(phase_fin_cd(kp, lds); if (PROBE_DUP & 4096) phase_fin_cd(kp, lds););
        PHASE(phase_gemm_out_cd(kp, lds); if (PROBE_DUP & 256) phase_gemm_out_cd(kp, lds););
        PHASE(phase_r(kp, lds, 1, g););
    }
    PHASE(phase_moe_gather(kp, 1); phase_conv_moe(kp, lds, 1, obid(), (int)gridDim.x););
    PHASE(phase_moe_gemm(kp, lds, 1, false););
    PHASE(phase_moe_gemm(kp, lds, 1, true););
    PHASE(phase_combine(kp, 1););
#undef PHASE
#undef IN
#undef SEAM
}

extern "C" void kernel_launch(void* const* d_in, const int* in_sizes, int n_in, void* d_out, int out_size, void* d_ws, size_t ws_size, hipStream_t stream) {
    static int grid = 0;
    if (grid == 0) {
        if (n_in != 42 || out_size != NLAT * D || ws_size < WS_NEED) { fprintf(stderr, "kernel_launch: unexpected shapes: n_in %d out %d ws %zu (need %zu)\n", n_in, out_size, ws_size, (size_t)WS_NEED); grid = -1; return; }
        int dev = 0, cus = 0, per_cu = 0;
        if (hipGetDevice(&dev) != hipSuccess || hipDeviceGetAttribute(&cus, hipDeviceAttributeMultiprocessorCount, dev) != hipSuccess) { grid = -1; return; }
        if (hipFuncSetAttribute((const void*)fwd_kernel, hipFuncAttributeMaxDynamicSharedMemorySize, LDS_BYTES) != hipSuccess) { fprintf(stderr, "kernel_launch: hipFuncSetAttribute failed\n"); grid = -1; return; }
        if (hipOccupancyMaxActiveBlocksPerMultiprocessor(&per_cu, (const void*)fwd_kernel, 512, LDS_BYTES) != hipSuccess || per_cu < 1) { fprintf(stderr, "kernel_launch: occupancy query says %d blocks per CU\n", per_cu); grid = -1; (void)hipGetLastError(); return; }
        grid = cus;
    }
    if (grid < 0) return;
    (void)hipMemsetAsync(d_ws, 0, CTL_BYTES, stream);
    KP kp{};
    for (int i = 0; i < 42; ++i) kp.in[i] = (const float*)d_in[i];
    kp.out = (float*)d_out; kp.ws = (unsigned char*)d_ws;
#if N_LAUNCH_MODE == 1
    kp.ph_lo = 0; kp.ph_hi = N_PHASES;
    hipLaunchKernelGGL(fwd_kernel, dim3(grid), dim3(512), LDS_BYTES, stream, kp);
#else
    for (int p = 0; p < N_PHASES; ++p) { kp.ph_lo = p; kp.ph_hi = p + 1; hipLaunchKernelGGL(fwd_kernel, dim3(grid), dim3(512), LDS_BYTES, stream, kp); }
#endif
}
```

```cpp
#include <hip/hip_runtime.h>
#include <stdint.h>
#include <stdio.h>

typedef unsigned short bf16_t;
typedef short bf16x8 __attribute__((ext_vector_type(8)));
typedef float f32x4 __attribute__((ext_vector_type(4)));
typedef float f32x2 __attribute__((ext_vector_type(2)));
typedef unsigned u32x4 __attribute__((ext_vector_type(4)));
typedef unsigned u32x2 __attribute__((ext_vector_type(2)));

#ifndef RWP
#define RWP 0
#endif
#ifndef PROBE_DUP
#define PROBE_DUP 0
#endif
#ifndef N_LAUNCH_MODE
#define N_LAUNCH_MODE 1
#endif

constexpr int NB = 16, SEQ = 2048, CTXL = 256, TT = 2304, D = 1024;
constexpr int NTOK = NB * TT, NLAT = NB * SEQ;
constexpr int NG = 2, BG = NB / NG, RG = BG * TT, RGL = BG * SEQ;
constexpr float EPS = 1e-6f;
constexpr int AB_N = 5424, AB_NPAD = 5632, AB_Q = 0, AB_K = 512, AB_V = 1024, AB_OG = 2048, AB_IG = 3072, AB_FG = 3080, AB_Z = 3088, AB_XBC = 4112, AB_DT = 5392;
constexpr int CD_N = 4128, CD_NPAD = 4352, CD_M0 = 0, CD_M1 = 384, CD_KR = 640, CD_R = 672, CD_K = 1696, CD_V = 2720, CD_WL = 3744, CD_AL = 3872, CD_GL = 4000;
constexpr int CD_RW0 = 672;

constexpr size_t CTL_BYTES = 32768;
constexpr size_t CTL_CNT = 16384;
constexpr size_t WS_MODV = CTL_BYTES;
constexpr size_t WS_HC   = WS_MODV + (size_t)2 * 17 * 6144 * 4;
constexpr size_t WS_TOKE = WS_HC + (size_t)NB * CTXL * D * 4;
constexpr size_t WS_TOKP = WS_TOKE + (size_t)NTOK * 2 * 4;
constexpr size_t WS_TOKW = WS_TOKP + (size_t)NTOK * 2 * 4;
constexpr size_t WS_LIST = WS_TOKW + (size_t)NTOK * 2 * 4;
constexpr size_t WS_BSC  = WS_LIST + (size_t)16 * NTOK * 4;
constexpr size_t WS_SG   = WS_BSC + (size_t)2 * RGL * 16 * 4;
constexpr size_t WS_WMIX = WS_SG + (size_t)RGL * 128 * 2;
constexpr size_t WMIX_BYTES = (size_t)16 << 20;
constexpr size_t WS_V    = WS_WMIX + WMIX_BYTES;
constexpr size_t WS_BIG  = WS_V + (size_t)NTOK * D * 2;
constexpr size_t WM_AB_IN = 0, WM_AB_OUT = (size_t)AB_NPAD * 1024 * 2;
constexpr size_t WM_CD_IN = 0, WM_CD_OUT = (size_t)CD_NPAD * 1024 * 2, WM_UQ = WM_CD_OUT + (size_t)1024 * 1536 * 2, WM_UKV = WM_UQ + (size_t)768 * 384 * 2, WM_G2 = WM_UKV + (size_t)1024 * 256 * 2;
static_assert(WM_AB_OUT + (size_t)1024 * 2048 * 2 <= WMIX_BYTES, "wmix ab");
static_assert(WM_G2 + (size_t)1024 * 128 * 2 <= WMIX_BYTES, "wmix cd");
constexpr size_t SZ_RG1K = (size_t)RG * 1024 * 2, SZ_RGL1K = (size_t)RGL * 1024 * 2;
constexpr size_t L0_P = 0, L0_AO = (size_t)RG * AB_N * 2  , L0_HB = L0_AO + 2 * SZ_RG1K, L0_YB = L0_HB + SZ_RG1K, L0_U = L0_YB + SZ_RG1K, L0_END = L0_U + SZ_RG1K;
constexpr size_t L1_P = 0, L1_Q = (size_t)RG * CD_N * 2, L1_KV = L1_Q + (size_t)RGL * 768 * 2, L1_OF = L1_KV + SZ_RG1K, L1_OB = L1_OF + SZ_RGL1K, L1_AOUT = L1_OB + SZ_RGL1K, L1_U = L1_AOUT + (size_t)RGL * 1536 * 2, L1_TWAL = L1_U + SZ_RG1K  , L1_END = L1_TWAL + (size_t)RG * 256 * 2;
constexpr int MOE_PADROWS = 16 * 256;
constexpr size_t MO_WUP = 0, MO_WDN = (size_t)17 * 1024 * 1024 * 2, MO_HID = MO_WDN + (size_t)17 * 1024 * 512 * 2;
constexpr size_t MO_XG = MO_HID + (size_t)(3 * NTOK + MOE_PADROWS) * 512 * 2;
constexpr size_t MO_CON = MO_XG, MO_END = MO_CON + (size_t)(3 * NTOK + MOE_PADROWS) * 1024 * 2;
constexpr size_t BIG_BYTES = MO_END > L0_END ? (MO_END > L1_END ? MO_END : L1_END) : (L0_END > L1_END ? L0_END : L1_END);
constexpr size_t WS_NEED = WS_BIG + BIG_BYTES;

constexpr int LDS_BYTES = 151552;

__device__ __forceinline__ float bf2f(unsigned short h) { return __uint_as_float(((unsigned)h) << 16); }
typedef __bf16 bf16v2_t __attribute__((ext_vector_type(2)));
__device__ __forceinline__ unsigned pack2(float a, float b) { const bf16v2_t h = __builtin_convertvector((f32x2){a, b}, bf16v2_t); return __builtin_bit_cast(unsigned, h); }
__device__ __forceinline__ unsigned short f2bf(float f) { const __bf16 h = (__bf16)f; return __builtin_bit_cast(unsigned short, h); }
__device__ __forceinline__ float lo2f(unsigned w) { return __uint_as_float(w << 16); }
__device__ __forceinline__ float hi2f(unsigned w) { return __uint_as_float(w & 0xffff0000u); }
__device__ __forceinline__ float wsum(float v) {
#pragma unroll
    for (int o = 32; o; o >>= 1) v += __shfl_xor(v, o);
    return v; }
template <int CTRL> __device__ __forceinline__ float dpp_mov(float x) { return __builtin_bit_cast(float, __builtin_amdgcn_update_dpp(0, __builtin_bit_cast(int, x), CTRL, 0xf, 0xf, true)); }
__device__ __forceinline__ float rsum16(float x) { x += dpp_mov<0xB1>(x); x += dpp_mov<0x4E>(x); x += dpp_mov<0x124>(x); x += dpp_mov<0x128>(x); return x; }
template <int CTRL, int RM> __device__ __forceinline__ float dpp_upd(float old, float x) { return __builtin_bit_cast(float, __builtin_amdgcn_update_dpp(__builtin_bit_cast(int, old), __builtin_bit_cast(int, x), CTRL, RM, 0xf, false)); }
__device__ __forceinline__ float wscan_add(float x) { x += dpp_upd<0x111, 0xf>(0.f, x); x += dpp_upd<0x112, 0xf>(0.f, x); x += dpp_upd<0x114, 0xf>(0.f, x); x += dpp_upd<0x118, 0xf>(0.f, x);
    x += dpp_upd<0x142, 0xa>(0.f, x); x += dpp_upd<0x143, 0xc>(0.f, x); return x; }
__device__ __forceinline__ float wscan_max(float x) { const float ni = -__builtin_inff();
    x = fmaxf(x, dpp_upd<0x111, 0xf>(ni, x)); x = fmaxf(x, dpp_upd<0x112, 0xf>(ni, x)); x = fmaxf(x, dpp_upd<0x114, 0xf>(ni, x)); x = fmaxf(x, dpp_upd<0x118, 0xf>(ni, x));
    x = fmaxf(x, dpp_upd<0x142, 0xa>(ni, x)); x = fmaxf(x, dpp_upd<0x143, 0xc>(ni, x)); return x; }
__device__ __forceinline__ float lane63(float x) { return __builtin_bit_cast(float, __builtin_amdgcn_readlane(__builtin_bit_cast(int, x), 63)); }
__device__ __forceinline__ float xmax_rows(float x) {
    const auto a = __builtin_amdgcn_permlane16_swap(__builtin_bit_cast(unsigned, x), __builtin_bit_cast(unsigned, x), false, false);
    const unsigned a0 = a[0], a1 = a[1]; x = fmaxf(__builtin_bit_cast(float, a0), __builtin_bit_cast(float, a1));
    const auto b = __builtin_amdgcn_permlane32_swap(__builtin_bit_cast(unsigned, x), __builtin_bit_cast(unsigned, x), false, false);
    const unsigned b0 = b[0], b1 = b[1]; return fmaxf(__builtin_bit_cast(float, b0), __builtin_bit_cast(float, b1)); }
__device__ __forceinline__ float frcp_(float x) { return __builtin_amdgcn_rcpf(x); }
__device__ __forceinline__ float sigmoidf_(float x) { return __builtin_amdgcn_rcpf(1.0f + __expf(-x)); }
__device__ __forceinline__ float siluf_(float x) { return x * __builtin_amdgcn_rcpf(1.0f + __expf(-x)); }
__device__ __forceinline__ float softplusf_(float x) { return fmaxf(x, 0.0f) + __logf(1.0f + __expf(-fabsf(x))); }
__device__ __forceinline__ float logsigmoidf_(float x) { return fminf(x, 0.0f) - __logf(1.0f + __expf(-fabsf(x))); }
__device__ __forceinline__ float tanhf_(float x) { return 1.0f - 2.0f * __builtin_amdgcn_rcpf(__expf(2.0f * x) + 1.0f); }
__device__ __forceinline__ f32x4 mma16(bf16x8 a, bf16x8 b, f32x4 c) { return __builtin_amdgcn_mfma_f32_16x16x32_bf16(a, b, c, 0, 0, 0); }
__device__ __forceinline__ bf16x8 ldfrag(const bf16_t* base, int ld, int row0, int k0, int fr, int fq) { return *(const bf16x8*)(base + (row0 + fr) * ld + k0 + fq * 8); }
__device__ __forceinline__ void st4bf(bf16_t* p, f32x4 v) { u32x2 w; w.x = pack2(v[0], v[1]); w.y = pack2(v[2], v[3]); *(u32x2*)p = w; }
__device__ __forceinline__ f32x4 ld4bf(const bf16_t* p) { u32x2 w = *(const u32x2*)p; return (f32x4){lo2f(w.x), hi2f(w.x), lo2f(w.y), hi2f(w.y)}; }

#define PHASE_FN __device__ __forceinline__
__device__ __forceinline__ int otid() { int t = threadIdx.x; asm volatile("" : "+v"(t)); return t; }
__device__ __forceinline__ int obid() { int t = blockIdx.x; asm volatile("" : "+s"(t)); return t; }
template <class T> __device__ __forceinline__ T* as_global(T* p) { return p; }
__device__ __forceinline__ void lds_barrier() { asm volatile("s_waitcnt lgkmcnt(0)" ::: "memory"); __builtin_amdgcn_s_barrier(); asm volatile("" ::: "memory"); }
constexpr float W8_SCALE = 64.0f, W8_INV = 1.0f / 64.0f;
__device__ __forceinline__ unsigned pack4f8(float a, float b, float c, float d) { unsigned r = 0; r = __builtin_amdgcn_cvt_pk_fp8_f32(a, b, r, false); r = __builtin_amdgcn_cvt_pk_fp8_f32(c, d, r, true); return r; }
__device__ __forceinline__ void st4f8(unsigned char* p, f32x4 v) { *(unsigned*)p = pack4f8(v[0], v[1], v[2], v[3]); }
struct KP { const float* in[42]; float* out; unsigned char* ws; int ph_lo, ph_hi; };

#define XB_TMO      128
#define XB_XCNT(j)  (256  + 64 * (j))
#define XB_XSUB(j)  (1280 + 64 * (j))
#define XB_XGEN(j)  (2304 + 64 * (j))
#define XB_TOP      3328
#define XB_TOPGEN   3392
#define XCD_BAR_WORDS 3456
#define XB_SPIN_CAP (1u << 18)
#define LAS __attribute__((address_space(3)))

__device__ __forceinline__ unsigned xb_ld(unsigned* p)              { return __hip_atomic_load(p, __ATOMIC_RELAXED, __HIP_MEMORY_SCOPE_AGENT); }
__device__ __forceinline__ unsigned xb_add(unsigned* p, unsigned v) { return __hip_atomic_fetch_add(p, v, __ATOMIC_RELAXED, __HIP_MEMORY_SCOPE_AGENT); }
__device__ __forceinline__ unsigned xb_xcc_id() { return (unsigned)__builtin_amdgcn_s_getreg((3 << 11) | 20) & 0xFu; }
#define XB_SPIN(cond, bar) do { unsigned _sp = 0; while (cond) { __builtin_amdgcn_s_sleep(1); \
    if ((++_sp & 255u) == 0u) { if (xb_ld(&(bar)[XB_TMO])) break; if (_sp > XB_SPIN_CAP) { atomicAdd(&(bar)[XB_TMO], 1u); break; } } } } while (0)

struct XcdBarrier {
    unsigned* bar; unsigned x;
    volatile LAS unsigned* st;
};

__device__ __forceinline__ XcdBarrier xcd_barrier_post(unsigned* bar, volatile LAS unsigned* st) {
    XcdBarrier b; b.bar = bar; b.x = xb_xcc_id(); b.st = st;
    if (threadIdx.x == 0) (void)xb_add(&bar[XB_XCNT(b.x)], 1u);
    return b;
}
__device__ __forceinline__ void xcd_barrier_complete(unsigned* bar, unsigned x, unsigned& nloc, unsigned& nx) {
    const unsigned G = gridDim.x * gridDim.y * gridDim.z;
    unsigned sum, cnt, mine, sp = 0u;
    for (;;) {
        sum = 0u; cnt = 0u; mine = 0u;
#pragma unroll
        for (unsigned j = 0; j < 16; ++j) { const unsigned c = xb_ld(&bar[XB_XCNT(j)]); sum += c; cnt += (c > 0u) ? 1u : 0u; mine = (j == x) ? c : mine; }
        if (sum == G) break;
        __builtin_amdgcn_s_sleep(1);
        if ((++sp & 255u) == 0u) { if (xb_ld(&bar[XB_TMO])) break; if (sp > XB_SPIN_CAP) { atomicAdd(&bar[XB_TMO], 1u); break; } }
    }
    nloc = mine > 0u ? mine : 1u; nx = cnt > 0u ? cnt : 1u;
}

__device__ __forceinline__ void xcd_barrier(const XcdBarrier& b) {
    asm volatile("s_waitcnt vmcnt(0)" ::: "memory");
    __syncthreads();
    if (threadIdx.x == 0) {
        unsigned* bar = b.bar;
        __builtin_amdgcn_s_waitcnt(0);
        unsigned nloc = b.st[0], nx = b.st[1];
        if (nloc == 0u) { xcd_barrier_complete(bar, b.x, nloc, nx); b.st[0] = nloc; b.st[1] = nx; }
        const unsigned old = xb_add(&bar[XB_XSUB(b.x)], 1u);
        const unsigned gen = old / nloc;
        if (old + 1u == (gen + 1u) * nloc) {
            __builtin_amdgcn_fence(__ATOMIC_RELEASE, "agent");
            asm volatile("s_waitcnt vmcnt(0)" ::: "memory");
            const unsigned og = xb_add(&bar[XB_TOP], 1u);
            const unsigned tg = og / nx;
            if (og + 1u == (tg + 1u) * nx) xb_add(&bar[XB_TOPGEN], 1u);
            else XB_SPIN(xb_ld(&bar[XB_TOPGEN]) == tg, bar);
            __builtin_amdgcn_fence(__ATOMIC_ACQUIRE, "agent");
            xb_add(&bar[XB_XGEN(b.x)], 1u);
            asm volatile("s_waitcnt vmcnt(0)" ::: "memory");
        } else {
            XB_SPIN(xb_ld(&bar[XB_XGEN(b.x)]) == gen, bar);
            __builtin_amdgcn_fence(__ATOMIC_ACQUIRE, "agent");
            asm volatile("s_waitcnt vmcnt(0)" ::: "memory");
        }
    }
    __syncthreads();
}
struct GA {
    const bf16_t* a0; const bf16_t* a1;
    int ld0, ld1, ksplit;
    const int* list;
    int nrows;
    int mode;
    int row0;
};
constexpr int G_LDT = 40;
constexpr int GEMM_LDS = (2 * 256 * G_LDT + 2 * 128 * G_LDT) * 2;

template <class Epi>
__device__ __forceinline__ void gemm_tile(unsigned char* lds, const GA& ga, const bf16_t* __restrict__ Bt, int K, int mt, int nt, const Epi& epi) {
    const int tid = otid(), lane = tid & 63, wid = __builtin_amdgcn_readfirstlane(tid >> 6), wm = wid >> 1, wn = wid & 1, fr = lane & 15, fq = lane >> 4;
    bf16_t* sA = (bf16_t*)lds;
    bf16_t* sB = sA + 2 * 256 * G_LDT;
    const int kp = tid & 3;
    const int r0 = tid >> 2, r1 = r0 + 128;
    int s0, s1;
    {
        int lr = mt * 256 + r0; if (lr >= ga.nrows) lr = 0;
        s0 = ga.list ? ga.list[lr] : (ga.mode == 1 ? (lr >> 11) * TT + CTXL + (lr & 2047) : ga.row0 + lr);
        lr = mt * 256 + r1; if (lr >= ga.nrows) lr = 0;
        s1 = ga.list ? ga.list[lr] : (ga.mode == 1 ? (lr >> 11) * TT + CTXL + (lr & 2047) : ga.row0 + lr);
    }
    const bf16_t* pa00 = ga.a0 + (size_t)s0 * ga.ld0 + kp * 8;
    const bf16_t* pa01 = ga.a0 + (size_t)s1 * ga.ld0 + kp * 8;
    const bf16_t* pa10 = ga.a1 ? ga.a1 + (size_t)s0 * ga.ld1 + kp * 8 : pa00;
    const bf16_t* pa11 = ga.a1 ? ga.a1 + (size_t)s1 * ga.ld1 + kp * 8 : pa01;
    const bf16_t* pb = Bt + (size_t)(nt * 128 + r0) * K + kp * 8;
    const int ksplit = ga.ksplit;
    f32x4 acc[4][4];
#pragma unroll
    for (int i = 0; i < 4; ++i)
#pragma unroll
        for (int j = 0; j < 4; ++j) acc[i][j] = (f32x4){0.f, 0.f, 0.f, 0.f};
    const int nk = K >> 5;
    u32x4 ra0, ra1, rb;
    {
        ra0 = *(const u32x4*)(pa00); ra1 = *(const u32x4*)(pa01); rb = *(const u32x4*)(pb);
        if (0 >= ksplit) { ra0 = *(const u32x4*)(pa10); ra1 = *(const u32x4*)(pa11); }
    }
    *(u32x4*)(sA + (r0) * G_LDT + kp * 8) = ra0;
    *(u32x4*)(sA + (r1) * G_LDT + kp * 8) = ra1;
    *(u32x4*)(sB + (r0) * G_LDT + kp * 8) = rb;
    __syncthreads();
    for (int kt = 0; kt < nk; ++kt) {
        const int cur = kt & 1;
        if (kt + 1 < nk) {
            const int k0 = (kt + 1) << 5;
            if (k0 < ksplit) { ra0 = *(const u32x4*)(pa00 + k0); ra1 = *(const u32x4*)(pa01 + k0); }
            else { ra0 = *(const u32x4*)(pa10 + (k0 - ksplit)); ra1 = *(const u32x4*)(pa11 + (k0 - ksplit)); }
            rb = *(const u32x4*)(pb + k0);
        }
        const bf16_t* cA = sA + cur * 256 * G_LDT;
        const bf16_t* cB = sB + cur * 128 * G_LDT;
        bf16x8 af[4], bfr[4];
#pragma unroll
        for (int i = 0; i < 4; ++i) af[i] = ldfrag(cA, G_LDT, wm * 64 + i * 16, 0, fr, fq);
#pragma unroll
        for (int j = 0; j < 4; ++j) bfr[j] = ldfrag(cB, G_LDT, wn * 64 + j * 16, 0, fr, fq);
#pragma unroll
        for (int i = 0; i < 4; ++i)
#pragma unroll
            for (int j = 0; j < 4; ++j) acc[i][j] = mma16(bfr[j], af[i], acc[i][j]);
        if (kt + 1 < nk) {
            const int nb = cur ^ 1;
            *(u32x4*)(sA + (nb * 256 + r0) * G_LDT + kp * 8) = ra0;
            *(u32x4*)(sA + (nb * 256 + r1) * G_LDT + kp * 8) = ra1;
            *(u32x4*)(sB + (nb * 128 + r0) * G_LDT + kp * 8) = rb;
        }
        __syncthreads();
    }
    epi(acc, mt * 256 + wm * 64, nt * 128 + wn * 64, fr, fq);
}

struct EpiBf {
    bf16_t* out; int ld, nrows, ncols;
    __device__ __forceinline__ void operator()(const f32x4 (&acc)[4][4], int rb, int cb, int fr, int fq) const {
#pragma unroll
        for (int i = 0; i < 4; ++i) { const int lr = rb + i * 16 + fr; if (lr < nrows) {
#pragma unroll
            for (int j = 0; j < 4; ++j) { const int col = cb + j * 16 + fq * 4; if (col < ncols) st4bf(out + (size_t)lr * ld + col, acc[i][j]); } } }
    }
};
struct EpiSwiglu {
    bf16_t* out; int nrows;
    __device__ __forceinline__ void operator()(const f32x4 (&acc)[4][4], int rb, int cb, int fr, int fq) const {
#pragma unroll
        for (int i = 0; i < 4; ++i) { const int lr = rb + i * 16 + fr; if (lr < nrows) {
#pragma unroll
            for (int j = 0; j < 2; ++j) { const int col = (cb >> 1) + j * 16 + fq * 4; f32x4 g = acc[i][j], u = acc[i][j + 2], o;
#pragma unroll
                for (int r = 0; r < 4; ++r) o[r] = siluf_(g[r]) * u[r];
                st4bf(out + (size_t)lr * 512 + col, o); } } }
    }
};

namespace pg8 {
#define PG8_LAS __attribute__((address_space(3)))
typedef unsigned short bf16_t;
typedef short bf16x8 __attribute__((ext_vector_type(8)));
typedef float f32x4 __attribute__((ext_vector_type(4)));
typedef unsigned u32x4 __attribute__((ext_vector_type(4)));
constexpr int BM = 256, BK = 64, HALF = 128, HTB = HALF * BK * 2  , STAGE_BYTES = 8 * HTB, NXCD = 8, WGM = 8;

__host__ __device__ __forceinline__ int lds_byte(int r, int c) { const int st = (r >> 4) * 2 + (c >> 5), rr = r & 15, cc = c & 31, ob = rr * 64 + cc * 2; return st * 1024 + (ob ^ (((ob >> 9) & 1) << 5)); }
__host__ __device__ __forceinline__ void stage_rc(int b, int& R, int& C) { const int st = b / 1024, sb = b % 1024, swz = sb ^ (((sb >> 9) & 1) << 5); R = (st >> 1) * 16 + swz / 64; C = (st & 1) * 32 + (swz % 64) / 2; }
__host__ __device__ __forceinline__ int perm32(int rho) { const int n = rho >> 4, i = rho & 15; return 8 * (i >> 2) + 4 * n + (i & 3); }

struct Unit { int pm, pn; };
struct Gemm { const bf16_t* A; const bf16_t* Bt; int M, N, K; const bf16_t* A2; int pm_split; int lda, amode; };
#define PG8_ABASE(g, pm) ((g).amode == 1 ? (const char*)(g).A + (size_t)(((pm) >> 3) * 2304 + 256 + ((pm) & 7) * 256) * lda_ * 2 : ((pm) < (g).pm_split ? (const char*)(g).A + (size_t)(pm) * tstepA : (const char*)(g).A2 + (size_t)((pm) - (g).pm_split) * tstepA))
struct StaticOrder {
    int nM, nN, nwg, G, c;
    __host__ __device__ void init(int M, int N, int G_, int c_) { nM = M / BM; nN = N / BM; nwg = nM * nN; G = G_; c = c_; }
    __host__ __device__ bool next(int i, Unit& u) const {
        const long L = (long)i * G + c; if (L >= nwg) return false;
        int wgid = (int)L; { const int q = nwg / NXCD, r = nwg % NXCD, xcd = wgid % NXCD, off = wgid / NXCD; wgid = (xcd < r ? xcd * (q + 1) : r * (q + 1) + (xcd - r) * q) + off; }
        const int nig = WGM * nN, gid = wgid / nig, fm = gid * WGM, gsz = (nM - fm) < WGM ? (nM - fm) : WGM;
        u.pm = fm + ((wgid % nig) % gsz); u.pn = (wgid % nig) / gsz; return true;
    }
    __device__ __forceinline__ void a_ready(const Unit&) const {}
    __device__ __forceinline__ void done(const Unit&) const {}
};
__device__ __forceinline__ unsigned cvt_pk_bf16(float lo, float hi) { unsigned r; asm volatile("v_cvt_pk_bf16_f32 %0, %1, %2" : "=v"(r) : "v"(lo), "v"(hi)); return r; }
typedef float f32x2 __attribute__((ext_vector_type(2)));
template <class Epi, class Sched, bool STAMP = false, bool F8 = false>
__device__ __forceinline__ void gemm_phase(PG8_LAS unsigned char* lds, const Gemm g, const Sched& S, const Epi& E, unsigned long long* stamps) {
    const int tid = otid(), wid = __builtin_amdgcn_readfirstlane(tid >> 6), lane = tid & 63, wr = wid >> 2, wc = wid & 3, fr = lane & 15, fq = lane >> 4;
    const int K = g.K, nt = K / BK, lda_ = g.lda ? g.lda : g.K;
    int ts_lo = 0, ts_hi = 0, nts = 0; const unsigned long long rt_entry = STAMP ? (unsigned long long)wall_clock64() : 0ull;
#define PG8_STAMP() do { if (STAMP && wid == 0 && nts < 64) { const unsigned long long _c = (unsigned long long)clock64(); \
        ts_lo = (lane == nts) ? (int)(unsigned)_c : ts_lo; ts_hi = (lane == nts) ? (int)(unsigned)(_c >> 32) : ts_hi; ++nts; } } while (0)
    PG8_STAMP();
    unsigned voffA[2], voffB[2];
#pragma unroll
    for (int i = 0; i < 2; ++i) { int R, C; stage_rc(tid * 16 + i * 8192, R, C); const int Rb = Epi::PERM ? ((R & ~31) + perm32(R & 31)) : R;
        voffA[i] = (unsigned)(R * lda_ + C) * 2u; voffB[i] = (unsigned)(Rb * K + C) * 2u; }
    const size_t kstep = (size_t)(BK * 2);
    const size_t hstep = (size_t)HALF * K * 2;
    const size_t hstepA = (size_t)HALF * lda_ * 2, tstepA = 2 * hstepA;
    const size_t tstep = 2 * hstep;
    const unsigned ldsw = (unsigned)wid * 1024u;
    const int aoff = lds_byte(wr * 64 + fr, fq * 8), boff = lds_byte(wc * 32 + fr, fq * 8);
#define PG8_SA(b, h) (((b) * 2 + (h)) * HTB)
#define PG8_SB(b, h) ((4 + (b) * 2 + (h)) * HTB)
#define PG8_STAGE(bufoff, gbase, voff) do { _Pragma("unroll") for (int _i = 0; _i < 2; ++_i) \
        __builtin_amdgcn_global_load_lds((const unsigned*)((const char*)(gbase) + (voff)[_i]), (PG8_LAS unsigned*)(lds + (bufoff) + ldsw + _i * 8192), 16, 0, 0); } while (0)
#define PG8_LDA(dst, b, h) do { _Pragma("unroll") for (int m = 0; m < 4; ++m) { \
        if constexpr (F8) { dst##8[m].lo = *(const PG8_LAS v4i_*)(lds + PG8_SA(b, h) + aoff + m * 2048); dst##8[m].hi = *(const PG8_LAS v4i_*)(lds + PG8_SA(b, h) + aoff + m * 2048 + 1024); } \
        else { _Pragma("unroll") for (int k = 0; k < 2; ++k) dst[m][k] = *(const PG8_LAS bf16x8*)(lds + PG8_SA(b, h) + aoff + m * 2048 + k * 1024); } } } while (0)
#define PG8_LDB(dst, b, h) do { _Pragma("unroll") for (int n = 0; n < 2; ++n) { \
        if constexpr (F8) { dst##8[n].lo = *(const PG8_LAS v4i_*)(lds + PG8_SB(b, h) + boff + n * 2048); dst##8[n].hi = *(const PG8_LAS v4i_*)(lds + PG8_SB(b, h) + boff + n * 2048 + 1024); } \
        else { _Pragma("unroll") for (int k = 0; k < 2; ++k) dst[n][k] = *(const PG8_LAS bf16x8*)(lds + PG8_SB(b, h) + boff + n * 2048 + k * 1024); } } } while (0)
#define PG8_MMA(ai, bj, At, Bt) do { __builtin_amdgcn_s_setprio(1); _Pragma("unroll") for (int m = 0; m < 4; ++m) _Pragma("unroll") for (int n = 0; n < 2; ++n) { \
        if constexpr (F8) asm volatile("v_mfma_scale_f32_16x16x128_f8f6f4 %0, %1, %2, %0, %3, %3 op_sel_hi:[0,0,0]" : "+v"(acc[ai][bj][m][n]) : "v"(Bt##8[n]), "v"(At##8[m]), "v"(one_scale)); \
        else { _Pragma("unroll") for (int k = 0; k < 2; ++k) acc[ai][bj][m][n] = __builtin_amdgcn_mfma_f32_16x16x32_bf16(Bt[n][k], At[m][k], acc[ai][bj][m][n], 0, 0, 0); } } \
        __builtin_amdgcn_s_setprio(0); } while (0)
#define PG8_WAIT_V(n) asm volatile("s_waitcnt vmcnt(" #n ")" ::: "memory")
#define PG8_WAIT_L(n) asm volatile("s_waitcnt lgkmcnt(" #n ")" ::: "memory")
#define PG8_BAR __builtin_amdgcn_s_barrier()
#define PG8_SCHED __builtin_amdgcn_sched_barrier(0)
    Unit cur, nxt; int ui = 0;
    if (!S.next(0, cur)) return;
    f32x4 acc[2][2][4][2];
#pragma unroll
    for (int a = 0; a < 2; ++a)
#pragma unroll
        for (int b = 0; b < 2; ++b)
#pragma unroll
            for (int m = 0; m < 4; ++m)
#pragma unroll
                for (int n = 0; n < 2; ++n) acc[a][b][m][n] = (f32x4){0.f, 0.f, 0.f, 0.f};
    bf16x8 At[4][2], B0[2][2], B1[2][2];
    typedef int v4i_ __attribute__((ext_vector_type(4))); typedef int v8i_ __attribute__((ext_vector_type(8)));
    v8i_ At8[4], B08[2], B18[2];
    const int one_scale = 0x7f7f7f7f;
    const char* cA = PG8_ABASE(g, cur.pm); const char* cB = (const char*)g.Bt + (size_t)cur.pn * tstep;
    S.a_ready(cur);
    PG8_STAGE(PG8_SB(0, 0), cB, voffB); PG8_STAGE(PG8_SA(0, 0), cA, voffA); PG8_STAGE(PG8_SB(0, 1), cB + hstep, voffB); PG8_STAGE(PG8_SA(0, 1), cA + hstepA, voffA);
    if (wr == 1) PG8_BAR;
    PG8_WAIT_V(4); PG8_BAR;
    PG8_STAGE(PG8_SB(1, 0), cB + kstep, voffB); PG8_STAGE(PG8_SA(1, 0), cA + kstep, voffA); PG8_STAGE(PG8_SB(1, 1), cB + hstep + kstep, voffB);
    PG8_WAIT_V(6); PG8_BAR;
    PG8_STAMP();
    for (;;) {
        const bool has_next = S.next(ui + 1, nxt);
        const char* nA = has_next ? PG8_ABASE(g, nxt.pm) : cA; const char* nB = has_next ? (const char*)g.Bt + (size_t)nxt.pn * tstep : cB;
#pragma unroll 1
        for (int t = 0; t < nt; t += 2) {
            const bool last = (t == nt - 2);
            const char* a1 = cA + (size_t)(t + 1) * kstep;
            const char* a2 = last ? nA : cA + (size_t)(t + 2) * kstep; const char* b2 = last ? nB : cB + (size_t)(t + 2) * kstep;
            const char* a3 = a2 + kstep; const char* b3 = b2 + kstep;
            if (last && has_next) S.a_ready(nxt);
            PG8_LDB(B0, 0, 0); PG8_SCHED; PG8_LDA(At, 0, 0); PG8_STAGE(PG8_SA(1, 1), a1 + hstepA, voffA);
            PG8_WAIT_L(8); PG8_BAR; PG8_WAIT_L(0); PG8_MMA(0, 0, At, B0); PG8_BAR; PG8_SCHED;
            PG8_LDB(B1, 0, 1); PG8_STAGE(PG8_SB(0, 0), b2, voffB);
            PG8_BAR; PG8_WAIT_L(0); PG8_MMA(0, 1, At, B1); PG8_BAR;
            PG8_LDA(At, 0, 1); PG8_STAGE(PG8_SA(0, 0), a2, voffA);
            PG8_BAR; PG8_WAIT_L(0); PG8_MMA(1, 0, At, B0); PG8_BAR; PG8_SCHED;
            PG8_STAGE(PG8_SB(0, 1), b2 + hstep, voffB);
            PG8_WAIT_V(6); PG8_BAR; PG8_MMA(1, 1, At, B1); PG8_BAR;
            PG8_LDB(B0, 1, 0); PG8_SCHED; PG8_LDA(At, 1, 0); PG8_STAGE(PG8_SA(0, 1), a2 + hstepA, voffA);
            PG8_WAIT_L(8); PG8_BAR; PG8_WAIT_L(0); PG8_MMA(0, 0, At, B0); PG8_BAR; PG8_SCHED;
            PG8_LDB(B1, 1, 1); PG8_STAGE(PG8_SB(1, 0), b3, voffB);
            PG8_BAR; PG8_WAIT_L(0); PG8_MMA(0, 1, At, B1); PG8_BAR;
            PG8_LDA(At, 1, 1); PG8_STAGE(PG8_SA(1, 0), a3, voffA);
            PG8_BAR; PG8_WAIT_L(0); PG8_MMA(1, 0, At, B0); PG8_BAR; PG8_SCHED;
            PG8_STAGE(PG8_SB(1, 1), b3 + hstep, voffB);
            PG8_WAIT_V(6); PG8_BAR; PG8_MMA(1, 1, At, B1); PG8_BAR;
        }
        PG8_STAMP();
        if constexpr (F8) asm volatile("s_nop 15\n\ts_nop 15" ::: "memory");
        if constexpr (!Epi::AFTER_DRAIN) { E(acc, cur, wr, wc, fr, fq); S.done(cur); }
        PG8_STAMP();
        if (!has_next) break;
#pragma unroll
        for (int a = 0; a < 2; ++a)
#pragma unroll
            for (int b = 0; b < 2; ++b)
#pragma unroll
                for (int m = 0; m < 4; ++m)
#pragma unroll
                    for (int n = 0; n < 2; ++n) acc[a][b][m][n] = (f32x4){0.f, 0.f, 0.f, 0.f};
        cur = nxt; cA = nA; cB = nB; ++ui;
    }
    PG8_WAIT_V(0);
    if (wr == 0) PG8_BAR;
    PG8_BAR;
    if constexpr (Epi::AFTER_DRAIN) { E.fused(acc, cur, wr, wc, fr, fq, lds, wid, lane); S.done(cur); }
    PG8_STAMP();
    if (STAMP && wid == 0) { stamps[lane] = lane < nts ? (((unsigned long long)(unsigned)ts_hi << 32) | (unsigned)ts_lo) : 0ull;
        if (lane == 62) stamps[62] = rt_entry; if (lane == 63) stamps[63] = (unsigned long long)wall_clock64(); }
#undef PG8_STAMP
#undef PG8_SA
#undef PG8_SB
#undef PG8_STAGE
#undef PG8_LDA
#undef PG8_LDB
#undef PG8_MMA
#undef PG8_WAIT_V
#undef PG8_WAIT_L
#undef PG8_BAR
#undef PG8_SCHED
}
}
namespace pg8 {
struct EpiBfG {
    static constexpr bool PERM = true, AFTER_DRAIN = false;
    bf16_t* O; int ldc, ncols, pn_mask; float oscale;
    __device__ __forceinline__ void operator()(const f32x4 (&acc)[2][2][4][2], const Unit& u, int wr, int wc, int fr, int fq) const {
        const int row0 = u.pm * BM + wr * 64 + fr, col0 = (u.pn & pn_mask) * BM + wc * 32 + 8 * fq;
#pragma unroll
        for (int ai = 0; ai < 2; ++ai)
#pragma unroll
            for (int m = 0; m < 4; ++m) { bf16_t* rowp = O + (size_t)(row0 + ai * HALF + m * 16) * ldc;
#pragma unroll
                for (int bj = 0; bj < 2; ++bj) { const int c = col0 + bj * HALF;
                    if (c < ncols) { const f32x4 v0 = acc[ai][bj][m][0] * oscale, v1 = acc[ai][bj][m][1] * oscale;
                        u32x4 w; w.x = cvt_pk_bf16(v0[0], v0[1]); w.y = cvt_pk_bf16(v0[2], v0[3]); w.z = cvt_pk_bf16(v1[0], v1[1]); w.w = cvt_pk_bf16(v1[2], v1[3]);
                        *(u32x4*)(rowp + c) = w; } } }
    }
};
struct EpiSwi {
    static constexpr bool PERM = true, AFTER_DRAIN = false;
    bf16_t* H;
    __device__ __forceinline__ void operator()(const f32x4 (&acc)[2][2][4][2], const Unit& u, int wr, int wc, int fr, int fq) const {
        const int row0 = u.pm * BM + wr * 64 + fr, hc0 = (u.pn & 3) * HALF + wc * 32 + 8 * fq;
#pragma unroll
        for (int ai = 0; ai < 2; ++ai)
#pragma unroll
            for (int m = 0; m < 4; ++m) { unsigned char* rowp = (unsigned char*)H + (size_t)(row0 + ai * HALF + m * 16) * 1024 + hc0;
                float o[8];
#pragma unroll
                for (int n = 0; n < 2; ++n)
#pragma unroll
                    for (int r = 0; r < 4; ++r) { const float g = acc[ai][0][m][n][r] * W8_INV; o[n * 4 + r] = g * __builtin_amdgcn_rcpf(1.0f + __expf(-g)) * (acc[ai][1][m][n][r] * W8_INV); }
                u32x2 w; w.x = pack4f8(o[0], o[1], o[2], o[3]); w.y = pack4f8(o[4], o[5], o[6], o[7]);
                *(u32x2*)rowp = w; }
    }
};
struct MoeOrder {
    const int* slotmap; int ntiles, G, c;
    __device__ __forceinline__ bool next(int i, Unit& u) const {
        const int L = i * G + c; if (L >= ntiles * 4) return false;
        u.pm = L >> 2; u.pn = __builtin_amdgcn_readfirstlane(slotmap[L >> 2]) * 4 + (L & 3); return true;
    }
    __device__ __forceinline__ void a_ready(const Unit&) const {}
    __device__ __forceinline__ void done(const Unit&) const {}
};
}
#define WSP(T, off) as_global((T*)(kp.ws + (off)))
#define KIN(i) as_global(kp.in[i])
#define KOUT as_global(kp.out)

PHASE_FN void phase_mod(const KP& kp, unsigned char* lds) {
    float* sc = (float*)lds;
    float* red = sc + 17 * 1024;
    float* modv = WSP(float, WS_MODV);
    const int tid = otid();
    for (int i = tid; i < 17 * 1024; i += 512) { const int bb = i >> 10, k = i & 1023; const float c = bb < 16 ? KIN(1)[bb * 1024 + k] : KIN(3)[k]; sc[i] = siluf_(c); }
    __syncthreads();
    const int jc = tid & 63, ks = tid >> 6;
    for (int u = obid(); u < 192; u += gridDim.x) {
        const int l = u / 96, j0 = (u % 96) * 64;
        const float* w = KIN(4) + (size_t)l * 1024 * 6144 + j0 + jc;
        float acc[17];
#pragma unroll
        for (int bb = 0; bb < 17; ++bb) acc[bb] = 0.f;
        for (int k = ks * 128; k < ks * 128 + 128; ++k) {
            const float wv = w[(size_t)k * 6144];
#pragma unroll
            for (int bb = 0; bb < 17; ++bb) acc[bb] += sc[bb * 1024 + k] * wv;
        }
#pragma unroll
        for (int bb = 0; bb < 17; ++bb) red[(ks * 17 + bb) * 64 + jc] = acc[bb];
        __syncthreads();
        for (int i = tid; i < 17 * 64; i += 512) {
            const int bb = i >> 6, j = i & 63; float s = KIN(5)[l * 6144 + j0 + j];
#pragma unroll
            for (int k2 = 0; k2 < 8; ++k2) s += red[(k2 * 17 + bb) * 64 + j];
            modv[((size_t)l * 17 + bb) * 6144 + j0 + j] = s;
        }
        __syncthreads();
    }
}

struct CvJob { const float* src; bf16_t* dst; int N, ldd, mode, kt, ntile, f8; };
__device__ __forceinline__ bool cv_pick(int& u, CvJob& J, const float* src, int K, int N, bf16_t* dst, int mode = 0, int ldd = -1, int f8 = 0) {
    const int ntl = (N + 63) >> 6, cnt = ntl * (K >> 6);
    if (u < cnt) { J.src = src; J.dst = dst; J.N = N; J.ldd = ldd < 0 ? K : ldd; J.mode = mode; J.kt = u / ntl; J.ntile = u % ntl; J.f8 = f8; return true; }
    u -= cnt; return false;
}
__device__ __forceinline__ void cv_load(const CvJob& J, int tid, f32x4 (&r)[2]) {
#pragma unroll
    for (int i = 0; i < 2; ++i) { const int idx = tid + i * 512, k = idx >> 4, n0 = J.ntile * 64 + (idx & 15) * 4;
        r[i] = (n0 < J.N) ? *(const f32x4*)(J.src + (size_t)(J.kt * 64 + k) * J.N + n0) : (f32x4){0.f, 0.f, 0.f, 0.f}; }
}
__device__ __forceinline__ void cv_put(float* tile, int tid, const f32x4 (&r)[2]) {
#pragma unroll
    for (int i = 0; i < 2; ++i) { const int idx = tid + i * 512, k = idx >> 4, nq = (idx & 15) * 4;
        tile[k * 65 + nq] = r[i][0]; tile[k * 65 + nq + 1] = r[i][1]; tile[k * 65 + nq + 2] = r[i][2]; tile[k * 65 + nq + 3] = r[i][3]; }
}
__device__ __forceinline__ void cv_store(const float* tile, const CvJob& J, int tid) {
    const int nl = tid >> 3, k8 = tid & 7, n = J.ntile * 64 + nl;
    if (n < J.N) { int row = n; if (J.mode) row = (n >> 7) * 256 + (n & 127) + (J.mode == 2 ? 128 : 0);
        const float* tp = tile + (k8 * 8) * 65 + nl;
        if (J.f8) { u32x2 w; w.x = pack4f8(tp[0] * W8_SCALE, tp[65] * W8_SCALE, tp[130] * W8_SCALE, tp[195] * W8_SCALE); w.y = pack4f8(tp[260] * W8_SCALE, tp[325] * W8_SCALE, tp[390] * W8_SCALE, tp[455] * W8_SCALE);
            *(u32x2*)((unsigned char*)J.dst + (size_t)row * J.ldd + J.kt * 64 + k8 * 8) = w; }
        else { u32x4 w; w.x = pack2(tp[0], tp[65]); w.y = pack2(tp[130], tp[195]); w.z = pack2(tp[260], tp[325]); w.w = pack2(tp[390], tp[455]);
            *(u32x4*)(J.dst + (size_t)row * J.ldd + J.kt * 64 + k8 * 8) = w; } }
}
#define CV_RUN(total, PICK) CV_RUN_ON(total, PICK, obid(), (int)gridDim.x)
#define CV_SUB(total, PICK, Jx, rx, ux, tilex) { if (ux >= (total)) break; cv_put(tilex, tid, rx); lds_barrier(); const CvJob Jt_ = Jx; ux += 3 * G_; \
            if (ux < (total)) { int u = ux; PICK(u, Jx); cv_load(Jx, tid, rx); } cv_store(tilex, Jt_, tid); }
#define CV_RUN_ON(total, PICK, bid_, nb_) do { float* tile = (float*)lds; const int tid = otid(); const int G_ = (nb_); CvJob Ja, Jb, Jc; f32x4 ra[2], rb[2], rc[2]; \
        int ua_ = (bid_), ub_ = ua_ + G_, uc_ = ub_ + G_; \
        if (ua_ < (total)) { int u = ua_; PICK(u, Ja); cv_load(Ja, tid, ra); } \
        if (ub_ < (total)) { int u = ub_; PICK(u, Jb); cv_load(Jb, tid, rb); } \
        if (uc_ < (total)) { int u = uc_; PICK(u, Jc); cv_load(Jc, tid, rc); } \
        for (;;) { CV_SUB(total, PICK, Ja, ra, ua_, tile) CV_SUB(total, PICK, Jb, rb, ub_, tile + 64 * 65) CV_SUB(total, PICK, Jc, rc, uc_, tile + 2 * 64 * 65) } \
        lds_barrier(); } while (0)
PHASE_FN void phase_conv_ab(const KP& kp, unsigned char* lds) {
#define PICK_AB(u, J) do { if (!cv_pick(u, J, KIN(7), 1024, AB_N, WSP(bf16_t, WS_WMIX + WM_AB_IN))) cv_pick(u, J, KIN(8), 2048, 1024, WSP(bf16_t, WS_WMIX + WM_AB_OUT)); } while (0)
    CV_RUN(16 * 85 + 32 * 16, PICK_AB);
#undef PICK_AB
}
PHASE_FN void phase_conv_cd(const KP& kp, unsigned char* lds) {
#define PICK_CD(u, J) do { if (cv_pick(u, J, KIN(18), 1024, CD_N, WSP(bf16_t, WS_WMIX + WM_CD_IN), 0, 1024, 1)) break;     \
        if (cv_pick(u, J, KIN(19), 1536, 1024, WSP(bf16_t, WS_WMIX + WM_CD_OUT))) break; \
        if (cv_pick(u, J, KIN(21), 384, 768, WSP(bf16_t, WS_WMIX + WM_UQ))) break; \
        if (cv_pick(u, J, KIN(23), 256, 1024, WSP(bf16_t, WS_WMIX + WM_UKV))) break; \
        cv_pick(u, J, KIN(29), 128, 1024, WSP(bf16_t, WS_WMIX + WM_G2)); } while (0)
    CV_RUN(16 * 65 + 24 * 16 + 6 * 12 + 4 * 16 + 2 * 16, PICK_CD);
#undef PICK_CD
}
PHASE_FN void phase_conv_moe(const KP& kp, unsigned char* lds, int l, int bid, int nb) {
#define PICK_MOE(u0, J) do { const int es = (u0) / 384; int uu = (u0) % 384; \
        const float* wg = es < 16 ? KIN(36) + ((size_t)l * 16 + es) * 1024 * 512 : KIN(39) + (size_t)l * 1024 * 512; \
        const float* wu = es < 16 ? KIN(37) + ((size_t)l * 16 + es) * 1024 * 512 : KIN(40) + (size_t)l * 1024 * 512; \
        const float* wd = es < 16 ? KIN(38) + ((size_t)l * 16 + es) * 512 * 1024 : KIN(41) + (size_t)l * 512 * 1024; \
        bf16_t* dup = (bf16_t*)(WSP(unsigned char, WS_BIG + MO_WUP) + (size_t)es * 1024 * 1024); bf16_t* ddn = (bf16_t*)(WSP(unsigned char, WS_BIG + MO_WDN) + (size_t)es * 1024 * 512); \
        if (cv_pick(uu, J, wg, 1024, 512, dup, 1, 1024, 1)) break; if (cv_pick(uu, J, wu, 1024, 512, dup, 2, 1024, 1)) break; cv_pick(uu, J, wd, 512, 1024, ddn, 0, 512, 1); } while (0)
    CV_RUN_ON(17 * 384, PICK_MOE, bid, nb);
#undef PICK_MOE
}

__device__ __forceinline__ const float* hrow_rd(const KP& kp, bool from_inputs, int b, int t) {
    if (t < CTXL) return (from_inputs ? KIN(2) : WSP(const float, WS_HC)) + ((size_t)b * CTXL + t) * D;
    return (from_inputs ? KIN(0) : KOUT) + ((size_t)b * SEQ + (t - CTXL)) * D;
}
__device__ __forceinline__ float* hrow_wr(const KP& kp, int b, int t) {
    if (t < CTXL) return WSP(float, WS_HC) + ((size_t)b * CTXL + t) * D;
    return KOUT + ((size_t)b * SEQ + (t - CTXL)) * D;
}

PHASE_FN void phase_u(const KP& kp, int layer, int g, int bid, int nb, bool to_v) {
    const int lane = otid() & 63, wid = __builtin_amdgcn_readfirstlane(otid() >> 6);
    const float* modv = WSP(const float, WS_MODV) + (size_t)layer * 17 * 6144;
    const float* ng = KIN(6) + (size_t)layer * 4 * 1024;
    bf16_t* U = to_v ? WSP(bf16_t, WS_V) + (size_t)RG * 1024 : WSP(bf16_t, WS_BIG + (layer == 0 ? L0_U : L1_U));
    for (int lr = bid * 8 + wid; lr < RG; lr += nb * 8) {
        const int bl = lr / TT, t = lr - bl * TT, b = g * BG + bl;
        const float* src = hrow_rd(kp, layer == 0, b, t);
        const float* mv = modv + (size_t)(t < CTXL ? 16 : b) * 6144;
        f32x4 x[4]; float ss = 0.f;
#pragma unroll
        for (int i = 0; i < 4; ++i) { x[i] = *(const f32x4*)(src + i * 256 + lane * 4); ss += x[i][0] * x[i][0] + x[i][1] * x[i][1] + x[i][2] * x[i][2] + x[i][3] * x[i][3]; }
        ss = wsum(ss); const float rstd = rsqrtf(ss * (1.0f / 1024.0f) + EPS);
#pragma unroll
        for (int i = 0; i < 4; ++i) { const int col = i * 256 + lane * 4;
            const f32x4 gv = *(const f32x4*)(ng + col), sc = *(const f32x4*)(mv + 1024 + col), sh = *(const f32x4*)(mv + col);
            st4bf(U + (size_t)lr * 1024 + col, x[i] * rstd * gv * (sc + 1.0f) + sh); }
    }
}

PHASE_FN void phase_r(const KP& kp, unsigned char* lds, int layer, int g) {
    const int tid = otid(), lane = tid & 63, wid = __builtin_amdgcn_readfirstlane(tid >> 6);
    float* rw = (float*)lds;
    int* se = (int*)(rw + 1024 * 16);
    int* sbase = se + 160;
    for (int i = tid; i < 1024 * 16; i += 512) rw[i] = KIN(34)[i];
    __syncthreads();
    const float* modv = WSP(const float, WS_MODV) + (size_t)layer * 17 * 6144;
    const float* ng = KIN(6) + (size_t)layer * 4 * 1024;
    const bf16_t* MIX = WSP(const bf16_t, WS_BIG + (layer == 0 ? L0_U : L1_U));
    bf16_t* V = WSP(bf16_t, WS_V);
    unsigned* cnt = WSP(unsigned, CTL_CNT) + layer * 16;
    int* TOKE = WSP(int, WS_TOKE); int* TOKP = WSP(int, WS_TOKP); float* TOKW = WSP(float, WS_TOKW); int* LIST = WSP(int, WS_LIST);
    const int nrows = layer == 0 ? RG : RGL, CH = layer == 0 ? 72 : 64, RW = CH >> 3, nchunks = nrows / CH;
    float rbias[16];
#pragma unroll
    for (int e = 0; e < 16; ++e) rbias[e] = KIN(35)[e];
    for (int ch = obid(); ch < nchunks; ch += gridDim.x) {
        for (int rr = 0; rr < RW; ++rr) {
            const int rl = wid * RW + rr, lr = ch * CH + rl;
            int b, t, tok;
            if (layer == 0) { const int bl = lr / TT; t = lr - bl * TT; b = g * BG + bl; tok = g * RG + lr; }
            else { const int bl = lr >> 11; t = CTXL + (lr & 2047); b = g * BG + bl; tok = g * RGL + lr; }
            const float* hsrc = hrow_rd(kp, layer == 0, b, t);
            float* hdst = hrow_wr(kp, b, t);
            const float* mv = modv + (size_t)(t < CTXL ? 16 : b) * 6144;
            f32x4 y[4], h[4]; float ss = 0.f;
#pragma unroll
            for (int i = 0; i < 4; ++i) { y[i] = ld4bf(MIX + (size_t)lr * 1024 + i * 256 + lane * 4); ss += y[i][0] * y[i][0] + y[i][1] * y[i][1] + y[i][2] * y[i][2] + y[i][3] * y[i][3]; }
            ss = wsum(ss); float rstd = rsqrtf(ss * (1.0f / 1024.0f) + EPS);
            float s2 = 0.f;
#pragma unroll
            for (int i = 0; i < 4; ++i) { const int col = i * 256 + lane * 4;
                const f32x4 g1 = *(const f32x4*)(ng + 1024 + col), ga = *(const f32x4*)(mv + 2048 + col), hx = *(const f32x4*)(hsrc + col);
                h[i] = hx + ga * (y[i] * rstd * g1);
                *(f32x4*)(hdst + col) = h[i];
                s2 += h[i][0] * h[i][0] + h[i][1] * h[i][1] + h[i][2] * h[i][2] + h[i][3] * h[i][3]; }
            s2 = wsum(s2); rstd = rsqrtf(s2 * (1.0f / 1024.0f) + EPS);
            float lg[16];
#pragma unroll
            for (int e = 0; e < 16; ++e) lg[e] = 0.f;
#pragma unroll
            for (int i = 0; i < 4; ++i) { const int col = i * 256 + lane * 4;
                const f32x4 g2 = *(const f32x4*)(ng + 2048 + col), scf = *(const f32x4*)(mv + 4096 + col), shf = *(const f32x4*)(mv + 3072 + col);
                const f32x4 v = h[i] * rstd * g2 * (scf + 1.0f) + shf;
                st4f8((unsigned char*)V + (size_t)tok * 2048 + col, v);
#pragma unroll
                for (int j = 0; j < 4; ++j) {
#pragma unroll
                    for (int q = 0; q < 4; ++q) { const f32x4 w4 = *(const f32x4*)(rw + (col + j) * 16 + q * 4);
                        lg[q * 4 + 0] += v[j] * w4[0]; lg[q * 4 + 1] += v[j] * w4[1]; lg[q * 4 + 2] += v[j] * w4[2]; lg[q * 4 + 3] += v[j] * w4[3]; } } }
#pragma unroll
            for (int e = 0; e < 16; ++e) lg[e] = wsum(lg[e]);
            float aff[16], sel[16];
#pragma unroll
            for (int e = 0; e < 16; ++e) { aff[e] = sigmoidf_(lg[e]); sel[e] = aff[e] + rbias[e]; }
            float gs[4];
#pragma unroll
            for (int gi = 0; gi < 4; ++gi) { const float a0 = sel[gi * 4], a1 = sel[gi * 4 + 1], a2 = sel[gi * 4 + 2], a3 = sel[gi * 4 + 3];
                gs[gi] = fmaxf(fmaxf(fmaxf(a0 + a1, a0 + a2), fmaxf(a0 + a3, a1 + a2)), fmaxf(a1 + a3, a2 + a3)); }
            int gidx = 0; float gb = gs[0];
#pragma unroll
            for (int gi = 1; gi < 4; ++gi) if (gs[gi] > gb) { gb = gs[gi]; gidx = gi; }
            float c[4], f[4];
#pragma unroll
            for (int i = 0; i < 4; ++i) { c[i] = gidx == 0 ? sel[i] : gidx == 1 ? sel[4 + i] : gidx == 2 ? sel[8 + i] : sel[12 + i];
                                           f[i] = gidx == 0 ? aff[i] : gidx == 1 ? aff[4 + i] : gidx == 2 ? aff[8 + i] : aff[12 + i]; }
            int i1 = 0; float cb = c[0];
#pragma unroll
            for (int i = 1; i < 4; ++i) if (c[i] > cb) { cb = c[i]; i1 = i; }
            int i2 = -1; float cb2 = 0.f;
#pragma unroll
            for (int i = 0; i < 4; ++i) if (i != i1 && (i2 < 0 || c[i] > cb2)) { cb2 = c[i]; i2 = i; }
            float w1 = i1 == 0 ? f[0] : i1 == 1 ? f[1] : i1 == 2 ? f[2] : f[3];
            float w2 = i2 == 0 ? f[0] : i2 == 1 ? f[1] : i2 == 2 ? f[2] : f[3];
            const float wsn = 1.0f / (w1 + w2); w1 *= wsn; w2 *= wsn;
            if (lane == 0) { se[rl * 2] = gidx * 4 + i1; se[rl * 2 + 1] = gidx * 4 + i2;
                TOKE[tok * 2] = gidx * 4 + i1; TOKE[tok * 2 + 1] = gidx * 4 + i2; TOKW[tok * 2] = w1; TOKW[tok * 2 + 1] = w2; }
        }
        __syncthreads();
        if (tid < 16) { int c2 = 0; for (int i = 0; i < 2 * CH; ++i) c2 += (se[i] == tid) ? 1 : 0; sbase[tid] = (int)atomicAdd(&cnt[tid], (unsigned)c2); }
        __syncthreads();
        if (tid < 2 * CH) { const int e = se[tid]; int rank = 0; for (int j = 0; j < tid; ++j) rank += (se[j] == e) ? 1 : 0;
            const int pos = sbase[e] + rank; const int lr = ch * CH + (tid >> 1); const int tok = (layer == 0 ? g * RG : g * RGL) + lr;
            LIST[(size_t)e * NTOK + pos] = tok; TOKP[tok * 2 + (tid & 1)] = pos; }
        __syncthreads();
    }
}

__device__ __forceinline__ int moe_tile_prefix(const unsigned* cnt, int ntok, int lane) {
    const int myt = lane < 16 ? (int)((cnt[lane & 15] + 255u) >> 8) : 0; int pref = myt;
#pragma unroll
    for (int o = 1; o < 16; o <<= 1) { const int t = __shfl_up(pref, o); if (lane >= o) pref += t; }
    return pref - myt + ntok / 256;
}
PHASE_FN void phase_moe_gather(const KP& kp, int layer) {
    const int lane = otid() & 63, wid = __builtin_amdgcn_readfirstlane(otid() >> 6);
    const int ntok = layer == 0 ? NTOK : NLAT;
    const int tpre = moe_tile_prefix(WSP(const unsigned, CTL_CNT) + layer * 16, ntok, lane);
    const bf16_t* V = WSP(const bf16_t, WS_V); bf16_t* XG = WSP(bf16_t, WS_BIG + MO_XG);
    const int* TOKE = WSP(const int, WS_TOKE); const int* TOKP = WSP(const int, WS_TOKP);
    for (int it = obid() * 8 + wid; it < 2 * ntok; it += gridDim.x * 8) {
        const int tok = it >> 1, e = TOKE[it], pos = TOKP[it];
        const size_t row = (size_t)(__shfl(tpre, e) - ntok / 256) * 256 + pos;
        const u32x4* src = (const u32x4*)(V + (size_t)tok * 1024) + lane; u32x4* dst = (u32x4*)(XG + row * 1024) + lane;
        dst[0] = src[0];
    }
}
PHASE_FN void phase_moe_gemm(const KP& kp, unsigned char* lds, int layer, bool down) {
    const int tid = otid();
    int* pre = (int*)(lds + pg8::STAGE_BYTES);
    int* slotmap = pre + 32;
    const int ntok = layer == 0 ? NTOK : NLAT;
    const unsigned* cnt = WSP(const unsigned, CTL_CNT) + layer * 16;
    if (tid == 0) { int p = ntok / 256; pre[0] = 0; pre[1] = p; for (int e = 0; e < 16; ++e) { p += ((int)cnt[e] + 255) >> 8; pre[2 + e] = p; } }
    __syncthreads();
    const int ntiles = pre[17];
    for (int t = tid; t < ntiles; t += 512) { int idx = 0; for (int e = 1; e < 17; ++e) if (pre[e] <= t) idx = e; slotmap[t] = idx == 0 ? 16 : idx - 1; }
    __syncthreads();
    pg8::MoeOrder S{slotmap, ntiles, (int)gridDim.x, obid()};
    if (!down) {
        pg8::Gemm g{WSP(const bf16_t, WS_V), WSP(const bf16_t, WS_BIG + MO_WUP), 0, 0, 512, WSP(const bf16_t, WS_BIG + MO_XG), ntok / 256, 1024, 0};
        pg8::EpiSwi E{WSP(bf16_t, WS_BIG + MO_HID)};
        pg8::gemm_phase<pg8::EpiSwi, pg8::MoeOrder, false, true>((PG8_LAS unsigned char*)lds, g, S, E, nullptr);
    } else {
        pg8::Gemm g{WSP(const bf16_t, WS_BIG + MO_HID), WSP(const bf16_t, WS_BIG + MO_WDN), 0, 0, 256, nullptr, 0x7fffffff, 512, 0};
        pg8::EpiBfG E{WSP(bf16_t, WS_BIG + MO_CON), 1024, 1024, 3, W8_INV};
        pg8::gemm_phase<pg8::EpiBfG, pg8::MoeOrder, false, true>((PG8_LAS unsigned char*)lds, g, S, E, nullptr);
    }
    __syncthreads();
}

PHASE_FN void phase_combine(const KP& kp, int layer) {
    const int lane = otid() & 63, wid = __builtin_amdgcn_readfirstlane(otid() >> 6);
    const int ntok = layer == 0 ? NTOK : NLAT;
    const unsigned* cnt = WSP(const unsigned, CTL_CNT) + layer * 16;
    const float* modv = WSP(const float, WS_MODV) + (size_t)layer * 17 * 6144;
    const float* ng = KIN(6) + (size_t)layer * 4 * 1024 + 3 * 1024;
    const bf16_t* CON = WSP(const bf16_t, WS_BIG + MO_CON);
    const int* TOKE = WSP(const int, WS_TOKE); const int* TOKP = WSP(const int, WS_TOKP); const float* TOKW = WSP(const float, WS_TOKW);
    const int tpre = moe_tile_prefix(cnt, ntok, lane);
    for (int tok0 = (obid() * 8 + wid) * 2; tok0 < ntok; tok0 += gridDim.x * 16) {
        int e1[2], e2[2], p1[2], p2[2]; float w1[2], w2[2];
#pragma unroll
        for (int u = 0; u < 2; ++u) { const int tok = tok0 + u; e1[u] = TOKE[tok * 2]; e2[u] = TOKE[tok * 2 + 1]; p1[u] = TOKP[tok * 2]; p2[u] = TOKP[tok * 2 + 1]; w1[u] = TOKW[tok * 2]; w2[u] = TOKW[tok * 2 + 1]; }
        f32x4 f[2][4], hx[2][4]; float* hp[2]; const float* mv[2];
#pragma unroll
        for (int u = 0; u < 2; ++u) { const int tok = tok0 + u;
            const size_t r1 = (size_t)__shfl(tpre, e1[u]) * 256 + p1[u], r2 = (size_t)__shfl(tpre, e2[u]) * 256 + p2[u];
            int b, t;
            if (layer == 0) { b = tok / TT; t = tok - b * TT; } else { b = tok >> 11; t = CTXL + (tok & 2047); }
            hp[u] = hrow_wr(kp, b, t); mv[u] = modv + (size_t)(t < CTXL ? 16 : b) * 6144 + 5 * 1024;
#pragma unroll
            for (int i = 0; i < 4; ++i) { const int col = i * 256 + lane * 4;
                f[u][i] = ld4bf(CON + (size_t)tok * 1024 + col) + ld4bf(CON + r1 * 1024 + col) * w1[u] + ld4bf(CON + r2 * 1024 + col) * w2[u];
                hx[u][i] = *(const f32x4*)(hp[u] + col); } }
#pragma unroll
        for (int u = 0; u < 2; ++u) { float ss = 0.f;
#pragma unroll
            for (int i = 0; i < 4; ++i) ss += f[u][i][0] * f[u][i][0] + f[u][i][1] * f[u][i][1] + f[u][i][2] * f[u][i][2] + f[u][i][3] * f[u][i][3];
            ss = wsum(ss); const float rstd = rsqrtf(ss * (1.0f / 1024.0f) + EPS);
            float s2 = 0.f;
#pragma unroll
            for (int i = 0; i < 4; ++i) { const int col = i * 256 + lane * 4;
                const f32x4 g3 = *(const f32x4*)(ng + col), gf = *(const f32x4*)(mv[u] + col);
                const f32x4 hn = hx[u][i] + gf * (f[u][i] * rstd * g3);
                *(f32x4*)(hp[u] + col) = hn; hx[u][i] = hn;
                s2 += hn[0] * hn[0] + hn[1] * hn[1] + hn[2] * hn[2] + hn[3] * hn[3]; }
            if (layer == 0) {
                s2 = wsum(s2); const float rs2 = rsqrtf(s2 * (1.0f / 1024.0f) + EPS);
                const float* mv1 = mv[u] - 5 * 1024 + 17 * 6144;
                const float* ng1 = KIN(6) + 4 * 1024;
                unsigned char* U1 = WSP(unsigned char, WS_V) + (size_t)(tok0 + u) * 2048;
#pragma unroll
                for (int i = 0; i < 4; ++i) { const int col = i * 256 + lane * 4;
                    const f32x4 gv = *(const f32x4*)(ng1 + col), sc = *(const f32x4*)(mv1 + 1024 + col), sh = *(const f32x4*)(mv1 + col);
                    st4f8(U1 + col, hx[u][i] * rs2 * gv * (sc + 1.0f) + sh); } } }
    }
}

template <int CH>
__device__ __forceinline__ int scan_t(int dir, int ci, int j) {
    constexpr int NC_CTX = CTXL / CH;
    if (!dir) return ci * CH + j;
    return ci < NC_CTX ? (CTXL - 1 - ci * CH - j) : (TT - 1 - (ci - NC_CTX) * CH - j);
}

constexpr int ML_LQ = 136, ML_LT = 72, ML_VR = 144;
PHASE_FN void mlstm_unit(const KP& kp, unsigned char* lds, int bl, int h, int dir, int vh) {
    const int tid = otid();
    bf16_t* Qs = (bf16_t*)lds;
    bf16_t* Ks = Qs + 64 * ML_LQ;
    bf16_t* KTE = Ks + 64 * ML_LQ;
    bf16_t* VT = KTE + 128 * ML_LT;
    bf16_t* Ps = VT + ML_VR * ML_LT;
    bf16_t* Cb = Ps + 64 * ML_LT;
    float* fs = (float*)(Cb + ML_VR * ML_LQ);
    float* s_rowv = fs;
    float* s_colv = fs + 64;
    float* s_wint = fs + 128;
    float* s_emj = fs + 192;
    float* s_E = fs + 256;
    float* s_den = fs + 320;
    float* s_misc = fs + 384;
    const bf16_t* P = WSP(const bf16_t, WS_BIG + L0_P);
    bf16_t* HOUT = WSP(bf16_t, WS_BIG + (dir ? L0_HB : L0_AO)); const int ldh = dir ? 1024 : 2048;
    const float ibias = KIN(9)[dir * 4 + h], fbias = KIN(10)[dir * 4 + h];
    for (int i = tid; i < ML_VR * ML_LQ; i += 512) Cb[i] = 0;
    for (int i = tid; i < 16 * ML_LT; i += 512) VT[128 * ML_LT + i] = (i < ML_LT) ? (bf16_t)0x3f80 : (bf16_t)0;
    f32x4 Cacc[8], Nacc;
#pragma unroll
    for (int i = 0; i < 8; ++i) Cacc[i] = (f32x4){0.f, 0.f, 0.f, 0.f};
    Nacc = (f32x4){0.f, 0.f, 0.f, 0.f};
    float m_state = 0.f;
    u32x4 pq[2], pk[2], pv[2]; bf16_t pgi = 0, pgf = 0;
#define ML_REQ(ci_) do { _Pragma("unroll") for (int i = 0; i < 2; ++i) { const int p = tid + i * 512, j = p >> 4, c8 = p & 15; \
            const bf16_t* pr = P + ((size_t)bl * TT + scan_t<64>(dir, (ci_), j)) * AB_N; \
            pq[i] = *(const u32x4*)(pr + AB_Q + h * 128 + c8 * 8); pk[i] = *(const u32x4*)(pr + AB_K + h * 128 + c8 * 8); \
            const int jv = tid & 63, cv = (tid >> 6) + i * 8; \
            pv[i] = *(const u32x4*)(P + ((size_t)bl * TT + scan_t<64>(dir, (ci_), jv)) * AB_N + AB_V + h * 256 + vh * 128 + cv * 8); } \
        if (tid < 64) { const bf16_t* pg = P + ((size_t)bl * TT + scan_t<64>(dir, (ci_), tid)) * AB_N; pgi = pg[AB_IG + dir * 4 + h]; pgf = pg[AB_FG + dir * 4 + h]; } } while (0)
    ML_REQ(0);
    lds_barrier();
    for (int ci = 0; ci < TT / 64; ++ci) {
        int tq = tid; asm volatile("" : "+v"(tq));
        const int lane = tq & 63, wid = __builtin_amdgcn_readfirstlane(tq >> 6), fr = lane & 15, fq = lane >> 4;
#pragma unroll
        for (int i = 0; i < 2; ++i) {
            const int p = tq + i * 512, j = p >> 4, c8 = p & 15;
            u32x4 q = pq[i];
            const float qs = 0.08838834764831845f;
            q.x = pack2(lo2f(q.x) * qs, hi2f(q.x) * qs); q.y = pack2(lo2f(q.y) * qs, hi2f(q.y) * qs);
            q.z = pack2(lo2f(q.z) * qs, hi2f(q.z) * qs); q.w = pack2(lo2f(q.w) * qs, hi2f(q.w) * qs);
            *(u32x4*)(Qs + j * ML_LQ + c8 * 8) = q;
            *(u32x4*)(Ks + j * ML_LQ + c8 * 8) = pk[i];
            const u32x4 v = pv[i];
            bf16_t* vt = VT + (((tq >> 6) + i * 8) * 8) * ML_LT + (tq & 63);
            vt[0 * ML_LT] = (bf16_t)(v.x & 0xffff); vt[1 * ML_LT] = (bf16_t)(v.x >> 16); vt[2 * ML_LT] = (bf16_t)(v.y & 0xffff); vt[3 * ML_LT] = (bf16_t)(v.y >> 16);
            vt[4 * ML_LT] = (bf16_t)(v.z & 0xffff); vt[5 * ML_LT] = (bf16_t)(v.z >> 16); vt[6 * ML_LT] = (bf16_t)(v.w & 0xffff); vt[7 * ML_LT] = (bf16_t)(v.w >> 16);
        }
        if (wid == 0) {
            const float ig = bf2f(pgi) + ibias;
            const float lf = logsigmoidf_(bf2f(pgf) + fbias);
            const float b = wscan_add(lf);
            const float u = ig - b; const float pm = wscan_max(u);
            const float mj = fmaxf(b + m_state, b + pm);
            const float b63 = lane63(b), pm63 = lane63(pm);
            const float mnew = fmaxf(b63 + m_state, b63 + pm63);
            s_rowv[lane] = b - mj; s_colv[lane] = u; s_wint[lane] = __expf(b + m_state - mj); s_emj[lane] = __expf(-mj);
            s_E[lane] = __expf(b63 + u - mnew);
            if (lane == 0) { s_misc[0] = mnew; s_misc[1] = __expf(b63 + m_state - mnew); }
        }
        if (ci + 1 < TT / 64) ML_REQ(ci + 1);
        lds_barrier();
        {
            const int jt = wid >> 1;
#pragma unroll
            for (int q2 = 0; q2 < 2; ++q2) {
                const int st = (wid & 1) * 2 + q2;
                f32x4 acc = (f32x4){0.f, 0.f, 0.f, 0.f};
                if (st <= jt) {
                    bf16x8 fa[4], fb[4];
#pragma unroll
                    for (int k = 0; k < 4; ++k) { fa[k] = ldfrag(Qs, ML_LQ, jt * 16, k * 32, fr, fq); fb[k] = ldfrag(Ks, ML_LQ, st * 16, k * 32, fr, fq); }
                    __builtin_amdgcn_sched_barrier(0);
                    f32x4 acc2 = (f32x4){0.f, 0.f, 0.f, 0.f};
                    acc = mma16(fa[0], fb[0], acc); acc2 = mma16(fa[1], fb[1], acc2); acc = mma16(fa[2], fb[2], acc); acc2 = mma16(fa[3], fb[3], acc2);
                    acc = acc + acc2;
                }
                const int s = st * 16 + fr; const float cv = s_colv[s];
#pragma unroll
                for (int r = 0; r < 4; ++r) { const int j = jt * 16 + fq * 4 + r;
                    const float pv2 = (s <= j) ? acc[r] * __expf(s_rowv[j] + cv) : 0.f;
                    Ps[j * ML_LT + s] = f2bf(pv2); }
            }
#pragma unroll
            for (int i = 0; i < 2; ++i) {
                const int s = lane, c8 = wid + i * 8; const float e = s_E[s];
                const u32x4 kv = *(const u32x4*)(Ks + s * ML_LQ + c8 * 8);
                bf16_t* kt = KTE + (c8 * 8) * ML_LT + s;
                kt[0 * ML_LT] = f2bf(lo2f(kv.x) * e); kt[1 * ML_LT] = f2bf(hi2f(kv.x) * e); kt[2 * ML_LT] = f2bf(lo2f(kv.y) * e); kt[3 * ML_LT] = f2bf(hi2f(kv.y) * e);
                kt[4 * ML_LT] = f2bf(lo2f(kv.z) * e); kt[5 * ML_LT] = f2bf(hi2f(kv.z) * e); kt[6 * ML_LT] = f2bf(lo2f(kv.w) * e); kt[7 * ML_LT] = f2bf(hi2f(kv.w) * e);
            }
        }
        lds_barrier();
        f32x4 a1[4], a2[4];
        {
            const int jt = wid >> 1;
            bf16x8 fp[2], fqq[4];
#pragma unroll
            for (int k = 0; k < 2; ++k) fp[k] = ldfrag(Ps, ML_LT, jt * 16, k * 32, fr, fq);
#pragma unroll
            for (int k = 0; k < 4; ++k) fqq[k] = ldfrag(Qs, ML_LQ, jt * 16, k * 32, fr, fq);
            {
                bf16x8 fv[4][2];
#pragma unroll
                for (int q4 = 0; q4 < 4; ++q4)
#pragma unroll
                    for (int k = 0; k < 2; ++k) fv[q4][k] = ldfrag(VT, ML_LT, ((wid & 1) * 4 + q4) * 16, k * 32, fr, fq);
                __builtin_amdgcn_sched_barrier(0);
#pragma unroll
                for (int q4 = 0; q4 < 4; ++q4) a1[q4] = (f32x4){0.f, 0.f, 0.f, 0.f};
#pragma unroll
                for (int k = 0; k < 2; ++k)
#pragma unroll
                    for (int q4 = 0; q4 < 4; ++q4) a1[q4] = mma16(fv[q4][k], fp[k], a1[q4]);
            }
#pragma unroll
            for (int hh = 0; hh < 2; ++hh) {
                bf16x8 fc[2][4];
#pragma unroll
                for (int q2 = 0; q2 < 2; ++q2)
#pragma unroll
                    for (int k = 0; k < 4; ++k) fc[q2][k] = ldfrag(Cb, ML_LQ, ((wid & 1) * 4 + hh * 2 + q2) * 16, k * 32, fr, fq);
                __builtin_amdgcn_sched_barrier(0);
                a2[hh * 2] = (f32x4){0.f, 0.f, 0.f, 0.f}; a2[hh * 2 + 1] = (f32x4){0.f, 0.f, 0.f, 0.f};
#pragma unroll
                for (int k = 0; k < 4; ++k) { a2[hh * 2] = mma16(fc[0][k], fqq[k], a2[hh * 2]); a2[hh * 2 + 1] = mma16(fc[1][k], fqq[k], a2[hh * 2 + 1]); }
            }
            if (wid & 1) {
                f32x4 d1 = (f32x4){0.f, 0.f, 0.f, 0.f}, d2 = (f32x4){0.f, 0.f, 0.f, 0.f};
                bf16x8 fo[2], fn[4];
#pragma unroll
                for (int k = 0; k < 2; ++k) fo[k] = ldfrag(VT, ML_LT, 128, k * 32, fr, fq);
#pragma unroll
                for (int k = 0; k < 4; ++k) fn[k] = ldfrag(Cb, ML_LQ, 128, k * 32, fr, fq);
                __builtin_amdgcn_sched_barrier(0);
                d1 = mma16(fo[0], fp[0], d1); d2 = mma16(fn[0], fqq[0], d2); d1 = mma16(fo[1], fp[1], d1); d2 = mma16(fn[1], fqq[1], d2);
                d2 = mma16(fn[2], fqq[2], d2); d2 = mma16(fn[3], fqq[3], d2);
                if (fq == 0) { const int j = jt * 16 + fr; s_den[j] = fmaxf(fabsf(d1[0] + s_wint[j] * d2[0]), s_emj[j]); }
            }
        }
        lds_barrier();
        {
            const int jt = wid >> 1, j = jt * 16 + fr;
            const float wi = s_wint[j], rden = frcp_(s_den[j]);
            const size_t row = (size_t)bl * TT + scan_t<64>(dir, ci, j);
#pragma unroll
            for (int q4 = 0; q4 < 4; ++q4) { const int v0 = ((wid & 1) * 4 + q4) * 16 + fq * 4;
                st4bf(HOUT + row * ldh + h * 256 + vh * 128 + v0, (a1[q4] + a2[q4] * wi) * rden); }
        }
        {
            const float dec = s_misc[1];
            const bf16x8 bv0 = ldfrag(VT, ML_LT, wid * 16, 0, fr, fq), bv1 = ldfrag(VT, ML_LT, wid * 16, 32, fr, fq);
#pragma unroll
            for (int hh = 0; hh < 2; ++hh) {
                bf16x8 fk[4][2];
#pragma unroll
                for (int q = 0; q < 4; ++q) { fk[q][0] = ldfrag(KTE, ML_LT, (hh * 4 + q) * 16, 0, fr, fq); fk[q][1] = ldfrag(KTE, ML_LT, (hh * 4 + q) * 16, 32, fr, fq); }
                __builtin_amdgcn_sched_barrier(0);
#pragma unroll
                for (int q = 0; q < 4; ++q) Cacc[hh * 4 + q] = Cacc[hh * 4 + q] * dec;
#pragma unroll
                for (int q = 0; q < 4; ++q) Cacc[hh * 4 + q] = mma16(fk[q][0], bv0, Cacc[hh * 4 + q]);
#pragma unroll
                for (int q = 0; q < 4; ++q) Cacc[hh * 4 + q] = mma16(fk[q][1], bv1, Cacc[hh * 4 + q]);
#pragma unroll
                for (int q = 0; q < 4; ++q) st4bf(Cb + (wid * 16 + fr) * ML_LQ + (hh * 4 + q) * 16 + fq * 4, Cacc[hh * 4 + q]);
            }
            Nacc = Nacc * dec;
            Nacc = mma16(ldfrag(KTE, ML_LT, wid * 16, 0, fr, fq), ldfrag(VT, ML_LT, 128, 0, fr, fq), Nacc);
            Nacc = mma16(ldfrag(KTE, ML_LT, wid * 16, 32, fr, fq), ldfrag(VT, ML_LT, 128, 32, fr, fq), Nacc);
            st4bf(Cb + (128 + fr) * ML_LQ + wid * 16 + fq * 4, Nacc);
            m_state = s_misc[0];
        }
        lds_barrier();
    }
#undef ML_REQ
}

constexpr size_t L0_XC = L0_U;
static_assert(L0_XC + (size_t)RG * 1280 * 2 <= BIG_BYTES, "xconv buffer");
PHASE_FN void phase_xconv(const KP& kp) {
    const int lane = otid() & 63, wid = __builtin_amdgcn_readfirstlane(otid() >> 6);
    const bf16_t* P = WSP(const bf16_t, WS_BIG + L0_P); bf16_t* XC = WSP(bf16_t, WS_BIG + L0_XC);
    const float* cw = KIN(12); const float* cb = KIN(13);
    constexpr int RUN = 9;
    for (int run = obid() * 8 + wid; run < RG / RUN; run += gridDim.x * 8) {
        const int r0 = run * RUN;
#pragma unroll
        for (int i = 0; i < 5; ++i) { const int col = i * 256 + lane * 4;
            const f32x4 bias = *(const f32x4*)(cb + col);
            f32x4 w[5], x[5];
#pragma unroll
            for (int q = 0; q < 5; ++q) w[q] = *(const f32x4*)(cw + q * 1280 + col);
#pragma unroll
            for (int q = 0; q < 4; ++q) { const int rr = r0 - 2 + q; x[q + 1] = (rr >= 0 && rr < RG) ? ld4bf(P + (size_t)rr * AB_N + AB_XBC + col) : (f32x4){0.f, 0.f, 0.f, 0.f}; }
#pragma unroll
            for (int k = 0; k < RUN; ++k) {
                const int lr = r0 + k, bl = lr / TT, t = lr - bl * TT, lo = t < CTXL ? 0 : CTXL, hi = t < CTXL ? CTXL : TT;
#pragma unroll
                for (int q = 0; q < 4; ++q) x[q] = x[q + 1];
                { const int rr = lr + 2; x[4] = (rr < RG) ? ld4bf(P + (size_t)rr * AB_N + AB_XBC + col) : (f32x4){0.f, 0.f, 0.f, 0.f}; }
                f32x4 a = bias;
#pragma unroll
                for (int q = 0; q < 5; ++q) { const int tt = t - 2 + q; if (tt >= lo && tt < hi) a += w[q] * x[q]; }
                f32x4 o;
#pragma unroll
                for (int r = 0; r < 4; ++r) o[r] = siluf_(a[r]);
                st4bf(XC + (size_t)lr * 1280 + col, o);
            }
        }
    }
}

constexpr int SS_LT = 72, SS_LX = 136;
PHASE_FN void ssd_unit(const KP& kp, unsigned char* lds, int bl, int dir, int hp) {
    const int tid = otid();
    const int gi = hp >> 2, hh0 = hp * 2;
    bf16_t* Wm = (bf16_t*)lds;
    bf16_t* CM = Wm + 2 * 64 * SS_LT;
    bf16_t* BM = CM + 64 * SS_LT;
    bf16_t* Xn = BM + 64 * SS_LT;
    bf16_t* XT = Xn + 64 * SS_LX;
    bf16_t* BTE = XT + 2 * 64 * SS_LT;
    bf16_t* Sb = BTE + 2 * 64 * SS_LT;
    float* fs = (float*)(Sb + 2 * 64 * SS_LT);
    float* s_b = fs;
    float* s_dt = fs + 128;
    float* s_e = fs + 256;
    float* s_misc = fs + 384;
    const bf16_t* P = WSP(const bf16_t, WS_BIG + L0_P); const bf16_t* XC = WSP(const bf16_t, WS_BIG + L0_XC);
    bf16_t* YOUT = WSP(bf16_t, WS_BIG + (dir ? L0_YB : L0_AO + 2048)); const int ldy = dir ? 1024 : 2048;
    for (int i = tid; i < 2 * 64 * SS_LT; i += 512) Sb[i] = 0;
    f32x4 Sacc[4];
#pragma unroll
    for (int i = 0; i < 4; ++i) Sacc[i] = (f32x4){0.f, 0.f, 0.f, 0.f};
    const float dtb = KIN(14)[dir * 16 + hh0 + ((tid >> 6) & 1)], aexp = __expf(KIN(15)[dir * 16 + hh0 + ((tid >> 6) & 1)]);
    const float dskip = KIN(16)[hh0 + (tid >> 8)];
    u32x4 pr[4]; bf16_t pdt = 0;
#define SS_REQ(ci_) do { _Pragma("unroll") for (int q = 0; q < 4; ++q) { const int p = tid + q * 512, j = p >> 5, c8 = p & 31; \
            const int col = c8 < 16 ? hh0 * 64 + c8 * 8 : (c8 < 24 ? 1024 + gi * 64 + (c8 - 16) * 8 : 1152 + gi * 64 + (c8 - 24) * 8); \
            pr[q] = *(const u32x4*)(XC + ((size_t)bl * TT + scan_t<64>(dir, (ci_), j)) * 1280 + col); } \
        if (tid < 128) pdt = P[((size_t)bl * TT + scan_t<64>(dir, (ci_), tid & 63)) * AB_N + AB_DT + dir * 16 + hh0 + (tid >> 6)]; } while (0)
    SS_REQ(0);
    lds_barrier();
    for (int ci = 0; ci < TT / 64; ++ci) {
        int tq = tid; asm volatile("" : "+v"(tq));
        const int lane = tq & 63, wid = __builtin_amdgcn_readfirstlane(tq >> 6), fr = lane & 15, fq = lane >> 4, hl_w = wid >> 2;
#pragma unroll
        for (int q = 0; q < 4; ++q) { const int p = tq + q * 512, j = p >> 5, c8 = p & 31;
            bf16_t* dst = c8 < 16 ? Xn + j * SS_LX + c8 * 8 : (c8 < 24 ? BM + j * SS_LT + (c8 - 16) * 8 : CM + j * SS_LT + (c8 - 24) * 8);
            *(u32x4*)dst = pr[q]; }
        if (wid < 2) {
            const float dt = softplusf_(bf2f(pdt) + dtb);
            const float b = wscan_add(-dt * aexp);
            const float b63 = lane63(b);
            s_b[wid * 64 + lane] = b; s_dt[wid * 64 + lane] = dt; s_e[wid * 64 + lane] = __expf(b63 - b) * dt;
            if (lane == 0) s_misc[wid] = __expf(b63);
        }
        if (ci + 1 < TT / 64) SS_REQ(ci + 1);
        lds_barrier();
        {
            const int jt = wid >> 1;
#pragma unroll
            for (int q2 = 0; q2 < 2; ++q2) {
                const int st = (wid & 1) * 2 + q2;
                f32x4 acc = (f32x4){0.f, 0.f, 0.f, 0.f};
                if (st <= jt) {
                    const bf16x8 c0 = ldfrag(CM, SS_LT, jt * 16, 0, fr, fq), c1 = ldfrag(CM, SS_LT, jt * 16, 32, fr, fq), b0 = ldfrag(BM, SS_LT, st * 16, 0, fr, fq), b1 = ldfrag(BM, SS_LT, st * 16, 32, fr, fq);
                    __builtin_amdgcn_sched_barrier(0);
                    acc = mma16(c0, b0, acc); acc = mma16(c1, b1, acc);
                }
                const int s = st * 16 + fr;
#pragma unroll
                for (int hl = 0; hl < 2; ++hl) { const float bs = s_b[hl * 64 + s], ds = s_dt[hl * 64 + s];
#pragma unroll
                    for (int r = 0; r < 4; ++r) { const int j = jt * 16 + fq * 4 + r;
                        const float wv = (s <= j) ? acc[r] * __expf(s_b[hl * 64 + j] - bs) * ds : 0.f;
                        Wm[(hl * 64 + j) * SS_LT + s] = f2bf(wv); } }
            }
            {
                const int s = lane, n8 = wid;
                const u32x4 bv = *(const u32x4*)(BM + s * SS_LT + n8 * 8);
#pragma unroll
                for (int hl = 0; hl < 2; ++hl) { const float e = s_e[hl * 64 + s];
                    bf16_t* bt = BTE + (hl * 64 + n8 * 8) * SS_LT + s;
                    bt[0 * SS_LT] = f2bf(lo2f(bv.x) * e); bt[1 * SS_LT] = f2bf(hi2f(bv.x) * e); bt[2 * SS_LT] = f2bf(lo2f(bv.y) * e); bt[3 * SS_LT] = f2bf(hi2f(bv.y) * e);
                    bt[4 * SS_LT] = f2bf(lo2f(bv.z) * e); bt[5 * SS_LT] = f2bf(hi2f(bv.z) * e); bt[6 * SS_LT] = f2bf(lo2f(bv.w) * e); bt[7 * SS_LT] = f2bf(hi2f(bv.w) * e); }
#pragma unroll
                for (int i = 0; i < 2; ++i) { const int c8 = wid + i * 8;
                    const u32x4 xv = *(const u32x4*)(Xn + s * SS_LX + c8 * 8);
                    bf16_t* xt = XT + (c8 * 8) * SS_LT + s;
                    xt[0 * SS_LT] = (bf16_t)(xv.x & 0xffff); xt[1 * SS_LT] = (bf16_t)(xv.x >> 16); xt[2 * SS_LT] = (bf16_t)(xv.y & 0xffff); xt[3 * SS_LT] = (bf16_t)(xv.y >> 16);
                    xt[4 * SS_LT] = (bf16_t)(xv.z & 0xffff); xt[5 * SS_LT] = (bf16_t)(xv.z >> 16); xt[6 * SS_LT] = (bf16_t)(xv.w & 0xffff); xt[7 * SS_LT] = (bf16_t)(xv.w >> 16); }
            }
        }
        lds_barrier();
        {
            const int hl = hl_w, jt = wid & 3, j = jt * 16 + fr;
            const bf16_t* Wh = Wm + hl * 64 * SS_LT; const bf16_t* Xh = XT + hl * 64 * SS_LT; const bf16_t* Sh = Sb + hl * 64 * SS_LT;
            const float eb = __expf(s_b[hl * 64 + j]);
            const size_t row = (size_t)bl * TT + scan_t<64>(dir, ci, j);
            const bf16x8 w0 = ldfrag(Wh, SS_LT, jt * 16, 0, fr, fq), w1 = ldfrag(Wh, SS_LT, jt * 16, 32, fr, fq), m0 = ldfrag(CM, SS_LT, jt * 16, 0, fr, fq), m1 = ldfrag(CM, SS_LT, jt * 16, 32, fr, fq);
#pragma unroll
            for (int hh = 0; hh < 2; ++hh) {
                bf16x8 fx[2][2], fs2[2][2];
#pragma unroll
                for (int q = 0; q < 2; ++q)
#pragma unroll
                    for (int k = 0; k < 2; ++k) { fx[q][k] = ldfrag(Xh, SS_LT, (hh * 2 + q) * 16, k * 32, fr, fq); fs2[q][k] = ldfrag(Sh, SS_LT, (hh * 2 + q) * 16, k * 32, fr, fq); }
                f32x4 dx[2];
                if (!dir) { dx[0] = ld4bf(Xn + j * SS_LX + hl * 64 + (hh * 2) * 16 + fq * 4); dx[1] = ld4bf(Xn + j * SS_LX + hl * 64 + (hh * 2 + 1) * 16 + fq * 4); }
                __builtin_amdgcn_sched_barrier(0);
                f32x4 y1[2], y2[2];
#pragma unroll
                for (int q = 0; q < 2; ++q) { y1[q] = (f32x4){0.f, 0.f, 0.f, 0.f}; y2[q] = (f32x4){0.f, 0.f, 0.f, 0.f}; }
#pragma unroll
                for (int q = 0; q < 2; ++q) { y1[q] = mma16(fx[q][0], w0, y1[q]); y2[q] = mma16(fs2[q][0], m0, y2[q]); }
#pragma unroll
                for (int q = 0; q < 2; ++q) { y1[q] = mma16(fx[q][1], w1, y1[q]); y2[q] = mma16(fs2[q][1], m1, y2[q]); }
#pragma unroll
                for (int q = 0; q < 2; ++q) { f32x4 y = y1[q] + y2[q] * eb;
                    if (!dir) y = y + dx[q] * dskip;
                    st4bf(YOUT + row * ldy + (hh0 + hl) * 64 + (hh * 2 + q) * 16 + fq * 4, y); }
            }
        }
        lds_barrier();
        {
            const int hl = hl_w, pt = wid & 3; const float eb63 = s_misc[hl];
            const bf16_t* Xh = XT + hl * 64 * SS_LT; const bf16_t* Bh = BTE + hl * 64 * SS_LT; bf16_t* Sh = Sb + hl * 64 * SS_LT;
            const bf16x8 x0 = ldfrag(Xh, SS_LT, pt * 16, 0, fr, fq), x1 = ldfrag(Xh, SS_LT, pt * 16, 32, fr, fq);
            bf16x8 fb[4][2];
#pragma unroll
            for (int nt = 0; nt < 4; ++nt) { fb[nt][0] = ldfrag(Bh, SS_LT, nt * 16, 0, fr, fq); fb[nt][1] = ldfrag(Bh, SS_LT, nt * 16, 32, fr, fq); }
            __builtin_amdgcn_sched_barrier(0);
#pragma unroll
            for (int nt = 0; nt < 4; ++nt) Sacc[nt] = Sacc[nt] * eb63;
#pragma unroll
            for (int nt = 0; nt < 4; ++nt) Sacc[nt] = mma16(fb[nt][0], x0, Sacc[nt]);
#pragma unroll
            for (int nt = 0; nt < 4; ++nt) Sacc[nt] = mma16(fb[nt][1], x1, Sacc[nt]);
#pragma unroll
            for (int nt = 0; nt < 4; ++nt) st4bf(Sh + (pt * 16 + fr) * SS_LT + nt * 16 + fq * 4, Sacc[nt]);
        }
        lds_barrier();
    }
#undef SS_REQ
}

__device__ __forceinline__ void phase_scan_ab(const KP& kp, unsigned char* lds) {
    for (int rep = 0; rep < ((PROBE_DUP & 8192) ? 2 : 1); ++rep)
    for (int u = obid(); u < 256; u += gridDim.x) if (u < 128) { const int r = ((u >> 4) << 3) | (u & 7);
        mlstm_unit(kp, lds, r >> 3, (r >> 1) & 3, r & 1, (u >> 3) & 1); __syncthreads(); }
    for (int rep = 0; rep < ((PROBE_DUP & 16384) ? 2 : 1); ++rep)
    for (int u = obid(); u < 256; u += gridDim.x) if (u >= 128) { const int v = u - 128, r = ((v >> 5) << 3) | (v & 7);
        ssd_unit(kp, lds, r >> 2, (r >> 1) & 1, (r & 1) * 4 + ((v >> 3) & 3)); __syncthreads(); }
}

PHASE_FN void phase_fin_ab(const KP& kp) {
    const int lane = otid() & 63, wid = __builtin_amdgcn_readfirstlane(otid() >> 6);
    const bf16_t* P = WSP(const bf16_t, WS_BIG + L0_P);
    bf16_t* AO = WSP(bf16_t, WS_BIG + L0_AO); const bf16_t* HB = WSP(const bf16_t, WS_BIG + L0_HB); const bf16_t* YB = WSP(const bf16_t, WS_BIG + L0_YB);
    const float* mln = KIN(11); const float* sn = KIN(17);
    for (int lr = obid() * 8 + wid; lr < RG; lr += gridDim.x * 8) {
        const bf16_t* pr = P + (size_t)lr * AB_N;
        f32x4 yz[4]; float ss2 = 0.f;
#pragma unroll
        for (int i = 0; i < 4; ++i) { const int col = i * 256 + lane * 4;
            const f32x4 hs = ld4bf(AO + (size_t)lr * 2048 + col) + ld4bf(HB + (size_t)lr * 1024 + col);
            float ss = hs[0] * hs[0] + hs[1] * hs[1] + hs[2] * hs[2] + hs[3] * hs[3];
            ss = wsum(ss); const float rstd = rsqrtf(ss * (1.0f / 256.0f) + EPS);
            const f32x4 og = ld4bf(pr + AB_OG + col), w = *(const f32x4*)(mln + col);
            f32x4 o;
#pragma unroll
            for (int r = 0; r < 4; ++r) o[r] = hs[r] * rstd * w[r] * sigmoidf_(og[r]);
            st4bf(AO + (size_t)lr * 2048 + col, o);
            const f32x4 ys = ld4bf(AO + (size_t)lr * 2048 + 1024 + col) + ld4bf(YB + (size_t)lr * 1024 + col), z = ld4bf(pr + AB_Z + col);
#pragma unroll
            for (int r = 0; r < 4; ++r) { yz[i][r] = ys[r] * siluf_(z[r]); ss2 += yz[i][r] * yz[i][r]; }
        }
        ss2 = wsum(ss2); const float rstd2 = rsqrtf(ss2 * (1.0f / 1024.0f) + EPS);
#pragma unroll
        for (int i = 0; i < 4; ++i) { const int col = i * 256 + lane * 4; st4bf(AO + (size_t)lr * 2048 + 1024 + col, yz[i] * rstd2 * *(const f32x4*)(sn + col)); }
    }
}

PHASE_FN void phase_gemm_in(const KP& kp, unsigned char* lds, int layer, int grp) {
    const int npad = layer == 0 ? AB_NPAD : CD_NPAD, n = layer == 0 ? AB_N : CD_N;
    pg8::StaticOrder S; S.init(RG, npad, (int)gridDim.x, obid());
    if (layer == 0) {
        pg8::Gemm g{grp == 0 ? WSP(const bf16_t, WS_BIG + L0_U) : WSP(const bf16_t, WS_V) + (size_t)grp * RG * 1024, WSP(const bf16_t, WS_WMIX), RG, npad, 1024, nullptr, 0x7fffffff};
        pg8::EpiBfG E{WSP(bf16_t, WS_BIG), n, n, 0x7fffffff, 1.0f};
        pg8::gemm_phase<pg8::EpiBfG, pg8::StaticOrder, false>((PG8_LAS unsigned char*)lds, g, S, E, nullptr);
    } else {
        pg8::Gemm g{WSP(const bf16_t, WS_V) + (size_t)grp * RG * 1024, WSP(const bf16_t, WS_WMIX), RG, npad, 512, nullptr, 0x7fffffff, 1024, 0};
        pg8::EpiBfG E{WSP(bf16_t, WS_BIG), n, n, 0x7fffffff, W8_INV};
        pg8::gemm_phase<pg8::EpiBfG, pg8::StaticOrder, false, true>((PG8_LAS unsigned char*)lds, g, S, E, nullptr);
    }
    __syncthreads();
}
PHASE_FN void phase_gemm_out_ab(const KP& kp, unsigned char* lds, int grp) {
    pg8::Gemm g{WSP(const bf16_t, WS_BIG + L0_AO), WSP(const bf16_t, WS_WMIX + WM_AB_OUT), RG, 1024, 2048, nullptr, 0x7fffffff};
    pg8::StaticOrder S; S.init(RG, 1024, (int)gridDim.x, obid());
    pg8::EpiBfG E{WSP(bf16_t, WS_BIG + L0_U), 1024, 1024, 0x7fffffff, 1.0f};
    pg8::gemm_phase<pg8::EpiBfG, pg8::StaticOrder, false>((PG8_LAS unsigned char*)lds, g, S, E, nullptr);
    __syncthreads();
    const int G = (int)gridDim.x, units = (RG / 256) * 4, two = units > G ? (units - G < G ? units - G : G) : 0;
    const int nb = G - two > 0 ? G - two : G, bid = G - two > 0 ? obid() - two : obid();
    if (bid >= 0) { if (grp == 0) phase_u(kp, 0, 1, bid, nb, true); else phase_conv_moe(kp, lds, 0, bid, nb); }
    __syncthreads();
}

PHASE_FN void phase_prep_cd(const KP& kp) {
    const int lane = otid() & 63, wid = __builtin_amdgcn_readfirstlane(otid() >> 6);
    bf16_t* P = WSP(bf16_t, WS_BIG + L1_P);
    bf16_t* SG = WSP(bf16_t, WS_SG);
    const float* qn = KIN(20); const float* kvn = KIN(22); const float* mu = KIN(24);
    for (int lr = obid() * 8 + wid; lr < RG; lr += gridDim.x * 8) {
        const int bl = lr / TT, t = lr - bl * TT;
        bf16_t* pr = P + (size_t)lr * CD_N;
        {
            const f32x4 x = ld4bf(pr + CD_M1 + lane * 4);
            float ss = x[0] * x[0] + x[1] * x[1] + x[2] * x[2] + x[3] * x[3]; ss = wsum(ss);
            const float rstd = rsqrtf(ss * (1.0f / 256.0f) + EPS);
            st4bf(pr + CD_M1 + lane * 4, x * rstd * *(const f32x4*)(kvn + lane * 4));
        }
        {
            const int lo = t < CTXL ? 0 : CTXL, hi = t < CTXL ? CTXL : TT, c = lane * 4;
            const f32x4 x = ld4bf(pr + CD_WL + c);
            const f32x4 xp = t > lo ? ld4bf(pr - CD_N + CD_WL + c) : (f32x4){0.f, 0.f, 0.f, 0.f};
            const f32x4 xn = t < hi - 1 ? ld4bf(pr + CD_N + CD_WL + c) : (f32x4){0.f, 0.f, 0.f, 0.f};
            f32x4 l = x + *(const f32x4*)(mu + CD_WL - CD_RW0 + c) * ((xp + xn) * 0.5f - x);
            if (c < 128) {
#pragma unroll
                for (int q = 0; q < 4; ++q) l[q] = tanhf_(l[q]); }
            st4bf(WSP(bf16_t, WS_BIG + L1_TWAL) + (size_t)lr * 256 + c, l);
        }
        if (t >= CTXL) {
            const int s = t - CTXL;
            float x0[3], x1[3]; float ss = 0.f;
#pragma unroll
            for (int i = 0; i < 3; ++i) { const unsigned w = *(const unsigned*)(pr + CD_M0 + i * 128 + lane * 2); x0[i] = lo2f(w); x1[i] = hi2f(w); ss += x0[i] * x0[i] + x1[i] * x1[i]; }
            ss = wsum(ss); const float rstd = rsqrtf(ss * (1.0f / 384.0f) + EPS);
#pragma unroll
            for (int i = 0; i < 3; ++i) { const int c = i * 128 + lane * 2; *(unsigned*)(pr + CD_M0 + c) = pack2(x0[i] * rstd * qn[c], x1[i] * rstd * qn[c + 1]); }
            if (lane < 16) {
                const float pos = (lane < 8) ? (float)(s >> 6) : (float)(s & 63);
                const float inv = __expf(-(float)(lane & 7) * (9.210340371976184f / 8.0f));
                float sn, cs; sincosf(pos * inv, &sn, &cs);
                const float a = bf2f(pr[CD_KR + lane]), b2 = bf2f(pr[CD_KR + 16 + lane]);
                pr[CD_KR + lane] = f2bf(a * cs - b2 * sn); pr[CD_KR + 16 + lane] = f2bf(a * sn + b2 * cs);
            }
            {
                const int c = lane * 2;
                const unsigned w = *(const unsigned*)(pr + CD_GL + c);
                const unsigned wp = s > 0 ? *(const unsigned*)(pr - CD_N + CD_GL + c) : 0u;
                const unsigned wn = s < SEQ - 1 ? *(const unsigned*)(pr + CD_N + CD_GL + c) : 0u;
                const float m0 = mu[CD_GL - CD_RW0 + c], m1 = mu[CD_GL - CD_RW0 + c + 1];
                const float g0 = lo2f(w) + m0 * (0.5f * (lo2f(wp) + lo2f(wn)) - lo2f(w));
                const float g1 = hi2f(w) + m1 * (0.5f * (hi2f(wp) + hi2f(wn)) - hi2f(w));
                *(unsigned*)(SG + ((size_t)bl * SEQ + s) * 128 + c) = pack2(sigmoidf_(g0), sigmoidf_(g1));
            }
        }
    }
}

PHASE_FN void phase_upproj(const KP& kp, unsigned char* lds) {
    const bf16_t* P = WSP(const bf16_t, WS_BIG + L1_P);
    {
        pg8::Gemm g{P + CD_M0, WSP(const bf16_t, WS_WMIX + WM_UQ), RGL, 768, 384, nullptr, 0x7fffffff, CD_N, 1};
        pg8::StaticOrder S; S.init(RGL, 768, (int)gridDim.x, obid());
        pg8::EpiBfG E{WSP(bf16_t, WS_BIG + L1_Q), 768, 768, 0x7fffffff, 1.0f};
        pg8::gemm_phase<pg8::EpiBfG, pg8::StaticOrder, false>((PG8_LAS unsigned char*)lds, g, S, E, nullptr);
    }
    __syncthreads();
    {
        pg8::Gemm g{P + CD_M1, WSP(const bf16_t, WS_WMIX + WM_UKV), RG, 1024, 256, nullptr, 0x7fffffff, CD_N, 0};
        pg8::StaticOrder S; S.init(RG, 1024, (int)gridDim.x, (obid() + 64) % (int)gridDim.x);
        pg8::EpiBfG E{WSP(bf16_t, WS_BIG + L1_KV), 1024, 1024, 0x7fffffff, 1.0f};
        pg8::gemm_phase<pg8::EpiBfG, pg8::StaticOrder, false>((PG8_LAS unsigned char*)lds, g, S, E, nullptr);
    }
    __syncthreads();
}

constexpr int AT_LQ = 104, AT_LV = 72;
PHASE_FN void attn_unit(const KP& kp, unsigned char* lds, int bl, int head, int qb) {
    const int tid = otid(), lane = tid & 63, wid = __builtin_amdgcn_readfirstlane(tid >> 6), fr = lane & 15, fq = lane >> 4;
    bf16_t* Qs = (bf16_t*)lds;
    bf16_t* Kt = Qs + 256 * AT_LQ;
    bf16_t* Vt = Kt + 2 * 64 * AT_LQ;
    const bf16_t* P = WSP(const bf16_t, WS_BIG + L1_P);
    const bf16_t* Q = WSP(const bf16_t, WS_BIG + L1_Q);
    const bf16_t* KV = WSP(const bf16_t, WS_BIG + L1_KV);
    bf16_t* AOUT = WSP(bf16_t, WS_BIG + L1_AOUT);
    const float SC = 0.10206207261596577f;
#pragma unroll
    for (int i = 0; i < 6; ++i) { const int p = tid + i * 512, r = p / 12, c = p % 12;
        *(u32x4*)(Qs + r * AT_LQ + c * 8) = *(const u32x4*)(Q + ((size_t)bl * SEQ + qb * 256 + r) * 768 + head * 96 + c * 8); }
    lds_barrier();
#pragma unroll
    for (int i = 0; i < 8; ++i) { const int p = tid + i * 512, r = p >> 4, f = p & 15, s = qb * 256 + r;
        const float pos = (f < 8) ? (float)(s >> 6) : (float)(s & 63);
        const float inv = __expf(-(float)(f & 7) * (9.210340371976184f / 8.0f));
        float sn, cs; sincosf(pos * inv, &sn, &cs);
        const float a = bf2f(Qs[r * AT_LQ + 64 + f]), b2 = bf2f(Qs[r * AT_LQ + 80 + f]);
        Qs[r * AT_LQ + 64 + f] = f2bf(a * cs - b2 * sn); Qs[r * AT_LQ + 80 + f] = f2bf(a * sn + b2 * cs); }
    lds_barrier();
    bf16x8 qf[2][3];
#pragma unroll
    for (int rt = 0; rt < 2; ++rt)
#pragma unroll
        for (int k = 0; k < 3; ++k) qf[rt][k] = ldfrag(Qs, AT_LQ, wid * 32 + rt * 16, k * 32, fr, fq);
    f32x4 ot[2][4];
#pragma unroll
    for (int rt = 0; rt < 2; ++rt)
#pragma unroll
        for (int i = 0; i < 4; ++i) ot[rt][i] = (f32x4){0.f, 0.f, 0.f, 0.f};
    float mrow[2] = {-1e30f, -1e30f}, lsum[2] = {0.f, 0.f};
    u32x4 pk0[2], pk1[2], pvv[2];
    const int kkey0 = tid / 12, kc0 = tid % 12, kkey1 = (tid + 512) / 12, kc1 = (tid + 512) % 12, vkey = tid & 63, vc8 = tid >> 6;
#define AT_REQ(kt_) do { _Pragma("unroll") for (int h_ = 0; h_ < 2; ++h_) { const size_t rb_ = (size_t)bl * TT + ((kt_) * 2 + h_) * 64; \
        pk0[h_] = kc0 < 8 ? *(const u32x4*)(KV + (rb_ + kkey0) * 1024 + head * 128 + kc0 * 8) : *(const u32x4*)(P + (rb_ + kkey0) * CD_N + CD_KR + (kc0 - 8) * 8); \
        if (tid < 256) pk1[h_] = kc1 < 8 ? *(const u32x4*)(KV + (rb_ + kkey1) * 1024 + head * 128 + kc1 * 8) : *(const u32x4*)(P + (rb_ + kkey1) * CD_N + CD_KR + (kc1 - 8) * 8); \
        pvv[h_] = *(const u32x4*)(KV + (rb_ + vkey) * 1024 + head * 128 + 64 + vc8 * 8); } } while (0)
    AT_REQ(0);
    const float SC2 = SC * 1.4426950408889634f;
    for (int kt = 0; kt < TT / 128; ++kt) {
        lds_barrier();
#pragma unroll
        for (int h_ = 0; h_ < 2; ++h_) {
            *(u32x4*)(Kt + (h_ * 64 + kkey0) * AT_LQ + kc0 * 8) = pk0[h_];
            if (tid < 256) *(u32x4*)(Kt + (h_ * 64 + kkey1) * AT_LQ + kc1 * 8) = pk1[h_];
            { bf16_t* vt = Vt + (h_ * 64 + vc8 * 8) * AT_LV + vkey; const u32x4 v = pvv[h_];
                vt[0 * AT_LV] = (bf16_t)(v.x & 0xffff); vt[1 * AT_LV] = (bf16_t)(v.x >> 16); vt[2 * AT_LV] = (bf16_t)(v.y & 0xffff); vt[3 * AT_LV] = (bf16_t)(v.y >> 16);
                vt[4 * AT_LV] = (bf16_t)(v.z & 0xffff); vt[5 * AT_LV] = (bf16_t)(v.z >> 16); vt[6 * AT_LV] = (bf16_t)(v.w & 0xffff); vt[7 * AT_LV] = (bf16_t)(v.w >> 16); }
        }
        if (kt + 1 < TT / 128) AT_REQ(kt + 1);
        lds_barrier();
        {
        bf16x8 kf[3][4]; f32x4 sta[2][4], stb[2][4]; u32x2 vlo[2][4], vhi[2][4];
        union { bf16x8 v; unsigned u[4]; } pb[2][2];
#define AT_LOADK(hs_) do { const bf16_t* Kth = Kt + (hs_) * 64 * AT_LQ; \
            _Pragma("unroll") for (int k = 0; k < 3; ++k) _Pragma("unroll") for (int kk = 0; kk < 4; ++kk) kf[k][kk] = ldfrag(Kth, AT_LQ, kk * 16, k * 32, fr, fq); } while (0)
#define AT_LOADV(hs_) do { const bf16_t* Vth = Vt + (hs_) * 64 * AT_LV; \
            _Pragma("unroll") for (int k2 = 0; k2 < 2; ++k2) _Pragma("unroll") for (int dvt = 0; dvt < 4; ++dvt) { const bf16_t* vp = Vth + (dvt * 16 + fr) * AT_LV + k2 * 32 + fq * 4; vlo[k2][dvt] = *(const u32x2*)vp; vhi[k2][dvt] = *(const u32x2*)(vp + 16); } } while (0)
#define AT_QK(st) do { _Pragma("unroll") for (int rt = 0; rt < 2; ++rt) _Pragma("unroll") for (int kk = 0; kk < 4; ++kk) st[rt][kk] = (f32x4){0.f, 0.f, 0.f, 0.f}; \
            _Pragma("unroll") for (int k = 0; k < 3; ++k) _Pragma("unroll") for (int kk = 0; kk < 4; ++kk) _Pragma("unroll") for (int rt = 0; rt < 2; ++rt) st[rt][kk] = mma16(kf[k][kk], qf[rt][k], st[rt][kk]); } while (0)
#define AT_SM(st) do { _Pragma("unroll") for (int rt = 0; rt < 2; ++rt) { \
            float mx = -1e30f; \
            _Pragma("unroll") for (int kk = 0; kk < 4; ++kk) mx = fmaxf(mx, fmaxf(fmaxf(st[rt][kk][0], st[rt][kk][1]), fmaxf(st[rt][kk][2], st[rt][kk][3]))); \
            mx = xmax_rows(mx); \
            const float mold = mrow[rt], mnew = fmaxf(mold, mx), mb = mnew * SC2; \
            float ls = 0.f; \
            _Pragma("unroll") for (int kk = 0; kk < 4; ++kk) _Pragma("unroll") for (int r = 0; r < 4; ++r) { const float pv = __builtin_amdgcn_exp2f(st[rt][kk][r] * SC2 - mb); st[rt][kk][r] = pv; ls += pv; } \
            _Pragma("unroll") for (int k2 = 0; k2 < 2; ++k2) { \
                pb[rt][k2].u[0] = pack2(st[rt][2 * k2][0], st[rt][2 * k2][1]); pb[rt][k2].u[1] = pack2(st[rt][2 * k2][2], st[rt][2 * k2][3]); \
                pb[rt][k2].u[2] = pack2(st[rt][2 * k2 + 1][0], st[rt][2 * k2 + 1][1]); pb[rt][k2].u[3] = pack2(st[rt][2 * k2 + 1][2], st[rt][2 * k2 + 1][3]); } \
            if (__builtin_amdgcn_ballot_w64(mnew > mold) != 0ull) {         \
                const float alpha = __builtin_amdgcn_exp2f((mold - mnew) * SC2); \
                lsum[rt] *= alpha; \
                _Pragma("unroll") for (int i = 0; i < 4; ++i) ot[rt][i] = ot[rt][i] * alpha; } \
            mrow[rt] = mnew; lsum[rt] += ls; } } while (0)
#define AT_PV() do { _Pragma("unroll") for (int k2 = 0; k2 < 2; ++k2) _Pragma("unroll") for (int dvt = 0; dvt < 4; ++dvt) { union { bf16x8 v; u32x2 h[2]; } va; va.h[0] = vlo[k2][dvt]; va.h[1] = vhi[k2][dvt]; \
            _Pragma("unroll") for (int rt = 0; rt < 2; ++rt) ot[rt][dvt] = mma16(va.v, pb[rt][k2].v, ot[rt][dvt]); } } while (0)
        AT_LOADK(0);
        __builtin_amdgcn_sched_barrier(0);
        AT_QK(sta);
        AT_LOADK(1);
        AT_QK(stb);
        AT_LOADV(0);
        __builtin_amdgcn_sched_barrier(0);
        AT_SM(sta);
        AT_PV();
        AT_LOADV(1);
        __builtin_amdgcn_sched_barrier(0);
        AT_SM(stb);
        AT_PV();
#undef AT_LOADK
#undef AT_LOADV
#undef AT_QK
#undef AT_SM
#undef AT_PV
        }
    }
#undef AT_REQ
#pragma unroll
    for (int rt = 0; rt < 2; ++rt) {
        float ls = lsum[rt]; ls += __shfl_xor(ls, 16); ls += __shfl_xor(ls, 32);
        const float rl = frcp_(ls);
        const size_t orow = (size_t)bl * SEQ + qb * 256 + wid * 32 + rt * 16 + fr;
#pragma unroll
        for (int dvt = 0; dvt < 4; ++dvt) st4bf(AOUT + orow * 1536 + head * 64 + dvt * 16 + fq * 4, ot[rt][dvt] * rl);
    }
}

constexpr int RW_LR = 200, RW_LP = 72;
struct TrueT { static constexpr bool value = true; }; struct FalseT { static constexpr bool value = false; };
PHASE_FN void rwkv_unit(const KP& kp, unsigned char* lds, int bl, int h, int dir) {
    const int tid = otid();
    constexpr int NC = TT / 32;
    bf16_t* RAW = (bf16_t*)lds;
    bf16_t* TWb = RAW + 34 * RW_LR;
    bf16_t* ALb = TWb + 32 * RW_LP;
    float* WLf = (float*)(ALb + 32 * RW_LP);
    float* ALf = WLf + 32 * 64;
    bf16_t* BK = (bf16_t*)WLf;
    float* WT = ALf + 32 * 64;
    bf16_t* AR = (bf16_t*)(WT + 8 * 64);
    float* AABT = (float*)(AR + 64 * RW_LP);
    bf16_t* ARB0 = (bf16_t*)(AABT + 32 * 36);
    bf16_t* AAK = ARB0 + 2 * 32 * 40;
    bf16_t* ARK = AAK + 32 * 40;
    float* RHS = (float*)(ARK + 32 * 40);
    float* YB = RHS + 32 * 64;
    bf16_t* ZVT0 = (bf16_t*)(YB + 32 * 64);
    bf16_t* BKh0 = ZVT0 + 2 * 64 * RW_LP;
    bf16_t* Sb = BKh0 + 2 * 64 * RW_LP;
    float* PL0 = (float*)(Sb + 64 * RW_LP);
    float* CV = PL0 + 2 * 64;
    bf16_t* A21b = (bf16_t*)(CV + 8 * 64);
    bf16_t* TI = A21b + 16 * 40;
    bf16_t* RHSb = TI + 2 * 16 * 40;
    bf16_t* XB = RHSb + 64 * 40;
    static_assert((34 * RW_LR + 2 * 32 * RW_LP) * 2 + (2 * 32 * 64 + 8 * 64) * 4 + 64 * RW_LP * 2 + 32 * 36 * 4 + 4 * 32 * 40 * 2 + 2 * 32 * 64 * 4
                  + 5 * 64 * RW_LP * 2 + (2 * 64 + 8 * 64) * 4 + (16 * 40 + 2 * 16 * 40 + 2 * 64 * 40) * 2 <= LDS_BYTES - 16, "rwkv LDS");
    const bf16_t* P = WSP(const bf16_t, WS_BIG + L1_P); const bf16_t* TWAL = WSP(const bf16_t, WS_BIG + L1_TWAL);
    bf16_t* OUT = WSP(bf16_t, WS_BIG + (dir ? L1_OB : L1_OF));
    float* BSC = WSP(float, WS_BSC) + (size_t)dir * RGL * 16;
    const float* mu = KIN(24);
    bf16x8 wfr[2][2];
    {
        const int wv = tid >> 6, fr0 = tid & 15, fq0 = (tid & 63) >> 4; const float* wsrc = (wv >> 2) ? KIN(28) : KIN(26);
#pragma unroll
        for (int q2 = 0; q2 < 2; ++q2)
#pragma unroll
            for (int k = 0; k < 2; ++k) { const int n = ((wv & 1) * 2 + q2) * 16 + fr0; union { bf16x8 v; unsigned u[4]; } tw;
#pragma unroll
                for (int e = 0; e < 4; ++e) { const int c0 = k * 32 + fq0 * 8 + 2 * e;
                    tw.u[e] = pack2(wsrc[((size_t)dir * 64 + c0) * 1024 + h * 64 + n], wsrc[((size_t)dir * 64 + c0 + 1) * 1024 + h * 64 + n]); }
                wfr[q2][k] = tw.v; }
    }
    for (int i = tid; i < 2 * 16 * 40; i += 512) TI[i] = 0;
    for (int i = tid; i < 64 * 40; i += 512) XB[i] = 0;
    for (int i = tid; i < 64 * RW_LP; i += 512) Sb[i] = 0;
    for (int i = tid; i < 16 * 40; i += 512) A21b[i] = 0;
    for (int i = tid; i < 2 * 64 * RW_LP; i += 512) ZVT0[i] = 0;
    if (tid < 64) { const int n = tid;
        CV[0 * 64 + n] = KIN(25)[dir * 1024 + h * 64 + n]; CV[1 * 64 + n] = KIN(27)[dir * 1024 + h * 64 + n];
        CV[2 * 64 + n] = KIN(30)[h * 64 + n]; CV[3 * 64 + n] = KIN(31)[h * 64 + n]; CV[4 * 64 + n] = KIN(32)[h * 64 + n];
        CV[5 * 64 + n] = mu[h * 64 + n]; CV[6 * 64 + n] = mu[1024 + h * 64 + n]; CV[7 * 64 + n] = mu[2048 + h * 64 + n]; }
    f32x4 Sacc[2];
    Sacc[0] = (f32x4){0.f, 0.f, 0.f, 0.f}; Sacc[1] = (f32x4){0.f, 0.f, 0.f, 0.f};
    u32x4 pf[3];
#define RW_PREFETCH(cn, tix) do { const int t0n_ = dir ? scan_t<32>(1, (cn), 31) : (cn) * 32; const int lo_ = t0n_ < CTXL ? 0 : CTXL, hi_ = t0n_ < CTXL ? CTXL : TT; \
        _Pragma("unroll") for (int q = 0; q < 2; ++q) { const int p = (tix) + q * 512; pf[q] = (u32x4){0u, 0u, 0u, 0u}; \
            if (p < 34 * 24) { const int rr = p / 24, c = p % 24, t = t0n_ - 1 + rr; \
                if (t >= lo_ && t < hi_) { const int seg = c >> 3, c8 = c & 7; \
                    const int col = (seg == 0 ? CD_R : seg == 1 ? CD_K : CD_V) + h * 64; \
                    pf[q] = *(const u32x4*)(P + ((size_t)bl * TT + t) * CD_N + col + c8 * 8); } } } \
        { const int i_ = (tix) >> 4, c16 = (tix) & 15; \
          pf[2] = *(const u32x4*)(TWAL + ((size_t)bl * TT + t0n_ + i_) * 256 + (c16 >> 3) * 128 + dir * 64 + (c16 & 7) * 8); } } while (0)
    RW_PREFETCH(0, tid);
    lds_barrier();
    auto step = [&](auto doP_t, auto doD_t, const int ci) __attribute__((always_inline)) {
        constexpr bool doP = decltype(doP_t)::value, doD = decltype(doD_t)::value;
        int tq = tid; asm volatile("" : "+v"(tq));
        const int lane = tq & 63, wid = __builtin_amdgcn_readfirstlane(tq >> 6), fr = lane & 15, fq = lane >> 4, pi = tq >> 4, n4 = (tq & 15) * 4;
        const int cp = ci + 1, pc = ci & 1, pn = cp & 1;
        const int t0 = dir ? scan_t<32>(1, ci, 31) : ci * 32, t0p = dir ? scan_t<32>(1, cp, 31) : cp * 32;
        bf16_t* ZVc = ZVT0 + pc * 64 * RW_LP; bf16_t* ZVn = ZVT0 + pn * 64 * RW_LP;
        const bf16_t* BKhc = BKh0 + pc * 64 * RW_LP; bf16_t* BKhn = BKh0 + pn * 64 * RW_LP;
        const bf16_t* ARBc = ARB0 + pc * 32 * 40; bf16_t* ARBn = ARB0 + pn * 32 * 40;
        const float* PLc = PL0 + pc * 64; float* PLn = PL0 + pn * 64;
        if constexpr (doP) {
#pragma unroll
            for (int q = 0; q < 2; ++q) { const int p = tq + q * 512; if (p < 34 * 24) *(u32x4*)(RAW + (p / 24) * RW_LR + (p % 24) * 8) = pf[q]; }
            { const int i_ = tq >> 4, c16 = tq & 15; *(u32x4*)(((c16 >> 3) ? ALb : TWb) + i_ * RW_LP + (c16 & 7) * 8) = pf[2]; }
        }
        if constexpr (doD) {
            if (wid > 0) for (int rep_ = 0; rep_ < ((RWP & 32) ? 2 : 1); ++rep_) {
#pragma unroll
                for (int q3 = 0; q3 < 3; ++q3) { const int tl = (wid - 1) + 7 * q3;
                    if (tl < 16) {
                        const int which = tl >> 3, tt = (tl >> 2) & 1, vt = tl & 3;
                        const bf16_t* Ak = which ? ARK : AAK; float* Od = which ? YB : RHS;
                        f32x4 acc = (f32x4){0.f, 0.f, 0.f, 0.f};
#pragma unroll
                        for (int k = 0; k < 2; ++k) acc = mma16(ldfrag(AR, RW_LP, which * 32 + tt * 16, k * 32, fr, fq), ldfrag(Sb, RW_LP, vt * 16, k * 32, fr, fq), acc);
                        acc = mma16(ldfrag(Ak, 40, tt * 16, 0, fr, fq), ldfrag(ZVc, RW_LP, vt * 16, 32, fr, fq), acc);
#pragma unroll
                        for (int rr = 0; rr < 4; ++rr) Od[(tt * 16 + fq * 4 + rr) * 64 + vt * 16 + fr] = acc[rr];
                        if (!which) st4bf(RHSb + (vt * 16 + fr) * 40 + tt * 16 + fq * 4, acc);
                    } }
            } else for (int rep_ = 0; rep_ < ((RWP & 1) ? 2 : 1); ++rep_) {
                const float* AB = AABT + ((lane >> 4) & 1) * (16 * 36 + 16);
                float z[16]; f32x4 ca0, ca1, ca2, ca3, cb0, cb1, cb2, cb3;
#pragma unroll
                for (int t = 0; t < 16; ++t) z[t] = (t == (lane & 15)) ? 1.0f : 0.f;
                ca0 = *(const f32x4*)(AB + 0 * 36 + 0); ca1 = *(const f32x4*)(AB + 0 * 36 + 4); ca2 = *(const f32x4*)(AB + 0 * 36 + 8); ca3 = *(const f32x4*)(AB + 0 * 36 + 12);
                cb0 = *(const f32x4*)(AB + 1 * 36 + 0); cb1 = *(const f32x4*)(AB + 1 * 36 + 4); cb2 = *(const f32x4*)(AB + 1 * 36 + 8); cb3 = *(const f32x4*)(AB + 1 * 36 + 12);
                { const float zs = z[0]; z[1] = __builtin_fmaf(ca0[1], zs, z[1]); z[2] = __builtin_fmaf(ca0[2], zs, z[2]); z[3] = __builtin_fmaf(ca0[3], zs, z[3]); z[4] = __builtin_fmaf(ca1[0], zs, z[4]); z[5] = __builtin_fmaf(ca1[1], zs, z[5]); z[6] = __builtin_fmaf(ca1[2], zs, z[6]); z[7] = __builtin_fmaf(ca1[3], zs, z[7]); z[8] = __builtin_fmaf(ca2[0], zs, z[8]); z[9] = __builtin_fmaf(ca2[1], zs, z[9]); z[10] = __builtin_fmaf(ca2[2], zs, z[10]); z[11] = __builtin_fmaf(ca2[3], zs, z[11]); z[12] = __builtin_fmaf(ca3[0], zs, z[12]); z[13] = __builtin_fmaf(ca3[1], zs, z[13]); z[14] = __builtin_fmaf(ca3[2], zs, z[14]); z[15] = __builtin_fmaf(ca3[3], zs, z[15]); }
                asm volatile("" : "+v"(z[1]) :: "memory");
                ca0 = *(const f32x4*)(AB + 2 * 36 + 0); ca1 = *(const f32x4*)(AB + 2 * 36 + 4); ca2 = *(const f32x4*)(AB + 2 * 36 + 8); ca3 = *(const f32x4*)(AB + 2 * 36 + 12);
                { const float zs = z[1]; z[2] = __builtin_fmaf(cb0[2], zs, z[2]); z[3] = __builtin_fmaf(cb0[3], zs, z[3]); z[4] = __builtin_fmaf(cb1[0], zs, z[4]); z[5] = __builtin_fmaf(cb1[1], zs, z[5]); z[6] = __builtin_fmaf(cb1[2], zs, z[6]); z[7] = __builtin_fmaf(cb1[3], zs, z[7]); z[8] = __builtin_fmaf(cb2[0], zs, z[8]); z[9] = __builtin_fmaf(cb2[1], zs, z[9]); z[10] = __builtin_fmaf(cb2[2], zs, z[10]); z[11] = __builtin_fmaf(cb2[3], zs, z[11]); z[12] = __builtin_fmaf(cb3[0], zs, z[12]); z[13] = __builtin_fmaf(cb3[1], zs, z[13]); z[14] = __builtin_fmaf(cb3[2], zs, z[14]); z[15] = __builtin_fmaf(cb3[3], zs, z[15]); }
                asm volatile("" : "+v"(z[2]) :: "memory");
                cb1 = *(const f32x4*)(AB + 3 * 36 + 4); cb2 = *(const f32x4*)(AB + 3 * 36 + 8); cb3 = *(const f32x4*)(AB + 3 * 36 + 12);
                { const float zs = z[2]; z[3] = __builtin_fmaf(ca0[3], zs, z[3]); z[4] = __builtin_fmaf(ca1[0], zs, z[4]); z[5] = __builtin_fmaf(ca1[1], zs, z[5]); z[6] = __builtin_fmaf(ca1[2], zs, z[6]); z[7] = __builtin_fmaf(ca1[3], zs, z[7]); z[8] = __builtin_fmaf(ca2[0], zs, z[8]); z[9] = __builtin_fmaf(ca2[1], zs, z[9]); z[10] = __builtin_fmaf(ca2[2], zs, z[10]); z[11] = __builtin_fmaf(ca2[3], zs, z[11]); z[12] = __builtin_fmaf(ca3[0], zs, z[12]); z[13] = __builtin_fmaf(ca3[1], zs, z[13]); z[14] = __builtin_fmaf(ca3[2], zs, z[14]); z[15] = __builtin_fmaf(ca3[3], zs, z[15]); }
                asm volatile("" : "+v"(z[3]) :: "memory");
                ca1 = *(const f32x4*)(AB + 4 * 36 + 4); ca2 = *(const f32x4*)(AB + 4 * 36 + 8); ca3 = *(const f32x4*)(AB + 4 * 36 + 12);
                { const float zs = z[3]; z[4] = __builtin_fmaf(cb1[0], zs, z[4]); z[5] = __builtin_fmaf(cb1[1], zs, z[5]); z[6] = __builtin_fmaf(cb1[2], zs, z[6]); z[7] = __builtin_fmaf(cb1[3], zs, z[7]); z[8] = __builtin_fmaf(cb2[0], zs, z[8]); z[9] = __builtin_fmaf(cb2[1], zs, z[9]); z[10] = __builtin_fmaf(cb2[2], zs, z[10]); z[11] = __builtin_fmaf(cb2[3], zs, z[11]); z[12] = __builtin_fmaf(cb3[0], zs, z[12]); z[13] = __builtin_fmaf(cb3[1], zs, z[13]); z[14] = __builtin_fmaf(cb3[2], zs, z[14]); z[15] = __builtin_fmaf(cb3[3], zs, z[15]); }
                asm volatile("" : "+v"(z[4]) :: "memory");
                cb1 = *(const f32x4*)(AB + 5 * 36 + 4); cb2 = *(const f32x4*)(AB + 5 * 36 + 8); cb3 = *(const f32x4*)(AB + 5 * 36 + 12);
                { const float zs = z[4]; z[5] = __builtin_fmaf(ca1[1], zs, z[5]); z[6] = __builtin_fmaf(ca1[2], zs, z[6]); z[7] = __builtin_fmaf(ca1[3], zs, z[7]); z[8] = __builtin_fmaf(ca2[0], zs, z[8]); z[9] = __builtin_fmaf(ca2[1], zs, z[9]); z[10] = __builtin_fmaf(ca2[2], zs, z[10]); z[11] = __builtin_fmaf(ca2[3], zs, z[11]); z[12] = __builtin_fmaf(ca3[0], zs, z[12]); z[13] = __builtin_fmaf(ca3[1], zs, z[13]); z[14] = __builtin_fmaf(ca3[2], zs, z[14]); z[15] = __builtin_fmaf(ca3[3], zs, z[15]); }
                asm volatile("" : "+v"(z[5]) :: "memory");
                ca1 = *(const f32x4*)(AB + 6 * 36 + 4); ca2 = *(const f32x4*)(AB + 6 * 36 + 8); ca3 = *(const f32x4*)(AB + 6 * 36 + 12);
                { const float zs = z[5]; z[6] = __builtin_fmaf(cb1[2], zs, z[6]); z[7] = __builtin_fmaf(cb1[3], zs, z[7]); z[8] = __builtin_fmaf(cb2[0], zs, z[8]); z[9] = __builtin_fmaf(cb2[1], zs, z[9]); z[10] = __builtin_fmaf(cb2[2], zs, z[10]); z[11] = __builtin_fmaf(cb2[3], zs, z[11]); z[12] = __builtin_fmaf(cb3[0], zs, z[12]); z[13] = __builtin_fmaf(cb3[1], zs, z[13]); z[14] = __builtin_fmaf(cb3[2], zs, z[14]); z[15] = __builtin_fmaf(cb3[3], zs, z[15]); }
                asm volatile("" : "+v"(z[6]) :: "memory");
                cb2 = *(const f32x4*)(AB + 7 * 36 + 8); cb3 = *(const f32x4*)(AB + 7 * 36 + 12);
                { const float zs = z[6]; z[7] = __builtin_fmaf(ca1[3], zs, z[7]); z[8] = __builtin_fmaf(ca2[0], zs, z[8]); z[9] = __builtin_fmaf(ca2[1], zs, z[9]); z[10] = __builtin_fmaf(ca2[2], zs, z[10]); z[11] = __builtin_fmaf(ca2[3], zs, z[11]); z[12] = __builtin_fmaf(ca3[0], zs, z[12]); z[13] = __builtin_fmaf(ca3[1], zs, z[13]); z[14] = __builtin_fmaf(ca3[2], zs, z[14]); z[15] = __builtin_fmaf(ca3[3], zs, z[15]); }
                asm volatile("" : "+v"(z[7]) :: "memory");
                ca2 = *(const f32x4*)(AB + 8 * 36 + 8); ca3 = *(const f32x4*)(AB + 8 * 36 + 12);
                { const float zs = z[7]; z[8] = __builtin_fmaf(cb2[0], zs, z[8]); z[9] = __builtin_fmaf(cb2[1], zs, z[9]); z[10] = __builtin_fmaf(cb2[2], zs, z[10]); z[11] = __builtin_fmaf(cb2[3], zs, z[11]); z[12] = __builtin_fmaf(cb3[0], zs, z[12]); z[13] = __builtin_fmaf(cb3[1], zs, z[13]); z[14] = __builtin_fmaf(cb3[2], zs, z[14]); z[15] = __builtin_fmaf(cb3[3], zs, z[15]); }
                asm volatile("" : "+v"(z[8]) :: "memory");
                cb2 = *(const f32x4*)(AB + 9 * 36 + 8); cb3 = *(const f32x4*)(AB + 9 * 36 + 12);
                { const float zs = z[8]; z[9] = __builtin_fmaf(ca2[1], zs, z[9]); z[10] = __builtin_fmaf(ca2[2], zs, z[10]); z[11] = __builtin_fmaf(ca2[3], zs, z[11]); z[12] = __builtin_fmaf(ca3[0], zs, z[12]); z[13] = __builtin_fmaf(ca3[1], zs, z[13]); z[14] = __builtin_fmaf(ca3[2], zs, z[14]); z[15] = __builtin_fmaf(ca3[3], zs, z[15]); }
                asm volatile("" : "+v"(z[9]) :: "memory");
                ca2 = *(const f32x4*)(AB + 10 * 36 + 8); ca3 = *(const f32x4*)(AB + 10 * 36 + 12);
                { const float zs = z[9]; z[10] = __builtin_fmaf(cb2[2], zs, z[10]); z[11] = __builtin_fmaf(cb2[3], zs, z[11]); z[12] = __builtin_fmaf(cb3[0], zs, z[12]); z[13] = __builtin_fmaf(cb3[1], zs, z[13]); z[14] = __builtin_fmaf(cb3[2], zs, z[14]); z[15] = __builtin_fmaf(cb3[3], zs, z[15]); }
                asm volatile("" : "+v"(z[10]) :: "memory");
                cb3 = *(const f32x4*)(AB + 11 * 36 + 12);
                { const float zs = z[10]; z[11] = __builtin_fmaf(ca2[3], zs, z[11]); z[12] = __builtin_fmaf(ca3[0], zs, z[12]); z[13] = __builtin_fmaf(ca3[1], zs, z[13]); z[14] = __builtin_fmaf(ca3[2], zs, z[14]); z[15] = __builtin_fmaf(ca3[3], zs, z[15]); }
                asm volatile("" : "+v"(z[11]) :: "memory");
                ca3 = *(const f32x4*)(AB + 12 * 36 + 12);
                { const float zs = z[11]; z[12] = __builtin_fmaf(cb3[0], zs, z[12]); z[13] = __builtin_fmaf(cb3[1], zs, z[13]); z[14] = __builtin_fmaf(cb3[2], zs, z[14]); z[15] = __builtin_fmaf(cb3[3], zs, z[15]); }
                asm volatile("" : "+v"(z[12]) :: "memory");
                cb3 = *(const f32x4*)(AB + 13 * 36 + 12);
                { const float zs = z[12]; z[13] = __builtin_fmaf(ca3[1], zs, z[13]); z[14] = __builtin_fmaf(ca3[2], zs, z[14]); z[15] = __builtin_fmaf(ca3[3], zs, z[15]); }
                asm volatile("" : "+v"(z[13]) :: "memory");
                ca3 = *(const f32x4*)(AB + 14 * 36 + 12);
                { const float zs = z[13]; z[14] = __builtin_fmaf(cb3[2], zs, z[14]); z[15] = __builtin_fmaf(cb3[3], zs, z[15]); }
                asm volatile("" : "+v"(z[14]) :: "memory");
                { const float zs = z[14]; z[15] = __builtin_fmaf(ca3[3], zs, z[15]); }
                asm volatile("" : "+v"(z[15]) :: "memory");
                if (lane < 32) {
#pragma unroll
                    for (int t = 0; t < 16; ++t) TI[(lane >> 4) * 16 * 40 + t * 40 + (lane & 15)] = f2bf(z[t]);
                }
            }
        }
        if constexpr (doP) { if (cp + 1 < NC) RW_PREFETCH(cp + 1, tq); }
        lds_barrier();
        if constexpr (doD) if (wid < 4) {
            f32x4 acc = (f32x4){0.f, 0.f, 0.f, 0.f};
            acc = mma16(ldfrag(TI, 40, 0, 0, fr, fq), ldfrag(RHSb, 40, wid * 16, 0, fr, fq), acc);
            st4bf(ZVc + (wid * 16 + fr) * RW_LP + fq * 4, acc);
        }
        if constexpr (doP) for (int rep_ = 0; rep_ < ((RWP & 64) ? 2 : 1); ++rep_) {
            const int which = wid >> 2, tt = (wid >> 1) & 1;
            const bf16_t* Xa = which ? ALb : TWb; float* Od = which ? ALf : WLf;
#pragma unroll
            for (int q2 = 0; q2 < 2; ++q2) { const int nt = (wid & 1) * 2 + q2;
                f32x4 acc = (f32x4){0.f, 0.f, 0.f, 0.f};
#pragma unroll
                for (int k = 0; k < 2; ++k) acc = mma16(ldfrag(Xa, RW_LP, tt * 16, k * 32, fr, fq), wfr[q2][k], acc);
#pragma unroll
                for (int rr = 0; rr < 4; ++rr) Od[(tt * 16 + fq * 4 + rr) * 64 + nt * 16 + fr] = acc[rr]; }
            const int pp = tq & 31, cg = tq >> 5, jj = dir ? 31 - pp : pp;
            const bf16_t* r1v = RAW + (pp + 1) * RW_LR + 128 + cg * 4;
            const f32x4 muv = *(const f32x4*)(CV + 448 + cg * 4);
            f32x4 v = ld4bf(r1v);
            v = v + muv * ((ld4bf(r1v - RW_LR) + ld4bf(r1v + RW_LR)) * 0.5f - v);
#pragma unroll
            for (int q = 0; q < 4; ++q) ZVn[(cg * 4 + q) * RW_LP + 32 + jj] = f2bf(v[q]);
        }
        lds_barrier();
        if (RWP & 16) { lds_barrier(); lds_barrier(); lds_barrier(); lds_barrier(); lds_barrier(); }
        const int j = dir ? 31 - pi : pi;
        f32x4 r, kd, av, bv, lw, cin;
        f32x4 xacc = (f32x4){0.f, 0.f, 0.f, 0.f};
        if constexpr (doD) {
            xacc = mma16(ldfrag(A21b, 40, 0, 0, fr, fq), ldfrag(ZVc, RW_LP, (wid & 3) * 16, 0, fr, fq), xacc);
#pragma unroll
            for (int rr = 0; rr < 4; ++rr) xacc[rr] += RHS[(16 + fq * 4 + rr) * 64 + (wid & 3) * 16 + fr];
        }
        if constexpr (doP) for (int rep_ = 0; rep_ < ((RWP & 2) ? 2 : 1); ++rep_) {
            const f32x4 w0v = *(const f32x4*)(CV + n4), a0v = *(const f32x4*)(CV + 64 + n4), kkw = *(const f32x4*)(CV + 128 + n4), kaw = *(const f32x4*)(CV + 192 + n4), rkw = *(const f32x4*)(CV + 256 + n4);
            const f32x4 mur = *(const f32x4*)(CV + 320 + n4), muk = *(const f32x4*)(CV + 384 + n4);
            const f32x4 wl = w0v + *(const f32x4*)(WLf + pi * 64 + n4), al = a0v + *(const f32x4*)(ALf + pi * 64 + n4);
            const bf16_t* r1 = RAW + (pi + 1) * RW_LR; const bf16_t* rp = RAW + pi * RW_LR; const bf16_t* rn = RAW + (pi + 2) * RW_LR;
            f32x4 k;
            r = ld4bf(r1 + n4); k = ld4bf(r1 + 64 + n4);
            r = r + mur * ((ld4bf(rp + n4) + ld4bf(rn + n4)) * 0.5f - r);
            k = k + muk * ((ld4bf(rp + 64 + n4) + ld4bf(rn + 64 + n4)) * 0.5f - k);
            f32x4 a, kk = k * kkw;
            float ssq = kk[0] * kk[0] + kk[1] * kk[1] + kk[2] * kk[2] + kk[3] * kk[3];
            ssq = rsum16(ssq);
            kk = kk * __builtin_amdgcn_rsqf(fmaxf(ssq, 1e-24f));
#pragma unroll
            for (int q = 0; q < 4; ++q) { lw[q] = -0.6065306597126334f * sigmoidf_(wl[q]); a[q] = sigmoidf_(al[q]); }
            kd = k * ((a - 1.0f) * kaw + 1.0f);
            float bs = r[0] * kd[0] * rkw[0] + r[1] * kd[1] * rkw[1] + r[2] * kd[2] * rkw[2] + r[3] * kd[3] * rkw[3];
            bs = rsum16(bs);
            av = kk * -1.0f; bv = kk * a;
            f32x4 wt;
#pragma unroll
            for (int q = 0; q < 4; ++q) {
                const float lwq = lw[q];
                const auto e16 = __builtin_amdgcn_permlane16_swap(__builtin_bit_cast(unsigned, lwq), __builtin_bit_cast(unsigned, lwq), false, false);
                const unsigned e16a = e16[0], e16b = e16[1];
                const float y = __builtin_bit_cast(float, e16a) + __builtin_bit_cast(float, e16b);
                const auto e32 = __builtin_amdgcn_permlane32_swap(__builtin_bit_cast(unsigned, y), __builtin_bit_cast(unsigned, y), false, false);
                const unsigned e32a = e32[0], e32b = e32[1];
                wt[q] = __builtin_bit_cast(float, e32a) + __builtin_bit_cast(float, e32b);
                cin[q] = ((fq & 1) ? y : lwq) + ((fq & 2) ? (wt[q] - y) : 0.f);
            }
            if (fq == 0) *(f32x4*)(WT + wid * 64 + n4) = wt;
            const int t = t0p + pi;
            if (t >= CTXL && (tq & 15) == 0) BSC[((size_t)bl * SEQ + (t - CTXL)) * 16 + h] = bs;
        }
        if constexpr (doD) if (wid < 4) st4bf(XB + (wid * 16 + fr) * 40 + fq * 4, xacc);
        lds_barrier();
        if constexpr (doD) if (wid < 4) {
            f32x4 acc = (f32x4){0.f, 0.f, 0.f, 0.f};
            acc = mma16(ldfrag(TI + 16 * 40, 40, 0, 0, fr, fq), ldfrag(XB, 40, wid * 16, 0, fr, fq), acc);
            st4bf(ZVc + (wid * 16 + fr) * RW_LP + 16 + fq * 4, acc);
        }
        if constexpr (doP) for (int rep_ = 0; rep_ < ((RWP & 4) ? 2 : 1); ++rep_) {
            f32x4 pre = (f32x4){0.f, 0.f, 0.f, 0.f}, cle = (f32x4){0.f, 0.f, 0.f, 0.f};
#pragma unroll
            for (int w = 0; w < 8; ++w) { const f32x4 t4 = *(const f32x4*)(WT + w * 64 + n4); cle = cle + t4; if (w < wid) pre = pre + t4; }
            const f32x4 cim = cin + pre;
            const f32x4 clj = dir ? cle - cim + lw : cim;
            const f32x4 clp = dir ? cle - cim : cim - lw;
            f32x4 at, rt, bt, kt, bh, kh;
#pragma unroll
            for (int q = 0; q < 4; ++q) { const float ep = __expf(clp[q]), ej = __expf(clj[q]), ei = __expf(-clj[q]), ee = __expf(cle[q] - clj[q]);
                at[q] = av[q] * ep; rt[q] = r[q] * ej; bt[q] = bv[q] * ei; kt[q] = kd[q] * ei; bh[q] = bv[q] * ee; kh[q] = kd[q] * ee; }
            if (tq < 16) { f32x4 e;
#pragma unroll
                for (int q = 0; q < 4; ++q) e[q] = __expf(cle[q]);
                *(f32x4*)(PLn + n4) = e; }
            st4bf(AR + j * RW_LP + n4, at); st4bf(AR + (32 + j) * RW_LP + n4, rt);
            st4bf(BK + j * RW_LP + n4, bt); st4bf(BK + (32 + j) * RW_LP + n4, kt);
            const int cbh = (((j >> 3) ^ (tq & 7)) << 3) | (j & 7), ckh = ((((j >> 3) + 4) ^ (tq & 7)) << 3) | (j & 7);
#pragma unroll
            for (int q = 0; q < 4; ++q) { BKhn[(n4 + q) * RW_LP + cbh] = f2bf(bh[q]); BKhn[(n4 + q) * RW_LP + ckh] = f2bf(kh[q]); }
        }
        lds_barrier();
        if constexpr (doD) {
            const int nt = wid >> 1;
            const f32x4 pl = *(const f32x4*)(PLc + nt * 16 + fq * 4);
#pragma unroll
            for (int q2 = 0; q2 < 2; ++q2) {
                const int vt = (wid & 1) * 2 + q2;
                Sacc[q2] = Sacc[q2] * pl;
#pragma unroll
                for (int k = 0; k < 2; ++k) Sacc[q2] = mma16(*(const bf16x8*)(BKhc + (nt * 16 + fr) * RW_LP + (((k * 4 + fq) ^ (((nt & 1) << 2) + (fr >> 2))) << 3)), ldfrag(ZVc, RW_LP, vt * 16, k * 32, fr, fq), Sacc[q2]);
                st4bf(Sb + (vt * 16 + fr) * RW_LP + nt * 16 + fq * 4, Sacc[q2]);
            }
            if (t0 >= CTXL) {
                const int vt = wid >> 1, tt = wid & 1;
                f32x4 acc = (f32x4){0.f, 0.f, 0.f, 0.f};
                acc = mma16(ldfrag(ZVc, RW_LP, vt * 16, 0, fr, fq), ldfrag(ARBc, 40, tt * 16, 0, fr, fq), acc);
                const int t = tt * 16 + fr, v0 = vt * 16 + fq * 4;
#pragma unroll
                for (int rr = 0; rr < 4; ++rr) acc[rr] += YB[t * 64 + v0 + rr];
                const int tn = scan_t<32>(dir, ci, t);
                st4bf(OUT + ((size_t)bl * SEQ + (tn - CTXL)) * 1024 + h * 64 + v0, acc);
            }
        }
        if constexpr (doP) for (int rep_ = 0; rep_ < ((RWP & 8) ? 2 : 1); ++rep_) {
            const int ti = wid >> 1;
#pragma unroll
            for (int q2 = 0; q2 < 2; ++q2) {
                const int si = (wid & 1) * 2 + q2;
                f32x4 acc = (f32x4){0.f, 0.f, 0.f, 0.f};
#pragma unroll
                for (int k = 0; k < 2; ++k) acc = mma16(ldfrag(AR, RW_LP, ti * 16, k * 32, fr, fq), ldfrag(BK, RW_LP, si * 16, k * 32, fr, fq), acc);
                const int s = (si & 1) * 16 + fr;
                const bool incl = ti >= 2, kcols = si >= 2;
                bf16_t* dstb = kcols ? (incl ? ARK : AAK) : ARBn;
#pragma unroll
                for (int rr = 0; rr < 4; ++rr) { const int t = (ti & 1) * 16 + fq * 4 + rr;
                    const float val = (incl ? (s <= t) : (s < t)) ? acc[rr] : 0.f;
                    if (kcols || incl) dstb[t * 40 + s] = f2bf(val);
                    else { AABT[s * 36 + t] = val; if (ti == 1 && si == 0) A21b[(t - 16) * 40 + s] = f2bf(val); } }
            }
        }
        lds_barrier();
    };
    step(TrueT{}, FalseT{}, -1);
#pragma unroll 1
    for (int ci = 0; ci < NC - 1; ++ci) step(TrueT{}, TrueT{}, ci);
    step(FalseT{}, TrueT{}, NC - 1);
#undef RW_PREFETCH
}

__device__ __forceinline__ void phase_mix_cd(const KP& kp, unsigned char* lds, int which) {
    if (which & 1) for (int u = obid(); u < 256; u += gridDim.x) { rwkv_unit(kp, lds, u >> 5, (u >> 1) & 15, u & 1); __syncthreads(); }
    if (which & 2) for (int u = obid(); u < 512; u += gridDim.x) { attn_unit(kp, lds, u >> 6, (u >> 3) & 7, u & 7); __syncthreads(); }
}

struct EpiFinCD {
    const bf16_t* OF; const bf16_t* OB; const bf16_t* P; const float* BSC; const float* ln; const float* mu; bf16_t* AOUT;
    __device__ __forceinline__ void operator()(const f32x4 (&acc)[4][4], int rb, int cb, int fr, int fq) const {
        const int head = cb >> 6;
#pragma unroll
        for (int i = 0; i < 4; ++i) { const int lr = rb + i * 16 + fr, s = lr & 2047;
            const size_t prow = (size_t)(lr >> 11) * TT + CTXL + s;
            f32x4 o[4]; float ss = 0.f;
#pragma unroll
            for (int j = 0; j < 4; ++j) { const int col = cb + j * 16 + fq * 4;
                o[j] = ld4bf(OF + (size_t)lr * 1024 + col) + ld4bf(OB + (size_t)lr * 1024 + col);
                ss += o[j][0] * o[j][0] + o[j][1] * o[j][1] + o[j][2] * o[j][2] + o[j][3] * o[j][3]; }
            ss += __shfl_xor(ss, 16); ss += __shfl_xor(ss, 32);
            const float rstd = rsqrtf(ss * (1.0f / 64.0f) + EPS);
            const float bon = BSC[(size_t)lr * 16 + head] + BSC[(size_t)RGL * 16 + (size_t)lr * 16 + head];
#pragma unroll
            for (int j = 0; j < 4; ++j) { const int col = cb + j * 16 + fq * 4;
                const bf16_t* pv = P + prow * CD_N + CD_V + col;
                const f32x4 v = ld4bf(pv);
                const f32x4 vp = s > 0 ? ld4bf(pv - CD_N) : (f32x4){0.f, 0.f, 0.f, 0.f};
                const f32x4 vn = s < SEQ - 1 ? ld4bf(pv + CD_N) : (f32x4){0.f, 0.f, 0.f, 0.f};
                const f32x4 vl = v + *(const f32x4*)(mu + 2048 + col) * ((vp + vn) * 0.5f - v);
                const f32x4 y = o[j] * rstd * *(const f32x4*)(ln + col) + vl * bon;
                st4bf(AOUT + (size_t)lr * 1536 + 512 + col, y * acc[i][j]); }
        }
    }
};
PHASE_FN void phase_fin_cd(const KP& kp, unsigned char* lds) {
    GA ga{WSP(const bf16_t, WS_SG), nullptr, 128, 0, 128, nullptr, RGL, 0, 0};
    EpiFinCD ep{WSP(const bf16_t, WS_BIG + L1_OF), WSP(const bf16_t, WS_BIG + L1_OB), WSP(const bf16_t, WS_BIG + L1_P), WSP(const float, WS_BSC), KIN(33), KIN(24), WSP(bf16_t, WS_BIG + L1_AOUT)};
    for (int u = obid(); u < (RGL / 256) * 8; u += gridDim.x) gemm_tile(lds, ga, WSP(const bf16_t, WS_WMIX + WM_G2), 128, u >> 3, u & 7, ep);
}
PHASE_FN void phase_gemm_out_cd(const KP& kp, unsigned char* lds) {
    pg8::Gemm g{WSP(const bf16_t, WS_BIG + L1_AOUT), WSP(const bf16_t, WS_WMIX + WM_CD_OUT), RGL, 1024, 1536, nullptr, 0x7fffffff};
    pg8::StaticOrder S; S.init(RGL, 1024, (int)gridDim.x, obid());
    pg8::EpiBfG E{WSP(bf16_t, WS_BIG + L1_U), 1024, 1024, 0x7fffffff, 1.0f};
    pg8::gemm_phase<pg8::EpiBfG, pg8::StaticOrder, false>((PG8_LAS unsigned char*)lds, g, S, E, nullptr);
    __syncthreads();
}

__device__ __attribute__((noinline)) void grid_sync(unsigned* barw, unsigned x, volatile LAS unsigned* st) { XcdBarrier b; b.bar = barw; b.x = x; b.st = st; xcd_barrier(b); }
constexpr int N_PHASES = 36;
__global__ void __launch_bounds__(512, 2) fwd_kernel(KP kparg) {
    extern __shared__ __attribute__((aligned(16))) unsigned char lds[];
    const int lo = kparg.ph_lo, hi = kparg.ph_hi;
    const KP& kp = kparg;
    volatile LAS unsigned* xbst = (volatile LAS unsigned*)(LAS unsigned char*)(lds + LDS_BYTES - 16);
    if (threadIdx.x == 0) { xbst[0] = 0u; xbst[1] = 0u; }
    __syncthreads();
    XcdBarrier bar; bar.bar = (unsigned*)kparg.ws; bar.x = 0; bar.st = xbst;
    if (hi - lo > 1) bar = xcd_barrier_post((unsigned*)kparg.ws, xbst);
#define IN(k) (lo <= (k) && (k) < hi)
#define SEAM(k) do { if (IN(k) && IN((k) + 1)) { grid_sync((unsigned*)kp.ws, bar.x, xbst); if (PROBE_DUP & 512) grid_sync((unsigned*)kp.ws, bar.x, xbst); } } while (0)
#define PHASE(...) do { if (IN(ph)) { __VA_ARGS__ } SEAM(ph); ++ph; } while (0)
    int ph = 0;
    PHASE(phase_mod(kp, lds); __syncthreads(); phase_conv_ab(kp, lds); if (PROBE_DUP & 32) { __syncthreads(); phase_mod(kp, lds); __syncthreads(); phase_conv_ab(kp, lds); });
#pragma unroll
    for (int g = 0; g < NG; ++g) {
        if (g == 0) PHASE(phase_u(kp, 0, 0, obid(), (int)gridDim.x, false););
        PHASE(phase_gemm_in(kp, lds, 0, g); if (PROBE_DUP & 8) phase_gemm_in(kp, lds, 0, g););
        PHASE(phase_xconv(kp); if (PROBE_DUP & 2048) phase_xconv(kp););
        PHASE(phase_scan_ab(kp, lds); if (PROBE_DUP & 1) { __syncthreads(); phase_scan_ab(kp, lds); });
        PHASE(phase_fin_ab(kp););
        PHASE(phase_gemm_out_ab(kp, lds, g););
        PHASE(phase_r(kp, lds, 0, g););
    }
    PHASE(phase_moe_gather(kp, 0); phase_conv_cd(kp, lds););
    PHASE(phase_moe_gemm(kp, lds, 0, false); if (PROBE_DUP & 16) { __syncthreads(); phase_moe_gemm(kp, lds, 0, false); });
    PHASE(phase_moe_gemm(kp, lds, 0, true); if (PROBE_DUP & 16) { __syncthreads(); phase_moe_gemm(kp, lds, 0, true); });
    PHASE(phase_combine(kp, 0););
#pragma unroll
    for (int g = 0; g < NG; ++g) {
        PHASE(phase_gemm_in(kp, lds, 1, g); if (PROBE_DUP & 8) phase_gemm_in(kp, lds, 1, g););
        PHASE(phase_prep_cd(kp););
        PHASE(phase_upproj(kp, lds); if (PROBE_DUP & 4096) phase_upproj(kp, lds););
        PHASE(phase_mix_cd(kp, lds, 3); if (PROBE_DUP & 2) { __syncthreads(); phase_mix_cd(kp, lds, 1); } if (PROBE_DUP & 4) { __syncthreads(); phase_mix_cd(kp, lds, 2); });
        PHASE(phase_fin_cd(kp, lds); if (PROBE_DUP & 4096) phase_fin_cd(kp, lds););
        PHASE(phase_gemm_out_cd(kp, lds); if (PROBE_DUP & 256) phase_gemm_out_cd(kp, lds););
        PHASE(phase_r(kp, lds, 1, g););
    }
    PHASE(phase_moe_gather(kp, 1); phase_conv_moe(kp, lds, 1, obid(), (int)gridDim.x); if (PROBE_DUP & 64) { phase_conv_moe(kp, lds, 1, obid(), (int)gridDim.x); phase_conv_moe(kp, lds, 1, obid(), (int)gridDim.x); });
    PHASE(phase_moe_gemm(kp, lds, 1, false););
    PHASE(phase_moe_gemm(kp, lds, 1, true););
    PHASE(phase_combine(kp, 1););
#undef PHASE
#undef IN
#undef SEAM
}

extern "C" void kernel_launch(void* const* d_in, const int* in_sizes, int n_in, void* d_out, int out_size, void* d_ws, size_t ws_size, hipStream_t stream) {
    static int grid = 0;
    if (grid == 0) {
        if (n_in != 42 || out_size != NLAT * D || ws_size < WS_NEED) { fprintf(stderr, "kernel_launch: unexpected shapes: n_in %d out %d ws %zu (need %zu)\n", n_in, out_size, ws_size, (size_t)WS_NEED); grid = -1; return; }
        int dev = 0, cus = 0, per_cu = 0;
        if (hipGetDevice(&dev) != hipSuccess || hipDeviceGetAttribute(&cus, hipDeviceAttributeMultiprocessorCount, dev) != hipSuccess) { grid = -1; return; }
        if (hipFuncSetAttribute((const void*)fwd_kernel, hipFuncAttributeMaxDynamicSharedMemorySize, LDS_BYTES) != hipSuccess) { fprintf(stderr, "kernel_launch: hipFuncSetAttribute failed\n"); grid = -1; return; }
        if (hipOccupancyMaxActiveBlocksPerMultiprocessor(&per_cu, (const void*)fwd_kernel, 512, LDS_BYTES) != hipSuccess || per_cu < 1) { fprintf(stderr, "kernel_launch: occupancy query says %d blocks per CU\n", per_cu); grid = -1; (void)hipGetLastError(); return; }
        grid = cus;
    }
    if (grid < 0) return;
    (void)hipMemsetAsync(d_ws, 0, CTL_BYTES, stream);
    KP kp{};
    for (int i = 0; i < 42; ++i) kp.in[i] = (const float*)d_in[i];
    kp.out = (float*)d_out; kp.ws = (unsigned char*)d_ws;
#if N_LAUNCH_MODE == 1
    kp.ph_lo = 0; kp.ph_hi = N_PHASES;
    hipLaunchKernelGGL(fwd_kernel, dim3(grid), dim3(512), LDS_BYTES, stream, kp);
#else
    for (int p = 0; p < N_PHASES; ++p) { kp.ph_lo = p; kp.ph_hi = p + 1; hipLaunchKernelGGL(fwd_kernel, dim3(grid), dim3(512), LDS_BYTES, stream, kp); }
#endif
}
```

```cpp
#include <hip/hip_runtime.h>
#include <stdint.h>
#include <stdio.h>

typedef unsigned short bf16_t;
typedef short bf16x8 __attribute__((ext_vector_type(8)));
typedef float f32x4 __attribute__((ext_vector_type(4)));
typedef float f32x2 __attribute__((ext_vector_type(2)));
typedef unsigned u32x4 __attribute__((ext_vector_type(4)));
typedef unsigned u32x2 __attribute__((ext_vector_type(2)));

#ifndef RWP
#define RWP 0
#endif
#ifndef PROBE_DUP
#define PROBE_DUP 0
#endif
#ifndef N_LAUNCH_MODE
#define N_LAUNCH_MODE 1
#endif

constexpr int NB = 16, SEQ = 2048, CTXL = 256, TT = 2304, D = 1024;
constexpr int NTOK = NB * TT, NLAT = NB * SEQ;
constexpr int NG = 2, BG = NB / NG, RG = BG * TT, RGL = BG * SEQ;
constexpr float EPS = 1e-6f;
constexpr int AB_N = 5424, AB_NPAD = 5632, AB_Q = 0, AB_K = 512, AB_V = 1024, AB_OG = 2048, AB_IG = 3072, AB_FG = 3080, AB_Z = 3088, AB_XBC = 4112, AB_DT = 5392;
constexpr int CD_N = 4128, CD_NPAD = 4352, CD_M0 = 0, CD_M1 = 384, CD_KR = 640, CD_R = 672, CD_K = 1696, CD_V = 2720, CD_WL = 3744, CD_AL = 3872, CD_GL = 4000;
constexpr int CD_RW0 = 672;

constexpr size_t CTL_BYTES = 32768;
constexpr size_t CTL_CNT = 16384;
constexpr size_t WS_MODV = CTL_BYTES;
constexpr size_t WS_HC   = WS_MODV + (size_t)2 * 17 * 6144 * 4;
constexpr size_t WS_TOKE = WS_HC + (size_t)NB * CTXL * D * 4;
constexpr size_t WS_TOKP = WS_TOKE + (size_t)NTOK * 2 * 4;
constexpr size_t WS_TOKW = WS_TOKP + (size_t)NTOK * 2 * 4;
constexpr size_t WS_LIST = WS_TOKW + (size_t)NTOK * 2 * 4;
constexpr size_t WS_BSC  = WS_LIST + (size_t)16 * NTOK * 4;
constexpr size_t WS_SG   = WS_BSC + (size_t)2 * RGL * 16 * 4;
constexpr size_t WS_WMIX = WS_SG + (size_t)RGL * 128 * 2;
constexpr size_t WMIX_BYTES = (size_t)16 << 20;
constexpr size_t WS_V    = WS_WMIX + WMIX_BYTES;
constexpr size_t WS_BIG  = WS_V + (size_t)NTOK * D * 2;
constexpr size_t WM_AB_IN = 0, WM_AB_OUT = (size_t)AB_NPAD * 1024 * 2;
constexpr size_t WM_CD_IN = 0, WM_CD_OUT = (size_t)CD_NPAD * 1024 * 2, WM_UQ = WM_CD_OUT + (size_t)1024 * 1536 * 2, WM_UKV = WM_UQ + (size_t)768 * 384 * 2, WM_G2 = WM_UKV + (size_t)1024 * 256 * 2;
static_assert(WM_AB_OUT + (size_t)1024 * 2048 * 2 <= WMIX_BYTES, "wmix ab");
static_assert(WM_G2 + (size_t)1024 * 128 * 2 <= WMIX_BYTES, "wmix cd");
constexpr size_t SZ_RG1K = (size_t)RG * 1024 * 2, SZ_RGL1K = (size_t)RGL * 1024 * 2;
constexpr size_t L0_P = 0, L0_AO = (size_t)RG * AB_N * 2  , L0_HB = L0_AO + 2 * SZ_RG1K, L0_YB = L0_HB + SZ_RG1K, L0_U = L0_YB + SZ_RG1K, L0_END = L0_U + SZ_RG1K;
constexpr size_t L1_P = 0, L1_Q = (size_t)RG * CD_N * 2, L1_KV = L1_Q + (size_t)RGL * 768 * 2, L1_OF = L1_KV + SZ_RG1K, L1_OB = L1_OF + SZ_RGL1K, L1_AOUT = L1_OB + SZ_RGL1K, L1_U = L1_AOUT + (size_t)RGL * 1536 * 2, L1_TWAL = L1_U + SZ_RG1K  , L1_END = L1_TWAL + (size_t)RG * 256 * 2;
constexpr int MOE_PADROWS = 16 * 256;
constexpr size_t MO_WUP = 0, MO_WDN = (size_t)17 * 1024 * 1024 * 2, MO_HID = MO_WDN + (size_t)17 * 1024 * 512 * 2;
constexpr size_t MO_XG = MO_HID + (size_t)(3 * NTOK + MOE_PADROWS) * 512 * 2;
constexpr size_t MO_CON = MO_XG, MO_END = MO_CON + (size_t)(3 * NTOK + MOE_PADROWS) * 1024 * 2;
constexpr size_t BIG_BYTES = MO_END > L0_END ? (MO_END > L1_END ? MO_END : L1_END) : (L0_END > L1_END ? L0_END : L1_END);
constexpr size_t WS_NEED = WS_BIG + BIG_BYTES;

constexpr int LDS_BYTES = 151552;

__device__ __forceinline__ float bf2f(unsigned short h) { return __uint_as_float(((unsigned)h) << 16); }
typedef __bf16 bf16v2_t __attribute__((ext_vector_type(2)));
__device__ __forceinline__ unsigned pack2(float a, float b) { const bf16v2_t h = __builtin_convertvector((f32x2){a, b}, bf16v2_t); return __builtin_bit_cast(unsigned, h); }
__device__ __forceinline__ unsigned short f2bf(float f) { const __bf16 h = (__bf16)f; return __builtin_bit_cast(unsigned short, h); }
__device__ __forceinline__ float lo2f(unsigned w) { return __uint_as_float(w << 16); }
__device__ __forceinline__ float hi2f(unsigned w) { return __uint_as_float(w & 0xffff0000u); }

template <int CTRL> __device__ __forceinline__ float dpp_mov(float x) { return __builtin_bit_cast(float, __builtin_amdgcn_update_dpp(0, __builtin_bit_cast(int, x), CTRL, 0xf, 0xf, true)); }
__device__ __forceinline__ float rsum16(float x) { x += dpp_mov<0xB1>(x); x += dpp_mov<0x4E>(x); x += dpp_mov<0x124>(x); x += dpp_mov<0x128>(x); return x; }
template <int CTRL, int RM> __device__ __forceinline__ float dpp_upd(float old, float x) { return __builtin_bit_cast(float, __builtin_amdgcn_update_dpp(__builtin_bit_cast(int, old), __builtin_bit_cast(int, x), CTRL, RM, 0xf, false)); }
__device__ __forceinline__ float wscan_add(float x) { x += dpp_upd<0x111, 0xf>(0.f, x); x += dpp_upd<0x112, 0xf>(0.f, x); x += dpp_upd<0x114, 0xf>(0.f, x); x += dpp_upd<0x118, 0xf>(0.f, x);
    x += dpp_upd<0x142, 0xa>(0.f, x); x += dpp_upd<0x143, 0xc>(0.f, x); return x; }
__device__ __forceinline__ float wscan_max(float x) { const float ni = -__builtin_inff();
    x = fmaxf(x, dpp_upd<0x111, 0xf>(ni, x)); x = fmaxf(x, dpp_upd<0x112, 0xf>(ni, x)); x = fmaxf(x, dpp_upd<0x114, 0xf>(ni, x)); x = fmaxf(x, dpp_upd<0x118, 0xf>(ni, x));
    x = fmaxf(x, dpp_upd<0x142, 0xa>(ni, x)); x = fmaxf(x, dpp_upd<0x143, 0xc>(ni, x)); return x; }
__device__ __forceinline__ float lane63(float x) { return __builtin_bit_cast(float, __builtin_amdgcn_readlane(__builtin_bit_cast(int, x), 63)); }
__device__ __forceinline__ float xmax_rows(float x) {
    const auto a = __builtin_amdgcn_permlane16_swap(__builtin_bit_cast(unsigned, x), __builtin_bit_cast(unsigned, x), false, false);
    const unsigned a0 = a[0], a1 = a[1]; x = fmaxf(__builtin_bit_cast(float, a0), __builtin_bit_cast(float, a1));
    const auto b = __builtin_amdgcn_permlane32_swap(__builtin_bit_cast(unsigned, x), __builtin_bit_cast(unsigned, x), false, false);
    const unsigned b0 = b[0], b1 = b[1]; return fmaxf(__builtin_bit_cast(float, b0), __builtin_bit_cast(float, b1)); }
__device__ __forceinline__ float wsum(float v) {
    v = rsum16(v);
    const auto a = __builtin_amdgcn_permlane16_swap(__builtin_bit_cast(unsigned, v), __builtin_bit_cast(unsigned, v), false, false);
    const unsigned a0 = a[0], a1 = a[1]; v = __builtin_bit_cast(float, a0) + __builtin_bit_cast(float, a1);
    const auto b = __builtin_amdgcn_permlane32_swap(__builtin_bit_cast(unsigned, v), __builtin_bit_cast(unsigned, v), false, false);
    const unsigned b0 = b[0], b1 = b[1]; return __builtin_bit_cast(float, b0) + __builtin_bit_cast(float, b1); }
__device__ __forceinline__ float frcp_(float x) { return __builtin_amdgcn_rcpf(x); }
__device__ __forceinline__ float sigmoidf_(float x) { return __builtin_amdgcn_rcpf(1.0f + __expf(-x)); }
__device__ __forceinline__ float siluf_(float x) { return x * __builtin_amdgcn_rcpf(1.0f + __expf(-x)); }
__device__ __forceinline__ float softplusf_(float x) { return fmaxf(x, 0.0f) + __logf(1.0f + __expf(-fabsf(x))); }
__device__ __forceinline__ float logsigmoidf_(float x) { return fminf(x, 0.0f) - __logf(1.0f + __expf(-fabsf(x))); }
__device__ __forceinline__ float tanhf_(float x) { return 1.0f - 2.0f * __builtin_amdgcn_rcpf(__expf(2.0f * x) + 1.0f); }
__device__ __forceinline__ f32x4 mma16(bf16x8 a, bf16x8 b, f32x4 c) { return __builtin_amdgcn_mfma_f32_16x16x32_bf16(a, b, c, 0, 0, 0); }
__device__ __forceinline__ bf16x8 ldfrag(const bf16_t* base, int ld, int row0, int k0, int fr, int fq) { return *(const bf16x8*)(base + (row0 + fr) * ld + k0 + fq * 8); }
__device__ __forceinline__ void st4bf(bf16_t* p, f32x4 v) { u32x2 w; w.x = pack2(v[0], v[1]); w.y = pack2(v[2], v[3]); *(u32x2*)p = w; }
__device__ __forceinline__ f32x4 ld4bf(const bf16_t* p) { u32x2 w = *(const u32x2*)p; return (f32x4){lo2f(w.x), hi2f(w.x), lo2f(w.y), hi2f(w.y)}; }

#define PHASE_FN __device__ __forceinline__
__device__ __forceinline__ int otid() { int t = threadIdx.x; asm volatile("" : "+v"(t)); return t; }
__device__ __forceinline__ int obid() { int t = blockIdx.x; asm volatile("" : "+s"(t)); return t; }
template <class T> __device__ __forceinline__ T* as_global(T* p) { return p; }
__device__ __forceinline__ void lds_barrier() { asm volatile("s_waitcnt lgkmcnt(0)" ::: "memory"); __builtin_amdgcn_s_barrier(); asm volatile("" ::: "memory"); }
constexpr float W8_SCALE = 64.0f, W8_INV = 1.0f / 64.0f;
__device__ __forceinline__ unsigned pack4f8(float a, float b, float c, float d) { unsigned r = 0; r = __builtin_amdgcn_cvt_pk_fp8_f32(a, b, r, false); r = __builtin_amdgcn_cvt_pk_fp8_f32(c, d, r, true); return r; }
__device__ __forceinline__ void st4f8(unsigned char* p, f32x4 v) { *(unsigned*)p = pack4f8(v[0], v[1], v[2], v[3]); }
struct KP { const float* in[42]; float* out; unsigned char* ws; int ph_lo, ph_hi; };

#define XB_TMO      128
#define XB_XCNT(j)  (256  + 64 * (j))
#define XB_XSUB(j)  (1280 + 64 * (j))
#define XB_XGEN(j)  (2304 + 64 * (j))
#define XB_TOP      3328
#define XB_TOPGEN   3392
#define XCD_BAR_WORDS 3456
#define XB_SPIN_CAP (1u << 18)
#define LAS __attribute__((address_space(3)))

__device__ __forceinline__ unsigned xb_ld(unsigned* p)              { return __hip_atomic_load(p, __ATOMIC_RELAXED, __HIP_MEMORY_SCOPE_AGENT); }
__device__ __forceinline__ unsigned xb_add(unsigned* p, unsigned v) { return __hip_atomic_fetch_add(p, v, __ATOMIC_RELAXED, __HIP_MEMORY_SCOPE_AGENT); }
__device__ __forceinline__ unsigned xb_xcc_id() { return (unsigned)__builtin_amdgcn_s_getreg((3 << 11) | 20) & 0xFu; }
#define XB_SPIN(cond, bar) do { unsigned _sp = 0; while (cond) { __builtin_amdgcn_s_sleep(1); \
    if ((++_sp & 255u) == 0u) { if (xb_ld(&(bar)[XB_TMO])) break; if (_sp > XB_SPIN_CAP) { atomicAdd(&(bar)[XB_TMO], 1u); break; } } } } while (0)

struct XcdBarrier {
    unsigned* bar; unsigned x;
    volatile LAS unsigned* st;
};

__device__ __forceinline__ XcdBarrier xcd_barrier_post(unsigned* bar, volatile LAS unsigned* st) {
    XcdBarrier b; b.bar = bar; b.x = xb_xcc_id(); b.st = st;
    if (threadIdx.x == 0) (void)xb_add(&bar[XB_XCNT(b.x)], 1u);
    return b;
}
__device__ __forceinline__ void xcd_barrier_complete(unsigned* bar, unsigned x, unsigned& nloc, unsigned& nx) {
    const unsigned G = gridDim.x * gridDim.y * gridDim.z;
    unsigned sum, cnt, mine, sp = 0u;
    for (;;) {
        sum = 0u; cnt = 0u; mine = 0u;
#pragma unroll
        for (unsigned j = 0; j < 16; ++j) { const unsigned c = xb_ld(&bar[XB_XCNT(j)]); sum += c; cnt += (c > 0u) ? 1u : 0u; mine = (j == x) ? c : mine; }
        if (sum == G) break;
        __builtin_amdgcn_s_sleep(1);
        if ((++sp & 255u) == 0u) { if (xb_ld(&bar[XB_TMO])) break; if (sp > XB_SPIN_CAP) { atomicAdd(&bar[XB_TMO], 1u); break; } }
    }
    nloc = mine > 0u ? mine : 1u; nx = cnt > 0u ? cnt : 1u;
}

__device__ __forceinline__ void xcd_barrier(const XcdBarrier& b) {
    asm volatile("s_waitcnt vmcnt(0)" ::: "memory");
    __syncthreads();
    if (threadIdx.x == 0) {
        unsigned* bar = b.bar;
        __builtin_amdgcn_s_waitcnt(0);
        unsigned nloc = b.st[0], nx = b.st[1];
        if (nloc == 0u) { xcd_barrier_complete(bar, b.x, nloc, nx); b.st[0] = nloc; b.st[1] = nx; }
        const unsigned old = xb_add(&bar[XB_XSUB(b.x)], 1u);
        const unsigned gen = old / nloc;
        if (old + 1u == (gen + 1u) * nloc) {
            __builtin_amdgcn_fence(__ATOMIC_RELEASE, "agent");
            asm volatile("s_waitcnt vmcnt(0)" ::: "memory");
            const unsigned og = xb_add(&bar[XB_TOP], 1u);
            const unsigned tg = og / nx;
            if (og + 1u == (tg + 1u) * nx) xb_add(&bar[XB_TOPGEN], 1u);
            else XB_SPIN(xb_ld(&bar[XB_TOPGEN]) == tg, bar);
            __builtin_amdgcn_fence(__ATOMIC_ACQUIRE, "agent");
            xb_add(&bar[XB_XGEN(b.x)], 1u);
            asm volatile("s_waitcnt vmcnt(0)" ::: "memory");
        } else {
            XB_SPIN(xb_ld(&bar[XB_XGEN(b.x)]) == gen, bar);
            __builtin_amdgcn_fence(__ATOMIC_ACQUIRE, "agent");
            asm volatile("s_waitcnt vmcnt(0)" ::: "memory");
        }
    }
    __syncthreads();
}
struct GA {
    const bf16_t* a0; const bf16_t* a1;
    int ld0, ld1, ksplit;
    const int* list;
    int nrows;
    int mode;
    int row0;
};
constexpr int G_LDT = 40;
constexpr int GEMM_LDS = (2 * 256 * G_LDT + 2 * 128 * G_LDT) * 2;

template <class Epi>
__device__ __forceinline__ void gemm_tile(unsigned char* lds, const GA& ga, const bf16_t* __restrict__ Bt, int K, int mt, int nt, const Epi& epi) {
    const int tid = otid(), lane = tid & 63, wid = __builtin_amdgcn_readfirstlane(tid >> 6), wm = wid >> 1, wn = wid & 1, fr = lane & 15, fq = lane >> 4;
    bf16_t* sA = (bf16_t*)lds;
    bf16_t* sB = sA + 2 * 256 * G_LDT;
    const int kp = tid & 3;
    const int r0 = tid >> 2, r1 = r0 + 128;
    int s0, s1;
    {
        int lr = mt * 256 + r0; if (lr >= ga.nrows) lr = 0;
        s0 = ga.list ? ga.list[lr] : (ga.mode == 1 ? (lr >> 11) * TT + CTXL + (lr & 2047) : ga.row0 + lr);
        lr = mt * 256 + r1; if (lr >= ga.nrows) lr = 0;
        s1 = ga.list ? ga.list[lr] : (ga.mode == 1 ? (lr >> 11) * TT + CTXL + (lr & 2047) : ga.row0 + lr);
    }
    const bf16_t* pa00 = ga.a0 + (size_t)s0 * ga.ld0 + kp * 8;
    const bf16_t* pa01 = ga.a0 + (size_t)s1 * ga.ld0 + kp * 8;
    const bf16_t* pa10 = ga.a1 ? ga.a1 + (size_t)s0 * ga.ld1 + kp * 8 : pa00;
    const bf16_t* pa11 = ga.a1 ? ga.a1 + (size_t)s1 * ga.ld1 + kp * 8 : pa01;
    const bf16_t* pb = Bt + (size_t)(nt * 128 + r0) * K + kp * 8;
    const int ksplit = ga.ksplit;
    f32x4 acc[4][4];
#pragma unroll
    for (int i = 0; i < 4; ++i)
#pragma unroll
        for (int j = 0; j < 4; ++j) acc[i][j] = (f32x4){0.f, 0.f, 0.f, 0.f};
    const int nk = K >> 5;
    u32x4 ra0, ra1, rb;
    {
        ra0 = *(const u32x4*)(pa00); ra1 = *(const u32x4*)(pa01); rb = *(const u32x4*)(pb);
        if (0 >= ksplit) { ra0 = *(const u32x4*)(pa10); ra1 = *(const u32x4*)(pa11); }
    }
    *(u32x4*)(sA + (r0) * G_LDT + kp * 8) = ra0;
    *(u32x4*)(sA + (r1) * G_LDT + kp * 8) = ra1;
    *(u32x4*)(sB + (r0) * G_LDT + kp * 8) = rb;
    __syncthreads();
    for (int kt = 0; kt < nk; ++kt) {
        const int cur = kt & 1;
        if (kt + 1 < nk) {
            const int k0 = (kt + 1) << 5;
            if (k0 < ksplit) { ra0 = *(const u32x4*)(pa00 + k0); ra1 = *(const u32x4*)(pa01 + k0); }
            else { ra0 = *(const u32x4*)(pa10 + (k0 - ksplit)); ra1 = *(const u32x4*)(pa11 + (k0 - ksplit)); }
            rb = *(const u32x4*)(pb + k0);
        }
        const bf16_t* cA = sA + cur * 256 * G_LDT;
        const bf16_t* cB = sB + cur * 128 * G_LDT;
        bf16x8 af[4], bfr[4];
#pragma unroll
        for (int i = 0; i < 4; ++i) af[i] = ldfrag(cA, G_LDT, wm * 64 + i * 16, 0, fr, fq);
#pragma unroll
        for (int j = 0; j < 4; ++j) bfr[j] = ldfrag(cB, G_LDT, wn * 64 + j * 16, 0, fr, fq);
#pragma unroll
        for (int i = 0; i < 4; ++i)
#pragma unroll
            for (int j = 0; j < 4; ++j) acc[i][j] = mma16(bfr[j], af[i], acc[i][j]);
        if (kt + 1 < nk) {
            const int nb = cur ^ 1;
            *(u32x4*)(sA + (nb * 256 + r0) * G_LDT + kp * 8) = ra0;
            *(u32x4*)(sA + (nb * 256 + r1) * G_LDT + kp * 8) = ra1;
            *(u32x4*)(sB + (nb * 128 + r0) * G_LDT + kp * 8) = rb;
        }
        __syncthreads();
    }
    epi(acc, mt * 256 + wm * 64, nt * 128 + wn * 64, fr, fq);
}

struct EpiBf {
    bf16_t* out; int ld, nrows, ncols;
    __device__ __forceinline__ void operator()(const f32x4 (&acc)[4][4], int rb, int cb, int fr, int fq) const {
#pragma unroll
        for (int i = 0; i < 4; ++i) { const int lr = rb + i * 16 + fr; if (lr < nrows) {
#pragma unroll
            for (int j = 0; j < 4; ++j) { const int col = cb + j * 16 + fq * 4; if (col < ncols) st4bf(out + (size_t)lr * ld + col, acc[i][j]); } } }
    }
};
struct EpiSwiglu {
    bf16_t* out; int nrows;
    __device__ __forceinline__ void operator()(const f32x4 (&acc)[4][4], int rb, int cb, int fr, int fq) const {
#pragma unroll
        for (int i = 0; i < 4; ++i) { const int lr = rb + i * 16 + fr; if (lr < nrows) {
#pragma unroll
            for (int j = 0; j < 2; ++j) { const int col = (cb >> 1) + j * 16 + fq * 4; f32x4 g = acc[i][j], u = acc[i][j + 2], o;
#pragma unroll
                for (int r = 0; r < 4; ++r) o[r] = siluf_(g[r]) * u[r];
                st4bf(out + (size_t)lr * 512 + col, o); } } }
    }
};

namespace pg8 {
#define PG8_LAS __attribute__((address_space(3)))
typedef unsigned short bf16_t;
typedef short bf16x8 __attribute__((ext_vector_type(8)));
typedef float f32x4 __attribute__((ext_vector_type(4)));
typedef unsigned u32x4 __attribute__((ext_vector_type(4)));
constexpr int BM = 256, BK = 64, HALF = 128, HTB = HALF * BK * 2  , STAGE_BYTES = 8 * HTB, NXCD = 8, WGM = 8;

__host__ __device__ __forceinline__ int lds_byte(int r, int c) { const int st = (r >> 4) * 2 + (c >> 5), rr = r & 15, cc = c & 31, ob = rr * 64 + cc * 2; return st * 1024 + (ob ^ (((ob >> 9) & 1) << 5)); }
__host__ __device__ __forceinline__ void stage_rc(int b, int& R, int& C) { const int st = b / 1024, sb = b % 1024, swz = sb ^ (((sb >> 9) & 1) << 5); R = (st >> 1) * 16 + swz / 64; C = (st & 1) * 32 + (swz % 64) / 2; }
__host__ __device__ __forceinline__ int perm32(int rho) { const int n = rho >> 4, i = rho & 15; return 8 * (i >> 2) + 4 * n + (i & 3); }

struct Unit { int pm, pn; };
struct Gemm { const bf16_t* A; const bf16_t* Bt; int M, N, K; const bf16_t* A2; int pm_split; int lda, amode; };
#define PG8_ABASE(g, pm) ((g).amode == 1 ? (const char*)(g).A + (size_t)(((pm) >> 3) * 2304 + 256 + ((pm) & 7) * 256) * lda_ * 2 : ((pm) < (g).pm_split ? (const char*)(g).A + (size_t)(pm) * tstepA : (const char*)(g).A2 + (size_t)((pm) - (g).pm_split) * tstepA))
struct StaticOrder {
    int nM, nN, nwg, G, c;
    __host__ __device__ void init(int M, int N, int G_, int c_) { nM = M / BM; nN = N / BM; nwg = nM * nN; G = G_; c = c_; }
    __host__ __device__ bool next(int i, Unit& u) const {
        const long L = (long)i * G + c; if (L >= nwg) return false;
        int wgid = (int)L; { const int q = nwg / NXCD, r = nwg % NXCD, xcd = wgid % NXCD, off = wgid / NXCD; wgid = (xcd < r ? xcd * (q + 1) : r * (q + 1) + (xcd - r) * q) + off; }
        const int nig = WGM * nN, gid = wgid / nig, fm = gid * WGM, gsz = (nM - fm) < WGM ? (nM - fm) : WGM;
        u.pm = fm + ((wgid % nig) % gsz); u.pn = (wgid % nig) / gsz; return true;
    }
    __device__ __forceinline__ void a_ready(const Unit&) const {}
    __device__ __forceinline__ void done(const Unit&) const {}
};
__device__ __forceinline__ unsigned cvt_pk_bf16(float lo, float hi) { unsigned r; asm volatile("v_cvt_pk_bf16_f32 %0, %1, %2" : "=v"(r) : "v"(lo), "v"(hi)); return r; }
typedef float f32x2 __attribute__((ext_vector_type(2)));
template <class Epi, class Sched, bool STAMP = false, bool F8 = false>
__device__ __forceinline__ void gemm_phase(PG8_LAS unsigned char* lds, const Gemm g, const Sched& S, const Epi& E, unsigned long long* stamps) {
    const int tid = otid(), wid = __builtin_amdgcn_readfirstlane(tid >> 6), lane = tid & 63, wr = wid >> 2, wc = wid & 3, fr = lane & 15, fq = lane >> 4;
    const int K = g.K, nt = K / BK, lda_ = g.lda ? g.lda : g.K;
    int ts_lo = 0, ts_hi = 0, nts = 0; const unsigned long long rt_entry = STAMP ? (unsigned long long)wall_clock64() : 0ull;
#define PG8_STAMP() do { if (STAMP && wid == 0 && nts < 64) { const unsigned long long _c = (unsigned long long)clock64(); \
        ts_lo = (lane == nts) ? (int)(unsigned)_c : ts_lo; ts_hi = (lane == nts) ? (int)(unsigned)(_c >> 32) : ts_hi; ++nts; } } while (0)
    PG8_STAMP();
    unsigned voffA[2], voffB[2];
#pragma unroll
    for (int i = 0; i < 2; ++i) { int R, C; stage_rc(tid * 16 + i * 8192, R, C); const int Rb = Epi::PERM ? ((R & ~31) + perm32(R & 31)) : R;
        voffA[i] = (unsigned)(R * lda_ + C) * 2u; voffB[i] = (unsigned)(Rb * K + C) * 2u; }
    const size_t kstep = (size_t)(BK * 2);
    const size_t hstep = (size_t)HALF * K * 2;
    const size_t hstepA = (size_t)HALF * lda_ * 2, tstepA = 2 * hstepA;
    const size_t tstep = 2 * hstep;
    const unsigned ldsw = (unsigned)wid * 1024u;
    const int aoff = lds_byte(wr * 64 + fr, fq * 8), boff = lds_byte(wc * 32 + fr, fq * 8);
#define PG8_SA(b, h) (((b) * 2 + (h)) * HTB)
#define PG8_SB(b, h) ((4 + (b) * 2 + (h)) * HTB)
#define PG8_STAGE(bufoff, gbase, voff) do { _Pragma("unroll") for (int _i = 0; _i < 2; ++_i) \
        __builtin_amdgcn_global_load_lds((const unsigned*)((const char*)(gbase) + (voff)[_i]), (PG8_LAS unsigned*)(lds + (bufoff) + ldsw + _i * 8192), 16, 0, 0); } while (0)
#define PG8_LDA(dst, b, h) do { _Pragma("unroll") for (int m = 0; m < 4; ++m) { \
        if constexpr (F8) { dst##8[m].lo = *(const PG8_LAS v4i_*)(lds + PG8_SA(b, h) + aoff + m * 2048); dst##8[m].hi = *(const PG8_LAS v4i_*)(lds + PG8_SA(b, h) + aoff + m * 2048 + 1024); } \
        else { _Pragma("unroll") for (int k = 0; k < 2; ++k) dst[m][k] = *(const PG8_LAS bf16x8*)(lds + PG8_SA(b, h) + aoff + m * 2048 + k * 1024); } } } while (0)
#define PG8_LDB(dst, b, h) do { _Pragma("unroll") for (int n = 0; n < 2; ++n) { \
        if constexpr (F8) { dst##8[n].lo = *(const PG8_LAS v4i_*)(lds + PG8_SB(b, h) + boff + n * 2048); dst##8[n].hi = *(const PG8_LAS v4i_*)(lds + PG8_SB(b, h) + boff + n * 2048 + 1024); } \
        else { _Pragma("unroll") for (int k = 0; k < 2; ++k) dst[n][k] = *(const PG8_LAS bf16x8*)(lds + PG8_SB(b, h) + boff + n * 2048 + k * 1024); } } } while (0)
#define PG8_MMA(ai, bj, At, Bt) do { __builtin_amdgcn_s_setprio(1); _Pragma("unroll") for (int m = 0; m < 4; ++m) _Pragma("unroll") for (int n = 0; n < 2; ++n) { \
        if constexpr (F8) asm volatile("v_mfma_scale_f32_16x16x128_f8f6f4 %0, %1, %2, %0, %3, %3 op_sel_hi:[0,0,0]" : "+v"(acc[ai][bj][m][n]) : "v"(Bt##8[n]), "v"(At##8[m]), "v"(one_scale)); \
        else { _Pragma("unroll") for (int k = 0; k < 2; ++k) acc[ai][bj][m][n] = __builtin_amdgcn_mfma_f32_16x16x32_bf16(Bt[n][k], At[m][k], acc[ai][bj][m][n], 0, 0, 0); } } \
        __builtin_amdgcn_s_setprio(0); } while (0)
#define PG8_WAIT_V(n) asm volatile("s_waitcnt vmcnt(" #n ")" ::: "memory")
#define PG8_WAIT_L(n) asm volatile("s_waitcnt lgkmcnt(" #n ")" ::: "memory")
#define PG8_BAR __builtin_amdgcn_s_barrier()
#define PG8_SCHED __builtin_amdgcn_sched_barrier(0)
    Unit cur, nxt; int ui = 0;
    if (!S.next(0, cur)) return;
    f32x4 acc[2][2][4][2];
#pragma unroll
    for (int a = 0; a < 2; ++a)
#pragma unroll
        for (int b = 0; b < 2; ++b)
#pragma unroll
            for (int m = 0; m < 4; ++m)
#pragma unroll
                for (int n = 0; n < 2; ++n) acc[a][b][m][n] = (f32x4){0.f, 0.f, 0.f, 0.f};
    bf16x8 At[4][2], B0[2][2], B1[2][2];
    typedef int v4i_ __attribute__((ext_vector_type(4))); typedef int v8i_ __attribute__((ext_vector_type(8)));
    v8i_ At8[4], B08[2], B18[2];
    const int one_scale = 0x7f7f7f7f;
    const char* cA = PG8_ABASE(g, cur.pm); const char* cB = (const char*)g.Bt + (size_t)cur.pn * tstep;
    S.a_ready(cur);
    PG8_STAGE(PG8_SB(0, 0), cB, voffB); PG8_STAGE(PG8_SA(0, 0), cA, voffA); PG8_STAGE(PG8_SB(0, 1), cB + hstep, voffB); PG8_STAGE(PG8_SA(0, 1), cA + hstepA, voffA);
    if (wr == 1) PG8_BAR;
    PG8_WAIT_V(4); PG8_BAR;
    PG8_STAGE(PG8_SB(1, 0), cB + kstep, voffB); PG8_STAGE(PG8_SA(1, 0), cA + kstep, voffA); PG8_STAGE(PG8_SB(1, 1), cB + hstep + kstep, voffB);
    PG8_WAIT_V(6); PG8_BAR;
    PG8_STAMP();
    for (;;) {
        const bool has_next = S.next(ui + 1, nxt);
        const char* nA = has_next ? PG8_ABASE(g, nxt.pm) : cA; const char* nB = has_next ? (const char*)g.Bt + (size_t)nxt.pn * tstep : cB;
#pragma unroll 1
        for (int t = 0; t < nt; t += 2) {
            const bool last = (t == nt - 2);
            const char* a1 = cA + (size_t)(t + 1) * kstep;
            const char* a2 = last ? nA : cA + (size_t)(t + 2) * kstep; const char* b2 = last ? nB : cB + (size_t)(t + 2) * kstep;
            const char* a3 = a2 + kstep; const char* b3 = b2 + kstep;
            if (last && has_next) S.a_ready(nxt);
            PG8_LDB(B0, 0, 0); PG8_SCHED; PG8_LDA(At, 0, 0); PG8_STAGE(PG8_SA(1, 1), a1 + hstepA, voffA);
            PG8_WAIT_L(8); PG8_BAR; PG8_WAIT_L(0); PG8_MMA(0, 0, At, B0); PG8_BAR; PG8_SCHED;
            PG8_LDB(B1, 0, 1); PG8_STAGE(PG8_SB(0, 0), b2, voffB);
            PG8_BAR; PG8_WAIT_L(0); PG8_MMA(0, 1, At, B1); PG8_BAR;
            PG8_LDA(At, 0, 1); PG8_STAGE(PG8_SA(0, 0), a2, voffA);
            PG8_BAR; PG8_WAIT_L(0); PG8_MMA(1, 0, At, B0); PG8_BAR; PG8_SCHED;
            PG8_STAGE(PG8_SB(0, 1), b2 + hstep, voffB);
            PG8_WAIT_V(6); PG8_BAR; PG8_MMA(1, 1, At, B1); PG8_BAR;
            PG8_LDB(B0, 1, 0); PG8_SCHED; PG8_LDA(At, 1, 0); PG8_STAGE(PG8_SA(0, 1), a2 + hstepA, voffA);
            PG8_WAIT_L(8); PG8_BAR; PG8_WAIT_L(0); PG8_MMA(0, 0, At, B0); PG8_BAR; PG8_SCHED;
            PG8_LDB(B1, 1, 1); PG8_STAGE(PG8_SB(1, 0), b3, voffB);
            PG8_BAR; PG8_WAIT_L(0); PG8_MMA(0, 1, At, B1); PG8_BAR;
            PG8_LDA(At, 1, 1); PG8_STAGE(PG8_SA(1, 0), a3, voffA);
            PG8_BAR; PG8_WAIT_L(0); PG8_MMA(1, 0, At, B0); PG8_BAR; PG8_SCHED;
            PG8_STAGE(PG8_SB(1, 1), b3 + hstep, voffB);
            PG8_WAIT_V(6); PG8_BAR; PG8_MMA(1, 1, At, B1); PG8_BAR;
        }
        PG8_STAMP();
        if constexpr (F8) asm volatile("s_nop 15\n\ts_nop 15" ::: "memory");
        if constexpr (!Epi::AFTER_DRAIN) { E(acc, cur, wr, wc, fr, fq); S.done(cur); }
        PG8_STAMP();
        if (!has_next) break;
#pragma unroll
        for (int a = 0; a < 2; ++a)
#pragma unroll
            for (int b = 0; b < 2; ++b)
#pragma unroll
                for (int m = 0; m < 4; ++m)
#pragma unroll
                    for (int n = 0; n < 2; ++n) acc[a][b][m][n] = (f32x4){0.f, 0.f, 0.f, 0.f};
        cur = nxt; cA = nA; cB = nB; ++ui;
    }
    PG8_WAIT_V(0);
    if (wr == 0) PG8_BAR;
    PG8_BAR;
    if constexpr (Epi::AFTER_DRAIN) { E.fused(acc, cur, wr, wc, fr, fq, lds, wid, lane); S.done(cur); }
    PG8_STAMP();
    if (STAMP && wid == 0) { stamps[lane] = lane < nts ? (((unsigned long long)(unsigned)ts_hi << 32) | (unsigned)ts_lo) : 0ull;
        if (lane == 62) stamps[62] = rt_entry; if (lane == 63) stamps[63] = (unsigned long long)wall_clock64(); }
#undef PG8_STAMP
#undef PG8_SA
#undef PG8_SB
#undef PG8_STAGE
#undef PG8_LDA
#undef PG8_LDB
#undef PG8_MMA
#undef PG8_WAIT_V
#undef PG8_WAIT_L
#undef PG8_BAR
#undef PG8_SCHED
}
}
namespace pg8 {
struct EpiBfG {
    static constexpr bool PERM = true, AFTER_DRAIN = false;
    bf16_t* O; int ldc, ncols, pn_mask; float oscale;
    __device__ __forceinline__ void operator()(const f32x4 (&acc)[2][2][4][2], const Unit& u, int wr, int wc, int fr, int fq) const {
        const int row0 = u.pm * BM + wr * 64 + fr, col0 = (u.pn & pn_mask) * BM + wc * 32 + 8 * fq;
#pragma unroll
        for (int ai = 0; ai < 2; ++ai)
#pragma unroll
            for (int m = 0; m < 4; ++m) { bf16_t* rowp = O + (size_t)(row0 + ai * HALF + m * 16) * ldc;
#pragma unroll
                for (int bj = 0; bj < 2; ++bj) { const int c = col0 + bj * HALF;
                    if (c < ncols) { const f32x4 v0 = acc[ai][bj][m][0] * oscale, v1 = acc[ai][bj][m][1] * oscale;
                        u32x4 w; w.x = cvt_pk_bf16(v0[0], v0[1]); w.y = cvt_pk_bf16(v0[2], v0[3]); w.z = cvt_pk_bf16(v1[0], v1[1]); w.w = cvt_pk_bf16(v1[2], v1[3]);
                        *(u32x4*)(rowp + c) = w; } } }
    }
};
struct EpiSwi {
    static constexpr bool PERM = true, AFTER_DRAIN = false;
    bf16_t* H;
    __device__ __forceinline__ void operator()(const f32x4 (&acc)[2][2][4][2], const Unit& u, int wr, int wc, int fr, int fq) const {
        const int row0 = u.pm * BM + wr * 64 + fr, hc0 = (u.pn & 3) * HALF + wc * 32 + 8 * fq;
#pragma unroll
        for (int ai = 0; ai < 2; ++ai)
#pragma unroll
            for (int m = 0; m < 4; ++m) { unsigned char* rowp = (unsigned char*)H + (size_t)(row0 + ai * HALF + m * 16) * 1024 + hc0;
                float o[8];
#pragma unroll
                for (int n = 0; n < 2; ++n)
#pragma unroll
                    for (int r = 0; r < 4; ++r) { const float g = acc[ai][0][m][n][r] * W8_INV; o[n * 4 + r] = g * __builtin_amdgcn_rcpf(1.0f + __expf(-g)) * (acc[ai][1][m][n][r] * W8_INV); }
                u32x2 w; w.x = pack4f8(o[0], o[1], o[2], o[3]); w.y = pack4f8(o[4], o[5], o[6], o[7]);
                *(u32x2*)rowp = w; }
    }
};
struct MoeOrder {
    const int* slotmap; int ntiles, G, c;
    __device__ __forceinline__ bool next(int i, Unit& u) const {
        const int L = i * G + c; if (L >= ntiles * 4) return false;
        u.pm = L >> 2; u.pn = __builtin_amdgcn_readfirstlane(slotmap[L >> 2]) * 4 + (L & 3); return true;
    }
    __device__ __forceinline__ void a_ready(const Unit&) const {}
    __device__ __forceinline__ void done(const Unit&) const {}
};
}
#define WSP(T, off) as_global((T*)(kp.ws + (off)))
#define KIN(i) as_global(kp.in[i])
#define KOUT as_global(kp.out)

PHASE_FN void phase_mod(const KP& kp, unsigned char* lds) {
    float* sc = (float*)lds;
    float* red = sc + 17 * 1024;
    float* modv = WSP(float, WS_MODV);
    const int tid = otid();
    for (int i = tid; i < 17 * 1024; i += 512) { const int bb = i >> 10, k = i & 1023; const float c = bb < 16 ? KIN(1)[bb * 1024 + k] : KIN(3)[k]; sc[i] = siluf_(c); }
    __syncthreads();
    const int jc = tid & 63, ks = tid >> 6;
    for (int u = obid(); u < 192; u += gridDim.x) {
        const int l = u / 96, j0 = (u % 96) * 64;
        const float* w = KIN(4) + (size_t)l * 1024 * 6144 + j0 + jc;
        float acc[17];
#pragma unroll
        for (int bb = 0; bb < 17; ++bb) acc[bb] = 0.f;
        for (int k = ks * 128; k < ks * 128 + 128; ++k) {
            const float wv = w[(size_t)k * 6144];
#pragma unroll
            for (int bb = 0; bb < 17; ++bb) acc[bb] += sc[bb * 1024 + k] * wv;
        }
#pragma unroll
        for (int bb = 0; bb < 17; ++bb) red[(ks * 17 + bb) * 64 + jc] = acc[bb];
        __syncthreads();
        for (int i = tid; i < 17 * 64; i += 512) {
            const int bb = i >> 6, j = i & 63; float s = KIN(5)[l * 6144 + j0 + j];
#pragma unroll
            for (int k2 = 0; k2 < 8; ++k2) s += red[(k2 * 17 + bb) * 64 + j];
            modv[((size_t)l * 17 + bb) * 6144 + j0 + j] = s;
        }
        __syncthreads();
    }
}

struct CvJob { const float* src; bf16_t* dst; int N, ldd, mode, kt, ntile, f8; };
__device__ __forceinline__ bool cv_pick(int& u, CvJob& J, const float* src, int K, int N, bf16_t* dst, int mode = 0, int ldd = -1, int f8 = 0) {
    const int ntl = (N + 63) >> 6, cnt = ntl * (K >> 6);
    if (u < cnt) { J.src = src; J.dst = dst; J.N = N; J.ldd = ldd < 0 ? K : ldd; J.mode = mode; J.kt = u / ntl; J.ntile = u % ntl; J.f8 = f8; return true; }
    u -= cnt; return false;
}
__device__ __forceinline__ void cv_load(const CvJob& J, int tid, f32x4 (&r)[2]) {
#pragma unroll
    for (int i = 0; i < 2; ++i) { const int idx = tid + i * 512, k = idx >> 4, n0 = J.ntile * 64 + (idx & 15) * 4;
        r[i] = (n0 < J.N) ? *(const f32x4*)(J.src + (size_t)(J.kt * 64 + k) * J.N + n0) : (f32x4){0.f, 0.f, 0.f, 0.f}; }
}
__device__ __forceinline__ void cv_put(float* tile, int tid, const f32x4 (&r)[2]) {
#pragma unroll
    for (int i = 0; i < 2; ++i) { const int idx = tid + i * 512, k = idx >> 4, nq = (idx & 15) * 4;
        tile[k * 65 + nq] = r[i][0]; tile[k * 65 + nq + 1] = r[i][1]; tile[k * 65 + nq + 2] = r[i][2]; tile[k * 65 + nq + 3] = r[i][3]; }
}
__device__ __forceinline__ void cv_store(const float* tile, const CvJob& J, int tid) {
    const int nl = tid >> 3, k8 = tid & 7, n = J.ntile * 64 + nl;
    if (n < J.N) { int row = n; if (J.mode) row = (n >> 7) * 256 + (n & 127) + (J.mode == 2 ? 128 : 0);
        const float* tp = tile + (k8 * 8) * 65 + nl;
        if (J.f8) { u32x2 w; w.x = pack4f8(tp[0] * W8_SCALE, tp[65] * W8_SCALE, tp[130] * W8_SCALE, tp[195] * W8_SCALE); w.y = pack4f8(tp[260] * W8_SCALE, tp[325] * W8_SCALE, tp[390] * W8_SCALE, tp[455] * W8_SCALE);
            *(u32x2*)((unsigned char*)J.dst + (size_t)row * J.ldd + J.kt * 64 + k8 * 8) = w; }
        else { u32x4 w; w.x = pack2(tp[0], tp[65]); w.y = pack2(tp[130], tp[195]); w.z = pack2(tp[260], tp[325]); w.w = pack2(tp[390], tp[455]);
            *(u32x4*)(J.dst + (size_t)row * J.ldd + J.kt * 64 + k8 * 8) = w; } }
}
#define CV_RUN(total, PICK) CV_RUN_ON(total, PICK, obid(), (int)gridDim.x)
#define CV_SUB(total, PICK, Jx, rx, ux, tilex) { if (ux >= (total)) break; cv_put(tilex, tid, rx); lds_barrier(); const CvJob Jt_ = Jx; ux += 3 * G_; \
            if (ux < (total)) { int u = ux; PICK(u, Jx); cv_load(Jx, tid, rx); } cv_store(tilex, Jt_, tid); }
#define CV_RUN_ON(total, PICK, bid_, nb_) do { float* tile = (float*)lds; const int tid = otid(); const int G_ = (nb_); CvJob Ja, Jb, Jc; f32x4 ra[2], rb[2], rc[2]; \
        int ua_ = (bid_), ub_ = ua_ + G_, uc_ = ub_ + G_; \
        if (ua_ < (total)) { int u = ua_; PICK(u, Ja); cv_load(Ja, tid, ra); } \
        if (ub_ < (total)) { int u = ub_; PICK(u, Jb); cv_load(Jb, tid, rb); } \
        if (uc_ < (total)) { int u = uc_; PICK(u, Jc); cv_load(Jc, tid, rc); } \
        for (;;) { CV_SUB(total, PICK, Ja, ra, ua_, tile) CV_SUB(total, PICK, Jb, rb, ub_, tile + 64 * 65) CV_SUB(total, PICK, Jc, rc, uc_, tile + 2 * 64 * 65) } \
        lds_barrier(); } while (0)
PHASE_FN void phase_conv_ab(const KP& kp, unsigned char* lds) {
#define PICK_AB(u, J) do { if (!cv_pick(u, J, KIN(7), 1024, AB_N, WSP(bf16_t, WS_WMIX + WM_AB_IN))) cv_pick(u, J, KIN(8), 2048, 1024, WSP(bf16_t, WS_WMIX + WM_AB_OUT)); } while (0)
    CV_RUN(16 * 85 + 32 * 16, PICK_AB);
#undef PICK_AB
}
PHASE_FN void phase_conv_cd(const KP& kp, unsigned char* lds) {
#define PICK_CD(u, J) do { if (cv_pick(u, J, KIN(18), 1024, CD_N, WSP(bf16_t, WS_WMIX + WM_CD_IN), 0, 1024, 1)) break;     \
        if (cv_pick(u, J, KIN(19), 1536, 1024, WSP(bf16_t, WS_WMIX + WM_CD_OUT))) break; \
        if (cv_pick(u, J, KIN(21), 384, 768, WSP(bf16_t, WS_WMIX + WM_UQ))) break; \
        if (cv_pick(u, J, KIN(23), 256, 1024, WSP(bf16_t, WS_WMIX + WM_UKV))) break; \
        cv_pick(u, J, KIN(29), 128, 1024, WSP(bf16_t, WS_WMIX + WM_G2)); } while (0)
    CV_RUN(16 * 65 + 24 * 16 + 6 * 12 + 4 * 16 + 2 * 16, PICK_CD);
#undef PICK_CD
}
PHASE_FN void phase_conv_moe(const KP& kp, unsigned char* lds, int l, int bid, int nb) {
#define PICK_MOE(u0, J) do { const int es = (u0) / 384; int uu = (u0) % 384; \
        const float* wg = es < 16 ? KIN(36) + ((size_t)l * 16 + es) * 1024 * 512 : KIN(39) + (size_t)l * 1024 * 512; \
        const float* wu = es < 16 ? KIN(37) + ((size_t)l * 16 + es) * 1024 * 512 : KIN(40) + (size_t)l * 1024 * 512; \
        const float* wd = es < 16 ? KIN(38) + ((size_t)l * 16 + es) * 512 * 1024 : KIN(41) + (size_t)l * 512 * 1024; \
        bf16_t* dup = (bf16_t*)(WSP(unsigned char, WS_BIG + MO_WUP) + (size_t)es * 1024 * 1024); bf16_t* ddn = (bf16_t*)(WSP(unsigned char, WS_BIG + MO_WDN) + (size_t)es * 1024 * 512); \
        if (cv_pick(uu, J, wg, 1024, 512, dup, 1, 1024, 1)) break; if (cv_pick(uu, J, wu, 1024, 512, dup, 2, 1024, 1)) break; cv_pick(uu, J, wd, 512, 1024, ddn, 0, 512, 1); } while (0)
    CV_RUN_ON(17 * 384, PICK_MOE, bid, nb);
#undef PICK_MOE
}

__device__ __forceinline__ const float* hrow_rd(const KP& kp, bool from_inputs, int b, int t) {
    if (t < CTXL) return (from_inputs ? KIN(2) : WSP(const float, WS_HC)) + ((size_t)b * CTXL + t) * D;
    return (from_inputs ? KIN(0) : KOUT) + ((size_t)b * SEQ + (t - CTXL)) * D;
}
__device__ __forceinline__ float* hrow_wr(const KP& kp, int b, int t) {
    if (t < CTXL) return WSP(float, WS_HC) + ((size_t)b * CTXL + t) * D;
    return KOUT + ((size_t)b * SEQ + (t - CTXL)) * D;
}

PHASE_FN void phase_u(const KP& kp, int layer, int g, int bid, int nb, bool to_v) {
    const int lane = otid() & 63, wid = __builtin_amdgcn_readfirstlane(otid() >> 6);
    const float* modv = WSP(const float, WS_MODV) + (size_t)layer * 17 * 6144;
    const float* ng = KIN(6) + (size_t)layer * 4 * 1024;
    bf16_t* U = to_v ? WSP(bf16_t, WS_V) + (size_t)RG * 1024 : WSP(bf16_t, WS_BIG + (layer == 0 ? L0_U : L1_U));
    for (int lr = bid * 8 + wid; lr < RG; lr += nb * 8) {
        const int bl = lr / TT, t = lr - bl * TT, b = g * BG + bl;
        const float* src = hrow_rd(kp, layer == 0, b, t);
        const float* mv = modv + (size_t)(t < CTXL ? 16 : b) * 6144;
        f32x4 x[4]; float ss = 0.f;
#pragma unroll
        for (int i = 0; i < 4; ++i) { x[i] = *(const f32x4*)(src + i * 256 + lane * 4); ss += x[i][0] * x[i][0] + x[i][1] * x[i][1] + x[i][2] * x[i][2] + x[i][3] * x[i][3]; }
        ss = wsum(ss); const float rstd = rsqrtf(ss * (1.0f / 1024.0f) + EPS);
#pragma unroll
        for (int i = 0; i < 4; ++i) { const int col = i * 256 + lane * 4;
            const f32x4 gv = *(const f32x4*)(ng + col), sc = *(const f32x4*)(mv + 1024 + col), sh = *(const f32x4*)(mv + col);
            st4bf(U + (size_t)lr * 1024 + col, x[i] * rstd * gv * (sc + 1.0f) + sh); }
    }
}

PHASE_FN void phase_r(const KP& kp, unsigned char* lds, int layer, int g) {
    const int tid = otid(), lane = tid & 63, wid = __builtin_amdgcn_readfirstlane(tid >> 6);
    float* rw = (float*)lds;
    int* se = (int*)(rw + 1024 * 16);
    int* sbase = se + 160;
    for (int i = tid; i < 1024 * 16; i += 512) rw[i] = KIN(34)[i];
    __syncthreads();
    const float* modv = WSP(const float, WS_MODV) + (size_t)layer * 17 * 6144;
    const float* ng = KIN(6) + (size_t)layer * 4 * 1024;
    const bf16_t* MIX = WSP(const bf16_t, WS_BIG + (layer == 0 ? L0_U : L1_U));
    bf16_t* V = WSP(bf16_t, WS_V);
    unsigned* cnt = WSP(unsigned, CTL_CNT) + layer * 16;
    int* TOKE = WSP(int, WS_TOKE); int* TOKP = WSP(int, WS_TOKP); float* TOKW = WSP(float, WS_TOKW); int* LIST = WSP(int, WS_LIST);
    const int nrows = layer == 0 ? RG : RGL, CH = layer == 0 ? 72 : 64, RW = CH >> 3, nchunks = nrows / CH;
    float rbias[16];
#pragma unroll
    for (int e = 0; e < 16; ++e) rbias[e] = KIN(35)[e];
    for (int ch = obid(); ch < nchunks; ch += gridDim.x) {
        for (int rr = 0; rr < RW; ++rr) {
            const int rl = wid * RW + rr, lr = ch * CH + rl;
            int b, t, tok;
            if (layer == 0) { const int bl = lr / TT; t = lr - bl * TT; b = g * BG + bl; tok = g * RG + lr; }
            else { const int bl = lr >> 11; t = CTXL + (lr & 2047); b = g * BG + bl; tok = g * RGL + lr; }
            const float* hsrc = hrow_rd(kp, layer == 0, b, t);
            float* hdst = hrow_wr(kp, b, t);
            const float* mv = modv + (size_t)(t < CTXL ? 16 : b) * 6144;
            f32x4 y[4], h[4]; float ss = 0.f;
#pragma unroll
            for (int i = 0; i < 4; ++i) { y[i] = ld4bf(MIX + (size_t)lr * 1024 + i * 256 + lane * 4); ss += y[i][0] * y[i][0] + y[i][1] * y[i][1] + y[i][2] * y[i][2] + y[i][3] * y[i][3]; }
            ss = wsum(ss); float rstd = rsqrtf(ss * (1.0f / 1024.0f) + EPS);
            float s2 = 0.f;
#pragma unroll
            for (int i = 0; i < 4; ++i) { const int col = i * 256 + lane * 4;
                const f32x4 g1 = *(const f32x4*)(ng + 1024 + col), ga = *(const f32x4*)(mv + 2048 + col), hx = *(const f32x4*)(hsrc + col);
                h[i] = hx + ga * (y[i] * rstd * g1);
                *(f32x4*)(hdst + col) = h[i];
                s2 += h[i][0] * h[i][0] + h[i][1] * h[i][1] + h[i][2] * h[i][2] + h[i][3] * h[i][3]; }
            s2 = wsum(s2); rstd = rsqrtf(s2 * (1.0f / 1024.0f) + EPS);
            float lg[16];
#pragma unroll
            for (int e = 0; e < 16; ++e) lg[e] = 0.f;
#pragma unroll
            for (int i = 0; i < 4; ++i) { const int col = i * 256 + lane * 4;
                const f32x4 g2 = *(const f32x4*)(ng + 2048 + col), scf = *(const f32x4*)(mv + 4096 + col), shf = *(const f32x4*)(mv + 3072 + col);
                const f32x4 v = h[i] * rstd * g2 * (scf + 1.0f) + shf;
                st4f8((unsigned char*)V + (size_t)tok * 2048 + col, v);
#pragma unroll
                for (int j = 0; j < 4; ++j) {
#pragma unroll
                    for (int q = 0; q < 4; ++q) { const f32x4 w4 = *(const f32x4*)(rw + (col + j) * 16 + q * 4);
                        lg[q * 4 + 0] += v[j] * w4[0]; lg[q * 4 + 1] += v[j] * w4[1]; lg[q * 4 + 2] += v[j] * w4[2]; lg[q * 4 + 3] += v[j] * w4[3]; } } }
#pragma unroll
            for (int e = 0; e < 16; ++e) lg[e] = wsum(lg[e]);
            float aff[16], sel[16];
#pragma unroll
            for (int e = 0; e < 16; ++e) { aff[e] = sigmoidf_(lg[e]); sel[e] = aff[e] + rbias[e]; }
            float gs[4];
#pragma unroll
            for (int gi = 0; gi < 4; ++gi) { const float a0 = sel[gi * 4], a1 = sel[gi * 4 + 1], a2 = sel[gi * 4 + 2], a3 = sel[gi * 4 + 3];
                gs[gi] = fmaxf(fmaxf(fmaxf(a0 + a1, a0 + a2), fmaxf(a0 + a3, a1 + a2)), fmaxf(a1 + a3, a2 + a3)); }
            int gidx = 0; float gb = gs[0];
#pragma unroll
            for (int gi = 1; gi < 4; ++gi) if (gs[gi] > gb) { gb = gs[gi]; gidx = gi; }
            float c[4], f[4];
#pragma unroll
            for (int i = 0; i < 4; ++i) { c[i] = gidx == 0 ? sel[i] : gidx == 1 ? sel[4 + i] : gidx == 2 ? sel[8 + i] : sel[12 + i];
                                           f[i] = gidx == 0 ? aff[i] : gidx == 1 ? aff[4 + i] : gidx == 2 ? aff[8 + i] : aff[12 + i]; }
            int i1 = 0; float cb = c[0];
#pragma unroll
            for (int i = 1; i < 4; ++i) if (c[i] > cb) { cb = c[i]; i1 = i; }
            int i2 = -1; float cb2 = 0.f;
#pragma unroll
            for (int i = 0; i < 4; ++i) if (i != i1 && (i2 < 0 || c[i] > cb2)) { cb2 = c[i]; i2 = i; }
            float w1 = i1 == 0 ? f[0] : i1 == 1 ? f[1] : i1 == 2 ? f[2] : f[3];
            float w2 = i2 == 0 ? f[0] : i2 == 1 ? f[1] : i2 == 2 ? f[2] : f[3];
            const float wsn = 1.0f / (w1 + w2); w1 *= wsn; w2 *= wsn;
            if (lane == 0) { se[rl * 2] = gidx * 4 + i1; se[rl * 2 + 1] = gidx * 4 + i2;
                TOKE[tok * 2] = gidx * 4 + i1; TOKE[tok * 2 + 1] = gidx * 4 + i2; TOKW[tok * 2] = w1; TOKW[tok * 2 + 1] = w2; }
        }
        __syncthreads();
        if (tid < 16) { int c2 = 0; for (int i = 0; i < 2 * CH; ++i) c2 += (se[i] == tid) ? 1 : 0; sbase[tid] = (int)atomicAdd(&cnt[tid], (unsigned)c2); }
        __syncthreads();
        if (tid < 2 * CH) { const int e = se[tid]; int rank = 0; for (int j = 0; j < tid; ++j) rank += (se[j] == e) ? 1 : 0;
            const int pos = sbase[e] + rank; const int lr = ch * CH + (tid >> 1); const int tok = (layer == 0 ? g * RG : g * RGL) + lr;
            LIST[(size_t)e * NTOK + pos] = tok; TOKP[tok * 2 + (tid & 1)] = pos; }
        __syncthreads();
    }
}

__device__ __forceinline__ int moe_tile_prefix(const unsigned* cnt, int ntok, int lane) {
    const int myt = lane < 16 ? (int)((cnt[lane & 15] + 255u) >> 8) : 0; int pref = myt;
#pragma unroll
    for (int o = 1; o < 16; o <<= 1) { const int t = __shfl_up(pref, o); if (lane >= o) pref += t; }
    return pref - myt + ntok / 256;
}
PHASE_FN void phase_moe_gather(const KP& kp, int layer) {
    const int lane = otid() & 63, wid = __builtin_amdgcn_readfirstlane(otid() >> 6);
    const int ntok = layer == 0 ? NTOK : NLAT;
    const int tpre = moe_tile_prefix(WSP(const unsigned, CTL_CNT) + layer * 16, ntok, lane);
    const bf16_t* V = WSP(const bf16_t, WS_V); bf16_t* XG = WSP(bf16_t, WS_BIG + MO_XG);
    const int* TOKE = WSP(const int, WS_TOKE); const int* TOKP = WSP(const int, WS_TOKP);
    for (int it = obid() * 8 + wid; it < 2 * ntok; it += gridDim.x * 8) {
        const int tok = it >> 1, e = TOKE[it], pos = TOKP[it];
        const size_t row = (size_t)(__shfl(tpre, e) - ntok / 256) * 256 + pos;
        const u32x4* src = (const u32x4*)(V + (size_t)tok * 1024) + lane; u32x4* dst = (u32x4*)(XG + row * 1024) + lane;
        dst[0] = src[0];
    }
}
PHASE_FN void phase_moe_gemm(const KP& kp, unsigned char* lds, int layer, bool down) {
    const int tid = otid();
    int* pre = (int*)(lds + pg8::STAGE_BYTES);
    int* slotmap = pre + 32;
    const int ntok = layer == 0 ? NTOK : NLAT;
    const unsigned* cnt = WSP(const unsigned, CTL_CNT) + layer * 16;
    if (tid == 0) { int p = ntok / 256; pre[0] = 0; pre[1] = p; for (int e = 0; e < 16; ++e) { p += ((int)cnt[e] + 255) >> 8; pre[2 + e] = p; } }
    __syncthreads();
    const int ntiles = pre[17];
    for (int t = tid; t < ntiles; t += 512) { int idx = 0; for (int e = 1; e < 17; ++e) if (pre[e] <= t) idx = e; slotmap[t] = idx == 0 ? 16 : idx - 1; }
    __syncthreads();
    pg8::MoeOrder S{slotmap, ntiles, (int)gridDim.x, obid()};
    if (!down) {
        pg8::Gemm g{WSP(const bf16_t, WS_V), WSP(const bf16_t, WS_BIG + MO_WUP), 0, 0, 512, WSP(const bf16_t, WS_BIG + MO_XG), ntok / 256, 1024, 0};
        pg8::EpiSwi E{WSP(bf16_t, WS_BIG + MO_HID)};
        pg8::gemm_phase<pg8::EpiSwi, pg8::MoeOrder, false, true>((PG8_LAS unsigned char*)lds, g, S, E, nullptr);
    } else {
        pg8::Gemm g{WSP(const bf16_t, WS_BIG + MO_HID), WSP(const bf16_t, WS_BIG + MO_WDN), 0, 0, 256, nullptr, 0x7fffffff, 512, 0};
        pg8::EpiBfG E{WSP(bf16_t, WS_BIG + MO_CON), 1024, 1024, 3, W8_INV};
        pg8::gemm_phase<pg8::EpiBfG, pg8::MoeOrder, false, true>((PG8_LAS unsigned char*)lds, g, S, E, nullptr);
    }
    __syncthreads();
}

PHASE_FN void phase_combine(const KP& kp, int layer) {
    const int lane = otid() & 63, wid = __builtin_amdgcn_readfirstlane(otid() >> 6);
    const int ntok = layer == 0 ? NTOK : NLAT;
    const unsigned* cnt = WSP(const unsigned, CTL_CNT) + layer * 16;
    const float* modv = WSP(const float, WS_MODV) + (size_t)layer * 17 * 6144;
    const float* ng = KIN(6) + (size_t)layer * 4 * 1024 + 3 * 1024;
    const bf16_t* CON = WSP(const bf16_t, WS_BIG + MO_CON);
    const int* TOKE = WSP(const int, WS_TOKE); const int* TOKP = WSP(const int, WS_TOKP); const float* TOKW = WSP(const float, WS_TOKW);
    const int tpre = moe_tile_prefix(cnt, ntok, lane);
    for (int tok0 = (obid() * 8 + wid) * 2; tok0 < ntok; tok0 += gridDim.x * 16) {
        int e1[2], e2[2], p1[2], p2[2]; float w1[2], w2[2];
#pragma unroll
        for (int u = 0; u < 2; ++u) { const int tok = tok0 + u; e1[u] = TOKE[tok * 2]; e2[u] = TOKE[tok * 2 + 1]; p1[u] = TOKP[tok * 2]; p2[u] = TOKP[tok * 2 + 1]; w1[u] = TOKW[tok * 2]; w2[u] = TOKW[tok * 2 + 1]; }
        f32x4 f[2][4], hx[2][4]; float* hp[2]; const float* mv[2];
#pragma unroll
        for (int u = 0; u < 2; ++u) { const int tok = tok0 + u;
            const size_t r1 = (size_t)__shfl(tpre, e1[u]) * 256 + p1[u], r2 = (size_t)__shfl(tpre, e2[u]) * 256 + p2[u];
            int b, t;
            if (layer == 0) { b = tok / TT; t = tok - b * TT; } else { b = tok >> 11; t = CTXL + (tok & 2047); }
            hp[u] = hrow_wr(kp, b, t); mv[u] = modv + (size_t)(t < CTXL ? 16 : b) * 6144 + 5 * 1024;
#pragma unroll
            for (int i = 0; i < 4; ++i) { const int col = i * 256 + lane * 4;
                f[u][i] = ld4bf(CON + (size_t)tok * 1024 + col) + ld4bf(CON + r1 * 1024 + col) * w1[u] + ld4bf(CON + r2 * 1024 + col) * w2[u];
                hx[u][i] = *(const f32x4*)(hp[u] + col); } }
#pragma unroll
        for (int u = 0; u < 2; ++u) { float ss = 0.f;
#pragma unroll
            for (int i = 0; i < 4; ++i) ss += f[u][i][0] * f[u][i][0] + f[u][i][1] * f[u][i][1] + f[u][i][2] * f[u][i][2] + f[u][i][3] * f[u][i][3];
            ss = wsum(ss); const float rstd = rsqrtf(ss * (1.0f / 1024.0f) + EPS);
            float s2 = 0.f;
#pragma unroll
            for (int i = 0; i < 4; ++i) { const int col = i * 256 + lane * 4;
                const f32x4 g3 = *(const f32x4*)(ng + col), gf = *(const f32x4*)(mv[u] + col);
                const f32x4 hn = hx[u][i] + gf * (f[u][i] * rstd * g3);
                *(f32x4*)(hp[u] + col) = hn; hx[u][i] = hn;
                s2 += hn[0] * hn[0] + hn[1] * hn[1] + hn[2] * hn[2] + hn[3] * hn[3]; }
            if (layer == 0) {
                s2 = wsum(s2); const float rs2 = rsqrtf(s2 * (1.0f / 1024.0f) + EPS);
                const float* mv1 = mv[u] - 5 * 1024 + 17 * 6144;
                const float* ng1 = KIN(6) + 4 * 1024;
                unsigned char* U1 = WSP(unsigned char, WS_V) + (size_t)(tok0 + u) * 2048;
#pragma unroll
                for (int i = 0; i < 4; ++i) { const int col = i * 256 + lane * 4;
                    const f32x4 gv = *(const f32x4*)(ng1 + col), sc = *(const f32x4*)(mv1 + 1024 + col), sh = *(const f32x4*)(mv1 + col);
                    st4f8(U1 + col, hx[u][i] * rs2 * gv * (sc + 1.0f) + sh); } } }
    }
}

template <int CH>
__device__ __forceinline__ int scan_t(int dir, int ci, int j) {
    constexpr int NC_CTX = CTXL / CH;
    if (!dir) return ci * CH + j;
    return ci < NC_CTX ? (CTXL - 1 - ci * CH - j) : (TT - 1 - (ci - NC_CTX) * CH - j);
}

constexpr int ML_LQ = 136, ML_LT = 72, ML_VR = 144;
PHASE_FN void mlstm_unit(const KP& kp, unsigned char* lds, int bl, int h, int dir, int vh) {
    const int tid = otid();
    bf16_t* Qs = (bf16_t*)lds;
    bf16_t* Ks = Qs + 64 * ML_LQ;
    bf16_t* KTE = Ks + 64 * ML_LQ;
    bf16_t* VT = KTE + 128 * ML_LT;
    bf16_t* Ps = VT + ML_VR * ML_LT;
    bf16_t* Cb = Ps + 64 * ML_LT;
    float* fs = (float*)(Cb + ML_VR * ML_LQ);
    float* s_rowv = fs;
    float* s_colv = fs + 64;
    float* s_wint = fs + 128;
    float* s_emj = fs + 192;
    float* s_E = fs + 256;
    float* s_den = fs + 320;
    float* s_misc = fs + 384;
    const bf16_t* P = WSP(const bf16_t, WS_BIG + L0_P);
    bf16_t* HOUT = WSP(bf16_t, WS_BIG + (dir ? L0_HB : L0_AO)); const int ldh = dir ? 1024 : 2048;
    const float ibias = KIN(9)[dir * 4 + h], fbias = KIN(10)[dir * 4 + h];
    for (int i = tid; i < ML_VR * ML_LQ; i += 512) Cb[i] = 0;
    for (int i = tid; i < 16 * ML_LT; i += 512) VT[128 * ML_LT + i] = (i < ML_LT) ? (bf16_t)0x3f80 : (bf16_t)0;
    f32x4 Cacc[8], Nacc;
#pragma unroll
    for (int i = 0; i < 8; ++i) Cacc[i] = (f32x4){0.f, 0.f, 0.f, 0.f};
    Nacc = (f32x4){0.f, 0.f, 0.f, 0.f};
    float m_state = 0.f;
    u32x4 pq[2], pk[2], pv[2]; bf16_t pgi = 0, pgf = 0;
#define ML_REQ(ci_) do { _Pragma("unroll") for (int i = 0; i < 2; ++i) { const int p = tid + i * 512, j = p >> 4, c8 = p & 15; \
            const bf16_t* pr = P + ((size_t)bl * TT + scan_t<64>(dir, (ci_), j)) * AB_N; \
            pq[i] = *(const u32x4*)(pr + AB_Q + h * 128 + c8 * 8); pk[i] = *(const u32x4*)(pr + AB_K + h * 128 + c8 * 8); \
            const int jv = tid & 63, cv = (tid >> 6) + i * 8; \
            pv[i] = *(const u32x4*)(P + ((size_t)bl * TT + scan_t<64>(dir, (ci_), jv)) * AB_N + AB_V + h * 256 + vh * 128 + cv * 8); } \
        if (tid < 64) { const bf16_t* pg = P + ((size_t)bl * TT + scan_t<64>(dir, (ci_), tid)) * AB_N; pgi = pg[AB_IG + dir * 4 + h]; pgf = pg[AB_FG + dir * 4 + h]; } } while (0)
    ML_REQ(0);
    lds_barrier();
    for (int ci = 0; ci < TT / 64; ++ci) {
        int tq = tid; asm volatile("" : "+v"(tq));
        const int lane = tq & 63, wid = __builtin_amdgcn_readfirstlane(tq >> 6), fr = lane & 15, fq = lane >> 4;
#pragma unroll
        for (int i = 0; i < 2; ++i) {
            const int p = tq + i * 512, j = p >> 4, c8 = p & 15;
            u32x4 q = pq[i];
            const float qs = 0.08838834764831845f;
            q.x = pack2(lo2f(q.x) * qs, hi2f(q.x) * qs); q.y = pack2(lo2f(q.y) * qs, hi2f(q.y) * qs);
            q.z = pack2(lo2f(q.z) * qs, hi2f(q.z) * qs); q.w = pack2(lo2f(q.w) * qs, hi2f(q.w) * qs);
            *(u32x4*)(Qs + j * ML_LQ + c8 * 8) = q;
            *(u32x4*)(Ks + j * ML_LQ + c8 * 8) = pk[i];
            const u32x4 v = pv[i];
            bf16_t* vt = VT + (((tq >> 6) + i * 8) * 8) * ML_LT + (tq & 63);
            vt[0 * ML_LT] = (bf16_t)(v.x & 0xffff); vt[1 * ML_LT] = (bf16_t)(v.x >> 16); vt[2 * ML_LT] = (bf16_t)(v.y & 0xffff); vt[3 * ML_LT] = (bf16_t)(v.y >> 16);
            vt[4 * ML_LT] = (bf16_t)(v.z & 0xffff); vt[5 * ML_LT] = (bf16_t)(v.z >> 16); vt[6 * ML_LT] = (bf16_t)(v.w & 0xffff); vt[7 * ML_LT] = (bf16_t)(v.w >> 16);
        }
        if (wid == 0) {
            const float ig = bf2f(pgi) + ibias;
            const float lf = logsigmoidf_(bf2f(pgf) + fbias);
            const float b = wscan_add(lf);
            const float u = ig - b; const float pm = wscan_max(u);
            const float mj = fmaxf(b + m_state, b + pm);
            const float b63 = lane63(b), pm63 = lane63(pm);
            const float mnew = fmaxf(b63 + m_state, b63 + pm63);
            s_rowv[lane] = b - mj; s_colv[lane] = u; s_wint[lane] = __expf(b + m_state - mj); s_emj[lane] = __expf(-mj);
            s_E[lane] = __expf(b63 + u - mnew);
            if (lane == 0) { s_misc[0] = mnew; s_misc[1] = __expf(b63 + m_state - mnew); }
        }
        if (ci + 1 < TT / 64) ML_REQ(ci + 1);
        lds_barrier();
        {
            const int jt = wid >> 1;
#pragma unroll
            for (int q2 = 0; q2 < 2; ++q2) {
                const int st = (wid & 1) * 2 + q2;
                f32x4 acc = (f32x4){0.f, 0.f, 0.f, 0.f};
                if (st <= jt) {
                    bf16x8 fa[4], fb[4];
#pragma unroll
                    for (int k = 0; k < 4; ++k) { fa[k] = ldfrag(Qs, ML_LQ, jt * 16, k * 32, fr, fq); fb[k] = ldfrag(Ks, ML_LQ, st * 16, k * 32, fr, fq); }
                    __builtin_amdgcn_sched_barrier(0);
                    f32x4 acc2 = (f32x4){0.f, 0.f, 0.f, 0.f};
                    acc = mma16(fa[0], fb[0], acc); acc2 = mma16(fa[1], fb[1], acc2); acc = mma16(fa[2], fb[2], acc); acc2 = mma16(fa[3], fb[3], acc2);
                    acc = acc + acc2;
                }
                const int s = st * 16 + fr; const float cv = s_colv[s];
#pragma unroll
                for (int r = 0; r < 4; ++r) { const int j = jt * 16 + fq * 4 + r;
                    const float pv2 = (s <= j) ? acc[r] * __expf(s_rowv[j] + cv) : 0.f;
                    Ps[j * ML_LT + s] = f2bf(pv2); }
            }
#pragma unroll
            for (int i = 0; i < 2; ++i) {
                const int s = lane, c8 = wid + i * 8; const float e = s_E[s];
                const u32x4 kv = *(const u32x4*)(Ks + s * ML_LQ + c8 * 8);
                bf16_t* kt = KTE + (c8 * 8) * ML_LT + s;
                kt[0 * ML_LT] = f2bf(lo2f(kv.x) * e); kt[1 * ML_LT] = f2bf(hi2f(kv.x) * e); kt[2 * ML_LT] = f2bf(lo2f(kv.y) * e); kt[3 * ML_LT] = f2bf(hi2f(kv.y) * e);
                kt[4 * ML_LT] = f2bf(lo2f(kv.z) * e); kt[5 * ML_LT] = f2bf(hi2f(kv.z) * e); kt[6 * ML_LT] = f2bf(lo2f(kv.w) * e); kt[7 * ML_LT] = f2bf(hi2f(kv.w) * e);
            }
        }
        lds_barrier();
        f32x4 a1[4], a2[4];
        {
            const int jt = wid >> 1;
            bf16x8 fp[2], fqq[4];
#pragma unroll
            for (int k = 0; k < 2; ++k) fp[k] = ldfrag(Ps, ML_LT, jt * 16, k * 32, fr, fq);
#pragma unroll
            for (int k = 0; k < 4; ++k) fqq[k] = ldfrag(Qs, ML_LQ, jt * 16, k * 32, fr, fq);
            {
                bf16x8 fv[4][2];
#pragma unroll
                for (int q4 = 0; q4 < 4; ++q4)
#pragma unroll
                    for (int k = 0; k < 2; ++k) fv[q4][k] = ldfrag(VT, ML_LT, ((wid & 1) * 4 + q4) * 16, k * 32, fr, fq);
                __builtin_amdgcn_sched_barrier(0);
#pragma unroll
                for (int q4 = 0; q4 < 4; ++q4) a1[q4] = (f32x4){0.f, 0.f, 0.f, 0.f};
#pragma unroll
                for (int k = 0; k < 2; ++k)
#pragma unroll
                    for (int q4 = 0; q4 < 4; ++q4) a1[q4] = mma16(fv[q4][k], fp[k], a1[q4]);
            }
#pragma unroll
            for (int hh = 0; hh < 2; ++hh) {
                bf16x8 fc[2][4];
#pragma unroll
                for (int q2 = 0; q2 < 2; ++q2)
#pragma unroll
                    for (int k = 0; k < 4; ++k) fc[q2][k] = ldfrag(Cb, ML_LQ, ((wid & 1) * 4 + hh * 2 + q2) * 16, k * 32, fr, fq);
                __builtin_amdgcn_sched_barrier(0);
                a2[hh * 2] = (f32x4){0.f, 0.f, 0.f, 0.f}; a2[hh * 2 + 1] = (f32x4){0.f, 0.f, 0.f, 0.f};
#pragma unroll
                for (int k = 0; k < 4; ++k) { a2[hh * 2] = mma16(fc[0][k], fqq[k], a2[hh * 2]); a2[hh * 2 + 1] = mma16(fc[1][k], fqq[k], a2[hh * 2 + 1]); }
            }
            if (wid & 1) {
                f32x4 d1 = (f32x4){0.f, 0.f, 0.f, 0.f}, d2 = (f32x4){0.f, 0.f, 0.f, 0.f};
                bf16x8 fo[2], fn[4];
#pragma unroll
                for (int k = 0; k < 2; ++k) fo[k] = ldfrag(VT, ML_LT, 128, k * 32, fr, fq);
#pragma unroll
                for (int k = 0; k < 4; ++k) fn[k] = ldfrag(Cb, ML_LQ, 128, k * 32, fr, fq);
                __builtin_amdgcn_sched_barrier(0);
                d1 = mma16(fo[0], fp[0], d1); d2 = mma16(fn[0], fqq[0], d2); d1 = mma16(fo[1], fp[1], d1); d2 = mma16(fn[1], fqq[1], d2);
                d2 = mma16(fn[2], fqq[2], d2); d2 = mma16(fn[3], fqq[3], d2);
                if (fq == 0) { const int j = jt * 16 + fr; s_den[j] = fmaxf(fabsf(d1[0] + s_wint[j] * d2[0]), s_emj[j]); }
            }
        }
        lds_barrier();
        {
            const int jt = wid >> 1, j = jt * 16 + fr;
            const float wi = s_wint[j], rden = frcp_(s_den[j]);
            const size_t row = (size_t)bl * TT + scan_t<64>(dir, ci, j);
#pragma unroll
            for (int q4 = 0; q4 < 4; ++q4) { const int v0 = ((wid & 1) * 4 + q4) * 16 + fq * 4;
                st4bf(HOUT + row * ldh + h * 256 + vh * 128 + v0, (a1[q4] + a2[q4] * wi) * rden); }
        }
        {
            const float dec = s_misc[1];
            const bf16x8 bv0 = ldfrag(VT, ML_LT, wid * 16, 0, fr, fq), bv1 = ldfrag(VT, ML_LT, wid * 16, 32, fr, fq);
#pragma unroll
            for (int hh = 0; hh < 2; ++hh) {
                bf16x8 fk[4][2];
#pragma unroll
                for (int q = 0; q < 4; ++q) { fk[q][0] = ldfrag(KTE, ML_LT, (hh * 4 + q) * 16, 0, fr, fq); fk[q][1] = ldfrag(KTE, ML_LT, (hh * 4 + q) * 16, 32, fr, fq); }
                __builtin_amdgcn_sched_barrier(0);
#pragma unroll
                for (int q = 0; q < 4; ++q) Cacc[hh * 4 + q] = Cacc[hh * 4 + q] * dec;
#pragma unroll
                for (int q = 0; q < 4; ++q) Cacc[hh * 4 + q] = mma16(fk[q][0], bv0, Cacc[hh * 4 + q]);
#pragma unroll
                for (int q = 0; q < 4; ++q) Cacc[hh * 4 + q] = mma16(fk[q][1], bv1, Cacc[hh * 4 + q]);
#pragma unroll
                for (int q = 0; q < 4; ++q) st4bf(Cb + (wid * 16 + fr) * ML_LQ + (hh * 4 + q) * 16 + fq * 4, Cacc[hh * 4 + q]);
            }
            Nacc = Nacc * dec;
            Nacc = mma16(ldfrag(KTE, ML_LT, wid * 16, 0, fr, fq), ldfrag(VT, ML_LT, 128, 0, fr, fq), Nacc);
            Nacc = mma16(ldfrag(KTE, ML_LT, wid * 16, 32, fr, fq), ldfrag(VT, ML_LT, 128, 32, fr, fq), Nacc);
            st4bf(Cb + (128 + fr) * ML_LQ + wid * 16 + fq * 4, Nacc);
            m_state = s_misc[0];
        }
        lds_barrier();
    }
#undef ML_REQ
}

constexpr size_t L0_XC = L0_U;
static_assert(L0_XC + (size_t)RG * 1280 * 2 <= BIG_BYTES, "xconv buffer");
PHASE_FN void phase_xconv(const KP& kp) {
    const int lane = otid() & 63, wid = __builtin_amdgcn_readfirstlane(otid() >> 6);
    const bf16_t* P = WSP(const bf16_t, WS_BIG + L0_P); bf16_t* XC = WSP(bf16_t, WS_BIG + L0_XC);
    const float* cw = KIN(12); const float* cb = KIN(13);
    constexpr int RUN = 9;
    for (int run = obid() * 8 + wid; run < RG / RUN; run += gridDim.x * 8) {
        const int r0 = run * RUN;
#pragma unroll
        for (int i = 0; i < 5; ++i) { const int col = i * 256 + lane * 4;
            const f32x4 bias = *(const f32x4*)(cb + col);
            f32x4 w[5], x[5];
#pragma unroll
            for (int q = 0; q < 5; ++q) w[q] = *(const f32x4*)(cw + q * 1280 + col);
#pragma unroll
            for (int q = 0; q < 4; ++q) { const int rr = r0 - 2 + q; x[q + 1] = (rr >= 0 && rr < RG) ? ld4bf(P + (size_t)rr * AB_N + AB_XBC + col) : (f32x4){0.f, 0.f, 0.f, 0.f}; }
#pragma unroll
            for (int k = 0; k < RUN; ++k) {
                const int lr = r0 + k, bl = lr / TT, t = lr - bl * TT, lo = t < CTXL ? 0 : CTXL, hi = t < CTXL ? CTXL : TT;
#pragma unroll
                for (int q = 0; q < 4; ++q) x[q] = x[q + 1];
                { const int rr = lr + 2; x[4] = (rr < RG) ? ld4bf(P + (size_t)rr * AB_N + AB_XBC + col) : (f32x4){0.f, 0.f, 0.f, 0.f}; }
                f32x4 a = bias;
#pragma unroll
                for (int q = 0; q < 5; ++q) { const int tt = t - 2 + q; if (tt >= lo && tt < hi) a += w[q] * x[q]; }
                f32x4 o;
#pragma unroll
                for (int r = 0; r < 4; ++r) o[r] = siluf_(a[r]);
                st4bf(XC + (size_t)lr * 1280 + col, o);
            }
        }
    }
}

constexpr int SS_LT = 72, SS_LX = 136;
PHASE_FN void ssd_unit(const KP& kp, unsigned char* lds, int bl, int dir, int hp) {
    const int tid = otid();
    const int gi = hp >> 2, hh0 = hp * 2;
    bf16_t* Wm = (bf16_t*)lds;
    bf16_t* CM = Wm + 2 * 64 * SS_LT;
    bf16_t* BM = CM + 64 * SS_LT;
    bf16_t* Xn = BM + 64 * SS_LT;
    bf16_t* XT = Xn + 64 * SS_LX;
    bf16_t* BTE = XT + 2 * 64 * SS_LT;
    bf16_t* Sb = BTE + 2 * 64 * SS_LT;
    float* fs = (float*)(Sb + 2 * 64 * SS_LT);
    float* s_b = fs;
    float* s_dt = fs + 128;
    float* s_e = fs + 256;
    float* s_misc = fs + 384;
    const bf16_t* P = WSP(const bf16_t, WS_BIG + L0_P); const bf16_t* XC = WSP(const bf16_t, WS_BIG + L0_XC);
    bf16_t* YOUT = WSP(bf16_t, WS_BIG + (dir ? L0_YB : L0_AO + 2048)); const int ldy = dir ? 1024 : 2048;
    for (int i = tid; i < 2 * 64 * SS_LT; i += 512) Sb[i] = 0;
    f32x4 Sacc[4];
#pragma unroll
    for (int i = 0; i < 4; ++i) Sacc[i] = (f32x4){0.f, 0.f, 0.f, 0.f};
    const float dtb = KIN(14)[dir * 16 + hh0 + ((tid >> 6) & 1)], aexp = __expf(KIN(15)[dir * 16 + hh0 + ((tid >> 6) & 1)]);
    const float dskip = KIN(16)[hh0 + (tid >> 8)];
    u32x4 pr[4]; bf16_t pdt = 0;
#define SS_REQ(ci_) do { _Pragma("unroll") for (int q = 0; q < 4; ++q) { const int p = tid + q * 512, j = p >> 5, c8 = p & 31; \
            const int col = c8 < 16 ? hh0 * 64 + c8 * 8 : (c8 < 24 ? 1024 + gi * 64 + (c8 - 16) * 8 : 1152 + gi * 64 + (c8 - 24) * 8); \
            pr[q] = *(const u32x4*)(XC + ((size_t)bl * TT + scan_t<64>(dir, (ci_), j)) * 1280 + col); } \
        if (tid < 128) pdt = P[((size_t)bl * TT + scan_t<64>(dir, (ci_), tid & 63)) * AB_N + AB_DT + dir * 16 + hh0 + (tid >> 6)]; } while (0)
    SS_REQ(0);
    lds_barrier();
    for (int ci = 0; ci < TT / 64; ++ci) {
        int tq = tid; asm volatile("" : "+v"(tq));
        const int lane = tq & 63, wid = __builtin_amdgcn_readfirstlane(tq >> 6), fr = lane & 15, fq = lane >> 4, hl_w = wid >> 2;
#pragma unroll
        for (int q = 0; q < 4; ++q) { const int p = tq + q * 512, j = p >> 5, c8 = p & 31;
            bf16_t* dst = c8 < 16 ? Xn + j * SS_LX + c8 * 8 : (c8 < 24 ? BM + j * SS_LT + (c8 - 16) * 8 : CM + j * SS_LT + (c8 - 24) * 8);
            *(u32x4*)dst = pr[q]; }
        if (wid < 2) {
            const float dt = softplusf_(bf2f(pdt) + dtb);
            const float b = wscan_add(-dt * aexp);
            const float b63 = lane63(b);
            s_b[wid * 64 + lane] = b; s_dt[wid * 64 + lane] = dt; s_e[wid * 64 + lane] = __expf(b63 - b) * dt;
            if (lane == 0) s_misc[wid] = __expf(b63);
        }
        if (ci + 1 < TT / 64) SS_REQ(ci + 1);
        lds_barrier();
        {
            const int jt = wid >> 1;
#pragma unroll
            for (int q2 = 0; q2 < 2; ++q2) {
                const int st = (wid & 1) * 2 + q2;
                f32x4 acc = (f32x4){0.f, 0.f, 0.f, 0.f};
                if (st <= jt) {
                    const bf16x8 c0 = ldfrag(CM, SS_LT, jt * 16, 0, fr, fq), c1 = ldfrag(CM, SS_LT, jt * 16, 32, fr, fq), b0 = ldfrag(BM, SS_LT, st * 16, 0, fr, fq), b1 = ldfrag(BM, SS_LT, st * 16, 32, fr, fq);
                    __builtin_amdgcn_sched_barrier(0);
                    acc = mma16(c0, b0, acc); acc = mma16(c1, b1, acc);
                }
                const int s = st * 16 + fr;
#pragma unroll
                for (int hl = 0; hl < 2; ++hl) { const float bs = s_b[hl * 64 + s], ds = s_dt[hl * 64 + s];
#pragma unroll
                    for (int r = 0; r < 4; ++r) { const int j = jt * 16 + fq * 4 + r;
                        const float wv = (s <= j) ? acc[r] * __expf(s_b[hl * 64 + j] - bs) * ds : 0.f;
                        Wm[(hl * 64 + j) * SS_LT + s] = f2bf(wv); } }
            }
            {
                const int s = lane, n8 = wid;
                const u32x4 bv = *(const u32x4*)(BM + s * SS_LT + n8 * 8);
#pragma unroll
                for (int hl = 0; hl < 2; ++hl) { const float e = s_e[hl * 64 + s];
                    bf16_t* bt = BTE + (hl * 64 + n8 * 8) * SS_LT + s;
                    bt[0 * SS_LT] = f2bf(lo2f(bv.x) * e); bt[1 * SS_LT] = f2bf(hi2f(bv.x) * e); bt[2 * SS_LT] = f2bf(lo2f(bv.y) * e); bt[3 * SS_LT] = f2bf(hi2f(bv.y) * e);
                    bt[4 * SS_LT] = f2bf(lo2f(bv.z) * e); bt[5 * SS_LT] = f2bf(hi2f(bv.z) * e); bt[6 * SS_LT] = f2bf(lo2f(bv.w) * e); bt[7 * SS_LT] = f2bf(hi2f(bv.w) * e); }
#pragma unroll
                for (int i = 0; i < 2; ++i) { const int c8 = wid + i * 8;
                    const u32x4 xv = *(const u32x4*)(Xn + s * SS_LX + c8 * 8);
                    bf16_t* xt = XT + (c8 * 8) * SS_LT + s;
                    xt[0 * SS_LT] = (bf16_t)(xv.x & 0xffff); xt[1 * SS_LT] = (bf16_t)(xv.x >> 16); xt[2 * SS_LT] = (bf16_t)(xv.y & 0xffff); xt[3 * SS_LT] = (bf16_t)(xv.y >> 16);
                    xt[4 * SS_LT] = (bf16_t)(xv.z & 0xffff); xt[5 * SS_LT] = (bf16_t)(xv.z >> 16); xt[6 * SS_LT] = (bf16_t)(xv.w & 0xffff); xt[7 * SS_LT] = (bf16_t)(xv.w >> 16); }
            }
        }
        lds_barrier();
        {
            const int hl = hl_w, jt = wid & 3, j = jt * 16 + fr;
            const bf16_t* Wh = Wm + hl * 64 * SS_LT; const bf16_t* Xh = XT + hl * 64 * SS_LT; const bf16_t* Sh = Sb + hl * 64 * SS_LT;
            const float eb = __expf(s_b[hl * 64 + j]);
            const size_t row = (size_t)bl * TT + scan_t<64>(dir, ci, j);
            const bf16x8 w0 = ldfrag(Wh, SS_LT, jt * 16, 0, fr, fq), w1 = ldfrag(Wh, SS_LT, jt * 16, 32, fr, fq), m0 = ldfrag(CM, SS_LT, jt * 16, 0, fr, fq), m1 = ldfrag(CM, SS_LT, jt * 16, 32, fr, fq);
#pragma unroll
            for (int hh = 0; hh < 2; ++hh) {
                bf16x8 fx[2][2], fs2[2][2];
#pragma unroll
                for (int q = 0; q < 2; ++q)
#pragma unroll
                    for (int k = 0; k < 2; ++k) { fx[q][k] = ldfrag(Xh, SS_LT, (hh * 2 + q) * 16, k * 32, fr, fq); fs2[q][k] = ldfrag(Sh, SS_LT, (hh * 2 + q) * 16, k * 32, fr, fq); }
                f32x4 dx[2];
                if (!dir) { dx[0] = ld4bf(Xn + j * SS_LX + hl * 64 + (hh * 2) * 16 + fq * 4); dx[1] = ld4bf(Xn + j * SS_LX + hl * 64 + (hh * 2 + 1) * 16 + fq * 4); }
                __builtin_amdgcn_sched_barrier(0);
                f32x4 y1[2], y2[2];
#pragma unroll
                for (int q = 0; q < 2; ++q) { y1[q] = (f32x4){0.f, 0.f, 0.f, 0.f}; y2[q] = (f32x4){0.f, 0.f, 0.f, 0.f}; }
#pragma unroll
                for (int q = 0; q < 2; ++q) { y1[q] = mma16(fx[q][0], w0, y1[q]); y2[q] = mma16(fs2[q][0], m0, y2[q]); }
#pragma unroll
                for (int q = 0; q < 2; ++q) { y1[q] = mma16(fx[q][1], w1, y1[q]); y2[q] = mma16(fs2[q][1], m1, y2[q]); }
#pragma unroll
                for (int q = 0; q < 2; ++q) { f32x4 y = y1[q] + y2[q] * eb;
                    if (!dir) y = y + dx[q] * dskip;
                    st4bf(YOUT + row * ldy + (hh0 + hl) * 64 + (hh * 2 + q) * 16 + fq * 4, y); }
            }
        }
        lds_barrier();
        {
            const int hl = hl_w, pt = wid & 3; const float eb63 = s_misc[hl];
            const bf16_t* Xh = XT + hl * 64 * SS_LT; const bf16_t* Bh = BTE + hl * 64 * SS_LT; bf16_t* Sh = Sb + hl * 64 * SS_LT;
            const bf16x8 x0 = ldfrag(Xh, SS_LT, pt * 16, 0, fr, fq), x1 = ldfrag(Xh, SS_LT, pt * 16, 32, fr, fq);
            bf16x8 fb[4][2];
#pragma unroll
            for (int nt = 0; nt < 4; ++nt) { fb[nt][0] = ldfrag(Bh, SS_LT, nt * 16, 0, fr, fq); fb[nt][1] = ldfrag(Bh, SS_LT, nt * 16, 32, fr, fq); }
            __builtin_amdgcn_sched_barrier(0);
#pragma unroll
            for (int nt = 0; nt < 4; ++nt) Sacc[nt] = Sacc[nt] * eb63;
#pragma unroll
            for (int nt = 0; nt < 4; ++nt) Sacc[nt] = mma16(fb[nt][0], x0, Sacc[nt]);
#pragma unroll
            for (int nt = 0; nt < 4; ++nt) Sacc[nt] = mma16(fb[nt][1], x1, Sacc[nt]);
#pragma unroll
            for (int nt = 0; nt < 4; ++nt) st4bf(Sh + (pt * 16 + fr) * SS_LT + nt * 16 + fq * 4, Sacc[nt]);
        }
        lds_barrier();
    }
#undef SS_REQ
}

__device__ __forceinline__ void phase_scan_ab(const KP& kp, unsigned char* lds) {
    for (int rep = 0; rep < ((PROBE_DUP & 8192) ? 2 : 1); ++rep)
    for (int u = obid(); u < 256; u += gridDim.x) if (u < 128) { const int r = ((u >> 4) << 3) | (u & 7);
        mlstm_unit(kp, lds, r >> 3, (r >> 1) & 3, r & 1, (u >> 3) & 1); __syncthreads(); }
    for (int rep = 0; rep < ((PROBE_DUP & 16384) ? 2 : 1); ++rep)
    for (int u = obid(); u < 256; u += gridDim.x) if (u >= 128) { const int v = u - 128, r = ((v >> 5) << 3) | (v & 7);
        ssd_unit(kp, lds, r >> 2, (r >> 1) & 1, (r & 1) * 4 + ((v >> 3) & 3)); __syncthreads(); }
}

PHASE_FN void phase_fin_ab(const KP& kp) {
    const int lane = otid() & 63, wid = __builtin_amdgcn_readfirstlane(otid() >> 6);
    const bf16_t* P = WSP(const bf16_t, WS_BIG + L0_P);
    bf16_t* AO = WSP(bf16_t, WS_BIG + L0_AO); const bf16_t* HB = WSP(const bf16_t, WS_BIG + L0_HB); const bf16_t* YB = WSP(const bf16_t, WS_BIG + L0_YB);
    const float* mln = KIN(11); const float* sn = KIN(17);
    for (int lr = obid() * 8 + wid; lr < RG; lr += gridDim.x * 8) {
        const bf16_t* pr = P + (size_t)lr * AB_N;
        f32x4 yz[4]; float ss2 = 0.f;
#pragma unroll
        for (int i = 0; i < 4; ++i) { const int col = i * 256 + lane * 4;
            const f32x4 hs = ld4bf(AO + (size_t)lr * 2048 + col) + ld4bf(HB + (size_t)lr * 1024 + col);
            float ss = hs[0] * hs[0] + hs[1] * hs[1] + hs[2] * hs[2] + hs[3] * hs[3];
            ss = wsum(ss); const float rstd = rsqrtf(ss * (1.0f / 256.0f) + EPS);
            const f32x4 og = ld4bf(pr + AB_OG + col), w = *(const f32x4*)(mln + col);
            f32x4 o;
#pragma unroll
            for (int r = 0; r < 4; ++r) o[r] = hs[r] * rstd * w[r] * sigmoidf_(og[r]);
            st4bf(AO + (size_t)lr * 2048 + col, o);
            const f32x4 ys = ld4bf(AO + (size_t)lr * 2048 + 1024 + col) + ld4bf(YB + (size_t)lr * 1024 + col), z = ld4bf(pr + AB_Z + col);
#pragma unroll
            for (int r = 0; r < 4; ++r) { yz[i][r] = ys[r] * siluf_(z[r]); ss2 += yz[i][r] * yz[i][r]; }
        }
        ss2 = wsum(ss2); const float rstd2 = rsqrtf(ss2 * (1.0f / 1024.0f) + EPS);
#pragma unroll
        for (int i = 0; i < 4; ++i) { const int col = i * 256 + lane * 4; st4bf(AO + (size_t)lr * 2048 + 1024 + col, yz[i] * rstd2 * *(const f32x4*)(sn + col)); }
    }
}

PHASE_FN void phase_gemm_in(const KP& kp, unsigned char* lds, int layer, int grp) {
    const int npad = layer == 0 ? AB_NPAD : CD_NPAD, n = layer == 0 ? AB_N : CD_N;
    pg8::StaticOrder S; S.init(RG, npad, (int)gridDim.x, obid());
    if (layer == 0) {
        pg8::Gemm g{grp == 0 ? WSP(const bf16_t, WS_BIG + L0_U) : WSP(const bf16_t, WS_V) + (size_t)grp * RG * 1024, WSP(const bf16_t, WS_WMIX), RG, npad, 1024, nullptr, 0x7fffffff};
        pg8::EpiBfG E{WSP(bf16_t, WS_BIG), n, n, 0x7fffffff, 1.0f};
        pg8::gemm_phase<pg8::EpiBfG, pg8::StaticOrder, false>((PG8_LAS unsigned char*)lds, g, S, E, nullptr);
    } else {
        pg8::Gemm g{WSP(const bf16_t, WS_V) + (size_t)grp * RG * 1024, WSP(const bf16_t, WS_WMIX), RG, npad, 512, nullptr, 0x7fffffff, 1024, 0};
        pg8::EpiBfG E{WSP(bf16_t, WS_BIG), n, n, 0x7fffffff, W8_INV};
        pg8::gemm_phase<pg8::EpiBfG, pg8::StaticOrder, false, true>((PG8_LAS unsigned char*)lds, g, S, E, nullptr);
    }
    __syncthreads();
}
PHASE_FN void phase_gemm_out_ab(const KP& kp, unsigned char* lds, int grp) {
    pg8::Gemm g{WSP(const bf16_t, WS_BIG + L0_AO), WSP(const bf16_t, WS_WMIX + WM_AB_OUT), RG, 1024, 2048, nullptr, 0x7fffffff};
    pg8::StaticOrder S; S.init(RG, 1024, (int)gridDim.x, obid());
    pg8::EpiBfG E{WSP(bf16_t, WS_BIG + L0_U), 1024, 1024, 0x7fffffff, 1.0f};
    pg8::gemm_phase<pg8::EpiBfG, pg8::StaticOrder, false>((PG8_LAS unsigned char*)lds, g, S, E, nullptr);
    __syncthreads();
    const int G = (int)gridDim.x, units = (RG / 256) * 4, two = units > G ? (units - G < G ? units - G : G) : 0;
    const int nb = G - two > 0 ? G - two : G, bid = G - two > 0 ? obid() - two : obid();
    if (bid >= 0) { if (grp == 0) phase_u(kp, 0, 1, bid, nb, true); else phase_conv_moe(kp, lds, 0, bid, nb); }
    __syncthreads();
}

PHASE_FN void phase_prep_cd(const KP& kp) {
    const int lane = otid() & 63, wid = __builtin_amdgcn_readfirstlane(otid() >> 6);
    bf16_t* P = WSP(bf16_t, WS_BIG + L1_P);
    bf16_t* SG = WSP(bf16_t, WS_SG);
    const float* qn = KIN(20); const float* kvn = KIN(22); const float* mu = KIN(24);
    for (int lr = obid() * 8 + wid; lr < RG; lr += gridDim.x * 8) {
        const int bl = lr / TT, t = lr - bl * TT;
        bf16_t* pr = P + (size_t)lr * CD_N;
        {
            const f32x4 x = ld4bf(pr + CD_M1 + lane * 4);
            float ss = x[0] * x[0] + x[1] * x[1] + x[2] * x[2] + x[3] * x[3]; ss = wsum(ss);
            const float rstd = rsqrtf(ss * (1.0f / 256.0f) + EPS);
            st4bf(pr + CD_M1 + lane * 4, x * rstd * *(const f32x4*)(kvn + lane * 4));
        }
        {
            const int lo = t < CTXL ? 0 : CTXL, hi = t < CTXL ? CTXL : TT, c = lane * 4;
            const f32x4 x = ld4bf(pr + CD_WL + c);
            const f32x4 xp = t > lo ? ld4bf(pr - CD_N + CD_WL + c) : (f32x4){0.f, 0.f, 0.f, 0.f};
            const f32x4 xn = t < hi - 1 ? ld4bf(pr + CD_N + CD_WL + c) : (f32x4){0.f, 0.f, 0.f, 0.f};
            f32x4 l = x + *(const f32x4*)(mu + CD_WL - CD_RW0 + c) * ((xp + xn) * 0.5f - x);
            if (c < 128) {
#pragma unroll
                for (int q = 0; q < 4; ++q) l[q] = tanhf_(l[q]); }
            st4bf(WSP(bf16_t, WS_BIG + L1_TWAL) + (size_t)lr * 256 + c, l);
        }
        if (t >= CTXL) {
            const int s = t - CTXL;
            float x0[3], x1[3]; float ss = 0.f;
#pragma unroll
            for (int i = 0; i < 3; ++i) { const unsigned w = *(const unsigned*)(pr + CD_M0 + i * 128 + lane * 2); x0[i] = lo2f(w); x1[i] = hi2f(w); ss += x0[i] * x0[i] + x1[i] * x1[i]; }
            ss = wsum(ss); const float rstd = rsqrtf(ss * (1.0f / 384.0f) + EPS);
#pragma unroll
            for (int i = 0; i < 3; ++i) { const int c = i * 128 + lane * 2; *(unsigned*)(pr + CD_M0 + c) = pack2(x0[i] * rstd * qn[c], x1[i] * rstd * qn[c + 1]); }
            if (lane < 16) {
                const float pos = (lane < 8) ? (float)(s >> 6) : (float)(s & 63);
                const float inv = __expf(-(float)(lane & 7) * (9.210340371976184f / 8.0f));
                float sn, cs; sincosf(pos * inv, &sn, &cs);
                const float a = bf2f(pr[CD_KR + lane]), b2 = bf2f(pr[CD_KR + 16 + lane]);
                pr[CD_KR + lane] = f2bf(a * cs - b2 * sn); pr[CD_KR + 16 + lane] = f2bf(a * sn + b2 * cs);
            }
            {
                const int c = lane * 2;
                const unsigned w = *(const unsigned*)(pr + CD_GL + c);
                const unsigned wp = s > 0 ? *(const unsigned*)(pr - CD_N + CD_GL + c) : 0u;
                const unsigned wn = s < SEQ - 1 ? *(const unsigned*)(pr + CD_N + CD_GL + c) : 0u;
                const float m0 = mu[CD_GL - CD_RW0 + c], m1 = mu[CD_GL - CD_RW0 + c + 1];
                const float g0 = lo2f(w) + m0 * (0.5f * (lo2f(wp) + lo2f(wn)) - lo2f(w));
                const float g1 = hi2f(w) + m1 * (0.5f * (hi2f(wp) + hi2f(wn)) - hi2f(w));
                *(unsigned*)(SG + ((size_t)bl * SEQ + s) * 128 + c) = pack2(sigmoidf_(g0), sigmoidf_(g1));
            }
        }
    }
}

PHASE_FN void phase_upproj(const KP& kp, unsigned char* lds) {
    const bf16_t* P = WSP(const bf16_t, WS_BIG + L1_P);
    {
        pg8::Gemm g{P + CD_M0, WSP(const bf16_t, WS_WMIX + WM_UQ), RGL, 768, 384, nullptr, 0x7fffffff, CD_N, 1};
        pg8::StaticOrder S; S.init(RGL, 768, (int)gridDim.x, obid());
        pg8::EpiBfG E{WSP(bf16_t, WS_BIG + L1_Q), 768, 768, 0x7fffffff, 1.0f};
        pg8::gemm_phase<pg8::EpiBfG, pg8::StaticOrder, false>((PG8_LAS unsigned char*)lds, g, S, E, nullptr);
    }
    __syncthreads();
    {
        pg8::Gemm g{P + CD_M1, WSP(const bf16_t, WS_WMIX + WM_UKV), RG, 1024, 256, nullptr, 0x7fffffff, CD_N, 0};
        pg8::StaticOrder S; S.init(RG, 1024, (int)gridDim.x, (obid() + 64) % (int)gridDim.x);
        pg8::EpiBfG E{WSP(bf16_t, WS_BIG + L1_KV), 1024, 1024, 0x7fffffff, 1.0f};
        pg8::gemm_phase<pg8::EpiBfG, pg8::StaticOrder, false>((PG8_LAS unsigned char*)lds, g, S, E, nullptr);
    }
    __syncthreads();
}

constexpr int AT_LQ = 104, AT_LV = 72;
PHASE_FN void attn_unit(const KP& kp, unsigned char* lds, int bl, int head, int qb) {
    const int tid = otid(), lane = tid & 63, wid = __builtin_amdgcn_readfirstlane(tid >> 6), fr = lane & 15, fq = lane >> 4;
    bf16_t* Qs = (bf16_t*)lds;
    bf16_t* Kt = Qs + 256 * AT_LQ;
    bf16_t* Vt = Kt + 2 * 64 * AT_LQ;
    const bf16_t* P = WSP(const bf16_t, WS_BIG + L1_P);
    const bf16_t* Q = WSP(const bf16_t, WS_BIG + L1_Q);
    const bf16_t* KV = WSP(const bf16_t, WS_BIG + L1_KV);
    bf16_t* AOUT = WSP(bf16_t, WS_BIG + L1_AOUT);
    const float SC = 0.10206207261596577f;
#pragma unroll
    for (int i = 0; i < 6; ++i) { const int p = tid + i * 512, r = p / 12, c = p % 12;
        *(u32x4*)(Qs + r * AT_LQ + c * 8) = *(const u32x4*)(Q + ((size_t)bl * SEQ + qb * 256 + r) * 768 + head * 96 + c * 8); }
    lds_barrier();
#pragma unroll
    for (int i = 0; i < 8; ++i) { const int p = tid + i * 512, r = p >> 4, f = p & 15, s = qb * 256 + r;
        const float pos = (f < 8) ? (float)(s >> 6) : (float)(s & 63);
        const float inv = __expf(-(float)(f & 7) * (9.210340371976184f / 8.0f));
        float sn, cs; sincosf(pos * inv, &sn, &cs);
        const float a = bf2f(Qs[r * AT_LQ + 64 + f]), b2 = bf2f(Qs[r * AT_LQ + 80 + f]);
        Qs[r * AT_LQ + 64 + f] = f2bf(a * cs - b2 * sn); Qs[r * AT_LQ + 80 + f] = f2bf(a * sn + b2 * cs); }
    lds_barrier();
    bf16x8 qf[2][3];
#pragma unroll
    for (int rt = 0; rt < 2; ++rt)
#pragma unroll
        for (int k = 0; k < 3; ++k) qf[rt][k] = ldfrag(Qs, AT_LQ, wid * 32 + rt * 16, k * 32, fr, fq);
    f32x4 ot[2][4];
#pragma unroll
    for (int rt = 0; rt < 2; ++rt)
#pragma unroll
        for (int i = 0; i < 4; ++i) ot[rt][i] = (f32x4){0.f, 0.f, 0.f, 0.f};
    float mrow[2] = {-1e30f, -1e30f}, lsum[2] = {0.f, 0.f};
    u32x4 pk0[2], pk1[2], pvv[2];
    const int kkey0 = tid / 12, kc0 = tid % 12, kkey1 = (tid + 512) / 12, kc1 = (tid + 512) % 12, vkey = tid & 63, vc8 = tid >> 6;
#define AT_REQ(kt_) do { _Pragma("unroll") for (int h_ = 0; h_ < 2; ++h_) { const size_t rb_ = (size_t)bl * TT + ((kt_) * 2 + h_) * 64; \
        pk0[h_] = kc0 < 8 ? *(const u32x4*)(KV + (rb_ + kkey0) * 1024 + head * 128 + kc0 * 8) : *(const u32x4*)(P + (rb_ + kkey0) * CD_N + CD_KR + (kc0 - 8) * 8); \
        if (tid < 256) pk1[h_] = kc1 < 8 ? *(const u32x4*)(KV + (rb_ + kkey1) * 1024 + head * 128 + kc1 * 8) : *(const u32x4*)(P + (rb_ + kkey1) * CD_N + CD_KR + (kc1 - 8) * 8); \
        pvv[h_] = *(const u32x4*)(KV + (rb_ + vkey) * 1024 + head * 128 + 64 + vc8 * 8); } } while (0)
    AT_REQ(0);
    const float SC2 = SC * 1.4426950408889634f;
    for (int kt = 0; kt < TT / 128; ++kt) {
        lds_barrier();
#pragma unroll
        for (int h_ = 0; h_ < 2; ++h_) {
            *(u32x4*)(Kt + (h_ * 64 + kkey0) * AT_LQ + kc0 * 8) = pk0[h_];
            if (tid < 256) *(u32x4*)(Kt + (h_ * 64 + kkey1) * AT_LQ + kc1 * 8) = pk1[h_];
            { bf16_t* vt = Vt + (h_ * 64 + vc8 * 8) * AT_LV + vkey; const u32x4 v = pvv[h_];
                vt[0 * AT_LV] = (bf16_t)(v.x & 0xffff); vt[1 * AT_LV] = (bf16_t)(v.x >> 16); vt[2 * AT_LV] = (bf16_t)(v.y & 0xffff); vt[3 * AT_LV] = (bf16_t)(v.y >> 16);
                vt[4 * AT_LV] = (bf16_t)(v.z & 0xffff); vt[5 * AT_LV] = (bf16_t)(v.z >> 16); vt[6 * AT_LV] = (bf16_t)(v.w & 0xffff); vt[7 * AT_LV] = (bf16_t)(v.w >> 16); }
        }
        if (kt + 1 < TT / 128) AT_REQ(kt + 1);
        lds_barrier();
        {
        bf16x8 kf[3][4]; f32x4 sta[2][4], stb[2][4]; u32x2 vlo[2][4], vhi[2][4];
        union { bf16x8 v; unsigned u[4]; } pb[2][2];
#define AT_LOADK(hs_) do { const bf16_t* Kth = Kt + (hs_) * 64 * AT_LQ; \
            _Pragma("unroll") for (int k = 0; k < 3; ++k) _Pragma("unroll") for (int kk = 0; kk < 4; ++kk) kf[k][kk] = ldfrag(Kth, AT_LQ, kk * 16, k * 32, fr, fq); } while (0)
#define AT_LOADV(hs_) do { const bf16_t* Vth = Vt + (hs_) * 64 * AT_LV; \
            _Pragma("unroll") for (int k2 = 0; k2 < 2; ++k2) _Pragma("unroll") for (int dvt = 0; dvt < 4; ++dvt) { const bf16_t* vp = Vth + (dvt * 16 + fr) * AT_LV + k2 * 32 + fq * 4; vlo[k2][dvt] = *(const u32x2*)vp; vhi[k2][dvt] = *(const u32x2*)(vp + 16); } } while (0)
#define AT_QK(st) do { _Pragma("unroll") for (int rt = 0; rt < 2; ++rt) _Pragma("unroll") for (int kk = 0; kk < 4; ++kk) st[rt][kk] = (f32x4){0.f, 0.f, 0.f, 0.f}; \
            _Pragma("unroll") for (int k = 0; k < 3; ++k) _Pragma("unroll") for (int kk = 0; kk < 4; ++kk) _Pragma("unroll") for (int rt = 0; rt < 2; ++rt) st[rt][kk] = mma16(kf[k][kk], qf[rt][k], st[rt][kk]); } while (0)
#define AT_SM(st) do { _Pragma("unroll") for (int rt = 0; rt < 2; ++rt) { \
            float mx = -1e30f; \
            _Pragma("unroll") for (int kk = 0; kk < 4; ++kk) mx = fmaxf(mx, fmaxf(fmaxf(st[rt][kk][0], st[rt][kk][1]), fmaxf(st[rt][kk][2], st[rt][kk][3]))); \
            mx = xmax_rows(mx); \
            const float mold = mrow[rt], mnew = fmaxf(mold, mx), mb = mnew * SC2; \
            float ls = 0.f; \
            _Pragma("unroll") for (int kk = 0; kk < 4; ++kk) _Pragma("unroll") for (int r = 0; r < 4; ++r) { const float pv = __builtin_amdgcn_exp2f(st[rt][kk][r] * SC2 - mb); st[rt][kk][r] = pv; ls += pv; } \
            _Pragma("unroll") for (int k2 = 0; k2 < 2; ++k2) { \
                pb[rt][k2].u[0] = pack2(st[rt][2 * k2][0], st[rt][2 * k2][1]); pb[rt][k2].u[1] = pack2(st[rt][2 * k2][2], st[rt][2 * k2][3]); \
                pb[rt][k2].u[2] = pack2(st[rt][2 * k2 + 1][0], st[rt][2 * k2 + 1][1]); pb[rt][k2].u[3] = pack2(st[rt][2 * k2 + 1][2], st[rt][2 * k2 + 1][3]); } \
            if (__builtin_amdgcn_ballot_w64(mnew > mold) != 0ull) {         \
                const float alpha = __builtin_amdgcn_exp2f((mold - mnew) * SC2); \
                lsum[rt] *= alpha; \
                _Pragma("unroll") for (int i = 0; i < 4; ++i) ot[rt][i] = ot[rt][i] * alpha; } \
            mrow[rt] = mnew; lsum[rt] += ls; } } while (0)
#define AT_PV() do { _Pragma("unroll") for (int k2 = 0; k2 < 2; ++k2) _Pragma("unroll") for (int dvt = 0; dvt < 4; ++dvt) { union { bf16x8 v; u32x2 h[2]; } va; va.h[0] = vlo[k2][dvt]; va.h[1] = vhi[k2][dvt]; \
            _Pragma("unroll") for (int rt = 0; rt < 2; ++rt) ot[rt][dvt] = mma16(va.v, pb[rt][k2].v, ot[rt][dvt]); } } while (0)
        AT_LOADK(0);
        __builtin_amdgcn_sched_barrier(0);
        AT_QK(sta);
        AT_LOADK(1);
        AT_QK(stb);
        AT_LOADV(0);
        __builtin_amdgcn_sched_barrier(0);
        AT_SM(sta);
        AT_PV();
        AT_LOADV(1);
        __builtin_amdgcn_sched_barrier(0);
        AT_SM(stb);
        AT_PV();
#undef AT_LOADK
#undef AT_LOADV
#undef AT_QK
#undef AT_SM
#undef AT_PV
        }
    }
#undef AT_REQ
#pragma unroll
    for (int rt = 0; rt < 2; ++rt) {
        float ls = lsum[rt]; ls += __shfl_xor(ls, 16); ls += __shfl_xor(ls, 32);
        const float rl = frcp_(ls);
        const size_t orow = (size_t)bl * SEQ + qb * 256 + wid * 32 + rt * 16 + fr;
#pragma unroll
        for (int dvt = 0; dvt < 4; ++dvt) st4bf(AOUT + orow * 1536 + head * 64 + dvt * 16 + fq * 4, ot[rt][dvt] * rl);
    }
}

constexpr int RW_LR = 200, RW_LP = 72;
struct TrueT { static constexpr bool value = true; }; struct FalseT { static constexpr bool value = false; };
PHASE_FN void rwkv_unit(const KP& kp, unsigned char* lds, int bl, int h, int dir) {
    const int tid = otid();
    constexpr int NC = TT / 32;
    bf16_t* RAW = (bf16_t*)lds;
    bf16_t* TWb = RAW + 34 * RW_LR;
    bf16_t* ALb = TWb + 32 * RW_LP;
    float* WLf = (float*)(ALb + 32 * RW_LP);
    float* ALf = WLf + 32 * 64;
    bf16_t* BK = (bf16_t*)WLf;
    float* WT = ALf + 32 * 64;
    bf16_t* AR = (bf16_t*)(WT + 8 * 64);
    float* AABT = (float*)(AR + 64 * RW_LP);
    bf16_t* ARB0 = (bf16_t*)(AABT + 32 * 36);
    bf16_t* AAK = ARB0 + 2 * 32 * 40;
    bf16_t* ARK = AAK + 32 * 40;
    float* RHS = (float*)(ARK + 32 * 40);
    float* YB = RHS + 32 * 64;
    bf16_t* ZVT0 = (bf16_t*)(YB + 32 * 64);
    bf16_t* BKh0 = ZVT0 + 2 * 64 * RW_LP;
    bf16_t* Sb = BKh0 + 2 * 64 * RW_LP;
    float* PL0 = (float*)(Sb + 64 * RW_LP);
    float* CV = PL0 + 2 * 64;
    bf16_t* A21b = (bf16_t*)(CV + 8 * 64);
    bf16_t* TI = A21b + 16 * 40;
    bf16_t* RHSb = TI + 2 * 16 * 40;
    bf16_t* XB = RHSb + 64 * 40;
    static_assert((34 * RW_LR + 2 * 32 * RW_LP) * 2 + (2 * 32 * 64 + 8 * 64) * 4 + 64 * RW_LP * 2 + 32 * 36 * 4 + 4 * 32 * 40 * 2 + 2 * 32 * 64 * 4
                  + 5 * 64 * RW_LP * 2 + (2 * 64 + 8 * 64) * 4 + (16 * 40 + 2 * 16 * 40 + 2 * 64 * 40) * 2 <= LDS_BYTES - 16, "rwkv LDS");
    const bf16_t* P = WSP(const bf16_t, WS_BIG + L1_P); const bf16_t* TWAL = WSP(const bf16_t, WS_BIG + L1_TWAL);
    bf16_t* OUT = WSP(bf16_t, WS_BIG + (dir ? L1_OB : L1_OF));
    float* BSC = WSP(float, WS_BSC) + (size_t)dir * RGL * 16;
    const float* mu = KIN(24);
    bf16x8 wfr[2][2];
    {
        const int wv = tid >> 6, fr0 = tid & 15, fq0 = (tid & 63) >> 4; const float* wsrc = (wv >> 2) ? KIN(28) : KIN(26);
#pragma unroll
        for (int q2 = 0; q2 < 2; ++q2)
#pragma unroll
            for (int k = 0; k < 2; ++k) { const int n = ((wv & 1) * 2 + q2) * 16 + fr0; union { bf16x8 v; unsigned u[4]; } tw;
#pragma unroll
                for (int e = 0; e < 4; ++e) { const int c0 = k * 32 + fq0 * 8 + 2 * e;
                    tw.u[e] = pack2(wsrc[((size_t)dir * 64 + c0) * 1024 + h * 64 + n], wsrc[((size_t)dir * 64 + c0 + 1) * 1024 + h * 64 + n]); }
                wfr[q2][k] = tw.v; }
    }
    for (int i = tid; i < 2 * 16 * 40; i += 512) TI[i] = 0;
    for (int i = tid; i < 64 * 40; i += 512) XB[i] = 0;
    for (int i = tid; i < 64 * RW_LP; i += 512) Sb[i] = 0;
    for (int i = tid; i < 16 * 40; i += 512) A21b[i] = 0;
    for (int i = tid; i < 2 * 64 * RW_LP; i += 512) ZVT0[i] = 0;
    if (tid < 64) { const int n = tid;
        CV[0 * 64 + n] = KIN(25)[dir * 1024 + h * 64 + n]; CV[1 * 64 + n] = KIN(27)[dir * 1024 + h * 64 + n];
        CV[2 * 64 + n] = KIN(30)[h * 64 + n]; CV[3 * 64 + n] = KIN(31)[h * 64 + n]; CV[4 * 64 + n] = KIN(32)[h * 64 + n];
        CV[5 * 64 + n] = mu[h * 64 + n]; CV[6 * 64 + n] = mu[1024 + h * 64 + n]; CV[7 * 64 + n] = mu[2048 + h * 64 + n]; }
    f32x4 Sacc[2];
    Sacc[0] = (f32x4){0.f, 0.f, 0.f, 0.f}; Sacc[1] = (f32x4){0.f, 0.f, 0.f, 0.f};
    u32x4 pf[3];
#define RW_PREFETCH(cn, tix) do { const int t0n_ = dir ? scan_t<32>(1, (cn), 31) : (cn) * 32; const int lo_ = t0n_ < CTXL ? 0 : CTXL, hi_ = t0n_ < CTXL ? CTXL : TT; \
        _Pragma("unroll") for (int q = 0; q < 2; ++q) { const int p = (tix) + q * 512; pf[q] = (u32x4){0u, 0u, 0u, 0u}; \
            if (p < 34 * 24) { const int rr = p / 24, c = p % 24, t = t0n_ - 1 + rr; \
                if (t >= lo_ && t < hi_) { const int seg = c >> 3, c8 = c & 7; \
                    const int col = (seg == 0 ? CD_R : seg == 1 ? CD_K : CD_V) + h * 64; \
                    pf[q] = *(const u32x4*)(P + ((size_t)bl * TT + t) * CD_N + col + c8 * 8); } } } \
        { const int i_ = (tix) >> 4, c16 = (tix) & 15; \
          pf[2] = *(const u32x4*)(TWAL + ((size_t)bl * TT + t0n_ + i_) * 256 + (c16 >> 3) * 128 + dir * 64 + (c16 & 7) * 8); } } while (0)
    RW_PREFETCH(0, tid);
    lds_barrier();
    auto step = [&](auto doP_t, auto doD_t, const int ci) __attribute__((always_inline)) {
        constexpr bool doP = decltype(doP_t)::value, doD = decltype(doD_t)::value;
        int tq = tid; asm volatile("" : "+v"(tq));
        const int lane = tq & 63, wid = __builtin_amdgcn_readfirstlane(tq >> 6), fr = lane & 15, fq = lane >> 4, pi = tq >> 4, n4 = (tq & 15) * 4;
        const int cp = ci + 1, pc = ci & 1, pn = cp & 1;
        const int t0 = dir ? scan_t<32>(1, ci, 31) : ci * 32, t0p = dir ? scan_t<32>(1, cp, 31) : cp * 32;
        bf16_t* ZVc = ZVT0 + pc * 64 * RW_LP; bf16_t* ZVn = ZVT0 + pn * 64 * RW_LP;
        const bf16_t* BKhc = BKh0 + pc * 64 * RW_LP; bf16_t* BKhn = BKh0 + pn * 64 * RW_LP;
        const bf16_t* ARBc = ARB0 + pc * 32 * 40; bf16_t* ARBn = ARB0 + pn * 32 * 40;
        const float* PLc = PL0 + pc * 64; float* PLn = PL0 + pn * 64;
        if constexpr (doP) {
#pragma unroll
            for (int q = 0; q < 2; ++q) { const int p = tq + q * 512; if (p < 34 * 24) *(u32x4*)(RAW + (p / 24) * RW_LR + (p % 24) * 8) = pf[q]; }
            { const int i_ = tq >> 4, c16 = tq & 15; *(u32x4*)(((c16 >> 3) ? ALb : TWb) + i_ * RW_LP + (c16 & 7) * 8) = pf[2]; }
        }
        if constexpr (doD) {
            if (wid > 0) for (int rep_ = 0; rep_ < ((RWP & 32) ? 2 : 1); ++rep_) {
#pragma unroll
                for (int q3 = 0; q3 < 3; ++q3) { const int tl = (wid - 1) + 7 * q3;
                    if (tl < 16) {
                        const int which = tl >> 3, tt = (tl >> 2) & 1, vt = tl & 3;
                        const bf16_t* Ak = which ? ARK : AAK; float* Od = which ? YB : RHS;
                        f32x4 acc = (f32x4){0.f, 0.f, 0.f, 0.f};
#pragma unroll
                        for (int k = 0; k < 2; ++k) acc = mma16(ldfrag(AR, RW_LP, which * 32 + tt * 16, k * 32, fr, fq), ldfrag(Sb, RW_LP, vt * 16, k * 32, fr, fq), acc);
                        acc = mma16(ldfrag(Ak, 40, tt * 16, 0, fr, fq), ldfrag(ZVc, RW_LP, vt * 16, 32, fr, fq), acc);
#pragma unroll
                        for (int rr = 0; rr < 4; ++rr) Od[(tt * 16 + fq * 4 + rr) * 64 + vt * 16 + fr] = acc[rr];
                        if (!which) st4bf(RHSb + (vt * 16 + fr) * 40 + tt * 16 + fq * 4, acc);
                    } }
            } else for (int rep_ = 0; rep_ < ((RWP & 1) ? 2 : 1); ++rep_) {
                const float* AB = AABT + ((lane >> 4) & 1) * (16 * 36 + 16);
                float z[16]; f32x4 ca0, ca1, ca2, ca3, cb0, cb1, cb2, cb3;
#pragma unroll
                for (int t = 0; t < 16; ++t) z[t] = (t == (lane & 15)) ? 1.0f : 0.f;
                ca0 = *(const f32x4*)(AB + 0 * 36 + 0); ca1 = *(const f32x4*)(AB + 0 * 36 + 4); ca2 = *(const f32x4*)(AB + 0 * 36 + 8); ca3 = *(const f32x4*)(AB + 0 * 36 + 12);
                cb0 = *(const f32x4*)(AB + 1 * 36 + 0); cb1 = *(const f32x4*)(AB + 1 * 36 + 4); cb2 = *(const f32x4*)(AB + 1 * 36 + 8); cb3 = *(const f32x4*)(AB + 1 * 36 + 12);
                { const float zs = z[0]; z[1] = __builtin_fmaf(ca0[1], zs, z[1]); z[2] = __builtin_fmaf(ca0[2], zs, z[2]); z[3] = __builtin_fmaf(ca0[3], zs, z[3]); z[4] = __builtin_fmaf(ca1[0], zs, z[4]); z[5] = __builtin_fmaf(ca1[1], zs, z[5]); z[6] = __builtin_fmaf(ca1[2], zs, z[6]); z[7] = __builtin_fmaf(ca1[3], zs, z[7]); z[8] = __builtin_fmaf(ca2[0], zs, z[8]); z[9] = __builtin_fmaf(ca2[1], zs, z[9]); z[10] = __builtin_fmaf(ca2[2], zs, z[10]); z[11] = __builtin_fmaf(ca2[3], zs, z[11]); z[12] = __builtin_fmaf(ca3[0], zs, z[12]); z[13] = __builtin_fmaf(ca3[1], zs, z[13]); z[14] = __builtin_fmaf(ca3[2], zs, z[14]); z[15] = __builtin_fmaf(ca3[3], zs, z[15]); }
                asm volatile("" : "+v"(z[1]) );
                ca0 = *(const f32x4*)(AB + 2 * 36 + 0); ca1 = *(const f32x4*)(AB + 2 * 36 + 4); ca2 = *(const f32x4*)(AB + 2 * 36 + 8); ca3 = *(const f32x4*)(AB + 2 * 36 + 12);
                { const float zs = z[1]; z[2] = __builtin_fmaf(cb0[2], zs, z[2]); z[3] = __builtin_fmaf(cb0[3], zs, z[3]); z[4] = __builtin_fmaf(cb1[0], zs, z[4]); z[5] = __builtin_fmaf(cb1[1], zs, z[5]); z[6] = __builtin_fmaf(cb1[2], zs, z[6]); z[7] = __builtin_fmaf(cb1[3], zs, z[7]); z[8] = __builtin_fmaf(cb2[0], zs, z[8]); z[9] = __builtin_fmaf(cb2[1], zs, z[9]); z[10] = __builtin_fmaf(cb2[2], zs, z[10]); z[11] = __builtin_fmaf(cb2[3], zs, z[11]); z[12] = __builtin_fmaf(cb3[0], zs, z[12]); z[13] = __builtin_fmaf(cb3[1], zs, z[13]); z[14] = __builtin_fmaf(cb3[2], zs, z[14]); z[15] = __builtin_fmaf(cb3[3], zs, z[15]); }
                asm volatile("" : "+v"(z[2]) );
                cb1 = *(const f32x4*)(AB + 3 * 36 + 4); cb2 = *(const f32x4*)(AB + 3 * 36 + 8); cb3 = *(const f32x4*)(AB + 3 * 36 + 12);
                { const float zs = z[2]; z[3] = __builtin_fmaf(ca0[3], zs, z[3]); z[4] = __builtin_fmaf(ca1[0], zs, z[4]); z[5] = __builtin_fmaf(ca1[1], zs, z[5]); z[6] = __builtin_fmaf(ca1[2], zs, z[6]); z[7] = __builtin_fmaf(ca1[3], zs, z[7]); z[8] = __builtin_fmaf(ca2[0], zs, z[8]); z[9] = __builtin_fmaf(ca2[1], zs, z[9]); z[10] = __builtin_fmaf(ca2[2], zs, z[10]); z[11] = __builtin_fmaf(ca2[3], zs, z[11]); z[12] = __builtin_fmaf(ca3[0], zs, z[12]); z[13] = __builtin_fmaf(ca3[1], zs, z[13]); z[14] = __builtin_fmaf(ca3[2], zs, z[14]); z[15] = __builtin_fmaf(ca3[3], zs, z[15]); }
                asm volatile("" : "+v"(z[3]) );
                ca1 = *(const f32x4*)(AB + 4 * 36 + 4); ca2 = *(const f32x4*)(AB + 4 * 36 + 8); ca3 = *(const f32x4*)(AB + 4 * 36 + 12);
                { const float zs = z[3]; z[4] = __builtin_fmaf(cb1[0], zs, z[4]); z[5] = __builtin_fmaf(cb1[1], zs, z[5]); z[6] = __builtin_fmaf(cb1[2], zs, z[6]); z[7] = __builtin_fmaf(cb1[3], zs, z[7]); z[8] = __builtin_fmaf(cb2[0], zs, z[8]); z[9] = __builtin_fmaf(cb2[1], zs, z[9]); z[10] = __builtin_fmaf(cb2[2], zs, z[10]); z[11] = __builtin_fmaf(cb2[3], zs, z[11]); z[12] = __builtin_fmaf(cb3[0], zs, z[12]); z[13] = __builtin_fmaf(cb3[1], zs, z[13]); z[14] = __builtin_fmaf(cb3[2], zs, z[14]); z[15] = __builtin_fmaf(cb3[3], zs, z[15]); }
                asm volatile("" : "+v"(z[4]) );
                cb1 = *(const f32x4*)(AB + 5 * 36 + 4); cb2 = *(const f32x4*)(AB + 5 * 36 + 8); cb3 = *(const f32x4*)(AB + 5 * 36 + 12);
                { const float zs = z[4]; z[5] = __builtin_fmaf(ca1[1], zs, z[5]); z[6] = __builtin_fmaf(ca1[2], zs, z[6]); z[7] = __builtin_fmaf(ca1[3], zs, z[7]); z[8] = __builtin_fmaf(ca2[0], zs, z[8]); z[9] = __builtin_fmaf(ca2[1], zs, z[9]); z[10] = __builtin_fmaf(ca2[2], zs, z[10]); z[11] = __builtin_fmaf(ca2[3], zs, z[11]); z[12] = __builtin_fmaf(ca3[0], zs, z[12]); z[13] = __builtin_fmaf(ca3[1], zs, z[13]); z[14] = __builtin_fmaf(ca3[2], zs, z[14]); z[15] = __builtin_fmaf(ca3[3], zs, z[15]); }
                asm volatile("" : "+v"(z[5]) );
                ca1 = *(const f32x4*)(AB + 6 * 36 + 4); ca2 = *(const f32x4*)(AB + 6 * 36 + 8); ca3 = *(const f32x4*)(AB + 6 * 36 + 12);
                { const float zs = z[5]; z[6] = __builtin_fmaf(cb1[2], zs, z[6]); z[7] = __builtin_fmaf(cb1[3], zs, z[7]); z[8] = __builtin_fmaf(cb2[0], zs, z[8]); z[9] = __builtin_fmaf(cb2[1], zs, z[9]); z[10] = __builtin_fmaf(cb2[2], zs, z[10]); z[11] = __builtin_fmaf(cb2[3], zs, z[11]); z[12] = __builtin_fmaf(cb3[0], zs, z[12]); z[13] = __builtin_fmaf(cb3[1], zs, z[13]); z[14] = __builtin_fmaf(cb3[2], zs, z[14]); z[15] = __builtin_fmaf(cb3[3], zs, z[15]); }
                asm volatile("" : "+v"(z[6]) );
                cb2 = *(const f32x4*)(AB + 7 * 36 + 8); cb3 = *(const f32x4*)(AB + 7 * 36 + 12);
                { const float zs = z[6]; z[7] = __builtin_fmaf(ca1[3], zs, z[7]); z[8] = __builtin_fmaf(ca2[0], zs, z[8]); z[9] = __builtin_fmaf(ca2[1], zs, z[9]); z[10] = __builtin_fmaf(ca2[2], zs, z[10]); z[11] = __builtin_fmaf(ca2[3], zs, z[11]); z[12] = __builtin_fmaf(ca3[0], zs, z[12]); z[13] = __builtin_fmaf(ca3[1], zs, z[13]); z[14] = __builtin_fmaf(ca3[2], zs, z[14]); z[15] = __builtin_fmaf(ca3[3], zs, z[15]); }
                asm volatile("" : "+v"(z[7]) );
                ca2 = *(const f32x4*)(AB + 8 * 36 + 8); ca3 = *(const f32x4*)(AB + 8 * 36 + 12);
                { const float zs = z[7]; z[8] = __builtin_fmaf(cb2[0], zs, z[8]); z[9] = __builtin_fmaf(cb2[1], zs, z[9]); z[10] = __builtin_fmaf(cb2[2], zs, z[10]); z[11] = __builtin_fmaf(cb2[3], zs, z[11]); z[12] = __builtin_fmaf(cb3[0], zs, z[12]); z[13] = __builtin_fmaf(cb3[1], zs, z[13]); z[14] = __builtin_fmaf(cb3[2], zs, z[14]); z[15] = __builtin_fmaf(cb3[3], zs, z[15]); }
                asm volatile("" : "+v"(z[8]) );
                cb2 = *(const f32x4*)(AB + 9 * 36 + 8); cb3 = *(const f32x4*)(AB + 9 * 36 + 12);
                { const float zs = z[8]; z[9] = __builtin_fmaf(ca2[1], zs, z[9]); z[10] = __builtin_fmaf(ca2[2], zs, z[10]); z[11] = __builtin_fmaf(ca2[3], zs, z[11]); z[12] = __builtin_fmaf(ca3[0], zs, z[12]); z[13] = __builtin_fmaf(ca3[1], zs, z[13]); z[14] = __builtin_fmaf(ca3[2], zs, z[14]); z[15] = __builtin_fmaf(ca3[3], zs, z[15]); }
                asm volatile("" : "+v"(z[9]) );
                ca2 = *(const f32x4*)(AB + 10 * 36 + 8); ca3 = *(const f32x4*)(AB + 10 * 36 + 12);
                { const float zs = z[9]; z[10] = __builtin_fmaf(cb2[2], zs, z[10]); z[11] = __builtin_fmaf(cb2[3], zs, z[11]); z[12] = __builtin_fmaf(cb3[0], zs, z[12]); z[13] = __builtin_fmaf(cb3[1], zs, z[13]); z[14] = __builtin_fmaf(cb3[2], zs, z[14]); z[15] = __builtin_fmaf(cb3[3], zs, z[15]); }
                asm volatile("" : "+v"(z[10]) );
                cb3 = *(const f32x4*)(AB + 11 * 36 + 12);
                { const float zs = z[10]; z[11] = __builtin_fmaf(ca2[3], zs, z[11]); z[12] = __builtin_fmaf(ca3[0], zs, z[12]); z[13] = __builtin_fmaf(ca3[1], zs, z[13]); z[14] = __builtin_fmaf(ca3[2], zs, z[14]); z[15] = __builtin_fmaf(ca3[3], zs, z[15]); }
                asm volatile("" : "+v"(z[11]) );
                ca3 = *(const f32x4*)(AB + 12 * 36 + 12);
                { const float zs = z[11]; z[12] = __builtin_fmaf(cb3[0], zs, z[12]); z[13] = __builtin_fmaf(cb3[1], zs, z[13]); z[14] = __builtin_fmaf(cb3[2], zs, z[14]); z[15] = __builtin_fmaf(cb3[3], zs, z[15]); }
                asm volatile("" : "+v"(z[12]) );
                cb3 = *(const f32x4*)(AB + 13 * 36 + 12);
                { const float zs = z[12]; z[13] = __builtin_fmaf(ca3[1], zs, z[13]); z[14] = __builtin_fmaf(ca3[2], zs, z[14]); z[15] = __builtin_fmaf(ca3[3], zs, z[15]); }
                asm volatile("" : "+v"(z[13]) );
                ca3 = *(const f32x4*)(AB + 14 * 36 + 12);
                { const float zs = z[13]; z[14] = __builtin_fmaf(cb3[2], zs, z[14]); z[15] = __builtin_fmaf(cb3[3], zs, z[15]); }
                asm volatile("" : "+v"(z[14]) );
                { const float zs = z[14]; z[15] = __builtin_fmaf(ca3[3], zs, z[15]); }
                asm volatile("" : "+v"(z[15]) );
                if (lane < 32) {
#pragma unroll
                    for (int t = 0; t < 16; ++t) TI[(lane >> 4) * 16 * 40 + t * 40 + (lane & 15)] = f2bf(z[t]);
                }
            }
        }
        if constexpr (doP) { if (cp + 1 < NC) RW_PREFETCH(cp + 1, tq); }
        lds_barrier();
        if constexpr (doD) if (wid < 4) {
            f32x4 acc = (f32x4){0.f, 0.f, 0.f, 0.f};
            acc = mma16(ldfrag(TI, 40, 0, 0, fr, fq), ldfrag(RHSb, 40, wid * 16, 0, fr, fq), acc);
            st4bf(ZVc + (wid * 16 + fr) * RW_LP + fq * 4, acc);
        }
        if constexpr (doP) for (int rep_ = 0; rep_ < ((RWP & 64) ? 2 : 1); ++rep_) {
            const int which = wid >> 2, tt = (wid >> 1) & 1;
            const bf16_t* Xa = which ? ALb : TWb; float* Od = which ? ALf : WLf;
#pragma unroll
            for (int q2 = 0; q2 < 2; ++q2) { const int nt = (wid & 1) * 2 + q2;
                f32x4 acc = (f32x4){0.f, 0.f, 0.f, 0.f};
#pragma unroll
                for (int k = 0; k < 2; ++k) acc = mma16(ldfrag(Xa, RW_LP, tt * 16, k * 32, fr, fq), wfr[q2][k], acc);
#pragma unroll
                for (int rr = 0; rr < 4; ++rr) Od[(tt * 16 + fq * 4 + rr) * 64 + nt * 16 + fr] = acc[rr]; }
            const int pp = tq & 31, cg = tq >> 5, jj = dir ? 31 - pp : pp;
            const bf16_t* r1v = RAW + (pp + 1) * RW_LR + 128 + cg * 4;
            const f32x4 muv = *(const f32x4*)(CV + 448 + cg * 4);
            f32x4 v = ld4bf(r1v);
            v = v + muv * ((ld4bf(r1v - RW_LR) + ld4bf(r1v + RW_LR)) * 0.5f - v);
#pragma unroll
            for (int q = 0; q < 4; ++q) ZVn[(cg * 4 + q) * RW_LP + 32 + jj] = f2bf(v[q]);
        }
        lds_barrier();
        if (RWP & 16) { lds_barrier(); lds_barrier(); lds_barrier(); lds_barrier(); lds_barrier(); }
        const int j = dir ? 31 - pi : pi;
        f32x4 r, kd, av, bv, lw, cin;
        f32x4 xacc = (f32x4){0.f, 0.f, 0.f, 0.f};
        if constexpr (doD) {
            xacc = mma16(ldfrag(A21b, 40, 0, 0, fr, fq), ldfrag(ZVc, RW_LP, (wid & 3) * 16, 0, fr, fq), xacc);
#pragma unroll
            for (int rr = 0; rr < 4; ++rr) xacc[rr] += RHS[(16 + fq * 4 + rr) * 64 + (wid & 3) * 16 + fr];
        }
        if constexpr (doP) for (int rep_ = 0; rep_ < ((RWP & 2) ? 2 : 1); ++rep_) {
            const f32x4 w0v = *(const f32x4*)(CV + n4), a0v = *(const f32x4*)(CV + 64 + n4), kkw = *(const f32x4*)(CV + 128 + n4), kaw = *(const f32x4*)(CV + 192 + n4), rkw = *(const f32x4*)(CV + 256 + n4);
            const f32x4 mur = *(const f32x4*)(CV + 320 + n4), muk = *(const f32x4*)(CV + 384 + n4);
            const f32x4 wl = w0v + *(const f32x4*)(WLf + pi * 64 + n4), al = a0v + *(const f32x4*)(ALf + pi * 64 + n4);
            const bf16_t* r1 = RAW + (pi + 1) * RW_LR; const bf16_t* rp = RAW + pi * RW_LR; const bf16_t* rn = RAW + (pi + 2) * RW_LR;
            f32x4 k;
            r = ld4bf(r1 + n4); k = ld4bf(r1 + 64 + n4);
            r = r + mur * ((ld4bf(rp + n4) + ld4bf(rn + n4)) * 0.5f - r);
            k = k + muk * ((ld4bf(rp + 64 + n4) + ld4bf(rn + 64 + n4)) * 0.5f - k);
            f32x4 a, kk = k * kkw;
            float ssq = kk[0] * kk[0] + kk[1] * kk[1] + kk[2] * kk[2] + kk[3] * kk[3];
            ssq = rsum16(ssq);
            kk = kk * __builtin_amdgcn_rsqf(fmaxf(ssq, 1e-24f));
#pragma unroll
            for (int q = 0; q < 4; ++q) { lw[q] = -0.6065306597126334f * sigmoidf_(wl[q]); a[q] = sigmoidf_(al[q]); }
            kd = k * ((a - 1.0f) * kaw + 1.0f);
            float bs = r[0] * kd[0] * rkw[0] + r[1] * kd[1] * rkw[1] + r[2] * kd[2] * rkw[2] + r[3] * kd[3] * rkw[3];
            bs = rsum16(bs);
            av = kk * -1.0f; bv = kk * a;
            f32x4 wt;
#pragma unroll
            for (int q = 0; q < 4; ++q) {
                const float lwq = lw[q];
                const auto e16 = __builtin_amdgcn_permlane16_swap(__builtin_bit_cast(unsigned, lwq), __builtin_bit_cast(unsigned, lwq), false, false);
                const unsigned e16a = e16[0], e16b = e16[1];
                const float y = __builtin_bit_cast(float, e16a) + __builtin_bit_cast(float, e16b);
                const auto e32 = __builtin_amdgcn_permlane32_swap(__builtin_bit_cast(unsigned, y), __builtin_bit_cast(unsigned, y), false, false);
                const unsigned e32a = e32[0], e32b = e32[1];
                wt[q] = __builtin_bit_cast(float, e32a) + __builtin_bit_cast(float, e32b);
                cin[q] = ((fq & 1) ? y : lwq) + ((fq & 2) ? (wt[q] - y) : 0.f);
            }
            if (fq == 0) *(f32x4*)(WT + wid * 64 + n4) = wt;
            const int t = t0p + pi;
            if (t >= CTXL && (tq & 15) == 0) BSC[((size_t)bl * SEQ + (t - CTXL)) * 16 + h] = bs;
        }
        if constexpr (doD) if (wid < 4) st4bf(XB + (wid * 16 + fr) * 40 + fq * 4, xacc);
        lds_barrier();
        if constexpr (doD) if (wid < 4) {
            f32x4 acc = (f32x4){0.f, 0.f, 0.f, 0.f};
            acc = mma16(ldfrag(TI + 16 * 40, 40, 0, 0, fr, fq), ldfrag(XB, 40, wid * 16, 0, fr, fq), acc);
            st4bf(ZVc + (wid * 16 + fr) * RW_LP + 16 + fq * 4, acc);
        }
        if constexpr (doP) for (int rep_ = 0; rep_ < ((RWP & 4) ? 2 : 1); ++rep_) {
            f32x4 pre = (f32x4){0.f, 0.f, 0.f, 0.f}, cle = (f32x4){0.f, 0.f, 0.f, 0.f};
#pragma unroll
            for (int w = 0; w < 8; ++w) { const f32x4 t4 = *(const f32x4*)(WT + w * 64 + n4); cle = cle + t4; if (w < wid) pre = pre + t4; }
            const f32x4 cim = cin + pre;
            const f32x4 clj = dir ? cle - cim + lw : cim;
            const f32x4 clp = dir ? cle - cim : cim - lw;
            f32x4 at, rt, bt, kt, bh, kh;
#pragma unroll
            for (int q = 0; q < 4; ++q) { const float ep = __expf(clp[q]), ej = __expf(clj[q]), ei = __expf(-clj[q]), ee = __expf(cle[q] - clj[q]);
                at[q] = av[q] * ep; rt[q] = r[q] * ej; bt[q] = bv[q] * ei; kt[q] = kd[q] * ei; bh[q] = bv[q] * ee; kh[q] = kd[q] * ee; }
            if (tq < 16) { f32x4 e;
#pragma unroll
                for (int q = 0; q < 4; ++q) e[q] = __expf(cle[q]);
                *(f32x4*)(PLn + n4) = e; }
            st4bf(AR + j * RW_LP + n4, at); st4bf(AR + (32 + j) * RW_LP + n4, rt);
            st4bf(BK + j * RW_LP + n4, bt); st4bf(BK + (32 + j) * RW_LP + n4, kt);
            const int cbh = (((j >> 3) ^ (tq & 7)) << 3) | (j & 7), ckh = ((((j >> 3) + 4) ^ (tq & 7)) << 3) | (j & 7);
#pragma unroll
            for (int q = 0; q < 4; ++q) { BKhn[(n4 + q) * RW_LP + cbh] = f2bf(bh[q]); BKhn[(n4 + q) * RW_LP + ckh] = f2bf(kh[q]); }
        }
        lds_barrier();
        if constexpr (doD) {
            const int nt = wid >> 1;
            const f32x4 pl = *(const f32x4*)(PLc + nt * 16 + fq * 4);
#pragma unroll
            for (int q2 = 0; q2 < 2; ++q2) {
                const int vt = (wid & 1) * 2 + q2;
                Sacc[q2] = Sacc[q2] * pl;
#pragma unroll
                for (int k = 0; k < 2; ++k) Sacc[q2] = mma16(*(const bf16x8*)(BKhc + (nt * 16 + fr) * RW_LP + (((k * 4 + fq) ^ (((nt & 1) << 2) + (fr >> 2))) << 3)), ldfrag(ZVc, RW_LP, vt * 16, k * 32, fr, fq), Sacc[q2]);
                st4bf(Sb + (vt * 16 + fr) * RW_LP + nt * 16 + fq * 4, Sacc[q2]);
            }
            if (t0 >= CTXL) {
                const int vt = wid >> 1, tt = wid & 1;
                f32x4 acc = (f32x4){0.f, 0.f, 0.f, 0.f};
                acc = mma16(ldfrag(ZVc, RW_LP, vt * 16, 0, fr, fq), ldfrag(ARBc, 40, tt * 16, 0, fr, fq), acc);
                const int t = tt * 16 + fr, v0 = vt * 16 + fq * 4;
#pragma unroll
                for (int rr = 0; rr < 4; ++rr) acc[rr] += YB[t * 64 + v0 + rr];
                const int tn = scan_t<32>(dir, ci, t);
                st4bf(OUT + ((size_t)bl * SEQ + (tn - CTXL)) * 1024 + h * 64 + v0, acc);
            }
        }
        if constexpr (doP) for (int rep_ = 0; rep_ < ((RWP & 8) ? 2 : 1); ++rep_) {
            const int ti = wid >> 1;
#pragma unroll
            for (int q2 = 0; q2 < 2; ++q2) {
                const int si = (wid & 1) * 2 + q2;
                f32x4 acc = (f32x4){0.f, 0.f, 0.f, 0.f};
#pragma unroll
                for (int k = 0; k < 2; ++k) acc = mma16(ldfrag(AR, RW_LP, ti * 16, k * 32, fr, fq), ldfrag(BK, RW_LP, si * 16, k * 32, fr, fq), acc);
                const int s = (si & 1) * 16 + fr;
                const bool incl = ti >= 2, kcols = si >= 2;
                bf16_t* dstb = kcols ? (incl ? ARK : AAK) : ARBn;
#pragma unroll
                for (int rr = 0; rr < 4; ++rr) { const int t = (ti & 1) * 16 + fq * 4 + rr;
                    const float val = (incl ? (s <= t) : (s < t)) ? acc[rr] : 0.f;
                    if (kcols || incl) dstb[t * 40 + s] = f2bf(val);
                    else { AABT[s * 36 + t] = val; if (ti == 1 && si == 0) A21b[(t - 16) * 40 + s] = f2bf(val); } }
            }
        }
        lds_barrier();
    };
    step(TrueT{}, FalseT{}, -1);
#pragma unroll 1
    for (int ci = 0; ci < NC - 1; ++ci) step(TrueT{}, TrueT{}, ci);
    step(FalseT{}, TrueT{}, NC - 1);
#undef RW_PREFETCH
}

__device__ __forceinline__ void phase_mix_cd(const KP& kp, unsigned char* lds, int which) {
    if (which & 1) for (int u = obid(); u < 256; u += gridDim.x) { rwkv_unit(kp, lds, u >> 5, (u >> 1) & 15, u & 1); __syncthreads(); }
    if (which & 2) for (int u = obid(); u < 512; u += gridDim.x) { attn_unit(kp, lds, u >> 6, (u >> 3) & 7, u & 7); __syncthreads(); }
}

struct EpiFinCD {
    const bf16_t* OF; const bf16_t* OB; const bf16_t* P; const float* BSC; const float* ln; const float* mu; bf16_t* AOUT;
    __device__ __forceinline__ void operator()(const f32x4 (&acc)[4][4], int rb, int cb, int fr, int fq) const {
        const int head = cb >> 6;
#pragma unroll
        for (int i = 0; i < 4; ++i) { const int lr = rb + i * 16 + fr, s = lr & 2047;
            const size_t prow = (size_t)(lr >> 11) * TT + CTXL + s;
            f32x4 o[4]; float ss = 0.f;
#pragma unroll
            for (int j = 0; j < 4; ++j) { const int col = cb + j * 16 + fq * 4;
                o[j] = ld4bf(OF + (size_t)lr * 1024 + col) + ld4bf(OB + (size_t)lr * 1024 + col);
                ss += o[j][0] * o[j][0] + o[j][1] * o[j][1] + o[j][2] * o[j][2] + o[j][3] * o[j][3]; }
            ss += __shfl_xor(ss, 16); ss += __shfl_xor(ss, 32);
            const float rstd = rsqrtf(ss * (1.0f / 64.0f) + EPS);
            const float bon = BSC[(size_t)lr * 16 + head] + BSC[(size_t)RGL * 16 + (size_t)lr * 16 + head];
#pragma unroll
            for (int j = 0; j < 4; ++j) { const int col = cb + j * 16 + fq * 4;
                const bf16_t* pv = P + prow * CD_N + CD_V + col;
                const f32x4 v = ld4bf(pv);
                const f32x4 vp = s > 0 ? ld4bf(pv - CD_N) : (f32x4){0.f, 0.f, 0.f, 0.f};
                const f32x4 vn = s < SEQ - 1 ? ld4bf(pv + CD_N) : (f32x4){0.f, 0.f, 0.f, 0.f};
                const f32x4 vl = v + *(const f32x4*)(mu + 2048 + col) * ((vp + vn) * 0.5f - v);
                const f32x4 y = o[j] * rstd * *(const f32x4*)(ln + col) + vl * bon;
                st4bf(AOUT + (size_t)lr * 1536 + 512 + col, y * acc[i][j]); }
        }
    }
};
PHASE_FN void phase_fin_cd(const KP& kp, unsigned char* lds) {
    GA ga{WSP(const bf16_t, WS_SG), nullptr, 128, 0, 128, nullptr, RGL, 0, 0};
    EpiFinCD ep{WSP(const bf16_t, WS_BIG + L1_OF), WSP(const bf16_t, WS_BIG + L1_OB), WSP(const bf16_t, WS_BIG + L1_P), WSP(const float, WS_BSC), KIN(33), KIN(24), WSP(bf16_t, WS_BIG + L1_AOUT)};
    for (int u = obid(); u < (RGL / 256) * 8; u += gridDim.x) gemm_tile(lds, ga, WSP(const bf16_t, WS_WMIX + WM_G2), 128, u >> 3, u & 7, ep);
}
PHASE_FN void phase_gemm_out_cd(const KP& kp, unsigned char* lds) {
    pg8::Gemm g{WSP(const bf16_t, WS_BIG + L1_AOUT), WSP(const bf16_t, WS_WMIX + WM_CD_OUT), RGL, 1024, 1536, nullptr, 0x7fffffff};
    pg8::StaticOrder S; S.init(RGL, 1024, (int)gridDim.x, obid());
    pg8::EpiBfG E{WSP(bf16_t, WS_BIG + L1_U), 1024, 1024, 0x7fffffff, 1.0f};
    pg8::gemm_phase<pg8::EpiBfG, pg8::StaticOrder, false>((PG8_LAS unsigned char*)lds, g, S, E, nullptr);
    __syncthreads();
}

__device__ __attribute__((noinline)) void grid_sync(unsigned* barw, unsigned x, volatile LAS unsigned* st) { XcdBarrier b; b.bar = barw; b.x = x; b.st = st; xcd_barrier(b); }
constexpr int N_PHASES = 36;
__global__ void __launch_bounds__(512, 2) fwd_kernel(KP kparg) {
    extern __shared__ __attribute__((aligned(16))) unsigned char lds[];
    const int lo = kparg.ph_lo, hi = kparg.ph_hi;
    const KP& kp = kparg;
    volatile LAS unsigned* xbst = (volatile LAS unsigned*)(LAS unsigned char*)(lds + LDS_BYTES - 16);
    if (threadIdx.x == 0) { xbst[0] = 0u; xbst[1] = 0u; }
    __syncthreads();
    XcdBarrier bar; bar.bar = (unsigned*)kparg.ws; bar.x = 0; bar.st = xbst;
    if (hi - lo > 1) bar = xcd_barrier_post((unsigned*)kparg.ws, xbst);
#define IN(k) (lo <= (k) && (k) < hi)
#define SEAM(k) do { if (IN(k) && IN((k) + 1)) { grid_sync((unsigned*)kp.ws, bar.x, xbst); if (PROBE_DUP & 512) grid_sync((unsigned*)kp.ws, bar.x, xbst); } } while (0)
#define PHASE(...) do { if (IN(ph)) { __VA_ARGS__ } SEAM(ph); ++ph; } while (0)
    int ph = 0;
    PHASE(phase_mod(kp, lds); __syncthreads(); phase_conv_ab(kp, lds); if (PROBE_DUP & 32) { __syncthreads(); phase_mod(kp, lds); __syncthreads(); phase_conv_ab(kp, lds); });
#pragma unroll
    for (int g = 0; g < NG; ++g) {
        if (g == 0) PHASE(phase_u(kp, 0, 0, obid(), (int)gridDim.x, false););
        PHASE(phase_gemm_in(kp, lds, 0, g); if (PROBE_DUP & 8) phase_gemm_in(kp, lds, 0, g););
        PHASE(phase_xconv(kp); if (PROBE_DUP & 2048) phase_xconv(kp););
        PHASE(phase_scan_ab(kp, lds); if (PROBE_DUP & 1) { __syncthreads(); phase_scan_ab(kp, lds); });
        PHASE(phase_fin_ab(kp););
        PHASE(phase_gemm_out_ab(kp, lds, g););
        PHASE(phase_r(kp, lds, 0, g););
    }
    PHASE(phase_moe_gather(kp, 0); phase_conv_cd(kp, lds););
    PHASE(phase_moe_gemm(kp, lds, 0, false); if (PROBE_DUP & 16) { __syncthreads(); phase_moe_gemm(kp, lds, 0, false); });
    PHASE(phase_moe_gemm(kp, lds, 0, true); if (PROBE_DUP & 16) { __syncthreads(); phase_moe_gemm(kp, lds, 0, true); });
    PHASE(phase_combine(kp, 0););
#pragma unroll
    for (int g = 0; g < NG; ++g) {
        PHASE(phase_gemm_in(kp, lds, 1, g); if (PROBE_DUP & 8) phase_gemm_in(kp, lds, 1, g););
        PHASE(phase_prep_cd(kp););
        PHASE(phase_upproj(kp, lds); if (PROBE_DUP & 4096) phase_upproj(kp, lds););
        PHASE(phase_mix_cd(kp, lds, 3); if (PROBE_DUP & 2) { __syncthreads(); phase_mix_cd(kp, lds, 1); } if (PROBE_DUP & 4) { __syncthreads(); phase_mix_cd(kp, lds, 2); });
        PHASE(phase_fin_cd(kp, lds); if (PROBE_DUP & 4096) phase_fin_cd(kp, lds););
        PHASE(phase_gemm_out_cd(kp, lds); if (PROBE_DUP & 256) phase_gemm_out_cd(kp, lds););
        PHASE(phase_r(kp, lds, 1, g););
    }
    PHASE(phase_moe_gather(kp, 1); phase_conv_moe(kp, lds, 1, obid(), (int)gridDim.x); if (PROBE_DUP & 64) { phase_conv_moe(kp, lds, 1, obid(), (int)gridDim.x); phase_conv_moe(kp, lds, 1, obid(), (int)gridDim.x); });
    PHASE(phase_moe_gemm(kp, lds, 1, false););
    PHASE(phase_moe_gemm(kp, lds, 1, true););
    PHASE(phase_combine(kp, 1););
#undef PHASE
#undef IN
#undef SEAM
}

extern "C" void kernel_launch(void* const* d_in, const int* in_sizes, int n_in, void* d_out, int out_size, void* d_ws, size_t ws_size, hipStream_t stream) {
    static int grid = 0;
    if (grid == 0) {
        if (n_in != 42 || out_size != NLAT * D || ws_size < WS_NEED) { fprintf(stderr, "kernel_launch: unexpected shapes: n_in %d out %d ws %zu (need %zu)\n", n_in, out_size, ws_size, (size_t)WS_NEED); grid = -1; return; }
        int dev = 0, cus = 0, per_cu = 0;
        if (hipGetDevice(&dev) != hipSuccess || hipDeviceGetAttribute(&cus, hipDeviceAttributeMultiprocessorCount, dev) != hipSuccess) { grid = -1; return; }
        if (hipFuncSetAttribute((const void*)fwd_kernel, hipFuncAttributeMaxDynamicSharedMemorySize, LDS_BYTES) != hipSuccess) { fprintf(stderr, "kernel_launch: hipFuncSetAttribute failed\n"); grid = -1; return; }
        if (hipOccupancyMaxActiveBlocksPerMultiprocessor(&per_cu, (const void*)fwd_kernel, 512, LDS_BYTES) != hipSuccess || per_cu < 1) { fprintf(stderr, "kernel_launch: occupancy query says %d blocks per CU\n", per_cu); grid = -1; (void)hipGetLastError(); return; }
        grid = cus;
    }
    if (grid < 0) return;
    (void)hipMemsetAsync(d_ws, 0, CTL_BYTES, stream);
    KP kp{};
    for (int i = 0; i < 42; ++i) kp.in[i] = (const float*)d_in[i];
    kp.out = (float*)d_out; kp.ws = (unsigned char*)d_ws;
#if N_LAUNCH_MODE == 1
    kp.ph_lo = 0; kp.ph_hi = N_PHASES;
    hipLaunchKernelGGL(fwd_kernel, dim3(grid), dim3(512), LDS_BYTES, stream, kp);
#else
    for (int p = 0; p < N_PHASES; ++p) { kp.ph_lo = p; kp.ph_hi = p + 1; hipLaunchKernelGGL(fwd_kernel, dim3(grid), dim3(512), LDS_BYTES, stream, kp); }
#endif
}
```

```cpp
#include <hip/hip_runtime.h>
#include <stdint.h>
#include <stdio.h>

typedef unsigned short bf16_t;
typedef short bf16x8 __attribute__((ext_vector_type(8)));
typedef float f32x4 __attribute__((ext_vector_type(4)));
typedef float f32x2 __attribute__((ext_vector_type(2)));
typedef unsigned u32x4 __attribute__((ext_vector_type(4)));
typedef unsigned u32x2 __attribute__((ext_vector_type(2)));

#ifndef RWP
#define RWP 0
#endif
#ifndef PROBE_DUP
#define PROBE_DUP 0
#endif
#ifndef N_LAUNCH_MODE
#define N_LAUNCH_MODE 1
#endif

constexpr int NB = 16, SEQ = 2048, CTXL = 256, TT = 2304, D = 1024;
constexpr int NTOK = NB * TT, NLAT = NB * SEQ;
constexpr int NG = 2, BG = NB / NG, RG = BG * TT, RGL = BG * SEQ;
constexpr float EPS = 1e-6f;
constexpr int AB_N = 5424, AB_NPAD = 5632, AB_Q = 0, AB_K = 512, AB_V = 1024, AB_OG = 2048, AB_IG = 3072, AB_FG = 3080, AB_Z = 3088, AB_XBC = 4112, AB_DT = 5392;
constexpr int CD_N = 4128, CD_NPAD = 4352, CD_M0 = 0, CD_M1 = 384, CD_KR = 640, CD_R = 672, CD_K = 1696, CD_V = 2720, CD_WL = 3744, CD_AL = 3872, CD_GL = 4000;
constexpr int CD_RW0 = 672;

constexpr size_t CTL_BYTES = 32768;
constexpr size_t CTL_CNT = 16384;
constexpr size_t WS_MODV = CTL_BYTES;
constexpr size_t WS_HC   = WS_MODV + (size_t)2 * 17 * 6144 * 4;
constexpr size_t WS_TOKE = WS_HC + (size_t)NB * CTXL * D * 4;
constexpr size_t WS_TOKP = WS_TOKE + (size_t)NTOK * 2 * 4;
constexpr size_t WS_TOKW = WS_TOKP + (size_t)NTOK * 2 * 4;
constexpr size_t WS_LIST = WS_TOKW + (size_t)NTOK * 2 * 4;
constexpr size_t WS_BSC  = WS_LIST + (size_t)16 * NTOK * 4;
constexpr size_t WS_SG   = WS_BSC + (size_t)2 * RGL * 16 * 4;
constexpr size_t WS_WMIX = WS_SG + (size_t)RGL * 128 * 2;
constexpr size_t WMIX_BYTES = (size_t)16 << 20;
constexpr size_t WS_V    = WS_WMIX + WMIX_BYTES;
constexpr size_t WS_BIG  = WS_V + (size_t)NTOK * D * 2;
constexpr size_t WM_AB_IN = 0, WM_AB_OUT = (size_t)AB_NPAD * 1024 * 2;
constexpr size_t WM_CD_IN = 0, WM_CD_OUT = (size_t)CD_NPAD * 1024 * 2, WM_UQ = WM_CD_OUT + (size_t)1024 * 1536 * 2, WM_UKV = WM_UQ + (size_t)768 * 384 * 2, WM_G2 = WM_UKV + (size_t)1024 * 256 * 2;
static_assert(WM_AB_OUT + (size_t)1024 * 2048 * 2 <= WMIX_BYTES, "wmix ab");
static_assert(WM_G2 + (size_t)1024 * 128 * 2 <= WMIX_BYTES, "wmix cd");
constexpr size_t SZ_RG1K = (size_t)RG * 1024 * 2, SZ_RGL1K = (size_t)RGL * 1024 * 2;
constexpr size_t L0_P = 0, L0_AO = (size_t)RG * AB_N * 2  , L0_HB = L0_AO + 2 * SZ_RG1K, L0_YB = L0_HB + SZ_RG1K, L0_U = L0_YB + SZ_RG1K, L0_END = L0_U + SZ_RG1K;
constexpr size_t L1_P = 0, L1_Q = (size_t)RG * CD_N * 2, L1_KV = L1_Q + (size_t)RGL * 768 * 2, L1_OF = L1_KV + SZ_RG1K, L1_OB = L1_OF + SZ_RGL1K, L1_AOUT = L1_OB + SZ_RGL1K, L1_U = L1_AOUT + (size_t)RGL * 1536 * 2, L1_TWAL = L1_U + SZ_RG1K  , L1_END = L1_TWAL + (size_t)RG * 256 * 2;
constexpr int MOE_PADROWS = 16 * 256;
constexpr size_t MO_WUP = 0, MO_WDN = (size_t)17 * 1024 * 1024 * 2, MO_HID = MO_WDN + (size_t)17 * 1024 * 512 * 2;
constexpr size_t MO_XG = MO_HID + (size_t)(3 * NTOK + MOE_PADROWS) * 512 * 2;
constexpr size_t MO_CON = MO_XG, MO_END = MO_CON + (size_t)(3 * NTOK + MOE_PADROWS) * 1024 * 2;
constexpr size_t BIG_BYTES = MO_END > L0_END ? (MO_END > L1_END ? MO_END : L1_END) : (L0_END > L1_END ? L0_END : L1_END);
constexpr size_t WS_NEED = WS_BIG + BIG_BYTES;

constexpr int LDS_BYTES = 151552;

__device__ __forceinline__ float bf2f(unsigned short h) { return __uint_as_float(((unsigned)h) << 16); }
typedef __bf16 bf16v2_t __attribute__((ext_vector_type(2)));
__device__ __forceinline__ unsigned pack2(float a, float b) { const bf16v2_t h = __builtin_convertvector((f32x2){a, b}, bf16v2_t); return __builtin_bit_cast(unsigned, h); }
__device__ __forceinline__ unsigned short f2bf(float f) { const __bf16 h = (__bf16)f; return __builtin_bit_cast(unsigned short, h); }
__device__ __forceinline__ float lo2f(unsigned w) { return __uint_as_float(w << 16); }
__device__ __forceinline__ float hi2f(unsigned w) { return __uint_as_float(w & 0xffff0000u); }

template <int CTRL> __device__ __forceinline__ float dpp_mov(float x) { return __builtin_bit_cast(float, __builtin_amdgcn_update_dpp(0, __builtin_bit_cast(int, x), CTRL, 0xf, 0xf, true)); }
__device__ __forceinline__ float rsum16(float x) { x += dpp_mov<0xB1>(x); x += dpp_mov<0x4E>(x); x += dpp_mov<0x124>(x); x += dpp_mov<0x128>(x); return x; }
template <int CTRL, int RM> __device__ __forceinline__ float dpp_upd(float old, float x) { return __builtin_bit_cast(float, __builtin_amdgcn_update_dpp(__builtin_bit_cast(int, old), __builtin_bit_cast(int, x), CTRL, RM, 0xf, false)); }
__device__ __forceinline__ float wscan_add(float x) { x += dpp_upd<0x111, 0xf>(0.f, x); x += dpp_upd<0x112, 0xf>(0.f, x); x += dpp_upd<0x114, 0xf>(0.f, x); x += dpp_upd<0x118, 0xf>(0.f, x);
    x += dpp_upd<0x142, 0xa>(0.f, x); x += dpp_upd<0x143, 0xc>(0.f, x); return x; }
__device__ __forceinline__ float wscan_max(float x) { const float ni = -__builtin_inff();
    x = fmaxf(x, dpp_upd<0x111, 0xf>(ni, x)); x = fmaxf(x, dpp_upd<0x112, 0xf>(ni, x)); x = fmaxf(x, dpp_upd<0x114, 0xf>(ni, x)); x = fmaxf(x, dpp_upd<0x118, 0xf>(ni, x));
    x = fmaxf(x, dpp_upd<0x142, 0xa>(ni, x)); x = fmaxf(x, dpp_upd<0x143, 0xc>(ni, x)); return x; }
__device__ __forceinline__ float lane63(float x) { return __builtin_bit_cast(float, __builtin_amdgcn_readlane(__builtin_bit_cast(int, x), 63)); }
__device__ __forceinline__ float xmax_rows(float x) {
    const auto a = __builtin_amdgcn_permlane16_swap(__builtin_bit_cast(unsigned, x), __builtin_bit_cast(unsigned, x), false, false);
    const unsigned a0 = a[0], a1 = a[1]; x = fmaxf(__builtin_bit_cast(float, a0), __builtin_bit_cast(float, a1));
    const auto b = __builtin_amdgcn_permlane32_swap(__builtin_bit_cast(unsigned, x), __builtin_bit_cast(unsigned, x), false, false);
    const unsigned b0 = b[0], b1 = b[1]; return fmaxf(__builtin_bit_cast(float, b0), __builtin_bit_cast(float, b1)); }
__device__ __forceinline__ float xsum_rows(float v) {
    const auto a = __builtin_amdgcn_permlane16_swap(__builtin_bit_cast(unsigned, v), __builtin_bit_cast(unsigned, v), false, false);
    const unsigned a0 = a[0], a1 = a[1]; v = __builtin_bit_cast(float, a0) + __builtin_bit_cast(float, a1);
    const auto b = __builtin_amdgcn_permlane32_swap(__builtin_bit_cast(unsigned, v), __builtin_bit_cast(unsigned, v), false, false);
    const unsigned b0 = b[0], b1 = b[1]; return __builtin_bit_cast(float, b0) + __builtin_bit_cast(float, b1); }
__device__ __forceinline__ float wsum(float v) {
    v = rsum16(v);
    const auto a = __builtin_amdgcn_permlane16_swap(__builtin_bit_cast(unsigned, v), __builtin_bit_cast(unsigned, v), false, false);
    const unsigned a0 = a[0], a1 = a[1]; v = __builtin_bit_cast(float, a0) + __builtin_bit_cast(float, a1);
    const auto b = __builtin_amdgcn_permlane32_swap(__builtin_bit_cast(unsigned, v), __builtin_bit_cast(unsigned, v), false, false);
    const unsigned b0 = b[0], b1 = b[1]; return __builtin_bit_cast(float, b0) + __builtin_bit_cast(float, b1); }
__device__ __forceinline__ float frcp_(float x) { return __builtin_amdgcn_rcpf(x); }
__device__ __forceinline__ float sigmoidf_(float x) { return __builtin_amdgcn_rcpf(1.0f + __expf(-x)); }
__device__ __forceinline__ float siluf_(float x) { return x * __builtin_amdgcn_rcpf(1.0f + __expf(-x)); }
__device__ __forceinline__ float softplusf_(float x) { return fmaxf(x, 0.0f) + __logf(1.0f + __expf(-fabsf(x))); }
__device__ __forceinline__ float logsigmoidf_(float x) { return fminf(x, 0.0f) - __logf(1.0f + __expf(-fabsf(x))); }
__device__ __forceinline__ float tanhf_(float x) { return 1.0f - 2.0f * __builtin_amdgcn_rcpf(__expf(2.0f * x) + 1.0f); }
__device__ __forceinline__ f32x4 mma16(bf16x8 a, bf16x8 b, f32x4 c) { return __builtin_amdgcn_mfma_f32_16x16x32_bf16(a, b, c, 0, 0, 0); }
__device__ __forceinline__ bf16x8 ldfrag(const bf16_t* base, int ld, int row0, int k0, int fr, int fq) { return *(const bf16x8*)(base + (row0 + fr) * ld + k0 + fq * 8); }
__device__ __forceinline__ void st4bf(bf16_t* p, f32x4 v) { u32x2 w; w.x = pack2(v[0], v[1]); w.y = pack2(v[2], v[3]); *(u32x2*)p = w; }
__device__ __forceinline__ f32x4 ld4bf(const bf16_t* p) { u32x2 w = *(const u32x2*)p; return (f32x4){lo2f(w.x), hi2f(w.x), lo2f(w.y), hi2f(w.y)}; }

#define PHASE_FN __device__ __forceinline__
__device__ __forceinline__ int otid() { int t = threadIdx.x; asm volatile("" : "+v"(t)); return t; }
__device__ __forceinline__ int obid() { int t = blockIdx.x; asm volatile("" : "+s"(t)); return t; }
template <class T> __device__ __forceinline__ T* as_global(T* p) { return p; }
__device__ __forceinline__ void lds_barrier() { asm volatile("s_waitcnt lgkmcnt(0)" ::: "memory"); __builtin_amdgcn_s_barrier(); asm volatile("" ::: "memory"); }
constexpr float W8_SCALE = 64.0f, W8_INV = 1.0f / 64.0f;
__device__ __forceinline__ unsigned pack4f8(float a, float b, float c, float d) { unsigned r = 0; r = __builtin_amdgcn_cvt_pk_fp8_f32(a, b, r, false); r = __builtin_amdgcn_cvt_pk_fp8_f32(c, d, r, true); return r; }
__device__ __forceinline__ void st4f8(unsigned char* p, f32x4 v) { *(unsigned*)p = pack4f8(v[0], v[1], v[2], v[3]); }
struct KP { const float* in[42]; float* out; unsigned char* ws; int ph_lo, ph_hi; };

#define XB_TMO      128
#define XB_XCNT(j)  (256  + 64 * (j))
#define XB_XSUB(j)  (1280 + 64 * (j))
#define XB_XGEN(j)  (2304 + 64 * (j))
#define XB_TOP      3328
#define XB_TOPGEN   3392
#define XCD_BAR_WORDS 3456
#define XB_SPIN_CAP (1u << 18)
#define LAS __attribute__((address_space(3)))

__device__ __forceinline__ unsigned xb_ld(unsigned* p)              { return __hip_atomic_load(p, __ATOMIC_RELAXED, __HIP_MEMORY_SCOPE_AGENT); }
__device__ __forceinline__ unsigned xb_add(unsigned* p, unsigned v) { return __hip_atomic_fetch_add(p, v, __ATOMIC_RELAXED, __HIP_MEMORY_SCOPE_AGENT); }
__device__ __forceinline__ unsigned xb_xcc_id() { return (unsigned)__builtin_amdgcn_s_getreg((3 << 11) | 20) & 0xFu; }
#define XB_SPIN(cond, bar) do { unsigned _sp = 0; while (cond) { __builtin_amdgcn_s_sleep(1); \
    if ((++_sp & 255u) == 0u) { if (xb_ld(&(bar)[XB_TMO])) break; if (_sp > XB_SPIN_CAP) { atomicAdd(&(bar)[XB_TMO], 1u); break; } } } } while (0)

struct XcdBarrier {
    unsigned* bar; unsigned x;
    volatile LAS unsigned* st;
};

__device__ __forceinline__ XcdBarrier xcd_barrier_post(unsigned* bar, volatile LAS unsigned* st) {
    XcdBarrier b; b.bar = bar; b.x = xb_xcc_id(); b.st = st;
    if (threadIdx.x == 0) (void)xb_add(&bar[XB_XCNT(b.x)], 1u);
    return b;
}
__device__ __forceinline__ void xcd_barrier_complete(unsigned* bar, unsigned x, unsigned& nloc, unsigned& nx) {
    const unsigned G = gridDim.x * gridDim.y * gridDim.z;
    unsigned sum, cnt, mine, sp = 0u;
    for (;;) {
        sum = 0u; cnt = 0u; mine = 0u;
#pragma unroll
        for (unsigned j = 0; j < 16; ++j) { const unsigned c = xb_ld(&bar[XB_XCNT(j)]); sum += c; cnt += (c > 0u) ? 1u : 0u; mine = (j == x) ? c : mine; }
        if (sum == G) break;
        __builtin_amdgcn_s_sleep(1);
        if ((++sp & 255u) == 0u) { if (xb_ld(&bar[XB_TMO])) break; if (sp > XB_SPIN_CAP) { atomicAdd(&bar[XB_TMO], 1u); break; } }
    }
    nloc = mine > 0u ? mine : 1u; nx = cnt > 0u ? cnt : 1u;
}

__device__ __forceinline__ void xcd_barrier(const XcdBarrier& b) {
    asm volatile("s_waitcnt vmcnt(0)" ::: "memory");
    __syncthreads();
    if (threadIdx.x == 0) {
        unsigned* bar = b.bar;
        __builtin_amdgcn_s_waitcnt(0);
        unsigned nloc = b.st[0], nx = b.st[1];
        if (nloc == 0u) { xcd_barrier_complete(bar, b.x, nloc, nx); b.st[0] = nloc; b.st[1] = nx; }
        const unsigned old = xb_add(&bar[XB_XSUB(b.x)], 1u);
        const unsigned gen = old / nloc;
        if (old + 1u == (gen + 1u) * nloc) {
            __builtin_amdgcn_fence(__ATOMIC_RELEASE, "agent");
            asm volatile("s_waitcnt vmcnt(0)" ::: "memory");
            const unsigned og = xb_add(&bar[XB_TOP], 1u);
            const unsigned tg = og / nx;
            if (og + 1u == (tg + 1u) * nx) xb_add(&bar[XB_TOPGEN], 1u);
            else XB_SPIN(xb_ld(&bar[XB_TOPGEN]) == tg, bar);
            __builtin_amdgcn_fence(__ATOMIC_ACQUIRE, "agent");
            xb_add(&bar[XB_XGEN(b.x)], 1u);
            asm volatile("s_waitcnt vmcnt(0)" ::: "memory");
        } else {
            XB_SPIN(xb_ld(&bar[XB_XGEN(b.x)]) == gen, bar);
            __builtin_amdgcn_fence(__ATOMIC_ACQUIRE, "agent");
            asm volatile("s_waitcnt vmcnt(0)" ::: "memory");
        }
    }
    __syncthreads();
}
struct GA {
    const bf16_t* a0; const bf16_t* a1;
    int ld0, ld1, ksplit;
    const int* list;
    int nrows;
    int mode;
    int row0;
};
constexpr int G_LDT = 40;
constexpr int GEMM_LDS = (2 * 256 * G_LDT + 2 * 128 * G_LDT) * 2;

template <class Epi>
__device__ __forceinline__ void gemm_tile(unsigned char* lds, const GA& ga, const bf16_t* __restrict__ Bt, int K, int mt, int nt, const Epi& epi) {
    const int tid = otid(), lane = tid & 63, wid = __builtin_amdgcn_readfirstlane(tid >> 6), wm = wid >> 1, wn = wid & 1, fr = lane & 15, fq = lane >> 4;
    bf16_t* sA = (bf16_t*)lds;
    bf16_t* sB = sA + 2 * 256 * G_LDT;
    const int kp = tid & 3;
    const int r0 = tid >> 2, r1 = r0 + 128;
    int s0, s1;
    {
        int lr = mt * 256 + r0; if (lr >= ga.nrows) lr = 0;
        s0 = ga.list ? ga.list[lr] : (ga.mode == 1 ? (lr >> 11) * TT + CTXL + (lr & 2047) : ga.row0 + lr);
        lr = mt * 256 + r1; if (lr >= ga.nrows) lr = 0;
        s1 = ga.list ? ga.list[lr] : (ga.mode == 1 ? (lr >> 11) * TT + CTXL + (lr & 2047) : ga.row0 + lr);
    }
    const bf16_t* pa00 = ga.a0 + (size_t)s0 * ga.ld0 + kp * 8;
    const bf16_t* pa01 = ga.a0 + (size_t)s1 * ga.ld0 + kp * 8;
    const bf16_t* pa10 = ga.a1 ? ga.a1 + (size_t)s0 * ga.ld1 + kp * 8 : pa00;
    const bf16_t* pa11 = ga.a1 ? ga.a1 + (size_t)s1 * ga.ld1 + kp * 8 : pa01;
    const bf16_t* pb = Bt + (size_t)(nt * 128 + r0) * K + kp * 8;
    const int ksplit = ga.ksplit;
    f32x4 acc[4][4];
#pragma unroll
    for (int i = 0; i < 4; ++i)
#pragma unroll
        for (int j = 0; j < 4; ++j) acc[i][j] = (f32x4){0.f, 0.f, 0.f, 0.f};
    const int nk = K >> 5;
    u32x4 ra0, ra1, rb;
    {
        ra0 = *(const u32x4*)(pa00); ra1 = *(const u32x4*)(pa01); rb = *(const u32x4*)(pb);
        if (0 >= ksplit) { ra0 = *(const u32x4*)(pa10); ra1 = *(const u32x4*)(pa11); }
    }
    *(u32x4*)(sA + (r0) * G_LDT + kp * 8) = ra0;
    *(u32x4*)(sA + (r1) * G_LDT + kp * 8) = ra1;
    *(u32x4*)(sB + (r0) * G_LDT + kp * 8) = rb;
    __syncthreads();
    for (int kt = 0; kt < nk; ++kt) {
        const int cur = kt & 1;
        if (kt + 1 < nk) {
            const int k0 = (kt + 1) << 5;
            if (k0 < ksplit) { ra0 = *(const u32x4*)(pa00 + k0); ra1 = *(const u32x4*)(pa01 + k0); }
            else { ra0 = *(const u32x4*)(pa10 + (k0 - ksplit)); ra1 = *(const u32x4*)(pa11 + (k0 - ksplit)); }
            rb = *(const u32x4*)(pb + k0);
        }
        const bf16_t* cA = sA + cur * 256 * G_LDT;
        const bf16_t* cB = sB + cur * 128 * G_LDT;
        bf16x8 af[4], bfr[4];
#pragma unroll
        for (int i = 0; i < 4; ++i) af[i] = ldfrag(cA, G_LDT, wm * 64 + i * 16, 0, fr, fq);
#pragma unroll
        for (int j = 0; j < 4; ++j) bfr[j] = ldfrag(cB, G_LDT, wn * 64 + j * 16, 0, fr, fq);
#pragma unroll
        for (int i = 0; i < 4; ++i)
#pragma unroll
            for (int j = 0; j < 4; ++j) acc[i][j] = mma16(bfr[j], af[i], acc[i][j]);
        if (kt + 1 < nk) {
            const int nb = cur ^ 1;
            *(u32x4*)(sA + (nb * 256 + r0) * G_LDT + kp * 8) = ra0;
            *(u32x4*)(sA + (nb * 256 + r1) * G_LDT + kp * 8) = ra1;
            *(u32x4*)(sB + (nb * 128 + r0) * G_LDT + kp * 8) = rb;
        }
        __syncthreads();
    }
    epi(acc, mt * 256 + wm * 64, nt * 128 + wn * 64, fr, fq);
}

struct EpiBf {
    bf16_t* out; int ld, nrows, ncols;
    __device__ __forceinline__ void operator()(const f32x4 (&acc)[4][4], int rb, int cb, int fr, int fq) const {
#pragma unroll
        for (int i = 0; i < 4; ++i) { const int lr = rb + i * 16 + fr; if (lr < nrows) {
#pragma unroll
            for (int j = 0; j < 4; ++j) { const int col = cb + j * 16 + fq * 4; if (col < ncols) st4bf(out + (size_t)lr * ld + col, acc[i][j]); } } }
    }
};
struct EpiSwiglu {
    bf16_t* out; int nrows;
    __device__ __forceinline__ void operator()(const f32x4 (&acc)[4][4], int rb, int cb, int fr, int fq) const {
#pragma unroll
        for (int i = 0; i < 4; ++i) { const int lr = rb + i * 16 + fr; if (lr < nrows) {
#pragma unroll
            for (int j = 0; j < 2; ++j) { const int col = (cb >> 1) + j * 16 + fq * 4; f32x4 g = acc[i][j], u = acc[i][j + 2], o;
#pragma unroll
                for (int r = 0; r < 4; ++r) o[r] = siluf_(g[r]) * u[r];
                st4bf(out + (size_t)lr * 512 + col, o); } } }
    }
};

namespace pg8 {
#define PG8_LAS __attribute__((address_space(3)))
typedef unsigned short bf16_t;
typedef short bf16x8 __attribute__((ext_vector_type(8)));
typedef float f32x4 __attribute__((ext_vector_type(4)));
typedef unsigned u32x4 __attribute__((ext_vector_type(4)));
constexpr int BM = 256, BK = 64, HALF = 128, HTB = HALF * BK * 2  , STAGE_BYTES = 8 * HTB, NXCD = 8, WGM = 8;

__host__ __device__ __forceinline__ int lds_byte(int r, int c) { const int st = (r >> 4) * 2 + (c >> 5), rr = r & 15, cc = c & 31, ob = rr * 64 + cc * 2; return st * 1024 + (ob ^ (((ob >> 9) & 1) << 5)); }
__host__ __device__ __forceinline__ void stage_rc(int b, int& R, int& C) { const int st = b / 1024, sb = b % 1024, swz = sb ^ (((sb >> 9) & 1) << 5); R = (st >> 1) * 16 + swz / 64; C = (st & 1) * 32 + (swz % 64) / 2; }
__host__ __device__ __forceinline__ int perm32(int rho) { const int n = rho >> 4, i = rho & 15; return 8 * (i >> 2) + 4 * n + (i & 3); }

struct Unit { int pm, pn; };
struct Gemm { const bf16_t* A; const bf16_t* Bt; int M, N, K; const bf16_t* A2; int pm_split; int lda, amode; };
#define PG8_ABASE(g, pm) ((g).amode == 1 ? (const char*)(g).A + (size_t)(((pm) >> 3) * 2304 + 256 + ((pm) & 7) * 256) * lda_ * 2 : ((pm) < (g).pm_split ? (const char*)(g).A + (size_t)(pm) * tstepA : (const char*)(g).A2 + (size_t)((pm) - (g).pm_split) * tstepA))
struct StaticOrder {
    int nM, nN, nwg, G, c;
    __host__ __device__ void init(int M, int N, int G_, int c_) { nM = M / BM; nN = N / BM; nwg = nM * nN; G = G_; c = c_; }
    __host__ __device__ bool next(int i, Unit& u) const {
        const long L = (long)i * G + c; if (L >= nwg) return false;
        int wgid = (int)L; { const int q = nwg / NXCD, r = nwg % NXCD, xcd = wgid % NXCD, off = wgid / NXCD; wgid = (xcd < r ? xcd * (q + 1) : r * (q + 1) + (xcd - r) * q) + off; }
        const int nig = WGM * nN, gid = wgid / nig, fm = gid * WGM, gsz = (nM - fm) < WGM ? (nM - fm) : WGM;
        u.pm = fm + ((wgid % nig) % gsz); u.pn = (wgid % nig) / gsz; return true;
    }
    __device__ __forceinline__ void a_ready(const Unit&) const {}
    __device__ __forceinline__ void done(const Unit&) const {}
};
__device__ __forceinline__ unsigned cvt_pk_bf16(float lo, float hi) { unsigned r; asm volatile("v_cvt_pk_bf16_f32 %0, %1, %2" : "=v"(r) : "v"(lo), "v"(hi)); return r; }
typedef float f32x2 __attribute__((ext_vector_type(2)));
template <class Epi, class Sched, bool STAMP = false, bool F8 = false>
__device__ __forceinline__ void gemm_phase(PG8_LAS unsigned char* lds, const Gemm g, const Sched& S, const Epi& E, unsigned long long* stamps) {
    const int tid = otid(), wid = __builtin_amdgcn_readfirstlane(tid >> 6), lane = tid & 63, wr = wid >> 2, wc = wid & 3, fr = lane & 15, fq = lane >> 4;
    const int K = g.K, nt = K / BK, lda_ = g.lda ? g.lda : g.K;
    int ts_lo = 0, ts_hi = 0, nts = 0; const unsigned long long rt_entry = STAMP ? (unsigned long long)wall_clock64() : 0ull;
#define PG8_STAMP() do { if (STAMP && wid == 0 && nts < 64) { const unsigned long long _c = (unsigned long long)clock64(); \
        ts_lo = (lane == nts) ? (int)(unsigned)_c : ts_lo; ts_hi = (lane == nts) ? (int)(unsigned)(_c >> 32) : ts_hi; ++nts; } } while (0)
    PG8_STAMP();
    unsigned voffA[2], voffB[2];
#pragma unroll
    for (int i = 0; i < 2; ++i) { int R, C; stage_rc(tid * 16 + i * 8192, R, C); const int Rb = Epi::PERM ? ((R & ~31) + perm32(R & 31)) : R;
        voffA[i] = (unsigned)(R * lda_ + C) * 2u; voffB[i] = (unsigned)(Rb * K + C) * 2u; }
    const size_t kstep = (size_t)(BK * 2);
    const size_t hstep = (size_t)HALF * K * 2;
    const size_t hstepA = (size_t)HALF * lda_ * 2, tstepA = 2 * hstepA;
    const size_t tstep = 2 * hstep;
    const unsigned ldsw = (unsigned)wid * 1024u;
    const int aoff = lds_byte(wr * 64 + fr, fq * 8), boff = lds_byte(wc * 32 + fr, fq * 8);
#define PG8_SA(b, h) (((b) * 2 + (h)) * HTB)
#define PG8_SB(b, h) ((4 + (b) * 2 + (h)) * HTB)
#define PG8_STAGE(bufoff, gbase, voff) do { _Pragma("unroll") for (int _i = 0; _i < 2; ++_i) \
        __builtin_amdgcn_global_load_lds((const unsigned*)((const char*)(gbase) + (voff)[_i]), (PG8_LAS unsigned*)(lds + (bufoff) + ldsw + _i * 8192), 16, 0, 0); } while (0)
#define PG8_LDA(dst, b, h) do { _Pragma("unroll") for (int m = 0; m < 4; ++m) { \
        if constexpr (F8) { dst##8[m].lo = *(const PG8_LAS v4i_*)(lds + PG8_SA(b, h) + aoff + m * 2048); dst##8[m].hi = *(const PG8_LAS v4i_*)(lds + PG8_SA(b, h) + aoff + m * 2048 + 1024); } \
        else { _Pragma("unroll") for (int k = 0; k < 2; ++k) dst[m][k] = *(const PG8_LAS bf16x8*)(lds + PG8_SA(b, h) + aoff + m * 2048 + k * 1024); } } } while (0)
#define PG8_LDB(dst, b, h) do { _Pragma("unroll") for (int n = 0; n < 2; ++n) { \
        if constexpr (F8) { dst##8[n].lo = *(const PG8_LAS v4i_*)(lds + PG8_SB(b, h) + boff + n * 2048); dst##8[n].hi = *(const PG8_LAS v4i_*)(lds + PG8_SB(b, h) + boff + n * 2048 + 1024); } \
        else { _Pragma("unroll") for (int k = 0; k < 2; ++k) dst[n][k] = *(const PG8_LAS bf16x8*)(lds + PG8_SB(b, h) + boff + n * 2048 + k * 1024); } } } while (0)
#define PG8_MMA(ai, bj, At, Bt) do { __builtin_amdgcn_s_setprio(1); _Pragma("unroll") for (int m = 0; m < 4; ++m) _Pragma("unroll") for (int n = 0; n < 2; ++n) { \
        if constexpr (F8) asm volatile("v_mfma_scale_f32_16x16x128_f8f6f4 %0, %1, %2, %0, %3, %3 op_sel_hi:[0,0,0]" : "+v"(acc[ai][bj][m][n]) : "v"(Bt##8[n]), "v"(At##8[m]), "v"(one_scale)); \
        else { _Pragma("unroll") for (int k = 0; k < 2; ++k) acc[ai][bj][m][n] = __builtin_amdgcn_mfma_f32_16x16x32_bf16(Bt[n][k], At[m][k], acc[ai][bj][m][n], 0, 0, 0); } } \
        __builtin_amdgcn_s_setprio(0); } while (0)
#define PG8_WAIT_V(n) asm volatile("s_waitcnt vmcnt(" #n ")" ::: "memory")
#define PG8_WAIT_L(n) asm volatile("s_waitcnt lgkmcnt(" #n ")" ::: "memory")
#define PG8_BAR __builtin_amdgcn_s_barrier()
#define PG8_SCHED __builtin_amdgcn_sched_barrier(0)
    Unit cur, nxt; int ui = 0;
    if (!S.next(0, cur)) return;
    f32x4 acc[2][2][4][2];
#pragma unroll
    for (int a = 0; a < 2; ++a)
#pragma unroll
        for (int b = 0; b < 2; ++b)
#pragma unroll
            for (int m = 0; m < 4; ++m)
#pragma unroll
                for (int n = 0; n < 2; ++n) acc[a][b][m][n] = (f32x4){0.f, 0.f, 0.f, 0.f};
    bf16x8 At[4][2], B0[2][2], B1[2][2];
    typedef int v4i_ __attribute__((ext_vector_type(4))); typedef int v8i_ __attribute__((ext_vector_type(8)));
    v8i_ At8[4], B08[2], B18[2];
    const int one_scale = 0x7f7f7f7f;
    const char* cA = PG8_ABASE(g, cur.pm); const char* cB = (const char*)g.Bt + (size_t)cur.pn * tstep;
    S.a_ready(cur);
    PG8_STAGE(PG8_SB(0, 0), cB, voffB); PG8_STAGE(PG8_SA(0, 0), cA, voffA); PG8_STAGE(PG8_SB(0, 1), cB + hstep, voffB); PG8_STAGE(PG8_SA(0, 1), cA + hstepA, voffA);
    if (wr == 1) PG8_BAR;
    PG8_WAIT_V(4); PG8_BAR;
    PG8_STAGE(PG8_SB(1, 0), cB + kstep, voffB); PG8_STAGE(PG8_SA(1, 0), cA + kstep, voffA); PG8_STAGE(PG8_SB(1, 1), cB + hstep + kstep, voffB);
    PG8_WAIT_V(6); PG8_BAR;
    PG8_STAMP();
    for (;;) {
        const bool has_next = S.next(ui + 1, nxt);
        const char* nA = has_next ? PG8_ABASE(g, nxt.pm) : cA; const char* nB = has_next ? (const char*)g.Bt + (size_t)nxt.pn * tstep : cB;
#pragma unroll 1
        for (int t = 0; t < nt; t += 2) {
            const bool last = (t == nt - 2);
            const char* a1 = cA + (size_t)(t + 1) * kstep;
            const char* a2 = last ? nA : cA + (size_t)(t + 2) * kstep; const char* b2 = last ? nB : cB + (size_t)(t + 2) * kstep;
            const char* a3 = a2 + kstep; const char* b3 = b2 + kstep;
            if (last && has_next) S.a_ready(nxt);
            PG8_LDB(B0, 0, 0); PG8_SCHED; PG8_LDA(At, 0, 0); PG8_STAGE(PG8_SA(1, 1), a1 + hstepA, voffA);
            PG8_WAIT_L(8); PG8_BAR; PG8_WAIT_L(0); PG8_MMA(0, 0, At, B0); PG8_BAR; PG8_SCHED;
            PG8_LDB(B1, 0, 1); PG8_STAGE(PG8_SB(0, 0), b2, voffB);
            PG8_BAR; PG8_WAIT_L(0); PG8_MMA(0, 1, At, B1); PG8_BAR;
            PG8_LDA(At, 0, 1); PG8_STAGE(PG8_SA(0, 0), a2, voffA);
            PG8_BAR; PG8_WAIT_L(0); PG8_MMA(1, 0, At, B0); PG8_BAR; PG8_SCHED;
            PG8_STAGE(PG8_SB(0, 1), b2 + hstep, voffB);
            PG8_WAIT_V(6); PG8_BAR; PG8_MMA(1, 1, At, B1); PG8_BAR;
            PG8_LDB(B0, 1, 0); PG8_SCHED; PG8_LDA(At, 1, 0); PG8_STAGE(PG8_SA(0, 1), a2 + hstepA, voffA);
            PG8_WAIT_L(8); PG8_BAR; PG8_WAIT_L(0); PG8_MMA(0, 0, At, B0); PG8_BAR; PG8_SCHED;
            PG8_LDB(B1, 1, 1); PG8_STAGE(PG8_SB(1, 0), b3, voffB);
            PG8_BAR; PG8_WAIT_L(0); PG8_MMA(0, 1, At, B1); PG8_BAR;
            PG8_LDA(At, 1, 1); PG8_STAGE(PG8_SA(1, 0), a3, voffA);
            PG8_BAR; PG8_WAIT_L(0); PG8_MMA(1, 0, At, B0); PG8_BAR; PG8_SCHED;
            PG8_STAGE(PG8_SB(1, 1), b3 + hstep, voffB);
            PG8_WAIT_V(6); PG8_BAR; PG8_MMA(1, 1, At, B1); PG8_BAR;
        }
        PG8_STAMP();
        if constexpr (F8) asm volatile("s_nop 15\n\ts_nop 15" ::: "memory");
        if constexpr (!Epi::AFTER_DRAIN) { E(acc, cur, wr, wc, fr, fq); S.done(cur); }
        PG8_STAMP();
        if (!has_next) break;
#pragma unroll
        for (int a = 0; a < 2; ++a)
#pragma unroll
            for (int b = 0; b < 2; ++b)
#pragma unroll
                for (int m = 0; m < 4; ++m)
#pragma unroll
                    for (int n = 0; n < 2; ++n) acc[a][b][m][n] = (f32x4){0.f, 0.f, 0.f, 0.f};
        cur = nxt; cA = nA; cB = nB; ++ui;
    }
    PG8_WAIT_V(0);
    if (wr == 0) PG8_BAR;
    PG8_BAR;
    if constexpr (Epi::AFTER_DRAIN) { E.fused(acc, cur, wr, wc, fr, fq, lds, wid, lane); S.done(cur); }
    PG8_STAMP();
    if (STAMP && wid == 0) { stamps[lane] = lane < nts ? (((unsigned long long)(unsigned)ts_hi << 32) | (unsigned)ts_lo) : 0ull;
        if (lane == 62) stamps[62] = rt_entry; if (lane == 63) stamps[63] = (unsigned long long)wall_clock64(); }
#undef PG8_STAMP
#undef PG8_SA
#undef PG8_SB
#undef PG8_STAGE
#undef PG8_LDA
#undef PG8_LDB
#undef PG8_MMA
#undef PG8_WAIT_V
#undef PG8_WAIT_L
#undef PG8_BAR
#undef PG8_SCHED
}
}
namespace pg8 {
struct EpiBfG {
    static constexpr bool PERM = true, AFTER_DRAIN = false;
    bf16_t* O; int ldc, ncols, pn_mask; float oscale;
    __device__ __forceinline__ void operator()(const f32x4 (&acc)[2][2][4][2], const Unit& u, int wr, int wc, int fr, int fq) const {
        const int row0 = u.pm * BM + wr * 64 + fr, col0 = (u.pn & pn_mask) * BM + wc * 32 + 8 * fq;
#pragma unroll
        for (int ai = 0; ai < 2; ++ai)
#pragma unroll
            for (int m = 0; m < 4; ++m) { bf16_t* rowp = O + (size_t)(row0 + ai * HALF + m * 16) * ldc;
#pragma unroll
                for (int bj = 0; bj < 2; ++bj) { const int c = col0 + bj * HALF;
                    if (c < ncols) { const f32x4 v0 = acc[ai][bj][m][0] * oscale, v1 = acc[ai][bj][m][1] * oscale;
                        u32x4 w; w.x = cvt_pk_bf16(v0[0], v0[1]); w.y = cvt_pk_bf16(v0[2], v0[3]); w.z = cvt_pk_bf16(v1[0], v1[1]); w.w = cvt_pk_bf16(v1[2], v1[3]);
                        *(u32x4*)(rowp + c) = w; } } }
    }
};
struct EpiSwi {
    static constexpr bool PERM = true, AFTER_DRAIN = false;
    bf16_t* H;
    __device__ __forceinline__ void operator()(const f32x4 (&acc)[2][2][4][2], const Unit& u, int wr, int wc, int fr, int fq) const {
        const int row0 = u.pm * BM + wr * 64 + fr, hc0 = (u.pn & 3) * HALF + wc * 32 + 8 * fq;
#pragma unroll
        for (int ai = 0; ai < 2; ++ai)
#pragma unroll
            for (int m = 0; m < 4; ++m) { unsigned char* rowp = (unsigned char*)H + (size_t)(row0 + ai * HALF + m * 16) * 1024 + hc0;
                float o[8];
#pragma unroll
                for (int n = 0; n < 2; ++n)
#pragma unroll
                    for (int r = 0; r < 4; ++r) { const float g = acc[ai][0][m][n][r] * W8_INV; o[n * 4 + r] = g * __builtin_amdgcn_rcpf(1.0f + __expf(-g)) * (acc[ai][1][m][n][r] * W8_INV); }
                u32x2 w; w.x = pack4f8(o[0], o[1], o[2], o[3]); w.y = pack4f8(o[4], o[5], o[6], o[7]);
                *(u32x2*)rowp = w; }
    }
};
struct MoeOrder {
    const int* slotmap; int ntiles, G, c;
    __device__ __forceinline__ bool next(int i, Unit& u) const {
        const int L = i * G + c; if (L >= ntiles * 4) return false;
        u.pm = L >> 2; u.pn = __builtin_amdgcn_readfirstlane(slotmap[L >> 2]) * 4 + (L & 3); return true;
    }
    __device__ __forceinline__ void a_ready(const Unit&) const {}
    __device__ __forceinline__ void done(const Unit&) const {}
};
}
#define WSP(T, off) as_global((T*)(kp.ws + (off)))
#define KIN(i) as_global(kp.in[i])
#define KOUT as_global(kp.out)

PHASE_FN void phase_mod(const KP& kp, unsigned char* lds) {
    float* sc = (float*)lds;
    float* red = sc + 17 * 1024;
    float* modv = WSP(float, WS_MODV);
    const int tid = otid();
    for (int i = tid; i < 17 * 1024; i += 512) { const int bb = i >> 10, k = i & 1023; const float c = bb < 16 ? KIN(1)[bb * 1024 + k] : KIN(3)[k]; sc[i] = siluf_(c); }
    __syncthreads();
    const int jc = tid & 63, ks = tid >> 6;
    for (int u = obid(); u < 192; u += gridDim.x) {
        const int l = u / 96, j0 = (u % 96) * 64;
        const float* w = KIN(4) + (size_t)l * 1024 * 6144 + j0 + jc;
        float acc[17];
#pragma unroll
        for (int bb = 0; bb < 17; ++bb) acc[bb] = 0.f;
        for (int k = ks * 128; k < ks * 128 + 128; ++k) {
            const float wv = w[(size_t)k * 6144];
#pragma unroll
            for (int bb = 0; bb < 17; ++bb) acc[bb] += sc[bb * 1024 + k] * wv;
        }
#pragma unroll
        for (int bb = 0; bb < 17; ++bb) red[(ks * 17 + bb) * 64 + jc] = acc[bb];
        __syncthreads();
        for (int i = tid; i < 17 * 64; i += 512) {
            const int bb = i >> 6, j = i & 63; float s = KIN(5)[l * 6144 + j0 + j];
#pragma unroll
            for (int k2 = 0; k2 < 8; ++k2) s += red[(k2 * 17 + bb) * 64 + j];
            modv[((size_t)l * 17 + bb) * 6144 + j0 + j] = s;
        }
        __syncthreads();
    }
}

struct CvJob { const float* src; bf16_t* dst; int N, ldd, mode, kt, ntile, f8; };
__device__ __forceinline__ bool cv_pick(int& u, CvJob& J, const float* src, int K, int N, bf16_t* dst, int mode = 0, int ldd = -1, int f8 = 0) {
    const int ntl = (N + 63) >> 6, cnt = ntl * (K >> 6);
    if (u < cnt) { J.src = src; J.dst = dst; J.N = N; J.ldd = ldd < 0 ? K : ldd; J.mode = mode; J.kt = u / ntl; J.ntile = u % ntl; J.f8 = f8; return true; }
    u -= cnt; return false;
}
__device__ __forceinline__ void cv_load(const CvJob& J, int tid, f32x4 (&r)[2]) {
#pragma unroll
    for (int i = 0; i < 2; ++i) { const int idx = tid + i * 512, k = idx >> 4, n0 = J.ntile * 64 + (idx & 15) * 4;
        r[i] = (n0 < J.N) ? *(const f32x4*)(J.src + (size_t)(J.kt * 64 + k) * J.N + n0) : (f32x4){0.f, 0.f, 0.f, 0.f}; }
}
__device__ __forceinline__ void cv_put(float* tile, int tid, const f32x4 (&r)[2]) {
#pragma unroll
    for (int i = 0; i < 2; ++i) { const int idx = tid + i * 512, k = idx >> 4, nq = (idx & 15) * 4;
        tile[k * 65 + nq] = r[i][0]; tile[k * 65 + nq + 1] = r[i][1]; tile[k * 65 + nq + 2] = r[i][2]; tile[k * 65 + nq + 3] = r[i][3]; }
}
__device__ __forceinline__ void cv_store(const float* tile, const CvJob& J, int tid) {
    const int nl = tid >> 3, k8 = tid & 7, n = J.ntile * 64 + nl;
    if (n < J.N) { int row = n; if (J.mode) row = (n >> 7) * 256 + (n & 127) + (J.mode == 2 ? 128 : 0);
        const float* tp = tile + (k8 * 8) * 65 + nl;
        if (J.f8) { u32x2 w; w.x = pack4f8(tp[0] * W8_SCALE, tp[65] * W8_SCALE, tp[130] * W8_SCALE, tp[195] * W8_SCALE); w.y = pack4f8(tp[260] * W8_SCALE, tp[325] * W8_SCALE, tp[390] * W8_SCALE, tp[455] * W8_SCALE);
            *(u32x2*)((unsigned char*)J.dst + (size_t)row * J.ldd + J.kt * 64 + k8 * 8) = w; }
        else { u32x4 w; w.x = pack2(tp[0], tp[65]); w.y = pack2(tp[130], tp[195]); w.z = pack2(tp[260], tp[325]); w.w = pack2(tp[390], tp[455]);
            *(u32x4*)(J.dst + (size_t)row * J.ldd + J.kt * 64 + k8 * 8) = w; } }
}
#define CV_RUN(total, PICK) CV_RUN_ON(total, PICK, obid(), (int)gridDim.x)
#define CV_SUB(total, PICK, Jx, rx, ux, tilex) { if (ux >= (total)) break; cv_put(tilex, tid, rx); lds_barrier(); const CvJob Jt_ = Jx; ux += 3 * G_; \
            if (ux < (total)) { int u = ux; PICK(u, Jx); cv_load(Jx, tid, rx); } cv_store(tilex, Jt_, tid); }
#define CV_RUN_ON(total, PICK, bid_, nb_) do { float* tile = (float*)lds; const int tid = otid(); const int G_ = (nb_); CvJob Ja, Jb, Jc; f32x4 ra[2], rb[2], rc[2]; \
        int ua_ = (bid_), ub_ = ua_ + G_, uc_ = ub_ + G_; \
        if (ua_ < (total)) { int u = ua_; PICK(u, Ja); cv_load(Ja, tid, ra); } \
        if (ub_ < (total)) { int u = ub_; PICK(u, Jb); cv_load(Jb, tid, rb); } \
        if (uc_ < (total)) { int u = uc_; PICK(u, Jc); cv_load(Jc, tid, rc); } \
        for (;;) { CV_SUB(total, PICK, Ja, ra, ua_, tile) CV_SUB(total, PICK, Jb, rb, ub_, tile + 64 * 65) CV_SUB(total, PICK, Jc, rc, uc_, tile + 2 * 64 * 65) } \
        lds_barrier(); } while (0)
PHASE_FN void phase_conv_ab(const KP& kp, unsigned char* lds) {
#define PICK_AB(u, J) do { if (!cv_pick(u, J, KIN(7), 1024, AB_N, WSP(bf16_t, WS_WMIX + WM_AB_IN))) cv_pick(u, J, KIN(8), 2048, 1024, WSP(bf16_t, WS_WMIX + WM_AB_OUT)); } while (0)
    CV_RUN(16 * 85 + 32 * 16, PICK_AB);
#undef PICK_AB
}
PHASE_FN void phase_conv_cd(const KP& kp, unsigned char* lds) {
#define PICK_CD(u, J) do { if (cv_pick(u, J, KIN(18), 1024, CD_N, WSP(bf16_t, WS_WMIX + WM_CD_IN), 0, 1024, 1)) break;     \
        if (cv_pick(u, J, KIN(19), 1536, 1024, WSP(bf16_t, WS_WMIX + WM_CD_OUT))) break; \
        if (cv_pick(u, J, KIN(21), 384, 768, WSP(bf16_t, WS_WMIX + WM_UQ))) break; \
        if (cv_pick(u, J, KIN(23), 256, 1024, WSP(bf16_t, WS_WMIX + WM_UKV))) break; \
        cv_pick(u, J, KIN(29), 128, 1024, WSP(bf16_t, WS_WMIX + WM_G2)); } while (0)
    CV_RUN(16 * 65 + 24 * 16 + 6 * 12 + 4 * 16 + 2 * 16, PICK_CD);
#undef PICK_CD
}
PHASE_FN void phase_conv_moe(const KP& kp, unsigned char* lds, int l, int bid, int nb) {
#define PICK_MOE(u0, J) do { const int es = (u0) / 384; int uu = (u0) % 384; \
        const float* wg = es < 16 ? KIN(36) + ((size_t)l * 16 + es) * 1024 * 512 : KIN(39) + (size_t)l * 1024 * 512; \
        const float* wu = es < 16 ? KIN(37) + ((size_t)l * 16 + es) * 1024 * 512 : KIN(40) + (size_t)l * 1024 * 512; \
        const float* wd = es < 16 ? KIN(38) + ((size_t)l * 16 + es) * 512 * 1024 : KIN(41) + (size_t)l * 512 * 1024; \
        bf16_t* dup = (bf16_t*)(WSP(unsigned char, WS_BIG + MO_WUP) + (size_t)es * 1024 * 1024); bf16_t* ddn = (bf16_t*)(WSP(unsigned char, WS_BIG + MO_WDN) + (size_t)es * 1024 * 512); \
        if (cv_pick(uu, J, wg, 1024, 512, dup, 1, 1024, 1)) break; if (cv_pick(uu, J, wu, 1024, 512, dup, 2, 1024, 1)) break; cv_pick(uu, J, wd, 512, 1024, ddn, 0, 512, 1); } while (0)
    CV_RUN_ON(17 * 384, PICK_MOE, bid, nb);
#undef PICK_MOE
}

__device__ __forceinline__ const float* hrow_rd(const KP& kp, bool from_inputs, int b, int t) {
    if (t < CTXL) return (from_inputs ? KIN(2) : WSP(const float, WS_HC)) + ((size_t)b * CTXL + t) * D;
    return (from_inputs ? KIN(0) : KOUT) + ((size_t)b * SEQ + (t - CTXL)) * D;
}
__device__ __forceinline__ float* hrow_wr(const KP& kp, int b, int t) {
    if (t < CTXL) return WSP(float, WS_HC) + ((size_t)b * CTXL + t) * D;
    return KOUT + ((size_t)b * SEQ + (t - CTXL)) * D;
}

PHASE_FN void phase_u(const KP& kp, int layer, int g, int bid, int nb, bool to_v) {
    const int lane = otid() & 63, wid = __builtin_amdgcn_readfirstlane(otid() >> 6);
    const float* modv = WSP(const float, WS_MODV) + (size_t)layer * 17 * 6144;
    const float* ng = KIN(6) + (size_t)layer * 4 * 1024;
    bf16_t* U = to_v ? WSP(bf16_t, WS_V) + (size_t)RG * 1024 : WSP(bf16_t, WS_BIG + (layer == 0 ? L0_U : L1_U));
    for (int lr = bid * 8 + wid; lr < RG; lr += nb * 8) {
        const int bl = lr / TT, t = lr - bl * TT, b = g * BG + bl;
        const float* src = hrow_rd(kp, layer == 0, b, t);
        const float* mv = modv + (size_t)(t < CTXL ? 16 : b) * 6144;
        f32x4 x[4], gvv[4], scv[4], shv[4]; float ss = 0.f;
#pragma unroll
        for (int i = 0; i < 4; ++i) { const int col = i * 256 + lane * 4; x[i] = *(const f32x4*)(src + col);
            gvv[i] = *(const f32x4*)(ng + col); scv[i] = *(const f32x4*)(mv + 1024 + col); shv[i] = *(const f32x4*)(mv + col); }
#pragma unroll
        for (int i = 0; i < 4; ++i) ss += x[i][0] * x[i][0] + x[i][1] * x[i][1] + x[i][2] * x[i][2] + x[i][3] * x[i][3];
        ss = wsum(ss); const float rstd = rsqrtf(ss * (1.0f / 1024.0f) + EPS);
#pragma unroll
        for (int i = 0; i < 4; ++i) st4bf(U + (size_t)lr * 1024 + i * 256 + lane * 4, x[i] * rstd * gvv[i] * (scv[i] + 1.0f) + shv[i]);
    }
}

PHASE_FN void phase_r(const KP& kp, unsigned char* lds, int layer, int g, size_t mix_off) {
    const int tid = otid(), lane = tid & 63, wid = __builtin_amdgcn_readfirstlane(tid >> 6);
    float* rw = (float*)lds;
    int* se = (int*)(rw + 1024 * 16);
    int* sbase = se + 160;
    int* swc = sbase + 16;
    {
        f32x4 rwt[8];
#pragma unroll
        for (int q = 0; q < 8; ++q) rwt[q] = *(const f32x4*)(KIN(34) + (size_t)(tid + q * 512) * 4);
#pragma unroll
        for (int q = 0; q < 8; ++q) *(f32x4*)(rw + (tid + q * 512) * 4) = rwt[q];
    }
    __syncthreads();
    const float* modv = WSP(const float, WS_MODV) + (size_t)layer * 17 * 6144;
    const float* ng = KIN(6) + (size_t)layer * 4 * 1024;
    const bf16_t* MIX = WSP(const bf16_t, WS_BIG + mix_off);
    bf16_t* V = WSP(bf16_t, WS_V);
    unsigned* cnt = WSP(unsigned, CTL_CNT) + layer * 16;
    int* TOKE = WSP(int, WS_TOKE); int* TOKP = WSP(int, WS_TOKP); float* TOKW = WSP(float, WS_TOKW); int* LIST = WSP(int, WS_LIST);
    const int nrows = layer == 0 ? RG : RGL, CH = layer == 0 ? 72 : 64, RW = CH >> 3, nchunks = nrows / CH;
    float rbias[16];
#pragma unroll
    for (int e = 0; e < 16; ++e) rbias[e] = KIN(35)[e];
    for (int ch = obid(); ch < nchunks; ch += gridDim.x) {
        for (int rr = 0; rr < RW; ++rr) {
            const int rl = wid * RW + rr, lr = ch * CH + rl;
            int b, t, tok;
            if (layer == 0) { const int bl = lr / TT; t = lr - bl * TT; b = g * BG + bl; tok = g * RG + lr; }
            else { const int bl = lr >> 11; t = CTXL + (lr & 2047); b = g * BG + bl; tok = g * RGL + lr; }
            const float* hsrc = hrow_rd(kp, layer == 0, b, t);
            float* hdst = hrow_wr(kp, b, t);
            const float* mv = modv + (size_t)(t < CTXL ? 16 : b) * 6144;
            f32x4 y[4], h[4], hxr[4], g1v[4], gav[4], g2v[4], scv[4], shv[4]; float ss = 0.f;
            u32x2 yraw[4], hraw[4];
#pragma unroll
            for (int i = 0; i < 4; ++i) { const int col = i * 256 + lane * 4;
                yraw[i] = *(const u32x2*)(MIX + (size_t)lr * 1024 + col);
                if (layer == 0) hxr[i] = *(const f32x4*)(hsrc + col); else hraw[i] = *(const u32x2*)((const bf16_t*)hsrc + col);
                g1v[i] = *(const f32x4*)(ng + 1024 + col); gav[i] = *(const f32x4*)(mv + 2048 + col);
                g2v[i] = *(const f32x4*)(ng + 2048 + col); scv[i] = *(const f32x4*)(mv + 4096 + col); shv[i] = *(const f32x4*)(mv + 3072 + col); }
#pragma unroll
            for (int i = 0; i < 4; ++i) { y[i] = (f32x4){lo2f(yraw[i].x), hi2f(yraw[i].x), lo2f(yraw[i].y), hi2f(yraw[i].y)};
                if (layer != 0) hxr[i] = (f32x4){lo2f(hraw[i].x), hi2f(hraw[i].x), lo2f(hraw[i].y), hi2f(hraw[i].y)}; }
#pragma unroll
            for (int i = 0; i < 4; ++i) ss += y[i][0] * y[i][0] + y[i][1] * y[i][1] + y[i][2] * y[i][2] + y[i][3] * y[i][3];
            ss = wsum(ss); float rstd = rsqrtf(ss * (1.0f / 1024.0f) + EPS);
            float s2 = 0.f;
#pragma unroll
            for (int i = 0; i < 4; ++i) { h[i] = hxr[i] + gav[i] * (y[i] * rstd * g1v[i]);
                s2 += h[i][0] * h[i][0] + h[i][1] * h[i][1] + h[i][2] * h[i][2] + h[i][3] * h[i][3]; }
#pragma unroll
            for (int i = 0; i < 4; ++i) st4bf((bf16_t*)hdst + i * 256 + lane * 4, h[i]);
            s2 = wsum(s2); rstd = rsqrtf(s2 * (1.0f / 1024.0f) + EPS);
            float lg[16];
#pragma unroll
            for (int e = 0; e < 16; ++e) lg[e] = 0.f;
#pragma unroll
            for (int i = 0; i < 4; ++i) { const int col = i * 256 + lane * 4;
                const f32x4 v = h[i] * rstd * g2v[i] * (scv[i] + 1.0f) + shv[i];
                st4f8((unsigned char*)V + (size_t)tok * 2048 + col, v);
#pragma unroll
                for (int j = 0; j < 4; ++j) {
#pragma unroll
                    for (int q = 0; q < 4; ++q) { const f32x4 w4 = *(const f32x4*)(rw + (col + j) * 16 + q * 4);
                        lg[q * 4 + 0] += v[j] * w4[0]; lg[q * 4 + 1] += v[j] * w4[1]; lg[q * 4 + 2] += v[j] * w4[2]; lg[q * 4 + 3] += v[j] * w4[3]; } } }
#pragma unroll
            for (int e = 0; e < 16; ++e) lg[e] = wsum(lg[e]);
            float aff[16], sel[16];
#pragma unroll
            for (int e = 0; e < 16; ++e) { aff[e] = sigmoidf_(lg[e]); sel[e] = aff[e] + rbias[e]; }
            float gs[4];
#pragma unroll
            for (int gi = 0; gi < 4; ++gi) { const float a0 = sel[gi * 4], a1 = sel[gi * 4 + 1], a2 = sel[gi * 4 + 2], a3 = sel[gi * 4 + 3];
                gs[gi] = fmaxf(fmaxf(fmaxf(a0 + a1, a0 + a2), fmaxf(a0 + a3, a1 + a2)), fmaxf(a1 + a3, a2 + a3)); }
            int gidx = 0; float gb = gs[0];
#pragma unroll
            for (int gi = 1; gi < 4; ++gi) if (gs[gi] > gb) { gb = gs[gi]; gidx = gi; }
            float c[4], f[4];
#pragma unroll
            for (int i = 0; i < 4; ++i) { c[i] = gidx == 0 ? sel[i] : gidx == 1 ? sel[4 + i] : gidx == 2 ? sel[8 + i] : sel[12 + i];
                                           f[i] = gidx == 0 ? aff[i] : gidx == 1 ? aff[4 + i] : gidx == 2 ? aff[8 + i] : aff[12 + i]; }
            int i1 = 0; float cb = c[0];
#pragma unroll
            for (int i = 1; i < 4; ++i) if (c[i] > cb) { cb = c[i]; i1 = i; }
            int i2 = -1; float cb2 = 0.f;
#pragma unroll
            for (int i = 0; i < 4; ++i) if (i != i1 && (i2 < 0 || c[i] > cb2)) { cb2 = c[i]; i2 = i; }
            float w1 = i1 == 0 ? f[0] : i1 == 1 ? f[1] : i1 == 2 ? f[2] : f[3];
            float w2 = i2 == 0 ? f[0] : i2 == 1 ? f[1] : i2 == 2 ? f[2] : f[3];
            const float wsn = 1.0f / (w1 + w2); w1 *= wsn; w2 *= wsn;
            if (lane == 0) { se[rl * 2] = gidx * 4 + i1; se[rl * 2 + 1] = gidx * 4 + i2;
                TOKE[tok * 2] = gidx * 4 + i1; TOKE[tok * 2 + 1] = gidx * 4 + i2; TOKW[tok * 2] = w1; TOKW[tok * 2 + 1] = w2; }
        }
        __syncthreads();
        int my_e = -1, my_rank = 0;
        if (tid < 192) {
            if (tid < 2 * CH) my_e = se[tid];
            int cw = 0;
#pragma unroll
            for (int x = 0; x < 16; ++x) { const unsigned long long m = __builtin_amdgcn_ballot_w64(my_e == x);
                if (lane == x) cw = __builtin_popcountll(m);
                if (my_e == x) my_rank = __builtin_popcountll(m & ((1ull << lane) - 1ull)); }
            if (lane < 16) swc[wid * 16 + lane] = cw;
        }
        __syncthreads();
        if (tid < 16) sbase[tid] = (int)atomicAdd(&cnt[tid], (unsigned)(swc[tid] + swc[16 + tid] + swc[32 + tid]));
        __syncthreads();
        if (tid < 2 * CH) { const int e = my_e; int rank = my_rank; if (wid > 0) rank += swc[e]; if (wid > 1) rank += swc[16 + e];
            const int pos = sbase[e] + rank; const int lr = ch * CH + (tid >> 1); const int tok = (layer == 0 ? g * RG : g * RGL) + lr;
            LIST[(size_t)e * NTOK + pos] = tok; TOKP[tok * 2 + (tid & 1)] = pos; }
        __syncthreads();
    }
}

__device__ __forceinline__ int moe_tile_prefix(const unsigned* cnt, int ntok, int lane) {
    const int myt = lane < 16 ? (int)((cnt[lane & 15] + 255u) >> 8) : 0; int pref = myt;
#pragma unroll
    for (int o = 1; o < 16; o <<= 1) { const int t = __shfl_up(pref, o); if (lane >= o) pref += t; }
    return pref - myt + ntok / 256;
}
PHASE_FN void phase_moe_gather(const KP& kp, int layer) {
    const int lane = otid() & 63, wid = __builtin_amdgcn_readfirstlane(otid() >> 6);
    const int ntok = layer == 0 ? NTOK : NLAT;
    const int tpre = moe_tile_prefix(WSP(const unsigned, CTL_CNT) + layer * 16, ntok, lane);
    const bf16_t* V = WSP(const bf16_t, WS_V); bf16_t* XG = WSP(bf16_t, WS_BIG + MO_XG);
    const int* TOKE = WSP(const int, WS_TOKE); const int* TOKP = WSP(const int, WS_TOKP);
    for (int it = obid() * 8 + wid; it < 2 * ntok; it += gridDim.x * 8) {
        const int tok = it >> 1, e = TOKE[it], pos = TOKP[it];
        const size_t row = (size_t)(__builtin_amdgcn_readlane(tpre, __builtin_amdgcn_readfirstlane(e)) - ntok / 256) * 256 + pos;
        const u32x4* src = (const u32x4*)(V + (size_t)tok * 1024) + lane; u32x4* dst = (u32x4*)(XG + row * 1024) + lane;
        dst[0] = src[0];
    }
}
PHASE_FN void phase_moe_gemm(const KP& kp, unsigned char* lds, int layer, bool down) {
    const int tid = otid();
    int* pre = (int*)(lds + pg8::STAGE_BYTES);
    int* slotmap = pre + 32;
    const int ntok = layer == 0 ? NTOK : NLAT;
    const unsigned* cnt = WSP(const unsigned, CTL_CNT) + layer * 16;
    if (tid == 0) { unsigned cv16[16];
#pragma unroll
        for (int e = 0; e < 16; ++e) cv16[e] = cnt[e];
        int p = ntok / 256; pre[0] = 0; pre[1] = p;
#pragma unroll
        for (int e = 0; e < 16; ++e) { p += ((int)cv16[e] + 255) >> 8; pre[2 + e] = p; } }
    __syncthreads();
    const int ntiles = pre[17];
    for (int t = tid; t < ntiles; t += 512) { int idx = 0; for (int e = 1; e < 17; ++e) if (pre[e] <= t) idx = e; slotmap[t] = idx == 0 ? 16 : idx - 1; }
    __syncthreads();
    pg8::MoeOrder S{slotmap, ntiles, (int)gridDim.x, obid()};
    if (!down) {
        pg8::Gemm g{WSP(const bf16_t, WS_V), WSP(const bf16_t, WS_BIG + MO_WUP), 0, 0, 512, WSP(const bf16_t, WS_BIG + MO_XG), ntok / 256, 1024, 0};
        pg8::EpiSwi E{WSP(bf16_t, WS_BIG + MO_HID)};
        pg8::gemm_phase<pg8::EpiSwi, pg8::MoeOrder, false, true>((PG8_LAS unsigned char*)lds, g, S, E, nullptr);
    } else {
        pg8::Gemm g{WSP(const bf16_t, WS_BIG + MO_HID), WSP(const bf16_t, WS_BIG + MO_WDN), 0, 0, 256, nullptr, 0x7fffffff, 512, 0};
        pg8::EpiBfG E{WSP(bf16_t, WS_BIG + MO_CON), 1024, 1024, 3, W8_INV};
        pg8::gemm_phase<pg8::EpiBfG, pg8::MoeOrder, false, true>((PG8_LAS unsigned char*)lds, g, S, E, nullptr);
    }
    __syncthreads();
}

PHASE_FN void phase_combine(const KP& kp, int layer) {
    const int lane = otid() & 63, wid = __builtin_amdgcn_readfirstlane(otid() >> 6);
    const int ntok = layer == 0 ? NTOK : NLAT;
    const unsigned* cnt = WSP(const unsigned, CTL_CNT) + layer * 16;
    const float* modv = WSP(const float, WS_MODV) + (size_t)layer * 17 * 6144;
    const float* ng = KIN(6) + (size_t)layer * 4 * 1024 + 3 * 1024;
    const bf16_t* CON = WSP(const bf16_t, WS_BIG + MO_CON);
    const int* TOKE = WSP(const int, WS_TOKE); const int* TOKP = WSP(const int, WS_TOKP); const float* TOKW = WSP(const float, WS_TOKW);
    const int tpre = moe_tile_prefix(cnt, ntok, lane);
    int e1n[2], e2n[2], p1n[2], p2n[2]; float w1n[2], w2n[2];
#define CB_REQ(t0_) do { _Pragma("unroll") for (int u = 0; u < 2; ++u) { const int tok = (t0_) + u; e1n[u] = TOKE[tok * 2]; e2n[u] = TOKE[tok * 2 + 1]; p1n[u] = TOKP[tok * 2]; p2n[u] = TOKP[tok * 2 + 1]; w1n[u] = TOKW[tok * 2]; w2n[u] = TOKW[tok * 2 + 1]; } } while (0)
    if ((obid() * 8 + wid) * 2 < ntok) CB_REQ((obid() * 8 + wid) * 2);
    for (int tok0 = (obid() * 8 + wid) * 2; tok0 < ntok; tok0 += gridDim.x * 16) {
        int e1[2], e2[2], p1[2], p2[2]; float w1[2], w2[2];
#pragma unroll
        for (int u = 0; u < 2; ++u) { e1[u] = e1n[u]; e2[u] = e2n[u]; p1[u] = p1n[u]; p2[u] = p2n[u]; w1[u] = w1n[u]; w2[u] = w2n[u]; }
        if (tok0 + (int)gridDim.x * 16 < ntok) CB_REQ(tok0 + (int)gridDim.x * 16);
        f32x4 f[2][4], hx[2][4]; float* hp[2]; const float* mv[2]; u32x2 rs0[2][4], rs1[2][4], rs2r[2][4], rhx[2][4];
#pragma unroll
        for (int u = 0; u < 2; ++u) { const int tok = tok0 + u;
            const size_t r1 = (size_t)__builtin_amdgcn_readlane(tpre, __builtin_amdgcn_readfirstlane(e1[u])) * 256 + p1[u], r2 = (size_t)__builtin_amdgcn_readlane(tpre, __builtin_amdgcn_readfirstlane(e2[u])) * 256 + p2[u];
            int b, t;
            if (layer == 0) { b = tok / TT; t = tok - b * TT; } else { b = tok >> 11; t = CTXL + (tok & 2047); }
            hp[u] = hrow_wr(kp, b, t); mv[u] = modv + (size_t)(t < CTXL ? 16 : b) * 6144 + 5 * 1024;
#pragma unroll
            for (int i = 0; i < 4; ++i) { const int col = i * 256 + lane * 4;
                rs0[u][i] = *(const u32x2*)(CON + (size_t)tok * 1024 + col); rs1[u][i] = *(const u32x2*)(CON + r1 * 1024 + col); rs2r[u][i] = *(const u32x2*)(CON + r2 * 1024 + col);
                rhx[u][i] = *(const u32x2*)((const bf16_t*)hp[u] + col); } }
        f32x4 g3v[4], gfv[2][4];
#pragma unroll
        for (int i = 0; i < 4; ++i) { const int col = i * 256 + lane * 4; g3v[i] = *(const f32x4*)(ng + col);
#pragma unroll
            for (int u = 0; u < 2; ++u) gfv[u][i] = *(const f32x4*)(mv[u] + col); }
#define CB_UP(r_) ((f32x4){lo2f((r_).x), hi2f((r_).x), lo2f((r_).y), hi2f((r_).y)})
#pragma unroll
        for (int u = 0; u < 2; ++u)
#pragma unroll
            for (int i = 0; i < 4; ++i) { f[u][i] = CB_UP(rs0[u][i]) + CB_UP(rs1[u][i]) * w1[u] + CB_UP(rs2r[u][i]) * w2[u]; hx[u][i] = CB_UP(rhx[u][i]); }
#undef CB_UP
        f32x4 gvv[4], scv[2][4], shv[2][4];
        if (layer == 0) {
            const float* ng1 = KIN(6) + 4 * 1024;
#pragma unroll
            for (int i = 0; i < 4; ++i) { const int col = i * 256 + lane * 4; gvv[i] = *(const f32x4*)(ng1 + col);
#pragma unroll
                for (int u = 0; u < 2; ++u) { const float* mv1 = mv[u] - 5 * 1024 + 17 * 6144; scv[u][i] = *(const f32x4*)(mv1 + 1024 + col); shv[u][i] = *(const f32x4*)(mv1 + col); } }
        }
        float rs2[2];
#pragma unroll
        for (int u = 0; u < 2; ++u) { float ss = 0.f;
#pragma unroll
            for (int i = 0; i < 4; ++i) ss += f[u][i][0] * f[u][i][0] + f[u][i][1] * f[u][i][1] + f[u][i][2] * f[u][i][2] + f[u][i][3] * f[u][i][3];
            ss = wsum(ss); const float rstd = rsqrtf(ss * (1.0f / 1024.0f) + EPS);
            float s2 = 0.f;
#pragma unroll
            for (int i = 0; i < 4; ++i) { const f32x4 hn = hx[u][i] + gfv[u][i] * (f[u][i] * rstd * g3v[i]);
                hx[u][i] = hn; s2 += hn[0] * hn[0] + hn[1] * hn[1] + hn[2] * hn[2] + hn[3] * hn[3]; }
            rs2[u] = 0.f;
            if (layer == 0) { s2 = wsum(s2); rs2[u] = rsqrtf(s2 * (1.0f / 1024.0f) + EPS); } }
#pragma unroll
        for (int u = 0; u < 2; ++u)
#pragma unroll
            for (int i = 0; i < 4; ++i) { const int col = i * 256 + lane * 4;
                if (layer == 0) st4bf((bf16_t*)hp[u] + col, hx[u][i]); else *(f32x4*)(hp[u] + col) = hx[u][i]; }
        if (layer == 0) {
#pragma unroll
            for (int u = 0; u < 2; ++u) { unsigned char* U1 = WSP(unsigned char, WS_V) + (size_t)(tok0 + u) * 2048;
#pragma unroll
                for (int i = 0; i < 4; ++i) st4f8(U1 + i * 256 + lane * 4, hx[u][i] * rs2[u] * gvv[i] * (scv[u][i] + 1.0f) + shv[u][i]); }
        }
    }
}

template <int CH>
__device__ __forceinline__ int scan_t(int dir, int ci, int j) {
    constexpr int NC_CTX = CTXL / CH;
    if (!dir) return ci * CH + j;
    return ci < NC_CTX ? (CTXL - 1 - ci * CH - j) : (TT - 1 - (ci - NC_CTX) * CH - j);
}

constexpr int ML_LQ = 136, ML_LT = 72, ML_VR = 144;
PHASE_FN void mlstm_unit(const KP& kp, unsigned char* lds, int bl, int h, int dir, int vh) {
    const int tid = otid();
    bf16_t* Qs = (bf16_t*)lds;
    bf16_t* Ks = Qs + 64 * ML_LQ;
    bf16_t* KTE = Ks + 64 * ML_LQ;
    bf16_t* VT = KTE + 128 * ML_LT;
    bf16_t* Ps = VT + ML_VR * ML_LT;
    bf16_t* Cb = Ps + 64 * ML_LT;
    float* fs = (float*)(Cb + ML_VR * ML_LQ);
    float* s_rowv = fs;
    float* s_colv = fs + 64;
    float* s_wint = fs + 128;
    float* s_emj = fs + 192;
    float* s_E = fs + 256;
    float* s_den = fs + 320;
    float* s_misc = fs + 384;
    const bf16_t* P = WSP(const bf16_t, WS_BIG + L0_P);
    bf16_t* HOUT = WSP(bf16_t, WS_BIG + (dir ? L0_HB : L0_AO)); const int ldh = dir ? 1024 : 2048;
    const float ibias = KIN(9)[dir * 4 + h], fbias = KIN(10)[dir * 4 + h];
    for (int i = tid; i < ML_VR * ML_LQ; i += 512) Cb[i] = 0;
    for (int i = tid; i < 16 * ML_LT; i += 512) VT[128 * ML_LT + i] = (i < ML_LT) ? (bf16_t)0x3f80 : (bf16_t)0;
    f32x4 Cacc[8], Nacc;
#pragma unroll
    for (int i = 0; i < 8; ++i) Cacc[i] = (f32x4){0.f, 0.f, 0.f, 0.f};
    Nacc = (f32x4){0.f, 0.f, 0.f, 0.f};
    float m_state = 0.f;
    u32x4 pq[2], pk[2], pv[2]; bf16_t pgi = 0, pgf = 0;
#define ML_REQ(ci_) do { _Pragma("unroll") for (int i = 0; i < 2; ++i) { const int p = tid + i * 512, j = p >> 4, c8 = p & 15; \
            const bf16_t* pr = P + ((size_t)bl * TT + scan_t<64>(dir, (ci_), j)) * AB_N; \
            pq[i] = *(const u32x4*)(pr + AB_Q + h * 128 + c8 * 8); pk[i] = *(const u32x4*)(pr + AB_K + h * 128 + c8 * 8); \
            const int jv = tid & 63, cv = (tid >> 6) + i * 8; \
            pv[i] = *(const u32x4*)(P + ((size_t)bl * TT + scan_t<64>(dir, (ci_), jv)) * AB_N + AB_V + h * 256 + vh * 128 + cv * 8); } \
        if (tid < 64) { const bf16_t* pg = P + ((size_t)bl * TT + scan_t<64>(dir, (ci_), tid)) * AB_N; pgi = pg[AB_IG + dir * 4 + h]; pgf = pg[AB_FG + dir * 4 + h]; } } while (0)
    ML_REQ(0);
    lds_barrier();
    for (int ci = 0; ci < TT / 64; ++ci) {
        int tq = tid; asm volatile("" : "+v"(tq));
        const int lane = tq & 63, wid = __builtin_amdgcn_readfirstlane(tq >> 6), fr = lane & 15, fq = lane >> 4;
#pragma unroll
        for (int i = 0; i < 2; ++i) {
            const int p = tq + i * 512, j = p >> 4, c8 = p & 15;
            u32x4 q = pq[i];
            const float qs = 0.08838834764831845f;
            q.x = pack2(lo2f(q.x) * qs, hi2f(q.x) * qs); q.y = pack2(lo2f(q.y) * qs, hi2f(q.y) * qs);
            q.z = pack2(lo2f(q.z) * qs, hi2f(q.z) * qs); q.w = pack2(lo2f(q.w) * qs, hi2f(q.w) * qs);
            *(u32x4*)(Qs + j * ML_LQ + c8 * 8) = q;
            *(u32x4*)(Ks + j * ML_LQ + c8 * 8) = pk[i];
            const u32x4 v = pv[i];
            bf16_t* vt = VT + (((tq >> 6) + i * 8) * 8) * ML_LT + (tq & 63);
            vt[0 * ML_LT] = (bf16_t)(v.x & 0xffff); vt[1 * ML_LT] = (bf16_t)(v.x >> 16); vt[2 * ML_LT] = (bf16_t)(v.y & 0xffff); vt[3 * ML_LT] = (bf16_t)(v.y >> 16);
            vt[4 * ML_LT] = (bf16_t)(v.z & 0xffff); vt[5 * ML_LT] = (bf16_t)(v.z >> 16); vt[6 * ML_LT] = (bf16_t)(v.w & 0xffff); vt[7 * ML_LT] = (bf16_t)(v.w >> 16);
        }
        if (wid == 0) {
            const float ig = bf2f(pgi) + ibias;
            const float lf = logsigmoidf_(bf2f(pgf) + fbias);
            const float b = wscan_add(lf);
            const float u = ig - b; const float pm = wscan_max(u);
            const float mj = fmaxf(b + m_state, b + pm);
            const float b63 = lane63(b), pm63 = lane63(pm);
            const float mnew = fmaxf(b63 + m_state, b63 + pm63);
            s_rowv[lane] = b - mj; s_colv[lane] = u; s_wint[lane] = __expf(b + m_state - mj); s_emj[lane] = __expf(-mj);
            s_E[lane] = __expf(b63 + u - mnew);
            if (lane == 0) { s_misc[0] = mnew; s_misc[1] = __expf(b63 + m_state - mnew); }
        }
        if (ci + 1 < TT / 64) ML_REQ(ci + 1);
        lds_barrier();
        {
            const int jt = wid >> 1;
#pragma unroll
            for (int q2 = 0; q2 < 2; ++q2) {
                const int st = (wid & 1) * 2 + q2;
                f32x4 acc = (f32x4){0.f, 0.f, 0.f, 0.f};
                if (st <= jt) {
                    bf16x8 fa[4], fb[4];
#pragma unroll
                    for (int k = 0; k < 4; ++k) { fa[k] = ldfrag(Qs, ML_LQ, jt * 16, k * 32, fr, fq); fb[k] = ldfrag(Ks, ML_LQ, st * 16, k * 32, fr, fq); }
                    __builtin_amdgcn_sched_barrier(0);
                    f32x4 acc2 = (f32x4){0.f, 0.f, 0.f, 0.f};
                    acc = mma16(fa[0], fb[0], acc); acc2 = mma16(fa[1], fb[1], acc2); acc = mma16(fa[2], fb[2], acc); acc2 = mma16(fa[3], fb[3], acc2);
                    acc = acc + acc2;
                }
                const int s = st * 16 + fr; const float cv = s_colv[s];
#pragma unroll
                for (int r = 0; r < 4; ++r) { const int j = jt * 16 + fq * 4 + r;
                    const float pv2 = (s <= j) ? acc[r] * __expf(s_rowv[j] + cv) : 0.f;
                    Ps[j * ML_LT + s] = f2bf(pv2); }
            }
#pragma unroll
            for (int i = 0; i < 2; ++i) {
                const int s = lane, c8 = wid + i * 8; const float e = s_E[s];
                const u32x4 kv = *(const u32x4*)(Ks + s * ML_LQ + c8 * 8);
                bf16_t* kt = KTE + (c8 * 8) * ML_LT + s;
                kt[0 * ML_LT] = f2bf(lo2f(kv.x) * e); kt[1 * ML_LT] = f2bf(hi2f(kv.x) * e); kt[2 * ML_LT] = f2bf(lo2f(kv.y) * e); kt[3 * ML_LT] = f2bf(hi2f(kv.y) * e);
                kt[4 * ML_LT] = f2bf(lo2f(kv.z) * e); kt[5 * ML_LT] = f2bf(hi2f(kv.z) * e); kt[6 * ML_LT] = f2bf(lo2f(kv.w) * e); kt[7 * ML_LT] = f2bf(hi2f(kv.w) * e);
            }
        }
        lds_barrier();
        f32x4 a1[4], a2[4];
        {
            const int jt = wid >> 1;
            bf16x8 fp[2], fqq[4];
#pragma unroll
            for (int k = 0; k < 2; ++k) fp[k] = ldfrag(Ps, ML_LT, jt * 16, k * 32, fr, fq);
#pragma unroll
            for (int k = 0; k < 4; ++k) fqq[k] = ldfrag(Qs, ML_LQ, jt * 16, k * 32, fr, fq);
            {
                bf16x8 fv[4][2];
#pragma unroll
                for (int q4 = 0; q4 < 4; ++q4)
#pragma unroll
                    for (int k = 0; k < 2; ++k) fv[q4][k] = ldfrag(VT, ML_LT, ((wid & 1) * 4 + q4) * 16, k * 32, fr, fq);
                __builtin_amdgcn_sched_barrier(0);
#pragma unroll
                for (int q4 = 0; q4 < 4; ++q4) a1[q4] = (f32x4){0.f, 0.f, 0.f, 0.f};
#pragma unroll
                for (int k = 0; k < 2; ++k)
#pragma unroll
                    for (int q4 = 0; q4 < 4; ++q4) a1[q4] = mma16(fv[q4][k], fp[k], a1[q4]);
            }
#pragma unroll
            for (int hh = 0; hh < 2; ++hh) {
                bf16x8 fc[2][4];
#pragma unroll
                for (int q2 = 0; q2 < 2; ++q2)
#pragma unroll
                    for (int k = 0; k < 4; ++k) fc[q2][k] = ldfrag(Cb, ML_LQ, ((wid & 1) * 4 + hh * 2 + q2) * 16, k * 32, fr, fq);
                __builtin_amdgcn_sched_barrier(0);
                a2[hh * 2] = (f32x4){0.f, 0.f, 0.f, 0.f}; a2[hh * 2 + 1] = (f32x4){0.f, 0.f, 0.f, 0.f};
#pragma unroll
                for (int k = 0; k < 4; ++k) { a2[hh * 2] = mma16(fc[0][k], fqq[k], a2[hh * 2]); a2[hh * 2 + 1] = mma16(fc[1][k], fqq[k], a2[hh * 2 + 1]); }
            }
            if (wid & 1) {
                f32x4 d1 = (f32x4){0.f, 0.f, 0.f, 0.f}, d2 = (f32x4){0.f, 0.f, 0.f, 0.f};
                bf16x8 fo[2], fn[4];
#pragma unroll
                for (int k = 0; k < 2; ++k) fo[k] = ldfrag(VT, ML_LT, 128, k * 32, fr, fq);
#pragma unroll
                for (int k = 0; k < 4; ++k) fn[k] = ldfrag(Cb, ML_LQ, 128, k * 32, fr, fq);
                __builtin_amdgcn_sched_barrier(0);
                d1 = mma16(fo[0], fp[0], d1); d2 = mma16(fn[0], fqq[0], d2); d1 = mma16(fo[1], fp[1], d1); d2 = mma16(fn[1], fqq[1], d2);
                d2 = mma16(fn[2], fqq[2], d2); d2 = mma16(fn[3], fqq[3], d2);
                if (fq == 0) { const int j = jt * 16 + fr; s_den[j] = fmaxf(fabsf(d1[0] + s_wint[j] * d2[0]), s_emj[j]); }
            }
        }
        lds_barrier();
        {
            const int jt = wid >> 1, j = jt * 16 + fr;
            const float wi = s_wint[j], rden = frcp_(s_den[j]);
            const size_t row = (size_t)bl * TT + scan_t<64>(dir, ci, j);
#pragma unroll
            for (int q4 = 0; q4 < 4; ++q4) { const int v0 = ((wid & 1) * 4 + q4) * 16 + fq * 4;
                st4bf(HOUT + row * ldh + h * 256 + vh * 128 + v0, (a1[q4] + a2[q4] * wi) * rden); }
        }
        {
            const float dec = s_misc[1];
            const bf16x8 bv0 = ldfrag(VT, ML_LT, wid * 16, 0, fr, fq), bv1 = ldfrag(VT, ML_LT, wid * 16, 32, fr, fq);
#pragma unroll
            for (int hh = 0; hh < 2; ++hh) {
                bf16x8 fk[4][2];
#pragma unroll
                for (int q = 0; q < 4; ++q) { fk[q][0] = ldfrag(KTE, ML_LT, (hh * 4 + q) * 16, 0, fr, fq); fk[q][1] = ldfrag(KTE, ML_LT, (hh * 4 + q) * 16, 32, fr, fq); }
                __builtin_amdgcn_sched_barrier(0);
#pragma unroll
                for (int q = 0; q < 4; ++q) Cacc[hh * 4 + q] = Cacc[hh * 4 + q] * dec;
#pragma unroll
                for (int q = 0; q < 4; ++q) Cacc[hh * 4 + q] = mma16(fk[q][0], bv0, Cacc[hh * 4 + q]);
#pragma unroll
                for (int q = 0; q < 4; ++q) Cacc[hh * 4 + q] = mma16(fk[q][1], bv1, Cacc[hh * 4 + q]);
#pragma unroll
                for (int q = 0; q < 4; ++q) st4bf(Cb + (wid * 16 + fr) * ML_LQ + (hh * 4 + q) * 16 + fq * 4, Cacc[hh * 4 + q]);
            }
            Nacc = Nacc * dec;
            Nacc = mma16(ldfrag(KTE, ML_LT, wid * 16, 0, fr, fq), ldfrag(VT, ML_LT, 128, 0, fr, fq), Nacc);
            Nacc = mma16(ldfrag(KTE, ML_LT, wid * 16, 32, fr, fq), ldfrag(VT, ML_LT, 128, 32, fr, fq), Nacc);
            st4bf(Cb + (128 + fr) * ML_LQ + wid * 16 + fq * 4, Nacc);
            m_state = s_misc[0];
        }
        lds_barrier();
    }
#undef ML_REQ
}

constexpr size_t L0_XC = L0_U;
static_assert(L0_XC + (size_t)RG * 1280 * 2 <= BIG_BYTES, "xconv buffer");
PHASE_FN void phase_xconv(const KP& kp) {
    const int lane = otid() & 63, wid = __builtin_amdgcn_readfirstlane(otid() >> 6);
    const bf16_t* P = WSP(const bf16_t, WS_BIG + L0_P); bf16_t* XC = WSP(bf16_t, WS_BIG + L0_XC);
    const float* cw = KIN(12); const float* cb = KIN(13);
    constexpr int RUN = 9;
    for (int run = obid() * 8 + wid; run < RG / RUN; run += gridDim.x * 8) {
        const int r0 = run * RUN;
#pragma unroll
        for (int i = 0; i < 5; ++i) { const int col = i * 256 + lane * 4;
            const f32x4 bias = *(const f32x4*)(cb + col);
            f32x4 w[5]; u32x2 xr[RUN + 4];
#pragma unroll
            for (int q = 0; q < 5; ++q) w[q] = *(const f32x4*)(cw + q * 1280 + col);
#pragma unroll
            for (int q = 0; q < RUN + 4; ++q) { const int rr = r0 - 2 + q; xr[q] = (rr >= 0 && rr < RG) ? *(const u32x2*)(P + (size_t)rr * AB_N + AB_XBC + col) : (u32x2){0u, 0u}; }
#pragma unroll
            for (int k = 0; k < RUN; ++k) {
                const int lr = r0 + k, bl = lr / TT, t = lr - bl * TT, lo = t < CTXL ? 0 : CTXL, hi = t < CTXL ? CTXL : TT;
                f32x4 a = bias;
#pragma unroll
                for (int q = 0; q < 5; ++q) { const int tt = t - 2 + q; const u32x2 xw = xr[k + q];
                    if (tt >= lo && tt < hi) a += w[q] * (f32x4){lo2f(xw.x), hi2f(xw.x), lo2f(xw.y), hi2f(xw.y)}; }
                f32x4 o;
#pragma unroll
                for (int r = 0; r < 4; ++r) o[r] = siluf_(a[r]);
                st4bf(XC + (size_t)lr * 1280 + col, o);
            }
        }
    }
}

constexpr int SS_LT = 72, SS_LX = 136;
PHASE_FN void ssd_unit(const KP& kp, unsigned char* lds, int bl, int dir, int hp) {
    const int tid = otid();
    const int gi = hp >> 2, hh0 = hp * 2;
    bf16_t* Wm = (bf16_t*)lds;
    bf16_t* CM = Wm + 2 * 64 * SS_LT;
    bf16_t* BM = CM + 64 * SS_LT;
    bf16_t* Xn = BM + 64 * SS_LT;
    bf16_t* XT = Xn + 64 * SS_LX;
    bf16_t* BTE = XT + 2 * 64 * SS_LT;
    bf16_t* Sb = BTE + 2 * 64 * SS_LT;
    float* fs = (float*)(Sb + 2 * 64 * SS_LT);
    float* s_b = fs;
    float* s_dt = fs + 128;
    float* s_e = fs + 256;
    float* s_misc = fs + 384;
    const bf16_t* P = WSP(const bf16_t, WS_BIG + L0_P); const bf16_t* XC = WSP(const bf16_t, WS_BIG + L0_XC);
    bf16_t* YOUT = WSP(bf16_t, WS_BIG + (dir ? L0_YB : L0_AO + 2048)); const int ldy = dir ? 1024 : 2048;
    for (int i = tid; i < 2 * 64 * SS_LT; i += 512) Sb[i] = 0;
    f32x4 Sacc[4];
#pragma unroll
    for (int i = 0; i < 4; ++i) Sacc[i] = (f32x4){0.f, 0.f, 0.f, 0.f};
    const float dtb = KIN(14)[dir * 16 + hh0 + ((tid >> 6) & 1)], aexp = __expf(KIN(15)[dir * 16 + hh0 + ((tid >> 6) & 1)]);
    const float dskip = KIN(16)[hh0 + (tid >> 8)];
    u32x4 pr[4]; bf16_t pdt = 0;
#define SS_REQ(ci_) do { _Pragma("unroll") for (int q = 0; q < 4; ++q) { const int p = tid + q * 512, j = p >> 5, c8 = p & 31; \
            const int col = c8 < 16 ? hh0 * 64 + c8 * 8 : (c8 < 24 ? 1024 + gi * 64 + (c8 - 16) * 8 : 1152 + gi * 64 + (c8 - 24) * 8); \
            pr[q] = *(const u32x4*)(XC + ((size_t)bl * TT + scan_t<64>(dir, (ci_), j)) * 1280 + col); } \
        if (tid < 128) pdt = P[((size_t)bl * TT + scan_t<64>(dir, (ci_), tid & 63)) * AB_N + AB_DT + dir * 16 + hh0 + (tid >> 6)]; } while (0)
    SS_REQ(0);
    lds_barrier();
    for (int ci = 0; ci < TT / 64; ++ci) {
        int tq = tid; asm volatile("" : "+v"(tq));
        const int lane = tq & 63, wid = __builtin_amdgcn_readfirstlane(tq >> 6), fr = lane & 15, fq = lane >> 4, hl_w = wid >> 2;
#pragma unroll
        for (int q = 0; q < 4; ++q) { const int p = tq + q * 512, j = p >> 5, c8 = p & 31;
            bf16_t* dst = c8 < 16 ? Xn + j * SS_LX + c8 * 8 : (c8 < 24 ? BM + j * SS_LT + (c8 - 16) * 8 : CM + j * SS_LT + (c8 - 24) * 8);
            *(u32x4*)dst = pr[q]; }
        if (wid < 2) {
            const float dt = softplusf_(bf2f(pdt) + dtb);
            const float b = wscan_add(-dt * aexp);
            const float b63 = lane63(b);
            s_b[wid * 64 + lane] = b; s_dt[wid * 64 + lane] = dt; s_e[wid * 64 + lane] = __expf(b63 - b) * dt;
            if (lane == 0) s_misc[wid] = __expf(b63);
        }
        if (ci + 1 < TT / 64) SS_REQ(ci + 1);
        lds_barrier();
        {
            const int jt = wid >> 1;
#pragma unroll
            for (int q2 = 0; q2 < 2; ++q2) {
                const int st = (wid & 1) * 2 + q2;
                f32x4 acc = (f32x4){0.f, 0.f, 0.f, 0.f};
                if (st <= jt) {
                    const bf16x8 c0 = ldfrag(CM, SS_LT, jt * 16, 0, fr, fq), c1 = ldfrag(CM, SS_LT, jt * 16, 32, fr, fq), b0 = ldfrag(BM, SS_LT, st * 16, 0, fr, fq), b1 = ldfrag(BM, SS_LT, st * 16, 32, fr, fq);
                    __builtin_amdgcn_sched_barrier(0);
                    acc = mma16(c0, b0, acc); acc = mma16(c1, b1, acc);
                }
                const int s = st * 16 + fr;
#pragma unroll
                for (int hl = 0; hl < 2; ++hl) { const float bs = s_b[hl * 64 + s], ds = s_dt[hl * 64 + s];
#pragma unroll
                    for (int r = 0; r < 4; ++r) { const int j = jt * 16 + fq * 4 + r;
                        const float wv = (s <= j) ? acc[r] * __expf(s_b[hl * 64 + j] - bs) * ds : 0.f;
                        Wm[(hl * 64 + j) * SS_LT + s] = f2bf(wv); } }
            }
            {
                const int s = lane, n8 = wid;
                const u32x4 bv = *(const u32x4*)(BM + s * SS_LT + n8 * 8);
#pragma unroll
                for (int hl = 0; hl < 2; ++hl) { const float e = s_e[hl * 64 + s];
                    bf16_t* bt = BTE + (hl * 64 + n8 * 8) * SS_LT + s;
                    bt[0 * SS_LT] = f2bf(lo2f(bv.x) * e); bt[1 * SS_LT] = f2bf(hi2f(bv.x) * e); bt[2 * SS_LT] = f2bf(lo2f(bv.y) * e); bt[3 * SS_LT] = f2bf(hi2f(bv.y) * e);
                    bt[4 * SS_LT] = f2bf(lo2f(bv.z) * e); bt[5 * SS_LT] = f2bf(hi2f(bv.z) * e); bt[6 * SS_LT] = f2bf(lo2f(bv.w) * e); bt[7 * SS_LT] = f2bf(hi2f(bv.w) * e); }
#pragma unroll
                for (int i = 0; i < 2; ++i) { const int c8 = wid + i * 8;
                    const u32x4 xv = *(const u32x4*)(Xn + s * SS_LX + c8 * 8);
                    bf16_t* xt = XT + (c8 * 8) * SS_LT + s;
                    xt[0 * SS_LT] = (bf16_t)(xv.x & 0xffff); xt[1 * SS_LT] = (bf16_t)(xv.x >> 16); xt[2 * SS_LT] = (bf16_t)(xv.y & 0xffff); xt[3 * SS_LT] = (bf16_t)(xv.y >> 16);
                    xt[4 * SS_LT] = (bf16_t)(xv.z & 0xffff); xt[5 * SS_LT] = (bf16_t)(xv.z >> 16); xt[6 * SS_LT] = (bf16_t)(xv.w & 0xffff); xt[7 * SS_LT] = (bf16_t)(xv.w >> 16); }
            }
        }
        lds_barrier();
        {
            const int hl = hl_w, jt = wid & 3, j = jt * 16 + fr;
            const bf16_t* Wh = Wm + hl * 64 * SS_LT; const bf16_t* Xh = XT + hl * 64 * SS_LT; const bf16_t* Sh = Sb + hl * 64 * SS_LT;
            const float eb = __expf(s_b[hl * 64 + j]);
            const size_t row = (size_t)bl * TT + scan_t<64>(dir, ci, j);
            const bf16x8 w0 = ldfrag(Wh, SS_LT, jt * 16, 0, fr, fq), w1 = ldfrag(Wh, SS_LT, jt * 16, 32, fr, fq), m0 = ldfrag(CM, SS_LT, jt * 16, 0, fr, fq), m1 = ldfrag(CM, SS_LT, jt * 16, 32, fr, fq);
#pragma unroll
            for (int hh = 0; hh < 2; ++hh) {
                bf16x8 fx[2][2], fs2[2][2];
#pragma unroll
                for (int q = 0; q < 2; ++q)
#pragma unroll
                    for (int k = 0; k < 2; ++k) { fx[q][k] = ldfrag(Xh, SS_LT, (hh * 2 + q) * 16, k * 32, fr, fq); fs2[q][k] = ldfrag(Sh, SS_LT, (hh * 2 + q) * 16, k * 32, fr, fq); }
                f32x4 dx[2];
                if (!dir) { dx[0] = ld4bf(Xn + j * SS_LX + hl * 64 + (hh * 2) * 16 + fq * 4); dx[1] = ld4bf(Xn + j * SS_LX + hl * 64 + (hh * 2 + 1) * 16 + fq * 4); }
                __builtin_amdgcn_sched_barrier(0);
                f32x4 y1[2], y2[2];
#pragma unroll
                for (int q = 0; q < 2; ++q) { y1[q] = (f32x4){0.f, 0.f, 0.f, 0.f}; y2[q] = (f32x4){0.f, 0.f, 0.f, 0.f}; }
#pragma unroll
                for (int q = 0; q < 2; ++q) { y1[q] = mma16(fx[q][0], w0, y1[q]); y2[q] = mma16(fs2[q][0], m0, y2[q]); }
#pragma unroll
                for (int q = 0; q < 2; ++q) { y1[q] = mma16(fx[q][1], w1, y1[q]); y2[q] = mma16(fs2[q][1], m1, y2[q]); }
#pragma unroll
                for (int q = 0; q < 2; ++q) { f32x4 y = y1[q] + y2[q] * eb;
                    if (!dir) y = y + dx[q] * dskip;
                    st4bf(YOUT + row * ldy + (hh0 + hl) * 64 + (hh * 2 + q) * 16 + fq * 4, y); }
            }
        }
        lds_barrier();
        {
            const int hl = hl_w, pt = wid & 3; const float eb63 = s_misc[hl];
            const bf16_t* Xh = XT + hl * 64 * SS_LT; const bf16_t* Bh = BTE + hl * 64 * SS_LT; bf16_t* Sh = Sb + hl * 64 * SS_LT;
            const bf16x8 x0 = ldfrag(Xh, SS_LT, pt * 16, 0, fr, fq), x1 = ldfrag(Xh, SS_LT, pt * 16, 32, fr, fq);
            bf16x8 fb[4][2];
#pragma unroll
            for (int nt = 0; nt < 4; ++nt) { fb[nt][0] = ldfrag(Bh, SS_LT, nt * 16, 0, fr, fq); fb[nt][1] = ldfrag(Bh, SS_LT, nt * 16, 32, fr, fq); }
            __builtin_amdgcn_sched_barrier(0);
#pragma unroll
            for (int nt = 0; nt < 4; ++nt) Sacc[nt] = Sacc[nt] * eb63;
#pragma unroll
            for (int nt = 0; nt < 4; ++nt) Sacc[nt] = mma16(fb[nt][0], x0, Sacc[nt]);
#pragma unroll
            for (int nt = 0; nt < 4; ++nt) Sacc[nt] = mma16(fb[nt][1], x1, Sacc[nt]);
#pragma unroll
            for (int nt = 0; nt < 4; ++nt) st4bf(Sh + (pt * 16 + fr) * SS_LT + nt * 16 + fq * 4, Sacc[nt]);
        }
        lds_barrier();
    }
#undef SS_REQ
}

__device__ __forceinline__ void phase_scan_ab(const KP& kp, unsigned char* lds) {
    for (int rep = 0; rep < ((PROBE_DUP & 8192) ? 2 : 1); ++rep)
    for (int u = obid(); u < 256; u += gridDim.x) if (u < 128) { const int r = ((u >> 4) << 3) | (u & 7);
        mlstm_unit(kp, lds, r >> 3, (r >> 1) & 3, r & 1, (u >> 3) & 1); __syncthreads(); }
    for (int rep = 0; rep < ((PROBE_DUP & 16384) ? 2 : 1); ++rep)
    for (int u = obid(); u < 256; u += gridDim.x) if (u >= 128) { const int v = u - 128, r = ((v >> 5) << 3) | (v & 7);
        ssd_unit(kp, lds, r >> 2, (r >> 1) & 1, (r & 1) * 4 + ((v >> 3) & 3)); __syncthreads(); }
}

PHASE_FN void phase_fin_ab(const KP& kp) {
    const int lane = otid() & 63, wid = __builtin_amdgcn_readfirstlane(otid() >> 6);
    const bf16_t* P = WSP(const bf16_t, WS_BIG + L0_P);
    bf16_t* AO = WSP(bf16_t, WS_BIG + L0_AO); const bf16_t* HB = WSP(const bf16_t, WS_BIG + L0_HB); const bf16_t* YB = WSP(const bf16_t, WS_BIG + L0_YB);
    const float* mln = KIN(11); const float* sn = KIN(17);
    for (int lr = obid() * 8 + wid; lr < RG; lr += gridDim.x * 8) {
        const bf16_t* pr = P + (size_t)lr * AB_N;
        u32x2 rhf[4], rhb[4], rog[4], ryf[4], ryb[4], rz[4]; f32x4 wv[4], snv[4];
#pragma unroll
        for (int i = 0; i < 4; ++i) { const int col = i * 256 + lane * 4;
            rhf[i] = *(const u32x2*)(AO + (size_t)lr * 2048 + col); rhb[i] = *(const u32x2*)(HB + (size_t)lr * 1024 + col); rog[i] = *(const u32x2*)(pr + AB_OG + col);
            ryf[i] = *(const u32x2*)(AO + (size_t)lr * 2048 + 1024 + col); ryb[i] = *(const u32x2*)(YB + (size_t)lr * 1024 + col); rz[i] = *(const u32x2*)(pr + AB_Z + col);
            wv[i] = *(const f32x4*)(mln + col); snv[i] = *(const f32x4*)(sn + col); }
#define FA_UP(r_) ((f32x4){lo2f((r_).x), hi2f((r_).x), lo2f((r_).y), hi2f((r_).y)})
        f32x4 yz[4], o4[4]; float ss2 = 0.f;
#pragma unroll
        for (int i = 0; i < 4; ++i) {
            const f32x4 hs = FA_UP(rhf[i]) + FA_UP(rhb[i]);
            float ss = hs[0] * hs[0] + hs[1] * hs[1] + hs[2] * hs[2] + hs[3] * hs[3];
            ss = wsum(ss); const float rstd = rsqrtf(ss * (1.0f / 256.0f) + EPS);
            const f32x4 og = FA_UP(rog[i]);
#pragma unroll
            for (int r = 0; r < 4; ++r) o4[i][r] = hs[r] * rstd * wv[i][r] * sigmoidf_(og[r]);
            const f32x4 ys = FA_UP(ryf[i]) + FA_UP(ryb[i]), z = FA_UP(rz[i]);
#pragma unroll
            for (int r = 0; r < 4; ++r) { yz[i][r] = ys[r] * siluf_(z[r]); ss2 += yz[i][r] * yz[i][r]; }
        }
#undef FA_UP
        ss2 = wsum(ss2); const float rstd2 = rsqrtf(ss2 * (1.0f / 1024.0f) + EPS);
#pragma unroll
        for (int i = 0; i < 4; ++i) { const int col = i * 256 + lane * 4;
            st4bf(AO + (size_t)lr * 2048 + col, o4[i]);
            st4bf(AO + (size_t)lr * 2048 + 1024 + col, yz[i] * rstd2 * snv[i]); }
    }
}

PHASE_FN void phase_gemm_in(const KP& kp, unsigned char* lds, int layer, int grp, int rot = 0) {
    const int npad = layer == 0 ? AB_NPAD : CD_NPAD, n = layer == 0 ? AB_N : CD_N;
    int cidx = obid() + rot; if (cidx >= (int)gridDim.x) cidx -= (int)gridDim.x;
    pg8::StaticOrder S; S.init(RG, npad, (int)gridDim.x, cidx);
    if (layer == 0) {
        pg8::Gemm g{grp == 0 ? WSP(const bf16_t, WS_BIG + L0_U) : WSP(const bf16_t, WS_V) + (size_t)grp * RG * 1024, WSP(const bf16_t, WS_WMIX), RG, npad, 1024, nullptr, 0x7fffffff};
        pg8::EpiBfG E{WSP(bf16_t, WS_BIG), n, n, 0x7fffffff, 1.0f};
        pg8::gemm_phase<pg8::EpiBfG, pg8::StaticOrder, false>((PG8_LAS unsigned char*)lds, g, S, E, nullptr);
    } else {
        pg8::Gemm g{WSP(const bf16_t, WS_V) + (size_t)grp * RG * 1024, WSP(const bf16_t, WS_WMIX), RG, npad, 512, nullptr, 0x7fffffff, 1024, 0};
        pg8::EpiBfG E{WSP(bf16_t, WS_BIG), n, n, 0x7fffffff, W8_INV};
        pg8::gemm_phase<pg8::EpiBfG, pg8::StaticOrder, false, true>((PG8_LAS unsigned char*)lds, g, S, E, nullptr);
    }
    __syncthreads();
    if (layer == 0 && grp == 0) {
        const int G = (int)gridDim.x, units = (RG / 256) * (npad / 256), extra = units % G;
        if (obid() >= extra) phase_u(kp, 0, 1, obid() - extra, G - extra, true);
        __syncthreads();
    }
}
PHASE_FN void phase_gemm_out_ab(const KP& kp, unsigned char* lds, int grp) {
    pg8::Gemm g{WSP(const bf16_t, WS_BIG + L0_AO), WSP(const bf16_t, WS_WMIX + WM_AB_OUT), RG, 1024, 2048, nullptr, 0x7fffffff};
    pg8::StaticOrder S; S.init(RG, 1024, (int)gridDim.x, obid());
    pg8::EpiBfG E{WSP(bf16_t, WS_BIG + (grp == 0 ? L0_HB : L0_U)), 1024, 1024, 0x7fffffff, 1.0f};
    pg8::gemm_phase<pg8::EpiBfG, pg8::StaticOrder, false>((PG8_LAS unsigned char*)lds, g, S, E, nullptr);
    __syncthreads();
    if (grp == 1) {
        const int G = (int)gridDim.x, units = (RG / 256) * 4, two = units > G ? (units - G < G ? units - G : G) : 0;
        const int nb = G - two > 0 ? G - two : G, bid = G - two > 0 ? obid() - two : obid();
        if (bid >= 0) phase_conv_moe(kp, lds, 0, bid, nb);
        __syncthreads();
    }
}

PHASE_FN void phase_prep_cd(const KP& kp) {
    const int lane = otid() & 63, wid = __builtin_amdgcn_readfirstlane(otid() >> 6);
    bf16_t* P = WSP(bf16_t, WS_BIG + L1_P);
    bf16_t* SG = WSP(bf16_t, WS_SG);
    const float* qn = KIN(20); const float* kvn = KIN(22); const float* mu = KIN(24);
    for (int lr = obid() * 8 + wid; lr < RG; lr += gridDim.x * 8) {
        const int bl = lr / TT, t = lr - bl * TT;
        bf16_t* pr = P + (size_t)lr * CD_N;
        const int lo = t < CTXL ? 0 : CTXL, hi = t < CTXL ? CTXL : TT, c4 = lane * 4, c2 = lane * 2, s = t - CTXL;
        const bool lat = t >= CTXL;
        const u32x2 rkv = *(const u32x2*)(pr + CD_M1 + c4);
        const f32x4 kvnv = *(const f32x4*)(kvn + c4);
        const u32x2 rwl = *(const u32x2*)(pr + CD_WL + c4);
        const u32x2 rwp = t > lo ? *(const u32x2*)(pr - CD_N + CD_WL + c4) : (u32x2){0u, 0u};
        const u32x2 rwn = t < hi - 1 ? *(const u32x2*)(pr + CD_N + CD_WL + c4) : (u32x2){0u, 0u};
        const f32x4 muw = *(const f32x4*)(mu + CD_WL - CD_RW0 + c4);
        unsigned rq[3] = {0u, 0u, 0u}, rg = 0u, rgp = 0u, rgn = 0u; float qa[3] = {0.f, 0.f, 0.f}, qb[3] = {0.f, 0.f, 0.f}, m0 = 0.f, m1 = 0.f; bf16_t kra = 0, krb = 0;
        if (lat) {
#pragma unroll
            for (int i = 0; i < 3; ++i) { const int c = i * 128 + c2; rq[i] = *(const unsigned*)(pr + CD_M0 + c); qa[i] = qn[c]; qb[i] = qn[c + 1]; }
            if (lane < 16) { kra = pr[CD_KR + lane]; krb = pr[CD_KR + 16 + lane]; }
            rg = *(const unsigned*)(pr + CD_GL + c2);
            rgp = s > 0 ? *(const unsigned*)(pr - CD_N + CD_GL + c2) : 0u;
            rgn = s < SEQ - 1 ? *(const unsigned*)(pr + CD_N + CD_GL + c2) : 0u;
            m0 = mu[CD_GL - CD_RW0 + c2]; m1 = mu[CD_GL - CD_RW0 + c2 + 1];
        }
#define PC_UP(r_) ((f32x4){lo2f((r_).x), hi2f((r_).x), lo2f((r_).y), hi2f((r_).y)})
        {
            const f32x4 x = PC_UP(rkv);
            float ss = x[0] * x[0] + x[1] * x[1] + x[2] * x[2] + x[3] * x[3]; ss = wsum(ss);
            const float rstd = rsqrtf(ss * (1.0f / 256.0f) + EPS);
            st4bf(pr + CD_M1 + c4, x * rstd * kvnv);
        }
        {
            const f32x4 x = PC_UP(rwl), xp = PC_UP(rwp), xn = PC_UP(rwn);
            f32x4 l = x + muw * ((xp + xn) * 0.5f - x);
            if (c4 < 128) {
#pragma unroll
                for (int q = 0; q < 4; ++q) l[q] = tanhf_(l[q]); }
            st4bf(WSP(bf16_t, WS_BIG + L1_TWAL) + (size_t)lr * 256 + c4, l);
        }
#undef PC_UP
        if (lat) {
            float x0[3], x1[3]; float ss = 0.f;
#pragma unroll
            for (int i = 0; i < 3; ++i) { x0[i] = lo2f(rq[i]); x1[i] = hi2f(rq[i]); ss += x0[i] * x0[i] + x1[i] * x1[i]; }
            ss = wsum(ss); const float rstd = rsqrtf(ss * (1.0f / 384.0f) + EPS);
#pragma unroll
            for (int i = 0; i < 3; ++i) { const int c = i * 128 + c2; *(unsigned*)(pr + CD_M0 + c) = pack2(x0[i] * rstd * qa[i], x1[i] * rstd * qb[i]); }
            if (lane < 16) {
                const float pos = (lane < 8) ? (float)(s >> 6) : (float)(s & 63);
                const float inv = __expf(-(float)(lane & 7) * (9.210340371976184f / 8.0f));
                const float ang_ = pos * inv, sn = __sinf(ang_), cs = __cosf(ang_);
                const float a = bf2f(kra), b2 = bf2f(krb);
                pr[CD_KR + lane] = f2bf(a * cs - b2 * sn); pr[CD_KR + 16 + lane] = f2bf(a * sn + b2 * cs);
            }
            {
                const float g0 = lo2f(rg) + m0 * (0.5f * (lo2f(rgp) + lo2f(rgn)) - lo2f(rg));
                const float g1 = hi2f(rg) + m1 * (0.5f * (hi2f(rgp) + hi2f(rgn)) - hi2f(rg));
                *(unsigned*)(SG + ((size_t)bl * SEQ + s) * 128 + c2) = pack2(sigmoidf_(g0), sigmoidf_(g1));
            }
        }
    }
}

PHASE_FN void phase_upproj(const KP& kp, unsigned char* lds) {
    const bf16_t* P = WSP(const bf16_t, WS_BIG + L1_P);
    {
        pg8::Gemm g{P + CD_M0, WSP(const bf16_t, WS_WMIX + WM_UQ), RGL, 768, 384, nullptr, 0x7fffffff, CD_N, 1};
        pg8::StaticOrder S; S.init(RGL, 768, (int)gridDim.x, obid());
        pg8::EpiBfG E{WSP(bf16_t, WS_BIG + L1_Q), 768, 768, 0x7fffffff, 1.0f};
        pg8::gemm_phase<pg8::EpiBfG, pg8::StaticOrder, false>((PG8_LAS unsigned char*)lds, g, S, E, nullptr);
    }
    __syncthreads();
    {
        pg8::Gemm g{P + CD_M1, WSP(const bf16_t, WS_WMIX + WM_UKV), RG, 1024, 256, nullptr, 0x7fffffff, CD_N, 0};
        pg8::StaticOrder S; S.init(RG, 1024, (int)gridDim.x, (obid() + 64) % (int)gridDim.x);
        pg8::EpiBfG E{WSP(bf16_t, WS_BIG + L1_KV), 1024, 1024, 0x7fffffff, 1.0f};
        pg8::gemm_phase<pg8::EpiBfG, pg8::StaticOrder, false>((PG8_LAS unsigned char*)lds, g, S, E, nullptr);
    }
    __syncthreads();
}

constexpr int AT_LQ = 104, AT_LV = 80;
typedef short v4s16 __attribute__((ext_vector_type(4)));
PHASE_FN void attn_unit(const KP& kp, unsigned char* lds, int bl, int head, int qb) {
    const int tid = otid(), lane = tid & 63, wid = __builtin_amdgcn_readfirstlane(tid >> 6), fr = lane & 15, fq = lane >> 4;
    bf16_t* Qs = (bf16_t*)lds;
    bf16_t* Kt = Qs + 256 * AT_LQ;
    bf16_t* Vt = Kt + 2 * 64 * AT_LQ;
    const bf16_t* P = WSP(const bf16_t, WS_BIG + L1_P);
    const bf16_t* Q = WSP(const bf16_t, WS_BIG + L1_Q);
    const bf16_t* KV = WSP(const bf16_t, WS_BIG + L1_KV);
    bf16_t* AOUT = WSP(bf16_t, WS_BIG + L1_AOUT);
    const float SC = 0.10206207261596577f;
    {
        u32x4 qreg[6];
#pragma unroll
        for (int i = 0; i < 6; ++i) { const int p = tid + i * 512, r = p / 12, c = p % 12;
            qreg[i] = *(const u32x4*)(Q + ((size_t)bl * SEQ + qb * 256 + r) * 768 + head * 96 + c * 8); }
#pragma unroll
        for (int i = 0; i < 6; ++i) { const int p = tid + i * 512, r = p / 12, c = p % 12; *(u32x4*)(Qs + r * AT_LQ + c * 8) = qreg[i]; }
    }
    lds_barrier();
#pragma unroll
    for (int i = 0; i < 8; ++i) { const int p = tid + i * 512, r = p >> 4, f = p & 15, s = qb * 256 + r;
        const float pos = (f < 8) ? (float)(s >> 6) : (float)(s & 63);
        const float inv = __expf(-(float)(f & 7) * (9.210340371976184f / 8.0f));
        const float ang_ = pos * inv, sn = __sinf(ang_), cs = __cosf(ang_);
        const float a = bf2f(Qs[r * AT_LQ + 64 + f]), b2 = bf2f(Qs[r * AT_LQ + 80 + f]);
        Qs[r * AT_LQ + 64 + f] = f2bf(a * cs - b2 * sn); Qs[r * AT_LQ + 80 + f] = f2bf(a * sn + b2 * cs); }
    lds_barrier();
    bf16x8 qf[2][3];
#pragma unroll
    for (int rt = 0; rt < 2; ++rt)
#pragma unroll
        for (int k = 0; k < 3; ++k) qf[rt][k] = ldfrag(Qs, AT_LQ, wid * 32 + rt * 16, k * 32, fr, fq);
    f32x4 ot[2][4];
#pragma unroll
    for (int rt = 0; rt < 2; ++rt)
#pragma unroll
        for (int i = 0; i < 4; ++i) ot[rt][i] = (f32x4){0.f, 0.f, 0.f, 0.f};
    float mrow[2] = {-1e30f, -1e30f}, lsum[2] = {0.f, 0.f};
    u32x4 pk0[2], pk1[2], pvv[2];
    const int kkey0 = tid / 12, kc0 = tid % 12, kkey1 = (tid + 512) / 12, kc1 = (tid + 512) % 12, vkey = tid >> 3, vc8 = tid & 7;
#define AT_REQ(kt_) do { _Pragma("unroll") for (int h_ = 0; h_ < 2; ++h_) { const size_t rb_ = (size_t)bl * TT + ((kt_) * 2 + h_) * 64; \
        pk0[h_] = kc0 < 8 ? *(const u32x4*)(KV + (rb_ + kkey0) * 1024 + head * 128 + kc0 * 8) : *(const u32x4*)(P + (rb_ + kkey0) * CD_N + CD_KR + (kc0 - 8) * 8); \
        if (tid < 256) pk1[h_] = kc1 < 8 ? *(const u32x4*)(KV + (rb_ + kkey1) * 1024 + head * 128 + kc1 * 8) : *(const u32x4*)(P + (rb_ + kkey1) * CD_N + CD_KR + (kc1 - 8) * 8); \
        pvv[h_] = *(const u32x4*)(KV + (rb_ + vkey) * 1024 + head * 128 + 64 + vc8 * 8); } } while (0)
    AT_REQ(0);
    const float SC2 = SC * 1.4426950408889634f;
    for (int kt = 0; kt < TT / 128; ++kt) {
        lds_barrier();
#pragma unroll
        for (int h_ = 0; h_ < 2; ++h_) {
            *(u32x4*)(Kt + (h_ * 64 + kkey0) * AT_LQ + kc0 * 8) = pk0[h_];
            if (tid < 256) *(u32x4*)(Kt + (h_ * 64 + kkey1) * AT_LQ + kc1 * 8) = pk1[h_];
            *(u32x4*)(Vt + (h_ * 64 + vkey) * AT_LV + vc8 * 8) = pvv[h_];
        }
        if (kt + 1 < TT / 128) AT_REQ(kt + 1);
        lds_barrier();
        {
        bf16x8 kf[3][4]; f32x4 sta[2][4], stb[2][4]; u32x2 vlo[2][4], vhi[2][4];
        union { bf16x8 v; unsigned u[4]; } pb[2][2];
#define AT_LOADK(hs_) do { const bf16_t* Kth = Kt + (hs_) * 64 * AT_LQ; \
            _Pragma("unroll") for (int k = 0; k < 3; ++k) _Pragma("unroll") for (int kk = 0; kk < 4; ++kk) kf[k][kk] = ldfrag(Kth, AT_LQ, kk * 16, k * 32, fr, fq); } while (0)
#define AT_LOADV(hs_) do { const bf16_t* Vth = Vt + (hs_) * 64 * AT_LV; \
            _Pragma("unroll") for (int k2 = 0; k2 < 2; ++k2) _Pragma("unroll") for (int dvt = 0; dvt < 4; ++dvt) { \
                  \
                const bf16_t* vp = Vth + (k2 * 32 + fq * 4 + (fr >> 2)) * AT_LV + dvt * 16 + (fr & 3) * 4; \
                const v4s16 t0_ = __builtin_amdgcn_ds_read_tr16_b64_v4i16((__attribute__((address_space(3))) v4s16*)vp); \
                const v4s16 t1_ = __builtin_amdgcn_ds_read_tr16_b64_v4i16((__attribute__((address_space(3))) v4s16*)(vp + 16 * AT_LV)); \
                vlo[k2][dvt] = __builtin_bit_cast(u32x2, t0_); vhi[k2][dvt] = __builtin_bit_cast(u32x2, t1_); } } while (0)
#define AT_QK(st) do { _Pragma("unroll") for (int rt = 0; rt < 2; ++rt) _Pragma("unroll") for (int kk = 0; kk < 4; ++kk) st[rt][kk] = (f32x4){0.f, 0.f, 0.f, 0.f}; \
            _Pragma("unroll") for (int k = 0; k < 3; ++k) _Pragma("unroll") for (int kk = 0; kk < 4; ++kk) _Pragma("unroll") for (int rt = 0; rt < 2; ++rt) st[rt][kk] = mma16(kf[k][kk], qf[rt][k], st[rt][kk]); } while (0)
#define AT_SM(st) do { _Pragma("unroll") for (int rt = 0; rt < 2; ++rt) { \
            float mx = -1e30f; \
            _Pragma("unroll") for (int kk = 0; kk < 4; ++kk) mx = fmaxf(mx, fmaxf(fmaxf(st[rt][kk][0], st[rt][kk][1]), fmaxf(st[rt][kk][2], st[rt][kk][3]))); \
            mx = xmax_rows(mx); \
            const float mold = mrow[rt], mnew = fmaxf(mold, mx), mb = mnew * SC2; \
            float ls = 0.f; \
            _Pragma("unroll") for (int kk = 0; kk < 4; ++kk) _Pragma("unroll") for (int r = 0; r < 4; ++r) { const float pv = __builtin_amdgcn_exp2f(st[rt][kk][r] * SC2 - mb); st[rt][kk][r] = pv; ls += pv; } \
            _Pragma("unroll") for (int k2 = 0; k2 < 2; ++k2) { \
                pb[rt][k2].u[0] = pack2(st[rt][2 * k2][0], st[rt][2 * k2][1]); pb[rt][k2].u[1] = pack2(st[rt][2 * k2][2], st[rt][2 * k2][3]); \
                pb[rt][k2].u[2] = pack2(st[rt][2 * k2 + 1][0], st[rt][2 * k2 + 1][1]); pb[rt][k2].u[3] = pack2(st[rt][2 * k2 + 1][2], st[rt][2 * k2 + 1][3]); } \
            if (__builtin_amdgcn_ballot_w64(mnew > mold) != 0ull) {         \
                const float alpha = __builtin_amdgcn_exp2f((mold - mnew) * SC2); \
                lsum[rt] *= alpha; \
                _Pragma("unroll") for (int i = 0; i < 4; ++i) ot[rt][i] = ot[rt][i] * alpha; } \
            mrow[rt] = mnew; lsum[rt] += ls; } } while (0)
#define AT_PV() do { _Pragma("unroll") for (int k2 = 0; k2 < 2; ++k2) _Pragma("unroll") for (int dvt = 0; dvt < 4; ++dvt) { union { bf16x8 v; u32x2 h[2]; } va; va.h[0] = vlo[k2][dvt]; va.h[1] = vhi[k2][dvt]; \
            _Pragma("unroll") for (int rt = 0; rt < 2; ++rt) ot[rt][dvt] = mma16(va.v, pb[rt][k2].v, ot[rt][dvt]); } } while (0)
        const int h0 = wid < 4 ? 0 : 1, h1 = h0 ^ 1;
        AT_LOADK(h0);
        __builtin_amdgcn_sched_barrier(0);
        AT_QK(sta);
        AT_LOADK(h1);
        AT_QK(stb);
        AT_LOADV(h0);
        __builtin_amdgcn_sched_barrier(0);
        AT_SM(sta);
        AT_PV();
        AT_LOADV(h1);
        __builtin_amdgcn_sched_barrier(0);
        AT_SM(stb);
        AT_PV();
#undef AT_LOADK
#undef AT_LOADV
#undef AT_QK
#undef AT_SM
#undef AT_PV
        }
    }
#undef AT_REQ
#pragma unroll
    for (int rt = 0; rt < 2; ++rt) {
        const float ls = xsum_rows(lsum[rt]);
        const float rl = frcp_(ls);
        const size_t orow = (size_t)bl * SEQ + qb * 256 + wid * 32 + rt * 16 + fr;
#pragma unroll
        for (int dvt = 0; dvt < 4; ++dvt) st4bf(AOUT + orow * 1536 + head * 64 + dvt * 16 + fq * 4, ot[rt][dvt] * rl);
    }
}

constexpr int RW_LR = 200, RW_LP = 72;
struct TrueT { static constexpr bool value = true; }; struct FalseT { static constexpr bool value = false; };
PHASE_FN void rwkv_unit(const KP& kp, unsigned char* lds, int bl, int h, int dir) {
    const int tid = otid();
    constexpr int NC = TT / 32;
    bf16_t* RAW = (bf16_t*)lds;
    bf16_t* TWb = RAW + 34 * RW_LR;
    bf16_t* ALb = TWb + 32 * RW_LP;
    float* WLf = (float*)(ALb + 32 * RW_LP);
    float* ALf = WLf + 32 * 64;
    bf16_t* BK = (bf16_t*)WLf;
    float* WT = ALf + 32 * 64;
    bf16_t* AR = (bf16_t*)(WT + 8 * 64);
    float* AABT = (float*)(AR + 64 * RW_LP);
    bf16_t* ARB0 = (bf16_t*)(AABT + 32 * 36);
    bf16_t* AAK = ARB0 + 2 * 32 * 40;
    bf16_t* ARK = AAK + 32 * 40;
    float* RHS = (float*)(ARK + 32 * 40);
    float* YB = RHS + 32 * 64;
    bf16_t* ZVT0 = (bf16_t*)(YB + 32 * 64);
    bf16_t* BKh0 = ZVT0 + 2 * 64 * RW_LP;
    bf16_t* Sb = BKh0 + 2 * 64 * RW_LP;
    float* PL0 = (float*)(Sb + 64 * RW_LP);
    float* CV = PL0 + 2 * 64;
    bf16_t* A21b = (bf16_t*)(CV + 8 * 64);
    bf16_t* TI = A21b + 16 * 40;
    bf16_t* RHSb = TI + 2 * 16 * 40;
    bf16_t* XB = RHSb + 64 * 40;
    static_assert((34 * RW_LR + 2 * 32 * RW_LP) * 2 + (2 * 32 * 64 + 8 * 64) * 4 + 64 * RW_LP * 2 + 32 * 36 * 4 + 4 * 32 * 40 * 2 + 2 * 32 * 64 * 4
                  + 5 * 64 * RW_LP * 2 + (2 * 64 + 8 * 64) * 4 + (16 * 40 + 2 * 16 * 40 + 2 * 64 * 40) * 2 <= LDS_BYTES - 16, "rwkv LDS");
    const bf16_t* P = WSP(const bf16_t, WS_BIG + L1_P); const bf16_t* TWAL = WSP(const bf16_t, WS_BIG + L1_TWAL);
    bf16_t* OUT = WSP(bf16_t, WS_BIG + (dir ? L1_OB : L1_OF));
    float* BSC = WSP(float, WS_BSC) + (size_t)dir * RGL * 16;
    const float* mu = KIN(24);
    bf16x8 wfr[2][2];
    {
        const int wv = tid >> 6, fr0 = tid & 15, fq0 = (tid & 63) >> 4; const float* wsrc = (wv >> 2) ? KIN(28) : KIN(26);
#pragma unroll
        for (int q2 = 0; q2 < 2; ++q2)
#pragma unroll
            for (int k = 0; k < 2; ++k) { const int n = ((wv & 1) * 2 + q2) * 16 + fr0; union { bf16x8 v; unsigned u[4]; } tw;
                float wt8[8];
#pragma unroll
                for (int e = 0; e < 8; ++e) wt8[e] = wsrc[((size_t)dir * 64 + k * 32 + fq0 * 8 + e) * 1024 + h * 64 + n];
#pragma unroll
                for (int e = 0; e < 4; ++e) tw.u[e] = pack2(wt8[2 * e], wt8[2 * e + 1]);
                wfr[q2][k] = tw.v; }
    }
    for (int i = tid; i < 2 * 16 * 40; i += 512) TI[i] = 0;
    for (int i = tid; i < 64 * 40; i += 512) XB[i] = 0;
    for (int i = tid; i < 64 * RW_LP; i += 512) Sb[i] = 0;
    for (int i = tid; i < 16 * 40; i += 512) A21b[i] = 0;
    for (int i = tid; i < 2 * 64 * RW_LP; i += 512) ZVT0[i] = 0;
    if (tid < 64) { const int n = tid;
        const float c0_ = KIN(25)[dir * 1024 + h * 64 + n], c1_ = KIN(27)[dir * 1024 + h * 64 + n], c2_ = KIN(30)[h * 64 + n], c3_ = KIN(31)[h * 64 + n], c4_ = KIN(32)[h * 64 + n],
                    c5_ = mu[h * 64 + n], c6_ = mu[1024 + h * 64 + n], c7_ = mu[2048 + h * 64 + n];
        CV[0 * 64 + n] = c0_; CV[1 * 64 + n] = c1_; CV[2 * 64 + n] = c2_; CV[3 * 64 + n] = c3_; CV[4 * 64 + n] = c4_; CV[5 * 64 + n] = c5_; CV[6 * 64 + n] = c6_; CV[7 * 64 + n] = c7_; }
    f32x4 Sacc[2];
    Sacc[0] = (f32x4){0.f, 0.f, 0.f, 0.f}; Sacc[1] = (f32x4){0.f, 0.f, 0.f, 0.f};
    u32x4 pf[3];
#define RW_PREFETCH(cn, tix) do { const int t0n_ = dir ? scan_t<32>(1, (cn), 31) : (cn) * 32; const int lo_ = t0n_ < CTXL ? 0 : CTXL, hi_ = t0n_ < CTXL ? CTXL : TT; \
        _Pragma("unroll") for (int q = 0; q < 2; ++q) { const int p = (tix) + q * 512; pf[q] = (u32x4){0u, 0u, 0u, 0u}; \
            if (p < 34 * 24) { const int rr = p / 24, c = p % 24, t = t0n_ - 1 + rr; \
                if (t >= lo_ && t < hi_) { const int seg = c >> 3, c8 = c & 7; \
                    const int col = (seg == 0 ? CD_R : seg == 1 ? CD_K : CD_V) + h * 64; \
                    pf[q] = *(const u32x4*)(P + ((size_t)bl * TT + t) * CD_N + col + c8 * 8); } } } \
        { const int i_ = (tix) >> 4, c16 = (tix) & 15; \
          pf[2] = *(const u32x4*)(TWAL + ((size_t)bl * TT + t0n_ + i_) * 256 + (c16 >> 3) * 128 + dir * 64 + (c16 & 7) * 8); } } while (0)
    RW_PREFETCH(0, tid);
    lds_barrier();
    auto step = [&](auto doP_t, auto doD_t, const int ci) __attribute__((always_inline)) {
        constexpr bool doP = decltype(doP_t)::value, doD = decltype(doD_t)::value;
        int tq = tid; asm volatile("" : "+v"(tq));
        const int lane = tq & 63, wid = __builtin_amdgcn_readfirstlane(tq >> 6), fr = lane & 15, fq = lane >> 4, pi = tq >> 4, n4 = (tq & 15) * 4;
        const int cp = ci + 1, pc = ci & 1, pn = cp & 1;
        const int t0 = dir ? scan_t<32>(1, ci, 31) : ci * 32, t0p = dir ? scan_t<32>(1, cp, 31) : cp * 32;
        bf16_t* ZVc = ZVT0 + pc * 64 * RW_LP; bf16_t* ZVn = ZVT0 + pn * 64 * RW_LP;
        const bf16_t* BKhc = BKh0 + pc * 64 * RW_LP; bf16_t* BKhn = BKh0 + pn * 64 * RW_LP;
        const bf16_t* ARBc = ARB0 + pc * 32 * 40; bf16_t* ARBn = ARB0 + pn * 32 * 40;
        const float* PLc = PL0 + pc * 64; float* PLn = PL0 + pn * 64;
        auto P1 = [&]() __attribute__((always_inline)) {
        if constexpr (doP) {
#pragma unroll
            for (int q = 0; q < 2; ++q) { const int p = tq + q * 512; if (p < 34 * 24) *(u32x4*)(RAW + (p / 24) * RW_LR + (p % 24) * 8) = pf[q]; }
            { const int i_ = tq >> 4, c16 = tq & 15; *(u32x4*)(((c16 >> 3) ? ALb : TWb) + i_ * RW_LP + (c16 & 7) * 8) = pf[2]; }
        }
        if constexpr (doP) { if (cp + 1 < NC) RW_PREFETCH(cp + 1, tq); }
        };
        auto D1 = [&]() __attribute__((always_inline)) {
        if constexpr (doD) {
            if (wid > 0) for (int rep_ = 0; rep_ < ((RWP & 32) ? 2 : 1); ++rep_) {
#pragma unroll
                for (int q3 = 0; q3 < 3; ++q3) { const int tl = (wid - 1) + 7 * q3;
                    if (tl < 16) {
                        const int which = tl >> 3, tt = (tl >> 2) & 1, vt = tl & 3;
                        const bf16_t* Ak = which ? ARK : AAK; float* Od = which ? YB : RHS;
                        f32x4 acc = (f32x4){0.f, 0.f, 0.f, 0.f};
#pragma unroll
                        for (int k = 0; k < 2; ++k) acc = mma16(ldfrag(AR, RW_LP, which * 32 + tt * 16, k * 32, fr, fq), ldfrag(Sb, RW_LP, vt * 16, k * 32, fr, fq), acc);
                        acc = mma16(ldfrag(Ak, 40, tt * 16, 0, fr, fq), ldfrag(ZVc, RW_LP, vt * 16, 32, fr, fq), acc);
#pragma unroll
                        for (int rr = 0; rr < 4; ++rr) Od[(tt * 16 + fq * 4 + rr) * 64 + vt * 16 + fr] = acc[rr];
                        if (!which) st4bf(RHSb + (vt * 16 + fr) * 40 + tt * 16 + fq * 4, acc);
                    } }
            } else for (int rep_ = 0; rep_ < ((RWP & 1) ? 2 : 1); ++rep_) {
                const float* AB = AABT + ((lane >> 4) & 1) * (16 * 36 + 16);
                float z[16]; f32x4 ca0, ca1, ca2, ca3, cb0, cb1, cb2, cb3;
#pragma unroll
                for (int t = 0; t < 16; ++t) z[t] = (t == (lane & 15)) ? 1.0f : 0.f;
                ca0 = *(const f32x4*)(AB + 0 * 36 + 0); ca1 = *(const f32x4*)(AB + 0 * 36 + 4); ca2 = *(const f32x4*)(AB + 0 * 36 + 8); ca3 = *(const f32x4*)(AB + 0 * 36 + 12);
                cb0 = *(const f32x4*)(AB + 1 * 36 + 0); cb1 = *(const f32x4*)(AB + 1 * 36 + 4); cb2 = *(const f32x4*)(AB + 1 * 36 + 8); cb3 = *(const f32x4*)(AB + 1 * 36 + 12);
                { const float zs = z[0]; z[1] = __builtin_fmaf(ca0[1], zs, z[1]); z[2] = __builtin_fmaf(ca0[2], zs, z[2]); z[3] = __builtin_fmaf(ca0[3], zs, z[3]); z[4] = __builtin_fmaf(ca1[0], zs, z[4]); z[5] = __builtin_fmaf(ca1[1], zs, z[5]); z[6] = __builtin_fmaf(ca1[2], zs, z[6]); z[7] = __builtin_fmaf(ca1[3], zs, z[7]); z[8] = __builtin_fmaf(ca2[0], zs, z[8]); z[9] = __builtin_fmaf(ca2[1], zs, z[9]); z[10] = __builtin_fmaf(ca2[2], zs, z[10]); z[11] = __builtin_fmaf(ca2[3], zs, z[11]); z[12] = __builtin_fmaf(ca3[0], zs, z[12]); z[13] = __builtin_fmaf(ca3[1], zs, z[13]); z[14] = __builtin_fmaf(ca3[2], zs, z[14]); z[15] = __builtin_fmaf(ca3[3], zs, z[15]); }
                asm volatile("" : "+v"(z[1]) );
                ca0 = *(const f32x4*)(AB + 2 * 36 + 0); ca1 = *(const f32x4*)(AB + 2 * 36 + 4); ca2 = *(const f32x4*)(AB + 2 * 36 + 8); ca3 = *(const f32x4*)(AB + 2 * 36 + 12);
                { const float zs = z[1]; z[2] = __builtin_fmaf(cb0[2], zs, z[2]); z[3] = __builtin_fmaf(cb0[3], zs, z[3]); z[4] = __builtin_fmaf(cb1[0], zs, z[4]); z[5] = __builtin_fmaf(cb1[1], zs, z[5]); z[6] = __builtin_fmaf(cb1[2], zs, z[6]); z[7] = __builtin_fmaf(cb1[3], zs, z[7]); z[8] = __builtin_fmaf(cb2[0], zs, z[8]); z[9] = __builtin_fmaf(cb2[1], zs, z[9]); z[10] = __builtin_fmaf(cb2[2], zs, z[10]); z[11] = __builtin_fmaf(cb2[3], zs, z[11]); z[12] = __builtin_fmaf(cb3[0], zs, z[12]); z[13] = __builtin_fmaf(cb3[1], zs, z[13]); z[14] = __builtin_fmaf(cb3[2], zs, z[14]); z[15] = __builtin_fmaf(cb3[3], zs, z[15]); }
                asm volatile("" : "+v"(z[2]) );
                cb1 = *(const f32x4*)(AB + 3 * 36 + 4); cb2 = *(const f32x4*)(AB + 3 * 36 + 8); cb3 = *(const f32x4*)(AB + 3 * 36 + 12);
                { const float zs = z[2]; z[3] = __builtin_fmaf(ca0[3], zs, z[3]); z[4] = __builtin_fmaf(ca1[0], zs, z[4]); z[5] = __builtin_fmaf(ca1[1], zs, z[5]); z[6] = __builtin_fmaf(ca1[2], zs, z[6]); z[7] = __builtin_fmaf(ca1[3], zs, z[7]); z[8] = __builtin_fmaf(ca2[0], zs, z[8]); z[9] = __builtin_fmaf(ca2[1], zs, z[9]); z[10] = __builtin_fmaf(ca2[2], zs, z[10]); z[11] = __builtin_fmaf(ca2[3], zs, z[11]); z[12] = __builtin_fmaf(ca3[0], zs, z[12]); z[13] = __builtin_fmaf(ca3[1], zs, z[13]); z[14] = __builtin_fmaf(ca3[2], zs, z[14]); z[15] = __builtin_fmaf(ca3[3], zs, z[15]); }
                asm volatile("" : "+v"(z[3]) );
                ca1 = *(const f32x4*)(AB + 4 * 36 + 4); ca2 = *(const f32x4*)(AB + 4 * 36 + 8); ca3 = *(const f32x4*)(AB + 4 * 36 + 12);
                { const float zs = z[3]; z[4] = __builtin_fmaf(cb1[0], zs, z[4]); z[5] = __builtin_fmaf(cb1[1], zs, z[5]); z[6] = __builtin_fmaf(cb1[2], zs, z[6]); z[7] = __builtin_fmaf(cb1[3], zs, z[7]); z[8] = __builtin_fmaf(cb2[0], zs, z[8]); z[9] = __builtin_fmaf(cb2[1], zs, z[9]); z[10] = __builtin_fmaf(cb2[2], zs, z[10]); z[11] = __builtin_fmaf(cb2[3], zs, z[11]); z[12] = __builtin_fmaf(cb3[0], zs, z[12]); z[13] = __builtin_fmaf(cb3[1], zs, z[13]); z[14] = __builtin_fmaf(cb3[2], zs, z[14]); z[15] = __builtin_fmaf(cb3[3], zs, z[15]); }
                asm volatile("" : "+v"(z[4]) );
                cb1 = *(const f32x4*)(AB + 5 * 36 + 4); cb2 = *(const f32x4*)(AB + 5 * 36 + 8); cb3 = *(const f32x4*)(AB + 5 * 36 + 12);
                { const float zs = z[4]; z[5] = __builtin_fmaf(ca1[1], zs, z[5]); z[6] = __builtin_fmaf(ca1[2], zs, z[6]); z[7] = __builtin_fmaf(ca1[3], zs, z[7]); z[8] = __builtin_fmaf(ca2[0], zs, z[8]); z[9] = __builtin_fmaf(ca2[1], zs, z[9]); z[10] = __builtin_fmaf(ca2[2], zs, z[10]); z[11] = __builtin_fmaf(ca2[3], zs, z[11]); z[12] = __builtin_fmaf(ca3[0], zs, z[12]); z[13] = __builtin_fmaf(ca3[1], zs, z[13]); z[14] = __builtin_fmaf(ca3[2], zs, z[14]); z[15] = __builtin_fmaf(ca3[3], zs, z[15]); }
                asm volatile("" : "+v"(z[5]) );
                ca1 = *(const f32x4*)(AB + 6 * 36 + 4); ca2 = *(const f32x4*)(AB + 6 * 36 + 8); ca3 = *(const f32x4*)(AB + 6 * 36 + 12);
                { const float zs = z[5]; z[6] = __builtin_fmaf(cb1[2], zs, z[6]); z[7] = __builtin_fmaf(cb1[3], zs, z[7]); z[8] = __builtin_fmaf(cb2[0], zs, z[8]); z[9] = __builtin_fmaf(cb2[1], zs, z[9]); z[10] = __builtin_fmaf(cb2[2], zs, z[10]); z[11] = __builtin_fmaf(cb2[3], zs, z[11]); z[12] = __builtin_fmaf(cb3[0], zs, z[12]); z[13] = __builtin_fmaf(cb3[1], zs, z[13]); z[14] = __builtin_fmaf(cb3[2], zs, z[14]); z[15] = __builtin_fmaf(cb3[3], zs, z[15]); }
                asm volatile("" : "+v"(z[6]) );
                cb2 = *(const f32x4*)(AB + 7 * 36 + 8); cb3 = *(const f32x4*)(AB + 7 * 36 + 12);
                { const float zs = z[6]; z[7] = __builtin_fmaf(ca1[3], zs, z[7]); z[8] = __builtin_fmaf(ca2[0], zs, z[8]); z[9] = __builtin_fmaf(ca2[1], zs, z[9]); z[10] = __builtin_fmaf(ca2[2], zs, z[10]); z[11] = __builtin_fmaf(ca2[3], zs, z[11]); z[12] = __builtin_fmaf(ca3[0], zs, z[12]); z[13] = __builtin_fmaf(ca3[1], zs, z[13]); z[14] = __builtin_fmaf(ca3[2], zs, z[14]); z[15] = __builtin_fmaf(ca3[3], zs, z[15]); }
                asm volatile("" : "+v"(z[7]) );
                ca2 = *(const f32x4*)(AB + 8 * 36 + 8); ca3 = *(const f32x4*)(AB + 8 * 36 + 12);
                { const float zs = z[7]; z[8] = __builtin_fmaf(cb2[0], zs, z[8]); z[9] = __builtin_fmaf(cb2[1], zs, z[9]); z[10] = __builtin_fmaf(cb2[2], zs, z[10]); z[11] = __builtin_fmaf(cb2[3], zs, z[11]); z[12] = __builtin_fmaf(cb3[0], zs, z[12]); z[13] = __builtin_fmaf(cb3[1], zs, z[13]); z[14] = __builtin_fmaf(cb3[2], zs, z[14]); z[15] = __builtin_fmaf(cb3[3], zs, z[15]); }
                asm volatile("" : "+v"(z[8]) );
                cb2 = *(const f32x4*)(AB + 9 * 36 + 8); cb3 = *(const f32x4*)(AB + 9 * 36 + 12);
                { const float zs = z[8]; z[9] = __builtin_fmaf(ca2[1], zs, z[9]); z[10] = __builtin_fmaf(ca2[2], zs, z[10]); z[11] = __builtin_fmaf(ca2[3], zs, z[11]); z[12] = __builtin_fmaf(ca3[0], zs, z[12]); z[13] = __builtin_fmaf(ca3[1], zs, z[13]); z[14] = __builtin_fmaf(ca3[2], zs, z[14]); z[15] = __builtin_fmaf(ca3[3], zs, z[15]); }
                asm volatile("" : "+v"(z[9]) );
                ca2 = *(const f32x4*)(AB + 10 * 36 + 8); ca3 = *(const f32x4*)(AB + 10 * 36 + 12);
                { const float zs = z[9]; z[10] = __builtin_fmaf(cb2[2], zs, z[10]); z[11] = __builtin_fmaf(cb2[3], zs, z[11]); z[12] = __builtin_fmaf(cb3[0], zs, z[12]); z[13] = __builtin_fmaf(cb3[1], zs, z[13]); z[14] = __builtin_fmaf(cb3[2], zs, z[14]); z[15] = __builtin_fmaf(cb3[3], zs, z[15]); }
                asm volatile("" : "+v"(z[10]) );
                cb3 = *(const f32x4*)(AB + 11 * 36 + 12);
                { const float zs = z[10]; z[11] = __builtin_fmaf(ca2[3], zs, z[11]); z[12] = __builtin_fmaf(ca3[0], zs, z[12]); z[13] = __builtin_fmaf(ca3[1], zs, z[13]); z[14] = __builtin_fmaf(ca3[2], zs, z[14]); z[15] = __builtin_fmaf(ca3[3], zs, z[15]); }
                asm volatile("" : "+v"(z[11]) );
                ca3 = *(const f32x4*)(AB + 12 * 36 + 12);
                { const float zs = z[11]; z[12] = __builtin_fmaf(cb3[0], zs, z[12]); z[13] = __builtin_fmaf(cb3[1], zs, z[13]); z[14] = __builtin_fmaf(cb3[2], zs, z[14]); z[15] = __builtin_fmaf(cb3[3], zs, z[15]); }
                asm volatile("" : "+v"(z[12]) );
                cb3 = *(const f32x4*)(AB + 13 * 36 + 12);
                { const float zs = z[12]; z[13] = __builtin_fmaf(ca3[1], zs, z[13]); z[14] = __builtin_fmaf(ca3[2], zs, z[14]); z[15] = __builtin_fmaf(ca3[3], zs, z[15]); }
                asm volatile("" : "+v"(z[13]) );
                ca3 = *(const f32x4*)(AB + 14 * 36 + 12);
                { const float zs = z[13]; z[14] = __builtin_fmaf(cb3[2], zs, z[14]); z[15] = __builtin_fmaf(cb3[3], zs, z[15]); }
                asm volatile("" : "+v"(z[14]) );
                { const float zs = z[14]; z[15] = __builtin_fmaf(ca3[3], zs, z[15]); }
                asm volatile("" : "+v"(z[15]) );
                if (lane < 32) {
#pragma unroll
                    for (int t = 0; t < 16; ++t) TI[(lane >> 4) * 16 * 40 + t * 40 + (lane & 15)] = f2bf(z[t]);
                }
            }
        }
        };
        if (wid < 4) { P1(); D1(); } else { D1(); P1(); }
        lds_barrier();
        auto P2 = [&]() __attribute__((always_inline)) {
        if constexpr (doP) for (int rep_ = 0; rep_ < ((RWP & 64) ? 2 : 1); ++rep_) {
            const int which = wid >> 2, tt = (wid >> 1) & 1;
            const bf16_t* Xa = which ? ALb : TWb; float* Od = which ? ALf : WLf;
#pragma unroll
            for (int q2 = 0; q2 < 2; ++q2) { const int nt = (wid & 1) * 2 + q2;
                f32x4 acc = (f32x4){0.f, 0.f, 0.f, 0.f};
#pragma unroll
                for (int k = 0; k < 2; ++k) acc = mma16(ldfrag(Xa, RW_LP, tt * 16, k * 32, fr, fq), wfr[q2][k], acc);
#pragma unroll
                for (int rr = 0; rr < 4; ++rr) Od[(tt * 16 + fq * 4 + rr) * 64 + nt * 16 + fr] = acc[rr]; }
            const int pp = tq & 31, cg = tq >> 5, jj = dir ? 31 - pp : pp;
            const bf16_t* r1v = RAW + (pp + 1) * RW_LR + 128 + cg * 4;
            const f32x4 muv = *(const f32x4*)(CV + 448 + cg * 4);
            f32x4 v = ld4bf(r1v);
            v = v + muv * ((ld4bf(r1v - RW_LR) + ld4bf(r1v + RW_LR)) * 0.5f - v);
#pragma unroll
            for (int q = 0; q < 4; ++q) ZVn[(cg * 4 + q) * RW_LP + 32 + jj] = f2bf(v[q]);
        }
        };
        auto D2 = [&]() __attribute__((always_inline)) {
        if constexpr (doD) if (wid < 4) {
            f32x4 acc = (f32x4){0.f, 0.f, 0.f, 0.f};
            acc = mma16(ldfrag(TI, 40, 0, 0, fr, fq), ldfrag(RHSb, 40, wid * 16, 0, fr, fq), acc);
            st4bf(ZVc + (wid * 16 + fr) * RW_LP + fq * 4, acc);
        }
        };
        if (wid < 4) { P2(); D2(); } else { D2(); P2(); }
        lds_barrier();
        if (RWP & 16) { lds_barrier(); lds_barrier(); lds_barrier(); lds_barrier(); lds_barrier(); }
        const int j = dir ? 31 - pi : pi;
        f32x4 r, kd, av, bv, lw, cin;
        f32x4 xacc = (f32x4){0.f, 0.f, 0.f, 0.f};
        auto P3 = [&]() __attribute__((always_inline)) {
        if constexpr (doP) for (int rep_ = 0; rep_ < ((RWP & 2) ? 2 : 1); ++rep_) {
            const f32x4 w0v = *(const f32x4*)(CV + n4), a0v = *(const f32x4*)(CV + 64 + n4), kkw = *(const f32x4*)(CV + 128 + n4), kaw = *(const f32x4*)(CV + 192 + n4), rkw = *(const f32x4*)(CV + 256 + n4);
            const f32x4 mur = *(const f32x4*)(CV + 320 + n4), muk = *(const f32x4*)(CV + 384 + n4);
            const f32x4 wl = w0v + *(const f32x4*)(WLf + pi * 64 + n4), al = a0v + *(const f32x4*)(ALf + pi * 64 + n4);
            const bf16_t* r1 = RAW + (pi + 1) * RW_LR; const bf16_t* rp = RAW + pi * RW_LR; const bf16_t* rn = RAW + (pi + 2) * RW_LR;
            f32x4 k;
            r = ld4bf(r1 + n4); k = ld4bf(r1 + 64 + n4);
            r = r + mur * ((ld4bf(rp + n4) + ld4bf(rn + n4)) * 0.5f - r);
            k = k + muk * ((ld4bf(rp + 64 + n4) + ld4bf(rn + 64 + n4)) * 0.5f - k);
            f32x4 a, kk = k * kkw;
            float ssq = kk[0] * kk[0] + kk[1] * kk[1] + kk[2] * kk[2] + kk[3] * kk[3];
            ssq = rsum16(ssq);
            kk = kk * __builtin_amdgcn_rsqf(fmaxf(ssq, 1e-24f));
#pragma unroll
            for (int q = 0; q < 4; ++q) { lw[q] = -0.8750387749f * sigmoidf_(wl[q]); a[q] = sigmoidf_(al[q]); }
            kd = k * ((a - 1.0f) * kaw + 1.0f);
            float bs = r[0] * kd[0] * rkw[0] + r[1] * kd[1] * rkw[1] + r[2] * kd[2] * rkw[2] + r[3] * kd[3] * rkw[3];
            bs = rsum16(bs);
            av = kk * -1.0f; bv = kk * a;
            f32x4 wt;
#pragma unroll
            for (int q = 0; q < 4; ++q) {
                const float lwq = lw[q];
                const auto e16 = __builtin_amdgcn_permlane16_swap(__builtin_bit_cast(unsigned, lwq), __builtin_bit_cast(unsigned, lwq), false, false);
                const unsigned e16a = e16[0], e16b = e16[1];
                const float y = __builtin_bit_cast(float, e16a) + __builtin_bit_cast(float, e16b);
                const auto e32 = __builtin_amdgcn_permlane32_swap(__builtin_bit_cast(unsigned, y), __builtin_bit_cast(unsigned, y), false, false);
                const unsigned e32a = e32[0], e32b = e32[1];
                wt[q] = __builtin_bit_cast(float, e32a) + __builtin_bit_cast(float, e32b);
                cin[q] = ((fq & 1) ? y : lwq) + ((fq & 2) ? (wt[q] - y) : 0.f);
            }
            if (fq == 0) *(f32x4*)(WT + wid * 64 + n4) = wt;
            const int t = t0p + pi;
            if (t >= CTXL && (tq & 15) == 0) BSC[((size_t)bl * SEQ + (t - CTXL)) * 16 + h] = bs;
        }
        };
        auto D3 = [&]() __attribute__((always_inline)) {
        if constexpr (doD) {
            xacc = mma16(ldfrag(A21b, 40, 0, 0, fr, fq), ldfrag(ZVc, RW_LP, (wid & 3) * 16, 0, fr, fq), xacc);
#pragma unroll
            for (int rr = 0; rr < 4; ++rr) xacc[rr] += RHS[(16 + fq * 4 + rr) * 64 + (wid & 3) * 16 + fr];
        }
        if constexpr (doD) if (wid < 4) st4bf(XB + (wid * 16 + fr) * 40 + fq * 4, xacc);
        };
        if (wid < 4) { P3(); D3(); } else { D3(); P3(); }
        lds_barrier();
        auto P4 = [&]() __attribute__((always_inline)) {
        if constexpr (doP) for (int rep_ = 0; rep_ < ((RWP & 4) ? 2 : 1); ++rep_) {
            f32x4 pre = (f32x4){0.f, 0.f, 0.f, 0.f}, cle = (f32x4){0.f, 0.f, 0.f, 0.f};
#pragma unroll
            for (int w = 0; w < 8; ++w) { const f32x4 t4 = *(const f32x4*)(WT + w * 64 + n4); cle = cle + t4; if (w < wid) pre = pre + t4; }
            const f32x4 cim = cin + pre;
            const f32x4 clj = dir ? cle - cim + lw : cim;
            const f32x4 clp = dir ? cle - cim : cim - lw;
            f32x4 at, rt, bt, kt, bh, kh;
#pragma unroll
            for (int q = 0; q < 4; ++q) { const float ep = __builtin_amdgcn_exp2f(clp[q]), ej = __builtin_amdgcn_exp2f(clj[q]), ei = __builtin_amdgcn_exp2f(-clj[q]), ee = __builtin_amdgcn_exp2f(cle[q] - clj[q]);
                at[q] = av[q] * ep; rt[q] = r[q] * ej; bt[q] = bv[q] * ei; kt[q] = kd[q] * ei; bh[q] = bv[q] * ee; kh[q] = kd[q] * ee; }
            if (tq < 16) { f32x4 e;
#pragma unroll
                for (int q = 0; q < 4; ++q) e[q] = __builtin_amdgcn_exp2f(cle[q]);
                *(f32x4*)(PLn + n4) = e; }
            st4bf(AR + j * RW_LP + n4, at); st4bf(AR + (32 + j) * RW_LP + n4, rt);
            st4bf(BK + j * RW_LP + n4, bt); st4bf(BK + (32 + j) * RW_LP + n4, kt);
            const int cbh = (((j >> 3) ^ (tq & 7)) << 3) | (j & 7), ckh = ((((j >> 3) + 4) ^ (tq & 7)) << 3) | (j & 7);
#pragma unroll
            for (int q = 0; q < 4; ++q) { BKhn[(n4 + q) * RW_LP + cbh] = f2bf(bh[q]); BKhn[(n4 + q) * RW_LP + ckh] = f2bf(kh[q]); }
        }
        };
        auto D4 = [&]() __attribute__((always_inline)) {
        if constexpr (doD) if (wid < 4) {
            f32x4 acc = (f32x4){0.f, 0.f, 0.f, 0.f};
            acc = mma16(ldfrag(TI + 16 * 40, 40, 0, 0, fr, fq), ldfrag(XB, 40, wid * 16, 0, fr, fq), acc);
            st4bf(ZVc + (wid * 16 + fr) * RW_LP + 16 + fq * 4, acc);
        }
        };
        if (wid < 4) { P4(); D4(); } else { D4(); P4(); }
        lds_barrier();
        auto P5 = [&]() __attribute__((always_inline)) {
        if constexpr (doP) for (int rep_ = 0; rep_ < ((RWP & 8) ? 2 : 1); ++rep_) {
            const int ti = wid >> 1;
#pragma unroll
            for (int q2 = 0; q2 < 2; ++q2) {
                const int si = (wid & 1) * 2 + q2;
                f32x4 acc = (f32x4){0.f, 0.f, 0.f, 0.f};
#pragma unroll
                for (int k = 0; k < 2; ++k) acc = mma16(ldfrag(AR, RW_LP, ti * 16, k * 32, fr, fq), ldfrag(BK, RW_LP, si * 16, k * 32, fr, fq), acc);
                const int s = (si & 1) * 16 + fr;
                const bool incl = ti >= 2, kcols = si >= 2;
                bf16_t* dstb = kcols ? (incl ? ARK : AAK) : ARBn;
#pragma unroll
                for (int rr = 0; rr < 4; ++rr) { const int t = (ti & 1) * 16 + fq * 4 + rr;
                    const float val = (incl ? (s <= t) : (s < t)) ? acc[rr] : 0.f;
                    if (kcols || incl) dstb[t * 40 + s] = f2bf(val);
                    else { AABT[s * 36 + t] = val; if (ti == 1 && si == 0) A21b[(t - 16) * 40 + s] = f2bf(val); } }
            }
        }
        };
        auto D5 = [&]() __attribute__((always_inline)) {
        if constexpr (doD) {
            const int nt = wid >> 1;
            const f32x4 pl = *(const f32x4*)(PLc + nt * 16 + fq * 4);
#pragma unroll
            for (int q2 = 0; q2 < 2; ++q2) {
                const int vt = (wid & 1) * 2 + q2;
                Sacc[q2] = Sacc[q2] * pl;
#pragma unroll
                for (int k = 0; k < 2; ++k) Sacc[q2] = mma16(*(const bf16x8*)(BKhc + (nt * 16 + fr) * RW_LP + (((k * 4 + fq) ^ (((nt & 1) << 2) + (fr >> 2))) << 3)), ldfrag(ZVc, RW_LP, vt * 16, k * 32, fr, fq), Sacc[q2]);
                st4bf(Sb + (vt * 16 + fr) * RW_LP + nt * 16 + fq * 4, Sacc[q2]);
            }
            if (t0 >= CTXL) {
                const int vt = wid >> 1, tt = wid & 1;
                f32x4 acc = (f32x4){0.f, 0.f, 0.f, 0.f};
                acc = mma16(ldfrag(ZVc, RW_LP, vt * 16, 0, fr, fq), ldfrag(ARBc, 40, tt * 16, 0, fr, fq), acc);
                const int t = tt * 16 + fr, v0 = vt * 16 + fq * 4;
#pragma unroll
                for (int rr = 0; rr < 4; ++rr) acc[rr] += YB[t * 64 + v0 + rr];
                const int tn = scan_t<32>(dir, ci, t);
                st4bf(OUT + ((size_t)bl * SEQ + (tn - CTXL)) * 1024 + h * 64 + v0, acc);
            }
        }
        };
        if (wid < 4) { P5(); D5(); } else { D5(); P5(); }
        lds_barrier();
    };
    step(TrueT{}, FalseT{}, -1);
#pragma unroll 1
    for (int ci = 0; ci < NC - 1; ++ci) step(TrueT{}, TrueT{}, ci);
    step(FalseT{}, TrueT{}, NC - 1);
#undef RW_PREFETCH
}

__device__ __forceinline__ void phase_mix_cd(const KP& kp, unsigned char* lds, int which) {
    if (which & 1) for (int u = obid(); u < 256; u += gridDim.x) { rwkv_unit(kp, lds, u >> 5, (u >> 1) & 15, u & 1); __syncthreads(); }
    if (which & 2) for (int u = obid(); u < 512; u += gridDim.x) { const int slot = ((u & 255) >> 3) + 32 * (u >> 8), pair = (u & 7) * 8 + (slot >> 3);
        attn_unit(kp, lds, pair >> 3, pair & 7, slot & 7); __syncthreads(); }
}

struct EpiFinCD {
    const bf16_t* OF; const bf16_t* OB; const bf16_t* P; const float* BSC; const float* ln; const float* mu; bf16_t* AOUT;
    __device__ __forceinline__ void operator()(const f32x4 (&acc)[4][4], int rb, int cb, int fr, int fq) const {
        const int head = cb >> 6;
        f32x4 muv[4], lnv[4];
#pragma unroll
        for (int j = 0; j < 4; ++j) { const int col = cb + j * 16 + fq * 4; muv[j] = *(const f32x4*)(mu + 2048 + col); lnv[j] = *(const f32x4*)(ln + col); }
        u32x2 rof[2][4], rob[2][4], rv[2][4], rvp[2][4], rvn[2][4]; float bonv[2];
#define FC_REQ(i_, set_) do { const int lr_ = rb + (i_) * 16 + fr, s_ = lr_ & 2047; const size_t prow_ = (size_t)(lr_ >> 11) * TT + CTXL + s_; \
            _Pragma("unroll") for (int j = 0; j < 4; ++j) { const int col = cb + j * 16 + fq * 4; const bf16_t* pv = P + prow_ * CD_N + CD_V + col; \
                rof[set_][j] = *(const u32x2*)(OF + (size_t)lr_ * 1024 + col); rob[set_][j] = *(const u32x2*)(OB + (size_t)lr_ * 1024 + col); \
                rv[set_][j] = *(const u32x2*)pv; \
                rvp[set_][j] = s_ > 0 ? *(const u32x2*)(pv - CD_N) : (u32x2){0u, 0u}; \
                rvn[set_][j] = s_ < SEQ - 1 ? *(const u32x2*)(pv + CD_N) : (u32x2){0u, 0u}; } \
            bonv[set_] = BSC[(size_t)lr_ * 16 + head] + BSC[(size_t)RGL * 16 + (size_t)lr_ * 16 + head]; } while (0)
        FC_REQ(0, 0);
#pragma unroll
        for (int i = 0; i < 4; ++i) { const int lr = rb + i * 16 + fr; const int cs = i & 1;
            if (i + 1 < 4) FC_REQ(i + 1, (i + 1) & 1);
            const float bon = bonv[cs];
            f32x4 o[4]; float ss = 0.f;
#pragma unroll
            for (int j = 0; j < 4; ++j) {
                o[j] = (f32x4){lo2f(rof[cs][j].x), hi2f(rof[cs][j].x), lo2f(rof[cs][j].y), hi2f(rof[cs][j].y)} + (f32x4){lo2f(rob[cs][j].x), hi2f(rob[cs][j].x), lo2f(rob[cs][j].y), hi2f(rob[cs][j].y)};
                ss += o[j][0] * o[j][0] + o[j][1] * o[j][1] + o[j][2] * o[j][2] + o[j][3] * o[j][3]; }
            ss = xsum_rows(ss);
            const float rstd = rsqrtf(ss * (1.0f / 64.0f) + EPS);
            f32x4 y[4];
#pragma unroll
            for (int j = 0; j < 4; ++j) {
                const f32x4 v = (f32x4){lo2f(rv[cs][j].x), hi2f(rv[cs][j].x), lo2f(rv[cs][j].y), hi2f(rv[cs][j].y)};
                const f32x4 vp = (f32x4){lo2f(rvp[cs][j].x), hi2f(rvp[cs][j].x), lo2f(rvp[cs][j].y), hi2f(rvp[cs][j].y)};
                const f32x4 vn = (f32x4){lo2f(rvn[cs][j].x), hi2f(rvn[cs][j].x), lo2f(rvn[cs][j].y), hi2f(rvn[cs][j].y)};
                const f32x4 vl = v + muv[j] * ((vp + vn) * 0.5f - v);
                y[j] = (o[j] * rstd * lnv[j] + vl * bon) * acc[i][j]; }
#pragma unroll
            for (int j = 0; j < 4; ++j) st4bf(AOUT + (size_t)lr * 1536 + 512 + cb + j * 16 + fq * 4, y[j]);
        }
#undef FC_REQ
    }
};
constexpr int FT_LD = 136;
template <class Epi>
__device__ __forceinline__ void gemm_tile_k128(unsigned char* lds, const bf16_t* __restrict__ A, const bf16_t* __restrict__ Bt, int mt, int nt, const Epi& epi) {
    const int tid = otid(), lane = tid & 63, wid = __builtin_amdgcn_readfirstlane(tid >> 6), wm = wid >> 1, wn = wid & 1, fr = lane & 15, fq = lane >> 4;
    bf16_t* sA = (bf16_t*)lds;
    bf16_t* sB = sA + 256 * FT_LD;
    const bf16_t* At = A + (size_t)mt * 256 * 128; const bf16_t* Btt = Bt + (size_t)nt * 128 * 128;
    u32x4 ra[8], rb[4];
#pragma unroll
    for (int i = 0; i < 8; ++i) ra[i] = *(const u32x4*)(At + (size_t)(tid + i * 512) * 8);
#pragma unroll
    for (int i = 0; i < 4; ++i) rb[i] = *(const u32x4*)(Btt + (size_t)(tid + i * 512) * 8);
    lds_barrier();
#pragma unroll
    for (int i = 0; i < 8; ++i) { const int p = tid + i * 512; *(u32x4*)(sA + (p >> 4) * FT_LD + (p & 15) * 8) = ra[i]; }
#pragma unroll
    for (int i = 0; i < 4; ++i) { const int p = tid + i * 512; *(u32x4*)(sB + (p >> 4) * FT_LD + (p & 15) * 8) = rb[i]; }
    lds_barrier();
    f32x4 acc[4][4];
#pragma unroll
    for (int i = 0; i < 4; ++i)
#pragma unroll
        for (int j = 0; j < 4; ++j) acc[i][j] = (f32x4){0.f, 0.f, 0.f, 0.f};
#pragma unroll
    for (int kt = 0; kt < 4; ++kt) {
        bf16x8 af[4], bfr[4];
#pragma unroll
        for (int i = 0; i < 4; ++i) af[i] = ldfrag(sA, FT_LD, wm * 64 + i * 16, kt * 32, fr, fq);
#pragma unroll
        for (int j = 0; j < 4; ++j) bfr[j] = ldfrag(sB, FT_LD, wn * 64 + j * 16, kt * 32, fr, fq);
#pragma unroll
        for (int i = 0; i < 4; ++i)
#pragma unroll
            for (int j = 0; j < 4; ++j) acc[i][j] = mma16(bfr[j], af[i], acc[i][j]);
    }
    epi(acc, mt * 256 + wm * 64, nt * 128 + wn * 64, fr, fq);
}
PHASE_FN void phase_fin_cd(const KP& kp, unsigned char* lds) {
    EpiFinCD ep{WSP(const bf16_t, WS_BIG + L1_OF), WSP(const bf16_t, WS_BIG + L1_OB), WSP(const bf16_t, WS_BIG + L1_P), WSP(const float, WS_BSC), KIN(33), KIN(24), WSP(bf16_t, WS_BIG + L1_AOUT)};
    for (int u = obid(); u < (RGL / 256) * 8; u += gridDim.x) gemm_tile_k128(lds, WSP(const bf16_t, WS_SG), WSP(const bf16_t, WS_WMIX + WM_G2), u >> 3, u & 7, ep);
    lds_barrier();
}
PHASE_FN void phase_gemm_out_cd(const KP& kp, unsigned char* lds) {
    pg8::Gemm g{WSP(const bf16_t, WS_BIG + L1_AOUT), WSP(const bf16_t, WS_WMIX + WM_CD_OUT), RGL, 1024, 1536, nullptr, 0x7fffffff};
    pg8::StaticOrder S; S.init(RGL, 1024, (int)gridDim.x, obid());
    pg8::EpiBfG E{WSP(bf16_t, WS_BIG + L1_U), 1024, 1024, 0x7fffffff, 1.0f};
    pg8::gemm_phase<pg8::EpiBfG, pg8::StaticOrder, false>((PG8_LAS unsigned char*)lds, g, S, E, nullptr);
    __syncthreads();
}

__device__ __attribute__((noinline)) void grid_sync(unsigned* barw, unsigned x, volatile LAS unsigned* st) { XcdBarrier b; b.bar = barw; b.x = x; b.st = st; xcd_barrier(b); }
constexpr int N_PHASES = 34;
__global__ void __launch_bounds__(512, 2) fwd_kernel(KP kparg) {
    extern __shared__ __attribute__((aligned(16))) unsigned char lds[];
    const int lo = kparg.ph_lo, hi = kparg.ph_hi;
    const KP& kp = kparg;
    volatile LAS unsigned* xbst = (volatile LAS unsigned*)(LAS unsigned char*)(lds + LDS_BYTES - 16);
    if (threadIdx.x == 0) { xbst[0] = 0u; xbst[1] = 0u; }
    __syncthreads();
    XcdBarrier bar; bar.bar = (unsigned*)kparg.ws; bar.x = 0; bar.st = xbst;
    if (hi - lo > 1) bar = xcd_barrier_post((unsigned*)kparg.ws, xbst);
#define IN(k) (lo <= (k) && (k) < hi)
#define SEAM(k) do { if (IN(k) && IN((k) + 1)) { grid_sync((unsigned*)kp.ws, bar.x, xbst); if (PROBE_DUP & 512) grid_sync((unsigned*)kp.ws, bar.x, xbst); } } while (0)
#define PHASE(...) do { if (IN(ph)) { __VA_ARGS__ } SEAM(ph); ++ph; } while (0)
    int ph = 0;
    PHASE(phase_mod(kp, lds); __syncthreads(); phase_conv_ab(kp, lds); if (PROBE_DUP & 32) { __syncthreads(); phase_mod(kp, lds); __syncthreads(); phase_conv_ab(kp, lds); });
    static_assert(NG == 2, "phase program written out for two batch groups");
    PHASE(phase_u(kp, 0, 0, obid(), (int)gridDim.x, false););
    PHASE(phase_gemm_in(kp, lds, 0, 0); if (PROBE_DUP & 8) phase_gemm_in(kp, lds, 0, 0););
    PHASE(phase_xconv(kp); if (PROBE_DUP & 2048) phase_xconv(kp););
    PHASE(phase_scan_ab(kp, lds); if (PROBE_DUP & 1) { __syncthreads(); phase_scan_ab(kp, lds); });
    PHASE(phase_fin_ab(kp););
    PHASE(phase_gemm_out_ab(kp, lds, 0); phase_gemm_in(kp, lds, 0, 1, (int)gridDim.x - 32););
    PHASE(phase_r(kp, lds, 0, 0, L0_HB); __syncthreads(); phase_xconv(kp););
    PHASE(phase_scan_ab(kp, lds););
    PHASE(phase_fin_ab(kp););
    PHASE(phase_gemm_out_ab(kp, lds, 1););
    PHASE(phase_r(kp, lds, 0, 1, L0_U););
    PHASE(phase_moe_gather(kp, 0); if (PROBE_DUP & 128) { phase_moe_gather(kp, 0); phase_moe_gather(kp, 0); } phase_conv_cd(kp, lds););
    PHASE(phase_moe_gemm(kp, lds, 0, false); if (PROBE_DUP & 16) { __syncthreads(); phase_moe_gemm(kp, lds, 0, false); });
    PHASE(phase_moe_gemm(kp, lds, 0, true); if (PROBE_DUP & 16) { __syncthreads(); phase_moe_gemm(kp, lds, 0, true); });
    PHASE(phase_combine(kp, 0););
#pragma unroll
    for (int g = 0; g < NG; ++g) {
        PHASE(phase_gemm_in(kp, lds, 1, g); if (PROBE_DUP & 8) phase_gemm_in(kp, lds, 1, g););
        PHASE(phase_prep_cd(kp););
        PHASE(phase_upproj(kp, lds); if (PROBE_DUP & 4096) phase_upproj(kp, lds););
        PHASE(phase_mix_cd(kp, lds, 3); if (PROBE_DUP & 2) { __syncthreads(); phase_mix_cd(kp, lds, 1); } if (PROBE_DUP & 4) { __syncthreads(); phase_mix_cd(kp, lds, 2); });
        PHASE(phase_fin_cd(kp, lds); if (PROBE_DUP & 4096) phase_fin_cd(kp, lds););
        PHASE(phase_gemm_out_cd(kp, lds); if (PROBE_DUP & 256) phase_gemm_out_cd(kp, lds););
        PHASE(phase_r(kp, lds, 1, g, L1_U););
    }
    PHASE(phase_moe_gather(kp, 1); phase_conv_moe(kp, lds, 1, obid(), (int)gridDim.x); if (PROBE_DUP & 64) { phase_conv_moe(kp, lds, 1, obid(), (int)gridDim.x); phase_conv_moe(kp, lds, 1, obid(), (int)gridDim.x); });
    PHASE(phase_moe_gemm(kp, lds, 1, false););
    PHASE(phase_moe_gemm(kp, lds, 1, true););
    PHASE(phase_combine(kp, 1););
#undef PHASE
#undef IN
#undef SEAM
}

extern "C" void kernel_launch(void* const* d_in, const int* in_sizes, int n_in, void* d_out, int out_size, void* d_ws, size_t ws_size, hipStream_t stream) {
    static int grid = 0;
    if (grid == 0) {
        if (n_in != 42 || out_size != NLAT * D || ws_size < WS_NEED) { fprintf(stderr, "kernel_launch: unexpected shapes: n_in %d out %d ws %zu (need %zu)\n", n_in, out_size, ws_size, (size_t)WS_NEED); grid = -1; return; }
        int dev = 0, cus = 0, per_cu = 0;
        if (hipGetDevice(&dev) != hipSuccess || hipDeviceGetAttribute(&cus, hipDeviceAttributeMultiprocessorCount, dev) != hipSuccess) { grid = -1; return; }
        if (hipFuncSetAttribute((const void*)fwd_kernel, hipFuncAttributeMaxDynamicSharedMemorySize, LDS_BYTES) != hipSuccess) { fprintf(stderr, "kernel_launch: hipFuncSetAttribute failed\n"); grid = -1; return; }
        if (hipOccupancyMaxActiveBlocksPerMultiprocessor(&per_cu, (const void*)fwd_kernel, 512, LDS_BYTES) != hipSuccess || per_cu < 1) { fprintf(stderr, "kernel_launch: occupancy query says %d blocks per CU\n", per_cu); grid = -1; (void)hipGetLastError(); return; }
        grid = cus;
    }
    if (grid < 0) return;
    (void)hipMemsetAsync(d_ws, 0, CTL_BYTES, stream);
    KP kp{};
    for (int i = 0; i < 42; ++i) kp.in[i] = (const float*)d_in[i];
    kp.out = (float*)d_out; kp.ws = (unsigned char*)d_ws;
#if N_LAUNCH_MODE == 1
    kp.ph_lo = 0; kp.ph_hi = N_PHASES;
    hipLaunchKernelGGL(fwd_kernel, dim3(grid), dim3(512), LDS_BYTES, stream, kp);
#else
    for (int p = 0; p < N_PHASES; ++p) { kp.ph_lo = p; kp.ph_hi = p + 1; hipLaunchKernelGGL(fwd_kernel, dim3(grid), dim3(512), LDS_BYTES, stream, kp); }
#endif
}
```
